# Optimizing an MI355X kernel written in HIP

```python
import jax, jax.numpy as jnp
from jax import lax
import numpy as np

D_MODEL = 1024
BATCH = 4
SEQ = 8192
DEPTH = 2

GRID_W = 64
CTX_LEN = 256
N_EVEN = (DEPTH + 1) // 2
N_ODD = DEPTH // 2
HEAD_DIM = 64
N_HEADS = (D_MODEL // 2) // HEAD_DIM
N_KV_HEADS = 2
GROUP = N_HEADS // N_KV_HEADS
WINDOW = 128
ATT_BLOCK = 128
ROPE_THETA = 10000.0
FOURIER_W = D_MODEL // 2
FOURIER_GROUPS = 4
FOURIER_GROUP_W = FOURIER_W // FOURIER_GROUPS
Q_W = N_HEADS * HEAD_DIM
KV_W = N_KV_HEADS * HEAD_DIM
EVEN_MIX_W = FOURIER_W + Q_W
EVEN_IN_W = EVEN_MIX_W + 2 * KV_W
CONV_W = 31
CONV_CH = D_MODEL
N_EXPERTS = 16
N_GROUPS = 4
EXPERTS_PER_GROUP = N_EXPERTS // N_GROUPS
TOP_K = 2
GROUP_SCORE_K = 2
EXPERT_FF = 512
MOE_BLOCK = 128
EPS = 1e-6
NEG_INF = -1e30

kernel_name = 'hybrid_fourier_swa_conformer_grouped_moe'

f32 = jnp.float32


def _rmsnorm(x, g):
    xf = x.astype(f32)
    y = xf * lax.rsqrt(jnp.mean(xf * xf, axis=-1, keepdims=True) + EPS)
    return (y * g.astype(f32)).astype(x.dtype)


def _layernorm(x, g, b):
    xf = x.astype(f32)
    mu = jnp.mean(xf, axis=-1, keepdims=True)
    var = jnp.mean(jnp.square(xf - mu), axis=-1, keepdims=True)
    return ((xf - mu) * lax.rsqrt(var + EPS) * g.astype(f32) + b.astype(f32)).astype(x.dtype)


def _adaln(cond, w, b):
    m = jax.nn.silu(cond) @ w + b
    parts = jnp.split(m, 6, axis=-1)
    if m.ndim == 2:
        parts = [p_[:, None, :] for p_ in parts]
    return parts


def _modulate(xn, shift, scale):
    return xn * (1 + scale) + shift


def _rope_half(xh, pos):
    half = xh.shape[-1] // 2
    inv = ROPE_THETA ** (-jnp.arange(half, dtype=f32) / half)
    ang = pos[:, None] * inv[None, :]
    cos = jnp.cos(ang)[None, :, None, :]
    sin = jnp.sin(ang)[None, :, None, :]
    x1 = xh[..., :half].astype(f32)
    x2 = xh[..., half:].astype(f32)
    return jnp.concatenate([x1 * cos - x2 * sin, x1 * sin + x2 * cos], axis=-1).astype(xh.dtype)


def _axial_rope(x, row, col):
    h = x.shape[-1] // 2
    return jnp.concatenate([_rope_half(x[..., :h], row), _rope_half(x[..., h:], col)], axis=-1)


def _fourier_mix(u):
    B, L, _ = u.shape
    ug = u.reshape(B, L, FOURIER_GROUPS, FOURIER_GROUP_W).astype(f32)
    y = jnp.fft.fftn(ug, axes=(1, 3), norm='ortho').real
    return y.reshape(B, L, FOURIER_W).astype(u.dtype)


def _sink_softmax(logits, sink):
    sk = jnp.broadcast_to(sink, logits.shape[:-1] + (1,))
    p = jax.nn.softmax(jnp.concatenate([logits, sk], axis=-1), axis=-1)
    return p[..., :-1]


def _window_attention(q, k, v, ck, cv, sink):
    B, L, _, _ = q.shape
    C = ck.shape[1]
    nb = L // ATT_BLOCK
    scale = HEAD_DIM ** -0.5
    qg = q.reshape(B, nb, ATT_BLOCK, N_KV_HEADS, GROUP, HEAD_DIM).transpose(1, 0, 2, 3, 4, 5)
    pad = ((0, 0), (ATT_BLOCK, ATT_BLOCK), (0, 0), (0, 0))
    kp = jnp.pad(k, pad)
    vp = jnp.pad(v, pad)
    idx = jnp.arange(nb)[:, None] * ATT_BLOCK + jnp.arange(3 * ATT_BLOCK)[None, :]
    kb = jnp.moveaxis(kp[:, idx], 1, 0)
    vb = jnp.moveaxis(vp[:, idx], 1, 0)
    sink_l = sink.astype(f32).reshape(N_KV_HEADS, GROUP)[None, :, :, None, None]
    offs = jnp.arange(3 * ATT_BLOCK)[None, :] - ATT_BLOCK - jnp.arange(ATT_BLOCK)[:, None]

    def block(args):
        qb, kbb, vbb, j = args
        kpos = j * ATT_BLOCK - ATT_BLOCK + jnp.arange(3 * ATT_BLOCK)
        valid = (jnp.abs(offs) <= WINDOW) & ((kpos >= 0) & (kpos < L))[None, :]
        s_c = jnp.einsum('bqkgd,bckd->bkgqc', qb, ck, preferred_element_type=f32) * scale
        s_l = jnp.einsum('bqkgd,bpkd->bkgqp', qb, kbb, preferred_element_type=f32) * scale
        s_l = jnp.where(valid, s_l, NEG_INF)
        p = _sink_softmax(jnp.concatenate([s_c, s_l], axis=-1), sink_l)
        p_c = p[..., :C].astype(vbb.dtype)
        p_l = p[..., C:].astype(vbb.dtype)
        return (jnp.einsum('bkgqc,bckd->bqkgd', p_c, cv)
                + jnp.einsum('bkgqp,bpkd->bqkgd', p_l, vbb))

    o = lax.map(block, (qg, kb, vb, jnp.arange(nb)))
    return o.transpose(1, 0, 2, 3, 4, 5).reshape(B, L, Q_W)


def _context_attention(qc, ck, cv, sink):
    B, C, _, _ = qc.shape
    qg = qc.reshape(B, C, N_KV_HEADS, GROUP, HEAD_DIM)
    s = jnp.einsum('bqkgd,bckd->bkgqc', qg, ck, preferred_element_type=f32) * (HEAD_DIM ** -0.5)
    p = _sink_softmax(s, sink.astype(f32).reshape(N_KV_HEADS, GROUP)[None, :, :, None, None])
    o = jnp.einsum('bkgqc,bckd->bqkgd', p.astype(cv.dtype), cv)
    return o.reshape(B, C, Q_W)


def _even_mixer(h, hc, w_in, w_out, sink, ctx_out):
    B, L, _ = h.shape
    p = h @ w_in
    u_f = p[..., :FOURIER_W]
    q = p[..., FOURIER_W:EVEN_MIX_W].reshape(B, L, N_HEADS, HEAD_DIM)
    k = p[..., EVEN_MIX_W:EVEN_MIX_W + KV_W].reshape(B, L, N_KV_HEADS, HEAD_DIM)
    v = p[..., EVEN_MIX_W + KV_W:].reshape(B, L, N_KV_HEADS, HEAD_DIM)
    pc = hc @ (w_in if ctx_out else w_in[:, EVEN_MIX_W:])
    C = hc.shape[1]
    ck = pc[..., -2 * KV_W:-KV_W].reshape(B, C, N_KV_HEADS, HEAD_DIM)
    cv = pc[..., -KV_W:].reshape(B, C, N_KV_HEADS, HEAD_DIM)
    n_rows = L // GRID_W
    row = jnp.repeat(jnp.arange(n_rows, dtype=f32), GRID_W)
    col = jnp.tile(jnp.arange(GRID_W, dtype=f32), n_rows)
    q = _axial_rope(q, row, col)
    k = _axial_rope(k, row, col)
    attn = _window_attention(q, k, v, ck, cv, sink)
    out = jnp.concatenate([_fourier_mix(u_f), attn], axis=-1) @ w_out
    out_c = None
    if ctx_out:
        qc = pc[..., FOURIER_W:EVEN_MIX_W].reshape(B, C, N_HEADS, HEAD_DIM)
        out_c = jnp.concatenate([_fourier_mix(pc[..., :FOURIER_W]),
                                 _context_attention(qc, ck, cv, sink)], axis=-1) @ w_out
    return out, out_c


def _conformer_conv(h, pw1_w, pw1_b, dw_w, dw_b, ln_g, ln_b, pw2_w, pw2_b):
    a, g = jnp.split(h @ pw1_w + pw1_b, 2, axis=-1)
    u = a * jax.nn.sigmoid(g)
    u = lax.conv_general_dilated(u, dw_w[:, None, :], window_strides=(1,),
                                 padding=[(CONV_W // 2, CONV_W // 2)],
                                 dimension_numbers=('NWC', 'WIO', 'NWC'),
                                 feature_group_count=u.shape[-1]) + dw_b
    u = jax.nn.silu(_layernorm(u, ln_g, ln_b))
    return u @ pw2_w + pw2_b


def _grouped_moe(h, router_w, router_b, w_gate, w_up, w_down):
    B, L, D = h.shape
    T = B * L
    t = h.reshape(T, D)
    scores = jax.nn.sigmoid(jnp.matmul(t.astype(f32), router_w.astype(f32)))
    grouped = (scores + router_b.astype(f32)).reshape(T, N_GROUPS, EXPERTS_PER_GROUP)
    group_score = lax.top_k(grouped, GROUP_SCORE_K)[0].sum(-1)
    g_sel = jnp.argmax(group_score, axis=-1)
    in_group = jnp.take_along_axis(grouped, g_sel[:, None, None], axis=1)[:, 0]
    _, local = lax.top_k(in_group, TOP_K)
    e_idx = g_sel[:, None] * EXPERTS_PER_GROUP + local
    w = jnp.take_along_axis(scores, e_idx, axis=1)
    w = w / jnp.sum(w, axis=-1, keepdims=True)
    A = T * TOP_K
    flat_e = e_idx.reshape(A).astype(jnp.int32)
    flat_tok = jnp.repeat(jnp.arange(T, dtype=jnp.int32), TOP_K)
    flat_w = w.reshape(A).astype(h.dtype)
    order = jnp.argsort(flat_e)
    sorted_e = flat_e[order]
    counts = jnp.bincount(flat_e, length=N_EXPERTS)
    starts = jnp.cumsum(counts) - counts
    padded = (counts + MOE_BLOCK - 1) // MOE_BLOCK * MOE_BLOCK
    pends = jnp.cumsum(padded)
    pstarts = pends - padded
    dest = pstarts[sorted_e] + jnp.arange(A) - starts[sorted_e]
    n_blocks = -(-A // MOE_BLOCK) + N_EXPERTS
    n_slots = n_blocks * MOE_BLOCK
    slot_tok = jnp.full((n_slots,), T, jnp.int32).at[dest].set(flat_tok[order])
    slot_w = jnp.zeros((n_slots,), h.dtype).at[dest].set(flat_w[order])
    block_e = jnp.minimum(jnp.searchsorted(pends, jnp.arange(n_blocks) * MOE_BLOCK, side='right'),
                          N_EXPERTS - 1)
    t_pad = jnp.concatenate([t, jnp.zeros((1, D), t.dtype)], axis=0)

    def expert_block(args):
        tok, e = args
        xb = t_pad[tok]
        hid = jax.nn.silu(xb @ w_gate[e]) * (xb @ w_up[e])
        return hid @ w_down[e]

    y_slots = lax.map(expert_block, (slot_tok.reshape(n_blocks, MOE_BLOCK), block_e))
    y = jnp.zeros((T + 1, D), h.dtype).at[slot_tok].add(y_slots.reshape(n_slots, D) * slot_w[:, None])
    return y[:T].reshape(B, L, D)


def setup_inputs(seed: int = 0) -> dict:
    key = jax.random.key(seed)
    ks = jax.random.split(key, 26)
    D = D_MODEL
    nrm = lambda k, shape, s: jax.random.normal(k, shape, f32) * s
    return {
        'x': nrm(ks[0], (BATCH, SEQ, D), 1.0),
        'c': nrm(ks[1], (BATCH, D), 1.0),
        'ctx': nrm(ks[2], (BATCH, CTX_LEN, D), 1.0),
        'c_ctx': nrm(ks[3], (D,), 1.0),
        'ada_w': nrm(ks[4], (DEPTH, D, 6 * D), 0.5 * D ** -0.5),
        'ada_b': nrm(ks[5], (DEPTH, 6 * D), 0.02),
        'norm_mix_g': 1.0 + nrm(ks[6], (DEPTH, D), 0.02),
        'norm_ffn_g': 1.0 + nrm(ks[7], (DEPTH, D), 0.02),
        'even_w_in': nrm(ks[8], (N_EVEN, D, EVEN_IN_W), D ** -0.5),
        'even_w_out': nrm(ks[9], (N_EVEN, EVEN_MIX_W, D), EVEN_MIX_W ** -0.5),
        'even_sink': nrm(ks[10], (N_EVEN, N_HEADS), 0.5),
        'conv_pw1_w': nrm(ks[11], (N_ODD, D, 2 * CONV_CH), D ** -0.5),
        'conv_pw1_b': nrm(ks[12], (N_ODD, 2 * CONV_CH), 0.02),
        'conv_dw_w': nrm(ks[13], (N_ODD, CONV_W, CONV_CH), CONV_W ** -0.5),
        'conv_dw_b': nrm(ks[14], (N_ODD, CONV_CH), 0.02),
        'conv_ln_g': 1.0 + nrm(ks[15], (N_ODD, CONV_CH), 0.02),
        'conv_ln_b': nrm(ks[16], (N_ODD, CONV_CH), 0.02),
        'conv_pw2_w': nrm(ks[17], (N_ODD, CONV_CH, D), CONV_CH ** -0.5),
        'conv_pw2_b': nrm(ks[18], (N_ODD, D), 0.02),
        'router_w': nrm(ks[19], (D, N_EXPERTS), D ** -0.5),
        'router_b': nrm(ks[20], (N_EXPERTS,), 0.01),
        'moe_w_gate': nrm(ks[21], (DEPTH, N_EXPERTS, D, EXPERT_FF), D ** -0.5),
        'moe_w_up': nrm(ks[22], (DEPTH, N_EXPERTS, D, EXPERT_FF), D ** -0.5),
        'moe_w_down': nrm(ks[23], (DEPTH, N_EXPERTS, EXPERT_FF, D), EXPERT_FF ** -0.5),
        'final_norm_g': 1.0 + nrm(ks[24], (D,), 0.02),
    }


def reference(x, c, ctx, c_ctx, ada_w, ada_b, norm_mix_g, norm_ffn_g, even_w_in, even_w_out,
              even_sink, conv_pw1_w, conv_pw1_b, conv_dw_w, conv_dw_b, conv_ln_g, conv_ln_b,
              conv_pw2_w, conv_pw2_b, router_w, router_b, moe_w_gate, moe_w_up, moe_w_down,
              final_norm_g):
    last_even = DEPTH - 1 if (DEPTH - 1) % 2 == 0 else DEPTH - 2
    for i in range(DEPTH):
        j = i // 2
        is_even = i % 2 == 0
        advance_ctx = i < last_even
        sh1, sc1, g1, sh2, sc2, g2 = _adaln(c, ada_w[i], ada_b[i])
        h = _modulate(_rmsnorm(x, norm_mix_g[i]), sh1, sc1)
        if is_even or advance_ctx:
            csh1, csc1, cg1, csh2, csc2, cg2 = _adaln(c_ctx, ada_w[i], ada_b[i])
            hc = _modulate(_rmsnorm(ctx, norm_mix_g[i]), csh1, csc1)
        if is_even:
            mix, mix_c = _even_mixer(h, hc, even_w_in[j], even_w_out[j], even_sink[j], advance_ctx)
        else:
            conv_p = (conv_pw1_w[j], conv_pw1_b[j], conv_dw_w[j], conv_dw_b[j],
                      conv_ln_g[j], conv_ln_b[j], conv_pw2_w[j], conv_pw2_b[j])
            mix = _conformer_conv(h, *conv_p)
            mix_c = _conformer_conv(hc, *conv_p) if advance_ctx else None
        x = x + g1 * mix
        f = _modulate(_rmsnorm(x, norm_ffn_g[i]), sh2, sc2)
        x = x + g2 * _grouped_moe(f, router_w, router_b, moe_w_gate[i], moe_w_up[i], moe_w_down[i])
        if advance_ctx:
            ctx = ctx + cg1 * mix_c
            fc = _modulate(_rmsnorm(ctx, norm_ffn_g[i]), csh2, csc2)
            ctx = ctx + cg2 * _grouped_moe(fc, router_w, router_b, moe_w_gate[i], moe_w_up[i], moe_w_down[i])
    return _rmsnorm(x, final_norm_g)
```

```cpp
#include <hip/hip_runtime.h>
#include <cstdio>

#ifndef MK_ONE_LAUNCH
#define MK_ONE_LAUNCH 0
#endif

#define GAS __attribute__((address_space(1)))
#define LAS __attribute__((address_space(3)))
typedef unsigned short bf16;
typedef short bf16x8 __attribute__((ext_vector_type(8)));
typedef float f32x4 __attribute__((ext_vector_type(4)));
typedef float f32x16 __attribute__((ext_vector_type(16)));
typedef unsigned u32x4 __attribute__((ext_vector_type(4)));
typedef unsigned u32x2 __attribute__((ext_vector_type(2)));

constexpr int D = 1024, NB = 4, L = 8192, T = NB * L, CL = 256, TC = NB * CL;
constexpr int NE = 16, FF = 512, CONVW = 31;
constexpr int N_IN = 1280;
constexpr int FN1 = 64, FN2 = 128;
constexpr int IL = 32;
constexpr float EPS = 1e-6f;
constexpr int NWAVES = 8, NTHR = 512;
constexpr int CAP = 32768;
constexpr int HROWS = 65536 + 4096;

constexpr size_t MiB = 1u << 20;
constexpr size_t WS_CTL = 0, CTL_BYTES = 1 * MiB;
constexpr size_t WS_MOD = 1 * MiB;
constexpr size_t WS_TW = 1 * MiB + 512 * 1024;
constexpr size_t WS_WIN = 2 * MiB, WS_WOUT = 6 * MiB, WS_WPW1 = 10 * MiB, WS_WPW2 = 14 * MiB;
constexpr size_t WS_WGU = 16 * MiB, WS_WDN = 80 * MiB;
constexpr size_t WS_TOKE = 112 * MiB, WS_TOKP = 113 * MiB, WS_TOKW = 114 * MiB;
constexpr size_t WS_SLOTT = 116 * MiB, WS_SLOTW = 118 * MiB;
constexpr size_t WS_HB = 128 * MiB;
constexpr size_t WS_UF = 196 * MiB, WS_Q = 228 * MiB, WS_K = 260 * MiB, WS_V = 268 * MiB, WS_CK = 276 * MiB, WS_CV = 277 * MiB;
constexpr size_t WS_G = 280 * MiB, WS_MIX = 344 * MiB, WS_AB = 408 * MiB;
constexpr size_t WS_HID = 196 * MiB, WS_Y = 264 * MiB;
constexpr size_t WS_U = 196 * MiB, WS_V1 = 260 * MiB;
constexpr size_t WS_END = 472 * MiB;
constexpr int CW_BAR = 4096;
constexpr int CW_CNT = 8192;

constexpr int LDS_BYTES = 147456;

__device__ __forceinline__ unsigned f2bf(float f) { unsigned u = __float_as_uint(f); return (u + 0x7fffu + ((u >> 16) & 1u)) >> 16; }
__device__ __forceinline__ float bf2f(unsigned b) { return __uint_as_float(b << 16); }
__device__ __forceinline__ unsigned pk2(float lo, float hi) { return f2bf(lo) | (f2bf(hi) << 16); }
__device__ __forceinline__ float bflo(unsigned w) { return __uint_as_float(w << 16); }
__device__ __forceinline__ float bfhi(unsigned w) { return __uint_as_float(w & 0xffff0000u); }
__device__ __forceinline__ float wave_sum(float v) {
#pragma unroll
    for (int o = 1; o < 64; o <<= 1) v += __shfl_xor(v, o);
    return v;
}
__device__ __forceinline__ float silu_f(float x) { return x / (1.f + __expf(-x)); }
__device__ __forceinline__ float sigmoid_f(float x) { return 1.f / (1.f + __expf(-x)); }
#define LDS_WAIT() asm volatile("s_waitcnt lgkmcnt(0)" ::: "memory")

#define XB_TMO      128
#define XB_XCNT(j)  (256  + 64 * (j))
#define XB_XSUB(j)  (1280 + 64 * (j))
#define XB_XGEN(j)  (2304 + 64 * (j))
#define XB_TOP      3328
#define XB_TOPGEN   3392
#define XCD_BAR_WORDS 3456
#define XB_SPIN_CAP (1u << 20)
__device__ __forceinline__ unsigned xb_ld(unsigned* p)              { return __hip_atomic_load(p, __ATOMIC_RELAXED, __HIP_MEMORY_SCOPE_AGENT); }
__device__ __forceinline__ unsigned xb_add(unsigned* p, unsigned v) { return __hip_atomic_fetch_add(p, v, __ATOMIC_RELAXED, __HIP_MEMORY_SCOPE_AGENT); }
__device__ __forceinline__ unsigned xb_xcc_id() { return (unsigned)__builtin_amdgcn_s_getreg((3 << 11) | 20) & 0xFu; }
#define XB_SPIN(cond, bar) do { unsigned _sp = 0; while (cond) { __builtin_amdgcn_s_sleep(1); \
    if ((++_sp & 255u) == 0u) { if (xb_ld(&(bar)[XB_TMO])) break; if (_sp > XB_SPIN_CAP) { atomicAdd(&(bar)[XB_TMO], 1u); break; } } } } while (0)
struct XcdBarrier { unsigned* bar; unsigned x; volatile LAS unsigned* st; };
__device__ __forceinline__ XcdBarrier xcd_barrier_post(unsigned* bar, volatile LAS unsigned* st) {
    XcdBarrier b; b.bar = bar; b.x = xb_xcc_id(); b.st = st;
    if (threadIdx.x == 0) (void)xb_add(&bar[XB_XCNT(b.x)], 1u);
    return b;
}
__device__ __forceinline__ void xcd_barrier_complete(unsigned* bar, unsigned x, unsigned& nloc, unsigned& nx) {
    const unsigned G = gridDim.x * gridDim.y * gridDim.z;
    unsigned sum, cnt, mine, sp = 0u;
    for (;;) {
        sum = 0u; cnt = 0u; mine = 0u;
#pragma unroll
        for (unsigned j = 0; j < 16; ++j) { const unsigned c = xb_ld(&bar[XB_XCNT(j)]); sum += c; cnt += (c > 0u) ? 1u : 0u; mine = (j == x) ? c : mine; }
        if (sum == G) break;
        __builtin_amdgcn_s_sleep(1);
        if ((++sp & 255u) == 0u) { if (xb_ld(&bar[XB_TMO])) break; if (sp > XB_SPIN_CAP) { atomicAdd(&bar[XB_TMO], 1u); break; } }
    }
    nloc = mine > 0u ? mine : 1u; nx = cnt > 0u ? cnt : 1u;
}
__device__ __forceinline__ void xcd_barrier(const XcdBarrier& b) {
    asm volatile("s_waitcnt vmcnt(0)" ::: "memory");
    __syncthreads();
    if (threadIdx.x == 0) {
        unsigned* bar = b.bar;
        __builtin_amdgcn_s_waitcnt(0);
        unsigned nloc = b.st[0], nx = b.st[1];
        if (nloc == 0u) { xcd_barrier_complete(bar, b.x, nloc, nx); b.st[0] = nloc; b.st[1] = nx; }
        const unsigned old = xb_add(&bar[XB_XSUB(b.x)], 1u);
        const unsigned gen = old / nloc;
        if (old + 1u == (gen + 1u) * nloc) {
            __builtin_amdgcn_fence(__ATOMIC_RELEASE, "agent");
            asm volatile("s_waitcnt vmcnt(0)" ::: "memory");
            const unsigned og = xb_add(&bar[XB_TOP], 1u);
            const unsigned tg = og / nx;
            if (og + 1u == (tg + 1u) * nx) xb_add(&bar[XB_TOPGEN], 1u);
            else XB_SPIN(xb_ld(&bar[XB_TOPGEN]) == tg, bar);
            __builtin_amdgcn_fence(__ATOMIC_ACQUIRE, "agent");
            xb_add(&bar[XB_XGEN(b.x)], 1u);
            asm volatile("s_waitcnt vmcnt(0)" ::: "memory");
        } else {
            XB_SPIN(xb_ld(&bar[XB_XGEN(b.x)]) == gen, bar);
            __builtin_amdgcn_fence(__ATOMIC_ACQUIRE, "agent");
            asm volatile("s_waitcnt vmcnt(0)" ::: "memory");
        }
    }
    __syncthreads();
}

struct Args { const float* in[25]; float* out; unsigned char* ws; int ph_lo, ph_hi; };
enum { I_X = 0, I_C, I_CTX, I_CCTX, I_ADAW, I_ADAB, I_NMG, I_NFG, I_WIN, I_WOUT, I_SINK, I_PW1W, I_PW1B, I_DWW, I_DWB, I_LNG, I_LNB,
       I_PW2W, I_PW2B, I_RW, I_RB, I_WG, I_WU, I_WD, I_FNG };

struct Frame {
    LAS unsigned char* lds;
    int tid, lane, wave, G, wg;
    const float* const* in;
    float* out;
    unsigned char* ws;
    unsigned* ctl;
};

__device__ __forceinline__ int crow(int i, int h) { return (i & 3) + 8 * (i >> 2) + 4 * h; }
template <class RowPtr, class Epi>
__device__ __forceinline__ void sgemm_tile(const RowPtr& rowptr, const bf16* Bt, int K, int m0, int n0, const Epi& epi, int wave, int lane) {
    const int wm = wave & 3, wn = wave >> 2, r = lane & 31, h = lane >> 5;
    const bf16* ap = rowptr(m0 + wm * 32 + r) + 8 * h;
    const bf16* bp0 = Bt + (size_t)(n0 + wn * 64 + r) * K + 8 * h;
    const bf16* bp1 = bp0 + (size_t)32 * K;
    f32x16 c0, c1;
#pragma unroll
    for (int i = 0; i < 16; ++i) { c0[i] = 0.f; c1[i] = 0.f; }
#pragma unroll 2
    for (int k = 0; k < K; k += 32) {
        const bf16x8 a0 = *(const bf16x8*)(ap + k), a1 = *(const bf16x8*)(ap + k + 16);
        const bf16x8 b00 = *(const bf16x8*)(bp0 + k), b01 = *(const bf16x8*)(bp0 + k + 16);
        const bf16x8 b10 = *(const bf16x8*)(bp1 + k), b11 = *(const bf16x8*)(bp1 + k + 16);
        c0 = __builtin_amdgcn_mfma_f32_32x32x16_bf16(a0, b00, c0, 0, 0, 0);
        c1 = __builtin_amdgcn_mfma_f32_32x32x16_bf16(a0, b10, c1, 0, 0, 0);
        c0 = __builtin_amdgcn_mfma_f32_32x32x16_bf16(a1, b01, c0, 0, 0, 0);
        c1 = __builtin_amdgcn_mfma_f32_32x32x16_bf16(a1, b11, c1, 0, 0, 0);
    }
    epi(m0 + wm * 32, n0 + wn * 64, c0, c1, lane);
}

__device__ __forceinline__ void p0_transpose_item(const float* W, int K, int N, bf16* WT, int k0, int n0, int drow0, LAS float* scr, int lane) {
#pragma unroll 8
    for (int i = 0; i < 32; ++i) { const int kk = 2 * i + (lane >> 5); scr[kk * 33 + (lane & 31)] = W[(size_t)(k0 + kk) * N + n0 + (lane & 31)]; }
    LDS_WAIT(); asm volatile("" ::: "memory");
    const int c = lane & 7;
#pragma unroll
    for (int j = 0; j < 4; ++j) { const int n = (lane >> 3) + 8 * j; const LAS float* s = scr + (8 * c) * 33 + n;
        u32x4 o; o.x = pk2(s[0 * 33], s[1 * 33]); o.y = pk2(s[2 * 33], s[3 * 33]); o.z = pk2(s[4 * 33], s[5 * 33]); o.w = pk2(s[6 * 33], s[7 * 33]);
        *(u32x4*)(WT + (size_t)(drow0 + n) * K + k0 + 8 * c) = o; }
    LDS_WAIT(); asm volatile("" ::: "memory");
}
__device__ __forceinline__ int il_row(int j, int half) { return (j / IL) * (2 * IL) + half * IL + (j % IL); }

__device__ __forceinline__ void phase_prep(Frame& F) {
    {
        LAS float* sc = (LAS float*)F.lds;
        LAS float* red = sc + 5 * 1024;
        bool loaded = false;
        for (int it = F.wg; it < 192; it += F.G) {
            if (!loaded) {
                for (int i = F.tid; i < 5 * 1024; i += NTHR) { const int b = i >> 10, k = i & 1023; const float v = b < 4 ? F.in[I_C][b * 1024 + k] : F.in[I_CCTX][k]; sc[i] = silu_f(v); }
                __syncthreads(); loaded = true;
            }
            const int l = it / 96, n0 = (it % 96) * 64, col = F.tid & 63, kg = F.tid >> 6;
            const float* w = F.in[I_ADAW] + (size_t)l * 1024 * 6144 + n0 + col;
            float a0 = 0.f, a1 = 0.f, a2 = 0.f, a3 = 0.f, a4 = 0.f;
#pragma unroll 8
            for (int k = kg * 128; k < kg * 128 + 128; ++k) { const float wv = w[(size_t)k * 6144];
                a0 += sc[k] * wv; a1 += sc[1024 + k] * wv; a2 += sc[2048 + k] * wv; a3 += sc[3072 + k] * wv; a4 += sc[4096 + k] * wv; }
            red[(kg * 5 + 0) * 64 + col] = a0; red[(kg * 5 + 1) * 64 + col] = a1; red[(kg * 5 + 2) * 64 + col] = a2; red[(kg * 5 + 3) * 64 + col] = a3; red[(kg * 5 + 4) * 64 + col] = a4;
            __syncthreads();
            if (F.tid < 320) { const int b = F.tid >> 6, c2 = F.tid & 63; float s = 0.f;
#pragma unroll
                for (int g = 0; g < 8; ++g) s += red[(g * 5 + b) * 64 + c2];
                ((float*)(F.ws + WS_MOD))[((size_t)l * 5 + b) * 6144 + n0 + c2] = s + F.in[I_ADAB][l * 6144 + n0 + c2]; }
            __syncthreads();
        }
        __syncthreads();
    }
    { float* tw = (float*)(F.ws + WS_TW);
      for (int k = F.wg * NTHR + F.tid; k < 8192; k += F.G * NTHR) { const float a = (float)k * (6.283185307179586f / 8192.f); tw[2 * k] = __cosf(a); tw[2 * k + 1] = __sinf(a); } }
    {
        LAS float* scr = (LAS float*)(F.lds + F.wave * 8704);
        const int gw = F.wg * NWAVES + F.wave, NGW = F.G * NWAVES;
        constexpr int S0 = 640, S1 = 512, S2 = 1024, S3 = 512, SM = 32 * 256;
        constexpr int NIT = S0 + S1 + S2 + S3 + 3 * SM;
        for (int it = gw; it < NIT; it += NGW) {
            int r = it;
            if (r < S0) { const int kb = r / 40, nb = r % 40; p0_transpose_item(F.in[I_WIN], 1024, 1280, (bf16*)(F.ws + WS_WIN), kb * 64, nb * 32, nb * 32, scr, F.lane); continue; } r -= S0;
            if (r < S1) { const int kb = r / 32, nb = r % 32; p0_transpose_item(F.in[I_WOUT], 1024, 1024, (bf16*)(F.ws + WS_WOUT), kb * 64, nb * 32, nb * 32, scr, F.lane); continue; } r -= S1;
            if (r < S2) { const int kb = r / 64, nb = r % 64, n0 = nb * 32; p0_transpose_item(F.in[I_PW1W], 1024, 2048, (bf16*)(F.ws + WS_WPW1), kb * 64, n0, il_row(n0 & 1023, n0 >> 10), scr, F.lane); continue; } r -= S2;
            if (r < S3) { const int kb = r / 32, nb = r % 32; p0_transpose_item(F.in[I_PW2W], 1024, 1024, (bf16*)(F.ws + WS_WPW2), kb * 64, nb * 32, nb * 32, scr, F.lane); continue; } r -= S3;
            if (r < SM) { const int le = r >> 8, q = r & 255, kb = q / 16, nb = q % 16;
                p0_transpose_item(F.in[I_WG] + (size_t)le * 1024 * 512, 1024, 512, (bf16*)(F.ws + WS_WGU) + (size_t)le * 1024 * 1024, kb * 64, nb * 32, il_row(nb * 32, 0), scr, F.lane); continue; } r -= SM;
            if (r < SM) { const int le = r >> 8, q = r & 255, kb = q / 16, nb = q % 16;
                p0_transpose_item(F.in[I_WU] + (size_t)le * 1024 * 512, 1024, 512, (bf16*)(F.ws + WS_WGU) + (size_t)le * 1024 * 1024, kb * 64, nb * 32, il_row(nb * 32, 1), scr, F.lane); continue; } r -= SM;
            { const int le = r >> 8, q = r & 255, kb = q / 32, nb = q % 32;
                p0_transpose_item(F.in[I_WD] + (size_t)le * 512 * 1024, 512, 1024, (bf16*)(F.ws + WS_WDN) + (size_t)le * 1024 * 512, kb * 64, nb * 32, nb * 32, scr, F.lane); }
        }
    }
}

__device__ __forceinline__ void row_load(const float* p, int lane, f32x4 (&v)[4]) {
#pragma unroll
    for (int j = 0; j < 4; ++j) v[j] = *(const f32x4*)(p + 4 * lane + 256 * j);
}
__device__ __forceinline__ float row_sumsq(const f32x4 (&v)[4]) {
    float s = 0.f;
#pragma unroll
    for (int j = 0; j < 4; ++j) s += (v[j].x * v[j].x + v[j].y * v[j].y) + (v[j].z * v[j].z + v[j].w * v[j].w);
    return wave_sum(s);
}
__device__ __forceinline__ void row_modulate(f32x4 (&v)[4], float rstd, const float* g, const float* sh, const float* sc, int lane) {
#pragma unroll
    for (int j = 0; j < 4; ++j) { const int o = 4 * lane + 256 * j; const f32x4 gg = *(const f32x4*)(g + o), s1 = *(const f32x4*)(sc + o), s0 = *(const f32x4*)(sh + o);
        v[j] = v[j] * rstd * gg * (1.f + s1) + s0; }
}
__device__ __forceinline__ void row_store_bf16(bf16* dst, const f32x4 (&v)[4], int lane) {
#pragma unroll
    for (int j = 0; j < 4; ++j) { u32x2 w; w.x = pk2(v[j].x, v[j].y); w.y = pk2(v[j].z, v[j].w); *(u32x2*)(dst + 4 * lane + 256 * j) = w; }
}

__device__ __forceinline__ void phase_norm1_l0(Frame& F) {
    const int gw = F.wg * NWAVES + F.wave, NGW = F.G * NWAVES;
    const float* mod = (const float*)(F.ws + WS_MOD);
    bf16* HB = (bf16*)(F.ws + WS_HB);
    for (int row = gw; row < T + TC; row += NGW) {
        const float* src = row < T ? F.in[I_X] + (size_t)row * D : F.in[I_CTX] + (size_t)(row - T) * D;
        const int b = row < T ? (row >> 13) : 4;
        f32x4 v[4]; row_load(src, F.lane, v);
        const float rstd = rsqrtf(row_sumsq(v) * (1.f / D) + EPS);
        const float* m = mod + (size_t)b * 6144;
        row_modulate(v, rstd, F.in[I_NMG], m, m + 1024, F.lane);
        row_store_bf16(HB + (size_t)row * D, v, F.lane);
    }
}

struct RowLin { const bf16* base; size_t pitch; __device__ __forceinline__ const bf16* operator()(int m) const { return base + (size_t)m * pitch; } };

__device__ __forceinline__ void inproj_block(Frame& F, int mb, int nbk, const f32x16& c, int lane) {
    const int h = lane >> 5, cl = lane & 31;
    bf16* dst; int pitch, cbase; bool rope = false; bool isctx = (mb >= T);
    if (nbk < 512) { dst = (bf16*)(F.ws + WS_UF); pitch = 512; cbase = 0; }
    else if (nbk < 1024) { dst = (bf16*)(F.ws + WS_Q); pitch = 512; cbase = 512; rope = true; }
    else if (nbk < 1152) { dst = isctx ? (bf16*)(F.ws + WS_CK) : (bf16*)(F.ws + WS_K); pitch = 128; cbase = 1024; rope = !isctx; }
    else { dst = isctx ? (bf16*)(F.ws + WS_CV) : (bf16*)(F.ws + WS_V); pitch = 128; cbase = 1152; }
    const int rbase = isctx ? mb - T : mb;
    const int col = nbk - cbase + cl;
    const float inv = exp2f(-(float)(cl & 15) * (13.287712379549449f / 16.f));
    const bool second = (cl & 16) != 0; const bool bycol = ((nbk >> 5) & 1) != 0;
#pragma unroll
    for (int i = 0; i < 16; ++i) {
        const int rr = crow(i, h); float v = c[i];
        if (rope) {
            const float partner = __shfl_xor(v, 16);
            const int l = (mb + rr) & (L - 1);
            const float pos = (float)(bycol ? (l & 63) : (l >> 6));
            const float ang = pos * inv, cs = __cosf(ang), sn = __sinf(ang);
            v = second ? (partner * sn + v * cs) : (v * cs - partner * sn);
        }
        dst[(size_t)(rbase + rr) * pitch + col] = (bf16)f2bf(v);
    }
}
__device__ __forceinline__ void phase_inproj(Frame& F) {
    const bf16* HB = (const bf16*)(F.ws + WS_HB); const bf16* Wt = (const bf16*)(F.ws + WS_WIN);
    constexpr int MT = (T + TC) / 128, NT = N_IN / 128;
    RowLin rp{HB, (size_t)D};
    for (int u = F.wg; u < MT * NT; u += F.G) {
        const int mt = u / NT, nt = u % NT;
        if (mt >= T / 128 && nt < 8) continue;
        auto epi = [&](int mb, int nb, const f32x16& c0, const f32x16& c1, int lane) { inproj_block(F, mb, nb, c0, lane); inproj_block(F, mb, nb + 32, c1, lane); };
        sgemm_tile(rp, Wt, D, mt * 128, nt * 128, epi, F.wave, F.lane);
    }
}

__device__ __forceinline__ void attn_key(const bf16* kp, const bf16* vp, const float (&q)[64], float& m, float& s, float (&o)[64]) {
    float dot = 0.f;
#pragma unroll
    for (int j = 0; j < 8; ++j) { const u32x4 w = *(const u32x4*)(kp + 8 * j);
        dot += q[8 * j + 0] * bflo(w.x) + q[8 * j + 1] * bfhi(w.x) + q[8 * j + 2] * bflo(w.y) + q[8 * j + 3] * bfhi(w.y)
             + q[8 * j + 4] * bflo(w.z) + q[8 * j + 5] * bfhi(w.z) + q[8 * j + 6] * bflo(w.w) + q[8 * j + 7] * bfhi(w.w); }
    const float mn = fmaxf(m, dot), alpha = __expf(m - mn), p = __expf(dot - mn);
    s = s * alpha + p; m = mn;
#pragma unroll
    for (int j = 0; j < 8; ++j) { const u32x4 w = *(const u32x4*)(vp + 8 * j);
        o[8 * j + 0] = o[8 * j + 0] * alpha + p * bflo(w.x); o[8 * j + 1] = o[8 * j + 1] * alpha + p * bfhi(w.x);
        o[8 * j + 2] = o[8 * j + 2] * alpha + p * bflo(w.y); o[8 * j + 3] = o[8 * j + 3] * alpha + p * bfhi(w.y);
        o[8 * j + 4] = o[8 * j + 4] * alpha + p * bflo(w.z); o[8 * j + 5] = o[8 * j + 5] * alpha + p * bfhi(w.z);
        o[8 * j + 6] = o[8 * j + 6] * alpha + p * bflo(w.w); o[8 * j + 7] = o[8 * j + 7] * alpha + p * bfhi(w.w); }
}
__device__ __forceinline__ void phase_attn_simple(Frame& F) {
    const bf16* Q = (const bf16*)(F.ws + WS_Q); const bf16* Kb = (const bf16*)(F.ws + WS_K); const bf16* Vb = (const bf16*)(F.ws + WS_V);
    const bf16* CK = (const bf16*)(F.ws + WS_CK); const bf16* CV = (const bf16*)(F.ws + WS_CV); bf16* MIX = (bf16*)(F.ws + WS_MIX);
    for (int idx = F.wg * NTHR + F.tid; idx < T * 8; idx += F.G * NTHR) {
        const int hd = idx / T, t = idx % T, b = t >> 13, l = t & (L - 1), kvh = hd >> 2;
        float q[64], o[64];
#pragma unroll
        for (int j = 0; j < 8; ++j) { const u32x4 w = *(const u32x4*)(Q + (size_t)t * 512 + hd * 64 + 8 * j);
            q[8 * j + 0] = bflo(w.x) * 0.125f; q[8 * j + 1] = bfhi(w.x) * 0.125f; q[8 * j + 2] = bflo(w.y) * 0.125f; q[8 * j + 3] = bfhi(w.y) * 0.125f;
            q[8 * j + 4] = bflo(w.z) * 0.125f; q[8 * j + 5] = bfhi(w.z) * 0.125f; q[8 * j + 6] = bflo(w.w) * 0.125f; q[8 * j + 7] = bfhi(w.w) * 0.125f; }
#pragma unroll
        for (int j = 0; j < 64; ++j) o[j] = 0.f;
        float m = F.in[I_SINK][hd], s = 1.f;
        for (int c = 0; c < CL; ++c) { const size_t r = (size_t)(b * CL + c) * 128 + kvh * 64; attn_key(CK + r, CV + r, q, m, s, o); }
        const int lo = l - 128 < 0 ? 0 : l - 128, hi = l + 128 > L - 1 ? L - 1 : l + 128;
        for (int kp = lo; kp <= hi; ++kp) { const size_t r = (size_t)(b * L + kp) * 128 + kvh * 64; attn_key(Kb + r, Vb + r, q, m, s, o); }
        const float is = 1.f / s;
#pragma unroll
        for (int j = 0; j < 8; ++j) { u32x4 w; w.x = pk2(o[8 * j] * is, o[8 * j + 1] * is); w.y = pk2(o[8 * j + 2] * is, o[8 * j + 3] * is); w.z = pk2(o[8 * j + 4] * is, o[8 * j + 5] * is); w.w = pk2(o[8 * j + 6] * is, o[8 * j + 7] * is);
            *(u32x4*)(MIX + (size_t)t * 1024 + 512 + hd * 64 + 8 * j) = w; }
    }
}

__device__ __forceinline__ void phase_fft1_simple(Frame& F) {
    const bf16* UF = (const bf16*)(F.ws + WS_UF); bf16* Gb = (bf16*)(F.ws + WS_G); const float* tw = (const float*)(F.ws + WS_TW);
    for (int idx = F.wg * NTHR + F.tid; idx < NB * FN1 * FN2 * 512; idx += F.G * NTHR) {
        const int ch = idx & 511, bp = (idx >> 9) & 127, c = (idx >> 16) & 63, b = idx >> 22;
        float re = 0.f, im = 0.f;
        for (int a = 0; a < FN1; ++a) { const float u = bf2f(UF[(size_t)(b * L + 128 * a + bp) * 512 + ch]); const int k = ((a * c) & 63) * 128;
            re += u * tw[2 * k]; im -= u * tw[2 * k + 1]; }
        const int k2 = bp * c; const float cs = tw[2 * k2], sn = tw[2 * k2 + 1];
        const float gr = re * cs + im * sn, gi = im * cs - re * sn;
        const size_t row = (size_t)(b * FN1 + c) * FN2 + bp;
        Gb[row * 1024 + ch] = (bf16)f2bf(gr); Gb[row * 1024 + 512 + ch] = (bf16)f2bf(gi);
    }
}
__device__ __forceinline__ void phase_fft2_simple(Frame& F) {
    const bf16* Gb = (const bf16*)(F.ws + WS_G); bf16* AB = (bf16*)(F.ws + WS_AB); const float* tw = (const float*)(F.ws + WS_TW);
    for (int idx = F.wg * NTHR + F.tid; idx < NB * FN1 * FN2 * 512; idx += F.G * NTHR) {
        const int ch = idx & 511, d = (idx >> 9) & 127, c = (idx >> 16) & 63, b = idx >> 22;
        float fr = 0.f, fi = 0.f;
        for (int bp = 0; bp < FN2; ++bp) { const size_t row = (size_t)(b * FN1 + c) * FN2 + bp; const float gr = bf2f(Gb[row * 1024 + ch]), gi = bf2f(Gb[row * 1024 + 512 + ch]);
            const int k = ((bp * d) & 127) * 64; const float cs = tw[2 * k], sn = tw[2 * k + 1];
            fr += gr * cs + gi * sn; fi += gi * cs - gr * sn; }
        const size_t t = (size_t)b * L + c + 64 * d;
        AB[t * 1024 + ch] = (bf16)f2bf(fr); AB[t * 1024 + 512 + ch] = (bf16)f2bf(-fi);
    }
}
__device__ __forceinline__ void phase_fft3_simple(Frame& F) {
    const bf16* AB = (const bf16*)(F.ws + WS_AB); bf16* MIX = (bf16*)(F.ws + WS_MIX); const float* tw = (const float*)(F.ws + WS_TW);
    LAS float* t128 = (LAS float*)F.lds;
    for (int i = F.tid; i < 128; i += NTHR) { t128[2 * i] = tw[2 * (i * 64)]; t128[2 * i + 1] = tw[2 * (i * 64) + 1]; }
    __syncthreads();
    for (int idx = F.wg * NTHR + F.tid; idx < T * 512; idx += F.G * NTHR) {
        const int cp = idx & 127, g = (idx >> 7) & 3, t = idx >> 9;
        const bf16* arow = AB + (size_t)t * 1024 + g * 128;
        float y = 0.f;
        for (int cc = 0; cc < 128; ++cc) { const int k = (cc * cp) & 127; y += bf2f(arow[cc]) * t128[2 * k] - bf2f(arow[512 + cc]) * t128[2 * k + 1]; }
        MIX[(size_t)t * 1024 + g * 128 + cp] = (bf16)f2bf(y * (1.f / 1024.f));
    }
    __syncthreads();
}

__device__ __forceinline__ void phase_outproj(Frame& F, const bf16* A, const bf16* Wt, const float* base, float* X, const float* gate  , const float* bias) {
    RowLin rp{A, (size_t)D};
    for (int u = F.wg; u < (T / 128) * 8; u += F.G) {
        const int mt = u / 8, nt = u % 8;
        auto epi = [&](int mb, int nb, const f32x16& c0, const f32x16& c1, int lane) {
            const int h = lane >> 5, cl = lane & 31, b = mb >> 13;
#pragma unroll
            for (int half = 0; half < 2; ++half) { const int col = nb + 32 * half + cl; const float gv = gate[(size_t)b * 6144 + col], bv = bias ? bias[col] : 0.f;
#pragma unroll
                for (int i = 0; i < 16; ++i) { const size_t o = (size_t)(mb + crow(i, h)) * D + col; const float a = half ? c1[i] : c0[i]; X[o] = base[o] + gv * (a + bv); } }
        };
        sgemm_tile(rp, Wt, D, mt * 128, nt * 128, epi, F.wave, F.lane);
    }
}

__device__ __forceinline__ void phase_norm2_route(Frame& F, int layer) {
    const float* mod = (const float*)(F.ws + WS_MOD) + (size_t)layer * 5 * 6144;
    const float* X = F.out; bf16* HB = (bf16*)(F.ws + WS_HB);
    const float* rw = F.in[I_RW]; const float* rb = F.in[I_RB];
    int* tok_e = (int*)(F.ws + WS_TOKE); int* tok_p = (int*)(F.ws + WS_TOKP); float* tok_w = (float*)(F.ws + WS_TOKW);
    int* slot_t = (int*)(F.ws + WS_SLOTT);
    float* slot_w = (float*)(F.ws + WS_SLOTW);
    unsigned* cnt = F.ctl + CW_CNT + layer * 16 * 64;
    LAS int* sel_e = (LAS int*)F.lds;
    LAS float* sel_w = (LAS float*)(F.lds + 1024);
    for (int rb0 = F.wg; rb0 < T / 128; rb0 += F.G) {
        for (int j = 0; j < 16; ++j) {
            const int lr = F.wave * 16 + j, row = rb0 * 128 + lr, b = row >> 13;
            f32x4 v[4]; row_load(X + (size_t)row * D, F.lane, v);
            const float rstd = rsqrtf(row_sumsq(v) * (1.f / D) + EPS);
            const float* m = mod + (size_t)b * 6144;
            row_modulate(v, rstd, F.in[I_NFG] + layer * D, m + 3072, m + 4096, F.lane);
            row_store_bf16(HB + (size_t)row * D, v, F.lane);
            float lg[16];
#pragma unroll
            for (int e = 0; e < 16; ++e) lg[e] = 0.f;
#pragma unroll
            for (int jj = 0; jj < 4; ++jj)
#pragma unroll
                for (int q = 0; q < 4; ++q) { const float* wr = rw + (size_t)(4 * F.lane + 256 * jj + q) * 16; const float fv = v[jj][q];
#pragma unroll
                    for (int e4 = 0; e4 < 4; ++e4) { const f32x4 w4 = *(const f32x4*)(wr + 4 * e4); lg[4 * e4] += fv * w4.x; lg[4 * e4 + 1] += fv * w4.y; lg[4 * e4 + 2] += fv * w4.z; lg[4 * e4 + 3] += fv * w4.w; } }
#pragma unroll
            for (int e = 0; e < 16; ++e) lg[e] = wave_sum(lg[e]);
            float best = -1e30f; int be1 = 0, be2 = 0; float bs1 = 0.f, bs2 = 0.f;
#pragma unroll
            for (int g = 0; g < 4; ++g) {
                float v1 = -1e30f, v2 = -1e30f, s1 = 0.f, s2 = 0.f; int j1 = 0, j2 = 0;
#pragma unroll
                for (int q = 0; q < 4; ++q) { const float sc = sigmoid_f(lg[4 * g + q]), x = sc + rb[4 * g + q];
                    if (x > v1) { v2 = v1; j2 = j1; s2 = s1; v1 = x; j1 = q; s1 = sc; } else if (x > v2) { v2 = x; j2 = q; s2 = sc; } }
                const float gs = v1 + v2;
                if (gs > best) { best = gs; be1 = 4 * g + j1; be2 = 4 * g + j2; bs1 = s1; bs2 = s2; }
            }
            if (F.lane == 0) { const float inv = 1.f / (bs1 + bs2); sel_e[2 * lr] = be1; sel_e[2 * lr + 1] = be2; sel_w[2 * lr] = bs1 * inv; sel_w[2 * lr + 1] = bs2 * inv; }
        }
        __syncthreads();
        if (F.tid < 16) {
            const int e = F.tid; int n = 0;
            for (int i = 0; i < 256; ++i) n += (sel_e[i] == e) ? 1 : 0;
            int pos = n ? (int)atomicAdd(cnt + e * 64, (unsigned)n) : 0;
            for (int i = 0; i < 256; ++i) if (sel_e[i] == e) { const int tok = rb0 * 128 + (i >> 1);
                slot_t[e * CAP + pos] = tok; slot_w[e * CAP + pos] = sel_w[i]; tok_e[2 * tok + (i & 1)] = e; tok_p[2 * tok + (i & 1)] = pos; tok_w[2 * tok + (i & 1)] = sel_w[i]; ++pos; }
        }
        __syncthreads();
    }
}

constexpr int MOEMAP_OFF = LDS_BYTES - 256;
__device__ __forceinline__ LAS int* moe_map(Frame& F, int layer) {
    LAS int* mm = (LAS int*)(F.lds + MOEMAP_OFF);
    __syncthreads();
    if (F.tid == 0) { const unsigned* cnt = F.ctl + CW_CNT + layer * 16 * 64; int acc = 0;
        for (int e = 0; e < 16; ++e) { const int n = (int)__hip_atomic_load(cnt + e * 64, __ATOMIC_RELAXED, __HIP_MEMORY_SCOPE_AGENT); mm[e] = n; mm[16 + e] = acc; acc += (n + 255) & ~255; } }
    __syncthreads();
    return mm;
}
struct RowGather { const bf16* base; const int* list; int n; __device__ __forceinline__ const bf16* operator()(int m) const { const int tok = m < n ? list[m] : 0; return base + (size_t)tok * D; } };

__device__ __forceinline__ void phase_moe_gateup(Frame& F, int layer) {
    LAS int* mm = moe_map(F, layer);
    const bf16* HB = (const bf16*)(F.ws + WS_HB); bf16* HID = (bf16*)(F.ws + WS_HID);
    const int* slot_t = (const int*)(F.ws + WS_SLOTT); const float* slot_w = (const float*)(F.ws + WS_SLOTW);
    int ubase = 0;
#pragma unroll 1
    for (int e = 0; e < 16; ++e) {
        const int n = mm[e], hbe = mm[16 + e], rt = (n + 127) >> 7, nu = rt * 8;
        const bf16* Wt = (const bf16*)(F.ws + WS_WGU) + (size_t)(layer * 16 + e) * 1024 * 1024;
        RowGather rp{HB, slot_t + e * CAP, n};
        int first = (F.wg - ubase % F.G + F.G) % F.G;
        for (int u = first; u < nu; u += F.G) {
            const int mt = u / 8, nt = u % 8;
            auto epi = [&](int mb, int nb, const f32x16& c0, const f32x16& c1, int lane) {
                const int h = lane >> 5, cl = lane & 31; const int col = (nb >> 1) + cl;
#pragma unroll
                for (int i = 0; i < 16; ++i) { const int r = mb + crow(i, h);
                    if (r < n) { const float w = slot_w[e * CAP + r]; HID[(size_t)(hbe + r) * FF + col] = (bf16)f2bf(w * silu_f(c0[i]) * c1[i]); } }
            };
            sgemm_tile(rp, Wt, D, mt * 128, nt * 128, epi, F.wave, F.lane);
        }
        ubase += nu;
    }
}
__device__ __forceinline__ void phase_moe_down(Frame& F, int layer) {
    LAS int* mm = moe_map(F, layer);
    const bf16* HID = (const bf16*)(F.ws + WS_HID); bf16* Y = (bf16*)(F.ws + WS_Y);
    int ubase = 0;
#pragma unroll 1
    for (int e = 0; e < 16; ++e) {
        const int n = mm[e], hbe = mm[16 + e], rt = (n + 127) >> 7, nu = rt * 8;
        const bf16* Wt = (const bf16*)(F.ws + WS_WDN) + (size_t)(layer * 16 + e) * 1024 * 512;
        RowLin rp{HID + (size_t)hbe * FF, (size_t)FF};
        int first = (F.wg - ubase % F.G + F.G) % F.G;
        for (int u = first; u < nu; u += F.G) {
            const int mt = u / 8, nt = u % 8;
            auto epi = [&](int mb, int nb, const f32x16& c0, const f32x16& c1, int lane) {
                const int h = lane >> 5, cl = lane & 31;
#pragma unroll
                for (int i = 0; i < 16; ++i) { const int r = mb + crow(i, h);
                    if (r < n) { bf16* yr = Y + (size_t)(hbe + r) * D + nb + cl; yr[0] = (bf16)f2bf(c0[i]); yr[32] = (bf16)f2bf(c1[i]); } }
            };
            sgemm_tile(rp, Wt, FF, mt * 128, nt * 128, epi, F.wave, F.lane);
        }
        ubase += nu;
    }
}

template <bool FINAL>
__device__ __forceinline__ void phase_combine(Frame& F, int layer) {
    LAS int* hbs = moe_map(F, layer) + 16;
    const int gw = F.wg * NWAVES + F.wave, NGW = F.G * NWAVES;
    const float* mod = (const float*)(F.ws + WS_MOD);
    const int* tok_e = (const int*)(F.ws + WS_TOKE); const int* tok_p = (const int*)(F.ws + WS_TOKP);
    const bf16* Y = (const bf16*)(F.ws + WS_Y); float* X = F.out; bf16* HB = (bf16*)(F.ws + WS_HB);
    for (int row = gw; row < T; row += NGW) {
        const int b = row >> 13;
        const int s0 = hbs[tok_e[2 * row]] + tok_p[2 * row], s1 = hbs[tok_e[2 * row + 1]] + tok_p[2 * row + 1];
        f32x4 v[4]; row_load(X + (size_t)row * D, F.lane, v);
        const float* g2 = mod + ((size_t)layer * 5 + b) * 6144 + 5120;
#pragma unroll
        for (int j = 0; j < 4; ++j) { const int o = 4 * F.lane + 256 * j;
            const u32x2 y0 = *(const u32x2*)(Y + (size_t)s0 * D + o), y1 = *(const u32x2*)(Y + (size_t)s1 * D + o); const f32x4 gg = *(const f32x4*)(g2 + o);
            v[j].x += gg.x * (bflo(y0.x) + bflo(y1.x)); v[j].y += gg.y * (bfhi(y0.x) + bfhi(y1.x)); v[j].z += gg.z * (bflo(y0.y) + bflo(y1.y)); v[j].w += gg.w * (bfhi(y0.y) + bfhi(y1.y)); }
        const float rstd = rsqrtf(row_sumsq(v) * (1.f / D) + EPS);
        if (FINAL) {
#pragma unroll
            for (int j = 0; j < 4; ++j) { const int o = 4 * F.lane + 256 * j; const f32x4 gg = *(const f32x4*)(F.in[I_FNG] + o); *(f32x4*)(X + (size_t)row * D + o) = v[j] * rstd * gg; }
        } else {
#pragma unroll
            for (int j = 0; j < 4; ++j) *(f32x4*)(X + (size_t)row * D + 4 * F.lane + 256 * j) = v[j];
            const float* m = mod + ((size_t)(layer + 1) * 5 + b) * 6144;
            row_modulate(v, rstd, F.in[I_NMG] + (layer + 1) * D, m, m + 1024, F.lane);
            row_store_bf16(HB + (size_t)row * D, v, F.lane);
        }
    }
    __syncthreads();
}

__device__ __forceinline__ void phase_pw1(Frame& F) {
    const bf16* HB = (const bf16*)(F.ws + WS_HB); const bf16* Wt = (const bf16*)(F.ws + WS_WPW1); bf16* U = (bf16*)(F.ws + WS_U);
    const float* bias = F.in[I_PW1B];
    RowLin rp{HB, (size_t)D};
    for (int u = F.wg; u < (T / 128) * 16; u += F.G) {
        const int mt = u / 16, nt = u % 16;
        auto epi = [&](int mb, int nb, const f32x16& c0, const f32x16& c1, int lane) {
            const int h = lane >> 5, cl = lane & 31, col = (nb >> 1) + cl; const float ba = bias[col], bg = bias[1024 + col];
#pragma unroll
            for (int i = 0; i < 16; ++i) U[(size_t)(mb + crow(i, h)) * D + col] = (bf16)f2bf((c0[i] + ba) * sigmoid_f(c1[i] + bg));
        };
        sgemm_tile(rp, Wt, D, mt * 128, nt * 128, epi, F.wave, F.lane);
    }
}
__device__ __forceinline__ void phase_dwconv(Frame& F) {
    const bf16* U = (const bf16*)(F.ws + WS_U); bf16* V1 = (bf16*)(F.ws + WS_V1);
    const float* dww = F.in[I_DWW]; const float* dwb = F.in[I_DWB]; const float* lng = F.in[I_LNG]; const float* lnb = F.in[I_LNB];
    const int gw = F.wg * NWAVES + F.wave, NGW = F.G * NWAVES;
    for (int row = gw; row < T; row += NGW) {
        const int l = row & (L - 1);
        f32x4 acc[4];
#pragma unroll
        for (int j = 0; j < 4; ++j) acc[j] = *(const f32x4*)(dwb + 4 * F.lane + 256 * j);
        for (int tp = 0; tp < CONVW; ++tp) { const int ll = l + tp - 15; if (ll < 0 || ll >= L) continue;
            const bf16* ur = U + (size_t)(row + tp - 15) * D; const float* wr = dww + (size_t)tp * D;
#pragma unroll
            for (int j = 0; j < 4; ++j) { const int o = 4 * F.lane + 256 * j; const u32x2 uu = *(const u32x2*)(ur + o); const f32x4 ww = *(const f32x4*)(wr + o);
                acc[j].x += bflo(uu.x) * ww.x; acc[j].y += bfhi(uu.x) * ww.y; acc[j].z += bflo(uu.y) * ww.z; acc[j].w += bfhi(uu.y) * ww.w; } }
        float s = 0.f;
#pragma unroll
        for (int j = 0; j < 4; ++j) s += (acc[j].x + acc[j].y) + (acc[j].z + acc[j].w);
        const float mean = wave_sum(s) * (1.f / D); float q = 0.f;
#pragma unroll
        for (int j = 0; j < 4; ++j) { acc[j] = acc[j] - mean; q += (acc[j].x * acc[j].x + acc[j].y * acc[j].y) + (acc[j].z * acc[j].z + acc[j].w * acc[j].w); }
        const float rstd = rsqrtf(wave_sum(q) * (1.f / D) + EPS);
#pragma unroll
        for (int j = 0; j < 4; ++j) { const int o = 4 * F.lane + 256 * j; const f32x4 gg = *(const f32x4*)(lng + o), bb = *(const f32x4*)(lnb + o);
            f32x4 y = acc[j] * rstd * gg + bb; y.x = silu_f(y.x); y.y = silu_f(y.y); y.z = silu_f(y.z); y.w = silu_f(y.w); acc[j] = y; }
        row_store_bf16(V1 + (size_t)row * D, acc, F.lane);
    }
}

constexpr int NPH = 18;
__global__ void __launch_bounds__(NTHR, 2) mega(Args args) {
    extern __shared__ __attribute__((aligned(16))) unsigned char lds[];
    Frame F;
    F.lds = (LAS unsigned char*)lds;
    F.tid = threadIdx.x; F.lane = F.tid & 63; F.wave = __builtin_amdgcn_readfirstlane(F.tid >> 6);
    F.G = gridDim.x; F.wg = blockIdx.x;
    F.in = args.in; F.out = args.out; F.ws = args.ws; F.ctl = (unsigned*)(args.ws + WS_CTL);
    volatile LAS unsigned* bst = (volatile LAS unsigned*)(F.lds + LDS_BYTES - 16);
    if (F.tid < 4) bst[F.tid] = 0u;
    __syncthreads();
    const int lo = args.ph_lo, hi = args.ph_hi;
    XcdBarrier bar; bar.bar = F.ctl + CW_BAR; bar.x = 0; bar.st = bst;
    if (hi - lo > 1) bar = xcd_barrier_post(F.ctl + CW_BAR, bst);
#define IN(k) (lo <= (k) && (k) < hi)
#define SEAM(k) do { if (IN(k) && IN((k) + 1)) xcd_barrier(bar); } while (0)
    const float* mod = (const float*)(F.ws + WS_MOD);

    if (IN(0)) { phase_prep(F); } SEAM(0);
    if (IN(1)) { phase_norm1_l0(F); } SEAM(1);
    if (IN(2)) { phase_inproj(F); } SEAM(2);
    if (IN(3)) { phase_attn_simple(F); phase_fft1_simple(F); } SEAM(3);
    if (IN(4)) { phase_fft2_simple(F); } SEAM(4);
    if (IN(5)) { phase_fft3_simple(F); } SEAM(5);
    if (IN(6)) { phase_outproj(F, (const bf16*)(F.ws + WS_MIX), (const bf16*)(F.ws + WS_WOUT), F.in[I_X], F.out, mod + 2048, nullptr); } SEAM(6);
    if (IN(7)) { phase_norm2_route(F, 0); } SEAM(7);
    if (IN(8)) { phase_moe_gateup(F, 0); } SEAM(8);
    if (IN(9)) { phase_moe_down(F, 0); } SEAM(9);
    if (IN(10)) { phase_combine<false>(F, 0); } SEAM(10);
    if (IN(11)) { phase_pw1(F); } SEAM(11);
    if (IN(12)) { phase_dwconv(F); } SEAM(12);
    if (IN(13)) { phase_outproj(F, (const bf16*)(F.ws + WS_V1), (const bf16*)(F.ws + WS_WPW2), F.out, F.out, mod + 5 * 6144 + 2048, F.in[I_PW2B]); } SEAM(13);
    if (IN(14)) { phase_norm2_route(F, 1); } SEAM(14);
    if (IN(15)) { phase_moe_gateup(F, 1); } SEAM(15);
    if (IN(16)) { phase_moe_down(F, 1); } SEAM(16);
    if (IN(17)) { phase_combine<true>(F, 1); }
#undef IN
#undef SEAM
}

extern "C" void kernel_launch(void* const* d_in, const int* in_sizes, int n_in, void* d_out, int out_size, void* d_ws, size_t ws_size, hipStream_t stream) {
    static int grid = 0;
    if (grid == 0) {
        if (n_in != 25 || out_size != T * D || ws_size < WS_END) { fprintf(stderr, "kernel_launch: unexpected shapes (n_in %d out %d ws %zu)\n", n_in, out_size, ws_size); grid = -1; return; }
        int dev = 0, cus = 0, per_cu = 0;
        if (hipGetDevice(&dev) != hipSuccess || hipDeviceGetAttribute(&cus, hipDeviceAttributeMultiprocessorCount, dev) != hipSuccess) { grid = -1; return; }
        if (hipFuncSetAttribute((const void*)mega, hipFuncAttributeMaxDynamicSharedMemorySize, LDS_BYTES) != hipSuccess) { fprintf(stderr, "kernel_launch: hipFuncSetAttribute failed\n"); grid = -1; return; }
        if (hipOccupancyMaxActiveBlocksPerMultiprocessor(&per_cu, (const void*)mega, NTHR, LDS_BYTES) != hipSuccess || per_cu < 1) { fprintf(stderr, "kernel_launch: occupancy query says %d\n", per_cu); }
        (void)hipGetLastError();
        grid = cus;
    }
    if (grid < 0) return;
    (void)hipMemsetAsync((char*)d_ws + WS_CTL, 0, CTL_BYTES, stream);
    Args a{};
    for (int i = 0; i < 25; ++i) a.in[i] = (const float*)d_in[i];
    a.out = (float*)d_out; a.ws = (unsigned char*)d_ws;
#if MK_ONE_LAUNCH
    a.ph_lo = 0; a.ph_hi = NPH;
    hipLaunchKernelGGL(mega, dim3(grid), dim3(NTHR), LDS_BYTES, stream, a);
#else
    for (int p = 0; p < NPH; ++p) { a.ph_lo = p; a.ph_hi = p + 1; hipLaunchKernelGGL(mega, dim3(grid), dim3(NTHR), LDS_BYTES, stream, a); }
#endif
}
```

```cpp
#include <hip/hip_runtime.h>
#include <cstdio>

#ifndef MK_ONE_LAUNCH
#define MK_ONE_LAUNCH 1
#endif

#define GAS __attribute__((address_space(1)))
#define LAS __attribute__((address_space(3)))
typedef unsigned short bf16;
typedef short bf16x8 __attribute__((ext_vector_type(8)));
typedef float f32x4 __attribute__((ext_vector_type(4)));
typedef float f32x16 __attribute__((ext_vector_type(16)));
typedef unsigned u32x4 __attribute__((ext_vector_type(4)));
typedef unsigned u32x2 __attribute__((ext_vector_type(2)));

constexpr int D = 1024, NB = 4, L = 8192, T = NB * L, CL = 256, TC = NB * CL;
constexpr int NE = 16, FF = 512, CONVW = 31;
constexpr int N_IN = 1280;
constexpr int FN1 = 64, FN2 = 128;
constexpr int IL = 32;
constexpr float EPS = 1e-6f;
constexpr int NWAVES = 8, NTHR = 512;
constexpr int CAP = 32768;
constexpr int HROWS = 65536 + 4096;

constexpr size_t MiB = 1u << 20;
constexpr size_t WS_CTL = 0, CTL_BYTES = 1 * MiB;
constexpr size_t WS_MOD = 1 * MiB;
constexpr size_t WS_TW = 1 * MiB + 512 * 1024;
constexpr size_t WS_WIN = 2 * MiB, WS_WOUT = 6 * MiB, WS_WPW1 = 10 * MiB, WS_WPW2 = 14 * MiB;
constexpr size_t WS_WGU = 16 * MiB, WS_WDN = 80 * MiB;
constexpr size_t WS_TOKE = 112 * MiB, WS_TOKP = 113 * MiB, WS_TOKW = 114 * MiB;
constexpr size_t WS_SLOTT = 116 * MiB, WS_SLOTW = 118 * MiB;
constexpr size_t WS_HB = 128 * MiB;
constexpr size_t WS_UF = 196 * MiB, WS_Q = 228 * MiB, WS_K = 260 * MiB, WS_V = 268 * MiB, WS_CK = 276 * MiB, WS_CV = 277 * MiB;
constexpr size_t WS_G = 280 * MiB, WS_MIX = 344 * MiB, WS_AB = 408 * MiB;
constexpr size_t WS_HID = 196 * MiB, WS_Y = 264 * MiB;
constexpr size_t WS_U = 196 * MiB, WS_V1 = 260 * MiB;
constexpr size_t WS_END = 472 * MiB;
constexpr int CW_BAR = 4096;
constexpr int CW_CNT = 8192;

constexpr int LDS_BYTES = 147456;

__device__ __forceinline__ unsigned f2bf(float f) { unsigned u = __float_as_uint(f); return (u + 0x7fffu + ((u >> 16) & 1u)) >> 16; }
__device__ __forceinline__ float bf2f(unsigned b) { return __uint_as_float(b << 16); }
__device__ __forceinline__ unsigned pk2(float lo, float hi) { return f2bf(lo) | (f2bf(hi) << 16); }
__device__ __forceinline__ float bflo(unsigned w) { return __uint_as_float(w << 16); }
__device__ __forceinline__ float bfhi(unsigned w) { return __uint_as_float(w & 0xffff0000u); }
__device__ __forceinline__ float wave_sum(float v) {
#pragma unroll
    for (int o = 1; o < 64; o <<= 1) v += __shfl_xor(v, o);
    return v;
}
__device__ __forceinline__ float silu_f(float x) { return x / (1.f + __expf(-x)); }
__device__ __forceinline__ float sigmoid_f(float x) { return 1.f / (1.f + __expf(-x)); }
#define LDS_WAIT() asm volatile("s_waitcnt lgkmcnt(0)" ::: "memory")

#define XB_TMO      128
#define XB_XCNT(j)  (256  + 64 * (j))
#define XB_XSUB(j)  (1280 + 64 * (j))
#define XB_XGEN(j)  (2304 + 64 * (j))
#define XB_TOP      3328
#define XB_TOPGEN   3392
#define XCD_BAR_WORDS 3456
#define XB_SPIN_CAP (1u << 20)
__device__ __forceinline__ unsigned xb_ld(unsigned* p)              { return __hip_atomic_load(p, __ATOMIC_RELAXED, __HIP_MEMORY_SCOPE_AGENT); }
__device__ __forceinline__ unsigned xb_add(unsigned* p, unsigned v) { return __hip_atomic_fetch_add(p, v, __ATOMIC_RELAXED, __HIP_MEMORY_SCOPE_AGENT); }
__device__ __forceinline__ unsigned xb_xcc_id() { return (unsigned)__builtin_amdgcn_s_getreg((3 << 11) | 20) & 0xFu; }
#define XB_SPIN(cond, bar) do { unsigned _sp = 0; while (cond) { __builtin_amdgcn_s_sleep(1); \
    if ((++_sp & 255u) == 0u) { if (xb_ld(&(bar)[XB_TMO])) break; if (_sp > XB_SPIN_CAP) { atomicAdd(&(bar)[XB_TMO], 1u); break; } } } } while (0)
struct XcdBarrier { unsigned* bar; unsigned x; volatile LAS unsigned* st; };
__device__ __forceinline__ XcdBarrier xcd_barrier_post(unsigned* bar, volatile LAS unsigned* st) {
    XcdBarrier b; b.bar = bar; b.x = xb_xcc_id(); b.st = st;
    if (threadIdx.x == 0) (void)xb_add(&bar[XB_XCNT(b.x)], 1u);
    return b;
}
__device__ __forceinline__ void xcd_barrier_complete(unsigned* bar, unsigned x, unsigned& nloc, unsigned& nx) {
    const unsigned G = gridDim.x * gridDim.y * gridDim.z;
    unsigned sum, cnt, mine, sp = 0u;
    for (;;) {
        sum = 0u; cnt = 0u; mine = 0u;
#pragma unroll
        for (unsigned j = 0; j < 16; ++j) { const unsigned c = xb_ld(&bar[XB_XCNT(j)]); sum += c; cnt += (c > 0u) ? 1u : 0u; mine = (j == x) ? c : mine; }
        if (sum == G) break;
        __builtin_amdgcn_s_sleep(1);
        if ((++sp & 255u) == 0u) { if (xb_ld(&bar[XB_TMO])) break; if (sp > XB_SPIN_CAP) { atomicAdd(&bar[XB_TMO], 1u); break; } }
    }
    nloc = mine > 0u ? mine : 1u; nx = cnt > 0u ? cnt : 1u;
}
__device__ __forceinline__ void xcd_barrier(const XcdBarrier& b) {
    asm volatile("s_waitcnt vmcnt(0)" ::: "memory");
    __syncthreads();
    if (threadIdx.x == 0) {
        unsigned* bar = b.bar;
        __builtin_amdgcn_s_waitcnt(0);
        unsigned nloc = b.st[0], nx = b.st[1];
        if (nloc == 0u) { xcd_barrier_complete(bar, b.x, nloc, nx); b.st[0] = nloc; b.st[1] = nx; }
        const unsigned old = xb_add(&bar[XB_XSUB(b.x)], 1u);
        const unsigned gen = old / nloc;
        if (old + 1u == (gen + 1u) * nloc) {
            __builtin_amdgcn_fence(__ATOMIC_RELEASE, "agent");
            asm volatile("s_waitcnt vmcnt(0)" ::: "memory");
            const unsigned og = xb_add(&bar[XB_TOP], 1u);
            const unsigned tg = og / nx;
            if (og + 1u == (tg + 1u) * nx) xb_add(&bar[XB_TOPGEN], 1u);
            else XB_SPIN(xb_ld(&bar[XB_TOPGEN]) == tg, bar);
            __builtin_amdgcn_fence(__ATOMIC_ACQUIRE, "agent");
            xb_add(&bar[XB_XGEN(b.x)], 1u);
            asm volatile("s_waitcnt vmcnt(0)" ::: "memory");
        } else {
            XB_SPIN(xb_ld(&bar[XB_XGEN(b.x)]) == gen, bar);
            __builtin_amdgcn_fence(__ATOMIC_ACQUIRE, "agent");
            asm volatile("s_waitcnt vmcnt(0)" ::: "memory");
        }
    }
    __syncthreads();
}

struct Args { const float* in[25]; float* out; unsigned char* ws; int ph_lo, ph_hi; };
enum { I_X = 0, I_C, I_CTX, I_CCTX, I_ADAW, I_ADAB, I_NMG, I_NFG, I_WIN, I_WOUT, I_SINK, I_PW1W, I_PW1B, I_DWW, I_DWB, I_LNG, I_LNB,
       I_PW2W, I_PW2B, I_RW, I_RB, I_WG, I_WU, I_WD, I_FNG };

struct Frame {
    LAS unsigned char* lds;
    int tid, lane, wave, G, wg;
    const float* const* in;
    float* out;
    unsigned char* ws;
    unsigned* ctl;
};

__device__ __forceinline__ int crow(int i, int h) { return (i & 3) + 8 * (i >> 2) + 4 * h; }
template <class RowPtr, class Epi>
__device__ __forceinline__ void sgemm_tile(const RowPtr& rowptr, const bf16* Bt, int K, int m0, int n0, const Epi& epi, int wave, int lane) {
    const int wm = wave & 3, wn = wave >> 2, r = lane & 31, h = lane >> 5;
    const bf16* ap = rowptr(m0 + wm * 32 + r) + 8 * h;
    const bf16* bp0 = Bt + (size_t)(n0 + wn * 64 + r) * K + 8 * h;
    const bf16* bp1 = bp0 + (size_t)32 * K;
    f32x16 c0, c1;
#pragma unroll
    for (int i = 0; i < 16; ++i) { c0[i] = 0.f; c1[i] = 0.f; }
#pragma unroll 2
    for (int k = 0; k < K; k += 32) {
        const bf16x8 a0 = *(const bf16x8*)(ap + k), a1 = *(const bf16x8*)(ap + k + 16);
        const bf16x8 b00 = *(const bf16x8*)(bp0 + k), b01 = *(const bf16x8*)(bp0 + k + 16);
        const bf16x8 b10 = *(const bf16x8*)(bp1 + k), b11 = *(const bf16x8*)(bp1 + k + 16);
        c0 = __builtin_amdgcn_mfma_f32_32x32x16_bf16(a0, b00, c0, 0, 0, 0);
        c1 = __builtin_amdgcn_mfma_f32_32x32x16_bf16(a0, b10, c1, 0, 0, 0);
        c0 = __builtin_amdgcn_mfma_f32_32x32x16_bf16(a1, b01, c0, 0, 0, 0);
        c1 = __builtin_amdgcn_mfma_f32_32x32x16_bf16(a1, b11, c1, 0, 0, 0);
    }
    epi(m0 + wm * 32, n0 + wn * 64, c0, c1, lane);
}

__device__ __forceinline__ void p0_transpose_item(const float* W, int K, int N, bf16* WT, int k0, int n0, int drow0, LAS float* scr, int lane) {
#pragma unroll 8
    for (int i = 0; i < 32; ++i) { const int kk = 2 * i + (lane >> 5); scr[kk * 33 + (lane & 31)] = W[(size_t)(k0 + kk) * N + n0 + (lane & 31)]; }
    LDS_WAIT(); asm volatile("" ::: "memory");
    const int c = lane & 7;
#pragma unroll
    for (int j = 0; j < 4; ++j) { const int n = (lane >> 3) + 8 * j; const LAS float* s = scr + (8 * c) * 33 + n;
        u32x4 o; o.x = pk2(s[0 * 33], s[1 * 33]); o.y = pk2(s[2 * 33], s[3 * 33]); o.z = pk2(s[4 * 33], s[5 * 33]); o.w = pk2(s[6 * 33], s[7 * 33]);
        *(u32x4*)(WT + (size_t)(drow0 + n) * K + k0 + 8 * c) = o; }
    LDS_WAIT(); asm volatile("" ::: "memory");
}
__device__ __forceinline__ int il_row(int j, int half) { return (j / IL) * (2 * IL) + half * IL + (j % IL); }

__device__ __forceinline__ void phase_prep(Frame& F) {
    {
        LAS float* sc = (LAS float*)F.lds;
        LAS float* red = sc + 5 * 1024;
        bool loaded = false;
        for (int it = F.wg; it < 192; it += F.G) {
            if (!loaded) {
                for (int i = F.tid; i < 5 * 1024; i += NTHR) { const int b = i >> 10, k = i & 1023; const float v = b < 4 ? F.in[I_C][b * 1024 + k] : F.in[I_CCTX][k]; sc[i] = silu_f(v); }
                __syncthreads(); loaded = true;
            }
            const int l = it / 96, n0 = (it % 96) * 64, col = F.tid & 63, kg = F.tid >> 6;
            const float* w = F.in[I_ADAW] + (size_t)l * 1024 * 6144 + n0 + col;
            float a0 = 0.f, a1 = 0.f, a2 = 0.f, a3 = 0.f, a4 = 0.f;
#pragma unroll 8
            for (int k = kg * 128; k < kg * 128 + 128; ++k) { const float wv = w[(size_t)k * 6144];
                a0 += sc[k] * wv; a1 += sc[1024 + k] * wv; a2 += sc[2048 + k] * wv; a3 += sc[3072 + k] * wv; a4 += sc[4096 + k] * wv; }
            red[(kg * 5 + 0) * 64 + col] = a0; red[(kg * 5 + 1) * 64 + col] = a1; red[(kg * 5 + 2) * 64 + col] = a2; red[(kg * 5 + 3) * 64 + col] = a3; red[(kg * 5 + 4) * 64 + col] = a4;
            __syncthreads();
            if (F.tid < 320) { const int b = F.tid >> 6, c2 = F.tid & 63; float s = 0.f;
#pragma unroll
                for (int g = 0; g < 8; ++g) s += red[(g * 5 + b) * 64 + c2];
                ((float*)(F.ws + WS_MOD))[((size_t)l * 5 + b) * 6144 + n0 + c2] = s + F.in[I_ADAB][l * 6144 + n0 + c2]; }
            __syncthreads();
        }
        __syncthreads();
    }
    { float* tw = (float*)(F.ws + WS_TW);
      for (int k = F.wg * NTHR + F.tid; k < 8192; k += F.G * NTHR) { const float a = (float)k * (6.283185307179586f / 8192.f); tw[2 * k] = __cosf(a); tw[2 * k + 1] = __sinf(a); } }
    {
        LAS float* scr = (LAS float*)(F.lds + F.wave * 8704);
        const int gw = F.wg * NWAVES + F.wave, NGW = F.G * NWAVES;
        constexpr int S0 = 640, S1 = 512, S2 = 1024, S3 = 512, SM = 32 * 256;
        constexpr int NIT = S0 + S1 + S2 + S3 + 3 * SM;
        for (int it = gw; it < NIT; it += NGW) {
            int r = it;
            if (r < S0) { const int kb = r / 40, nb = r % 40; p0_transpose_item(F.in[I_WIN], 1024, 1280, (bf16*)(F.ws + WS_WIN), kb * 64, nb * 32, nb * 32, scr, F.lane); continue; } r -= S0;
            if (r < S1) { const int kb = r / 32, nb = r % 32; p0_transpose_item(F.in[I_WOUT], 1024, 1024, (bf16*)(F.ws + WS_WOUT), kb * 64, nb * 32, nb * 32, scr, F.lane); continue; } r -= S1;
            if (r < S2) { const int kb = r / 64, nb = r % 64, n0 = nb * 32; p0_transpose_item(F.in[I_PW1W], 1024, 2048, (bf16*)(F.ws + WS_WPW1), kb * 64, n0, il_row(n0 & 1023, n0 >> 10), scr, F.lane); continue; } r -= S2;
            if (r < S3) { const int kb = r / 32, nb = r % 32; p0_transpose_item(F.in[I_PW2W], 1024, 1024, (bf16*)(F.ws + WS_WPW2), kb * 64, nb * 32, nb * 32, scr, F.lane); continue; } r -= S3;
            if (r < SM) { const int le = r >> 8, q = r & 255, kb = q / 16, nb = q % 16;
                p0_transpose_item(F.in[I_WG] + (size_t)le * 1024 * 512, 1024, 512, (bf16*)(F.ws + WS_WGU) + (size_t)le * 1024 * 1024, kb * 64, nb * 32, il_row(nb * 32, 0), scr, F.lane); continue; } r -= SM;
            if (r < SM) { const int le = r >> 8, q = r & 255, kb = q / 16, nb = q % 16;
                p0_transpose_item(F.in[I_WU] + (size_t)le * 1024 * 512, 1024, 512, (bf16*)(F.ws + WS_WGU) + (size_t)le * 1024 * 1024, kb * 64, nb * 32, il_row(nb * 32, 1), scr, F.lane); continue; } r -= SM;
            { const int le = r >> 8, q = r & 255, kb = q / 32, nb = q % 32;
                p0_transpose_item(F.in[I_WD] + (size_t)le * 512 * 1024, 512, 1024, (bf16*)(F.ws + WS_WDN) + (size_t)le * 1024 * 512, kb * 64, nb * 32, nb * 32, scr, F.lane); }
        }
    }
}

__device__ __forceinline__ void row_load(const float* p, int lane, f32x4 (&v)[4]) {
#pragma unroll
    for (int j = 0; j < 4; ++j) v[j] = *(const f32x4*)(p + 4 * lane + 256 * j);
}
__device__ __forceinline__ float row_sumsq(const f32x4 (&v)[4]) {
    float s = 0.f;
#pragma unroll
    for (int j = 0; j < 4; ++j) s += (v[j].x * v[j].x + v[j].y * v[j].y) + (v[j].z * v[j].z + v[j].w * v[j].w);
    return wave_sum(s);
}
__device__ __forceinline__ void row_modulate(f32x4 (&v)[4], float rstd, const float* g, const float* sh, const float* sc, int lane) {
#pragma unroll
    for (int j = 0; j < 4; ++j) { const int o = 4 * lane + 256 * j; const f32x4 gg = *(const f32x4*)(g + o), s1 = *(const f32x4*)(sc + o), s0 = *(const f32x4*)(sh + o);
        v[j] = v[j] * rstd * gg * (1.f + s1) + s0; }
}
__device__ __forceinline__ void row_store_bf16(bf16* dst, const f32x4 (&v)[4], int lane) {
#pragma unroll
    for (int j = 0; j < 4; ++j) { u32x2 w; w.x = pk2(v[j].x, v[j].y); w.y = pk2(v[j].z, v[j].w); *(u32x2*)(dst + 4 * lane + 256 * j) = w; }
}

__device__ __forceinline__ void phase_norm1_l0(Frame& F) {
    const int gw = F.wg * NWAVES + F.wave, NGW = F.G * NWAVES;
    const float* mod = (const float*)(F.ws + WS_MOD);
    bf16* HB = (bf16*)(F.ws + WS_HB);
    for (int row = gw; row < T + TC; row += NGW) {
        const float* src = row < T ? F.in[I_X] + (size_t)row * D : F.in[I_CTX] + (size_t)(row - T) * D;
        const int b = row < T ? (row >> 13) : 4;
        f32x4 v[4]; row_load(src, F.lane, v);
        const float rstd = rsqrtf(row_sumsq(v) * (1.f / D) + EPS);
        const float* m = mod + (size_t)b * 6144;
        row_modulate(v, rstd, F.in[I_NMG], m, m + 1024, F.lane);
        row_store_bf16(HB + (size_t)row * D, v, F.lane);
    }
}

struct RowLin { const bf16* base; size_t pitch; __device__ __forceinline__ const bf16* operator()(int m) const { return base + (size_t)m * pitch; } };

__device__ __forceinline__ void inproj_block(Frame& F, int mb, int nbk, const f32x16& c, int lane) {
    const int h = lane >> 5, cl = lane & 31;
    bf16* dst; int pitch, cbase; bool rope = false; bool isctx = (mb >= T);
    if (nbk < 512) { dst = (bf16*)(F.ws + WS_UF); pitch = 512; cbase = 0; }
    else if (nbk < 1024) { dst = (bf16*)(F.ws + WS_Q); pitch = 512; cbase = 512; rope = true; }
    else if (nbk < 1152) { dst = isctx ? (bf16*)(F.ws + WS_CK) : (bf16*)(F.ws + WS_K); pitch = 128; cbase = 1024; rope = !isctx; }
    else { dst = isctx ? (bf16*)(F.ws + WS_CV) : (bf16*)(F.ws + WS_V); pitch = 128; cbase = 1152; }
    const int rbase = isctx ? mb - T : mb;
    const int col = nbk - cbase + cl;
    const float inv = exp2f(-(float)(cl & 15) * (13.287712379549449f / 16.f));
    const bool second = (cl & 16) != 0; const bool bycol = ((nbk >> 5) & 1) != 0;
#pragma unroll
    for (int i = 0; i < 16; ++i) {
        const int rr = crow(i, h); float v = c[i];
        if (rope) {
            const float partner = __shfl_xor(v, 16);
            const int l = (mb + rr) & (L - 1);
            const float pos = (float)(bycol ? (l & 63) : (l >> 6));
            const float ang = pos * inv, cs = __cosf(ang), sn = __sinf(ang);
            v = second ? (partner * sn + v * cs) : (v * cs - partner * sn);
        }
        dst[(size_t)(rbase + rr) * pitch + col] = (bf16)f2bf(v);
    }
}
__device__ __forceinline__ void phase_inproj(Frame& F) {
    const bf16* HB = (const bf16*)(F.ws + WS_HB); const bf16* Wt = (const bf16*)(F.ws + WS_WIN);
    constexpr int MT = (T + TC) / 128, NT = N_IN / 128;
    RowLin rp{HB, (size_t)D};
    for (int u = F.wg; u < MT * NT; u += F.G) {
        const int mt = u / NT, nt = u % NT;
        if (mt >= T / 128 && nt < 8) continue;
        auto epi = [&](int mb, int nb, const f32x16& c0, const f32x16& c1, int lane) { inproj_block(F, mb, nb, c0, lane); inproj_block(F, mb, nb + 32, c1, lane); };
        sgemm_tile(rp, Wt, D, mt * 128, nt * 128, epi, F.wave, F.lane);
    }
}

__device__ __forceinline__ void attn_key(const bf16* kp, const bf16* vp, const float (&q)[64], float& m, float& s, float (&o)[64]) {
    float dot = 0.f;
#pragma unroll
    for (int j = 0; j < 8; ++j) { const u32x4 w = *(const u32x4*)(kp + 8 * j);
        dot += q[8 * j + 0] * bflo(w.x) + q[8 * j + 1] * bfhi(w.x) + q[8 * j + 2] * bflo(w.y) + q[8 * j + 3] * bfhi(w.y)
             + q[8 * j + 4] * bflo(w.z) + q[8 * j + 5] * bfhi(w.z) + q[8 * j + 6] * bflo(w.w) + q[8 * j + 7] * bfhi(w.w); }
    const float mn = fmaxf(m, dot), alpha = __expf(m - mn), p = __expf(dot - mn);
    s = s * alpha + p; m = mn;
#pragma unroll
    for (int j = 0; j < 8; ++j) { const u32x4 w = *(const u32x4*)(vp + 8 * j);
        o[8 * j + 0] = o[8 * j + 0] * alpha + p * bflo(w.x); o[8 * j + 1] = o[8 * j + 1] * alpha + p * bfhi(w.x);
        o[8 * j + 2] = o[8 * j + 2] * alpha + p * bflo(w.y); o[8 * j + 3] = o[8 * j + 3] * alpha + p * bfhi(w.y);
        o[8 * j + 4] = o[8 * j + 4] * alpha + p * bflo(w.z); o[8 * j + 5] = o[8 * j + 5] * alpha + p * bfhi(w.z);
        o[8 * j + 6] = o[8 * j + 6] * alpha + p * bflo(w.w); o[8 * j + 7] = o[8 * j + 7] * alpha + p * bfhi(w.w); }
}
__device__ __forceinline__ void phase_attn_simple(Frame& F) {
    const bf16* Q = (const bf16*)(F.ws + WS_Q); const bf16* Kb = (const bf16*)(F.ws + WS_K); const bf16* Vb = (const bf16*)(F.ws + WS_V);
    const bf16* CK = (const bf16*)(F.ws + WS_CK); const bf16* CV = (const bf16*)(F.ws + WS_CV); bf16* MIX = (bf16*)(F.ws + WS_MIX);
    for (int idx = F.wg * NTHR + F.tid; idx < T * 8; idx += F.G * NTHR) {
        const int hd = idx / T, t = idx % T, b = t >> 13, l = t & (L - 1), kvh = hd >> 2;
        float q[64], o[64];
#pragma unroll
        for (int j = 0; j < 8; ++j) { const u32x4 w = *(const u32x4*)(Q + (size_t)t * 512 + hd * 64 + 8 * j);
            q[8 * j + 0] = bflo(w.x) * 0.125f; q[8 * j + 1] = bfhi(w.x) * 0.125f; q[8 * j + 2] = bflo(w.y) * 0.125f; q[8 * j + 3] = bfhi(w.y) * 0.125f;
            q[8 * j + 4] = bflo(w.z) * 0.125f; q[8 * j + 5] = bfhi(w.z) * 0.125f; q[8 * j + 6] = bflo(w.w) * 0.125f; q[8 * j + 7] = bfhi(w.w) * 0.125f; }
#pragma unroll
        for (int j = 0; j < 64; ++j) o[j] = 0.f;
        float m = F.in[I_SINK][hd], s = 1.f;
        for (int c = 0; c < CL; ++c) { const size_t r = (size_t)(b * CL + c) * 128 + kvh * 64; attn_key(CK + r, CV + r, q, m, s, o); }
        const int lo = l - 128 < 0 ? 0 : l - 128, hi = l + 128 > L - 1 ? L - 1 : l + 128;
        for (int kp = lo; kp <= hi; ++kp) { const size_t r = (size_t)(b * L + kp) * 128 + kvh * 64; attn_key(Kb + r, Vb + r, q, m, s, o); }
        const float is = 1.f / s;
#pragma unroll
        for (int j = 0; j < 8; ++j) { u32x4 w; w.x = pk2(o[8 * j] * is, o[8 * j + 1] * is); w.y = pk2(o[8 * j + 2] * is, o[8 * j + 3] * is); w.z = pk2(o[8 * j + 4] * is, o[8 * j + 5] * is); w.w = pk2(o[8 * j + 6] * is, o[8 * j + 7] * is);
            *(u32x4*)(MIX + (size_t)t * 1024 + 512 + hd * 64 + 8 * j) = w; }
    }
}

__device__ __forceinline__ void phase_fft1_simple(Frame& F) {
    const bf16* UF = (const bf16*)(F.ws + WS_UF); bf16* Gb = (bf16*)(F.ws + WS_G); const float* tw = (const float*)(F.ws + WS_TW);
    for (int idx = F.wg * NTHR + F.tid; idx < NB * FN1 * FN2 * 512; idx += F.G * NTHR) {
        const int ch = idx & 511, bp = (idx >> 9) & 127, c = (idx >> 16) & 63, b = idx >> 22;
        float re = 0.f, im = 0.f;
        for (int a = 0; a < FN1; ++a) { const float u = bf2f(UF[(size_t)(b * L + 128 * a + bp) * 512 + ch]); const int k = ((a * c) & 63) * 128;
            re += u * tw[2 * k]; im -= u * tw[2 * k + 1]; }
        const int k2 = bp * c; const float cs = tw[2 * k2], sn = tw[2 * k2 + 1];
        const float gr = re * cs + im * sn, gi = im * cs - re * sn;
        const size_t row = (size_t)(b * FN1 + c) * FN2 + bp;
        Gb[row * 1024 + ch] = (bf16)f2bf(gr); Gb[row * 1024 + 512 + ch] = (bf16)f2bf(gi);
    }
}
__device__ __forceinline__ void phase_fft2_simple(Frame& F) {
    const bf16* Gb = (const bf16*)(F.ws + WS_G); bf16* AB = (bf16*)(F.ws + WS_AB); const float* tw = (const float*)(F.ws + WS_TW);
    for (int idx = F.wg * NTHR + F.tid; idx < NB * FN1 * FN2 * 512; idx += F.G * NTHR) {
        const int ch = idx & 511, d = (idx >> 9) & 127, c = (idx >> 16) & 63, b = idx >> 22;
        float fr = 0.f, fi = 0.f;
        for (int bp = 0; bp < FN2; ++bp) { const size_t row = (size_t)(b * FN1 + c) * FN2 + bp; const float gr = bf2f(Gb[row * 1024 + ch]), gi = bf2f(Gb[row * 1024 + 512 + ch]);
            const int k = ((bp * d) & 127) * 64; const float cs = tw[2 * k], sn = tw[2 * k + 1];
            fr += gr * cs + gi * sn; fi += gi * cs - gr * sn; }
        const size_t t = (size_t)b * L + c + 64 * d;
        AB[t * 1024 + ch] = (bf16)f2bf(fr); AB[t * 1024 + 512 + ch] = (bf16)f2bf(-fi);
    }
}
__device__ __forceinline__ void phase_fft3_simple(Frame& F) {
    const bf16* AB = (const bf16*)(F.ws + WS_AB); bf16* MIX = (bf16*)(F.ws + WS_MIX); const float* tw = (const float*)(F.ws + WS_TW);
    LAS float* t128 = (LAS float*)F.lds;
    for (int i = F.tid; i < 128; i += NTHR) { t128[2 * i] = tw[2 * (i * 64)]; t128[2 * i + 1] = tw[2 * (i * 64) + 1]; }
    __syncthreads();
    for (int idx = F.wg * NTHR + F.tid; idx < T * 512; idx += F.G * NTHR) {
        const int cp = idx & 127, g = (idx >> 7) & 3, t = idx >> 9;
        const bf16* arow = AB + (size_t)t * 1024 + g * 128;
        float y = 0.f;
        for (int cc = 0; cc < 128; ++cc) { const int k = (cc * cp) & 127; y += bf2f(arow[cc]) * t128[2 * k] - bf2f(arow[512 + cc]) * t128[2 * k + 1]; }
        MIX[(size_t)t * 1024 + g * 128 + cp] = (bf16)f2bf(y * (1.f / 1024.f));
    }
    __syncthreads();
}

__device__ __forceinline__ void phase_outproj(Frame& F, const bf16* A, const bf16* Wt, const float* base, float* X, const float* gate  , const float* bias) {
    RowLin rp{A, (size_t)D};
    for (int u = F.wg; u < (T / 128) * 8; u += F.G) {
        const int mt = u / 8, nt = u % 8;
        auto epi = [&](int mb, int nb, const f32x16& c0, const f32x16& c1, int lane) {
            const int h = lane >> 5, cl = lane & 31, b = mb >> 13;
#pragma unroll
            for (int half = 0; half < 2; ++half) { const int col = nb + 32 * half + cl; const float gv = gate[(size_t)b * 6144 + col], bv = bias ? bias[col] : 0.f;
#pragma unroll
                for (int i = 0; i < 16; ++i) { const size_t o = (size_t)(mb + crow(i, h)) * D + col; const float a = half ? c1[i] : c0[i]; X[o] = base[o] + gv * (a + bv); } }
        };
        sgemm_tile(rp, Wt, D, mt * 128, nt * 128, epi, F.wave, F.lane);
    }
}

__device__ __forceinline__ void phase_norm2_route(Frame& F, int layer) {
    const float* mod = (const float*)(F.ws + WS_MOD) + (size_t)layer * 5 * 6144;
    const float* X = F.out; bf16* HB = (bf16*)(F.ws + WS_HB);
    const float* rw = F.in[I_RW]; const float* rb = F.in[I_RB];
    int* tok_e = (int*)(F.ws + WS_TOKE); int* tok_p = (int*)(F.ws + WS_TOKP); float* tok_w = (float*)(F.ws + WS_TOKW);
    int* slot_t = (int*)(F.ws + WS_SLOTT);
    float* slot_w = (float*)(F.ws + WS_SLOTW);
    unsigned* cnt = F.ctl + CW_CNT + layer * 16 * 64;
    LAS int* sel_e = (LAS int*)F.lds;
    LAS float* sel_w = (LAS float*)(F.lds + 1024);
    for (int rb0 = F.wg; rb0 < T / 128; rb0 += F.G) {
        for (int j = 0; j < 16; ++j) {
            const int lr = F.wave * 16 + j, row = rb0 * 128 + lr, b = row >> 13;
            f32x4 v[4]; row_load(X + (size_t)row * D, F.lane, v);
            const float rstd = rsqrtf(row_sumsq(v) * (1.f / D) + EPS);
            const float* m = mod + (size_t)b * 6144;
            row_modulate(v, rstd, F.in[I_NFG] + layer * D, m + 3072, m + 4096, F.lane);
            row_store_bf16(HB + (size_t)row * D, v, F.lane);
            float lg[16];
#pragma unroll
            for (int e = 0; e < 16; ++e) lg[e] = 0.f;
#pragma unroll
            for (int jj = 0; jj < 4; ++jj)
#pragma unroll
                for (int q = 0; q < 4; ++q) { const float* wr = rw + (size_t)(4 * F.lane + 256 * jj + q) * 16; const float fv = v[jj][q];
#pragma unroll
                    for (int e4 = 0; e4 < 4; ++e4) { const f32x4 w4 = *(const f32x4*)(wr + 4 * e4); lg[4 * e4] += fv * w4.x; lg[4 * e4 + 1] += fv * w4.y; lg[4 * e4 + 2] += fv * w4.z; lg[4 * e4 + 3] += fv * w4.w; } }
#pragma unroll
            for (int e = 0; e < 16; ++e) lg[e] = wave_sum(lg[e]);
            float best = -1e30f; int be1 = 0, be2 = 0; float bs1 = 0.f, bs2 = 0.f;
#pragma unroll
            for (int g = 0; g < 4; ++g) {
                float v1 = -1e30f, v2 = -1e30f, s1 = 0.f, s2 = 0.f; int j1 = 0, j2 = 0;
#pragma unroll
                for (int q = 0; q < 4; ++q) { const float sc = sigmoid_f(lg[4 * g + q]), x = sc + rb[4 * g + q];
                    if (x > v1) { v2 = v1; j2 = j1; s2 = s1; v1 = x; j1 = q; s1 = sc; } else if (x > v2) { v2 = x; j2 = q; s2 = sc; } }
                const float gs = v1 + v2;
                if (gs > best) { best = gs; be1 = 4 * g + j1; be2 = 4 * g + j2; bs1 = s1; bs2 = s2; }
            }
            if (F.lane == 0) { const float inv = 1.f / (bs1 + bs2); sel_e[2 * lr] = be1; sel_e[2 * lr + 1] = be2; sel_w[2 * lr] = bs1 * inv; sel_w[2 * lr + 1] = bs2 * inv; }
        }
        __syncthreads();
        if (F.tid < 16) {
            const int e = F.tid; int n = 0;
            for (int i = 0; i < 256; ++i) n += (sel_e[i] == e) ? 1 : 0;
            int pos = n ? (int)atomicAdd(cnt + e * 64, (unsigned)n) : 0;
            for (int i = 0; i < 256; ++i) if (sel_e[i] == e) { const int tok = rb0 * 128 + (i >> 1);
                slot_t[e * CAP + pos] = tok; slot_w[e * CAP + pos] = sel_w[i]; tok_e[2 * tok + (i & 1)] = e; tok_p[2 * tok + (i & 1)] = pos; tok_w[2 * tok + (i & 1)] = sel_w[i]; ++pos; }
        }
        __syncthreads();
    }
}

constexpr int MOEMAP_OFF = LDS_BYTES - 256;
__device__ __forceinline__ LAS int* moe_map(Frame& F, int layer) {
    LAS int* mm = (LAS int*)(F.lds + MOEMAP_OFF);
    __syncthreads();
    if (F.tid == 0) { const unsigned* cnt = F.ctl + CW_CNT + layer * 16 * 64; int acc = 0;
        for (int e = 0; e < 16; ++e) { const int n = (int)__hip_atomic_load(cnt + e * 64, __ATOMIC_RELAXED, __HIP_MEMORY_SCOPE_AGENT); mm[e] = n; mm[16 + e] = acc; acc += (n + 255) & ~255; } }
    __syncthreads();
    return mm;
}
struct RowGather { const bf16* base; const int* list; int n; __device__ __forceinline__ const bf16* operator()(int m) const { const int tok = m < n ? list[m] : 0; return base + (size_t)tok * D; } };

__device__ __forceinline__ void phase_moe_gateup(Frame& F, int layer) {
    LAS int* mm = moe_map(F, layer);
    const bf16* HB = (const bf16*)(F.ws + WS_HB); bf16* HID = (bf16*)(F.ws + WS_HID);
    const int* slot_t = (const int*)(F.ws + WS_SLOTT); const float* slot_w = (const float*)(F.ws + WS_SLOTW);
    int ubase = 0;
#pragma unroll 1
    for (int e = 0; e < 16; ++e) {
        const int n = mm[e], hbe = mm[16 + e], rt = (n + 127) >> 7, nu = rt * 8;
        const bf16* Wt = (const bf16*)(F.ws + WS_WGU) + (size_t)(layer * 16 + e) * 1024 * 1024;
        RowGather rp{HB, slot_t + e * CAP, n};
        int first = (F.wg - ubase % F.G + F.G) % F.G;
        for (int u = first; u < nu; u += F.G) {
            const int mt = u / 8, nt = u % 8;
            auto epi = [&](int mb, int nb, const f32x16& c0, const f32x16& c1, int lane) {
                const int h = lane >> 5, cl = lane & 31; const int col = (nb >> 1) + cl;
#pragma unroll
                for (int i = 0; i < 16; ++i) { const int r = mb + crow(i, h);
                    if (r < n) { const float w = slot_w[e * CAP + r]; HID[(size_t)(hbe + r) * FF + col] = (bf16)f2bf(w * silu_f(c0[i]) * c1[i]); } }
            };
            sgemm_tile(rp, Wt, D, mt * 128, nt * 128, epi, F.wave, F.lane);
        }
        ubase += nu;
    }
}
__device__ __forceinline__ void phase_moe_down(Frame& F, int layer) {
    LAS int* mm = moe_map(F, layer);
    const bf16* HID = (const bf16*)(F.ws + WS_HID); bf16* Y = (bf16*)(F.ws + WS_Y);
    int ubase = 0;
#pragma unroll 1
    for (int e = 0; e < 16; ++e) {
        const int n = mm[e], hbe = mm[16 + e], rt = (n + 127) >> 7, nu = rt * 8;
        const bf16* Wt = (const bf16*)(F.ws + WS_WDN) + (size_t)(layer * 16 + e) * 1024 * 512;
        RowLin rp{HID + (size_t)hbe * FF, (size_t)FF};
        int first = (F.wg - ubase % F.G + F.G) % F.G;
        for (int u = first; u < nu; u += F.G) {
            const int mt = u / 8, nt = u % 8;
            auto epi = [&](int mb, int nb, const f32x16& c0, const f32x16& c1, int lane) {
                const int h = lane >> 5, cl = lane & 31;
#pragma unroll
                for (int i = 0; i < 16; ++i) { const int r = mb + crow(i, h);
                    if (r < n) { bf16* yr = Y + (size_t)(hbe + r) * D + nb + cl; yr[0] = (bf16)f2bf(c0[i]); yr[32] = (bf16)f2bf(c1[i]); } }
            };
            sgemm_tile(rp, Wt, FF, mt * 128, nt * 128, epi, F.wave, F.lane);
        }
        ubase += nu;
    }
}

template <bool FINAL>
__device__ __forceinline__ void phase_combine(Frame& F, int layer) {
    LAS int* hbs = moe_map(F, layer) + 16;
    const int gw = F.wg * NWAVES + F.wave, NGW = F.G * NWAVES;
    const float* mod = (const float*)(F.ws + WS_MOD);
    const int* tok_e = (const int*)(F.ws + WS_TOKE); const int* tok_p = (const int*)(F.ws + WS_TOKP);
    const bf16* Y = (const bf16*)(F.ws + WS_Y); float* X = F.out; bf16* HB = (bf16*)(F.ws + WS_HB);
    for (int row = gw; row < T; row += NGW) {
        const int b = row >> 13;
        const int s0 = hbs[tok_e[2 * row]] + tok_p[2 * row], s1 = hbs[tok_e[2 * row + 1]] + tok_p[2 * row + 1];
        f32x4 v[4]; row_load(X + (size_t)row * D, F.lane, v);
        const float* g2 = mod + ((size_t)layer * 5 + b) * 6144 + 5120;
#pragma unroll
        for (int j = 0; j < 4; ++j) { const int o = 4 * F.lane + 256 * j;
            const u32x2 y0 = *(const u32x2*)(Y + (size_t)s0 * D + o), y1 = *(const u32x2*)(Y + (size_t)s1 * D + o); const f32x4 gg = *(const f32x4*)(g2 + o);
            v[j].x += gg.x * (bflo(y0.x) + bflo(y1.x)); v[j].y += gg.y * (bfhi(y0.x) + bfhi(y1.x)); v[j].z += gg.z * (bflo(y0.y) + bflo(y1.y)); v[j].w += gg.w * (bfhi(y0.y) + bfhi(y1.y)); }
        const float rstd = rsqrtf(row_sumsq(v) * (1.f / D) + EPS);
        if (FINAL) {
#pragma unroll
            for (int j = 0; j < 4; ++j) { const int o = 4 * F.lane + 256 * j; const f32x4 gg = *(const f32x4*)(F.in[I_FNG] + o); *(f32x4*)(X + (size_t)row * D + o) = v[j] * rstd * gg; }
        } else {
#pragma unroll
            for (int j = 0; j < 4; ++j) *(f32x4*)(X + (size_t)row * D + 4 * F.lane + 256 * j) = v[j];
            const float* m = mod + ((size_t)(layer + 1) * 5 + b) * 6144;
            row_modulate(v, rstd, F.in[I_NMG] + (layer + 1) * D, m, m + 1024, F.lane);
            row_store_bf16(HB + (size_t)row * D, v, F.lane);
        }
    }
    __syncthreads();
}

__device__ __forceinline__ void phase_pw1(Frame& F) {
    const bf16* HB = (const bf16*)(F.ws + WS_HB); const bf16* Wt = (const bf16*)(F.ws + WS_WPW1); bf16* U = (bf16*)(F.ws + WS_U);
    const float* bias = F.in[I_PW1B];
    RowLin rp{HB, (size_t)D};
    for (int u = F.wg; u < (T / 128) * 16; u += F.G) {
        const int mt = u / 16, nt = u % 16;
        auto epi = [&](int mb, int nb, const f32x16& c0, const f32x16& c1, int lane) {
            const int h = lane >> 5, cl = lane & 31, col = (nb >> 1) + cl; const float ba = bias[col], bg = bias[1024 + col];
#pragma unroll
            for (int i = 0; i < 16; ++i) U[(size_t)(mb + crow(i, h)) * D + col] = (bf16)f2bf((c0[i] + ba) * sigmoid_f(c1[i] + bg));
        };
        sgemm_tile(rp, Wt, D, mt * 128, nt * 128, epi, F.wave, F.lane);
    }
}
__device__ __forceinline__ void phase_dwconv(Frame& F) {
    const bf16* U = (const bf16*)(F.ws + WS_U); bf16* V1 = (bf16*)(F.ws + WS_V1);
    const float* dww = F.in[I_DWW]; const float* dwb = F.in[I_DWB]; const float* lng = F.in[I_LNG]; const float* lnb = F.in[I_LNB];
    const int gw = F.wg * NWAVES + F.wave, NGW = F.G * NWAVES;
    for (int row = gw; row < T; row += NGW) {
        const int l = row & (L - 1);
        f32x4 acc[4];
#pragma unroll
        for (int j = 0; j < 4; ++j) acc[j] = *(const f32x4*)(dwb + 4 * F.lane + 256 * j);
        for (int tp = 0; tp < CONVW; ++tp) { const int ll = l + tp - 15; if (ll < 0 || ll >= L) continue;
            const bf16* ur = U + (size_t)(row + tp - 15) * D; const float* wr = dww + (size_t)tp * D;
#pragma unroll
            for (int j = 0; j < 4; ++j) { const int o = 4 * F.lane + 256 * j; const u32x2 uu = *(const u32x2*)(ur + o); const f32x4 ww = *(const f32x4*)(wr + o);
                acc[j].x += bflo(uu.x) * ww.x; acc[j].y += bfhi(uu.x) * ww.y; acc[j].z += bflo(uu.y) * ww.z; acc[j].w += bfhi(uu.y) * ww.w; } }
        float s = 0.f;
#pragma unroll
        for (int j = 0; j < 4; ++j) s += (acc[j].x + acc[j].y) + (acc[j].z + acc[j].w);
        const float mean = wave_sum(s) * (1.f / D); float q = 0.f;
#pragma unroll
        for (int j = 0; j < 4; ++j) { acc[j] = acc[j] - mean; q += (acc[j].x * acc[j].x + acc[j].y * acc[j].y) + (acc[j].z * acc[j].z + acc[j].w * acc[j].w); }
        const float rstd = rsqrtf(wave_sum(q) * (1.f / D) + EPS);
#pragma unroll
        for (int j = 0; j < 4; ++j) { const int o = 4 * F.lane + 256 * j; const f32x4 gg = *(const f32x4*)(lng + o), bb = *(const f32x4*)(lnb + o);
            f32x4 y = acc[j] * rstd * gg + bb; y.x = silu_f(y.x); y.y = silu_f(y.y); y.z = silu_f(y.z); y.w = silu_f(y.w); acc[j] = y; }
        row_store_bf16(V1 + (size_t)row * D, acc, F.lane);
    }
}

constexpr int NPH = 18;
__global__ void __launch_bounds__(NTHR, 2) mega(Args args) {
    extern __shared__ __attribute__((aligned(16))) unsigned char lds[];
    Frame F;
    F.lds = (LAS unsigned char*)lds;
    F.tid = threadIdx.x; F.lane = F.tid & 63; F.wave = __builtin_amdgcn_readfirstlane(F.tid >> 6);
    F.G = gridDim.x; F.wg = blockIdx.x;
    F.in = args.in; F.out = args.out; F.ws = args.ws; F.ctl = (unsigned*)(args.ws + WS_CTL);
    volatile LAS unsigned* bst = (volatile LAS unsigned*)(F.lds + LDS_BYTES - 16);
    if (F.tid < 4) bst[F.tid] = 0u;
    __syncthreads();
    const int lo = args.ph_lo, hi = args.ph_hi;
    XcdBarrier bar; bar.bar = F.ctl + CW_BAR; bar.x = 0; bar.st = bst;
    if (hi - lo > 1) bar = xcd_barrier_post(F.ctl + CW_BAR, bst);
#define IN(k) (lo <= (k) && (k) < hi)
#define SEAM(k) do { if (IN(k) && IN((k) + 1)) xcd_barrier(bar); } while (0)
    const float* mod = (const float*)(F.ws + WS_MOD);

    if (IN(0)) { phase_prep(F); } SEAM(0);
    if (IN(1)) { phase_norm1_l0(F); } SEAM(1);
    if (IN(2)) { phase_inproj(F); } SEAM(2);
    if (IN(3)) { phase_attn_simple(F); phase_fft1_simple(F); } SEAM(3);
    if (IN(4)) { phase_fft2_simple(F); } SEAM(4);
    if (IN(5)) { phase_fft3_simple(F); } SEAM(5);
    if (IN(6)) { phase_outproj(F, (const bf16*)(F.ws + WS_MIX), (const bf16*)(F.ws + WS_WOUT), F.in[I_X], F.out, mod + 2048, nullptr); } SEAM(6);
    if (IN(7)) { phase_norm2_route(F, 0); } SEAM(7);
    if (IN(8)) { phase_moe_gateup(F, 0); } SEAM(8);
    if (IN(9)) { phase_moe_down(F, 0); } SEAM(9);
    if (IN(10)) { phase_combine<false>(F, 0); } SEAM(10);
    if (IN(11)) { phase_pw1(F); } SEAM(11);
    if (IN(12)) { phase_dwconv(F); } SEAM(12);
    if (IN(13)) { phase_outproj(F, (const bf16*)(F.ws + WS_V1), (const bf16*)(F.ws + WS_WPW2), F.out, F.out, mod + 5 * 6144 + 2048, F.in[I_PW2B]); } SEAM(13);
    if (IN(14)) { phase_norm2_route(F, 1); } SEAM(14);
    if (IN(15)) { phase_moe_gateup(F, 1); } SEAM(15);
    if (IN(16)) { phase_moe_down(F, 1); } SEAM(16);
    if (IN(17)) { phase_combine<true>(F, 1); }
#undef IN
#undef SEAM
}

extern "C" void kernel_launch(void* const* d_in, const int* in_sizes, int n_in, void* d_out, int out_size, void* d_ws, size_t ws_size, hipStream_t stream) {
    static int grid = 0;
    if (grid == 0) {
        if (n_in != 25 || out_size != T * D || ws_size < WS_END) { fprintf(stderr, "kernel_launch: unexpected shapes (n_in %d out %d ws %zu)\n", n_in, out_size, ws_size); grid = -1; return; }
        int dev = 0, cus = 0, per_cu = 0;
        if (hipGetDevice(&dev) != hipSuccess || hipDeviceGetAttribute(&cus, hipDeviceAttributeMultiprocessorCount, dev) != hipSuccess) { grid = -1; return; }
        if (hipFuncSetAttribute((const void*)mega, hipFuncAttributeMaxDynamicSharedMemorySize, LDS_BYTES) != hipSuccess) { fprintf(stderr, "kernel_launch: hipFuncSetAttribute failed\n"); grid = -1; return; }
        if (hipOccupancyMaxActiveBlocksPerMultiprocessor(&per_cu, (const void*)mega, NTHR, LDS_BYTES) != hipSuccess || per_cu < 1) { fprintf(stderr, "kernel_launch: occupancy query says %d\n", per_cu); }
        (void)hipGetLastError();
        grid = cus;
    }
    if (grid < 0) return;
    (void)hipMemsetAsync((char*)d_ws + WS_CTL, 0, CTL_BYTES, stream);
    Args a{};
    for (int i = 0; i < 25; ++i) a.in[i] = (const float*)d_in[i];
    a.out = (float*)d_out; a.ws = (unsigned char*)d_ws;
#if MK_ONE_LAUNCH
    a.ph_lo = 0; a.ph_hi = NPH;
    hipLaunchKernelGGL(mega, dim3(grid), dim3(NTHR), LDS_BYTES, stream, a);
#else
    for (int p = 0; p < NPH; ++p) { a.ph_lo = p; a.ph_hi = p + 1; hipLaunchKernelGGL(mega, dim3(grid), dim3(NTHR), LDS_BYTES, stream, a); }
#endif
}
```

```cpp
#include <hip/hip_runtime.h>
#include <cstdio>

#ifndef MK_ONE_LAUNCH
#define MK_ONE_LAUNCH 1
#endif

#define GAS __attribute__((address_space(1)))
#define LAS __attribute__((address_space(3)))
typedef unsigned short bf16;
typedef short bf16x8 __attribute__((ext_vector_type(8)));
typedef float f32x4 __attribute__((ext_vector_type(4)));
typedef float f32x16 __attribute__((ext_vector_type(16)));
typedef unsigned u32x4 __attribute__((ext_vector_type(4)));
typedef unsigned u32x2 __attribute__((ext_vector_type(2)));

constexpr int D = 1024, NB = 4, L = 8192, T = NB * L, CL = 256, TC = NB * CL;
constexpr int NE = 16, FF = 512, CONVW = 31;
constexpr int N_IN = 1280;
constexpr int FN1 = 64, FN2 = 128;
#ifndef FAST_GEMM
#define FAST_GEMM 1
#endif
constexpr int IL = FAST_GEMM ? 128 : 32;
constexpr float EPS = 1e-6f;
constexpr int NWAVES = 8, NTHR = 512;
constexpr int CAP = 32768;
constexpr int HROWS = 65536 + 4096;

constexpr size_t MiB = 1u << 20;
constexpr size_t WS_CTL = 0, CTL_BYTES = 1 * MiB;
constexpr size_t WS_MOD = 1 * MiB;
constexpr size_t WS_TW = 1 * MiB + 512 * 1024;
constexpr size_t WS_WIN = 2 * MiB, WS_WOUT = 6 * MiB, WS_WPW1 = 10 * MiB, WS_WPW2 = 14 * MiB;
constexpr size_t WS_WGU = 16 * MiB, WS_WDN = 80 * MiB;
constexpr size_t WS_TOKE = 112 * MiB, WS_TOKP = 113 * MiB, WS_TOKW = 114 * MiB;
constexpr size_t WS_SLOTT = 116 * MiB, WS_SLOTW = 120 * MiB;
constexpr size_t WS_HB = 128 * MiB;
constexpr size_t WS_UF = 196 * MiB, WS_Q = 228 * MiB, WS_K = 260 * MiB, WS_V = 268 * MiB, WS_CK = 276 * MiB, WS_CV = 277 * MiB;
constexpr size_t WS_G = 280 * MiB, WS_MIX = 344 * MiB, WS_AB = 408 * MiB;
constexpr size_t WS_HID = 196 * MiB, WS_Y = 264 * MiB;
constexpr size_t WS_U = 196 * MiB, WS_V1 = 260 * MiB;
constexpr size_t WS_END = 472 * MiB;
constexpr int CW_BAR = 4096;
constexpr int CW_CNT = 8192;

constexpr int LDS_BYTES = 147456;

__device__ __forceinline__ unsigned f2bf(float f) { unsigned u = __float_as_uint(f); return (u + 0x7fffu + ((u >> 16) & 1u)) >> 16; }
__device__ __forceinline__ float bf2f(unsigned b) { return __uint_as_float(b << 16); }
__device__ __forceinline__ unsigned pk2(float lo, float hi) { return f2bf(lo) | (f2bf(hi) << 16); }
__device__ __forceinline__ float bflo(unsigned w) { return __uint_as_float(w << 16); }
__device__ __forceinline__ float bfhi(unsigned w) { return __uint_as_float(w & 0xffff0000u); }
__device__ __forceinline__ float wave_sum(float v) {
#pragma unroll
    for (int o = 1; o < 64; o <<= 1) v += __shfl_xor(v, o);
    return v;
}
__device__ __forceinline__ float silu_f(float x) { return x / (1.f + __expf(-x)); }
__device__ __forceinline__ float sigmoid_f(float x) { return 1.f / (1.f + __expf(-x)); }
#define LDS_WAIT() asm volatile("s_waitcnt lgkmcnt(0)" ::: "memory")

#define XB_TMO      128
#define XB_XCNT(j)  (256  + 64 * (j))
#define XB_XSUB(j)  (1280 + 64 * (j))
#define XB_XGEN(j)  (2304 + 64 * (j))
#define XB_TOP      3328
#define XB_TOPGEN   3392
#define XCD_BAR_WORDS 3456
#define XB_SPIN_CAP (1u << 20)
__device__ __forceinline__ unsigned xb_ld(unsigned* p)              { return __hip_atomic_load(p, __ATOMIC_RELAXED, __HIP_MEMORY_SCOPE_AGENT); }
__device__ __forceinline__ unsigned xb_add(unsigned* p, unsigned v) { return __hip_atomic_fetch_add(p, v, __ATOMIC_RELAXED, __HIP_MEMORY_SCOPE_AGENT); }
__device__ __forceinline__ unsigned xb_xcc_id() { return (unsigned)__builtin_amdgcn_s_getreg((3 << 11) | 20) & 0xFu; }
#define XB_SPIN(cond, bar) do { unsigned _sp = 0; while (cond) { __builtin_amdgcn_s_sleep(1); \
    if ((++_sp & 255u) == 0u) { if (xb_ld(&(bar)[XB_TMO])) break; if (_sp > XB_SPIN_CAP) { atomicAdd(&(bar)[XB_TMO], 1u); break; } } } } while (0)
struct XcdBarrier { unsigned* bar; unsigned x; volatile LAS unsigned* st; };
__device__ __forceinline__ XcdBarrier xcd_barrier_post(unsigned* bar, volatile LAS unsigned* st) {
    XcdBarrier b; b.bar = bar; b.x = xb_xcc_id(); b.st = st;
    if (threadIdx.x == 0) (void)xb_add(&bar[XB_XCNT(b.x)], 1u);
    return b;
}
__device__ __forceinline__ void xcd_barrier_complete(unsigned* bar, unsigned x, unsigned& nloc, unsigned& nx) {
    const unsigned G = gridDim.x * gridDim.y * gridDim.z;
    unsigned sum, cnt, mine, sp = 0u;
    for (;;) {
        sum = 0u; cnt = 0u; mine = 0u;
#pragma unroll
        for (unsigned j = 0; j < 16; ++j) { const unsigned c = xb_ld(&bar[XB_XCNT(j)]); sum += c; cnt += (c > 0u) ? 1u : 0u; mine = (j == x) ? c : mine; }
        if (sum == G) break;
        __builtin_amdgcn_s_sleep(1);
        if ((++sp & 255u) == 0u) { if (xb_ld(&bar[XB_TMO])) break; if (sp > XB_SPIN_CAP) { atomicAdd(&bar[XB_TMO], 1u); break; } }
    }
    nloc = mine > 0u ? mine : 1u; nx = cnt > 0u ? cnt : 1u;
}
__device__ __forceinline__ void xcd_barrier(const XcdBarrier& b) {
    asm volatile("s_waitcnt vmcnt(0)" ::: "memory");
    __syncthreads();
    if (threadIdx.x == 0) {
        unsigned* bar = b.bar;
        __builtin_amdgcn_s_waitcnt(0);
        unsigned nloc = b.st[0], nx = b.st[1];
        if (nloc == 0u) { xcd_barrier_complete(bar, b.x, nloc, nx); b.st[0] = nloc; b.st[1] = nx; }
        const unsigned old = xb_add(&bar[XB_XSUB(b.x)], 1u);
        const unsigned gen = old / nloc;
        if (old + 1u == (gen + 1u) * nloc) {
            __builtin_amdgcn_fence(__ATOMIC_RELEASE, "agent");
            asm volatile("s_waitcnt vmcnt(0)" ::: "memory");
            const unsigned og = xb_add(&bar[XB_TOP], 1u);
            const unsigned tg = og / nx;
            if (og + 1u == (tg + 1u) * nx) xb_add(&bar[XB_TOPGEN], 1u);
            else XB_SPIN(xb_ld(&bar[XB_TOPGEN]) == tg, bar);
            __builtin_amdgcn_fence(__ATOMIC_ACQUIRE, "agent");
            xb_add(&bar[XB_XGEN(b.x)], 1u);
            asm volatile("s_waitcnt vmcnt(0)" ::: "memory");
        } else {
            XB_SPIN(xb_ld(&bar[XB_XGEN(b.x)]) == gen, bar);
            __builtin_amdgcn_fence(__ATOMIC_ACQUIRE, "agent");
            asm volatile("s_waitcnt vmcnt(0)" ::: "memory");
        }
    }
    __syncthreads();
}

struct Args { const float* in[25]; float* out; unsigned char* ws; int ph_lo, ph_hi; };
enum { I_X = 0, I_C, I_CTX, I_CCTX, I_ADAW, I_ADAB, I_NMG, I_NFG, I_WIN, I_WOUT, I_SINK, I_PW1W, I_PW1B, I_DWW, I_DWB, I_LNG, I_LNB,
       I_PW2W, I_PW2B, I_RW, I_RB, I_WG, I_WU, I_WD, I_FNG };

struct Frame {
    LAS unsigned char* lds;
    int tid, lane, wave, G, wg;
    const float* const* in;
    float* out;
    unsigned char* ws;
    unsigned* ctl;
};

__device__ __forceinline__ int crow(int i, int h) { return (i & 3) + 8 * (i >> 2) + 4 * h; }
template <class RowPtr, class Epi>
__device__ __forceinline__ void sgemm_tile(const RowPtr& rowptr, const bf16* Bt, int K, int m0, int n0, const Epi& epi, int wave, int lane) {
    const int wm = wave & 3, wn = wave >> 2, r = lane & 31, h = lane >> 5;
    const bf16* ap = rowptr(m0 + wm * 32 + r) + 8 * h;
    const bf16* bp0 = Bt + (size_t)(n0 + wn * 64 + r) * K + 8 * h;
    const bf16* bp1 = bp0 + (size_t)32 * K;
    f32x16 c0, c1;
#pragma unroll
    for (int i = 0; i < 16; ++i) { c0[i] = 0.f; c1[i] = 0.f; }
#pragma unroll 2
    for (int k = 0; k < K; k += 32) {
        const bf16x8 a0 = *(const bf16x8*)(ap + k), a1 = *(const bf16x8*)(ap + k + 16);
        const bf16x8 b00 = *(const bf16x8*)(bp0 + k), b01 = *(const bf16x8*)(bp0 + k + 16);
        const bf16x8 b10 = *(const bf16x8*)(bp1 + k), b11 = *(const bf16x8*)(bp1 + k + 16);
        c0 = __builtin_amdgcn_mfma_f32_32x32x16_bf16(a0, b00, c0, 0, 0, 0);
        c1 = __builtin_amdgcn_mfma_f32_32x32x16_bf16(a0, b10, c1, 0, 0, 0);
        c0 = __builtin_amdgcn_mfma_f32_32x32x16_bf16(a1, b01, c0, 0, 0, 0);
        c1 = __builtin_amdgcn_mfma_f32_32x32x16_bf16(a1, b11, c1, 0, 0, 0);
    }
    epi(m0 + wm * 32, n0 + wn * 64, c0, c1, lane);
}

__device__ __forceinline__ void p0_transpose_item(const float* W, int K, int N, bf16* WT, int k0, int n0, int drow0, LAS float* scr, int lane) {
#pragma unroll 8
    for (int i = 0; i < 32; ++i) { const int kk = 2 * i + (lane >> 5); scr[kk * 33 + (lane & 31)] = W[(size_t)(k0 + kk) * N + n0 + (lane & 31)]; }
    LDS_WAIT(); asm volatile("" ::: "memory");
    const int c = lane & 7;
#pragma unroll
    for (int j = 0; j < 4; ++j) { const int n = (lane >> 3) + 8 * j; const LAS float* s = scr + (8 * c) * 33 + n;
        u32x4 o; o.x = pk2(s[0 * 33], s[1 * 33]); o.y = pk2(s[2 * 33], s[3 * 33]); o.z = pk2(s[4 * 33], s[5 * 33]); o.w = pk2(s[6 * 33], s[7 * 33]);
        *(u32x4*)(WT + (size_t)(drow0 + n) * K + k0 + 8 * c) = o; }
    LDS_WAIT(); asm volatile("" ::: "memory");
}
__device__ __forceinline__ int il_row(int j, int half) { return (j / IL) * (2 * IL) + half * IL + (j % IL); }

__device__ __forceinline__ void phase_prep(Frame& F) {
    {
        LAS float* sc = (LAS float*)F.lds;
        LAS float* red = sc + 5 * 1024;
        bool loaded = false;
        for (int it = F.wg; it < 192; it += F.G) {
            if (!loaded) {
                for (int i = F.tid; i < 5 * 1024; i += NTHR) { const int b = i >> 10, k = i & 1023; const float v = b < 4 ? F.in[I_C][b * 1024 + k] : F.in[I_CCTX][k]; sc[i] = silu_f(v); }
                __syncthreads(); loaded = true;
            }
            const int l = it / 96, n0 = (it % 96) * 64, col = F.tid & 63, kg = F.tid >> 6;
            const float* w = F.in[I_ADAW] + (size_t)l * 1024 * 6144 + n0 + col;
            float a0 = 0.f, a1 = 0.f, a2 = 0.f, a3 = 0.f, a4 = 0.f;
#pragma unroll 8
            for (int k = kg * 128; k < kg * 128 + 128; ++k) { const float wv = w[(size_t)k * 6144];
                a0 += sc[k] * wv; a1 += sc[1024 + k] * wv; a2 += sc[2048 + k] * wv; a3 += sc[3072 + k] * wv; a4 += sc[4096 + k] * wv; }
            red[(kg * 5 + 0) * 64 + col] = a0; red[(kg * 5 + 1) * 64 + col] = a1; red[(kg * 5 + 2) * 64 + col] = a2; red[(kg * 5 + 3) * 64 + col] = a3; red[(kg * 5 + 4) * 64 + col] = a4;
            __syncthreads();
            if (F.tid < 320) { const int b = F.tid >> 6, c2 = F.tid & 63; float s = 0.f;
#pragma unroll
                for (int g = 0; g < 8; ++g) s += red[(g * 5 + b) * 64 + c2];
                ((float*)(F.ws + WS_MOD))[((size_t)l * 5 + b) * 6144 + n0 + c2] = s + F.in[I_ADAB][l * 6144 + n0 + c2]; }
            __syncthreads();
        }
        __syncthreads();
    }
    { u32x4* z = (u32x4*)(F.ws + WS_SLOTT); const u32x4 zero = {0u, 0u, 0u, 0u};
      for (int i = F.wg * NTHR + F.tid; i < 2 * 16 * CAP / 4; i += F.G * NTHR) z[i] = zero; }
    { float* tw = (float*)(F.ws + WS_TW);
      for (int k = F.wg * NTHR + F.tid; k < 8192; k += F.G * NTHR) { const float a = (float)k * (6.283185307179586f / 8192.f); tw[2 * k] = __cosf(a); tw[2 * k + 1] = __sinf(a); } }
    {
        LAS float* scr = (LAS float*)(F.lds + F.wave * 8704);
        const int gw = F.wg * NWAVES + F.wave, NGW = F.G * NWAVES;
        constexpr int S0 = 640, S1 = 512, S2 = 1024, S3 = 512, SM = 32 * 256;
        constexpr int NIT = S0 + S1 + S2 + S3 + 3 * SM;
        for (int it = gw; it < NIT; it += NGW) {
            int r = it;
            if (r < S0) { const int kb = r / 40, nb = r % 40; p0_transpose_item(F.in[I_WIN], 1024, 1280, (bf16*)(F.ws + WS_WIN), kb * 64, nb * 32, nb * 32, scr, F.lane); continue; } r -= S0;
            if (r < S1) { const int kb = r / 32, nb = r % 32; p0_transpose_item(F.in[I_WOUT], 1024, 1024, (bf16*)(F.ws + WS_WOUT), kb * 64, nb * 32, nb * 32, scr, F.lane); continue; } r -= S1;
            if (r < S2) { const int kb = r / 64, nb = r % 64, n0 = nb * 32; p0_transpose_item(F.in[I_PW1W], 1024, 2048, (bf16*)(F.ws + WS_WPW1), kb * 64, n0, il_row(n0 & 1023, n0 >> 10), scr, F.lane); continue; } r -= S2;
            if (r < S3) { const int kb = r / 32, nb = r % 32; p0_transpose_item(F.in[I_PW2W], 1024, 1024, (bf16*)(F.ws + WS_WPW2), kb * 64, nb * 32, nb * 32, scr, F.lane); continue; } r -= S3;
            if (r < SM) { const int le = r >> 8, q = r & 255, kb = q / 16, nb = q % 16;
                p0_transpose_item(F.in[I_WG] + (size_t)le * 1024 * 512, 1024, 512, (bf16*)(F.ws + WS_WGU) + (size_t)le * 1024 * 1024, kb * 64, nb * 32, il_row(nb * 32, 0), scr, F.lane); continue; } r -= SM;
            if (r < SM) { const int le = r >> 8, q = r & 255, kb = q / 16, nb = q % 16;
                p0_transpose_item(F.in[I_WU] + (size_t)le * 1024 * 512, 1024, 512, (bf16*)(F.ws + WS_WGU) + (size_t)le * 1024 * 1024, kb * 64, nb * 32, il_row(nb * 32, 1), scr, F.lane); continue; } r -= SM;
            { const int le = r >> 8, q = r & 255, kb = q / 32, nb = q % 32;
                p0_transpose_item(F.in[I_WD] + (size_t)le * 512 * 1024, 512, 1024, (bf16*)(F.ws + WS_WDN) + (size_t)le * 1024 * 512, kb * 64, nb * 32, nb * 32, scr, F.lane); }
        }
    }
}

__device__ __forceinline__ void row_load(const float* p, int lane, f32x4 (&v)[4]) {
#pragma unroll
    for (int j = 0; j < 4; ++j) v[j] = *(const f32x4*)(p + 4 * lane + 256 * j);
}
__device__ __forceinline__ float row_sumsq(const f32x4 (&v)[4]) {
    float s = 0.f;
#pragma unroll
    for (int j = 0; j < 4; ++j) s += (v[j].x * v[j].x + v[j].y * v[j].y) + (v[j].z * v[j].z + v[j].w * v[j].w);
    return wave_sum(s);
}
__device__ __forceinline__ void row_modulate(f32x4 (&v)[4], float rstd, const float* g, const float* sh, const float* sc, int lane) {
#pragma unroll
    for (int j = 0; j < 4; ++j) { const int o = 4 * lane + 256 * j; const f32x4 gg = *(const f32x4*)(g + o), s1 = *(const f32x4*)(sc + o), s0 = *(const f32x4*)(sh + o);
        v[j] = v[j] * rstd * gg * (1.f + s1) + s0; }
}
__device__ __forceinline__ void row_store_bf16(bf16* dst, const f32x4 (&v)[4], int lane) {
#pragma unroll
    for (int j = 0; j < 4; ++j) { u32x2 w; w.x = pk2(v[j].x, v[j].y); w.y = pk2(v[j].z, v[j].w); *(u32x2*)(dst + 4 * lane + 256 * j) = w; }
}

__device__ __forceinline__ void phase_norm1_l0(Frame& F) {
    const int gw = F.wg * NWAVES + F.wave, NGW = F.G * NWAVES;
    const float* mod = (const float*)(F.ws + WS_MOD);
    bf16* HB = (bf16*)(F.ws + WS_HB);
    for (int row = gw; row < T + TC; row += NGW) {
        const float* src = row < T ? F.in[I_X] + (size_t)row * D : F.in[I_CTX] + (size_t)(row - T) * D;
        const int b = row < T ? (row >> 13) : 4;
        f32x4 v[4]; row_load(src, F.lane, v);
        const float rstd = rsqrtf(row_sumsq(v) * (1.f / D) + EPS);
        const float* m = mod + (size_t)b * 6144;
        row_modulate(v, rstd, F.in[I_NMG], m, m + 1024, F.lane);
        row_store_bf16(HB + (size_t)row * D, v, F.lane);
    }
}

struct RowLin { const bf16* base; size_t pitch; __device__ __forceinline__ const bf16* operator()(int m) const { return base + (size_t)m * pitch; } };

__device__ __forceinline__ void inproj_block(Frame& F, int mb, int nbk, const f32x16& c, int lane) {
    const int h = lane >> 5, cl = lane & 31;
    bf16* dst; int pitch, cbase; bool rope = false; bool isctx = (mb >= T);
    if (nbk < 512) { dst = (bf16*)(F.ws + WS_UF); pitch = 512; cbase = 0; }
    else if (nbk < 1024) { dst = (bf16*)(F.ws + WS_Q); pitch = 512; cbase = 512; rope = true; }
    else if (nbk < 1152) { dst = isctx ? (bf16*)(F.ws + WS_CK) : (bf16*)(F.ws + WS_K); pitch = 128; cbase = 1024; rope = !isctx; }
    else { dst = isctx ? (bf16*)(F.ws + WS_CV) : (bf16*)(F.ws + WS_V); pitch = 128; cbase = 1152; }
    const int rbase = isctx ? mb - T : mb;
    const int col = nbk - cbase + cl;
    const float inv = exp2f(-(float)(cl & 15) * (13.287712379549449f / 16.f));
    const bool second = (cl & 16) != 0; const bool bycol = ((nbk >> 5) & 1) != 0;
#pragma unroll
    for (int i = 0; i < 16; ++i) {
        const int rr = crow(i, h); float v = c[i];
        if (rope) {
            const float partner = __shfl_xor(v, 16);
            const int l = (mb + rr) & (L - 1);
            const float pos = (float)(bycol ? (l & 63) : (l >> 6));
            const float ang = pos * inv, cs = __cosf(ang), sn = __sinf(ang);
            v = second ? (partner * sn + v * cs) : (v * cs - partner * sn);
        }
        dst[(size_t)(rbase + rr) * pitch + col] = (bf16)f2bf(v);
    }
}
__device__ __forceinline__ void phase_inproj(Frame& F) {
    const bf16* HB = (const bf16*)(F.ws + WS_HB); const bf16* Wt = (const bf16*)(F.ws + WS_WIN);
    constexpr int MT = (T + TC) / 128, NT = N_IN / 128;
    RowLin rp{HB, (size_t)D};
    for (int u = F.wg; u < MT * NT; u += F.G) {
        const int mt = u / NT, nt = u % NT;
        if (mt >= T / 128 && nt < 8) continue;
        auto epi = [&](int mb, int nb, const f32x16& c0, const f32x16& c1, int lane) { inproj_block(F, mb, nb, c0, lane); inproj_block(F, mb, nb + 32, c1, lane); };
        sgemm_tile(rp, Wt, D, mt * 128, nt * 128, epi, F.wave, F.lane);
    }
}

__device__ __forceinline__ void attn_key(const bf16* kp, const bf16* vp, const float (&q)[64], float& m, float& s, float (&o)[64]) {
    float dot = 0.f;
#pragma unroll
    for (int j = 0; j < 8; ++j) { const u32x4 w = *(const u32x4*)(kp + 8 * j);
        dot += q[8 * j + 0] * bflo(w.x) + q[8 * j + 1] * bfhi(w.x) + q[8 * j + 2] * bflo(w.y) + q[8 * j + 3] * bfhi(w.y)
             + q[8 * j + 4] * bflo(w.z) + q[8 * j + 5] * bfhi(w.z) + q[8 * j + 6] * bflo(w.w) + q[8 * j + 7] * bfhi(w.w); }
    const float mn = fmaxf(m, dot), alpha = __expf(m - mn), p = __expf(dot - mn);
    s = s * alpha + p; m = mn;
#pragma unroll
    for (int j = 0; j < 8; ++j) { const u32x4 w = *(const u32x4*)(vp + 8 * j);
        o[8 * j + 0] = o[8 * j + 0] * alpha + p * bflo(w.x); o[8 * j + 1] = o[8 * j + 1] * alpha + p * bfhi(w.x);
        o[8 * j + 2] = o[8 * j + 2] * alpha + p * bflo(w.y); o[8 * j + 3] = o[8 * j + 3] * alpha + p * bfhi(w.y);
        o[8 * j + 4] = o[8 * j + 4] * alpha + p * bflo(w.z); o[8 * j + 5] = o[8 * j + 5] * alpha + p * bfhi(w.z);
        o[8 * j + 6] = o[8 * j + 6] * alpha + p * bflo(w.w); o[8 * j + 7] = o[8 * j + 7] * alpha + p * bfhi(w.w); }
}
__device__ __forceinline__ void phase_attn_simple(Frame& F) {
    const bf16* Q = (const bf16*)(F.ws + WS_Q); const bf16* Kb = (const bf16*)(F.ws + WS_K); const bf16* Vb = (const bf16*)(F.ws + WS_V);
    const bf16* CK = (const bf16*)(F.ws + WS_CK); const bf16* CV = (const bf16*)(F.ws + WS_CV); bf16* MIX = (bf16*)(F.ws + WS_MIX);
    for (int idx = F.wg * NTHR + F.tid; idx < T * 8; idx += F.G * NTHR) {
        const int hd = idx / T, t = idx % T, b = t >> 13, l = t & (L - 1), kvh = hd >> 2;
        float q[64], o[64];
#pragma unroll
        for (int j = 0; j < 8; ++j) { const u32x4 w = *(const u32x4*)(Q + (size_t)t * 512 + hd * 64 + 8 * j);
            q[8 * j + 0] = bflo(w.x) * 0.125f; q[8 * j + 1] = bfhi(w.x) * 0.125f; q[8 * j + 2] = bflo(w.y) * 0.125f; q[8 * j + 3] = bfhi(w.y) * 0.125f;
            q[8 * j + 4] = bflo(w.z) * 0.125f; q[8 * j + 5] = bfhi(w.z) * 0.125f; q[8 * j + 6] = bflo(w.w) * 0.125f; q[8 * j + 7] = bfhi(w.w) * 0.125f; }
#pragma unroll
        for (int j = 0; j < 64; ++j) o[j] = 0.f;
        float m = F.in[I_SINK][hd], s = 1.f;
        for (int c = 0; c < CL; ++c) { const size_t r = (size_t)(b * CL + c) * 128 + kvh * 64; attn_key(CK + r, CV + r, q, m, s, o); }
        const int lo = l - 128 < 0 ? 0 : l - 128, hi = l + 128 > L - 1 ? L - 1 : l + 128;
        for (int kp = lo; kp <= hi; ++kp) { const size_t r = (size_t)(b * L + kp) * 128 + kvh * 64; attn_key(Kb + r, Vb + r, q, m, s, o); }
        const float is = 1.f / s;
#pragma unroll
        for (int j = 0; j < 8; ++j) { u32x4 w; w.x = pk2(o[8 * j] * is, o[8 * j + 1] * is); w.y = pk2(o[8 * j + 2] * is, o[8 * j + 3] * is); w.z = pk2(o[8 * j + 4] * is, o[8 * j + 5] * is); w.w = pk2(o[8 * j + 6] * is, o[8 * j + 7] * is);
            *(u32x4*)(MIX + (size_t)t * 1024 + 512 + hd * 64 + 8 * j) = w; }
    }
}

__device__ __forceinline__ void phase_fft1_simple(Frame& F) {
    const bf16* UF = (const bf16*)(F.ws + WS_UF); bf16* Gb = (bf16*)(F.ws + WS_G); const float* tw = (const float*)(F.ws + WS_TW);
    for (int idx = F.wg * NTHR + F.tid; idx < NB * FN1 * FN2 * 512; idx += F.G * NTHR) {
        const int ch = idx & 511, bp = (idx >> 9) & 127, c = (idx >> 16) & 63, b = idx >> 22;
        float re = 0.f, im = 0.f;
        for (int a = 0; a < FN1; ++a) { const float u = bf2f(UF[(size_t)(b * L + 128 * a + bp) * 512 + ch]); const int k = ((a * c) & 63) * 128;
            re += u * tw[2 * k]; im -= u * tw[2 * k + 1]; }
        const int k2 = bp * c; const float cs = tw[2 * k2], sn = tw[2 * k2 + 1];
        const float gr = re * cs + im * sn, gi = im * cs - re * sn;
        const size_t row = (size_t)(b * FN1 + c) * FN2 + bp;
        Gb[row * 1024 + ch] = (bf16)f2bf(gr); Gb[row * 1024 + 512 + ch] = (bf16)f2bf(gi);
    }
}
__device__ __forceinline__ void phase_fft2_simple(Frame& F) {
    const bf16* Gb = (const bf16*)(F.ws + WS_G); bf16* AB = (bf16*)(F.ws + WS_AB); const float* tw = (const float*)(F.ws + WS_TW);
    for (int idx = F.wg * NTHR + F.tid; idx < NB * FN1 * FN2 * 512; idx += F.G * NTHR) {
        const int ch = idx & 511, d = (idx >> 9) & 127, c = (idx >> 16) & 63, b = idx >> 22;
        float fr = 0.f, fi = 0.f;
        for (int bp = 0; bp < FN2; ++bp) { const size_t row = (size_t)(b * FN1 + c) * FN2 + bp; const float gr = bf2f(Gb[row * 1024 + ch]), gi = bf2f(Gb[row * 1024 + 512 + ch]);
            const int k = ((bp * d) & 127) * 64; const float cs = tw[2 * k], sn = tw[2 * k + 1];
            fr += gr * cs + gi * sn; fi += gi * cs - gr * sn; }
        const size_t t = (size_t)b * L + c + 64 * d;
        AB[t * 1024 + ch] = (bf16)f2bf(fr); AB[t * 1024 + 512 + ch] = (bf16)f2bf(-fi);
    }
}
__device__ __forceinline__ void phase_fft3_simple(Frame& F) {
    const bf16* AB = (const bf16*)(F.ws + WS_AB); bf16* MIX = (bf16*)(F.ws + WS_MIX); const float* tw = (const float*)(F.ws + WS_TW);
    LAS float* t128 = (LAS float*)F.lds;
    for (int i = F.tid; i < 128; i += NTHR) { t128[2 * i] = tw[2 * (i * 64)]; t128[2 * i + 1] = tw[2 * (i * 64) + 1]; }
    __syncthreads();
    for (int idx = F.wg * NTHR + F.tid; idx < T * 512; idx += F.G * NTHR) {
        const int cp = idx & 127, g = (idx >> 7) & 3, t = idx >> 9;
        const bf16* arow = AB + (size_t)t * 1024 + g * 128;
        float y = 0.f;
        for (int cc = 0; cc < 128; ++cc) { const int k = (cc * cp) & 127; y += bf2f(arow[cc]) * t128[2 * k] - bf2f(arow[512 + cc]) * t128[2 * k + 1]; }
        MIX[(size_t)t * 1024 + g * 128 + cp] = (bf16)f2bf(y * (1.f / 1024.f));
    }
    __syncthreads();
}

__device__ __forceinline__ void phase_outproj(Frame& F, const bf16* A, const bf16* Wt, const float* base, float* X, const float* gate  , const float* bias) {
    RowLin rp{A, (size_t)D};
    for (int u = F.wg; u < (T / 128) * 8; u += F.G) {
        const int mt = u / 8, nt = u % 8;
        auto epi = [&](int mb, int nb, const f32x16& c0, const f32x16& c1, int lane) {
            const int h = lane >> 5, cl = lane & 31, b = mb >> 13;
#pragma unroll
            for (int half = 0; half < 2; ++half) { const int col = nb + 32 * half + cl; const float gv = gate[(size_t)b * 6144 + col], bv = bias ? bias[col] : 0.f;
#pragma unroll
                for (int i = 0; i < 16; ++i) { const size_t o = (size_t)(mb + crow(i, h)) * D + col; const float a = half ? c1[i] : c0[i]; X[o] = base[o] + gv * (a + bv); } }
        };
        sgemm_tile(rp, Wt, D, mt * 128, nt * 128, epi, F.wave, F.lane);
    }
}

__device__ __forceinline__ void phase_norm2_route(Frame& F, int layer) {
    const float* mod = (const float*)(F.ws + WS_MOD) + (size_t)layer * 5 * 6144;
    const float* X = F.out; bf16* HB = (bf16*)(F.ws + WS_HB);
    const float* rw = F.in[I_RW]; const float* rb = F.in[I_RB];
    int* tok_e = (int*)(F.ws + WS_TOKE); int* tok_p = (int*)(F.ws + WS_TOKP); float* tok_w = (float*)(F.ws + WS_TOKW);
    int* slot_t = (int*)(F.ws + WS_SLOTT) + layer * 16 * CAP;
    float* slot_w = (float*)(F.ws + WS_SLOTW) + layer * 16 * CAP;
    unsigned* cnt = F.ctl + CW_CNT + layer * 16 * 64;
    LAS int* sel_e = (LAS int*)F.lds;
    LAS float* sel_w = (LAS float*)(F.lds + 1024);
    for (int rb0 = F.wg; rb0 < T / 128; rb0 += F.G) {
        for (int j = 0; j < 16; ++j) {
            const int lr = F.wave * 16 + j, row = rb0 * 128 + lr, b = row >> 13;
            f32x4 v[4]; row_load(X + (size_t)row * D, F.lane, v);
            const float rstd = rsqrtf(row_sumsq(v) * (1.f / D) + EPS);
            const float* m = mod + (size_t)b * 6144;
            row_modulate(v, rstd, F.in[I_NFG] + layer * D, m + 3072, m + 4096, F.lane);
            row_store_bf16(HB + (size_t)row * D, v, F.lane);
            float lg[16];
#pragma unroll
            for (int e = 0; e < 16; ++e) lg[e] = 0.f;
#pragma unroll
            for (int jj = 0; jj < 4; ++jj)
#pragma unroll
                for (int q = 0; q < 4; ++q) { const float* wr = rw + (size_t)(4 * F.lane + 256 * jj + q) * 16; const float fv = v[jj][q];
#pragma unroll
                    for (int e4 = 0; e4 < 4; ++e4) { const f32x4 w4 = *(const f32x4*)(wr + 4 * e4); lg[4 * e4] += fv * w4.x; lg[4 * e4 + 1] += fv * w4.y; lg[4 * e4 + 2] += fv * w4.z; lg[4 * e4 + 3] += fv * w4.w; } }
#pragma unroll
            for (int e = 0; e < 16; ++e) lg[e] = wave_sum(lg[e]);
            float best = -1e30f; int be1 = 0, be2 = 0; float bs1 = 0.f, bs2 = 0.f;
#pragma unroll
            for (int g = 0; g < 4; ++g) {
                float v1 = -1e30f, v2 = -1e30f, s1 = 0.f, s2 = 0.f; int j1 = 0, j2 = 0;
#pragma unroll
                for (int q = 0; q < 4; ++q) { const float sc = sigmoid_f(lg[4 * g + q]), x = sc + rb[4 * g + q];
                    if (x > v1) { v2 = v1; j2 = j1; s2 = s1; v1 = x; j1 = q; s1 = sc; } else if (x > v2) { v2 = x; j2 = q; s2 = sc; } }
                const float gs = v1 + v2;
                if (gs > best) { best = gs; be1 = 4 * g + j1; be2 = 4 * g + j2; bs1 = s1; bs2 = s2; }
            }
            if (F.lane == 0) { const float inv = 1.f / (bs1 + bs2); sel_e[2 * lr] = be1; sel_e[2 * lr + 1] = be2; sel_w[2 * lr] = bs1 * inv; sel_w[2 * lr + 1] = bs2 * inv; }
        }
        __syncthreads();
        if (F.tid < 16) {
            const int e = F.tid; int n = 0;
            for (int i = 0; i < 256; ++i) n += (sel_e[i] == e) ? 1 : 0;
            int pos = n ? (int)atomicAdd(cnt + e * 64, (unsigned)n) : 0;
            for (int i = 0; i < 256; ++i) if (sel_e[i] == e) { const int tok = rb0 * 128 + (i >> 1);
                slot_t[e * CAP + pos] = tok; slot_w[e * CAP + pos] = sel_w[i]; tok_e[2 * tok + (i & 1)] = e; tok_p[2 * tok + (i & 1)] = pos; tok_w[2 * tok + (i & 1)] = sel_w[i]; ++pos; }
        }
        __syncthreads();
    }
}

constexpr int MOEMAP_OFF = LDS_BYTES - 256;
__device__ __forceinline__ LAS int* moe_map(Frame& F, int layer) {
    LAS int* mm = (LAS int*)(F.lds + MOEMAP_OFF);
    __syncthreads();
    if (F.tid == 0) { const unsigned* cnt = F.ctl + CW_CNT + layer * 16 * 64; int acc = 0;
        for (int e = 0; e < 16; ++e) { const int n = (int)__hip_atomic_load(cnt + e * 64, __ATOMIC_RELAXED, __HIP_MEMORY_SCOPE_AGENT); mm[e] = n; mm[16 + e] = acc; acc += (n + 255) & ~255; } }
    __syncthreads();
    return mm;
}
struct RowGather { const bf16* base; const int* list; int n; __device__ __forceinline__ const bf16* operator()(int m) const { const int tok = m < n ? list[m] : 0; return base + (size_t)tok * D; } };

__device__ __forceinline__ void phase_moe_gateup(Frame& F, int layer) {
    LAS int* mm = moe_map(F, layer);
    const bf16* HB = (const bf16*)(F.ws + WS_HB); bf16* HID = (bf16*)(F.ws + WS_HID);
    const int* slot_t = (const int*)(F.ws + WS_SLOTT) + layer * 16 * CAP; const float* slot_w = (const float*)(F.ws + WS_SLOTW) + layer * 16 * CAP;
    int ubase = 0;
#pragma unroll 1
    for (int e = 0; e < 16; ++e) {
        const int n = mm[e], hbe = mm[16 + e], rt = (n + 127) >> 7, nu = rt * 8;
        const bf16* Wt = (const bf16*)(F.ws + WS_WGU) + (size_t)(layer * 16 + e) * 1024 * 1024;
        RowGather rp{HB, slot_t + e * CAP, n};
        int first = (F.wg - ubase % F.G + F.G) % F.G;
        for (int u = first; u < nu; u += F.G) {
            const int mt = u / 8, nt = u % 8;
            auto epi = [&](int mb, int nb, const f32x16& c0, const f32x16& c1, int lane) {
                const int h = lane >> 5, cl = lane & 31; const int col = (nb >> 1) + cl;
#pragma unroll
                for (int i = 0; i < 16; ++i) { const int r = mb + crow(i, h);
                    if (r < n) { const float w = slot_w[e * CAP + r]; HID[(size_t)(hbe + r) * FF + col] = (bf16)f2bf(w * silu_f(c0[i]) * c1[i]); } }
            };
            sgemm_tile(rp, Wt, D, mt * 128, nt * 128, epi, F.wave, F.lane);
        }
        ubase += nu;
    }
}
__device__ __forceinline__ void phase_moe_down(Frame& F, int layer) {
    LAS int* mm = moe_map(F, layer);
    const bf16* HID = (const bf16*)(F.ws + WS_HID); bf16* Y = (bf16*)(F.ws + WS_Y);
    int ubase = 0;
#pragma unroll 1
    for (int e = 0; e < 16; ++e) {
        const int n = mm[e], hbe = mm[16 + e], rt = (n + 127) >> 7, nu = rt * 8;
        const bf16* Wt = (const bf16*)(F.ws + WS_WDN) + (size_t)(layer * 16 + e) * 1024 * 512;
        RowLin rp{HID + (size_t)hbe * FF, (size_t)FF};
        int first = (F.wg - ubase % F.G + F.G) % F.G;
        for (int u = first; u < nu; u += F.G) {
            const int mt = u / 8, nt = u % 8;
            auto epi = [&](int mb, int nb, const f32x16& c0, const f32x16& c1, int lane) {
                const int h = lane >> 5, cl = lane & 31;
#pragma unroll
                for (int i = 0; i < 16; ++i) { const int r = mb + crow(i, h);
                    if (r < n) { bf16* yr = Y + (size_t)(hbe + r) * D + nb + cl; yr[0] = (bf16)f2bf(c0[i]); yr[32] = (bf16)f2bf(c1[i]); } }
            };
            sgemm_tile(rp, Wt, FF, mt * 128, nt * 128, epi, F.wave, F.lane);
        }
        ubase += nu;
    }
}

template <bool FINAL>
__device__ __forceinline__ void phase_combine(Frame& F, int layer) {
    LAS int* hbs = moe_map(F, layer) + 16;
    const int gw = F.wg * NWAVES + F.wave, NGW = F.G * NWAVES;
    const float* mod = (const float*)(F.ws + WS_MOD);
    const int* tok_e = (const int*)(F.ws + WS_TOKE); const int* tok_p = (const int*)(F.ws + WS_TOKP);
    const bf16* Y = (const bf16*)(F.ws + WS_Y); float* X = F.out; bf16* HB = (bf16*)(F.ws + WS_HB);
    for (int row = gw; row < T; row += NGW) {
        const int b = row >> 13;
        const int s0 = hbs[tok_e[2 * row]] + tok_p[2 * row], s1 = hbs[tok_e[2 * row + 1]] + tok_p[2 * row + 1];
        f32x4 v[4]; row_load(X + (size_t)row * D, F.lane, v);
        const float* g2 = mod + ((size_t)layer * 5 + b) * 6144 + 5120;
#pragma unroll
        for (int j = 0; j < 4; ++j) { const int o = 4 * F.lane + 256 * j;
            const u32x2 y0 = *(const u32x2*)(Y + (size_t)s0 * D + o), y1 = *(const u32x2*)(Y + (size_t)s1 * D + o); const f32x4 gg = *(const f32x4*)(g2 + o);
            v[j].x += gg.x * (bflo(y0.x) + bflo(y1.x)); v[j].y += gg.y * (bfhi(y0.x) + bfhi(y1.x)); v[j].z += gg.z * (bflo(y0.y) + bflo(y1.y)); v[j].w += gg.w * (bfhi(y0.y) + bfhi(y1.y)); }
        const float rstd = rsqrtf(row_sumsq(v) * (1.f / D) + EPS);
        if (FINAL) {
#pragma unroll
            for (int j = 0; j < 4; ++j) { const int o = 4 * F.lane + 256 * j; const f32x4 gg = *(const f32x4*)(F.in[I_FNG] + o); *(f32x4*)(X + (size_t)row * D + o) = v[j] * rstd * gg; }
        } else {
#pragma unroll
            for (int j = 0; j < 4; ++j) *(f32x4*)(X + (size_t)row * D + 4 * F.lane + 256 * j) = v[j];
            const float* m = mod + ((size_t)(layer + 1) * 5 + b) * 6144;
            row_modulate(v, rstd, F.in[I_NMG] + (layer + 1) * D, m, m + 1024, F.lane);
            row_store_bf16(HB + (size_t)row * D, v, F.lane);
        }
    }
    __syncthreads();
}

__device__ __forceinline__ void phase_pw1(Frame& F) {
    const bf16* HB = (const bf16*)(F.ws + WS_HB); const bf16* Wt = (const bf16*)(F.ws + WS_WPW1); bf16* U = (bf16*)(F.ws + WS_U);
    const float* bias = F.in[I_PW1B];
    RowLin rp{HB, (size_t)D};
    for (int u = F.wg; u < (T / 128) * 16; u += F.G) {
        const int mt = u / 16, nt = u % 16;
        auto epi = [&](int mb, int nb, const f32x16& c0, const f32x16& c1, int lane) {
            const int h = lane >> 5, cl = lane & 31, col = (nb >> 1) + cl; const float ba = bias[col], bg = bias[1024 + col];
#pragma unroll
            for (int i = 0; i < 16; ++i) U[(size_t)(mb + crow(i, h)) * D + col] = (bf16)f2bf((c0[i] + ba) * sigmoid_f(c1[i] + bg));
        };
        sgemm_tile(rp, Wt, D, mt * 128, nt * 128, epi, F.wave, F.lane);
    }
}
__device__ __forceinline__ void phase_dwconv(Frame& F) {
    const bf16* U = (const bf16*)(F.ws + WS_U); bf16* V1 = (bf16*)(F.ws + WS_V1);
    const float* dww = F.in[I_DWW]; const float* dwb = F.in[I_DWB]; const float* lng = F.in[I_LNG]; const float* lnb = F.in[I_LNB];
    const int gw = F.wg * NWAVES + F.wave, NGW = F.G * NWAVES;
    for (int row = gw; row < T; row += NGW) {
        const int l = row & (L - 1);
        f32x4 acc[4];
#pragma unroll
        for (int j = 0; j < 4; ++j) acc[j] = *(const f32x4*)(dwb + 4 * F.lane + 256 * j);
        for (int tp = 0; tp < CONVW; ++tp) { const int ll = l + tp - 15; if (ll < 0 || ll >= L) continue;
            const bf16* ur = U + (size_t)(row + tp - 15) * D; const float* wr = dww + (size_t)tp * D;
#pragma unroll
            for (int j = 0; j < 4; ++j) { const int o = 4 * F.lane + 256 * j; const u32x2 uu = *(const u32x2*)(ur + o); const f32x4 ww = *(const f32x4*)(wr + o);
                acc[j].x += bflo(uu.x) * ww.x; acc[j].y += bfhi(uu.x) * ww.y; acc[j].z += bflo(uu.y) * ww.z; acc[j].w += bfhi(uu.y) * ww.w; } }
        float s = 0.f;
#pragma unroll
        for (int j = 0; j < 4; ++j) s += (acc[j].x + acc[j].y) + (acc[j].z + acc[j].w);
        const float mean = wave_sum(s) * (1.f / D); float q = 0.f;
#pragma unroll
        for (int j = 0; j < 4; ++j) { acc[j] = acc[j] - mean; q += (acc[j].x * acc[j].x + acc[j].y * acc[j].y) + (acc[j].z * acc[j].z + acc[j].w * acc[j].w); }
        const float rstd = rsqrtf(wave_sum(q) * (1.f / D) + EPS);
#pragma unroll
        for (int j = 0; j < 4; ++j) { const int o = 4 * F.lane + 256 * j; const f32x4 gg = *(const f32x4*)(lng + o), bb = *(const f32x4*)(lnb + o);
            f32x4 y = acc[j] * rstd * gg + bb; y.x = silu_f(y.x); y.y = silu_f(y.y); y.z = silu_f(y.z); y.w = silu_f(y.w); acc[j] = y; }
        row_store_bf16(V1 + (size_t)row * D, acc, F.lane);
    }
}


namespace pg {
constexpr int BM = 256, BK = 64, HALF = 128, HTB = HALF * BK * 2, STAGE_BYTES = 8 * HTB;
constexpr int TAB_OFF = STAGE_BYTES;
__device__ __forceinline__ int lds_byte(int r, int c) { const int st = (r >> 4) * 2 + (c >> 5), rr = r & 15, cc = c & 31, ob = rr * 64 + cc * 2; return st * 1024 + (ob ^ (((ob >> 9) & 1) << 5)); }
__device__ __forceinline__ void stage_rc(int b, int& R, int& C) { const int st = b / 1024, sb = b % 1024, swz = sb ^ (((sb >> 9) & 1) << 5); R = (st >> 1) * 16 + swz / 64; C = (st & 1) * 32 + (swz % 64) / 2; }
__device__ __forceinline__ int perm32(int rho) { const int n = rho >> 4, i = rho & 15; return 8 * (i >> 2) + 4 * n + (i & 3); }
__device__ __forceinline__ unsigned cvt_pk_bf16(float lo, float hi) { unsigned r; asm volatile("v_cvt_pk_bf16_f32 %0, %1, %2" : "=v"(r) : "v"(lo), "v"(hi)); return r; }

struct GU { const char* B; int p0, p1, p2, p3; };

template <class Epi, class Sched>
__device__ __forceinline__ void gemm_phase(LAS unsigned char* lds, const char* Abase, const int K, const Sched& S, const Epi& E) {
    const int tid = threadIdx.x, wid = __builtin_amdgcn_readfirstlane(tid >> 6), lane = tid & 63, wr = wid >> 2, wc = wid & 3, fr = lane & 15, fq = lane >> 4;
    const int nt = K / BK;
    int sR[2], sC[2]; unsigned voffB[2];
#pragma unroll
    for (int i = 0; i < 2; ++i) { int R, C; stage_rc(tid * 16 + i * 8192, R, C); sR[i] = R; sC[i] = C; const int Rb = Epi::PERM ? ((R & ~31) + perm32(R & 31)) : R; voffB[i] = (unsigned)(Rb * K + C) * 2u; }
    const size_t kstep = (size_t)(BK * 2);
    const size_t hstep = (size_t)HALF * K * 2;
    const unsigned ldsw = (unsigned)wid * 1024u;
    const int aoff = lds_byte(wr * 64 + fr, fq * 8), boff = lds_byte(wc * 32 + fr, fq * 8);
#define PG_SA(b, h) (((b) * 2 + (h)) * HTB)
#define PG_SB(b, h) ((4 + (b) * 2 + (h)) * HTB)
#define PG_STAGE(bufoff, gbase, voff) do { _Pragma("unroll") for (int _i = 0; _i < 2; ++_i) \
        __builtin_amdgcn_global_load_lds((const unsigned*)((const char*)(gbase) + (voff)[_i]), (LAS unsigned*)(lds + (bufoff) + ldsw + _i * 8192), 16, 0, 0); } while (0)
#define PG_LDA(dst, b, h) do { _Pragma("unroll") for (int m = 0; m < 4; ++m) _Pragma("unroll") for (int k = 0; k < 2; ++k) dst[m][k] = *(const LAS bf16x8*)(lds + PG_SA(b, h) + aoff + m * 2048 + k * 1024); } while (0)
#define PG_LDB(dst, b, h) do { _Pragma("unroll") for (int n = 0; n < 2; ++n) _Pragma("unroll") for (int k = 0; k < 2; ++k) dst[n][k] = *(const LAS bf16x8*)(lds + PG_SB(b, h) + boff + n * 2048 + k * 1024); } while (0)
#define PG_MMA(ai, bj, At, Bt) do { __builtin_amdgcn_s_setprio(1); _Pragma("unroll") for (int m = 0; m < 4; ++m) _Pragma("unroll") for (int n = 0; n < 2; ++n) _Pragma("unroll") for (int k = 0; k < 2; ++k) \
        acc[ai][bj][m][n] = __builtin_amdgcn_mfma_f32_16x16x32_bf16(Bt[n][k], At[m][k], acc[ai][bj][m][n], 0, 0, 0); __builtin_amdgcn_s_setprio(0); } while (0)
#define PG_WAIT_V(n) asm volatile("s_waitcnt vmcnt(" #n ")" ::: "memory")
#define PG_WAIT_L(n) asm volatile("s_waitcnt lgkmcnt(" #n ")" ::: "memory")
#define PG_BAR __builtin_amdgcn_s_barrier()
#define PG_SCHED __builtin_amdgcn_sched_barrier(0)
    GU cur, nxt; int ui = 0;
    if (!S.next(0, cur)) return;
    f32x4 acc[2][2][4][2];
#pragma unroll
    for (int a = 0; a < 2; ++a)
#pragma unroll
        for (int b = 0; b < 2; ++b)
#pragma unroll
            for (int m = 0; m < 4; ++m)
#pragma unroll
                for (int n = 0; n < 2; ++n) acc[a][b][m][n] = (f32x4){0.f, 0.f, 0.f, 0.f};
    bf16x8 At[4][2], B0[2][2], B1[2][2];
    if constexpr (Sched::GATHER) { S.stage_table(cur, 0, lds, wid, lane); PG_WAIT_V(0); PG_BAR; }
    unsigned voC[2][2], voN[2][2];
#pragma unroll
    for (int h = 0; h < 2; ++h)
#pragma unroll
        for (int i = 0; i < 2; ++i) { voC[h][i] = S.voff(cur, 0, lds, h * HALF + sR[i], sC[i]); voN[h][i] = voC[h][i]; }
    const char* cB = cur.B;
    PG_STAGE(PG_SB(0, 0), cB, voffB); PG_STAGE(PG_SB(0, 1), cB + hstep, voffB); PG_STAGE(PG_SA(0, 0), Abase, voC[0]); PG_STAGE(PG_SA(0, 1), Abase, voC[1]);
    if (wr == 1) PG_BAR;
    PG_WAIT_V(2); PG_BAR;
    PG_STAGE(PG_SB(1, 0), cB + kstep, voffB); PG_STAGE(PG_SA(1, 0), Abase + kstep, voC[0]); PG_STAGE(PG_SB(1, 1), cB + hstep + kstep, voffB);
    PG_WAIT_V(6); PG_BAR;
    for (;;) {
        const bool has_next = S.next(ui + 1, nxt);
        if constexpr (Sched::GATHER) { if (has_next) S.stage_table(nxt, (ui + 1) & 1, lds, wid, lane); }
        const char* nB = has_next ? nxt.B : cB;
        for (int t = 0; t < nt; t += 2) {
            const bool last = (t == nt - 2);
            if (last && has_next) {
#pragma unroll
                for (int h = 0; h < 2; ++h)
#pragma unroll
                    for (int i = 0; i < 2; ++i) voN[h][i] = S.voff(nxt, (ui + 1) & 1, lds, h * HALF + sR[i], sC[i]);
            }
            unsigned vo2[2][2];
#pragma unroll
            for (int h = 0; h < 2; ++h)
#pragma unroll
                for (int i = 0; i < 2; ++i) vo2[h][i] = last ? voN[h][i] : voC[h][i];
            const char* a1 = Abase + (size_t)(t + 1) * kstep;
            const char* a2 = last ? Abase : Abase + (size_t)(t + 2) * kstep; const char* b2 = last ? nB : cB + (size_t)(t + 2) * kstep;
            const char* a3 = a2 + kstep; const char* b3 = b2 + kstep;
            PG_LDB(B0, 0, 0); PG_LDB(B1, 0, 1); PG_SCHED; PG_LDA(At, 0, 0); PG_STAGE(PG_SA(1, 1), a1, voC[1]);
            PG_WAIT_V(8); PG_WAIT_L(0); PG_BAR; PG_MMA(0, 0, At, B0); PG_MMA(0, 1, At, B1); PG_BAR; PG_SCHED;
            PG_LDA(At, 0, 1); PG_STAGE(PG_SB(0, 0), b2, voffB); PG_STAGE(PG_SB(0, 1), b2 + hstep, voffB); PG_STAGE(PG_SA(0, 0), a2, vo2[0]);
            PG_WAIT_V(8); PG_WAIT_L(0); PG_BAR; PG_MMA(1, 0, At, B0); PG_MMA(1, 1, At, B1); PG_BAR; PG_SCHED;
            PG_LDB(B0, 1, 0); PG_LDB(B1, 1, 1); PG_SCHED; PG_LDA(At, 1, 0); PG_STAGE(PG_SA(0, 1), a2, vo2[1]);
            PG_WAIT_V(8); PG_WAIT_L(0); PG_BAR; PG_MMA(0, 0, At, B0); PG_MMA(0, 1, At, B1); PG_BAR; PG_SCHED;
            PG_LDA(At, 1, 1); PG_STAGE(PG_SB(1, 0), b3, voffB); PG_STAGE(PG_SB(1, 1), b3 + hstep, voffB); PG_STAGE(PG_SA(1, 0), a3, vo2[0]);
            PG_WAIT_V(8); PG_WAIT_L(0); PG_BAR; PG_MMA(1, 0, At, B0); PG_MMA(1, 1, At, B1); PG_BAR; PG_SCHED;
        }
        if (wr == 0) PG_BAR;
        E(acc, cur, wr, wc, fr, fq);
        if (!has_next) break;
#pragma unroll
        for (int a = 0; a < 2; ++a)
#pragma unroll
            for (int b = 0; b < 2; ++b)
#pragma unroll
                for (int m = 0; m < 4; ++m)
#pragma unroll
                    for (int n = 0; n < 2; ++n) acc[a][b][m][n] = (f32x4){0.f, 0.f, 0.f, 0.f};
        cur = nxt; cB = nB; ++ui;
#pragma unroll
        for (int h = 0; h < 2; ++h)
#pragma unroll
            for (int i = 0; i < 2; ++i) voC[h][i] = voN[h][i];
        if (wr == 1) PG_BAR;
    }
    PG_WAIT_V(0);
    PG_BAR;
#undef PG_SA
#undef PG_SB
#undef PG_STAGE
#undef PG_LDA
#undef PG_LDB
#undef PG_MMA
#undef PG_WAIT_V
#undef PG_WAIT_L
#undef PG_BAR
#undef PG_SCHED
}

__device__ __forceinline__ void static_tile(int L, int nM, int nN, int& pm, int& pn) {
    const int nwg = nM * nN; int wgid = L; { const int q = nwg / 8, r = nwg % 8, xcd = wgid % 8, off = wgid / 8; wgid = (xcd < r ? xcd * (q + 1) : r * (q + 1) + (xcd - r) * q) + off; }
    const int nig = 8 * nN, gid = wgid / nig, fm = gid * 8, gsz = (nM - fm) < 8 ? (nM - fm) : 8;
    pm = fm + ((wgid % nig) % gsz); pn = (wgid % nig) / gsz;
}
struct DenseSched {
    static constexpr bool GATHER = false;
    const char* Bt; int K, nM, nN, G, c, xn, xm0, xpn;
    __device__ __forceinline__ bool next(int i, GU& u) const {
        const int L = i * G + c, nmain = nM * nN; int pm, pn;
        if (L < nmain) static_tile(L, nM, nN, pm, pn); else if (L < nmain + xn) { pm = xm0 + (L - nmain); pn = xpn; } else return false;
        u.B = Bt + (size_t)pn * BM * K * 2; u.p0 = pm; u.p1 = pn; u.p2 = 0; u.p3 = 0; return true;
    }
    __device__ __forceinline__ unsigned voff(const GU& u, int, LAS unsigned char*, int R, int C) const { return (unsigned)(((u.p0 * BM + R) * K + C) * 2); }
    __device__ __forceinline__ void stage_table(const GU&, int, LAS unsigned char*, int, int) const {}
};
template <bool GATHER_> struct MoeSched {
    static constexpr bool GATHER = GATHER_;
    const char* Wt; size_t wstride; int K; const int* list; LAS int* mm; int G, c;
    __device__ __forceinline__ bool next(int i, GU& u) const {
        int L = i * G + c;
        for (int e = 0; e < 16; ++e) { const int n = mm[e], nu = ((n + 255) >> 8) * 4;
            if (L < nu) { const int rt = L >> 2, pn = L & 3; u.B = Wt + (size_t)e * wstride + (size_t)pn * BM * K * 2; u.p0 = e; u.p1 = rt; u.p2 = pn; u.p3 = mm[16 + e]; return true; }
            L -= nu; }
        return false;
    }
    __device__ __forceinline__ unsigned voff(const GU& u, int buf, LAS unsigned char* lds, int R, int C) const {
        if constexpr (GATHER_) { const int tok = ((const LAS int*)(lds + TAB_OFF))[buf * 256 + R]; return (unsigned)((tok * K + C) * 2); }
        else return (unsigned)(((u.p3 + u.p1 * BM + R) * K + C) * 2);
    }
    __device__ __forceinline__ void stage_table(const GU& u, int buf, LAS unsigned char* lds, int wid, int lane) const {
        if constexpr (GATHER_) { const int r = (wid & 3) * 64 + lane;
            __builtin_amdgcn_global_load_lds((const unsigned*)(list + u.p0 * CAP + u.p1 * BM + r), (LAS unsigned*)(lds + TAB_OFF + buf * 1024 + (wid & 3) * 256), 4, 0, 0); }
    }
};

struct EpiInProj {
    static constexpr bool PERM = false;
    unsigned char* ws;
    __device__ __forceinline__ void operator()(const f32x4 (&acc)[2][2][4][2], const GU& u, int wr, int wc, int fr, int fq) const {
        const int pm = u.p0, pn = u.p1; const bool isctx = pm >= T / BM;
        float inv[4];
#pragma unroll
        for (int j = 0; j < 4; ++j) inv[j] = exp2f(-(float)(4 * fq + j) * (13.287712379549449f / 16.f));
#pragma unroll
        for (int bj = 0; bj < 2; ++bj) {
            const int cb = pn * BM + bj * HALF + wc * 32;
            bf16* dst; int pitch, cbase; bool rope = false;
            if (cb < 512) { dst = (bf16*)(ws + WS_UF); pitch = 512; cbase = 0; }
            else if (cb < 1024) { dst = (bf16*)(ws + WS_Q); pitch = 512; cbase = 512; rope = true; }
            else if (cb < 1152) { dst = isctx ? (bf16*)(ws + WS_CK) : (bf16*)(ws + WS_K); pitch = 128; cbase = 1024; rope = !isctx; }
            else { dst = isctx ? (bf16*)(ws + WS_CV) : (bf16*)(ws + WS_V); pitch = 128; cbase = 1152; }
            const bool bycol = ((cb >> 5) & 1) != 0;
#pragma unroll
            for (int ai = 0; ai < 2; ++ai)
#pragma unroll
                for (int m = 0; m < 4; ++m) {
                    const int row = pm * BM + ai * HALF + wr * 64 + m * 16 + fr;
                    f32x4 v0 = acc[ai][bj][m][0], v1 = acc[ai][bj][m][1];
                    if (rope) { const int l = row & (L - 1); const float pos = (float)(bycol ? (l & 63) : (l >> 6));
#pragma unroll
                        for (int j = 0; j < 4; ++j) { const float ang = pos * inv[j], cs = __cosf(ang), sn = __sinf(ang); const float x1 = v0[j], x2 = v1[j]; v0[j] = x1 * cs - x2 * sn; v1[j] = x1 * sn + x2 * cs; } }
                    const int orow = isctx ? row - T : row;
                    bf16* o = dst + (size_t)orow * pitch + (cb - cbase) + 4 * fq;
                    u32x2 w0, w1; w0.x = cvt_pk_bf16(v0[0], v0[1]); w0.y = cvt_pk_bf16(v0[2], v0[3]); w1.x = cvt_pk_bf16(v1[0], v1[1]); w1.y = cvt_pk_bf16(v1[2], v1[3]);
                    *(u32x2*)o = w0; *(u32x2*)(o + 16) = w1;
                }
        }
    }
};
struct EpiRes {
    static constexpr bool PERM = false;
    const float* base; float* X; const float* gate; const float* bias;
    __device__ __forceinline__ void operator()(const f32x4 (&acc)[2][2][4][2], const GU& u, int wr, int wc, int fr, int fq) const {
        const int row0 = u.p0 * BM + wr * 64 + fr, col0 = u.p1 * BM + wc * 32 + 4 * fq; const int b = (u.p0 * BM) >> 13;
        f32x4 gv[2][2], bv[2][2];
#pragma unroll
        for (int bj = 0; bj < 2; ++bj)
#pragma unroll
            for (int n = 0; n < 2; ++n) { gv[bj][n] = *(const f32x4*)(gate + (size_t)b * 6144 + col0 + bj * HALF + n * 16); bv[bj][n] = bias ? *(const f32x4*)(bias + col0 + bj * HALF + n * 16) : (f32x4){0.f, 0.f, 0.f, 0.f}; }
#pragma unroll
        for (int ai = 0; ai < 2; ++ai)
#pragma unroll
            for (int m = 0; m < 4; ++m) { const size_t off = (size_t)(row0 + ai * HALF + m * 16) * D + col0;
#pragma unroll
                for (int bj = 0; bj < 2; ++bj)
#pragma unroll
                    for (int n = 0; n < 2; ++n) { const f32x4 bs = *(const f32x4*)(base + off + bj * HALF + n * 16); *(f32x4*)(X + off + bj * HALF + n * 16) = bs + gv[bj][n] * (acc[ai][bj][m][n] + bv[bj][n]); }
                asm volatile("" ::: "memory"); }
    }
};
struct EpiGLU {
    static constexpr bool PERM = true;
    bf16* U; const float* bias;
    __device__ __forceinline__ void operator()(const f32x4 (&acc)[2][2][4][2], const GU& u, int wr, int wc, int fr, int fq) const {
        const int row0 = u.p0 * BM + wr * 64 + fr, col0 = u.p1 * HALF + wc * 32 + 8 * fq;
        f32x4 ba[2], bg[2];
#pragma unroll
        for (int n = 0; n < 2; ++n) { ba[n] = *(const f32x4*)(bias + col0 + 4 * n); bg[n] = *(const f32x4*)(bias + 1024 + col0 + 4 * n); }
#pragma unroll
        for (int ai = 0; ai < 2; ++ai)
#pragma unroll
            for (int m = 0; m < 4; ++m) { f32x4 o[2];
#pragma unroll
                for (int n = 0; n < 2; ++n) { const f32x4 a = acc[ai][0][m][n] + ba[n], g = acc[ai][1][m][n] + bg[n];
#pragma unroll
                    for (int j = 0; j < 4; ++j) o[n][j] = a[j] * sigmoid_f(g[j]); }
                u32x4 w; w.x = cvt_pk_bf16(o[0][0], o[0][1]); w.y = cvt_pk_bf16(o[0][2], o[0][3]); w.z = cvt_pk_bf16(o[1][0], o[1][1]); w.w = cvt_pk_bf16(o[1][2], o[1][3]);
                *(u32x4*)(U + (size_t)(row0 + ai * HALF + m * 16) * D + col0) = w; }
    }
};
struct EpiGateUp {
    static constexpr bool PERM = true;
    bf16* HID; const float* slot_w; LAS int* mm;
    __device__ __forceinline__ void operator()(const f32x4 (&acc)[2][2][4][2], const GU& u, int wr, int wc, int fr, int fq) const {
        const int e = u.p0, n_e = mm[e], r0 = u.p1 * BM + wr * 64 + fr, col0 = u.p2 * HALF + wc * 32 + 8 * fq;
#pragma unroll
        for (int ai = 0; ai < 2; ++ai)
#pragma unroll
            for (int m = 0; m < 4; ++m) { const int r = r0 + ai * HALF + m * 16;
                if (r < n_e) { const float w = slot_w[e * CAP + r]; f32x4 o[2];
#pragma unroll
                    for (int n = 0; n < 2; ++n) { const f32x4 g = acc[ai][0][m][n], up = acc[ai][1][m][n];
#pragma unroll
                        for (int j = 0; j < 4; ++j) o[n][j] = w * silu_f(g[j]) * up[j]; }
                    u32x4 q; q.x = cvt_pk_bf16(o[0][0], o[0][1]); q.y = cvt_pk_bf16(o[0][2], o[0][3]); q.z = cvt_pk_bf16(o[1][0], o[1][1]); q.w = cvt_pk_bf16(o[1][2], o[1][3]);
                    *(u32x4*)(HID + (size_t)(u.p3 + r) * FF + col0) = q; } }
    }
};
struct EpiDown {
    static constexpr bool PERM = true;
    bf16* Y; LAS int* mm;
    __device__ __forceinline__ void operator()(const f32x4 (&acc)[2][2][4][2], const GU& u, int wr, int wc, int fr, int fq) const {
        const int e = u.p0, n_e = mm[e], r0 = u.p1 * BM + wr * 64 + fr, col0 = u.p2 * BM + wc * 32 + 8 * fq;
#pragma unroll
        for (int ai = 0; ai < 2; ++ai)
#pragma unroll
            for (int m = 0; m < 4; ++m) { const int r = r0 + ai * HALF + m * 16;
                if (r < n_e) {
#pragma unroll
                    for (int bj = 0; bj < 2; ++bj) { const f32x4 v0 = acc[ai][bj][m][0], v1 = acc[ai][bj][m][1];
                        u32x4 q; q.x = cvt_pk_bf16(v0[0], v0[1]); q.y = cvt_pk_bf16(v0[2], v0[3]); q.z = cvt_pk_bf16(v1[0], v1[1]); q.w = cvt_pk_bf16(v1[2], v1[3]);
                        *(u32x4*)(Y + (size_t)(u.p3 + r) * D + col0 + bj * HALF) = q; } } }
    }
};
}

__device__ __forceinline__ void fast_inproj(Frame& F) {
    pg::DenseSched S{(const char*)(F.ws + WS_WIN), D, T / 256, N_IN / 256, F.G, F.wg, TC / 256, T / 256, 4};
    pg::EpiInProj E{F.ws};
    pg::gemm_phase(F.lds, (const char*)(F.ws + WS_HB), D, S, E);
}
__device__ __forceinline__ void fast_outproj(Frame& F, size_t a_off, size_t w_off, const float* base, float* X, const float* gate, const float* bias) {
    pg::DenseSched S{(const char*)(F.ws + w_off), D, T / 256, D / 256, F.G, F.wg, 0, 0, 0};
    pg::EpiRes E{base, X, gate, bias};
    pg::gemm_phase(F.lds, (const char*)(F.ws + a_off), D, S, E);
}
__device__ __forceinline__ void fast_pw1(Frame& F) {
    pg::DenseSched S{(const char*)(F.ws + WS_WPW1), D, T / 256, 2048 / 256, F.G, F.wg, 0, 0, 0};
    pg::EpiGLU E{(bf16*)(F.ws + WS_U), F.in[I_PW1B]};
    pg::gemm_phase(F.lds, (const char*)(F.ws + WS_HB), D, S, E);
}
__device__ __forceinline__ void fast_moe_gateup(Frame& F, int layer) {
    LAS int* mm = moe_map(F, layer);
    pg::MoeSched<true> S{(const char*)(F.ws + WS_WGU) + (size_t)layer * 16 * 1024 * 1024 * 2, (size_t)1024 * 1024 * 2, D, (const int*)(F.ws + WS_SLOTT) + layer * 16 * CAP, mm, F.G, F.wg};
    pg::EpiGateUp E{(bf16*)(F.ws + WS_HID), (const float*)(F.ws + WS_SLOTW) + layer * 16 * CAP, mm};
    pg::gemm_phase(F.lds, (const char*)(F.ws + WS_HB), D, S, E);
}
__device__ __forceinline__ void fast_moe_down(Frame& F, int layer) {
    LAS int* mm = moe_map(F, layer);
    pg::MoeSched<false> S{(const char*)(F.ws + WS_WDN) + (size_t)layer * 16 * 1024 * 512 * 2, (size_t)1024 * 512 * 2, FF, nullptr, mm, F.G, F.wg};
    pg::EpiDown E{(bf16*)(F.ws + WS_Y), mm};
    pg::gemm_phase(F.lds, (const char*)(F.ws + WS_HID), FF, S, E);
}

constexpr int NPH = 18;
__global__ void __launch_bounds__(NTHR, 2) mega(Args args) {
    extern __shared__ __attribute__((aligned(16))) unsigned char lds[];
    Frame F;
    F.lds = (LAS unsigned char*)lds;
    F.tid = threadIdx.x; F.lane = F.tid & 63; F.wave = __builtin_amdgcn_readfirstlane(F.tid >> 6);
    F.G = gridDim.x; F.wg = blockIdx.x;
    F.in = args.in; F.out = args.out; F.ws = args.ws; F.ctl = (unsigned*)(args.ws + WS_CTL);
    volatile LAS unsigned* bst = (volatile LAS unsigned*)(F.lds + LDS_BYTES - 16);
    if (F.tid < 4) bst[F.tid] = 0u;
    __syncthreads();
    const int lo = args.ph_lo, hi = args.ph_hi;
    XcdBarrier bar; bar.bar = F.ctl + CW_BAR; bar.x = 0; bar.st = bst;
    if (hi - lo > 1) bar = xcd_barrier_post(F.ctl + CW_BAR, bst);
#define IN(k) (lo <= (k) && (k) < hi)
#define SEAM(k) do { if (IN(k) && IN((k) + 1)) xcd_barrier(bar); } while (0)
    const float* mod = (const float*)(F.ws + WS_MOD);

    if (IN(0)) { phase_prep(F); } SEAM(0);
    if (IN(1)) { phase_norm1_l0(F); } SEAM(1);
    if (IN(2)) { if (FAST_GEMM) fast_inproj(F); else phase_inproj(F); } SEAM(2);
    if (IN(3)) { phase_attn_simple(F); phase_fft1_simple(F); } SEAM(3);
    if (IN(4)) { phase_fft2_simple(F); } SEAM(4);
    if (IN(5)) { phase_fft3_simple(F); } SEAM(5);
    if (IN(6)) { if (FAST_GEMM) fast_outproj(F, WS_MIX, WS_WOUT, F.in[I_X], F.out, mod + 2048, nullptr); else phase_outproj(F, (const bf16*)(F.ws + WS_MIX), (const bf16*)(F.ws + WS_WOUT), F.in[I_X], F.out, mod + 2048, nullptr); } SEAM(6);
    if (IN(7)) { phase_norm2_route(F, 0); } SEAM(7);
    if (IN(8)) { if (FAST_GEMM) fast_moe_gateup(F, 0); else phase_moe_gateup(F, 0); } SEAM(8);
    if (IN(9)) { if (FAST_GEMM) fast_moe_down(F, 0); else phase_moe_down(F, 0); } SEAM(9);
    if (IN(10)) { phase_combine<false>(F, 0); } SEAM(10);
    if (IN(11)) { if (FAST_GEMM) fast_pw1(F); else phase_pw1(F); } SEAM(11);
    if (IN(12)) { phase_dwconv(F); } SEAM(12);
    if (IN(13)) { if (FAST_GEMM) fast_outproj(F, WS_V1, WS_WPW2, F.out, F.out, mod + 5 * 6144 + 2048, F.in[I_PW2B]); else phase_outproj(F, (const bf16*)(F.ws + WS_V1), (const bf16*)(F.ws + WS_WPW2), F.out, F.out, mod + 5 * 6144 + 2048, F.in[I_PW2B]); } SEAM(13);
    if (IN(14)) { phase_norm2_route(F, 1); } SEAM(14);
    if (IN(15)) { if (FAST_GEMM) fast_moe_gateup(F, 1); else phase_moe_gateup(F, 1); } SEAM(15);
    if (IN(16)) { if (FAST_GEMM) fast_moe_down(F, 1); else phase_moe_down(F, 1); } SEAM(16);
    if (IN(17)) { phase_combine<true>(F, 1); }
#undef IN
#undef SEAM
}

extern "C" void kernel_launch(void* const* d_in, const int* in_sizes, int n_in, void* d_out, int out_size, void* d_ws, size_t ws_size, hipStream_t stream) {
    static int grid = 0;
    if (grid == 0) {
        if (n_in != 25 || out_size != T * D || ws_size < WS_END) { fprintf(stderr, "kernel_launch: unexpected shapes (n_in %d out %d ws %zu)\n", n_in, out_size, ws_size); grid = -1; return; }
        int dev = 0, cus = 0, per_cu = 0;
        if (hipGetDevice(&dev) != hipSuccess || hipDeviceGetAttribute(&cus, hipDeviceAttributeMultiprocessorCount, dev) != hipSuccess) { grid = -1; return; }
        if (hipFuncSetAttribute((const void*)mega, hipFuncAttributeMaxDynamicSharedMemorySize, LDS_BYTES) != hipSuccess) { fprintf(stderr, "kernel_launch: hipFuncSetAttribute failed\n"); grid = -1; return; }
        if (hipOccupancyMaxActiveBlocksPerMultiprocessor(&per_cu, (const void*)mega, NTHR, LDS_BYTES) != hipSuccess || per_cu < 1) { fprintf(stderr, "kernel_launch: occupancy query says %d\n", per_cu); }
        (void)hipGetLastError();
        grid = cus;
    }
    if (grid < 0) return;
    (void)hipMemsetAsync((char*)d_ws + WS_CTL, 0, CTL_BYTES, stream);
    Args a{};
    for (int i = 0; i < 25; ++i) a.in[i] = (const float*)d_in[i];
    a.out = (float*)d_out; a.ws = (unsigned char*)d_ws;
#if MK_ONE_LAUNCH
    a.ph_lo = 0; a.ph_hi = NPH;
    hipLaunchKernelGGL(mega, dim3(grid), dim3(NTHR), LDS_BYTES, stream, a);
#else
    for (int p = 0; p < NPH; ++p) { a.ph_lo = p; a.ph_hi = p + 1; hipLaunchKernelGGL(mega, dim3(grid), dim3(NTHR), LDS_BYTES, stream, a); }
#endif
}
```

```cpp
#include <hip/hip_runtime.h>
#include <cstdio>

#ifndef MK_ONE_LAUNCH
#define MK_ONE_LAUNCH 1
#endif

#define GAS __attribute__((address_space(1)))
#define LAS __attribute__((address_space(3)))
typedef unsigned short bf16;
typedef short bf16x8 __attribute__((ext_vector_type(8)));
typedef float f32x4 __attribute__((ext_vector_type(4)));
typedef float f32x16 __attribute__((ext_vector_type(16)));
typedef unsigned u32x4 __attribute__((ext_vector_type(4)));
typedef unsigned u32x2 __attribute__((ext_vector_type(2)));

constexpr int D = 1024, NB = 4, L = 8192, T = NB * L, CL = 256, TC = NB * CL;
constexpr int NE = 16, FF = 512, CONVW = 31;
constexpr int N_IN = 1280;
constexpr int FN1 = 64, FN2 = 128;
#ifndef FAST_GEMM
#define FAST_GEMM 1
#endif
#ifndef FAST_ATTN
#define FAST_ATTN 1
#endif
#ifndef FAST_FFT
#define FAST_FFT 1
#endif
constexpr int IL = FAST_GEMM ? 128 : 32;
constexpr float EPS = 1e-6f;
constexpr int NWAVES = 8, NTHR = 512;
constexpr int CAP = 32768;
constexpr int HROWS = 65536 + 4096;

constexpr size_t MiB = 1u << 20;
constexpr size_t WS_CTL = 0, CTL_BYTES = 1 * MiB;
constexpr size_t WS_MOD = 1 * MiB;
constexpr size_t WS_TW = 1 * MiB + 512 * 1024;
constexpr size_t WS_WIN = 2 * MiB, WS_WOUT = 6 * MiB, WS_WPW1 = 10 * MiB, WS_WPW2 = 14 * MiB;
constexpr size_t WS_WGU = 16 * MiB, WS_WDN = 80 * MiB;
constexpr size_t WS_TOKE = 112 * MiB, WS_TOKP = 113 * MiB, WS_TOKW = 114 * MiB;
constexpr size_t WS_SLOTT = 116 * MiB, WS_SLOTW = 120 * MiB;
constexpr size_t WS_HB = 128 * MiB;
constexpr size_t WS_UF = 196 * MiB, WS_Q = 228 * MiB, WS_K = 260 * MiB, WS_V = 268 * MiB, WS_CK = 276 * MiB, WS_CV = 277 * MiB;
constexpr size_t WS_G = 280 * MiB, WS_MIX = 344 * MiB, WS_AB = 408 * MiB;
constexpr size_t WS_HID = 196 * MiB, WS_Y = 264 * MiB;
constexpr size_t WS_U = 196 * MiB, WS_V1 = 260 * MiB;
constexpr size_t WS_END = 472 * MiB;
constexpr int CW_BAR = 4096;
constexpr int CW_CNT = 8192;

constexpr int LDS_BYTES = 147456;

__device__ __forceinline__ unsigned f2bf(float f) { unsigned u = __float_as_uint(f); return (u + 0x7fffu + ((u >> 16) & 1u)) >> 16; }
__device__ __forceinline__ float bf2f(unsigned b) { return __uint_as_float(b << 16); }
__device__ __forceinline__ unsigned pk2(float lo, float hi) { return f2bf(lo) | (f2bf(hi) << 16); }
__device__ __forceinline__ float bflo(unsigned w) { return __uint_as_float(w << 16); }
__device__ __forceinline__ float bfhi(unsigned w) { return __uint_as_float(w & 0xffff0000u); }
__device__ __forceinline__ float wave_sum(float v) {
#pragma unroll
    for (int o = 1; o < 64; o <<= 1) v += __shfl_xor(v, o);
    return v;
}
__device__ __forceinline__ float silu_f(float x) { return x / (1.f + __expf(-x)); }
__device__ __forceinline__ float sigmoid_f(float x) { return 1.f / (1.f + __expf(-x)); }
#define LDS_WAIT() asm volatile("s_waitcnt lgkmcnt(0)" ::: "memory")

#define XB_TMO      128
#define XB_XCNT(j)  (256  + 64 * (j))
#define XB_XSUB(j)  (1280 + 64 * (j))
#define XB_XGEN(j)  (2304 + 64 * (j))
#define XB_TOP      3328
#define XB_TOPGEN   3392
#define XCD_BAR_WORDS 3456
#define XB_SPIN_CAP (1u << 20)
__device__ __forceinline__ unsigned xb_ld(unsigned* p)              { return __hip_atomic_load(p, __ATOMIC_RELAXED, __HIP_MEMORY_SCOPE_AGENT); }
__device__ __forceinline__ unsigned xb_add(unsigned* p, unsigned v) { return __hip_atomic_fetch_add(p, v, __ATOMIC_RELAXED, __HIP_MEMORY_SCOPE_AGENT); }
__device__ __forceinline__ unsigned xb_xcc_id() { return (unsigned)__builtin_amdgcn_s_getreg((3 << 11) | 20) & 0xFu; }
#define XB_SPIN(cond, bar) do { unsigned _sp = 0; while (cond) { __builtin_amdgcn_s_sleep(1); \
    if ((++_sp & 255u) == 0u) { if (xb_ld(&(bar)[XB_TMO])) break; if (_sp > XB_SPIN_CAP) { atomicAdd(&(bar)[XB_TMO], 1u); break; } } } } while (0)
struct XcdBarrier { unsigned* bar; unsigned x; volatile LAS unsigned* st; };
__device__ __forceinline__ XcdBarrier xcd_barrier_post(unsigned* bar, volatile LAS unsigned* st) {
    XcdBarrier b; b.bar = bar; b.x = xb_xcc_id(); b.st = st;
    if (threadIdx.x == 0) (void)xb_add(&bar[XB_XCNT(b.x)], 1u);
    return b;
}
__device__ __forceinline__ void xcd_barrier_complete(unsigned* bar, unsigned x, unsigned& nloc, unsigned& nx) {
    const unsigned G = gridDim.x * gridDim.y * gridDim.z;
    unsigned sum, cnt, mine, sp = 0u;
    for (;;) {
        sum = 0u; cnt = 0u; mine = 0u;
#pragma unroll
        for (unsigned j = 0; j < 16; ++j) { const unsigned c = xb_ld(&bar[XB_XCNT(j)]); sum += c; cnt += (c > 0u) ? 1u : 0u; mine = (j == x) ? c : mine; }
        if (sum == G) break;
        __builtin_amdgcn_s_sleep(1);
        if ((++sp & 255u) == 0u) { if (xb_ld(&bar[XB_TMO])) break; if (sp > XB_SPIN_CAP) { atomicAdd(&bar[XB_TMO], 1u); break; } }
    }
    nloc = mine > 0u ? mine : 1u; nx = cnt > 0u ? cnt : 1u;
}
__device__ __forceinline__ void xcd_barrier(const XcdBarrier& b) {
    asm volatile("s_waitcnt vmcnt(0)" ::: "memory");
    __syncthreads();
    if (threadIdx.x == 0) {
        unsigned* bar = b.bar;
        __builtin_amdgcn_s_waitcnt(0);
        unsigned nloc = b.st[0], nx = b.st[1];
        if (nloc == 0u) { xcd_barrier_complete(bar, b.x, nloc, nx); b.st[0] = nloc; b.st[1] = nx; }
        const unsigned old = xb_add(&bar[XB_XSUB(b.x)], 1u);
        const unsigned gen = old / nloc;
        if (old + 1u == (gen + 1u) * nloc) {
            __builtin_amdgcn_fence(__ATOMIC_RELEASE, "agent");
            asm volatile("s_waitcnt vmcnt(0)" ::: "memory");
            const unsigned og = xb_add(&bar[XB_TOP], 1u);
            const unsigned tg = og / nx;
            if (og + 1u == (tg + 1u) * nx) xb_add(&bar[XB_TOPGEN], 1u);
            else XB_SPIN(xb_ld(&bar[XB_TOPGEN]) == tg, bar);
            __builtin_amdgcn_fence(__ATOMIC_ACQUIRE, "agent");
            xb_add(&bar[XB_XGEN(b.x)], 1u);
            asm volatile("s_waitcnt vmcnt(0)" ::: "memory");
        } else {
            XB_SPIN(xb_ld(&bar[XB_XGEN(b.x)]) == gen, bar);
            __builtin_amdgcn_fence(__ATOMIC_ACQUIRE, "agent");
            asm volatile("s_waitcnt vmcnt(0)" ::: "memory");
        }
    }
    __syncthreads();
}

struct Args { const float* in[25]; float* out; unsigned char* ws; int ph_lo, ph_hi; };
enum { I_X = 0, I_C, I_CTX, I_CCTX, I_ADAW, I_ADAB, I_NMG, I_NFG, I_WIN, I_WOUT, I_SINK, I_PW1W, I_PW1B, I_DWW, I_DWB, I_LNG, I_LNB,
       I_PW2W, I_PW2B, I_RW, I_RB, I_WG, I_WU, I_WD, I_FNG };

struct Frame {
    LAS unsigned char* lds;
    int tid, lane, wave, G, wg;
    const float* const* in;
    float* out;
    unsigned char* ws;
    unsigned* ctl;
};

__device__ __forceinline__ int crow(int i, int h) { return (i & 3) + 8 * (i >> 2) + 4 * h; }
template <class RowPtr, class Epi>
__device__ __forceinline__ void sgemm_tile(const RowPtr& rowptr, const bf16* Bt, int K, int m0, int n0, const Epi& epi, int wave, int lane) {
    const int wm = wave & 3, wn = wave >> 2, r = lane & 31, h = lane >> 5;
    const bf16* ap = rowptr(m0 + wm * 32 + r) + 8 * h;
    const bf16* bp0 = Bt + (size_t)(n0 + wn * 64 + r) * K + 8 * h;
    const bf16* bp1 = bp0 + (size_t)32 * K;
    f32x16 c0, c1;
#pragma unroll
    for (int i = 0; i < 16; ++i) { c0[i] = 0.f; c1[i] = 0.f; }
#pragma unroll 2
    for (int k = 0; k < K; k += 32) {
        const bf16x8 a0 = *(const bf16x8*)(ap + k), a1 = *(const bf16x8*)(ap + k + 16);
        const bf16x8 b00 = *(const bf16x8*)(bp0 + k), b01 = *(const bf16x8*)(bp0 + k + 16);
        const bf16x8 b10 = *(const bf16x8*)(bp1 + k), b11 = *(const bf16x8*)(bp1 + k + 16);
        c0 = __builtin_amdgcn_mfma_f32_32x32x16_bf16(a0, b00, c0, 0, 0, 0);
        c1 = __builtin_amdgcn_mfma_f32_32x32x16_bf16(a0, b10, c1, 0, 0, 0);
        c0 = __builtin_amdgcn_mfma_f32_32x32x16_bf16(a1, b01, c0, 0, 0, 0);
        c1 = __builtin_amdgcn_mfma_f32_32x32x16_bf16(a1, b11, c1, 0, 0, 0);
    }
    epi(m0 + wm * 32, n0 + wn * 64, c0, c1, lane);
}

__device__ __forceinline__ void p0_transpose_item(const float* W, int K, int N, bf16* WT, int k0, int n0, int drow0, LAS float* scr, int lane) {
#pragma unroll 8
    for (int i = 0; i < 32; ++i) { const int kk = 2 * i + (lane >> 5); scr[kk * 33 + (lane & 31)] = W[(size_t)(k0 + kk) * N + n0 + (lane & 31)]; }
    LDS_WAIT(); asm volatile("" ::: "memory");
    const int c = lane & 7;
#pragma unroll
    for (int j = 0; j < 4; ++j) { const int n = (lane >> 3) + 8 * j; const LAS float* s = scr + (8 * c) * 33 + n;
        u32x4 o; o.x = pk2(s[0 * 33], s[1 * 33]); o.y = pk2(s[2 * 33], s[3 * 33]); o.z = pk2(s[4 * 33], s[5 * 33]); o.w = pk2(s[6 * 33], s[7 * 33]);
        *(u32x4*)(WT + (size_t)(drow0 + n) * K + k0 + 8 * c) = o; }
    LDS_WAIT(); asm volatile("" ::: "memory");
}
__device__ __forceinline__ int il_row(int j, int half) { return (j / IL) * (2 * IL) + half * IL + (j % IL); }

__device__ __forceinline__ void phase_prep(Frame& F) {
    {
        LAS float* sc = (LAS float*)F.lds;
        LAS float* red = sc + 5 * 1024;
        bool loaded = false;
        for (int it = F.wg; it < 192; it += F.G) {
            if (!loaded) {
                for (int i = F.tid; i < 5 * 1024; i += NTHR) { const int b = i >> 10, k = i & 1023; const float v = b < 4 ? F.in[I_C][b * 1024 + k] : F.in[I_CCTX][k]; sc[i] = silu_f(v); }
                __syncthreads(); loaded = true;
            }
            const int l = it / 96, n0 = (it % 96) * 64, col = F.tid & 63, kg = F.tid >> 6;
            const float* w = F.in[I_ADAW] + (size_t)l * 1024 * 6144 + n0 + col;
            float a0 = 0.f, a1 = 0.f, a2 = 0.f, a3 = 0.f, a4 = 0.f;
#pragma unroll 8
            for (int k = kg * 128; k < kg * 128 + 128; ++k) { const float wv = w[(size_t)k * 6144];
                a0 += sc[k] * wv; a1 += sc[1024 + k] * wv; a2 += sc[2048 + k] * wv; a3 += sc[3072 + k] * wv; a4 += sc[4096 + k] * wv; }
            red[(kg * 5 + 0) * 64 + col] = a0; red[(kg * 5 + 1) * 64 + col] = a1; red[(kg * 5 + 2) * 64 + col] = a2; red[(kg * 5 + 3) * 64 + col] = a3; red[(kg * 5 + 4) * 64 + col] = a4;
            __syncthreads();
            if (F.tid < 320) { const int b = F.tid >> 6, c2 = F.tid & 63; float s = 0.f;
#pragma unroll
                for (int g = 0; g < 8; ++g) s += red[(g * 5 + b) * 64 + c2];
                ((float*)(F.ws + WS_MOD))[((size_t)l * 5 + b) * 6144 + n0 + c2] = s + F.in[I_ADAB][l * 6144 + n0 + c2]; }
            __syncthreads();
        }
        __syncthreads();
    }
    { u32x4* z = (u32x4*)(F.ws + WS_SLOTT); const u32x4 zero = {0u, 0u, 0u, 0u};
      for (int i = F.wg * NTHR + F.tid; i < 2 * 16 * CAP / 4; i += F.G * NTHR) z[i] = zero; }
    { float* tw = (float*)(F.ws + WS_TW);
      for (int k = F.wg * NTHR + F.tid; k < 8192; k += F.G * NTHR) { const float a = (float)k * (6.283185307179586f / 8192.f); tw[2 * k] = __cosf(a); tw[2 * k + 1] = __sinf(a); } }
    {
        LAS float* scr = (LAS float*)(F.lds + F.wave * 8704);
        const int gw = F.wg * NWAVES + F.wave, NGW = F.G * NWAVES;
        constexpr int S0 = 640, S1 = 512, S2 = 1024, S3 = 512, SM = 32 * 256;
        constexpr int NIT = S0 + S1 + S2 + S3 + 3 * SM;
        for (int it = gw; it < NIT; it += NGW) {
            int r = it;
            if (r < S0) { const int kb = r / 40, nb = r % 40; p0_transpose_item(F.in[I_WIN], 1024, 1280, (bf16*)(F.ws + WS_WIN), kb * 64, nb * 32, nb * 32, scr, F.lane); continue; } r -= S0;
            if (r < S1) { const int kb = r / 32, nb = r % 32; p0_transpose_item(F.in[I_WOUT], 1024, 1024, (bf16*)(F.ws + WS_WOUT), kb * 64, nb * 32, nb * 32, scr, F.lane); continue; } r -= S1;
            if (r < S2) { const int kb = r / 64, nb = r % 64, n0 = nb * 32; p0_transpose_item(F.in[I_PW1W], 1024, 2048, (bf16*)(F.ws + WS_WPW1), kb * 64, n0, il_row(n0 & 1023, n0 >> 10), scr, F.lane); continue; } r -= S2;
            if (r < S3) { const int kb = r / 32, nb = r % 32; p0_transpose_item(F.in[I_PW2W], 1024, 1024, (bf16*)(F.ws + WS_WPW2), kb * 64, nb * 32, nb * 32, scr, F.lane); continue; } r -= S3;
            if (r < SM) { const int le = r >> 8, q = r & 255, kb = q / 16, nb = q % 16;
                p0_transpose_item(F.in[I_WG] + (size_t)le * 1024 * 512, 1024, 512, (bf16*)(F.ws + WS_WGU) + (size_t)le * 1024 * 1024, kb * 64, nb * 32, il_row(nb * 32, 0), scr, F.lane); continue; } r -= SM;
            if (r < SM) { const int le = r >> 8, q = r & 255, kb = q / 16, nb = q % 16;
                p0_transpose_item(F.in[I_WU] + (size_t)le * 1024 * 512, 1024, 512, (bf16*)(F.ws + WS_WGU) + (size_t)le * 1024 * 1024, kb * 64, nb * 32, il_row(nb * 32, 1), scr, F.lane); continue; } r -= SM;
            { const int le = r >> 8, q = r & 255, kb = q / 32, nb = q % 32;
                p0_transpose_item(F.in[I_WD] + (size_t)le * 512 * 1024, 512, 1024, (bf16*)(F.ws + WS_WDN) + (size_t)le * 1024 * 512, kb * 64, nb * 32, nb * 32, scr, F.lane); }
        }
    }
}

__device__ __forceinline__ void row_load(const float* p, int lane, f32x4 (&v)[4]) {
#pragma unroll
    for (int j = 0; j < 4; ++j) v[j] = *(const f32x4*)(p + 4 * lane + 256 * j);
}
__device__ __forceinline__ float row_sumsq(const f32x4 (&v)[4]) {
    float s = 0.f;
#pragma unroll
    for (int j = 0; j < 4; ++j) s += (v[j].x * v[j].x + v[j].y * v[j].y) + (v[j].z * v[j].z + v[j].w * v[j].w);
    return wave_sum(s);
}
__device__ __forceinline__ void row_modulate(f32x4 (&v)[4], float rstd, const float* g, const float* sh, const float* sc, int lane) {
#pragma unroll
    for (int j = 0; j < 4; ++j) { const int o = 4 * lane + 256 * j; const f32x4 gg = *(const f32x4*)(g + o), s1 = *(const f32x4*)(sc + o), s0 = *(const f32x4*)(sh + o);
        v[j] = v[j] * rstd * gg * (1.f + s1) + s0; }
}
__device__ __forceinline__ void row_store_bf16(bf16* dst, const f32x4 (&v)[4], int lane) {
#pragma unroll
    for (int j = 0; j < 4; ++j) { u32x2 w; w.x = pk2(v[j].x, v[j].y); w.y = pk2(v[j].z, v[j].w); *(u32x2*)(dst + 4 * lane + 256 * j) = w; }
}

__device__ __forceinline__ void phase_norm1_l0(Frame& F) {
    const int gw = F.wg * NWAVES + F.wave, NGW = F.G * NWAVES;
    const float* mod = (const float*)(F.ws + WS_MOD);
    bf16* HB = (bf16*)(F.ws + WS_HB);
    for (int row = gw; row < T + TC; row += NGW) {
        const float* src = row < T ? F.in[I_X] + (size_t)row * D : F.in[I_CTX] + (size_t)(row - T) * D;
        const int b = row < T ? (row >> 13) : 4;
        f32x4 v[4]; row_load(src, F.lane, v);
        const float rstd = rsqrtf(row_sumsq(v) * (1.f / D) + EPS);
        const float* m = mod + (size_t)b * 6144;
        row_modulate(v, rstd, F.in[I_NMG], m, m + 1024, F.lane);
        row_store_bf16(HB + (size_t)row * D, v, F.lane);
    }
}

struct RowLin { const bf16* base; size_t pitch; __device__ __forceinline__ const bf16* operator()(int m) const { return base + (size_t)m * pitch; } };

__device__ __forceinline__ void inproj_block(Frame& F, int mb, int nbk, const f32x16& c, int lane) {
    const int h = lane >> 5, cl = lane & 31;
    bf16* dst; int pitch, cbase; bool rope = false; bool isctx = (mb >= T);
    if (nbk < 512) { dst = (bf16*)(F.ws + WS_UF); pitch = 512; cbase = 0; }
    else if (nbk < 1024) { dst = (bf16*)(F.ws + WS_Q); pitch = 512; cbase = 512; rope = true; }
    else if (nbk < 1152) { dst = isctx ? (bf16*)(F.ws + WS_CK) : (bf16*)(F.ws + WS_K); pitch = 128; cbase = 1024; rope = !isctx; }
    else { dst = isctx ? (bf16*)(F.ws + WS_CV) : (bf16*)(F.ws + WS_V); pitch = 128; cbase = 1152; }
    const int rbase = isctx ? mb - T : mb;
    const int col = nbk - cbase + cl;
    const float inv = exp2f(-(float)(cl & 15) * (13.287712379549449f / 16.f));
    const bool second = (cl & 16) != 0; const bool bycol = ((nbk >> 5) & 1) != 0;
#pragma unroll
    for (int i = 0; i < 16; ++i) {
        const int rr = crow(i, h); float v = c[i];
        if (rope) {
            const float partner = __shfl_xor(v, 16);
            const int l = (mb + rr) & (L - 1);
            const float pos = (float)(bycol ? (l & 63) : (l >> 6));
            const float ang = pos * inv, cs = __cosf(ang), sn = __sinf(ang);
            v = second ? (partner * sn + v * cs) : (v * cs - partner * sn);
        }
        dst[(size_t)(rbase + rr) * pitch + col] = (bf16)f2bf(v);
    }
}
__device__ __forceinline__ void phase_inproj(Frame& F) {
    const bf16* HB = (const bf16*)(F.ws + WS_HB); const bf16* Wt = (const bf16*)(F.ws + WS_WIN);
    constexpr int MT = (T + TC) / 128, NT = N_IN / 128;
    RowLin rp{HB, (size_t)D};
    for (int u = F.wg; u < MT * NT; u += F.G) {
        const int mt = u / NT, nt = u % NT;
        if (mt >= T / 128 && nt < 8) continue;
        auto epi = [&](int mb, int nb, const f32x16& c0, const f32x16& c1, int lane) { inproj_block(F, mb, nb, c0, lane); inproj_block(F, mb, nb + 32, c1, lane); };
        sgemm_tile(rp, Wt, D, mt * 128, nt * 128, epi, F.wave, F.lane);
    }
}

__device__ __forceinline__ void attn_key(const bf16* kp, const bf16* vp, const float (&q)[64], float& m, float& s, float (&o)[64]) {
    float dot = 0.f;
#pragma unroll
    for (int j = 0; j < 8; ++j) { const u32x4 w = *(const u32x4*)(kp + 8 * j);
        dot += q[8 * j + 0] * bflo(w.x) + q[8 * j + 1] * bfhi(w.x) + q[8 * j + 2] * bflo(w.y) + q[8 * j + 3] * bfhi(w.y)
             + q[8 * j + 4] * bflo(w.z) + q[8 * j + 5] * bfhi(w.z) + q[8 * j + 6] * bflo(w.w) + q[8 * j + 7] * bfhi(w.w); }
    const float mn = fmaxf(m, dot), alpha = __expf(m - mn), p = __expf(dot - mn);
    s = s * alpha + p; m = mn;
#pragma unroll
    for (int j = 0; j < 8; ++j) { const u32x4 w = *(const u32x4*)(vp + 8 * j);
        o[8 * j + 0] = o[8 * j + 0] * alpha + p * bflo(w.x); o[8 * j + 1] = o[8 * j + 1] * alpha + p * bfhi(w.x);
        o[8 * j + 2] = o[8 * j + 2] * alpha + p * bflo(w.y); o[8 * j + 3] = o[8 * j + 3] * alpha + p * bfhi(w.y);
        o[8 * j + 4] = o[8 * j + 4] * alpha + p * bflo(w.z); o[8 * j + 5] = o[8 * j + 5] * alpha + p * bfhi(w.z);
        o[8 * j + 6] = o[8 * j + 6] * alpha + p * bflo(w.w); o[8 * j + 7] = o[8 * j + 7] * alpha + p * bfhi(w.w); }
}
__device__ __forceinline__ void phase_attn_simple(Frame& F) {
    const bf16* Q = (const bf16*)(F.ws + WS_Q); const bf16* Kb = (const bf16*)(F.ws + WS_K); const bf16* Vb = (const bf16*)(F.ws + WS_V);
    const bf16* CK = (const bf16*)(F.ws + WS_CK); const bf16* CV = (const bf16*)(F.ws + WS_CV); bf16* MIX = (bf16*)(F.ws + WS_MIX);
    for (int idx = F.wg * NTHR + F.tid; idx < T * 8; idx += F.G * NTHR) {
        const int hd = idx / T, t = idx % T, b = t >> 13, l = t & (L - 1), kvh = hd >> 2;
        float q[64], o[64];
#pragma unroll
        for (int j = 0; j < 8; ++j) { const u32x4 w = *(const u32x4*)(Q + (size_t)t * 512 + hd * 64 + 8 * j);
            q[8 * j + 0] = bflo(w.x) * 0.125f; q[8 * j + 1] = bfhi(w.x) * 0.125f; q[8 * j + 2] = bflo(w.y) * 0.125f; q[8 * j + 3] = bfhi(w.y) * 0.125f;
            q[8 * j + 4] = bflo(w.z) * 0.125f; q[8 * j + 5] = bfhi(w.z) * 0.125f; q[8 * j + 6] = bflo(w.w) * 0.125f; q[8 * j + 7] = bfhi(w.w) * 0.125f; }
#pragma unroll
        for (int j = 0; j < 64; ++j) o[j] = 0.f;
        float m = F.in[I_SINK][hd], s = 1.f;
        for (int c = 0; c < CL; ++c) { const size_t r = (size_t)(b * CL + c) * 128 + kvh * 64; attn_key(CK + r, CV + r, q, m, s, o); }
        const int lo = l - 128 < 0 ? 0 : l - 128, hi = l + 128 > L - 1 ? L - 1 : l + 128;
        for (int kp = lo; kp <= hi; ++kp) { const size_t r = (size_t)(b * L + kp) * 128 + kvh * 64; attn_key(Kb + r, Vb + r, q, m, s, o); }
        const float is = 1.f / s;
#pragma unroll
        for (int j = 0; j < 8; ++j) { u32x4 w; w.x = pk2(o[8 * j] * is, o[8 * j + 1] * is); w.y = pk2(o[8 * j + 2] * is, o[8 * j + 3] * is); w.z = pk2(o[8 * j + 4] * is, o[8 * j + 5] * is); w.w = pk2(o[8 * j + 6] * is, o[8 * j + 7] * is);
            *(u32x4*)(MIX + (size_t)t * 1024 + 512 + hd * 64 + 8 * j) = w; }
    }
}

__device__ __forceinline__ void phase_fft1_simple(Frame& F) {
    const bf16* UF = (const bf16*)(F.ws + WS_UF); bf16* Gb = (bf16*)(F.ws + WS_G); const float* tw = (const float*)(F.ws + WS_TW);
    for (int idx = F.wg * NTHR + F.tid; idx < NB * FN1 * FN2 * 512; idx += F.G * NTHR) {
        const int ch = idx & 511, bp = (idx >> 9) & 127, c = (idx >> 16) & 63, b = idx >> 22;
        float re = 0.f, im = 0.f;
        for (int a = 0; a < FN1; ++a) { const float u = bf2f(UF[(size_t)(b * L + 128 * a + bp) * 512 + ch]); const int k = ((a * c) & 63) * 128;
            re += u * tw[2 * k]; im -= u * tw[2 * k + 1]; }
        const int k2 = bp * c; const float cs = tw[2 * k2], sn = tw[2 * k2 + 1];
        const float gr = re * cs + im * sn, gi = im * cs - re * sn;
        const size_t row = (size_t)(b * FN1 + c) * FN2 + bp;
        Gb[row * 1024 + ch] = (bf16)f2bf(gr); Gb[row * 1024 + 512 + ch] = (bf16)f2bf(gi);
    }
}
__device__ __forceinline__ void phase_fft2_simple(Frame& F) {
    const bf16* Gb = (const bf16*)(F.ws + WS_G); bf16* AB = (bf16*)(F.ws + WS_AB); const float* tw = (const float*)(F.ws + WS_TW);
    for (int idx = F.wg * NTHR + F.tid; idx < NB * FN1 * FN2 * 512; idx += F.G * NTHR) {
        const int ch = idx & 511, d = (idx >> 9) & 127, c = (idx >> 16) & 63, b = idx >> 22;
        float fr = 0.f, fi = 0.f;
        for (int bp = 0; bp < FN2; ++bp) { const size_t row = (size_t)(b * FN1 + c) * FN2 + bp; const float gr = bf2f(Gb[row * 1024 + ch]), gi = bf2f(Gb[row * 1024 + 512 + ch]);
            const int k = ((bp * d) & 127) * 64; const float cs = tw[2 * k], sn = tw[2 * k + 1];
            fr += gr * cs + gi * sn; fi += gi * cs - gr * sn; }
        const size_t t = (size_t)b * L + c + 64 * d;
        AB[t * 1024 + ch] = (bf16)f2bf(fr); AB[t * 1024 + 512 + ch] = (bf16)f2bf(-fi);
    }
}
__device__ __forceinline__ void phase_fft3_simple(Frame& F) {
    const bf16* AB = (const bf16*)(F.ws + WS_AB); bf16* MIX = (bf16*)(F.ws + WS_MIX); const float* tw = (const float*)(F.ws + WS_TW);
    LAS float* t128 = (LAS float*)F.lds;
    for (int i = F.tid; i < 128; i += NTHR) { t128[2 * i] = tw[2 * (i * 64)]; t128[2 * i + 1] = tw[2 * (i * 64) + 1]; }
    __syncthreads();
    for (int idx = F.wg * NTHR + F.tid; idx < T * 512; idx += F.G * NTHR) {
        const int cp = idx & 127, g = (idx >> 7) & 3, t = idx >> 9;
        const bf16* arow = AB + (size_t)t * 1024 + g * 128;
        float y = 0.f;
        for (int cc = 0; cc < 128; ++cc) { const int k = (cc * cp) & 127; y += bf2f(arow[cc]) * t128[2 * k] - bf2f(arow[512 + cc]) * t128[2 * k + 1]; }
        MIX[(size_t)t * 1024 + g * 128 + cp] = (bf16)f2bf(y * (1.f / 1024.f));
    }
    __syncthreads();
}

__device__ __forceinline__ void phase_outproj(Frame& F, const bf16* A, const bf16* Wt, const float* base, float* X, const float* gate  , const float* bias) {
    RowLin rp{A, (size_t)D};
    for (int u = F.wg; u < (T / 128) * 8; u += F.G) {
        const int mt = u / 8, nt = u % 8;
        auto epi = [&](int mb, int nb, const f32x16& c0, const f32x16& c1, int lane) {
            const int h = lane >> 5, cl = lane & 31, b = mb >> 13;
#pragma unroll
            for (int half = 0; half < 2; ++half) { const int col = nb + 32 * half + cl; const float gv = gate[(size_t)b * 6144 + col], bv = bias ? bias[col] : 0.f;
#pragma unroll
                for (int i = 0; i < 16; ++i) { const size_t o = (size_t)(mb + crow(i, h)) * D + col; const float a = half ? c1[i] : c0[i]; X[o] = base[o] + gv * (a + bv); } }
        };
        sgemm_tile(rp, Wt, D, mt * 128, nt * 128, epi, F.wave, F.lane);
    }
}

__device__ __forceinline__ void phase_norm2_route(Frame& F, int layer) {
    const float* mod = (const float*)(F.ws + WS_MOD) + (size_t)layer * 5 * 6144;
    const float* X = F.out; bf16* HB = (bf16*)(F.ws + WS_HB);
    const float* rw = F.in[I_RW]; const float* rb = F.in[I_RB];
    int* tok_e = (int*)(F.ws + WS_TOKE); int* tok_p = (int*)(F.ws + WS_TOKP); float* tok_w = (float*)(F.ws + WS_TOKW);
    int* slot_t = (int*)(F.ws + WS_SLOTT) + layer * 16 * CAP;
    float* slot_w = (float*)(F.ws + WS_SLOTW) + layer * 16 * CAP;
    unsigned* cnt = F.ctl + CW_CNT + layer * 16 * 64;
    LAS int* sel_e = (LAS int*)F.lds;
    LAS float* sel_w = (LAS float*)(F.lds + 1024);
    for (int rb0 = F.wg; rb0 < T / 128; rb0 += F.G) {
        for (int j = 0; j < 16; ++j) {
            const int lr = F.wave * 16 + j, row = rb0 * 128 + lr, b = row >> 13;
            f32x4 v[4]; row_load(X + (size_t)row * D, F.lane, v);
            const float rstd = rsqrtf(row_sumsq(v) * (1.f / D) + EPS);
            const float* m = mod + (size_t)b * 6144;
            row_modulate(v, rstd, F.in[I_NFG] + layer * D, m + 3072, m + 4096, F.lane);
            row_store_bf16(HB + (size_t)row * D, v, F.lane);
            float lg[16];
#pragma unroll
            for (int e = 0; e < 16; ++e) lg[e] = 0.f;
#pragma unroll
            for (int jj = 0; jj < 4; ++jj)
#pragma unroll
                for (int q = 0; q < 4; ++q) { const float* wr = rw + (size_t)(4 * F.lane + 256 * jj + q) * 16; const float fv = v[jj][q];
#pragma unroll
                    for (int e4 = 0; e4 < 4; ++e4) { const f32x4 w4 = *(const f32x4*)(wr + 4 * e4); lg[4 * e4] += fv * w4.x; lg[4 * e4 + 1] += fv * w4.y; lg[4 * e4 + 2] += fv * w4.z; lg[4 * e4 + 3] += fv * w4.w; } }
#pragma unroll
            for (int e = 0; e < 16; ++e) lg[e] = wave_sum(lg[e]);
            float best = -1e30f; int be1 = 0, be2 = 0; float bs1 = 0.f, bs2 = 0.f;
#pragma unroll
            for (int g = 0; g < 4; ++g) {
                float v1 = -1e30f, v2 = -1e30f, s1 = 0.f, s2 = 0.f; int j1 = 0, j2 = 0;
#pragma unroll
                for (int q = 0; q < 4; ++q) { const float sc = sigmoid_f(lg[4 * g + q]), x = sc + rb[4 * g + q];
                    if (x > v1) { v2 = v1; j2 = j1; s2 = s1; v1 = x; j1 = q; s1 = sc; } else if (x > v2) { v2 = x; j2 = q; s2 = sc; } }
                const float gs = v1 + v2;
                if (gs > best) { best = gs; be1 = 4 * g + j1; be2 = 4 * g + j2; bs1 = s1; bs2 = s2; }
            }
            if (F.lane == 0) { const float inv = 1.f / (bs1 + bs2); sel_e[2 * lr] = be1; sel_e[2 * lr + 1] = be2; sel_w[2 * lr] = bs1 * inv; sel_w[2 * lr + 1] = bs2 * inv; }
        }
        __syncthreads();
        if (F.tid < 16) {
            const int e = F.tid; int n = 0;
            for (int i = 0; i < 256; ++i) n += (sel_e[i] == e) ? 1 : 0;
            int pos = n ? (int)atomicAdd(cnt + e * 64, (unsigned)n) : 0;
            for (int i = 0; i < 256; ++i) if (sel_e[i] == e) { const int tok = rb0 * 128 + (i >> 1);
                slot_t[e * CAP + pos] = tok; slot_w[e * CAP + pos] = sel_w[i]; tok_e[2 * tok + (i & 1)] = e; tok_p[2 * tok + (i & 1)] = pos; tok_w[2 * tok + (i & 1)] = sel_w[i]; ++pos; }
        }
        __syncthreads();
    }
}

constexpr int MOEMAP_OFF = LDS_BYTES - 256;
__device__ __forceinline__ LAS int* moe_map(Frame& F, int layer) {
    LAS int* mm = (LAS int*)(F.lds + MOEMAP_OFF);
    __syncthreads();
    if (F.tid == 0) { const unsigned* cnt = F.ctl + CW_CNT + layer * 16 * 64; int acc = 0;
        for (int e = 0; e < 16; ++e) { const int n = (int)__hip_atomic_load(cnt + e * 64, __ATOMIC_RELAXED, __HIP_MEMORY_SCOPE_AGENT); mm[e] = n; mm[16 + e] = acc; acc += (n + 255) & ~255; } }
    __syncthreads();
    return mm;
}
struct RowGather { const bf16* base; const int* list; int n; __device__ __forceinline__ const bf16* operator()(int m) const { const int tok = m < n ? list[m] : 0; return base + (size_t)tok * D; } };

__device__ __forceinline__ void phase_moe_gateup(Frame& F, int layer) {
    LAS int* mm = moe_map(F, layer);
    const bf16* HB = (const bf16*)(F.ws + WS_HB); bf16* HID = (bf16*)(F.ws + WS_HID);
    const int* slot_t = (const int*)(F.ws + WS_SLOTT) + layer * 16 * CAP; const float* slot_w = (const float*)(F.ws + WS_SLOTW) + layer * 16 * CAP;
    int ubase = 0;
#pragma unroll 1
    for (int e = 0; e < 16; ++e) {
        const int n = mm[e], hbe = mm[16 + e], rt = (n + 127) >> 7, nu = rt * 8;
        const bf16* Wt = (const bf16*)(F.ws + WS_WGU) + (size_t)(layer * 16 + e) * 1024 * 1024;
        RowGather rp{HB, slot_t + e * CAP, n};
        int first = (F.wg - ubase % F.G + F.G) % F.G;
        for (int u = first; u < nu; u += F.G) {
            const int mt = u / 8, nt = u % 8;
            auto epi = [&](int mb, int nb, const f32x16& c0, const f32x16& c1, int lane) {
                const int h = lane >> 5, cl = lane & 31; const int col = (nb >> 1) + cl;
#pragma unroll
                for (int i = 0; i < 16; ++i) { const int r = mb + crow(i, h);
                    if (r < n) { const float w = slot_w[e * CAP + r]; HID[(size_t)(hbe + r) * FF + col] = (bf16)f2bf(w * silu_f(c0[i]) * c1[i]); } }
            };
            sgemm_tile(rp, Wt, D, mt * 128, nt * 128, epi, F.wave, F.lane);
        }
        ubase += nu;
    }
}
__device__ __forceinline__ void phase_moe_down(Frame& F, int layer) {
    LAS int* mm = moe_map(F, layer);
    const bf16* HID = (const bf16*)(F.ws + WS_HID); bf16* Y = (bf16*)(F.ws + WS_Y);
    int ubase = 0;
#pragma unroll 1
    for (int e = 0; e < 16; ++e) {
        const int n = mm[e], hbe = mm[16 + e], rt = (n + 127) >> 7, nu = rt * 8;
        const bf16* Wt = (const bf16*)(F.ws + WS_WDN) + (size_t)(layer * 16 + e) * 1024 * 512;
        RowLin rp{HID + (size_t)hbe * FF, (size_t)FF};
        int first = (F.wg - ubase % F.G + F.G) % F.G;
        for (int u = first; u < nu; u += F.G) {
            const int mt = u / 8, nt = u % 8;
            auto epi = [&](int mb, int nb, const f32x16& c0, const f32x16& c1, int lane) {
                const int h = lane >> 5, cl = lane & 31;
#pragma unroll
                for (int i = 0; i < 16; ++i) { const int r = mb + crow(i, h);
                    if (r < n) { bf16* yr = Y + (size_t)(hbe + r) * D + nb + cl; yr[0] = (bf16)f2bf(c0[i]); yr[32] = (bf16)f2bf(c1[i]); } }
            };
            sgemm_tile(rp, Wt, FF, mt * 128, nt * 128, epi, F.wave, F.lane);
        }
        ubase += nu;
    }
}

template <bool FINAL>
__device__ __forceinline__ void phase_combine(Frame& F, int layer) {
    LAS int* hbs = moe_map(F, layer) + 16;
    const int gw = F.wg * NWAVES + F.wave, NGW = F.G * NWAVES;
    const float* mod = (const float*)(F.ws + WS_MOD);
    const int* tok_e = (const int*)(F.ws + WS_TOKE); const int* tok_p = (const int*)(F.ws + WS_TOKP);
    const bf16* Y = (const bf16*)(F.ws + WS_Y); float* X = F.out; bf16* HB = (bf16*)(F.ws + WS_HB);
    for (int row = gw; row < T; row += NGW) {
        const int b = row >> 13;
        const int s0 = hbs[tok_e[2 * row]] + tok_p[2 * row], s1 = hbs[tok_e[2 * row + 1]] + tok_p[2 * row + 1];
        f32x4 v[4]; row_load(X + (size_t)row * D, F.lane, v);
        const float* g2 = mod + ((size_t)layer * 5 + b) * 6144 + 5120;
#pragma unroll
        for (int j = 0; j < 4; ++j) { const int o = 4 * F.lane + 256 * j;
            const u32x2 y0 = *(const u32x2*)(Y + (size_t)s0 * D + o), y1 = *(const u32x2*)(Y + (size_t)s1 * D + o); const f32x4 gg = *(const f32x4*)(g2 + o);
            v[j].x += gg.x * (bflo(y0.x) + bflo(y1.x)); v[j].y += gg.y * (bfhi(y0.x) + bfhi(y1.x)); v[j].z += gg.z * (bflo(y0.y) + bflo(y1.y)); v[j].w += gg.w * (bfhi(y0.y) + bfhi(y1.y)); }
        const float rstd = rsqrtf(row_sumsq(v) * (1.f / D) + EPS);
        if (FINAL) {
#pragma unroll
            for (int j = 0; j < 4; ++j) { const int o = 4 * F.lane + 256 * j; const f32x4 gg = *(const f32x4*)(F.in[I_FNG] + o); *(f32x4*)(X + (size_t)row * D + o) = v[j] * rstd * gg; }
        } else {
#pragma unroll
            for (int j = 0; j < 4; ++j) *(f32x4*)(X + (size_t)row * D + 4 * F.lane + 256 * j) = v[j];
            const float* m = mod + ((size_t)(layer + 1) * 5 + b) * 6144;
            row_modulate(v, rstd, F.in[I_NMG] + (layer + 1) * D, m, m + 1024, F.lane);
            row_store_bf16(HB + (size_t)row * D, v, F.lane);
        }
    }
    __syncthreads();
}

__device__ __forceinline__ void phase_pw1(Frame& F) {
    const bf16* HB = (const bf16*)(F.ws + WS_HB); const bf16* Wt = (const bf16*)(F.ws + WS_WPW1); bf16* U = (bf16*)(F.ws + WS_U);
    const float* bias = F.in[I_PW1B];
    RowLin rp{HB, (size_t)D};
    for (int u = F.wg; u < (T / 128) * 16; u += F.G) {
        const int mt = u / 16, nt = u % 16;
        auto epi = [&](int mb, int nb, const f32x16& c0, const f32x16& c1, int lane) {
            const int h = lane >> 5, cl = lane & 31, col = (nb >> 1) + cl; const float ba = bias[col], bg = bias[1024 + col];
#pragma unroll
            for (int i = 0; i < 16; ++i) U[(size_t)(mb + crow(i, h)) * D + col] = (bf16)f2bf((c0[i] + ba) * sigmoid_f(c1[i] + bg));
        };
        sgemm_tile(rp, Wt, D, mt * 128, nt * 128, epi, F.wave, F.lane);
    }
}
__device__ __forceinline__ void phase_dwconv(Frame& F) {
    const bf16* U = (const bf16*)(F.ws + WS_U); bf16* V1 = (bf16*)(F.ws + WS_V1);
    const float* dww = F.in[I_DWW]; const float* dwb = F.in[I_DWB]; const float* lng = F.in[I_LNG]; const float* lnb = F.in[I_LNB];
    const int gw = F.wg * NWAVES + F.wave, NGW = F.G * NWAVES;
    for (int row = gw; row < T; row += NGW) {
        const int l = row & (L - 1);
        f32x4 acc[4];
#pragma unroll
        for (int j = 0; j < 4; ++j) acc[j] = *(const f32x4*)(dwb + 4 * F.lane + 256 * j);
        for (int tp = 0; tp < CONVW; ++tp) { const int ll = l + tp - 15; if (ll < 0 || ll >= L) continue;
            const bf16* ur = U + (size_t)(row + tp - 15) * D; const float* wr = dww + (size_t)tp * D;
#pragma unroll
            for (int j = 0; j < 4; ++j) { const int o = 4 * F.lane + 256 * j; const u32x2 uu = *(const u32x2*)(ur + o); const f32x4 ww = *(const f32x4*)(wr + o);
                acc[j].x += bflo(uu.x) * ww.x; acc[j].y += bfhi(uu.x) * ww.y; acc[j].z += bflo(uu.y) * ww.z; acc[j].w += bfhi(uu.y) * ww.w; } }
        float s = 0.f;
#pragma unroll
        for (int j = 0; j < 4; ++j) s += (acc[j].x + acc[j].y) + (acc[j].z + acc[j].w);
        const float mean = wave_sum(s) * (1.f / D); float q = 0.f;
#pragma unroll
        for (int j = 0; j < 4; ++j) { acc[j] = acc[j] - mean; q += (acc[j].x * acc[j].x + acc[j].y * acc[j].y) + (acc[j].z * acc[j].z + acc[j].w * acc[j].w); }
        const float rstd = rsqrtf(wave_sum(q) * (1.f / D) + EPS);
#pragma unroll
        for (int j = 0; j < 4; ++j) { const int o = 4 * F.lane + 256 * j; const f32x4 gg = *(const f32x4*)(lng + o), bb = *(const f32x4*)(lnb + o);
            f32x4 y = acc[j] * rstd * gg + bb; y.x = silu_f(y.x); y.y = silu_f(y.y); y.z = silu_f(y.z); y.w = silu_f(y.w); acc[j] = y; }
        row_store_bf16(V1 + (size_t)row * D, acc, F.lane);
    }
}


namespace pg {
constexpr int BM = 256, BK = 64, HALF = 128, HTB = HALF * BK * 2, STAGE_BYTES = 8 * HTB;
constexpr int TAB_OFF = STAGE_BYTES;
__device__ __forceinline__ int lds_byte(int r, int c) { const int st = (r >> 4) * 2 + (c >> 5), rr = r & 15, cc = c & 31, ob = rr * 64 + cc * 2; return st * 1024 + (ob ^ (((ob >> 9) & 1) << 5)); }
__device__ __forceinline__ void stage_rc(int b, int& R, int& C) { const int st = b / 1024, sb = b % 1024, swz = sb ^ (((sb >> 9) & 1) << 5); R = (st >> 1) * 16 + swz / 64; C = (st & 1) * 32 + (swz % 64) / 2; }
__device__ __forceinline__ int perm32(int rho) { const int n = rho >> 4, i = rho & 15; return 8 * (i >> 2) + 4 * n + (i & 3); }
__device__ __forceinline__ unsigned cvt_pk_bf16(float lo, float hi) { unsigned r; asm volatile("v_cvt_pk_bf16_f32 %0, %1, %2" : "=v"(r) : "v"(lo), "v"(hi)); return r; }

struct GU { const char* B; int p0, p1, p2, p3; };

template <class Epi, class Sched>
__device__ __forceinline__ void gemm_phase(LAS unsigned char* lds, const char* Abase, const int K, const Sched& S, const Epi& E) {
    const int tid = threadIdx.x, wid = __builtin_amdgcn_readfirstlane(tid >> 6), lane = tid & 63, wr = wid >> 2, wc = wid & 3, fr = lane & 15, fq = lane >> 4;
    const int nt = K / BK;
    int sR[2], sC[2]; unsigned voffB[2];
#pragma unroll
    for (int i = 0; i < 2; ++i) { int R, C; stage_rc(tid * 16 + i * 8192, R, C); sR[i] = R; sC[i] = C; const int Rb = Epi::PERM ? ((R & ~31) + perm32(R & 31)) : R; voffB[i] = (unsigned)(Rb * K + C) * 2u; }
    const size_t kstep = (size_t)(BK * 2);
    const size_t hstep = (size_t)HALF * K * 2;
    const unsigned ldsw = (unsigned)wid * 1024u;
    const int aoff = lds_byte(wr * 64 + fr, fq * 8), boff = lds_byte(wc * 32 + fr, fq * 8);
#define PG_SA(b, h) (((b) * 2 + (h)) * HTB)
#define PG_SB(b, h) ((4 + (b) * 2 + (h)) * HTB)
#define PG_STAGE(bufoff, gbase, voff) do { _Pragma("unroll") for (int _i = 0; _i < 2; ++_i) \
        __builtin_amdgcn_global_load_lds((const unsigned*)((const char*)(gbase) + (voff)[_i]), (LAS unsigned*)(lds + (bufoff) + ldsw + _i * 8192), 16, 0, 0); } while (0)
#define PG_LDA(dst, b, h) do { _Pragma("unroll") for (int m = 0; m < 4; ++m) _Pragma("unroll") for (int k = 0; k < 2; ++k) dst[m][k] = *(const LAS bf16x8*)(lds + PG_SA(b, h) + aoff + m * 2048 + k * 1024); } while (0)
#define PG_LDB(dst, b, h) do { _Pragma("unroll") for (int n = 0; n < 2; ++n) _Pragma("unroll") for (int k = 0; k < 2; ++k) dst[n][k] = *(const LAS bf16x8*)(lds + PG_SB(b, h) + boff + n * 2048 + k * 1024); } while (0)
#define PG_MMA(ai, bj, At, Bt) do { __builtin_amdgcn_s_setprio(1); _Pragma("unroll") for (int m = 0; m < 4; ++m) _Pragma("unroll") for (int n = 0; n < 2; ++n) _Pragma("unroll") for (int k = 0; k < 2; ++k) \
        acc[ai][bj][m][n] = __builtin_amdgcn_mfma_f32_16x16x32_bf16(Bt[n][k], At[m][k], acc[ai][bj][m][n], 0, 0, 0); __builtin_amdgcn_s_setprio(0); } while (0)
#define PG_WAIT_V(n) asm volatile("s_waitcnt vmcnt(" #n ")" ::: "memory")
#define PG_WAIT_L(n) asm volatile("s_waitcnt lgkmcnt(" #n ")" ::: "memory")
#define PG_BAR __builtin_amdgcn_s_barrier()
#define PG_SCHED __builtin_amdgcn_sched_barrier(0)
    GU cur, nxt; int ui = 0;
    if (!S.next(0, cur)) return;
    f32x4 acc[2][2][4][2];
#pragma unroll
    for (int a = 0; a < 2; ++a)
#pragma unroll
        for (int b = 0; b < 2; ++b)
#pragma unroll
            for (int m = 0; m < 4; ++m)
#pragma unroll
                for (int n = 0; n < 2; ++n) acc[a][b][m][n] = (f32x4){0.f, 0.f, 0.f, 0.f};
    bf16x8 At[4][2], B0[2][2], B1[2][2];
    if constexpr (Sched::GATHER) { S.stage_table(cur, 0, lds, wid, lane); PG_WAIT_V(0); PG_BAR; }
    unsigned voC[2][2], voN[2][2];
#pragma unroll
    for (int h = 0; h < 2; ++h)
#pragma unroll
        for (int i = 0; i < 2; ++i) { voC[h][i] = S.voff(cur, 0, lds, h * HALF + sR[i], sC[i]); voN[h][i] = voC[h][i]; }
    const char* cB = cur.B;
    PG_STAGE(PG_SB(0, 0), cB, voffB); PG_STAGE(PG_SB(0, 1), cB + hstep, voffB); PG_STAGE(PG_SA(0, 0), Abase, voC[0]); PG_STAGE(PG_SA(0, 1), Abase, voC[1]);
    if (wr == 1) PG_BAR;
    PG_WAIT_V(2); PG_BAR;
    PG_STAGE(PG_SB(1, 0), cB + kstep, voffB); PG_STAGE(PG_SA(1, 0), Abase + kstep, voC[0]); PG_STAGE(PG_SB(1, 1), cB + hstep + kstep, voffB);
    PG_WAIT_V(6); PG_BAR;
    for (;;) {
        const bool has_next = S.next(ui + 1, nxt);
        if constexpr (Sched::GATHER) { if (has_next) S.stage_table(nxt, (ui + 1) & 1, lds, wid, lane); }
        const char* nB = has_next ? nxt.B : cB;
        for (int t = 0; t < nt; t += 2) {
            const bool last = (t == nt - 2);
            if (last && has_next) {
#pragma unroll
                for (int h = 0; h < 2; ++h)
#pragma unroll
                    for (int i = 0; i < 2; ++i) voN[h][i] = S.voff(nxt, (ui + 1) & 1, lds, h * HALF + sR[i], sC[i]);
            }
            unsigned vo2[2][2];
#pragma unroll
            for (int h = 0; h < 2; ++h)
#pragma unroll
                for (int i = 0; i < 2; ++i) vo2[h][i] = last ? voN[h][i] : voC[h][i];
            const char* a1 = Abase + (size_t)(t + 1) * kstep;
            const char* a2 = last ? Abase : Abase + (size_t)(t + 2) * kstep; const char* b2 = last ? nB : cB + (size_t)(t + 2) * kstep;
            const char* a3 = a2 + kstep; const char* b3 = b2 + kstep;
            PG_LDB(B0, 0, 0); PG_LDB(B1, 0, 1); PG_SCHED; PG_LDA(At, 0, 0); PG_STAGE(PG_SA(1, 1), a1, voC[1]);
            PG_WAIT_V(8); PG_WAIT_L(0); PG_BAR; PG_MMA(0, 0, At, B0); PG_MMA(0, 1, At, B1); PG_BAR; PG_SCHED;
            PG_LDA(At, 0, 1); PG_STAGE(PG_SB(0, 0), b2, voffB); PG_STAGE(PG_SB(0, 1), b2 + hstep, voffB); PG_STAGE(PG_SA(0, 0), a2, vo2[0]);
            PG_WAIT_V(8); PG_WAIT_L(0); PG_BAR; PG_MMA(1, 0, At, B0); PG_MMA(1, 1, At, B1); PG_BAR; PG_SCHED;
            PG_LDB(B0, 1, 0); PG_LDB(B1, 1, 1); PG_SCHED; PG_LDA(At, 1, 0); PG_STAGE(PG_SA(0, 1), a2, vo2[1]);
            PG_WAIT_V(8); PG_WAIT_L(0); PG_BAR; PG_MMA(0, 0, At, B0); PG_MMA(0, 1, At, B1); PG_BAR; PG_SCHED;
            PG_LDA(At, 1, 1); PG_STAGE(PG_SB(1, 0), b3, voffB); PG_STAGE(PG_SB(1, 1), b3 + hstep, voffB); PG_STAGE(PG_SA(1, 0), a3, vo2[0]);
            PG_WAIT_V(8); PG_WAIT_L(0); PG_BAR; PG_MMA(1, 0, At, B0); PG_MMA(1, 1, At, B1); PG_BAR; PG_SCHED;
        }
        if (wr == 0) PG_BAR;
        E(acc, cur, wr, wc, fr, fq);
        if (!has_next) break;
#pragma unroll
        for (int a = 0; a < 2; ++a)
#pragma unroll
            for (int b = 0; b < 2; ++b)
#pragma unroll
                for (int m = 0; m < 4; ++m)
#pragma unroll
                    for (int n = 0; n < 2; ++n) acc[a][b][m][n] = (f32x4){0.f, 0.f, 0.f, 0.f};
        cur = nxt; cB = nB; ++ui;
#pragma unroll
        for (int h = 0; h < 2; ++h)
#pragma unroll
            for (int i = 0; i < 2; ++i) voC[h][i] = voN[h][i];
        if (wr == 1) PG_BAR;
    }
    PG_WAIT_V(0);
    PG_BAR;
#undef PG_SA
#undef PG_SB
#undef PG_STAGE
#undef PG_LDA
#undef PG_LDB
#undef PG_MMA
#undef PG_WAIT_V
#undef PG_WAIT_L
#undef PG_BAR
#undef PG_SCHED
}

__device__ __forceinline__ void static_tile(int L, int nM, int nN, int& pm, int& pn) {
    const int nwg = nM * nN; int wgid = L; { const int q = nwg / 8, r = nwg % 8, xcd = wgid % 8, off = wgid / 8; wgid = (xcd < r ? xcd * (q + 1) : r * (q + 1) + (xcd - r) * q) + off; }
    const int nig = 8 * nN, gid = wgid / nig, fm = gid * 8, gsz = (nM - fm) < 8 ? (nM - fm) : 8;
    pm = fm + ((wgid % nig) % gsz); pn = (wgid % nig) / gsz;
}
struct DenseSched {
    static constexpr bool GATHER = false;
    const char* Bt; int K, nM, nN, G, c, xn, xm0, xpn;
    __device__ __forceinline__ bool next(int i, GU& u) const {
        const int L = i * G + c, nmain = nM * nN; int pm, pn;
        if (L < nmain) static_tile(L, nM, nN, pm, pn); else if (L < nmain + xn) { pm = xm0 + (L - nmain); pn = xpn; } else return false;
        u.B = Bt + (size_t)pn * BM * K * 2; u.p0 = pm; u.p1 = pn; u.p2 = 0; u.p3 = 0; return true;
    }
    __device__ __forceinline__ unsigned voff(const GU& u, int, LAS unsigned char*, int R, int C) const { return (unsigned)(((u.p0 * BM + R) * K + C) * 2); }
    __device__ __forceinline__ void stage_table(const GU&, int, LAS unsigned char*, int, int) const {}
};
template <bool GATHER_> struct MoeSched {
    static constexpr bool GATHER = GATHER_;
    const char* Wt; size_t wstride; int K; const int* list; LAS int* mm; int G, c;
    __device__ __forceinline__ bool next(int i, GU& u) const {
        int L = i * G + c;
        for (int e = 0; e < 16; ++e) { const int n = mm[e], nu = ((n + 255) >> 8) * 4;
            if (L < nu) { const int rt = L >> 2, pn = L & 3; u.B = Wt + (size_t)e * wstride + (size_t)pn * BM * K * 2; u.p0 = e; u.p1 = rt; u.p2 = pn; u.p3 = mm[16 + e]; return true; }
            L -= nu; }
        return false;
    }
    __device__ __forceinline__ unsigned voff(const GU& u, int buf, LAS unsigned char* lds, int R, int C) const {
        if constexpr (GATHER_) { const int tok = ((const LAS int*)(lds + TAB_OFF))[buf * 256 + R]; return (unsigned)((tok * K + C) * 2); }
        else return (unsigned)(((u.p3 + u.p1 * BM + R) * K + C) * 2);
    }
    __device__ __forceinline__ void stage_table(const GU& u, int buf, LAS unsigned char* lds, int wid, int lane) const {
        if constexpr (GATHER_) { const int r = (wid & 3) * 64 + lane;
            __builtin_amdgcn_global_load_lds((const unsigned*)(list + u.p0 * CAP + u.p1 * BM + r), (LAS unsigned*)(lds + TAB_OFF + buf * 1024 + (wid & 3) * 256), 4, 0, 0); }
    }
};

struct EpiInProj {
    static constexpr bool PERM = false;
    unsigned char* ws;
    __device__ __forceinline__ void operator()(const f32x4 (&acc)[2][2][4][2], const GU& u, int wr, int wc, int fr, int fq) const {
        const int pm = u.p0, pn = u.p1; const bool isctx = pm >= T / BM;
        float inv[4];
#pragma unroll
        for (int j = 0; j < 4; ++j) inv[j] = exp2f(-(float)(4 * fq + j) * (13.287712379549449f / 16.f));
#pragma unroll
        for (int bj = 0; bj < 2; ++bj) {
            const int cb = pn * BM + bj * HALF + wc * 32;
            bf16* dst; int pitch, cbase; bool rope = false;
            if (cb < 512) { dst = (bf16*)(ws + WS_UF); pitch = 512; cbase = 0; }
            else if (cb < 1024) { dst = (bf16*)(ws + WS_Q); pitch = 512; cbase = 512; rope = true; }
            else if (cb < 1152) { dst = isctx ? (bf16*)(ws + WS_CK) : (bf16*)(ws + WS_K); pitch = 128; cbase = 1024; rope = !isctx; }
            else { dst = isctx ? (bf16*)(ws + WS_CV) : (bf16*)(ws + WS_V); pitch = 128; cbase = 1152; }
            const bool bycol = ((cb >> 5) & 1) != 0;
#pragma unroll
            for (int ai = 0; ai < 2; ++ai)
#pragma unroll
                for (int m = 0; m < 4; ++m) {
                    const int row = pm * BM + ai * HALF + wr * 64 + m * 16 + fr;
                    f32x4 v0 = acc[ai][bj][m][0], v1 = acc[ai][bj][m][1];
                    if (rope) { const int l = row & (L - 1); const float pos = (float)(bycol ? (l & 63) : (l >> 6));
#pragma unroll
                        for (int j = 0; j < 4; ++j) { const float ang = pos * inv[j], cs = __cosf(ang), sn = __sinf(ang); const float x1 = v0[j], x2 = v1[j]; v0[j] = x1 * cs - x2 * sn; v1[j] = x1 * sn + x2 * cs; } }
                    const int orow = isctx ? row - T : row;
                    if (FAST_ATTN && cb >= 1152) {
                        const int kp = isctx ? CL : L, bb = isctx ? (orow >> 8) : (orow >> 13), key = isctx ? (orow & (CL - 1)) : (orow & (L - 1));
#pragma unroll
                        for (int n = 0; n < 2; ++n)
#pragma unroll
                            for (int j = 0; j < 4; ++j) { const int c = (cb - 1152) + 16 * n + 4 * fq + j;
                                dst[((size_t)bb * 128 + c) * kp + key] = (bf16)f2bf(n ? v1[j] : v0[j]); }
                        continue;
                    }
                    bf16* o = dst + (size_t)orow * pitch + (cb - cbase) + 4 * fq;
                    u32x2 w0, w1; w0.x = cvt_pk_bf16(v0[0], v0[1]); w0.y = cvt_pk_bf16(v0[2], v0[3]); w1.x = cvt_pk_bf16(v1[0], v1[1]); w1.y = cvt_pk_bf16(v1[2], v1[3]);
                    *(u32x2*)o = w0; *(u32x2*)(o + 16) = w1;
                }
        }
    }
};
struct EpiRes {
    static constexpr bool PERM = false;
    const float* base; float* X; const float* gate; const float* bias;
    __device__ __forceinline__ void operator()(const f32x4 (&acc)[2][2][4][2], const GU& u, int wr, int wc, int fr, int fq) const {
        const int row0 = u.p0 * BM + wr * 64 + fr, col0 = u.p1 * BM + wc * 32 + 4 * fq; const int b = (u.p0 * BM) >> 13;
        f32x4 gv[2][2], bv[2][2];
#pragma unroll
        for (int bj = 0; bj < 2; ++bj)
#pragma unroll
            for (int n = 0; n < 2; ++n) { gv[bj][n] = *(const f32x4*)(gate + (size_t)b * 6144 + col0 + bj * HALF + n * 16); bv[bj][n] = bias ? *(const f32x4*)(bias + col0 + bj * HALF + n * 16) : (f32x4){0.f, 0.f, 0.f, 0.f}; }
#pragma unroll
        for (int ai = 0; ai < 2; ++ai)
#pragma unroll
            for (int m = 0; m < 4; ++m) { const size_t off = (size_t)(row0 + ai * HALF + m * 16) * D + col0;
#pragma unroll
                for (int bj = 0; bj < 2; ++bj)
#pragma unroll
                    for (int n = 0; n < 2; ++n) { const f32x4 bs = *(const f32x4*)(base + off + bj * HALF + n * 16); *(f32x4*)(X + off + bj * HALF + n * 16) = bs + gv[bj][n] * (acc[ai][bj][m][n] + bv[bj][n]); }
                asm volatile("" ::: "memory"); }
    }
};
struct EpiGLU {
    static constexpr bool PERM = true;
    bf16* U; const float* bias;
    __device__ __forceinline__ void operator()(const f32x4 (&acc)[2][2][4][2], const GU& u, int wr, int wc, int fr, int fq) const {
        const int row0 = u.p0 * BM + wr * 64 + fr, col0 = u.p1 * HALF + wc * 32 + 8 * fq;
        f32x4 ba[2], bg[2];
#pragma unroll
        for (int n = 0; n < 2; ++n) { ba[n] = *(const f32x4*)(bias + col0 + 4 * n); bg[n] = *(const f32x4*)(bias + 1024 + col0 + 4 * n); }
#pragma unroll
        for (int ai = 0; ai < 2; ++ai)
#pragma unroll
            for (int m = 0; m < 4; ++m) { f32x4 o[2];
#pragma unroll
                for (int n = 0; n < 2; ++n) { const f32x4 a = acc[ai][0][m][n] + ba[n], g = acc[ai][1][m][n] + bg[n];
#pragma unroll
                    for (int j = 0; j < 4; ++j) o[n][j] = a[j] * sigmoid_f(g[j]); }
                u32x4 w; w.x = cvt_pk_bf16(o[0][0], o[0][1]); w.y = cvt_pk_bf16(o[0][2], o[0][3]); w.z = cvt_pk_bf16(o[1][0], o[1][1]); w.w = cvt_pk_bf16(o[1][2], o[1][3]);
                *(u32x4*)(U + (size_t)(row0 + ai * HALF + m * 16) * D + col0) = w; }
    }
};
struct EpiGateUp {
    static constexpr bool PERM = true;
    bf16* HID; const float* slot_w; LAS int* mm;
    __device__ __forceinline__ void operator()(const f32x4 (&acc)[2][2][4][2], const GU& u, int wr, int wc, int fr, int fq) const {
        const int e = u.p0, n_e = mm[e], r0 = u.p1 * BM + wr * 64 + fr, col0 = u.p2 * HALF + wc * 32 + 8 * fq;
#pragma unroll
        for (int ai = 0; ai < 2; ++ai)
#pragma unroll
            for (int m = 0; m < 4; ++m) { const int r = r0 + ai * HALF + m * 16;
                if (r < n_e) { const float w = slot_w[e * CAP + r]; f32x4 o[2];
#pragma unroll
                    for (int n = 0; n < 2; ++n) { const f32x4 g = acc[ai][0][m][n], up = acc[ai][1][m][n];
#pragma unroll
                        for (int j = 0; j < 4; ++j) o[n][j] = w * silu_f(g[j]) * up[j]; }
                    u32x4 q; q.x = cvt_pk_bf16(o[0][0], o[0][1]); q.y = cvt_pk_bf16(o[0][2], o[0][3]); q.z = cvt_pk_bf16(o[1][0], o[1][1]); q.w = cvt_pk_bf16(o[1][2], o[1][3]);
                    *(u32x4*)(HID + (size_t)(u.p3 + r) * FF + col0) = q; } }
    }
};
struct EpiDown {
    static constexpr bool PERM = true;
    bf16* Y; LAS int* mm;
    __device__ __forceinline__ void operator()(const f32x4 (&acc)[2][2][4][2], const GU& u, int wr, int wc, int fr, int fq) const {
        const int e = u.p0, n_e = mm[e], r0 = u.p1 * BM + wr * 64 + fr, col0 = u.p2 * BM + wc * 32 + 8 * fq;
#pragma unroll
        for (int ai = 0; ai < 2; ++ai)
#pragma unroll
            for (int m = 0; m < 4; ++m) { const int r = r0 + ai * HALF + m * 16;
                if (r < n_e) {
#pragma unroll
                    for (int bj = 0; bj < 2; ++bj) { const f32x4 v0 = acc[ai][bj][m][0], v1 = acc[ai][bj][m][1];
                        u32x4 q; q.x = cvt_pk_bf16(v0[0], v0[1]); q.y = cvt_pk_bf16(v0[2], v0[3]); q.z = cvt_pk_bf16(v1[0], v1[1]); q.w = cvt_pk_bf16(v1[2], v1[3]);
                        *(u32x4*)(Y + (size_t)(u.p3 + r) * D + col0 + bj * HALF) = q; } } }
    }
};
}

__device__ __forceinline__ void fast_inproj(Frame& F) {
    pg::DenseSched S{(const char*)(F.ws + WS_WIN), D, T / 256, N_IN / 256, F.G, F.wg, TC / 256, T / 256, 4};
    pg::EpiInProj E{F.ws};
    pg::gemm_phase(F.lds, (const char*)(F.ws + WS_HB), D, S, E);
}
__device__ __forceinline__ void fast_outproj(Frame& F, size_t a_off, size_t w_off, const float* base, float* X, const float* gate, const float* bias) {
    pg::DenseSched S{(const char*)(F.ws + w_off), D, T / 256, D / 256, F.G, F.wg, 0, 0, 0};
    pg::EpiRes E{base, X, gate, bias};
    pg::gemm_phase(F.lds, (const char*)(F.ws + a_off), D, S, E);
}
__device__ __forceinline__ void fast_pw1(Frame& F) {
    pg::DenseSched S{(const char*)(F.ws + WS_WPW1), D, T / 256, 2048 / 256, F.G, F.wg, 0, 0, 0};
    pg::EpiGLU E{(bf16*)(F.ws + WS_U), F.in[I_PW1B]};
    pg::gemm_phase(F.lds, (const char*)(F.ws + WS_HB), D, S, E);
}
__device__ __forceinline__ void fast_moe_gateup(Frame& F, int layer) {
    LAS int* mm = moe_map(F, layer);
    pg::MoeSched<true> S{(const char*)(F.ws + WS_WGU) + (size_t)layer * 16 * 1024 * 1024 * 2, (size_t)1024 * 1024 * 2, D, (const int*)(F.ws + WS_SLOTT) + layer * 16 * CAP, mm, F.G, F.wg};
    pg::EpiGateUp E{(bf16*)(F.ws + WS_HID), (const float*)(F.ws + WS_SLOTW) + layer * 16 * CAP, mm};
    pg::gemm_phase(F.lds, (const char*)(F.ws + WS_HB), D, S, E);
}
__device__ __forceinline__ void fast_moe_down(Frame& F, int layer) {
    LAS int* mm = moe_map(F, layer);
    pg::MoeSched<false> S{(const char*)(F.ws + WS_WDN) + (size_t)layer * 16 * 1024 * 512 * 2, (size_t)1024 * 512 * 2, FF, nullptr, mm, F.G, F.wg};
    pg::EpiDown E{(bf16*)(F.ws + WS_Y), mm};
    pg::gemm_phase(F.lds, (const char*)(F.ws + WS_HID), FF, S, E);
}


typedef __bf16 b16x2_t __attribute__((ext_vector_type(2)));
__device__ __forceinline__ unsigned pkbf(float a, float b) { typedef float f2 __attribute__((ext_vector_type(2))); f2 v = {a, b}; return __builtin_bit_cast(unsigned, __builtin_convertvector(v, b16x2_t)); }
struct AttnBlk { const bf16* kp; const bf16* vp; int pitch; int kb; bool valid, masked; };
__device__ __forceinline__ AttnBlk attn_blk(const unsigned char* ws, int bi, int b, int kvh, int qs) {
    AttnBlk a;
    if (bi < 8) { a.kp = (const bf16*)(ws + WS_CK) + (size_t)(b * CL + bi * 32) * 128 + kvh * 64; a.vp = (const bf16*)(ws + WS_CV) + (size_t)(b * 2 + kvh) * 64 * CL + bi * 32; a.pitch = CL; a.kb = 0; a.valid = true; a.masked = false; }
    else { const int kb = qs - 128 + 32 * (bi - 8); a.valid = (kb >= 0 && kb < L); a.kb = kb; a.masked = true; a.pitch = L;
        a.kp = (const bf16*)(ws + WS_K) + (size_t)(b * L + kb) * 128 + kvh * 64; a.vp = (const bf16*)(ws + WS_V) + (size_t)(b * 2 + kvh) * 64 * L + kb; }
    return a;
}
__device__ __forceinline__ void attn_load(const AttnBlk& a, int r, int h, bf16x8 (&kf)[4], u32x4 (&vf)[2][2]) {
    if (a.valid) {
#pragma unroll
        for (int s = 0; s < 4; ++s) kf[s] = *(const bf16x8*)(a.kp + (size_t)r * 128 + 16 * s + 8 * h);
#pragma unroll
        for (int db = 0; db < 2; ++db)
#pragma unroll
            for (int ks = 0; ks < 2; ++ks) { const bf16* vr = a.vp + (size_t)(32 * db + r) * a.pitch + 16 * ks + 4 * h;
                const u32x2 lo = *(const u32x2*)vr, hi = *(const u32x2*)(vr + 8); vf[db][ks] = (u32x4){lo.x, lo.y, hi.x, hi.y}; }
    }
}
__device__ __forceinline__ void attn_compute(const AttnBlk& a, int qs, int r, int h, const bf16x8 (&kf)[4], const u32x4 (&vf)[2][2], const bf16x8 (&qf)[2][4],
                                             f32x16 (&o)[2][2], float (&m)[2], float (&l)[2]) {
    if (!a.valid) return;
#pragma unroll
    for (int nq = 0; nq < 2; ++nq) {
        f32x16 st;
#pragma unroll
        for (int i = 0; i < 16; ++i) st[i] = 0.f;
#pragma unroll
        for (int s = 0; s < 4; ++s) st = __builtin_amdgcn_mfma_f32_32x32x16_bf16(kf[s], qf[nq][s], st, 0, 0, 0);
        float t[16]; float tmax = -INFINITY;
        const int dbase = a.kb - qs - 32 * nq - r + 4 * h;
#pragma unroll
        for (int i = 0; i < 16; ++i) { float v = st[i] * (0.125f * 1.4426950408889634f);
            if (a.masked) { const int df = dbase + (i & 3) + 8 * (i >> 2); v = (df >= -128 && df <= 128) ? v : -INFINITY; }
            t[i] = v; tmax = fmaxf(tmax, v); }
        tmax = fmaxf(tmax, __shfl_xor(tmax, 32));
        const float mn = fmaxf(m[nq], tmax), alpha = __builtin_amdgcn_exp2f(m[nq] - mn); m[nq] = mn;
        float ps = 0.f;
#pragma unroll
        for (int i = 0; i < 16; ++i) { t[i] = __builtin_amdgcn_exp2f(t[i] - mn); ps += t[i]; }
        l[nq] = l[nq] * alpha + ps;
#pragma unroll
        for (int i = 0; i < 16; ++i) { o[0][nq][i] *= alpha; o[1][nq][i] *= alpha; }
        bf16x8 pf[2];
#pragma unroll
        for (int ks = 0; ks < 2; ++ks) { const u32x4 w = {pkbf(t[8 * ks], t[8 * ks + 1]), pkbf(t[8 * ks + 2], t[8 * ks + 3]), pkbf(t[8 * ks + 4], t[8 * ks + 5]), pkbf(t[8 * ks + 6], t[8 * ks + 7])};
            pf[ks] = __builtin_bit_cast(bf16x8, w); }
#pragma unroll
        for (int db = 0; db < 2; ++db)
#pragma unroll
            for (int ks = 0; ks < 2; ++ks) o[db][nq] = __builtin_amdgcn_mfma_f32_32x32x16_bf16(__builtin_bit_cast(bf16x8, vf[db][ks]), pf[ks], o[db][nq], 0, 0, 0);
    }
}
__device__ __forceinline__ void phase_attn_mfma(Frame& F) {
    const bf16* Q = (const bf16*)(F.ws + WS_Q); bf16* MIX = (bf16*)(F.ws + WS_MIX);
    const int g = F.wave >> 1, half = F.wave & 1, r = F.lane & 31, h = F.lane >> 5;
    for (int item = F.wg; item < NB * 2 * 64; item += F.G) {
        const int qb = item & 63, kvh = (item >> 6) & 1, b = item >> 7, hd = kvh * 4 + g, qs = qb * 128 + half * 64;
        bf16x8 qf[2][4];
#pragma unroll
        for (int nq = 0; nq < 2; ++nq)
#pragma unroll
            for (int s = 0; s < 4; ++s) qf[nq][s] = *(const bf16x8*)(Q + (size_t)(b * L + qs + 32 * nq + r) * 512 + hd * 64 + 16 * s + 8 * h);
        f32x16 o[2][2];
#pragma unroll
        for (int db = 0; db < 2; ++db)
#pragma unroll
            for (int nq = 0; nq < 2; ++nq)
#pragma unroll
                for (int i = 0; i < 16; ++i) o[db][nq][i] = 0.f;
        float m[2], l[2];
        m[0] = m[1] = F.in[I_SINK][hd] * 1.4426950408889634f; l[0] = l[1] = (h == 0) ? 1.f : 0.f;
        bf16x8 kfA[4], kfB[4]; u32x4 vfA[2][2], vfB[2][2];
        AttnBlk ba = attn_blk(F.ws, 0, b, kvh, qs), bb;
        attn_load(ba, r, h, kfA, vfA);
#pragma unroll 1
        for (int bi = 0; bi < 18; bi += 2) {
            bb = attn_blk(F.ws, bi + 1, b, kvh, qs); attn_load(bb, r, h, kfB, vfB);
            attn_compute(ba, qs, r, h, kfA, vfA, qf, o, m, l);
            if (bi + 2 < 18) { ba = attn_blk(F.ws, bi + 2, b, kvh, qs); attn_load(ba, r, h, kfA, vfA); }
            attn_compute(bb, qs, r, h, kfB, vfB, qf, o, m, l);
        }
#pragma unroll
        for (int nq = 0; nq < 2; ++nq) {
            const float lt = l[nq] + __shfl_xor(l[nq], 32), il = 1.f / lt;
            bf16* orow = MIX + (size_t)(b * L + qs + 32 * nq + r) * 1024 + 512 + hd * 64;
#pragma unroll
            for (int db = 0; db < 2; ++db)
#pragma unroll
                for (int i4 = 0; i4 < 4; ++i4) { u32x2 w; w.x = pkbf(o[db][nq][4 * i4] * il, o[db][nq][4 * i4 + 1] * il); w.y = pkbf(o[db][nq][4 * i4 + 2] * il, o[db][nq][4 * i4 + 3] * il);
                    *(u32x2*)(orow + 32 * db + 8 * i4 + 4 * h) = w; }
        }
    }
}


constexpr int F1_PC = 136, F1_PW = 68, F2_P = 264;
constexpr int F1_CSC = 0, F1_CSS = 128 * F1_PC * 2, F1_C64 = 2 * 128 * F1_PC * 2, F1_S64 = F1_C64 + 64 * F1_PW * 2;
__device__ __forceinline__ bf16x8 pack8(float a0, float a1, float a2, float a3, float a4, float a5, float a6, float a7) {
    const u32x4 w = {pkbf(a0, a1), pkbf(a2, a3), pkbf(a4, a5), pkbf(a6, a7)}; return __builtin_bit_cast(bf16x8, w); }
__device__ __forceinline__ void phase_fft1_mfma(Frame& F) {
    __syncthreads();
    LAS bf16* csc = (LAS bf16*)(F.lds + F1_CSC); LAS bf16* css = (LAS bf16*)(F.lds + F1_CSS); LAS bf16* c64 = (LAS bf16*)(F.lds + F1_C64); LAS bf16* s64 = (LAS bf16*)(F.lds + F1_S64);
    for (int i = F.tid; i < 128 * 128; i += NTHR) { const int n = i >> 7, k = i & 127; const float ang = (float)((n * k) & 127) * (6.283185307179586f / 128.f);
        csc[n * F1_PC + k] = (bf16)f2bf(__cosf(ang)); css[n * F1_PC + k] = (bf16)f2bf(__sinf(ang)); }
    for (int i = F.tid; i < 64 * 64; i += NTHR) { const int c = i >> 6, a = i & 63; const float ang = (float)((c * a) & 63) * (6.283185307179586f / 64.f);
        c64[c * F1_PW + a] = (bf16)f2bf(__cosf(ang)); s64[c * F1_PW + a] = (bf16)f2bf(__sinf(ang)); }
    __syncthreads();
    const bf16* UF = (const bf16*)(F.ws + WS_UF); bf16* Gb = (bf16*)(F.ws + WS_G);
    const int r = F.lane & 31, h = F.lane >> 5, g = F.wave >> 1;
    for (int item = F.wg; item < NB * FN2; item += F.G) {
        const int b = item >> 7, bp = item & 127;
#pragma unroll 1
        for (int q = 0; q < 2; ++q) {
            const int cbk = 2 * F.wave + q, n = 32 * (cbk & 3) + r, ch = 32 * cbk + r;
            f32x16 zr[2], zi[2];
#pragma unroll
            for (int rb = 0; rb < 2; ++rb) {
                bf16x8 uf[8];
#pragma unroll
                for (int s2 = 0; s2 < 8; ++s2) uf[s2] = *(const bf16x8*)(UF + (size_t)(b * L + 128 * (32 * rb + r) + bp) * 512 + g * 128 + 16 * s2 + 8 * h);
#pragma unroll
                for (int i = 0; i < 16; ++i) { zr[rb][i] = 0.f; zi[rb][i] = 0.f; }
#pragma unroll
                for (int s2 = 0; s2 < 8; ++s2) { const bf16x8 bc = *(const LAS bf16x8*)(csc + n * F1_PC + 16 * s2 + 8 * h), bs = *(const LAS bf16x8*)(css + n * F1_PC + 16 * s2 + 8 * h);
                    zr[rb] = __builtin_amdgcn_mfma_f32_32x32x16_bf16(uf[s2], bc, zr[rb], 0, 0, 0); zi[rb] = __builtin_amdgcn_mfma_f32_32x32x16_bf16(uf[s2], bs, zi[rb], 0, 0, 0); }
                __builtin_amdgcn_sched_barrier(0);
            }
            bf16x8 zfr[4], zfi[4];
#pragma unroll
            for (int ks = 0; ks < 4; ++ks) { const int rb = ks >> 1, o = 8 * (ks & 1);
                zfr[ks] = pack8(zr[rb][o], zr[rb][o + 1], zr[rb][o + 2], zr[rb][o + 3], zr[rb][o + 4], zr[rb][o + 5], zr[rb][o + 6], zr[rb][o + 7]);
                zfi[ks] = pack8(-zi[rb][o], -zi[rb][o + 1], -zi[rb][o + 2], -zi[rb][o + 3], -zi[rb][o + 4], -zi[rb][o + 5], -zi[rb][o + 6], -zi[rb][o + 7]); }
            __builtin_amdgcn_sched_barrier(0);
#pragma unroll 1
            for (int rbc = 0; rbc < 2; ++rbc) {
                f32x16 gr, gi; const int cr = 32 * rbc + r;
#pragma unroll
                for (int i = 0; i < 16; ++i) { gr[i] = 0.f; gi[i] = 0.f; }
#pragma unroll
                for (int ks = 0; ks < 4; ++ks) {
                    const u32x2 cl = *(const LAS u32x2*)(c64 + cr * F1_PW + 16 * ks + 4 * h), chh = *(const LAS u32x2*)(c64 + cr * F1_PW + 16 * ks + 8 + 4 * h);
                    const u32x2 sl = *(const LAS u32x2*)(s64 + cr * F1_PW + 16 * ks + 4 * h), shh = *(const LAS u32x2*)(s64 + cr * F1_PW + 16 * ks + 8 + 4 * h);
                    const u32x4 sw = {sl.x, sl.y, shh.x, shh.y}; const u32x4 swn = sw ^ 0x80008000u;
                    const bf16x8 wc = __builtin_bit_cast(bf16x8, ((u32x4){cl.x, cl.y, chh.x, chh.y})), wsn = __builtin_bit_cast(bf16x8, sw), wsm = __builtin_bit_cast(bf16x8, swn);
                    gr = __builtin_amdgcn_mfma_f32_32x32x16_bf16(wc, zfr[ks], gr, 0, 0, 0); gr = __builtin_amdgcn_mfma_f32_32x32x16_bf16(wsn, zfi[ks], gr, 0, 0, 0);
                    gi = __builtin_amdgcn_mfma_f32_32x32x16_bf16(wc, zfi[ks], gi, 0, 0, 0); gi = __builtin_amdgcn_mfma_f32_32x32x16_bf16(wsm, zfr[ks], gi, 0, 0, 0); }
                __builtin_amdgcn_sched_barrier(0);
#pragma unroll
                for (int i = 0; i < 16; ++i) { const int c = 32 * rbc + crow(i, h); const float ang = (float)(bp * c) * (6.283185307179586f / 8192.f), cs = __cosf(ang), sn = __sinf(ang);
                    const float re = gr[i] * cs + gi[i] * sn, im = gi[i] * cs - gr[i] * sn;
                    bf16* o = Gb + (size_t)((b * FN1 + c) * FN2 + bp) * 1024 + ch; o[0] = (bf16)f2bf(re); o[512] = (bf16)f2bf(im);
                    if ((i & 3) == 3) __builtin_amdgcn_sched_barrier(0); }
            }
        }
    }
    __syncthreads();
}
__device__ __forceinline__ void phase_fft2_mfma(Frame& F) {
    __syncthreads();
    LAS bf16* t2 = (LAS bf16*)F.lds;
    for (int i = F.tid; i < 128 * 256; i += NTHR) { const int d = i >> 8, k = i & 255; const float ang = (float)((d * (k & 127)) & 127) * (6.283185307179586f / 128.f);
        t2[d * F2_P + k] = (bf16)f2bf(k < 128 ? __cosf(ang) : __sinf(ang)); }
    __syncthreads();
    const bf16* Gb = (const bf16*)(F.ws + WS_G); bf16* MIX = (bf16*)(F.ws + WS_MIX);
    const int r = F.lane & 31, h = F.lane >> 5;
    for (int item = F.wg; item < NB * FN1; item += F.G) {
        const int b = item >> 6, c = item & 63;
        const bf16* Gp = Gb + (size_t)((b * FN1 + c) * FN2) * 1024 + 64 * F.wave + r;
        f32x16 y[4][2];
#pragma unroll
        for (int rb = 0; rb < 4; ++rb)
#pragma unroll
            for (int cb = 0; cb < 2; ++cb)
#pragma unroll
                for (int i = 0; i < 16; ++i) y[rb][cb][i] = 0.f;
#pragma unroll 1
        for (int ks = 0; ks < 16; ++ks) {
            const bf16* p = Gp + (size_t)(16 * (ks & 7) + 8 * h) * 1024 + (ks >> 3) * 512;
            bf16x8 bfr[2];
#pragma unroll
            for (int cb = 0; cb < 2; ++cb) { unsigned e[8];
#pragma unroll
                for (int j = 0; j < 8; ++j) e[j] = p[(size_t)j * 1024 + 32 * cb];
                const u32x4 w = {e[0] | (e[1] << 16), e[2] | (e[3] << 16), e[4] | (e[5] << 16), e[6] | (e[7] << 16)}; bfr[cb] = __builtin_bit_cast(bf16x8, w); }
#pragma unroll
            for (int rb = 0; rb < 4; ++rb) { const bf16x8 a = *(const LAS bf16x8*)(t2 + (32 * rb + r) * F2_P + 16 * ks + 8 * h);
#pragma unroll
                for (int cb = 0; cb < 2; ++cb) y[rb][cb] = __builtin_amdgcn_mfma_f32_32x32x16_bf16(a, bfr[cb], y[rb][cb], 0, 0, 0); }
        }
#pragma unroll
        for (int rb = 0; rb < 4; ++rb)
#pragma unroll
            for (int cb = 0; cb < 2; ++cb)
#pragma unroll
                for (int i = 0; i < 16; ++i) { const int d = 32 * rb + crow(i, h); MIX[(size_t)(b * L + c + 64 * d) * 1024 + 64 * F.wave + 32 * cb + r] = (bf16)f2bf(y[rb][cb][i] * (1.f / 1024.f)); }
    }
    __syncthreads();
}

constexpr int NPH = 18;
__global__ void __launch_bounds__(NTHR, 2) mega(Args args) {
    extern __shared__ __attribute__((aligned(16))) unsigned char lds[];
    Frame F;
    F.lds = (LAS unsigned char*)lds;
    F.tid = threadIdx.x; F.lane = F.tid & 63; F.wave = __builtin_amdgcn_readfirstlane(F.tid >> 6);
    F.G = gridDim.x; F.wg = blockIdx.x;
    F.in = args.in; F.out = args.out; F.ws = args.ws; F.ctl = (unsigned*)(args.ws + WS_CTL);
    volatile LAS unsigned* bst = (volatile LAS unsigned*)(F.lds + LDS_BYTES - 16);
    if (F.tid < 4) bst[F.tid] = 0u;
    __syncthreads();
    const int lo = args.ph_lo, hi = args.ph_hi;
    XcdBarrier bar; bar.bar = F.ctl + CW_BAR; bar.x = 0; bar.st = bst;
    if (hi - lo > 1) bar = xcd_barrier_post(F.ctl + CW_BAR, bst);
#define IN(k) (lo <= (k) && (k) < hi)
#define SEAM(k) do { if (IN(k) && IN((k) + 1)) xcd_barrier(bar); } while (0)
    const float* mod = (const float*)(F.ws + WS_MOD);

    if (IN(0)) { phase_prep(F); } SEAM(0);
    if (IN(1)) { phase_norm1_l0(F); } SEAM(1);
    if (IN(2)) { if (FAST_GEMM) fast_inproj(F); else phase_inproj(F); } SEAM(2);
    if (IN(3)) { if (FAST_ATTN && FAST_GEMM) phase_attn_mfma(F); else phase_attn_simple(F); if (FAST_FFT) phase_fft1_mfma(F); else phase_fft1_simple(F); } SEAM(3);
    if (IN(4)) { if (FAST_FFT) phase_fft2_mfma(F); else phase_fft2_simple(F); } SEAM(4);
    if (IN(5)) { if (!FAST_FFT) phase_fft3_simple(F); } if (!FAST_FFT) SEAM(5);
    if (IN(6)) { if (FAST_GEMM) fast_outproj(F, WS_MIX, WS_WOUT, F.in[I_X], F.out, mod + 2048, nullptr); else phase_outproj(F, (const bf16*)(F.ws + WS_MIX), (const bf16*)(F.ws + WS_WOUT), F.in[I_X], F.out, mod + 2048, nullptr); } SEAM(6);
    if (IN(7)) { phase_norm2_route(F, 0); } SEAM(7);
    if (IN(8)) { if (FAST_GEMM) fast_moe_gateup(F, 0); else phase_moe_gateup(F, 0); } SEAM(8);
    if (IN(9)) { if (FAST_GEMM) fast_moe_down(F, 0); else phase_moe_down(F, 0); } SEAM(9);
    if (IN(10)) { phase_combine<false>(F, 0); } SEAM(10);
    if (IN(11)) { if (FAST_GEMM) fast_pw1(F); else phase_pw1(F); } SEAM(11);
    if (IN(12)) { phase_dwconv(F); } SEAM(12);
    if (IN(13)) { if (FAST_GEMM) fast_outproj(F, WS_V1, WS_WPW2, F.out, F.out, mod + 5 * 6144 + 2048, F.in[I_PW2B]); else phase_outproj(F, (const bf16*)(F.ws + WS_V1), (const bf16*)(F.ws + WS_WPW2), F.out, F.out, mod + 5 * 6144 + 2048, F.in[I_PW2B]); } SEAM(13);
    if (IN(14)) { phase_norm2_route(F, 1); } SEAM(14);
    if (IN(15)) { if (FAST_GEMM) fast_moe_gateup(F, 1); else phase_moe_gateup(F, 1); } SEAM(15);
    if (IN(16)) { if (FAST_GEMM) fast_moe_down(F, 1); else phase_moe_down(F, 1); } SEAM(16);
    if (IN(17)) { phase_combine<true>(F, 1); }
#undef IN
#undef SEAM
}

extern "C" void kernel_launch(void* const* d_in, const int* in_sizes, int n_in, void* d_out, int out_size, void* d_ws, size_t ws_size, hipStream_t stream) {
    static int grid = 0;
    if (grid == 0) {
        if (n_in != 25 || out_size != T * D || ws_size < WS_END) { fprintf(stderr, "kernel_launch: unexpected shapes (n_in %d out %d ws %zu)\n", n_in, out_size, ws_size); grid = -1; return; }
        int dev = 0, cus = 0, per_cu = 0;
        if (hipGetDevice(&dev) != hipSuccess || hipDeviceGetAttribute(&cus, hipDeviceAttributeMultiprocessorCount, dev) != hipSuccess) { grid = -1; return; }
        if (hipFuncSetAttribute((const void*)mega, hipFuncAttributeMaxDynamicSharedMemorySize, LDS_BYTES) != hipSuccess) { fprintf(stderr, "kernel_launch: hipFuncSetAttribute failed\n"); grid = -1; return; }
        if (hipOccupancyMaxActiveBlocksPerMultiprocessor(&per_cu, (const void*)mega, NTHR, LDS_BYTES) != hipSuccess || per_cu < 1) { fprintf(stderr, "kernel_launch: occupancy query says %d\n", per_cu); }
        (void)hipGetLastError();
        grid = cus;
    }
    if (grid < 0) return;
    (void)hipMemsetAsync((char*)d_ws + WS_CTL, 0, CTL_BYTES, stream);
    Args a{};
    for (int i = 0; i < 25; ++i) a.in[i] = (const float*)d_in[i];
    a.out = (float*)d_out; a.ws = (unsigned char*)d_ws;
#if MK_ONE_LAUNCH
    a.ph_lo = 0; a.ph_hi = NPH;
    hipLaunchKernelGGL(mega, dim3(grid), dim3(NTHR), LDS_BYTES, stream, a);
#else
    for (int p = 0; p < NPH; ++p) { a.ph_lo = p; a.ph_hi = p + 1; hipLaunchKernelGGL(mega, dim3(grid), dim3(NTHR), LDS_BYTES, stream, a); }
#endif
}
```

```cpp
#include <hip/hip_runtime.h>
#include <cstdio>

#ifndef MK_ONE_LAUNCH
#define MK_ONE_LAUNCH 1
#endif

#define GAS __attribute__((address_space(1)))
#define LAS __attribute__((address_space(3)))
typedef unsigned short bf16;
typedef short bf16x8 __attribute__((ext_vector_type(8)));
typedef float f32x4 __attribute__((ext_vector_type(4)));
typedef float f32x16 __attribute__((ext_vector_type(16)));
typedef unsigned u32x4 __attribute__((ext_vector_type(4)));
typedef unsigned u32x2 __attribute__((ext_vector_type(2)));

constexpr int D = 1024, NB = 4, L = 8192, T = NB * L, CL = 256, TC = NB * CL;
constexpr int NE = 16, FF = 512, CONVW = 31;
constexpr int N_IN = 1280;
constexpr int FN1 = 64, FN2 = 128;
#ifndef FAST_GEMM
#define FAST_GEMM 1
#endif
#ifndef FAST_ATTN
#define FAST_ATTN 1
#endif
#ifndef FAST_FFT
#define FAST_FFT 1
#endif
constexpr int IL = FAST_GEMM ? 128 : 32;
constexpr float EPS = 1e-6f;
constexpr int NWAVES = 8, NTHR = 512;
constexpr int CAP = 32768;
constexpr int HROWS = 65536 + 4096;

constexpr size_t MiB = 1u << 20;
constexpr size_t WS_CTL = 0, CTL_BYTES = 1 * MiB;
constexpr size_t WS_MOD = 1 * MiB;
constexpr size_t WS_TW = 1 * MiB + 512 * 1024;
constexpr size_t WS_WIN = 2 * MiB, WS_WOUT = 6 * MiB, WS_WPW1 = 10 * MiB, WS_WPW2 = 14 * MiB;
constexpr size_t WS_WGU = 16 * MiB, WS_WDN = 80 * MiB;
constexpr size_t WS_TOKE = 112 * MiB, WS_TOKP = 113 * MiB, WS_TOKW = 114 * MiB;
constexpr size_t WS_SLOTT = 116 * MiB, WS_SLOTW = 120 * MiB;
constexpr size_t WS_HB = 128 * MiB;
constexpr size_t WS_UF = 196 * MiB, WS_Q = 228 * MiB, WS_K = 260 * MiB, WS_V = 268 * MiB, WS_CK = 276 * MiB, WS_CV = 277 * MiB;
constexpr size_t WS_G = 280 * MiB, WS_MIX = 344 * MiB, WS_AB = 408 * MiB;
constexpr size_t WS_HID = 196 * MiB, WS_Y = 264 * MiB;
constexpr size_t WS_U = 196 * MiB, WS_V1 = 260 * MiB;
constexpr size_t WS_END = 472 * MiB;
constexpr int CW_BAR = 4096;
constexpr int CW_CNT = 8192;

constexpr int LDS_BYTES = 147456;

__device__ __forceinline__ unsigned f2bf(float f) { unsigned u = __float_as_uint(f); return (u + 0x7fffu + ((u >> 16) & 1u)) >> 16; }
__device__ __forceinline__ float bf2f(unsigned b) { return __uint_as_float(b << 16); }
__device__ __forceinline__ unsigned pk2(float lo, float hi) { return f2bf(lo) | (f2bf(hi) << 16); }
__device__ __forceinline__ float bflo(unsigned w) { return __uint_as_float(w << 16); }
__device__ __forceinline__ float bfhi(unsigned w) { return __uint_as_float(w & 0xffff0000u); }
__device__ __forceinline__ float wave_sum(float v) {
#pragma unroll
    for (int o = 1; o < 64; o <<= 1) v += __shfl_xor(v, o);
    return v;
}
__device__ __forceinline__ float silu_f(float x) { return x / (1.f + __expf(-x)); }
__device__ __forceinline__ float sigmoid_f(float x) { return 1.f / (1.f + __expf(-x)); }
#define LDS_WAIT() asm volatile("s_waitcnt lgkmcnt(0)" ::: "memory")

#define XB_TMO      128
#define XB_XCNT(j)  (256  + 64 * (j))
#define XB_XSUB(j)  (1280 + 64 * (j))
#define XB_XGEN(j)  (2304 + 64 * (j))
#define XB_TOP      3328
#define XB_TOPGEN   3392
#define XCD_BAR_WORDS 3456
#define XB_SPIN_CAP (1u << 20)
__device__ __forceinline__ unsigned xb_ld(unsigned* p)              { return __hip_atomic_load(p, __ATOMIC_RELAXED, __HIP_MEMORY_SCOPE_AGENT); }
__device__ __forceinline__ unsigned xb_add(unsigned* p, unsigned v) { return __hip_atomic_fetch_add(p, v, __ATOMIC_RELAXED, __HIP_MEMORY_SCOPE_AGENT); }
__device__ __forceinline__ unsigned xb_xcc_id() { return (unsigned)__builtin_amdgcn_s_getreg((3 << 11) | 20) & 0xFu; }
#define XB_SPIN(cond, bar) do { unsigned _sp = 0; while (cond) { __builtin_amdgcn_s_sleep(1); \
    if ((++_sp & 255u) == 0u) { if (xb_ld(&(bar)[XB_TMO])) break; if (_sp > XB_SPIN_CAP) { atomicAdd(&(bar)[XB_TMO], 1u); break; } } } } while (0)
struct XcdBarrier { unsigned* bar; unsigned x; volatile LAS unsigned* st; };
__device__ __forceinline__ XcdBarrier xcd_barrier_post(unsigned* bar, volatile LAS unsigned* st) {
    XcdBarrier b; b.bar = bar; b.x = xb_xcc_id(); b.st = st;
    if (threadIdx.x == 0) (void)xb_add(&bar[XB_XCNT(b.x)], 1u);
    return b;
}
__device__ __forceinline__ void xcd_barrier_complete(unsigned* bar, unsigned x, unsigned& nloc, unsigned& nx) {
    const unsigned G = gridDim.x * gridDim.y * gridDim.z;
    unsigned sum, cnt, mine, sp = 0u;
    for (;;) {
        sum = 0u; cnt = 0u; mine = 0u;
#pragma unroll
        for (unsigned j = 0; j < 16; ++j) { const unsigned c = xb_ld(&bar[XB_XCNT(j)]); sum += c; cnt += (c > 0u) ? 1u : 0u; mine = (j == x) ? c : mine; }
        if (sum == G) break;
        __builtin_amdgcn_s_sleep(1);
        if ((++sp & 255u) == 0u) { if (xb_ld(&bar[XB_TMO])) break; if (sp > XB_SPIN_CAP) { atomicAdd(&bar[XB_TMO], 1u); break; } }
    }
    nloc = mine > 0u ? mine : 1u; nx = cnt > 0u ? cnt : 1u;
}
__device__ __forceinline__ void xcd_barrier(const XcdBarrier& b) {
    asm volatile("s_waitcnt vmcnt(0)" ::: "memory");
    __syncthreads();
    if (threadIdx.x == 0) {
        unsigned* bar = b.bar;
        __builtin_amdgcn_s_waitcnt(0);
        unsigned nloc = b.st[0], nx = b.st[1];
        if (nloc == 0u) { xcd_barrier_complete(bar, b.x, nloc, nx); b.st[0] = nloc; b.st[1] = nx; }
        const unsigned old = xb_add(&bar[XB_XSUB(b.x)], 1u);
        const unsigned gen = old / nloc;
        if (old + 1u == (gen + 1u) * nloc) {
            __builtin_amdgcn_fence(__ATOMIC_RELEASE, "agent");
            asm volatile("s_waitcnt vmcnt(0)" ::: "memory");
            const unsigned og = xb_add(&bar[XB_TOP], 1u);
            const unsigned tg = og / nx;
            if (og + 1u == (tg + 1u) * nx) xb_add(&bar[XB_TOPGEN], 1u);
            else XB_SPIN(xb_ld(&bar[XB_TOPGEN]) == tg, bar);
            __builtin_amdgcn_fence(__ATOMIC_ACQUIRE, "agent");
            xb_add(&bar[XB_XGEN(b.x)], 1u);
            asm volatile("s_waitcnt vmcnt(0)" ::: "memory");
        } else {
            XB_SPIN(xb_ld(&bar[XB_XGEN(b.x)]) == gen, bar);
            __builtin_amdgcn_fence(__ATOMIC_ACQUIRE, "agent");
            asm volatile("s_waitcnt vmcnt(0)" ::: "memory");
        }
    }
    __syncthreads();
}

struct Args { const float* in[25]; float* out; unsigned char* ws; int ph_lo, ph_hi; };
enum { I_X = 0, I_C, I_CTX, I_CCTX, I_ADAW, I_ADAB, I_NMG, I_NFG, I_WIN, I_WOUT, I_SINK, I_PW1W, I_PW1B, I_DWW, I_DWB, I_LNG, I_LNB,
       I_PW2W, I_PW2B, I_RW, I_RB, I_WG, I_WU, I_WD, I_FNG };

struct Frame {
    LAS unsigned char* lds;
    int tid, lane, wave, G, wg;
    const float* const* in;
    float* out;
    unsigned char* ws;
    unsigned* ctl;
};

__device__ __forceinline__ int crow(int i, int h) { return (i & 3) + 8 * (i >> 2) + 4 * h; }
template <class RowPtr, class Epi>
__device__ __forceinline__ void sgemm_tile(const RowPtr& rowptr, const bf16* Bt, int K, int m0, int n0, const Epi& epi, int wave, int lane) {
    const int wm = wave & 3, wn = wave >> 2, r = lane & 31, h = lane >> 5;
    const bf16* ap = rowptr(m0 + wm * 32 + r) + 8 * h;
    const bf16* bp0 = Bt + (size_t)(n0 + wn * 64 + r) * K + 8 * h;
    const bf16* bp1 = bp0 + (size_t)32 * K;
    f32x16 c0, c1;
#pragma unroll
    for (int i = 0; i < 16; ++i) { c0[i] = 0.f; c1[i] = 0.f; }
#pragma unroll 2
    for (int k = 0; k < K; k += 32) {
        const bf16x8 a0 = *(const bf16x8*)(ap + k), a1 = *(const bf16x8*)(ap + k + 16);
        const bf16x8 b00 = *(const bf16x8*)(bp0 + k), b01 = *(const bf16x8*)(bp0 + k + 16);
        const bf16x8 b10 = *(const bf16x8*)(bp1 + k), b11 = *(const bf16x8*)(bp1 + k + 16);
        c0 = __builtin_amdgcn_mfma_f32_32x32x16_bf16(a0, b00, c0, 0, 0, 0);
        c1 = __builtin_amdgcn_mfma_f32_32x32x16_bf16(a0, b10, c1, 0, 0, 0);
        c0 = __builtin_amdgcn_mfma_f32_32x32x16_bf16(a1, b01, c0, 0, 0, 0);
        c1 = __builtin_amdgcn_mfma_f32_32x32x16_bf16(a1, b11, c1, 0, 0, 0);
    }
    epi(m0 + wm * 32, n0 + wn * 64, c0, c1, lane);
}

__device__ __forceinline__ void p0_transpose_item(const float* W, int K, int N, bf16* WT, int k0, int n0, int drow0, LAS float* scr, int lane) {
#pragma unroll 8
    for (int i = 0; i < 32; ++i) { const int kk = 2 * i + (lane >> 5); scr[kk * 33 + (lane & 31)] = W[(size_t)(k0 + kk) * N + n0 + (lane & 31)]; }
    LDS_WAIT(); asm volatile("" ::: "memory");
    const int c = lane & 7;
#pragma unroll
    for (int j = 0; j < 4; ++j) { const int n = (lane >> 3) + 8 * j; const LAS float* s = scr + (8 * c) * 33 + n;
        u32x4 o; o.x = pk2(s[0 * 33], s[1 * 33]); o.y = pk2(s[2 * 33], s[3 * 33]); o.z = pk2(s[4 * 33], s[5 * 33]); o.w = pk2(s[6 * 33], s[7 * 33]);
        *(u32x4*)(WT + (size_t)(drow0 + n) * K + k0 + 8 * c) = o; }
    LDS_WAIT(); asm volatile("" ::: "memory");
}
__device__ __forceinline__ int il_row(int j, int half) { return (j / IL) * (2 * IL) + half * IL + (j % IL); }

__device__ __forceinline__ void phase_prep(Frame& F) {
    {
        LAS float* sc = (LAS float*)F.lds;
        LAS float* red = sc + 5 * 1024;
        bool loaded = false;
        for (int it = F.wg; it < 192; it += F.G) {
            if (!loaded) {
                for (int i = F.tid; i < 5 * 1024; i += NTHR) { const int b = i >> 10, k = i & 1023; const float v = b < 4 ? F.in[I_C][b * 1024 + k] : F.in[I_CCTX][k]; sc[i] = silu_f(v); }
                __syncthreads(); loaded = true;
            }
            const int l = it / 96, n0 = (it % 96) * 64, col = F.tid & 63, kg = F.tid >> 6;
            const float* w = F.in[I_ADAW] + (size_t)l * 1024 * 6144 + n0 + col;
            float a0 = 0.f, a1 = 0.f, a2 = 0.f, a3 = 0.f, a4 = 0.f;
#pragma unroll 8
            for (int k = kg * 128; k < kg * 128 + 128; ++k) { const float wv = w[(size_t)k * 6144];
                a0 += sc[k] * wv; a1 += sc[1024 + k] * wv; a2 += sc[2048 + k] * wv; a3 += sc[3072 + k] * wv; a4 += sc[4096 + k] * wv; }
            red[(kg * 5 + 0) * 64 + col] = a0; red[(kg * 5 + 1) * 64 + col] = a1; red[(kg * 5 + 2) * 64 + col] = a2; red[(kg * 5 + 3) * 64 + col] = a3; red[(kg * 5 + 4) * 64 + col] = a4;
            __syncthreads();
            if (F.tid < 320) { const int b = F.tid >> 6, c2 = F.tid & 63; float s = 0.f;
#pragma unroll
                for (int g = 0; g < 8; ++g) s += red[(g * 5 + b) * 64 + c2];
                ((float*)(F.ws + WS_MOD))[((size_t)l * 5 + b) * 6144 + n0 + c2] = s + F.in[I_ADAB][l * 6144 + n0 + c2]; }
            __syncthreads();
        }
        __syncthreads();
    }
    { u32x4* z = (u32x4*)(F.ws + WS_SLOTT); const u32x4 zero = {0u, 0u, 0u, 0u};
      for (int i = F.wg * NTHR + F.tid; i < 2 * 16 * CAP / 4; i += F.G * NTHR) z[i] = zero; }
    { float* tw = (float*)(F.ws + WS_TW);
      for (int k = F.wg * NTHR + F.tid; k < 8192; k += F.G * NTHR) { const float a = (float)k * (6.283185307179586f / 8192.f); tw[2 * k] = __cosf(a); tw[2 * k + 1] = __sinf(a); } }
    {
        LAS float* scr = (LAS float*)(F.lds + F.wave * 8704);
        const int gw = F.wg * NWAVES + F.wave, NGW = F.G * NWAVES;
        constexpr int S0 = 640, S1 = 512, S2 = 1024, S3 = 512, SM = 32 * 256;
        constexpr int NIT = S0 + S1 + S2 + S3 + 3 * SM;
        for (int it = gw; it < NIT; it += NGW) {
            int r = it;
            if (r < S0) { const int kb = r / 40, nb = r % 40; p0_transpose_item(F.in[I_WIN], 1024, 1280, (bf16*)(F.ws + WS_WIN), kb * 64, nb * 32, nb * 32, scr, F.lane); continue; } r -= S0;
            if (r < S1) { const int kb = r / 32, nb = r % 32; p0_transpose_item(F.in[I_WOUT], 1024, 1024, (bf16*)(F.ws + WS_WOUT), kb * 64, nb * 32, nb * 32, scr, F.lane); continue; } r -= S1;
            if (r < S2) { const int kb = r / 64, nb = r % 64, n0 = nb * 32; p0_transpose_item(F.in[I_PW1W], 1024, 2048, (bf16*)(F.ws + WS_WPW1), kb * 64, n0, il_row(n0 & 1023, n0 >> 10), scr, F.lane); continue; } r -= S2;
            if (r < S3) { const int kb = r / 32, nb = r % 32; p0_transpose_item(F.in[I_PW2W], 1024, 1024, (bf16*)(F.ws + WS_WPW2), kb * 64, nb * 32, nb * 32, scr, F.lane); continue; } r -= S3;
            if (r < SM) { const int le = r >> 8, q = r & 255, kb = q / 16, nb = q % 16;
                p0_transpose_item(F.in[I_WG] + (size_t)le * 1024 * 512, 1024, 512, (bf16*)(F.ws + WS_WGU) + (size_t)le * 1024 * 1024, kb * 64, nb * 32, il_row(nb * 32, 0), scr, F.lane); continue; } r -= SM;
            if (r < SM) { const int le = r >> 8, q = r & 255, kb = q / 16, nb = q % 16;
                p0_transpose_item(F.in[I_WU] + (size_t)le * 1024 * 512, 1024, 512, (bf16*)(F.ws + WS_WGU) + (size_t)le * 1024 * 1024, kb * 64, nb * 32, il_row(nb * 32, 1), scr, F.lane); continue; } r -= SM;
            { const int le = r >> 8, q = r & 255, kb = q / 32, nb = q % 32;
                p0_transpose_item(F.in[I_WD] + (size_t)le * 512 * 1024, 512, 1024, (bf16*)(F.ws + WS_WDN) + (size_t)le * 1024 * 512, kb * 64, nb * 32, nb * 32, scr, F.lane); }
        }
    }
}

__device__ __forceinline__ void row_load(const float* p, int lane, f32x4 (&v)[4]) {
#pragma unroll
    for (int j = 0; j < 4; ++j) v[j] = *(const f32x4*)(p + 4 * lane + 256 * j);
}
__device__ __forceinline__ float row_sumsq(const f32x4 (&v)[4]) {
    float s = 0.f;
#pragma unroll
    for (int j = 0; j < 4; ++j) s += (v[j].x * v[j].x + v[j].y * v[j].y) + (v[j].z * v[j].z + v[j].w * v[j].w);
    return wave_sum(s);
}
__device__ __forceinline__ void row_modulate(f32x4 (&v)[4], float rstd, const float* g, const float* sh, const float* sc, int lane) {
#pragma unroll
    for (int j = 0; j < 4; ++j) { const int o = 4 * lane + 256 * j; const f32x4 gg = *(const f32x4*)(g + o), s1 = *(const f32x4*)(sc + o), s0 = *(const f32x4*)(sh + o);
        v[j] = v[j] * rstd * gg * (1.f + s1) + s0; }
}
__device__ __forceinline__ void row_store_bf16(bf16* dst, const f32x4 (&v)[4], int lane) {
#pragma unroll
    for (int j = 0; j < 4; ++j) { u32x2 w; w.x = pk2(v[j].x, v[j].y); w.y = pk2(v[j].z, v[j].w); *(u32x2*)(dst + 4 * lane + 256 * j) = w; }
}

__device__ __forceinline__ void phase_norm1_l0(Frame& F) {
    const int gw = F.wg * NWAVES + F.wave, NGW = F.G * NWAVES;
    const float* mod = (const float*)(F.ws + WS_MOD);
    bf16* HB = (bf16*)(F.ws + WS_HB);
    for (int row = gw; row < T + TC; row += NGW) {
        const float* src = row < T ? F.in[I_X] + (size_t)row * D : F.in[I_CTX] + (size_t)(row - T) * D;
        const int b = row < T ? (row >> 13) : 4;
        f32x4 v[4]; row_load(src, F.lane, v);
        const float rstd = rsqrtf(row_sumsq(v) * (1.f / D) + EPS);
        const float* m = mod + (size_t)b * 6144;
        row_modulate(v, rstd, F.in[I_NMG], m, m + 1024, F.lane);
        row_store_bf16(HB + (size_t)row * D, v, F.lane);
    }
}

struct RowLin { const bf16* base; size_t pitch; __device__ __forceinline__ const bf16* operator()(int m) const { return base + (size_t)m * pitch; } };

__device__ __forceinline__ void inproj_block(Frame& F, int mb, int nbk, const f32x16& c, int lane) {
    const int h = lane >> 5, cl = lane & 31;
    bf16* dst; int pitch, cbase; bool rope = false; bool isctx = (mb >= T);
    if (nbk < 512) { dst = (bf16*)(F.ws + WS_UF); pitch = 512; cbase = 0; }
    else if (nbk < 1024) { dst = (bf16*)(F.ws + WS_Q); pitch = 512; cbase = 512; rope = true; }
    else if (nbk < 1152) { dst = isctx ? (bf16*)(F.ws + WS_CK) : (bf16*)(F.ws + WS_K); pitch = 128; cbase = 1024; rope = !isctx; }
    else { dst = isctx ? (bf16*)(F.ws + WS_CV) : (bf16*)(F.ws + WS_V); pitch = 128; cbase = 1152; }
    const int rbase = isctx ? mb - T : mb;
    const int col = nbk - cbase + cl;
    const float inv = exp2f(-(float)(cl & 15) * (13.287712379549449f / 16.f));
    const bool second = (cl & 16) != 0; const bool bycol = ((nbk >> 5) & 1) != 0;
#pragma unroll
    for (int i = 0; i < 16; ++i) {
        const int rr = crow(i, h); float v = c[i];
        if (rope) {
            const float partner = __shfl_xor(v, 16);
            const int l = (mb + rr) & (L - 1);
            const float pos = (float)(bycol ? (l & 63) : (l >> 6));
            const float ang = pos * inv, cs = __cosf(ang), sn = __sinf(ang);
            v = second ? (partner * sn + v * cs) : (v * cs - partner * sn);
        }
        dst[(size_t)(rbase + rr) * pitch + col] = (bf16)f2bf(v);
    }
}
__device__ __forceinline__ void phase_inproj(Frame& F) {
    const bf16* HB = (const bf16*)(F.ws + WS_HB); const bf16* Wt = (const bf16*)(F.ws + WS_WIN);
    constexpr int MT = (T + TC) / 128, NT = N_IN / 128;
    RowLin rp{HB, (size_t)D};
    for (int u = F.wg; u < MT * NT; u += F.G) {
        const int mt = u / NT, nt = u % NT;
        if (mt >= T / 128 && nt < 8) continue;
        auto epi = [&](int mb, int nb, const f32x16& c0, const f32x16& c1, int lane) { inproj_block(F, mb, nb, c0, lane); inproj_block(F, mb, nb + 32, c1, lane); };
        sgemm_tile(rp, Wt, D, mt * 128, nt * 128, epi, F.wave, F.lane);
    }
}

__device__ __forceinline__ void attn_key(const bf16* kp, const bf16* vp, const float (&q)[64], float& m, float& s, float (&o)[64]) {
    float dot = 0.f;
#pragma unroll
    for (int j = 0; j < 8; ++j) { const u32x4 w = *(const u32x4*)(kp + 8 * j);
        dot += q[8 * j + 0] * bflo(w.x) + q[8 * j + 1] * bfhi(w.x) + q[8 * j + 2] * bflo(w.y) + q[8 * j + 3] * bfhi(w.y)
             + q[8 * j + 4] * bflo(w.z) + q[8 * j + 5] * bfhi(w.z) + q[8 * j + 6] * bflo(w.w) + q[8 * j + 7] * bfhi(w.w); }
    const float mn = fmaxf(m, dot), alpha = __expf(m - mn), p = __expf(dot - mn);
    s = s * alpha + p; m = mn;
#pragma unroll
    for (int j = 0; j < 8; ++j) { const u32x4 w = *(const u32x4*)(vp + 8 * j);
        o[8 * j + 0] = o[8 * j + 0] * alpha + p * bflo(w.x); o[8 * j + 1] = o[8 * j + 1] * alpha + p * bfhi(w.x);
        o[8 * j + 2] = o[8 * j + 2] * alpha + p * bflo(w.y); o[8 * j + 3] = o[8 * j + 3] * alpha + p * bfhi(w.y);
        o[8 * j + 4] = o[8 * j + 4] * alpha + p * bflo(w.z); o[8 * j + 5] = o[8 * j + 5] * alpha + p * bfhi(w.z);
        o[8 * j + 6] = o[8 * j + 6] * alpha + p * bflo(w.w); o[8 * j + 7] = o[8 * j + 7] * alpha + p * bfhi(w.w); }
}
__device__ __forceinline__ void phase_attn_simple(Frame& F) {
    const bf16* Q = (const bf16*)(F.ws + WS_Q); const bf16* Kb = (const bf16*)(F.ws + WS_K); const bf16* Vb = (const bf16*)(F.ws + WS_V);
    const bf16* CK = (const bf16*)(F.ws + WS_CK); const bf16* CV = (const bf16*)(F.ws + WS_CV); bf16* MIX = (bf16*)(F.ws + WS_MIX);
    for (int idx = F.wg * NTHR + F.tid; idx < T * 8; idx += F.G * NTHR) {
        const int hd = idx / T, t = idx % T, b = t >> 13, l = t & (L - 1), kvh = hd >> 2;
        float q[64], o[64];
#pragma unroll
        for (int j = 0; j < 8; ++j) { const u32x4 w = *(const u32x4*)(Q + (size_t)t * 512 + hd * 64 + 8 * j);
            q[8 * j + 0] = bflo(w.x) * 0.125f; q[8 * j + 1] = bfhi(w.x) * 0.125f; q[8 * j + 2] = bflo(w.y) * 0.125f; q[8 * j + 3] = bfhi(w.y) * 0.125f;
            q[8 * j + 4] = bflo(w.z) * 0.125f; q[8 * j + 5] = bfhi(w.z) * 0.125f; q[8 * j + 6] = bflo(w.w) * 0.125f; q[8 * j + 7] = bfhi(w.w) * 0.125f; }
#pragma unroll
        for (int j = 0; j < 64; ++j) o[j] = 0.f;
        float m = F.in[I_SINK][hd], s = 1.f;
        for (int c = 0; c < CL; ++c) { const size_t r = (size_t)(b * CL + c) * 128 + kvh * 64; attn_key(CK + r, CV + r, q, m, s, o); }
        const int lo = l - 128 < 0 ? 0 : l - 128, hi = l + 128 > L - 1 ? L - 1 : l + 128;
        for (int kp = lo; kp <= hi; ++kp) { const size_t r = (size_t)(b * L + kp) * 128 + kvh * 64; attn_key(Kb + r, Vb + r, q, m, s, o); }
        const float is = 1.f / s;
#pragma unroll
        for (int j = 0; j < 8; ++j) { u32x4 w; w.x = pk2(o[8 * j] * is, o[8 * j + 1] * is); w.y = pk2(o[8 * j + 2] * is, o[8 * j + 3] * is); w.z = pk2(o[8 * j + 4] * is, o[8 * j + 5] * is); w.w = pk2(o[8 * j + 6] * is, o[8 * j + 7] * is);
            *(u32x4*)(MIX + (size_t)t * 1024 + 512 + hd * 64 + 8 * j) = w; }
    }
}

__device__ __forceinline__ void phase_fft1_simple(Frame& F) {
    const bf16* UF = (const bf16*)(F.ws + WS_UF); bf16* Gb = (bf16*)(F.ws + WS_G); const float* tw = (const float*)(F.ws + WS_TW);
    for (int idx = F.wg * NTHR + F.tid; idx < NB * FN1 * FN2 * 512; idx += F.G * NTHR) {
        const int ch = idx & 511, bp = (idx >> 9) & 127, c = (idx >> 16) & 63, b = idx >> 22;
        float re = 0.f, im = 0.f;
        for (int a = 0; a < FN1; ++a) { const float u = bf2f(UF[(size_t)(b * L + 128 * a + bp) * 512 + ch]); const int k = ((a * c) & 63) * 128;
            re += u * tw[2 * k]; im -= u * tw[2 * k + 1]; }
        const int k2 = bp * c; const float cs = tw[2 * k2], sn = tw[2 * k2 + 1];
        const float gr = re * cs + im * sn, gi = im * cs - re * sn;
        const size_t row = (size_t)(b * FN1 + c) * FN2 + bp;
        Gb[row * 1024 + ch] = (bf16)f2bf(gr); Gb[row * 1024 + 512 + ch] = (bf16)f2bf(gi);
    }
}
__device__ __forceinline__ void phase_fft2_simple(Frame& F) {
    const bf16* Gb = (const bf16*)(F.ws + WS_G); bf16* AB = (bf16*)(F.ws + WS_AB); const float* tw = (const float*)(F.ws + WS_TW);
    for (int idx = F.wg * NTHR + F.tid; idx < NB * FN1 * FN2 * 512; idx += F.G * NTHR) {
        const int ch = idx & 511, d = (idx >> 9) & 127, c = (idx >> 16) & 63, b = idx >> 22;
        float fr = 0.f, fi = 0.f;
        for (int bp = 0; bp < FN2; ++bp) { const size_t row = (size_t)(b * FN1 + c) * FN2 + bp; const float gr = bf2f(Gb[row * 1024 + ch]), gi = bf2f(Gb[row * 1024 + 512 + ch]);
            const int k = ((bp * d) & 127) * 64; const float cs = tw[2 * k], sn = tw[2 * k + 1];
            fr += gr * cs + gi * sn; fi += gi * cs - gr * sn; }
        const size_t t = (size_t)b * L + c + 64 * d;
        AB[t * 1024 + ch] = (bf16)f2bf(fr); AB[t * 1024 + 512 + ch] = (bf16)f2bf(-fi);
    }
}
__device__ __forceinline__ void phase_fft3_simple(Frame& F) {
    const bf16* AB = (const bf16*)(F.ws + WS_AB); bf16* MIX = (bf16*)(F.ws + WS_MIX); const float* tw = (const float*)(F.ws + WS_TW);
    LAS float* t128 = (LAS float*)F.lds;
    for (int i = F.tid; i < 128; i += NTHR) { t128[2 * i] = tw[2 * (i * 64)]; t128[2 * i + 1] = tw[2 * (i * 64) + 1]; }
    __syncthreads();
    for (int idx = F.wg * NTHR + F.tid; idx < T * 512; idx += F.G * NTHR) {
        const int cp = idx & 127, g = (idx >> 7) & 3, t = idx >> 9;
        const bf16* arow = AB + (size_t)t * 1024 + g * 128;
        float y = 0.f;
        for (int cc = 0; cc < 128; ++cc) { const int k = (cc * cp) & 127; y += bf2f(arow[cc]) * t128[2 * k] - bf2f(arow[512 + cc]) * t128[2 * k + 1]; }
        MIX[(size_t)t * 1024 + g * 128 + cp] = (bf16)f2bf(y * (1.f / 1024.f));
    }
    __syncthreads();
}

__device__ __forceinline__ void phase_outproj(Frame& F, const bf16* A, const bf16* Wt, const float* base, float* X, const float* gate  , const float* bias) {
    RowLin rp{A, (size_t)D};
    for (int u = F.wg; u < (T / 128) * 8; u += F.G) {
        const int mt = u / 8, nt = u % 8;
        auto epi = [&](int mb, int nb, const f32x16& c0, const f32x16& c1, int lane) {
            const int h = lane >> 5, cl = lane & 31, b = mb >> 13;
#pragma unroll
            for (int half = 0; half < 2; ++half) { const int col = nb + 32 * half + cl; const float gv = gate[(size_t)b * 6144 + col], bv = bias ? bias[col] : 0.f;
#pragma unroll
                for (int i = 0; i < 16; ++i) { const size_t o = (size_t)(mb + crow(i, h)) * D + col; const float a = half ? c1[i] : c0[i]; X[o] = base[o] + gv * (a + bv); } }
        };
        sgemm_tile(rp, Wt, D, mt * 128, nt * 128, epi, F.wave, F.lane);
    }
}

__device__ __forceinline__ void route_select(const float (&lg)[16], const float* rb, int& be1, int& be2, float& w1, float& w2) {
    float best = -1e30f; float bs1 = 0.f, bs2 = 0.f; be1 = 0; be2 = 0;
#pragma unroll
    for (int g = 0; g < 4; ++g) {
        float v1 = -1e30f, v2 = -1e30f, s1 = 0.f, s2 = 0.f; int j1 = 0, j2 = 0;
#pragma unroll
        for (int q = 0; q < 4; ++q) { const float sc = sigmoid_f(lg[4 * g + q]), x = sc + rb[4 * g + q];
            if (x > v1) { v2 = v1; j2 = j1; s2 = s1; v1 = x; j1 = q; s1 = sc; } else if (x > v2) { v2 = x; j2 = q; s2 = sc; } }
        const float gs = v1 + v2;
        if (gs > best) { best = gs; be1 = 4 * g + j1; be2 = 4 * g + j2; bs1 = s1; bs2 = s2; }
    }
    const float inv = 1.f / (bs1 + bs2); w1 = bs1 * inv; w2 = bs2 * inv;
}
__device__ __forceinline__ void phase_norm2_route(Frame& F, int layer) {
    const float* mod = (const float*)(F.ws + WS_MOD) + (size_t)layer * 5 * 6144;
    const float* X = F.out; bf16* HB = (bf16*)(F.ws + WS_HB);
    const float* rw = F.in[I_RW]; const float* rb = F.in[I_RB];
    int* tok_e = (int*)(F.ws + WS_TOKE); int* tok_p = (int*)(F.ws + WS_TOKP); float* tok_w = (float*)(F.ws + WS_TOKW);
    int* slot_t = (int*)(F.ws + WS_SLOTT) + layer * 16 * CAP;
    float* slot_w = (float*)(F.ws + WS_SLOTW) + layer * 16 * CAP;
    unsigned* cnt = F.ctl + CW_CNT + layer * 16 * 64;
    LAS float* rwt = (LAS float*)F.lds;
    LAS int* sel_e = (LAS int*)(F.lds + 65536);
    LAS float* sel_w = (LAS float*)(F.lds + 65536 + 1024);
    LAS int* wcnt = (LAS int*)(F.lds + 65536 + 2048);
    LAS int* ebase = wcnt + 64;
    __syncthreads();
    for (int t = F.tid; t < 4096; t += NTHR) { const int i = t >> 2, e4 = t & 3; const f32x4 w = *(const f32x4*)(rw + (size_t)i * 16 + 4 * e4);
        rwt[(4 * e4 + 0) * 1024 + i] = w.x; rwt[(4 * e4 + 1) * 1024 + i] = w.y; rwt[(4 * e4 + 2) * 1024 + i] = w.z; rwt[(4 * e4 + 3) * 1024 + i] = w.w; }
    __syncthreads();
    for (int rb0 = F.wg; rb0 < T / 128; rb0 += F.G) {
#pragma unroll 1
        for (int j = 0; j < 16; j += 2) {
            const int lr = F.wave * 16 + j, row = rb0 * 128 + lr, b = row >> 13;
            f32x4 v0[4], v1[4]; row_load(X + (size_t)row * D, F.lane, v0); row_load(X + (size_t)(row + 1) * D, F.lane, v1);
            const float rstd0 = rsqrtf(row_sumsq(v0) * (1.f / D) + EPS), rstd1 = rsqrtf(row_sumsq(v1) * (1.f / D) + EPS);
            const float* m = mod + (size_t)b * 6144;
            row_modulate(v0, rstd0, F.in[I_NFG] + layer * D, m + 3072, m + 4096, F.lane);
            row_modulate(v1, rstd1, F.in[I_NFG] + layer * D, m + 3072, m + 4096, F.lane);
            row_store_bf16(HB + (size_t)row * D, v0, F.lane); row_store_bf16(HB + (size_t)(row + 1) * D, v1, F.lane);
            float lg0[16], lg1[16];
#pragma unroll
            for (int e = 0; e < 16; ++e) { float a0 = 0.f, a1 = 0.f;
#pragma unroll
                for (int jj = 0; jj < 4; ++jj) { const f32x4 w4 = *(const LAS f32x4*)(rwt + e * 1024 + 4 * F.lane + 256 * jj);
                    a0 += (v0[jj].x * w4.x + v0[jj].y * w4.y) + (v0[jj].z * w4.z + v0[jj].w * w4.w); a1 += (v1[jj].x * w4.x + v1[jj].y * w4.y) + (v1[jj].z * w4.z + v1[jj].w * w4.w); }
                lg0[e] = a0; lg1[e] = a1; }
#pragma unroll
            for (int e = 0; e < 16; ++e) { lg0[e] = wave_sum(lg0[e]); lg1[e] = wave_sum(lg1[e]); }
            int e1, e2; float w1, w2;
            route_select(lg0, rb, e1, e2, w1, w2);
            if (F.lane == 0) { sel_e[2 * lr] = e1; sel_e[2 * lr + 1] = e2; sel_w[2 * lr] = w1; sel_w[2 * lr + 1] = w2; }
            route_select(lg1, rb, e1, e2, w1, w2);
            if (F.lane == 0) { sel_e[2 * lr + 2] = e1; sel_e[2 * lr + 3] = e2; sel_w[2 * lr + 2] = w1; sel_w[2 * lr + 3] = w2; }
        }
        __syncthreads();
        int my_e = 0, my_rank = 0; float my_w = 0.f;
        if (F.tid < 256) { my_e = sel_e[F.tid]; my_w = sel_w[F.tid];
            const unsigned long long below = (1ull << F.lane) - 1ull;
#pragma unroll 1
            for (int ee = 0; ee < 16; ++ee) { const unsigned long long mk = __ballot(my_e == ee);
                if (my_e == ee) my_rank = __popcll(mk & below);
                if (F.lane == 0) wcnt[F.wave * 16 + ee] = __popcll(mk); } }
        __syncthreads();
        if (F.tid < 16) { const int n = wcnt[F.tid] + wcnt[16 + F.tid] + wcnt[32 + F.tid] + wcnt[48 + F.tid];
            ebase[F.tid] = n ? (int)atomicAdd(cnt + F.tid * 64, (unsigned)n) : 0; }
        __syncthreads();
        if (F.tid < 256) { int pos = ebase[my_e] + my_rank;
            for (int w = 0; w < F.wave; ++w) pos += wcnt[w * 16 + my_e];
            const int tok = rb0 * 128 + (F.tid >> 1), k = F.tid & 1;
            slot_t[my_e * CAP + pos] = tok; slot_w[my_e * CAP + pos] = my_w; tok_e[2 * tok + k] = my_e; tok_p[2 * tok + k] = pos; tok_w[2 * tok + k] = my_w; }
        __syncthreads();
    }
}

constexpr int MOEMAP_OFF = LDS_BYTES - 256;
__device__ __forceinline__ LAS int* moe_map(Frame& F, int layer) {
    LAS int* mm = (LAS int*)(F.lds + MOEMAP_OFF);
    __syncthreads();
    if (F.tid < 64) { const unsigned* cnt = F.ctl + CW_CNT + layer * 16 * 64;
        const int n = (F.tid < 16) ? (int)__hip_atomic_load(cnt + F.tid * 64, __ATOMIC_RELAXED, __HIP_MEMORY_SCOPE_AGENT) : 0;
        const int pad = (n + 255) & ~255; int x = pad;
#pragma unroll
        for (int o = 1; o < 16; o <<= 1) { const int t = __shfl_up(x, o); if (F.lane >= o) x += t; }
        if (F.tid < 16) { mm[F.tid] = n; mm[16 + F.tid] = x - pad; } }
    __syncthreads();
    return mm;
}
struct RowGather { const bf16* base; const int* list; int n; __device__ __forceinline__ const bf16* operator()(int m) const { const int tok = m < n ? list[m] : 0; return base + (size_t)tok * D; } };

__device__ __forceinline__ void phase_moe_gateup(Frame& F, int layer) {
    LAS int* mm = moe_map(F, layer);
    const bf16* HB = (const bf16*)(F.ws + WS_HB); bf16* HID = (bf16*)(F.ws + WS_HID);
    const int* slot_t = (const int*)(F.ws + WS_SLOTT) + layer * 16 * CAP; const float* slot_w = (const float*)(F.ws + WS_SLOTW) + layer * 16 * CAP;
    int ubase = 0;
#pragma unroll 1
    for (int e = 0; e < 16; ++e) {
        const int n = mm[e], hbe = mm[16 + e], rt = (n + 127) >> 7, nu = rt * 8;
        const bf16* Wt = (const bf16*)(F.ws + WS_WGU) + (size_t)(layer * 16 + e) * 1024 * 1024;
        RowGather rp{HB, slot_t + e * CAP, n};
        int first = (F.wg - ubase % F.G + F.G) % F.G;
        for (int u = first; u < nu; u += F.G) {
            const int mt = u / 8, nt = u % 8;
            auto epi = [&](int mb, int nb, const f32x16& c0, const f32x16& c1, int lane) {
                const int h = lane >> 5, cl = lane & 31; const int col = (nb >> 1) + cl;
#pragma unroll
                for (int i = 0; i < 16; ++i) { const int r = mb + crow(i, h);
                    if (r < n) { const float w = slot_w[e * CAP + r]; HID[(size_t)(hbe + r) * FF + col] = (bf16)f2bf(w * silu_f(c0[i]) * c1[i]); } }
            };
            sgemm_tile(rp, Wt, D, mt * 128, nt * 128, epi, F.wave, F.lane);
        }
        ubase += nu;
    }
}
__device__ __forceinline__ void phase_moe_down(Frame& F, int layer) {
    LAS int* mm = moe_map(F, layer);
    const bf16* HID = (const bf16*)(F.ws + WS_HID); bf16* Y = (bf16*)(F.ws + WS_Y);
    int ubase = 0;
#pragma unroll 1
    for (int e = 0; e < 16; ++e) {
        const int n = mm[e], hbe = mm[16 + e], rt = (n + 127) >> 7, nu = rt * 8;
        const bf16* Wt = (const bf16*)(F.ws + WS_WDN) + (size_t)(layer * 16 + e) * 1024 * 512;
        RowLin rp{HID + (size_t)hbe * FF, (size_t)FF};
        int first = (F.wg - ubase % F.G + F.G) % F.G;
        for (int u = first; u < nu; u += F.G) {
            const int mt = u / 8, nt = u % 8;
            auto epi = [&](int mb, int nb, const f32x16& c0, const f32x16& c1, int lane) {
                const int h = lane >> 5, cl = lane & 31;
#pragma unroll
                for (int i = 0; i < 16; ++i) { const int r = mb + crow(i, h);
                    if (r < n) { bf16* yr = Y + (size_t)(hbe + r) * D + nb + cl; yr[0] = (bf16)f2bf(c0[i]); yr[32] = (bf16)f2bf(c1[i]); } }
            };
            sgemm_tile(rp, Wt, FF, mt * 128, nt * 128, epi, F.wave, F.lane);
        }
        ubase += nu;
    }
}

template <bool FINAL>
__device__ __forceinline__ void phase_combine(Frame& F, int layer) {
    LAS int* hbs = moe_map(F, layer) + 16;
    const int gw = F.wg * NWAVES + F.wave, NGW = F.G * NWAVES;
    const float* mod = (const float*)(F.ws + WS_MOD);
    const int* tok_e = (const int*)(F.ws + WS_TOKE); const int* tok_p = (const int*)(F.ws + WS_TOKP);
    const bf16* Y = (const bf16*)(F.ws + WS_Y); float* X = F.out; bf16* HB = (bf16*)(F.ws + WS_HB);
    for (int rp = gw; rp < T / 2; rp += NGW) {
        const int row = 2 * rp, b = row >> 13;
        int sl[2][2];
#pragma unroll
        for (int q = 0; q < 2; ++q) { const int4 te = *(const int4*)(tok_e + 2 * row), tp = *(const int4*)(tok_p + 2 * row);
            sl[0][0] = hbs[te.x] + tp.x; sl[0][1] = hbs[te.y] + tp.y; sl[1][0] = hbs[te.z] + tp.z; sl[1][1] = hbs[te.w] + tp.w; }
        f32x4 v[2][4]; row_load(X + (size_t)row * D, F.lane, v[0]); row_load(X + (size_t)(row + 1) * D, F.lane, v[1]);
        const float* g2 = mod + ((size_t)layer * 5 + b) * 6144 + 5120;
        u32x2 y0[2][4], y1[2][4];
#pragma unroll
        for (int q = 0; q < 2; ++q)
#pragma unroll
            for (int j = 0; j < 4; ++j) { const int o = 4 * F.lane + 256 * j; y0[q][j] = *(const u32x2*)(Y + (size_t)sl[q][0] * D + o); y1[q][j] = *(const u32x2*)(Y + (size_t)sl[q][1] * D + o); }
#pragma unroll
        for (int q = 0; q < 2; ++q)
#pragma unroll
            for (int j = 0; j < 4; ++j) { const int o = 4 * F.lane + 256 * j; const f32x4 gg = *(const f32x4*)(g2 + o);
                v[q][j].x += gg.x * (bflo(y0[q][j].x) + bflo(y1[q][j].x)); v[q][j].y += gg.y * (bfhi(y0[q][j].x) + bfhi(y1[q][j].x));
                v[q][j].z += gg.z * (bflo(y0[q][j].y) + bflo(y1[q][j].y)); v[q][j].w += gg.w * (bfhi(y0[q][j].y) + bfhi(y1[q][j].y)); }
        const float rstd0 = rsqrtf(row_sumsq(v[0]) * (1.f / D) + EPS), rstd1 = rsqrtf(row_sumsq(v[1]) * (1.f / D) + EPS);
#pragma unroll
        for (int q = 0; q < 2; ++q) { const float rstd = q ? rstd1 : rstd0; const size_t ro = (size_t)(row + q) * D;
            if (FINAL) {
#pragma unroll
                for (int j = 0; j < 4; ++j) { const int o = 4 * F.lane + 256 * j; const f32x4 gg = *(const f32x4*)(F.in[I_FNG] + o); *(f32x4*)(X + ro + o) = v[q][j] * rstd * gg; }
            } else {
#pragma unroll
                for (int j = 0; j < 4; ++j) *(f32x4*)(X + ro + 4 * F.lane + 256 * j) = v[q][j];
                const float* m = mod + ((size_t)(layer + 1) * 5 + b) * 6144;
                row_modulate(v[q], rstd, F.in[I_NMG] + (layer + 1) * D, m, m + 1024, F.lane);
                row_store_bf16(HB + ro, v[q], F.lane);
            }
        }
    }
    __syncthreads();
}

__device__ __forceinline__ void phase_pw1(Frame& F) {
    const bf16* HB = (const bf16*)(F.ws + WS_HB); const bf16* Wt = (const bf16*)(F.ws + WS_WPW1); bf16* U = (bf16*)(F.ws + WS_U);
    const float* bias = F.in[I_PW1B];
    RowLin rp{HB, (size_t)D};
    for (int u = F.wg; u < (T / 128) * 16; u += F.G) {
        const int mt = u / 16, nt = u % 16;
        auto epi = [&](int mb, int nb, const f32x16& c0, const f32x16& c1, int lane) {
            const int h = lane >> 5, cl = lane & 31, col = (nb >> 1) + cl; const float ba = bias[col], bg = bias[1024 + col];
#pragma unroll
            for (int i = 0; i < 16; ++i) U[(size_t)(mb + crow(i, h)) * D + col] = (bf16)f2bf((c0[i] + ba) * sigmoid_f(c1[i] + bg));
        };
        sgemm_tile(rp, Wt, D, mt * 128, nt * 128, epi, F.wave, F.lane);
    }
}
__device__ __forceinline__ void phase_dwconv(Frame& F) {
    const bf16* U = (const bf16*)(F.ws + WS_U); bf16* V1 = (bf16*)(F.ws + WS_V1);
    const float* dww = F.in[I_DWW]; const float* dwb = F.in[I_DWB]; const float* lng = F.in[I_LNG]; const float* lnb = F.in[I_LNB];
    const int gw = F.wg * NWAVES + F.wave, NGW = F.G * NWAVES;
    for (int row = gw; row < T; row += NGW) {
        const int l = row & (L - 1);
        f32x4 acc[4];
#pragma unroll
        for (int j = 0; j < 4; ++j) acc[j] = *(const f32x4*)(dwb + 4 * F.lane + 256 * j);
        for (int tp = 0; tp < CONVW; ++tp) { const int ll = l + tp - 15; if (ll < 0 || ll >= L) continue;
            const bf16* ur = U + (size_t)(row + tp - 15) * D; const float* wr = dww + (size_t)tp * D;
#pragma unroll
            for (int j = 0; j < 4; ++j) { const int o = 4 * F.lane + 256 * j; const u32x2 uu = *(const u32x2*)(ur + o); const f32x4 ww = *(const f32x4*)(wr + o);
                acc[j].x += bflo(uu.x) * ww.x; acc[j].y += bfhi(uu.x) * ww.y; acc[j].z += bflo(uu.y) * ww.z; acc[j].w += bfhi(uu.y) * ww.w; } }
        float s = 0.f;
#pragma unroll
        for (int j = 0; j < 4; ++j) s += (acc[j].x + acc[j].y) + (acc[j].z + acc[j].w);
        const float mean = wave_sum(s) * (1.f / D); float q = 0.f;
#pragma unroll
        for (int j = 0; j < 4; ++j) { acc[j] = acc[j] - mean; q += (acc[j].x * acc[j].x + acc[j].y * acc[j].y) + (acc[j].z * acc[j].z + acc[j].w * acc[j].w); }
        const float rstd = rsqrtf(wave_sum(q) * (1.f / D) + EPS);
#pragma unroll
        for (int j = 0; j < 4; ++j) { const int o = 4 * F.lane + 256 * j; const f32x4 gg = *(const f32x4*)(lng + o), bb = *(const f32x4*)(lnb + o);
            f32x4 y = acc[j] * rstd * gg + bb; y.x = silu_f(y.x); y.y = silu_f(y.y); y.z = silu_f(y.z); y.w = silu_f(y.w); acc[j] = y; }
        row_store_bf16(V1 + (size_t)row * D, acc, F.lane);
    }
}


namespace pg {
constexpr int BM = 256, BK = 64, HALF = 128, HTB = HALF * BK * 2, STAGE_BYTES = 8 * HTB;
constexpr int TAB_OFF = STAGE_BYTES;
__device__ __forceinline__ int lds_byte(int r, int c) { const int st = (r >> 4) * 2 + (c >> 5), rr = r & 15, cc = c & 31, ob = rr * 64 + cc * 2; return st * 1024 + (ob ^ (((ob >> 9) & 1) << 5)); }
__device__ __forceinline__ void stage_rc(int b, int& R, int& C) { const int st = b / 1024, sb = b % 1024, swz = sb ^ (((sb >> 9) & 1) << 5); R = (st >> 1) * 16 + swz / 64; C = (st & 1) * 32 + (swz % 64) / 2; }
__device__ __forceinline__ int perm32(int rho) { const int n = rho >> 4, i = rho & 15; return 8 * (i >> 2) + 4 * n + (i & 3); }
__device__ __forceinline__ unsigned cvt_pk_bf16(float lo, float hi) { unsigned r; asm volatile("v_cvt_pk_bf16_f32 %0, %1, %2" : "=v"(r) : "v"(lo), "v"(hi)); return r; }

struct GU { const char* B; int p0, p1, p2, p3; };

template <class Epi, class Sched>
__device__ __forceinline__ void gemm_phase(LAS unsigned char* lds, const char* Abase, const int K, const Sched& S, const Epi& E) {
    const int tid = threadIdx.x, wid = __builtin_amdgcn_readfirstlane(tid >> 6), lane = tid & 63, wr = wid >> 2, wc = wid & 3, fr = lane & 15, fq = lane >> 4;
    const int nt = K / BK;
    int sR[2], sC[2]; unsigned voffB[2];
#pragma unroll
    for (int i = 0; i < 2; ++i) { int R, C; stage_rc(tid * 16 + i * 8192, R, C); sR[i] = R; sC[i] = C; const int Rb = Epi::PERM ? ((R & ~31) + perm32(R & 31)) : R; voffB[i] = (unsigned)(Rb * K + C) * 2u; }
    const size_t kstep = (size_t)(BK * 2);
    const size_t hstep = (size_t)HALF * K * 2;
    const unsigned ldsw = (unsigned)wid * 1024u;
    const int aoff = lds_byte(wr * 64 + fr, fq * 8), boff = lds_byte(wc * 32 + fr, fq * 8);
#define PG_SA(b, h) (((b) * 2 + (h)) * HTB)
#define PG_SB(b, h) ((4 + (b) * 2 + (h)) * HTB)
#define PG_STAGE(bufoff, gbase, voff) do { _Pragma("unroll") for (int _i = 0; _i < 2; ++_i) \
        __builtin_amdgcn_global_load_lds((const unsigned*)((const char*)(gbase) + (voff)[_i]), (LAS unsigned*)(lds + (bufoff) + ldsw + _i * 8192), 16, 0, 0); } while (0)
#define PG_LDA(dst, b, h) do { _Pragma("unroll") for (int m = 0; m < 4; ++m) _Pragma("unroll") for (int k = 0; k < 2; ++k) dst[m][k] = *(const LAS bf16x8*)(lds + PG_SA(b, h) + aoff + m * 2048 + k * 1024); } while (0)
#define PG_LDB(dst, b, h) do { _Pragma("unroll") for (int n = 0; n < 2; ++n) _Pragma("unroll") for (int k = 0; k < 2; ++k) dst[n][k] = *(const LAS bf16x8*)(lds + PG_SB(b, h) + boff + n * 2048 + k * 1024); } while (0)
#define PG_MMA(ai, bj, At, Bt) do { __builtin_amdgcn_s_setprio(1); _Pragma("unroll") for (int m = 0; m < 4; ++m) _Pragma("unroll") for (int n = 0; n < 2; ++n) _Pragma("unroll") for (int k = 0; k < 2; ++k) \
        acc[ai][bj][m][n] = __builtin_amdgcn_mfma_f32_16x16x32_bf16(Bt[n][k], At[m][k], acc[ai][bj][m][n], 0, 0, 0); __builtin_amdgcn_s_setprio(0); } while (0)
#define PG_WAIT_V(n) asm volatile("s_waitcnt vmcnt(" #n ")" ::: "memory")
#define PG_WAIT_L(n) asm volatile("s_waitcnt lgkmcnt(" #n ")" ::: "memory")
#define PG_BAR __builtin_amdgcn_s_barrier()
#define PG_SCHED __builtin_amdgcn_sched_barrier(0)
    GU cur, nxt; int ui = 0;
    if (!S.next(0, cur)) return;
    f32x4 acc[2][2][4][2];
#pragma unroll
    for (int a = 0; a < 2; ++a)
#pragma unroll
        for (int b = 0; b < 2; ++b)
#pragma unroll
            for (int m = 0; m < 4; ++m)
#pragma unroll
                for (int n = 0; n < 2; ++n) acc[a][b][m][n] = (f32x4){0.f, 0.f, 0.f, 0.f};
    bf16x8 At[4][2], B0[2][2], B1[2][2];
    if constexpr (Sched::GATHER) { S.stage_table(cur, 0, lds, wid, lane); PG_WAIT_V(0); PG_BAR; }
    unsigned voC[2][2], voN[2][2];
#pragma unroll
    for (int h = 0; h < 2; ++h)
#pragma unroll
        for (int i = 0; i < 2; ++i) { voC[h][i] = S.voff(cur, 0, lds, h * HALF + sR[i], sC[i]); voN[h][i] = voC[h][i]; }
    const char* cB = cur.B;
    PG_STAGE(PG_SB(0, 0), cB, voffB); PG_STAGE(PG_SB(0, 1), cB + hstep, voffB); PG_STAGE(PG_SA(0, 0), Abase, voC[0]); PG_STAGE(PG_SA(0, 1), Abase, voC[1]);
    if (wr == 1) PG_BAR;
    PG_WAIT_V(2); PG_BAR;
    PG_STAGE(PG_SB(1, 0), cB + kstep, voffB); PG_STAGE(PG_SA(1, 0), Abase + kstep, voC[0]); PG_STAGE(PG_SB(1, 1), cB + hstep + kstep, voffB);
    PG_WAIT_V(6); PG_BAR;
    for (;;) {
        const bool has_next = S.next(ui + 1, nxt);
        if constexpr (Sched::GATHER) { if (has_next) S.stage_table(nxt, (ui + 1) & 1, lds, wid, lane); }
        const char* nB = has_next ? nxt.B : cB;
        for (int t = 0; t < nt; t += 2) {
            const bool last = (t == nt - 2);
            if (last && has_next) {
#pragma unroll
                for (int h = 0; h < 2; ++h)
#pragma unroll
                    for (int i = 0; i < 2; ++i) voN[h][i] = S.voff(nxt, (ui + 1) & 1, lds, h * HALF + sR[i], sC[i]);
            }
            unsigned vo2[2][2];
#pragma unroll
            for (int h = 0; h < 2; ++h)
#pragma unroll
                for (int i = 0; i < 2; ++i) vo2[h][i] = last ? voN[h][i] : voC[h][i];
            const char* a1 = Abase + (size_t)(t + 1) * kstep;
            const char* a2 = last ? Abase : Abase + (size_t)(t + 2) * kstep; const char* b2 = last ? nB : cB + (size_t)(t + 2) * kstep;
            const char* a3 = a2 + kstep; const char* b3 = b2 + kstep;
            PG_LDB(B0, 0, 0); PG_LDB(B1, 0, 1); PG_SCHED; PG_LDA(At, 0, 0); PG_STAGE(PG_SA(1, 1), a1, voC[1]);
            PG_WAIT_V(8); PG_WAIT_L(0); PG_BAR; PG_MMA(0, 0, At, B0); PG_MMA(0, 1, At, B1); PG_BAR; PG_SCHED;
            PG_LDA(At, 0, 1); PG_STAGE(PG_SB(0, 0), b2, voffB); PG_STAGE(PG_SB(0, 1), b2 + hstep, voffB); PG_STAGE(PG_SA(0, 0), a2, vo2[0]);
            PG_WAIT_V(8); PG_WAIT_L(0); PG_BAR; PG_MMA(1, 0, At, B0); PG_MMA(1, 1, At, B1); PG_BAR; PG_SCHED;
            PG_LDB(B0, 1, 0); PG_LDB(B1, 1, 1); PG_SCHED; PG_LDA(At, 1, 0); PG_STAGE(PG_SA(0, 1), a2, vo2[1]);
            PG_WAIT_V(8); PG_WAIT_L(0); PG_BAR; PG_MMA(0, 0, At, B0); PG_MMA(0, 1, At, B1); PG_BAR; PG_SCHED;
            PG_LDA(At, 1, 1); PG_STAGE(PG_SB(1, 0), b3, voffB); PG_STAGE(PG_SB(1, 1), b3 + hstep, voffB); PG_STAGE(PG_SA(1, 0), a3, vo2[0]);
            PG_WAIT_V(8); PG_WAIT_L(0); PG_BAR; PG_MMA(1, 0, At, B0); PG_MMA(1, 1, At, B1); PG_BAR; PG_SCHED;
        }
        if (wr == 0) PG_BAR;
        E(acc, cur, wr, wc, fr, fq);
        if (!has_next) break;
#pragma unroll
        for (int a = 0; a < 2; ++a)
#pragma unroll
            for (int b = 0; b < 2; ++b)
#pragma unroll
                for (int m = 0; m < 4; ++m)
#pragma unroll
                    for (int n = 0; n < 2; ++n) acc[a][b][m][n] = (f32x4){0.f, 0.f, 0.f, 0.f};
        cur = nxt; cB = nB; ++ui;
#pragma unroll
        for (int h = 0; h < 2; ++h)
#pragma unroll
            for (int i = 0; i < 2; ++i) voC[h][i] = voN[h][i];
        if (wr == 1) PG_BAR;
    }
    PG_WAIT_V(0);
    PG_BAR;
#undef PG_SA
#undef PG_SB
#undef PG_STAGE
#undef PG_LDA
#undef PG_LDB
#undef PG_MMA
#undef PG_WAIT_V
#undef PG_WAIT_L
#undef PG_BAR
#undef PG_SCHED
}

__device__ __forceinline__ void static_tile(int L, int nM, int nN, int& pm, int& pn) {
    const int nwg = nM * nN; int wgid = L; { const int q = nwg / 8, r = nwg % 8, xcd = wgid % 8, off = wgid / 8; wgid = (xcd < r ? xcd * (q + 1) : r * (q + 1) + (xcd - r) * q) + off; }
    const int nig = 8 * nN, gid = wgid / nig, fm = gid * 8, gsz = (nM - fm) < 8 ? (nM - fm) : 8;
    pm = fm + ((wgid % nig) % gsz); pn = (wgid % nig) / gsz;
}
struct DenseSched {
    static constexpr bool GATHER = false;
    const char* Bt; int K, nM, nN, G, c, xn, xm0, xpn;
    __device__ __forceinline__ bool next(int i, GU& u) const {
        const int L = i * G + c, nmain = nM * nN; int pm, pn;
        if (L < nmain) static_tile(L, nM, nN, pm, pn); else if (L < nmain + xn) { pm = xm0 + (L - nmain); pn = xpn; } else return false;
        u.B = Bt + (size_t)pn * BM * K * 2; u.p0 = pm; u.p1 = pn; u.p2 = 0; u.p3 = 0; return true;
    }
    __device__ __forceinline__ unsigned voff(const GU& u, int, LAS unsigned char*, int R, int C) const { return (unsigned)(((u.p0 * BM + R) * K + C) * 2); }
    __device__ __forceinline__ void stage_table(const GU&, int, LAS unsigned char*, int, int) const {}
};
template <bool GATHER_> struct MoeSched {
    static constexpr bool GATHER = GATHER_;
    const char* Wt; size_t wstride; int K; const int* list; LAS int* mm; int G, c;
    __device__ __forceinline__ bool next(int i, GU& u) const {
        int L = i * G + c;
        for (int e = 0; e < 16; ++e) { const int n = mm[e], nu = ((n + 255) >> 8) * 4;
            if (L < nu) { const int rt = L >> 2, pn = L & 3; u.B = Wt + (size_t)e * wstride + (size_t)pn * BM * K * 2; u.p0 = e; u.p1 = rt; u.p2 = pn; u.p3 = mm[16 + e]; return true; }
            L -= nu; }
        return false;
    }
    __device__ __forceinline__ unsigned voff(const GU& u, int buf, LAS unsigned char* lds, int R, int C) const {
        if constexpr (GATHER_) { const int tok = ((const LAS int*)(lds + TAB_OFF))[buf * 256 + R]; return (unsigned)((tok * K + C) * 2); }
        else return (unsigned)(((u.p3 + u.p1 * BM + R) * K + C) * 2);
    }
    __device__ __forceinline__ void stage_table(const GU& u, int buf, LAS unsigned char* lds, int wid, int lane) const {
        if constexpr (GATHER_) { const int r = (wid & 3) * 64 + lane;
            __builtin_amdgcn_global_load_lds((const unsigned*)(list + u.p0 * CAP + u.p1 * BM + r), (LAS unsigned*)(lds + TAB_OFF + buf * 1024 + (wid & 3) * 256), 4, 0, 0); }
    }
};

struct EpiInProj {
    static constexpr bool PERM = false;
    unsigned char* ws;
    __device__ __forceinline__ void operator()(const f32x4 (&acc)[2][2][4][2], const GU& u, int wr, int wc, int fr, int fq) const {
        const int pm = u.p0, pn = u.p1; const bool isctx = pm >= T / BM;
        float inv[4];
#pragma unroll
        for (int j = 0; j < 4; ++j) inv[j] = exp2f(-(float)(4 * fq + j) * (13.287712379549449f / 16.f));
#pragma unroll
        for (int bj = 0; bj < 2; ++bj) {
            const int cb = pn * BM + bj * HALF + wc * 32;
            bf16* dst; int pitch, cbase; bool rope = false;
            if (cb < 512) { dst = (bf16*)(ws + WS_UF); pitch = 512; cbase = 0; }
            else if (cb < 1024) { dst = (bf16*)(ws + WS_Q); pitch = 512; cbase = 512; rope = true; }
            else if (cb < 1152) { dst = isctx ? (bf16*)(ws + WS_CK) : (bf16*)(ws + WS_K); pitch = 128; cbase = 1024; rope = !isctx; }
            else { dst = isctx ? (bf16*)(ws + WS_CV) : (bf16*)(ws + WS_V); pitch = 128; cbase = 1152; }
            const bool bycol = ((cb >> 5) & 1) != 0;
#pragma unroll
            for (int ai = 0; ai < 2; ++ai)
#pragma unroll
                for (int m = 0; m < 4; ++m) {
                    const int row = pm * BM + ai * HALF + wr * 64 + m * 16 + fr;
                    f32x4 v0 = acc[ai][bj][m][0], v1 = acc[ai][bj][m][1];
                    if (rope) { const int l = row & (L - 1); const float pos = (float)(bycol ? (l & 63) : (l >> 6));
#pragma unroll
                        for (int j = 0; j < 4; ++j) { const float ang = pos * inv[j], cs = __cosf(ang), sn = __sinf(ang); const float x1 = v0[j], x2 = v1[j]; v0[j] = x1 * cs - x2 * sn; v1[j] = x1 * sn + x2 * cs; } }
                    const int orow = isctx ? row - T : row;
                    if (FAST_ATTN && cb >= 1152) {
                        const int kp = isctx ? CL : L, bb = isctx ? (orow >> 8) : (orow >> 13), key = isctx ? (orow & (CL - 1)) : (orow & (L - 1));
#pragma unroll
                        for (int n = 0; n < 2; ++n)
#pragma unroll
                            for (int j = 0; j < 4; ++j) { const int c = (cb - 1152) + 16 * n + 4 * fq + j;
                                dst[((size_t)bb * 128 + c) * kp + key] = (bf16)f2bf(n ? v1[j] : v0[j]); }
                        continue;
                    }
                    bf16* o = dst + (size_t)orow * pitch + (cb - cbase) + 4 * fq;
                    u32x2 w0, w1; w0.x = cvt_pk_bf16(v0[0], v0[1]); w0.y = cvt_pk_bf16(v0[2], v0[3]); w1.x = cvt_pk_bf16(v1[0], v1[1]); w1.y = cvt_pk_bf16(v1[2], v1[3]);
                    *(u32x2*)o = w0; *(u32x2*)(o + 16) = w1;
                }
        }
    }
};
struct EpiRes {
    static constexpr bool PERM = false;
    const float* base; float* X; const float* gate; const float* bias;
    __device__ __forceinline__ void operator()(const f32x4 (&acc)[2][2][4][2], const GU& u, int wr, int wc, int fr, int fq) const {
        const int row0 = u.p0 * BM + wr * 64 + fr, col0 = u.p1 * BM + wc * 32 + 4 * fq; const int b = (u.p0 * BM) >> 13;
        f32x4 gv[2][2], bv[2][2];
#pragma unroll
        for (int bj = 0; bj < 2; ++bj)
#pragma unroll
            for (int n = 0; n < 2; ++n) { gv[bj][n] = *(const f32x4*)(gate + (size_t)b * 6144 + col0 + bj * HALF + n * 16); bv[bj][n] = bias ? *(const f32x4*)(bias + col0 + bj * HALF + n * 16) : (f32x4){0.f, 0.f, 0.f, 0.f}; }
#pragma unroll
        for (int ai = 0; ai < 2; ++ai)
#pragma unroll
            for (int mp = 0; mp < 2; ++mp) {
                f32x4 bs[2][2][2];
#pragma unroll
                for (int mm = 0; mm < 2; ++mm) { const size_t off = (size_t)(row0 + ai * HALF + (2 * mp + mm) * 16) * D + col0;
#pragma unroll
                    for (int bj = 0; bj < 2; ++bj)
#pragma unroll
                        for (int n = 0; n < 2; ++n) bs[mm][bj][n] = *(const f32x4*)(base + off + bj * HALF + n * 16); }
#pragma unroll
                for (int mm = 0; mm < 2; ++mm) { const int m = 2 * mp + mm; const size_t off = (size_t)(row0 + ai * HALF + m * 16) * D + col0;
#pragma unroll
                    for (int bj = 0; bj < 2; ++bj)
#pragma unroll
                        for (int n = 0; n < 2; ++n) *(f32x4*)(X + off + bj * HALF + n * 16) = bs[mm][bj][n] + gv[bj][n] * (acc[ai][bj][m][n] + bv[bj][n]); }
                asm volatile("" ::: "memory"); }
    }
};
struct EpiGLU {
    static constexpr bool PERM = true;
    bf16* U; const float* bias;
    __device__ __forceinline__ void operator()(const f32x4 (&acc)[2][2][4][2], const GU& u, int wr, int wc, int fr, int fq) const {
        const int row0 = u.p0 * BM + wr * 64 + fr, col0 = u.p1 * HALF + wc * 32 + 8 * fq;
        f32x4 ba[2], bg[2];
#pragma unroll
        for (int n = 0; n < 2; ++n) { ba[n] = *(const f32x4*)(bias + col0 + 4 * n); bg[n] = *(const f32x4*)(bias + 1024 + col0 + 4 * n); }
#pragma unroll
        for (int ai = 0; ai < 2; ++ai)
#pragma unroll
            for (int m = 0; m < 4; ++m) { f32x4 o[2];
#pragma unroll
                for (int n = 0; n < 2; ++n) { const f32x4 a = acc[ai][0][m][n] + ba[n], g = acc[ai][1][m][n] + bg[n];
#pragma unroll
                    for (int j = 0; j < 4; ++j) o[n][j] = a[j] * sigmoid_f(g[j]); }
                u32x4 w; w.x = cvt_pk_bf16(o[0][0], o[0][1]); w.y = cvt_pk_bf16(o[0][2], o[0][3]); w.z = cvt_pk_bf16(o[1][0], o[1][1]); w.w = cvt_pk_bf16(o[1][2], o[1][3]);
                *(u32x4*)(U + (size_t)(row0 + ai * HALF + m * 16) * D + col0) = w; }
    }
};
struct EpiGateUp {
    static constexpr bool PERM = true;
    bf16* HID; const float* slot_w; LAS int* mm;
    __device__ __forceinline__ void operator()(const f32x4 (&acc)[2][2][4][2], const GU& u, int wr, int wc, int fr, int fq) const {
        const int e = u.p0, n_e = mm[e], r0 = u.p1 * BM + wr * 64 + fr, col0 = u.p2 * HALF + wc * 32 + 8 * fq;
        float wv[2][4];
#pragma unroll
        for (int ai = 0; ai < 2; ++ai)
#pragma unroll
            for (int m = 0; m < 4; ++m) wv[ai][m] = slot_w[e * CAP + r0 + ai * HALF + m * 16];
#pragma unroll
        for (int ai = 0; ai < 2; ++ai)
#pragma unroll
            for (int m = 0; m < 4; ++m) { const int r = r0 + ai * HALF + m * 16;
                if (r < n_e) { const float w = wv[ai][m]; f32x4 o[2];
#pragma unroll
                    for (int n = 0; n < 2; ++n) { const f32x4 g = acc[ai][0][m][n], up = acc[ai][1][m][n];
#pragma unroll
                        for (int j = 0; j < 4; ++j) o[n][j] = w * silu_f(g[j]) * up[j]; }
                    u32x4 q; q.x = cvt_pk_bf16(o[0][0], o[0][1]); q.y = cvt_pk_bf16(o[0][2], o[0][3]); q.z = cvt_pk_bf16(o[1][0], o[1][1]); q.w = cvt_pk_bf16(o[1][2], o[1][3]);
                    *(u32x4*)(HID + (size_t)(u.p3 + r) * FF + col0) = q; } }
    }
};
struct EpiDown {
    static constexpr bool PERM = true;
    bf16* Y; LAS int* mm;
    __device__ __forceinline__ void operator()(const f32x4 (&acc)[2][2][4][2], const GU& u, int wr, int wc, int fr, int fq) const {
        const int e = u.p0, n_e = mm[e], r0 = u.p1 * BM + wr * 64 + fr, col0 = u.p2 * BM + wc * 32 + 8 * fq;
#pragma unroll
        for (int ai = 0; ai < 2; ++ai)
#pragma unroll
            for (int m = 0; m < 4; ++m) { const int r = r0 + ai * HALF + m * 16;
                if (r < n_e) {
#pragma unroll
                    for (int bj = 0; bj < 2; ++bj) { const f32x4 v0 = acc[ai][bj][m][0], v1 = acc[ai][bj][m][1];
                        u32x4 q; q.x = cvt_pk_bf16(v0[0], v0[1]); q.y = cvt_pk_bf16(v0[2], v0[3]); q.z = cvt_pk_bf16(v1[0], v1[1]); q.w = cvt_pk_bf16(v1[2], v1[3]);
                        *(u32x4*)(Y + (size_t)(u.p3 + r) * D + col0 + bj * HALF) = q; } } }
    }
};
}

__device__ __forceinline__ void fast_inproj(Frame& F) {
    pg::DenseSched S{(const char*)(F.ws + WS_WIN), D, T / 256, N_IN / 256, F.G, F.wg, TC / 256, T / 256, 4};
    pg::EpiInProj E{F.ws};
    pg::gemm_phase(F.lds, (const char*)(F.ws + WS_HB), D, S, E);
}
__device__ __forceinline__ void fast_outproj(Frame& F, size_t a_off, size_t w_off, const float* base, float* X, const float* gate, const float* bias) {
    pg::DenseSched S{(const char*)(F.ws + w_off), D, T / 256, D / 256, F.G, F.wg, 0, 0, 0};
    pg::EpiRes E{base, X, gate, bias};
    pg::gemm_phase(F.lds, (const char*)(F.ws + a_off), D, S, E);
}
__device__ __forceinline__ void fast_pw1(Frame& F) {
    pg::DenseSched S{(const char*)(F.ws + WS_WPW1), D, T / 256, 2048 / 256, F.G, F.wg, 0, 0, 0};
    pg::EpiGLU E{(bf16*)(F.ws + WS_U), F.in[I_PW1B]};
    pg::gemm_phase(F.lds, (const char*)(F.ws + WS_HB), D, S, E);
}
__device__ __forceinline__ void fast_moe_gateup(Frame& F, int layer) {
    LAS int* mm = moe_map(F, layer);
    pg::MoeSched<true> S{(const char*)(F.ws + WS_WGU) + (size_t)layer * 16 * 1024 * 1024 * 2, (size_t)1024 * 1024 * 2, D, (const int*)(F.ws + WS_SLOTT) + layer * 16 * CAP, mm, F.G, F.wg};
    pg::EpiGateUp E{(bf16*)(F.ws + WS_HID), (const float*)(F.ws + WS_SLOTW) + layer * 16 * CAP, mm};
    pg::gemm_phase(F.lds, (const char*)(F.ws + WS_HB), D, S, E);
}
__device__ __forceinline__ void fast_moe_down(Frame& F, int layer) {
    LAS int* mm = moe_map(F, layer);
    pg::MoeSched<false> S{(const char*)(F.ws + WS_WDN) + (size_t)layer * 16 * 1024 * 512 * 2, (size_t)1024 * 512 * 2, FF, nullptr, mm, F.G, F.wg};
    pg::EpiDown E{(bf16*)(F.ws + WS_Y), mm};
    pg::gemm_phase(F.lds, (const char*)(F.ws + WS_HID), FF, S, E);
}


typedef __bf16 b16x2_t __attribute__((ext_vector_type(2)));
__device__ __forceinline__ unsigned pkbf(float a, float b) { typedef float f2 __attribute__((ext_vector_type(2))); f2 v = {a, b}; return __builtin_bit_cast(unsigned, __builtin_convertvector(v, b16x2_t)); }
struct AttnBlk { const bf16* kp; const bf16* vp; int pitch; int kb; bool valid, masked; };
__device__ __forceinline__ AttnBlk attn_blk(const unsigned char* ws, int bi, int b, int kvh, int qs) {
    AttnBlk a;
    if (bi < 8) { a.kp = (const bf16*)(ws + WS_CK) + (size_t)(b * CL + bi * 32) * 128 + kvh * 64; a.vp = (const bf16*)(ws + WS_CV) + (size_t)(b * 2 + kvh) * 64 * CL + bi * 32; a.pitch = CL; a.kb = 0; a.valid = true; a.masked = false; }
    else { const int kb = qs - 128 + 32 * (bi - 8); a.valid = (kb >= 0 && kb < L); a.kb = kb; a.masked = true; a.pitch = L;
        a.kp = (const bf16*)(ws + WS_K) + (size_t)(b * L + kb) * 128 + kvh * 64; a.vp = (const bf16*)(ws + WS_V) + (size_t)(b * 2 + kvh) * 64 * L + kb; }
    return a;
}
__device__ __forceinline__ void attn_load(const AttnBlk& a, int r, int h, bf16x8 (&kf)[4], u32x4 (&vf)[2][2]) {
    if (a.valid) {
#pragma unroll
        for (int s = 0; s < 4; ++s) kf[s] = *(const bf16x8*)(a.kp + (size_t)r * 128 + 16 * s + 8 * h);
#pragma unroll
        for (int db = 0; db < 2; ++db)
#pragma unroll
            for (int ks = 0; ks < 2; ++ks) { const bf16* vr = a.vp + (size_t)(32 * db + r) * a.pitch + 16 * ks + 4 * h;
                const u32x2 lo = *(const u32x2*)vr, hi = *(const u32x2*)(vr + 8); vf[db][ks] = (u32x4){lo.x, lo.y, hi.x, hi.y}; }
    }
}
__device__ __forceinline__ void attn_compute(const AttnBlk& a, int qs, int r, int h, const bf16x8 (&kf)[4], const u32x4 (&vf)[2][2], const bf16x8 (&qf)[2][4],
                                             f32x16 (&o)[2][2], float (&m)[2], float (&l)[2]) {
    if (!a.valid) return;
#pragma unroll
    for (int nq = 0; nq < 2; ++nq) {
        f32x16 st;
#pragma unroll
        for (int i = 0; i < 16; ++i) st[i] = 0.f;
#pragma unroll
        for (int s = 0; s < 4; ++s) st = __builtin_amdgcn_mfma_f32_32x32x16_bf16(kf[s], qf[nq][s], st, 0, 0, 0);
        float t[16]; float tmax = -INFINITY;
        const int dbase = a.kb - qs - 32 * nq - r + 4 * h;
#pragma unroll
        for (int i = 0; i < 16; ++i) { float v = st[i] * (0.125f * 1.4426950408889634f);
            if (a.masked) { const int df = dbase + (i & 3) + 8 * (i >> 2); v = (df >= -128 && df <= 128) ? v : -INFINITY; }
            t[i] = v; tmax = fmaxf(tmax, v); }
        tmax = fmaxf(tmax, __shfl_xor(tmax, 32));
        const float mn = fmaxf(m[nq], tmax), alpha = __builtin_amdgcn_exp2f(m[nq] - mn); m[nq] = mn;
        float ps = 0.f;
#pragma unroll
        for (int i = 0; i < 16; ++i) { t[i] = __builtin_amdgcn_exp2f(t[i] - mn); ps += t[i]; }
        l[nq] = l[nq] * alpha + ps;
#pragma unroll
        for (int i = 0; i < 16; ++i) { o[0][nq][i] *= alpha; o[1][nq][i] *= alpha; }
        bf16x8 pf[2];
#pragma unroll
        for (int ks = 0; ks < 2; ++ks) { const u32x4 w = {pkbf(t[8 * ks], t[8 * ks + 1]), pkbf(t[8 * ks + 2], t[8 * ks + 3]), pkbf(t[8 * ks + 4], t[8 * ks + 5]), pkbf(t[8 * ks + 6], t[8 * ks + 7])};
            pf[ks] = __builtin_bit_cast(bf16x8, w); }
#pragma unroll
        for (int db = 0; db < 2; ++db)
#pragma unroll
            for (int ks = 0; ks < 2; ++ks) o[db][nq] = __builtin_amdgcn_mfma_f32_32x32x16_bf16(__builtin_bit_cast(bf16x8, vf[db][ks]), pf[ks], o[db][nq], 0, 0, 0);
    }
}
__device__ __forceinline__ void phase_attn_mfma(Frame& F) {
    const bf16* Q = (const bf16*)(F.ws + WS_Q); bf16* MIX = (bf16*)(F.ws + WS_MIX);
    const int g = F.wave >> 1, half = F.wave & 1, r = F.lane & 31, h = F.lane >> 5;
    for (int item = F.wg; item < NB * 2 * 64; item += F.G) {
        const int qb = item & 63, kvh = (item >> 6) & 1, b = item >> 7, hd = kvh * 4 + g, qs = qb * 128 + half * 64;
        bf16x8 qf[2][4];
#pragma unroll
        for (int nq = 0; nq < 2; ++nq)
#pragma unroll
            for (int s = 0; s < 4; ++s) qf[nq][s] = *(const bf16x8*)(Q + (size_t)(b * L + qs + 32 * nq + r) * 512 + hd * 64 + 16 * s + 8 * h);
        f32x16 o[2][2];
#pragma unroll
        for (int db = 0; db < 2; ++db)
#pragma unroll
            for (int nq = 0; nq < 2; ++nq)
#pragma unroll
                for (int i = 0; i < 16; ++i) o[db][nq][i] = 0.f;
        float m[2], l[2];
        m[0] = m[1] = F.in[I_SINK][hd] * 1.4426950408889634f; l[0] = l[1] = (h == 0) ? 1.f : 0.f;
        bf16x8 kfA[4], kfB[4]; u32x4 vfA[2][2], vfB[2][2];
        AttnBlk ba = attn_blk(F.ws, 0, b, kvh, qs), bb;
        attn_load(ba, r, h, kfA, vfA);
#pragma unroll 1
        for (int bi = 0; bi < 18; bi += 2) {
            bb = attn_blk(F.ws, bi + 1, b, kvh, qs); attn_load(bb, r, h, kfB, vfB);
            attn_compute(ba, qs, r, h, kfA, vfA, qf, o, m, l);
            if (bi + 2 < 18) { ba = attn_blk(F.ws, bi + 2, b, kvh, qs); attn_load(ba, r, h, kfA, vfA); }
            attn_compute(bb, qs, r, h, kfB, vfB, qf, o, m, l);
        }
#pragma unroll
        for (int nq = 0; nq < 2; ++nq) {
            const float lt = l[nq] + __shfl_xor(l[nq], 32), il = 1.f / lt;
            bf16* orow = MIX + (size_t)(b * L + qs + 32 * nq + r) * 1024 + 512 + hd * 64;
#pragma unroll
            for (int db = 0; db < 2; ++db)
#pragma unroll
                for (int i4 = 0; i4 < 4; ++i4) { u32x2 w; w.x = pkbf(o[db][nq][4 * i4] * il, o[db][nq][4 * i4 + 1] * il); w.y = pkbf(o[db][nq][4 * i4 + 2] * il, o[db][nq][4 * i4 + 3] * il);
                    *(u32x2*)(orow + 32 * db + 8 * i4 + 4 * h) = w; }
        }
    }
}


constexpr int F1_PC = 136, F1_PW = 68, F2_P = 264;
constexpr int F1_CSC = 0, F1_CSS = 128 * F1_PC * 2, F1_C64 = 2 * 128 * F1_PC * 2, F1_S64 = F1_C64 + 64 * F1_PW * 2;
__device__ __forceinline__ bf16x8 pack8(float a0, float a1, float a2, float a3, float a4, float a5, float a6, float a7) {
    const u32x4 w = {pkbf(a0, a1), pkbf(a2, a3), pkbf(a4, a5), pkbf(a6, a7)}; return __builtin_bit_cast(bf16x8, w); }
__device__ __forceinline__ void phase_fft1_mfma(Frame& F) {
    __syncthreads();
    LAS bf16* csc = (LAS bf16*)(F.lds + F1_CSC); LAS bf16* css = (LAS bf16*)(F.lds + F1_CSS); LAS bf16* c64 = (LAS bf16*)(F.lds + F1_C64); LAS bf16* s64 = (LAS bf16*)(F.lds + F1_S64);
    for (int i = F.tid; i < 128 * 128; i += NTHR) { const int n = i >> 7, k = i & 127; const float ang = (float)((n * k) & 127) * (6.283185307179586f / 128.f);
        csc[n * F1_PC + k] = (bf16)f2bf(__cosf(ang)); css[n * F1_PC + k] = (bf16)f2bf(__sinf(ang)); }
    for (int i = F.tid; i < 64 * 64; i += NTHR) { const int c = i >> 6, a = i & 63; const float ang = (float)((c * a) & 63) * (6.283185307179586f / 64.f);
        c64[c * F1_PW + a] = (bf16)f2bf(__cosf(ang)); s64[c * F1_PW + a] = (bf16)f2bf(__sinf(ang)); }
    __syncthreads();
    const bf16* UF = (const bf16*)(F.ws + WS_UF); bf16* Gb = (bf16*)(F.ws + WS_G);
    const int r = F.lane & 31, h = F.lane >> 5, g = F.wave >> 1;
    for (int item = F.wg; item < NB * FN2; item += F.G) {
        const int b = item >> 7, bp = item & 127;
#pragma unroll 1
        for (int q = 0; q < 2; ++q) {
            const int cbk = 2 * F.wave + q, n = 32 * (cbk & 3) + r, ch = 32 * cbk + r;
            f32x16 zr[2], zi[2];
#pragma unroll
            for (int rb = 0; rb < 2; ++rb) {
                bf16x8 uf[8];
#pragma unroll
                for (int s2 = 0; s2 < 8; ++s2) uf[s2] = *(const bf16x8*)(UF + (size_t)(b * L + 128 * (32 * rb + r) + bp) * 512 + g * 128 + 16 * s2 + 8 * h);
#pragma unroll
                for (int i = 0; i < 16; ++i) { zr[rb][i] = 0.f; zi[rb][i] = 0.f; }
#pragma unroll
                for (int s2 = 0; s2 < 8; ++s2) { const bf16x8 bc = *(const LAS bf16x8*)(csc + n * F1_PC + 16 * s2 + 8 * h), bs = *(const LAS bf16x8*)(css + n * F1_PC + 16 * s2 + 8 * h);
                    zr[rb] = __builtin_amdgcn_mfma_f32_32x32x16_bf16(uf[s2], bc, zr[rb], 0, 0, 0); zi[rb] = __builtin_amdgcn_mfma_f32_32x32x16_bf16(uf[s2], bs, zi[rb], 0, 0, 0); }
                __builtin_amdgcn_sched_barrier(0);
            }
            bf16x8 zfr[4], zfi[4];
#pragma unroll
            for (int ks = 0; ks < 4; ++ks) { const int rb = ks >> 1, o = 8 * (ks & 1);
                zfr[ks] = pack8(zr[rb][o], zr[rb][o + 1], zr[rb][o + 2], zr[rb][o + 3], zr[rb][o + 4], zr[rb][o + 5], zr[rb][o + 6], zr[rb][o + 7]);
                zfi[ks] = pack8(-zi[rb][o], -zi[rb][o + 1], -zi[rb][o + 2], -zi[rb][o + 3], -zi[rb][o + 4], -zi[rb][o + 5], -zi[rb][o + 6], -zi[rb][o + 7]); }
            __builtin_amdgcn_sched_barrier(0);
#pragma unroll 1
            for (int rbc = 0; rbc < 2; ++rbc) {
                f32x16 gr, gi; const int cr = 32 * rbc + r;
#pragma unroll
                for (int i = 0; i < 16; ++i) { gr[i] = 0.f; gi[i] = 0.f; }
#pragma unroll
                for (int ks = 0; ks < 4; ++ks) {
                    const u32x2 cl = *(const LAS u32x2*)(c64 + cr * F1_PW + 16 * ks + 4 * h), chh = *(const LAS u32x2*)(c64 + cr * F1_PW + 16 * ks + 8 + 4 * h);
                    const u32x2 sl = *(const LAS u32x2*)(s64 + cr * F1_PW + 16 * ks + 4 * h), shh = *(const LAS u32x2*)(s64 + cr * F1_PW + 16 * ks + 8 + 4 * h);
                    const u32x4 sw = {sl.x, sl.y, shh.x, shh.y}; const u32x4 swn = sw ^ 0x80008000u;
                    const bf16x8 wc = __builtin_bit_cast(bf16x8, ((u32x4){cl.x, cl.y, chh.x, chh.y})), wsn = __builtin_bit_cast(bf16x8, sw), wsm = __builtin_bit_cast(bf16x8, swn);
                    gr = __builtin_amdgcn_mfma_f32_32x32x16_bf16(wc, zfr[ks], gr, 0, 0, 0); gr = __builtin_amdgcn_mfma_f32_32x32x16_bf16(wsn, zfi[ks], gr, 0, 0, 0);
                    gi = __builtin_amdgcn_mfma_f32_32x32x16_bf16(wc, zfi[ks], gi, 0, 0, 0); gi = __builtin_amdgcn_mfma_f32_32x32x16_bf16(wsm, zfr[ks], gi, 0, 0, 0); }
                __builtin_amdgcn_sched_barrier(0);
#pragma unroll
                for (int i = 0; i < 16; ++i) { const int c = 32 * rbc + crow(i, h); const float ang = (float)(bp * c) * (6.283185307179586f / 8192.f), cs = __cosf(ang), sn = __sinf(ang);
                    const float re = gr[i] * cs + gi[i] * sn, im = gi[i] * cs - gr[i] * sn;
                    bf16* o = Gb + (size_t)((b * FN1 + c) * FN2 + bp) * 1024 + ch; o[0] = (bf16)f2bf(re); o[512] = (bf16)f2bf(im);
                    if ((i & 3) == 3) __builtin_amdgcn_sched_barrier(0); }
            }
        }
    }
    __syncthreads();
}
__device__ __forceinline__ void phase_fft2_mfma(Frame& F) {
    __syncthreads();
    LAS bf16* t2 = (LAS bf16*)F.lds;
    for (int i = F.tid; i < 128 * 256; i += NTHR) { const int d = i >> 8, k = i & 255; const float ang = (float)((d * (k & 127)) & 127) * (6.283185307179586f / 128.f);
        t2[d * F2_P + k] = (bf16)f2bf(k < 128 ? __cosf(ang) : __sinf(ang)); }
    __syncthreads();
    const bf16* Gb = (const bf16*)(F.ws + WS_G); bf16* MIX = (bf16*)(F.ws + WS_MIX);
    const int r = F.lane & 31, h = F.lane >> 5;
    for (int item = F.wg; item < NB * FN1; item += F.G) {
        const int b = item >> 6, c = item & 63;
        const bf16* Gp = Gb + (size_t)((b * FN1 + c) * FN2) * 1024 + 64 * F.wave + r;
        f32x16 y[4][2];
#pragma unroll
        for (int rb = 0; rb < 4; ++rb)
#pragma unroll
            for (int cb = 0; cb < 2; ++cb)
#pragma unroll
                for (int i = 0; i < 16; ++i) y[rb][cb][i] = 0.f;
#pragma unroll 1
        for (int ks = 0; ks < 16; ++ks) {
            const bf16* p = Gp + (size_t)(16 * (ks & 7) + 8 * h) * 1024 + (ks >> 3) * 512;
            bf16x8 bfr[2];
#pragma unroll
            for (int cb = 0; cb < 2; ++cb) { unsigned e[8];
#pragma unroll
                for (int j = 0; j < 8; ++j) e[j] = p[(size_t)j * 1024 + 32 * cb];
                const u32x4 w = {e[0] | (e[1] << 16), e[2] | (e[3] << 16), e[4] | (e[5] << 16), e[6] | (e[7] << 16)}; bfr[cb] = __builtin_bit_cast(bf16x8, w); }
#pragma unroll
            for (int rb = 0; rb < 4; ++rb) { const bf16x8 a = *(const LAS bf16x8*)(t2 + (32 * rb + r) * F2_P + 16 * ks + 8 * h);
#pragma unroll
                for (int cb = 0; cb < 2; ++cb) y[rb][cb] = __builtin_amdgcn_mfma_f32_32x32x16_bf16(a, bfr[cb], y[rb][cb], 0, 0, 0); }
        }
#pragma unroll
        for (int rb = 0; rb < 4; ++rb)
#pragma unroll
            for (int cb = 0; cb < 2; ++cb)
#pragma unroll
                for (int i = 0; i < 16; ++i) { const int d = 32 * rb + crow(i, h); MIX[(size_t)(b * L + c + 64 * d) * 1024 + 64 * F.wave + 32 * cb + r] = (bf16)f2bf(y[rb][cb][i] * (1.f / 1024.f)); }
    }
    __syncthreads();
}


typedef float f32x2_t __attribute__((ext_vector_type(2)));
template <int IR> struct DwIn {
    static __device__ __forceinline__ void run(const unsigned (&uin)[62], const f32x2_t (&w)[31], f32x2_t (&o)[32]) {
        const f32x2_t x = {bflo(uin[IR]), bfhi(uin[IR])};
#pragma unroll
        for (int r = 0; r < 32; ++r) { if (IR - r >= 0 && IR - r <= 30) o[r] += w[(IR - r >= 0 && IR - r <= 30) ? IR - r : 0] * x; }
        DwIn<IR + 1>::run(uin, w, o);
    }
};
template <> struct DwIn<62> { static __device__ __forceinline__ void run(const unsigned (&)[62], const f32x2_t (&)[31], f32x2_t (&)[32]) {} };
__device__ __forceinline__ void phase_dwconv_fast(Frame& F) {
    const bf16* U = (const bf16*)(F.ws + WS_U); bf16* V1 = (bf16*)(F.ws + WS_V1);
    const float* dww = F.in[I_DWW];
    const int c0 = 2 * F.tid;
    f32x2_t w[31];
#pragma unroll
    for (int j = 0; j < 31; ++j) w[j] = *(const f32x2_t*)(dww + (size_t)j * D + c0);
    const f32x2_t bb = *(const f32x2_t*)(F.in[I_DWB] + c0), gg = *(const f32x2_t*)(F.in[I_LNG] + c0), lb = *(const f32x2_t*)(F.in[I_LNB] + c0);
    LAS float* red = (LAS float*)F.lds;
    LAS float* stat = red + 32 * 8 * 2;
    __syncthreads();
    for (int item = F.wg; item < T / 32; item += F.G) {
        const int row0 = item * 32, l0 = row0 & (L - 1);
        unsigned uin[62];
#pragma unroll
        for (int ir = 0; ir < 62; ++ir) { const int l = l0 - 15 + ir; const bool ok = (l >= 0 && l < L);
            const unsigned u = *(const unsigned*)(U + (size_t)(ok ? row0 - 15 + ir : row0) * D + c0); uin[ir] = ok ? u : 0u; }
        f32x2_t o[32];
#pragma unroll
        for (int r = 0; r < 32; ++r) o[r] = bb;
        DwIn<0>::run(uin, w, o);
#pragma unroll
        for (int r = 0; r < 32; ++r) { const float sm = wave_sum(o[r].x + o[r].y), sq = wave_sum(o[r].x * o[r].x + o[r].y * o[r].y);
            if (F.lane == 0) { red[(r * 8 + F.wave) * 2] = sm; red[(r * 8 + F.wave) * 2 + 1] = sq; } }
        __syncthreads();
        if (F.tid < 32) { float sm = 0.f, sq = 0.f;
#pragma unroll
            for (int wv = 0; wv < 8; ++wv) { sm += red[(F.tid * 8 + wv) * 2]; sq += red[(F.tid * 8 + wv) * 2 + 1]; }
            const float mean = sm * (1.f / D), var = fmaxf(sq * (1.f / D) - mean * mean, 0.f);
            stat[2 * F.tid] = mean; stat[2 * F.tid + 1] = rsqrtf(var + EPS); }
        __syncthreads();
#pragma unroll
        for (int r = 0; r < 32; ++r) { const float mean = stat[2 * r], rstd = stat[2 * r + 1];
            const float y0 = silu_f((o[r].x - mean) * rstd * gg.x + lb.x), y1 = silu_f((o[r].y - mean) * rstd * gg.y + lb.y);
            *(unsigned*)(V1 + (size_t)(row0 + r) * D + c0) = pkbf(y0, y1); }
        __syncthreads();
    }
}

constexpr int NPH = 18;
__global__ void __launch_bounds__(NTHR, 2) mega(Args args) {
    extern __shared__ __attribute__((aligned(16))) unsigned char lds[];
    Frame F;
    F.lds = (LAS unsigned char*)lds;
    F.tid = threadIdx.x; F.lane = F.tid & 63; F.wave = __builtin_amdgcn_readfirstlane(F.tid >> 6);
    F.G = gridDim.x; F.wg = blockIdx.x;
    F.in = args.in; F.out = args.out; F.ws = args.ws; F.ctl = (unsigned*)(args.ws + WS_CTL);
    volatile LAS unsigned* bst = (volatile LAS unsigned*)(F.lds + LDS_BYTES - 16);
    if (F.tid < 4) bst[F.tid] = 0u;
    __syncthreads();
    const int lo = args.ph_lo, hi = args.ph_hi;
    XcdBarrier bar; bar.bar = F.ctl + CW_BAR; bar.x = 0; bar.st = bst;
    if (hi - lo > 1) bar = xcd_barrier_post(F.ctl + CW_BAR, bst);
#define IN(k) (lo <= (k) && (k) < hi)
#define SEAM(k) do { if (IN(k) && IN((k) + 1)) xcd_barrier(bar); } while (0)
    const float* mod = (const float*)(F.ws + WS_MOD);

#ifndef DBL_MASK
#define DBL_MASK 0x0u
#endif
#define RUN(k, body) do { if (IN(k)) { _Pragma("unroll 1") for (int _r = 0; _r < ((((DBL_MASK) >> (k)) & 1u) ? 2 : 1); ++_r) { if (_r) xcd_barrier(bar); body; } } } while (0)
    RUN(0, phase_prep(F)); SEAM(0);
    RUN(1, phase_norm1_l0(F)); SEAM(1);
    RUN(2, if (FAST_GEMM) fast_inproj(F); else phase_inproj(F)); SEAM(2);
    if (IN(3)) {
#pragma unroll 1
        for (int _r = 0; _r < ((DBL_MASK & 0x100000u) ? 2 : 1); ++_r) { if (FAST_ATTN && FAST_GEMM) phase_attn_mfma(F); else phase_attn_simple(F); }
#pragma unroll 1
        for (int _r = 0; _r < ((DBL_MASK & 0x200000u) ? 2 : 1); ++_r) { if (FAST_FFT) phase_fft1_mfma(F); else phase_fft1_simple(F); }
    } SEAM(3);
    RUN(4, if (FAST_FFT) phase_fft2_mfma(F); else phase_fft2_simple(F)); SEAM(4);
    if (IN(5)) { if (!FAST_FFT) phase_fft3_simple(F); } if (!FAST_FFT) SEAM(5);
    RUN(6, if (FAST_GEMM) fast_outproj(F, WS_MIX, WS_WOUT, F.in[I_X], F.out, mod + 2048, nullptr); else phase_outproj(F, (const bf16*)(F.ws + WS_MIX), (const bf16*)(F.ws + WS_WOUT), F.in[I_X], F.out, mod + 2048, nullptr)); SEAM(6);
    if (IN(7)) { phase_norm2_route(F, 0); } SEAM(7);
    RUN(8, if (FAST_GEMM) fast_moe_gateup(F, 0); else phase_moe_gateup(F, 0)); SEAM(8);
    RUN(9, if (FAST_GEMM) fast_moe_down(F, 0); else phase_moe_down(F, 0)); SEAM(9);
    if (IN(10)) { phase_combine<false>(F, 0); } SEAM(10);
    RUN(11, if (FAST_GEMM) fast_pw1(F); else phase_pw1(F)); SEAM(11);
    RUN(12, phase_dwconv_fast(F)); SEAM(12);
    if (IN(13)) { if (FAST_GEMM) fast_outproj(F, WS_V1, WS_WPW2, F.out, F.out, mod + 5 * 6144 + 2048, F.in[I_PW2B]); else phase_outproj(F, (const bf16*)(F.ws + WS_V1), (const bf16*)(F.ws + WS_WPW2), F.out, F.out, mod + 5 * 6144 + 2048, F.in[I_PW2B]); } SEAM(13);
    if (IN(14)) { phase_norm2_route(F, 1); } SEAM(14);
    RUN(15, if (FAST_GEMM) fast_moe_gateup(F, 1); else phase_moe_gateup(F, 1)); SEAM(15);
    RUN(16, if (FAST_GEMM) fast_moe_down(F, 1); else phase_moe_down(F, 1)); SEAM(16);
    if (IN(17)) { phase_combine<true>(F, 1); }
#undef RUN
#undef IN
#undef SEAM
}

extern "C" void kernel_launch(void* const* d_in, const int* in_sizes, int n_in, void* d_out, int out_size, void* d_ws, size_t ws_size, hipStream_t stream) {
    static int grid = 0;
    if (grid == 0) {
        if (n_in != 25 || out_size != T * D || ws_size < WS_END) { fprintf(stderr, "kernel_launch: unexpected shapes (n_in %d out %d ws %zu)\n", n_in, out_size, ws_size); grid = -1; return; }
        int dev = 0, cus = 0, per_cu = 0;
        if (hipGetDevice(&dev) != hipSuccess || hipDeviceGetAttribute(&cus, hipDeviceAttributeMultiprocessorCount, dev) != hipSuccess) { grid = -1; return; }
        if (hipFuncSetAttribute((const void*)mega, hipFuncAttributeMaxDynamicSharedMemorySize, LDS_BYTES) != hipSuccess) { fprintf(stderr, "kernel_launch: hipFuncSetAttribute failed\n"); grid = -1; return; }
        if (hipOccupancyMaxActiveBlocksPerMultiprocessor(&per_cu, (const void*)mega, NTHR, LDS_BYTES) != hipSuccess || per_cu < 1) { fprintf(stderr, "kernel_launch: occupancy query says %d\n", per_cu); }
        (void)hipGetLastError();
        grid = cus;
    }
    if (grid < 0) return;
    (void)hipMemsetAsync((char*)d_ws + WS_CTL, 0, CTL_BYTES, stream);
    Args a{};
    for (int i = 0; i < 25; ++i) a.in[i] = (const float*)d_in[i];
    a.out = (float*)d_out; a.ws = (unsigned char*)d_ws;
#if MK_ONE_LAUNCH
    a.ph_lo = 0; a.ph_hi = NPH;
    hipLaunchKernelGGL(mega, dim3(grid), dim3(NTHR), LDS_BYTES, stream, a);
#else
#ifndef PROBE_PHASE
#define PROBE_PHASE -1
#endif
    for (int p = 0; p < NPH; ++p) { a.ph_lo = p; a.ph_hi = p + 1; hipLaunchKernelGGL(mega, dim3(grid), dim3(NTHR), LDS_BYTES, stream, a);
        if (p == PROBE_PHASE) { if (p == 7 || p == 14) (void)hipMemsetAsync((char*)d_ws + WS_CTL, 0, CTL_BYTES, stream);
            hipLaunchKernelGGL(mega, dim3(grid), dim3(NTHR), LDS_BYTES, stream, a); } }
#endif
}
```

```cpp
#include <hip/hip_runtime.h>
#include <cstdio>

#ifndef MK_ONE_LAUNCH
#define MK_ONE_LAUNCH 1
#endif

#define GAS __attribute__((address_space(1)))
#define LAS __attribute__((address_space(3)))
typedef unsigned short bf16;
typedef short bf16x8 __attribute__((ext_vector_type(8)));
typedef float f32x4 __attribute__((ext_vector_type(4)));
typedef float f32x16 __attribute__((ext_vector_type(16)));
typedef unsigned u32x4 __attribute__((ext_vector_type(4)));
typedef unsigned u32x2 __attribute__((ext_vector_type(2)));

constexpr int D = 1024, NB = 4, L = 8192, T = NB * L, CL = 256, TC = NB * CL;
constexpr int NE = 16, FF = 512, CONVW = 31;
constexpr int N_IN = 1280;
constexpr int FN1 = 64, FN2 = 128;
#ifndef FAST_GEMM
#define FAST_GEMM 1
#endif
#ifndef MOE_MERGED
#define MOE_MERGED 1
#endif
#ifndef XBF16
#define XBF16 FAST_GEMM
#endif
#ifndef FAST_ATTN
#define FAST_ATTN 1
#endif
#ifndef FAST_FFT
#define FAST_FFT 1
#endif
constexpr int IL = FAST_GEMM ? 128 : 32;
constexpr float EPS = 1e-6f;
constexpr int NWAVES = 8, NTHR = 512;
constexpr int CAP = 32768;
constexpr int HROWS = 65536 + 4096;

constexpr size_t MiB = 1u << 20;
constexpr size_t WS_CTL = 0, CTL_BYTES = 1 * MiB;
constexpr size_t WS_MOD = 1 * MiB;
constexpr size_t WS_TW = 1 * MiB + 512 * 1024;
constexpr size_t WS_WIN = 2 * MiB, WS_WOUT = 6 * MiB, WS_WPW1 = 10 * MiB, WS_WPW2 = 14 * MiB;
constexpr size_t WS_WGU = 16 * MiB, WS_WDN = 80 * MiB;
constexpr size_t WS_TOKE = 112 * MiB, WS_TOKP = 113 * MiB, WS_TOKW = 114 * MiB;
constexpr size_t WS_SLOTT = 116 * MiB, WS_SLOTW = 120 * MiB;
constexpr size_t WS_HB = 128 * MiB;
constexpr size_t WS_UF = 196 * MiB, WS_Q = 228 * MiB, WS_K = 260 * MiB, WS_V = 268 * MiB, WS_CK = 276 * MiB, WS_CV = 277 * MiB;
constexpr size_t WS_G = 280 * MiB, WS_MIX = 344 * MiB, WS_AB = 408 * MiB;
constexpr size_t WS_XB = 408 * MiB;
constexpr size_t WS_HID = 196 * MiB, WS_Y = 264 * MiB;
constexpr size_t WS_U = 196 * MiB, WS_V1 = 260 * MiB;
constexpr size_t WS_END = 472 * MiB;
constexpr int CW_BAR = 4096;
constexpr int CW_CNT = 8192;
constexpr int CW_TILE = 16384;
constexpr int CW_TMO2 = 2048;

constexpr int LDS_BYTES = 147456;

__device__ __forceinline__ unsigned f2bf(float f) { unsigned u = __float_as_uint(f); return (u + 0x7fffu + ((u >> 16) & 1u)) >> 16; }
__device__ __forceinline__ float bf2f(unsigned b) { return __uint_as_float(b << 16); }
__device__ __forceinline__ unsigned pk2(float lo, float hi) { return f2bf(lo) | (f2bf(hi) << 16); }
__device__ __forceinline__ float bflo(unsigned w) { return __uint_as_float(w << 16); }
__device__ __forceinline__ float bfhi(unsigned w) { return __uint_as_float(w & 0xffff0000u); }
__device__ __forceinline__ float wave_sum(float v) {
    v += __builtin_bit_cast(float, __builtin_amdgcn_mov_dpp(__builtin_bit_cast(int, v), 0xB1, 0xf, 0xf, true));
    v += __builtin_bit_cast(float, __builtin_amdgcn_mov_dpp(__builtin_bit_cast(int, v), 0x4E, 0xf, 0xf, true));
    v += __builtin_bit_cast(float, __builtin_amdgcn_mov_dpp(__builtin_bit_cast(int, v), 0x141, 0xf, 0xf, true));
    v += __builtin_bit_cast(float, __builtin_amdgcn_mov_dpp(__builtin_bit_cast(int, v), 0x140, 0xf, 0xf, true));
    const int iv = __builtin_bit_cast(int, v);
    const float a = __builtin_bit_cast(float, __builtin_amdgcn_readlane(iv, 15)), b = __builtin_bit_cast(float, __builtin_amdgcn_readlane(iv, 31));
    const float c = __builtin_bit_cast(float, __builtin_amdgcn_readlane(iv, 47)), d = __builtin_bit_cast(float, __builtin_amdgcn_readlane(iv, 63));
    return (a + b) + (c + d);
}
__device__ __forceinline__ float silu_f(float x) { return x / (1.f + __expf(-x)); }
__device__ __forceinline__ float sigmoid_f(float x) { return 1.f / (1.f + __expf(-x)); }
#define LDS_WAIT() asm volatile("s_waitcnt lgkmcnt(0)" ::: "memory")
__device__ __forceinline__ int fresh_lane() { int l; asm volatile("v_mbcnt_lo_u32_b32 %0, -1, 0\n\tv_mbcnt_hi_u32_b32 %0, -1, %0" : "=v"(l)); return l; }

#define XB_TMO      128
#define XB_XCNT(j)  (256  + 64 * (j))
#define XB_XSUB(j)  (1280 + 64 * (j))
#define XB_XGEN(j)  (2304 + 64 * (j))
#define XB_TOP      3328
#define XB_TOPGEN   3392
#define XCD_BAR_WORDS 3456
#define XB_SPIN_CAP (1u << 20)
__device__ __forceinline__ unsigned xb_ld(unsigned* p)              { return __hip_atomic_load(p, __ATOMIC_RELAXED, __HIP_MEMORY_SCOPE_AGENT); }
__device__ __forceinline__ unsigned xb_add(unsigned* p, unsigned v) { return __hip_atomic_fetch_add(p, v, __ATOMIC_RELAXED, __HIP_MEMORY_SCOPE_AGENT); }
__device__ __forceinline__ unsigned xb_xcc_id() { return (unsigned)__builtin_amdgcn_s_getreg((3 << 11) | 20) & 0xFu; }
#define XB_SPIN(cond, bar) do { unsigned _sp = 0; while (cond) { __builtin_amdgcn_s_sleep(1); \
    if ((++_sp & 255u) == 0u) { if (xb_ld(&(bar)[XB_TMO])) break; if (_sp > XB_SPIN_CAP) { atomicAdd(&(bar)[XB_TMO], 1u); break; } } } } while (0)
struct XcdBarrier { unsigned* bar; unsigned x; volatile LAS unsigned* st; };
__device__ __forceinline__ XcdBarrier xcd_barrier_post(unsigned* bar, volatile LAS unsigned* st) {
    XcdBarrier b; b.bar = bar; b.x = xb_xcc_id(); b.st = st;
    if (threadIdx.x == 0) (void)xb_add(&bar[XB_XCNT(b.x)], 1u);
    return b;
}
__device__ __forceinline__ void xcd_barrier_complete(unsigned* bar, unsigned x, unsigned& nloc, unsigned& nx) {
    const unsigned G = gridDim.x * gridDim.y * gridDim.z;
    unsigned sum, cnt, mine, sp = 0u;
    for (;;) {
        sum = 0u; cnt = 0u; mine = 0u;
#pragma unroll
        for (unsigned j = 0; j < 16; ++j) { const unsigned c = xb_ld(&bar[XB_XCNT(j)]); sum += c; cnt += (c > 0u) ? 1u : 0u; mine = (j == x) ? c : mine; }
        if (sum == G) break;
        __builtin_amdgcn_s_sleep(1);
        if ((++sp & 255u) == 0u) { if (xb_ld(&bar[XB_TMO])) break; if (sp > XB_SPIN_CAP) { atomicAdd(&bar[XB_TMO], 1u); break; } }
    }
    nloc = mine > 0u ? mine : 1u; nx = cnt > 0u ? cnt : 1u;
}
__device__ __forceinline__ void xcd_barrier(const XcdBarrier& b) {
    asm volatile("s_waitcnt vmcnt(0)" ::: "memory");
    __syncthreads();
    if (threadIdx.x == 0) {
        unsigned* bar = b.bar;
        __builtin_amdgcn_s_waitcnt(0);
        unsigned nloc = b.st[0], nx = b.st[1];
        if (nloc == 0u) { xcd_barrier_complete(bar, b.x, nloc, nx); b.st[0] = nloc; b.st[1] = nx; }
        const unsigned old = xb_add(&bar[XB_XSUB(b.x)], 1u);
        const unsigned gen = old / nloc;
        if (old + 1u == (gen + 1u) * nloc) {
            __builtin_amdgcn_fence(__ATOMIC_RELEASE, "agent");
            asm volatile("s_waitcnt vmcnt(0)" ::: "memory");
            const unsigned og = xb_add(&bar[XB_TOP], 1u);
            const unsigned tg = og / nx;
            if (og + 1u == (tg + 1u) * nx) xb_add(&bar[XB_TOPGEN], 1u);
            else XB_SPIN(xb_ld(&bar[XB_TOPGEN]) == tg, bar);
            __builtin_amdgcn_fence(__ATOMIC_ACQUIRE, "agent");
            xb_add(&bar[XB_XGEN(b.x)], 1u);
            asm volatile("s_waitcnt vmcnt(0)" ::: "memory");
        } else {
            XB_SPIN(xb_ld(&bar[XB_XGEN(b.x)]) == gen, bar);
            __builtin_amdgcn_fence(__ATOMIC_ACQUIRE, "agent");
            asm volatile("s_waitcnt vmcnt(0)" ::: "memory");
        }
    }
    __syncthreads();
}

struct Args { const float* in[25]; float* out; unsigned char* ws; int ph_lo, ph_hi; };
enum { I_X = 0, I_C, I_CTX, I_CCTX, I_ADAW, I_ADAB, I_NMG, I_NFG, I_WIN, I_WOUT, I_SINK, I_PW1W, I_PW1B, I_DWW, I_DWB, I_LNG, I_LNB,
       I_PW2W, I_PW2B, I_RW, I_RB, I_WG, I_WU, I_WD, I_FNG };

struct Frame {
    LAS unsigned char* lds;
    int tid, lane, wave, G, wg;
    const float* const* in;
    float* out;
    unsigned char* ws;
    unsigned* ctl;
};

__device__ __forceinline__ int crow(int i, int h) { return (i & 3) + 8 * (i >> 2) + 4 * h; }
template <class RowPtr, class Epi>
__device__ __forceinline__ void sgemm_tile(const RowPtr& rowptr, const bf16* Bt, int K, int m0, int n0, const Epi& epi, int wave, int lane) {
    const int wm = wave & 3, wn = wave >> 2, r = lane & 31, h = lane >> 5;
    const bf16* ap = rowptr(m0 + wm * 32 + r) + 8 * h;
    const bf16* bp0 = Bt + (size_t)(n0 + wn * 64 + r) * K + 8 * h;
    const bf16* bp1 = bp0 + (size_t)32 * K;
    f32x16 c0, c1;
#pragma unroll
    for (int i = 0; i < 16; ++i) { c0[i] = 0.f; c1[i] = 0.f; }
#pragma unroll 2
    for (int k = 0; k < K; k += 32) {
        const bf16x8 a0 = *(const bf16x8*)(ap + k), a1 = *(const bf16x8*)(ap + k + 16);
        const bf16x8 b00 = *(const bf16x8*)(bp0 + k), b01 = *(const bf16x8*)(bp0 + k + 16);
        const bf16x8 b10 = *(const bf16x8*)(bp1 + k), b11 = *(const bf16x8*)(bp1 + k + 16);
        c0 = __builtin_amdgcn_mfma_f32_32x32x16_bf16(a0, b00, c0, 0, 0, 0);
        c1 = __builtin_amdgcn_mfma_f32_32x32x16_bf16(a0, b10, c1, 0, 0, 0);
        c0 = __builtin_amdgcn_mfma_f32_32x32x16_bf16(a1, b01, c0, 0, 0, 0);
        c1 = __builtin_amdgcn_mfma_f32_32x32x16_bf16(a1, b11, c1, 0, 0, 0);
    }
    epi(m0 + wm * 32, n0 + wn * 64, c0, c1, lane);
}

__device__ __forceinline__ void p0_transpose_item(const float* W, int K, int N, bf16* WT, int k0, int n0, int drow0, LAS float* scr, int lane) {
#pragma unroll 8
    for (int i = 0; i < 32; ++i) { const int kk = 2 * i + (lane >> 5); scr[kk * 33 + (lane & 31)] = W[(size_t)(k0 + kk) * N + n0 + (lane & 31)]; }
    LDS_WAIT(); asm volatile("" ::: "memory");
    const int c = lane & 7;
#pragma unroll
    for (int j = 0; j < 4; ++j) { const int n = (lane >> 3) + 8 * j; const LAS float* s = scr + (8 * c) * 33 + n;
        u32x4 o; o.x = pk2(s[0 * 33], s[1 * 33]); o.y = pk2(s[2 * 33], s[3 * 33]); o.z = pk2(s[4 * 33], s[5 * 33]); o.w = pk2(s[6 * 33], s[7 * 33]);
        *(u32x4*)(WT + (size_t)(drow0 + n) * K + k0 + 8 * c) = o; }
    LDS_WAIT(); asm volatile("" ::: "memory");
}
__device__ __forceinline__ int il_row(int j, int half) { return (j / IL) * (2 * IL) + half * IL + (j % IL); }

__device__ __forceinline__ void phase_prep(Frame& F) {
    {
        LAS float* sc = (LAS float*)F.lds;
        LAS float* red = sc + 5 * 1024;
        bool loaded = false;
        for (int it = F.wg; it < 192; it += F.G) {
            if (!loaded) {
                for (int i = F.tid; i < 5 * 1024; i += NTHR) { const int b = i >> 10, k = i & 1023; const float v = b < 4 ? F.in[I_C][b * 1024 + k] : F.in[I_CCTX][k]; sc[i] = silu_f(v); }
                __syncthreads(); loaded = true;
            }
            const int l = it / 96, n0 = (it % 96) * 64, col = F.tid & 63, kg = F.tid >> 6;
            const float* w = F.in[I_ADAW] + (size_t)l * 1024 * 6144 + n0 + col;
            float a0 = 0.f, a1 = 0.f, a2 = 0.f, a3 = 0.f, a4 = 0.f;
#pragma unroll 8
            for (int k = kg * 128; k < kg * 128 + 128; ++k) { const float wv = w[(size_t)k * 6144];
                a0 += sc[k] * wv; a1 += sc[1024 + k] * wv; a2 += sc[2048 + k] * wv; a3 += sc[3072 + k] * wv; a4 += sc[4096 + k] * wv; }
            red[(kg * 5 + 0) * 64 + col] = a0; red[(kg * 5 + 1) * 64 + col] = a1; red[(kg * 5 + 2) * 64 + col] = a2; red[(kg * 5 + 3) * 64 + col] = a3; red[(kg * 5 + 4) * 64 + col] = a4;
            __syncthreads();
            if (F.tid < 320) { const int b = F.tid >> 6, c2 = F.tid & 63; float s = 0.f;
#pragma unroll
                for (int g = 0; g < 8; ++g) s += red[(g * 5 + b) * 64 + c2];
                ((float*)(F.ws + WS_MOD))[((size_t)l * 5 + b) * 6144 + n0 + c2] = s + F.in[I_ADAB][l * 6144 + n0 + c2]; }
            __syncthreads();
        }
        __syncthreads();
    }
    { u32x4* z = (u32x4*)(F.ws + WS_SLOTT); const u32x4 zero = {0u, 0u, 0u, 0u};
      for (int i = F.wg * NTHR + F.tid; i < 2 * 16 * CAP / 4; i += F.G * NTHR) z[i] = zero; }
    { float* tw = (float*)(F.ws + WS_TW);
      for (int k = F.wg * NTHR + F.tid; k < 8192; k += F.G * NTHR) { const float a = (float)k * (6.283185307179586f / 8192.f); tw[2 * k] = __cosf(a); tw[2 * k + 1] = __sinf(a); } }
    {
        LAS float* scr = (LAS float*)(F.lds + F.wave * 8704);
        const int gw = F.wg * NWAVES + F.wave, NGW = F.G * NWAVES;
        constexpr int S0 = 640, S1 = 512, S2 = 1024, S3 = 512, SM = 32 * 256;
        constexpr int NIT = S0 + S1 + S2 + S3 + 3 * SM;
        for (int it = gw; it < NIT; it += NGW) {
            int r = it;
            if (r < S0) { const int kb = r / 40, nb = r % 40; p0_transpose_item(F.in[I_WIN], 1024, 1280, (bf16*)(F.ws + WS_WIN), kb * 64, nb * 32, nb * 32, scr, F.lane); continue; } r -= S0;
            if (r < S1) { const int kb = r / 32, nb = r % 32; p0_transpose_item(F.in[I_WOUT], 1024, 1024, (bf16*)(F.ws + WS_WOUT), kb * 64, nb * 32, nb * 32, scr, F.lane); continue; } r -= S1;
            if (r < S2) { const int kb = r / 64, nb = r % 64, n0 = nb * 32; p0_transpose_item(F.in[I_PW1W], 1024, 2048, (bf16*)(F.ws + WS_WPW1), kb * 64, n0, il_row(n0 & 1023, n0 >> 10), scr, F.lane); continue; } r -= S2;
            if (r < S3) { const int kb = r / 32, nb = r % 32; p0_transpose_item(F.in[I_PW2W], 1024, 1024, (bf16*)(F.ws + WS_WPW2), kb * 64, nb * 32, nb * 32, scr, F.lane); continue; } r -= S3;
            if (r < SM) { const int le = r >> 8, q = r & 255, kb = q / 16, nb = q % 16;
                p0_transpose_item(F.in[I_WG] + (size_t)le * 1024 * 512, 1024, 512, (bf16*)(F.ws + WS_WGU) + (size_t)le * 1024 * 1024, kb * 64, nb * 32, il_row(nb * 32, 0), scr, F.lane); continue; } r -= SM;
            if (r < SM) { const int le = r >> 8, q = r & 255, kb = q / 16, nb = q % 16;
                p0_transpose_item(F.in[I_WU] + (size_t)le * 1024 * 512, 1024, 512, (bf16*)(F.ws + WS_WGU) + (size_t)le * 1024 * 1024, kb * 64, nb * 32, il_row(nb * 32, 1), scr, F.lane); continue; } r -= SM;
            { const int le = r >> 8, q = r & 255, kb = q / 32, nb = q % 32;
                p0_transpose_item(F.in[I_WD] + (size_t)le * 512 * 1024, 512, 1024, (bf16*)(F.ws + WS_WDN) + (size_t)le * 1024 * 512, kb * 64, nb * 32, nb * 32, scr, F.lane); }
        }
    }
}

__device__ __forceinline__ void row_load(const float* p, int lane, f32x4 (&v)[4]) {
#pragma unroll
    for (int j = 0; j < 4; ++j) v[j] = *(const f32x4*)(p + 4 * lane + 256 * j);
}
__device__ __forceinline__ void row_load_bf(const bf16* p, int lane, f32x4 (&v)[4]) {
#pragma unroll
    for (int j = 0; j < 4; ++j) { const u32x2 w = *(const u32x2*)(p + 4 * lane + 256 * j); v[j] = (f32x4){bflo(w.x), bfhi(w.x), bflo(w.y), bfhi(w.y)}; }
}
__device__ __forceinline__ void xrow_load(const float* xf, const bf16* xb, size_t row, int lane, f32x4 (&v)[4]) { if (XBF16) row_load_bf(xb + row * D, lane, v); else row_load(xf + row * D, lane, v); }
__device__ __forceinline__ float row_sumsq(const f32x4 (&v)[4]) {
    float s = 0.f;
#pragma unroll
    for (int j = 0; j < 4; ++j) s += (v[j].x * v[j].x + v[j].y * v[j].y) + (v[j].z * v[j].z + v[j].w * v[j].w);
    return wave_sum(s);
}
__device__ __forceinline__ void row_modulate(f32x4 (&v)[4], float rstd, const float* g, const float* sh, const float* sc, int lane) {
#pragma unroll
    for (int j = 0; j < 4; ++j) { const int o = 4 * lane + 256 * j; const f32x4 gg = *(const f32x4*)(g + o), s1 = *(const f32x4*)(sc + o), s0 = *(const f32x4*)(sh + o);
        v[j] = v[j] * rstd * gg * (1.f + s1) + s0; }
}
__device__ __forceinline__ void row_store_bf16(bf16* dst, const f32x4 (&v)[4], int lane) {
#pragma unroll
    for (int j = 0; j < 4; ++j) { u32x2 w; w.x = pk2(v[j].x, v[j].y); w.y = pk2(v[j].z, v[j].w); *(u32x2*)(dst + 4 * lane + 256 * j) = w; }
}

__device__ __forceinline__ void phase_norm1_l0(Frame& F) {
    const int gw = F.wg * NWAVES + F.wave, NGW = F.G * NWAVES;
    const float* mod = (const float*)(F.ws + WS_MOD);
    bf16* HB = (bf16*)(F.ws + WS_HB);
    for (int row = gw; row < T + TC; row += NGW) {
        const float* src = row < T ? F.in[I_X] + (size_t)row * D : F.in[I_CTX] + (size_t)(row - T) * D;
        const int b = row < T ? (row >> 13) : 4;
        f32x4 v[4]; row_load(src, F.lane, v);
        const float rstd = rsqrtf(row_sumsq(v) * (1.f / D) + EPS);
        const float* m = mod + (size_t)b * 6144;
        row_modulate(v, rstd, F.in[I_NMG], m, m + 1024, F.lane);
        row_store_bf16(HB + (size_t)row * D, v, F.lane);
    }
}

struct RowLin { const bf16* base; size_t pitch; __device__ __forceinline__ const bf16* operator()(int m) const { return base + (size_t)m * pitch; } };

__device__ __forceinline__ void inproj_block(Frame& F, int mb, int nbk, const f32x16& c, int lane) {
    const int h = lane >> 5, cl = lane & 31;
    bf16* dst; int pitch, cbase; bool rope = false; bool isctx = (mb >= T);
    if (nbk < 512) { dst = (bf16*)(F.ws + WS_UF); pitch = 512; cbase = 0; }
    else if (nbk < 1024) { dst = (bf16*)(F.ws + WS_Q); pitch = 512; cbase = 512; rope = true; }
    else if (nbk < 1152) { dst = isctx ? (bf16*)(F.ws + WS_CK) : (bf16*)(F.ws + WS_K); pitch = 128; cbase = 1024; rope = !isctx; }
    else { dst = isctx ? (bf16*)(F.ws + WS_CV) : (bf16*)(F.ws + WS_V); pitch = 128; cbase = 1152; }
    const int rbase = isctx ? mb - T : mb;
    const int col = nbk - cbase + cl;
    const float inv = exp2f(-(float)(cl & 15) * (13.287712379549449f / 16.f));
    const bool second = (cl & 16) != 0; const bool bycol = ((nbk >> 5) & 1) != 0;
#pragma unroll
    for (int i = 0; i < 16; ++i) {
        const int rr = crow(i, h); float v = c[i];
        if (rope) {
            const float partner = __shfl_xor(v, 16);
            const int l = (mb + rr) & (L - 1);
            const float pos = (float)(bycol ? (l & 63) : (l >> 6));
            const float ang = pos * inv, cs = __cosf(ang), sn = __sinf(ang);
            v = second ? (partner * sn + v * cs) : (v * cs - partner * sn);
        }
        dst[(size_t)(rbase + rr) * pitch + col] = (bf16)f2bf(v);
    }
}
__device__ __forceinline__ void phase_inproj(Frame& F) {
    const bf16* HB = (const bf16*)(F.ws + WS_HB); const bf16* Wt = (const bf16*)(F.ws + WS_WIN);
    constexpr int MT = (T + TC) / 128, NT = N_IN / 128;
    RowLin rp{HB, (size_t)D};
    for (int u = F.wg; u < MT * NT; u += F.G) {
        const int mt = u / NT, nt = u % NT;
        if (mt >= T / 128 && nt < 8) continue;
        auto epi = [&](int mb, int nb, const f32x16& c0, const f32x16& c1, int lane) { inproj_block(F, mb, nb, c0, lane); inproj_block(F, mb, nb + 32, c1, lane); };
        sgemm_tile(rp, Wt, D, mt * 128, nt * 128, epi, F.wave, F.lane);
    }
}

__device__ __forceinline__ void attn_key(const bf16* kp, const bf16* vp, const float (&q)[64], float& m, float& s, float (&o)[64]) {
    float dot = 0.f;
#pragma unroll
    for (int j = 0; j < 8; ++j) { const u32x4 w = *(const u32x4*)(kp + 8 * j);
        dot += q[8 * j + 0] * bflo(w.x) + q[8 * j + 1] * bfhi(w.x) + q[8 * j + 2] * bflo(w.y) + q[8 * j + 3] * bfhi(w.y)
             + q[8 * j + 4] * bflo(w.z) + q[8 * j + 5] * bfhi(w.z) + q[8 * j + 6] * bflo(w.w) + q[8 * j + 7] * bfhi(w.w); }
    const float mn = fmaxf(m, dot), alpha = __expf(m - mn), p = __expf(dot - mn);
    s = s * alpha + p; m = mn;
#pragma unroll
    for (int j = 0; j < 8; ++j) { const u32x4 w = *(const u32x4*)(vp + 8 * j);
        o[8 * j + 0] = o[8 * j + 0] * alpha + p * bflo(w.x); o[8 * j + 1] = o[8 * j + 1] * alpha + p * bfhi(w.x);
        o[8 * j + 2] = o[8 * j + 2] * alpha + p * bflo(w.y); o[8 * j + 3] = o[8 * j + 3] * alpha + p * bfhi(w.y);
        o[8 * j + 4] = o[8 * j + 4] * alpha + p * bflo(w.z); o[8 * j + 5] = o[8 * j + 5] * alpha + p * bfhi(w.z);
        o[8 * j + 6] = o[8 * j + 6] * alpha + p * bflo(w.w); o[8 * j + 7] = o[8 * j + 7] * alpha + p * bfhi(w.w); }
}
__device__ __forceinline__ void phase_attn_simple(Frame& F) {
    const bf16* Q = (const bf16*)(F.ws + WS_Q); const bf16* Kb = (const bf16*)(F.ws + WS_K); const bf16* Vb = (const bf16*)(F.ws + WS_V);
    const bf16* CK = (const bf16*)(F.ws + WS_CK); const bf16* CV = (const bf16*)(F.ws + WS_CV); bf16* MIX = (bf16*)(F.ws + WS_MIX);
    for (int idx = F.wg * NTHR + F.tid; idx < T * 8; idx += F.G * NTHR) {
        const int hd = idx / T, t = idx % T, b = t >> 13, l = t & (L - 1), kvh = hd >> 2;
        float q[64], o[64];
#pragma unroll
        for (int j = 0; j < 8; ++j) { const u32x4 w = *(const u32x4*)(Q + (size_t)t * 512 + hd * 64 + 8 * j);
            q[8 * j + 0] = bflo(w.x) * 0.125f; q[8 * j + 1] = bfhi(w.x) * 0.125f; q[8 * j + 2] = bflo(w.y) * 0.125f; q[8 * j + 3] = bfhi(w.y) * 0.125f;
            q[8 * j + 4] = bflo(w.z) * 0.125f; q[8 * j + 5] = bfhi(w.z) * 0.125f; q[8 * j + 6] = bflo(w.w) * 0.125f; q[8 * j + 7] = bfhi(w.w) * 0.125f; }
#pragma unroll
        for (int j = 0; j < 64; ++j) o[j] = 0.f;
        float m = F.in[I_SINK][hd], s = 1.f;
        for (int c = 0; c < CL; ++c) { const size_t r = (size_t)(b * CL + c) * 128 + kvh * 64; attn_key(CK + r, CV + r, q, m, s, o); }
        const int lo = l - 128 < 0 ? 0 : l - 128, hi = l + 128 > L - 1 ? L - 1 : l + 128;
        for (int kp = lo; kp <= hi; ++kp) { const size_t r = (size_t)(b * L + kp) * 128 + kvh * 64; attn_key(Kb + r, Vb + r, q, m, s, o); }
        const float is = 1.f / s;
#pragma unroll
        for (int j = 0; j < 8; ++j) { u32x4 w; w.x = pk2(o[8 * j] * is, o[8 * j + 1] * is); w.y = pk2(o[8 * j + 2] * is, o[8 * j + 3] * is); w.z = pk2(o[8 * j + 4] * is, o[8 * j + 5] * is); w.w = pk2(o[8 * j + 6] * is, o[8 * j + 7] * is);
            *(u32x4*)(MIX + (size_t)t * 1024 + 512 + hd * 64 + 8 * j) = w; }
    }
}

__device__ __forceinline__ void phase_fft1_simple(Frame& F) {
    const bf16* UF = (const bf16*)(F.ws + WS_UF); bf16* Gb = (bf16*)(F.ws + WS_G); const float* tw = (const float*)(F.ws + WS_TW);
    for (int idx = F.wg * NTHR + F.tid; idx < NB * FN1 * FN2 * 512; idx += F.G * NTHR) {
        const int ch = idx & 511, bp = (idx >> 9) & 127, c = (idx >> 16) & 63, b = idx >> 22;
        float re = 0.f, im = 0.f;
        for (int a = 0; a < FN1; ++a) { const float u = bf2f(UF[(size_t)(b * L + 128 * a + bp) * 512 + ch]); const int k = ((a * c) & 63) * 128;
            re += u * tw[2 * k]; im -= u * tw[2 * k + 1]; }
        const int k2 = bp * c; const float cs = tw[2 * k2], sn = tw[2 * k2 + 1];
        const float gr = re * cs + im * sn, gi = im * cs - re * sn;
        const size_t row = (size_t)(b * FN1 + c) * FN2 + bp;
        Gb[row * 1024 + ch] = (bf16)f2bf(gr); Gb[row * 1024 + 512 + ch] = (bf16)f2bf(gi);
    }
}
__device__ __forceinline__ void phase_fft2_simple(Frame& F) {
    const bf16* Gb = (const bf16*)(F.ws + WS_G); bf16* AB = (bf16*)(F.ws + WS_AB); const float* tw = (const float*)(F.ws + WS_TW);
    for (int idx = F.wg * NTHR + F.tid; idx < NB * FN1 * FN2 * 512; idx += F.G * NTHR) {
        const int ch = idx & 511, d = (idx >> 9) & 127, c = (idx >> 16) & 63, b = idx >> 22;
        float fr = 0.f, fi = 0.f;
        for (int bp = 0; bp < FN2; ++bp) { const size_t row = (size_t)(b * FN1 + c) * FN2 + bp; const float gr = bf2f(Gb[row * 1024 + ch]), gi = bf2f(Gb[row * 1024 + 512 + ch]);
            const int k = ((bp * d) & 127) * 64; const float cs = tw[2 * k], sn = tw[2 * k + 1];
            fr += gr * cs + gi * sn; fi += gi * cs - gr * sn; }
        const size_t t = (size_t)b * L + c + 64 * d;
        AB[t * 1024 + ch] = (bf16)f2bf(fr); AB[t * 1024 + 512 + ch] = (bf16)f2bf(-fi);
    }
}
__device__ __forceinline__ void phase_fft3_simple(Frame& F) {
    const bf16* AB = (const bf16*)(F.ws + WS_AB); bf16* MIX = (bf16*)(F.ws + WS_MIX); const float* tw = (const float*)(F.ws + WS_TW);
    LAS float* t128 = (LAS float*)F.lds;
    for (int i = F.tid; i < 128; i += NTHR) { t128[2 * i] = tw[2 * (i * 64)]; t128[2 * i + 1] = tw[2 * (i * 64) + 1]; }
    __syncthreads();
    for (int idx = F.wg * NTHR + F.tid; idx < T * 512; idx += F.G * NTHR) {
        const int cp = idx & 127, g = (idx >> 7) & 3, t = idx >> 9;
        const bf16* arow = AB + (size_t)t * 1024 + g * 128;
        float y = 0.f;
        for (int cc = 0; cc < 128; ++cc) { const int k = (cc * cp) & 127; y += bf2f(arow[cc]) * t128[2 * k] - bf2f(arow[512 + cc]) * t128[2 * k + 1]; }
        MIX[(size_t)t * 1024 + g * 128 + cp] = (bf16)f2bf(y * (1.f / 1024.f));
    }
    __syncthreads();
}

__device__ __forceinline__ void phase_outproj(Frame& F, const bf16* A, const bf16* Wt, const float* base, float* X, const float* gate  , const float* bias) {
    RowLin rp{A, (size_t)D};
    for (int u = F.wg; u < (T / 128) * 8; u += F.G) {
        const int mt = u / 8, nt = u % 8;
        auto epi = [&](int mb, int nb, const f32x16& c0, const f32x16& c1, int lane) {
            const int h = lane >> 5, cl = lane & 31, b = mb >> 13;
#pragma unroll
            for (int half = 0; half < 2; ++half) { const int col = nb + 32 * half + cl; const float gv = gate[(size_t)b * 6144 + col], bv = bias ? bias[col] : 0.f;
#pragma unroll
                for (int i = 0; i < 16; ++i) { const size_t o = (size_t)(mb + crow(i, h)) * D + col; const float a = half ? c1[i] : c0[i]; X[o] = base[o] + gv * (a + bv); } }
        };
        sgemm_tile(rp, Wt, D, mt * 128, nt * 128, epi, F.wave, F.lane);
    }
}

__device__ __forceinline__ void route_select(const float (&lg)[16], const float* rb, int& be1, int& be2, float& w1, float& w2) {
    float best = -1e30f; float bs1 = 0.f, bs2 = 0.f; be1 = 0; be2 = 0;
#pragma unroll
    for (int g = 0; g < 4; ++g) {
        float v1 = -1e30f, v2 = -1e30f, s1 = 0.f, s2 = 0.f; int j1 = 0, j2 = 0;
#pragma unroll
        for (int q = 0; q < 4; ++q) { const float sc = sigmoid_f(lg[4 * g + q]), x = sc + rb[4 * g + q];
            if (x > v1) { v2 = v1; j2 = j1; s2 = s1; v1 = x; j1 = q; s1 = sc; } else if (x > v2) { v2 = x; j2 = q; s2 = sc; } }
        const float gs = v1 + v2;
        if (gs > best) { best = gs; be1 = 4 * g + j1; be2 = 4 * g + j2; bs1 = s1; bs2 = s2; }
    }
    const float inv = 1.f / (bs1 + bs2); w1 = bs1 * inv; w2 = bs2 * inv;
}
__device__ __forceinline__ void phase_norm2_route(Frame& F, int layer) {
    const float* mod = (const float*)(F.ws + WS_MOD) + (size_t)layer * 5 * 6144;
    const float* X = F.out; const bf16* XB = (const bf16*)(F.ws + WS_XB); bf16* HB = (bf16*)(F.ws + WS_HB);
    const float* rw = F.in[I_RW]; const float* rb = F.in[I_RB];
    int* tok_e = (int*)(F.ws + WS_TOKE); int* tok_p = (int*)(F.ws + WS_TOKP); float* tok_w = (float*)(F.ws + WS_TOKW);
    int* slot_t = (int*)(F.ws + WS_SLOTT) + layer * 16 * CAP;
    float* slot_w = (float*)(F.ws + WS_SLOTW) + layer * 16 * CAP;
    unsigned* cnt = F.ctl + CW_CNT + layer * 16 * 64;
    LAS float* rwt = (LAS float*)F.lds;
    LAS int* sel_e = (LAS int*)(F.lds + 65536);
    LAS float* sel_w = (LAS float*)(F.lds + 65536 + 1024);
    LAS int* wcnt = (LAS int*)(F.lds + 65536 + 2048);
    LAS int* ebase = wcnt + 64;
    __syncthreads();
    for (int t = F.tid; t < 4096; t += NTHR) { const int i = t >> 2, e4 = t & 3; const f32x4 w = *(const f32x4*)(rw + (size_t)i * 16 + 4 * e4);
        rwt[(4 * e4 + 0) * 1024 + i] = w.x; rwt[(4 * e4 + 1) * 1024 + i] = w.y; rwt[(4 * e4 + 2) * 1024 + i] = w.z; rwt[(4 * e4 + 3) * 1024 + i] = w.w; }
    __syncthreads();
    for (int rb0 = F.wg; rb0 < T / 128; rb0 += F.G) {
        const int b = (rb0 * 128) >> 13;
        f32x4 gm[4], sh[4];
        { const float* m = mod + (size_t)b * 6144; const float* g = F.in[I_NFG] + layer * D;
#pragma unroll
          for (int jj = 0; jj < 4; ++jj) { const int o = 4 * F.lane + 256 * jj; gm[jj] = *(const f32x4*)(g + o) * (1.f + *(const f32x4*)(m + 4096 + o)); sh[jj] = *(const f32x4*)(m + 3072 + o); } }
        const int rbase = rb0 * 128 + F.wave * 16;
        f32x4 v0[4], v1[4]; xrow_load(X, XB, (size_t)rbase, F.lane, v0); xrow_load(X, XB, (size_t)(rbase + 1), F.lane, v1);
#pragma unroll 1
        for (int j = 0; j < 16; j += 2) {
            const int lr = F.wave * 16 + j, row = rbase + j;
            f32x4 n0[4], n1[4];
            { const int nr = (j + 2 < 16) ? row + 2 : row; xrow_load(X, XB, (size_t)nr, F.lane, n0); xrow_load(X, XB, (size_t)(nr + 1), F.lane, n1); }
            const float rstd0 = rsqrtf(row_sumsq(v0) * (1.f / D) + EPS), rstd1 = rsqrtf(row_sumsq(v1) * (1.f / D) + EPS);
#pragma unroll
            for (int jj = 0; jj < 4; ++jj) { v0[jj] = v0[jj] * rstd0 * gm[jj] + sh[jj]; v1[jj] = v1[jj] * rstd1 * gm[jj] + sh[jj]; }
            row_store_bf16(HB + (size_t)row * D, v0, F.lane); row_store_bf16(HB + (size_t)(row + 1) * D, v1, F.lane);
            float lg0[16], lg1[16];
#pragma unroll
            for (int e = 0; e < 16; ++e) { float a0 = 0.f, a1 = 0.f;
#pragma unroll
                for (int jj = 0; jj < 4; ++jj) { const f32x4 w4 = *(const LAS f32x4*)(rwt + e * 1024 + 4 * F.lane + 256 * jj);
                    a0 += (v0[jj].x * w4.x + v0[jj].y * w4.y) + (v0[jj].z * w4.z + v0[jj].w * w4.w); a1 += (v1[jj].x * w4.x + v1[jj].y * w4.y) + (v1[jj].z * w4.z + v1[jj].w * w4.w); }
                lg0[e] = a0; lg1[e] = a1; }
#pragma unroll
            for (int e = 0; e < 16; ++e) { lg0[e] = wave_sum(lg0[e]); lg1[e] = wave_sum(lg1[e]); }
            int e1, e2; float w1, w2;
            route_select(lg0, rb, e1, e2, w1, w2);
            if (F.lane == 0) { sel_e[2 * lr] = e1; sel_e[2 * lr + 1] = e2; sel_w[2 * lr] = w1; sel_w[2 * lr + 1] = w2; }
            route_select(lg1, rb, e1, e2, w1, w2);
            if (F.lane == 0) { sel_e[2 * lr + 2] = e1; sel_e[2 * lr + 3] = e2; sel_w[2 * lr + 2] = w1; sel_w[2 * lr + 3] = w2; }
#pragma unroll
            for (int jj = 0; jj < 4; ++jj) { v0[jj] = n0[jj]; v1[jj] = n1[jj]; }
        }
        __syncthreads();
        int my_e = 0, my_rank = 0; float my_w = 0.f;
        if (F.tid < 256) { my_e = sel_e[F.tid]; my_w = sel_w[F.tid];
            const unsigned long long below = (1ull << F.lane) - 1ull;
#pragma unroll 1
            for (int ee = 0; ee < 16; ++ee) { const unsigned long long mk = __ballot(my_e == ee);
                if (my_e == ee) my_rank = __popcll(mk & below);
                if (F.lane == 0) wcnt[F.wave * 16 + ee] = __popcll(mk); } }
        __syncthreads();
        if (F.tid < 16) { const int n = wcnt[F.tid] + wcnt[16 + F.tid] + wcnt[32 + F.tid] + wcnt[48 + F.tid];
            ebase[F.tid] = n ? (int)atomicAdd(cnt + F.tid * 64, (unsigned)n) : 0; }
        __syncthreads();
        if (F.tid < 256) { int pos = ebase[my_e] + my_rank;
            for (int w = 0; w < F.wave; ++w) pos += wcnt[w * 16 + my_e];
            const int tok = rb0 * 128 + (F.tid >> 1), k = F.tid & 1;
            slot_t[my_e * CAP + pos] = tok; slot_w[my_e * CAP + pos] = my_w; tok_e[2 * tok + k] = my_e; tok_p[2 * tok + k] = pos; tok_w[2 * tok + k] = my_w; }
        __syncthreads();
    }
}

constexpr int MOEMAP_OFF = LDS_BYTES - 256;
__device__ __forceinline__ LAS int* moe_map(Frame& F, int layer) {
    LAS int* mm = (LAS int*)(F.lds + MOEMAP_OFF);
    __syncthreads();
    if (F.tid < 64) { const unsigned* cnt = F.ctl + CW_CNT + layer * 16 * 64;
        const int n = (F.tid < 16) ? (int)__hip_atomic_load(cnt + F.tid * 64, __ATOMIC_RELAXED, __HIP_MEMORY_SCOPE_AGENT) : 0;
        const int pad = (n + 255) & ~255; int x = pad;
#pragma unroll
        for (int o = 1; o < 16; o <<= 1) { const int t = __shfl_up(x, o); if (F.lane >= o) x += t; }
        if (F.tid < 16) { mm[F.tid] = n; mm[16 + F.tid] = x - pad; } }
    __syncthreads();
    return mm;
}
struct RowGather { const bf16* base; const int* list; int n; __device__ __forceinline__ const bf16* operator()(int m) const { const int tok = m < n ? list[m] : 0; return base + (size_t)tok * D; } };

__device__ __forceinline__ void phase_moe_gateup(Frame& F, int layer) {
    LAS int* mm = moe_map(F, layer);
    const bf16* HB = (const bf16*)(F.ws + WS_HB); bf16* HID = (bf16*)(F.ws + WS_HID);
    const int* slot_t = (const int*)(F.ws + WS_SLOTT) + layer * 16 * CAP; const float* slot_w = (const float*)(F.ws + WS_SLOTW) + layer * 16 * CAP;
    int ubase = 0;
#pragma unroll 1
    for (int e = 0; e < 16; ++e) {
        const int n = mm[e], hbe = mm[16 + e], rt = (n + 127) >> 7, nu = rt * 8;
        const bf16* Wt = (const bf16*)(F.ws + WS_WGU) + (size_t)(layer * 16 + e) * 1024 * 1024;
        RowGather rp{HB, slot_t + e * CAP, n};
        int first = (F.wg - ubase % F.G + F.G) % F.G;
        for (int u = first; u < nu; u += F.G) {
            const int mt = u / 8, nt = u % 8;
            auto epi = [&](int mb, int nb, const f32x16& c0, const f32x16& c1, int lane) {
                const int h = lane >> 5, cl = lane & 31; const int col = (nb >> 1) + cl;
#pragma unroll
                for (int i = 0; i < 16; ++i) { const int r = mb + crow(i, h);
                    if (r < n) { const float w = slot_w[e * CAP + r]; HID[(size_t)(hbe + r) * FF + col] = (bf16)f2bf(w * silu_f(c0[i]) * c1[i]); } }
            };
            sgemm_tile(rp, Wt, D, mt * 128, nt * 128, epi, F.wave, F.lane);
        }
        ubase += nu;
    }
}
__device__ __forceinline__ void phase_moe_down(Frame& F, int layer) {
    LAS int* mm = moe_map(F, layer);
    const bf16* HID = (const bf16*)(F.ws + WS_HID); bf16* Y = (bf16*)(F.ws + WS_Y);
    int ubase = 0;
#pragma unroll 1
    for (int e = 0; e < 16; ++e) {
        const int n = mm[e], hbe = mm[16 + e], rt = (n + 127) >> 7, nu = rt * 8;
        const bf16* Wt = (const bf16*)(F.ws + WS_WDN) + (size_t)(layer * 16 + e) * 1024 * 512;
        RowLin rp{HID + (size_t)hbe * FF, (size_t)FF};
        int first = (F.wg - ubase % F.G + F.G) % F.G;
        for (int u = first; u < nu; u += F.G) {
            const int mt = u / 8, nt = u % 8;
            auto epi = [&](int mb, int nb, const f32x16& c0, const f32x16& c1, int lane) {
                const int h = lane >> 5, cl = lane & 31;
#pragma unroll
                for (int i = 0; i < 16; ++i) { const int r = mb + crow(i, h);
                    if (r < n) { bf16* yr = Y + (size_t)(hbe + r) * D + nb + cl; yr[0] = (bf16)f2bf(c0[i]); yr[32] = (bf16)f2bf(c1[i]); } }
            };
            sgemm_tile(rp, Wt, FF, mt * 128, nt * 128, epi, F.wave, F.lane);
        }
        ubase += nu;
    }
}

template <bool FINAL>
__device__ __forceinline__ void phase_combine(Frame& F, int layer) {
    LAS int* hbs = moe_map(F, layer) + 16;
    const int gw = F.wg * NWAVES + F.wave, NGW = F.G * NWAVES;
    const float* mod = (const float*)(F.ws + WS_MOD);
    const int* tok_e = (const int*)(F.ws + WS_TOKE); const int* tok_p = (const int*)(F.ws + WS_TOKP);
    const bf16* Y = (const bf16*)(F.ws + WS_Y); float* X = F.out; bf16* XB = (bf16*)(F.ws + WS_XB); bf16* HB = (bf16*)(F.ws + WS_HB);
    for (int blk = gw; blk < T / 16; blk += NGW) {
        const int rbase = blk * 16, b = rbase >> 13;
        f32x4 g2v[4], gm[4], shv[4];
        { const float* g2 = mod + ((size_t)layer * 5 + b) * 6144 + 5120;
#pragma unroll
          for (int j = 0; j < 4; ++j) { const int o = 4 * F.lane + 256 * j; g2v[j] = *(const f32x4*)(g2 + o);
              if (FINAL) { gm[j] = *(const f32x4*)(F.in[I_FNG] + o); shv[j] = (f32x4){0.f, 0.f, 0.f, 0.f}; }
              else { const float* m = mod + ((size_t)(layer + 1) * 5 + b) * 6144; gm[j] = *(const f32x4*)(F.in[I_NMG] + (layer + 1) * D + o) * (1.f + *(const f32x4*)(m + 1024 + o)); shv[j] = *(const f32x4*)(m + o); } } }
        int4 te = *(const int4*)(tok_e + 2 * rbase), tp = *(const int4*)(tok_p + 2 * rbase);
#pragma unroll 1
        for (int jr = 0; jr < 16; jr += 2) {
            const int row = rbase + jr;
            const int s00 = hbs[te.x] + tp.x, s01 = hbs[te.y] + tp.y, s10 = hbs[te.z] + tp.z, s11 = hbs[te.w] + tp.w;
            f32x4 v[2][4]; xrow_load(X, XB, (size_t)row, F.lane, v[0]); xrow_load(X, XB, (size_t)(row + 1), F.lane, v[1]);
            u32x2 y0[2][4], y1[2][4];
#pragma unroll
            for (int j = 0; j < 4; ++j) { const int o = 4 * F.lane + 256 * j;
                y0[0][j] = *(const u32x2*)(Y + (size_t)s00 * D + o); y1[0][j] = *(const u32x2*)(Y + (size_t)s01 * D + o);
                y0[1][j] = *(const u32x2*)(Y + (size_t)s10 * D + o); y1[1][j] = *(const u32x2*)(Y + (size_t)s11 * D + o); }
            { const int nr = (jr + 2 < 16) ? row + 2 : row; te = *(const int4*)(tok_e + 2 * nr); tp = *(const int4*)(tok_p + 2 * nr); }
#pragma unroll
            for (int q = 0; q < 2; ++q)
#pragma unroll
                for (int j = 0; j < 4; ++j) { const f32x4 gg = g2v[j];
                    v[q][j].x += gg.x * (bflo(y0[q][j].x) + bflo(y1[q][j].x)); v[q][j].y += gg.y * (bfhi(y0[q][j].x) + bfhi(y1[q][j].x));
                    v[q][j].z += gg.z * (bflo(y0[q][j].y) + bflo(y1[q][j].y)); v[q][j].w += gg.w * (bfhi(y0[q][j].y) + bfhi(y1[q][j].y)); }
            const float rstd0 = rsqrtf(row_sumsq(v[0]) * (1.f / D) + EPS), rstd1 = rsqrtf(row_sumsq(v[1]) * (1.f / D) + EPS);
#pragma unroll
            for (int q = 0; q < 2; ++q) { const float rstd = q ? rstd1 : rstd0; const size_t ro = (size_t)(row + q) * D;
                if (FINAL) {
#pragma unroll
                    for (int j = 0; j < 4; ++j) *(f32x4*)(X + ro + 4 * F.lane + 256 * j) = v[q][j] * rstd * gm[j];
                } else {
                    if (XBF16) row_store_bf16(XB + ro, v[q], F.lane);
#pragma unroll
                    for (int j = 0; j < 4; ++j) { if (!XBF16) *(f32x4*)(X + ro + 4 * F.lane + 256 * j) = v[q][j]; v[q][j] = v[q][j] * rstd * gm[j] + shv[j]; }
                    row_store_bf16(HB + ro, v[q], F.lane);
                }
            }
        }
    }
    __syncthreads();
}

__device__ __forceinline__ void phase_pw1(Frame& F) {
    const bf16* HB = (const bf16*)(F.ws + WS_HB); const bf16* Wt = (const bf16*)(F.ws + WS_WPW1); bf16* U = (bf16*)(F.ws + WS_U);
    const float* bias = F.in[I_PW1B];
    RowLin rp{HB, (size_t)D};
    for (int u = F.wg; u < (T / 128) * 16; u += F.G) {
        const int mt = u / 16, nt = u % 16;
        auto epi = [&](int mb, int nb, const f32x16& c0, const f32x16& c1, int lane) {
            const int h = lane >> 5, cl = lane & 31, col = (nb >> 1) + cl; const float ba = bias[col], bg = bias[1024 + col];
#pragma unroll
            for (int i = 0; i < 16; ++i) U[(size_t)(mb + crow(i, h)) * D + col] = (bf16)f2bf((c0[i] + ba) * sigmoid_f(c1[i] + bg));
        };
        sgemm_tile(rp, Wt, D, mt * 128, nt * 128, epi, F.wave, F.lane);
    }
}
__device__ __forceinline__ void phase_dwconv(Frame& F) {
    const bf16* U = (const bf16*)(F.ws + WS_U); bf16* V1 = (bf16*)(F.ws + WS_V1);
    const float* dww = F.in[I_DWW]; const float* dwb = F.in[I_DWB]; const float* lng = F.in[I_LNG]; const float* lnb = F.in[I_LNB];
    const int gw = F.wg * NWAVES + F.wave, NGW = F.G * NWAVES;
    for (int row = gw; row < T; row += NGW) {
        const int l = row & (L - 1);
        f32x4 acc[4];
#pragma unroll
        for (int j = 0; j < 4; ++j) acc[j] = *(const f32x4*)(dwb + 4 * F.lane + 256 * j);
        for (int tp = 0; tp < CONVW; ++tp) { const int ll = l + tp - 15; if (ll < 0 || ll >= L) continue;
            const bf16* ur = U + (size_t)(row + tp - 15) * D; const float* wr = dww + (size_t)tp * D;
#pragma unroll
            for (int j = 0; j < 4; ++j) { const int o = 4 * F.lane + 256 * j; const u32x2 uu = *(const u32x2*)(ur + o); const f32x4 ww = *(const f32x4*)(wr + o);
                acc[j].x += bflo(uu.x) * ww.x; acc[j].y += bfhi(uu.x) * ww.y; acc[j].z += bflo(uu.y) * ww.z; acc[j].w += bfhi(uu.y) * ww.w; } }
        float s = 0.f;
#pragma unroll
        for (int j = 0; j < 4; ++j) s += (acc[j].x + acc[j].y) + (acc[j].z + acc[j].w);
        const float mean = wave_sum(s) * (1.f / D); float q = 0.f;
#pragma unroll
        for (int j = 0; j < 4; ++j) { acc[j] = acc[j] - mean; q += (acc[j].x * acc[j].x + acc[j].y * acc[j].y) + (acc[j].z * acc[j].z + acc[j].w * acc[j].w); }
        const float rstd = rsqrtf(wave_sum(q) * (1.f / D) + EPS);
#pragma unroll
        for (int j = 0; j < 4; ++j) { const int o = 4 * F.lane + 256 * j; const f32x4 gg = *(const f32x4*)(lng + o), bb = *(const f32x4*)(lnb + o);
            f32x4 y = acc[j] * rstd * gg + bb; y.x = silu_f(y.x); y.y = silu_f(y.y); y.z = silu_f(y.z); y.w = silu_f(y.w); acc[j] = y; }
        row_store_bf16(V1 + (size_t)row * D, acc, F.lane);
    }
}


namespace pg {
constexpr int BM = 256, BK = 64, HALF = 128, HTB = HALF * BK * 2, STAGE_BYTES = 8 * HTB;
constexpr int TAB_OFF = STAGE_BYTES;
__device__ __forceinline__ int lds_byte(int r, int c) { const int st = (r >> 4) * 2 + (c >> 5), rr = r & 15, cc = c & 31, ob = rr * 64 + cc * 2; return st * 1024 + (ob ^ (((ob >> 9) & 1) << 5)); }
__device__ __forceinline__ void stage_rc(int b, int& R, int& C) { const int st = b / 1024, sb = b % 1024, swz = sb ^ (((sb >> 9) & 1) << 5); R = (st >> 1) * 16 + swz / 64; C = (st & 1) * 32 + (swz % 64) / 2; }
__device__ __forceinline__ int perm32(int rho) { const int n = rho >> 4, i = rho & 15; return 8 * (i >> 2) + 4 * n + (i & 3); }
__device__ __forceinline__ unsigned cvt_pk_bf16(float lo, float hi) { unsigned r; asm volatile("v_cvt_pk_bf16_f32 %0, %1, %2" : "=v"(r) : "v"(lo), "v"(hi)); return r; }

struct GU { const char* B; int p0, p1, p2, p3; };

template <class Epi, class Sched>
__device__ __forceinline__ void gemm_phase(LAS unsigned char* lds, const char* Abase, const int K, const Sched& S, const Epi& E) {
    const int tid = threadIdx.x, wid = __builtin_amdgcn_readfirstlane(tid >> 6), lane = tid & 63, wr = wid >> 2, wc = wid & 3, fr = lane & 15, fq = lane >> 4;
    const int nt = K / BK;
    int sR[2], sC[2]; unsigned voffB[2];
#pragma unroll
    for (int i = 0; i < 2; ++i) { int R, C; stage_rc(tid * 16 + i * 8192, R, C); sR[i] = R; sC[i] = C; const int Rb = Epi::PERM ? ((R & ~31) + perm32(R & 31)) : R; voffB[i] = (unsigned)(Rb * K + C) * 2u; }
    const size_t kstep = (size_t)(BK * 2);
    const size_t hstep = (size_t)HALF * K * 2;
    const unsigned ldsw = (unsigned)wid * 1024u;
    const int aoff = lds_byte(wr * 64 + fr, fq * 8), boff = lds_byte(wc * 32 + fr, fq * 8);
#define PG_SA(b, h) (((b) * 2 + (h)) * HTB)
#define PG_SB(b, h) ((4 + (b) * 2 + (h)) * HTB)
#define PG_STAGE(bufoff, gbase, voff) do { _Pragma("unroll") for (int _i = 0; _i < 2; ++_i) \
        __builtin_amdgcn_global_load_lds((const unsigned*)((const char*)(gbase) + (voff)[_i]), (LAS unsigned*)(lds + (bufoff) + ldsw + _i * 8192), 16, 0, 0); } while (0)
#define PG_LDA(dst, b, h) do { _Pragma("unroll") for (int m = 0; m < 4; ++m) _Pragma("unroll") for (int k = 0; k < 2; ++k) dst[m][k] = *(const LAS bf16x8*)(lds + PG_SA(b, h) + aoff + m * 2048 + k * 1024); } while (0)
#define PG_LDB(dst, b, h) do { _Pragma("unroll") for (int n = 0; n < 2; ++n) _Pragma("unroll") for (int k = 0; k < 2; ++k) dst[n][k] = *(const LAS bf16x8*)(lds + PG_SB(b, h) + boff + n * 2048 + k * 1024); } while (0)
#define PG_MMA(ai, bj, At, Bt) do { __builtin_amdgcn_s_setprio(1); _Pragma("unroll") for (int m = 0; m < 4; ++m) _Pragma("unroll") for (int n = 0; n < 2; ++n) _Pragma("unroll") for (int k = 0; k < 2; ++k) \
        acc[ai][bj][m][n] = __builtin_amdgcn_mfma_f32_16x16x32_bf16(Bt[n][k], At[m][k], acc[ai][bj][m][n], 0, 0, 0); __builtin_amdgcn_s_setprio(0); } while (0)
#define PG_WAIT_V(n) asm volatile("s_waitcnt vmcnt(" #n ")" ::: "memory")
#define PG_WAIT_L(n) asm volatile("s_waitcnt lgkmcnt(" #n ")" ::: "memory")
#define PG_BAR __builtin_amdgcn_s_barrier()
#define PG_SCHED __builtin_amdgcn_sched_barrier(0)
    GU cur, nxt; int ui = 0;
    if (!S.next(0, cur)) return;
    f32x4 acc[2][2][4][2];
#pragma unroll
    for (int a = 0; a < 2; ++a)
#pragma unroll
        for (int b = 0; b < 2; ++b)
#pragma unroll
            for (int m = 0; m < 4; ++m)
#pragma unroll
                for (int n = 0; n < 2; ++n) acc[a][b][m][n] = (f32x4){0.f, 0.f, 0.f, 0.f};
    bf16x8 At[4][2], B0[2][2], B1[2][2];
    if constexpr (Sched::GATHER) { S.stage_table(cur, 0, lds, wid, lane); PG_WAIT_V(0); PG_BAR; }
    unsigned voC[2][2], voN[2][2];
#pragma unroll
    for (int h = 0; h < 2; ++h)
#pragma unroll
        for (int i = 0; i < 2; ++i) { voC[h][i] = S.voff(cur, 0, lds, h * HALF + sR[i], sC[i]); voN[h][i] = voC[h][i]; }
    const char* cB = cur.B;
    PG_STAGE(PG_SB(0, 0), cB, voffB); PG_STAGE(PG_SB(0, 1), cB + hstep, voffB); PG_STAGE(PG_SA(0, 0), Abase, voC[0]); PG_STAGE(PG_SA(0, 1), Abase, voC[1]);
    if (wr == 1) PG_BAR;
    PG_WAIT_V(2); PG_BAR;
    PG_STAGE(PG_SB(1, 0), cB + kstep, voffB); PG_STAGE(PG_SA(1, 0), Abase + kstep, voC[0]); PG_STAGE(PG_SB(1, 1), cB + hstep + kstep, voffB);
    PG_WAIT_V(6); PG_BAR;
    for (;;) {
        const bool has_next = S.next(ui + 1, nxt);
        if constexpr (Sched::GATHER) { if (has_next) S.stage_table(nxt, (ui + 1) & 1, lds, wid, lane); }
        const char* nB = has_next ? nxt.B : cB;
        for (int t = 0; t < nt; t += 2) {
            const bool last = (t == nt - 2);
            if (last && has_next) {
#pragma unroll
                for (int h = 0; h < 2; ++h)
#pragma unroll
                    for (int i = 0; i < 2; ++i) voN[h][i] = S.voff(nxt, (ui + 1) & 1, lds, h * HALF + sR[i], sC[i]);
            }
            unsigned vo2[2][2];
#pragma unroll
            for (int h = 0; h < 2; ++h)
#pragma unroll
                for (int i = 0; i < 2; ++i) vo2[h][i] = last ? voN[h][i] : voC[h][i];
            const char* a1 = Abase + (size_t)(t + 1) * kstep;
            const char* a2 = last ? Abase : Abase + (size_t)(t + 2) * kstep; const char* b2 = last ? nB : cB + (size_t)(t + 2) * kstep;
            const char* a3 = a2 + kstep; const char* b3 = b2 + kstep;
            PG_LDB(B0, 0, 0); PG_LDB(B1, 0, 1); PG_SCHED; PG_LDA(At, 0, 0); PG_STAGE(PG_SA(1, 1), a1, voC[1]);
            PG_WAIT_V(8); PG_WAIT_L(0); PG_BAR; PG_MMA(0, 0, At, B0); PG_MMA(0, 1, At, B1); PG_BAR; PG_SCHED;
            PG_LDA(At, 0, 1); PG_STAGE(PG_SB(0, 0), b2, voffB); PG_STAGE(PG_SB(0, 1), b2 + hstep, voffB); PG_STAGE(PG_SA(0, 0), a2, vo2[0]);
            PG_WAIT_V(8); PG_WAIT_L(0); PG_BAR; PG_MMA(1, 0, At, B0); PG_MMA(1, 1, At, B1); PG_BAR; PG_SCHED;
            PG_LDB(B0, 1, 0); PG_LDB(B1, 1, 1); PG_SCHED; PG_LDA(At, 1, 0); PG_STAGE(PG_SA(0, 1), a2, vo2[1]);
            PG_WAIT_V(8); PG_WAIT_L(0); PG_BAR; PG_MMA(0, 0, At, B0); PG_MMA(0, 1, At, B1); PG_BAR; PG_SCHED;
            PG_LDA(At, 1, 1); PG_STAGE(PG_SB(1, 0), b3, voffB); PG_STAGE(PG_SB(1, 1), b3 + hstep, voffB); PG_STAGE(PG_SA(1, 0), a3, vo2[0]);
            PG_WAIT_V(8); PG_WAIT_L(0); PG_BAR; PG_MMA(1, 0, At, B0); PG_MMA(1, 1, At, B1); PG_BAR; PG_SCHED;
        }
        if (wr == 0) PG_BAR;
        E(acc, cur, wr, wc, fr, fq);
        if (!has_next) break;
#pragma unroll
        for (int a = 0; a < 2; ++a)
#pragma unroll
            for (int b = 0; b < 2; ++b)
#pragma unroll
                for (int m = 0; m < 4; ++m)
#pragma unroll
                    for (int n = 0; n < 2; ++n) acc[a][b][m][n] = (f32x4){0.f, 0.f, 0.f, 0.f};
        cur = nxt; cB = nB; ++ui;
#pragma unroll
        for (int h = 0; h < 2; ++h)
#pragma unroll
            for (int i = 0; i < 2; ++i) voC[h][i] = voN[h][i];
        if (wr == 1) PG_BAR;
    }
    PG_WAIT_V(0);
    PG_BAR;
#undef PG_SA
#undef PG_SB
#undef PG_STAGE
#undef PG_LDA
#undef PG_LDB
#undef PG_MMA
#undef PG_WAIT_V
#undef PG_WAIT_L
#undef PG_BAR
#undef PG_SCHED
}

__device__ __forceinline__ void static_tile(int L, int nM, int nN, int& pm, int& pn) {
    const int nwg = nM * nN; int wgid = L; { const int q = nwg / 8, r = nwg % 8, xcd = wgid % 8, off = wgid / 8; wgid = (xcd < r ? xcd * (q + 1) : r * (q + 1) + (xcd - r) * q) + off; }
    const int nig = 8 * nN, gid = wgid / nig, fm = gid * 8, gsz = (nM - fm) < 8 ? (nM - fm) : 8;
    pm = fm + ((wgid % nig) % gsz); pn = (wgid % nig) / gsz;
}
struct DenseSched {
    static constexpr bool GATHER = false;
    const char* Bt; int K, nM, nN, G, c, xn, xm0, xpn;
    __device__ __forceinline__ bool next(int i, GU& u) const {
        const int L = i * G + c, nmain = nM * nN; int pm, pn;
        if (L < nmain) static_tile(L, nM, nN, pm, pn); else if (L < nmain + xn) { pm = xm0 + (L - nmain); pn = xpn; } else return false;
        u.B = Bt + (size_t)pn * BM * K * 2; u.p0 = pm; u.p1 = pn; u.p2 = 0; u.p3 = 0; return true;
    }
    __device__ __forceinline__ unsigned voff(const GU& u, int, LAS unsigned char*, int R, int C) const { return (unsigned)(((u.p0 * BM + R) * K + C) * 2); }
    __device__ __forceinline__ void stage_table(const GU&, int, LAS unsigned char*, int, int) const {}
};
template <bool GATHER_> struct MoeSched {
    static constexpr bool GATHER = GATHER_;
    const char* Wt; size_t wstride; int K; const int* list; LAS int* mm; int G, c;
    __device__ __forceinline__ bool next(int i, GU& u) const {
        int L = i * G + c;
        for (int e = 0; e < 16; ++e) { const int n = mm[e], nu = ((n + 255) >> 8) * 4;
            if (L < nu) { const int rt = L >> 2, pn = L & 3; u.B = Wt + (size_t)e * wstride + (size_t)pn * BM * K * 2; u.p0 = e; u.p1 = rt; u.p2 = pn; u.p3 = mm[16 + e]; return true; }
            L -= nu; }
        return false;
    }
    __device__ __forceinline__ unsigned voff(const GU& u, int buf, LAS unsigned char* lds, int R, int C) const {
        if constexpr (GATHER_) { const int tok = ((const LAS int*)(lds + TAB_OFF))[buf * 256 + R]; return (unsigned)((tok * K + C) * 2); }
        else return (unsigned)(((u.p3 + u.p1 * BM + R) * K + C) * 2);
    }
    __device__ __forceinline__ void stage_table(const GU& u, int buf, LAS unsigned char* lds, int wid, int lane) const {
        if constexpr (GATHER_) { const int r = (wid & 3) * 64 + lane;
            __builtin_amdgcn_global_load_lds((const unsigned*)(list + u.p0 * CAP + u.p1 * BM + r), (LAS unsigned*)(lds + TAB_OFF + buf * 1024 + (wid & 3) * 256), 4, 0, 0); }
    }
};

struct EpiInProj {
    static constexpr bool PERM = false;
    unsigned char* ws;
    __device__ __forceinline__ void operator()(const f32x4 (&acc)[2][2][4][2], const GU& u, int wr, int wc, int fr, int fq) const {
        const int pm = u.p0, pn = u.p1; const bool isctx = pm >= T / BM;
        float inv[4];
#pragma unroll
        for (int j = 0; j < 4; ++j) inv[j] = exp2f(-(float)(4 * fq + j) * (13.287712379549449f / 16.f));
#pragma unroll
        for (int bj = 0; bj < 2; ++bj) {
            const int cb = pn * BM + bj * HALF + wc * 32;
            bf16* dst; int pitch, cbase; bool rope = false;
            if (cb < 512) { dst = (bf16*)(ws + WS_UF); pitch = 512; cbase = 0; }
            else if (cb < 1024) { dst = (bf16*)(ws + WS_Q); pitch = 512; cbase = 512; rope = true; }
            else if (cb < 1152) { dst = isctx ? (bf16*)(ws + WS_CK) : (bf16*)(ws + WS_K); pitch = 128; cbase = 1024; rope = !isctx; }
            else { dst = isctx ? (bf16*)(ws + WS_CV) : (bf16*)(ws + WS_V); pitch = 128; cbase = 1152; }
            const bool bycol = ((cb >> 5) & 1) != 0;
#pragma unroll
            for (int ai = 0; ai < 2; ++ai)
#pragma unroll
                for (int m = 0; m < 4; ++m) {
                    const int row = pm * BM + ai * HALF + wr * 64 + m * 16 + fr;
                    f32x4 v0 = acc[ai][bj][m][0], v1 = acc[ai][bj][m][1];
                    if (rope) { const int l = row & (L - 1); const float pos = (float)(bycol ? (l & 63) : (l >> 6));
#pragma unroll
                        for (int j = 0; j < 4; ++j) { const float ang = pos * inv[j], cs = __cosf(ang), sn = __sinf(ang); const float x1 = v0[j], x2 = v1[j]; v0[j] = x1 * cs - x2 * sn; v1[j] = x1 * sn + x2 * cs; } }
                    const int orow = isctx ? row - T : row;
                    if (FAST_ATTN && cb >= 1152) {
                        const int kp = isctx ? CL : L, bb = isctx ? (orow >> 8) : (orow >> 13), key = isctx ? (orow & (CL - 1)) : (orow & (L - 1));
#pragma unroll
                        for (int n = 0; n < 2; ++n)
#pragma unroll
                            for (int j = 0; j < 4; ++j) { const int c = (cb - 1152) + 16 * n + 4 * fq + j;
                                dst[((size_t)bb * 128 + c) * kp + key] = (bf16)f2bf(n ? v1[j] : v0[j]); }
                        continue;
                    }
                    bf16* o = dst + (size_t)orow * pitch + (cb - cbase) + 4 * fq;
                    u32x2 w0, w1; w0.x = cvt_pk_bf16(v0[0], v0[1]); w0.y = cvt_pk_bf16(v0[2], v0[3]); w1.x = cvt_pk_bf16(v1[0], v1[1]); w1.y = cvt_pk_bf16(v1[2], v1[3]);
                    *(u32x2*)o = w0; *(u32x2*)(o + 16) = w1;
                }
        }
    }
};
struct EpiRes {
    static constexpr bool PERM = false;
    const float* base; float* X; const float* gate; const float* bias;
    __device__ __forceinline__ void operator()(const f32x4 (&acc)[2][2][4][2], const GU& u, int wr, int wc, int fr, int fq) const {
        const int row0 = u.p0 * BM + wr * 64 + fr, col0 = u.p1 * BM + wc * 32 + 4 * fq; const int b = (u.p0 * BM) >> 13;
        f32x4 gv[2][2], bv[2][2];
#pragma unroll
        for (int bj = 0; bj < 2; ++bj)
#pragma unroll
            for (int n = 0; n < 2; ++n) { gv[bj][n] = *(const f32x4*)(gate + (size_t)b * 6144 + col0 + bj * HALF + n * 16); bv[bj][n] = bias ? *(const f32x4*)(bias + col0 + bj * HALF + n * 16) : (f32x4){0.f, 0.f, 0.f, 0.f}; }
#pragma unroll
        for (int ai = 0; ai < 2; ++ai)
#pragma unroll
            for (int mp = 0; mp < 2; ++mp) {
                f32x4 bs[2][2][2];
#pragma unroll
                for (int mm = 0; mm < 2; ++mm) { const size_t off = (size_t)(row0 + ai * HALF + (2 * mp + mm) * 16) * D + col0;
#pragma unroll
                    for (int bj = 0; bj < 2; ++bj)
#pragma unroll
                        for (int n = 0; n < 2; ++n) bs[mm][bj][n] = *(const f32x4*)(base + off + bj * HALF + n * 16); }
#pragma unroll
                for (int mm = 0; mm < 2; ++mm) { const int m = 2 * mp + mm; const size_t off = (size_t)(row0 + ai * HALF + m * 16) * D + col0;
#pragma unroll
                    for (int bj = 0; bj < 2; ++bj)
#pragma unroll
                        for (int n = 0; n < 2; ++n) *(f32x4*)(X + off + bj * HALF + n * 16) = bs[mm][bj][n] + gv[bj][n] * (acc[ai][bj][m][n] + bv[bj][n]); }
                asm volatile("" ::: "memory"); }
    }
};
template <bool BASEBF> struct EpiResB {
    static constexpr bool PERM = false;
    const float* basef; bf16* XB; const float* gate; const float* bias;
    __device__ __forceinline__ void operator()(const f32x4 (&acc)[2][2][4][2], const GU& u, int wr, int wc, int fr, int fq) const {
        const int row0 = u.p0 * BM + wr * 64 + fr, col0 = u.p1 * BM + wc * 32 + 4 * fq; const int b = (u.p0 * BM) >> 13;
        f32x4 gv[2][2], bv[2][2];
#pragma unroll
        for (int bj = 0; bj < 2; ++bj)
#pragma unroll
            for (int n = 0; n < 2; ++n) { gv[bj][n] = *(const f32x4*)(gate + (size_t)b * 6144 + col0 + bj * HALF + n * 16); bv[bj][n] = bias ? *(const f32x4*)(bias + col0 + bj * HALF + n * 16) : (f32x4){0.f, 0.f, 0.f, 0.f}; }
#pragma unroll
        for (int ai = 0; ai < 2; ++ai)
#pragma unroll
            for (int mp = 0; mp < 2; ++mp) {
                f32x4 bs[2][2][2];
#pragma unroll
                for (int mm = 0; mm < 2; ++mm) { const size_t off = (size_t)(row0 + ai * HALF + (2 * mp + mm) * 16) * D + col0;
#pragma unroll
                    for (int bj = 0; bj < 2; ++bj)
#pragma unroll
                        for (int n = 0; n < 2; ++n) { if (BASEBF) { const u32x2 w = *(const u32x2*)(XB + off + bj * HALF + n * 16); bs[mm][bj][n] = (f32x4){bflo(w.x), bfhi(w.x), bflo(w.y), bfhi(w.y)}; }
                                                      else bs[mm][bj][n] = *(const f32x4*)(basef + off + bj * HALF + n * 16); } }
#pragma unroll
                for (int mm = 0; mm < 2; ++mm) { const int m = 2 * mp + mm; const size_t off = (size_t)(row0 + ai * HALF + m * 16) * D + col0;
#pragma unroll
                    for (int bj = 0; bj < 2; ++bj)
#pragma unroll
                        for (int n = 0; n < 2; ++n) { const f32x4 o = bs[mm][bj][n] + gv[bj][n] * (acc[ai][bj][m][n] + bv[bj][n]);
                            u32x2 w; w.x = cvt_pk_bf16(o[0], o[1]); w.y = cvt_pk_bf16(o[2], o[3]); *(u32x2*)(XB + off + bj * HALF + n * 16) = w; } }
                asm volatile("" ::: "memory"); }
    }
};
struct EpiGLU {
    static constexpr bool PERM = true;
    bf16* U; const float* bias;
    __device__ __forceinline__ void operator()(const f32x4 (&acc)[2][2][4][2], const GU& u, int wr, int wc, int fr, int fq) const {
        const int row0 = u.p0 * BM + wr * 64 + fr, col0 = u.p1 * HALF + wc * 32 + 8 * fq;
        f32x4 ba[2], bg[2];
#pragma unroll
        for (int n = 0; n < 2; ++n) { ba[n] = *(const f32x4*)(bias + col0 + 4 * n); bg[n] = *(const f32x4*)(bias + 1024 + col0 + 4 * n); }
#pragma unroll
        for (int ai = 0; ai < 2; ++ai)
#pragma unroll
            for (int m = 0; m < 4; ++m) { f32x4 o[2];
#pragma unroll
                for (int n = 0; n < 2; ++n) { const f32x4 a = acc[ai][0][m][n] + ba[n], g = acc[ai][1][m][n] + bg[n];
#pragma unroll
                    for (int j = 0; j < 4; ++j) o[n][j] = a[j] * sigmoid_f(g[j]); }
                u32x4 w; w.x = cvt_pk_bf16(o[0][0], o[0][1]); w.y = cvt_pk_bf16(o[0][2], o[0][3]); w.z = cvt_pk_bf16(o[1][0], o[1][1]); w.w = cvt_pk_bf16(o[1][2], o[1][3]);
                *(u32x4*)(U + (size_t)(row0 + ai * HALF + m * 16) * D + col0) = w; }
    }
};
struct EpiGateUp {
    static constexpr bool PERM = true;
    bf16* HID; const float* slot_w; LAS int* mm;
    __device__ __forceinline__ void operator()(const f32x4 (&acc)[2][2][4][2], const GU& u, int wr, int wc, int fr, int fq) const {
        const int e = u.p0, n_e = mm[e], r0 = u.p1 * BM + wr * 64 + fr, col0 = u.p2 * HALF + wc * 32 + 8 * fq;
        float wv[2][4];
#pragma unroll
        for (int ai = 0; ai < 2; ++ai)
#pragma unroll
            for (int m = 0; m < 4; ++m) wv[ai][m] = slot_w[e * CAP + r0 + ai * HALF + m * 16];
#pragma unroll
        for (int ai = 0; ai < 2; ++ai)
#pragma unroll
            for (int m = 0; m < 4; ++m) { const int r = r0 + ai * HALF + m * 16;
                if (r < n_e) { const float w = wv[ai][m]; f32x4 o[2];
#pragma unroll
                    for (int n = 0; n < 2; ++n) { const f32x4 g = acc[ai][0][m][n], up = acc[ai][1][m][n];
#pragma unroll
                        for (int j = 0; j < 4; ++j) o[n][j] = w * silu_f(g[j]) * up[j]; }
                    u32x4 q; q.x = cvt_pk_bf16(o[0][0], o[0][1]); q.y = cvt_pk_bf16(o[0][2], o[0][3]); q.z = cvt_pk_bf16(o[1][0], o[1][1]); q.w = cvt_pk_bf16(o[1][2], o[1][3]);
                    *(u32x4*)(HID + (size_t)(u.p3 + r) * FF + col0) = q; } }
    }
};
struct EpiDown {
    static constexpr bool PERM = true;
    bf16* Y; LAS int* mm;
    __device__ __forceinline__ void operator()(const f32x4 (&acc)[2][2][4][2], const GU& u, int wr, int wc, int fr, int fq) const {
        const int e = u.p0, n_e = mm[e], r0 = u.p1 * BM + wr * 64 + fr, col0 = u.p2 * BM + wc * 32 + 8 * fq;
#pragma unroll
        for (int ai = 0; ai < 2; ++ai)
#pragma unroll
            for (int m = 0; m < 4; ++m) { const int r = r0 + ai * HALF + m * 16;
                if (r < n_e) {
#pragma unroll
                    for (int bj = 0; bj < 2; ++bj) { const f32x4 v0 = acc[ai][bj][m][0], v1 = acc[ai][bj][m][1];
                        u32x4 q; q.x = cvt_pk_bf16(v0[0], v0[1]); q.y = cvt_pk_bf16(v0[2], v0[3]); q.z = cvt_pk_bf16(v1[0], v1[1]); q.w = cvt_pk_bf16(v1[2], v1[3]);
                        *(u32x4*)(Y + (size_t)(u.p3 + r) * D + col0 + bj * HALF) = q; } } }
    }
};
}

__device__ __forceinline__ void fast_inproj(Frame& F) {
    pg::DenseSched S{(const char*)(F.ws + WS_WIN), D, T / 256, N_IN / 256, F.G, F.wg, TC / 256, T / 256, 4};
    pg::EpiInProj E{F.ws};
    pg::gemm_phase(F.lds, (const char*)(F.ws + WS_HB), D, S, E);
}
__device__ __forceinline__ void fast_outproj(Frame& F, size_t a_off, size_t w_off, const float* base, float* X, const float* gate, const float* bias) {
    pg::DenseSched S{(const char*)(F.ws + w_off), D, T / 256, D / 256, F.G, F.wg, 0, 0, 0};
    if (XBF16) {
        if (base == X) { pg::EpiResB<true> E{nullptr, (bf16*)(F.ws + WS_XB), gate, bias}; pg::gemm_phase(F.lds, (const char*)(F.ws + a_off), D, S, E); }
        else { pg::EpiResB<false> E{base, (bf16*)(F.ws + WS_XB), gate, bias}; pg::gemm_phase(F.lds, (const char*)(F.ws + a_off), D, S, E); }
    } else { pg::EpiRes E{base, X, gate, bias}; pg::gemm_phase(F.lds, (const char*)(F.ws + a_off), D, S, E); }
}
__device__ __forceinline__ void fast_pw1(Frame& F) {
    pg::DenseSched S{(const char*)(F.ws + WS_WPW1), D, T / 256, 2048 / 256, F.G, F.wg, 0, 0, 0};
    pg::EpiGLU E{(bf16*)(F.ws + WS_U), F.in[I_PW1B]};
    pg::gemm_phase(F.lds, (const char*)(F.ws + WS_HB), D, S, E);
}
__device__ __forceinline__ void fast_moe_gateup(Frame& F, int layer) {
    LAS int* mm = moe_map(F, layer);
    pg::MoeSched<true> S{(const char*)(F.ws + WS_WGU) + (size_t)layer * 16 * 1024 * 1024 * 2, (size_t)1024 * 1024 * 2, D, (const int*)(F.ws + WS_SLOTT) + layer * 16 * CAP, mm, F.G, F.wg};
    pg::EpiGateUp E{(bf16*)(F.ws + WS_HID), (const float*)(F.ws + WS_SLOTW) + layer * 16 * CAP, mm};
    pg::gemm_phase(F.lds, (const char*)(F.ws + WS_HB), D, S, E);
}
__device__ __forceinline__ void fast_moe_down(Frame& F, int layer) {
    LAS int* mm = moe_map(F, layer);
    pg::MoeSched<false> S{(const char*)(F.ws + WS_WDN) + (size_t)layer * 16 * 1024 * 512 * 2, (size_t)1024 * 512 * 2, FF, nullptr, mm, F.G, F.wg};
    pg::EpiDown E{(bf16*)(F.ws + WS_Y), mm};
    pg::gemm_phase(F.lds, (const char*)(F.ws + WS_HID), FF, S, E);
}


typedef __bf16 b16x2_t __attribute__((ext_vector_type(2)));
__device__ __forceinline__ unsigned pkbf(float a, float b) { typedef float f2 __attribute__((ext_vector_type(2))); f2 v = {a, b}; return __builtin_bit_cast(unsigned, __builtin_convertvector(v, b16x2_t)); }
struct AttnBlk { const bf16* kp; const bf16* vp; int pitch; int kb; bool valid, masked; };
__device__ __forceinline__ AttnBlk attn_blk(const unsigned char* ws, int bi, int b, int kvh, int qs) {
    AttnBlk a;
    if (bi < 8) { a.kp = (const bf16*)(ws + WS_CK) + (size_t)(b * CL + bi * 32) * 128 + kvh * 64; a.vp = (const bf16*)(ws + WS_CV) + (size_t)(b * 2 + kvh) * 64 * CL + bi * 32; a.pitch = CL; a.kb = 0; a.valid = true; a.masked = false; }
    else { const int kb = qs - 128 + 32 * (bi - 8); a.valid = (kb >= 0 && kb < L); a.kb = kb; a.masked = true; a.pitch = L;
        a.kp = (const bf16*)(ws + WS_K) + (size_t)(b * L + kb) * 128 + kvh * 64; a.vp = (const bf16*)(ws + WS_V) + (size_t)(b * 2 + kvh) * 64 * L + kb; }
    return a;
}
__device__ __forceinline__ void attn_load(const AttnBlk& a, int r, int h, bf16x8 (&kf)[4], u32x4 (&vf)[2][2]) {
    if (a.valid) {
#pragma unroll
        for (int s = 0; s < 4; ++s) kf[s] = *(const bf16x8*)(a.kp + (size_t)r * 128 + 16 * s + 8 * h);
#pragma unroll
        for (int db = 0; db < 2; ++db)
#pragma unroll
            for (int ks = 0; ks < 2; ++ks) { const bf16* vr = a.vp + (size_t)(32 * db + r) * a.pitch + 16 * ks + 4 * h;
                const u32x2 lo = *(const u32x2*)vr, hi = *(const u32x2*)(vr + 8); vf[db][ks] = (u32x4){lo.x, lo.y, hi.x, hi.y}; }
    }
}
__device__ __forceinline__ void attn_compute(const AttnBlk& a, int qs, int r, int h, const bf16x8 (&kf)[4], const u32x4 (&vf)[2][2], const bf16x8 (&qf)[2][4],
                                             f32x16 (&o)[2][2], float (&m)[2], float (&l)[2]) {
    if (!a.valid) return;
#pragma unroll
    for (int nq = 0; nq < 2; ++nq) {
        f32x16 st;
#pragma unroll
        for (int i = 0; i < 16; ++i) st[i] = 0.f;
#pragma unroll
        for (int s = 0; s < 4; ++s) st = __builtin_amdgcn_mfma_f32_32x32x16_bf16(kf[s], qf[nq][s], st, 0, 0, 0);
        float t[16]; float tmax = -INFINITY;
        const int dbase = a.kb - qs - 32 * nq - r + 4 * h;
#pragma unroll
        for (int i = 0; i < 16; ++i) { float v = st[i] * (0.125f * 1.4426950408889634f);
            if (a.masked) { const int df = dbase + (i & 3) + 8 * (i >> 2); v = (df >= -128 && df <= 128) ? v : -INFINITY; }
            t[i] = v; tmax = fmaxf(tmax, v); }
        tmax = fmaxf(tmax, __shfl_xor(tmax, 32));
        const float mn = fmaxf(m[nq], tmax), alpha = __builtin_amdgcn_exp2f(m[nq] - mn); m[nq] = mn;
        float ps = 0.f;
#pragma unroll
        for (int i = 0; i < 16; ++i) { t[i] = __builtin_amdgcn_exp2f(t[i] - mn); ps += t[i]; }
        l[nq] = l[nq] * alpha + ps;
#pragma unroll
        for (int i = 0; i < 16; ++i) { o[0][nq][i] *= alpha; o[1][nq][i] *= alpha; }
        bf16x8 pf[2];
#pragma unroll
        for (int ks = 0; ks < 2; ++ks) { const u32x4 w = {pkbf(t[8 * ks], t[8 * ks + 1]), pkbf(t[8 * ks + 2], t[8 * ks + 3]), pkbf(t[8 * ks + 4], t[8 * ks + 5]), pkbf(t[8 * ks + 6], t[8 * ks + 7])};
            pf[ks] = __builtin_bit_cast(bf16x8, w); }
#pragma unroll
        for (int db = 0; db < 2; ++db)
#pragma unroll
            for (int ks = 0; ks < 2; ++ks) o[db][nq] = __builtin_amdgcn_mfma_f32_32x32x16_bf16(__builtin_bit_cast(bf16x8, vf[db][ks]), pf[ks], o[db][nq], 0, 0, 0);
    }
}
__device__ __forceinline__ void phase_attn_mfma(Frame& F) {
    const bf16* Q = (const bf16*)(F.ws + WS_Q); bf16* MIX = (bf16*)(F.ws + WS_MIX);
    const int g = F.wave >> 1, half = F.wave & 1, r = F.lane & 31, h = F.lane >> 5;
    for (int item = F.wg; item < NB * 2 * 64; item += F.G) {
        const int qb = item & 63, kvh = (item >> 6) & 1, b = item >> 7, hd = kvh * 4 + g, qs = qb * 128 + half * 64;
        bf16x8 qf[2][4];
#pragma unroll
        for (int nq = 0; nq < 2; ++nq)
#pragma unroll
            for (int s = 0; s < 4; ++s) qf[nq][s] = *(const bf16x8*)(Q + (size_t)(b * L + qs + 32 * nq + r) * 512 + hd * 64 + 16 * s + 8 * h);
        f32x16 o[2][2];
#pragma unroll
        for (int db = 0; db < 2; ++db)
#pragma unroll
            for (int nq = 0; nq < 2; ++nq)
#pragma unroll
                for (int i = 0; i < 16; ++i) o[db][nq][i] = 0.f;
        float m[2], l[2];
        m[0] = m[1] = F.in[I_SINK][hd] * 1.4426950408889634f; l[0] = l[1] = (h == 0) ? 1.f : 0.f;
        bf16x8 kfA[4], kfB[4]; u32x4 vfA[2][2], vfB[2][2];
        AttnBlk ba = attn_blk(F.ws, 0, b, kvh, qs), bb;
        attn_load(ba, r, h, kfA, vfA);
#pragma unroll 1
        for (int bi = 0; bi < 18; bi += 2) {
            bb = attn_blk(F.ws, bi + 1, b, kvh, qs); attn_load(bb, r, h, kfB, vfB);
            attn_compute(ba, qs, r, h, kfA, vfA, qf, o, m, l);
            if (bi + 2 < 18) { ba = attn_blk(F.ws, bi + 2, b, kvh, qs); attn_load(ba, r, h, kfA, vfA); }
            attn_compute(bb, qs, r, h, kfB, vfB, qf, o, m, l);
        }
#pragma unroll
        for (int nq = 0; nq < 2; ++nq) {
            const float lt = l[nq] + __shfl_xor(l[nq], 32), il = 1.f / lt;
            bf16* orow = MIX + (size_t)(b * L + qs + 32 * nq + r) * 1024 + 512 + hd * 64;
#pragma unroll
            for (int db = 0; db < 2; ++db)
#pragma unroll
                for (int i4 = 0; i4 < 4; ++i4) { u32x2 w; w.x = pkbf(o[db][nq][4 * i4] * il, o[db][nq][4 * i4 + 1] * il); w.y = pkbf(o[db][nq][4 * i4 + 2] * il, o[db][nq][4 * i4 + 3] * il);
                    *(u32x2*)(orow + 32 * db + 8 * i4 + 4 * h) = w; }
        }
    }
}


constexpr int F1_PC = 136, F1_PW = 68, F2_P = 264;
constexpr int F1_CSC = 0, F1_CSS = 128 * F1_PC * 2, F1_C64 = 2 * 128 * F1_PC * 2, F1_S64 = F1_C64 + 64 * F1_PW * 2;
__device__ __forceinline__ bf16x8 pack8(float a0, float a1, float a2, float a3, float a4, float a5, float a6, float a7) {
    const u32x4 w = {pkbf(a0, a1), pkbf(a2, a3), pkbf(a4, a5), pkbf(a6, a7)}; return __builtin_bit_cast(bf16x8, w); }
__device__ __forceinline__ void phase_fft1_mfma(Frame& F) {
    __syncthreads();
    LAS bf16* csc = (LAS bf16*)(F.lds + F1_CSC); LAS bf16* css = (LAS bf16*)(F.lds + F1_CSS); LAS bf16* c64 = (LAS bf16*)(F.lds + F1_C64); LAS bf16* s64 = (LAS bf16*)(F.lds + F1_S64);
    for (int i = F.tid; i < 128 * 128; i += NTHR) { const int n = i >> 7, k = i & 127; const float ang = (float)((n * k) & 127) * (6.283185307179586f / 128.f);
        csc[n * F1_PC + k] = (bf16)f2bf(__cosf(ang)); css[n * F1_PC + k] = (bf16)f2bf(__sinf(ang)); }
    for (int i = F.tid; i < 64 * 64; i += NTHR) { const int c = i >> 6, a = i & 63; const float ang = (float)((c * a) & 63) * (6.283185307179586f / 64.f);
        c64[c * F1_PW + a] = (bf16)f2bf(__cosf(ang)); s64[c * F1_PW + a] = (bf16)f2bf(__sinf(ang)); }
    __syncthreads();
    const bf16* UF = (const bf16*)(F.ws + WS_UF); bf16* Gb = (bf16*)(F.ws + WS_G);
    const int r = F.lane & 31, h = F.lane >> 5, g = F.wave >> 1;
    for (int item = F.wg; item < NB * FN2; item += F.G) {
        const int b = item >> 7, bp = item & 127;
#pragma unroll 1
        for (int q = 0; q < 2; ++q) {
            const int cbk = 2 * F.wave + q, n = 32 * (cbk & 3) + r, ch = 32 * cbk + r;
            f32x16 zr[2], zi[2];
#pragma unroll
            for (int rb = 0; rb < 2; ++rb) {
                bf16x8 uf[8];
#pragma unroll
                for (int s2 = 0; s2 < 8; ++s2) uf[s2] = *(const bf16x8*)(UF + (size_t)(b * L + 128 * (32 * rb + r) + bp) * 512 + g * 128 + 16 * s2 + 8 * h);
#pragma unroll
                for (int i = 0; i < 16; ++i) { zr[rb][i] = 0.f; zi[rb][i] = 0.f; }
#pragma unroll
                for (int s2 = 0; s2 < 8; ++s2) { const bf16x8 bc = *(const LAS bf16x8*)(csc + n * F1_PC + 16 * s2 + 8 * h), bs = *(const LAS bf16x8*)(css + n * F1_PC + 16 * s2 + 8 * h);
                    zr[rb] = __builtin_amdgcn_mfma_f32_32x32x16_bf16(uf[s2], bc, zr[rb], 0, 0, 0); zi[rb] = __builtin_amdgcn_mfma_f32_32x32x16_bf16(uf[s2], bs, zi[rb], 0, 0, 0); }
                __builtin_amdgcn_sched_barrier(0);
            }
            bf16x8 zfr[4], zfi[4];
#pragma unroll
            for (int ks = 0; ks < 4; ++ks) { const int rb = ks >> 1, o = 8 * (ks & 1);
                zfr[ks] = pack8(zr[rb][o], zr[rb][o + 1], zr[rb][o + 2], zr[rb][o + 3], zr[rb][o + 4], zr[rb][o + 5], zr[rb][o + 6], zr[rb][o + 7]);
                zfi[ks] = pack8(-zi[rb][o], -zi[rb][o + 1], -zi[rb][o + 2], -zi[rb][o + 3], -zi[rb][o + 4], -zi[rb][o + 5], -zi[rb][o + 6], -zi[rb][o + 7]); }
            __builtin_amdgcn_sched_barrier(0);
#pragma unroll 1
            for (int rbc = 0; rbc < 2; ++rbc) {
                f32x16 gr, gi; const int cr = 32 * rbc + r;
#pragma unroll
                for (int i = 0; i < 16; ++i) { gr[i] = 0.f; gi[i] = 0.f; }
#pragma unroll
                for (int ks = 0; ks < 4; ++ks) {
                    const u32x2 cl = *(const LAS u32x2*)(c64 + cr * F1_PW + 16 * ks + 4 * h), chh = *(const LAS u32x2*)(c64 + cr * F1_PW + 16 * ks + 8 + 4 * h);
                    const u32x2 sl = *(const LAS u32x2*)(s64 + cr * F1_PW + 16 * ks + 4 * h), shh = *(const LAS u32x2*)(s64 + cr * F1_PW + 16 * ks + 8 + 4 * h);
                    const u32x4 sw = {sl.x, sl.y, shh.x, shh.y}; const u32x4 swn = sw ^ 0x80008000u;
                    const bf16x8 wc = __builtin_bit_cast(bf16x8, ((u32x4){cl.x, cl.y, chh.x, chh.y})), wsn = __builtin_bit_cast(bf16x8, sw), wsm = __builtin_bit_cast(bf16x8, swn);
                    gr = __builtin_amdgcn_mfma_f32_32x32x16_bf16(wc, zfr[ks], gr, 0, 0, 0); gr = __builtin_amdgcn_mfma_f32_32x32x16_bf16(wsn, zfi[ks], gr, 0, 0, 0);
                    gi = __builtin_amdgcn_mfma_f32_32x32x16_bf16(wc, zfi[ks], gi, 0, 0, 0); gi = __builtin_amdgcn_mfma_f32_32x32x16_bf16(wsm, zfr[ks], gi, 0, 0, 0); }
                __builtin_amdgcn_sched_barrier(0);
#pragma unroll
                for (int i = 0; i < 16; ++i) { const int c = 32 * rbc + crow(i, h); const float ang = (float)(bp * c) * (6.283185307179586f / 8192.f), cs = __cosf(ang), sn = __sinf(ang);
                    const float re = gr[i] * cs + gi[i] * sn, im = gi[i] * cs - gr[i] * sn;
                    bf16* o = Gb + (size_t)((b * FN1 + c) * FN2 + bp) * 1024 + ch; o[0] = (bf16)f2bf(re); o[512] = (bf16)f2bf(im);
                    if ((i & 3) == 3) __builtin_amdgcn_sched_barrier(0); }
            }
        }
    }
    __syncthreads();
}
__device__ __forceinline__ void phase_fft2_mfma(Frame& F) {
    __syncthreads();
    LAS bf16* t2 = (LAS bf16*)F.lds;
    for (int i = F.tid; i < 128 * 256; i += NTHR) { const int d = i >> 8, k = i & 255; const float ang = (float)((d * (k & 127)) & 127) * (6.283185307179586f / 128.f);
        t2[d * F2_P + k] = (bf16)f2bf(k < 128 ? __cosf(ang) : __sinf(ang)); }
    __syncthreads();
    const bf16* Gb = (const bf16*)(F.ws + WS_G); bf16* MIX = (bf16*)(F.ws + WS_MIX);
    const int r = F.lane & 31, h = F.lane >> 5;
    for (int item = F.wg; item < NB * FN1; item += F.G) {
        const int b = item >> 6, c = item & 63;
        const bf16* Gp = Gb + (size_t)((b * FN1 + c) * FN2) * 1024 + 64 * F.wave + r;
        f32x16 y[4][2];
#pragma unroll
        for (int rb = 0; rb < 4; ++rb)
#pragma unroll
            for (int cb = 0; cb < 2; ++cb)
#pragma unroll
                for (int i = 0; i < 16; ++i) y[rb][cb][i] = 0.f;
#pragma unroll 1
        for (int ks = 0; ks < 16; ++ks) {
            const bf16* p = Gp + (size_t)(16 * (ks & 7) + 8 * h) * 1024 + (ks >> 3) * 512;
            bf16x8 bfr[2];
#pragma unroll
            for (int cb = 0; cb < 2; ++cb) { unsigned e[8];
#pragma unroll
                for (int j = 0; j < 8; ++j) e[j] = p[(size_t)j * 1024 + 32 * cb];
                const u32x4 w = {e[0] | (e[1] << 16), e[2] | (e[3] << 16), e[4] | (e[5] << 16), e[6] | (e[7] << 16)}; bfr[cb] = __builtin_bit_cast(bf16x8, w); }
#pragma unroll
            for (int rb = 0; rb < 4; ++rb) { const bf16x8 a = *(const LAS bf16x8*)(t2 + (32 * rb + r) * F2_P + 16 * ks + 8 * h);
#pragma unroll
                for (int cb = 0; cb < 2; ++cb) y[rb][cb] = __builtin_amdgcn_mfma_f32_32x32x16_bf16(a, bfr[cb], y[rb][cb], 0, 0, 0); }
        }
#pragma unroll
        for (int rb = 0; rb < 4; ++rb)
#pragma unroll
            for (int cb = 0; cb < 2; ++cb)
#pragma unroll
                for (int i = 0; i < 16; ++i) { const int d = 32 * rb + crow(i, h); MIX[(size_t)(b * L + c + 64 * d) * 1024 + 64 * F.wave + 32 * cb + r] = (bf16)f2bf(y[rb][cb][i] * (1.f / 1024.f)); }
    }
    __syncthreads();
}


typedef float f32x2_t __attribute__((ext_vector_type(2)));
template <int IR> struct DwIn {
    static __device__ __forceinline__ void run(const unsigned (&uin)[62], const f32x2_t (&w)[31], f32x2_t (&o)[32]) {
        const f32x2_t x = {bflo(uin[IR]), bfhi(uin[IR])};
#pragma unroll
        for (int r = 0; r < 32; ++r) { if (IR - r >= 0 && IR - r <= 30) o[r] += w[(IR - r >= 0 && IR - r <= 30) ? IR - r : 0] * x; }
        DwIn<IR + 1>::run(uin, w, o);
    }
};
template <> struct DwIn<62> { static __device__ __forceinline__ void run(const unsigned (&)[62], const f32x2_t (&)[31], f32x2_t (&)[32]) {} };
__device__ __forceinline__ void phase_dwconv_fast(Frame& F) {
    const bf16* U = (const bf16*)(F.ws + WS_U); bf16* V1 = (bf16*)(F.ws + WS_V1);
    const float* dww = F.in[I_DWW];
    const int c0 = 2 * F.tid;
    f32x2_t w[31];
#pragma unroll
    for (int j = 0; j < 31; ++j) w[j] = *(const f32x2_t*)(dww + (size_t)j * D + c0);
    const f32x2_t bb = *(const f32x2_t*)(F.in[I_DWB] + c0), gg = *(const f32x2_t*)(F.in[I_LNG] + c0), lb = *(const f32x2_t*)(F.in[I_LNB] + c0);
    LAS float* red = (LAS float*)F.lds;
    LAS float* stat = red + 32 * 8 * 2;
    __syncthreads();
    for (int item = F.wg; item < T / 32; item += F.G) {
        const int row0 = item * 32, l0 = row0 & (L - 1);
        unsigned uin[62];
#pragma unroll
        for (int ir = 0; ir < 62; ++ir) { const int l = l0 - 15 + ir; const bool ok = (l >= 0 && l < L);
            const unsigned u = *(const unsigned*)(U + (size_t)(ok ? row0 - 15 + ir : row0) * D + c0); uin[ir] = ok ? u : 0u; }
        f32x2_t o[32];
#pragma unroll
        for (int r = 0; r < 32; ++r) o[r] = bb;
        DwIn<0>::run(uin, w, o);
#pragma unroll
        for (int r = 0; r < 32; ++r) { const float sm = wave_sum(o[r].x + o[r].y), sq = wave_sum(o[r].x * o[r].x + o[r].y * o[r].y);
            if (F.lane == 0) { red[(r * 8 + F.wave) * 2] = sm; red[(r * 8 + F.wave) * 2 + 1] = sq; } }
        __syncthreads();
        if (F.tid < 32) { float sm = 0.f, sq = 0.f;
#pragma unroll
            for (int wv = 0; wv < 8; ++wv) { sm += red[(F.tid * 8 + wv) * 2]; sq += red[(F.tid * 8 + wv) * 2 + 1]; }
            const float mean = sm * (1.f / D), var = fmaxf(sq * (1.f / D) - mean * mean, 0.f);
            stat[2 * F.tid] = mean; stat[2 * F.tid + 1] = rsqrtf(var + EPS); }
        __syncthreads();
#pragma unroll
        for (int r = 0; r < 32; ++r) { const float mean = stat[2 * r], rstd = stat[2 * r + 1];
            const float y0 = silu_f((o[r].x - mean) * rstd * gg.x + lb.x), y1 = silu_f((o[r].y - mean) * rstd * gg.y + lb.y);
            *(unsigned*)(V1 + (size_t)(row0 + r) * D + c0) = pkbf(y0, y1); }
        __syncthreads();
    }
}


namespace pg {
struct MU { const char* B; const char* A; int K, type, e, rt, pn, hb; };
struct MoeMergedSched {
    const char* Wgu; const char* Wdn; const char* HBp; const char* HIDp; const int* list; LAS int* mm; unsigned* tcnt; unsigned* tmo; int G, c, U;
    __device__ __forceinline__ bool flat(int L, int type, MU& u) const {
        for (int e = 0; e < 16; ++e) { const int n = mm[e], nu = ((n + 255) >> 8) * 4;
            if (L < nu) { u.e = e; u.rt = L >> 2; u.pn = L & 3; u.hb = mm[16 + e]; u.type = type;
                if (type == 0) { u.K = D; u.A = HBp; u.B = Wgu + (size_t)e * (1024 * 1024 * 2) + (size_t)u.pn * BM * D * 2; }
                else { u.K = FF; u.A = HIDp; u.B = Wdn + (size_t)e * (1024 * 512 * 2) + (size_t)u.pn * BM * FF * 2; }
                return true; }
            L -= nu; }
        return false;
    }
    __device__ __forceinline__ bool next(int i, MU& u) const {
        const int ngu = c < U ? (U - 1 - c) / G + 1 : 0;
        if (i < ngu) return flat(i * G + c, 0, u);
        const int k = i - ngu, x = U % G; int j;
        if (c >= x) { if (k == 0) j = c - x; else j = (G - 1 - c) + (k - 1) * G + (G - x); } else j = (G - 1 - c) + k * G + (G - x);
        if (j >= U) return false;
        return flat(j, 1, u);
    }
    __device__ __forceinline__ unsigned voff(const MU& u, int buf, LAS unsigned char* lds, int R, int C) const {
        if (u.type == 0) { const int tok = ((const LAS int*)(lds + TAB_OFF))[buf * 256 + R]; return (unsigned)((tok * D + C) * 2); }
        return (unsigned)(((u.hb + u.rt * BM + R) * FF + C) * 2);
    }
    __device__ __forceinline__ void stage_table(const MU& u, int buf, LAS unsigned char* lds, int wid, int lane) const {
        const int r = (wid & 3) * 64 + lane;
        __builtin_amdgcn_global_load_lds((const unsigned*)(list + u.e * CAP + u.rt * BM + r), (LAS unsigned*)(lds + TAB_OFF + buf * 1024 + (wid & 3) * 256), 4, 0, 0);
    }
    __device__ __forceinline__ unsigned* tile_word(const MU& u) const { return tcnt + ((u.hb >> 8) + u.rt) * 64; }
    __device__ __forceinline__ void wait_ready(const MU& u, int wid) const {
        if (wid == 0) {
            unsigned* w = tile_word(u); unsigned spins = 0;
            while ((unsigned)__builtin_amdgcn_readfirstlane(__hip_atomic_load(w, __ATOMIC_RELAXED, __HIP_MEMORY_SCOPE_AGENT)) < 32u) {
                __builtin_amdgcn_s_sleep(2);
                if ((++spins & 255u) == 0u) { if (__builtin_amdgcn_readfirstlane(__hip_atomic_load(tmo, __ATOMIC_RELAXED, __HIP_MEMORY_SCOPE_AGENT)) != 0u) break;
                    if (spins > (1u << 20)) { __hip_atomic_store(tmo, 1u, __ATOMIC_RELAXED, __HIP_MEMORY_SCOPE_AGENT); break; } } }
            __builtin_amdgcn_fence(__ATOMIC_ACQUIRE, "agent");
            asm volatile("s_waitcnt vmcnt(0)" ::: "memory");
        }
        asm volatile("" ::: "memory"); __builtin_amdgcn_s_barrier(); asm volatile("" ::: "memory");
    }
};
struct EpiGateUpWT {
    __amdgpu_buffer_rsrc_t rsrc; const float* slot_w; LAS int* mm;
    __device__ __forceinline__ void operator()(const f32x4 (&acc)[2][2][4][2], const MU& u, int wr, int wc, int fr, int fq) const {
        const int e = u.e, n_e = mm[e], r0 = u.rt * BM + wr * 64 + fr, col0 = u.pn * HALF + wc * 32 + 8 * fq;
        float wv[2][4];
#pragma unroll
        for (int ai = 0; ai < 2; ++ai)
#pragma unroll
            for (int m = 0; m < 4; ++m) wv[ai][m] = slot_w[e * CAP + r0 + ai * HALF + m * 16];
#pragma unroll
        for (int ai = 0; ai < 2; ++ai)
#pragma unroll
            for (int m = 0; m < 4; ++m) { const int r = r0 + ai * HALF + m * 16;
                if (r < n_e) { const float w = wv[ai][m]; f32x4 o[2];
#pragma unroll
                    for (int n = 0; n < 2; ++n) { const f32x4 g = acc[ai][0][m][n], up = acc[ai][1][m][n];
#pragma unroll
                        for (int j = 0; j < 4; ++j) o[n][j] = w * silu_f(g[j]) * up[j]; }
                    u32x4 q; q.x = cvt_pk_bf16(o[0][0], o[0][1]); q.y = cvt_pk_bf16(o[0][2], o[0][3]); q.z = cvt_pk_bf16(o[1][0], o[1][1]); q.w = cvt_pk_bf16(o[1][2], o[1][3]);
                    __builtin_amdgcn_raw_buffer_store_b128(q, rsrc, (unsigned)(((u.hb + r) * FF + col0) * 2), 0, 16); } }
    }
};
struct EpiDownM {
    bf16* Y; LAS int* mm;
    __device__ __forceinline__ void operator()(const f32x4 (&acc)[2][2][4][2], const MU& u, int wr, int wc, int fr, int fq) const {
        const int e = u.e, n_e = mm[e], r0 = u.rt * BM + wr * 64 + fr, col0 = u.pn * BM + wc * 32 + 8 * fq;
#pragma unroll
        for (int ai = 0; ai < 2; ++ai)
#pragma unroll
            for (int m = 0; m < 4; ++m) { const int r = r0 + ai * HALF + m * 16;
                if (r < n_e) {
#pragma unroll
                    for (int bj = 0; bj < 2; ++bj) { const f32x4 v0 = acc[ai][bj][m][0], v1 = acc[ai][bj][m][1];
                        u32x4 q; q.x = cvt_pk_bf16(v0[0], v0[1]); q.y = cvt_pk_bf16(v0[2], v0[3]); q.z = cvt_pk_bf16(v1[0], v1[1]); q.w = cvt_pk_bf16(v1[2], v1[3]);
                        *(u32x4*)(Y + (size_t)(u.hb + r) * D + col0 + bj * HALF) = q; } } }
    }
};
__device__ __forceinline__ void gemm_phase_moe(LAS unsigned char* lds, const MoeMergedSched& S, const EpiGateUpWT& EA, const EpiDownM& EB) {
    const int tid = threadIdx.x, wid = __builtin_amdgcn_readfirstlane(tid >> 6), lane = tid & 63, wr = wid >> 2, wc = wid & 3, fr = lane & 15, fq = lane >> 4;
    int sR[2], sC[2]; unsigned vbA[2], vbD[2];
#pragma unroll
    for (int i = 0; i < 2; ++i) { int R, C; stage_rc(tid * 16 + i * 8192, R, C); sR[i] = R; sC[i] = C; const int Rb = (R & ~31) + perm32(R & 31);
        vbA[i] = (unsigned)(Rb * D + C) * 2u; vbD[i] = (unsigned)(Rb * FF + C) * 2u; }
    const size_t kstep = (size_t)(BK * 2);
    const unsigned ldsw = (unsigned)wid * 1024u;
    const int aoff = lds_byte(wr * 64 + fr, fq * 8), boff = lds_byte(wc * 32 + fr, fq * 8);
#define PG_SA(b, h) (((b) * 2 + (h)) * HTB)
#define PG_SB(b, h) ((4 + (b) * 2 + (h)) * HTB)
#define PG_STAGE(bufoff, gbase, voff) do { _Pragma("unroll") for (int _i = 0; _i < 2; ++_i) \
        __builtin_amdgcn_global_load_lds((const unsigned*)((const char*)(gbase) + (voff)[_i]), (LAS unsigned*)(lds + (bufoff) + ldsw + _i * 8192), 16, 0, 0); } while (0)
#define PG_LDA(dst, b, h) do { _Pragma("unroll") for (int m = 0; m < 4; ++m) _Pragma("unroll") for (int k = 0; k < 2; ++k) dst[m][k] = *(const LAS bf16x8*)(lds + PG_SA(b, h) + aoff + m * 2048 + k * 1024); } while (0)
#define PG_LDB(dst, b, h) do { _Pragma("unroll") for (int n = 0; n < 2; ++n) _Pragma("unroll") for (int k = 0; k < 2; ++k) dst[n][k] = *(const LAS bf16x8*)(lds + PG_SB(b, h) + boff + n * 2048 + k * 1024); } while (0)
#define PG_MMA(ai, bj, At, Bt) do { __builtin_amdgcn_s_setprio(1); _Pragma("unroll") for (int m = 0; m < 4; ++m) _Pragma("unroll") for (int n = 0; n < 2; ++n) _Pragma("unroll") for (int k = 0; k < 2; ++k) \
        acc[ai][bj][m][n] = __builtin_amdgcn_mfma_f32_16x16x32_bf16(Bt[n][k], At[m][k], acc[ai][bj][m][n], 0, 0, 0); __builtin_amdgcn_s_setprio(0); } while (0)
#define PG_WAIT_V(n) asm volatile("s_waitcnt vmcnt(" #n ")" ::: "memory")
#define PG_WAIT_L(n) asm volatile("s_waitcnt lgkmcnt(" #n ")" ::: "memory")
#define PG_BAR __builtin_amdgcn_s_barrier()
#define PG_SCHED __builtin_amdgcn_sched_barrier(0)
    MU cur, nxt; int ui = 0;
    if (!S.next(0, cur)) return;
    f32x4 acc[2][2][4][2];
#pragma unroll
    for (int a = 0; a < 2; ++a)
#pragma unroll
        for (int b = 0; b < 2; ++b)
#pragma unroll
            for (int m = 0; m < 4; ++m)
#pragma unroll
                for (int n = 0; n < 2; ++n) acc[a][b][m][n] = (f32x4){0.f, 0.f, 0.f, 0.f};
    bf16x8 At[4][2], B0[2][2], B1[2][2];
    if (cur.type == 0) { S.stage_table(cur, 0, lds, wid, lane); PG_WAIT_V(0); PG_BAR; } else S.wait_ready(cur, wid);
    unsigned voC[2][2], voN[2][2];
#pragma unroll
    for (int h = 0; h < 2; ++h)
#pragma unroll
        for (int i = 0; i < 2; ++i) { voC[h][i] = S.voff(cur, 0, lds, h * HALF + sR[i], sC[i]); voN[h][i] = voC[h][i]; }
    const char* cB = cur.B; const char* cA = cur.A; size_t hsC = (size_t)HALF * cur.K * 2; int nt = cur.K / BK;
    if (cur.type == 0) { PG_STAGE(PG_SB(0, 0), cB, vbA); PG_STAGE(PG_SB(0, 1), cB + hsC, vbA); } else { PG_STAGE(PG_SB(0, 0), cB, vbD); PG_STAGE(PG_SB(0, 1), cB + hsC, vbD); }
    PG_STAGE(PG_SA(0, 0), cA, voC[0]); PG_STAGE(PG_SA(0, 1), cA, voC[1]);
    if (wr == 1) PG_BAR;
    PG_WAIT_V(2); PG_BAR;
    if (cur.type == 0) { PG_STAGE(PG_SB(1, 0), cB + kstep, vbA); } else { PG_STAGE(PG_SB(1, 0), cB + kstep, vbD); }
    PG_STAGE(PG_SA(1, 0), cA + kstep, voC[0]);
    if (cur.type == 0) { PG_STAGE(PG_SB(1, 1), cB + hsC + kstep, vbA); } else { PG_STAGE(PG_SB(1, 1), cB + hsC + kstep, vbD); }
    PG_WAIT_V(6); PG_BAR;
    for (;;) {
        const bool has_next = S.next(ui + 1, nxt);
        if (has_next && nxt.type == 0) S.stage_table(nxt, (ui + 1) & 1, lds, wid, lane);
        const char* nB = has_next ? nxt.B : cB; const char* nA = has_next ? nxt.A : cA; const size_t hsN = has_next ? (size_t)HALF * nxt.K * 2 : hsC;
        for (int t = 0; t < nt; t += 2) {
            const bool last = (t == nt - 2);
            if (last && has_next) {
                if (nxt.type == 1) S.wait_ready(nxt, wid);
#pragma unroll
                for (int h = 0; h < 2; ++h)
#pragma unroll
                    for (int i = 0; i < 2; ++i) voN[h][i] = S.voff(nxt, (ui + 1) & 1, lds, h * HALF + sR[i], sC[i]);
            }
            unsigned vo2[2][2], vb2[2]; const bool b2gu = last ? (has_next ? nxt.type == 0 : cur.type == 0) : (cur.type == 0);
#pragma unroll
            for (int h = 0; h < 2; ++h)
#pragma unroll
                for (int i = 0; i < 2; ++i) vo2[h][i] = last ? voN[h][i] : voC[h][i];
#pragma unroll
            for (int i = 0; i < 2; ++i) vb2[i] = b2gu ? vbA[i] : vbD[i];
            const size_t hs2 = last ? hsN : hsC;
            const char* a1 = cA + (size_t)(t + 1) * kstep;
            const char* a2 = last ? nA : cA + (size_t)(t + 2) * kstep; const char* b2 = last ? nB : cB + (size_t)(t + 2) * kstep;
            const char* a3 = a2 + kstep; const char* b3 = b2 + kstep;
            PG_LDB(B0, 0, 0); PG_LDB(B1, 0, 1); PG_SCHED; PG_LDA(At, 0, 0); PG_STAGE(PG_SA(1, 1), a1, voC[1]);
            PG_WAIT_V(8); PG_WAIT_L(0); PG_BAR; PG_MMA(0, 0, At, B0); PG_MMA(0, 1, At, B1); PG_BAR; PG_SCHED;
            PG_LDA(At, 0, 1); PG_STAGE(PG_SB(0, 0), b2, vb2); PG_STAGE(PG_SB(0, 1), b2 + hs2, vb2); PG_STAGE(PG_SA(0, 0), a2, vo2[0]);
            PG_WAIT_V(8); PG_WAIT_L(0); PG_BAR; PG_MMA(1, 0, At, B0); PG_MMA(1, 1, At, B1); PG_BAR; PG_SCHED;
            PG_LDB(B0, 1, 0); PG_LDB(B1, 1, 1); PG_SCHED; PG_LDA(At, 1, 0); PG_STAGE(PG_SA(0, 1), a2, vo2[1]);
            PG_WAIT_V(8); PG_WAIT_L(0); PG_BAR; PG_MMA(0, 0, At, B0); PG_MMA(0, 1, At, B1); PG_BAR; PG_SCHED;
            PG_LDA(At, 1, 1); PG_STAGE(PG_SB(1, 0), b3, vb2); PG_STAGE(PG_SB(1, 1), b3 + hs2, vb2); PG_STAGE(PG_SA(1, 0), a3, vo2[0]);
            PG_WAIT_V(8); PG_WAIT_L(0); PG_BAR; PG_MMA(1, 0, At, B0); PG_MMA(1, 1, At, B1); PG_BAR; PG_SCHED;
        }
        if (wr == 0) PG_BAR;
        if (cur.type == 0) { EA(acc, cur, wr, wc, fr, fq);
            PG_WAIT_V(0);
            if (lane == 0) __hip_atomic_fetch_add(S.tile_word(cur), 1u, __ATOMIC_RELAXED, __HIP_MEMORY_SCOPE_AGENT); }
        else EB(acc, cur, wr, wc, fr, fq);
        if (!has_next) break;
#pragma unroll
        for (int a = 0; a < 2; ++a)
#pragma unroll
            for (int b = 0; b < 2; ++b)
#pragma unroll
                for (int m = 0; m < 4; ++m)
#pragma unroll
                    for (int n = 0; n < 2; ++n) acc[a][b][m][n] = (f32x4){0.f, 0.f, 0.f, 0.f};
        cur = nxt; cB = nB; cA = nA; hsC = hsN; nt = cur.K / BK; ++ui;
#pragma unroll
        for (int h = 0; h < 2; ++h)
#pragma unroll
            for (int i = 0; i < 2; ++i) voC[h][i] = voN[h][i];
        if (wr == 1) PG_BAR;
    }
    PG_WAIT_V(0);
    PG_BAR;
#undef PG_SA
#undef PG_SB
#undef PG_STAGE
#undef PG_LDA
#undef PG_LDB
#undef PG_MMA
#undef PG_WAIT_V
#undef PG_WAIT_L
#undef PG_BAR
#undef PG_SCHED
}
}
__device__ __forceinline__ void fast_moe_merged(Frame& F, int layer) {
    LAS int* mm = moe_map(F, layer);
    int U = 0;
    for (int e = 0; e < 16; ++e) U += ((mm[e] + 255) >> 8) * 4;
    pg::MoeMergedSched S{(const char*)(F.ws + WS_WGU) + (size_t)layer * 16 * 1024 * 1024 * 2, (const char*)(F.ws + WS_WDN) + (size_t)layer * 16 * 1024 * 512 * 2,
                         (const char*)(F.ws + WS_HB), (const char*)(F.ws + WS_HID), (const int*)(F.ws + WS_SLOTT) + layer * 16 * CAP, mm,
                         F.ctl + CW_TILE + layer * 288 * 64, F.ctl + CW_TMO2, F.G, F.wg, U};
    pg::EpiGateUpWT EA{__builtin_amdgcn_make_buffer_rsrc((void*)(F.ws + WS_HID), 0, HROWS * FF * 2, 0x00020000), (const float*)(F.ws + WS_SLOTW) + layer * 16 * CAP, mm};
    pg::EpiDownM EB{(bf16*)(F.ws + WS_Y), mm};
    pg::gemm_phase_moe(F.lds, S, EA, EB);
}

constexpr int NPH = 18;
__global__ void __launch_bounds__(NTHR, 2) mega(Args args) {
    extern __shared__ __attribute__((aligned(16))) unsigned char lds[];
    Frame F;
    F.lds = (LAS unsigned char*)lds;
    F.tid = threadIdx.x; F.lane = F.tid & 63; F.wave = __builtin_amdgcn_readfirstlane(F.tid >> 6);
    F.G = gridDim.x; F.wg = blockIdx.x;
    F.in = args.in; F.out = args.out; F.ws = args.ws; F.ctl = (unsigned*)(args.ws + WS_CTL);
    volatile LAS unsigned* bst = (volatile LAS unsigned*)(F.lds + LDS_BYTES - 16);
    if (F.tid < 4) bst[F.tid] = 0u;
    __syncthreads();
    const int lo = args.ph_lo, hi = args.ph_hi;
    XcdBarrier bar; bar.bar = F.ctl + CW_BAR; bar.x = 0; bar.st = bst;
    if (hi - lo > 1) bar = xcd_barrier_post(F.ctl + CW_BAR, bst);
#define IN(k) (lo <= (k) && (k) < hi)
#define SEAM(k) do { if (IN(k) && IN((k) + 1)) xcd_barrier(bar); } while (0)
    const float* mod = (const float*)(F.ws + WS_MOD);

#ifndef DBL_MASK
#define DBL_MASK 0x0u
#endif
#define RUN(k, body) do { if (IN(k)) { _Pragma("unroll 1") for (int _r = 0; _r < ((((DBL_MASK) >> (k)) & 1u) ? 2 : 1); ++_r) { if (_r) xcd_barrier(bar); F.lane = fresh_lane(); body; } } } while (0)
    RUN(0, phase_prep(F)); SEAM(0);
    RUN(1, phase_norm1_l0(F)); SEAM(1);
    RUN(2, if (FAST_GEMM) fast_inproj(F); else phase_inproj(F)); SEAM(2);
    if (IN(3)) { F.lane = fresh_lane();
#pragma unroll 1
        for (int _r = 0; _r < ((DBL_MASK & 0x100000u) ? 2 : 1); ++_r) { if (FAST_ATTN && FAST_GEMM) phase_attn_mfma(F); else phase_attn_simple(F); }
#pragma unroll 1
        for (int _r = 0; _r < ((DBL_MASK & 0x200000u) ? 2 : 1); ++_r) { if (FAST_FFT) phase_fft1_mfma(F); else phase_fft1_simple(F); }
    } SEAM(3);
    RUN(4, if (FAST_FFT) phase_fft2_mfma(F); else phase_fft2_simple(F)); SEAM(4);
    if (IN(5)) { if (!FAST_FFT) phase_fft3_simple(F); } if (!FAST_FFT) SEAM(5);
    RUN(6, if (FAST_GEMM) fast_outproj(F, WS_MIX, WS_WOUT, F.in[I_X], F.out, mod + 2048, nullptr); else phase_outproj(F, (const bf16*)(F.ws + WS_MIX), (const bf16*)(F.ws + WS_WOUT), F.in[I_X], F.out, mod + 2048, nullptr)); SEAM(6);
    if (IN(7)) { F.lane = fresh_lane(); phase_norm2_route(F, 0); } SEAM(7);
    if (MOE_MERGED && FAST_GEMM) { if (IN(8)) { F.lane = fresh_lane(); fast_moe_merged(F, 0); } if (IN(8) && IN(10)) xcd_barrier(bar); }
    else { RUN(8, if (FAST_GEMM) fast_moe_gateup(F, 0); else phase_moe_gateup(F, 0)); SEAM(8);
    RUN(9, if (FAST_GEMM) fast_moe_down(F, 0); else phase_moe_down(F, 0)); SEAM(9); }
    if (IN(10)) { F.lane = fresh_lane(); phase_combine<false>(F, 0); } SEAM(10);
    RUN(11, if (FAST_GEMM) fast_pw1(F); else phase_pw1(F)); SEAM(11);
    RUN(12, phase_dwconv_fast(F)); SEAM(12);
    if (IN(13)) { F.lane = fresh_lane(); if (FAST_GEMM) fast_outproj(F, WS_V1, WS_WPW2, F.out, F.out, mod + 5 * 6144 + 2048, F.in[I_PW2B]); else phase_outproj(F, (const bf16*)(F.ws + WS_V1), (const bf16*)(F.ws + WS_WPW2), F.out, F.out, mod + 5 * 6144 + 2048, F.in[I_PW2B]); } SEAM(13);
    if (IN(14)) { F.lane = fresh_lane(); phase_norm2_route(F, 1); } SEAM(14);
    if (MOE_MERGED && FAST_GEMM) { if (IN(15)) { F.lane = fresh_lane(); fast_moe_merged(F, 1); } if (IN(15) && IN(17)) xcd_barrier(bar); }
    else { RUN(15, if (FAST_GEMM) fast_moe_gateup(F, 1); else phase_moe_gateup(F, 1)); SEAM(15);
    RUN(16, if (FAST_GEMM) fast_moe_down(F, 1); else phase_moe_down(F, 1)); SEAM(16); }
    if (IN(17)) { F.lane = fresh_lane(); phase_combine<true>(F, 1); }
#undef RUN
#undef IN
#undef SEAM
}

extern "C" void kernel_launch(void* const* d_in, const int* in_sizes, int n_in, void* d_out, int out_size, void* d_ws, size_t ws_size, hipStream_t stream) {
    static int grid = 0;
    if (grid == 0) {
        if (n_in != 25 || out_size != T * D || ws_size < WS_END) { fprintf(stderr, "kernel_launch: unexpected shapes (n_in %d out %d ws %zu)\n", n_in, out_size, ws_size); grid = -1; return; }
        int dev = 0, cus = 0, per_cu = 0;
        if (hipGetDevice(&dev) != hipSuccess || hipDeviceGetAttribute(&cus, hipDeviceAttributeMultiprocessorCount, dev) != hipSuccess) { grid = -1; return; }
        if (hipFuncSetAttribute((const void*)mega, hipFuncAttributeMaxDynamicSharedMemorySize, LDS_BYTES) != hipSuccess) { fprintf(stderr, "kernel_launch: hipFuncSetAttribute failed\n"); grid = -1; return; }
        if (hipOccupancyMaxActiveBlocksPerMultiprocessor(&per_cu, (const void*)mega, NTHR, LDS_BYTES) != hipSuccess || per_cu < 1) { fprintf(stderr, "kernel_launch: occupancy query says %d\n", per_cu); }
        (void)hipGetLastError();
        grid = cus;
    }
    if (grid < 0) return;
    (void)hipMemsetAsync((char*)d_ws + WS_CTL, 0, CTL_BYTES, stream);
    Args a{};
    for (int i = 0; i < 25; ++i) a.in[i] = (const float*)d_in[i];
    a.out = (float*)d_out; a.ws = (unsigned char*)d_ws;
#if MK_ONE_LAUNCH
    a.ph_lo = 0; a.ph_hi = NPH;
    hipLaunchKernelGGL(mega, dim3(grid), dim3(NTHR), LDS_BYTES, stream, a);
#else
#ifndef PROBE_PHASE
#define PROBE_PHASE -1
#endif
    for (int p = 0; p < NPH; ++p) { a.ph_lo = p; a.ph_hi = p + 1; hipLaunchKernelGGL(mega, dim3(grid), dim3(NTHR), LDS_BYTES, stream, a);
        if (p == PROBE_PHASE) { if (p == 7 || p == 14) (void)hipMemsetAsync((char*)d_ws + WS_CTL, 0, CTL_BYTES, stream);
            hipLaunchKernelGGL(mega, dim3(grid), dim3(NTHR), LDS_BYTES, stream, a); } }
#endif
}
```

```cpp
#include <hip/hip_runtime.h>
#include <cstdio>

#ifndef MK_ONE_LAUNCH
#define MK_ONE_LAUNCH 1
#endif

#define GAS __attribute__((address_space(1)))
#define LAS __attribute__((address_space(3)))
typedef unsigned short bf16;
typedef short bf16x8 __attribute__((ext_vector_type(8)));
typedef float f32x4 __attribute__((ext_vector_type(4)));
typedef float f32x16 __attribute__((ext_vector_type(16)));
typedef unsigned u32x4 __attribute__((ext_vector_type(4)));
typedef unsigned u32x2 __attribute__((ext_vector_type(2)));

constexpr int D = 1024, NB = 4, L = 8192, T = NB * L, CL = 256, TC = NB * CL;
constexpr int NE = 16, FF = 512, CONVW = 31;
constexpr int N_IN = 1280;
constexpr int FN1 = 64, FN2 = 128;
#ifndef FAST_GEMM
#define FAST_GEMM 1
#endif
#ifndef MOE_MERGED
#define MOE_MERGED 1
#endif
#ifndef XBF16
#define XBF16 FAST_GEMM
#endif
#ifndef FAST_ATTN
#define FAST_ATTN 2
#endif
#ifndef FAST_FFT
#define FAST_FFT 1
#endif
constexpr int IL = FAST_GEMM ? 128 : 32;
constexpr float EPS = 1e-6f;
constexpr int NWAVES = 8, NTHR = 512;
constexpr int CAP = 32768;
constexpr int HROWS = 65536 + 4096;

constexpr size_t MiB = 1u << 20;
constexpr size_t WS_CTL = 0, CTL_BYTES = 1 * MiB;
constexpr size_t WS_MOD = 1 * MiB;
constexpr size_t WS_TW = 1 * MiB + 512 * 1024;
constexpr size_t WS_WIN = 2 * MiB, WS_WOUT = 6 * MiB, WS_WPW1 = 10 * MiB, WS_WPW2 = 14 * MiB;
constexpr size_t WS_WGU = 16 * MiB, WS_WDN = 80 * MiB;
constexpr size_t WS_TOKE = 112 * MiB, WS_TOKP = 113 * MiB, WS_TOKW = 114 * MiB;
constexpr size_t WS_SLOTT = 116 * MiB, WS_SLOTW = 120 * MiB;
constexpr size_t WS_HB = 128 * MiB;
constexpr size_t WS_UF = 196 * MiB, WS_Q = 228 * MiB, WS_K = 260 * MiB, WS_V = 268 * MiB, WS_CK = 276 * MiB, WS_CV = 277 * MiB;
constexpr size_t WS_G = 280 * MiB, WS_MIX = 344 * MiB, WS_AB = 408 * MiB;
constexpr size_t WS_XB = 408 * MiB;
constexpr size_t WS_HID = 196 * MiB, WS_Y = 264 * MiB;
constexpr size_t WS_U = 196 * MiB, WS_V1 = 260 * MiB;
constexpr size_t WS_END = 472 * MiB;
constexpr int CW_BAR = 4096;
constexpr int CW_CNT = 8192;
constexpr int CW_TILE = 16384;
constexpr int CW_TMO2 = 2048;

constexpr int LDS_BYTES = 147456;

__device__ __forceinline__ unsigned f2bf(float f) { unsigned u = __float_as_uint(f); return (u + 0x7fffu + ((u >> 16) & 1u)) >> 16; }
__device__ __forceinline__ float bf2f(unsigned b) { return __uint_as_float(b << 16); }
typedef __bf16 b16x2_t __attribute__((ext_vector_type(2)));
__device__ __forceinline__ unsigned pkbf(float a, float b) { typedef float f2 __attribute__((ext_vector_type(2))); f2 v = {a, b}; return __builtin_bit_cast(unsigned, __builtin_convertvector(v, b16x2_t)); }
__device__ __forceinline__ unsigned pk2(float lo, float hi) { return pkbf(lo, hi); }
__device__ __forceinline__ float bflo(unsigned w) { return __uint_as_float(w << 16); }
__device__ __forceinline__ float bfhi(unsigned w) { return __uint_as_float(w & 0xffff0000u); }
__device__ __forceinline__ float wave_sum(float v) {
    v += __builtin_bit_cast(float, __builtin_amdgcn_mov_dpp(__builtin_bit_cast(int, v), 0xB1, 0xf, 0xf, true));
    v += __builtin_bit_cast(float, __builtin_amdgcn_mov_dpp(__builtin_bit_cast(int, v), 0x4E, 0xf, 0xf, true));
    v += __builtin_bit_cast(float, __builtin_amdgcn_mov_dpp(__builtin_bit_cast(int, v), 0x141, 0xf, 0xf, true));
    v += __builtin_bit_cast(float, __builtin_amdgcn_mov_dpp(__builtin_bit_cast(int, v), 0x140, 0xf, 0xf, true));
    const int iv = __builtin_bit_cast(int, v);
    const float a = __builtin_bit_cast(float, __builtin_amdgcn_readlane(iv, 15)), b = __builtin_bit_cast(float, __builtin_amdgcn_readlane(iv, 31));
    const float c = __builtin_bit_cast(float, __builtin_amdgcn_readlane(iv, 47)), d = __builtin_bit_cast(float, __builtin_amdgcn_readlane(iv, 63));
    return (a + b) + (c + d);
}
__device__ __forceinline__ float silu_f(float x) { return x * __builtin_amdgcn_rcpf(1.f + __expf(-x)); }
__device__ __forceinline__ float sigmoid_f(float x) { return __builtin_amdgcn_rcpf(1.f + __expf(-x)); }
#define LDS_WAIT() asm volatile("s_waitcnt lgkmcnt(0)" ::: "memory")
__device__ __forceinline__ int fresh_lane() { int l; asm volatile("v_mbcnt_lo_u32_b32 %0, -1, 0\n\tv_mbcnt_hi_u32_b32 %0, -1, %0" : "=v"(l)); return l; }

#define XB_TMO      128
#define XB_XCNT(j)  (256  + 64 * (j))
#define XB_XSUB(j)  (1280 + 64 * (j))
#define XB_XGEN(j)  (2304 + 64 * (j))
#define XB_TOP      3328
#define XB_TOPGEN   3392
#define XCD_BAR_WORDS 3456
#define XB_SPIN_CAP (1u << 20)
__device__ __forceinline__ unsigned xb_ld(unsigned* p)              { return __hip_atomic_load(p, __ATOMIC_RELAXED, __HIP_MEMORY_SCOPE_AGENT); }
__device__ __forceinline__ unsigned xb_add(unsigned* p, unsigned v) { return __hip_atomic_fetch_add(p, v, __ATOMIC_RELAXED, __HIP_MEMORY_SCOPE_AGENT); }
__device__ __forceinline__ unsigned xb_xcc_id() { return (unsigned)__builtin_amdgcn_s_getreg((3 << 11) | 20) & 0xFu; }
#define XB_SPIN(cond, bar) do { unsigned _sp = 0; while (cond) { __builtin_amdgcn_s_sleep(1); \
    if ((++_sp & 255u) == 0u) { if (xb_ld(&(bar)[XB_TMO])) break; if (_sp > XB_SPIN_CAP) { atomicAdd(&(bar)[XB_TMO], 1u); break; } } } } while (0)
struct XcdBarrier { unsigned* bar; unsigned x; volatile LAS unsigned* st; };
__device__ __forceinline__ XcdBarrier xcd_barrier_post(unsigned* bar, volatile LAS unsigned* st) {
    XcdBarrier b; b.bar = bar; b.x = xb_xcc_id(); b.st = st;
    if (threadIdx.x == 0) (void)xb_add(&bar[XB_XCNT(b.x)], 1u);
    return b;
}
__device__ __forceinline__ void xcd_barrier_complete(unsigned* bar, unsigned x, unsigned& nloc, unsigned& nx) {
    const unsigned G = gridDim.x * gridDim.y * gridDim.z;
    unsigned sum, cnt, mine, sp = 0u;
    for (;;) {
        sum = 0u; cnt = 0u; mine = 0u;
#pragma unroll
        for (unsigned j = 0; j < 16; ++j) { const unsigned c = xb_ld(&bar[XB_XCNT(j)]); sum += c; cnt += (c > 0u) ? 1u : 0u; mine = (j == x) ? c : mine; }
        if (sum == G) break;
        __builtin_amdgcn_s_sleep(1);
        if ((++sp & 255u) == 0u) { if (xb_ld(&bar[XB_TMO])) break; if (sp > XB_SPIN_CAP) { atomicAdd(&bar[XB_TMO], 1u); break; } }
    }
    nloc = mine > 0u ? mine : 1u; nx = cnt > 0u ? cnt : 1u;
}
__device__ __forceinline__ void xcd_barrier(const XcdBarrier& b) {
    asm volatile("s_waitcnt vmcnt(0)" ::: "memory");
    __syncthreads();
    if (threadIdx.x == 0) {
        unsigned* bar = b.bar;
        __builtin_amdgcn_s_waitcnt(0);
        unsigned nloc = b.st[0], nx = b.st[1];
        if (nloc == 0u) { xcd_barrier_complete(bar, b.x, nloc, nx); b.st[0] = nloc; b.st[1] = nx; }
        const unsigned old = xb_add(&bar[XB_XSUB(b.x)], 1u);
        const unsigned gen = old / nloc;
        if (old + 1u == (gen + 1u) * nloc) {
            __builtin_amdgcn_fence(__ATOMIC_RELEASE, "agent");
            asm volatile("s_waitcnt vmcnt(0)" ::: "memory");
            const unsigned og = xb_add(&bar[XB_TOP], 1u);
            const unsigned tg = og / nx;
            if (og + 1u == (tg + 1u) * nx) xb_add(&bar[XB_TOPGEN], 1u);
            else XB_SPIN(xb_ld(&bar[XB_TOPGEN]) == tg, bar);
            __builtin_amdgcn_fence(__ATOMIC_ACQUIRE, "agent");
            xb_add(&bar[XB_XGEN(b.x)], 1u);
            asm volatile("s_waitcnt vmcnt(0)" ::: "memory");
        } else {
            XB_SPIN(xb_ld(&bar[XB_XGEN(b.x)]) == gen, bar);
            __builtin_amdgcn_fence(__ATOMIC_ACQUIRE, "agent");
            asm volatile("s_waitcnt vmcnt(0)" ::: "memory");
        }
    }
    __syncthreads();
}

struct Args { const float* in[25]; float* out; unsigned char* ws; int ph_lo, ph_hi; };
enum { I_X = 0, I_C, I_CTX, I_CCTX, I_ADAW, I_ADAB, I_NMG, I_NFG, I_WIN, I_WOUT, I_SINK, I_PW1W, I_PW1B, I_DWW, I_DWB, I_LNG, I_LNB,
       I_PW2W, I_PW2B, I_RW, I_RB, I_WG, I_WU, I_WD, I_FNG };

struct Frame {
    LAS unsigned char* lds;
    int tid, lane, wave, G, wg;
    const float* const* in;
    float* out;
    unsigned char* ws;
    unsigned* ctl;
};

__device__ __forceinline__ int crow(int i, int h) { return (i & 3) + 8 * (i >> 2) + 4 * h; }
template <class RowPtr, class Epi>
__device__ __forceinline__ void sgemm_tile(const RowPtr& rowptr, const bf16* Bt, int K, int m0, int n0, const Epi& epi, int wave, int lane) {
    const int wm = wave & 3, wn = wave >> 2, r = lane & 31, h = lane >> 5;
    const bf16* ap = rowptr(m0 + wm * 32 + r) + 8 * h;
    const bf16* bp0 = Bt + (size_t)(n0 + wn * 64 + r) * K + 8 * h;
    const bf16* bp1 = bp0 + (size_t)32 * K;
    f32x16 c0, c1;
#pragma unroll
    for (int i = 0; i < 16; ++i) { c0[i] = 0.f; c1[i] = 0.f; }
#pragma unroll 2
    for (int k = 0; k < K; k += 32) {
        const bf16x8 a0 = *(const bf16x8*)(ap + k), a1 = *(const bf16x8*)(ap + k + 16);
        const bf16x8 b00 = *(const bf16x8*)(bp0 + k), b01 = *(const bf16x8*)(bp0 + k + 16);
        const bf16x8 b10 = *(const bf16x8*)(bp1 + k), b11 = *(const bf16x8*)(bp1 + k + 16);
        c0 = __builtin_amdgcn_mfma_f32_32x32x16_bf16(a0, b00, c0, 0, 0, 0);
        c1 = __builtin_amdgcn_mfma_f32_32x32x16_bf16(a0, b10, c1, 0, 0, 0);
        c0 = __builtin_amdgcn_mfma_f32_32x32x16_bf16(a1, b01, c0, 0, 0, 0);
        c1 = __builtin_amdgcn_mfma_f32_32x32x16_bf16(a1, b11, c1, 0, 0, 0);
    }
    epi(m0 + wm * 32, n0 + wn * 64, c0, c1, lane);
}

__device__ __forceinline__ void p0_transpose_item(const float* W, int K, int N, bf16* WT, int k0, int n0, int drow0, LAS float* scr, int lane) {
#pragma unroll 8
    for (int i = 0; i < 32; ++i) { const int kk = 2 * i + (lane >> 5); scr[kk * 33 + (lane & 31)] = W[(size_t)(k0 + kk) * N + n0 + (lane & 31)]; }
    LDS_WAIT(); asm volatile("" ::: "memory");
    const int c = lane & 7;
#pragma unroll
    for (int j = 0; j < 4; ++j) { const int n = (lane >> 3) + 8 * j; const LAS float* s = scr + (8 * c) * 33 + n;
        u32x4 o; o.x = pk2(s[0 * 33], s[1 * 33]); o.y = pk2(s[2 * 33], s[3 * 33]); o.z = pk2(s[4 * 33], s[5 * 33]); o.w = pk2(s[6 * 33], s[7 * 33]);
        *(u32x4*)(WT + (size_t)(drow0 + n) * K + k0 + 8 * c) = o; }
    LDS_WAIT(); asm volatile("" ::: "memory");
}
__device__ __forceinline__ int il_row(int j, int half) { return (j / IL) * (2 * IL) + half * IL + (j % IL); }

__device__ __forceinline__ void phase_prep(Frame& F) {
    {
        LAS float* sc = (LAS float*)F.lds;
        LAS float* red = sc + 5 * 1024;
        bool loaded = false;
        for (int it = F.wg; it < 192; it += F.G) {
            if (!loaded) {
                for (int i = F.tid; i < 5 * 1024; i += NTHR) { const int b = i >> 10, k = i & 1023; const float v = b < 4 ? F.in[I_C][b * 1024 + k] : F.in[I_CCTX][k]; sc[i] = silu_f(v); }
                __syncthreads(); loaded = true;
            }
            const int l = it / 96, n0 = (it % 96) * 64, col = F.tid & 63, kg = F.tid >> 6;
            const float* w = F.in[I_ADAW] + (size_t)l * 1024 * 6144 + n0 + col;
            float a0 = 0.f, a1 = 0.f, a2 = 0.f, a3 = 0.f, a4 = 0.f;
#pragma unroll 8
            for (int k = kg * 128; k < kg * 128 + 128; ++k) { const float wv = w[(size_t)k * 6144];
                a0 += sc[k] * wv; a1 += sc[1024 + k] * wv; a2 += sc[2048 + k] * wv; a3 += sc[3072 + k] * wv; a4 += sc[4096 + k] * wv; }
            red[(kg * 5 + 0) * 64 + col] = a0; red[(kg * 5 + 1) * 64 + col] = a1; red[(kg * 5 + 2) * 64 + col] = a2; red[(kg * 5 + 3) * 64 + col] = a3; red[(kg * 5 + 4) * 64 + col] = a4;
            __syncthreads();
            if (F.tid < 320) { const int b = F.tid >> 6, c2 = F.tid & 63; float s = 0.f;
#pragma unroll
                for (int g = 0; g < 8; ++g) s += red[(g * 5 + b) * 64 + c2];
                ((float*)(F.ws + WS_MOD))[((size_t)l * 5 + b) * 6144 + n0 + c2] = s + F.in[I_ADAB][l * 6144 + n0 + c2]; }
            __syncthreads();
        }
        __syncthreads();
    }
    { u32x4* z = (u32x4*)(F.ws + WS_SLOTT); const u32x4 zero = {0u, 0u, 0u, 0u};
      for (int i = F.wg * NTHR + F.tid; i < 2 * 16 * CAP / 4; i += F.G * NTHR) z[i] = zero; }
    { float* tw = (float*)(F.ws + WS_TW);
      for (int k = F.wg * NTHR + F.tid; k < 8192; k += F.G * NTHR) { const float a = (float)k * (6.283185307179586f / 8192.f); tw[2 * k] = __cosf(a); tw[2 * k + 1] = __sinf(a); } }
    {
        LAS float* scr = (LAS float*)(F.lds + F.wave * 8704);
        const int gw = F.wg * NWAVES + F.wave, NGW = F.G * NWAVES;
        constexpr int S0 = 640, S1 = 512, S2 = 1024, S3 = 512, SM = 32 * 256;
        constexpr int NIT = S0 + S1 + S2 + S3 + 3 * SM;
        for (int it = gw; it < NIT; it += NGW) {
            int r = it;
            if (r < S0) { const int kb = r / 40, nb = r % 40; p0_transpose_item(F.in[I_WIN], 1024, 1280, (bf16*)(F.ws + WS_WIN), kb * 64, nb * 32, nb * 32, scr, F.lane); continue; } r -= S0;
            if (r < S1) { const int kb = r / 32, nb = r % 32; p0_transpose_item(F.in[I_WOUT], 1024, 1024, (bf16*)(F.ws + WS_WOUT), kb * 64, nb * 32, nb * 32, scr, F.lane); continue; } r -= S1;
            if (r < S2) { const int kb = r / 64, nb = r % 64, n0 = nb * 32; p0_transpose_item(F.in[I_PW1W], 1024, 2048, (bf16*)(F.ws + WS_WPW1), kb * 64, n0, il_row(n0 & 1023, n0 >> 10), scr, F.lane); continue; } r -= S2;
            if (r < S3) { const int kb = r / 32, nb = r % 32; p0_transpose_item(F.in[I_PW2W], 1024, 1024, (bf16*)(F.ws + WS_WPW2), kb * 64, nb * 32, nb * 32, scr, F.lane); continue; } r -= S3;
            if (r < SM) { const int le = r >> 8, q = r & 255, kb = q / 16, nb = q % 16;
                p0_transpose_item(F.in[I_WG] + (size_t)le * 1024 * 512, 1024, 512, (bf16*)(F.ws + WS_WGU) + (size_t)le * 1024 * 1024, kb * 64, nb * 32, il_row(nb * 32, 0), scr, F.lane); continue; } r -= SM;
            if (r < SM) { const int le = r >> 8, q = r & 255, kb = q / 16, nb = q % 16;
                p0_transpose_item(F.in[I_WU] + (size_t)le * 1024 * 512, 1024, 512, (bf16*)(F.ws + WS_WGU) + (size_t)le * 1024 * 1024, kb * 64, nb * 32, il_row(nb * 32, 1), scr, F.lane); continue; } r -= SM;
            { const int le = r >> 8, q = r & 255, kb = q / 32, nb = q % 32;
                p0_transpose_item(F.in[I_WD] + (size_t)le * 512 * 1024, 512, 1024, (bf16*)(F.ws + WS_WDN) + (size_t)le * 1024 * 512, kb * 64, nb * 32, nb * 32, scr, F.lane); }
        }
    }
}

__device__ __forceinline__ void row_load(const float* p, int lane, f32x4 (&v)[4]) {
#pragma unroll
    for (int j = 0; j < 4; ++j) v[j] = *(const f32x4*)(p + 4 * lane + 256 * j);
}
__device__ __forceinline__ void row_load_bf(const bf16* p, int lane, f32x4 (&v)[4]) {
#pragma unroll
    for (int j = 0; j < 4; ++j) { const u32x2 w = *(const u32x2*)(p + 4 * lane + 256 * j); v[j] = (f32x4){bflo(w.x), bfhi(w.x), bflo(w.y), bfhi(w.y)}; }
}
__device__ __forceinline__ void xrow_load(const float* xf, const bf16* xb, size_t row, int lane, f32x4 (&v)[4]) { if (XBF16) row_load_bf(xb + row * D, lane, v); else row_load(xf + row * D, lane, v); }
__device__ __forceinline__ float row_sumsq(const f32x4 (&v)[4]) {
    float s = 0.f;
#pragma unroll
    for (int j = 0; j < 4; ++j) s += (v[j].x * v[j].x + v[j].y * v[j].y) + (v[j].z * v[j].z + v[j].w * v[j].w);
    return wave_sum(s);
}
__device__ __forceinline__ void row_modulate(f32x4 (&v)[4], float rstd, const float* g, const float* sh, const float* sc, int lane) {
#pragma unroll
    for (int j = 0; j < 4; ++j) { const int o = 4 * lane + 256 * j; const f32x4 gg = *(const f32x4*)(g + o), s1 = *(const f32x4*)(sc + o), s0 = *(const f32x4*)(sh + o);
        v[j] = v[j] * rstd * gg * (1.f + s1) + s0; }
}
__device__ __forceinline__ void row_store_bf16(bf16* dst, const f32x4 (&v)[4], int lane) {
#pragma unroll
    for (int j = 0; j < 4; ++j) { u32x2 w; w.x = pk2(v[j].x, v[j].y); w.y = pk2(v[j].z, v[j].w); *(u32x2*)(dst + 4 * lane + 256 * j) = w; }
}

__device__ __forceinline__ void phase_norm1_l0(Frame& F) {
    const int gw = F.wg * NWAVES + F.wave, NGW = F.G * NWAVES;
    const float* mod = (const float*)(F.ws + WS_MOD);
    bf16* HB = (bf16*)(F.ws + WS_HB);
    for (int row = gw; row < T + TC; row += NGW) {
        const float* src = row < T ? F.in[I_X] + (size_t)row * D : F.in[I_CTX] + (size_t)(row - T) * D;
        const int b = row < T ? (row >> 13) : 4;
        f32x4 v[4]; row_load(src, F.lane, v);
        const float rstd = rsqrtf(row_sumsq(v) * (1.f / D) + EPS);
        const float* m = mod + (size_t)b * 6144;
        row_modulate(v, rstd, F.in[I_NMG], m, m + 1024, F.lane);
        row_store_bf16(HB + (size_t)row * D, v, F.lane);
    }
}

struct RowLin { const bf16* base; size_t pitch; __device__ __forceinline__ const bf16* operator()(int m) const { return base + (size_t)m * pitch; } };

__device__ __forceinline__ void inproj_block(Frame& F, int mb, int nbk, const f32x16& c, int lane) {
    const int h = lane >> 5, cl = lane & 31;
    bf16* dst; int pitch, cbase; bool rope = false; bool isctx = (mb >= T);
    if (nbk < 512) { dst = (bf16*)(F.ws + WS_UF); pitch = 512; cbase = 0; }
    else if (nbk < 1024) { dst = (bf16*)(F.ws + WS_Q); pitch = 512; cbase = 512; rope = true; }
    else if (nbk < 1152) { dst = isctx ? (bf16*)(F.ws + WS_CK) : (bf16*)(F.ws + WS_K); pitch = 128; cbase = 1024; rope = !isctx; }
    else { dst = isctx ? (bf16*)(F.ws + WS_CV) : (bf16*)(F.ws + WS_V); pitch = 128; cbase = 1152; }
    const int rbase = isctx ? mb - T : mb;
    const int col = nbk - cbase + cl;
    const float inv = exp2f(-(float)(cl & 15) * (13.287712379549449f / 16.f));
    const bool second = (cl & 16) != 0; const bool bycol = ((nbk >> 5) & 1) != 0;
#pragma unroll
    for (int i = 0; i < 16; ++i) {
        const int rr = crow(i, h); float v = c[i];
        if (rope) {
            const float partner = __shfl_xor(v, 16);
            const int l = (mb + rr) & (L - 1);
            const float pos = (float)(bycol ? (l & 63) : (l >> 6));
            const float ang = pos * inv, cs = __cosf(ang), sn = __sinf(ang);
            v = second ? (partner * sn + v * cs) : (v * cs - partner * sn);
        }
        dst[(size_t)(rbase + rr) * pitch + col] = (bf16)f2bf(v);
    }
}
__device__ __forceinline__ void phase_inproj(Frame& F) {
    const bf16* HB = (const bf16*)(F.ws + WS_HB); const bf16* Wt = (const bf16*)(F.ws + WS_WIN);
    constexpr int MT = (T + TC) / 128, NT = N_IN / 128;
    RowLin rp{HB, (size_t)D};
    for (int u = F.wg; u < MT * NT; u += F.G) {
        const int mt = u / NT, nt = u % NT;
        if (mt >= T / 128 && nt < 8) continue;
        auto epi = [&](int mb, int nb, const f32x16& c0, const f32x16& c1, int lane) { inproj_block(F, mb, nb, c0, lane); inproj_block(F, mb, nb + 32, c1, lane); };
        sgemm_tile(rp, Wt, D, mt * 128, nt * 128, epi, F.wave, F.lane);
    }
}

__device__ __forceinline__ void attn_key(const bf16* kp, const bf16* vp, const float (&q)[64], float& m, float& s, float (&o)[64]) {
    float dot = 0.f;
#pragma unroll
    for (int j = 0; j < 8; ++j) { const u32x4 w = *(const u32x4*)(kp + 8 * j);
        dot += q[8 * j + 0] * bflo(w.x) + q[8 * j + 1] * bfhi(w.x) + q[8 * j + 2] * bflo(w.y) + q[8 * j + 3] * bfhi(w.y)
             + q[8 * j + 4] * bflo(w.z) + q[8 * j + 5] * bfhi(w.z) + q[8 * j + 6] * bflo(w.w) + q[8 * j + 7] * bfhi(w.w); }
    const float mn = fmaxf(m, dot), alpha = __expf(m - mn), p = __expf(dot - mn);
    s = s * alpha + p; m = mn;
#pragma unroll
    for (int j = 0; j < 8; ++j) { const u32x4 w = *(const u32x4*)(vp + 8 * j);
        o[8 * j + 0] = o[8 * j + 0] * alpha + p * bflo(w.x); o[8 * j + 1] = o[8 * j + 1] * alpha + p * bfhi(w.x);
        o[8 * j + 2] = o[8 * j + 2] * alpha + p * bflo(w.y); o[8 * j + 3] = o[8 * j + 3] * alpha + p * bfhi(w.y);
        o[8 * j + 4] = o[8 * j + 4] * alpha + p * bflo(w.z); o[8 * j + 5] = o[8 * j + 5] * alpha + p * bfhi(w.z);
        o[8 * j + 6] = o[8 * j + 6] * alpha + p * bflo(w.w); o[8 * j + 7] = o[8 * j + 7] * alpha + p * bfhi(w.w); }
}
__device__ __forceinline__ void phase_attn_simple(Frame& F) {
    const bf16* Q = (const bf16*)(F.ws + WS_Q); const bf16* Kb = (const bf16*)(F.ws + WS_K); const bf16* Vb = (const bf16*)(F.ws + WS_V);
    const bf16* CK = (const bf16*)(F.ws + WS_CK); const bf16* CV = (const bf16*)(F.ws + WS_CV); bf16* MIX = (bf16*)(F.ws + WS_MIX);
    for (int idx = F.wg * NTHR + F.tid; idx < T * 8; idx += F.G * NTHR) {
        const int hd = idx / T, t = idx % T, b = t >> 13, l = t & (L - 1), kvh = hd >> 2;
        float q[64], o[64];
#pragma unroll
        for (int j = 0; j < 8; ++j) { const u32x4 w = *(const u32x4*)(Q + (size_t)t * 512 + hd * 64 + 8 * j);
            q[8 * j + 0] = bflo(w.x) * 0.125f; q[8 * j + 1] = bfhi(w.x) * 0.125f; q[8 * j + 2] = bflo(w.y) * 0.125f; q[8 * j + 3] = bfhi(w.y) * 0.125f;
            q[8 * j + 4] = bflo(w.z) * 0.125f; q[8 * j + 5] = bfhi(w.z) * 0.125f; q[8 * j + 6] = bflo(w.w) * 0.125f; q[8 * j + 7] = bfhi(w.w) * 0.125f; }
#pragma unroll
        for (int j = 0; j < 64; ++j) o[j] = 0.f;
        float m = F.in[I_SINK][hd], s = 1.f;
        for (int c = 0; c < CL; ++c) { const size_t r = (size_t)(b * CL + c) * 128 + kvh * 64; attn_key(CK + r, CV + r, q, m, s, o); }
        const int lo = l - 128 < 0 ? 0 : l - 128, hi = l + 128 > L - 1 ? L - 1 : l + 128;
        for (int kp = lo; kp <= hi; ++kp) { const size_t r = (size_t)(b * L + kp) * 128 + kvh * 64; attn_key(Kb + r, Vb + r, q, m, s, o); }
        const float is = 1.f / s;
#pragma unroll
        for (int j = 0; j < 8; ++j) { u32x4 w; w.x = pk2(o[8 * j] * is, o[8 * j + 1] * is); w.y = pk2(o[8 * j + 2] * is, o[8 * j + 3] * is); w.z = pk2(o[8 * j + 4] * is, o[8 * j + 5] * is); w.w = pk2(o[8 * j + 6] * is, o[8 * j + 7] * is);
            *(u32x4*)(MIX + (size_t)t * 1024 + 512 + hd * 64 + 8 * j) = w; }
    }
}

__device__ __forceinline__ void phase_fft1_simple(Frame& F) {
    const bf16* UF = (const bf16*)(F.ws + WS_UF); bf16* Gb = (bf16*)(F.ws + WS_G); const float* tw = (const float*)(F.ws + WS_TW);
    for (int idx = F.wg * NTHR + F.tid; idx < NB * FN1 * FN2 * 512; idx += F.G * NTHR) {
        const int ch = idx & 511, bp = (idx >> 9) & 127, c = (idx >> 16) & 63, b = idx >> 22;
        float re = 0.f, im = 0.f;
        for (int a = 0; a < FN1; ++a) { const float u = bf2f(UF[(size_t)(b * L + 128 * a + bp) * 512 + ch]); const int k = ((a * c) & 63) * 128;
            re += u * tw[2 * k]; im -= u * tw[2 * k + 1]; }
        const int k2 = bp * c; const float cs = tw[2 * k2], sn = tw[2 * k2 + 1];
        const float gr = re * cs + im * sn, gi = im * cs - re * sn;
        const size_t row = (size_t)(b * FN1 + c) * FN2 + bp;
        Gb[row * 1024 + ch] = (bf16)f2bf(gr); Gb[row * 1024 + 512 + ch] = (bf16)f2bf(gi);
    }
}
__device__ __forceinline__ void phase_fft2_simple(Frame& F) {
    const bf16* Gb = (const bf16*)(F.ws + WS_G); bf16* AB = (bf16*)(F.ws + WS_AB); const float* tw = (const float*)(F.ws + WS_TW);
    for (int idx = F.wg * NTHR + F.tid; idx < NB * FN1 * FN2 * 512; idx += F.G * NTHR) {
        const int ch = idx & 511, d = (idx >> 9) & 127, c = (idx >> 16) & 63, b = idx >> 22;
        float fr = 0.f, fi = 0.f;
        for (int bp = 0; bp < FN2; ++bp) { const size_t row = (size_t)(b * FN1 + c) * FN2 + bp; const float gr = bf2f(Gb[row * 1024 + ch]), gi = bf2f(Gb[row * 1024 + 512 + ch]);
            const int k = ((bp * d) & 127) * 64; const float cs = tw[2 * k], sn = tw[2 * k + 1];
            fr += gr * cs + gi * sn; fi += gi * cs - gr * sn; }
        const size_t t = (size_t)b * L + c + 64 * d;
        AB[t * 1024 + ch] = (bf16)f2bf(fr); AB[t * 1024 + 512 + ch] = (bf16)f2bf(-fi);
    }
}
__device__ __forceinline__ void phase_fft3_simple(Frame& F) {
    const bf16* AB = (const bf16*)(F.ws + WS_AB); bf16* MIX = (bf16*)(F.ws + WS_MIX); const float* tw = (const float*)(F.ws + WS_TW);
    LAS float* t128 = (LAS float*)F.lds;
    for (int i = F.tid; i < 128; i += NTHR) { t128[2 * i] = tw[2 * (i * 64)]; t128[2 * i + 1] = tw[2 * (i * 64) + 1]; }
    __syncthreads();
    for (int idx = F.wg * NTHR + F.tid; idx < T * 512; idx += F.G * NTHR) {
        const int cp = idx & 127, g = (idx >> 7) & 3, t = idx >> 9;
        const bf16* arow = AB + (size_t)t * 1024 + g * 128;
        float y = 0.f;
        for (int cc = 0; cc < 128; ++cc) { const int k = (cc * cp) & 127; y += bf2f(arow[cc]) * t128[2 * k] - bf2f(arow[512 + cc]) * t128[2 * k + 1]; }
        MIX[(size_t)t * 1024 + g * 128 + cp] = (bf16)f2bf(y * (1.f / 1024.f));
    }
    __syncthreads();
}

__device__ __forceinline__ void phase_outproj(Frame& F, const bf16* A, const bf16* Wt, const float* base, float* X, const float* gate  , const float* bias) {
    RowLin rp{A, (size_t)D};
    for (int u = F.wg; u < (T / 128) * 8; u += F.G) {
        const int mt = u / 8, nt = u % 8;
        auto epi = [&](int mb, int nb, const f32x16& c0, const f32x16& c1, int lane) {
            const int h = lane >> 5, cl = lane & 31, b = mb >> 13;
#pragma unroll
            for (int half = 0; half < 2; ++half) { const int col = nb + 32 * half + cl; const float gv = gate[(size_t)b * 6144 + col], bv = bias ? bias[col] : 0.f;
#pragma unroll
                for (int i = 0; i < 16; ++i) { const size_t o = (size_t)(mb + crow(i, h)) * D + col; const float a = half ? c1[i] : c0[i]; X[o] = base[o] + gv * (a + bv); } }
        };
        sgemm_tile(rp, Wt, D, mt * 128, nt * 128, epi, F.wave, F.lane);
    }
}

__device__ __forceinline__ void route_select(const float (&lg)[16], const float* rb, int& be1, int& be2, float& w1, float& w2) {
    float best = -1e30f; float bs1 = 0.f, bs2 = 0.f; be1 = 0; be2 = 0;
#pragma unroll
    for (int g = 0; g < 4; ++g) {
        float v1 = -1e30f, v2 = -1e30f, s1 = 0.f, s2 = 0.f; int j1 = 0, j2 = 0;
#pragma unroll
        for (int q = 0; q < 4; ++q) { const float sc = sigmoid_f(lg[4 * g + q]), x = sc + rb[4 * g + q];
            if (x > v1) { v2 = v1; j2 = j1; s2 = s1; v1 = x; j1 = q; s1 = sc; } else if (x > v2) { v2 = x; j2 = q; s2 = sc; } }
        const float gs = v1 + v2;
        if (gs > best) { best = gs; be1 = 4 * g + j1; be2 = 4 * g + j2; bs1 = s1; bs2 = s2; }
    }
    const float inv = 1.f / (bs1 + bs2); w1 = bs1 * inv; w2 = bs2 * inv;
}
__device__ __forceinline__ void phase_norm2_route(Frame& F, int layer) {
    const float* mod = (const float*)(F.ws + WS_MOD) + (size_t)layer * 5 * 6144;
    const float* X = F.out; const bf16* XB = (const bf16*)(F.ws + WS_XB); bf16* HB = (bf16*)(F.ws + WS_HB);
    const float* rw = F.in[I_RW]; const float* rb = F.in[I_RB];
    int* tok_e = (int*)(F.ws + WS_TOKE); int* tok_p = (int*)(F.ws + WS_TOKP); float* tok_w = (float*)(F.ws + WS_TOKW);
    int* slot_t = (int*)(F.ws + WS_SLOTT) + layer * 16 * CAP;
    float* slot_w = (float*)(F.ws + WS_SLOTW) + layer * 16 * CAP;
    unsigned* cnt = F.ctl + CW_CNT + layer * 16 * 64;
    LAS float* rwt = (LAS float*)F.lds;
    LAS int* sel_e = (LAS int*)(F.lds + 65536);
    LAS float* sel_w = (LAS float*)(F.lds + 65536 + 1024);
    LAS int* wcnt = (LAS int*)(F.lds + 65536 + 2048);
    LAS int* ebase = wcnt + 64;
    __syncthreads();
    for (int t = F.tid; t < 4096; t += NTHR) { const int i = t >> 2, e4 = t & 3; const f32x4 w = *(const f32x4*)(rw + (size_t)i * 16 + 4 * e4);
        rwt[(4 * e4 + 0) * 1024 + i] = w.x; rwt[(4 * e4 + 1) * 1024 + i] = w.y; rwt[(4 * e4 + 2) * 1024 + i] = w.z; rwt[(4 * e4 + 3) * 1024 + i] = w.w; }
    __syncthreads();
    for (int rb0 = F.wg; rb0 < T / 128; rb0 += F.G) {
        const int b = (rb0 * 128) >> 13;
        f32x4 gm[4], sh[4];
        { const float* m = mod + (size_t)b * 6144; const float* g = F.in[I_NFG] + layer * D;
#pragma unroll
          for (int jj = 0; jj < 4; ++jj) { const int o = 4 * F.lane + 256 * jj; gm[jj] = *(const f32x4*)(g + o) * (1.f + *(const f32x4*)(m + 4096 + o)); sh[jj] = *(const f32x4*)(m + 3072 + o); } }
        const int rbase = rb0 * 128 + F.wave * 16;
        f32x4 v0[4], v1[4]; xrow_load(X, XB, (size_t)rbase, F.lane, v0); xrow_load(X, XB, (size_t)(rbase + 1), F.lane, v1);
#pragma unroll 1
        for (int j = 0; j < 16; j += 2) {
            const int lr = F.wave * 16 + j, row = rbase + j;
            f32x4 n0[4], n1[4];
            { const int nr = (j + 2 < 16) ? row + 2 : row; xrow_load(X, XB, (size_t)nr, F.lane, n0); xrow_load(X, XB, (size_t)(nr + 1), F.lane, n1); }
            const float rstd0 = rsqrtf(row_sumsq(v0) * (1.f / D) + EPS), rstd1 = rsqrtf(row_sumsq(v1) * (1.f / D) + EPS);
#pragma unroll
            for (int jj = 0; jj < 4; ++jj) { v0[jj] = v0[jj] * rstd0 * gm[jj] + sh[jj]; v1[jj] = v1[jj] * rstd1 * gm[jj] + sh[jj]; }
            row_store_bf16(HB + (size_t)row * D, v0, F.lane); row_store_bf16(HB + (size_t)(row + 1) * D, v1, F.lane);
            float lg0[16], lg1[16];
#pragma unroll
            for (int e = 0; e < 16; ++e) { float a0 = 0.f, a1 = 0.f;
#pragma unroll
                for (int jj = 0; jj < 4; ++jj) { const f32x4 w4 = *(const LAS f32x4*)(rwt + e * 1024 + 4 * F.lane + 256 * jj);
                    a0 += (v0[jj].x * w4.x + v0[jj].y * w4.y) + (v0[jj].z * w4.z + v0[jj].w * w4.w); a1 += (v1[jj].x * w4.x + v1[jj].y * w4.y) + (v1[jj].z * w4.z + v1[jj].w * w4.w); }
                lg0[e] = a0; lg1[e] = a1; }
#pragma unroll
            for (int e = 0; e < 16; ++e) { lg0[e] = wave_sum(lg0[e]); lg1[e] = wave_sum(lg1[e]); }
            int e1, e2; float w1, w2;
            route_select(lg0, rb, e1, e2, w1, w2);
            if (F.lane == 0) { sel_e[2 * lr] = e1; sel_e[2 * lr + 1] = e2; sel_w[2 * lr] = w1; sel_w[2 * lr + 1] = w2; }
            route_select(lg1, rb, e1, e2, w1, w2);
            if (F.lane == 0) { sel_e[2 * lr + 2] = e1; sel_e[2 * lr + 3] = e2; sel_w[2 * lr + 2] = w1; sel_w[2 * lr + 3] = w2; }
#pragma unroll
            for (int jj = 0; jj < 4; ++jj) { v0[jj] = n0[jj]; v1[jj] = n1[jj]; }
        }
        __syncthreads();
        int my_e = 0, my_rank = 0; float my_w = 0.f;
        if (F.tid < 256) { my_e = sel_e[F.tid]; my_w = sel_w[F.tid];
            const unsigned long long below = (1ull << F.lane) - 1ull;
#pragma unroll 1
            for (int ee = 0; ee < 16; ++ee) { const unsigned long long mk = __ballot(my_e == ee);
                if (my_e == ee) my_rank = __popcll(mk & below);
                if (F.lane == 0) wcnt[F.wave * 16 + ee] = __popcll(mk); } }
        __syncthreads();
        if (F.tid < 16) { const int n = wcnt[F.tid] + wcnt[16 + F.tid] + wcnt[32 + F.tid] + wcnt[48 + F.tid];
            ebase[F.tid] = n ? (int)atomicAdd(cnt + F.tid * 64, (unsigned)n) : 0; }
        __syncthreads();
        if (F.tid < 256) { int pos = ebase[my_e] + my_rank;
            for (int w = 0; w < F.wave; ++w) pos += wcnt[w * 16 + my_e];
            const int tok = rb0 * 128 + (F.tid >> 1), k = F.tid & 1;
            slot_t[my_e * CAP + pos] = tok; slot_w[my_e * CAP + pos] = my_w; tok_e[2 * tok + k] = my_e; tok_p[2 * tok + k] = pos; tok_w[2 * tok + k] = my_w; }
        __syncthreads();
    }
}

constexpr int MOEMAP_OFF = LDS_BYTES - 256;
__device__ __forceinline__ LAS int* moe_map(Frame& F, int layer) {
    LAS int* mm = (LAS int*)(F.lds + MOEMAP_OFF);
    __syncthreads();
    if (F.tid < 64) { const unsigned* cnt = F.ctl + CW_CNT + layer * 16 * 64;
        const int n = (F.tid < 16) ? (int)__hip_atomic_load(cnt + F.tid * 64, __ATOMIC_RELAXED, __HIP_MEMORY_SCOPE_AGENT) : 0;
        const int pad = (n + 255) & ~255; int x = pad;
#pragma unroll
        for (int o = 1; o < 16; o <<= 1) { const int t = __shfl_up(x, o); if (F.lane >= o) x += t; }
        if (F.tid < 16) { mm[F.tid] = n; mm[16 + F.tid] = x - pad; } }
    __syncthreads();
    return mm;
}
struct RowGather { const bf16* base; const int* list; int n; __device__ __forceinline__ const bf16* operator()(int m) const { const int tok = m < n ? list[m] : 0; return base + (size_t)tok * D; } };

__device__ __forceinline__ void phase_moe_gateup(Frame& F, int layer) {
    LAS int* mm = moe_map(F, layer);
    const bf16* HB = (const bf16*)(F.ws + WS_HB); bf16* HID = (bf16*)(F.ws + WS_HID);
    const int* slot_t = (const int*)(F.ws + WS_SLOTT) + layer * 16 * CAP; const float* slot_w = (const float*)(F.ws + WS_SLOTW) + layer * 16 * CAP;
    int ubase = 0;
#pragma unroll 1
    for (int e = 0; e < 16; ++e) {
        const int n = mm[e], hbe = mm[16 + e], rt = (n + 127) >> 7, nu = rt * 8;
        const bf16* Wt = (const bf16*)(F.ws + WS_WGU) + (size_t)(layer * 16 + e) * 1024 * 1024;
        RowGather rp{HB, slot_t + e * CAP, n};
        int first = (F.wg - ubase % F.G + F.G) % F.G;
        for (int u = first; u < nu; u += F.G) {
            const int mt = u / 8, nt = u % 8;
            auto epi = [&](int mb, int nb, const f32x16& c0, const f32x16& c1, int lane) {
                const int h = lane >> 5, cl = lane & 31; const int col = (nb >> 1) + cl;
#pragma unroll
                for (int i = 0; i < 16; ++i) { const int r = mb + crow(i, h);
                    if (r < n) { const float w = slot_w[e * CAP + r]; HID[(size_t)(hbe + r) * FF + col] = (bf16)f2bf(w * silu_f(c0[i]) * c1[i]); } }
            };
            sgemm_tile(rp, Wt, D, mt * 128, nt * 128, epi, F.wave, F.lane);
        }
        ubase += nu;
    }
}
__device__ __forceinline__ void phase_moe_down(Frame& F, int layer) {
    LAS int* mm = moe_map(F, layer);
    const bf16* HID = (const bf16*)(F.ws + WS_HID); bf16* Y = (bf16*)(F.ws + WS_Y);
    int ubase = 0;
#pragma unroll 1
    for (int e = 0; e < 16; ++e) {
        const int n = mm[e], hbe = mm[16 + e], rt = (n + 127) >> 7, nu = rt * 8;
        const bf16* Wt = (const bf16*)(F.ws + WS_WDN) + (size_t)(layer * 16 + e) * 1024 * 512;
        RowLin rp{HID + (size_t)hbe * FF, (size_t)FF};
        int first = (F.wg - ubase % F.G + F.G) % F.G;
        for (int u = first; u < nu; u += F.G) {
            const int mt = u / 8, nt = u % 8;
            auto epi = [&](int mb, int nb, const f32x16& c0, const f32x16& c1, int lane) {
                const int h = lane >> 5, cl = lane & 31;
#pragma unroll
                for (int i = 0; i < 16; ++i) { const int r = mb + crow(i, h);
                    if (r < n) { bf16* yr = Y + (size_t)(hbe + r) * D + nb + cl; yr[0] = (bf16)f2bf(c0[i]); yr[32] = (bf16)f2bf(c1[i]); } }
            };
            sgemm_tile(rp, Wt, FF, mt * 128, nt * 128, epi, F.wave, F.lane);
        }
        ubase += nu;
    }
}

template <bool FINAL>
__device__ __forceinline__ void phase_combine(Frame& F, int layer) {
    LAS int* hbs = moe_map(F, layer) + 16;
    const int gw = F.wg * NWAVES + F.wave, NGW = F.G * NWAVES;
    const float* mod = (const float*)(F.ws + WS_MOD);
    const int* tok_e = (const int*)(F.ws + WS_TOKE); const int* tok_p = (const int*)(F.ws + WS_TOKP);
    const bf16* Y = (const bf16*)(F.ws + WS_Y); float* X = F.out; bf16* XB = (bf16*)(F.ws + WS_XB); bf16* HB = (bf16*)(F.ws + WS_HB);
    for (int blk = gw; blk < T / 16; blk += NGW) {
        const int rbase = blk * 16, b = rbase >> 13;
        f32x4 g2v[4], gm[4], shv[4];
        { const float* g2 = mod + ((size_t)layer * 5 + b) * 6144 + 5120;
#pragma unroll
          for (int j = 0; j < 4; ++j) { const int o = 4 * F.lane + 256 * j; g2v[j] = *(const f32x4*)(g2 + o);
              if (FINAL) { gm[j] = *(const f32x4*)(F.in[I_FNG] + o); shv[j] = (f32x4){0.f, 0.f, 0.f, 0.f}; }
              else { const float* m = mod + ((size_t)(layer + 1) * 5 + b) * 6144; gm[j] = *(const f32x4*)(F.in[I_NMG] + (layer + 1) * D + o) * (1.f + *(const f32x4*)(m + 1024 + o)); shv[j] = *(const f32x4*)(m + o); } } }
        int4 te = *(const int4*)(tok_e + 2 * rbase), tp = *(const int4*)(tok_p + 2 * rbase);
#pragma unroll 1
        for (int jr = 0; jr < 16; jr += 2) {
            const int row = rbase + jr;
            const int s00 = hbs[te.x] + tp.x, s01 = hbs[te.y] + tp.y, s10 = hbs[te.z] + tp.z, s11 = hbs[te.w] + tp.w;
            f32x4 v[2][4]; xrow_load(X, XB, (size_t)row, F.lane, v[0]); xrow_load(X, XB, (size_t)(row + 1), F.lane, v[1]);
            u32x2 y0[2][4], y1[2][4];
#pragma unroll
            for (int j = 0; j < 4; ++j) { const int o = 4 * F.lane + 256 * j;
                y0[0][j] = *(const u32x2*)(Y + (size_t)s00 * D + o); y1[0][j] = *(const u32x2*)(Y + (size_t)s01 * D + o);
                y0[1][j] = *(const u32x2*)(Y + (size_t)s10 * D + o); y1[1][j] = *(const u32x2*)(Y + (size_t)s11 * D + o); }
            { const int nr = (jr + 2 < 16) ? row + 2 : row; te = *(const int4*)(tok_e + 2 * nr); tp = *(const int4*)(tok_p + 2 * nr); }
#pragma unroll
            for (int q = 0; q < 2; ++q)
#pragma unroll
                for (int j = 0; j < 4; ++j) { const f32x4 gg = g2v[j];
                    v[q][j].x += gg.x * (bflo(y0[q][j].x) + bflo(y1[q][j].x)); v[q][j].y += gg.y * (bfhi(y0[q][j].x) + bfhi(y1[q][j].x));
                    v[q][j].z += gg.z * (bflo(y0[q][j].y) + bflo(y1[q][j].y)); v[q][j].w += gg.w * (bfhi(y0[q][j].y) + bfhi(y1[q][j].y)); }
            const float rstd0 = rsqrtf(row_sumsq(v[0]) * (1.f / D) + EPS), rstd1 = rsqrtf(row_sumsq(v[1]) * (1.f / D) + EPS);
#pragma unroll
            for (int q = 0; q < 2; ++q) { const float rstd = q ? rstd1 : rstd0; const size_t ro = (size_t)(row + q) * D;
                if (FINAL) {
#pragma unroll
                    for (int j = 0; j < 4; ++j) *(f32x4*)(X + ro + 4 * F.lane + 256 * j) = v[q][j] * rstd * gm[j];
                } else {
                    if (XBF16) row_store_bf16(XB + ro, v[q], F.lane);
#pragma unroll
                    for (int j = 0; j < 4; ++j) { if (!XBF16) *(f32x4*)(X + ro + 4 * F.lane + 256 * j) = v[q][j]; v[q][j] = v[q][j] * rstd * gm[j] + shv[j]; }
                    row_store_bf16(HB + ro, v[q], F.lane);
                }
            }
        }
    }
    __syncthreads();
}

__device__ __forceinline__ void phase_pw1(Frame& F) {
    const bf16* HB = (const bf16*)(F.ws + WS_HB); const bf16* Wt = (const bf16*)(F.ws + WS_WPW1); bf16* U = (bf16*)(F.ws + WS_U);
    const float* bias = F.in[I_PW1B];
    RowLin rp{HB, (size_t)D};
    for (int u = F.wg; u < (T / 128) * 16; u += F.G) {
        const int mt = u / 16, nt = u % 16;
        auto epi = [&](int mb, int nb, const f32x16& c0, const f32x16& c1, int lane) {
            const int h = lane >> 5, cl = lane & 31, col = (nb >> 1) + cl; const float ba = bias[col], bg = bias[1024 + col];
#pragma unroll
            for (int i = 0; i < 16; ++i) U[(size_t)(mb + crow(i, h)) * D + col] = (bf16)f2bf((c0[i] + ba) * sigmoid_f(c1[i] + bg));
        };
        sgemm_tile(rp, Wt, D, mt * 128, nt * 128, epi, F.wave, F.lane);
    }
}
__device__ __forceinline__ void phase_dwconv(Frame& F) {
    const bf16* U = (const bf16*)(F.ws + WS_U); bf16* V1 = (bf16*)(F.ws + WS_V1);
    const float* dww = F.in[I_DWW]; const float* dwb = F.in[I_DWB]; const float* lng = F.in[I_LNG]; const float* lnb = F.in[I_LNB];
    const int gw = F.wg * NWAVES + F.wave, NGW = F.G * NWAVES;
    for (int row = gw; row < T; row += NGW) {
        const int l = row & (L - 1);
        f32x4 acc[4];
#pragma unroll
        for (int j = 0; j < 4; ++j) acc[j] = *(const f32x4*)(dwb + 4 * F.lane + 256 * j);
        for (int tp = 0; tp < CONVW; ++tp) { const int ll = l + tp - 15; if (ll < 0 || ll >= L) continue;
            const bf16* ur = U + (size_t)(row + tp - 15) * D; const float* wr = dww + (size_t)tp * D;
#pragma unroll
            for (int j = 0; j < 4; ++j) { const int o = 4 * F.lane + 256 * j; const u32x2 uu = *(const u32x2*)(ur + o); const f32x4 ww = *(const f32x4*)(wr + o);
                acc[j].x += bflo(uu.x) * ww.x; acc[j].y += bfhi(uu.x) * ww.y; acc[j].z += bflo(uu.y) * ww.z; acc[j].w += bfhi(uu.y) * ww.w; } }
        float s = 0.f;
#pragma unroll
        for (int j = 0; j < 4; ++j) s += (acc[j].x + acc[j].y) + (acc[j].z + acc[j].w);
        const float mean = wave_sum(s) * (1.f / D); float q = 0.f;
#pragma unroll
        for (int j = 0; j < 4; ++j) { acc[j] = acc[j] - mean; q += (acc[j].x * acc[j].x + acc[j].y * acc[j].y) + (acc[j].z * acc[j].z + acc[j].w * acc[j].w); }
        const float rstd = rsqrtf(wave_sum(q) * (1.f / D) + EPS);
#pragma unroll
        for (int j = 0; j < 4; ++j) { const int o = 4 * F.lane + 256 * j; const f32x4 gg = *(const f32x4*)(lng + o), bb = *(const f32x4*)(lnb + o);
            f32x4 y = acc[j] * rstd * gg + bb; y.x = silu_f(y.x); y.y = silu_f(y.y); y.z = silu_f(y.z); y.w = silu_f(y.w); acc[j] = y; }
        row_store_bf16(V1 + (size_t)row * D, acc, F.lane);
    }
}


namespace pg {
constexpr int BM = 256, BK = 64, HALF = 128, HTB = HALF * BK * 2, STAGE_BYTES = 8 * HTB;
constexpr int TAB_OFF = STAGE_BYTES;
__device__ __forceinline__ int lds_byte(int r, int c) { const int st = (r >> 4) * 2 + (c >> 5), rr = r & 15, cc = c & 31, ob = rr * 64 + cc * 2; return st * 1024 + (ob ^ (((ob >> 9) & 1) << 5)); }
__device__ __forceinline__ void stage_rc(int b, int& R, int& C) { const int st = b / 1024, sb = b % 1024, swz = sb ^ (((sb >> 9) & 1) << 5); R = (st >> 1) * 16 + swz / 64; C = (st & 1) * 32 + (swz % 64) / 2; }
__device__ __forceinline__ int perm32(int rho) { const int n = rho >> 4, i = rho & 15; return 8 * (i >> 2) + 4 * n + (i & 3); }
__device__ __forceinline__ unsigned cvt_pk_bf16(float lo, float hi) { unsigned r; asm volatile("v_cvt_pk_bf16_f32 %0, %1, %2" : "=v"(r) : "v"(lo), "v"(hi)); return r; }

struct GU { const char* B; int p0, p1, p2, p3; };

template <class Epi, class Sched>
__device__ __forceinline__ void gemm_phase(LAS unsigned char* lds, const char* Abase, const int K, const Sched& S, const Epi& E) {
    const int tid = threadIdx.x, wid = __builtin_amdgcn_readfirstlane(tid >> 6), lane = tid & 63, wr = wid >> 2, wc = wid & 3, fr = lane & 15, fq = lane >> 4;
    const int nt = K / BK;
    int sR[2], sC[2]; unsigned voffB[2];
#pragma unroll
    for (int i = 0; i < 2; ++i) { int R, C; stage_rc(tid * 16 + i * 8192, R, C); sR[i] = R; sC[i] = C; const int Rb = Epi::PERM ? ((R & ~31) + perm32(R & 31)) : R; voffB[i] = (unsigned)(Rb * K + C) * 2u; }
    const size_t kstep = (size_t)(BK * 2);
    const size_t hstep = (size_t)HALF * K * 2;
    const unsigned ldsw = (unsigned)wid * 1024u;
    const int aoff = lds_byte(wr * 64 + fr, fq * 8), boff = lds_byte(wc * 32 + fr, fq * 8);
#define PG_SA(b, h) (((b) * 2 + (h)) * HTB)
#define PG_SB(b, h) ((4 + (b) * 2 + (h)) * HTB)
#define PG_STAGE(bufoff, gbase, voff) do { _Pragma("unroll") for (int _i = 0; _i < 2; ++_i) \
        __builtin_amdgcn_global_load_lds((const unsigned*)((const char*)(gbase) + (voff)[_i]), (LAS unsigned*)(lds + (bufoff) + ldsw + _i * 8192), 16, 0, 0); } while (0)
#define PG_LDA(dst, b, h) do { _Pragma("unroll") for (int m = 0; m < 4; ++m) _Pragma("unroll") for (int k = 0; k < 2; ++k) dst[m][k] = *(const LAS bf16x8*)(lds + PG_SA(b, h) + aoff + m * 2048 + k * 1024); } while (0)
#define PG_LDB(dst, b, h) do { _Pragma("unroll") for (int n = 0; n < 2; ++n) _Pragma("unroll") for (int k = 0; k < 2; ++k) dst[n][k] = *(const LAS bf16x8*)(lds + PG_SB(b, h) + boff + n * 2048 + k * 1024); } while (0)
#define PG_MMA(ai, bj, At, Bt) do { __builtin_amdgcn_s_setprio(1); _Pragma("unroll") for (int m = 0; m < 4; ++m) _Pragma("unroll") for (int n = 0; n < 2; ++n) _Pragma("unroll") for (int k = 0; k < 2; ++k) \
        acc[ai][bj][m][n] = __builtin_amdgcn_mfma_f32_16x16x32_bf16(Bt[n][k], At[m][k], acc[ai][bj][m][n], 0, 0, 0); __builtin_amdgcn_s_setprio(0); } while (0)
#define PG_WAIT_V(n) asm volatile("s_waitcnt vmcnt(" #n ")" ::: "memory")
#define PG_WAIT_L(n) asm volatile("s_waitcnt lgkmcnt(" #n ")" ::: "memory")
#define PG_BAR __builtin_amdgcn_s_barrier()
#define PG_SCHED __builtin_amdgcn_sched_barrier(0)
    GU cur, nxt; int ui = 0;
    if (!S.next(0, cur)) return;
    f32x4 acc[2][2][4][2];
#pragma unroll
    for (int a = 0; a < 2; ++a)
#pragma unroll
        for (int b = 0; b < 2; ++b)
#pragma unroll
            for (int m = 0; m < 4; ++m)
#pragma unroll
                for (int n = 0; n < 2; ++n) acc[a][b][m][n] = (f32x4){0.f, 0.f, 0.f, 0.f};
    bf16x8 At[4][2], B0[2][2], B1[2][2];
    if constexpr (Sched::GATHER) { S.stage_table(cur, 0, lds, wid, lane); PG_WAIT_V(0); PG_BAR; }
    unsigned voC[2][2], voN[2][2];
#pragma unroll
    for (int h = 0; h < 2; ++h)
#pragma unroll
        for (int i = 0; i < 2; ++i) { voC[h][i] = S.voff(cur, 0, lds, h * HALF + sR[i], sC[i]); voN[h][i] = voC[h][i]; }
    const char* cB = cur.B;
    PG_STAGE(PG_SB(0, 0), cB, voffB); PG_STAGE(PG_SB(0, 1), cB + hstep, voffB); PG_STAGE(PG_SA(0, 0), Abase, voC[0]); PG_STAGE(PG_SA(0, 1), Abase, voC[1]);
    if (wr == 1) PG_BAR;
    PG_WAIT_V(2); PG_BAR;
    PG_STAGE(PG_SB(1, 0), cB + kstep, voffB); PG_STAGE(PG_SA(1, 0), Abase + kstep, voC[0]); PG_STAGE(PG_SB(1, 1), cB + hstep + kstep, voffB);
    PG_WAIT_V(6); PG_BAR;
    for (;;) {
        const bool has_next = S.next(ui + 1, nxt);
        if constexpr (Sched::GATHER) { if (has_next) S.stage_table(nxt, (ui + 1) & 1, lds, wid, lane); }
        const char* nB = has_next ? nxt.B : cB;
        for (int t = 0; t < nt; t += 2) {
            const bool last = (t == nt - 2);
            if (last && has_next) {
#pragma unroll
                for (int h = 0; h < 2; ++h)
#pragma unroll
                    for (int i = 0; i < 2; ++i) voN[h][i] = S.voff(nxt, (ui + 1) & 1, lds, h * HALF + sR[i], sC[i]);
            }
            unsigned vo2[2][2];
#pragma unroll
            for (int h = 0; h < 2; ++h)
#pragma unroll
                for (int i = 0; i < 2; ++i) vo2[h][i] = last ? voN[h][i] : voC[h][i];
            const char* a1 = Abase + (size_t)(t + 1) * kstep;
            const char* a2 = last ? Abase : Abase + (size_t)(t + 2) * kstep; const char* b2 = last ? nB : cB + (size_t)(t + 2) * kstep;
            const char* a3 = a2 + kstep; const char* b3 = b2 + kstep;
            PG_LDB(B0, 0, 0); PG_LDB(B1, 0, 1); PG_SCHED; PG_LDA(At, 0, 0); PG_STAGE(PG_SA(1, 1), a1, voC[1]);
            PG_WAIT_V(8); PG_WAIT_L(0); PG_BAR; PG_MMA(0, 0, At, B0); PG_MMA(0, 1, At, B1); PG_BAR; PG_SCHED;
            PG_LDA(At, 0, 1); PG_STAGE(PG_SB(0, 0), b2, voffB); PG_STAGE(PG_SB(0, 1), b2 + hstep, voffB); PG_STAGE(PG_SA(0, 0), a2, vo2[0]);
            PG_WAIT_V(8); PG_WAIT_L(0); PG_BAR; PG_MMA(1, 0, At, B0); PG_MMA(1, 1, At, B1); PG_BAR; PG_SCHED;
            PG_LDB(B0, 1, 0); PG_LDB(B1, 1, 1); PG_SCHED; PG_LDA(At, 1, 0); PG_STAGE(PG_SA(0, 1), a2, vo2[1]);
            PG_WAIT_V(8); PG_WAIT_L(0); PG_BAR; PG_MMA(0, 0, At, B0); PG_MMA(0, 1, At, B1); PG_BAR; PG_SCHED;
            PG_LDA(At, 1, 1); PG_STAGE(PG_SB(1, 0), b3, voffB); PG_STAGE(PG_SB(1, 1), b3 + hstep, voffB); PG_STAGE(PG_SA(1, 0), a3, vo2[0]);
            PG_WAIT_V(8); PG_WAIT_L(0); PG_BAR; PG_MMA(1, 0, At, B0); PG_MMA(1, 1, At, B1); PG_BAR; PG_SCHED;
        }
        if (wr == 0) PG_BAR;
        E(acc, cur, wr, wc, fr, fq);
        if (!has_next) break;
#pragma unroll
        for (int a = 0; a < 2; ++a)
#pragma unroll
            for (int b = 0; b < 2; ++b)
#pragma unroll
                for (int m = 0; m < 4; ++m)
#pragma unroll
                    for (int n = 0; n < 2; ++n) acc[a][b][m][n] = (f32x4){0.f, 0.f, 0.f, 0.f};
        cur = nxt; cB = nB; ++ui;
#pragma unroll
        for (int h = 0; h < 2; ++h)
#pragma unroll
            for (int i = 0; i < 2; ++i) voC[h][i] = voN[h][i];
        if (wr == 1) PG_BAR;
    }
    PG_WAIT_V(0);
    PG_BAR;
#undef PG_SA
#undef PG_SB
#undef PG_STAGE
#undef PG_LDA
#undef PG_LDB
#undef PG_MMA
#undef PG_WAIT_V
#undef PG_WAIT_L
#undef PG_BAR
#undef PG_SCHED
}

__device__ __forceinline__ void static_tile(int L, int nM, int nN, int& pm, int& pn) {
    const int nwg = nM * nN; int wgid = L; { const int q = nwg / 8, r = nwg % 8, xcd = wgid % 8, off = wgid / 8; wgid = (xcd < r ? xcd * (q + 1) : r * (q + 1) + (xcd - r) * q) + off; }
    const int nig = 8 * nN, gid = wgid / nig, fm = gid * 8, gsz = (nM - fm) < 8 ? (nM - fm) : 8;
    pm = fm + ((wgid % nig) % gsz); pn = (wgid % nig) / gsz;
}
struct DenseSched {
    static constexpr bool GATHER = false;
    const char* Bt; int K, nM, nN, G, c, xn, xm0, xpn;
    __device__ __forceinline__ bool next(int i, GU& u) const {
        const int L = i * G + c, nmain = nM * nN; int pm, pn;
        if (L < nmain) static_tile(L, nM, nN, pm, pn); else if (L < nmain + xn) { pm = xm0 + (L - nmain); pn = xpn; } else return false;
        u.B = Bt + (size_t)pn * BM * K * 2; u.p0 = pm; u.p1 = pn; u.p2 = 0; u.p3 = 0; return true;
    }
    __device__ __forceinline__ unsigned voff(const GU& u, int, LAS unsigned char*, int R, int C) const { return (unsigned)(((u.p0 * BM + R) * K + C) * 2); }
    __device__ __forceinline__ void stage_table(const GU&, int, LAS unsigned char*, int, int) const {}
};
template <bool GATHER_> struct MoeSched {
    static constexpr bool GATHER = GATHER_;
    const char* Wt; size_t wstride; int K; const int* list; LAS int* mm; int G, c;
    __device__ __forceinline__ bool next(int i, GU& u) const {
        int L = i * G + c;
        for (int e = 0; e < 16; ++e) { const int n = mm[e], nu = ((n + 255) >> 8) * 4;
            if (L < nu) { const int rt = L >> 2, pn = L & 3; u.B = Wt + (size_t)e * wstride + (size_t)pn * BM * K * 2; u.p0 = e; u.p1 = rt; u.p2 = pn; u.p3 = mm[16 + e]; return true; }
            L -= nu; }
        return false;
    }
    __device__ __forceinline__ unsigned voff(const GU& u, int buf, LAS unsigned char* lds, int R, int C) const {
        if constexpr (GATHER_) { const int tok = ((const LAS int*)(lds + TAB_OFF))[buf * 256 + R]; return (unsigned)((tok * K + C) * 2); }
        else return (unsigned)(((u.p3 + u.p1 * BM + R) * K + C) * 2);
    }
    __device__ __forceinline__ void stage_table(const GU& u, int buf, LAS unsigned char* lds, int wid, int lane) const {
        if constexpr (GATHER_) { const int r = (wid & 3) * 64 + lane;
            __builtin_amdgcn_global_load_lds((const unsigned*)(list + u.p0 * CAP + u.p1 * BM + r), (LAS unsigned*)(lds + TAB_OFF + buf * 1024 + (wid & 3) * 256), 4, 0, 0); }
    }
};

struct EpiInProj {
    static constexpr bool PERM = false;
    unsigned char* ws;
    __device__ __forceinline__ void operator()(const f32x4 (&acc)[2][2][4][2], const GU& u, int wr, int wc, int fr, int fq) const {
        const int pm = u.p0, pn = u.p1; const bool isctx = pm >= T / BM;
        float inv[4];
#pragma unroll
        for (int j = 0; j < 4; ++j) inv[j] = exp2f(-(float)(4 * fq + j) * (13.287712379549449f / 16.f));
#pragma unroll
        for (int bj = 0; bj < 2; ++bj) {
            const int cb = pn * BM + bj * HALF + wc * 32;
            bf16* dst; int pitch, cbase; bool rope = false;
            if (cb < 512) { dst = (bf16*)(ws + WS_UF); pitch = 512; cbase = 0; }
            else if (cb < 1024) { dst = (bf16*)(ws + WS_Q); pitch = 512; cbase = 512; rope = true; }
            else if (cb < 1152) { dst = isctx ? (bf16*)(ws + WS_CK) : (bf16*)(ws + WS_K); pitch = 128; cbase = 1024; rope = !isctx; }
            else { dst = isctx ? (bf16*)(ws + WS_CV) : (bf16*)(ws + WS_V); pitch = 128; cbase = 1152; }
            const bool bycol = ((cb >> 5) & 1) != 0;
#pragma unroll
            for (int ai = 0; ai < 2; ++ai)
#pragma unroll
                for (int m = 0; m < 4; ++m) {
                    const int row = pm * BM + ai * HALF + wr * 64 + m * 16 + fr;
                    f32x4 v0 = acc[ai][bj][m][0], v1 = acc[ai][bj][m][1];
                    if (rope) { const int l = row & (L - 1); const float pos = (float)(bycol ? (l & 63) : (l >> 6));
#pragma unroll
                        for (int j = 0; j < 4; ++j) { const float ang = pos * inv[j], cs = __cosf(ang), sn = __sinf(ang); const float x1 = v0[j], x2 = v1[j]; v0[j] = x1 * cs - x2 * sn; v1[j] = x1 * sn + x2 * cs; } }
                    const int orow = isctx ? row - T : row;
                    if (FAST_ATTN && cb >= 1152) {
                        const int kp = isctx ? CL : L, bb = isctx ? (orow >> 8) : (orow >> 13), key = isctx ? (orow & (CL - 1)) : (orow & (L - 1));
#pragma unroll
                        for (int n = 0; n < 2; ++n)
#pragma unroll
                            for (int j = 0; j < 4; ++j) { const int c = (cb - 1152) + 16 * n + 4 * fq + j;
                                dst[((size_t)bb * 128 + c) * kp + key] = (bf16)f2bf(n ? v1[j] : v0[j]); }
                        continue;
                    }
                    bf16* o = dst + (size_t)orow * pitch + (cb - cbase) + 4 * fq;
                    u32x2 w0, w1; w0.x = cvt_pk_bf16(v0[0], v0[1]); w0.y = cvt_pk_bf16(v0[2], v0[3]); w1.x = cvt_pk_bf16(v1[0], v1[1]); w1.y = cvt_pk_bf16(v1[2], v1[3]);
                    *(u32x2*)o = w0; *(u32x2*)(o + 16) = w1;
                }
        }
    }
};
struct EpiRes {
    static constexpr bool PERM = false;
    const float* base; float* X; const float* gate; const float* bias;
    __device__ __forceinline__ void operator()(const f32x4 (&acc)[2][2][4][2], const GU& u, int wr, int wc, int fr, int fq) const {
        const int row0 = u.p0 * BM + wr * 64 + fr, col0 = u.p1 * BM + wc * 32 + 4 * fq; const int b = (u.p0 * BM) >> 13;
        f32x4 gv[2][2], bv[2][2];
#pragma unroll
        for (int bj = 0; bj < 2; ++bj)
#pragma unroll
            for (int n = 0; n < 2; ++n) { gv[bj][n] = *(const f32x4*)(gate + (size_t)b * 6144 + col0 + bj * HALF + n * 16); bv[bj][n] = bias ? *(const f32x4*)(bias + col0 + bj * HALF + n * 16) : (f32x4){0.f, 0.f, 0.f, 0.f}; }
#pragma unroll
        for (int ai = 0; ai < 2; ++ai)
#pragma unroll
            for (int mp = 0; mp < 2; ++mp) {
                f32x4 bs[2][2][2];
#pragma unroll
                for (int mm = 0; mm < 2; ++mm) { const size_t off = (size_t)(row0 + ai * HALF + (2 * mp + mm) * 16) * D + col0;
#pragma unroll
                    for (int bj = 0; bj < 2; ++bj)
#pragma unroll
                        for (int n = 0; n < 2; ++n) bs[mm][bj][n] = *(const f32x4*)(base + off + bj * HALF + n * 16); }
#pragma unroll
                for (int mm = 0; mm < 2; ++mm) { const int m = 2 * mp + mm; const size_t off = (size_t)(row0 + ai * HALF + m * 16) * D + col0;
#pragma unroll
                    for (int bj = 0; bj < 2; ++bj)
#pragma unroll
                        for (int n = 0; n < 2; ++n) *(f32x4*)(X + off + bj * HALF + n * 16) = bs[mm][bj][n] + gv[bj][n] * (acc[ai][bj][m][n] + bv[bj][n]); }
                asm volatile("" ::: "memory"); }
    }
};
template <bool BASEBF> struct EpiResB {
    static constexpr bool PERM = false;
    const float* basef; bf16* XB; const float* gate; const float* bias;
    __device__ __forceinline__ void operator()(const f32x4 (&acc)[2][2][4][2], const GU& u, int wr, int wc, int fr, int fq) const {
        const int row0 = u.p0 * BM + wr * 64 + fr, col0 = u.p1 * BM + wc * 32 + 4 * fq; const int b = (u.p0 * BM) >> 13;
        f32x4 gv[2][2], bv[2][2];
#pragma unroll
        for (int bj = 0; bj < 2; ++bj)
#pragma unroll
            for (int n = 0; n < 2; ++n) { gv[bj][n] = *(const f32x4*)(gate + (size_t)b * 6144 + col0 + bj * HALF + n * 16); bv[bj][n] = bias ? *(const f32x4*)(bias + col0 + bj * HALF + n * 16) : (f32x4){0.f, 0.f, 0.f, 0.f}; }
#pragma unroll
        for (int ai = 0; ai < 2; ++ai)
#pragma unroll
            for (int mp = 0; mp < 2; ++mp) {
                f32x4 bs[2][2][2];
#pragma unroll
                for (int mm = 0; mm < 2; ++mm) { const size_t off = (size_t)(row0 + ai * HALF + (2 * mp + mm) * 16) * D + col0;
#pragma unroll
                    for (int bj = 0; bj < 2; ++bj)
#pragma unroll
                        for (int n = 0; n < 2; ++n) { if (BASEBF) { const u32x2 w = *(const u32x2*)(XB + off + bj * HALF + n * 16); bs[mm][bj][n] = (f32x4){bflo(w.x), bfhi(w.x), bflo(w.y), bfhi(w.y)}; }
                                                      else bs[mm][bj][n] = *(const f32x4*)(basef + off + bj * HALF + n * 16); } }
#pragma unroll
                for (int mm = 0; mm < 2; ++mm) { const int m = 2 * mp + mm; const size_t off = (size_t)(row0 + ai * HALF + m * 16) * D + col0;
#pragma unroll
                    for (int bj = 0; bj < 2; ++bj)
#pragma unroll
                        for (int n = 0; n < 2; ++n) { const f32x4 o = bs[mm][bj][n] + gv[bj][n] * (acc[ai][bj][m][n] + bv[bj][n]);
                            u32x2 w; w.x = cvt_pk_bf16(o[0], o[1]); w.y = cvt_pk_bf16(o[2], o[3]); *(u32x2*)(XB + off + bj * HALF + n * 16) = w; } }
                asm volatile("" ::: "memory"); }
    }
};
struct EpiGLU {
    static constexpr bool PERM = true;
    bf16* U; const float* bias;
    __device__ __forceinline__ void operator()(const f32x4 (&acc)[2][2][4][2], const GU& u, int wr, int wc, int fr, int fq) const {
        const int row0 = u.p0 * BM + wr * 64 + fr, col0 = u.p1 * HALF + wc * 32 + 8 * fq;
        f32x4 ba[2], bg[2];
#pragma unroll
        for (int n = 0; n < 2; ++n) { ba[n] = *(const f32x4*)(bias + col0 + 4 * n); bg[n] = *(const f32x4*)(bias + 1024 + col0 + 4 * n); }
#pragma unroll
        for (int ai = 0; ai < 2; ++ai)
#pragma unroll
            for (int m = 0; m < 4; ++m) { f32x4 o[2];
#pragma unroll
                for (int n = 0; n < 2; ++n) { const f32x4 a = acc[ai][0][m][n] + ba[n], g = acc[ai][1][m][n] + bg[n];
#pragma unroll
                    for (int j = 0; j < 4; ++j) o[n][j] = a[j] * sigmoid_f(g[j]); }
                u32x4 w; w.x = cvt_pk_bf16(o[0][0], o[0][1]); w.y = cvt_pk_bf16(o[0][2], o[0][3]); w.z = cvt_pk_bf16(o[1][0], o[1][1]); w.w = cvt_pk_bf16(o[1][2], o[1][3]);
                *(u32x4*)(U + (size_t)(row0 + ai * HALF + m * 16) * D + col0) = w; }
    }
};
struct EpiGateUp {
    static constexpr bool PERM = true;
    bf16* HID; const float* slot_w; LAS int* mm;
    __device__ __forceinline__ void operator()(const f32x4 (&acc)[2][2][4][2], const GU& u, int wr, int wc, int fr, int fq) const {
        const int e = u.p0, n_e = mm[e], r0 = u.p1 * BM + wr * 64 + fr, col0 = u.p2 * HALF + wc * 32 + 8 * fq;
        float wv[2][4];
#pragma unroll
        for (int ai = 0; ai < 2; ++ai)
#pragma unroll
            for (int m = 0; m < 4; ++m) wv[ai][m] = slot_w[e * CAP + r0 + ai * HALF + m * 16];
#pragma unroll
        for (int ai = 0; ai < 2; ++ai)
#pragma unroll
            for (int m = 0; m < 4; ++m) { const int r = r0 + ai * HALF + m * 16;
                if (r < n_e) { const float w = wv[ai][m]; f32x4 o[2];
#pragma unroll
                    for (int n = 0; n < 2; ++n) { const f32x4 g = acc[ai][0][m][n], up = acc[ai][1][m][n];
#pragma unroll
                        for (int j = 0; j < 4; ++j) o[n][j] = w * silu_f(g[j]) * up[j]; }
                    u32x4 q; q.x = cvt_pk_bf16(o[0][0], o[0][1]); q.y = cvt_pk_bf16(o[0][2], o[0][3]); q.z = cvt_pk_bf16(o[1][0], o[1][1]); q.w = cvt_pk_bf16(o[1][2], o[1][3]);
                    *(u32x4*)(HID + (size_t)(u.p3 + r) * FF + col0) = q; } }
    }
};
struct EpiDown {
    static constexpr bool PERM = true;
    bf16* Y; LAS int* mm;
    __device__ __forceinline__ void operator()(const f32x4 (&acc)[2][2][4][2], const GU& u, int wr, int wc, int fr, int fq) const {
        const int e = u.p0, n_e = mm[e], r0 = u.p1 * BM + wr * 64 + fr, col0 = u.p2 * BM + wc * 32 + 8 * fq;
#pragma unroll
        for (int ai = 0; ai < 2; ++ai)
#pragma unroll
            for (int m = 0; m < 4; ++m) { const int r = r0 + ai * HALF + m * 16;
                if (r < n_e) {
#pragma unroll
                    for (int bj = 0; bj < 2; ++bj) { const f32x4 v0 = acc[ai][bj][m][0], v1 = acc[ai][bj][m][1];
                        u32x4 q; q.x = cvt_pk_bf16(v0[0], v0[1]); q.y = cvt_pk_bf16(v0[2], v0[3]); q.z = cvt_pk_bf16(v1[0], v1[1]); q.w = cvt_pk_bf16(v1[2], v1[3]);
                        *(u32x4*)(Y + (size_t)(u.p3 + r) * D + col0 + bj * HALF) = q; } } }
    }
};
}

__device__ __forceinline__ void fast_inproj(Frame& F) {
    pg::DenseSched S{(const char*)(F.ws + WS_WIN), D, T / 256, N_IN / 256, F.G, F.wg, TC / 256, T / 256, 4};
    pg::EpiInProj E{F.ws};
    pg::gemm_phase(F.lds, (const char*)(F.ws + WS_HB), D, S, E);
}
__device__ __forceinline__ void fast_outproj(Frame& F, size_t a_off, size_t w_off, const float* base, float* X, const float* gate, const float* bias) {
    pg::DenseSched S{(const char*)(F.ws + w_off), D, T / 256, D / 256, F.G, F.wg, 0, 0, 0};
    if (XBF16) {
        if (base == X) { pg::EpiResB<true> E{nullptr, (bf16*)(F.ws + WS_XB), gate, bias}; pg::gemm_phase(F.lds, (const char*)(F.ws + a_off), D, S, E); }
        else { pg::EpiResB<false> E{base, (bf16*)(F.ws + WS_XB), gate, bias}; pg::gemm_phase(F.lds, (const char*)(F.ws + a_off), D, S, E); }
    } else { pg::EpiRes E{base, X, gate, bias}; pg::gemm_phase(F.lds, (const char*)(F.ws + a_off), D, S, E); }
}
__device__ __forceinline__ void fast_pw1(Frame& F) {
    pg::DenseSched S{(const char*)(F.ws + WS_WPW1), D, T / 256, 2048 / 256, F.G, F.wg, 0, 0, 0};
    pg::EpiGLU E{(bf16*)(F.ws + WS_U), F.in[I_PW1B]};
    pg::gemm_phase(F.lds, (const char*)(F.ws + WS_HB), D, S, E);
}
__device__ __forceinline__ void fast_moe_gateup(Frame& F, int layer) {
    LAS int* mm = moe_map(F, layer);
    pg::MoeSched<true> S{(const char*)(F.ws + WS_WGU) + (size_t)layer * 16 * 1024 * 1024 * 2, (size_t)1024 * 1024 * 2, D, (const int*)(F.ws + WS_SLOTT) + layer * 16 * CAP, mm, F.G, F.wg};
    pg::EpiGateUp E{(bf16*)(F.ws + WS_HID), (const float*)(F.ws + WS_SLOTW) + layer * 16 * CAP, mm};
    pg::gemm_phase(F.lds, (const char*)(F.ws + WS_HB), D, S, E);
}
__device__ __forceinline__ void fast_moe_down(Frame& F, int layer) {
    LAS int* mm = moe_map(F, layer);
    pg::MoeSched<false> S{(const char*)(F.ws + WS_WDN) + (size_t)layer * 16 * 1024 * 512 * 2, (size_t)1024 * 512 * 2, FF, nullptr, mm, F.G, F.wg};
    pg::EpiDown E{(bf16*)(F.ws + WS_Y), mm};
    pg::gemm_phase(F.lds, (const char*)(F.ws + WS_HID), FF, S, E);
}


struct AttnBlk { const bf16* kp; const bf16* vp; int pitch; int kb; bool valid, masked; };
__device__ __forceinline__ AttnBlk attn_blk(const unsigned char* ws, int bi, int b, int kvh, int qs) {
    AttnBlk a;
    if (bi < 8) { a.kp = (const bf16*)(ws + WS_CK) + (size_t)(b * CL + bi * 32) * 128 + kvh * 64; a.vp = (const bf16*)(ws + WS_CV) + (size_t)(b * 2 + kvh) * 64 * CL + bi * 32; a.pitch = CL; a.kb = 0; a.valid = true; a.masked = false; }
    else { const int kb = qs - 128 + 32 * (bi - 8); a.valid = (kb >= 0 && kb < L); a.kb = kb; a.masked = true; a.pitch = L;
        a.kp = (const bf16*)(ws + WS_K) + (size_t)(b * L + kb) * 128 + kvh * 64; a.vp = (const bf16*)(ws + WS_V) + (size_t)(b * 2 + kvh) * 64 * L + kb; }
    return a;
}
__device__ __forceinline__ void attn_load(const AttnBlk& a, int r, int h, bf16x8 (&kf)[4], u32x4 (&vf)[2][2]) {
    if (a.valid) {
#pragma unroll
        for (int s = 0; s < 4; ++s) kf[s] = *(const bf16x8*)(a.kp + (size_t)r * 128 + 16 * s + 8 * h);
#pragma unroll
        for (int db = 0; db < 2; ++db)
#pragma unroll
            for (int ks = 0; ks < 2; ++ks) { const bf16* vr = a.vp + (size_t)(32 * db + r) * a.pitch + 16 * ks + 4 * h;
                const u32x2 lo = *(const u32x2*)vr, hi = *(const u32x2*)(vr + 8); vf[db][ks] = (u32x4){lo.x, lo.y, hi.x, hi.y}; }
    }
}
__device__ __forceinline__ void attn_compute(const AttnBlk& a, int qs, int r, int h, const bf16x8 (&kf)[4], const u32x4 (&vf)[2][2], const bf16x8 (&qf)[2][4],
                                             f32x16 (&o)[2][2], float (&m)[2], float (&l)[2]) {
    if (!a.valid) return;
#pragma unroll
    for (int nq = 0; nq < 2; ++nq) {
        f32x16 st;
#pragma unroll
        for (int i = 0; i < 16; ++i) st[i] = 0.f;
#pragma unroll
        for (int s = 0; s < 4; ++s) st = __builtin_amdgcn_mfma_f32_32x32x16_bf16(kf[s], qf[nq][s], st, 0, 0, 0);
        float t[16]; float tmax = -INFINITY;
        const int dbase = a.kb - qs - 32 * nq - r + 4 * h;
#pragma unroll
        for (int i = 0; i < 16; ++i) { float v = st[i] * (0.125f * 1.4426950408889634f);
            if (a.masked) { const int df = dbase + (i & 3) + 8 * (i >> 2); v = (df >= -128 && df <= 128) ? v : -INFINITY; }
            t[i] = v; tmax = fmaxf(tmax, v); }
        tmax = fmaxf(tmax, __shfl_xor(tmax, 32));
        const float mn = fmaxf(m[nq], tmax), alpha = __builtin_amdgcn_exp2f(m[nq] - mn); m[nq] = mn;
        float ps = 0.f;
#pragma unroll
        for (int i = 0; i < 16; ++i) { t[i] = __builtin_amdgcn_exp2f(t[i] - mn); ps += t[i]; }
        l[nq] = l[nq] * alpha + ps;
#pragma unroll
        for (int i = 0; i < 16; ++i) { o[0][nq][i] *= alpha; o[1][nq][i] *= alpha; }
        bf16x8 pf[2];
#pragma unroll
        for (int ks = 0; ks < 2; ++ks) { const u32x4 w = {pkbf(t[8 * ks], t[8 * ks + 1]), pkbf(t[8 * ks + 2], t[8 * ks + 3]), pkbf(t[8 * ks + 4], t[8 * ks + 5]), pkbf(t[8 * ks + 6], t[8 * ks + 7])};
            pf[ks] = __builtin_bit_cast(bf16x8, w); }
#pragma unroll
        for (int db = 0; db < 2; ++db)
#pragma unroll
            for (int ks = 0; ks < 2; ++ks) o[db][nq] = __builtin_amdgcn_mfma_f32_32x32x16_bf16(__builtin_bit_cast(bf16x8, vf[db][ks]), pf[ks], o[db][nq], 0, 0, 0);
    }
}
__device__ __forceinline__ void phase_attn_mfma(Frame& F) {
    const bf16* Q = (const bf16*)(F.ws + WS_Q); bf16* MIX = (bf16*)(F.ws + WS_MIX);
    const int g = F.wave >> 1, half = F.wave & 1, r = F.lane & 31, h = F.lane >> 5;
    for (int item = F.wg; item < NB * 2 * 64; item += F.G) {
        const int qb = item & 63, kvh = (item >> 6) & 1, b = item >> 7, hd = kvh * 4 + g, qs = qb * 128 + half * 64;
        bf16x8 qf[2][4];
#pragma unroll
        for (int nq = 0; nq < 2; ++nq)
#pragma unroll
            for (int s = 0; s < 4; ++s) qf[nq][s] = *(const bf16x8*)(Q + (size_t)(b * L + qs + 32 * nq + r) * 512 + hd * 64 + 16 * s + 8 * h);
        f32x16 o[2][2];
#pragma unroll
        for (int db = 0; db < 2; ++db)
#pragma unroll
            for (int nq = 0; nq < 2; ++nq)
#pragma unroll
                for (int i = 0; i < 16; ++i) o[db][nq][i] = 0.f;
        float m[2], l[2];
        m[0] = m[1] = F.in[I_SINK][hd] * 1.4426950408889634f; l[0] = l[1] = (h == 0) ? 1.f : 0.f;
        bf16x8 kfA[4], kfB[4]; u32x4 vfA[2][2], vfB[2][2];
        AttnBlk ba = attn_blk(F.ws, 0, b, kvh, qs), bb;
        attn_load(ba, r, h, kfA, vfA);
#pragma unroll 1
        for (int bi = 0; bi < 18; bi += 2) {
            bb = attn_blk(F.ws, bi + 1, b, kvh, qs); attn_load(bb, r, h, kfB, vfB);
            attn_compute(ba, qs, r, h, kfA, vfA, qf, o, m, l);
            if (bi + 2 < 18) { ba = attn_blk(F.ws, bi + 2, b, kvh, qs); attn_load(ba, r, h, kfA, vfA); }
            attn_compute(bb, qs, r, h, kfB, vfB, qf, o, m, l);
        }
#pragma unroll
        for (int nq = 0; nq < 2; ++nq) {
            const float lt = l[nq] + __shfl_xor(l[nq], 32), il = 1.f / lt;
            bf16* orow = MIX + (size_t)(b * L + qs + 32 * nq + r) * 1024 + 512 + hd * 64;
#pragma unroll
            for (int db = 0; db < 2; ++db)
#pragma unroll
                for (int i4 = 0; i4 < 4; ++i4) { u32x2 w; w.x = pkbf(o[db][nq][4 * i4] * il, o[db][nq][4 * i4 + 1] * il); w.y = pkbf(o[db][nq][4 * i4 + 2] * il, o[db][nq][4 * i4 + 3] * il);
                    *(u32x2*)(orow + 32 * db + 8 * i4 + 4 * h) = w; }
        }
    }
}


constexpr int AT_KP = 72, AT_VP = 136;
constexpr int AT_KB = 128 * AT_KP * 2, AT_BUF = AT_KB + 64 * AT_VP * 2;
struct AtChunk { const bf16* kg; const bf16* vg; int vpitch, lc, b, kvh, qb, c; bool valid, local, any; };
__device__ __forceinline__ AtChunk at_chunk(const unsigned char* ws, int seq, int wg, int G) {
    AtChunk k; const int item = wg + (seq / 5) * G; k.c = seq % 5; k.any = item < NB * 2 * 64;
    k.qb = item & 63; k.kvh = (item >> 6) & 1; k.b = (item >> 7) & 3; k.local = k.c >= 2; k.lc = k.c - 2;
    if (!k.local) { k.valid = k.any; k.vpitch = CL; k.kg = (const bf16*)(ws + WS_CK) + (size_t)(k.b * CL + 128 * k.c) * 128 + k.kvh * 64; k.vg = (const bf16*)(ws + WS_CV) + (size_t)(k.b * 2 + k.kvh) * 64 * CL + 128 * k.c; }
    else { const int key0 = 128 * k.qb - 128 + 128 * k.lc; k.valid = k.any && key0 >= 0 && key0 < L; k.vpitch = L;
        k.kg = (const bf16*)(ws + WS_K) + (size_t)(k.b * L + key0) * 128 + k.kvh * 64; k.vg = (const bf16*)(ws + WS_V) + (size_t)(k.b * 2 + k.kvh) * 64 * L + key0; }
    return k;
}
__device__ __forceinline__ void at_issue(const AtChunk& k, int tid, u32x4 (&rg)[4]) {
    if (k.valid) {
#pragma unroll
        for (int i = 0; i < 2; ++i) { const int id = tid + 512 * i; rg[i] = *(const u32x4*)(k.kg + (size_t)(id >> 3) * 128 + (id & 7) * 8); }
#pragma unroll
        for (int i = 0; i < 2; ++i) { const int id = tid + 512 * i; rg[2 + i] = *(const u32x4*)(k.vg + (size_t)(id >> 4) * k.vpitch + (id & 15) * 8); }
    }
}
__device__ __forceinline__ void at_write(const AtChunk& k, LAS unsigned char* buf, int tid, const u32x4 (&rg)[4]) {
    if (k.valid) {
#pragma unroll
        for (int i = 0; i < 2; ++i) { const int id = tid + 512 * i; *(LAS u32x4*)(buf + (id >> 3) * (AT_KP * 2) + (id & 7) * 16) = rg[i]; }
#pragma unroll
        for (int i = 0; i < 2; ++i) { const int id = tid + 512 * i; *(LAS u32x4*)(buf + AT_KB + (id >> 4) * (AT_VP * 2) + (id & 15) * 16) = rg[2 + i]; }
    }
}
__device__ __forceinline__ void at_load(LAS unsigned char* buf, int blk, int r, int h, bf16x8 (&kf)[4], u32x4 (&vf)[2][2]) {
#pragma unroll
    for (int s2 = 0; s2 < 4; ++s2) kf[s2] = *(const LAS bf16x8*)(buf + (32 * blk + r) * (AT_KP * 2) + (16 * s2 + 8 * h) * 2);
#pragma unroll
    for (int db = 0; db < 2; ++db)
#pragma unroll
        for (int ks = 0; ks < 2; ++ks) { const LAS unsigned char* vr = buf + AT_KB + (32 * db + r) * (AT_VP * 2) + (32 * blk + 16 * ks + 4 * h) * 2;
            const u32x2 lo = *(const LAS u32x2*)vr, hi = *(const LAS u32x2*)(vr + 16); vf[db][ks] = (u32x4){lo.x, lo.y, hi.x, hi.y}; }
}
__device__ __forceinline__ void at_math(const bf16x8 (&kf)[4], const u32x4 (&vf)[2][2], bool masked, int kbrel, int r, int h, const bf16x8 (&qf)[2][4], f32x16 (&o)[2][2], float (&m)[2], float (&l)[2]) {
    constexpr float C = 0.125f * 1.4426950408889634f;
#pragma unroll
    for (int nq = 0; nq < 2; ++nq) {
        f32x16 st;
#pragma unroll
        for (int i = 0; i < 16; ++i) st[i] = 0.f;
#pragma unroll
        for (int s2 = 0; s2 < 4; ++s2) st = __builtin_amdgcn_mfma_f32_32x32x16_bf16(kf[s2], qf[nq][s2], st, 0, 0, 0);
        if (masked) { const int dbase = kbrel - 32 * nq - r + 4 * h;
#pragma unroll
            for (int i = 0; i < 16; ++i) { const int df = dbase + (i & 3) + 8 * (i >> 2); st[i] = (df >= -128 && df <= 128) ? st[i] : -INFINITY; } }
        float smax = st[0];
#pragma unroll
        for (int i = 1; i < 16; ++i) smax = fmaxf(smax, st[i]);
        smax = fmaxf(smax, __shfl_xor(smax, 32));
        const float mn = fmaxf(m[nq], smax * C), alpha = __builtin_amdgcn_exp2f(m[nq] - mn); m[nq] = mn;
        float t[16]; float ps = 0.f;
#pragma unroll
        for (int i = 0; i < 16; ++i) { t[i] = __builtin_amdgcn_exp2f(__builtin_fmaf(st[i], C, -mn)); ps += t[i]; }
        l[nq] = l[nq] * alpha + ps;
        if (__ballot(alpha != 1.f)) {
#pragma unroll
            for (int i = 0; i < 16; ++i) { o[0][nq][i] *= alpha; o[1][nq][i] *= alpha; } }
        bf16x8 pf[2];
#pragma unroll
        for (int ks = 0; ks < 2; ++ks) { const u32x4 w = {pkbf(t[8 * ks], t[8 * ks + 1]), pkbf(t[8 * ks + 2], t[8 * ks + 3]), pkbf(t[8 * ks + 4], t[8 * ks + 5]), pkbf(t[8 * ks + 6], t[8 * ks + 7])};
            pf[ks] = __builtin_bit_cast(bf16x8, w); }
#pragma unroll
        for (int db = 0; db < 2; ++db)
#pragma unroll
            for (int ks = 0; ks < 2; ++ks) o[db][nq] = __builtin_amdgcn_mfma_f32_32x32x16_bf16(__builtin_bit_cast(bf16x8, vf[db][ks]), pf[ks], o[db][nq], 0, 0, 0);
    }
}
__device__ __forceinline__ void phase_attn_lds(Frame& F) {
    const bf16* Q = (const bf16*)(F.ws + WS_Q); bf16* MIX = (bf16*)(F.ws + WS_MIX);
    const int g = F.wave >> 1, half = F.wave & 1, r = F.lane & 31, h = F.lane >> 5;
    __syncthreads();
    u32x4 rg[4];
    AtChunk ck = at_chunk(F.ws, 0, F.wg, F.G);
    if (!ck.any) return;
    at_issue(ck, F.tid, rg); at_write(ck, F.lds, F.tid, rg);
    __syncthreads();
    bf16x8 qf[2][4]; f32x16 o[2][2]; float m[2], l[2];
#pragma unroll 1
    for (int seq = 0; ck.any; ++seq) {
        LAS unsigned char* buf = F.lds + (seq & 1) * AT_BUF;
        const AtChunk nk = at_chunk(F.ws, seq + 1, F.wg, F.G);
        at_issue(nk, F.tid, rg);
        const int hd = ck.kvh * 4 + g, qs = ck.qb * 128 + half * 64;
        if (ck.c == 0) {
#pragma unroll
            for (int nq = 0; nq < 2; ++nq)
#pragma unroll
                for (int s2 = 0; s2 < 4; ++s2) qf[nq][s2] = *(const bf16x8*)(Q + (size_t)(ck.b * L + qs + 32 * nq + r) * 512 + hd * 64 + 16 * s2 + 8 * h);
#pragma unroll
            for (int db = 0; db < 2; ++db)
#pragma unroll
                for (int nq = 0; nq < 2; ++nq)
#pragma unroll
                    for (int i = 0; i < 16; ++i) o[db][nq][i] = 0.f;
            m[0] = m[1] = F.in[I_SINK][hd] * 1.4426950408889634f; l[0] = l[1] = (h == 0) ? 1.f : 0.f;
        }
        if (ck.valid) {
            int b0 = 0, b1 = 4;
            if (ck.local) { b0 = 2 * half - 4 * ck.lc; b0 = b0 < 0 ? 0 : b0; b1 = 2 * half + 10 - 4 * ck.lc; b1 = b1 > 4 ? 4 : b1; }
            if (b0 < b1) {
                bf16x8 kfA[4], kfB[4]; u32x4 vfA[2][2], vfB[2][2];
                at_load(buf, b0, r, h, kfA, vfA);
#pragma unroll 1
                for (int blk = b0; blk < b1; blk += 2) {
                    const int iA = 4 * ck.lc + blk - 2 * half, iB = iA + 1;
                    if (blk + 1 < b1) at_load(buf, blk + 1, r, h, kfB, vfB);
                    at_math(kfA, vfA, ck.local && (iA < 2 || iA > 7), 32 * iA - 128, r, h, qf, o, m, l);
                    if (blk + 1 < b1) {
                        if (blk + 2 < b1) at_load(buf, blk + 2, r, h, kfA, vfA);
                        at_math(kfB, vfB, ck.local && (iB < 2 || iB > 7), 32 * iB - 128, r, h, qf, o, m, l);
                    }
                }
            }
        }
        if (ck.c == 4) {
#pragma unroll
            for (int nq = 0; nq < 2; ++nq) {
                const float lt = l[nq] + __shfl_xor(l[nq], 32), il = 1.f / lt;
                bf16* orow = MIX + (size_t)(ck.b * L + qs + 32 * nq + r) * 1024 + 512 + hd * 64;
#pragma unroll
                for (int db = 0; db < 2; ++db)
#pragma unroll
                    for (int i4 = 0; i4 < 4; ++i4) { u32x2 w; w.x = pkbf(o[db][nq][4 * i4] * il, o[db][nq][4 * i4 + 1] * il); w.y = pkbf(o[db][nq][4 * i4 + 2] * il, o[db][nq][4 * i4 + 3] * il);
                        *(u32x2*)(orow + 32 * db + 8 * i4 + 4 * h) = w; }
            }
        }
        at_write(nk, F.lds + ((seq + 1) & 1) * AT_BUF, F.tid, rg);
        __syncthreads();
        ck = nk;
    }
}

constexpr int F1_PC = 136, F1_PW = 68, F2_P = 264;
constexpr int F1_CSC = 0, F1_CSS = 128 * F1_PC * 2, F1_C64 = 2 * 128 * F1_PC * 2, F1_S64 = F1_C64 + 64 * F1_PW * 2;
__device__ __forceinline__ bf16x8 pack8(float a0, float a1, float a2, float a3, float a4, float a5, float a6, float a7) {
    const u32x4 w = {pkbf(a0, a1), pkbf(a2, a3), pkbf(a4, a5), pkbf(a6, a7)}; return __builtin_bit_cast(bf16x8, w); }
__device__ __forceinline__ void phase_fft1_mfma(Frame& F) {
    __syncthreads();
    LAS bf16* csc = (LAS bf16*)(F.lds + F1_CSC); LAS bf16* css = (LAS bf16*)(F.lds + F1_CSS); LAS bf16* c64 = (LAS bf16*)(F.lds + F1_C64); LAS bf16* s64 = (LAS bf16*)(F.lds + F1_S64);
    for (int i = F.tid; i < 128 * 128; i += NTHR) { const int n = i >> 7, k = i & 127; const float ang = (float)((n * k) & 127) * (6.283185307179586f / 128.f);
        csc[n * F1_PC + k] = (bf16)f2bf(__cosf(ang)); css[n * F1_PC + k] = (bf16)f2bf(__sinf(ang)); }
    for (int i = F.tid; i < 64 * 64; i += NTHR) { const int c = i >> 6, a = i & 63; const float ang = (float)((c * a) & 63) * (6.283185307179586f / 64.f);
        c64[c * F1_PW + a] = (bf16)f2bf(__cosf(ang)); s64[c * F1_PW + a] = (bf16)f2bf(__sinf(ang)); }
    __syncthreads();
    const bf16* UF = (const bf16*)(F.ws + WS_UF); bf16* Gb = (bf16*)(F.ws + WS_G);
    const int r = F.lane & 31, h = F.lane >> 5, g = F.wave >> 1;
    for (int item = F.wg; item < NB * FN2; item += F.G) {
        const int b = item >> 7, bp = item & 127;
#pragma unroll 1
        for (int q = 0; q < 2; ++q) {
            const int cbk = 2 * F.wave + q, n = 32 * (cbk & 3) + r, ch = 32 * cbk + r;
            f32x16 zr[2], zi[2];
#pragma unroll
            for (int rb = 0; rb < 2; ++rb) {
                bf16x8 uf[8];
#pragma unroll
                for (int s2 = 0; s2 < 8; ++s2) uf[s2] = *(const bf16x8*)(UF + (size_t)(b * L + 128 * (32 * rb + r) + bp) * 512 + g * 128 + 16 * s2 + 8 * h);
#pragma unroll
                for (int i = 0; i < 16; ++i) { zr[rb][i] = 0.f; zi[rb][i] = 0.f; }
#pragma unroll
                for (int s2 = 0; s2 < 8; ++s2) { const bf16x8 bc = *(const LAS bf16x8*)(csc + n * F1_PC + 16 * s2 + 8 * h), bs = *(const LAS bf16x8*)(css + n * F1_PC + 16 * s2 + 8 * h);
                    zr[rb] = __builtin_amdgcn_mfma_f32_32x32x16_bf16(uf[s2], bc, zr[rb], 0, 0, 0); zi[rb] = __builtin_amdgcn_mfma_f32_32x32x16_bf16(uf[s2], bs, zi[rb], 0, 0, 0); }
                __builtin_amdgcn_sched_barrier(0);
            }
            bf16x8 zfr[4], zfi[4];
#pragma unroll
            for (int ks = 0; ks < 4; ++ks) { const int rb = ks >> 1, o = 8 * (ks & 1);
                zfr[ks] = pack8(zr[rb][o], zr[rb][o + 1], zr[rb][o + 2], zr[rb][o + 3], zr[rb][o + 4], zr[rb][o + 5], zr[rb][o + 6], zr[rb][o + 7]);
                zfi[ks] = pack8(-zi[rb][o], -zi[rb][o + 1], -zi[rb][o + 2], -zi[rb][o + 3], -zi[rb][o + 4], -zi[rb][o + 5], -zi[rb][o + 6], -zi[rb][o + 7]); }
            __builtin_amdgcn_sched_barrier(0);
#pragma unroll 1
            for (int rbc = 0; rbc < 2; ++rbc) {
                f32x16 gr, gi; const int cr = 32 * rbc + r;
#pragma unroll
                for (int i = 0; i < 16; ++i) { gr[i] = 0.f; gi[i] = 0.f; }
#pragma unroll
                for (int ks = 0; ks < 4; ++ks) {
                    const u32x2 cl = *(const LAS u32x2*)(c64 + cr * F1_PW + 16 * ks + 4 * h), chh = *(const LAS u32x2*)(c64 + cr * F1_PW + 16 * ks + 8 + 4 * h);
                    const u32x2 sl = *(const LAS u32x2*)(s64 + cr * F1_PW + 16 * ks + 4 * h), shh = *(const LAS u32x2*)(s64 + cr * F1_PW + 16 * ks + 8 + 4 * h);
                    const u32x4 sw = {sl.x, sl.y, shh.x, shh.y}; const u32x4 swn = sw ^ 0x80008000u;
                    const bf16x8 wc = __builtin_bit_cast(bf16x8, ((u32x4){cl.x, cl.y, chh.x, chh.y})), wsn = __builtin_bit_cast(bf16x8, sw), wsm = __builtin_bit_cast(bf16x8, swn);
                    gr = __builtin_amdgcn_mfma_f32_32x32x16_bf16(wc, zfr[ks], gr, 0, 0, 0); gr = __builtin_amdgcn_mfma_f32_32x32x16_bf16(wsn, zfi[ks], gr, 0, 0, 0);
                    gi = __builtin_amdgcn_mfma_f32_32x32x16_bf16(wc, zfi[ks], gi, 0, 0, 0); gi = __builtin_amdgcn_mfma_f32_32x32x16_bf16(wsm, zfr[ks], gi, 0, 0, 0); }
                __builtin_amdgcn_sched_barrier(0);
#pragma unroll
                for (int i = 0; i < 16; ++i) { const int c = 32 * rbc + crow(i, h); const float ang = (float)(bp * c) * (6.283185307179586f / 8192.f), cs = __cosf(ang), sn = __sinf(ang);
                    const float re = gr[i] * cs + gi[i] * sn, im = gi[i] * cs - gr[i] * sn;
                    bf16* o = Gb + (size_t)((b * FN1 + c) * FN2 + bp) * 1024 + ch; o[0] = (bf16)f2bf(re); o[512] = (bf16)f2bf(im);
                    if ((i & 3) == 3) __builtin_amdgcn_sched_barrier(0); }
            }
        }
    }
    __syncthreads();
}
__device__ __forceinline__ void phase_fft2_mfma(Frame& F) {
    __syncthreads();
    LAS bf16* t2 = (LAS bf16*)F.lds;
    for (int i = F.tid; i < 128 * 256; i += NTHR) { const int d = i >> 8, k = i & 255; const float ang = (float)((d * (k & 127)) & 127) * (6.283185307179586f / 128.f);
        t2[d * F2_P + k] = (bf16)f2bf(k < 128 ? __cosf(ang) : __sinf(ang)); }
    __syncthreads();
    const bf16* Gb = (const bf16*)(F.ws + WS_G); bf16* MIX = (bf16*)(F.ws + WS_MIX);
    const int r = F.lane & 31, h = F.lane >> 5;
    for (int item = F.wg; item < NB * FN1; item += F.G) {
        const int b = item >> 6, c = item & 63;
        const bf16* Gp = Gb + (size_t)((b * FN1 + c) * FN2) * 1024 + 64 * F.wave + r;
        f32x16 y[4][2];
#pragma unroll
        for (int rb = 0; rb < 4; ++rb)
#pragma unroll
            for (int cb = 0; cb < 2; ++cb)
#pragma unroll
                for (int i = 0; i < 16; ++i) y[rb][cb][i] = 0.f;
#pragma unroll 1
        for (int ks = 0; ks < 16; ++ks) {
            const bf16* p = Gp + (size_t)(16 * (ks & 7) + 8 * h) * 1024 + (ks >> 3) * 512;
            bf16x8 bfr[2];
#pragma unroll
            for (int cb = 0; cb < 2; ++cb) { unsigned e[8];
#pragma unroll
                for (int j = 0; j < 8; ++j) e[j] = p[(size_t)j * 1024 + 32 * cb];
                const u32x4 w = {e[0] | (e[1] << 16), e[2] | (e[3] << 16), e[4] | (e[5] << 16), e[6] | (e[7] << 16)}; bfr[cb] = __builtin_bit_cast(bf16x8, w); }
#pragma unroll
            for (int rb = 0; rb < 4; ++rb) { const bf16x8 a = *(const LAS bf16x8*)(t2 + (32 * rb + r) * F2_P + 16 * ks + 8 * h);
#pragma unroll
                for (int cb = 0; cb < 2; ++cb) y[rb][cb] = __builtin_amdgcn_mfma_f32_32x32x16_bf16(a, bfr[cb], y[rb][cb], 0, 0, 0); }
        }
#pragma unroll
        for (int rb = 0; rb < 4; ++rb)
#pragma unroll
            for (int cb = 0; cb < 2; ++cb)
#pragma unroll
                for (int i = 0; i < 16; ++i) { const int d = 32 * rb + crow(i, h); MIX[(size_t)(b * L + c + 64 * d) * 1024 + 64 * F.wave + 32 * cb + r] = (bf16)f2bf(y[rb][cb][i] * (1.f / 1024.f)); }
    }
    __syncthreads();
}


typedef float f32x2_t __attribute__((ext_vector_type(2)));
template <int IR> struct DwIn {
    static __device__ __forceinline__ void run(const unsigned (&uin)[62], const f32x2_t (&w)[31], f32x2_t (&o)[32]) {
        const f32x2_t x = {bflo(uin[IR]), bfhi(uin[IR])};
#pragma unroll
        for (int r = 0; r < 32; ++r) { if (IR - r >= 0 && IR - r <= 30) o[r] += w[(IR - r >= 0 && IR - r <= 30) ? IR - r : 0] * x; }
        DwIn<IR + 1>::run(uin, w, o);
    }
};
template <> struct DwIn<62> { static __device__ __forceinline__ void run(const unsigned (&)[62], const f32x2_t (&)[31], f32x2_t (&)[32]) {} };
template <int IR> struct DwIn16 {
    static __device__ __forceinline__ void run(const unsigned (&uin)[46], const f32x2_t (&w)[31], f32x2_t (&o)[16]) {
        const f32x2_t x = {bflo(uin[IR]), bfhi(uin[IR])};
#pragma unroll
        for (int r = 0; r < 16; ++r) { if (IR - r >= 0 && IR - r <= 30) o[r] += w[(IR - r >= 0 && IR - r <= 30) ? IR - r : 0] * x; }
        DwIn16<IR + 1>::run(uin, w, o);
    }
};
template <> struct DwIn16<46> { static __device__ __forceinline__ void run(const unsigned (&)[46], const f32x2_t (&)[31], f32x2_t (&)[16]) {} };
__device__ __forceinline__ void phase_dwconv_fast(Frame& F) {
    const bf16* U = (const bf16*)(F.ws + WS_U); bf16* V1 = (bf16*)(F.ws + WS_V1);
    const float* dww = F.in[I_DWW];
    const int c0 = 2 * F.tid;
    f32x2_t w[31];
#pragma unroll
    for (int j = 0; j < 31; ++j) w[j] = *(const f32x2_t*)(dww + (size_t)j * D + c0);
    const f32x2_t bb = *(const f32x2_t*)(F.in[I_DWB] + c0), gg = *(const f32x2_t*)(F.in[I_LNG] + c0), lb = *(const f32x2_t*)(F.in[I_LNB] + c0);
    LAS float* red = (LAS float*)F.lds;
    LAS float* stat = red + 16 * 8 * 2;
    __syncthreads();
    for (int run = F.wg; run < T / 128; run += F.G) {
        const int row0 = run * 128, l0 = row0 & (L - 1);
        unsigned uin[46], nx[16];
#pragma unroll
        for (int ir = 0; ir < 46; ++ir) { const int l = l0 - 15 + ir; const bool ok = (l >= 0 && l < L);
            const unsigned u = *(const unsigned*)(U + (size_t)(ok ? row0 - 15 + ir : row0) * D + c0); uin[ir] = ok ? u : 0u; }
#pragma unroll 1
        for (int step = 0; step < 8; ++step) {
            const int r0 = row0 + 16 * step;
            if (step < 7) {
#pragma unroll
                for (int j = 0; j < 16; ++j) { const int l = l0 + 16 * step + 31 + j; const bool ok = l < L;
                    const unsigned u = *(const unsigned*)(U + (size_t)(ok ? r0 + 31 + j : r0) * D + c0); nx[j] = ok ? u : 0u; }
            }
            f32x2_t o[16];
#pragma unroll
            for (int r = 0; r < 16; ++r) o[r] = bb;
            DwIn16<0>::run(uin, w, o);
#pragma unroll
            for (int r = 0; r < 16; ++r) { const float sm = wave_sum(o[r].x + o[r].y), sq = wave_sum(o[r].x * o[r].x + o[r].y * o[r].y);
                if (F.lane == 0) { red[(r * 8 + F.wave) * 2] = sm; red[(r * 8 + F.wave) * 2 + 1] = sq; } }
            __syncthreads();
            if (F.tid < 16) { float sm = 0.f, sq = 0.f;
#pragma unroll
                for (int wv = 0; wv < 8; ++wv) { sm += red[(F.tid * 8 + wv) * 2]; sq += red[(F.tid * 8 + wv) * 2 + 1]; }
                const float mean = sm * (1.f / D), var = fmaxf(sq * (1.f / D) - mean * mean, 0.f);
                stat[2 * F.tid] = mean; stat[2 * F.tid + 1] = rsqrtf(var + EPS); }
            __syncthreads();
#pragma unroll
            for (int r = 0; r < 16; ++r) { const float mean = stat[2 * r], rstd = stat[2 * r + 1];
                const float y0 = silu_f((o[r].x - mean) * rstd * gg.x + lb.x), y1 = silu_f((o[r].y - mean) * rstd * gg.y + lb.y);
                *(unsigned*)(V1 + (size_t)(r0 + r) * D + c0) = pkbf(y0, y1); }
#pragma unroll
            for (int i = 0; i < 30; ++i) uin[i] = uin[i + 16];
#pragma unroll
            for (int j = 0; j < 16; ++j) uin[30 + j] = nx[j];
        }
        __syncthreads();
    }
}

namespace pg {
struct MU { const char* B; const char* A; int K, type, e, rt, pn, hb; };
struct MoeMergedSched {
    const char* Wgu; const char* Wdn; const char* HBp; const char* HIDp; const int* list; LAS int* mm; unsigned* tcnt; unsigned* tmo; int G, c, U;
    __device__ __forceinline__ bool flat(int L, int type, MU& u) const {
        for (int e = 0; e < 16; ++e) { const int n = mm[e], nu = ((n + 255) >> 8) * 4;
            if (L < nu) { u.e = e; u.rt = L >> 2; u.pn = L & 3; u.hb = mm[16 + e]; u.type = type;
                if (type == 0) { u.K = D; u.A = HBp; u.B = Wgu + (size_t)e * (1024 * 1024 * 2) + (size_t)u.pn * BM * D * 2; }
                else { u.K = FF; u.A = HIDp; u.B = Wdn + (size_t)e * (1024 * 512 * 2) + (size_t)u.pn * BM * FF * 2; }
                return true; }
            L -= nu; }
        return false;
    }
    __device__ __forceinline__ bool next(int i, MU& u) const {
        const int ngu = c < U ? (U - 1 - c) / G + 1 : 0;
        if (i < ngu) return flat(i * G + c, 0, u);
        const int k = i - ngu, x = U % G; int j;
        if (c >= x) { if (k == 0) j = c - x; else j = (G - 1 - c) + (k - 1) * G + (G - x); } else j = (G - 1 - c) + k * G + (G - x);
        if (j >= U) return false;
        return flat(j, 1, u);
    }
    __device__ __forceinline__ unsigned voff(const MU& u, int buf, LAS unsigned char* lds, int R, int C) const {
        if (u.type == 0) { const int tok = ((const LAS int*)(lds + TAB_OFF))[buf * 256 + R]; return (unsigned)((tok * D + C) * 2); }
        return (unsigned)(((u.hb + u.rt * BM + R) * FF + C) * 2);
    }
    __device__ __forceinline__ void stage_table(const MU& u, int buf, LAS unsigned char* lds, int wid, int lane) const {
        const int r = (wid & 3) * 64 + lane;
        __builtin_amdgcn_global_load_lds((const unsigned*)(list + u.e * CAP + u.rt * BM + r), (LAS unsigned*)(lds + TAB_OFF + buf * 1024 + (wid & 3) * 256), 4, 0, 0);
    }
    __device__ __forceinline__ unsigned* tile_word(const MU& u) const { return tcnt + ((u.hb >> 8) + u.rt) * 64; }
    __device__ __forceinline__ void wait_ready(const MU& u, int wid) const {
        if (wid == 0) {
            unsigned* w = tile_word(u); unsigned spins = 0;
            while ((unsigned)__builtin_amdgcn_readfirstlane(__hip_atomic_load(w, __ATOMIC_RELAXED, __HIP_MEMORY_SCOPE_AGENT)) < 32u) {
                __builtin_amdgcn_s_sleep(2);
                if ((++spins & 255u) == 0u) { if (__builtin_amdgcn_readfirstlane(__hip_atomic_load(tmo, __ATOMIC_RELAXED, __HIP_MEMORY_SCOPE_AGENT)) != 0u) break;
                    if (spins > (1u << 20)) { __hip_atomic_store(tmo, 1u, __ATOMIC_RELAXED, __HIP_MEMORY_SCOPE_AGENT); break; } } }
            __builtin_amdgcn_fence(__ATOMIC_ACQUIRE, "agent");
            asm volatile("s_waitcnt vmcnt(0)" ::: "memory");
        }
        asm volatile("" ::: "memory"); __builtin_amdgcn_s_barrier(); asm volatile("" ::: "memory");
    }
};
struct EpiGateUpWT {
    __amdgpu_buffer_rsrc_t rsrc; const float* slot_w; LAS int* mm;
    __device__ __forceinline__ void operator()(const f32x4 (&acc)[2][2][4][2], const MU& u, int wr, int wc, int fr, int fq) const {
        const int e = u.e, n_e = mm[e], r0 = u.rt * BM + wr * 64 + fr, col0 = u.pn * HALF + wc * 32 + 8 * fq;
        float wv[2][4];
#pragma unroll
        for (int ai = 0; ai < 2; ++ai)
#pragma unroll
            for (int m = 0; m < 4; ++m) wv[ai][m] = slot_w[e * CAP + r0 + ai * HALF + m * 16];
#pragma unroll
        for (int ai = 0; ai < 2; ++ai)
#pragma unroll
            for (int m = 0; m < 4; ++m) { const int r = r0 + ai * HALF + m * 16;
                if (r < n_e) { const float w = wv[ai][m]; f32x4 o[2];
#pragma unroll
                    for (int n = 0; n < 2; ++n) { const f32x4 g = acc[ai][0][m][n], up = acc[ai][1][m][n];
#pragma unroll
                        for (int j = 0; j < 4; ++j) o[n][j] = w * silu_f(g[j]) * up[j]; }
                    u32x4 q; q.x = cvt_pk_bf16(o[0][0], o[0][1]); q.y = cvt_pk_bf16(o[0][2], o[0][3]); q.z = cvt_pk_bf16(o[1][0], o[1][1]); q.w = cvt_pk_bf16(o[1][2], o[1][3]);
                    __builtin_amdgcn_raw_buffer_store_b128(q, rsrc, (unsigned)(((u.hb + r) * FF + col0) * 2), 0, 16); } }
    }
};
struct EpiDownM {
    bf16* Y; LAS int* mm;
    __device__ __forceinline__ void operator()(const f32x4 (&acc)[2][2][4][2], const MU& u, int wr, int wc, int fr, int fq) const {
        const int e = u.e, n_e = mm[e], r0 = u.rt * BM + wr * 64 + fr, col0 = u.pn * BM + wc * 32 + 8 * fq;
#pragma unroll
        for (int ai = 0; ai < 2; ++ai)
#pragma unroll
            for (int m = 0; m < 4; ++m) { const int r = r0 + ai * HALF + m * 16;
                if (r < n_e) {
#pragma unroll
                    for (int bj = 0; bj < 2; ++bj) { const f32x4 v0 = acc[ai][bj][m][0], v1 = acc[ai][bj][m][1];
                        u32x4 q; q.x = cvt_pk_bf16(v0[0], v0[1]); q.y = cvt_pk_bf16(v0[2], v0[3]); q.z = cvt_pk_bf16(v1[0], v1[1]); q.w = cvt_pk_bf16(v1[2], v1[3]);
                        *(u32x4*)(Y + (size_t)(u.hb + r) * D + col0 + bj * HALF) = q; } } }
    }
};
__device__ __forceinline__ void gemm_phase_moe(LAS unsigned char* lds, const MoeMergedSched& S, const EpiGateUpWT& EA, const EpiDownM& EB) {
    const int tid = threadIdx.x, wid = __builtin_amdgcn_readfirstlane(tid >> 6), lane = tid & 63, wr = wid >> 2, wc = wid & 3, fr = lane & 15, fq = lane >> 4;
    int sR[2], sC[2]; unsigned vbA[2], vbD[2];
#pragma unroll
    for (int i = 0; i < 2; ++i) { int R, C; stage_rc(tid * 16 + i * 8192, R, C); sR[i] = R; sC[i] = C; const int Rb = (R & ~31) + perm32(R & 31);
        vbA[i] = (unsigned)(Rb * D + C) * 2u; vbD[i] = (unsigned)(Rb * FF + C) * 2u; }
    const size_t kstep = (size_t)(BK * 2);
    const unsigned ldsw = (unsigned)wid * 1024u;
    const int aoff = lds_byte(wr * 64 + fr, fq * 8), boff = lds_byte(wc * 32 + fr, fq * 8);
#define PG_SA(b, h) (((b) * 2 + (h)) * HTB)
#define PG_SB(b, h) ((4 + (b) * 2 + (h)) * HTB)
#define PG_STAGE(bufoff, gbase, voff) do { _Pragma("unroll") for (int _i = 0; _i < 2; ++_i) \
        __builtin_amdgcn_global_load_lds((const unsigned*)((const char*)(gbase) + (voff)[_i]), (LAS unsigned*)(lds + (bufoff) + ldsw + _i * 8192), 16, 0, 0); } while (0)
#define PG_LDA(dst, b, h) do { _Pragma("unroll") for (int m = 0; m < 4; ++m) _Pragma("unroll") for (int k = 0; k < 2; ++k) dst[m][k] = *(const LAS bf16x8*)(lds + PG_SA(b, h) + aoff + m * 2048 + k * 1024); } while (0)
#define PG_LDB(dst, b, h) do { _Pragma("unroll") for (int n = 0; n < 2; ++n) _Pragma("unroll") for (int k = 0; k < 2; ++k) dst[n][k] = *(const LAS bf16x8*)(lds + PG_SB(b, h) + boff + n * 2048 + k * 1024); } while (0)
#define PG_MMA(ai, bj, At, Bt) do { __builtin_amdgcn_s_setprio(1); _Pragma("unroll") for (int m = 0; m < 4; ++m) _Pragma("unroll") for (int n = 0; n < 2; ++n) _Pragma("unroll") for (int k = 0; k < 2; ++k) \
        acc[ai][bj][m][n] = __builtin_amdgcn_mfma_f32_16x16x32_bf16(Bt[n][k], At[m][k], acc[ai][bj][m][n], 0, 0, 0); __builtin_amdgcn_s_setprio(0); } while (0)
#define PG_WAIT_V(n) asm volatile("s_waitcnt vmcnt(" #n ")" ::: "memory")
#define PG_WAIT_L(n) asm volatile("s_waitcnt lgkmcnt(" #n ")" ::: "memory")
#define PG_BAR __builtin_amdgcn_s_barrier()
#define PG_SCHED __builtin_amdgcn_sched_barrier(0)
    MU cur, nxt; int ui = 0;
    if (!S.next(0, cur)) return;
    f32x4 acc[2][2][4][2];
#pragma unroll
    for (int a = 0; a < 2; ++a)
#pragma unroll
        for (int b = 0; b < 2; ++b)
#pragma unroll
            for (int m = 0; m < 4; ++m)
#pragma unroll
                for (int n = 0; n < 2; ++n) acc[a][b][m][n] = (f32x4){0.f, 0.f, 0.f, 0.f};
    bf16x8 At[4][2], B0[2][2], B1[2][2];
    if (cur.type == 0) { S.stage_table(cur, 0, lds, wid, lane); PG_WAIT_V(0); PG_BAR; } else S.wait_ready(cur, wid);
    unsigned voC[2][2], voN[2][2];
#pragma unroll
    for (int h = 0; h < 2; ++h)
#pragma unroll
        for (int i = 0; i < 2; ++i) { voC[h][i] = S.voff(cur, 0, lds, h * HALF + sR[i], sC[i]); voN[h][i] = voC[h][i]; }
    const char* cB = cur.B; const char* cA = cur.A; size_t hsC = (size_t)HALF * cur.K * 2; int nt = cur.K / BK;
    if (cur.type == 0) { PG_STAGE(PG_SB(0, 0), cB, vbA); PG_STAGE(PG_SB(0, 1), cB + hsC, vbA); } else { PG_STAGE(PG_SB(0, 0), cB, vbD); PG_STAGE(PG_SB(0, 1), cB + hsC, vbD); }
    PG_STAGE(PG_SA(0, 0), cA, voC[0]); PG_STAGE(PG_SA(0, 1), cA, voC[1]);
    if (wr == 1) PG_BAR;
    PG_WAIT_V(2); PG_BAR;
    if (cur.type == 0) { PG_STAGE(PG_SB(1, 0), cB + kstep, vbA); } else { PG_STAGE(PG_SB(1, 0), cB + kstep, vbD); }
    PG_STAGE(PG_SA(1, 0), cA + kstep, voC[0]);
    if (cur.type == 0) { PG_STAGE(PG_SB(1, 1), cB + hsC + kstep, vbA); } else { PG_STAGE(PG_SB(1, 1), cB + hsC + kstep, vbD); }
    PG_WAIT_V(6); PG_BAR;
    for (;;) {
        const bool has_next = S.next(ui + 1, nxt);
        if (has_next && nxt.type == 0) S.stage_table(nxt, (ui + 1) & 1, lds, wid, lane);
        const char* nB = has_next ? nxt.B : cB; const char* nA = has_next ? nxt.A : cA; const size_t hsN = has_next ? (size_t)HALF * nxt.K * 2 : hsC;
        for (int t = 0; t < nt; t += 2) {
            const bool last = (t == nt - 2);
            if (last && has_next) {
                if (nxt.type == 1) S.wait_ready(nxt, wid);
#pragma unroll
                for (int h = 0; h < 2; ++h)
#pragma unroll
                    for (int i = 0; i < 2; ++i) voN[h][i] = S.voff(nxt, (ui + 1) & 1, lds, h * HALF + sR[i], sC[i]);
            }
            unsigned vo2[2][2], vb2[2]; const bool b2gu = last ? (has_next ? nxt.type == 0 : cur.type == 0) : (cur.type == 0);
#pragma unroll
            for (int h = 0; h < 2; ++h)
#pragma unroll
                for (int i = 0; i < 2; ++i) vo2[h][i] = last ? voN[h][i] : voC[h][i];
#pragma unroll
            for (int i = 0; i < 2; ++i) vb2[i] = b2gu ? vbA[i] : vbD[i];
            const size_t hs2 = last ? hsN : hsC;
            const char* a1 = cA + (size_t)(t + 1) * kstep;
            const char* a2 = last ? nA : cA + (size_t)(t + 2) * kstep; const char* b2 = last ? nB : cB + (size_t)(t + 2) * kstep;
            const char* a3 = a2 + kstep; const char* b3 = b2 + kstep;
            PG_LDB(B0, 0, 0); PG_LDB(B1, 0, 1); PG_SCHED; PG_LDA(At, 0, 0); PG_STAGE(PG_SA(1, 1), a1, voC[1]);
            PG_WAIT_V(8); PG_WAIT_L(0); PG_BAR; PG_MMA(0, 0, At, B0); PG_MMA(0, 1, At, B1); PG_BAR; PG_SCHED;
            PG_LDA(At, 0, 1); PG_STAGE(PG_SB(0, 0), b2, vb2); PG_STAGE(PG_SB(0, 1), b2 + hs2, vb2); PG_STAGE(PG_SA(0, 0), a2, vo2[0]);
            PG_WAIT_V(8); PG_WAIT_L(0); PG_BAR; PG_MMA(1, 0, At, B0); PG_MMA(1, 1, At, B1); PG_BAR; PG_SCHED;
            PG_LDB(B0, 1, 0); PG_LDB(B1, 1, 1); PG_SCHED; PG_LDA(At, 1, 0); PG_STAGE(PG_SA(0, 1), a2, vo2[1]);
            PG_WAIT_V(8); PG_WAIT_L(0); PG_BAR; PG_MMA(0, 0, At, B0); PG_MMA(0, 1, At, B1); PG_BAR; PG_SCHED;
            PG_LDA(At, 1, 1); PG_STAGE(PG_SB(1, 0), b3, vb2); PG_STAGE(PG_SB(1, 1), b3 + hs2, vb2); PG_STAGE(PG_SA(1, 0), a3, vo2[0]);
            PG_WAIT_V(8); PG_WAIT_L(0); PG_BAR; PG_MMA(1, 0, At, B0); PG_MMA(1, 1, At, B1); PG_BAR; PG_SCHED;
        }
        if (wr == 0) PG_BAR;
        if (cur.type == 0) { EA(acc, cur, wr, wc, fr, fq);
            PG_WAIT_V(0);
            if (lane == 0) __hip_atomic_fetch_add(S.tile_word(cur), 1u, __ATOMIC_RELAXED, __HIP_MEMORY_SCOPE_AGENT); }
        else EB(acc, cur, wr, wc, fr, fq);
        if (!has_next) break;
#pragma unroll
        for (int a = 0; a < 2; ++a)
#pragma unroll
            for (int b = 0; b < 2; ++b)
#pragma unroll
                for (int m = 0; m < 4; ++m)
#pragma unroll
                    for (int n = 0; n < 2; ++n) acc[a][b][m][n] = (f32x4){0.f, 0.f, 0.f, 0.f};
        cur = nxt; cB = nB; cA = nA; hsC = hsN; nt = cur.K / BK; ++ui;
#pragma unroll
        for (int h = 0; h < 2; ++h)
#pragma unroll
            for (int i = 0; i < 2; ++i) voC[h][i] = voN[h][i];
        if (wr == 1) PG_BAR;
    }
    PG_WAIT_V(0);
    PG_BAR;
#undef PG_SA
#undef PG_SB
#undef PG_STAGE
#undef PG_LDA
#undef PG_LDB
#undef PG_MMA
#undef PG_WAIT_V
#undef PG_WAIT_L
#undef PG_BAR
#undef PG_SCHED
}
}
__device__ __forceinline__ void fast_moe_merged(Frame& F, int layer) {
    LAS int* mm = moe_map(F, layer);
    int U = 0;
    for (int e = 0; e < 16; ++e) U += ((mm[e] + 255) >> 8) * 4;
    pg::MoeMergedSched S{(const char*)(F.ws + WS_WGU) + (size_t)layer * 16 * 1024 * 1024 * 2, (const char*)(F.ws + WS_WDN) + (size_t)layer * 16 * 1024 * 512 * 2,
                         (const char*)(F.ws + WS_HB), (const char*)(F.ws + WS_HID), (const int*)(F.ws + WS_SLOTT) + layer * 16 * CAP, mm,
                         F.ctl + CW_TILE + layer * 288 * 64, F.ctl + CW_TMO2, F.G, F.wg, U};
    pg::EpiGateUpWT EA{__builtin_amdgcn_make_buffer_rsrc((void*)(F.ws + WS_HID), 0, HROWS * FF * 2, 0x00020000), (const float*)(F.ws + WS_SLOTW) + layer * 16 * CAP, mm};
    pg::EpiDownM EB{(bf16*)(F.ws + WS_Y), mm};
    pg::gemm_phase_moe(F.lds, S, EA, EB);
}

constexpr int NPH = 18;
__global__ void __launch_bounds__(NTHR, 2) mega(Args args) {
    extern __shared__ __attribute__((aligned(16))) unsigned char lds[];
    Frame F;
    F.lds = (LAS unsigned char*)lds;
    F.tid = threadIdx.x; F.lane = F.tid & 63; F.wave = __builtin_amdgcn_readfirstlane(F.tid >> 6);
    F.G = gridDim.x; F.wg = blockIdx.x;
    F.in = args.in; F.out = args.out; F.ws = args.ws; F.ctl = (unsigned*)(args.ws + WS_CTL);
    volatile LAS unsigned* bst = (volatile LAS unsigned*)(F.lds + LDS_BYTES - 16);
    if (F.tid < 4) bst[F.tid] = 0u;
    __syncthreads();
    const int lo = args.ph_lo, hi = args.ph_hi;
    XcdBarrier bar; bar.bar = F.ctl + CW_BAR; bar.x = 0; bar.st = bst;
    if (hi - lo > 1) bar = xcd_barrier_post(F.ctl + CW_BAR, bst);
#define IN(k) (lo <= (k) && (k) < hi)
#define SEAM(k) do { if (IN(k) && IN((k) + 1)) xcd_barrier(bar); } while (0)
    const float* mod = (const float*)(F.ws + WS_MOD);

#ifndef DBL_MASK
#define DBL_MASK 0x0u
#endif
#define RUN(k, body) do { if (IN(k)) { _Pragma("unroll 1") for (int _r = 0; _r < ((((DBL_MASK) >> (k)) & 1u) ? 2 : 1); ++_r) { if (_r) xcd_barrier(bar); F.lane = fresh_lane(); body; } } } while (0)
    RUN(0, phase_prep(F)); SEAM(0);
    RUN(1, phase_norm1_l0(F)); SEAM(1);
    RUN(2, if (FAST_GEMM) fast_inproj(F); else phase_inproj(F)); SEAM(2);
    if (IN(3)) { F.lane = fresh_lane();
#pragma unroll 1
        for (int _r = 0; _r < ((DBL_MASK & 0x100000u) ? 2 : 1); ++_r) { if (FAST_ATTN == 2 && FAST_GEMM) phase_attn_lds(F); else if (FAST_ATTN && FAST_GEMM) phase_attn_mfma(F); else phase_attn_simple(F); }
#pragma unroll 1
        for (int _r = 0; _r < ((DBL_MASK & 0x200000u) ? 2 : 1); ++_r) { if (FAST_FFT) phase_fft1_mfma(F); else phase_fft1_simple(F); }
    } SEAM(3);
    RUN(4, if (FAST_FFT) phase_fft2_mfma(F); else phase_fft2_simple(F)); SEAM(4);
    if (IN(5)) { if (!FAST_FFT) phase_fft3_simple(F); } if (!FAST_FFT) SEAM(5);
    RUN(6, if (FAST_GEMM) fast_outproj(F, WS_MIX, WS_WOUT, F.in[I_X], F.out, mod + 2048, nullptr); else phase_outproj(F, (const bf16*)(F.ws + WS_MIX), (const bf16*)(F.ws + WS_WOUT), F.in[I_X], F.out, mod + 2048, nullptr)); SEAM(6);
    if (IN(7)) { F.lane = fresh_lane(); phase_norm2_route(F, 0); } SEAM(7);
    if (MOE_MERGED && FAST_GEMM) { if (IN(8)) { F.lane = fresh_lane(); fast_moe_merged(F, 0); } if (IN(8) && IN(10)) xcd_barrier(bar); }
    else { RUN(8, if (FAST_GEMM) fast_moe_gateup(F, 0); else phase_moe_gateup(F, 0)); SEAM(8);
    RUN(9, if (FAST_GEMM) fast_moe_down(F, 0); else phase_moe_down(F, 0)); SEAM(9); }
    if (IN(10)) { F.lane = fresh_lane(); phase_combine<false>(F, 0); } SEAM(10);
    RUN(11, if (FAST_GEMM) fast_pw1(F); else phase_pw1(F)); SEAM(11);
    RUN(12, phase_dwconv_fast(F)); SEAM(12);
    if (IN(13)) { F.lane = fresh_lane(); if (FAST_GEMM) fast_outproj(F, WS_V1, WS_WPW2, F.out, F.out, mod + 5 * 6144 + 2048, F.in[I_PW2B]); else phase_outproj(F, (const bf16*)(F.ws + WS_V1), (const bf16*)(F.ws + WS_WPW2), F.out, F.out, mod + 5 * 6144 + 2048, F.in[I_PW2B]); } SEAM(13);
    if (IN(14)) { F.lane = fresh_lane(); phase_norm2_route(F, 1); } SEAM(14);
    if (MOE_MERGED && FAST_GEMM) { if (IN(15)) { F.lane = fresh_lane(); fast_moe_merged(F, 1); } if (IN(15) && IN(17)) xcd_barrier(bar); }
    else { RUN(15, if (FAST_GEMM) fast_moe_gateup(F, 1); else phase_moe_gateup(F, 1)); SEAM(15);
    RUN(16, if (FAST_GEMM) fast_moe_down(F, 1); else phase_moe_down(F, 1)); SEAM(16); }
    if (IN(17)) { F.lane = fresh_lane(); phase_combine<true>(F, 1); }
#undef RUN
#undef IN
#undef SEAM
}

extern "C" void kernel_launch(void* const* d_in, const int* in_sizes, int n_in, void* d_out, int out_size, void* d_ws, size_t ws_size, hipStream_t stream) {
    static int grid = 0;
    if (grid == 0) {
        if (n_in != 25 || out_size != T * D || ws_size < WS_END) { fprintf(stderr, "kernel_launch: unexpected shapes (n_in %d out %d ws %zu)\n", n_in, out_size, ws_size); grid = -1; return; }
        int dev = 0, cus = 0, per_cu = 0;
        if (hipGetDevice(&dev) != hipSuccess || hipDeviceGetAttribute(&cus, hipDeviceAttributeMultiprocessorCount, dev) != hipSuccess) { grid = -1; return; }
        if (hipFuncSetAttribute((const void*)mega, hipFuncAttributeMaxDynamicSharedMemorySize, LDS_BYTES) != hipSuccess) { fprintf(stderr, "kernel_launch: hipFuncSetAttribute failed\n"); grid = -1; return; }
        if (hipOccupancyMaxActiveBlocksPerMultiprocessor(&per_cu, (const void*)mega, NTHR, LDS_BYTES) != hipSuccess || per_cu < 1) { fprintf(stderr, "kernel_launch: occupancy query says %d\n", per_cu); }
        (void)hipGetLastError();
        grid = cus;
    }
    if (grid < 0) return;
    (void)hipMemsetAsync((char*)d_ws + WS_CTL, 0, CTL_BYTES, stream);
    Args a{};
    for (int i = 0; i < 25; ++i) a.in[i] = (const float*)d_in[i];
    a.out = (float*)d_out; a.ws = (unsigned char*)d_ws;
#if MK_ONE_LAUNCH
    a.ph_lo = 0; a.ph_hi = NPH;
    hipLaunchKernelGGL(mega, dim3(grid), dim3(NTHR), LDS_BYTES, stream, a);
#else
#ifndef PROBE_PHASE
#define PROBE_PHASE -1
#endif
    for (int p = 0; p < NPH; ++p) { a.ph_lo = p; a.ph_hi = p + 1; hipLaunchKernelGGL(mega, dim3(grid), dim3(NTHR), LDS_BYTES, stream, a);
        if (p == PROBE_PHASE) { if (p == 7 || p == 14) (void)hipMemsetAsync((char*)d_ws + WS_CTL, 0, CTL_BYTES, stream);
            hipLaunchKernelGGL(mega, dim3(grid), dim3(NTHR), LDS_BYTES, stream, a); } }
#endif
}
```

```cpp
#include <hip/hip_runtime.h>
#include <cstdio>

#ifndef MK_ONE_LAUNCH
#define MK_ONE_LAUNCH 1
#endif

#define GAS __attribute__((address_space(1)))
#define LAS __attribute__((address_space(3)))
typedef unsigned short bf16;
typedef short bf16x8 __attribute__((ext_vector_type(8)));
typedef float f32x4 __attribute__((ext_vector_type(4)));
typedef float f32x16 __attribute__((ext_vector_type(16)));
typedef unsigned u32x4 __attribute__((ext_vector_type(4)));
typedef unsigned u32x2 __attribute__((ext_vector_type(2)));

constexpr int D = 1024, NB = 4, L = 8192, T = NB * L, CL = 256, TC = NB * CL;
constexpr int NE = 16, FF = 512, CONVW = 31;
constexpr int N_IN = 1280;
constexpr int FN1 = 64, FN2 = 128;
#ifndef FAST_GEMM
#define FAST_GEMM 1
#endif
#ifndef MOE_MERGED
#define MOE_MERGED 1
#endif
#ifndef XBF16
#define XBF16 FAST_GEMM
#endif
#ifndef FAST_ATTN
#define FAST_ATTN 2
#endif
#ifndef FAST_FFT
#define FAST_FFT 1
#endif
constexpr int IL = FAST_GEMM ? 128 : 32;
constexpr float EPS = 1e-6f;
constexpr int NWAVES = 8, NTHR = 512;
constexpr int CAP = 32768;
constexpr int HROWS = 65536 + 4096;

constexpr size_t MiB = 1u << 20;
constexpr size_t WS_CTL = 0, CTL_BYTES = 1 * MiB;
constexpr size_t WS_MOD = 1 * MiB;
constexpr size_t WS_TW = 1 * MiB + 512 * 1024;
constexpr size_t WS_WIN = 2 * MiB, WS_WOUT = 6 * MiB, WS_WPW1 = 10 * MiB, WS_WPW2 = 14 * MiB;
constexpr size_t WS_WGU = 16 * MiB, WS_WDN = 80 * MiB;
constexpr size_t WS_TOKE = 112 * MiB, WS_TOKP = 113 * MiB, WS_TOKW = 114 * MiB;
constexpr size_t WS_SLOTT = 116 * MiB, WS_SLOTW = 120 * MiB;
constexpr size_t WS_HB = 128 * MiB;
constexpr size_t WS_UF = 196 * MiB, WS_Q = 228 * MiB, WS_K = 260 * MiB, WS_V = 268 * MiB, WS_CK = 276 * MiB, WS_CV = 277 * MiB;
constexpr size_t WS_G = 280 * MiB, WS_MIX = 344 * MiB, WS_AB = 408 * MiB;
constexpr size_t WS_XB = 408 * MiB;
constexpr size_t WS_HID = 196 * MiB, WS_Y = 264 * MiB;
constexpr size_t WS_U = 196 * MiB, WS_V1 = 260 * MiB;
constexpr size_t WS_END = 472 * MiB;
constexpr int CW_BAR = 4096;
constexpr int CW_CNT = 8192;
constexpr int CW_TILE = 16384;
constexpr int CW_TMO2 = 2048;

constexpr int LDS_BYTES = 147456;

__device__ __forceinline__ unsigned f2bf(float f) { unsigned u = __float_as_uint(f); return (u + 0x7fffu + ((u >> 16) & 1u)) >> 16; }
__device__ __forceinline__ float bf2f(unsigned b) { return __uint_as_float(b << 16); }
typedef __bf16 b16x2_t __attribute__((ext_vector_type(2)));
__device__ __forceinline__ unsigned pkbf(float a, float b) { typedef float f2 __attribute__((ext_vector_type(2))); f2 v = {a, b}; return __builtin_bit_cast(unsigned, __builtin_convertvector(v, b16x2_t)); }
__device__ __forceinline__ unsigned pk2(float lo, float hi) { return pkbf(lo, hi); }
__device__ __forceinline__ float bflo(unsigned w) { return __uint_as_float(w << 16); }
__device__ __forceinline__ float bfhi(unsigned w) { return __uint_as_float(w & 0xffff0000u); }
__device__ __forceinline__ float wave_sum(float v) {
    v += __builtin_bit_cast(float, __builtin_amdgcn_mov_dpp(__builtin_bit_cast(int, v), 0xB1, 0xf, 0xf, true));
    v += __builtin_bit_cast(float, __builtin_amdgcn_mov_dpp(__builtin_bit_cast(int, v), 0x4E, 0xf, 0xf, true));
    v += __builtin_bit_cast(float, __builtin_amdgcn_mov_dpp(__builtin_bit_cast(int, v), 0x141, 0xf, 0xf, true));
    v += __builtin_bit_cast(float, __builtin_amdgcn_mov_dpp(__builtin_bit_cast(int, v), 0x140, 0xf, 0xf, true));
    const int iv = __builtin_bit_cast(int, v);
    const float a = __builtin_bit_cast(float, __builtin_amdgcn_readlane(iv, 15)), b = __builtin_bit_cast(float, __builtin_amdgcn_readlane(iv, 31));
    const float c = __builtin_bit_cast(float, __builtin_amdgcn_readlane(iv, 47)), d = __builtin_bit_cast(float, __builtin_amdgcn_readlane(iv, 63));
    return (a + b) + (c + d);
}
__device__ __forceinline__ float silu_f(float x) { return x * __builtin_amdgcn_rcpf(1.f + __expf(-x)); }
__device__ __forceinline__ float sigmoid_f(float x) { return __builtin_amdgcn_rcpf(1.f + __expf(-x)); }
#define LDS_WAIT() asm volatile("s_waitcnt lgkmcnt(0)" ::: "memory")
__device__ __forceinline__ int fresh_lane() { int l; asm volatile("v_mbcnt_lo_u32_b32 %0, -1, 0\n\tv_mbcnt_hi_u32_b32 %0, -1, %0" : "=v"(l)); return l; }

#define XB_TMO      128
#define XB_XCNT(j)  (256  + 64 * (j))
#define XB_XSUB(j)  (1280 + 64 * (j))
#define XB_XGEN(j)  (2304 + 64 * (j))
#define XB_TOP      3328
#define XB_TOPGEN   3392
#define XCD_BAR_WORDS 3456
#define XB_SPIN_CAP (1u << 20)
__device__ __forceinline__ unsigned xb_ld(unsigned* p)              { return __hip_atomic_load(p, __ATOMIC_RELAXED, __HIP_MEMORY_SCOPE_AGENT); }
__device__ __forceinline__ unsigned xb_add(unsigned* p, unsigned v) { return __hip_atomic_fetch_add(p, v, __ATOMIC_RELAXED, __HIP_MEMORY_SCOPE_AGENT); }
__device__ __forceinline__ unsigned xb_xcc_id() { return (unsigned)__builtin_amdgcn_s_getreg((3 << 11) | 20) & 0xFu; }
#define XB_SPIN(cond, bar) do { unsigned _sp = 0; while (cond) { __builtin_amdgcn_s_sleep(1); \
    if ((++_sp & 255u) == 0u) { if (xb_ld(&(bar)[XB_TMO])) break; if (_sp > XB_SPIN_CAP) { atomicAdd(&(bar)[XB_TMO], 1u); break; } } } } while (0)
struct XcdBarrier { unsigned* bar; unsigned x; volatile LAS unsigned* st; };
__device__ __forceinline__ XcdBarrier xcd_barrier_post(unsigned* bar, volatile LAS unsigned* st) {
    XcdBarrier b; b.bar = bar; b.x = xb_xcc_id(); b.st = st;
    if (threadIdx.x == 0) (void)xb_add(&bar[XB_XCNT(b.x)], 1u);
    return b;
}
__device__ __forceinline__ void xcd_barrier_complete(unsigned* bar, unsigned x, unsigned& nloc, unsigned& nx) {
    const unsigned G = gridDim.x * gridDim.y * gridDim.z;
    unsigned sum, cnt, mine, sp = 0u;
    for (;;) {
        sum = 0u; cnt = 0u; mine = 0u;
#pragma unroll
        for (unsigned j = 0; j < 16; ++j) { const unsigned c = xb_ld(&bar[XB_XCNT(j)]); sum += c; cnt += (c > 0u) ? 1u : 0u; mine = (j == x) ? c : mine; }
        if (sum == G) break;
        __builtin_amdgcn_s_sleep(1);
        if ((++sp & 255u) == 0u) { if (xb_ld(&bar[XB_TMO])) break; if (sp > XB_SPIN_CAP) { atomicAdd(&bar[XB_TMO], 1u); break; } }
    }
    nloc = mine > 0u ? mine : 1u; nx = cnt > 0u ? cnt : 1u;
}
__device__ __forceinline__ void xcd_barrier(const XcdBarrier& b) {
    asm volatile("s_waitcnt vmcnt(0)" ::: "memory");
    __syncthreads();
    if (threadIdx.x == 0) {
        unsigned* bar = b.bar;
        __builtin_amdgcn_s_waitcnt(0);
        unsigned nloc = b.st[0], nx = b.st[1];
        if (nloc == 0u) { xcd_barrier_complete(bar, b.x, nloc, nx); b.st[0] = nloc; b.st[1] = nx; }
        const unsigned old = xb_add(&bar[XB_XSUB(b.x)], 1u);
        const unsigned gen = old / nloc;
        if (old + 1u == (gen + 1u) * nloc) {
            __builtin_amdgcn_fence(__ATOMIC_RELEASE, "agent");
            asm volatile("s_waitcnt vmcnt(0)" ::: "memory");
            const unsigned og = xb_add(&bar[XB_TOP], 1u);
            const unsigned tg = og / nx;
            if (og + 1u == (tg + 1u) * nx) xb_add(&bar[XB_TOPGEN], 1u);
            else XB_SPIN(xb_ld(&bar[XB_TOPGEN]) == tg, bar);
            __builtin_amdgcn_fence(__ATOMIC_ACQUIRE, "agent");
            xb_add(&bar[XB_XGEN(b.x)], 1u);
            asm volatile("s_waitcnt vmcnt(0)" ::: "memory");
        } else {
            XB_SPIN(xb_ld(&bar[XB_XGEN(b.x)]) == gen, bar);
            __builtin_amdgcn_fence(__ATOMIC_ACQUIRE, "agent");
            asm volatile("s_waitcnt vmcnt(0)" ::: "memory");
        }
    }
    __syncthreads();
}

struct Args { const float* in[25]; float* out; unsigned char* ws; int ph_lo, ph_hi; };
enum { I_X = 0, I_C, I_CTX, I_CCTX, I_ADAW, I_ADAB, I_NMG, I_NFG, I_WIN, I_WOUT, I_SINK, I_PW1W, I_PW1B, I_DWW, I_DWB, I_LNG, I_LNB,
       I_PW2W, I_PW2B, I_RW, I_RB, I_WG, I_WU, I_WD, I_FNG };

struct InPtrs {
    __device__ __forceinline__ const float* operator[](int i) const { const float* r;
        asm volatile("s_load_dwordx2 %0, %1, %2\n\ts_waitcnt lgkmcnt(0)" : "=s"(r) : "s"(__builtin_amdgcn_kernarg_segment_ptr()), "s"(i * 8)); return r; }
};
struct Frame {
    LAS unsigned char* lds;
    int tid, lane, wave, G, wg;
    InPtrs in;
    float* out;
    unsigned char* ws;
    unsigned* ctl;
};

__device__ __forceinline__ int crow(int i, int h) { return (i & 3) + 8 * (i >> 2) + 4 * h; }
template <class RowPtr, class Epi>
__device__ __forceinline__ void sgemm_tile(const RowPtr& rowptr, const bf16* Bt, int K, int m0, int n0, const Epi& epi, int wave, int lane) {
    const int wm = wave & 3, wn = wave >> 2, r = lane & 31, h = lane >> 5;
    const bf16* ap = rowptr(m0 + wm * 32 + r) + 8 * h;
    const bf16* bp0 = Bt + (size_t)(n0 + wn * 64 + r) * K + 8 * h;
    const bf16* bp1 = bp0 + (size_t)32 * K;
    f32x16 c0, c1;
#pragma unroll
    for (int i = 0; i < 16; ++i) { c0[i] = 0.f; c1[i] = 0.f; }
#pragma unroll 2
    for (int k = 0; k < K; k += 32) {
        const bf16x8 a0 = *(const bf16x8*)(ap + k), a1 = *(const bf16x8*)(ap + k + 16);
        const bf16x8 b00 = *(const bf16x8*)(bp0 + k), b01 = *(const bf16x8*)(bp0 + k + 16);
        const bf16x8 b10 = *(const bf16x8*)(bp1 + k), b11 = *(const bf16x8*)(bp1 + k + 16);
        c0 = __builtin_amdgcn_mfma_f32_32x32x16_bf16(a0, b00, c0, 0, 0, 0);
        c1 = __builtin_amdgcn_mfma_f32_32x32x16_bf16(a0, b10, c1, 0, 0, 0);
        c0 = __builtin_amdgcn_mfma_f32_32x32x16_bf16(a1, b01, c0, 0, 0, 0);
        c1 = __builtin_amdgcn_mfma_f32_32x32x16_bf16(a1, b11, c1, 0, 0, 0);
    }
    epi(m0 + wm * 32, n0 + wn * 64, c0, c1, lane);
}

__device__ __forceinline__ void p0_transpose_item(const float* W, int K, int N, bf16* WT, int k0, int n0, int drow0, LAS float* scr, int lane) {
#pragma unroll 8
    for (int i = 0; i < 32; ++i) { const int kk = 2 * i + (lane >> 5); scr[kk * 33 + (lane & 31)] = W[(size_t)(k0 + kk) * N + n0 + (lane & 31)]; }
    LDS_WAIT(); asm volatile("" ::: "memory");
    const int c = lane & 7;
#pragma unroll
    for (int j = 0; j < 4; ++j) { const int n = (lane >> 3) + 8 * j; const LAS float* s = scr + (8 * c) * 33 + n;
        u32x4 o; o.x = pk2(s[0 * 33], s[1 * 33]); o.y = pk2(s[2 * 33], s[3 * 33]); o.z = pk2(s[4 * 33], s[5 * 33]); o.w = pk2(s[6 * 33], s[7 * 33]);
        *(u32x4*)(WT + (size_t)(drow0 + n) * K + k0 + 8 * c) = o; }
    LDS_WAIT(); asm volatile("" ::: "memory");
}
__device__ __forceinline__ int il_row(int j, int half) { return (j / IL) * (2 * IL) + half * IL + (j % IL); }

struct TItem { const float* W; bf16* WT; int K, N, k0, n0, drow0; bool ok; };
__device__ __forceinline__ TItem t_decode(const Frame& F, int it) {
    constexpr int S0 = 640, S1 = 512, S2 = 1024, S3 = 512, SM = 32 * 256;
    TItem t; t.ok = it < S0 + S1 + S2 + S3 + 3 * SM; t.W = F.in[I_WIN]; t.WT = (bf16*)(F.ws + WS_WIN); t.K = 1024; t.N = 1280; t.k0 = 0; t.n0 = 0; t.drow0 = 0;
    int r = it;
    if (r < S0) { const int kb = r / 40, nb = r % 40; t.k0 = kb * 64; t.n0 = nb * 32; t.drow0 = nb * 32; return t; } r -= S0;
    if (r < S1) { const int kb = r / 32, nb = r % 32; t.W = F.in[I_WOUT]; t.WT = (bf16*)(F.ws + WS_WOUT); t.N = 1024; t.k0 = kb * 64; t.n0 = nb * 32; t.drow0 = nb * 32; return t; } r -= S1;
    if (r < S2) { const int kb = r / 64, nb = r % 64, n0 = nb * 32; t.W = F.in[I_PW1W]; t.WT = (bf16*)(F.ws + WS_WPW1); t.N = 2048; t.k0 = kb * 64; t.n0 = n0; t.drow0 = il_row(n0 & 1023, n0 >> 10); return t; } r -= S2;
    if (r < S3) { const int kb = r / 32, nb = r % 32; t.W = F.in[I_PW2W]; t.WT = (bf16*)(F.ws + WS_WPW2); t.N = 1024; t.k0 = kb * 64; t.n0 = nb * 32; t.drow0 = nb * 32; return t; } r -= S3;
    if (r < SM) { const int le = r >> 8, q = r & 255, kb = q / 16, nb = q % 16; t.W = F.in[I_WG] + (size_t)le * 1024 * 512; t.WT = (bf16*)(F.ws + WS_WGU) + (size_t)le * 1024 * 1024; t.N = 512; t.k0 = kb * 64; t.n0 = nb * 32; t.drow0 = il_row(nb * 32, 0); return t; } r -= SM;
    if (r < SM) { const int le = r >> 8, q = r & 255, kb = q / 16, nb = q % 16; t.W = F.in[I_WU] + (size_t)le * 1024 * 512; t.WT = (bf16*)(F.ws + WS_WGU) + (size_t)le * 1024 * 1024; t.N = 512; t.k0 = kb * 64; t.n0 = nb * 32; t.drow0 = il_row(nb * 32, 1); return t; } r -= SM;
    { const int le = (r >> 8) & 31, q = r & 255, kb = q / 32, nb = q % 32; t.W = F.in[I_WD] + (size_t)le * 512 * 1024; t.WT = (bf16*)(F.ws + WS_WDN) + (size_t)le * 1024 * 512; t.K = 512; t.N = 1024; t.k0 = kb * 64; t.n0 = nb * 32; t.drow0 = nb * 32; }
    return t;
}
__device__ __forceinline__ void t_load(const TItem& t, int lane, float (&v)[32]) {
    if (t.ok) {
#pragma unroll
        for (int i = 0; i < 32; ++i) v[i] = t.W[(size_t)(t.k0 + 2 * i + (lane >> 5)) * t.N + t.n0 + (lane & 31)];
    }
}
__device__ __forceinline__ void t_store(const TItem& t, LAS float* scr, int lane, const float (&v)[32]) {
#pragma unroll
    for (int i = 0; i < 32; ++i) scr[(2 * i + (lane >> 5)) * 33 + (lane & 31)] = v[i];
    LDS_WAIT(); asm volatile("" ::: "memory");
    const int c = lane & 7;
#pragma unroll
    for (int j = 0; j < 4; ++j) { const int n = (lane >> 3) + 8 * j; const LAS float* s = scr + (8 * c) * 33 + n;
        u32x4 o; o.x = pk2(s[0 * 33], s[1 * 33]); o.y = pk2(s[2 * 33], s[3 * 33]); o.z = pk2(s[4 * 33], s[5 * 33]); o.w = pk2(s[6 * 33], s[7 * 33]);
        *(u32x4*)(t.WT + (size_t)(t.drow0 + n) * t.K + t.k0 + 8 * c) = o; }
    LDS_WAIT(); asm volatile("" ::: "memory");
}
__device__ __forceinline__ void phase_prep(Frame& F) {
    {
        LAS float* sc = (LAS float*)F.lds;
        LAS float* red = sc + 5 * 1024;
        bool loaded = false;
        for (int it = F.wg; it < 192; it += F.G) {
            if (!loaded) {
                for (int i = F.tid; i < 5 * 1024; i += NTHR) { const int b = i >> 10, k = i & 1023; const float v = b < 4 ? F.in[I_C][b * 1024 + k] : F.in[I_CCTX][k]; sc[i] = silu_f(v); }
                __syncthreads(); loaded = true;
            }
            const int l = it / 96, n0 = (it % 96) * 64, c4 = F.tid & 15, kg = F.tid >> 4;
            const float* w = F.in[I_ADAW] + (size_t)l * 1024 * 6144 + n0 + 4 * c4;
            f32x4 a[5];
#pragma unroll
            for (int b = 0; b < 5; ++b) a[b] = (f32x4){0.f, 0.f, 0.f, 0.f};
#pragma unroll 16
            for (int kk = 0; kk < 32; ++kk) { const int k = kg * 32 + kk; const f32x4 wv = *(const f32x4*)(w + (size_t)k * 6144);
#pragma unroll
                for (int b = 0; b < 5; ++b) a[b] += sc[b * 1024 + k] * wv; }
#pragma unroll
            for (int b = 0; b < 5; ++b) *(LAS f32x4*)(red + (kg * 5 + b) * 64 + 4 * c4) = a[b];
            __syncthreads();
            if (F.tid < 320) { const int b = F.tid >> 6, c2 = F.tid & 63; float sm = 0.f;
#pragma unroll
                for (int g = 0; g < 32; ++g) sm += red[(g * 5 + b) * 64 + c2];
                ((float*)(F.ws + WS_MOD))[((size_t)l * 5 + b) * 6144 + n0 + c2] = sm + F.in[I_ADAB][l * 6144 + n0 + c2]; }
            __syncthreads();
        }
        __syncthreads();
    }
    { u32x4* z = (u32x4*)(F.ws + WS_SLOTT); const u32x4 zero = {0u, 0u, 0u, 0u};
      for (int i = F.wg * NTHR + F.tid; i < 2 * 16 * CAP / 4; i += F.G * NTHR) z[i] = zero; }
    { float* tw = (float*)(F.ws + WS_TW);
      for (int k = F.wg * NTHR + F.tid; k < 8192; k += F.G * NTHR) { const float a = (float)k * (6.283185307179586f / 8192.f); tw[2 * k] = __cosf(a); tw[2 * k + 1] = __sinf(a); } }
    {
        LAS float* scr = (LAS float*)(F.lds + F.wave * 8704);
        const int gw = F.wg * NWAVES + F.wave, NGW = F.G * NWAVES;
        TItem cur = t_decode(F, gw); float va[32], vb[32];
        t_load(cur, F.lane, va);
#pragma unroll 1
        for (int it = gw; cur.ok; it += NGW) {
            const TItem nxt = t_decode(F, it + NGW);
            t_load(nxt, F.lane, vb);
            t_store(cur, scr, F.lane, va);
#pragma unroll
            for (int i = 0; i < 32; ++i) va[i] = vb[i];
            cur = nxt;
        }
    }
}

#define ROFF(lane, j) (512 * ((j) >> 1) + 8 * (lane) + 4 * ((j) & 1))
__device__ __forceinline__ void row_load(const float* p, int lane, f32x4 (&v)[4]) {
#pragma unroll
    for (int j = 0; j < 4; ++j) v[j] = *(const f32x4*)(p + ROFF(lane, j));
}
__device__ __forceinline__ void row_load_bf(const bf16* p, int lane, f32x4 (&v)[4]) {
#pragma unroll
    for (int jj = 0; jj < 2; ++jj) { const u32x4 w = *(const u32x4*)(p + 512 * jj + 8 * lane); v[2 * jj] = (f32x4){bflo(w.x), bfhi(w.x), bflo(w.y), bfhi(w.y)}; v[2 * jj + 1] = (f32x4){bflo(w.z), bfhi(w.z), bflo(w.w), bfhi(w.w)}; }
}
__device__ __forceinline__ void xrow_load(const float* xf, const bf16* xb, size_t row, int lane, f32x4 (&v)[4]) { if (XBF16) row_load_bf(xb + row * D, lane, v); else row_load(xf + row * D, lane, v); }
__device__ __forceinline__ float row_sumsq(const f32x4 (&v)[4]) {
    float s = 0.f;
#pragma unroll
    for (int j = 0; j < 4; ++j) s += (v[j].x * v[j].x + v[j].y * v[j].y) + (v[j].z * v[j].z + v[j].w * v[j].w);
    return wave_sum(s);
}
__device__ __forceinline__ void row_modulate(f32x4 (&v)[4], float rstd, const float* g, const float* sh, const float* sc, int lane) {
#pragma unroll
    for (int j = 0; j < 4; ++j) { const int o = ROFF(lane, j); const f32x4 gg = *(const f32x4*)(g + o), s1 = *(const f32x4*)(sc + o), s0 = *(const f32x4*)(sh + o);
        v[j] = v[j] * rstd * gg * (1.f + s1) + s0; }
}
__device__ __forceinline__ void row_store_bf16(bf16* dst, const f32x4 (&v)[4], int lane) {
#pragma unroll
    for (int jj = 0; jj < 2; ++jj) { u32x4 w; w.x = pk2(v[2 * jj].x, v[2 * jj].y); w.y = pk2(v[2 * jj].z, v[2 * jj].w); w.z = pk2(v[2 * jj + 1].x, v[2 * jj + 1].y); w.w = pk2(v[2 * jj + 1].z, v[2 * jj + 1].w); *(u32x4*)(dst + 512 * jj + 8 * lane) = w; }
}

__device__ __forceinline__ void phase_norm1_l0(Frame& F) {
    const int gw = F.wg * NWAVES + F.wave, NGW = F.G * NWAVES;
    const float* mod = (const float*)(F.ws + WS_MOD);
    bf16* HB = (bf16*)(F.ws + WS_HB);
    for (int row = gw; row < T + TC; row += NGW) {
        const float* src = row < T ? F.in[I_X] + (size_t)row * D : F.in[I_CTX] + (size_t)(row - T) * D;
        const int b = row < T ? (row >> 13) : 4;
        f32x4 v[4]; row_load(src, F.lane, v);
        const float rstd = rsqrtf(row_sumsq(v) * (1.f / D) + EPS);
        const float* m = mod + (size_t)b * 6144;
        row_modulate(v, rstd, F.in[I_NMG], m, m + 1024, F.lane);
        row_store_bf16(HB + (size_t)row * D, v, F.lane);
    }
}

struct RowLin { const bf16* base; size_t pitch; __device__ __forceinline__ const bf16* operator()(int m) const { return base + (size_t)m * pitch; } };

__device__ __forceinline__ void inproj_block(Frame& F, int mb, int nbk, const f32x16& c, int lane) {
    const int h = lane >> 5, cl = lane & 31;
    bf16* dst; int pitch, cbase; bool rope = false; bool isctx = (mb >= T);
    if (nbk < 512) { dst = (bf16*)(F.ws + WS_UF); pitch = 512; cbase = 0; }
    else if (nbk < 1024) { dst = (bf16*)(F.ws + WS_Q); pitch = 512; cbase = 512; rope = true; }
    else if (nbk < 1152) { dst = isctx ? (bf16*)(F.ws + WS_CK) : (bf16*)(F.ws + WS_K); pitch = 128; cbase = 1024; rope = !isctx; }
    else { dst = isctx ? (bf16*)(F.ws + WS_CV) : (bf16*)(F.ws + WS_V); pitch = 128; cbase = 1152; }
    const int rbase = isctx ? mb - T : mb;
    const int col = nbk - cbase + cl;
    const float inv = exp2f(-(float)(cl & 15) * (13.287712379549449f / 16.f));
    const bool second = (cl & 16) != 0; const bool bycol = ((nbk >> 5) & 1) != 0;
#pragma unroll
    for (int i = 0; i < 16; ++i) {
        const int rr = crow(i, h); float v = c[i];
        if (rope) {
            const float partner = __shfl_xor(v, 16);
            const int l = (mb + rr) & (L - 1);
            const float pos = (float)(bycol ? (l & 63) : (l >> 6));
            const float ang = pos * inv, cs = __cosf(ang), sn = __sinf(ang);
            v = second ? (partner * sn + v * cs) : (v * cs - partner * sn);
        }
        dst[(size_t)(rbase + rr) * pitch + col] = (bf16)f2bf(v);
    }
}
__device__ __forceinline__ void phase_inproj(Frame& F) {
    const bf16* HB = (const bf16*)(F.ws + WS_HB); const bf16* Wt = (const bf16*)(F.ws + WS_WIN);
    constexpr int MT = (T + TC) / 128, NT = N_IN / 128;
    RowLin rp{HB, (size_t)D};
    for (int u = F.wg; u < MT * NT; u += F.G) {
        const int mt = u / NT, nt = u % NT;
        if (mt >= T / 128 && nt < 8) continue;
        auto epi = [&](int mb, int nb, const f32x16& c0, const f32x16& c1, int lane) { inproj_block(F, mb, nb, c0, lane); inproj_block(F, mb, nb + 32, c1, lane); };
        sgemm_tile(rp, Wt, D, mt * 128, nt * 128, epi, F.wave, F.lane);
    }
}

__device__ __forceinline__ void attn_key(const bf16* kp, const bf16* vp, const float (&q)[64], float& m, float& s, float (&o)[64]) {
    float dot = 0.f;
#pragma unroll
    for (int j = 0; j < 8; ++j) { const u32x4 w = *(const u32x4*)(kp + 8 * j);
        dot += q[8 * j + 0] * bflo(w.x) + q[8 * j + 1] * bfhi(w.x) + q[8 * j + 2] * bflo(w.y) + q[8 * j + 3] * bfhi(w.y)
             + q[8 * j + 4] * bflo(w.z) + q[8 * j + 5] * bfhi(w.z) + q[8 * j + 6] * bflo(w.w) + q[8 * j + 7] * bfhi(w.w); }
    const float mn = fmaxf(m, dot), alpha = __expf(m - mn), p = __expf(dot - mn);
    s = s * alpha + p; m = mn;
#pragma unroll
    for (int j = 0; j < 8; ++j) { const u32x4 w = *(const u32x4*)(vp + 8 * j);
        o[8 * j + 0] = o[8 * j + 0] * alpha + p * bflo(w.x); o[8 * j + 1] = o[8 * j + 1] * alpha + p * bfhi(w.x);
        o[8 * j + 2] = o[8 * j + 2] * alpha + p * bflo(w.y); o[8 * j + 3] = o[8 * j + 3] * alpha + p * bfhi(w.y);
        o[8 * j + 4] = o[8 * j + 4] * alpha + p * bflo(w.z); o[8 * j + 5] = o[8 * j + 5] * alpha + p * bfhi(w.z);
        o[8 * j + 6] = o[8 * j + 6] * alpha + p * bflo(w.w); o[8 * j + 7] = o[8 * j + 7] * alpha + p * bfhi(w.w); }
}
__device__ __forceinline__ void phase_attn_simple(Frame& F) {
    const bf16* Q = (const bf16*)(F.ws + WS_Q); const bf16* Kb = (const bf16*)(F.ws + WS_K); const bf16* Vb = (const bf16*)(F.ws + WS_V);
    const bf16* CK = (const bf16*)(F.ws + WS_CK); const bf16* CV = (const bf16*)(F.ws + WS_CV); bf16* MIX = (bf16*)(F.ws + WS_MIX);
    for (int idx = F.wg * NTHR + F.tid; idx < T * 8; idx += F.G * NTHR) {
        const int hd = idx / T, t = idx % T, b = t >> 13, l = t & (L - 1), kvh = hd >> 2;
        float q[64], o[64];
#pragma unroll
        for (int j = 0; j < 8; ++j) { const u32x4 w = *(const u32x4*)(Q + (size_t)t * 512 + hd * 64 + 8 * j);
            q[8 * j + 0] = bflo(w.x) * 0.125f; q[8 * j + 1] = bfhi(w.x) * 0.125f; q[8 * j + 2] = bflo(w.y) * 0.125f; q[8 * j + 3] = bfhi(w.y) * 0.125f;
            q[8 * j + 4] = bflo(w.z) * 0.125f; q[8 * j + 5] = bfhi(w.z) * 0.125f; q[8 * j + 6] = bflo(w.w) * 0.125f; q[8 * j + 7] = bfhi(w.w) * 0.125f; }
#pragma unroll
        for (int j = 0; j < 64; ++j) o[j] = 0.f;
        float m = F.in[I_SINK][hd], s = 1.f;
        for (int c = 0; c < CL; ++c) { const size_t r = (size_t)(b * CL + c) * 128 + kvh * 64; attn_key(CK + r, CV + r, q, m, s, o); }
        const int lo = l - 128 < 0 ? 0 : l - 128, hi = l + 128 > L - 1 ? L - 1 : l + 128;
        for (int kp = lo; kp <= hi; ++kp) { const size_t r = (size_t)(b * L + kp) * 128 + kvh * 64; attn_key(Kb + r, Vb + r, q, m, s, o); }
        const float is = 1.f / s;
#pragma unroll
        for (int j = 0; j < 8; ++j) { u32x4 w; w.x = pk2(o[8 * j] * is, o[8 * j + 1] * is); w.y = pk2(o[8 * j + 2] * is, o[8 * j + 3] * is); w.z = pk2(o[8 * j + 4] * is, o[8 * j + 5] * is); w.w = pk2(o[8 * j + 6] * is, o[8 * j + 7] * is);
            *(u32x4*)(MIX + (size_t)t * 1024 + 512 + hd * 64 + 8 * j) = w; }
    }
}

__device__ __forceinline__ void phase_fft1_simple(Frame& F) {
    const bf16* UF = (const bf16*)(F.ws + WS_UF); bf16* Gb = (bf16*)(F.ws + WS_G); const float* tw = (const float*)(F.ws + WS_TW);
    for (int idx = F.wg * NTHR + F.tid; idx < NB * FN1 * FN2 * 512; idx += F.G * NTHR) {
        const int ch = idx & 511, bp = (idx >> 9) & 127, c = (idx >> 16) & 63, b = idx >> 22;
        float re = 0.f, im = 0.f;
        for (int a = 0; a < FN1; ++a) { const float u = bf2f(UF[(size_t)(b * L + 128 * a + bp) * 512 + ch]); const int k = ((a * c) & 63) * 128;
            re += u * tw[2 * k]; im -= u * tw[2 * k + 1]; }
        const int k2 = bp * c; const float cs = tw[2 * k2], sn = tw[2 * k2 + 1];
        const float gr = re * cs + im * sn, gi = im * cs - re * sn;
        const size_t row = (size_t)(b * FN1 + c) * FN2 + bp;
        Gb[row * 1024 + ch] = (bf16)f2bf(gr); Gb[row * 1024 + 512 + ch] = (bf16)f2bf(gi);
    }
}
__device__ __forceinline__ void phase_fft2_simple(Frame& F) {
    const bf16* Gb = (const bf16*)(F.ws + WS_G); bf16* AB = (bf16*)(F.ws + WS_AB); const float* tw = (const float*)(F.ws + WS_TW);
    for (int idx = F.wg * NTHR + F.tid; idx < NB * FN1 * FN2 * 512; idx += F.G * NTHR) {
        const int ch = idx & 511, d = (idx >> 9) & 127, c = (idx >> 16) & 63, b = idx >> 22;
        float fr = 0.f, fi = 0.f;
        for (int bp = 0; bp < FN2; ++bp) { const size_t row = (size_t)(b * FN1 + c) * FN2 + bp; const float gr = bf2f(Gb[row * 1024 + ch]), gi = bf2f(Gb[row * 1024 + 512 + ch]);
            const int k = ((bp * d) & 127) * 64; const float cs = tw[2 * k], sn = tw[2 * k + 1];
            fr += gr * cs + gi * sn; fi += gi * cs - gr * sn; }
        const size_t t = (size_t)b * L + c + 64 * d;
        AB[t * 1024 + ch] = (bf16)f2bf(fr); AB[t * 1024 + 512 + ch] = (bf16)f2bf(-fi);
    }
}
__device__ __forceinline__ void phase_fft3_simple(Frame& F) {
    const bf16* AB = (const bf16*)(F.ws + WS_AB); bf16* MIX = (bf16*)(F.ws + WS_MIX); const float* tw = (const float*)(F.ws + WS_TW);
    LAS float* t128 = (LAS float*)F.lds;
    for (int i = F.tid; i < 128; i += NTHR) { t128[2 * i] = tw[2 * (i * 64)]; t128[2 * i + 1] = tw[2 * (i * 64) + 1]; }
    __syncthreads();
    for (int idx = F.wg * NTHR + F.tid; idx < T * 512; idx += F.G * NTHR) {
        const int cp = idx & 127, g = (idx >> 7) & 3, t = idx >> 9;
        const bf16* arow = AB + (size_t)t * 1024 + g * 128;
        float y = 0.f;
        for (int cc = 0; cc < 128; ++cc) { const int k = (cc * cp) & 127; y += bf2f(arow[cc]) * t128[2 * k] - bf2f(arow[512 + cc]) * t128[2 * k + 1]; }
        MIX[(size_t)t * 1024 + g * 128 + cp] = (bf16)f2bf(y * (1.f / 1024.f));
    }
    __syncthreads();
}

__device__ __forceinline__ void phase_outproj(Frame& F, const bf16* A, const bf16* Wt, const float* base, float* X, const float* gate  , const float* bias) {
    RowLin rp{A, (size_t)D};
    for (int u = F.wg; u < (T / 128) * 8; u += F.G) {
        const int mt = u / 8, nt = u % 8;
        auto epi = [&](int mb, int nb, const f32x16& c0, const f32x16& c1, int lane) {
            const int h = lane >> 5, cl = lane & 31, b = mb >> 13;
#pragma unroll
            for (int half = 0; half < 2; ++half) { const int col = nb + 32 * half + cl; const float gv = gate[(size_t)b * 6144 + col], bv = bias ? bias[col] : 0.f;
#pragma unroll
                for (int i = 0; i < 16; ++i) { const size_t o = (size_t)(mb + crow(i, h)) * D + col; const float a = half ? c1[i] : c0[i]; X[o] = base[o] + gv * (a + bv); } }
        };
        sgemm_tile(rp, Wt, D, mt * 128, nt * 128, epi, F.wave, F.lane);
    }
}

__device__ __forceinline__ void route_select(const float (&lg)[16], const float* rb, int& be1, int& be2, float& w1, float& w2) {
    float best = -1e30f; float bs1 = 0.f, bs2 = 0.f; be1 = 0; be2 = 0;
#pragma unroll
    for (int g = 0; g < 4; ++g) {
        float v1 = -1e30f, v2 = -1e30f, s1 = 0.f, s2 = 0.f; int j1 = 0, j2 = 0;
#pragma unroll
        for (int q = 0; q < 4; ++q) { const float sc = sigmoid_f(lg[4 * g + q]), x = sc + rb[4 * g + q];
            if (x > v1) { v2 = v1; j2 = j1; s2 = s1; v1 = x; j1 = q; s1 = sc; } else if (x > v2) { v2 = x; j2 = q; s2 = sc; } }
        const float gs = v1 + v2;
        if (gs > best) { best = gs; be1 = 4 * g + j1; be2 = 4 * g + j2; bs1 = s1; bs2 = s2; }
    }
    const float inv = 1.f / (bs1 + bs2); w1 = bs1 * inv; w2 = bs2 * inv;
}
__device__ __forceinline__ void phase_norm2_route(Frame& F, int layer) {
    const float* mod = (const float*)(F.ws + WS_MOD) + (size_t)layer * 5 * 6144;
    const float* X = F.out; const bf16* XB = (const bf16*)(F.ws + WS_XB); bf16* HB = (bf16*)(F.ws + WS_HB);
    const float* rw = F.in[I_RW]; const float* rb = F.in[I_RB];
    int* tok_e = (int*)(F.ws + WS_TOKE); int* tok_p = (int*)(F.ws + WS_TOKP); float* tok_w = (float*)(F.ws + WS_TOKW);
    int* slot_t = (int*)(F.ws + WS_SLOTT) + layer * 16 * CAP;
    float* slot_w = (float*)(F.ws + WS_SLOTW) + layer * 16 * CAP;
    unsigned* cnt = F.ctl + CW_CNT + layer * 16 * 64;
    LAS float* rwt = (LAS float*)F.lds;
    LAS int* sel_e = (LAS int*)(F.lds + 65536);
    LAS float* sel_w = (LAS float*)(F.lds + 65536 + 1024);
    LAS int* wcnt = (LAS int*)(F.lds + 65536 + 2048);
    LAS int* ebase = wcnt + 64;
    __syncthreads();
    for (int t = F.tid; t < 4096; t += NTHR) { const int i = t >> 2, e4 = t & 3; const f32x4 w = *(const f32x4*)(rw + (size_t)i * 16 + 4 * e4);
        const int p = (i & 512) + 256 * ((i >> 2) & 1) + 4 * ((i >> 3) & 63) + (i & 3);
        rwt[(4 * e4 + 0) * 1024 + p] = w.x; rwt[(4 * e4 + 1) * 1024 + p] = w.y; rwt[(4 * e4 + 2) * 1024 + p] = w.z; rwt[(4 * e4 + 3) * 1024 + p] = w.w; }
    __syncthreads();
    for (int rb0 = F.wg; rb0 < T / 128; rb0 += F.G) {
        const int b = (rb0 * 128) >> 13;
        f32x4 gm[4], sh[4];
        { const float* m = mod + (size_t)b * 6144; const float* g = F.in[I_NFG] + layer * D;
#pragma unroll
          for (int jj = 0; jj < 4; ++jj) { const int o = ROFF(F.lane, jj); gm[jj] = *(const f32x4*)(g + o) * (1.f + *(const f32x4*)(m + 4096 + o)); sh[jj] = *(const f32x4*)(m + 3072 + o); } }
        const int rbase = rb0 * 128 + F.wave * 16;
        f32x4 v0[4], v1[4]; xrow_load(X, XB, (size_t)rbase, F.lane, v0); xrow_load(X, XB, (size_t)(rbase + 1), F.lane, v1);
#pragma unroll 1
        for (int j = 0; j < 16; j += 2) {
            const int lr = F.wave * 16 + j, row = rbase + j;
            f32x4 n0[4], n1[4];
            { const int nr = (j + 2 < 16) ? row + 2 : row; xrow_load(X, XB, (size_t)nr, F.lane, n0); xrow_load(X, XB, (size_t)(nr + 1), F.lane, n1); }
            const float rstd0 = rsqrtf(row_sumsq(v0) * (1.f / D) + EPS), rstd1 = rsqrtf(row_sumsq(v1) * (1.f / D) + EPS);
#pragma unroll
            for (int jj = 0; jj < 4; ++jj) { v0[jj] = v0[jj] * rstd0 * gm[jj] + sh[jj]; v1[jj] = v1[jj] * rstd1 * gm[jj] + sh[jj]; }
            row_store_bf16(HB + (size_t)row * D, v0, F.lane); row_store_bf16(HB + (size_t)(row + 1) * D, v1, F.lane);
            float lg0[16], lg1[16];
#pragma unroll
            for (int e = 0; e < 16; ++e) { float a0 = 0.f, a1 = 0.f;
#pragma unroll
                for (int jj = 0; jj < 4; ++jj) { const f32x4 w4 = *(const LAS f32x4*)(rwt + e * 1024 + 256 * jj + 4 * F.lane);
                    a0 += (v0[jj].x * w4.x + v0[jj].y * w4.y) + (v0[jj].z * w4.z + v0[jj].w * w4.w); a1 += (v1[jj].x * w4.x + v1[jj].y * w4.y) + (v1[jj].z * w4.z + v1[jj].w * w4.w); }
                lg0[e] = a0; lg1[e] = a1; }
#pragma unroll
            for (int e = 0; e < 16; ++e) { lg0[e] = wave_sum(lg0[e]); lg1[e] = wave_sum(lg1[e]); }
            int e1, e2; float w1, w2;
            route_select(lg0, rb, e1, e2, w1, w2);
            if (F.lane == 0) { sel_e[2 * lr] = e1; sel_e[2 * lr + 1] = e2; sel_w[2 * lr] = w1; sel_w[2 * lr + 1] = w2; }
            route_select(lg1, rb, e1, e2, w1, w2);
            if (F.lane == 0) { sel_e[2 * lr + 2] = e1; sel_e[2 * lr + 3] = e2; sel_w[2 * lr + 2] = w1; sel_w[2 * lr + 3] = w2; }
#pragma unroll
            for (int jj = 0; jj < 4; ++jj) { v0[jj] = n0[jj]; v1[jj] = n1[jj]; }
        }
        __syncthreads();
        int my_e = 0, my_rank = 0; float my_w = 0.f;
        if (F.tid < 256) { my_e = sel_e[F.tid]; my_w = sel_w[F.tid];
            const unsigned long long below = (1ull << F.lane) - 1ull;
#pragma unroll 1
            for (int ee = 0; ee < 16; ++ee) { const unsigned long long mk = __ballot(my_e == ee);
                if (my_e == ee) my_rank = __popcll(mk & below);
                if (F.lane == 0) wcnt[F.wave * 16 + ee] = __popcll(mk); } }
        __syncthreads();
        if (F.tid < 16) { const int n = wcnt[F.tid] + wcnt[16 + F.tid] + wcnt[32 + F.tid] + wcnt[48 + F.tid];
            ebase[F.tid] = n ? (int)atomicAdd(cnt + F.tid * 64, (unsigned)n) : 0; }
        __syncthreads();
        if (F.tid < 256) { int pos = ebase[my_e] + my_rank;
            for (int w = 0; w < F.wave; ++w) pos += wcnt[w * 16 + my_e];
            const int tok = rb0 * 128 + (F.tid >> 1), k = F.tid & 1;
            slot_t[my_e * CAP + pos] = tok; slot_w[my_e * CAP + pos] = my_w; tok_e[2 * tok + k] = my_e; tok_p[2 * tok + k] = pos; tok_w[2 * tok + k] = my_w; }
        __syncthreads();
    }
}


__device__ __forceinline__ void phase_norm2_route_mfma(Frame& F, int layer) {
    constexpr int AP = 1032;
    const float* mod = (const float*)(F.ws + WS_MOD) + (size_t)layer * 5 * 6144;
    const bf16* XB = (const bf16*)(F.ws + WS_XB); bf16* HB = (bf16*)(F.ws + WS_HB);
    const float* rw = F.in[I_RW]; const float* rb = F.in[I_RB]; const float* gsrc = F.in[I_NFG] + layer * D;
    int* tok_e = (int*)(F.ws + WS_TOKE); int* tok_p = (int*)(F.ws + WS_TOKP); float* tok_w = (float*)(F.ws + WS_TOKW);
    int* slot_t = (int*)(F.ws + WS_SLOTT) + layer * 16 * CAP;
    float* slot_w = (float*)(F.ws + WS_SLOTW) + layer * 16 * CAP;
    unsigned* cnt = F.ctl + CW_CNT + layer * 16 * 64;
    LAS bf16* AH = (LAS bf16*)F.lds; LAS bf16* AL = AH + 16 * AP;
    LAS float* cbv = (LAS float*)(F.lds + 2 * 16 * AP * 2);
    LAS float* rstdv = cbv + 16;
    LAS float* lgt = rstdv + 128;
    LAS int* sel_e = (LAS int*)(lgt + 128 * 16);
    LAS float* sel_w = (LAS float*)(sel_e + 256);
    LAS int* wcnt = (LAS int*)(sel_w + 256);
    LAS int* ebase = wcnt + 64;
    LAS float* cpart = (LAS float*)(ebase + 16);
    for (int rb0 = F.wg; rb0 < T / 128; rb0 += F.G) {
        const int b = (rb0 * 128) >> 13; const float* m = mod + (size_t)b * 6144;
        __syncthreads();
        { float cp[16];
#pragma unroll
          for (int e = 0; e < 16; ++e) cp[e] = 0.f;
          for (int k = F.tid; k < D; k += NTHR) { const float gmk = gsrc[k] * (1.f + m[4096 + k]), shk = m[3072 + k];
#pragma unroll
              for (int e4 = 0; e4 < 4; ++e4) { const f32x4 w4 = *(const f32x4*)(rw + (size_t)k * 16 + 4 * e4);
#pragma unroll
                  for (int q = 0; q < 4; ++q) { const int e = 4 * e4 + q; const float pr = gmk * w4[q]; const unsigned hi = f2bf(pr); const unsigned lo = f2bf(pr - bf2f(hi));
                      AH[e * AP + k] = (bf16)hi; AL[e * AP + k] = (bf16)lo; cp[e] += shk * w4[q]; } } }
#pragma unroll
          for (int e = 0; e < 16; ++e) { const float t = wave_sum(cp[e]); if (F.lane == 0) cpart[F.wave * 16 + e] = t; } }
        __syncthreads();
        if (F.tid < 16) { float t = 0.f;
#pragma unroll
            for (int w = 0; w < 8; ++w) t += cpart[w * 16 + F.tid];
            cbv[F.tid] = t; }
        f32x4 gm[4], sh[4];
#pragma unroll
        for (int jj = 0; jj < 4; ++jj) { const int o = ROFF(F.lane, jj); gm[jj] = *(const f32x4*)(gsrc + o) * (1.f + *(const f32x4*)(m + 4096 + o)); sh[jj] = *(const f32x4*)(m + 3072 + o); }
        const int rbase = rb0 * 128 + F.wave * 16;
        f32x4 v0[4], v1[4]; row_load_bf(XB + (size_t)rbase * D, F.lane, v0); row_load_bf(XB + (size_t)(rbase + 1) * D, F.lane, v1);
#pragma unroll 1
        for (int j = 0; j < 16; j += 2) {
            const int lr = F.wave * 16 + j, row = rbase + j;
            f32x4 n0[4], n1[4];
            { const int nr = (j + 2 < 16) ? row + 2 : row; row_load_bf(XB + (size_t)nr * D, F.lane, n0); row_load_bf(XB + (size_t)(nr + 1) * D, F.lane, n1); }
            const float rstd0 = rsqrtf(row_sumsq(v0) * (1.f / D) + EPS), rstd1 = rsqrtf(row_sumsq(v1) * (1.f / D) + EPS);
#pragma unroll
            for (int jj = 0; jj < 4; ++jj) { v0[jj] = v0[jj] * rstd0 * gm[jj] + sh[jj]; v1[jj] = v1[jj] * rstd1 * gm[jj] + sh[jj]; }
            row_store_bf16(HB + (size_t)row * D, v0, F.lane); row_store_bf16(HB + (size_t)(row + 1) * D, v1, F.lane);
            if (F.lane == 0) { rstdv[lr] = rstd0; rstdv[lr + 1] = rstd1; }
#pragma unroll
            for (int jj = 0; jj < 4; ++jj) { v0[jj] = n0[jj]; v1[jj] = n1[jj]; }
        }
        __syncthreads();
        { const int fr = F.lane & 15, fq = F.lane >> 4;
          f32x4 acc = {0.f, 0.f, 0.f, 0.f};
          const bf16* xr = XB + (size_t)(rb0 * 128 + 16 * F.wave + fr) * D + 8 * fq;
          const LAS bf16* ah = AH + fr * AP + 8 * fq; const LAS bf16* al = AL + fr * AP + 8 * fq;
#pragma unroll 8
          for (int s2 = 0; s2 < 32; ++s2) { const bf16x8 xb = *(const bf16x8*)(xr + 32 * s2);
              acc = __builtin_amdgcn_mfma_f32_16x16x32_bf16(*(const LAS bf16x8*)(ah + 32 * s2), xb, acc, 0, 0, 0);
              acc = __builtin_amdgcn_mfma_f32_16x16x32_bf16(*(const LAS bf16x8*)(al + 32 * s2), xb, acc, 0, 0, 0); }
          const int lrow = 16 * F.wave + fr; const float rs = rstdv[lrow];
#pragma unroll
          for (int i = 0; i < 4; ++i) lgt[lrow * 16 + 4 * fq + i] = rs * acc[i] + cbv[4 * fq + i]; }
        __syncthreads();
        if (F.tid < 128) { float lg[16];
#pragma unroll
            for (int e4 = 0; e4 < 4; ++e4) { const f32x4 t = *(const LAS f32x4*)(lgt + F.tid * 16 + 4 * e4); lg[4 * e4] = t.x; lg[4 * e4 + 1] = t.y; lg[4 * e4 + 2] = t.z; lg[4 * e4 + 3] = t.w; }
            int e1, e2; float w1, w2; route_select(lg, rb, e1, e2, w1, w2);
            sel_e[2 * F.tid] = e1; sel_e[2 * F.tid + 1] = e2; sel_w[2 * F.tid] = w1; sel_w[2 * F.tid + 1] = w2; }
        __syncthreads();
        int my_e = 0, my_rank = 0; float my_w = 0.f;
        if (F.tid < 256) { my_e = sel_e[F.tid]; my_w = sel_w[F.tid];
            const unsigned long long below = (1ull << F.lane) - 1ull;
#pragma unroll 1
            for (int ee = 0; ee < 16; ++ee) { const unsigned long long mk = __ballot(my_e == ee);
                if (my_e == ee) my_rank = __popcll(mk & below);
                if (F.lane == 0) wcnt[F.wave * 16 + ee] = __popcll(mk); } }
        __syncthreads();
        if (F.tid < 16) { const int n = wcnt[F.tid] + wcnt[16 + F.tid] + wcnt[32 + F.tid] + wcnt[48 + F.tid];
            ebase[F.tid] = n ? (int)atomicAdd(cnt + F.tid * 64, (unsigned)n) : 0; }
        __syncthreads();
        if (F.tid < 256) { int pos = ebase[my_e] + my_rank;
            for (int w = 0; w < F.wave; ++w) pos += wcnt[w * 16 + my_e];
            const int tok = rb0 * 128 + (F.tid >> 1), k = F.tid & 1;
            slot_t[my_e * CAP + pos] = tok; slot_w[my_e * CAP + pos] = my_w; tok_e[2 * tok + k] = my_e; tok_p[2 * tok + k] = pos; tok_w[2 * tok + k] = my_w; }
    }
    __syncthreads();
}

constexpr int MOEMAP_OFF = LDS_BYTES - 256;
__device__ __forceinline__ LAS int* moe_map(Frame& F, int layer) {
    LAS int* mm = (LAS int*)(F.lds + MOEMAP_OFF);
    __syncthreads();
    if (F.tid < 64) { const unsigned* cnt = F.ctl + CW_CNT + layer * 16 * 64;
        const int n = (F.tid < 16) ? (int)__hip_atomic_load(cnt + F.tid * 64, __ATOMIC_RELAXED, __HIP_MEMORY_SCOPE_AGENT) : 0;
        const int pad = (n + 255) & ~255; int x = pad;
#pragma unroll
        for (int o = 1; o < 16; o <<= 1) { const int t = __shfl_up(x, o); if (F.lane >= o) x += t; }
        if (F.tid < 16) { mm[F.tid] = n; mm[16 + F.tid] = x - pad; } }
    __syncthreads();
    return mm;
}
struct RowGather { const bf16* base; const int* list; int n; __device__ __forceinline__ const bf16* operator()(int m) const { const int tok = m < n ? list[m] : 0; return base + (size_t)tok * D; } };

__device__ __forceinline__ void phase_moe_gateup(Frame& F, int layer) {
    LAS int* mm = moe_map(F, layer);
    const bf16* HB = (const bf16*)(F.ws + WS_HB); bf16* HID = (bf16*)(F.ws + WS_HID);
    const int* slot_t = (const int*)(F.ws + WS_SLOTT) + layer * 16 * CAP; const float* slot_w = (const float*)(F.ws + WS_SLOTW) + layer * 16 * CAP;
    int ubase = 0;
#pragma unroll 1
    for (int e = 0; e < 16; ++e) {
        const int n = mm[e], hbe = mm[16 + e], rt = (n + 127) >> 7, nu = rt * 8;
        const bf16* Wt = (const bf16*)(F.ws + WS_WGU) + (size_t)(layer * 16 + e) * 1024 * 1024;
        RowGather rp{HB, slot_t + e * CAP, n};
        int first = (F.wg - ubase % F.G + F.G) % F.G;
        for (int u = first; u < nu; u += F.G) {
            const int mt = u / 8, nt = u % 8;
            auto epi = [&](int mb, int nb, const f32x16& c0, const f32x16& c1, int lane) {
                const int h = lane >> 5, cl = lane & 31; const int col = (nb >> 1) + cl;
#pragma unroll
                for (int i = 0; i < 16; ++i) { const int r = mb + crow(i, h);
                    if (r < n) { const float w = slot_w[e * CAP + r]; HID[(size_t)(hbe + r) * FF + col] = (bf16)f2bf(w * silu_f(c0[i]) * c1[i]); } }
            };
            sgemm_tile(rp, Wt, D, mt * 128, nt * 128, epi, F.wave, F.lane);
        }
        ubase += nu;
    }
}
__device__ __forceinline__ void phase_moe_down(Frame& F, int layer) {
    LAS int* mm = moe_map(F, layer);
    const bf16* HID = (const bf16*)(F.ws + WS_HID); bf16* Y = (bf16*)(F.ws + WS_Y);
    int ubase = 0;
#pragma unroll 1
    for (int e = 0; e < 16; ++e) {
        const int n = mm[e], hbe = mm[16 + e], rt = (n + 127) >> 7, nu = rt * 8;
        const bf16* Wt = (const bf16*)(F.ws + WS_WDN) + (size_t)(layer * 16 + e) * 1024 * 512;
        RowLin rp{HID + (size_t)hbe * FF, (size_t)FF};
        int first = (F.wg - ubase % F.G + F.G) % F.G;
        for (int u = first; u < nu; u += F.G) {
            const int mt = u / 8, nt = u % 8;
            auto epi = [&](int mb, int nb, const f32x16& c0, const f32x16& c1, int lane) {
                const int h = lane >> 5, cl = lane & 31;
#pragma unroll
                for (int i = 0; i < 16; ++i) { const int r = mb + crow(i, h);
                    if (r < n) { bf16* yr = Y + (size_t)(hbe + r) * D + nb + cl; yr[0] = (bf16)f2bf(c0[i]); yr[32] = (bf16)f2bf(c1[i]); } }
            };
            sgemm_tile(rp, Wt, FF, mt * 128, nt * 128, epi, F.wave, F.lane);
        }
        ubase += nu;
    }
}

template <bool FINAL>
__device__ __forceinline__ void phase_combine(Frame& F, int layer) {
    LAS int* hbs = moe_map(F, layer) + 16;
    const int gw = F.wg * NWAVES + F.wave, NGW = F.G * NWAVES;
    const float* mod = (const float*)(F.ws + WS_MOD);
    const int* tok_e = (const int*)(F.ws + WS_TOKE); const int* tok_p = (const int*)(F.ws + WS_TOKP);
    const bf16* Y = (const bf16*)(F.ws + WS_Y); float* X = F.out; bf16* XB = (bf16*)(F.ws + WS_XB); bf16* HB = (bf16*)(F.ws + WS_HB);
    for (int blk = gw; blk < T / 16; blk += NGW) {
        const int rbase = blk * 16, b = rbase >> 13;
        f32x4 g2v[4], gm[4], shv[4];
        { const float* g2 = mod + ((size_t)layer * 5 + b) * 6144 + 5120;
#pragma unroll
          for (int j = 0; j < 4; ++j) { const int o = ROFF(F.lane, j); g2v[j] = *(const f32x4*)(g2 + o);
              if (FINAL) { gm[j] = *(const f32x4*)(F.in[I_FNG] + o); shv[j] = (f32x4){0.f, 0.f, 0.f, 0.f}; }
              else { const float* m = mod + ((size_t)(layer + 1) * 5 + b) * 6144; gm[j] = *(const f32x4*)(F.in[I_NMG] + (layer + 1) * D + o) * (1.f + *(const f32x4*)(m + 1024 + o)); shv[j] = *(const f32x4*)(m + o); } } }
        int4 te = *(const int4*)(tok_e + 2 * rbase), tp = *(const int4*)(tok_p + 2 * rbase);
#pragma unroll 1
        for (int jr = 0; jr < 16; jr += 2) {
            const int row = rbase + jr;
            const int s00 = hbs[te.x] + tp.x, s01 = hbs[te.y] + tp.y, s10 = hbs[te.z] + tp.z, s11 = hbs[te.w] + tp.w;
            f32x4 v[2][4]; xrow_load(X, XB, (size_t)row, F.lane, v[0]); xrow_load(X, XB, (size_t)(row + 1), F.lane, v[1]);
            u32x2 y0[2][4], y1[2][4];
#pragma unroll
            for (int jj = 0; jj < 2; ++jj) { const int o = 512 * jj + 8 * F.lane;
                const u32x4 a0 = *(const u32x4*)(Y + (size_t)s00 * D + o), a1 = *(const u32x4*)(Y + (size_t)s01 * D + o), b0 = *(const u32x4*)(Y + (size_t)s10 * D + o), b1 = *(const u32x4*)(Y + (size_t)s11 * D + o);
                y0[0][2 * jj] = (u32x2){a0.x, a0.y}; y0[0][2 * jj + 1] = (u32x2){a0.z, a0.w}; y1[0][2 * jj] = (u32x2){a1.x, a1.y}; y1[0][2 * jj + 1] = (u32x2){a1.z, a1.w};
                y0[1][2 * jj] = (u32x2){b0.x, b0.y}; y0[1][2 * jj + 1] = (u32x2){b0.z, b0.w}; y1[1][2 * jj] = (u32x2){b1.x, b1.y}; y1[1][2 * jj + 1] = (u32x2){b1.z, b1.w}; }
            { const int nr = (jr + 2 < 16) ? row + 2 : row; te = *(const int4*)(tok_e + 2 * nr); tp = *(const int4*)(tok_p + 2 * nr); }
#pragma unroll
            for (int q = 0; q < 2; ++q)
#pragma unroll
                for (int j = 0; j < 4; ++j) { const f32x4 gg = g2v[j];
                    v[q][j].x += gg.x * (bflo(y0[q][j].x) + bflo(y1[q][j].x)); v[q][j].y += gg.y * (bfhi(y0[q][j].x) + bfhi(y1[q][j].x));
                    v[q][j].z += gg.z * (bflo(y0[q][j].y) + bflo(y1[q][j].y)); v[q][j].w += gg.w * (bfhi(y0[q][j].y) + bfhi(y1[q][j].y)); }
            const float rstd0 = rsqrtf(row_sumsq(v[0]) * (1.f / D) + EPS), rstd1 = rsqrtf(row_sumsq(v[1]) * (1.f / D) + EPS);
#pragma unroll
            for (int q = 0; q < 2; ++q) { const float rstd = q ? rstd1 : rstd0; const size_t ro = (size_t)(row + q) * D;
                if (FINAL) {
#pragma unroll
                    for (int j = 0; j < 4; ++j) *(f32x4*)(X + ro + ROFF(F.lane, j)) = v[q][j] * rstd * gm[j];
                } else {
                    if (XBF16) row_store_bf16(XB + ro, v[q], F.lane);
#pragma unroll
                    for (int j = 0; j < 4; ++j) { if (!XBF16) *(f32x4*)(X + ro + ROFF(F.lane, j)) = v[q][j]; v[q][j] = v[q][j] * rstd * gm[j] + shv[j]; }
                    row_store_bf16(HB + ro, v[q], F.lane);
                }
            }
        }
    }
    __syncthreads();
}

__device__ __forceinline__ void phase_pw1(Frame& F) {
    const bf16* HB = (const bf16*)(F.ws + WS_HB); const bf16* Wt = (const bf16*)(F.ws + WS_WPW1); bf16* U = (bf16*)(F.ws + WS_U);
    const float* bias = F.in[I_PW1B];
    RowLin rp{HB, (size_t)D};
    for (int u = F.wg; u < (T / 128) * 16; u += F.G) {
        const int mt = u / 16, nt = u % 16;
        auto epi = [&](int mb, int nb, const f32x16& c0, const f32x16& c1, int lane) {
            const int h = lane >> 5, cl = lane & 31, col = (nb >> 1) + cl; const float ba = bias[col], bg = bias[1024 + col];
#pragma unroll
            for (int i = 0; i < 16; ++i) U[(size_t)(mb + crow(i, h)) * D + col] = (bf16)f2bf((c0[i] + ba) * sigmoid_f(c1[i] + bg));
        };
        sgemm_tile(rp, Wt, D, mt * 128, nt * 128, epi, F.wave, F.lane);
    }
}
__device__ __forceinline__ void phase_dwconv(Frame& F) {
    const bf16* U = (const bf16*)(F.ws + WS_U); bf16* V1 = (bf16*)(F.ws + WS_V1);
    const float* dww = F.in[I_DWW]; const float* dwb = F.in[I_DWB]; const float* lng = F.in[I_LNG]; const float* lnb = F.in[I_LNB];
    const int gw = F.wg * NWAVES + F.wave, NGW = F.G * NWAVES;
    for (int row = gw; row < T; row += NGW) {
        const int l = row & (L - 1);
        f32x4 acc[4];
#pragma unroll
        for (int j = 0; j < 4; ++j) acc[j] = *(const f32x4*)(dwb + 4 * F.lane + 256 * j);
        for (int tp = 0; tp < CONVW; ++tp) { const int ll = l + tp - 15; if (ll < 0 || ll >= L) continue;
            const bf16* ur = U + (size_t)(row + tp - 15) * D; const float* wr = dww + (size_t)tp * D;
#pragma unroll
            for (int j = 0; j < 4; ++j) { const int o = 4 * F.lane + 256 * j; const u32x2 uu = *(const u32x2*)(ur + o); const f32x4 ww = *(const f32x4*)(wr + o);
                acc[j].x += bflo(uu.x) * ww.x; acc[j].y += bfhi(uu.x) * ww.y; acc[j].z += bflo(uu.y) * ww.z; acc[j].w += bfhi(uu.y) * ww.w; } }
        float s = 0.f;
#pragma unroll
        for (int j = 0; j < 4; ++j) s += (acc[j].x + acc[j].y) + (acc[j].z + acc[j].w);
        const float mean = wave_sum(s) * (1.f / D); float q = 0.f;
#pragma unroll
        for (int j = 0; j < 4; ++j) { acc[j] = acc[j] - mean; q += (acc[j].x * acc[j].x + acc[j].y * acc[j].y) + (acc[j].z * acc[j].z + acc[j].w * acc[j].w); }
        const float rstd = rsqrtf(wave_sum(q) * (1.f / D) + EPS);
#pragma unroll
        for (int j = 0; j < 4; ++j) { const int o = 4 * F.lane + 256 * j; const f32x4 gg = *(const f32x4*)(lng + o), bb = *(const f32x4*)(lnb + o);
            f32x4 y = acc[j] * rstd * gg + bb; y.x = silu_f(y.x); y.y = silu_f(y.y); y.z = silu_f(y.z); y.w = silu_f(y.w); acc[j] = y; }
        row_store_bf16(V1 + (size_t)row * D, acc, F.lane);
    }
}


namespace pg {
constexpr int BM = 256, BK = 64, HALF = 128, HTB = HALF * BK * 2, STAGE_BYTES = 8 * HTB;
constexpr int TAB_OFF = STAGE_BYTES;
__device__ __forceinline__ int lds_byte(int r, int c) { const int st = (r >> 4) * 2 + (c >> 5), rr = r & 15, cc = c & 31, ob = rr * 64 + cc * 2; return st * 1024 + (ob ^ (((ob >> 9) & 1) << 5)); }
__device__ __forceinline__ void stage_rc(int b, int& R, int& C) { const int st = b / 1024, sb = b % 1024, swz = sb ^ (((sb >> 9) & 1) << 5); R = (st >> 1) * 16 + swz / 64; C = (st & 1) * 32 + (swz % 64) / 2; }
__device__ __forceinline__ int perm32(int rho) { const int n = rho >> 4, i = rho & 15; return 8 * (i >> 2) + 4 * n + (i & 3); }
__device__ __forceinline__ unsigned cvt_pk_bf16(float lo, float hi) { unsigned r; asm volatile("v_cvt_pk_bf16_f32 %0, %1, %2" : "=v"(r) : "v"(lo), "v"(hi)); return r; }

struct GU { const char* B; int p0, p1, p2, p3; };

template <class Epi, class Sched>
__device__ __forceinline__ void gemm_phase(LAS unsigned char* lds, const char* Abase, const int K, const Sched& S, const Epi& E) {
    const int tid = threadIdx.x, wid = __builtin_amdgcn_readfirstlane(tid >> 6), lane = tid & 63, wr = wid >> 2, wc = wid & 3, fr = lane & 15, fq = lane >> 4;
    const int nt = K / BK;
    int sR[2], sC[2]; unsigned voffB[2];
#pragma unroll
    for (int i = 0; i < 2; ++i) { int R, C; stage_rc(tid * 16 + i * 8192, R, C); sR[i] = R; sC[i] = C; const int Rb = Epi::PERM ? ((R & ~31) + perm32(R & 31)) : R; voffB[i] = (unsigned)(Rb * K + C) * 2u; }
    const size_t kstep = (size_t)(BK * 2);
    const size_t hstep = (size_t)HALF * K * 2;
    const unsigned ldsw = (unsigned)wid * 1024u;
    const int aoff = lds_byte(wr * 64 + fr, fq * 8), boff = lds_byte(wc * 32 + fr, fq * 8);
#define PG_SA(b, h) (((b) * 2 + (h)) * HTB)
#define PG_SB(b, h) ((4 + (b) * 2 + (h)) * HTB)
#define PG_STAGE(bufoff, gbase, voff) do { _Pragma("unroll") for (int _i = 0; _i < 2; ++_i) \
        __builtin_amdgcn_global_load_lds((const unsigned*)((const char*)(gbase) + (voff)[_i]), (LAS unsigned*)(lds + (bufoff) + ldsw + _i * 8192), 16, 0, 0); } while (0)
#define PG_LDA(dst, b, h) do { _Pragma("unroll") for (int m = 0; m < 4; ++m) _Pragma("unroll") for (int k = 0; k < 2; ++k) dst[m][k] = *(const LAS bf16x8*)(lds + PG_SA(b, h) + aoff + m * 2048 + k * 1024); } while (0)
#define PG_LDB(dst, b, h) do { _Pragma("unroll") for (int n = 0; n < 2; ++n) _Pragma("unroll") for (int k = 0; k < 2; ++k) dst[n][k] = *(const LAS bf16x8*)(lds + PG_SB(b, h) + boff + n * 2048 + k * 1024); } while (0)
#define PG_MMA(ai, bj, At, Bt) do { __builtin_amdgcn_s_setprio(1); _Pragma("unroll") for (int m = 0; m < 4; ++m) _Pragma("unroll") for (int n = 0; n < 2; ++n) _Pragma("unroll") for (int k = 0; k < 2; ++k) \
        acc[ai][bj][m][n] = __builtin_amdgcn_mfma_f32_16x16x32_bf16(Bt[n][k], At[m][k], acc[ai][bj][m][n], 0, 0, 0); __builtin_amdgcn_s_setprio(0); } while (0)
#define PG_WAIT_V(n) asm volatile("s_waitcnt vmcnt(" #n ")" ::: "memory")
#define PG_WAIT_L(n) asm volatile("s_waitcnt lgkmcnt(" #n ")" ::: "memory")
#define PG_BAR __builtin_amdgcn_s_barrier()
#define PG_SCHED __builtin_amdgcn_sched_barrier(0)
    GU cur, nxt; int ui = 0;
    if (!S.next(0, cur)) return;
    f32x4 acc[2][2][4][2];
#pragma unroll
    for (int a = 0; a < 2; ++a)
#pragma unroll
        for (int b = 0; b < 2; ++b)
#pragma unroll
            for (int m = 0; m < 4; ++m)
#pragma unroll
                for (int n = 0; n < 2; ++n) acc[a][b][m][n] = (f32x4){0.f, 0.f, 0.f, 0.f};
    bf16x8 At[4][2], B0[2][2], B1[2][2];
    if constexpr (Sched::GATHER) { S.stage_table(cur, 0, lds, wid, lane); PG_WAIT_V(0); PG_BAR; }
    unsigned voC[2][2], voN[2][2];
#pragma unroll
    for (int h = 0; h < 2; ++h)
#pragma unroll
        for (int i = 0; i < 2; ++i) { voC[h][i] = S.voff(cur, 0, lds, h * HALF + sR[i], sC[i]); voN[h][i] = voC[h][i]; }
    const char* cB = cur.B;
    PG_STAGE(PG_SB(0, 0), cB, voffB); PG_STAGE(PG_SB(0, 1), cB + hstep, voffB); PG_STAGE(PG_SA(0, 0), Abase, voC[0]); PG_STAGE(PG_SA(0, 1), Abase, voC[1]);
    if (wr == 1) PG_BAR;
    PG_WAIT_V(2); PG_BAR;
    PG_STAGE(PG_SB(1, 0), cB + kstep, voffB); PG_STAGE(PG_SA(1, 0), Abase + kstep, voC[0]); PG_STAGE(PG_SB(1, 1), cB + hstep + kstep, voffB);
    PG_WAIT_V(6); PG_BAR;
    for (;;) {
        const bool has_next = S.next(ui + 1, nxt);
        if constexpr (Sched::GATHER) { if (has_next) S.stage_table(nxt, (ui + 1) & 1, lds, wid, lane); }
        const char* nB = has_next ? nxt.B : cB;
        for (int t = 0; t < nt; t += 2) {
            const bool last = (t == nt - 2);
            if (last && has_next) {
#pragma unroll
                for (int h = 0; h < 2; ++h)
#pragma unroll
                    for (int i = 0; i < 2; ++i) voN[h][i] = S.voff(nxt, (ui + 1) & 1, lds, h * HALF + sR[i], sC[i]);
            }
            unsigned vo2[2][2];
#pragma unroll
            for (int h = 0; h < 2; ++h)
#pragma unroll
                for (int i = 0; i < 2; ++i) vo2[h][i] = last ? voN[h][i] : voC[h][i];
            const char* a1 = Abase + (size_t)(t + 1) * kstep;
            const char* a2 = last ? Abase : Abase + (size_t)(t + 2) * kstep; const char* b2 = last ? nB : cB + (size_t)(t + 2) * kstep;
            const char* a3 = a2 + kstep; const char* b3 = b2 + kstep;
            PG_LDB(B0, 0, 0); PG_LDB(B1, 0, 1); PG_SCHED; PG_LDA(At, 0, 0); PG_STAGE(PG_SA(1, 1), a1, voC[1]);
            PG_WAIT_V(8); PG_WAIT_L(0); PG_BAR; PG_MMA(0, 0, At, B0); PG_MMA(0, 1, At, B1); PG_BAR; PG_SCHED;
            PG_LDA(At, 0, 1); PG_STAGE(PG_SB(0, 0), b2, voffB); PG_STAGE(PG_SB(0, 1), b2 + hstep, voffB); PG_STAGE(PG_SA(0, 0), a2, vo2[0]);
            PG_WAIT_V(8); PG_WAIT_L(0); PG_BAR; PG_MMA(1, 0, At, B0); PG_MMA(1, 1, At, B1); PG_BAR; PG_SCHED;
            PG_LDB(B0, 1, 0); PG_LDB(B1, 1, 1); PG_SCHED; PG_LDA(At, 1, 0); PG_STAGE(PG_SA(0, 1), a2, vo2[1]);
            PG_WAIT_V(8); PG_WAIT_L(0); PG_BAR; PG_MMA(0, 0, At, B0); PG_MMA(0, 1, At, B1); PG_BAR; PG_SCHED;
            PG_LDA(At, 1, 1); PG_STAGE(PG_SB(1, 0), b3, voffB); PG_STAGE(PG_SB(1, 1), b3 + hstep, voffB); PG_STAGE(PG_SA(1, 0), a3, vo2[0]);
            PG_WAIT_V(8); PG_WAIT_L(0); PG_BAR; PG_MMA(1, 0, At, B0); PG_MMA(1, 1, At, B1); PG_BAR; PG_SCHED;
        }
        if (wr == 0) PG_BAR;
        E(acc, cur, wr, wc, fr, fq);
        if (!has_next) break;
#pragma unroll
        for (int a = 0; a < 2; ++a)
#pragma unroll
            for (int b = 0; b < 2; ++b)
#pragma unroll
                for (int m = 0; m < 4; ++m)
#pragma unroll
                    for (int n = 0; n < 2; ++n) acc[a][b][m][n] = (f32x4){0.f, 0.f, 0.f, 0.f};
        cur = nxt; cB = nB; ++ui;
#pragma unroll
        for (int h = 0; h < 2; ++h)
#pragma unroll
            for (int i = 0; i < 2; ++i) voC[h][i] = voN[h][i];
        if (wr == 1) PG_BAR;
    }
    PG_WAIT_V(0);
    PG_BAR;
#undef PG_SA
#undef PG_SB
#undef PG_STAGE
#undef PG_LDA
#undef PG_LDB
#undef PG_MMA
#undef PG_WAIT_V
#undef PG_WAIT_L
#undef PG_BAR
#undef PG_SCHED
}

__device__ __forceinline__ void static_tile(int L, int nM, int nN, int& pm, int& pn) {
    const int nwg = nM * nN; int wgid = L; { const int q = nwg / 8, r = nwg % 8, xcd = wgid % 8, off = wgid / 8; wgid = (xcd < r ? xcd * (q + 1) : r * (q + 1) + (xcd - r) * q) + off; }
    const int nig = 8 * nN, gid = wgid / nig, fm = gid * 8, gsz = (nM - fm) < 8 ? (nM - fm) : 8;
    pm = fm + ((wgid % nig) % gsz); pn = (wgid % nig) / gsz;
}
struct DenseSched {
    static constexpr bool GATHER = false;
    const char* Bt; int K, nM, nN, G, c, xn, xm0, xpn;
    __device__ __forceinline__ bool next(int i, GU& u) const {
        const int L = i * G + c, nmain = nM * nN; int pm, pn;
        if (L < nmain) static_tile(L, nM, nN, pm, pn); else if (L < nmain + xn) { pm = xm0 + (L - nmain); pn = xpn; } else return false;
        u.B = Bt + (size_t)pn * BM * K * 2; u.p0 = pm; u.p1 = pn; u.p2 = 0; u.p3 = 0; return true;
    }
    __device__ __forceinline__ unsigned voff(const GU& u, int, LAS unsigned char*, int R, int C) const { return (unsigned)(((u.p0 * BM + R) * K + C) * 2); }
    __device__ __forceinline__ void stage_table(const GU&, int, LAS unsigned char*, int, int) const {}
};
template <bool GATHER_> struct MoeSched {
    static constexpr bool GATHER = GATHER_;
    const char* Wt; size_t wstride; int K; const int* list; LAS int* mm; int G, c;
    __device__ __forceinline__ bool next(int i, GU& u) const {
        int L = i * G + c;
        for (int e = 0; e < 16; ++e) { const int n = mm[e], nu = ((n + 255) >> 8) * 4;
            if (L < nu) { const int rt = L >> 2, pn = L & 3; u.B = Wt + (size_t)e * wstride + (size_t)pn * BM * K * 2; u.p0 = e; u.p1 = rt; u.p2 = pn; u.p3 = mm[16 + e]; return true; }
            L -= nu; }
        return false;
    }
    __device__ __forceinline__ unsigned voff(const GU& u, int buf, LAS unsigned char* lds, int R, int C) const {
        if constexpr (GATHER_) { const int tok = ((const LAS int*)(lds + TAB_OFF))[buf * 256 + R]; return (unsigned)((tok * K + C) * 2); }
        else return (unsigned)(((u.p3 + u.p1 * BM + R) * K + C) * 2);
    }
    __device__ __forceinline__ void stage_table(const GU& u, int buf, LAS unsigned char* lds, int wid, int lane) const {
        if constexpr (GATHER_) { const int r = (wid & 3) * 64 + lane;
            __builtin_amdgcn_global_load_lds((const unsigned*)(list + u.p0 * CAP + u.p1 * BM + r), (LAS unsigned*)(lds + TAB_OFF + buf * 1024 + (wid & 3) * 256), 4, 0, 0); }
    }
};

struct EpiInProj {
    static constexpr bool PERM = false;
    unsigned char* ws;
    __device__ __forceinline__ void operator()(const f32x4 (&acc)[2][2][4][2], const GU& u, int wr, int wc, int fr, int fq) const {
        const int pm = u.p0, pn = u.p1; const bool isctx = pm >= T / BM;
        float inv[4];
#pragma unroll
        for (int j = 0; j < 4; ++j) inv[j] = exp2f(-(float)(4 * fq + j) * (13.287712379549449f / 16.f));
#pragma unroll
        for (int bj = 0; bj < 2; ++bj) {
            const int cb = pn * BM + bj * HALF + wc * 32;
            bf16* dst; int pitch, cbase; bool rope = false;
            if (cb < 512) { dst = (bf16*)(ws + WS_UF); pitch = 512; cbase = 0; }
            else if (cb < 1024) { dst = (bf16*)(ws + WS_Q); pitch = 512; cbase = 512; rope = true; }
            else if (cb < 1152) { dst = isctx ? (bf16*)(ws + WS_CK) : (bf16*)(ws + WS_K); pitch = 128; cbase = 1024; rope = !isctx; }
            else { dst = isctx ? (bf16*)(ws + WS_CV) : (bf16*)(ws + WS_V); pitch = 128; cbase = 1152; }
            const bool bycol = ((cb >> 5) & 1) != 0;
#pragma unroll
            for (int ai = 0; ai < 2; ++ai)
#pragma unroll
                for (int m = 0; m < 4; ++m) {
                    const int row = pm * BM + ai * HALF + wr * 64 + m * 16 + fr;
                    f32x4 v0 = acc[ai][bj][m][0], v1 = acc[ai][bj][m][1];
                    if (rope) { const int l = row & (L - 1); const float pos = (float)(bycol ? (l & 63) : (l >> 6));
#pragma unroll
                        for (int j = 0; j < 4; ++j) { const float ang = pos * inv[j], cs = __cosf(ang), sn = __sinf(ang); const float x1 = v0[j], x2 = v1[j]; v0[j] = x1 * cs - x2 * sn; v1[j] = x1 * sn + x2 * cs; } }
                    const int orow = isctx ? row - T : row;
                    if (FAST_ATTN && cb >= 1152) {
                        const int kp = isctx ? CL : L, bb = isctx ? (orow >> 8) : (orow >> 13), key = isctx ? (orow & (CL - 1)) : (orow & (L - 1));
#pragma unroll
                        for (int n = 0; n < 2; ++n)
#pragma unroll
                            for (int j = 0; j < 4; ++j) { const int c = (cb - 1152) + 16 * n + 4 * fq + j;
                                dst[((size_t)bb * 128 + c) * kp + key] = (bf16)f2bf(n ? v1[j] : v0[j]); }
                        continue;
                    }
                    bf16* o = dst + (size_t)orow * pitch + (cb - cbase) + 4 * fq;
                    u32x2 w0, w1; w0.x = cvt_pk_bf16(v0[0], v0[1]); w0.y = cvt_pk_bf16(v0[2], v0[3]); w1.x = cvt_pk_bf16(v1[0], v1[1]); w1.y = cvt_pk_bf16(v1[2], v1[3]);
                    *(u32x2*)o = w0; *(u32x2*)(o + 16) = w1;
                }
        }
    }
};
struct EpiRes {
    static constexpr bool PERM = false;
    const float* base; float* X; const float* gate; const float* bias;
    __device__ __forceinline__ void operator()(const f32x4 (&acc)[2][2][4][2], const GU& u, int wr, int wc, int fr, int fq) const {
        const int row0 = u.p0 * BM + wr * 64 + fr, col0 = u.p1 * BM + wc * 32 + 4 * fq; const int b = (u.p0 * BM) >> 13;
        f32x4 gv[2][2], bv[2][2];
#pragma unroll
        for (int bj = 0; bj < 2; ++bj)
#pragma unroll
            for (int n = 0; n < 2; ++n) { gv[bj][n] = *(const f32x4*)(gate + (size_t)b * 6144 + col0 + bj * HALF + n * 16); bv[bj][n] = bias ? *(const f32x4*)(bias + col0 + bj * HALF + n * 16) : (f32x4){0.f, 0.f, 0.f, 0.f}; }
#pragma unroll
        for (int ai = 0; ai < 2; ++ai)
#pragma unroll
            for (int mp = 0; mp < 2; ++mp) {
                f32x4 bs[2][2][2];
#pragma unroll
                for (int mm = 0; mm < 2; ++mm) { const size_t off = (size_t)(row0 + ai * HALF + (2 * mp + mm) * 16) * D + col0;
#pragma unroll
                    for (int bj = 0; bj < 2; ++bj)
#pragma unroll
                        for (int n = 0; n < 2; ++n) bs[mm][bj][n] = *(const f32x4*)(base + off + bj * HALF + n * 16); }
#pragma unroll
                for (int mm = 0; mm < 2; ++mm) { const int m = 2 * mp + mm; const size_t off = (size_t)(row0 + ai * HALF + m * 16) * D + col0;
#pragma unroll
                    for (int bj = 0; bj < 2; ++bj)
#pragma unroll
                        for (int n = 0; n < 2; ++n) *(f32x4*)(X + off + bj * HALF + n * 16) = bs[mm][bj][n] + gv[bj][n] * (acc[ai][bj][m][n] + bv[bj][n]); }
                asm volatile("" ::: "memory"); }
    }
};
template <bool BASEBF> struct EpiResB {
    static constexpr bool PERM = false;
    const float* basef; bf16* XB; const float* gate; const float* bias;
    __device__ __forceinline__ void operator()(const f32x4 (&acc)[2][2][4][2], const GU& u, int wr, int wc, int fr, int fq) const {
        const int row0 = u.p0 * BM + wr * 64 + fr, col0 = u.p1 * BM + wc * 32 + 4 * fq; const int b = (u.p0 * BM) >> 13;
        f32x4 gv[2][2], bv[2][2];
#pragma unroll
        for (int bj = 0; bj < 2; ++bj)
#pragma unroll
            for (int n = 0; n < 2; ++n) { gv[bj][n] = *(const f32x4*)(gate + (size_t)b * 6144 + col0 + bj * HALF + n * 16); bv[bj][n] = bias ? *(const f32x4*)(bias + col0 + bj * HALF + n * 16) : (f32x4){0.f, 0.f, 0.f, 0.f}; }
#pragma unroll
        for (int ai = 0; ai < 2; ++ai)
#pragma unroll
            for (int mp = 0; mp < 2; ++mp) {
                f32x4 bs[2][2][2];
#pragma unroll
                for (int mm = 0; mm < 2; ++mm) { const size_t off = (size_t)(row0 + ai * HALF + (2 * mp + mm) * 16) * D + col0;
#pragma unroll
                    for (int bj = 0; bj < 2; ++bj)
#pragma unroll
                        for (int n = 0; n < 2; ++n) { if (BASEBF) { const u32x2 w = *(const u32x2*)(XB + off + bj * HALF + n * 16); bs[mm][bj][n] = (f32x4){bflo(w.x), bfhi(w.x), bflo(w.y), bfhi(w.y)}; }
                                                      else bs[mm][bj][n] = *(const f32x4*)(basef + off + bj * HALF + n * 16); } }
#pragma unroll
                for (int mm = 0; mm < 2; ++mm) { const int m = 2 * mp + mm; const size_t off = (size_t)(row0 + ai * HALF + m * 16) * D + col0;
#pragma unroll
                    for (int bj = 0; bj < 2; ++bj)
#pragma unroll
                        for (int n = 0; n < 2; ++n) { const f32x4 o = bs[mm][bj][n] + gv[bj][n] * (acc[ai][bj][m][n] + bv[bj][n]);
                            u32x2 w; w.x = cvt_pk_bf16(o[0], o[1]); w.y = cvt_pk_bf16(o[2], o[3]); *(u32x2*)(XB + off + bj * HALF + n * 16) = w; } }
                asm volatile("" ::: "memory"); }
    }
};
struct EpiGLU {
    static constexpr bool PERM = true;
    bf16* U; const float* bias;
    __device__ __forceinline__ void operator()(const f32x4 (&acc)[2][2][4][2], const GU& u, int wr, int wc, int fr, int fq) const {
        const int row0 = u.p0 * BM + wr * 64 + fr, col0 = u.p1 * HALF + wc * 32 + 8 * fq;
        f32x4 ba[2], bg[2];
#pragma unroll
        for (int n = 0; n < 2; ++n) { ba[n] = *(const f32x4*)(bias + col0 + 4 * n); bg[n] = *(const f32x4*)(bias + 1024 + col0 + 4 * n); }
#pragma unroll
        for (int ai = 0; ai < 2; ++ai)
#pragma unroll
            for (int m = 0; m < 4; ++m) { f32x4 o[2];
#pragma unroll
                for (int n = 0; n < 2; ++n) { const f32x4 a = acc[ai][0][m][n] + ba[n], g = acc[ai][1][m][n] + bg[n];
#pragma unroll
                    for (int j = 0; j < 4; ++j) o[n][j] = a[j] * sigmoid_f(g[j]); }
                u32x4 w; w.x = cvt_pk_bf16(o[0][0], o[0][1]); w.y = cvt_pk_bf16(o[0][2], o[0][3]); w.z = cvt_pk_bf16(o[1][0], o[1][1]); w.w = cvt_pk_bf16(o[1][2], o[1][3]);
                *(u32x4*)(U + (size_t)(row0 + ai * HALF + m * 16) * D + col0) = w; }
    }
};
struct EpiGateUp {
    static constexpr bool PERM = true;
    bf16* HID; const float* slot_w; LAS int* mm;
    __device__ __forceinline__ void operator()(const f32x4 (&acc)[2][2][4][2], const GU& u, int wr, int wc, int fr, int fq) const {
        const int e = u.p0, n_e = mm[e], r0 = u.p1 * BM + wr * 64 + fr, col0 = u.p2 * HALF + wc * 32 + 8 * fq;
        float wv[2][4];
#pragma unroll
        for (int ai = 0; ai < 2; ++ai)
#pragma unroll
            for (int m = 0; m < 4; ++m) wv[ai][m] = slot_w[e * CAP + r0 + ai * HALF + m * 16];
#pragma unroll
        for (int ai = 0; ai < 2; ++ai)
#pragma unroll
            for (int m = 0; m < 4; ++m) { const int r = r0 + ai * HALF + m * 16;
                if (r < n_e) { const float w = wv[ai][m]; f32x4 o[2];
#pragma unroll
                    for (int n = 0; n < 2; ++n) { const f32x4 g = acc[ai][0][m][n], up = acc[ai][1][m][n];
#pragma unroll
                        for (int j = 0; j < 4; ++j) o[n][j] = w * silu_f(g[j]) * up[j]; }
                    u32x4 q; q.x = cvt_pk_bf16(o[0][0], o[0][1]); q.y = cvt_pk_bf16(o[0][2], o[0][3]); q.z = cvt_pk_bf16(o[1][0], o[1][1]); q.w = cvt_pk_bf16(o[1][2], o[1][3]);
                    *(u32x4*)(HID + (size_t)(u.p3 + r) * FF + col0) = q; } }
    }
};
struct EpiDown {
    static constexpr bool PERM = true;
    bf16* Y; LAS int* mm;
    __device__ __forceinline__ void operator()(const f32x4 (&acc)[2][2][4][2], const GU& u, int wr, int wc, int fr, int fq) const {
        const int e = u.p0, n_e = mm[e], r0 = u.p1 * BM + wr * 64 + fr, col0 = u.p2 * BM + wc * 32 + 8 * fq;
#pragma unroll
        for (int ai = 0; ai < 2; ++ai)
#pragma unroll
            for (int m = 0; m < 4; ++m) { const int r = r0 + ai * HALF + m * 16;
                if (r < n_e) {
#pragma unroll
                    for (int bj = 0; bj < 2; ++bj) { const f32x4 v0 = acc[ai][bj][m][0], v1 = acc[ai][bj][m][1];
                        u32x4 q; q.x = cvt_pk_bf16(v0[0], v0[1]); q.y = cvt_pk_bf16(v0[2], v0[3]); q.z = cvt_pk_bf16(v1[0], v1[1]); q.w = cvt_pk_bf16(v1[2], v1[3]);
                        *(u32x4*)(Y + (size_t)(u.p3 + r) * D + col0 + bj * HALF) = q; } } }
    }
};
}

__device__ __forceinline__ void fast_inproj(Frame& F) {
    pg::DenseSched S{(const char*)(F.ws + WS_WIN), D, T / 256, N_IN / 256, F.G, F.wg, TC / 256, T / 256, 4};
    pg::EpiInProj E{F.ws};
    pg::gemm_phase(F.lds, (const char*)(F.ws + WS_HB), D, S, E);
}
__device__ __forceinline__ void fast_outproj(Frame& F, size_t a_off, size_t w_off, const float* base, float* X, const float* gate, const float* bias) {
    pg::DenseSched S{(const char*)(F.ws + w_off), D, T / 256, D / 256, F.G, F.wg, 0, 0, 0};
    if (XBF16) {
        if (base == X) { pg::EpiResB<true> E{nullptr, (bf16*)(F.ws + WS_XB), gate, bias}; pg::gemm_phase(F.lds, (const char*)(F.ws + a_off), D, S, E); }
        else { pg::EpiResB<false> E{base, (bf16*)(F.ws + WS_XB), gate, bias}; pg::gemm_phase(F.lds, (const char*)(F.ws + a_off), D, S, E); }
    } else { pg::EpiRes E{base, X, gate, bias}; pg::gemm_phase(F.lds, (const char*)(F.ws + a_off), D, S, E); }
}
__device__ __forceinline__ void fast_pw1(Frame& F) {
    pg::DenseSched S{(const char*)(F.ws + WS_WPW1), D, T / 256, 2048 / 256, F.G, F.wg, 0, 0, 0};
    pg::EpiGLU E{(bf16*)(F.ws + WS_U), F.in[I_PW1B]};
    pg::gemm_phase(F.lds, (const char*)(F.ws + WS_HB), D, S, E);
}
__device__ __forceinline__ void fast_moe_gateup(Frame& F, int layer) {
    LAS int* mm = moe_map(F, layer);
    pg::MoeSched<true> S{(const char*)(F.ws + WS_WGU) + (size_t)layer * 16 * 1024 * 1024 * 2, (size_t)1024 * 1024 * 2, D, (const int*)(F.ws + WS_SLOTT) + layer * 16 * CAP, mm, F.G, F.wg};
    pg::EpiGateUp E{(bf16*)(F.ws + WS_HID), (const float*)(F.ws + WS_SLOTW) + layer * 16 * CAP, mm};
    pg::gemm_phase(F.lds, (const char*)(F.ws + WS_HB), D, S, E);
}
__device__ __forceinline__ void fast_moe_down(Frame& F, int layer) {
    LAS int* mm = moe_map(F, layer);
    pg::MoeSched<false> S{(const char*)(F.ws + WS_WDN) + (size_t)layer * 16 * 1024 * 512 * 2, (size_t)1024 * 512 * 2, FF, nullptr, mm, F.G, F.wg};
    pg::EpiDown E{(bf16*)(F.ws + WS_Y), mm};
    pg::gemm_phase(F.lds, (const char*)(F.ws + WS_HID), FF, S, E);
}


struct AttnBlk { const bf16* kp; const bf16* vp; int pitch; int kb; bool valid, masked; };
__device__ __forceinline__ AttnBlk attn_blk(const unsigned char* ws, int bi, int b, int kvh, int qs) {
    AttnBlk a;
    if (bi < 8) { a.kp = (const bf16*)(ws + WS_CK) + (size_t)(b * CL + bi * 32) * 128 + kvh * 64; a.vp = (const bf16*)(ws + WS_CV) + (size_t)(b * 2 + kvh) * 64 * CL + bi * 32; a.pitch = CL; a.kb = 0; a.valid = true; a.masked = false; }
    else { const int kb = qs - 128 + 32 * (bi - 8); a.valid = (kb >= 0 && kb < L); a.kb = kb; a.masked = true; a.pitch = L;
        a.kp = (const bf16*)(ws + WS_K) + (size_t)(b * L + kb) * 128 + kvh * 64; a.vp = (const bf16*)(ws + WS_V) + (size_t)(b * 2 + kvh) * 64 * L + kb; }
    return a;
}
__device__ __forceinline__ void attn_load(const AttnBlk& a, int r, int h, bf16x8 (&kf)[4], u32x4 (&vf)[2][2]) {
    if (a.valid) {
#pragma unroll
        for (int s = 0; s < 4; ++s) kf[s] = *(const bf16x8*)(a.kp + (size_t)r * 128 + 16 * s + 8 * h);
#pragma unroll
        for (int db = 0; db < 2; ++db)
#pragma unroll
            for (int ks = 0; ks < 2; ++ks) { const bf16* vr = a.vp + (size_t)(32 * db + r) * a.pitch + 16 * ks + 4 * h;
                const u32x2 lo = *(const u32x2*)vr, hi = *(const u32x2*)(vr + 8); vf[db][ks] = (u32x4){lo.x, lo.y, hi.x, hi.y}; }
    }
}
__device__ __forceinline__ void attn_compute(const AttnBlk& a, int qs, int r, int h, const bf16x8 (&kf)[4], const u32x4 (&vf)[2][2], const bf16x8 (&qf)[2][4],
                                             f32x16 (&o)[2][2], float (&m)[2], float (&l)[2]) {
    if (!a.valid) return;
#pragma unroll
    for (int nq = 0; nq < 2; ++nq) {
        f32x16 st;
#pragma unroll
        for (int i = 0; i < 16; ++i) st[i] = 0.f;
#pragma unroll
        for (int s = 0; s < 4; ++s) st = __builtin_amdgcn_mfma_f32_32x32x16_bf16(kf[s], qf[nq][s], st, 0, 0, 0);
        float t[16]; float tmax = -INFINITY;
        const int dbase = a.kb - qs - 32 * nq - r + 4 * h;
#pragma unroll
        for (int i = 0; i < 16; ++i) { float v = st[i] * (0.125f * 1.4426950408889634f);
            if (a.masked) { const int df = dbase + (i & 3) + 8 * (i >> 2); v = (df >= -128 && df <= 128) ? v : -INFINITY; }
            t[i] = v; tmax = fmaxf(tmax, v); }
        tmax = fmaxf(tmax, __shfl_xor(tmax, 32));
        const float mn = fmaxf(m[nq], tmax), alpha = __builtin_amdgcn_exp2f(m[nq] - mn); m[nq] = mn;
        float ps = 0.f;
#pragma unroll
        for (int i = 0; i < 16; ++i) { t[i] = __builtin_amdgcn_exp2f(t[i] - mn); ps += t[i]; }
        l[nq] = l[nq] * alpha + ps;
#pragma unroll
        for (int i = 0; i < 16; ++i) { o[0][nq][i] *= alpha; o[1][nq][i] *= alpha; }
        bf16x8 pf[2];
#pragma unroll
        for (int ks = 0; ks < 2; ++ks) { const u32x4 w = {pkbf(t[8 * ks], t[8 * ks + 1]), pkbf(t[8 * ks + 2], t[8 * ks + 3]), pkbf(t[8 * ks + 4], t[8 * ks + 5]), pkbf(t[8 * ks + 6], t[8 * ks + 7])};
            pf[ks] = __builtin_bit_cast(bf16x8, w); }
#pragma unroll
        for (int db = 0; db < 2; ++db)
#pragma unroll
            for (int ks = 0; ks < 2; ++ks) o[db][nq] = __builtin_amdgcn_mfma_f32_32x32x16_bf16(__builtin_bit_cast(bf16x8, vf[db][ks]), pf[ks], o[db][nq], 0, 0, 0);
    }
}
__device__ __forceinline__ void phase_attn_mfma(Frame& F) {
    const bf16* Q = (const bf16*)(F.ws + WS_Q); bf16* MIX = (bf16*)(F.ws + WS_MIX);
    const int g = F.wave >> 1, half = F.wave & 1, r = F.lane & 31, h = F.lane >> 5;
    for (int item = F.wg; item < NB * 2 * 64; item += F.G) {
        const int qb = item & 63, kvh = (item >> 6) & 1, b = item >> 7, hd = kvh * 4 + g, qs = qb * 128 + half * 64;
        bf16x8 qf[2][4];
#pragma unroll
        for (int nq = 0; nq < 2; ++nq)
#pragma unroll
            for (int s = 0; s < 4; ++s) qf[nq][s] = *(const bf16x8*)(Q + (size_t)(b * L + qs + 32 * nq + r) * 512 + hd * 64 + 16 * s + 8 * h);
        f32x16 o[2][2];
#pragma unroll
        for (int db = 0; db < 2; ++db)
#pragma unroll
            for (int nq = 0; nq < 2; ++nq)
#pragma unroll
                for (int i = 0; i < 16; ++i) o[db][nq][i] = 0.f;
        float m[2], l[2];
        m[0] = m[1] = F.in[I_SINK][hd] * 1.4426950408889634f; l[0] = l[1] = (h == 0) ? 1.f : 0.f;
        bf16x8 kfA[4], kfB[4]; u32x4 vfA[2][2], vfB[2][2];
        AttnBlk ba = attn_blk(F.ws, 0, b, kvh, qs), bb;
        attn_load(ba, r, h, kfA, vfA);
#pragma unroll 1
        for (int bi = 0; bi < 18; bi += 2) {
            bb = attn_blk(F.ws, bi + 1, b, kvh, qs); attn_load(bb, r, h, kfB, vfB);
            attn_compute(ba, qs, r, h, kfA, vfA, qf, o, m, l);
            if (bi + 2 < 18) { ba = attn_blk(F.ws, bi + 2, b, kvh, qs); attn_load(ba, r, h, kfA, vfA); }
            attn_compute(bb, qs, r, h, kfB, vfB, qf, o, m, l);
        }
#pragma unroll
        for (int nq = 0; nq < 2; ++nq) {
            const float lt = l[nq] + __shfl_xor(l[nq], 32), il = 1.f / lt;
            bf16* orow = MIX + (size_t)(b * L + qs + 32 * nq + r) * 1024 + 512 + hd * 64;
#pragma unroll
            for (int db = 0; db < 2; ++db)
#pragma unroll
                for (int i4 = 0; i4 < 4; ++i4) { u32x2 w; w.x = pkbf(o[db][nq][4 * i4] * il, o[db][nq][4 * i4 + 1] * il); w.y = pkbf(o[db][nq][4 * i4 + 2] * il, o[db][nq][4 * i4 + 3] * il);
                    *(u32x2*)(orow + 32 * db + 8 * i4 + 4 * h) = w; }
        }
    }
}


__device__ __forceinline__ float half_max(float v) { const auto r = __builtin_amdgcn_permlane32_swap(__float_as_uint(v), __float_as_uint(v), false, false); return fmaxf(__uint_as_float(r[0]), __uint_as_float(r[1])); }
__device__ __forceinline__ float half_sum(float v) { const auto r = __builtin_amdgcn_permlane32_swap(__float_as_uint(v), __float_as_uint(v), false, false); return __uint_as_float(r[0]) + __uint_as_float(r[1]); }
constexpr int AT_KP = 72, AT_VP = 136;
constexpr int AT_KB = 128 * AT_KP * 2, AT_BUF = AT_KB + 64 * AT_VP * 2;
struct AtChunk { const bf16* kg; const bf16* vg; int vpitch, lc, b, kvh, qb, c; bool valid, local, any; };
__device__ __forceinline__ AtChunk at_chunk(const unsigned char* ws, int seq, int wg, int G) {
    AtChunk k; const int item = wg + (seq / 5) * G; k.c = seq % 5; k.any = item < NB * 2 * 64;
    k.qb = item & 63; k.kvh = (item >> 6) & 1; k.b = (item >> 7) & 3; k.local = k.c >= 2; k.lc = k.c - 2;
    if (!k.local) { k.valid = k.any; k.vpitch = CL; k.kg = (const bf16*)(ws + WS_CK) + (size_t)(k.b * CL + 128 * k.c) * 128 + k.kvh * 64; k.vg = (const bf16*)(ws + WS_CV) + (size_t)(k.b * 2 + k.kvh) * 64 * CL + 128 * k.c; }
    else { const int key0 = 128 * k.qb - 128 + 128 * k.lc; k.valid = k.any && key0 >= 0 && key0 < L; k.vpitch = L;
        k.kg = (const bf16*)(ws + WS_K) + (size_t)(k.b * L + key0) * 128 + k.kvh * 64; k.vg = (const bf16*)(ws + WS_V) + (size_t)(k.b * 2 + k.kvh) * 64 * L + key0; }
    return k;
}
__device__ __forceinline__ void at_issue(const AtChunk& k, int tid, u32x4 (&rg)[4]) {
    if (k.valid) {
#pragma unroll
        for (int i = 0; i < 2; ++i) { const int id = tid + 512 * i; rg[i] = *(const u32x4*)(k.kg + (size_t)(id >> 3) * 128 + (id & 7) * 8); }
#pragma unroll
        for (int i = 0; i < 2; ++i) { const int id = tid + 512 * i; rg[2 + i] = *(const u32x4*)(k.vg + (size_t)(id >> 4) * k.vpitch + (id & 15) * 8); }
    }
}
__device__ __forceinline__ void at_write(const AtChunk& k, LAS unsigned char* buf, int tid, const u32x4 (&rg)[4]) {
    if (k.valid) {
#pragma unroll
        for (int i = 0; i < 2; ++i) { const int id = tid + 512 * i; *(LAS u32x4*)(buf + (id >> 3) * (AT_KP * 2) + (id & 7) * 16) = rg[i]; }
#pragma unroll
        for (int i = 0; i < 2; ++i) { const int id = tid + 512 * i; *(LAS u32x4*)(buf + AT_KB + (id >> 4) * (AT_VP * 2) + (id & 15) * 16) = rg[2 + i]; }
    }
}
__device__ __forceinline__ void at_load(LAS unsigned char* buf, int blk, int r, int h, bf16x8 (&kf)[4], u32x4 (&vf)[2][2]) {
#pragma unroll
    for (int s2 = 0; s2 < 4; ++s2) kf[s2] = *(const LAS bf16x8*)(buf + (32 * blk + r) * (AT_KP * 2) + (16 * s2 + 8 * h) * 2);
#pragma unroll
    for (int db = 0; db < 2; ++db)
#pragma unroll
        for (int ks = 0; ks < 2; ++ks) { const LAS unsigned char* vr = buf + AT_KB + (32 * db + r) * (AT_VP * 2) + (32 * blk + 16 * ks + 4 * h) * 2;
            const u32x2 lo = *(const LAS u32x2*)vr, hi = *(const LAS u32x2*)(vr + 16); vf[db][ks] = (u32x4){lo.x, lo.y, hi.x, hi.y}; }
}
__device__ __forceinline__ void at_math(const bf16x8 (&kf)[4], const u32x4 (&vf)[2][2], bool masked, int kbrel, int r, int h, const bf16x8 (&qf)[2][4], f32x16 (&o)[2][2], float (&m)[2], float (&l)[2]) {
    constexpr float C = 0.125f * 1.4426950408889634f;
#pragma unroll
    for (int nq = 0; nq < 2; ++nq) {
        f32x16 st;
#pragma unroll
        for (int i = 0; i < 16; ++i) st[i] = 0.f;
#pragma unroll
        for (int s2 = 0; s2 < 4; ++s2) st = __builtin_amdgcn_mfma_f32_32x32x16_bf16(kf[s2], qf[nq][s2], st, 0, 0, 0);
        if (masked) { const int dbase = kbrel - 32 * nq - r + 4 * h;
#pragma unroll
            for (int i = 0; i < 16; ++i) { const int df = dbase + (i & 3) + 8 * (i >> 2); st[i] = (df >= -128 && df <= 128) ? st[i] : -INFINITY; } }
        float smax = st[0];
#pragma unroll
        for (int i = 1; i < 16; ++i) smax = fmaxf(smax, st[i]);
        smax = half_max(smax);
        const float mn = fmaxf(m[nq], smax * C), alpha = __builtin_amdgcn_exp2f(m[nq] - mn); m[nq] = mn;
        float t[16]; float ps = 0.f;
#pragma unroll
        for (int i = 0; i < 16; ++i) { t[i] = __builtin_amdgcn_exp2f(__builtin_fmaf(st[i], C, -mn)); ps += t[i]; }
        l[nq] = l[nq] * alpha + ps;
        if (__ballot(alpha != 1.f)) {
#pragma unroll
            for (int i = 0; i < 16; ++i) { o[0][nq][i] *= alpha; o[1][nq][i] *= alpha; } }
        bf16x8 pf[2];
#pragma unroll
        for (int ks = 0; ks < 2; ++ks) { const u32x4 w = {pkbf(t[8 * ks], t[8 * ks + 1]), pkbf(t[8 * ks + 2], t[8 * ks + 3]), pkbf(t[8 * ks + 4], t[8 * ks + 5]), pkbf(t[8 * ks + 6], t[8 * ks + 7])};
            pf[ks] = __builtin_bit_cast(bf16x8, w); }
#pragma unroll
        for (int db = 0; db < 2; ++db)
#pragma unroll
            for (int ks = 0; ks < 2; ++ks) o[db][nq] = __builtin_amdgcn_mfma_f32_32x32x16_bf16(__builtin_bit_cast(bf16x8, vf[db][ks]), pf[ks], o[db][nq], 0, 0, 0);
    }
}
__device__ __forceinline__ void phase_attn_lds(Frame& F) {
    const bf16* Q = (const bf16*)(F.ws + WS_Q); bf16* MIX = (bf16*)(F.ws + WS_MIX);
    const int g = F.wave >> 1, half = F.wave & 1, r = F.lane & 31, h = F.lane >> 5;
    __syncthreads();
    u32x4 rg[4];
    AtChunk ck = at_chunk(F.ws, 0, F.wg, F.G);
    if (!ck.any) return;
    at_issue(ck, F.tid, rg); at_write(ck, F.lds, F.tid, rg);
    __syncthreads();
    bf16x8 qf[2][4]; f32x16 o[2][2]; float m[2], l[2];
#pragma unroll 1
    for (int seq = 0; ck.any; ++seq) {
        LAS unsigned char* buf = F.lds + (seq & 1) * AT_BUF;
        const AtChunk nk = at_chunk(F.ws, seq + 1, F.wg, F.G);
        at_issue(nk, F.tid, rg);
        const int hd = ck.kvh * 4 + g, qs = ck.qb * 128 + half * 64;
        if (ck.c == 0) {
#pragma unroll
            for (int nq = 0; nq < 2; ++nq)
#pragma unroll
                for (int s2 = 0; s2 < 4; ++s2) qf[nq][s2] = *(const bf16x8*)(Q + (size_t)(ck.b * L + qs + 32 * nq + r) * 512 + hd * 64 + 16 * s2 + 8 * h);
#pragma unroll
            for (int db = 0; db < 2; ++db)
#pragma unroll
                for (int nq = 0; nq < 2; ++nq)
#pragma unroll
                    for (int i = 0; i < 16; ++i) o[db][nq][i] = 0.f;
            m[0] = m[1] = F.in[I_SINK][hd] * 1.4426950408889634f; l[0] = l[1] = (h == 0) ? 1.f : 0.f;
        }
        if (ck.valid) {
            int b0 = 0, b1 = 4;
            if (ck.local) { b0 = 2 * half - 4 * ck.lc; b0 = b0 < 0 ? 0 : b0; b1 = 2 * half + 10 - 4 * ck.lc; b1 = b1 > 4 ? 4 : b1; }
            if (b0 < b1) {
                bf16x8 kfA[4], kfB[4]; u32x4 vfA[2][2], vfB[2][2];
                at_load(buf, b0, r, h, kfA, vfA);
#pragma unroll 1
                for (int blk = b0; blk < b1; blk += 2) {
                    const int iA = 4 * ck.lc + blk - 2 * half, iB = iA + 1;
                    if (blk + 1 < b1) at_load(buf, blk + 1, r, h, kfB, vfB);
                    at_math(kfA, vfA, ck.local && (iA < 2 || iA > 7), 32 * iA - 128, r, h, qf, o, m, l);
                    if (blk + 1 < b1) {
                        if (blk + 2 < b1) at_load(buf, blk + 2, r, h, kfA, vfA);
                        at_math(kfB, vfB, ck.local && (iB < 2 || iB > 7), 32 * iB - 128, r, h, qf, o, m, l);
                    }
                }
            }
        }
        if (ck.c == 4) {
#pragma unroll
            for (int nq = 0; nq < 2; ++nq) {
                const float lt = half_sum(l[nq]), il = __builtin_amdgcn_rcpf(lt);
                bf16* orow = MIX + (size_t)(ck.b * L + qs + 32 * nq + r) * 1024 + 512 + hd * 64;
#pragma unroll
                for (int db = 0; db < 2; ++db)
#pragma unroll
                    for (int i4 = 0; i4 < 4; ++i4) { u32x2 w; w.x = pkbf(o[db][nq][4 * i4] * il, o[db][nq][4 * i4 + 1] * il); w.y = pkbf(o[db][nq][4 * i4 + 2] * il, o[db][nq][4 * i4 + 3] * il);
                        *(u32x2*)(orow + 32 * db + 8 * i4 + 4 * h) = w; }
            }
        }
        at_write(nk, F.lds + ((seq + 1) & 1) * AT_BUF, F.tid, rg);
        __syncthreads();
        ck = nk;
    }
}

constexpr int F1_PC = 136, F1_PW = 68, F2_P = 264;
constexpr int F1_CSC = 0, F1_CSS = 128 * F1_PC * 2, F1_C64 = 2 * 128 * F1_PC * 2, F1_S64 = F1_C64 + 64 * F1_PW * 2;
__device__ __forceinline__ bf16x8 pack8(float a0, float a1, float a2, float a3, float a4, float a5, float a6, float a7) {
    const u32x4 w = {pkbf(a0, a1), pkbf(a2, a3), pkbf(a4, a5), pkbf(a6, a7)}; return __builtin_bit_cast(bf16x8, w); }
__device__ __forceinline__ void phase_fft1_mfma(Frame& F) {
    __syncthreads();
    LAS bf16* csc = (LAS bf16*)(F.lds + F1_CSC); LAS bf16* css = (LAS bf16*)(F.lds + F1_CSS); LAS bf16* c64 = (LAS bf16*)(F.lds + F1_C64); LAS bf16* s64 = (LAS bf16*)(F.lds + F1_S64);
    for (int i = F.tid; i < 128 * 128; i += NTHR) { const int n = i >> 7, k = i & 127; const float ang = (float)((n * k) & 127) * (6.283185307179586f / 128.f);
        csc[n * F1_PC + k] = (bf16)f2bf(__cosf(ang)); css[n * F1_PC + k] = (bf16)f2bf(__sinf(ang)); }
    for (int i = F.tid; i < 64 * 64; i += NTHR) { const int c = i >> 6, a = i & 63; const float ang = (float)((c * a) & 63) * (6.283185307179586f / 64.f);
        c64[c * F1_PW + a] = (bf16)f2bf(__cosf(ang)); s64[c * F1_PW + a] = (bf16)f2bf(__sinf(ang)); }
    __syncthreads();
    const bf16* UF = (const bf16*)(F.ws + WS_UF); bf16* Gb = (bf16*)(F.ws + WS_G);
    const int r = F.lane & 31, h = F.lane >> 5, g = F.wave >> 1;
    for (int item = F.wg; item < NB * FN2; item += F.G) {
        const int b = item >> 7, bp = item & 127;
#pragma unroll 1
        for (int q = 0; q < 2; ++q) {
            const int cbk = 2 * F.wave + q, n = 32 * (cbk & 3) + r, ch = 32 * cbk + r;
            f32x16 zr[2], zi[2];
#pragma unroll
            for (int rb = 0; rb < 2; ++rb) {
                bf16x8 uf[8];
#pragma unroll
                for (int s2 = 0; s2 < 8; ++s2) uf[s2] = *(const bf16x8*)(UF + (size_t)(b * L + 128 * (32 * rb + r) + bp) * 512 + g * 128 + 16 * s2 + 8 * h);
#pragma unroll
                for (int i = 0; i < 16; ++i) { zr[rb][i] = 0.f; zi[rb][i] = 0.f; }
#pragma unroll
                for (int s2 = 0; s2 < 8; ++s2) { const bf16x8 bc = *(const LAS bf16x8*)(csc + n * F1_PC + 16 * s2 + 8 * h), bs = *(const LAS bf16x8*)(css + n * F1_PC + 16 * s2 + 8 * h);
                    zr[rb] = __builtin_amdgcn_mfma_f32_32x32x16_bf16(uf[s2], bc, zr[rb], 0, 0, 0); zi[rb] = __builtin_amdgcn_mfma_f32_32x32x16_bf16(uf[s2], bs, zi[rb], 0, 0, 0); }
                __builtin_amdgcn_sched_barrier(0);
            }
            bf16x8 zfr[4], zfi[4];
#pragma unroll
            for (int ks = 0; ks < 4; ++ks) { const int rb = ks >> 1, o = 8 * (ks & 1);
                zfr[ks] = pack8(zr[rb][o], zr[rb][o + 1], zr[rb][o + 2], zr[rb][o + 3], zr[rb][o + 4], zr[rb][o + 5], zr[rb][o + 6], zr[rb][o + 7]);
                zfi[ks] = pack8(-zi[rb][o], -zi[rb][o + 1], -zi[rb][o + 2], -zi[rb][o + 3], -zi[rb][o + 4], -zi[rb][o + 5], -zi[rb][o + 6], -zi[rb][o + 7]); }
            __builtin_amdgcn_sched_barrier(0);
#pragma unroll 1
            for (int rbc = 0; rbc < 2; ++rbc) {
                f32x16 gr, gi; const int cr = 32 * rbc + r;
#pragma unroll
                for (int i = 0; i < 16; ++i) { gr[i] = 0.f; gi[i] = 0.f; }
#pragma unroll
                for (int ks = 0; ks < 4; ++ks) {
                    const u32x2 cl = *(const LAS u32x2*)(c64 + cr * F1_PW + 16 * ks + 4 * h), chh = *(const LAS u32x2*)(c64 + cr * F1_PW + 16 * ks + 8 + 4 * h);
                    const u32x2 sl = *(const LAS u32x2*)(s64 + cr * F1_PW + 16 * ks + 4 * h), shh = *(const LAS u32x2*)(s64 + cr * F1_PW + 16 * ks + 8 + 4 * h);
                    const u32x4 sw = {sl.x, sl.y, shh.x, shh.y}; const u32x4 swn = sw ^ 0x80008000u;
                    const bf16x8 wc = __builtin_bit_cast(bf16x8, ((u32x4){cl.x, cl.y, chh.x, chh.y})), wsn = __builtin_bit_cast(bf16x8, sw), wsm = __builtin_bit_cast(bf16x8, swn);
                    gr = __builtin_amdgcn_mfma_f32_32x32x16_bf16(wc, zfr[ks], gr, 0, 0, 0); gr = __builtin_amdgcn_mfma_f32_32x32x16_bf16(wsn, zfi[ks], gr, 0, 0, 0);
                    gi = __builtin_amdgcn_mfma_f32_32x32x16_bf16(wc, zfi[ks], gi, 0, 0, 0); gi = __builtin_amdgcn_mfma_f32_32x32x16_bf16(wsm, zfr[ks], gi, 0, 0, 0); }
                __builtin_amdgcn_sched_barrier(0);
#pragma unroll
                for (int i = 0; i < 16; ++i) { const int c = 32 * rbc + crow(i, h); const float ang = (float)(bp * c) * (6.283185307179586f / 8192.f), cs = __cosf(ang), sn = __sinf(ang);
                    const float re = gr[i] * cs + gi[i] * sn, im = gi[i] * cs - gr[i] * sn;
                    bf16* o = Gb + (size_t)((b * FN1 + c) * FN2 + bp) * 1024 + ch; o[0] = (bf16)f2bf(re); o[512] = (bf16)f2bf(im);
                    if ((i & 3) == 3) __builtin_amdgcn_sched_barrier(0); }
            }
        }
    }
    __syncthreads();
}
__device__ __forceinline__ void phase_fft2_mfma(Frame& F) {
    __syncthreads();
    LAS bf16* t2 = (LAS bf16*)F.lds;
    for (int i = F.tid; i < 128 * 256; i += NTHR) { const int d = i >> 8, k = i & 255; const float ang = (float)((d * (k & 127)) & 127) * (6.283185307179586f / 128.f);
        t2[d * F2_P + k] = (bf16)f2bf(k < 128 ? __cosf(ang) : __sinf(ang)); }
    __syncthreads();
    const bf16* Gb = (const bf16*)(F.ws + WS_G); bf16* MIX = (bf16*)(F.ws + WS_MIX);
    const int r = F.lane & 31, h = F.lane >> 5;
    for (int item = F.wg; item < NB * FN1; item += F.G) {
        const int b = item >> 6, c = item & 63;
        const bf16* Gp = Gb + (size_t)((b * FN1 + c) * FN2) * 1024 + 64 * F.wave + r;
        f32x16 y[4][2];
#pragma unroll
        for (int rb = 0; rb < 4; ++rb)
#pragma unroll
            for (int cb = 0; cb < 2; ++cb)
#pragma unroll
                for (int i = 0; i < 16; ++i) y[rb][cb][i] = 0.f;
#pragma unroll 1
        for (int ks = 0; ks < 16; ++ks) {
            const bf16* p = Gp + (size_t)(16 * (ks & 7) + 8 * h) * 1024 + (ks >> 3) * 512;
            bf16x8 bfr[2];
#pragma unroll
            for (int cb = 0; cb < 2; ++cb) { unsigned e[8];
#pragma unroll
                for (int j = 0; j < 8; ++j) e[j] = p[(size_t)j * 1024 + 32 * cb];
                const u32x4 w = {e[0] | (e[1] << 16), e[2] | (e[3] << 16), e[4] | (e[5] << 16), e[6] | (e[7] << 16)}; bfr[cb] = __builtin_bit_cast(bf16x8, w); }
#pragma unroll
            for (int rb = 0; rb < 4; ++rb) { const bf16x8 a = *(const LAS bf16x8*)(t2 + (32 * rb + r) * F2_P + 16 * ks + 8 * h);
#pragma unroll
                for (int cb = 0; cb < 2; ++cb) y[rb][cb] = __builtin_amdgcn_mfma_f32_32x32x16_bf16(a, bfr[cb], y[rb][cb], 0, 0, 0); }
        }
#pragma unroll
        for (int rb = 0; rb < 4; ++rb)
#pragma unroll
            for (int cb = 0; cb < 2; ++cb)
#pragma unroll
                for (int i = 0; i < 16; ++i) { const int d = 32 * rb + crow(i, h); MIX[(size_t)(b * L + c + 64 * d) * 1024 + 64 * F.wave + 32 * cb + r] = (bf16)f2bf(y[rb][cb][i] * (1.f / 1024.f)); }
    }
    __syncthreads();
}


typedef float f32x2_t __attribute__((ext_vector_type(2)));
template <int IR> struct DwIn {
    static __device__ __forceinline__ void run(const unsigned (&uin)[62], const f32x2_t (&w)[31], f32x2_t (&o)[32]) {
        const f32x2_t x = {bflo(uin[IR]), bfhi(uin[IR])};
#pragma unroll
        for (int r = 0; r < 32; ++r) { if (IR - r >= 0 && IR - r <= 30) o[r] += w[(IR - r >= 0 && IR - r <= 30) ? IR - r : 0] * x; }
        DwIn<IR + 1>::run(uin, w, o);
    }
};
template <> struct DwIn<62> { static __device__ __forceinline__ void run(const unsigned (&)[62], const f32x2_t (&)[31], f32x2_t (&)[32]) {} };
template <int IR> struct DwIn16 {
    static __device__ __forceinline__ void run(const unsigned (&uin)[46], const f32x2_t (&w)[31], f32x2_t (&o)[16]) {
        const f32x2_t x = {bflo(uin[IR]), bfhi(uin[IR])};
#pragma unroll
        for (int r = 0; r < 16; ++r) { if (IR - r >= 0 && IR - r <= 30) o[r] += w[(IR - r >= 0 && IR - r <= 30) ? IR - r : 0] * x; }
        DwIn16<IR + 1>::run(uin, w, o);
    }
};
template <> struct DwIn16<46> { static __device__ __forceinline__ void run(const unsigned (&)[46], const f32x2_t (&)[31], f32x2_t (&)[16]) {} };
__device__ __forceinline__ void phase_dwconv_fast(Frame& F) {
    const bf16* U = (const bf16*)(F.ws + WS_U); bf16* V1 = (bf16*)(F.ws + WS_V1);
    const float* dww = F.in[I_DWW];
    const int c0 = 2 * F.tid;
    f32x2_t w[31];
#pragma unroll
    for (int j = 0; j < 31; ++j) w[j] = *(const f32x2_t*)(dww + (size_t)j * D + c0);
    const f32x2_t bb = *(const f32x2_t*)(F.in[I_DWB] + c0), gg = *(const f32x2_t*)(F.in[I_LNG] + c0), lb = *(const f32x2_t*)(F.in[I_LNB] + c0);
    LAS float* red = (LAS float*)F.lds;
    LAS float* stat = red + 16 * 8 * 2;
    __syncthreads();
    for (int run = F.wg; run < T / 128; run += F.G) {
        const int row0 = run * 128, l0 = row0 & (L - 1);
        unsigned uin[46], nx[16];
#pragma unroll
        for (int ir = 0; ir < 46; ++ir) { const int l = l0 - 15 + ir; const bool ok = (l >= 0 && l < L);
            const unsigned u = *(const unsigned*)(U + (size_t)(ok ? row0 - 15 + ir : row0) * D + c0); uin[ir] = ok ? u : 0u; }
#pragma unroll 1
        for (int step = 0; step < 8; ++step) {
            const int r0 = row0 + 16 * step;
            if (step < 7) {
#pragma unroll
                for (int j = 0; j < 16; ++j) { const int l = l0 + 16 * step + 31 + j; const bool ok = l < L;
                    const unsigned u = *(const unsigned*)(U + (size_t)(ok ? r0 + 31 + j : r0) * D + c0); nx[j] = ok ? u : 0u; }
            }
            f32x2_t o[16];
#pragma unroll
            for (int r = 0; r < 16; ++r) o[r] = bb;
            DwIn16<0>::run(uin, w, o);
#pragma unroll
            for (int r = 0; r < 16; ++r) { const float sm = wave_sum(o[r].x + o[r].y), sq = wave_sum(o[r].x * o[r].x + o[r].y * o[r].y);
                if (F.lane == 0) { red[(r * 8 + F.wave) * 2] = sm; red[(r * 8 + F.wave) * 2 + 1] = sq; } }
            __syncthreads();
            if (F.tid < 16) { float sm = 0.f, sq = 0.f;
#pragma unroll
                for (int wv = 0; wv < 8; ++wv) { sm += red[(F.tid * 8 + wv) * 2]; sq += red[(F.tid * 8 + wv) * 2 + 1]; }
                const float mean = sm * (1.f / D), var = fmaxf(sq * (1.f / D) - mean * mean, 0.f);
                stat[2 * F.tid] = mean; stat[2 * F.tid + 1] = rsqrtf(var + EPS); }
            __syncthreads();
#pragma unroll
            for (int r = 0; r < 16; ++r) { const float mean = stat[2 * r], rstd = stat[2 * r + 1];
                const float y0 = silu_f((o[r].x - mean) * rstd * gg.x + lb.x), y1 = silu_f((o[r].y - mean) * rstd * gg.y + lb.y);
                *(unsigned*)(V1 + (size_t)(r0 + r) * D + c0) = pkbf(y0, y1); }
#pragma unroll
            for (int i = 0; i < 30; ++i) uin[i] = uin[i + 16];
#pragma unroll
            for (int j = 0; j < 16; ++j) uin[30 + j] = nx[j];
        }
        __syncthreads();
    }
}

namespace pg {
struct MU { const char* B; const char* A; int K, type, e, rt, pn, hb; };
struct MoeMergedSched {
    const char* Wgu; const char* Wdn; const char* HBp; const char* HIDp; const int* list; LAS int* mm; unsigned* tcnt; unsigned* tmo; int G, c, U;
    __device__ __forceinline__ bool flat(int L, int type, MU& u) const {
        for (int e = 0; e < 16; ++e) { const int n = mm[e], nu = ((n + 255) >> 8) * 4;
            if (L < nu) { u.e = e; u.rt = L >> 2; u.pn = L & 3; u.hb = mm[16 + e]; u.type = type;
                if (type == 0) { u.K = D; u.A = HBp; u.B = Wgu + (size_t)e * (1024 * 1024 * 2) + (size_t)u.pn * BM * D * 2; }
                else { u.K = FF; u.A = HIDp; u.B = Wdn + (size_t)e * (1024 * 512 * 2) + (size_t)u.pn * BM * FF * 2; }
                return true; }
            L -= nu; }
        return false;
    }
    __device__ __forceinline__ bool next(int i, MU& u) const {
        const int ngu = c < U ? (U - 1 - c) / G + 1 : 0;
        if (i < ngu) return flat(i * G + c, 0, u);
        const int k = i - ngu, x = U % G; int j;
        if (c >= x) { if (k == 0) j = c - x; else j = (G - 1 - c) + (k - 1) * G + (G - x); } else j = (G - 1 - c) + k * G + (G - x);
        if (j >= U) return false;
        return flat(j, 1, u);
    }
    __device__ __forceinline__ unsigned voff(const MU& u, int buf, LAS unsigned char* lds, int R, int C) const {
        if (u.type == 0) { const int tok = ((const LAS int*)(lds + TAB_OFF))[buf * 256 + R]; return (unsigned)((tok * D + C) * 2); }
        return (unsigned)(((u.hb + u.rt * BM + R) * FF + C) * 2);
    }
    __device__ __forceinline__ void stage_table(const MU& u, int buf, LAS unsigned char* lds, int wid, int lane) const {
        const int r = (wid & 3) * 64 + lane;
        __builtin_amdgcn_global_load_lds((const unsigned*)(list + u.e * CAP + u.rt * BM + r), (LAS unsigned*)(lds + TAB_OFF + buf * 1024 + (wid & 3) * 256), 4, 0, 0);
    }
    __device__ __forceinline__ unsigned* tile_word(const MU& u) const { return tcnt + ((u.hb >> 8) + u.rt) * 64; }
    __device__ __forceinline__ void wait_ready(const MU& u, int wid) const {
        if (wid == 0) {
            unsigned* w = tile_word(u); unsigned spins = 0;
            while ((unsigned)__builtin_amdgcn_readfirstlane(__hip_atomic_load(w, __ATOMIC_RELAXED, __HIP_MEMORY_SCOPE_AGENT)) < 32u) {
                __builtin_amdgcn_s_sleep(2);
                if ((++spins & 255u) == 0u) { if (__builtin_amdgcn_readfirstlane(__hip_atomic_load(tmo, __ATOMIC_RELAXED, __HIP_MEMORY_SCOPE_AGENT)) != 0u) break;
                    if (spins > (1u << 20)) { __hip_atomic_store(tmo, 1u, __ATOMIC_RELAXED, __HIP_MEMORY_SCOPE_AGENT); break; } } }
            __builtin_amdgcn_fence(__ATOMIC_ACQUIRE, "agent");
            asm volatile("s_waitcnt vmcnt(0)" ::: "memory");
        }
        asm volatile("" ::: "memory"); __builtin_amdgcn_s_barrier(); asm volatile("" ::: "memory");
    }
};
struct EpiGateUpWT {
    __amdgpu_buffer_rsrc_t rsrc; const float* slot_w; LAS int* mm;
    __device__ __forceinline__ void operator()(const f32x4 (&acc)[2][2][4][2], const MU& u, int wr, int wc, int fr, int fq) const {
        const int e = u.e, n_e = mm[e], r0 = u.rt * BM + wr * 64 + fr, col0 = u.pn * HALF + wc * 32 + 8 * fq;
        float wv[2][4];
#pragma unroll
        for (int ai = 0; ai < 2; ++ai)
#pragma unroll
            for (int m = 0; m < 4; ++m) wv[ai][m] = slot_w[e * CAP + r0 + ai * HALF + m * 16];
#pragma unroll
        for (int ai = 0; ai < 2; ++ai)
#pragma unroll
            for (int m = 0; m < 4; ++m) { const int r = r0 + ai * HALF + m * 16;
                if (r < n_e) { const float w = wv[ai][m]; f32x4 o[2];
#pragma unroll
                    for (int n = 0; n < 2; ++n) { const f32x4 g = acc[ai][0][m][n], up = acc[ai][1][m][n];
#pragma unroll
                        for (int j = 0; j < 4; ++j) o[n][j] = w * silu_f(g[j]) * up[j]; }
                    u32x4 q; q.x = cvt_pk_bf16(o[0][0], o[0][1]); q.y = cvt_pk_bf16(o[0][2], o[0][3]); q.z = cvt_pk_bf16(o[1][0], o[1][1]); q.w = cvt_pk_bf16(o[1][2], o[1][3]);
                    __builtin_amdgcn_raw_buffer_store_b128(q, rsrc, (unsigned)(((u.hb + r) * FF + col0) * 2), 0, 16); } }
    }
};
struct EpiDownM {
    bf16* Y; LAS int* mm;
    __device__ __forceinline__ void operator()(const f32x4 (&acc)[2][2][4][2], const MU& u, int wr, int wc, int fr, int fq) const {
        const int e = u.e, n_e = mm[e], r0 = u.rt * BM + wr * 64 + fr, col0 = u.pn * BM + wc * 32 + 8 * fq;
#pragma unroll
        for (int ai = 0; ai < 2; ++ai)
#pragma unroll
            for (int m = 0; m < 4; ++m) { const int r = r0 + ai * HALF + m * 16;
                if (r < n_e) {
#pragma unroll
                    for (int bj = 0; bj < 2; ++bj) { const f32x4 v0 = acc[ai][bj][m][0], v1 = acc[ai][bj][m][1];
                        u32x4 q; q.x = cvt_pk_bf16(v0[0], v0[1]); q.y = cvt_pk_bf16(v0[2], v0[3]); q.z = cvt_pk_bf16(v1[0], v1[1]); q.w = cvt_pk_bf16(v1[2], v1[3]);
                        *(u32x4*)(Y + (size_t)(u.hb + r) * D + col0 + bj * HALF) = q; } } }
    }
};
__device__ __forceinline__ void gemm_phase_moe(LAS unsigned char* lds, const MoeMergedSched& S, const EpiGateUpWT& EA, const EpiDownM& EB) {
    const int tid = threadIdx.x, wid = __builtin_amdgcn_readfirstlane(tid >> 6), lane = tid & 63, wr = wid >> 2, wc = wid & 3, fr = lane & 15, fq = lane >> 4;
    int sR[2], sC[2]; unsigned vbA[2], vbD[2];
#pragma unroll
    for (int i = 0; i < 2; ++i) { int R, C; stage_rc(tid * 16 + i * 8192, R, C); sR[i] = R; sC[i] = C; const int Rb = (R & ~31) + perm32(R & 31);
        vbA[i] = (unsigned)(Rb * D + C) * 2u; vbD[i] = (unsigned)(Rb * FF + C) * 2u; }
    const size_t kstep = (size_t)(BK * 2);
    const unsigned ldsw = (unsigned)wid * 1024u;
    const int aoff = lds_byte(wr * 64 + fr, fq * 8), boff = lds_byte(wc * 32 + fr, fq * 8);
#define PG_SA(b, h) (((b) * 2 + (h)) * HTB)
#define PG_SB(b, h) ((4 + (b) * 2 + (h)) * HTB)
#define PG_STAGE(bufoff, gbase, voff) do { _Pragma("unroll") for (int _i = 0; _i < 2; ++_i) \
        __builtin_amdgcn_global_load_lds((const unsigned*)((const char*)(gbase) + (voff)[_i]), (LAS unsigned*)(lds + (bufoff) + ldsw + _i * 8192), 16, 0, 0); } while (0)
#define PG_LDA(dst, b, h) do { _Pragma("unroll") for (int m = 0; m < 4; ++m) _Pragma("unroll") for (int k = 0; k < 2; ++k) dst[m][k] = *(const LAS bf16x8*)(lds + PG_SA(b, h) + aoff + m * 2048 + k * 1024); } while (0)
#define PG_LDB(dst, b, h) do { _Pragma("unroll") for (int n = 0; n < 2; ++n) _Pragma("unroll") for (int k = 0; k < 2; ++k) dst[n][k] = *(const LAS bf16x8*)(lds + PG_SB(b, h) + boff + n * 2048 + k * 1024); } while (0)
#define PG_MMA(ai, bj, At, Bt) do { __builtin_amdgcn_s_setprio(1); _Pragma("unroll") for (int m = 0; m < 4; ++m) _Pragma("unroll") for (int n = 0; n < 2; ++n) _Pragma("unroll") for (int k = 0; k < 2; ++k) \
        acc[ai][bj][m][n] = __builtin_amdgcn_mfma_f32_16x16x32_bf16(Bt[n][k], At[m][k], acc[ai][bj][m][n], 0, 0, 0); __builtin_amdgcn_s_setprio(0); } while (0)
#define PG_WAIT_V(n) asm volatile("s_waitcnt vmcnt(" #n ")" ::: "memory")
#define PG_WAIT_L(n) asm volatile("s_waitcnt lgkmcnt(" #n ")" ::: "memory")
#define PG_BAR __builtin_amdgcn_s_barrier()
#define PG_SCHED __builtin_amdgcn_sched_barrier(0)
    MU cur, nxt; int ui = 0;
    if (!S.next(0, cur)) return;
    f32x4 acc[2][2][4][2];
#pragma unroll
    for (int a = 0; a < 2; ++a)
#pragma unroll
        for (int b = 0; b < 2; ++b)
#pragma unroll
            for (int m = 0; m < 4; ++m)
#pragma unroll
                for (int n = 0; n < 2; ++n) acc[a][b][m][n] = (f32x4){0.f, 0.f, 0.f, 0.f};
    bf16x8 At[4][2], B0[2][2], B1[2][2];
    if (cur.type == 0) { S.stage_table(cur, 0, lds, wid, lane); PG_WAIT_V(0); PG_BAR; } else S.wait_ready(cur, wid);
    unsigned voC[2][2], voN[2][2];
#pragma unroll
    for (int h = 0; h < 2; ++h)
#pragma unroll
        for (int i = 0; i < 2; ++i) { voC[h][i] = S.voff(cur, 0, lds, h * HALF + sR[i], sC[i]); voN[h][i] = voC[h][i]; }
    const char* cB = cur.B; const char* cA = cur.A; size_t hsC = (size_t)HALF * cur.K * 2; int nt = cur.K / BK;
    if (cur.type == 0) { PG_STAGE(PG_SB(0, 0), cB, vbA); PG_STAGE(PG_SB(0, 1), cB + hsC, vbA); } else { PG_STAGE(PG_SB(0, 0), cB, vbD); PG_STAGE(PG_SB(0, 1), cB + hsC, vbD); }
    PG_STAGE(PG_SA(0, 0), cA, voC[0]); PG_STAGE(PG_SA(0, 1), cA, voC[1]);
    if (wr == 1) PG_BAR;
    PG_WAIT_V(2); PG_BAR;
    if (cur.type == 0) { PG_STAGE(PG_SB(1, 0), cB + kstep, vbA); } else { PG_STAGE(PG_SB(1, 0), cB + kstep, vbD); }
    PG_STAGE(PG_SA(1, 0), cA + kstep, voC[0]);
    if (cur.type == 0) { PG_STAGE(PG_SB(1, 1), cB + hsC + kstep, vbA); } else { PG_STAGE(PG_SB(1, 1), cB + hsC + kstep, vbD); }
    PG_WAIT_V(6); PG_BAR;
    for (;;) {
        const bool has_next = S.next(ui + 1, nxt);
        if (has_next && nxt.type == 0) S.stage_table(nxt, (ui + 1) & 1, lds, wid, lane);
        const char* nB = has_next ? nxt.B : cB; const char* nA = has_next ? nxt.A : cA; const size_t hsN = has_next ? (size_t)HALF * nxt.K * 2 : hsC;
        for (int t = 0; t < nt; t += 2) {
            const bool last = (t == nt - 2);
            if (last && has_next) {
                if (nxt.type == 1) S.wait_ready(nxt, wid);
#pragma unroll
                for (int h = 0; h < 2; ++h)
#pragma unroll
                    for (int i = 0; i < 2; ++i) voN[h][i] = S.voff(nxt, (ui + 1) & 1, lds, h * HALF + sR[i], sC[i]);
            }
            unsigned vo2[2][2], vb2[2]; const bool b2gu = last ? (has_next ? nxt.type == 0 : cur.type == 0) : (cur.type == 0);
#pragma unroll
            for (int h = 0; h < 2; ++h)
#pragma unroll
                for (int i = 0; i < 2; ++i) vo2[h][i] = last ? voN[h][i] : voC[h][i];
#pragma unroll
            for (int i = 0; i < 2; ++i) vb2[i] = b2gu ? vbA[i] : vbD[i];
            const size_t hs2 = last ? hsN : hsC;
            const char* a1 = cA + (size_t)(t + 1) * kstep;
            const char* a2 = last ? nA : cA + (size_t)(t + 2) * kstep; const char* b2 = last ? nB : cB + (size_t)(t + 2) * kstep;
            const char* a3 = a2 + kstep; const char* b3 = b2 + kstep;
            PG_LDB(B0, 0, 0); PG_LDB(B1, 0, 1); PG_SCHED; PG_LDA(At, 0, 0); PG_STAGE(PG_SA(1, 1), a1, voC[1]);
            PG_WAIT_V(8); PG_WAIT_L(0); PG_BAR; PG_MMA(0, 0, At, B0); PG_MMA(0, 1, At, B1); PG_BAR; PG_SCHED;
            PG_LDA(At, 0, 1); PG_STAGE(PG_SB(0, 0), b2, vb2); PG_STAGE(PG_SB(0, 1), b2 + hs2, vb2); PG_STAGE(PG_SA(0, 0), a2, vo2[0]);
            PG_WAIT_V(8); PG_WAIT_L(0); PG_BAR; PG_MMA(1, 0, At, B0); PG_MMA(1, 1, At, B1); PG_BAR; PG_SCHED;
            PG_LDB(B0, 1, 0); PG_LDB(B1, 1, 1); PG_SCHED; PG_LDA(At, 1, 0); PG_STAGE(PG_SA(0, 1), a2, vo2[1]);
            PG_WAIT_V(8); PG_WAIT_L(0); PG_BAR; PG_MMA(0, 0, At, B0); PG_MMA(0, 1, At, B1); PG_BAR; PG_SCHED;
            PG_LDA(At, 1, 1); PG_STAGE(PG_SB(1, 0), b3, vb2); PG_STAGE(PG_SB(1, 1), b3 + hs2, vb2); PG_STAGE(PG_SA(1, 0), a3, vo2[0]);
            PG_WAIT_V(8); PG_WAIT_L(0); PG_BAR; PG_MMA(1, 0, At, B0); PG_MMA(1, 1, At, B1); PG_BAR; PG_SCHED;
        }
        if (wr == 0) PG_BAR;
        if (cur.type == 0) { EA(acc, cur, wr, wc, fr, fq);
            PG_WAIT_V(0);
            if (lane == 0) __hip_atomic_fetch_add(S.tile_word(cur), 1u, __ATOMIC_RELAXED, __HIP_MEMORY_SCOPE_AGENT); }
        else EB(acc, cur, wr, wc, fr, fq);
        if (!has_next) break;
#pragma unroll
        for (int a = 0; a < 2; ++a)
#pragma unroll
            for (int b = 0; b < 2; ++b)
#pragma unroll
                for (int m = 0; m < 4; ++m)
#pragma unroll
                    for (int n = 0; n < 2; ++n) acc[a][b][m][n] = (f32x4){0.f, 0.f, 0.f, 0.f};
        cur = nxt; cB = nB; cA = nA; hsC = hsN; nt = cur.K / BK; ++ui;
#pragma unroll
        for (int h = 0; h < 2; ++h)
#pragma unroll
            for (int i = 0; i < 2; ++i) voC[h][i] = voN[h][i];
        if (wr == 1) PG_BAR;
    }
    PG_WAIT_V(0);
    PG_BAR;
#undef PG_SA
#undef PG_SB
#undef PG_STAGE
#undef PG_LDA
#undef PG_LDB
#undef PG_MMA
#undef PG_WAIT_V
#undef PG_WAIT_L
#undef PG_BAR
#undef PG_SCHED
}
}
__device__ __forceinline__ void fast_moe_merged(Frame& F, int layer) {
    LAS int* mm = moe_map(F, layer);
    int U = 0;
    for (int e = 0; e < 16; ++e) U += ((mm[e] + 255) >> 8) * 4;
    pg::MoeMergedSched S{(const char*)(F.ws + WS_WGU) + (size_t)layer * 16 * 1024 * 1024 * 2, (const char*)(F.ws + WS_WDN) + (size_t)layer * 16 * 1024 * 512 * 2,
                         (const char*)(F.ws + WS_HB), (const char*)(F.ws + WS_HID), (const int*)(F.ws + WS_SLOTT) + layer * 16 * CAP, mm,
                         F.ctl + CW_TILE + layer * 288 * 64, F.ctl + CW_TMO2, F.G, F.wg, U};
    pg::EpiGateUpWT EA{__builtin_amdgcn_make_buffer_rsrc((void*)(F.ws + WS_HID), 0, HROWS * FF * 2, 0x00020000), (const float*)(F.ws + WS_SLOTW) + layer * 16 * CAP, mm};
    pg::EpiDownM EB{(bf16*)(F.ws + WS_Y), mm};
    pg::gemm_phase_moe(F.lds, S, EA, EB);
}

constexpr int NPH = 18;
__global__ void __launch_bounds__(NTHR, 2) mega(Args args) {
    extern __shared__ __attribute__((aligned(16))) unsigned char lds[];
    Frame F;
    F.lds = (LAS unsigned char*)lds;
    F.tid = threadIdx.x; F.lane = F.tid & 63; F.wave = __builtin_amdgcn_readfirstlane(F.tid >> 6);
    F.G = gridDim.x; F.wg = blockIdx.x;
    F.out = args.out; F.ws = args.ws; F.ctl = (unsigned*)(args.ws + WS_CTL);
    volatile LAS unsigned* bst = (volatile LAS unsigned*)(F.lds + LDS_BYTES - 16);
    if (F.tid < 4) bst[F.tid] = 0u;
    __syncthreads();
    const int lo = args.ph_lo, hi = args.ph_hi;
    XcdBarrier bar; bar.bar = F.ctl + CW_BAR; bar.x = 0; bar.st = bst;
    if (hi - lo > 1) bar = xcd_barrier_post(F.ctl + CW_BAR, bst);
#define IN(k) (lo <= (k) && (k) < hi)
#define SEAM(k) do { if (IN(k) && IN((k) + 1)) xcd_barrier(bar); } while (0)
    const float* mod = (const float*)(F.ws + WS_MOD);

#ifndef DBL_MASK
#define DBL_MASK 0x0u
#endif
#define RUN(k, body) do { if (IN(k)) { _Pragma("unroll 1") for (int _r = 0; _r < ((((DBL_MASK) >> (k)) & 1u) ? 2 : 1); ++_r) { if (_r) xcd_barrier(bar); F.lane = fresh_lane(); body; } } } while (0)
    RUN(0, phase_prep(F)); SEAM(0);
    RUN(1, phase_norm1_l0(F)); SEAM(1);
    RUN(2, if (FAST_GEMM) fast_inproj(F); else phase_inproj(F)); SEAM(2);
    if (IN(3)) { F.lane = fresh_lane();
#pragma unroll 1
        for (int _r = 0; _r < ((DBL_MASK & 0x100000u) ? 2 : 1); ++_r) { if (FAST_ATTN == 2 && FAST_GEMM) phase_attn_lds(F); else if (FAST_ATTN && FAST_GEMM) phase_attn_mfma(F); else phase_attn_simple(F); }
#pragma unroll 1
        for (int _r = 0; _r < ((DBL_MASK & 0x200000u) ? 2 : 1); ++_r) { if (FAST_FFT) phase_fft1_mfma(F); else phase_fft1_simple(F); }
    } SEAM(3);
    RUN(4, if (FAST_FFT) phase_fft2_mfma(F); else phase_fft2_simple(F)); SEAM(4);
    if (IN(5)) { if (!FAST_FFT) phase_fft3_simple(F); } if (!FAST_FFT) SEAM(5);
    RUN(6, if (FAST_GEMM) fast_outproj(F, WS_MIX, WS_WOUT, F.in[I_X], F.out, mod + 2048, nullptr); else phase_outproj(F, (const bf16*)(F.ws + WS_MIX), (const bf16*)(F.ws + WS_WOUT), F.in[I_X], F.out, mod + 2048, nullptr)); SEAM(6);
    if (IN(7)) { F.lane = fresh_lane(); if (XBF16) phase_norm2_route_mfma(F, 0); else phase_norm2_route(F, 0); } SEAM(7);
    if (MOE_MERGED && FAST_GEMM) { if (IN(8)) { F.lane = fresh_lane(); fast_moe_merged(F, 0); } if (IN(8) && IN(10)) xcd_barrier(bar); }
    else { RUN(8, if (FAST_GEMM) fast_moe_gateup(F, 0); else phase_moe_gateup(F, 0)); SEAM(8);
    RUN(9, if (FAST_GEMM) fast_moe_down(F, 0); else phase_moe_down(F, 0)); SEAM(9); }
    if (IN(10)) { F.lane = fresh_lane(); phase_combine<false>(F, 0); } SEAM(10);
    RUN(11, if (FAST_GEMM) fast_pw1(F); else phase_pw1(F)); SEAM(11);
    RUN(12, phase_dwconv_fast(F)); SEAM(12);
    if (IN(13)) { F.lane = fresh_lane(); if (FAST_GEMM) fast_outproj(F, WS_V1, WS_WPW2, F.out, F.out, mod + 5 * 6144 + 2048, F.in[I_PW2B]); else phase_outproj(F, (const bf16*)(F.ws + WS_V1), (const bf16*)(F.ws + WS_WPW2), F.out, F.out, mod + 5 * 6144 + 2048, F.in[I_PW2B]); } SEAM(13);
    if (IN(14)) { F.lane = fresh_lane(); if (XBF16) phase_norm2_route_mfma(F, 1); else phase_norm2_route(F, 1); } SEAM(14);
    if (MOE_MERGED && FAST_GEMM) { if (IN(15)) { F.lane = fresh_lane(); fast_moe_merged(F, 1); } if (IN(15) && IN(17)) xcd_barrier(bar); }
    else { RUN(15, if (FAST_GEMM) fast_moe_gateup(F, 1); else phase_moe_gateup(F, 1)); SEAM(15);
    RUN(16, if (FAST_GEMM) fast_moe_down(F, 1); else phase_moe_down(F, 1)); SEAM(16); }
    if (IN(17)) { F.lane = fresh_lane(); phase_combine<true>(F, 1); }
#undef RUN
#undef IN
#undef SEAM
}

extern "C" void kernel_launch(void* const* d_in, const int* in_sizes, int n_in, void* d_out, int out_size, void* d_ws, size_t ws_size, hipStream_t stream) {
    static int grid = 0;
    if (grid == 0) {
        if (n_in != 25 || out_size != T * D || ws_size < WS_END) { fprintf(stderr, "kernel_launch: unexpected shapes (n_in %d out %d ws %zu)\n", n_in, out_size, ws_size); grid = -1; return; }
        int dev = 0, cus = 0, per_cu = 0;
        if (hipGetDevice(&dev) != hipSuccess || hipDeviceGetAttribute(&cus, hipDeviceAttributeMultiprocessorCount, dev) != hipSuccess) { grid = -1; return; }
        if (hipFuncSetAttribute((const void*)mega, hipFuncAttributeMaxDynamicSharedMemorySize, LDS_BYTES) != hipSuccess) { fprintf(stderr, "kernel_launch: hipFuncSetAttribute failed\n"); grid = -1; return; }
        if (hipOccupancyMaxActiveBlocksPerMultiprocessor(&per_cu, (const void*)mega, NTHR, LDS_BYTES) != hipSuccess || per_cu < 1) { fprintf(stderr, "kernel_launch: occupancy query says %d\n", per_cu); }
        (void)hipGetLastError();
        grid = cus;
    }
    if (grid < 0) return;
    (void)hipMemsetAsync((char*)d_ws + WS_CTL, 0, CTL_BYTES, stream);
    Args a{};
    for (int i = 0; i < 25; ++i) a.in[i] = (const float*)d_in[i];
    a.out = (float*)d_out; a.ws = (unsigned char*)d_ws;
#if MK_ONE_LAUNCH
    a.ph_lo = 0; a.ph_hi = NPH;
    hipLaunchKernelGGL(mega, dim3(grid), dim3(NTHR), LDS_BYTES, stream, a);
#else
#ifndef PROBE_PHASE
#define PROBE_PHASE -1
#endif
    for (int p = 0; p < NPH; ++p) { a.ph_lo = p; a.ph_hi = p + 1; hipLaunchKernelGGL(mega, dim3(grid), dim3(NTHR), LDS_BYTES, stream, a);
        if (p == PROBE_PHASE) { if (p == 7 || p == 14) (void)hipMemsetAsync((char*)d_ws + WS_CTL, 0, CTL_BYTES, stream);
            hipLaunchKernelGGL(mega, dim3(grid), dim3(NTHR), LDS_BYTES, stream, a); } }
#endif
}
```

```cpp
#include <hip/hip_runtime.h>
#include <cstdio>

#ifndef MK_ONE_LAUNCH
#define MK_ONE_LAUNCH 1
#endif

#define GAS __attribute__((address_space(1)))
#define LAS __attribute__((address_space(3)))
typedef unsigned short bf16;
typedef short bf16x8 __attribute__((ext_vector_type(8)));
typedef float f32x4 __attribute__((ext_vector_type(4)));
typedef float f32x16 __attribute__((ext_vector_type(16)));
typedef unsigned u32x4 __attribute__((ext_vector_type(4)));
typedef unsigned u32x2 __attribute__((ext_vector_type(2)));

constexpr int D = 1024, NB = 4, L = 8192, T = NB * L, CL = 256, TC = NB * CL;
constexpr int NE = 16, FF = 512, CONVW = 31;
constexpr int N_IN = 1280;
constexpr int FN1 = 64, FN2 = 128;
#ifndef FAST_GEMM
#define FAST_GEMM 1
#endif
#ifndef MOE_MERGED
#define MOE_MERGED 1
#endif
#ifndef XBF16
#define XBF16 FAST_GEMM
#endif
#ifndef FAST_ATTN
#define FAST_ATTN 2
#endif
#ifndef FAST_FFT
#define FAST_FFT 1
#endif
constexpr int IL = FAST_GEMM ? 128 : 32;
constexpr float EPS = 1e-6f;
constexpr int NWAVES = 8, NTHR = 512;
constexpr int CAP = 32768;
constexpr int HROWS = 65536 + 4096;

constexpr size_t MiB = 1u << 20;
constexpr size_t WS_CTL = 0, CTL_BYTES = 1 * MiB;
constexpr size_t WS_MOD = 1 * MiB;
constexpr size_t WS_TW = 1 * MiB + 512 * 1024;
constexpr size_t WS_WIN = 2 * MiB, WS_WOUT = 6 * MiB, WS_WPW1 = 10 * MiB, WS_WPW2 = 14 * MiB;
constexpr size_t WS_WGU = 16 * MiB, WS_WDN = 80 * MiB;
constexpr size_t WS_TOKE = 112 * MiB, WS_TOKP = 113 * MiB, WS_TOKW = 114 * MiB;
constexpr size_t WS_SLOTT = 116 * MiB, WS_SLOTW = 120 * MiB;
constexpr size_t WS_HB = 128 * MiB;
constexpr size_t WS_UF = 196 * MiB, WS_Q = 228 * MiB, WS_K = 260 * MiB, WS_V = 268 * MiB, WS_CK = 276 * MiB, WS_CV = 277 * MiB;
constexpr size_t WS_G = 280 * MiB, WS_MIX = 344 * MiB, WS_AB = 408 * MiB;
constexpr size_t WS_XB = 408 * MiB;
constexpr size_t WS_HID = 196 * MiB, WS_Y = 264 * MiB;
constexpr size_t WS_U = 196 * MiB, WS_V1 = 260 * MiB;
constexpr size_t WS_END = 472 * MiB;
constexpr int CW_BAR = 4096;
constexpr int CW_CNT = 8192;
constexpr int CW_TILE = 16384;
constexpr int CW_TMO2 = 2048;

constexpr int LDS_BYTES = 147456;

__device__ __forceinline__ unsigned f2bf(float f) { unsigned u = __float_as_uint(f); return (u + 0x7fffu + ((u >> 16) & 1u)) >> 16; }
__device__ __forceinline__ float bf2f(unsigned b) { return __uint_as_float(b << 16); }
typedef __bf16 b16x2_t __attribute__((ext_vector_type(2)));
__device__ __forceinline__ unsigned pkbf(float a, float b) { typedef float f2 __attribute__((ext_vector_type(2))); f2 v = {a, b}; return __builtin_bit_cast(unsigned, __builtin_convertvector(v, b16x2_t)); }
__device__ __forceinline__ unsigned pk2(float lo, float hi) { return pkbf(lo, hi); }
__device__ __forceinline__ float bflo(unsigned w) { return __uint_as_float(w << 16); }
__device__ __forceinline__ float bfhi(unsigned w) { return __uint_as_float(w & 0xffff0000u); }
__device__ __forceinline__ float wave_sum(float v) {
    v += __builtin_bit_cast(float, __builtin_amdgcn_mov_dpp(__builtin_bit_cast(int, v), 0xB1, 0xf, 0xf, true));
    v += __builtin_bit_cast(float, __builtin_amdgcn_mov_dpp(__builtin_bit_cast(int, v), 0x4E, 0xf, 0xf, true));
    v += __builtin_bit_cast(float, __builtin_amdgcn_mov_dpp(__builtin_bit_cast(int, v), 0x141, 0xf, 0xf, true));
    v += __builtin_bit_cast(float, __builtin_amdgcn_mov_dpp(__builtin_bit_cast(int, v), 0x140, 0xf, 0xf, true));
    const int iv = __builtin_bit_cast(int, v);
    const float a = __builtin_bit_cast(float, __builtin_amdgcn_readlane(iv, 15)), b = __builtin_bit_cast(float, __builtin_amdgcn_readlane(iv, 31));
    const float c = __builtin_bit_cast(float, __builtin_amdgcn_readlane(iv, 47)), d = __builtin_bit_cast(float, __builtin_amdgcn_readlane(iv, 63));
    return (a + b) + (c + d);
}
__device__ __forceinline__ float silu_f(float x) { return x * __builtin_amdgcn_rcpf(1.f + __expf(-x)); }
__device__ __forceinline__ float sigmoid_f(float x) { return __builtin_amdgcn_rcpf(1.f + __expf(-x)); }
#define LDS_WAIT() asm volatile("s_waitcnt lgkmcnt(0)" ::: "memory")
__device__ __forceinline__ int fresh_lane() { int l; asm volatile("v_mbcnt_lo_u32_b32 %0, -1, 0\n\tv_mbcnt_hi_u32_b32 %0, -1, %0" : "=v"(l)); return l; }

#define XB_TMO      128
#define XB_XCNT(j)  (256  + 64 * (j))
#define XB_XSUB(j)  (1280 + 64 * (j))
#define XB_XGEN(j)  (2304 + 64 * (j))
#define XB_TOP      3328
#define XB_TOPGEN   3392
#define XCD_BAR_WORDS 3456
#define XB_SPIN_CAP (1u << 20)
__device__ __forceinline__ unsigned xb_ld(unsigned* p)              { return __hip_atomic_load(p, __ATOMIC_RELAXED, __HIP_MEMORY_SCOPE_AGENT); }
__device__ __forceinline__ unsigned xb_add(unsigned* p, unsigned v) { return __hip_atomic_fetch_add(p, v, __ATOMIC_RELAXED, __HIP_MEMORY_SCOPE_AGENT); }
__device__ __forceinline__ unsigned xb_xcc_id() { return (unsigned)__builtin_amdgcn_s_getreg((3 << 11) | 20) & 0xFu; }
#define XB_SPIN(cond, bar) do { unsigned _sp = 0; while (cond) { __builtin_amdgcn_s_sleep(1); \
    if ((++_sp & 255u) == 0u) { if (xb_ld(&(bar)[XB_TMO])) break; if (_sp > XB_SPIN_CAP) { atomicAdd(&(bar)[XB_TMO], 1u); break; } } } } while (0)
struct XcdBarrier { unsigned* bar; unsigned x; volatile LAS unsigned* st; };
__device__ __forceinline__ XcdBarrier xcd_barrier_post(unsigned* bar, volatile LAS unsigned* st) {
    XcdBarrier b; b.bar = bar; b.x = xb_xcc_id(); b.st = st;
    if (threadIdx.x == 0) (void)xb_add(&bar[XB_XCNT(b.x)], 1u);
    return b;
}
__device__ __forceinline__ void xcd_barrier_complete(unsigned* bar, unsigned x, unsigned& nloc, unsigned& nx) {
    const unsigned G = gridDim.x * gridDim.y * gridDim.z;
    unsigned sum, cnt, mine, sp = 0u;
    for (;;) {
        sum = 0u; cnt = 0u; mine = 0u;
#pragma unroll
        for (unsigned j = 0; j < 16; ++j) { const unsigned c = xb_ld(&bar[XB_XCNT(j)]); sum += c; cnt += (c > 0u) ? 1u : 0u; mine = (j == x) ? c : mine; }
        if (sum == G) break;
        __builtin_amdgcn_s_sleep(1);
        if ((++sp & 255u) == 0u) { if (xb_ld(&bar[XB_TMO])) break; if (sp > XB_SPIN_CAP) { atomicAdd(&bar[XB_TMO], 1u); break; } }
    }
    nloc = mine > 0u ? mine : 1u; nx = cnt > 0u ? cnt : 1u;
}
__device__ __forceinline__ void xcd_barrier(const XcdBarrier& b) {
    asm volatile("s_waitcnt vmcnt(0)" ::: "memory");
    __syncthreads();
    if (threadIdx.x == 0) {
        unsigned* bar = b.bar;
        __builtin_amdgcn_s_waitcnt(0);
        unsigned nloc = b.st[0], nx = b.st[1];
        if (nloc == 0u) { xcd_barrier_complete(bar, b.x, nloc, nx); b.st[0] = nloc; b.st[1] = nx; }
        const unsigned old = xb_add(&bar[XB_XSUB(b.x)], 1u);
        const unsigned gen = old / nloc;
        if (old + 1u == (gen + 1u) * nloc) {
            __builtin_amdgcn_fence(__ATOMIC_RELEASE, "agent");
            asm volatile("s_waitcnt vmcnt(0)" ::: "memory");
            const unsigned og = xb_add(&bar[XB_TOP], 1u);
            const unsigned tg = og / nx;
            if (og + 1u == (tg + 1u) * nx) xb_add(&bar[XB_TOPGEN], 1u);
            else XB_SPIN(xb_ld(&bar[XB_TOPGEN]) == tg, bar);
            __builtin_amdgcn_fence(__ATOMIC_ACQUIRE, "agent");
            xb_add(&bar[XB_XGEN(b.x)], 1u);
            asm volatile("s_waitcnt vmcnt(0)" ::: "memory");
        } else {
            XB_SPIN(xb_ld(&bar[XB_XGEN(b.x)]) == gen, bar);
            __builtin_amdgcn_fence(__ATOMIC_ACQUIRE, "agent");
            asm volatile("s_waitcnt vmcnt(0)" ::: "memory");
        }
    }
    __syncthreads();
}

struct Args { const float* in[25]; float* out; unsigned char* ws; int ph_lo, ph_hi; };
enum { I_X = 0, I_C, I_CTX, I_CCTX, I_ADAW, I_ADAB, I_NMG, I_NFG, I_WIN, I_WOUT, I_SINK, I_PW1W, I_PW1B, I_DWW, I_DWB, I_LNG, I_LNB,
       I_PW2W, I_PW2B, I_RW, I_RB, I_WG, I_WU, I_WD, I_FNG };

struct InPtrs {
    __device__ __forceinline__ const float* operator[](int i) const { const float* r;
        asm volatile("s_load_dwordx2 %0, %1, %2\n\ts_waitcnt lgkmcnt(0)" : "=s"(r) : "s"(__builtin_amdgcn_kernarg_segment_ptr()), "s"(i * 8)); return r; }
};
struct Frame {
    LAS unsigned char* lds;
    int tid, lane, wave, G, wg;
    InPtrs in;
    float* out;
    unsigned char* ws;
    unsigned* ctl;
};

__device__ __forceinline__ int crow(int i, int h) { return (i & 3) + 8 * (i >> 2) + 4 * h; }
template <class RowPtr, class Epi>
__device__ __forceinline__ void sgemm_tile(const RowPtr& rowptr, const bf16* Bt, int K, int m0, int n0, const Epi& epi, int wave, int lane) {
    const int wm = wave & 3, wn = wave >> 2, r = lane & 31, h = lane >> 5;
    const bf16* ap = rowptr(m0 + wm * 32 + r) + 8 * h;
    const bf16* bp0 = Bt + (size_t)(n0 + wn * 64 + r) * K + 8 * h;
    const bf16* bp1 = bp0 + (size_t)32 * K;
    f32x16 c0, c1;
#pragma unroll
    for (int i = 0; i < 16; ++i) { c0[i] = 0.f; c1[i] = 0.f; }
#pragma unroll 2
    for (int k = 0; k < K; k += 32) {
        const bf16x8 a0 = *(const bf16x8*)(ap + k), a1 = *(const bf16x8*)(ap + k + 16);
        const bf16x8 b00 = *(const bf16x8*)(bp0 + k), b01 = *(const bf16x8*)(bp0 + k + 16);
        const bf16x8 b10 = *(const bf16x8*)(bp1 + k), b11 = *(const bf16x8*)(bp1 + k + 16);
        c0 = __builtin_amdgcn_mfma_f32_32x32x16_bf16(a0, b00, c0, 0, 0, 0);
        c1 = __builtin_amdgcn_mfma_f32_32x32x16_bf16(a0, b10, c1, 0, 0, 0);
        c0 = __builtin_amdgcn_mfma_f32_32x32x16_bf16(a1, b01, c0, 0, 0, 0);
        c1 = __builtin_amdgcn_mfma_f32_32x32x16_bf16(a1, b11, c1, 0, 0, 0);
    }
    epi(m0 + wm * 32, n0 + wn * 64, c0, c1, lane);
}

__device__ __forceinline__ void p0_transpose_item(const float* W, int K, int N, bf16* WT, int k0, int n0, int drow0, LAS float* scr, int lane) {
#pragma unroll 8
    for (int i = 0; i < 32; ++i) { const int kk = 2 * i + (lane >> 5); scr[kk * 33 + (lane & 31)] = W[(size_t)(k0 + kk) * N + n0 + (lane & 31)]; }
    LDS_WAIT(); asm volatile("" ::: "memory");
    const int c = lane & 7;
#pragma unroll
    for (int j = 0; j < 4; ++j) { const int n = (lane >> 3) + 8 * j; const LAS float* s = scr + (8 * c) * 33 + n;
        u32x4 o; o.x = pk2(s[0 * 33], s[1 * 33]); o.y = pk2(s[2 * 33], s[3 * 33]); o.z = pk2(s[4 * 33], s[5 * 33]); o.w = pk2(s[6 * 33], s[7 * 33]);
        *(u32x4*)(WT + (size_t)(drow0 + n) * K + k0 + 8 * c) = o; }
    LDS_WAIT(); asm volatile("" ::: "memory");
}
__device__ __forceinline__ int il_row(int j, int half) { return (j / IL) * (2 * IL) + half * IL + (j % IL); }

struct TItem { const float* W; bf16* WT; int K, N, k0, n0, drow0; bool ok; };
__device__ __forceinline__ TItem t_decode(const Frame& F, int it) {
    constexpr int S0 = 640, S1 = 512, S2 = 1024, S3 = 512, SM = 32 * 256;
    TItem t; t.ok = it < S0 + S1 + S2 + S3 + 3 * SM; t.W = F.in[I_WIN]; t.WT = (bf16*)(F.ws + WS_WIN); t.K = 1024; t.N = 1280; t.k0 = 0; t.n0 = 0; t.drow0 = 0;
    int r = it;
    if (r < S0) { const int kb = r / 40, nb = r % 40; t.k0 = kb * 64; t.n0 = nb * 32; t.drow0 = nb * 32; return t; } r -= S0;
    if (r < S1) { const int kb = r / 32, nb = r % 32; t.W = F.in[I_WOUT]; t.WT = (bf16*)(F.ws + WS_WOUT); t.N = 1024; t.k0 = kb * 64; t.n0 = nb * 32; t.drow0 = nb * 32; return t; } r -= S1;
    if (r < S2) { const int kb = r / 64, nb = r % 64, n0 = nb * 32; t.W = F.in[I_PW1W]; t.WT = (bf16*)(F.ws + WS_WPW1); t.N = 2048; t.k0 = kb * 64; t.n0 = n0; t.drow0 = il_row(n0 & 1023, n0 >> 10); return t; } r -= S2;
    if (r < S3) { const int kb = r / 32, nb = r % 32; t.W = F.in[I_PW2W]; t.WT = (bf16*)(F.ws + WS_WPW2); t.N = 1024; t.k0 = kb * 64; t.n0 = nb * 32; t.drow0 = nb * 32; return t; } r -= S3;
    if (r < SM) { const int le = r >> 8, q = r & 255, kb = q / 16, nb = q % 16; t.W = F.in[I_WG] + (size_t)le * 1024 * 512; t.WT = (bf16*)(F.ws + WS_WGU) + (size_t)le * 1024 * 1024; t.N = 512; t.k0 = kb * 64; t.n0 = nb * 32; t.drow0 = il_row(nb * 32, 0); return t; } r -= SM;
    if (r < SM) { const int le = r >> 8, q = r & 255, kb = q / 16, nb = q % 16; t.W = F.in[I_WU] + (size_t)le * 1024 * 512; t.WT = (bf16*)(F.ws + WS_WGU) + (size_t)le * 1024 * 1024; t.N = 512; t.k0 = kb * 64; t.n0 = nb * 32; t.drow0 = il_row(nb * 32, 1); return t; } r -= SM;
    { const int le = (r >> 8) & 31, q = r & 255, kb = q / 32, nb = q % 32; t.W = F.in[I_WD] + (size_t)le * 512 * 1024; t.WT = (bf16*)(F.ws + WS_WDN) + (size_t)le * 1024 * 512; t.K = 512; t.N = 1024; t.k0 = kb * 64; t.n0 = nb * 32; t.drow0 = nb * 32; }
    return t;
}
__device__ __forceinline__ void t_load(const TItem& t, int lane, float (&v)[32]) {
    if (t.ok) {
#pragma unroll
        for (int i = 0; i < 32; ++i) v[i] = t.W[(size_t)(t.k0 + 2 * i + (lane >> 5)) * t.N + t.n0 + (lane & 31)];
    }
}
__device__ __forceinline__ void t_store(const TItem& t, LAS float* scr, int lane, const float (&v)[32]) {
#pragma unroll
    for (int i = 0; i < 32; ++i) scr[(2 * i + (lane >> 5)) * 33 + (lane & 31)] = v[i];
    LDS_WAIT(); asm volatile("" ::: "memory");
    const int c = lane & 7;
#pragma unroll
    for (int j = 0; j < 4; ++j) { const int n = (lane >> 3) + 8 * j; const LAS float* s = scr + (8 * c) * 33 + n;
        u32x4 o; o.x = pk2(s[0 * 33], s[1 * 33]); o.y = pk2(s[2 * 33], s[3 * 33]); o.z = pk2(s[4 * 33], s[5 * 33]); o.w = pk2(s[6 * 33], s[7 * 33]);
        *(u32x4*)(t.WT + (size_t)(t.drow0 + n) * t.K + t.k0 + 8 * c) = o; }
    LDS_WAIT(); asm volatile("" ::: "memory");
}
__device__ __forceinline__ void phase_prep(Frame& F) {
    {
        LAS float* sc = (LAS float*)F.lds;
        LAS float* red = sc + 5 * 1024;
        bool loaded = false;
        for (int it = F.wg; it < 192; it += F.G) {
            if (!loaded) {
                for (int i = F.tid; i < 5 * 1024; i += NTHR) { const int b = i >> 10, k = i & 1023; const float v = b < 4 ? F.in[I_C][b * 1024 + k] : F.in[I_CCTX][k]; sc[i] = silu_f(v); }
                __syncthreads(); loaded = true;
            }
            const int l = it / 96, n0 = (it % 96) * 64, c4 = F.tid & 15, kg = F.tid >> 4;
            const float* w = F.in[I_ADAW] + (size_t)l * 1024 * 6144 + n0 + 4 * c4;
            f32x4 a[5];
#pragma unroll
            for (int b = 0; b < 5; ++b) a[b] = (f32x4){0.f, 0.f, 0.f, 0.f};
#pragma unroll 16
            for (int kk = 0; kk < 32; ++kk) { const int k = kg * 32 + kk; const f32x4 wv = *(const f32x4*)(w + (size_t)k * 6144);
#pragma unroll
                for (int b = 0; b < 5; ++b) a[b] += sc[b * 1024 + k] * wv; }
#pragma unroll
            for (int b = 0; b < 5; ++b) *(LAS f32x4*)(red + (kg * 5 + b) * 64 + 4 * c4) = a[b];
            __syncthreads();
            if (F.tid < 320) { const int b = F.tid >> 6, c2 = F.tid & 63; float sm = 0.f;
#pragma unroll
                for (int g = 0; g < 32; ++g) sm += red[(g * 5 + b) * 64 + c2];
                ((float*)(F.ws + WS_MOD))[((size_t)l * 5 + b) * 6144 + n0 + c2] = sm + F.in[I_ADAB][l * 6144 + n0 + c2]; }
            __syncthreads();
        }
        __syncthreads();
    }
    { u32x4* z = (u32x4*)(F.ws + WS_SLOTT); const u32x4 zero = {0u, 0u, 0u, 0u};
      for (int i = F.wg * NTHR + F.tid; i < 2 * 16 * CAP / 4; i += F.G * NTHR) z[i] = zero; }
    { float* tw = (float*)(F.ws + WS_TW);
      for (int k = F.wg * NTHR + F.tid; k < 8192; k += F.G * NTHR) { const float a = (float)k * (6.283185307179586f / 8192.f); tw[2 * k] = __cosf(a); tw[2 * k + 1] = __sinf(a); } }
    {
        LAS float* scr = (LAS float*)(F.lds + F.wave * 8704);
        const int gw = F.wg * NWAVES + F.wave, NGW = F.G * NWAVES;
        TItem cur = t_decode(F, gw); float va[32], vb[32];
        t_load(cur, F.lane, va);
#pragma unroll 1
        for (int it = gw; cur.ok; it += NGW) {
            const TItem nxt = t_decode(F, it + NGW);
            t_load(nxt, F.lane, vb);
            t_store(cur, scr, F.lane, va);
#pragma unroll
            for (int i = 0; i < 32; ++i) va[i] = vb[i];
            cur = nxt;
        }
    }
}

#define ROFF(lane, j) (512 * ((j) >> 1) + 8 * (lane) + 4 * ((j) & 1))
__device__ __forceinline__ void row_load(const float* p, int lane, f32x4 (&v)[4]) {
#pragma unroll
    for (int j = 0; j < 4; ++j) v[j] = *(const f32x4*)(p + ROFF(lane, j));
}
__device__ __forceinline__ void row_load_bf(const bf16* p, int lane, f32x4 (&v)[4]) {
#pragma unroll
    for (int jj = 0; jj < 2; ++jj) { const u32x4 w = *(const u32x4*)(p + 512 * jj + 8 * lane); v[2 * jj] = (f32x4){bflo(w.x), bfhi(w.x), bflo(w.y), bfhi(w.y)}; v[2 * jj + 1] = (f32x4){bflo(w.z), bfhi(w.z), bflo(w.w), bfhi(w.w)}; }
}
__device__ __forceinline__ void xrow_load(const float* xf, const bf16* xb, size_t row, int lane, f32x4 (&v)[4]) { if (XBF16) row_load_bf(xb + row * D, lane, v); else row_load(xf + row * D, lane, v); }
__device__ __forceinline__ float row_sumsq(const f32x4 (&v)[4]) {
    float s = 0.f;
#pragma unroll
    for (int j = 0; j < 4; ++j) s += (v[j].x * v[j].x + v[j].y * v[j].y) + (v[j].z * v[j].z + v[j].w * v[j].w);
    return wave_sum(s);
}
__device__ __forceinline__ void row_modulate(f32x4 (&v)[4], float rstd, const float* g, const float* sh, const float* sc, int lane) {
#pragma unroll
    for (int j = 0; j < 4; ++j) { const int o = ROFF(lane, j); const f32x4 gg = *(const f32x4*)(g + o), s1 = *(const f32x4*)(sc + o), s0 = *(const f32x4*)(sh + o);
        v[j] = v[j] * rstd * gg * (1.f + s1) + s0; }
}
__device__ __forceinline__ void row_store_bf16(bf16* dst, const f32x4 (&v)[4], int lane) {
#pragma unroll
    for (int jj = 0; jj < 2; ++jj) { u32x4 w; w.x = pk2(v[2 * jj].x, v[2 * jj].y); w.y = pk2(v[2 * jj].z, v[2 * jj].w); w.z = pk2(v[2 * jj + 1].x, v[2 * jj + 1].y); w.w = pk2(v[2 * jj + 1].z, v[2 * jj + 1].w); *(u32x4*)(dst + 512 * jj + 8 * lane) = w; }
}

__device__ __forceinline__ void phase_norm1_l0(Frame& F) {
    const int gw = F.wg * NWAVES + F.wave, NGW = F.G * NWAVES;
    const float* mod = (const float*)(F.ws + WS_MOD);
    bf16* HB = (bf16*)(F.ws + WS_HB);
    for (int row = gw; row < T + TC; row += NGW) {
        const float* src = row < T ? F.in[I_X] + (size_t)row * D : F.in[I_CTX] + (size_t)(row - T) * D;
        const int b = row < T ? (row >> 13) : 4;
        f32x4 v[4]; row_load(src, F.lane, v);
        const float rstd = rsqrtf(row_sumsq(v) * (1.f / D) + EPS);
        const float* m = mod + (size_t)b * 6144;
        row_modulate(v, rstd, F.in[I_NMG], m, m + 1024, F.lane);
        row_store_bf16(HB + (size_t)row * D, v, F.lane);
    }
}

struct RowLin { const bf16* base; size_t pitch; __device__ __forceinline__ const bf16* operator()(int m) const { return base + (size_t)m * pitch; } };

__device__ __forceinline__ void inproj_block(Frame& F, int mb, int nbk, const f32x16& c, int lane) {
    const int h = lane >> 5, cl = lane & 31;
    bf16* dst; int pitch, cbase; bool rope = false; bool isctx = (mb >= T);
    if (nbk < 512) { dst = (bf16*)(F.ws + WS_UF); pitch = 512; cbase = 0; }
    else if (nbk < 1024) { dst = (bf16*)(F.ws + WS_Q); pitch = 512; cbase = 512; rope = true; }
    else if (nbk < 1152) { dst = isctx ? (bf16*)(F.ws + WS_CK) : (bf16*)(F.ws + WS_K); pitch = 128; cbase = 1024; rope = !isctx; }
    else { dst = isctx ? (bf16*)(F.ws + WS_CV) : (bf16*)(F.ws + WS_V); pitch = 128; cbase = 1152; }
    const int rbase = isctx ? mb - T : mb;
    const int col = nbk - cbase + cl;
    const float inv = exp2f(-(float)(cl & 15) * (13.287712379549449f / 16.f));
    const bool second = (cl & 16) != 0; const bool bycol = ((nbk >> 5) & 1) != 0;
#pragma unroll
    for (int i = 0; i < 16; ++i) {
        const int rr = crow(i, h); float v = c[i];
        if (rope) {
            const float partner = __shfl_xor(v, 16);
            const int l = (mb + rr) & (L - 1);
            const float pos = (float)(bycol ? (l & 63) : (l >> 6));
            const float ang = pos * inv, cs = __cosf(ang), sn = __sinf(ang);
            v = second ? (partner * sn + v * cs) : (v * cs - partner * sn);
        }
        dst[(size_t)(rbase + rr) * pitch + col] = (bf16)f2bf(v);
    }
}
__device__ __forceinline__ void phase_inproj(Frame& F) {
    const bf16* HB = (const bf16*)(F.ws + WS_HB); const bf16* Wt = (const bf16*)(F.ws + WS_WIN);
    constexpr int MT = (T + TC) / 128, NT = N_IN / 128;
    RowLin rp{HB, (size_t)D};
    for (int u = F.wg; u < MT * NT; u += F.G) {
        const int mt = u / NT, nt = u % NT;
        if (mt >= T / 128 && nt < 8) continue;
        auto epi = [&](int mb, int nb, const f32x16& c0, const f32x16& c1, int lane) { inproj_block(F, mb, nb, c0, lane); inproj_block(F, mb, nb + 32, c1, lane); };
        sgemm_tile(rp, Wt, D, mt * 128, nt * 128, epi, F.wave, F.lane);
    }
}

__device__ __forceinline__ void attn_key(const bf16* kp, const bf16* vp, const float (&q)[64], float& m, float& s, float (&o)[64]) {
    float dot = 0.f;
#pragma unroll
    for (int j = 0; j < 8; ++j) { const u32x4 w = *(const u32x4*)(kp + 8 * j);
        dot += q[8 * j + 0] * bflo(w.x) + q[8 * j + 1] * bfhi(w.x) + q[8 * j + 2] * bflo(w.y) + q[8 * j + 3] * bfhi(w.y)
             + q[8 * j + 4] * bflo(w.z) + q[8 * j + 5] * bfhi(w.z) + q[8 * j + 6] * bflo(w.w) + q[8 * j + 7] * bfhi(w.w); }
    const float mn = fmaxf(m, dot), alpha = __expf(m - mn), p = __expf(dot - mn);
    s = s * alpha + p; m = mn;
#pragma unroll
    for (int j = 0; j < 8; ++j) { const u32x4 w = *(const u32x4*)(vp + 8 * j);
        o[8 * j + 0] = o[8 * j + 0] * alpha + p * bflo(w.x); o[8 * j + 1] = o[8 * j + 1] * alpha + p * bfhi(w.x);
        o[8 * j + 2] = o[8 * j + 2] * alpha + p * bflo(w.y); o[8 * j + 3] = o[8 * j + 3] * alpha + p * bfhi(w.y);
        o[8 * j + 4] = o[8 * j + 4] * alpha + p * bflo(w.z); o[8 * j + 5] = o[8 * j + 5] * alpha + p * bfhi(w.z);
        o[8 * j + 6] = o[8 * j + 6] * alpha + p * bflo(w.w); o[8 * j + 7] = o[8 * j + 7] * alpha + p * bfhi(w.w); }
}
__device__ __forceinline__ void phase_attn_simple(Frame& F) {
    const bf16* Q = (const bf16*)(F.ws + WS_Q); const bf16* Kb = (const bf16*)(F.ws + WS_K); const bf16* Vb = (const bf16*)(F.ws + WS_V);
    const bf16* CK = (const bf16*)(F.ws + WS_CK); const bf16* CV = (const bf16*)(F.ws + WS_CV); bf16* MIX = (bf16*)(F.ws + WS_MIX);
    for (int idx = F.wg * NTHR + F.tid; idx < T * 8; idx += F.G * NTHR) {
        const int hd = idx / T, t = idx % T, b = t >> 13, l = t & (L - 1), kvh = hd >> 2;
        float q[64], o[64];
#pragma unroll
        for (int j = 0; j < 8; ++j) { const u32x4 w = *(const u32x4*)(Q + (size_t)t * 512 + hd * 64 + 8 * j);
            q[8 * j + 0] = bflo(w.x) * 0.125f; q[8 * j + 1] = bfhi(w.x) * 0.125f; q[8 * j + 2] = bflo(w.y) * 0.125f; q[8 * j + 3] = bfhi(w.y) * 0.125f;
            q[8 * j + 4] = bflo(w.z) * 0.125f; q[8 * j + 5] = bfhi(w.z) * 0.125f; q[8 * j + 6] = bflo(w.w) * 0.125f; q[8 * j + 7] = bfhi(w.w) * 0.125f; }
#pragma unroll
        for (int j = 0; j < 64; ++j) o[j] = 0.f;
        float m = F.in[I_SINK][hd], s = 1.f;
        for (int c = 0; c < CL; ++c) { const size_t r = (size_t)(b * CL + c) * 128 + kvh * 64; attn_key(CK + r, CV + r, q, m, s, o); }
        const int lo = l - 128 < 0 ? 0 : l - 128, hi = l + 128 > L - 1 ? L - 1 : l + 128;
        for (int kp = lo; kp <= hi; ++kp) { const size_t r = (size_t)(b * L + kp) * 128 + kvh * 64; attn_key(Kb + r, Vb + r, q, m, s, o); }
        const float is = 1.f / s;
#pragma unroll
        for (int j = 0; j < 8; ++j) { u32x4 w; w.x = pk2(o[8 * j] * is, o[8 * j + 1] * is); w.y = pk2(o[8 * j + 2] * is, o[8 * j + 3] * is); w.z = pk2(o[8 * j + 4] * is, o[8 * j + 5] * is); w.w = pk2(o[8 * j + 6] * is, o[8 * j + 7] * is);
            *(u32x4*)(MIX + (size_t)t * 1024 + 512 + hd * 64 + 8 * j) = w; }
    }
}

__device__ __forceinline__ void phase_fft1_simple(Frame& F) {
    const bf16* UF = (const bf16*)(F.ws + WS_UF); bf16* Gb = (bf16*)(F.ws + WS_G); const float* tw = (const float*)(F.ws + WS_TW);
    for (int idx = F.wg * NTHR + F.tid; idx < NB * FN1 * FN2 * 512; idx += F.G * NTHR) {
        const int ch = idx & 511, bp = (idx >> 9) & 127, c = (idx >> 16) & 63, b = idx >> 22;
        float re = 0.f, im = 0.f;
        for (int a = 0; a < FN1; ++a) { const float u = bf2f(UF[(size_t)(b * L + 128 * a + bp) * 512 + ch]); const int k = ((a * c) & 63) * 128;
            re += u * tw[2 * k]; im -= u * tw[2 * k + 1]; }
        const int k2 = bp * c; const float cs = tw[2 * k2], sn = tw[2 * k2 + 1];
        const float gr = re * cs + im * sn, gi = im * cs - re * sn;
        const size_t row = (size_t)(b * FN1 + c) * FN2 + bp;
        Gb[row * 1024 + ch] = (bf16)f2bf(gr); Gb[row * 1024 + 512 + ch] = (bf16)f2bf(gi);
    }
}
__device__ __forceinline__ void phase_fft2_simple(Frame& F) {
    const bf16* Gb = (const bf16*)(F.ws + WS_G); bf16* AB = (bf16*)(F.ws + WS_AB); const float* tw = (const float*)(F.ws + WS_TW);
    for (int idx = F.wg * NTHR + F.tid; idx < NB * FN1 * FN2 * 512; idx += F.G * NTHR) {
        const int ch = idx & 511, d = (idx >> 9) & 127, c = (idx >> 16) & 63, b = idx >> 22;
        float fr = 0.f, fi = 0.f;
        for (int bp = 0; bp < FN2; ++bp) { const size_t row = (size_t)(b * FN1 + c) * FN2 + bp; const float gr = bf2f(Gb[row * 1024 + ch]), gi = bf2f(Gb[row * 1024 + 512 + ch]);
            const int k = ((bp * d) & 127) * 64; const float cs = tw[2 * k], sn = tw[2 * k + 1];
            fr += gr * cs + gi * sn; fi += gi * cs - gr * sn; }
        const size_t t = (size_t)b * L + c + 64 * d;
        AB[t * 1024 + ch] = (bf16)f2bf(fr); AB[t * 1024 + 512 + ch] = (bf16)f2bf(-fi);
    }
}
__device__ __forceinline__ void phase_fft3_simple(Frame& F) {
    const bf16* AB = (const bf16*)(F.ws + WS_AB); bf16* MIX = (bf16*)(F.ws + WS_MIX); const float* tw = (const float*)(F.ws + WS_TW);
    LAS float* t128 = (LAS float*)F.lds;
    for (int i = F.tid; i < 128; i += NTHR) { t128[2 * i] = tw[2 * (i * 64)]; t128[2 * i + 1] = tw[2 * (i * 64) + 1]; }
    __syncthreads();
    for (int idx = F.wg * NTHR + F.tid; idx < T * 512; idx += F.G * NTHR) {
        const int cp = idx & 127, g = (idx >> 7) & 3, t = idx >> 9;
        const bf16* arow = AB + (size_t)t * 1024 + g * 128;
        float y = 0.f;
        for (int cc = 0; cc < 128; ++cc) { const int k = (cc * cp) & 127; y += bf2f(arow[cc]) * t128[2 * k] - bf2f(arow[512 + cc]) * t128[2 * k + 1]; }
        MIX[(size_t)t * 1024 + g * 128 + cp] = (bf16)f2bf(y * (1.f / 1024.f));
    }
    __syncthreads();
}

__device__ __forceinline__ void phase_outproj(Frame& F, const bf16* A, const bf16* Wt, const float* base, float* X, const float* gate  , const float* bias) {
    RowLin rp{A, (size_t)D};
    for (int u = F.wg; u < (T / 128) * 8; u += F.G) {
        const int mt = u / 8, nt = u % 8;
        auto epi = [&](int mb, int nb, const f32x16& c0, const f32x16& c1, int lane) {
            const int h = lane >> 5, cl = lane & 31, b = mb >> 13;
#pragma unroll
            for (int half = 0; half < 2; ++half) { const int col = nb + 32 * half + cl; const float gv = gate[(size_t)b * 6144 + col], bv = bias ? bias[col] : 0.f;
#pragma unroll
                for (int i = 0; i < 16; ++i) { const size_t o = (size_t)(mb + crow(i, h)) * D + col; const float a = half ? c1[i] : c0[i]; X[o] = base[o] + gv * (a + bv); } }
        };
        sgemm_tile(rp, Wt, D, mt * 128, nt * 128, epi, F.wave, F.lane);
    }
}

__device__ __forceinline__ void route_select(const float (&lg)[16], const float* rb, int& be1, int& be2, float& w1, float& w2) {
    float best = -1e30f; float bs1 = 0.f, bs2 = 0.f; be1 = 0; be2 = 0;
#pragma unroll
    for (int g = 0; g < 4; ++g) {
        float v1 = -1e30f, v2 = -1e30f, s1 = 0.f, s2 = 0.f; int j1 = 0, j2 = 0;
#pragma unroll
        for (int q = 0; q < 4; ++q) { const float sc = sigmoid_f(lg[4 * g + q]), x = sc + rb[4 * g + q];
            if (x > v1) { v2 = v1; j2 = j1; s2 = s1; v1 = x; j1 = q; s1 = sc; } else if (x > v2) { v2 = x; j2 = q; s2 = sc; } }
        const float gs = v1 + v2;
        if (gs > best) { best = gs; be1 = 4 * g + j1; be2 = 4 * g + j2; bs1 = s1; bs2 = s2; }
    }
    const float inv = 1.f / (bs1 + bs2); w1 = bs1 * inv; w2 = bs2 * inv;
}
__device__ __forceinline__ void phase_norm2_route(Frame& F, int layer) {
    const float* mod = (const float*)(F.ws + WS_MOD) + (size_t)layer * 5 * 6144;
    const float* X = F.out; const bf16* XB = (const bf16*)(F.ws + WS_XB); bf16* HB = (bf16*)(F.ws + WS_HB);
    const float* rw = F.in[I_RW]; const float* rb = F.in[I_RB];
    int* tok_e = (int*)(F.ws + WS_TOKE); int* tok_p = (int*)(F.ws + WS_TOKP); float* tok_w = (float*)(F.ws + WS_TOKW);
    int* slot_t = (int*)(F.ws + WS_SLOTT) + layer * 16 * CAP;
    float* slot_w = (float*)(F.ws + WS_SLOTW) + layer * 16 * CAP;
    unsigned* cnt = F.ctl + CW_CNT + layer * 16 * 64;
    LAS float* rwt = (LAS float*)F.lds;
    LAS int* sel_e = (LAS int*)(F.lds + 65536);
    LAS float* sel_w = (LAS float*)(F.lds + 65536 + 1024);
    LAS int* wcnt = (LAS int*)(F.lds + 65536 + 2048);
    LAS int* ebase = wcnt + 64;
    __syncthreads();
    for (int t = F.tid; t < 4096; t += NTHR) { const int i = t >> 2, e4 = t & 3; const f32x4 w = *(const f32x4*)(rw + (size_t)i * 16 + 4 * e4);
        const int p = (i & 512) + 256 * ((i >> 2) & 1) + 4 * ((i >> 3) & 63) + (i & 3);
        rwt[(4 * e4 + 0) * 1024 + p] = w.x; rwt[(4 * e4 + 1) * 1024 + p] = w.y; rwt[(4 * e4 + 2) * 1024 + p] = w.z; rwt[(4 * e4 + 3) * 1024 + p] = w.w; }
    __syncthreads();
    for (int rb0 = F.wg; rb0 < T / 128; rb0 += F.G) {
        const int b = (rb0 * 128) >> 13;
        f32x4 gm[4], sh[4];
        { const float* m = mod + (size_t)b * 6144; const float* g = F.in[I_NFG] + layer * D;
#pragma unroll
          for (int jj = 0; jj < 4; ++jj) { const int o = ROFF(F.lane, jj); gm[jj] = *(const f32x4*)(g + o) * (1.f + *(const f32x4*)(m + 4096 + o)); sh[jj] = *(const f32x4*)(m + 3072 + o); } }
        const int rbase = rb0 * 128 + F.wave * 16;
        f32x4 v0[4], v1[4]; xrow_load(X, XB, (size_t)rbase, F.lane, v0); xrow_load(X, XB, (size_t)(rbase + 1), F.lane, v1);
#pragma unroll 1
        for (int j = 0; j < 16; j += 2) {
            const int lr = F.wave * 16 + j, row = rbase + j;
            f32x4 n0[4], n1[4];
            { const int nr = (j + 2 < 16) ? row + 2 : row; xrow_load(X, XB, (size_t)nr, F.lane, n0); xrow_load(X, XB, (size_t)(nr + 1), F.lane, n1); }
            const float rstd0 = rsqrtf(row_sumsq(v0) * (1.f / D) + EPS), rstd1 = rsqrtf(row_sumsq(v1) * (1.f / D) + EPS);
#pragma unroll
            for (int jj = 0; jj < 4; ++jj) { v0[jj] = v0[jj] * rstd0 * gm[jj] + sh[jj]; v1[jj] = v1[jj] * rstd1 * gm[jj] + sh[jj]; }
            row_store_bf16(HB + (size_t)row * D, v0, F.lane); row_store_bf16(HB + (size_t)(row + 1) * D, v1, F.lane);
            float lg0[16], lg1[16];
#pragma unroll
            for (int e = 0; e < 16; ++e) { float a0 = 0.f, a1 = 0.f;
#pragma unroll
                for (int jj = 0; jj < 4; ++jj) { const f32x4 w4 = *(const LAS f32x4*)(rwt + e * 1024 + 256 * jj + 4 * F.lane);
                    a0 += (v0[jj].x * w4.x + v0[jj].y * w4.y) + (v0[jj].z * w4.z + v0[jj].w * w4.w); a1 += (v1[jj].x * w4.x + v1[jj].y * w4.y) + (v1[jj].z * w4.z + v1[jj].w * w4.w); }
                lg0[e] = a0; lg1[e] = a1; }
#pragma unroll
            for (int e = 0; e < 16; ++e) { lg0[e] = wave_sum(lg0[e]); lg1[e] = wave_sum(lg1[e]); }
            int e1, e2; float w1, w2;
            route_select(lg0, rb, e1, e2, w1, w2);
            if (F.lane == 0) { sel_e[2 * lr] = e1; sel_e[2 * lr + 1] = e2; sel_w[2 * lr] = w1; sel_w[2 * lr + 1] = w2; }
            route_select(lg1, rb, e1, e2, w1, w2);
            if (F.lane == 0) { sel_e[2 * lr + 2] = e1; sel_e[2 * lr + 3] = e2; sel_w[2 * lr + 2] = w1; sel_w[2 * lr + 3] = w2; }
#pragma unroll
            for (int jj = 0; jj < 4; ++jj) { v0[jj] = n0[jj]; v1[jj] = n1[jj]; }
        }
        __syncthreads();
        int my_e = 0, my_rank = 0; float my_w = 0.f;
        if (F.tid < 256) { my_e = sel_e[F.tid]; my_w = sel_w[F.tid];
            const unsigned long long below = (1ull << F.lane) - 1ull;
#pragma unroll 1
            for (int ee = 0; ee < 16; ++ee) { const unsigned long long mk = __ballot(my_e == ee);
                if (my_e == ee) my_rank = __popcll(mk & below);
                if (F.lane == 0) wcnt[F.wave * 16 + ee] = __popcll(mk); } }
        __syncthreads();
        if (F.tid < 16) { const int n = wcnt[F.tid] + wcnt[16 + F.tid] + wcnt[32 + F.tid] + wcnt[48 + F.tid];
            ebase[F.tid] = n ? (int)atomicAdd(cnt + F.tid * 64, (unsigned)n) : 0; }
        __syncthreads();
        if (F.tid < 256) { int pos = ebase[my_e] + my_rank;
            for (int w = 0; w < F.wave; ++w) pos += wcnt[w * 16 + my_e];
            const int tok = rb0 * 128 + (F.tid >> 1), k = F.tid & 1;
            slot_t[my_e * CAP + pos] = tok; slot_w[my_e * CAP + pos] = my_w; tok_e[2 * tok + k] = my_e; tok_p[2 * tok + k] = pos; tok_w[2 * tok + k] = my_w; }
        __syncthreads();
    }
}


__device__ __forceinline__ void phase_norm2_route_mfma(Frame& F, int layer) {
    constexpr int AP = 1032;
    const float* mod = (const float*)(F.ws + WS_MOD) + (size_t)layer * 5 * 6144;
    const bf16* XB = (const bf16*)(F.ws + WS_XB); bf16* HB = (bf16*)(F.ws + WS_HB);
    const float* rw = F.in[I_RW]; const float* rb = F.in[I_RB]; const float* gsrc = F.in[I_NFG] + layer * D;
    int* tok_e = (int*)(F.ws + WS_TOKE); int* tok_p = (int*)(F.ws + WS_TOKP); float* tok_w = (float*)(F.ws + WS_TOKW);
    int* slot_t = (int*)(F.ws + WS_SLOTT) + layer * 16 * CAP;
    float* slot_w = (float*)(F.ws + WS_SLOTW) + layer * 16 * CAP;
    unsigned* cnt = F.ctl + CW_CNT + layer * 16 * 64;
    LAS bf16* AH = (LAS bf16*)F.lds; LAS bf16* AL = AH + 16 * AP;
    LAS float* cbv = (LAS float*)(F.lds + 2 * 16 * AP * 2);
    LAS float* rstdv = cbv + 16;
    LAS float* lgt = rstdv + 128;
    LAS int* sel_e = (LAS int*)(lgt + 128 * 16);
    LAS float* sel_w = (LAS float*)(sel_e + 256);
    LAS int* wcnt = (LAS int*)(sel_w + 256);
    LAS int* ebase = wcnt + 64;
    LAS float* cpart = (LAS float*)(ebase + 16);
    for (int rb0 = F.wg; rb0 < T / 128; rb0 += F.G) {
        const int b = (rb0 * 128) >> 13; const float* m = mod + (size_t)b * 6144;
        __syncthreads();
        { float cp[16];
#pragma unroll
          for (int e = 0; e < 16; ++e) cp[e] = 0.f;
          for (int k = F.tid; k < D; k += NTHR) { const float gmk = gsrc[k] * (1.f + m[4096 + k]), shk = m[3072 + k];
#pragma unroll
              for (int e4 = 0; e4 < 4; ++e4) { const f32x4 w4 = *(const f32x4*)(rw + (size_t)k * 16 + 4 * e4);
#pragma unroll
                  for (int q = 0; q < 4; ++q) { const int e = 4 * e4 + q; const float pr = gmk * w4[q]; const unsigned hi = f2bf(pr); const unsigned lo = f2bf(pr - bf2f(hi));
                      AH[e * AP + k] = (bf16)hi; AL[e * AP + k] = (bf16)lo; cp[e] += shk * w4[q]; } } }
#pragma unroll
          for (int e = 0; e < 16; ++e) { const float t = wave_sum(cp[e]); if (F.lane == 0) cpart[F.wave * 16 + e] = t; } }
        __syncthreads();
        if (F.tid < 16) { float t = 0.f;
#pragma unroll
            for (int w = 0; w < 8; ++w) t += cpart[w * 16 + F.tid];
            cbv[F.tid] = t; }
        f32x4 gm[4], sh[4];
#pragma unroll
        for (int jj = 0; jj < 4; ++jj) { const int o = ROFF(F.lane, jj); gm[jj] = *(const f32x4*)(gsrc + o) * (1.f + *(const f32x4*)(m + 4096 + o)); sh[jj] = *(const f32x4*)(m + 3072 + o); }
        const int rbase = rb0 * 128 + F.wave * 16;
        f32x4 v0[4], v1[4]; row_load_bf(XB + (size_t)rbase * D, F.lane, v0); row_load_bf(XB + (size_t)(rbase + 1) * D, F.lane, v1);
#pragma unroll 1
        for (int j = 0; j < 16; j += 2) {
            const int lr = F.wave * 16 + j, row = rbase + j;
            f32x4 n0[4], n1[4];
            { const int nr = (j + 2 < 16) ? row + 2 : row; row_load_bf(XB + (size_t)nr * D, F.lane, n0); row_load_bf(XB + (size_t)(nr + 1) * D, F.lane, n1); }
            const float rstd0 = rsqrtf(row_sumsq(v0) * (1.f / D) + EPS), rstd1 = rsqrtf(row_sumsq(v1) * (1.f / D) + EPS);
#pragma unroll
            for (int jj = 0; jj < 4; ++jj) { v0[jj] = v0[jj] * rstd0 * gm[jj] + sh[jj]; v1[jj] = v1[jj] * rstd1 * gm[jj] + sh[jj]; }
            row_store_bf16(HB + (size_t)row * D, v0, F.lane); row_store_bf16(HB + (size_t)(row + 1) * D, v1, F.lane);
            if (F.lane == 0) { rstdv[lr] = rstd0; rstdv[lr + 1] = rstd1; }
#pragma unroll
            for (int jj = 0; jj < 4; ++jj) { v0[jj] = n0[jj]; v1[jj] = n1[jj]; }
        }
        __syncthreads();
        { const int fr = F.lane & 15, fq = F.lane >> 4;
          f32x4 acc = {0.f, 0.f, 0.f, 0.f};
          const bf16* xr = XB + (size_t)(rb0 * 128 + 16 * F.wave + fr) * D + 8 * fq;
          const LAS bf16* ah = AH + fr * AP + 8 * fq; const LAS bf16* al = AL + fr * AP + 8 * fq;
#pragma unroll 8
          for (int s2 = 0; s2 < 32; ++s2) { const bf16x8 xb = *(const bf16x8*)(xr + 32 * s2);
              acc = __builtin_amdgcn_mfma_f32_16x16x32_bf16(*(const LAS bf16x8*)(ah + 32 * s2), xb, acc, 0, 0, 0);
              acc = __builtin_amdgcn_mfma_f32_16x16x32_bf16(*(const LAS bf16x8*)(al + 32 * s2), xb, acc, 0, 0, 0); }
          const int lrow = 16 * F.wave + fr; const float rs = rstdv[lrow];
#pragma unroll
          for (int i = 0; i < 4; ++i) lgt[lrow * 16 + 4 * fq + i] = rs * acc[i] + cbv[4 * fq + i]; }
        __syncthreads();
        if (F.tid < 128) { float lg[16];
#pragma unroll
            for (int e4 = 0; e4 < 4; ++e4) { const f32x4 t = *(const LAS f32x4*)(lgt + F.tid * 16 + 4 * e4); lg[4 * e4] = t.x; lg[4 * e4 + 1] = t.y; lg[4 * e4 + 2] = t.z; lg[4 * e4 + 3] = t.w; }
            int e1, e2; float w1, w2; route_select(lg, rb, e1, e2, w1, w2);
            sel_e[2 * F.tid] = e1; sel_e[2 * F.tid + 1] = e2; sel_w[2 * F.tid] = w1; sel_w[2 * F.tid + 1] = w2; }
        __syncthreads();
        int my_e = 0, my_rank = 0; float my_w = 0.f;
        if (F.tid < 256) { my_e = sel_e[F.tid]; my_w = sel_w[F.tid];
            const unsigned long long below = (1ull << F.lane) - 1ull;
#pragma unroll 1
            for (int ee = 0; ee < 16; ++ee) { const unsigned long long mk = __ballot(my_e == ee);
                if (my_e == ee) my_rank = __popcll(mk & below);
                if (F.lane == 0) wcnt[F.wave * 16 + ee] = __popcll(mk); } }
        __syncthreads();
        if (F.tid < 16) { const int n = wcnt[F.tid] + wcnt[16 + F.tid] + wcnt[32 + F.tid] + wcnt[48 + F.tid];
            ebase[F.tid] = n ? (int)atomicAdd(cnt + F.tid * 64, (unsigned)n) : 0; }
        __syncthreads();
        if (F.tid < 256) { int pos = ebase[my_e] + my_rank;
            for (int w = 0; w < F.wave; ++w) pos += wcnt[w * 16 + my_e];
            const int tok = rb0 * 128 + (F.tid >> 1), k = F.tid & 1;
            slot_t[my_e * CAP + pos] = tok; slot_w[my_e * CAP + pos] = my_w; tok_e[2 * tok + k] = my_e; tok_p[2 * tok + k] = pos; tok_w[2 * tok + k] = my_w; }
    }
    __syncthreads();
}

constexpr int MOEMAP_OFF = LDS_BYTES - 256;
__device__ __forceinline__ LAS int* moe_map(Frame& F, int layer) {
    LAS int* mm = (LAS int*)(F.lds + MOEMAP_OFF);
    __syncthreads();
    if (F.tid < 64) { const unsigned* cnt = F.ctl + CW_CNT + layer * 16 * 64;
        const int n = (F.tid < 16) ? (int)__hip_atomic_load(cnt + F.tid * 64, __ATOMIC_RELAXED, __HIP_MEMORY_SCOPE_AGENT) : 0;
        const int pad = (n + 255) & ~255; int x = pad;
#pragma unroll
        for (int o = 1; o < 16; o <<= 1) { const int t = __shfl_up(x, o); if (F.lane >= o) x += t; }
        if (F.tid < 16) { mm[F.tid] = n; mm[16 + F.tid] = x - pad; } }
    __syncthreads();
    return mm;
}
struct RowGather { const bf16* base; const int* list; int n; __device__ __forceinline__ const bf16* operator()(int m) const { const int tok = m < n ? list[m] : 0; return base + (size_t)tok * D; } };

__device__ __forceinline__ void phase_moe_gateup(Frame& F, int layer) {
    LAS int* mm = moe_map(F, layer);
    const bf16* HB = (const bf16*)(F.ws + WS_HB); bf16* HID = (bf16*)(F.ws + WS_HID);
    const int* slot_t = (const int*)(F.ws + WS_SLOTT) + layer * 16 * CAP; const float* slot_w = (const float*)(F.ws + WS_SLOTW) + layer * 16 * CAP;
    int ubase = 0;
#pragma unroll 1
    for (int e = 0; e < 16; ++e) {
        const int n = mm[e], hbe = mm[16 + e], rt = (n + 127) >> 7, nu = rt * 8;
        const bf16* Wt = (const bf16*)(F.ws + WS_WGU) + (size_t)(layer * 16 + e) * 1024 * 1024;
        RowGather rp{HB, slot_t + e * CAP, n};
        int first = (F.wg - ubase % F.G + F.G) % F.G;
        for (int u = first; u < nu; u += F.G) {
            const int mt = u / 8, nt = u % 8;
            auto epi = [&](int mb, int nb, const f32x16& c0, const f32x16& c1, int lane) {
                const int h = lane >> 5, cl = lane & 31; const int col = (nb >> 1) + cl;
#pragma unroll
                for (int i = 0; i < 16; ++i) { const int r = mb + crow(i, h);
                    if (r < n) { const float w = slot_w[e * CAP + r]; HID[(size_t)(hbe + r) * FF + col] = (bf16)f2bf(w * silu_f(c0[i]) * c1[i]); } }
            };
            sgemm_tile(rp, Wt, D, mt * 128, nt * 128, epi, F.wave, F.lane);
        }
        ubase += nu;
    }
}
__device__ __forceinline__ void phase_moe_down(Frame& F, int layer) {
    LAS int* mm = moe_map(F, layer);
    const bf16* HID = (const bf16*)(F.ws + WS_HID); bf16* Y = (bf16*)(F.ws + WS_Y);
    int ubase = 0;
#pragma unroll 1
    for (int e = 0; e < 16; ++e) {
        const int n = mm[e], hbe = mm[16 + e], rt = (n + 127) >> 7, nu = rt * 8;
        const bf16* Wt = (const bf16*)(F.ws + WS_WDN) + (size_t)(layer * 16 + e) * 1024 * 512;
        RowLin rp{HID + (size_t)hbe * FF, (size_t)FF};
        int first = (F.wg - ubase % F.G + F.G) % F.G;
        for (int u = first; u < nu; u += F.G) {
            const int mt = u / 8, nt = u % 8;
            auto epi = [&](int mb, int nb, const f32x16& c0, const f32x16& c1, int lane) {
                const int h = lane >> 5, cl = lane & 31;
#pragma unroll
                for (int i = 0; i < 16; ++i) { const int r = mb + crow(i, h);
                    if (r < n) { bf16* yr = Y + (size_t)(hbe + r) * D + nb + cl; yr[0] = (bf16)f2bf(c0[i]); yr[32] = (bf16)f2bf(c1[i]); } }
            };
            sgemm_tile(rp, Wt, FF, mt * 128, nt * 128, epi, F.wave, F.lane);
        }
        ubase += nu;
    }
}

template <bool FINAL>
__device__ __forceinline__ void phase_combine(Frame& F, int layer) {
    LAS int* hbs = moe_map(F, layer) + 16;
    const int gw = F.wg * NWAVES + F.wave, NGW = F.G * NWAVES;
    const float* mod = (const float*)(F.ws + WS_MOD);
    const int* tok_e = (const int*)(F.ws + WS_TOKE); const int* tok_p = (const int*)(F.ws + WS_TOKP);
    const bf16* Y = (const bf16*)(F.ws + WS_Y); float* X = F.out; bf16* XB = (bf16*)(F.ws + WS_XB); bf16* HB = (bf16*)(F.ws + WS_HB);
    for (int blk = gw; blk < T / 16; blk += NGW) {
        const int rbase = blk * 16, b = rbase >> 13;
        f32x4 g2v[4], gm[4], shv[4];
        { const float* g2 = mod + ((size_t)layer * 5 + b) * 6144 + 5120;
#pragma unroll
          for (int j = 0; j < 4; ++j) { const int o = ROFF(F.lane, j); g2v[j] = *(const f32x4*)(g2 + o);
              if (FINAL) { gm[j] = *(const f32x4*)(F.in[I_FNG] + o); shv[j] = (f32x4){0.f, 0.f, 0.f, 0.f}; }
              else { const float* m = mod + ((size_t)(layer + 1) * 5 + b) * 6144; gm[j] = *(const f32x4*)(F.in[I_NMG] + (layer + 1) * D + o) * (1.f + *(const f32x4*)(m + 1024 + o)); shv[j] = *(const f32x4*)(m + o); } } }
        int4 te = *(const int4*)(tok_e + 2 * rbase), tp = *(const int4*)(tok_p + 2 * rbase);
        u32x4 xa[2][2], ya[2][2][2], xn[2][2], yn[2][2][2];
        { const int s00 = hbs[te.x] + tp.x, s01 = hbs[te.y] + tp.y, s10 = hbs[te.z] + tp.z, s11 = hbs[te.w] + tp.w;
#pragma unroll
          for (int jj = 0; jj < 2; ++jj) { const int o = 512 * jj + 8 * F.lane;
              xa[0][jj] = *(const u32x4*)(XB + (size_t)rbase * D + o); xa[1][jj] = *(const u32x4*)(XB + (size_t)(rbase + 1) * D + o);
              ya[0][0][jj] = *(const u32x4*)(Y + (size_t)s00 * D + o); ya[0][1][jj] = *(const u32x4*)(Y + (size_t)s01 * D + o);
              ya[1][0][jj] = *(const u32x4*)(Y + (size_t)s10 * D + o); ya[1][1][jj] = *(const u32x4*)(Y + (size_t)s11 * D + o); } }
        te = *(const int4*)(tok_e + 2 * (rbase + 2)); tp = *(const int4*)(tok_p + 2 * (rbase + 2));
#pragma unroll 1
        for (int jr = 0; jr < 16; jr += 2) {
            const int row = rbase + jr;
            if (jr + 2 < 16) { const int nr = row + 2;
                const int s00 = hbs[te.x] + tp.x, s01 = hbs[te.y] + tp.y, s10 = hbs[te.z] + tp.z, s11 = hbs[te.w] + tp.w;
#pragma unroll
                for (int jj = 0; jj < 2; ++jj) { const int o = 512 * jj + 8 * F.lane;
                    xn[0][jj] = *(const u32x4*)(XB + (size_t)nr * D + o); xn[1][jj] = *(const u32x4*)(XB + (size_t)(nr + 1) * D + o);
                    yn[0][0][jj] = *(const u32x4*)(Y + (size_t)s00 * D + o); yn[0][1][jj] = *(const u32x4*)(Y + (size_t)s01 * D + o);
                    yn[1][0][jj] = *(const u32x4*)(Y + (size_t)s10 * D + o); yn[1][1][jj] = *(const u32x4*)(Y + (size_t)s11 * D + o); }
                const int n2 = (jr + 4 < 16) ? row + 4 : row; te = *(const int4*)(tok_e + 2 * n2); tp = *(const int4*)(tok_p + 2 * n2); }
            f32x4 v[2][4];
#pragma unroll
            for (int q = 0; q < 2; ++q)
#pragma unroll
                for (int jj = 0; jj < 2; ++jj) { const u32x4 xw = xa[q][jj], a0 = ya[q][0][jj], a1 = ya[q][1][jj]; const f32x4 g0 = g2v[2 * jj], g1 = g2v[2 * jj + 1];
                    v[q][2 * jj] = (f32x4){bflo(xw.x) + g0.x * (bflo(a0.x) + bflo(a1.x)), bfhi(xw.x) + g0.y * (bfhi(a0.x) + bfhi(a1.x)), bflo(xw.y) + g0.z * (bflo(a0.y) + bflo(a1.y)), bfhi(xw.y) + g0.w * (bfhi(a0.y) + bfhi(a1.y))};
                    v[q][2 * jj + 1] = (f32x4){bflo(xw.z) + g1.x * (bflo(a0.z) + bflo(a1.z)), bfhi(xw.z) + g1.y * (bfhi(a0.z) + bfhi(a1.z)), bflo(xw.w) + g1.z * (bflo(a0.w) + bflo(a1.w)), bfhi(xw.w) + g1.w * (bfhi(a0.w) + bfhi(a1.w))}; }
            const float rstd0 = rsqrtf(row_sumsq(v[0]) * (1.f / D) + EPS), rstd1 = rsqrtf(row_sumsq(v[1]) * (1.f / D) + EPS);
#pragma unroll
            for (int q = 0; q < 2; ++q) { const float rstd = q ? rstd1 : rstd0; const size_t ro = (size_t)(row + q) * D;
                if (FINAL) {
#pragma unroll
                    for (int j = 0; j < 4; ++j) *(f32x4*)(X + ro + ROFF(F.lane, j)) = v[q][j] * rstd * gm[j];
                } else {
                    row_store_bf16(XB + ro, v[q], F.lane);
#pragma unroll
                    for (int j = 0; j < 4; ++j) v[q][j] = v[q][j] * rstd * gm[j] + shv[j];
                    row_store_bf16(HB + ro, v[q], F.lane);
                }
            }
#pragma unroll
            for (int q = 0; q < 2; ++q)
#pragma unroll
                for (int jj = 0; jj < 2; ++jj) { xa[q][jj] = xn[q][jj]; ya[q][0][jj] = yn[q][0][jj]; ya[q][1][jj] = yn[q][1][jj]; }
        }
    }
    __syncthreads();
}

__device__ __forceinline__ void phase_pw1(Frame& F) {
    const bf16* HB = (const bf16*)(F.ws + WS_HB); const bf16* Wt = (const bf16*)(F.ws + WS_WPW1); bf16* U = (bf16*)(F.ws + WS_U);
    const float* bias = F.in[I_PW1B];
    RowLin rp{HB, (size_t)D};
    for (int u = F.wg; u < (T / 128) * 16; u += F.G) {
        const int mt = u / 16, nt = u % 16;
        auto epi = [&](int mb, int nb, const f32x16& c0, const f32x16& c1, int lane) {
            const int h = lane >> 5, cl = lane & 31, col = (nb >> 1) + cl; const float ba = bias[col], bg = bias[1024 + col];
#pragma unroll
            for (int i = 0; i < 16; ++i) U[(size_t)(mb + crow(i, h)) * D + col] = (bf16)f2bf((c0[i] + ba) * sigmoid_f(c1[i] + bg));
        };
        sgemm_tile(rp, Wt, D, mt * 128, nt * 128, epi, F.wave, F.lane);
    }
}
__device__ __forceinline__ void phase_dwconv(Frame& F) {
    const bf16* U = (const bf16*)(F.ws + WS_U); bf16* V1 = (bf16*)(F.ws + WS_V1);
    const float* dww = F.in[I_DWW]; const float* dwb = F.in[I_DWB]; const float* lng = F.in[I_LNG]; const float* lnb = F.in[I_LNB];
    const int gw = F.wg * NWAVES + F.wave, NGW = F.G * NWAVES;
    for (int row = gw; row < T; row += NGW) {
        const int l = row & (L - 1);
        f32x4 acc[4];
#pragma unroll
        for (int j = 0; j < 4; ++j) acc[j] = *(const f32x4*)(dwb + 4 * F.lane + 256 * j);
        for (int tp = 0; tp < CONVW; ++tp) { const int ll = l + tp - 15; if (ll < 0 || ll >= L) continue;
            const bf16* ur = U + (size_t)(row + tp - 15) * D; const float* wr = dww + (size_t)tp * D;
#pragma unroll
            for (int j = 0; j < 4; ++j) { const int o = 4 * F.lane + 256 * j; const u32x2 uu = *(const u32x2*)(ur + o); const f32x4 ww = *(const f32x4*)(wr + o);
                acc[j].x += bflo(uu.x) * ww.x; acc[j].y += bfhi(uu.x) * ww.y; acc[j].z += bflo(uu.y) * ww.z; acc[j].w += bfhi(uu.y) * ww.w; } }
        float s = 0.f;
#pragma unroll
        for (int j = 0; j < 4; ++j) s += (acc[j].x + acc[j].y) + (acc[j].z + acc[j].w);
        const float mean = wave_sum(s) * (1.f / D); float q = 0.f;
#pragma unroll
        for (int j = 0; j < 4; ++j) { acc[j] = acc[j] - mean; q += (acc[j].x * acc[j].x + acc[j].y * acc[j].y) + (acc[j].z * acc[j].z + acc[j].w * acc[j].w); }
        const float rstd = rsqrtf(wave_sum(q) * (1.f / D) + EPS);
#pragma unroll
        for (int j = 0; j < 4; ++j) { const int o = 4 * F.lane + 256 * j; const f32x4 gg = *(const f32x4*)(lng + o), bb = *(const f32x4*)(lnb + o);
            f32x4 y = acc[j] * rstd * gg + bb; y.x = silu_f(y.x); y.y = silu_f(y.y); y.z = silu_f(y.z); y.w = silu_f(y.w); acc[j] = y; }
        row_store_bf16(V1 + (size_t)row * D, acc, F.lane);
    }
}


namespace pg {
constexpr int BM = 256, BK = 64, HALF = 128, HTB = HALF * BK * 2, STAGE_BYTES = 8 * HTB;
constexpr int TAB_OFF = STAGE_BYTES;
__device__ __forceinline__ int lds_byte(int r, int c) { const int st = (r >> 4) * 2 + (c >> 5), rr = r & 15, cc = c & 31, ob = rr * 64 + cc * 2; return st * 1024 + (ob ^ (((ob >> 9) & 1) << 5)); }
__device__ __forceinline__ void stage_rc(int b, int& R, int& C) { const int st = b / 1024, sb = b % 1024, swz = sb ^ (((sb >> 9) & 1) << 5); R = (st >> 1) * 16 + swz / 64; C = (st & 1) * 32 + (swz % 64) / 2; }
__device__ __forceinline__ int perm32(int rho) { const int n = rho >> 4, i = rho & 15; return 8 * (i >> 2) + 4 * n + (i & 3); }
__device__ __forceinline__ unsigned cvt_pk_bf16(float lo, float hi) { unsigned r; asm volatile("v_cvt_pk_bf16_f32 %0, %1, %2" : "=v"(r) : "v"(lo), "v"(hi)); return r; }

struct GU { const char* B; int p0, p1, p2, p3; };

template <class Epi, class Sched>
__device__ __forceinline__ void gemm_phase(LAS unsigned char* lds, const char* Abase, const int K, const Sched& S, const Epi& E) {
    const int tid = threadIdx.x, wid = __builtin_amdgcn_readfirstlane(tid >> 6), lane = tid & 63, wr = wid >> 2, wc = wid & 3, fr = lane & 15, fq = lane >> 4;
    const int nt = K / BK;
    int sR[2], sC[2]; unsigned voffB[2];
#pragma unroll
    for (int i = 0; i < 2; ++i) { int R, C; stage_rc(tid * 16 + i * 8192, R, C); sR[i] = R; sC[i] = C; const int Rb = Epi::PERM ? ((R & ~31) + perm32(R & 31)) : R; voffB[i] = (unsigned)(Rb * K + C) * 2u; }
    const size_t kstep = (size_t)(BK * 2);
    const size_t hstep = (size_t)HALF * K * 2;
    const unsigned ldsw = (unsigned)wid * 1024u;
    const int aoff = lds_byte(wr * 64 + fr, fq * 8), boff = lds_byte(wc * 32 + fr, fq * 8);
#define PG_SA(b, h) (((b) * 2 + (h)) * HTB)
#define PG_SB(b, h) ((4 + (b) * 2 + (h)) * HTB)
#define PG_STAGE(bufoff, gbase, voff) do { _Pragma("unroll") for (int _i = 0; _i < 2; ++_i) \
        __builtin_amdgcn_global_load_lds((const unsigned*)((const char*)(gbase) + (voff)[_i]), (LAS unsigned*)(lds + (bufoff) + ldsw + _i * 8192), 16, 0, 0); } while (0)
#define PG_LDA(dst, b, h) do { _Pragma("unroll") for (int m = 0; m < 4; ++m) _Pragma("unroll") for (int k = 0; k < 2; ++k) dst[m][k] = *(const LAS bf16x8*)(lds + PG_SA(b, h) + aoff + m * 2048 + k * 1024); } while (0)
#define PG_LDB(dst, b, h) do { _Pragma("unroll") for (int n = 0; n < 2; ++n) _Pragma("unroll") for (int k = 0; k < 2; ++k) dst[n][k] = *(const LAS bf16x8*)(lds + PG_SB(b, h) + boff + n * 2048 + k * 1024); } while (0)
#define PG_MMA(ai, bj, At, Bt) do { __builtin_amdgcn_s_setprio(1); _Pragma("unroll") for (int m = 0; m < 4; ++m) _Pragma("unroll") for (int n = 0; n < 2; ++n) _Pragma("unroll") for (int k = 0; k < 2; ++k) \
        acc[ai][bj][m][n] = __builtin_amdgcn_mfma_f32_16x16x32_bf16(Bt[n][k], At[m][k], acc[ai][bj][m][n], 0, 0, 0); __builtin_amdgcn_s_setprio(0); } while (0)
#define PG_WAIT_V(n) asm volatile("s_waitcnt vmcnt(" #n ")" ::: "memory")
#define PG_WAIT_L(n) asm volatile("s_waitcnt lgkmcnt(" #n ")" ::: "memory")
#define PG_BAR __builtin_amdgcn_s_barrier()
#define PG_SCHED __builtin_amdgcn_sched_barrier(0)
    GU cur, nxt; int ui = 0;
    if (!S.next(0, cur)) return;
    f32x4 acc[2][2][4][2];
#pragma unroll
    for (int a = 0; a < 2; ++a)
#pragma unroll
        for (int b = 0; b < 2; ++b)
#pragma unroll
            for (int m = 0; m < 4; ++m)
#pragma unroll
                for (int n = 0; n < 2; ++n) acc[a][b][m][n] = (f32x4){0.f, 0.f, 0.f, 0.f};
    bf16x8 At[4][2], B0[2][2], B1[2][2];
    if constexpr (Sched::GATHER) { S.stage_table(cur, 0, lds, wid, lane); PG_WAIT_V(0); PG_BAR; }
    unsigned voC[2][2], voN[2][2];
#pragma unroll
    for (int h = 0; h < 2; ++h)
#pragma unroll
        for (int i = 0; i < 2; ++i) { voC[h][i] = S.voff(cur, 0, lds, h * HALF + sR[i], sC[i]); voN[h][i] = voC[h][i]; }
    const char* cB = cur.B;
    PG_STAGE(PG_SB(0, 0), cB, voffB); PG_STAGE(PG_SB(0, 1), cB + hstep, voffB); PG_STAGE(PG_SA(0, 0), Abase, voC[0]); PG_STAGE(PG_SA(0, 1), Abase, voC[1]);
    if (wr == 1) PG_BAR;
    PG_WAIT_V(2); PG_BAR;
    PG_STAGE(PG_SB(1, 0), cB + kstep, voffB); PG_STAGE(PG_SA(1, 0), Abase + kstep, voC[0]); PG_STAGE(PG_SB(1, 1), cB + hstep + kstep, voffB);
    PG_WAIT_V(6); PG_BAR;
    for (;;) {
        const bool has_next = S.next(ui + 1, nxt);
        if constexpr (Sched::GATHER) { if (has_next) S.stage_table(nxt, (ui + 1) & 1, lds, wid, lane); }
        const char* nB = has_next ? nxt.B : cB;
        for (int t = 0; t < nt; t += 2) {
            const bool last = (t == nt - 2);
            if (last && has_next) {
#pragma unroll
                for (int h = 0; h < 2; ++h)
#pragma unroll
                    for (int i = 0; i < 2; ++i) voN[h][i] = S.voff(nxt, (ui + 1) & 1, lds, h * HALF + sR[i], sC[i]);
            }
            unsigned vo2[2][2];
#pragma unroll
            for (int h = 0; h < 2; ++h)
#pragma unroll
                for (int i = 0; i < 2; ++i) vo2[h][i] = last ? voN[h][i] : voC[h][i];
            const char* a1 = Abase + (size_t)(t + 1) * kstep;
            const char* a2 = last ? Abase : Abase + (size_t)(t + 2) * kstep; const char* b2 = last ? nB : cB + (size_t)(t + 2) * kstep;
            const char* a3 = a2 + kstep; const char* b3 = b2 + kstep;
            PG_LDB(B0, 0, 0); PG_LDB(B1, 0, 1); PG_SCHED; PG_LDA(At, 0, 0); PG_STAGE(PG_SA(1, 1), a1, voC[1]);
            PG_WAIT_V(8); PG_WAIT_L(0); PG_BAR; PG_MMA(0, 0, At, B0); PG_MMA(0, 1, At, B1); PG_BAR; PG_SCHED;
            PG_LDA(At, 0, 1); PG_STAGE(PG_SB(0, 0), b2, voffB); PG_STAGE(PG_SB(0, 1), b2 + hstep, voffB); PG_STAGE(PG_SA(0, 0), a2, vo2[0]);
            PG_WAIT_V(8); PG_WAIT_L(0); PG_BAR; PG_MMA(1, 0, At, B0); PG_MMA(1, 1, At, B1); PG_BAR; PG_SCHED;
            PG_LDB(B0, 1, 0); PG_LDB(B1, 1, 1); PG_SCHED; PG_LDA(At, 1, 0); PG_STAGE(PG_SA(0, 1), a2, vo2[1]);
            PG_WAIT_V(8); PG_WAIT_L(0); PG_BAR; PG_MMA(0, 0, At, B0); PG_MMA(0, 1, At, B1); PG_BAR; PG_SCHED;
            PG_LDA(At, 1, 1); PG_STAGE(PG_SB(1, 0), b3, voffB); PG_STAGE(PG_SB(1, 1), b3 + hstep, voffB); PG_STAGE(PG_SA(1, 0), a3, vo2[0]);
            PG_WAIT_V(8); PG_WAIT_L(0); PG_BAR; PG_MMA(1, 0, At, B0); PG_MMA(1, 1, At, B1); PG_BAR; PG_SCHED;
        }
        if (wr == 0) PG_BAR;
        E(acc, cur, wr, wc, fr, fq);
        if (!has_next) break;
#pragma unroll
        for (int a = 0; a < 2; ++a)
#pragma unroll
            for (int b = 0; b < 2; ++b)
#pragma unroll
                for (int m = 0; m < 4; ++m)
#pragma unroll
                    for (int n = 0; n < 2; ++n) acc[a][b][m][n] = (f32x4){0.f, 0.f, 0.f, 0.f};
        cur = nxt; cB = nB; ++ui;
#pragma unroll
        for (int h = 0; h < 2; ++h)
#pragma unroll
            for (int i = 0; i < 2; ++i) voC[h][i] = voN[h][i];
        if (wr == 1) PG_BAR;
    }
    PG_WAIT_V(0);
    PG_BAR;
#undef PG_SA
#undef PG_SB
#undef PG_STAGE
#undef PG_LDA
#undef PG_LDB
#undef PG_MMA
#undef PG_WAIT_V
#undef PG_WAIT_L
#undef PG_BAR
#undef PG_SCHED
}

__device__ __forceinline__ void static_tile(int L, int nM, int nN, int& pm, int& pn) {
    const int nwg = nM * nN; int wgid = L; { const int q = nwg / 8, r = nwg % 8, xcd = wgid % 8, off = wgid / 8; wgid = (xcd < r ? xcd * (q + 1) : r * (q + 1) + (xcd - r) * q) + off; }
    const int nig = 8 * nN, gid = wgid / nig, fm = gid * 8, gsz = (nM - fm) < 8 ? (nM - fm) : 8;
    pm = fm + ((wgid % nig) % gsz); pn = (wgid % nig) / gsz;
}
struct DenseSched {
    static constexpr bool GATHER = false;
    const char* Bt; int K, nM, nN, G, c, xn, xm0, xpn;
    __device__ __forceinline__ bool next(int i, GU& u) const {
        const int L = i * G + c, nmain = nM * nN; int pm, pn;
        if (L < nmain) static_tile(L, nM, nN, pm, pn); else if (L < nmain + xn) { pm = xm0 + (L - nmain); pn = xpn; } else return false;
        u.B = Bt + (size_t)pn * BM * K * 2; u.p0 = pm; u.p1 = pn; u.p2 = 0; u.p3 = 0; return true;
    }
    __device__ __forceinline__ unsigned voff(const GU& u, int, LAS unsigned char*, int R, int C) const { return (unsigned)(((u.p0 * BM + R) * K + C) * 2); }
    __device__ __forceinline__ void stage_table(const GU&, int, LAS unsigned char*, int, int) const {}
};
template <bool GATHER_> struct MoeSched {
    static constexpr bool GATHER = GATHER_;
    const char* Wt; size_t wstride; int K; const int* list; LAS int* mm; int G, c;
    __device__ __forceinline__ bool next(int i, GU& u) const {
        int L = i * G + c;
        for (int e = 0; e < 16; ++e) { const int n = mm[e], nu = ((n + 255) >> 8) * 4;
            if (L < nu) { const int rt = L >> 2, pn = L & 3; u.B = Wt + (size_t)e * wstride + (size_t)pn * BM * K * 2; u.p0 = e; u.p1 = rt; u.p2 = pn; u.p3 = mm[16 + e]; return true; }
            L -= nu; }
        return false;
    }
    __device__ __forceinline__ unsigned voff(const GU& u, int buf, LAS unsigned char* lds, int R, int C) const {
        if constexpr (GATHER_) { const int tok = ((const LAS int*)(lds + TAB_OFF))[buf * 256 + R]; return (unsigned)((tok * K + C) * 2); }
        else return (unsigned)(((u.p3 + u.p1 * BM + R) * K + C) * 2);
    }
    __device__ __forceinline__ void stage_table(const GU& u, int buf, LAS unsigned char* lds, int wid, int lane) const {
        if constexpr (GATHER_) { const int r = (wid & 3) * 64 + lane;
            __builtin_amdgcn_global_load_lds((const unsigned*)(list + u.p0 * CAP + u.p1 * BM + r), (LAS unsigned*)(lds + TAB_OFF + buf * 1024 + (wid & 3) * 256), 4, 0, 0); }
    }
};

struct EpiInProj {
    static constexpr bool PERM = false;
    unsigned char* ws;
    __device__ __forceinline__ void operator()(const f32x4 (&acc)[2][2][4][2], const GU& u, int wr, int wc, int fr, int fq) const {
        const int pm = u.p0, pn = u.p1; const bool isctx = pm >= T / BM;
        float inv[4];
#pragma unroll
        for (int j = 0; j < 4; ++j) inv[j] = exp2f(-(float)(4 * fq + j) * (13.287712379549449f / 16.f));
#pragma unroll
        for (int bj = 0; bj < 2; ++bj) {
            const int cb = pn * BM + bj * HALF + wc * 32;
            bf16* dst; int pitch, cbase; bool rope = false;
            if (cb < 512) { dst = (bf16*)(ws + WS_UF); pitch = 512; cbase = 0; }
            else if (cb < 1024) { dst = (bf16*)(ws + WS_Q); pitch = 512; cbase = 512; rope = true; }
            else if (cb < 1152) { dst = isctx ? (bf16*)(ws + WS_CK) : (bf16*)(ws + WS_K); pitch = 128; cbase = 1024; rope = !isctx; }
            else { dst = isctx ? (bf16*)(ws + WS_CV) : (bf16*)(ws + WS_V); pitch = 128; cbase = 1152; }
            const bool bycol = ((cb >> 5) & 1) != 0;
#pragma unroll
            for (int ai = 0; ai < 2; ++ai)
#pragma unroll
                for (int m = 0; m < 4; ++m) {
                    const int row = pm * BM + ai * HALF + wr * 64 + m * 16 + fr;
                    f32x4 v0 = acc[ai][bj][m][0], v1 = acc[ai][bj][m][1];
                    if (rope) { const int l = row & (L - 1); const float pos = (float)(bycol ? (l & 63) : (l >> 6));
#pragma unroll
                        for (int j = 0; j < 4; ++j) { const float ang = pos * inv[j], cs = __cosf(ang), sn = __sinf(ang); const float x1 = v0[j], x2 = v1[j]; v0[j] = x1 * cs - x2 * sn; v1[j] = x1 * sn + x2 * cs; } }
                    const int orow = isctx ? row - T : row;
                    if (FAST_ATTN && cb >= 1152) {
                        const int kp = isctx ? CL : L, bb = isctx ? (orow >> 8) : (orow >> 13), key = isctx ? (orow & (CL - 1)) : (orow & (L - 1));
#pragma unroll
                        for (int n = 0; n < 2; ++n)
#pragma unroll
                            for (int j = 0; j < 4; ++j) { const int c = (cb - 1152) + 16 * n + 4 * fq + j;
                                dst[((size_t)bb * 128 + c) * kp + key] = (bf16)f2bf(n ? v1[j] : v0[j]); }
                        continue;
                    }
                    bf16* o = dst + (size_t)orow * pitch + (cb - cbase) + 4 * fq;
                    u32x2 w0, w1; w0.x = cvt_pk_bf16(v0[0], v0[1]); w0.y = cvt_pk_bf16(v0[2], v0[3]); w1.x = cvt_pk_bf16(v1[0], v1[1]); w1.y = cvt_pk_bf16(v1[2], v1[3]);
                    *(u32x2*)o = w0; *(u32x2*)(o + 16) = w1;
                }
        }
    }
};
struct EpiRes {
    static constexpr bool PERM = false;
    const float* base; float* X; const float* gate; const float* bias;
    __device__ __forceinline__ void operator()(const f32x4 (&acc)[2][2][4][2], const GU& u, int wr, int wc, int fr, int fq) const {
        const int row0 = u.p0 * BM + wr * 64 + fr, col0 = u.p1 * BM + wc * 32 + 4 * fq; const int b = (u.p0 * BM) >> 13;
        f32x4 gv[2][2], bv[2][2];
#pragma unroll
        for (int bj = 0; bj < 2; ++bj)
#pragma unroll
            for (int n = 0; n < 2; ++n) { gv[bj][n] = *(const f32x4*)(gate + (size_t)b * 6144 + col0 + bj * HALF + n * 16); bv[bj][n] = bias ? *(const f32x4*)(bias + col0 + bj * HALF + n * 16) : (f32x4){0.f, 0.f, 0.f, 0.f}; }
#pragma unroll
        for (int ai = 0; ai < 2; ++ai)
#pragma unroll
            for (int mp = 0; mp < 2; ++mp) {
                f32x4 bs[2][2][2];
#pragma unroll
                for (int mm = 0; mm < 2; ++mm) { const size_t off = (size_t)(row0 + ai * HALF + (2 * mp + mm) * 16) * D + col0;
#pragma unroll
                    for (int bj = 0; bj < 2; ++bj)
#pragma unroll
                        for (int n = 0; n < 2; ++n) bs[mm][bj][n] = *(const f32x4*)(base + off + bj * HALF + n * 16); }
#pragma unroll
                for (int mm = 0; mm < 2; ++mm) { const int m = 2 * mp + mm; const size_t off = (size_t)(row0 + ai * HALF + m * 16) * D + col0;
#pragma unroll
                    for (int bj = 0; bj < 2; ++bj)
#pragma unroll
                        for (int n = 0; n < 2; ++n) *(f32x4*)(X + off + bj * HALF + n * 16) = bs[mm][bj][n] + gv[bj][n] * (acc[ai][bj][m][n] + bv[bj][n]); }
                asm volatile("" ::: "memory"); }
    }
};
template <bool BASEBF> struct EpiResB {
    static constexpr bool PERM = false;
    const float* basef; bf16* XB; const float* gate; const float* bias;
    __device__ __forceinline__ void operator()(const f32x4 (&acc)[2][2][4][2], const GU& u, int wr, int wc, int fr, int fq) const {
        const int row0 = u.p0 * BM + wr * 64 + fr, col0 = u.p1 * BM + wc * 32 + 4 * fq; const int b = (u.p0 * BM) >> 13;
        f32x4 gv[2][2], bv[2][2];
#pragma unroll
        for (int bj = 0; bj < 2; ++bj)
#pragma unroll
            for (int n = 0; n < 2; ++n) { gv[bj][n] = *(const f32x4*)(gate + (size_t)b * 6144 + col0 + bj * HALF + n * 16); bv[bj][n] = bias ? *(const f32x4*)(bias + col0 + bj * HALF + n * 16) : (f32x4){0.f, 0.f, 0.f, 0.f}; }
        constexpr int NB2 = BASEBF ? 4 : 2;
#pragma unroll
        for (int ai = 0; ai < 2; ++ai)
#pragma unroll
            for (int mb = 0; mb < 4; mb += NB2) {
                f32x4 bf[BASEBF ? 1 : NB2][2][2]; u32x2 bw[BASEBF ? NB2 : 1][2][2];
#pragma unroll
                for (int mm = 0; mm < NB2; ++mm) { const size_t off = (size_t)(row0 + ai * HALF + (mb + mm) * 16) * D + col0;
#pragma unroll
                    for (int bj = 0; bj < 2; ++bj)
#pragma unroll
                        for (int n = 0; n < 2; ++n) { if (BASEBF) bw[mm][bj][n] = *(const u32x2*)(XB + off + bj * HALF + n * 16); else bf[mm][bj][n] = *(const f32x4*)(basef + off + bj * HALF + n * 16); } }
#pragma unroll
                for (int mm = 0; mm < NB2; ++mm) { const int m = mb + mm; const size_t off = (size_t)(row0 + ai * HALF + m * 16) * D + col0;
#pragma unroll
                    for (int bj = 0; bj < 2; ++bj)
#pragma unroll
                        for (int n = 0; n < 2; ++n) { f32x4 bsv;
                            if (BASEBF) { const u32x2 w = bw[mm][bj][n]; bsv = (f32x4){bflo(w.x), bfhi(w.x), bflo(w.y), bfhi(w.y)}; } else bsv = bf[mm][bj][n];
                            const f32x4 o = bsv + gv[bj][n] * (acc[ai][bj][m][n] + bv[bj][n]);
                            u32x2 w2; w2.x = cvt_pk_bf16(o[0], o[1]); w2.y = cvt_pk_bf16(o[2], o[3]); *(u32x2*)(XB + off + bj * HALF + n * 16) = w2; } }
                asm volatile("" ::: "memory"); }
    }
};
struct EpiGLU {
    static constexpr bool PERM = true;
    bf16* U; const float* bias;
    __device__ __forceinline__ void operator()(const f32x4 (&acc)[2][2][4][2], const GU& u, int wr, int wc, int fr, int fq) const {
        const int row0 = u.p0 * BM + wr * 64 + fr, col0 = u.p1 * HALF + wc * 32 + 8 * fq;
        f32x4 ba[2], bg[2];
#pragma unroll
        for (int n = 0; n < 2; ++n) { ba[n] = *(const f32x4*)(bias + col0 + 4 * n); bg[n] = *(const f32x4*)(bias + 1024 + col0 + 4 * n); }
#pragma unroll
        for (int ai = 0; ai < 2; ++ai)
#pragma unroll
            for (int m = 0; m < 4; ++m) { f32x4 o[2];
#pragma unroll
                for (int n = 0; n < 2; ++n) { const f32x4 a = acc[ai][0][m][n] + ba[n], g = acc[ai][1][m][n] + bg[n];
#pragma unroll
                    for (int j = 0; j < 4; ++j) o[n][j] = a[j] * sigmoid_f(g[j]); }
                u32x4 w; w.x = cvt_pk_bf16(o[0][0], o[0][1]); w.y = cvt_pk_bf16(o[0][2], o[0][3]); w.z = cvt_pk_bf16(o[1][0], o[1][1]); w.w = cvt_pk_bf16(o[1][2], o[1][3]);
                *(u32x4*)(U + (size_t)(row0 + ai * HALF + m * 16) * D + col0) = w; }
    }
};
struct EpiGateUp {
    static constexpr bool PERM = true;
    bf16* HID; const float* slot_w; LAS int* mm;
    __device__ __forceinline__ void operator()(const f32x4 (&acc)[2][2][4][2], const GU& u, int wr, int wc, int fr, int fq) const {
        const int e = u.p0, n_e = mm[e], r0 = u.p1 * BM + wr * 64 + fr, col0 = u.p2 * HALF + wc * 32 + 8 * fq;
        float wv[2][4];
#pragma unroll
        for (int ai = 0; ai < 2; ++ai)
#pragma unroll
            for (int m = 0; m < 4; ++m) wv[ai][m] = slot_w[e * CAP + r0 + ai * HALF + m * 16];
#pragma unroll
        for (int ai = 0; ai < 2; ++ai)
#pragma unroll
            for (int m = 0; m < 4; ++m) { const int r = r0 + ai * HALF + m * 16;
                if (r < n_e) { const float w = wv[ai][m]; f32x4 o[2];
#pragma unroll
                    for (int n = 0; n < 2; ++n) { const f32x4 g = acc[ai][0][m][n], up = acc[ai][1][m][n];
#pragma unroll
                        for (int j = 0; j < 4; ++j) o[n][j] = w * silu_f(g[j]) * up[j]; }
                    u32x4 q; q.x = cvt_pk_bf16(o[0][0], o[0][1]); q.y = cvt_pk_bf16(o[0][2], o[0][3]); q.z = cvt_pk_bf16(o[1][0], o[1][1]); q.w = cvt_pk_bf16(o[1][2], o[1][3]);
                    *(u32x4*)(HID + (size_t)(u.p3 + r) * FF + col0) = q; } }
    }
};
struct EpiDown {
    static constexpr bool PERM = true;
    bf16* Y; LAS int* mm;
    __device__ __forceinline__ void operator()(const f32x4 (&acc)[2][2][4][2], const GU& u, int wr, int wc, int fr, int fq) const {
        const int e = u.p0, n_e = mm[e], r0 = u.p1 * BM + wr * 64 + fr, col0 = u.p2 * BM + wc * 32 + 8 * fq;
#pragma unroll
        for (int ai = 0; ai < 2; ++ai)
#pragma unroll
            for (int m = 0; m < 4; ++m) { const int r = r0 + ai * HALF + m * 16;
                if (r < n_e) {
#pragma unroll
                    for (int bj = 0; bj < 2; ++bj) { const f32x4 v0 = acc[ai][bj][m][0], v1 = acc[ai][bj][m][1];
                        u32x4 q; q.x = cvt_pk_bf16(v0[0], v0[1]); q.y = cvt_pk_bf16(v0[2], v0[3]); q.z = cvt_pk_bf16(v1[0], v1[1]); q.w = cvt_pk_bf16(v1[2], v1[3]);
                        *(u32x4*)(Y + (size_t)(u.p3 + r) * D + col0 + bj * HALF) = q; } } }
    }
};
}

__device__ __forceinline__ void fast_inproj(Frame& F) {
    pg::DenseSched S{(const char*)(F.ws + WS_WIN), D, T / 256, N_IN / 256, F.G, F.wg, TC / 256, T / 256, 4};
    pg::EpiInProj E{F.ws};
    pg::gemm_phase(F.lds, (const char*)(F.ws + WS_HB), D, S, E);
}
__device__ __forceinline__ void fast_outproj(Frame& F, size_t a_off, size_t w_off, const float* base, float* X, const float* gate, const float* bias) {
    pg::DenseSched S{(const char*)(F.ws + w_off), D, T / 256, D / 256, F.G, F.wg, 0, 0, 0};
    if (XBF16) {
        if (base == X) { pg::EpiResB<true> E{nullptr, (bf16*)(F.ws + WS_XB), gate, bias}; pg::gemm_phase(F.lds, (const char*)(F.ws + a_off), D, S, E); }
        else { pg::EpiResB<false> E{base, (bf16*)(F.ws + WS_XB), gate, bias}; pg::gemm_phase(F.lds, (const char*)(F.ws + a_off), D, S, E); }
    } else { pg::EpiRes E{base, X, gate, bias}; pg::gemm_phase(F.lds, (const char*)(F.ws + a_off), D, S, E); }
}
__device__ __forceinline__ void fast_pw1(Frame& F) {
    pg::DenseSched S{(const char*)(F.ws + WS_WPW1), D, T / 256, 2048 / 256, F.G, F.wg, 0, 0, 0};
    pg::EpiGLU E{(bf16*)(F.ws + WS_U), F.in[I_PW1B]};
    pg::gemm_phase(F.lds, (const char*)(F.ws + WS_HB), D, S, E);
}
__device__ __forceinline__ void fast_moe_gateup(Frame& F, int layer) {
    LAS int* mm = moe_map(F, layer);
    pg::MoeSched<true> S{(const char*)(F.ws + WS_WGU) + (size_t)layer * 16 * 1024 * 1024 * 2, (size_t)1024 * 1024 * 2, D, (const int*)(F.ws + WS_SLOTT) + layer * 16 * CAP, mm, F.G, F.wg};
    pg::EpiGateUp E{(bf16*)(F.ws + WS_HID), (const float*)(F.ws + WS_SLOTW) + layer * 16 * CAP, mm};
    pg::gemm_phase(F.lds, (const char*)(F.ws + WS_HB), D, S, E);
}
__device__ __forceinline__ void fast_moe_down(Frame& F, int layer) {
    LAS int* mm = moe_map(F, layer);
    pg::MoeSched<false> S{(const char*)(F.ws + WS_WDN) + (size_t)layer * 16 * 1024 * 512 * 2, (size_t)1024 * 512 * 2, FF, nullptr, mm, F.G, F.wg};
    pg::EpiDown E{(bf16*)(F.ws + WS_Y), mm};
    pg::gemm_phase(F.lds, (const char*)(F.ws + WS_HID), FF, S, E);
}


struct AttnBlk { const bf16* kp; const bf16* vp; int pitch; int kb; bool valid, masked; };
__device__ __forceinline__ AttnBlk attn_blk(const unsigned char* ws, int bi, int b, int kvh, int qs) {
    AttnBlk a;
    if (bi < 8) { a.kp = (const bf16*)(ws + WS_CK) + (size_t)(b * CL + bi * 32) * 128 + kvh * 64; a.vp = (const bf16*)(ws + WS_CV) + (size_t)(b * 2 + kvh) * 64 * CL + bi * 32; a.pitch = CL; a.kb = 0; a.valid = true; a.masked = false; }
    else { const int kb = qs - 128 + 32 * (bi - 8); a.valid = (kb >= 0 && kb < L); a.kb = kb; a.masked = true; a.pitch = L;
        a.kp = (const bf16*)(ws + WS_K) + (size_t)(b * L + kb) * 128 + kvh * 64; a.vp = (const bf16*)(ws + WS_V) + (size_t)(b * 2 + kvh) * 64 * L + kb; }
    return a;
}
__device__ __forceinline__ void attn_load(const AttnBlk& a, int r, int h, bf16x8 (&kf)[4], u32x4 (&vf)[2][2]) {
    if (a.valid) {
#pragma unroll
        for (int s = 0; s < 4; ++s) kf[s] = *(const bf16x8*)(a.kp + (size_t)r * 128 + 16 * s + 8 * h);
#pragma unroll
        for (int db = 0; db < 2; ++db)
#pragma unroll
            for (int ks = 0; ks < 2; ++ks) { const bf16* vr = a.vp + (size_t)(32 * db + r) * a.pitch + 16 * ks + 4 * h;
                const u32x2 lo = *(const u32x2*)vr, hi = *(const u32x2*)(vr + 8); vf[db][ks] = (u32x4){lo.x, lo.y, hi.x, hi.y}; }
    }
}
__device__ __forceinline__ void attn_compute(const AttnBlk& a, int qs, int r, int h, const bf16x8 (&kf)[4], const u32x4 (&vf)[2][2], const bf16x8 (&qf)[2][4],
                                             f32x16 (&o)[2][2], float (&m)[2], float (&l)[2]) {
    if (!a.valid) return;
#pragma unroll
    for (int nq = 0; nq < 2; ++nq) {
        f32x16 st;
#pragma unroll
        for (int i = 0; i < 16; ++i) st[i] = 0.f;
#pragma unroll
        for (int s = 0; s < 4; ++s) st = __builtin_amdgcn_mfma_f32_32x32x16_bf16(kf[s], qf[nq][s], st, 0, 0, 0);
        float t[16]; float tmax = -INFINITY;
        const int dbase = a.kb - qs - 32 * nq - r + 4 * h;
#pragma unroll
        for (int i = 0; i < 16; ++i) { float v = st[i] * (0.125f * 1.4426950408889634f);
            if (a.masked) { const int df = dbase + (i & 3) + 8 * (i >> 2); v = (df >= -128 && df <= 128) ? v : -INFINITY; }
            t[i] = v; tmax = fmaxf(tmax, v); }
        tmax = fmaxf(tmax, __shfl_xor(tmax, 32));
        const float mn = fmaxf(m[nq], tmax), alpha = __builtin_amdgcn_exp2f(m[nq] - mn); m[nq] = mn;
        float ps = 0.f;
#pragma unroll
        for (int i = 0; i < 16; ++i) { t[i] = __builtin_amdgcn_exp2f(t[i] - mn); ps += t[i]; }
        l[nq] = l[nq] * alpha + ps;
#pragma unroll
        for (int i = 0; i < 16; ++i) { o[0][nq][i] *= alpha; o[1][nq][i] *= alpha; }
        bf16x8 pf[2];
#pragma unroll
        for (int ks = 0; ks < 2; ++ks) { const u32x4 w = {pkbf(t[8 * ks], t[8 * ks + 1]), pkbf(t[8 * ks + 2], t[8 * ks + 3]), pkbf(t[8 * ks + 4], t[8 * ks + 5]), pkbf(t[8 * ks + 6], t[8 * ks + 7])};
            pf[ks] = __builtin_bit_cast(bf16x8, w); }
#pragma unroll
        for (int db = 0; db < 2; ++db)
#pragma unroll
            for (int ks = 0; ks < 2; ++ks) o[db][nq] = __builtin_amdgcn_mfma_f32_32x32x16_bf16(__builtin_bit_cast(bf16x8, vf[db][ks]), pf[ks], o[db][nq], 0, 0, 0);
    }
}
__device__ __forceinline__ void phase_attn_mfma(Frame& F) {
    const bf16* Q = (const bf16*)(F.ws + WS_Q); bf16* MIX = (bf16*)(F.ws + WS_MIX);
    const int g = F.wave >> 1, half = F.wave & 1, r = F.lane & 31, h = F.lane >> 5;
    for (int item = F.wg; item < NB * 2 * 64; item += F.G) {
        const int qb = item & 63, kvh = (item >> 6) & 1, b = item >> 7, hd = kvh * 4 + g, qs = qb * 128 + half * 64;
        bf16x8 qf[2][4];
#pragma unroll
        for (int nq = 0; nq < 2; ++nq)
#pragma unroll
            for (int s = 0; s < 4; ++s) qf[nq][s] = *(const bf16x8*)(Q + (size_t)(b * L + qs + 32 * nq + r) * 512 + hd * 64 + 16 * s + 8 * h);
        f32x16 o[2][2];
#pragma unroll
        for (int db = 0; db < 2; ++db)
#pragma unroll
            for (int nq = 0; nq < 2; ++nq)
#pragma unroll
                for (int i = 0; i < 16; ++i) o[db][nq][i] = 0.f;
        float m[2], l[2];
        m[0] = m[1] = F.in[I_SINK][hd] * 1.4426950408889634f; l[0] = l[1] = (h == 0) ? 1.f : 0.f;
        bf16x8 kfA[4], kfB[4]; u32x4 vfA[2][2], vfB[2][2];
        AttnBlk ba = attn_blk(F.ws, 0, b, kvh, qs), bb;
        attn_load(ba, r, h, kfA, vfA);
#pragma unroll 1
        for (int bi = 0; bi < 18; bi += 2) {
            bb = attn_blk(F.ws, bi + 1, b, kvh, qs); attn_load(bb, r, h, kfB, vfB);
            attn_compute(ba, qs, r, h, kfA, vfA, qf, o, m, l);
            if (bi + 2 < 18) { ba = attn_blk(F.ws, bi + 2, b, kvh, qs); attn_load(ba, r, h, kfA, vfA); }
            attn_compute(bb, qs, r, h, kfB, vfB, qf, o, m, l);
        }
#pragma unroll
        for (int nq = 0; nq < 2; ++nq) {
            const float lt = l[nq] + __shfl_xor(l[nq], 32), il = 1.f / lt;
            bf16* orow = MIX + (size_t)(b * L + qs + 32 * nq + r) * 1024 + 512 + hd * 64;
#pragma unroll
            for (int db = 0; db < 2; ++db)
#pragma unroll
                for (int i4 = 0; i4 < 4; ++i4) { u32x2 w; w.x = pkbf(o[db][nq][4 * i4] * il, o[db][nq][4 * i4 + 1] * il); w.y = pkbf(o[db][nq][4 * i4 + 2] * il, o[db][nq][4 * i4 + 3] * il);
                    *(u32x2*)(orow + 32 * db + 8 * i4 + 4 * h) = w; }
        }
    }
}


__device__ __forceinline__ float half_max(float v) { const auto r = __builtin_amdgcn_permlane32_swap(__float_as_uint(v), __float_as_uint(v), false, false); return fmaxf(__uint_as_float(r[0]), __uint_as_float(r[1])); }
__device__ __forceinline__ float half_sum(float v) { const auto r = __builtin_amdgcn_permlane32_swap(__float_as_uint(v), __float_as_uint(v), false, false); return __uint_as_float(r[0]) + __uint_as_float(r[1]); }
constexpr int AT_KP = 72, AT_VP = 136;
constexpr int AT_KB = 128 * AT_KP * 2, AT_BUF = AT_KB + 64 * AT_VP * 2;
struct AtChunk { const bf16* kg; const bf16* vg; int vpitch, lc, b, kvh, qb, c; bool valid, local, any; };
__device__ __forceinline__ AtChunk at_chunk(const unsigned char* ws, int seq, int wg, int G) {
    AtChunk k; const int item = wg + (seq / 5) * G; k.c = seq % 5; k.any = item < NB * 2 * 64;
    k.qb = item & 63; k.kvh = (item >> 6) & 1; k.b = (item >> 7) & 3; k.local = k.c >= 2; k.lc = k.c - 2;
    if (!k.local) { k.valid = k.any; k.vpitch = CL; k.kg = (const bf16*)(ws + WS_CK) + (size_t)(k.b * CL + 128 * k.c) * 128 + k.kvh * 64; k.vg = (const bf16*)(ws + WS_CV) + (size_t)(k.b * 2 + k.kvh) * 64 * CL + 128 * k.c; }
    else { const int key0 = 128 * k.qb - 128 + 128 * k.lc; k.valid = k.any && key0 >= 0 && key0 < L; k.vpitch = L;
        k.kg = (const bf16*)(ws + WS_K) + (size_t)(k.b * L + key0) * 128 + k.kvh * 64; k.vg = (const bf16*)(ws + WS_V) + (size_t)(k.b * 2 + k.kvh) * 64 * L + key0; }
    return k;
}
__device__ __forceinline__ void at_issue(const AtChunk& k, int tid, u32x4 (&rg)[4]) {
    if (k.valid) {
#pragma unroll
        for (int i = 0; i < 2; ++i) { const int id = tid + 512 * i; rg[i] = *(const u32x4*)(k.kg + (size_t)(id >> 3) * 128 + (id & 7) * 8); }
#pragma unroll
        for (int i = 0; i < 2; ++i) { const int id = tid + 512 * i; rg[2 + i] = *(const u32x4*)(k.vg + (size_t)(id >> 4) * k.vpitch + (id & 15) * 8); }
    }
}
__device__ __forceinline__ void at_write(const AtChunk& k, LAS unsigned char* buf, int tid, const u32x4 (&rg)[4]) {
    if (k.valid) {
#pragma unroll
        for (int i = 0; i < 2; ++i) { const int id = tid + 512 * i; *(LAS u32x4*)(buf + (id >> 3) * (AT_KP * 2) + (id & 7) * 16) = rg[i]; }
#pragma unroll
        for (int i = 0; i < 2; ++i) { const int id = tid + 512 * i; *(LAS u32x4*)(buf + AT_KB + (id >> 4) * (AT_VP * 2) + (id & 15) * 16) = rg[2 + i]; }
    }
}
__device__ __forceinline__ void at_load(LAS unsigned char* buf, int blk, int r, int h, bf16x8 (&kf)[4], u32x4 (&vf)[2][2]) {
#pragma unroll
    for (int s2 = 0; s2 < 4; ++s2) kf[s2] = *(const LAS bf16x8*)(buf + (32 * blk + r) * (AT_KP * 2) + (16 * s2 + 8 * h) * 2);
#pragma unroll
    for (int db = 0; db < 2; ++db)
#pragma unroll
        for (int ks = 0; ks < 2; ++ks) { const LAS unsigned char* vr = buf + AT_KB + (32 * db + r) * (AT_VP * 2) + (32 * blk + 16 * ks + 4 * h) * 2;
            const u32x2 lo = *(const LAS u32x2*)vr, hi = *(const LAS u32x2*)(vr + 16); vf[db][ks] = (u32x4){lo.x, lo.y, hi.x, hi.y}; }
}
__device__ __forceinline__ void at_math(const bf16x8 (&kf)[4], const u32x4 (&vf)[2][2], bool masked, int kbrel, int r, int h, const bf16x8 (&qf)[2][4], f32x16 (&o)[2][2], float (&m)[2], float (&l)[2]) {
    constexpr float C = 0.125f * 1.4426950408889634f;
#pragma unroll
    for (int nq = 0; nq < 2; ++nq) {
        f32x16 st;
#pragma unroll
        for (int i = 0; i < 16; ++i) st[i] = 0.f;
#pragma unroll
        for (int s2 = 0; s2 < 4; ++s2) st = __builtin_amdgcn_mfma_f32_32x32x16_bf16(kf[s2], qf[nq][s2], st, 0, 0, 0);
        if (masked) { const int dbase = kbrel - 32 * nq - r + 4 * h;
#pragma unroll
            for (int i = 0; i < 16; ++i) { const int df = dbase + (i & 3) + 8 * (i >> 2); st[i] = (df >= -128 && df <= 128) ? st[i] : -INFINITY; } }
        float smax = st[0];
#pragma unroll
        for (int i = 1; i < 16; ++i) smax = fmaxf(smax, st[i]);
        smax = half_max(smax);
        const float mn = fmaxf(m[nq], smax * C), alpha = __builtin_amdgcn_exp2f(m[nq] - mn); m[nq] = mn;
        float t[16]; float ps = 0.f;
#pragma unroll
        for (int i = 0; i < 16; ++i) { t[i] = __builtin_amdgcn_exp2f(__builtin_fmaf(st[i], C, -mn)); ps += t[i]; }
        l[nq] = l[nq] * alpha + ps;
        if (__ballot(alpha != 1.f)) {
#pragma unroll
            for (int i = 0; i < 16; ++i) { o[0][nq][i] *= alpha; o[1][nq][i] *= alpha; } }
        bf16x8 pf[2];
#pragma unroll
        for (int ks = 0; ks < 2; ++ks) { const u32x4 w = {pkbf(t[8 * ks], t[8 * ks + 1]), pkbf(t[8 * ks + 2], t[8 * ks + 3]), pkbf(t[8 * ks + 4], t[8 * ks + 5]), pkbf(t[8 * ks + 6], t[8 * ks + 7])};
            pf[ks] = __builtin_bit_cast(bf16x8, w); }
#pragma unroll
        for (int db = 0; db < 2; ++db)
#pragma unroll
            for (int ks = 0; ks < 2; ++ks) o[db][nq] = __builtin_amdgcn_mfma_f32_32x32x16_bf16(__builtin_bit_cast(bf16x8, vf[db][ks]), pf[ks], o[db][nq], 0, 0, 0);
    }
}
__device__ __forceinline__ void phase_attn_lds(Frame& F) {
    const bf16* Q = (const bf16*)(F.ws + WS_Q); bf16* MIX = (bf16*)(F.ws + WS_MIX);
    const int g = F.wave >> 1, half = F.wave & 1, r = F.lane & 31, h = F.lane >> 5;
    __syncthreads();
    u32x4 rg[4];
    AtChunk ck = at_chunk(F.ws, 0, F.wg, F.G);
    if (!ck.any) return;
    at_issue(ck, F.tid, rg); at_write(ck, F.lds, F.tid, rg);
    __syncthreads();
    bf16x8 qf[2][4]; f32x16 o[2][2]; float m[2], l[2];
#pragma unroll 1
    for (int seq = 0; ck.any; ++seq) {
        LAS unsigned char* buf = F.lds + (seq & 1) * AT_BUF;
        const AtChunk nk = at_chunk(F.ws, seq + 1, F.wg, F.G);
        at_issue(nk, F.tid, rg);
        const int hd = ck.kvh * 4 + g, qs = ck.qb * 128 + half * 64;
        if (ck.c == 0) {
#pragma unroll
            for (int nq = 0; nq < 2; ++nq)
#pragma unroll
                for (int s2 = 0; s2 < 4; ++s2) qf[nq][s2] = *(const bf16x8*)(Q + (size_t)(ck.b * L + qs + 32 * nq + r) * 512 + hd * 64 + 16 * s2 + 8 * h);
#pragma unroll
            for (int db = 0; db < 2; ++db)
#pragma unroll
                for (int nq = 0; nq < 2; ++nq)
#pragma unroll
                    for (int i = 0; i < 16; ++i) o[db][nq][i] = 0.f;
            m[0] = m[1] = F.in[I_SINK][hd] * 1.4426950408889634f; l[0] = l[1] = (h == 0) ? 1.f : 0.f;
        }
        if (ck.valid) {
            int b0 = 0, b1 = 4;
            if (ck.local) { b0 = 2 * half - 4 * ck.lc; b0 = b0 < 0 ? 0 : b0; b1 = 2 * half + 10 - 4 * ck.lc; b1 = b1 > 4 ? 4 : b1; }
            if (b0 < b1) {
                bf16x8 kfA[4], kfB[4]; u32x4 vfA[2][2], vfB[2][2];
                at_load(buf, b0, r, h, kfA, vfA);
#pragma unroll 1
                for (int blk = b0; blk < b1; blk += 2) {
                    const int iA = 4 * ck.lc + blk - 2 * half, iB = iA + 1;
                    if (blk + 1 < b1) at_load(buf, blk + 1, r, h, kfB, vfB);
                    at_math(kfA, vfA, ck.local && (iA < 2 || iA > 7), 32 * iA - 128, r, h, qf, o, m, l);
                    if (blk + 1 < b1) {
                        if (blk + 2 < b1) at_load(buf, blk + 2, r, h, kfA, vfA);
                        at_math(kfB, vfB, ck.local && (iB < 2 || iB > 7), 32 * iB - 128, r, h, qf, o, m, l);
                    }
                }
            }
        }
        if (ck.c == 4) {
#pragma unroll
            for (int nq = 0; nq < 2; ++nq) {
                const float lt = half_sum(l[nq]), il = __builtin_amdgcn_rcpf(lt);
                bf16* orow = MIX + (size_t)(ck.b * L + qs + 32 * nq + r) * 1024 + 512 + hd * 64;
#pragma unroll
                for (int db = 0; db < 2; ++db)
#pragma unroll
                    for (int i4 = 0; i4 < 4; ++i4) { u32x2 w; w.x = pkbf(o[db][nq][4 * i4] * il, o[db][nq][4 * i4 + 1] * il); w.y = pkbf(o[db][nq][4 * i4 + 2] * il, o[db][nq][4 * i4 + 3] * il);
                        *(u32x2*)(orow + 32 * db + 8 * i4 + 4 * h) = w; }
            }
        }
        at_write(nk, F.lds + ((seq + 1) & 1) * AT_BUF, F.tid, rg);
        __syncthreads();
        ck = nk;
    }
}

constexpr int F1_PC = 136, F1_PW = 68, F2_P = 264;
constexpr int F1_CSC = 0, F1_CSS = 128 * F1_PC * 2, F1_C64 = 2 * 128 * F1_PC * 2, F1_S64 = F1_C64 + 64 * F1_PW * 2;
__device__ __forceinline__ bf16x8 pack8(float a0, float a1, float a2, float a3, float a4, float a5, float a6, float a7) {
    const u32x4 w = {pkbf(a0, a1), pkbf(a2, a3), pkbf(a4, a5), pkbf(a6, a7)}; return __builtin_bit_cast(bf16x8, w); }
__device__ __forceinline__ void phase_fft1_mfma(Frame& F) {
    __syncthreads();
    LAS bf16* csc = (LAS bf16*)(F.lds + F1_CSC); LAS bf16* css = (LAS bf16*)(F.lds + F1_CSS); LAS bf16* c64 = (LAS bf16*)(F.lds + F1_C64); LAS bf16* s64 = (LAS bf16*)(F.lds + F1_S64);
    for (int i = F.tid; i < 128 * 128; i += NTHR) { const int n = i >> 7, k = i & 127; const float ang = (float)((n * k) & 127) * (6.283185307179586f / 128.f);
        csc[n * F1_PC + k] = (bf16)f2bf(__cosf(ang)); css[n * F1_PC + k] = (bf16)f2bf(__sinf(ang)); }
    for (int i = F.tid; i < 64 * 64; i += NTHR) { const int c = i >> 6, a = i & 63; const float ang = (float)((c * a) & 63) * (6.283185307179586f / 64.f);
        c64[c * F1_PW + a] = (bf16)f2bf(__cosf(ang)); s64[c * F1_PW + a] = (bf16)f2bf(__sinf(ang)); }
    __syncthreads();
    const bf16* UF = (const bf16*)(F.ws + WS_UF); bf16* Gb = (bf16*)(F.ws + WS_G);
    const int r = F.lane & 31, h = F.lane >> 5, g = F.wave >> 1;
    for (int item = F.wg; item < NB * FN2; item += F.G) {
        const int b = item >> 7, bp = item & 127;
#pragma unroll 1
        for (int q = 0; q < 2; ++q) {
            const int cbk = 2 * F.wave + q, n = 32 * (cbk & 3) + r, ch = 32 * cbk + r;
            f32x16 zr[2], zi[2];
#pragma unroll
            for (int rb = 0; rb < 2; ++rb) {
                bf16x8 uf[8];
#pragma unroll
                for (int s2 = 0; s2 < 8; ++s2) uf[s2] = *(const bf16x8*)(UF + (size_t)(b * L + 128 * (32 * rb + r) + bp) * 512 + g * 128 + 16 * s2 + 8 * h);
#pragma unroll
                for (int i = 0; i < 16; ++i) { zr[rb][i] = 0.f; zi[rb][i] = 0.f; }
#pragma unroll
                for (int s2 = 0; s2 < 8; ++s2) { const bf16x8 bc = *(const LAS bf16x8*)(csc + n * F1_PC + 16 * s2 + 8 * h), bs = *(const LAS bf16x8*)(css + n * F1_PC + 16 * s2 + 8 * h);
                    zr[rb] = __builtin_amdgcn_mfma_f32_32x32x16_bf16(uf[s2], bc, zr[rb], 0, 0, 0); zi[rb] = __builtin_amdgcn_mfma_f32_32x32x16_bf16(uf[s2], bs, zi[rb], 0, 0, 0); }
                __builtin_amdgcn_sched_barrier(0);
            }
            bf16x8 zfr[4], zfi[4];
#pragma unroll
            for (int ks = 0; ks < 4; ++ks) { const int rb = ks >> 1, o = 8 * (ks & 1);
                zfr[ks] = pack8(zr[rb][o], zr[rb][o + 1], zr[rb][o + 2], zr[rb][o + 3], zr[rb][o + 4], zr[rb][o + 5], zr[rb][o + 6], zr[rb][o + 7]);
                zfi[ks] = pack8(-zi[rb][o], -zi[rb][o + 1], -zi[rb][o + 2], -zi[rb][o + 3], -zi[rb][o + 4], -zi[rb][o + 5], -zi[rb][o + 6], -zi[rb][o + 7]); }
            __builtin_amdgcn_sched_barrier(0);
#pragma unroll 1
            for (int rbc = 0; rbc < 2; ++rbc) {
                f32x16 gr, gi; const int cr = 32 * rbc + r;
#pragma unroll
                for (int i = 0; i < 16; ++i) { gr[i] = 0.f; gi[i] = 0.f; }
#pragma unroll
                for (int ks = 0; ks < 4; ++ks) {
                    const u32x2 cl = *(const LAS u32x2*)(c64 + cr * F1_PW + 16 * ks + 4 * h), chh = *(const LAS u32x2*)(c64 + cr * F1_PW + 16 * ks + 8 + 4 * h);
                    const u32x2 sl = *(const LAS u32x2*)(s64 + cr * F1_PW + 16 * ks + 4 * h), shh = *(const LAS u32x2*)(s64 + cr * F1_PW + 16 * ks + 8 + 4 * h);
                    const u32x4 sw = {sl.x, sl.y, shh.x, shh.y}; const u32x4 swn = sw ^ 0x80008000u;
                    const bf16x8 wc = __builtin_bit_cast(bf16x8, ((u32x4){cl.x, cl.y, chh.x, chh.y})), wsn = __builtin_bit_cast(bf16x8, sw), wsm = __builtin_bit_cast(bf16x8, swn);
                    gr = __builtin_amdgcn_mfma_f32_32x32x16_bf16(wc, zfr[ks], gr, 0, 0, 0); gr = __builtin_amdgcn_mfma_f32_32x32x16_bf16(wsn, zfi[ks], gr, 0, 0, 0);
                    gi = __builtin_amdgcn_mfma_f32_32x32x16_bf16(wc, zfi[ks], gi, 0, 0, 0); gi = __builtin_amdgcn_mfma_f32_32x32x16_bf16(wsm, zfr[ks], gi, 0, 0, 0); }
                __builtin_amdgcn_sched_barrier(0);
#pragma unroll
                for (int i = 0; i < 16; ++i) { const int c = 32 * rbc + crow(i, h); const float ang = (float)(bp * c) * (6.283185307179586f / 8192.f), cs = __cosf(ang), sn = __sinf(ang);
                    const float re = gr[i] * cs + gi[i] * sn, im = gi[i] * cs - gr[i] * sn;
                    bf16* o = Gb + (size_t)((b * FN1 + c) * FN2 + bp) * 1024 + ch; o[0] = (bf16)f2bf(re); o[512] = (bf16)f2bf(im);
                    if ((i & 3) == 3) __builtin_amdgcn_sched_barrier(0); }
            }
        }
    }
    __syncthreads();
}
__device__ __forceinline__ void phase_fft2_mfma(Frame& F) {
    __syncthreads();
    LAS bf16* t2 = (LAS bf16*)F.lds;
    for (int i = F.tid; i < 128 * 256; i += NTHR) { const int d = i >> 8, k = i & 255; const float ang = (float)((d * (k & 127)) & 127) * (6.283185307179586f / 128.f);
        t2[d * F2_P + k] = (bf16)f2bf(k < 128 ? __cosf(ang) : __sinf(ang)); }
    __syncthreads();
    const bf16* Gb = (const bf16*)(F.ws + WS_G); bf16* MIX = (bf16*)(F.ws + WS_MIX);
    const int r = F.lane & 31, h = F.lane >> 5;
    for (int item = F.wg; item < NB * FN1; item += F.G) {
        const int b = item >> 6, c = item & 63;
        const bf16* Gp = Gb + (size_t)((b * FN1 + c) * FN2) * 1024 + 64 * F.wave + r;
        f32x16 y[4][2];
#pragma unroll
        for (int rb = 0; rb < 4; ++rb)
#pragma unroll
            for (int cb = 0; cb < 2; ++cb)
#pragma unroll
                for (int i = 0; i < 16; ++i) y[rb][cb][i] = 0.f;
        unsigned eA[2][8], eB[2][8];
#define F2_GATHER(dst, ks_) do { const bf16* p_ = Gp + (size_t)(16 * ((ks_) & 7) + 8 * h) * 1024 + ((ks_) >> 3) * 512; \
            _Pragma("unroll") for (int cb = 0; cb < 2; ++cb) _Pragma("unroll") for (int j = 0; j < 8; ++j) dst[cb][j] = p_[(size_t)j * 1024 + 32 * cb]; } while (0)
#define F2_MMA(src, ks_) do { bf16x8 bfr[2]; _Pragma("unroll") for (int cb = 0; cb < 2; ++cb) { \
                const u32x4 w = {src[cb][0] | (src[cb][1] << 16), src[cb][2] | (src[cb][3] << 16), src[cb][4] | (src[cb][5] << 16), src[cb][6] | (src[cb][7] << 16)}; bfr[cb] = __builtin_bit_cast(bf16x8, w); } \
            _Pragma("unroll") for (int rb = 0; rb < 4; ++rb) { const bf16x8 a = *(const LAS bf16x8*)(t2 + (32 * rb + r) * F2_P + 16 * (ks_) + 8 * h); \
                _Pragma("unroll") for (int cb = 0; cb < 2; ++cb) y[rb][cb] = __builtin_amdgcn_mfma_f32_32x32x16_bf16(a, bfr[cb], y[rb][cb], 0, 0, 0); } } while (0)
        F2_GATHER(eA, 0);
#pragma unroll 1
        for (int ks = 0; ks < 16; ks += 2) {
            F2_GATHER(eB, ks + 1);
            F2_MMA(eA, ks);
            if (ks + 2 < 16) F2_GATHER(eA, ks + 2);
            F2_MMA(eB, ks + 1);
        }
#undef F2_GATHER
#undef F2_MMA
#pragma unroll
        for (int rb = 0; rb < 4; ++rb)
#pragma unroll
            for (int cb = 0; cb < 2; ++cb)
#pragma unroll
                for (int i = 0; i < 16; ++i) { const int d = 32 * rb + crow(i, h); MIX[(size_t)(b * L + c + 64 * d) * 1024 + 64 * F.wave + 32 * cb + r] = (bf16)f2bf(y[rb][cb][i] * (1.f / 1024.f)); }
    }
    __syncthreads();
}


typedef float f32x2_t __attribute__((ext_vector_type(2)));
template <int IR> struct DwIn {
    static __device__ __forceinline__ void run(const unsigned (&uin)[62], const f32x2_t (&w)[31], f32x2_t (&o)[32]) {
        const f32x2_t x = {bflo(uin[IR]), bfhi(uin[IR])};
#pragma unroll
        for (int r = 0; r < 32; ++r) { if (IR - r >= 0 && IR - r <= 30) o[r] += w[(IR - r >= 0 && IR - r <= 30) ? IR - r : 0] * x; }
        DwIn<IR + 1>::run(uin, w, o);
    }
};
template <> struct DwIn<62> { static __device__ __forceinline__ void run(const unsigned (&)[62], const f32x2_t (&)[31], f32x2_t (&)[32]) {} };
template <int IR> struct DwIn16 {
    static __device__ __forceinline__ void run(const unsigned (&uin)[46], const f32x2_t (&w)[31], f32x2_t (&o)[16]) {
        const f32x2_t x = {bflo(uin[IR]), bfhi(uin[IR])};
#pragma unroll
        for (int r = 0; r < 16; ++r) { if (IR - r >= 0 && IR - r <= 30) o[r] += w[(IR - r >= 0 && IR - r <= 30) ? IR - r : 0] * x; }
        DwIn16<IR + 1>::run(uin, w, o);
    }
};
template <> struct DwIn16<46> { static __device__ __forceinline__ void run(const unsigned (&)[46], const f32x2_t (&)[31], f32x2_t (&)[16]) {} };
__device__ __forceinline__ void phase_dwconv_fast(Frame& F) {
    const bf16* U = (const bf16*)(F.ws + WS_U); bf16* V1 = (bf16*)(F.ws + WS_V1);
    const float* dww = F.in[I_DWW];
    const int c0 = 2 * F.tid;
    f32x2_t w[31];
#pragma unroll
    for (int j = 0; j < 31; ++j) w[j] = *(const f32x2_t*)(dww + (size_t)j * D + c0);
    const f32x2_t bb = *(const f32x2_t*)(F.in[I_DWB] + c0), gg = *(const f32x2_t*)(F.in[I_LNG] + c0), lb = *(const f32x2_t*)(F.in[I_LNB] + c0);
    LAS float* red = (LAS float*)F.lds;
    LAS float* stat = red + 16 * 8 * 2;
    __syncthreads();
    for (int run = F.wg; run < T / 128; run += F.G) {
        const int row0 = run * 128, l0 = row0 & (L - 1);
        unsigned uin[46], nx[16];
#pragma unroll
        for (int ir = 0; ir < 46; ++ir) { const int l = l0 - 15 + ir; const bool ok = (l >= 0 && l < L);
            const unsigned u = *(const unsigned*)(U + (size_t)(ok ? row0 - 15 + ir : row0) * D + c0); uin[ir] = ok ? u : 0u; }
#pragma unroll 1
        for (int step = 0; step < 8; ++step) {
            const int r0 = row0 + 16 * step;
            if (step < 7) {
#pragma unroll
                for (int j = 0; j < 16; ++j) { const int l = l0 + 16 * step + 31 + j; const bool ok = l < L;
                    const unsigned u = *(const unsigned*)(U + (size_t)(ok ? r0 + 31 + j : r0) * D + c0); nx[j] = ok ? u : 0u; }
            }
            f32x2_t o[16];
#pragma unroll
            for (int r = 0; r < 16; ++r) o[r] = bb;
            DwIn16<0>::run(uin, w, o);
#pragma unroll
            for (int r = 0; r < 16; ++r) { const float sm = wave_sum(o[r].x + o[r].y), sq = wave_sum(o[r].x * o[r].x + o[r].y * o[r].y);
                if (F.lane == 0) { red[(r * 8 + F.wave) * 2] = sm; red[(r * 8 + F.wave) * 2 + 1] = sq; } }
            __syncthreads();
            if (F.tid < 16) { float sm = 0.f, sq = 0.f;
#pragma unroll
                for (int wv = 0; wv < 8; ++wv) { sm += red[(F.tid * 8 + wv) * 2]; sq += red[(F.tid * 8 + wv) * 2 + 1]; }
                const float mean = sm * (1.f / D), var = fmaxf(sq * (1.f / D) - mean * mean, 0.f);
                stat[2 * F.tid] = mean; stat[2 * F.tid + 1] = rsqrtf(var + EPS); }
            __syncthreads();
#pragma unroll
            for (int r = 0; r < 16; ++r) { const float mean = stat[2 * r], rstd = stat[2 * r + 1];
                const float y0 = silu_f((o[r].x - mean) * rstd * gg.x + lb.x), y1 = silu_f((o[r].y - mean) * rstd * gg.y + lb.y);
                *(unsigned*)(V1 + (size_t)(r0 + r) * D + c0) = pkbf(y0, y1); }
#pragma unroll
            for (int i = 0; i < 30; ++i) uin[i] = uin[i + 16];
#pragma unroll
            for (int j = 0; j < 16; ++j) uin[30 + j] = nx[j];
        }
        __syncthreads();
    }
}

namespace pg {
struct MU { const char* B; const char* A; int K, type, e, rt, pn, hb, buf; };
struct MoeMergedSched {
    const char* Wgu; const char* Wdn; const char* HBp; const char* HIDp; const int* list; const float* wlist; LAS int* mm; unsigned* tcnt; unsigned* tmo; int G, c, U;
    __device__ __forceinline__ bool flat(int L, int type, MU& u) const {
        for (int e = 0; e < 16; ++e) { const int n = mm[e], nu = ((n + 255) >> 8) * 4;
            if (L < nu) { u.e = e; u.rt = L >> 2; u.pn = L & 3; u.hb = mm[16 + e]; u.type = type; u.buf = 0;
                if (type == 0) { u.K = D; u.A = HBp; u.B = Wgu + (size_t)e * (1024 * 1024 * 2) + (size_t)u.pn * BM * D * 2; }
                else { u.K = FF; u.A = HIDp; u.B = Wdn + (size_t)e * (1024 * 512 * 2) + (size_t)u.pn * BM * FF * 2; }
                return true; }
            L -= nu; }
        return false;
    }
    __device__ __forceinline__ bool next(int i, MU& u) const {
        const int ngu = c < U ? (U - 1 - c) / G + 1 : 0;
        if (i < ngu) return flat(i * G + c, 0, u);
        const int k = i - ngu, x = U % G; int j;
        if (c >= x) { if (k == 0) j = c - x; else j = (G - 1 - c) + (k - 1) * G + (G - x); } else j = (G - 1 - c) + k * G + (G - x);
        if (j >= U) return false;
        return flat(j, 1, u);
    }
    __device__ __forceinline__ unsigned voff(const MU& u, int buf, LAS unsigned char* lds, int R, int C) const {
        if (u.type == 0) { const int tok = ((const LAS int*)(lds + TAB_OFF))[buf * 256 + R]; return (unsigned)((tok * D + C) * 2); }
        return (unsigned)(((u.hb + u.rt * BM + R) * FF + C) * 2);
    }
    __device__ __forceinline__ void stage_table(const MU& u, int buf, LAS unsigned char* lds, int wid, int lane) const {
        const int r = (wid & 3) * 64 + lane;
        __builtin_amdgcn_global_load_lds((const unsigned*)(list + u.e * CAP + u.rt * BM + r), (LAS unsigned*)(lds + TAB_OFF + buf * 1024 + (wid & 3) * 256), 4, 0, 0);
        __builtin_amdgcn_global_load_lds((const unsigned*)(wlist + u.e * CAP + u.rt * BM + r), (LAS unsigned*)(lds + TAB_OFF + 2048 + buf * 1024 + (wid & 3) * 256), 4, 0, 0);
    }
    __device__ __forceinline__ unsigned* tile_word(const MU& u) const { return tcnt + ((u.hb >> 8) + u.rt) * 64; }
    __device__ __forceinline__ void wait_ready(const MU& u, int wid) const {
        if (wid == 0) {
            unsigned* w = tile_word(u); unsigned spins = 0;
            while ((unsigned)__builtin_amdgcn_readfirstlane(__hip_atomic_load(w, __ATOMIC_RELAXED, __HIP_MEMORY_SCOPE_AGENT)) < 32u) {
                __builtin_amdgcn_s_sleep(2);
                if ((++spins & 255u) == 0u) { if (__builtin_amdgcn_readfirstlane(__hip_atomic_load(tmo, __ATOMIC_RELAXED, __HIP_MEMORY_SCOPE_AGENT)) != 0u) break;
                    if (spins > (1u << 20)) { __hip_atomic_store(tmo, 1u, __ATOMIC_RELAXED, __HIP_MEMORY_SCOPE_AGENT); break; } } }
        }
        asm volatile("" ::: "memory"); __builtin_amdgcn_s_barrier(); asm volatile("" ::: "memory");
    }
};
struct EpiGateUpWT {
    __amdgpu_buffer_rsrc_t rsrc; LAS unsigned char* lds; LAS int* mm;
    __device__ __forceinline__ void operator()(const f32x4 (&acc)[2][2][4][2], const MU& u, int wr, int wc, int fr, int fq) const {
        const int e = u.e, n_e = mm[e], r0 = u.rt * BM + wr * 64 + fr, col0 = u.pn * HALF + wc * 32 + 8 * fq;
        float wv[2][4];
#pragma unroll
        for (int ai = 0; ai < 2; ++ai)
#pragma unroll
            for (int m = 0; m < 4; ++m) wv[ai][m] = ((const LAS float*)(lds + TAB_OFF + 2048))[u.buf * 256 + wr * 64 + fr + ai * HALF + m * 16];
#pragma unroll
        for (int ai = 0; ai < 2; ++ai)
#pragma unroll
            for (int m = 0; m < 4; ++m) { const int r = r0 + ai * HALF + m * 16;
                if (r < n_e) { const float w = wv[ai][m]; f32x4 o[2];
#pragma unroll
                    for (int n = 0; n < 2; ++n) { const f32x4 g = acc[ai][0][m][n], up = acc[ai][1][m][n];
#pragma unroll
                        for (int j = 0; j < 4; ++j) o[n][j] = w * silu_f(g[j]) * up[j]; }
                    u32x4 q; q.x = cvt_pk_bf16(o[0][0], o[0][1]); q.y = cvt_pk_bf16(o[0][2], o[0][3]); q.z = cvt_pk_bf16(o[1][0], o[1][1]); q.w = cvt_pk_bf16(o[1][2], o[1][3]);
                    __builtin_amdgcn_raw_buffer_store_b128(q, rsrc, (unsigned)(((u.hb + r) * FF + col0) * 2), 0, 16); } }
    }
};
struct EpiDownM {
    bf16* Y; LAS int* mm;
    __device__ __forceinline__ void operator()(const f32x4 (&acc)[2][2][4][2], const MU& u, int wr, int wc, int fr, int fq) const {
        const int e = u.e, n_e = mm[e], r0 = u.rt * BM + wr * 64 + fr, col0 = u.pn * BM + wc * 32 + 8 * fq;
#pragma unroll
        for (int ai = 0; ai < 2; ++ai)
#pragma unroll
            for (int m = 0; m < 4; ++m) { const int r = r0 + ai * HALF + m * 16;
                if (r < n_e) {
#pragma unroll
                    for (int bj = 0; bj < 2; ++bj) { const f32x4 v0 = acc[ai][bj][m][0], v1 = acc[ai][bj][m][1];
                        u32x4 q; q.x = cvt_pk_bf16(v0[0], v0[1]); q.y = cvt_pk_bf16(v0[2], v0[3]); q.z = cvt_pk_bf16(v1[0], v1[1]); q.w = cvt_pk_bf16(v1[2], v1[3]);
                        *(u32x4*)(Y + (size_t)(u.hb + r) * D + col0 + bj * HALF) = q; } } }
    }
};
__device__ __forceinline__ void gemm_phase_moe(LAS unsigned char* lds, const MoeMergedSched& S, const EpiGateUpWT& EA, const EpiDownM& EB) {
    const int tid = threadIdx.x, wid = __builtin_amdgcn_readfirstlane(tid >> 6), lane = tid & 63, wr = wid >> 2, wc = wid & 3, fr = lane & 15, fq = lane >> 4;
    int sR[2], sC[2]; unsigned vbA[2], vbD[2];
#pragma unroll
    for (int i = 0; i < 2; ++i) { int R, C; stage_rc(tid * 16 + i * 8192, R, C); sR[i] = R; sC[i] = C; const int Rb = (R & ~31) + perm32(R & 31);
        vbA[i] = (unsigned)(Rb * D + C) * 2u; vbD[i] = (unsigned)(Rb * FF + C) * 2u; }
    const size_t kstep = (size_t)(BK * 2);
    const unsigned ldsw = (unsigned)wid * 1024u;
    const int aoff = lds_byte(wr * 64 + fr, fq * 8), boff = lds_byte(wc * 32 + fr, fq * 8);
#define PG_SA(b, h) (((b) * 2 + (h)) * HTB)
#define PG_SB(b, h) ((4 + (b) * 2 + (h)) * HTB)
#define PG_STAGE(bufoff, gbase, voff) do { _Pragma("unroll") for (int _i = 0; _i < 2; ++_i) \
        __builtin_amdgcn_global_load_lds((const unsigned*)((const char*)(gbase) + (voff)[_i]), (LAS unsigned*)(lds + (bufoff) + ldsw + _i * 8192), 16, 0, 0); } while (0)
#define PG_LDA(dst, b, h) do { _Pragma("unroll") for (int m = 0; m < 4; ++m) _Pragma("unroll") for (int k = 0; k < 2; ++k) dst[m][k] = *(const LAS bf16x8*)(lds + PG_SA(b, h) + aoff + m * 2048 + k * 1024); } while (0)
#define PG_LDB(dst, b, h) do { _Pragma("unroll") for (int n = 0; n < 2; ++n) _Pragma("unroll") for (int k = 0; k < 2; ++k) dst[n][k] = *(const LAS bf16x8*)(lds + PG_SB(b, h) + boff + n * 2048 + k * 1024); } while (0)
#define PG_MMA(ai, bj, At, Bt) do { __builtin_amdgcn_s_setprio(1); _Pragma("unroll") for (int m = 0; m < 4; ++m) _Pragma("unroll") for (int n = 0; n < 2; ++n) _Pragma("unroll") for (int k = 0; k < 2; ++k) \
        acc[ai][bj][m][n] = __builtin_amdgcn_mfma_f32_16x16x32_bf16(Bt[n][k], At[m][k], acc[ai][bj][m][n], 0, 0, 0); __builtin_amdgcn_s_setprio(0); } while (0)
#define PG_WAIT_V(n) asm volatile("s_waitcnt vmcnt(" #n ")" ::: "memory")
#define PG_WAIT_L(n) asm volatile("s_waitcnt lgkmcnt(" #n ")" ::: "memory")
#define PG_BAR __builtin_amdgcn_s_barrier()
#define PG_SCHED __builtin_amdgcn_sched_barrier(0)
    MU cur, nxt; int ui = 0;
    if (!S.next(0, cur)) return;
    cur.buf = 0;
    f32x4 acc[2][2][4][2];
#pragma unroll
    for (int a = 0; a < 2; ++a)
#pragma unroll
        for (int b = 0; b < 2; ++b)
#pragma unroll
            for (int m = 0; m < 4; ++m)
#pragma unroll
                for (int n = 0; n < 2; ++n) acc[a][b][m][n] = (f32x4){0.f, 0.f, 0.f, 0.f};
    bf16x8 At[4][2], B0[2][2], B1[2][2];
    if (cur.type == 0) { S.stage_table(cur, 0, lds, wid, lane); PG_WAIT_V(0); PG_BAR; } else S.wait_ready(cur, wid);
    unsigned voC[2][2], voN[2][2];
#pragma unroll
    for (int h = 0; h < 2; ++h)
#pragma unroll
        for (int i = 0; i < 2; ++i) { voC[h][i] = S.voff(cur, 0, lds, h * HALF + sR[i], sC[i]); voN[h][i] = voC[h][i]; }
    const char* cB = cur.B; const char* cA = cur.A; size_t hsC = (size_t)HALF * cur.K * 2; int nt = cur.K / BK;
    if (cur.type == 0) { PG_STAGE(PG_SB(0, 0), cB, vbA); PG_STAGE(PG_SB(0, 1), cB + hsC, vbA); } else { PG_STAGE(PG_SB(0, 0), cB, vbD); PG_STAGE(PG_SB(0, 1), cB + hsC, vbD); }
    PG_STAGE(PG_SA(0, 0), cA, voC[0]); PG_STAGE(PG_SA(0, 1), cA, voC[1]);
    if (wr == 1) PG_BAR;
    PG_WAIT_V(2); PG_BAR;
    if (cur.type == 0) { PG_STAGE(PG_SB(1, 0), cB + kstep, vbA); } else { PG_STAGE(PG_SB(1, 0), cB + kstep, vbD); }
    PG_STAGE(PG_SA(1, 0), cA + kstep, voC[0]);
    if (cur.type == 0) { PG_STAGE(PG_SB(1, 1), cB + hsC + kstep, vbA); } else { PG_STAGE(PG_SB(1, 1), cB + hsC + kstep, vbD); }
    PG_WAIT_V(6); PG_BAR;
    for (;;) {
        const bool has_next = S.next(ui + 1, nxt); nxt.buf = (ui + 1) & 1;
        if (has_next && nxt.type == 0) S.stage_table(nxt, (ui + 1) & 1, lds, wid, lane);
        const char* nB = has_next ? nxt.B : cB; const char* nA = has_next ? nxt.A : cA; const size_t hsN = has_next ? (size_t)HALF * nxt.K * 2 : hsC;
        for (int t = 0; t < nt; t += 2) {
            const bool last = (t == nt - 2);
            if (last && has_next) {
                if (nxt.type == 1) S.wait_ready(nxt, wid);
#pragma unroll
                for (int h = 0; h < 2; ++h)
#pragma unroll
                    for (int i = 0; i < 2; ++i) voN[h][i] = S.voff(nxt, (ui + 1) & 1, lds, h * HALF + sR[i], sC[i]);
            }
            unsigned vo2[2][2], vb2[2]; const bool b2gu = last ? (has_next ? nxt.type == 0 : cur.type == 0) : (cur.type == 0);
#pragma unroll
            for (int h = 0; h < 2; ++h)
#pragma unroll
                for (int i = 0; i < 2; ++i) vo2[h][i] = last ? voN[h][i] : voC[h][i];
#pragma unroll
            for (int i = 0; i < 2; ++i) vb2[i] = b2gu ? vbA[i] : vbD[i];
            const size_t hs2 = last ? hsN : hsC;
            const char* a1 = cA + (size_t)(t + 1) * kstep;
            const char* a2 = last ? nA : cA + (size_t)(t + 2) * kstep; const char* b2 = last ? nB : cB + (size_t)(t + 2) * kstep;
            const char* a3 = a2 + kstep; const char* b3 = b2 + kstep;
            PG_LDB(B0, 0, 0); PG_LDB(B1, 0, 1); PG_SCHED; PG_LDA(At, 0, 0); PG_STAGE(PG_SA(1, 1), a1, voC[1]);
            PG_WAIT_V(8); PG_WAIT_L(0); PG_BAR; PG_MMA(0, 0, At, B0); PG_MMA(0, 1, At, B1); PG_BAR; PG_SCHED;
            PG_LDA(At, 0, 1); PG_STAGE(PG_SB(0, 0), b2, vb2); PG_STAGE(PG_SB(0, 1), b2 + hs2, vb2); PG_STAGE(PG_SA(0, 0), a2, vo2[0]);
            PG_WAIT_V(8); PG_WAIT_L(0); PG_BAR; PG_MMA(1, 0, At, B0); PG_MMA(1, 1, At, B1); PG_BAR; PG_SCHED;
            PG_LDB(B0, 1, 0); PG_LDB(B1, 1, 1); PG_SCHED; PG_LDA(At, 1, 0); PG_STAGE(PG_SA(0, 1), a2, vo2[1]);
            PG_WAIT_V(8); PG_WAIT_L(0); PG_BAR; PG_MMA(0, 0, At, B0); PG_MMA(0, 1, At, B1); PG_BAR; PG_SCHED;
            PG_LDA(At, 1, 1); PG_STAGE(PG_SB(1, 0), b3, vb2); PG_STAGE(PG_SB(1, 1), b3 + hs2, vb2); PG_STAGE(PG_SA(1, 0), a3, vo2[0]);
            PG_WAIT_V(8); PG_WAIT_L(0); PG_BAR; PG_MMA(1, 0, At, B0); PG_MMA(1, 1, At, B1); PG_BAR; PG_SCHED;
        }
        if (wr == 0) PG_BAR;
        if (cur.type == 0) { EA(acc, cur, wr, wc, fr, fq);
            PG_WAIT_V(0);
            if (lane == 0) __hip_atomic_fetch_add(S.tile_word(cur), 1u, __ATOMIC_RELAXED, __HIP_MEMORY_SCOPE_AGENT); }
        else EB(acc, cur, wr, wc, fr, fq);
        if (!has_next) break;
#pragma unroll
        for (int a = 0; a < 2; ++a)
#pragma unroll
            for (int b = 0; b < 2; ++b)
#pragma unroll
                for (int m = 0; m < 4; ++m)
#pragma unroll
                    for (int n = 0; n < 2; ++n) acc[a][b][m][n] = (f32x4){0.f, 0.f, 0.f, 0.f};
        cur = nxt; cB = nB; cA = nA; hsC = hsN; nt = cur.K / BK; ++ui;
#pragma unroll
        for (int h = 0; h < 2; ++h)
#pragma unroll
            for (int i = 0; i < 2; ++i) voC[h][i] = voN[h][i];
        if (wr == 1) PG_BAR;
    }
    PG_WAIT_V(0);
    PG_BAR;
#undef PG_SA
#undef PG_SB
#undef PG_STAGE
#undef PG_LDA
#undef PG_LDB
#undef PG_MMA
#undef PG_WAIT_V
#undef PG_WAIT_L
#undef PG_BAR
#undef PG_SCHED
}
}
__device__ __forceinline__ void fast_moe_merged(Frame& F, int layer) {
    LAS int* mm = moe_map(F, layer);
    int U = 0;
    for (int e = 0; e < 16; ++e) U += ((mm[e] + 255) >> 8) * 4;
    pg::MoeMergedSched S{(const char*)(F.ws + WS_WGU) + (size_t)layer * 16 * 1024 * 1024 * 2, (const char*)(F.ws + WS_WDN) + (size_t)layer * 16 * 1024 * 512 * 2,
                         (const char*)(F.ws + WS_HB), (const char*)(F.ws + WS_HID), (const int*)(F.ws + WS_SLOTT) + layer * 16 * CAP, (const float*)(F.ws + WS_SLOTW) + layer * 16 * CAP, mm,
                         F.ctl + CW_TILE + layer * 288 * 64, F.ctl + CW_TMO2, F.G, F.wg, U};
    pg::EpiGateUpWT EA{__builtin_amdgcn_make_buffer_rsrc((void*)(F.ws + WS_HID), 0, HROWS * FF * 2, 0x00020000), F.lds, mm};
    pg::EpiDownM EB{(bf16*)(F.ws + WS_Y), mm};
    pg::gemm_phase_moe(F.lds, S, EA, EB);
}

constexpr int NPH = 18;
__global__ void __launch_bounds__(NTHR, 2) mega(Args args) {
    extern __shared__ __attribute__((aligned(16))) unsigned char lds[];
    Frame F;
    F.lds = (LAS unsigned char*)lds;
    F.tid = threadIdx.x; F.lane = F.tid & 63; F.wave = __builtin_amdgcn_readfirstlane(F.tid >> 6);
    F.G = gridDim.x; F.wg = blockIdx.x;
    F.out = args.out; F.ws = args.ws; F.ctl = (unsigned*)(args.ws + WS_CTL);
    volatile LAS unsigned* bst = (volatile LAS unsigned*)(F.lds + LDS_BYTES - 16);
    if (F.tid < 4) bst[F.tid] = 0u;
    __syncthreads();
    const int lo = args.ph_lo, hi = args.ph_hi;
    XcdBarrier bar; bar.bar = F.ctl + CW_BAR; bar.x = 0; bar.st = bst;
    if (hi - lo > 1) bar = xcd_barrier_post(F.ctl + CW_BAR, bst);
#define IN(k) (lo <= (k) && (k) < hi)
#define SEAM(k) do { if (IN(k) && IN((k) + 1)) xcd_barrier(bar); } while (0)
    const float* mod = (const float*)(F.ws + WS_MOD);

#ifndef DBL_MASK
#define DBL_MASK 0x0u
#endif
#define RUN(k, body) do { if (IN(k)) { _Pragma("unroll 1") for (int _r = 0; _r < ((((DBL_MASK) >> (k)) & 1u) ? 2 : 1); ++_r) { if (_r) xcd_barrier(bar); F.lane = fresh_lane(); body; } } } while (0)
    RUN(0, phase_prep(F)); SEAM(0);
    RUN(1, phase_norm1_l0(F)); SEAM(1);
    RUN(2, if (FAST_GEMM) fast_inproj(F); else phase_inproj(F)); SEAM(2);
    if (IN(3)) { F.lane = fresh_lane();
#pragma unroll 1
        for (int _r = 0; _r < ((DBL_MASK & 0x100000u) ? 2 : 1); ++_r) { if (FAST_ATTN == 2 && FAST_GEMM) phase_attn_lds(F); else if (FAST_ATTN && FAST_GEMM) phase_attn_mfma(F); else phase_attn_simple(F); }
#pragma unroll 1
        for (int _r = 0; _r < ((DBL_MASK & 0x200000u) ? 2 : 1); ++_r) { if (FAST_FFT) phase_fft1_mfma(F); else phase_fft1_simple(F); }
    } SEAM(3);
    RUN(4, if (FAST_FFT) phase_fft2_mfma(F); else phase_fft2_simple(F)); SEAM(4);
    if (IN(5)) { if (!FAST_FFT) phase_fft3_simple(F); } if (!FAST_FFT) SEAM(5);
    RUN(6, if (FAST_GEMM) fast_outproj(F, WS_MIX, WS_WOUT, F.in[I_X], F.out, mod + 2048, nullptr); else phase_outproj(F, (const bf16*)(F.ws + WS_MIX), (const bf16*)(F.ws + WS_WOUT), F.in[I_X], F.out, mod + 2048, nullptr)); SEAM(6);
    if (IN(7)) { F.lane = fresh_lane(); if (XBF16) phase_norm2_route_mfma(F, 0); else phase_norm2_route(F, 0); } SEAM(7);
    if (MOE_MERGED && FAST_GEMM) { if (IN(8)) { F.lane = fresh_lane(); fast_moe_merged(F, 0); } if (IN(8) && IN(10)) xcd_barrier(bar); }
    else { RUN(8, if (FAST_GEMM) fast_moe_gateup(F, 0); else phase_moe_gateup(F, 0)); SEAM(8);
    RUN(9, if (FAST_GEMM) fast_moe_down(F, 0); else phase_moe_down(F, 0)); SEAM(9); }
    if (IN(10)) { F.lane = fresh_lane(); phase_combine<false>(F, 0); } SEAM(10);
    RUN(11, if (FAST_GEMM) fast_pw1(F); else phase_pw1(F)); SEAM(11);
    RUN(12, phase_dwconv_fast(F)); SEAM(12);
    if (IN(13)) { F.lane = fresh_lane(); if (FAST_GEMM) fast_outproj(F, WS_V1, WS_WPW2, F.out, F.out, mod + 5 * 6144 + 2048, F.in[I_PW2B]); else phase_outproj(F, (const bf16*)(F.ws + WS_V1), (const bf16*)(F.ws + WS_WPW2), F.out, F.out, mod + 5 * 6144 + 2048, F.in[I_PW2B]); } SEAM(13);
    if (IN(14)) { F.lane = fresh_lane(); if (XBF16) phase_norm2_route_mfma(F, 1); else phase_norm2_route(F, 1); } SEAM(14);
    if (MOE_MERGED && FAST_GEMM) { if (IN(15)) { F.lane = fresh_lane(); fast_moe_merged(F, 1); } if (IN(15) && IN(17)) xcd_barrier(bar); }
    else { RUN(15, if (FAST_GEMM) fast_moe_gateup(F, 1); else phase_moe_gateup(F, 1)); SEAM(15);
    RUN(16, if (FAST_GEMM) fast_moe_down(F, 1); else phase_moe_down(F, 1)); SEAM(16); }
    if (IN(17)) { F.lane = fresh_lane(); phase_combine<true>(F, 1); }
#undef RUN
#undef IN
#undef SEAM
}

extern "C" void kernel_launch(void* const* d_in, const int* in_sizes, int n_in, void* d_out, int out_size, void* d_ws, size_t ws_size, hipStream_t stream) {
    static int grid = 0;
    if (grid == 0) {
        if (n_in != 25 || out_size != T * D || ws_size < WS_END) { fprintf(stderr, "kernel_launch: unexpected shapes (n_in %d out %d ws %zu)\n", n_in, out_size, ws_size); grid = -1; return; }
        int dev = 0, cus = 0, per_cu = 0;
        if (hipGetDevice(&dev) != hipSuccess || hipDeviceGetAttribute(&cus, hipDeviceAttributeMultiprocessorCount, dev) != hipSuccess) { grid = -1; return; }
        if (hipFuncSetAttribute((const void*)mega, hipFuncAttributeMaxDynamicSharedMemorySize, LDS_BYTES) != hipSuccess) { fprintf(stderr, "kernel_launch: hipFuncSetAttribute failed\n"); grid = -1; return; }
        if (hipOccupancyMaxActiveBlocksPerMultiprocessor(&per_cu, (const void*)mega, NTHR, LDS_BYTES) != hipSuccess || per_cu < 1) { fprintf(stderr, "kernel_launch: occupancy query says %d\n", per_cu); }
        (void)hipGetLastError();
        grid = cus;
    }
    if (grid < 0) return;
    (void)hipMemsetAsync((char*)d_ws + WS_CTL, 0, CTL_BYTES, stream);
    Args a{};
    for (int i = 0; i < 25; ++i) a.in[i] = (const float*)d_in[i];
    a.out = (float*)d_out; a.ws = (unsigned char*)d_ws;
#if MK_ONE_LAUNCH
    a.ph_lo = 0; a.ph_hi = NPH;
    hipLaunchKernelGGL(mega, dim3(grid), dim3(NTHR), LDS_BYTES, stream, a);
#else
#ifndef PROBE_PHASE
#define PROBE_PHASE -1
#endif
    for (int p = 0; p < NPH; ++p) { a.ph_lo = p; a.ph_hi = p + 1; hipLaunchKernelGGL(mega, dim3(grid), dim3(NTHR), LDS_BYTES, stream, a);
        if (p == PROBE_PHASE) { if (p == 7 || p == 14) (void)hipMemsetAsync((char*)d_ws + WS_CTL, 0, CTL_BYTES, stream);
            hipLaunchKernelGGL(mega, dim3(grid), dim3(NTHR), LDS_BYTES, stream, a); } }
#endif
}
```

```cpp
#include <hip/hip_runtime.h>
#include <cstdio>

#ifndef MK_ONE_LAUNCH
#define MK_ONE_LAUNCH 1
#endif

#define GAS __attribute__((address_space(1)))
#define LAS __attribute__((address_space(3)))
typedef unsigned short bf16;
typedef short bf16x8 __attribute__((ext_vector_type(8)));
typedef float f32x4 __attribute__((ext_vector_type(4)));
typedef float f32x16 __attribute__((ext_vector_type(16)));
typedef unsigned u32x4 __attribute__((ext_vector_type(4)));
typedef unsigned u32x2 __attribute__((ext_vector_type(2)));

constexpr int D = 1024, NB = 4, L = 8192, T = NB * L, CL = 256, TC = NB * CL;
constexpr int NE = 16, FF = 512, CONVW = 31;
constexpr int N_IN = 1280;
constexpr int FN1 = 64, FN2 = 128;
#ifndef FAST_GEMM
#define FAST_GEMM 1
#endif
#ifndef MOE_MERGED
#define MOE_MERGED 1
#endif
#ifndef XBF16
#define XBF16 FAST_GEMM
#endif
#ifndef FAST_ATTN
#define FAST_ATTN 2
#endif
#ifndef FAST_FFT
#define FAST_FFT 1
#endif
constexpr int IL = FAST_GEMM ? 128 : 32;
constexpr float EPS = 1e-6f;
constexpr int NWAVES = 8, NTHR = 512;
constexpr int CAP = 32768;
constexpr int HROWS = 65536 + 4096;

constexpr size_t MiB = 1u << 20;
constexpr size_t WS_CTL = 0, CTL_BYTES = 1 * MiB;
constexpr size_t WS_MOD = 1 * MiB;
constexpr size_t WS_TW = 1 * MiB + 512 * 1024;
constexpr size_t WS_WIN = 2 * MiB, WS_WOUT = 6 * MiB, WS_WPW1 = 10 * MiB, WS_WPW2 = 14 * MiB;
constexpr size_t WS_WGU = 16 * MiB, WS_WDN = 80 * MiB;
constexpr size_t WS_TOKE = 112 * MiB, WS_TOKP = 113 * MiB, WS_TOKW = 114 * MiB;
constexpr size_t WS_SLOTT = 116 * MiB, WS_SLOTW = 120 * MiB;
constexpr size_t WS_HB = 128 * MiB;
constexpr size_t WS_UF = 196 * MiB, WS_Q = 228 * MiB, WS_K = 260 * MiB, WS_V = 268 * MiB, WS_CK = 276 * MiB, WS_CV = 277 * MiB;
constexpr size_t WS_G = 280 * MiB, WS_MIX = 344 * MiB, WS_AB = 408 * MiB;
constexpr size_t WS_XB = 408 * MiB;
constexpr size_t WS_HID = 196 * MiB, WS_Y = 264 * MiB;
constexpr size_t WS_U = 196 * MiB, WS_V1 = 260 * MiB;
constexpr size_t WS_END = 472 * MiB;
constexpr int CW_BAR = 4096;
constexpr int CW_CNT = 8192;
constexpr int CW_TILE = 16384;
constexpr int CW_TMO2 = 2048;

constexpr int LDS_BYTES = 147456;

__device__ __forceinline__ unsigned f2bf(float f) { unsigned u = __float_as_uint(f); return (u + 0x7fffu + ((u >> 16) & 1u)) >> 16; }
__device__ __forceinline__ float bf2f(unsigned b) { return __uint_as_float(b << 16); }
typedef __bf16 b16x2_t __attribute__((ext_vector_type(2)));
__device__ __forceinline__ unsigned pkbf(float a, float b) { typedef float f2 __attribute__((ext_vector_type(2))); f2 v = {a, b}; return __builtin_bit_cast(unsigned, __builtin_convertvector(v, b16x2_t)); }
__device__ __forceinline__ unsigned pk2(float lo, float hi) { return pkbf(lo, hi); }
__device__ __forceinline__ float bflo(unsigned w) { return __uint_as_float(w << 16); }
__device__ __forceinline__ float bfhi(unsigned w) { return __uint_as_float(w & 0xffff0000u); }
__device__ __forceinline__ float wave_sum(float v) {
    v += __builtin_bit_cast(float, __builtin_amdgcn_mov_dpp(__builtin_bit_cast(int, v), 0xB1, 0xf, 0xf, true));
    v += __builtin_bit_cast(float, __builtin_amdgcn_mov_dpp(__builtin_bit_cast(int, v), 0x4E, 0xf, 0xf, true));
    v += __builtin_bit_cast(float, __builtin_amdgcn_mov_dpp(__builtin_bit_cast(int, v), 0x141, 0xf, 0xf, true));
    v += __builtin_bit_cast(float, __builtin_amdgcn_mov_dpp(__builtin_bit_cast(int, v), 0x140, 0xf, 0xf, true));
    const int iv = __builtin_bit_cast(int, v);
    const float a = __builtin_bit_cast(float, __builtin_amdgcn_readlane(iv, 15)), b = __builtin_bit_cast(float, __builtin_amdgcn_readlane(iv, 31));
    const float c = __builtin_bit_cast(float, __builtin_amdgcn_readlane(iv, 47)), d = __builtin_bit_cast(float, __builtin_amdgcn_readlane(iv, 63));
    return (a + b) + (c + d);
}
__device__ __forceinline__ float silu_f(float x) { return x * __builtin_amdgcn_rcpf(1.f + __expf(-x)); }
__device__ __forceinline__ float sigmoid_f(float x) { return __builtin_amdgcn_rcpf(1.f + __expf(-x)); }
constexpr float YSCALE = 32.f;
__device__ __forceinline__ unsigned pk_fp8x4(f32x4 v) {
    int d = __builtin_amdgcn_cvt_pk_fp8_f32(__builtin_amdgcn_fmed3f(v[0] * YSCALE, -448.f, 448.f), __builtin_amdgcn_fmed3f(v[1] * YSCALE, -448.f, 448.f), 0, false);
    d = __builtin_amdgcn_cvt_pk_fp8_f32(__builtin_amdgcn_fmed3f(v[2] * YSCALE, -448.f, 448.f), __builtin_amdgcn_fmed3f(v[3] * YSCALE, -448.f, 448.f), d, true);
    return (unsigned)d;
}
__device__ __forceinline__ f32x4 un_fp8x4(unsigned d) { typedef float f2 __attribute__((ext_vector_type(2)));
    const f2 lo = __builtin_amdgcn_cvt_pk_f32_fp8((int)d, false), hi = __builtin_amdgcn_cvt_pk_f32_fp8((int)d, true); return (f32x4){lo.x, lo.y, hi.x, hi.y}; }
#define LDS_WAIT() asm volatile("s_waitcnt lgkmcnt(0)" ::: "memory")
__device__ __forceinline__ int fresh_lane() { int l; asm volatile("v_mbcnt_lo_u32_b32 %0, -1, 0\n\tv_mbcnt_hi_u32_b32 %0, -1, %0" : "=v"(l)); return l; }

#define XB_TMO      128
#define XB_XCNT(j)  (256  + 64 * (j))
#define XB_XSUB(j)  (1280 + 64 * (j))
#define XB_XGEN(j)  (2304 + 64 * (j))
#define XB_TOP      3328
#define XB_TOPGEN   3392
#define XCD_BAR_WORDS 3456
#define XB_SPIN_CAP (1u << 20)
__device__ __forceinline__ unsigned xb_ld(unsigned* p)              { return __hip_atomic_load(p, __ATOMIC_RELAXED, __HIP_MEMORY_SCOPE_AGENT); }
__device__ __forceinline__ unsigned xb_add(unsigned* p, unsigned v) { return __hip_atomic_fetch_add(p, v, __ATOMIC_RELAXED, __HIP_MEMORY_SCOPE_AGENT); }
__device__ __forceinline__ unsigned xb_xcc_id() { return (unsigned)__builtin_amdgcn_s_getreg((3 << 11) | 20) & 0xFu; }
#define XB_SPIN(cond, bar) do { unsigned _sp = 0; while (cond) { __builtin_amdgcn_s_sleep(1); \
    if ((++_sp & 255u) == 0u) { if (xb_ld(&(bar)[XB_TMO])) break; if (_sp > XB_SPIN_CAP) { atomicAdd(&(bar)[XB_TMO], 1u); break; } } } } while (0)
struct XcdBarrier { unsigned* bar; unsigned x; volatile LAS unsigned* st; };
__device__ __forceinline__ XcdBarrier xcd_barrier_post(unsigned* bar, volatile LAS unsigned* st) {
    XcdBarrier b; b.bar = bar; b.x = xb_xcc_id(); b.st = st;
    if (threadIdx.x == 0) (void)xb_add(&bar[XB_XCNT(b.x)], 1u);
    return b;
}
__device__ __forceinline__ void xcd_barrier_complete(unsigned* bar, unsigned x, unsigned& nloc, unsigned& nx) {
    const unsigned G = gridDim.x * gridDim.y * gridDim.z;
    unsigned sum, cnt, mine, sp = 0u;
    for (;;) {
        sum = 0u; cnt = 0u; mine = 0u;
#pragma unroll
        for (unsigned j = 0; j < 16; ++j) { const unsigned c = xb_ld(&bar[XB_XCNT(j)]); sum += c; cnt += (c > 0u) ? 1u : 0u; mine = (j == x) ? c : mine; }
        if (sum == G) break;
        __builtin_amdgcn_s_sleep(1);
        if ((++sp & 255u) == 0u) { if (xb_ld(&bar[XB_TMO])) break; if (sp > XB_SPIN_CAP) { atomicAdd(&bar[XB_TMO], 1u); break; } }
    }
    nloc = mine > 0u ? mine : 1u; nx = cnt > 0u ? cnt : 1u;
}
__device__ __forceinline__ void xcd_barrier(const XcdBarrier& b) {
    asm volatile("s_waitcnt vmcnt(0)" ::: "memory");
    __syncthreads();
    if (threadIdx.x == 0) {
        unsigned* bar = b.bar;
        __builtin_amdgcn_s_waitcnt(0);
        unsigned nloc = b.st[0], nx = b.st[1];
        if (nloc == 0u) { xcd_barrier_complete(bar, b.x, nloc, nx); b.st[0] = nloc; b.st[1] = nx; }
        const unsigned old = xb_add(&bar[XB_XSUB(b.x)], 1u);
        const unsigned gen = old / nloc;
        if (old + 1u == (gen + 1u) * nloc) {
            __builtin_amdgcn_fence(__ATOMIC_RELEASE, "agent");
            asm volatile("s_waitcnt vmcnt(0)" ::: "memory");
            const unsigned og = xb_add(&bar[XB_TOP], 1u);
            const unsigned tg = og / nx;
            if (og + 1u == (tg + 1u) * nx) xb_add(&bar[XB_TOPGEN], 1u);
            else XB_SPIN(xb_ld(&bar[XB_TOPGEN]) == tg, bar);
            __builtin_amdgcn_fence(__ATOMIC_ACQUIRE, "agent");
            xb_add(&bar[XB_XGEN(b.x)], 1u);
            asm volatile("s_waitcnt vmcnt(0)" ::: "memory");
        } else {
            XB_SPIN(xb_ld(&bar[XB_XGEN(b.x)]) == gen, bar);
            __builtin_amdgcn_fence(__ATOMIC_ACQUIRE, "agent");
            asm volatile("s_waitcnt vmcnt(0)" ::: "memory");
        }
    }
    __syncthreads();
}

struct Args { const float* in[25]; float* out; unsigned char* ws; int ph_lo, ph_hi; };
enum { I_X = 0, I_C, I_CTX, I_CCTX, I_ADAW, I_ADAB, I_NMG, I_NFG, I_WIN, I_WOUT, I_SINK, I_PW1W, I_PW1B, I_DWW, I_DWB, I_LNG, I_LNB,
       I_PW2W, I_PW2B, I_RW, I_RB, I_WG, I_WU, I_WD, I_FNG };

struct InPtrs {
    __device__ __forceinline__ const float* operator[](int i) const { const float* r;
        asm volatile("s_load_dwordx2 %0, %1, %2\n\ts_waitcnt lgkmcnt(0)" : "=s"(r) : "s"(__builtin_amdgcn_kernarg_segment_ptr()), "s"(i * 8)); return r; }
};
struct Frame {
    LAS unsigned char* lds;
    int tid, lane, wave, G, wg;
    InPtrs in;
    float* out;
    unsigned char* ws;
    unsigned* ctl;
};

__device__ __forceinline__ int crow(int i, int h) { return (i & 3) + 8 * (i >> 2) + 4 * h; }
template <class RowPtr, class Epi>
__device__ __forceinline__ void sgemm_tile(const RowPtr& rowptr, const bf16* Bt, int K, int m0, int n0, const Epi& epi, int wave, int lane) {
    const int wm = wave & 3, wn = wave >> 2, r = lane & 31, h = lane >> 5;
    const bf16* ap = rowptr(m0 + wm * 32 + r) + 8 * h;
    const bf16* bp0 = Bt + (size_t)(n0 + wn * 64 + r) * K + 8 * h;
    const bf16* bp1 = bp0 + (size_t)32 * K;
    f32x16 c0, c1;
#pragma unroll
    for (int i = 0; i < 16; ++i) { c0[i] = 0.f; c1[i] = 0.f; }
#pragma unroll 2
    for (int k = 0; k < K; k += 32) {
        const bf16x8 a0 = *(const bf16x8*)(ap + k), a1 = *(const bf16x8*)(ap + k + 16);
        const bf16x8 b00 = *(const bf16x8*)(bp0 + k), b01 = *(const bf16x8*)(bp0 + k + 16);
        const bf16x8 b10 = *(const bf16x8*)(bp1 + k), b11 = *(const bf16x8*)(bp1 + k + 16);
        c0 = __builtin_amdgcn_mfma_f32_32x32x16_bf16(a0, b00, c0, 0, 0, 0);
        c1 = __builtin_amdgcn_mfma_f32_32x32x16_bf16(a0, b10, c1, 0, 0, 0);
        c0 = __builtin_amdgcn_mfma_f32_32x32x16_bf16(a1, b01, c0, 0, 0, 0);
        c1 = __builtin_amdgcn_mfma_f32_32x32x16_bf16(a1, b11, c1, 0, 0, 0);
    }
    epi(m0 + wm * 32, n0 + wn * 64, c0, c1, lane);
}

__device__ __forceinline__ void p0_transpose_item(const float* W, int K, int N, bf16* WT, int k0, int n0, int drow0, LAS float* scr, int lane) {
#pragma unroll 8
    for (int i = 0; i < 32; ++i) { const int kk = 2 * i + (lane >> 5); scr[kk * 33 + (lane & 31)] = W[(size_t)(k0 + kk) * N + n0 + (lane & 31)]; }
    LDS_WAIT(); asm volatile("" ::: "memory");
    const int c = lane & 7;
#pragma unroll
    for (int j = 0; j < 4; ++j) { const int n = (lane >> 3) + 8 * j; const LAS float* s = scr + (8 * c) * 33 + n;
        u32x4 o; o.x = pk2(s[0 * 33], s[1 * 33]); o.y = pk2(s[2 * 33], s[3 * 33]); o.z = pk2(s[4 * 33], s[5 * 33]); o.w = pk2(s[6 * 33], s[7 * 33]);
        *(u32x4*)(WT + (size_t)(drow0 + n) * K + k0 + 8 * c) = o; }
    LDS_WAIT(); asm volatile("" ::: "memory");
}
__device__ __forceinline__ int il_row(int j, int half) { return (j / IL) * (2 * IL) + half * IL + (j % IL); }

struct TItem { const float* W; bf16* WT; int K, N, k0, n0, drow0; bool ok; };
__device__ __forceinline__ TItem t_decode(const Frame& F, int it) {
    constexpr int S0 = 640, S1 = 512, S2 = 1024, S3 = 512, SM = 32 * 256;
    TItem t; t.ok = it < S0 + S1 + S2 + S3 + 3 * SM; t.W = F.in[I_WIN]; t.WT = (bf16*)(F.ws + WS_WIN); t.K = 1024; t.N = 1280; t.k0 = 0; t.n0 = 0; t.drow0 = 0;
    int r = it;
    if (r < S0) { const int kb = r / 40, nb = r % 40; t.k0 = kb * 64; t.n0 = nb * 32; t.drow0 = nb * 32; return t; } r -= S0;
    if (r < S1) { const int kb = r / 32, nb = r % 32; t.W = F.in[I_WOUT]; t.WT = (bf16*)(F.ws + WS_WOUT); t.N = 1024; t.k0 = kb * 64; t.n0 = nb * 32; t.drow0 = nb * 32; return t; } r -= S1;
    if (r < S2) { const int kb = r / 64, nb = r % 64, n0 = nb * 32; t.W = F.in[I_PW1W]; t.WT = (bf16*)(F.ws + WS_WPW1); t.N = 2048; t.k0 = kb * 64; t.n0 = n0; t.drow0 = il_row(n0 & 1023, n0 >> 10); return t; } r -= S2;
    if (r < S3) { const int kb = r / 32, nb = r % 32; t.W = F.in[I_PW2W]; t.WT = (bf16*)(F.ws + WS_WPW2); t.N = 1024; t.k0 = kb * 64; t.n0 = nb * 32; t.drow0 = nb * 32; return t; } r -= S3;
    if (r < SM) { const int le = r >> 8, q = r & 255, kb = q / 16, nb = q % 16; t.W = F.in[I_WG] + (size_t)le * 1024 * 512; t.WT = (bf16*)(F.ws + WS_WGU) + (size_t)le * 1024 * 1024; t.N = 512; t.k0 = kb * 64; t.n0 = nb * 32; t.drow0 = il_row(nb * 32, 0); return t; } r -= SM;
    if (r < SM) { const int le = r >> 8, q = r & 255, kb = q / 16, nb = q % 16; t.W = F.in[I_WU] + (size_t)le * 1024 * 512; t.WT = (bf16*)(F.ws + WS_WGU) + (size_t)le * 1024 * 1024; t.N = 512; t.k0 = kb * 64; t.n0 = nb * 32; t.drow0 = il_row(nb * 32, 1); return t; } r -= SM;
    { const int le = (r >> 8) & 31, q = r & 255, kb = q / 32, nb = q % 32; t.W = F.in[I_WD] + (size_t)le * 512 * 1024; t.WT = (bf16*)(F.ws + WS_WDN) + (size_t)le * 1024 * 512; t.K = 512; t.N = 1024; t.k0 = kb * 64; t.n0 = nb * 32; t.drow0 = nb * 32; }
    return t;
}
__device__ __forceinline__ void t_load(const TItem& t, int lane, float (&v)[32]) {
    if (t.ok) {
#pragma unroll
        for (int i = 0; i < 32; ++i) v[i] = t.W[(size_t)(t.k0 + 2 * i + (lane >> 5)) * t.N + t.n0 + (lane & 31)];
    }
}
__device__ __forceinline__ void t_store(const TItem& t, LAS float* scr, int lane, const float (&v)[32]) {
#pragma unroll
    for (int i = 0; i < 32; ++i) scr[(2 * i + (lane >> 5)) * 33 + (lane & 31)] = v[i];
    LDS_WAIT(); asm volatile("" ::: "memory");
    const int c = lane & 7;
#pragma unroll
    for (int j = 0; j < 4; ++j) { const int n = (lane >> 3) + 8 * j; const LAS float* s = scr + (8 * c) * 33 + n;
        u32x4 o; o.x = pk2(s[0 * 33], s[1 * 33]); o.y = pk2(s[2 * 33], s[3 * 33]); o.z = pk2(s[4 * 33], s[5 * 33]); o.w = pk2(s[6 * 33], s[7 * 33]);
        *(u32x4*)(t.WT + (size_t)(t.drow0 + n) * t.K + t.k0 + 8 * c) = o; }
    LDS_WAIT(); asm volatile("" ::: "memory");
}
__device__ __forceinline__ void phase_prep(Frame& F) {
    {
        LAS float* sc = (LAS float*)F.lds;
        LAS float* red = sc + 5 * 1024;
        bool loaded = false;
        for (int it = F.wg; it < 192; it += F.G) {
            if (!loaded) {
                for (int i = F.tid; i < 5 * 1024; i += NTHR) { const int b = i >> 10, k = i & 1023; const float v = b < 4 ? F.in[I_C][b * 1024 + k] : F.in[I_CCTX][k]; sc[i] = silu_f(v); }
                __syncthreads(); loaded = true;
            }
            const int l = it / 96, n0 = (it % 96) * 64, c4 = F.tid & 15, kg = F.tid >> 4;
            const float* w = F.in[I_ADAW] + (size_t)l * 1024 * 6144 + n0 + 4 * c4;
            f32x4 a[5];
#pragma unroll
            for (int b = 0; b < 5; ++b) a[b] = (f32x4){0.f, 0.f, 0.f, 0.f};
#pragma unroll 16
            for (int kk = 0; kk < 32; ++kk) { const int k = kg * 32 + kk; const f32x4 wv = *(const f32x4*)(w + (size_t)k * 6144);
#pragma unroll
                for (int b = 0; b < 5; ++b) a[b] += sc[b * 1024 + k] * wv; }
#pragma unroll
            for (int b = 0; b < 5; ++b) *(LAS f32x4*)(red + (kg * 5 + b) * 64 + 4 * c4) = a[b];
            __syncthreads();
            if (F.tid < 320) { const int b = F.tid >> 6, c2 = F.tid & 63; float sm = 0.f;
#pragma unroll
                for (int g = 0; g < 32; ++g) sm += red[(g * 5 + b) * 64 + c2];
                ((float*)(F.ws + WS_MOD))[((size_t)l * 5 + b) * 6144 + n0 + c2] = sm + F.in[I_ADAB][l * 6144 + n0 + c2]; }
            __syncthreads();
        }
        __syncthreads();
    }
    { u32x4* z = (u32x4*)(F.ws + WS_SLOTT); const u32x4 zero = {0u, 0u, 0u, 0u};
      for (int i = F.wg * NTHR + F.tid; i < 2 * 16 * CAP / 4; i += F.G * NTHR) z[i] = zero; }
    { float* tw = (float*)(F.ws + WS_TW);
      for (int k = F.wg * NTHR + F.tid; k < 8192; k += F.G * NTHR) { const float a = (float)k * (6.283185307179586f / 8192.f); tw[2 * k] = __cosf(a); tw[2 * k + 1] = __sinf(a); } }
    {
        LAS float* scr = (LAS float*)(F.lds + F.wave * 8704);
        const int gw = F.wg * NWAVES + F.wave, NGW = F.G * NWAVES;
        TItem cur = t_decode(F, gw); float va[32], vb[32];
        t_load(cur, F.lane, va);
#pragma unroll 1
        for (int it = gw; cur.ok; it += NGW) {
            const TItem nxt = t_decode(F, it + NGW);
            t_load(nxt, F.lane, vb);
            t_store(cur, scr, F.lane, va);
#pragma unroll
            for (int i = 0; i < 32; ++i) va[i] = vb[i];
            cur = nxt;
        }
    }
}

#define ROFF(lane, j) (512 * ((j) >> 1) + 8 * (lane) + 4 * ((j) & 1))
__device__ __forceinline__ void row_load(const float* p, int lane, f32x4 (&v)[4]) {
#pragma unroll
    for (int j = 0; j < 4; ++j) v[j] = *(const f32x4*)(p + ROFF(lane, j));
}
__device__ __forceinline__ void row_load_bf(const bf16* p, int lane, f32x4 (&v)[4]) {
#pragma unroll
    for (int jj = 0; jj < 2; ++jj) { const u32x4 w = *(const u32x4*)(p + 512 * jj + 8 * lane); v[2 * jj] = (f32x4){bflo(w.x), bfhi(w.x), bflo(w.y), bfhi(w.y)}; v[2 * jj + 1] = (f32x4){bflo(w.z), bfhi(w.z), bflo(w.w), bfhi(w.w)}; }
}
__device__ __forceinline__ void xrow_load(const float* xf, const bf16* xb, size_t row, int lane, f32x4 (&v)[4]) { if (XBF16) row_load_bf(xb + row * D, lane, v); else row_load(xf + row * D, lane, v); }
__device__ __forceinline__ float row_sumsq(const f32x4 (&v)[4]) {
    float s = 0.f;
#pragma unroll
    for (int j = 0; j < 4; ++j) s += (v[j].x * v[j].x + v[j].y * v[j].y) + (v[j].z * v[j].z + v[j].w * v[j].w);
    return wave_sum(s);
}
__device__ __forceinline__ void row_modulate(f32x4 (&v)[4], float rstd, const float* g, const float* sh, const float* sc, int lane) {
#pragma unroll
    for (int j = 0; j < 4; ++j) { const int o = ROFF(lane, j); const f32x4 gg = *(const f32x4*)(g + o), s1 = *(const f32x4*)(sc + o), s0 = *(const f32x4*)(sh + o);
        v[j] = v[j] * rstd * gg * (1.f + s1) + s0; }
}
__device__ __forceinline__ void row_store_bf16(bf16* dst, const f32x4 (&v)[4], int lane) {
#pragma unroll
    for (int jj = 0; jj < 2; ++jj) { u32x4 w; w.x = pk2(v[2 * jj].x, v[2 * jj].y); w.y = pk2(v[2 * jj].z, v[2 * jj].w); w.z = pk2(v[2 * jj + 1].x, v[2 * jj + 1].y); w.w = pk2(v[2 * jj + 1].z, v[2 * jj + 1].w); *(u32x4*)(dst + 512 * jj + 8 * lane) = w; }
}

__device__ __forceinline__ void phase_norm1_l0(Frame& F) {
    const int gw = F.wg * NWAVES + F.wave, NGW = F.G * NWAVES;
    const float* mod = (const float*)(F.ws + WS_MOD);
    bf16* HB = (bf16*)(F.ws + WS_HB);
    for (int row = gw; row < T + TC; row += NGW) {
        const float* src = row < T ? F.in[I_X] + (size_t)row * D : F.in[I_CTX] + (size_t)(row - T) * D;
        const int b = row < T ? (row >> 13) : 4;
        f32x4 v[4]; row_load(src, F.lane, v);
        const float rstd = rsqrtf(row_sumsq(v) * (1.f / D) + EPS);
        const float* m = mod + (size_t)b * 6144;
        row_modulate(v, rstd, F.in[I_NMG], m, m + 1024, F.lane);
        row_store_bf16(HB + (size_t)row * D, v, F.lane);
    }
}

struct RowLin { const bf16* base; size_t pitch; __device__ __forceinline__ const bf16* operator()(int m) const { return base + (size_t)m * pitch; } };

__device__ __forceinline__ void inproj_block(Frame& F, int mb, int nbk, const f32x16& c, int lane) {
    const int h = lane >> 5, cl = lane & 31;
    bf16* dst; int pitch, cbase; bool rope = false; bool isctx = (mb >= T);
    if (nbk < 512) { dst = (bf16*)(F.ws + WS_UF); pitch = 512; cbase = 0; }
    else if (nbk < 1024) { dst = (bf16*)(F.ws + WS_Q); pitch = 512; cbase = 512; rope = true; }
    else if (nbk < 1152) { dst = isctx ? (bf16*)(F.ws + WS_CK) : (bf16*)(F.ws + WS_K); pitch = 128; cbase = 1024; rope = !isctx; }
    else { dst = isctx ? (bf16*)(F.ws + WS_CV) : (bf16*)(F.ws + WS_V); pitch = 128; cbase = 1152; }
    const int rbase = isctx ? mb - T : mb;
    const int col = nbk - cbase + cl;
    const float inv = exp2f(-(float)(cl & 15) * (13.287712379549449f / 16.f));
    const bool second = (cl & 16) != 0; const bool bycol = ((nbk >> 5) & 1) != 0;
#pragma unroll
    for (int i = 0; i < 16; ++i) {
        const int rr = crow(i, h); float v = c[i];
        if (rope) {
            const float partner = __shfl_xor(v, 16);
            const int l = (mb + rr) & (L - 1);
            const float pos = (float)(bycol ? (l & 63) : (l >> 6));
            const float ang = pos * inv, cs = __cosf(ang), sn = __sinf(ang);
            v = second ? (partner * sn + v * cs) : (v * cs - partner * sn);
        }
        dst[(size_t)(rbase + rr) * pitch + col] = (bf16)f2bf(v);
    }
}
__device__ __forceinline__ void phase_inproj(Frame& F) {
    const bf16* HB = (const bf16*)(F.ws + WS_HB); const bf16* Wt = (const bf16*)(F.ws + WS_WIN);
    constexpr int MT = (T + TC) / 128, NT = N_IN / 128;
    RowLin rp{HB, (size_t)D};
    for (int u = F.wg; u < MT * NT; u += F.G) {
        const int mt = u / NT, nt = u % NT;
        if (mt >= T / 128 && nt < 8) continue;
        auto epi = [&](int mb, int nb, const f32x16& c0, const f32x16& c1, int lane) { inproj_block(F, mb, nb, c0, lane); inproj_block(F, mb, nb + 32, c1, lane); };
        sgemm_tile(rp, Wt, D, mt * 128, nt * 128, epi, F.wave, F.lane);
    }
}

__device__ __forceinline__ void attn_key(const bf16* kp, const bf16* vp, const float (&q)[64], float& m, float& s, float (&o)[64]) {
    float dot = 0.f;
#pragma unroll
    for (int j = 0; j < 8; ++j) { const u32x4 w = *(const u32x4*)(kp + 8 * j);
        dot += q[8 * j + 0] * bflo(w.x) + q[8 * j + 1] * bfhi(w.x) + q[8 * j + 2] * bflo(w.y) + q[8 * j + 3] * bfhi(w.y)
             + q[8 * j + 4] * bflo(w.z) + q[8 * j + 5] * bfhi(w.z) + q[8 * j + 6] * bflo(w.w) + q[8 * j + 7] * bfhi(w.w); }
    const float mn = fmaxf(m, dot), alpha = __expf(m - mn), p = __expf(dot - mn);
    s = s * alpha + p; m = mn;
#pragma unroll
    for (int j = 0; j < 8; ++j) { const u32x4 w = *(const u32x4*)(vp + 8 * j);
        o[8 * j + 0] = o[8 * j + 0] * alpha + p * bflo(w.x); o[8 * j + 1] = o[8 * j + 1] * alpha + p * bfhi(w.x);
        o[8 * j + 2] = o[8 * j + 2] * alpha + p * bflo(w.y); o[8 * j + 3] = o[8 * j + 3] * alpha + p * bfhi(w.y);
        o[8 * j + 4] = o[8 * j + 4] * alpha + p * bflo(w.z); o[8 * j + 5] = o[8 * j + 5] * alpha + p * bfhi(w.z);
        o[8 * j + 6] = o[8 * j + 6] * alpha + p * bflo(w.w); o[8 * j + 7] = o[8 * j + 7] * alpha + p * bfhi(w.w); }
}
__device__ __forceinline__ void phase_attn_simple(Frame& F) {
    const bf16* Q = (const bf16*)(F.ws + WS_Q); const bf16* Kb = (const bf16*)(F.ws + WS_K); const bf16* Vb = (const bf16*)(F.ws + WS_V);
    const bf16* CK = (const bf16*)(F.ws + WS_CK); const bf16* CV = (const bf16*)(F.ws + WS_CV); bf16* MIX = (bf16*)(F.ws + WS_MIX);
    for (int idx = F.wg * NTHR + F.tid; idx < T * 8; idx += F.G * NTHR) {
        const int hd = idx / T, t = idx % T, b = t >> 13, l = t & (L - 1), kvh = hd >> 2;
        float q[64], o[64];
#pragma unroll
        for (int j = 0; j < 8; ++j) { const u32x4 w = *(const u32x4*)(Q + (size_t)t * 512 + hd * 64 + 8 * j);
            q[8 * j + 0] = bflo(w.x) * 0.125f; q[8 * j + 1] = bfhi(w.x) * 0.125f; q[8 * j + 2] = bflo(w.y) * 0.125f; q[8 * j + 3] = bfhi(w.y) * 0.125f;
            q[8 * j + 4] = bflo(w.z) * 0.125f; q[8 * j + 5] = bfhi(w.z) * 0.125f; q[8 * j + 6] = bflo(w.w) * 0.125f; q[8 * j + 7] = bfhi(w.w) * 0.125f; }
#pragma unroll
        for (int j = 0; j < 64; ++j) o[j] = 0.f;
        float m = F.in[I_SINK][hd], s = 1.f;
        for (int c = 0; c < CL; ++c) { const size_t r = (size_t)(b * CL + c) * 128 + kvh * 64; attn_key(CK + r, CV + r, q, m, s, o); }
        const int lo = l - 128 < 0 ? 0 : l - 128, hi = l + 128 > L - 1 ? L - 1 : l + 128;
        for (int kp = lo; kp <= hi; ++kp) { const size_t r = (size_t)(b * L + kp) * 128 + kvh * 64; attn_key(Kb + r, Vb + r, q, m, s, o); }
        const float is = 1.f / s;
#pragma unroll
        for (int j = 0; j < 8; ++j) { u32x4 w; w.x = pk2(o[8 * j] * is, o[8 * j + 1] * is); w.y = pk2(o[8 * j + 2] * is, o[8 * j + 3] * is); w.z = pk2(o[8 * j + 4] * is, o[8 * j + 5] * is); w.w = pk2(o[8 * j + 6] * is, o[8 * j + 7] * is);
            *(u32x4*)(MIX + (size_t)t * 1024 + 512 + hd * 64 + 8 * j) = w; }
    }
}

__device__ __forceinline__ void phase_fft1_simple(Frame& F) {
    const bf16* UF = (const bf16*)(F.ws + WS_UF); bf16* Gb = (bf16*)(F.ws + WS_G); const float* tw = (const float*)(F.ws + WS_TW);
    for (int idx = F.wg * NTHR + F.tid; idx < NB * FN1 * FN2 * 512; idx += F.G * NTHR) {
        const int ch = idx & 511, bp = (idx >> 9) & 127, c = (idx >> 16) & 63, b = idx >> 22;
        float re = 0.f, im = 0.f;
        for (int a = 0; a < FN1; ++a) { const float u = bf2f(UF[(size_t)(b * L + 128 * a + bp) * 512 + ch]); const int k = ((a * c) & 63) * 128;
            re += u * tw[2 * k]; im -= u * tw[2 * k + 1]; }
        const int k2 = bp * c; const float cs = tw[2 * k2], sn = tw[2 * k2 + 1];
        const float gr = re * cs + im * sn, gi = im * cs - re * sn;
        const size_t row = (size_t)(b * FN1 + c) * FN2 + bp;
        Gb[row * 1024 + ch] = (bf16)f2bf(gr); Gb[row * 1024 + 512 + ch] = (bf16)f2bf(gi);
    }
}
__device__ __forceinline__ void phase_fft2_simple(Frame& F) {
    const bf16* Gb = (const bf16*)(F.ws + WS_G); bf16* AB = (bf16*)(F.ws + WS_AB); const float* tw = (const float*)(F.ws + WS_TW);
    for (int idx = F.wg * NTHR + F.tid; idx < NB * FN1 * FN2 * 512; idx += F.G * NTHR) {
        const int ch = idx & 511, d = (idx >> 9) & 127, c = (idx >> 16) & 63, b = idx >> 22;
        float fr = 0.f, fi = 0.f;
        for (int bp = 0; bp < FN2; ++bp) { const size_t row = (size_t)(b * FN1 + c) * FN2 + bp; const float gr = bf2f(Gb[row * 1024 + ch]), gi = bf2f(Gb[row * 1024 + 512 + ch]);
            const int k = ((bp * d) & 127) * 64; const float cs = tw[2 * k], sn = tw[2 * k + 1];
            fr += gr * cs + gi * sn; fi += gi * cs - gr * sn; }
        const size_t t = (size_t)b * L + c + 64 * d;
        AB[t * 1024 + ch] = (bf16)f2bf(fr); AB[t * 1024 + 512 + ch] = (bf16)f2bf(-fi);
    }
}
__device__ __forceinline__ void phase_fft3_simple(Frame& F) {
    const bf16* AB = (const bf16*)(F.ws + WS_AB); bf16* MIX = (bf16*)(F.ws + WS_MIX); const float* tw = (const float*)(F.ws + WS_TW);
    LAS float* t128 = (LAS float*)F.lds;
    for (int i = F.tid; i < 128; i += NTHR) { t128[2 * i] = tw[2 * (i * 64)]; t128[2 * i + 1] = tw[2 * (i * 64) + 1]; }
    __syncthreads();
    for (int idx = F.wg * NTHR + F.tid; idx < T * 512; idx += F.G * NTHR) {
        const int cp = idx & 127, g = (idx >> 7) & 3, t = idx >> 9;
        const bf16* arow = AB + (size_t)t * 1024 + g * 128;
        float y = 0.f;
        for (int cc = 0; cc < 128; ++cc) { const int k = (cc * cp) & 127; y += bf2f(arow[cc]) * t128[2 * k] - bf2f(arow[512 + cc]) * t128[2 * k + 1]; }
        MIX[(size_t)t * 1024 + g * 128 + cp] = (bf16)f2bf(y * (1.f / 1024.f));
    }
    __syncthreads();
}

__device__ __forceinline__ void phase_outproj(Frame& F, const bf16* A, const bf16* Wt, const float* base, float* X, const float* gate  , const float* bias) {
    RowLin rp{A, (size_t)D};
    for (int u = F.wg; u < (T / 128) * 8; u += F.G) {
        const int mt = u / 8, nt = u % 8;
        auto epi = [&](int mb, int nb, const f32x16& c0, const f32x16& c1, int lane) {
            const int h = lane >> 5, cl = lane & 31, b = mb >> 13;
#pragma unroll
            for (int half = 0; half < 2; ++half) { const int col = nb + 32 * half + cl; const float gv = gate[(size_t)b * 6144 + col], bv = bias ? bias[col] : 0.f;
#pragma unroll
                for (int i = 0; i < 16; ++i) { const size_t o = (size_t)(mb + crow(i, h)) * D + col; const float a = half ? c1[i] : c0[i]; X[o] = base[o] + gv * (a + bv); } }
        };
        sgemm_tile(rp, Wt, D, mt * 128, nt * 128, epi, F.wave, F.lane);
    }
}

__device__ __forceinline__ void route_select(const float (&lg)[16], const float* rb, int& be1, int& be2, float& w1, float& w2) {
    float best = -1e30f; float bs1 = 0.f, bs2 = 0.f; be1 = 0; be2 = 0;
#pragma unroll
    for (int g = 0; g < 4; ++g) {
        float v1 = -1e30f, v2 = -1e30f, s1 = 0.f, s2 = 0.f; int j1 = 0, j2 = 0;
#pragma unroll
        for (int q = 0; q < 4; ++q) { const float sc = sigmoid_f(lg[4 * g + q]), x = sc + rb[4 * g + q];
            if (x > v1) { v2 = v1; j2 = j1; s2 = s1; v1 = x; j1 = q; s1 = sc; } else if (x > v2) { v2 = x; j2 = q; s2 = sc; } }
        const float gs = v1 + v2;
        if (gs > best) { best = gs; be1 = 4 * g + j1; be2 = 4 * g + j2; bs1 = s1; bs2 = s2; }
    }
    const float inv = 1.f / (bs1 + bs2); w1 = bs1 * inv; w2 = bs2 * inv;
}
__device__ __forceinline__ void phase_norm2_route(Frame& F, int layer) {
    const float* mod = (const float*)(F.ws + WS_MOD) + (size_t)layer * 5 * 6144;
    const float* X = F.out; const bf16* XB = (const bf16*)(F.ws + WS_XB); bf16* HB = (bf16*)(F.ws + WS_HB);
    const float* rw = F.in[I_RW]; const float* rb = F.in[I_RB];
    int* tok_e = (int*)(F.ws + WS_TOKE); int* tok_p = (int*)(F.ws + WS_TOKP); float* tok_w = (float*)(F.ws + WS_TOKW);
    int* slot_t = (int*)(F.ws + WS_SLOTT) + layer * 16 * CAP;
    float* slot_w = (float*)(F.ws + WS_SLOTW) + layer * 16 * CAP;
    unsigned* cnt = F.ctl + CW_CNT + layer * 16 * 64;
    LAS float* rwt = (LAS float*)F.lds;
    LAS int* sel_e = (LAS int*)(F.lds + 65536);
    LAS float* sel_w = (LAS float*)(F.lds + 65536 + 1024);
    LAS int* wcnt = (LAS int*)(F.lds + 65536 + 2048);
    LAS int* ebase = wcnt + 64;
    __syncthreads();
    for (int t = F.tid; t < 4096; t += NTHR) { const int i = t >> 2, e4 = t & 3; const f32x4 w = *(const f32x4*)(rw + (size_t)i * 16 + 4 * e4);
        const int p = (i & 512) + 256 * ((i >> 2) & 1) + 4 * ((i >> 3) & 63) + (i & 3);
        rwt[(4 * e4 + 0) * 1024 + p] = w.x; rwt[(4 * e4 + 1) * 1024 + p] = w.y; rwt[(4 * e4 + 2) * 1024 + p] = w.z; rwt[(4 * e4 + 3) * 1024 + p] = w.w; }
    __syncthreads();
    for (int rb0 = F.wg; rb0 < T / 128; rb0 += F.G) {
        const int b = (rb0 * 128) >> 13;
        f32x4 gm[4], sh[4];
        { const float* m = mod + (size_t)b * 6144; const float* g = F.in[I_NFG] + layer * D;
#pragma unroll
          for (int jj = 0; jj < 4; ++jj) { const int o = ROFF(F.lane, jj); gm[jj] = *(const f32x4*)(g + o) * (1.f + *(const f32x4*)(m + 4096 + o)); sh[jj] = *(const f32x4*)(m + 3072 + o); } }
        const int rbase = rb0 * 128 + F.wave * 16;
        f32x4 v0[4], v1[4]; xrow_load(X, XB, (size_t)rbase, F.lane, v0); xrow_load(X, XB, (size_t)(rbase + 1), F.lane, v1);
#pragma unroll 1
        for (int j = 0; j < 16; j += 2) {
            const int lr = F.wave * 16 + j, row = rbase + j;
            f32x4 n0[4], n1[4];
            { const int nr = (j + 2 < 16) ? row + 2 : row; xrow_load(X, XB, (size_t)nr, F.lane, n0); xrow_load(X, XB, (size_t)(nr + 1), F.lane, n1); }
            const float rstd0 = rsqrtf(row_sumsq(v0) * (1.f / D) + EPS), rstd1 = rsqrtf(row_sumsq(v1) * (1.f / D) + EPS);
#pragma unroll
            for (int jj = 0; jj < 4; ++jj) { v0[jj] = v0[jj] * rstd0 * gm[jj] + sh[jj]; v1[jj] = v1[jj] * rstd1 * gm[jj] + sh[jj]; }
            row_store_bf16(HB + (size_t)row * D, v0, F.lane); row_store_bf16(HB + (size_t)(row + 1) * D, v1, F.lane);
            float lg0[16], lg1[16];
#pragma unroll
            for (int e = 0; e < 16; ++e) { float a0 = 0.f, a1 = 0.f;
#pragma unroll
                for (int jj = 0; jj < 4; ++jj) { const f32x4 w4 = *(const LAS f32x4*)(rwt + e * 1024 + 256 * jj + 4 * F.lane);
                    a0 += (v0[jj].x * w4.x + v0[jj].y * w4.y) + (v0[jj].z * w4.z + v0[jj].w * w4.w); a1 += (v1[jj].x * w4.x + v1[jj].y * w4.y) + (v1[jj].z * w4.z + v1[jj].w * w4.w); }
                lg0[e] = a0; lg1[e] = a1; }
#pragma unroll
            for (int e = 0; e < 16; ++e) { lg0[e] = wave_sum(lg0[e]); lg1[e] = wave_sum(lg1[e]); }
            int e1, e2; float w1, w2;
            route_select(lg0, rb, e1, e2, w1, w2);
            if (F.lane == 0) { sel_e[2 * lr] = e1; sel_e[2 * lr + 1] = e2; sel_w[2 * lr] = w1; sel_w[2 * lr + 1] = w2; }
            route_select(lg1, rb, e1, e2, w1, w2);
            if (F.lane == 0) { sel_e[2 * lr + 2] = e1; sel_e[2 * lr + 3] = e2; sel_w[2 * lr + 2] = w1; sel_w[2 * lr + 3] = w2; }
#pragma unroll
            for (int jj = 0; jj < 4; ++jj) { v0[jj] = n0[jj]; v1[jj] = n1[jj]; }
        }
        __syncthreads();
        int my_e = 0, my_rank = 0; float my_w = 0.f;
        if (F.tid < 256) { my_e = sel_e[F.tid]; my_w = sel_w[F.tid];
            const unsigned long long below = (1ull << F.lane) - 1ull;
#pragma unroll 1
            for (int ee = 0; ee < 16; ++ee) { const unsigned long long mk = __ballot(my_e == ee);
                if (my_e == ee) my_rank = __popcll(mk & below);
                if (F.lane == 0) wcnt[F.wave * 16 + ee] = __popcll(mk); } }
        __syncthreads();
        if (F.tid < 16) { const int n = wcnt[F.tid] + wcnt[16 + F.tid] + wcnt[32 + F.tid] + wcnt[48 + F.tid];
            ebase[F.tid] = n ? (int)atomicAdd(cnt + F.tid * 64, (unsigned)n) : 0; }
        __syncthreads();
        if (F.tid < 256) { int pos = ebase[my_e] + my_rank;
            for (int w = 0; w < F.wave; ++w) pos += wcnt[w * 16 + my_e];
            const int tok = rb0 * 128 + (F.tid >> 1), k = F.tid & 1;
            slot_t[my_e * CAP + pos] = tok; slot_w[my_e * CAP + pos] = my_w; tok_e[2 * tok + k] = my_e; tok_p[2 * tok + k] = pos; tok_w[2 * tok + k] = my_w; }
        __syncthreads();
    }
}


__device__ __forceinline__ void phase_norm2_route_mfma(Frame& F, int layer) {
    constexpr int AP = 1032;
    const float* mod = (const float*)(F.ws + WS_MOD) + (size_t)layer * 5 * 6144;
    const bf16* XB = (const bf16*)(F.ws + WS_XB); bf16* HB = (bf16*)(F.ws + WS_HB);
    const float* rw = F.in[I_RW]; const float* rb = F.in[I_RB]; const float* gsrc = F.in[I_NFG] + layer * D;
    int* tok_e = (int*)(F.ws + WS_TOKE); int* tok_p = (int*)(F.ws + WS_TOKP); float* tok_w = (float*)(F.ws + WS_TOKW);
    int* slot_t = (int*)(F.ws + WS_SLOTT) + layer * 16 * CAP;
    float* slot_w = (float*)(F.ws + WS_SLOTW) + layer * 16 * CAP;
    unsigned* cnt = F.ctl + CW_CNT + layer * 16 * 64;
    LAS bf16* AH = (LAS bf16*)F.lds; LAS bf16* AL = AH + 16 * AP;
    LAS float* cbv = (LAS float*)(F.lds + 2 * 16 * AP * 2);
    LAS float* rstdv = cbv + 16;
    LAS float* lgt = rstdv + 128;
    LAS int* sel_e = (LAS int*)(lgt + 128 * 16);
    LAS float* sel_w = (LAS float*)(sel_e + 256);
    LAS int* wcnt = (LAS int*)(sel_w + 256);
    LAS int* ebase = wcnt + 64;
    LAS float* cpart = (LAS float*)(ebase + 16);
    for (int rb0 = F.wg; rb0 < T / 128; rb0 += F.G) {
        const int b = (rb0 * 128) >> 13; const float* m = mod + (size_t)b * 6144;
        __syncthreads();
        { float cp[16];
#pragma unroll
          for (int e = 0; e < 16; ++e) cp[e] = 0.f;
          for (int k = F.tid; k < D; k += NTHR) { const float gmk = gsrc[k] * (1.f + m[4096 + k]), shk = m[3072 + k];
#pragma unroll
              for (int e4 = 0; e4 < 4; ++e4) { const f32x4 w4 = *(const f32x4*)(rw + (size_t)k * 16 + 4 * e4);
#pragma unroll
                  for (int q = 0; q < 4; ++q) { const int e = 4 * e4 + q; const float pr = gmk * w4[q]; const unsigned hi = f2bf(pr); const unsigned lo = f2bf(pr - bf2f(hi));
                      AH[e * AP + k] = (bf16)hi; AL[e * AP + k] = (bf16)lo; cp[e] += shk * w4[q]; } } }
#pragma unroll
          for (int e = 0; e < 16; ++e) { const float t = wave_sum(cp[e]); if (F.lane == 0) cpart[F.wave * 16 + e] = t; } }
        __syncthreads();
        if (F.tid < 16) { float t = 0.f;
#pragma unroll
            for (int w = 0; w < 8; ++w) t += cpart[w * 16 + F.tid];
            cbv[F.tid] = t; }
        f32x4 gm[4], sh[4];
#pragma unroll
        for (int jj = 0; jj < 4; ++jj) { const int o = ROFF(F.lane, jj); gm[jj] = *(const f32x4*)(gsrc + o) * (1.f + *(const f32x4*)(m + 4096 + o)); sh[jj] = *(const f32x4*)(m + 3072 + o); }
        const int rbase = rb0 * 128 + F.wave * 16;
        f32x4 v0[4], v1[4]; row_load_bf(XB + (size_t)rbase * D, F.lane, v0); row_load_bf(XB + (size_t)(rbase + 1) * D, F.lane, v1);
#pragma unroll 1
        for (int j = 0; j < 16; j += 2) {
            const int lr = F.wave * 16 + j, row = rbase + j;
            f32x4 n0[4], n1[4];
            { const int nr = (j + 2 < 16) ? row + 2 : row; row_load_bf(XB + (size_t)nr * D, F.lane, n0); row_load_bf(XB + (size_t)(nr + 1) * D, F.lane, n1); }
            const float rstd0 = rsqrtf(row_sumsq(v0) * (1.f / D) + EPS), rstd1 = rsqrtf(row_sumsq(v1) * (1.f / D) + EPS);
#pragma unroll
            for (int jj = 0; jj < 4; ++jj) { v0[jj] = v0[jj] * rstd0 * gm[jj] + sh[jj]; v1[jj] = v1[jj] * rstd1 * gm[jj] + sh[jj]; }
            row_store_bf16(HB + (size_t)row * D, v0, F.lane); row_store_bf16(HB + (size_t)(row + 1) * D, v1, F.lane);
            if (F.lane == 0) { rstdv[lr] = rstd0; rstdv[lr + 1] = rstd1; }
#pragma unroll
            for (int jj = 0; jj < 4; ++jj) { v0[jj] = n0[jj]; v1[jj] = n1[jj]; }
        }
        __syncthreads();
        { const int fr = F.lane & 15, fq = F.lane >> 4;
          f32x4 acc = {0.f, 0.f, 0.f, 0.f};
          const bf16* xr = XB + (size_t)(rb0 * 128 + 16 * F.wave + fr) * D + 8 * fq;
          const LAS bf16* ah = AH + fr * AP + 8 * fq; const LAS bf16* al = AL + fr * AP + 8 * fq;
#pragma unroll 8
          for (int s2 = 0; s2 < 32; ++s2) { const bf16x8 xb = *(const bf16x8*)(xr + 32 * s2);
              acc = __builtin_amdgcn_mfma_f32_16x16x32_bf16(*(const LAS bf16x8*)(ah + 32 * s2), xb, acc, 0, 0, 0);
              acc = __builtin_amdgcn_mfma_f32_16x16x32_bf16(*(const LAS bf16x8*)(al + 32 * s2), xb, acc, 0, 0, 0); }
          const int lrow = 16 * F.wave + fr; const float rs = rstdv[lrow];
#pragma unroll
          for (int i = 0; i < 4; ++i) lgt[lrow * 16 + 4 * fq + i] = rs * acc[i] + cbv[4 * fq + i]; }
        __syncthreads();
        if (F.tid < 128) { float lg[16];
#pragma unroll
            for (int e4 = 0; e4 < 4; ++e4) { const f32x4 t = *(const LAS f32x4*)(lgt + F.tid * 16 + 4 * e4); lg[4 * e4] = t.x; lg[4 * e4 + 1] = t.y; lg[4 * e4 + 2] = t.z; lg[4 * e4 + 3] = t.w; }
            int e1, e2; float w1, w2; route_select(lg, rb, e1, e2, w1, w2);
            sel_e[2 * F.tid] = e1; sel_e[2 * F.tid + 1] = e2; sel_w[2 * F.tid] = w1; sel_w[2 * F.tid + 1] = w2; }
        __syncthreads();
        int my_e = 0, my_rank = 0; float my_w = 0.f;
        if (F.tid < 256) { my_e = sel_e[F.tid]; my_w = sel_w[F.tid];
            const unsigned long long below = (1ull << F.lane) - 1ull;
#pragma unroll 1
            for (int ee = 0; ee < 16; ++ee) { const unsigned long long mk = __ballot(my_e == ee);
                if (my_e == ee) my_rank = __popcll(mk & below);
                if (F.lane == 0) wcnt[F.wave * 16 + ee] = __popcll(mk); } }
        __syncthreads();
        if (F.tid < 16) { const int n = wcnt[F.tid] + wcnt[16 + F.tid] + wcnt[32 + F.tid] + wcnt[48 + F.tid];
            ebase[F.tid] = n ? (int)atomicAdd(cnt + F.tid * 64, (unsigned)n) : 0; }
        __syncthreads();
        if (F.tid < 256) { int pos = ebase[my_e] + my_rank;
            for (int w = 0; w < F.wave; ++w) pos += wcnt[w * 16 + my_e];
            const int tok = rb0 * 128 + (F.tid >> 1), k = F.tid & 1;
            slot_t[my_e * CAP + pos] = tok; slot_w[my_e * CAP + pos] = my_w; tok_e[2 * tok + k] = my_e; tok_p[2 * tok + k] = pos; tok_w[2 * tok + k] = my_w; }
    }
    __syncthreads();
}

constexpr int MOEMAP_OFF = LDS_BYTES - 256;
__device__ __forceinline__ LAS int* moe_map(Frame& F, int layer) {
    LAS int* mm = (LAS int*)(F.lds + MOEMAP_OFF);
    __syncthreads();
    if (F.tid < 64) { const unsigned* cnt = F.ctl + CW_CNT + layer * 16 * 64;
        const int n = (F.tid < 16) ? (int)__hip_atomic_load(cnt + F.tid * 64, __ATOMIC_RELAXED, __HIP_MEMORY_SCOPE_AGENT) : 0;
        const int pad = (n + 255) & ~255; int x = pad;
#pragma unroll
        for (int o = 1; o < 16; o <<= 1) { const int t = __shfl_up(x, o); if (F.lane >= o) x += t; }
        if (F.tid < 16) { mm[F.tid] = n; mm[16 + F.tid] = x - pad; } }
    __syncthreads();
    return mm;
}
struct RowGather { const bf16* base; const int* list; int n; __device__ __forceinline__ const bf16* operator()(int m) const { const int tok = m < n ? list[m] : 0; return base + (size_t)tok * D; } };

__device__ __forceinline__ void phase_moe_gateup(Frame& F, int layer) {
    LAS int* mm = moe_map(F, layer);
    const bf16* HB = (const bf16*)(F.ws + WS_HB); bf16* HID = (bf16*)(F.ws + WS_HID);
    const int* slot_t = (const int*)(F.ws + WS_SLOTT) + layer * 16 * CAP; const float* slot_w = (const float*)(F.ws + WS_SLOTW) + layer * 16 * CAP;
    int ubase = 0;
#pragma unroll 1
    for (int e = 0; e < 16; ++e) {
        const int n = mm[e], hbe = mm[16 + e], rt = (n + 127) >> 7, nu = rt * 8;
        const bf16* Wt = (const bf16*)(F.ws + WS_WGU) + (size_t)(layer * 16 + e) * 1024 * 1024;
        RowGather rp{HB, slot_t + e * CAP, n};
        int first = (F.wg - ubase % F.G + F.G) % F.G;
        for (int u = first; u < nu; u += F.G) {
            const int mt = u / 8, nt = u % 8;
            auto epi = [&](int mb, int nb, const f32x16& c0, const f32x16& c1, int lane) {
                const int h = lane >> 5, cl = lane & 31; const int col = (nb >> 1) + cl;
#pragma unroll
                for (int i = 0; i < 16; ++i) { const int r = mb + crow(i, h);
                    if (r < n) { const float w = slot_w[e * CAP + r]; HID[(size_t)(hbe + r) * FF + col] = (bf16)f2bf(w * silu_f(c0[i]) * c1[i]); } }
            };
            sgemm_tile(rp, Wt, D, mt * 128, nt * 128, epi, F.wave, F.lane);
        }
        ubase += nu;
    }
}
__device__ __forceinline__ void phase_moe_down(Frame& F, int layer) {
    LAS int* mm = moe_map(F, layer);
    const bf16* HID = (const bf16*)(F.ws + WS_HID); bf16* Y = (bf16*)(F.ws + WS_Y);
    int ubase = 0;
#pragma unroll 1
    for (int e = 0; e < 16; ++e) {
        const int n = mm[e], hbe = mm[16 + e], rt = (n + 127) >> 7, nu = rt * 8;
        const bf16* Wt = (const bf16*)(F.ws + WS_WDN) + (size_t)(layer * 16 + e) * 1024 * 512;
        RowLin rp{HID + (size_t)hbe * FF, (size_t)FF};
        int first = (F.wg - ubase % F.G + F.G) % F.G;
        for (int u = first; u < nu; u += F.G) {
            const int mt = u / 8, nt = u % 8;
            auto epi = [&](int mb, int nb, const f32x16& c0, const f32x16& c1, int lane) {
                const int h = lane >> 5, cl = lane & 31;
#pragma unroll
                for (int i = 0; i < 16; ++i) { const int r = mb + crow(i, h);
                    if (r < n) { bf16* yr = Y + (size_t)(hbe + r) * D + nb + cl; yr[0] = (bf16)f2bf(c0[i]); yr[32] = (bf16)f2bf(c1[i]); } }
            };
            sgemm_tile(rp, Wt, FF, mt * 128, nt * 128, epi, F.wave, F.lane);
        }
        ubase += nu;
    }
}

template <bool FINAL>
__device__ __forceinline__ void phase_combine(Frame& F, int layer) {
    LAS int* hbs = moe_map(F, layer) + 16;
    const int gw = F.wg * NWAVES + F.wave, NGW = F.G * NWAVES;
    const float* mod = (const float*)(F.ws + WS_MOD);
    const int* tok_e = (const int*)(F.ws + WS_TOKE); const int* tok_p = (const int*)(F.ws + WS_TOKP);
    const unsigned char* Y8 = (const unsigned char*)(F.ws + WS_Y);
    float* X = F.out; bf16* XB = (bf16*)(F.ws + WS_XB); bf16* HB = (bf16*)(F.ws + WS_HB);
    for (int blk = gw; blk < T / 16; blk += NGW) {
        const int rbase = blk * 16, b = rbase >> 13;
        f32x4 g2v[4], gm[4], shv[4];
        { const float* g2 = mod + ((size_t)layer * 5 + b) * 6144 + 5120;
#pragma unroll
          for (int j = 0; j < 4; ++j) { const int o = ROFF(F.lane, j); g2v[j] = *(const f32x4*)(g2 + o) * (1.f / YSCALE);
              if (FINAL) { gm[j] = *(const f32x4*)(F.in[I_FNG] + o); shv[j] = (f32x4){0.f, 0.f, 0.f, 0.f}; }
              else { const float* m = mod + ((size_t)(layer + 1) * 5 + b) * 6144; gm[j] = *(const f32x4*)(F.in[I_NMG] + (layer + 1) * D + o) * (1.f + *(const f32x4*)(m + 1024 + o)); shv[j] = *(const f32x4*)(m + o); } } }
        int4 te = *(const int4*)(tok_e + 2 * rbase), tp = *(const int4*)(tok_p + 2 * rbase);
        u32x4 xa[2][2], xn[2][2]; u32x2 ya[2][2][2], yn[2][2][2];
        { const int s00 = hbs[te.x] + tp.x, s01 = hbs[te.y] + tp.y, s10 = hbs[te.z] + tp.z, s11 = hbs[te.w] + tp.w;
#pragma unroll
          for (int jj = 0; jj < 2; ++jj) { const int o = 512 * jj + 8 * F.lane;
              xa[0][jj] = *(const u32x4*)(XB + (size_t)rbase * D + o); xa[1][jj] = *(const u32x4*)(XB + (size_t)(rbase + 1) * D + o);
              ya[0][0][jj] = *(const u32x2*)(Y8 + (size_t)s00 * D + o); ya[0][1][jj] = *(const u32x2*)(Y8 + (size_t)s01 * D + o);
              ya[1][0][jj] = *(const u32x2*)(Y8 + (size_t)s10 * D + o); ya[1][1][jj] = *(const u32x2*)(Y8 + (size_t)s11 * D + o); } }
        te = *(const int4*)(tok_e + 2 * (rbase + 2)); tp = *(const int4*)(tok_p + 2 * (rbase + 2));
#pragma unroll 1
        for (int jr = 0; jr < 16; jr += 2) {
            const int row = rbase + jr;
            if (jr + 2 < 16) { const int nr = row + 2;
                const int s00 = hbs[te.x] + tp.x, s01 = hbs[te.y] + tp.y, s10 = hbs[te.z] + tp.z, s11 = hbs[te.w] + tp.w;
#pragma unroll
                for (int jj = 0; jj < 2; ++jj) { const int o = 512 * jj + 8 * F.lane;
                    xn[0][jj] = *(const u32x4*)(XB + (size_t)nr * D + o); xn[1][jj] = *(const u32x4*)(XB + (size_t)(nr + 1) * D + o);
                    yn[0][0][jj] = *(const u32x2*)(Y8 + (size_t)s00 * D + o); yn[0][1][jj] = *(const u32x2*)(Y8 + (size_t)s01 * D + o);
                    yn[1][0][jj] = *(const u32x2*)(Y8 + (size_t)s10 * D + o); yn[1][1][jj] = *(const u32x2*)(Y8 + (size_t)s11 * D + o); }
                const int n2 = (jr + 4 < 16) ? row + 4 : row; te = *(const int4*)(tok_e + 2 * n2); tp = *(const int4*)(tok_p + 2 * n2); }
            f32x4 v[2][4];
#pragma unroll
            for (int q = 0; q < 2; ++q)
#pragma unroll
                for (int jj = 0; jj < 2; ++jj) { const u32x4 xw = xa[q][jj]; const u32x2 a0 = ya[q][0][jj], a1 = ya[q][1][jj];
                    v[q][2 * jj] = (f32x4){bflo(xw.x), bfhi(xw.x), bflo(xw.y), bfhi(xw.y)} + g2v[2 * jj] * (un_fp8x4(a0.x) + un_fp8x4(a1.x));
                    v[q][2 * jj + 1] = (f32x4){bflo(xw.z), bfhi(xw.z), bflo(xw.w), bfhi(xw.w)} + g2v[2 * jj + 1] * (un_fp8x4(a0.y) + un_fp8x4(a1.y)); }
            const float rstd0 = rsqrtf(row_sumsq(v[0]) * (1.f / D) + EPS), rstd1 = rsqrtf(row_sumsq(v[1]) * (1.f / D) + EPS);
#pragma unroll
            for (int q = 0; q < 2; ++q) { const float rstd = q ? rstd1 : rstd0; const size_t ro = (size_t)(row + q) * D;
                if (FINAL) {
#pragma unroll
                    for (int j = 0; j < 4; ++j) *(f32x4*)(X + ro + ROFF(F.lane, j)) = v[q][j] * rstd * gm[j];
                } else {
                    row_store_bf16(XB + ro, v[q], F.lane);
#pragma unroll
                    for (int j = 0; j < 4; ++j) v[q][j] = v[q][j] * rstd * gm[j] + shv[j];
                    row_store_bf16(HB + ro, v[q], F.lane);
                }
            }
#pragma unroll
            for (int q = 0; q < 2; ++q)
#pragma unroll
                for (int jj = 0; jj < 2; ++jj) { xa[q][jj] = xn[q][jj]; ya[q][0][jj] = yn[q][0][jj]; ya[q][1][jj] = yn[q][1][jj]; }
        }
    }
    __syncthreads();
}

__device__ __forceinline__ void phase_pw1(Frame& F) {
    const bf16* HB = (const bf16*)(F.ws + WS_HB); const bf16* Wt = (const bf16*)(F.ws + WS_WPW1); bf16* U = (bf16*)(F.ws + WS_U);
    const float* bias = F.in[I_PW1B];
    RowLin rp{HB, (size_t)D};
    for (int u = F.wg; u < (T / 128) * 16; u += F.G) {
        const int mt = u / 16, nt = u % 16;
        auto epi = [&](int mb, int nb, const f32x16& c0, const f32x16& c1, int lane) {
            const int h = lane >> 5, cl = lane & 31, col = (nb >> 1) + cl; const float ba = bias[col], bg = bias[1024 + col];
#pragma unroll
            for (int i = 0; i < 16; ++i) U[(size_t)(mb + crow(i, h)) * D + col] = (bf16)f2bf((c0[i] + ba) * sigmoid_f(c1[i] + bg));
        };
        sgemm_tile(rp, Wt, D, mt * 128, nt * 128, epi, F.wave, F.lane);
    }
}
__device__ __forceinline__ void phase_dwconv(Frame& F) {
    const bf16* U = (const bf16*)(F.ws + WS_U); bf16* V1 = (bf16*)(F.ws + WS_V1);
    const float* dww = F.in[I_DWW]; const float* dwb = F.in[I_DWB]; const float* lng = F.in[I_LNG]; const float* lnb = F.in[I_LNB];
    const int gw = F.wg * NWAVES + F.wave, NGW = F.G * NWAVES;
    for (int row = gw; row < T; row += NGW) {
        const int l = row & (L - 1);
        f32x4 acc[4];
#pragma unroll
        for (int j = 0; j < 4; ++j) acc[j] = *(const f32x4*)(dwb + 4 * F.lane + 256 * j);
        for (int tp = 0; tp < CONVW; ++tp) { const int ll = l + tp - 15; if (ll < 0 || ll >= L) continue;
            const bf16* ur = U + (size_t)(row + tp - 15) * D; const float* wr = dww + (size_t)tp * D;
#pragma unroll
            for (int j = 0; j < 4; ++j) { const int o = 4 * F.lane + 256 * j; const u32x2 uu = *(const u32x2*)(ur + o); const f32x4 ww = *(const f32x4*)(wr + o);
                acc[j].x += bflo(uu.x) * ww.x; acc[j].y += bfhi(uu.x) * ww.y; acc[j].z += bflo(uu.y) * ww.z; acc[j].w += bfhi(uu.y) * ww.w; } }
        float s = 0.f;
#pragma unroll
        for (int j = 0; j < 4; ++j) s += (acc[j].x + acc[j].y) + (acc[j].z + acc[j].w);
        const float mean = wave_sum(s) * (1.f / D); float q = 0.f;
#pragma unroll
        for (int j = 0; j < 4; ++j) { acc[j] = acc[j] - mean; q += (acc[j].x * acc[j].x + acc[j].y * acc[j].y) + (acc[j].z * acc[j].z + acc[j].w * acc[j].w); }
        const float rstd = rsqrtf(wave_sum(q) * (1.f / D) + EPS);
#pragma unroll
        for (int j = 0; j < 4; ++j) { const int o = 4 * F.lane + 256 * j; const f32x4 gg = *(const f32x4*)(lng + o), bb = *(const f32x4*)(lnb + o);
            f32x4 y = acc[j] * rstd * gg + bb; y.x = silu_f(y.x); y.y = silu_f(y.y); y.z = silu_f(y.z); y.w = silu_f(y.w); acc[j] = y; }
        row_store_bf16(V1 + (size_t)row * D, acc, F.lane);
    }
}


namespace pg {
constexpr int BM = 256, BK = 64, HALF = 128, HTB = HALF * BK * 2, STAGE_BYTES = 8 * HTB;
constexpr int TAB_OFF = STAGE_BYTES;
__device__ __forceinline__ int lds_byte(int r, int c) { const int st = (r >> 4) * 2 + (c >> 5), rr = r & 15, cc = c & 31, ob = rr * 64 + cc * 2; return st * 1024 + (ob ^ (((ob >> 9) & 1) << 5)); }
__device__ __forceinline__ void stage_rc(int b, int& R, int& C) { const int st = b / 1024, sb = b % 1024, swz = sb ^ (((sb >> 9) & 1) << 5); R = (st >> 1) * 16 + swz / 64; C = (st & 1) * 32 + (swz % 64) / 2; }
__device__ __forceinline__ int perm32(int rho) { const int n = rho >> 4, i = rho & 15; return 8 * (i >> 2) + 4 * n + (i & 3); }
__device__ __forceinline__ unsigned cvt_pk_bf16(float lo, float hi) { unsigned r; asm volatile("v_cvt_pk_bf16_f32 %0, %1, %2" : "=v"(r) : "v"(lo), "v"(hi)); return r; }

struct GU { const char* B; int p0, p1, p2, p3; };

template <class Epi, class Sched>
__device__ __forceinline__ void gemm_phase(LAS unsigned char* lds, const char* Abase, const int K, const Sched& S, const Epi& E) {
    const int tid = threadIdx.x, wid = __builtin_amdgcn_readfirstlane(tid >> 6), lane = tid & 63, wr = wid >> 2, wc = wid & 3, fr = lane & 15, fq = lane >> 4;
    const int nt = K / BK;
    int sR[2], sC[2]; unsigned voffB[2];
#pragma unroll
    for (int i = 0; i < 2; ++i) { int R, C; stage_rc(tid * 16 + i * 8192, R, C); sR[i] = R; sC[i] = C; const int Rb = Epi::PERM ? ((R & ~31) + perm32(R & 31)) : R; voffB[i] = (unsigned)(Rb * K + C) * 2u; }
    const size_t kstep = (size_t)(BK * 2);
    const size_t hstep = (size_t)HALF * K * 2;
    const unsigned ldsw = (unsigned)wid * 1024u;
    const int aoff = lds_byte(wr * 64 + fr, fq * 8), boff = lds_byte(wc * 32 + fr, fq * 8);
#define PG_SA(b, h) (((b) * 2 + (h)) * HTB)
#define PG_SB(b, h) ((4 + (b) * 2 + (h)) * HTB)
#define PG_STAGE(bufoff, gbase, voff) do { _Pragma("unroll") for (int _i = 0; _i < 2; ++_i) \
        __builtin_amdgcn_global_load_lds((const unsigned*)((const char*)(gbase) + (voff)[_i]), (LAS unsigned*)(lds + (bufoff) + ldsw + _i * 8192), 16, 0, 0); } while (0)
#define PG_LDA(dst, b, h) do { _Pragma("unroll") for (int m = 0; m < 4; ++m) _Pragma("unroll") for (int k = 0; k < 2; ++k) dst[m][k] = *(const LAS bf16x8*)(lds + PG_SA(b, h) + aoff + m * 2048 + k * 1024); } while (0)
#define PG_LDB(dst, b, h) do { _Pragma("unroll") for (int n = 0; n < 2; ++n) _Pragma("unroll") for (int k = 0; k < 2; ++k) dst[n][k] = *(const LAS bf16x8*)(lds + PG_SB(b, h) + boff + n * 2048 + k * 1024); } while (0)
#define PG_MMA(ai, bj, At, Bt) do { __builtin_amdgcn_s_setprio(1); _Pragma("unroll") for (int m = 0; m < 4; ++m) _Pragma("unroll") for (int n = 0; n < 2; ++n) _Pragma("unroll") for (int k = 0; k < 2; ++k) \
        acc[ai][bj][m][n] = __builtin_amdgcn_mfma_f32_16x16x32_bf16(Bt[n][k], At[m][k], acc[ai][bj][m][n], 0, 0, 0); __builtin_amdgcn_s_setprio(0); } while (0)
#define PG_WAIT_V(n) asm volatile("s_waitcnt vmcnt(" #n ")" ::: "memory")
#define PG_WAIT_L(n) asm volatile("s_waitcnt lgkmcnt(" #n ")" ::: "memory")
#define PG_BAR __builtin_amdgcn_s_barrier()
#define PG_SCHED __builtin_amdgcn_sched_barrier(0)
    GU cur, nxt; int ui = 0;
    if (!S.next(0, cur)) return;
    f32x4 acc[2][2][4][2];
#pragma unroll
    for (int a = 0; a < 2; ++a)
#pragma unroll
        for (int b = 0; b < 2; ++b)
#pragma unroll
            for (int m = 0; m < 4; ++m)
#pragma unroll
                for (int n = 0; n < 2; ++n) acc[a][b][m][n] = (f32x4){0.f, 0.f, 0.f, 0.f};
    bf16x8 At[4][2], B0[2][2], B1[2][2];
    if constexpr (Sched::GATHER) { S.stage_table(cur, 0, lds, wid, lane); PG_WAIT_V(0); PG_BAR; }
    unsigned voC[2][2], voN[2][2];
#pragma unroll
    for (int h = 0; h < 2; ++h)
#pragma unroll
        for (int i = 0; i < 2; ++i) { voC[h][i] = S.voff(cur, 0, lds, h * HALF + sR[i], sC[i]); voN[h][i] = voC[h][i]; }
    const char* cB = cur.B;
    PG_STAGE(PG_SB(0, 0), cB, voffB); PG_STAGE(PG_SB(0, 1), cB + hstep, voffB); PG_STAGE(PG_SA(0, 0), Abase, voC[0]); PG_STAGE(PG_SA(0, 1), Abase, voC[1]);
    if (wr == 1) PG_BAR;
    PG_WAIT_V(2); PG_BAR;
    PG_STAGE(PG_SB(1, 0), cB + kstep, voffB); PG_STAGE(PG_SA(1, 0), Abase + kstep, voC[0]); PG_STAGE(PG_SB(1, 1), cB + hstep + kstep, voffB);
    PG_WAIT_V(6); PG_BAR;
    for (;;) {
        const bool has_next = S.next(ui + 1, nxt);
        if constexpr (Sched::GATHER) { if (has_next) S.stage_table(nxt, (ui + 1) & 1, lds, wid, lane); }
        const char* nB = has_next ? nxt.B : cB;
        for (int t = 0; t < nt; t += 2) {
            const bool last = (t == nt - 2);
            if (last && has_next) {
#pragma unroll
                for (int h = 0; h < 2; ++h)
#pragma unroll
                    for (int i = 0; i < 2; ++i) voN[h][i] = S.voff(nxt, (ui + 1) & 1, lds, h * HALF + sR[i], sC[i]);
            }
            unsigned vo2[2][2];
#pragma unroll
            for (int h = 0; h < 2; ++h)
#pragma unroll
                for (int i = 0; i < 2; ++i) vo2[h][i] = last ? voN[h][i] : voC[h][i];
            const char* a1 = Abase + (size_t)(t + 1) * kstep;
            const char* a2 = last ? Abase : Abase + (size_t)(t + 2) * kstep; const char* b2 = last ? nB : cB + (size_t)(t + 2) * kstep;
            const char* a3 = a2 + kstep; const char* b3 = b2 + kstep;
            PG_LDB(B0, 0, 0); PG_LDB(B1, 0, 1); PG_SCHED; PG_LDA(At, 0, 0); PG_STAGE(PG_SA(1, 1), a1, voC[1]);
            PG_WAIT_V(8); PG_WAIT_L(0); PG_BAR; PG_MMA(0, 0, At, B0); PG_MMA(0, 1, At, B1); PG_BAR; PG_SCHED;
            PG_LDA(At, 0, 1); PG_STAGE(PG_SB(0, 0), b2, voffB); PG_STAGE(PG_SB(0, 1), b2 + hstep, voffB); PG_STAGE(PG_SA(0, 0), a2, vo2[0]);
            PG_WAIT_V(8); PG_WAIT_L(0); PG_BAR; PG_MMA(1, 0, At, B0); PG_MMA(1, 1, At, B1); PG_BAR; PG_SCHED;
            PG_LDB(B0, 1, 0); PG_LDB(B1, 1, 1); PG_SCHED; PG_LDA(At, 1, 0); PG_STAGE(PG_SA(0, 1), a2, vo2[1]);
            PG_WAIT_V(8); PG_WAIT_L(0); PG_BAR; PG_MMA(0, 0, At, B0); PG_MMA(0, 1, At, B1); PG_BAR; PG_SCHED;
            PG_LDA(At, 1, 1); PG_STAGE(PG_SB(1, 0), b3, voffB); PG_STAGE(PG_SB(1, 1), b3 + hstep, voffB); PG_STAGE(PG_SA(1, 0), a3, vo2[0]);
            PG_WAIT_V(8); PG_WAIT_L(0); PG_BAR; PG_MMA(1, 0, At, B0); PG_MMA(1, 1, At, B1); PG_BAR; PG_SCHED;
        }
        if (wr == 0) PG_BAR;
        E(acc, cur, wr, wc, fr, fq);
        if (!has_next) break;
#pragma unroll
        for (int a = 0; a < 2; ++a)
#pragma unroll
            for (int b = 0; b < 2; ++b)
#pragma unroll
                for (int m = 0; m < 4; ++m)
#pragma unroll
                    for (int n = 0; n < 2; ++n) acc[a][b][m][n] = (f32x4){0.f, 0.f, 0.f, 0.f};
        cur = nxt; cB = nB; ++ui;
#pragma unroll
        for (int h = 0; h < 2; ++h)
#pragma unroll
            for (int i = 0; i < 2; ++i) voC[h][i] = voN[h][i];
        if (wr == 1) PG_BAR;
    }
    PG_WAIT_V(0);
    PG_BAR;
#undef PG_SA
#undef PG_SB
#undef PG_STAGE
#undef PG_LDA
#undef PG_LDB
#undef PG_MMA
#undef PG_WAIT_V
#undef PG_WAIT_L
#undef PG_BAR
#undef PG_SCHED
}

__device__ __forceinline__ void static_tile(int L, int nM, int nN, int& pm, int& pn) {
    const int nwg = nM * nN; int wgid = L; { const int q = nwg / 8, r = nwg % 8, xcd = wgid % 8, off = wgid / 8; wgid = (xcd < r ? xcd * (q + 1) : r * (q + 1) + (xcd - r) * q) + off; }
    const int nig = 8 * nN, gid = wgid / nig, fm = gid * 8, gsz = (nM - fm) < 8 ? (nM - fm) : 8;
    pm = fm + ((wgid % nig) % gsz); pn = (wgid % nig) / gsz;
}
struct DenseSched {
    static constexpr bool GATHER = false;
    const char* Bt; int K, nM, nN, G, c, xn, xm0, xpn;
    __device__ __forceinline__ bool next(int i, GU& u) const {
        const int L = i * G + c, nmain = nM * nN; int pm, pn;
        if (L < nmain) static_tile(L, nM, nN, pm, pn); else if (L < nmain + xn) { pm = xm0 + (L - nmain); pn = xpn; } else return false;
        u.B = Bt + (size_t)pn * BM * K * 2; u.p0 = pm; u.p1 = pn; u.p2 = 0; u.p3 = 0; return true;
    }
    __device__ __forceinline__ unsigned voff(const GU& u, int, LAS unsigned char*, int R, int C) const { return (unsigned)(((u.p0 * BM + R) * K + C) * 2); }
    __device__ __forceinline__ void stage_table(const GU&, int, LAS unsigned char*, int, int) const {}
};
template <bool GATHER_> struct MoeSched {
    static constexpr bool GATHER = GATHER_;
    const char* Wt; size_t wstride; int K; const int* list; LAS int* mm; int G, c;
    __device__ __forceinline__ bool next(int i, GU& u) const {
        int L = i * G + c;
        for (int e = 0; e < 16; ++e) { const int n = mm[e], nu = ((n + 255) >> 8) * 4;
            if (L < nu) { const int rt = L >> 2, pn = L & 3; u.B = Wt + (size_t)e * wstride + (size_t)pn * BM * K * 2; u.p0 = e; u.p1 = rt; u.p2 = pn; u.p3 = mm[16 + e]; return true; }
            L -= nu; }
        return false;
    }
    __device__ __forceinline__ unsigned voff(const GU& u, int buf, LAS unsigned char* lds, int R, int C) const {
        if constexpr (GATHER_) { const int tok = ((const LAS int*)(lds + TAB_OFF))[buf * 256 + R]; return (unsigned)((tok * K + C) * 2); }
        else return (unsigned)(((u.p3 + u.p1 * BM + R) * K + C) * 2);
    }
    __device__ __forceinline__ void stage_table(const GU& u, int buf, LAS unsigned char* lds, int wid, int lane) const {
        if constexpr (GATHER_) { const int r = (wid & 3) * 64 + lane;
            __builtin_amdgcn_global_load_lds((const unsigned*)(list + u.p0 * CAP + u.p1 * BM + r), (LAS unsigned*)(lds + TAB_OFF + buf * 1024 + (wid & 3) * 256), 4, 0, 0); }
    }
};

struct EpiInProj {
    static constexpr bool PERM = false;
    unsigned char* ws;
    __device__ __forceinline__ void operator()(const f32x4 (&acc)[2][2][4][2], const GU& u, int wr, int wc, int fr, int fq) const {
        const int pm = u.p0, pn = u.p1; const bool isctx = pm >= T / BM;
        float inv[4];
#pragma unroll
        for (int j = 0; j < 4; ++j) inv[j] = exp2f(-(float)(4 * fq + j) * (13.287712379549449f / 16.f));
#pragma unroll
        for (int bj = 0; bj < 2; ++bj) {
            const int cb = pn * BM + bj * HALF + wc * 32;
            bf16* dst; int pitch, cbase; bool rope = false;
            if (cb < 512) { dst = (bf16*)(ws + WS_UF); pitch = 512; cbase = 0; }
            else if (cb < 1024) { dst = (bf16*)(ws + WS_Q); pitch = 512; cbase = 512; rope = true; }
            else if (cb < 1152) { dst = isctx ? (bf16*)(ws + WS_CK) : (bf16*)(ws + WS_K); pitch = 128; cbase = 1024; rope = !isctx; }
            else { dst = isctx ? (bf16*)(ws + WS_CV) : (bf16*)(ws + WS_V); pitch = 128; cbase = 1152; }
            const bool bycol = ((cb >> 5) & 1) != 0;
#pragma unroll
            for (int ai = 0; ai < 2; ++ai)
#pragma unroll
                for (int m = 0; m < 4; ++m) {
                    const int row = pm * BM + ai * HALF + wr * 64 + m * 16 + fr;
                    f32x4 v0 = acc[ai][bj][m][0], v1 = acc[ai][bj][m][1];
                    if (rope) { const int l = row & (L - 1); const float pos = (float)(bycol ? (l & 63) : (l >> 6));
#pragma unroll
                        for (int j = 0; j < 4; ++j) { const float ang = pos * inv[j], cs = __cosf(ang), sn = __sinf(ang); const float x1 = v0[j], x2 = v1[j]; v0[j] = x1 * cs - x2 * sn; v1[j] = x1 * sn + x2 * cs; } }
                    const int orow = isctx ? row - T : row;
                    if (FAST_ATTN && cb >= 1152) {
                        const int kp = isctx ? CL : L, bb = isctx ? (orow >> 8) : (orow >> 13), key = isctx ? (orow & (CL - 1)) : (orow & (L - 1));
#pragma unroll
                        for (int n = 0; n < 2; ++n)
#pragma unroll
                            for (int j = 0; j < 4; ++j) { const int c = (cb - 1152) + 16 * n + 4 * fq + j;
                                dst[((size_t)bb * 128 + c) * kp + key] = (bf16)f2bf(n ? v1[j] : v0[j]); }
                        continue;
                    }
                    bf16* o = dst + (size_t)orow * pitch + (cb - cbase) + 4 * fq;
                    u32x2 w0, w1; w0.x = cvt_pk_bf16(v0[0], v0[1]); w0.y = cvt_pk_bf16(v0[2], v0[3]); w1.x = cvt_pk_bf16(v1[0], v1[1]); w1.y = cvt_pk_bf16(v1[2], v1[3]);
                    *(u32x2*)o = w0; *(u32x2*)(o + 16) = w1;
                }
        }
    }
};
struct EpiRes {
    static constexpr bool PERM = false;
    const float* base; float* X; const float* gate; const float* bias;
    __device__ __forceinline__ void operator()(const f32x4 (&acc)[2][2][4][2], const GU& u, int wr, int wc, int fr, int fq) const {
        const int row0 = u.p0 * BM + wr * 64 + fr, col0 = u.p1 * BM + wc * 32 + 4 * fq; const int b = (u.p0 * BM) >> 13;
        f32x4 gv[2][2], bv[2][2];
#pragma unroll
        for (int bj = 0; bj < 2; ++bj)
#pragma unroll
            for (int n = 0; n < 2; ++n) { gv[bj][n] = *(const f32x4*)(gate + (size_t)b * 6144 + col0 + bj * HALF + n * 16); bv[bj][n] = bias ? *(const f32x4*)(bias + col0 + bj * HALF + n * 16) : (f32x4){0.f, 0.f, 0.f, 0.f}; }
#pragma unroll
        for (int ai = 0; ai < 2; ++ai)
#pragma unroll
            for (int mp = 0; mp < 2; ++mp) {
                f32x4 bs[2][2][2];
#pragma unroll
                for (int mm = 0; mm < 2; ++mm) { const size_t off = (size_t)(row0 + ai * HALF + (2 * mp + mm) * 16) * D + col0;
#pragma unroll
                    for (int bj = 0; bj < 2; ++bj)
#pragma unroll
                        for (int n = 0; n < 2; ++n) bs[mm][bj][n] = *(const f32x4*)(base + off + bj * HALF + n * 16); }
#pragma unroll
                for (int mm = 0; mm < 2; ++mm) { const int m = 2 * mp + mm; const size_t off = (size_t)(row0 + ai * HALF + m * 16) * D + col0;
#pragma unroll
                    for (int bj = 0; bj < 2; ++bj)
#pragma unroll
                        for (int n = 0; n < 2; ++n) *(f32x4*)(X + off + bj * HALF + n * 16) = bs[mm][bj][n] + gv[bj][n] * (acc[ai][bj][m][n] + bv[bj][n]); }
                asm volatile("" ::: "memory"); }
    }
};
template <bool BASEBF> struct EpiResB {
    static constexpr bool PERM = false;
    const float* basef; bf16* XB; const float* gate; const float* bias;
    __device__ __forceinline__ void operator()(const f32x4 (&acc)[2][2][4][2], const GU& u, int wr, int wc, int fr, int fq) const {
        const int row0 = u.p0 * BM + wr * 64 + fr, col0 = u.p1 * BM + wc * 32 + 4 * fq; const int b = (u.p0 * BM) >> 13;
        f32x4 gv[2][2], bv[2][2];
#pragma unroll
        for (int bj = 0; bj < 2; ++bj)
#pragma unroll
            for (int n = 0; n < 2; ++n) { gv[bj][n] = *(const f32x4*)(gate + (size_t)b * 6144 + col0 + bj * HALF + n * 16); bv[bj][n] = bias ? *(const f32x4*)(bias + col0 + bj * HALF + n * 16) : (f32x4){0.f, 0.f, 0.f, 0.f}; }
        constexpr int NB2 = BASEBF ? 4 : 2;
#pragma unroll
        for (int ai = 0; ai < 2; ++ai)
#pragma unroll
            for (int mb = 0; mb < 4; mb += NB2) {
                f32x4 bf[BASEBF ? 1 : NB2][2][2]; u32x2 bw[BASEBF ? NB2 : 1][2][2];
#pragma unroll
                for (int mm = 0; mm < NB2; ++mm) { const size_t off = (size_t)(row0 + ai * HALF + (mb + mm) * 16) * D + col0;
#pragma unroll
                    for (int bj = 0; bj < 2; ++bj)
#pragma unroll
                        for (int n = 0; n < 2; ++n) { if (BASEBF) bw[mm][bj][n] = *(const u32x2*)(XB + off + bj * HALF + n * 16); else bf[mm][bj][n] = *(const f32x4*)(basef + off + bj * HALF + n * 16); } }
#pragma unroll
                for (int mm = 0; mm < NB2; ++mm) { const int m = mb + mm; const size_t off = (size_t)(row0 + ai * HALF + m * 16) * D + col0;
#pragma unroll
                    for (int bj = 0; bj < 2; ++bj)
#pragma unroll
                        for (int n = 0; n < 2; ++n) { f32x4 bsv;
                            if (BASEBF) { const u32x2 w = bw[mm][bj][n]; bsv = (f32x4){bflo(w.x), bfhi(w.x), bflo(w.y), bfhi(w.y)}; } else bsv = bf[mm][bj][n];
                            const f32x4 o = bsv + gv[bj][n] * (acc[ai][bj][m][n] + bv[bj][n]);
                            u32x2 w2; w2.x = cvt_pk_bf16(o[0], o[1]); w2.y = cvt_pk_bf16(o[2], o[3]); *(u32x2*)(XB + off + bj * HALF + n * 16) = w2; } }
                asm volatile("" ::: "memory"); }
    }
};
struct EpiGLU {
    static constexpr bool PERM = true;
    bf16* U; const float* bias;
    __device__ __forceinline__ void operator()(const f32x4 (&acc)[2][2][4][2], const GU& u, int wr, int wc, int fr, int fq) const {
        const int row0 = u.p0 * BM + wr * 64 + fr, col0 = u.p1 * HALF + wc * 32 + 8 * fq;
        f32x4 ba[2], bg[2];
#pragma unroll
        for (int n = 0; n < 2; ++n) { ba[n] = *(const f32x4*)(bias + col0 + 4 * n); bg[n] = *(const f32x4*)(bias + 1024 + col0 + 4 * n); }
#pragma unroll
        for (int ai = 0; ai < 2; ++ai)
#pragma unroll
            for (int m = 0; m < 4; ++m) { f32x4 o[2];
#pragma unroll
                for (int n = 0; n < 2; ++n) { const f32x4 a = acc[ai][0][m][n] + ba[n], g = acc[ai][1][m][n] + bg[n];
#pragma unroll
                    for (int j = 0; j < 4; ++j) o[n][j] = a[j] * sigmoid_f(g[j]); }
                u32x4 w; w.x = cvt_pk_bf16(o[0][0], o[0][1]); w.y = cvt_pk_bf16(o[0][2], o[0][3]); w.z = cvt_pk_bf16(o[1][0], o[1][1]); w.w = cvt_pk_bf16(o[1][2], o[1][3]);
                *(u32x4*)(U + (size_t)(row0 + ai * HALF + m * 16) * D + col0) = w; }
    }
};
struct EpiGateUp {
    static constexpr bool PERM = true;
    bf16* HID; const float* slot_w; LAS int* mm;
    __device__ __forceinline__ void operator()(const f32x4 (&acc)[2][2][4][2], const GU& u, int wr, int wc, int fr, int fq) const {
        const int e = u.p0, n_e = mm[e], r0 = u.p1 * BM + wr * 64 + fr, col0 = u.p2 * HALF + wc * 32 + 8 * fq;
        float wv[2][4];
#pragma unroll
        for (int ai = 0; ai < 2; ++ai)
#pragma unroll
            for (int m = 0; m < 4; ++m) wv[ai][m] = slot_w[e * CAP + r0 + ai * HALF + m * 16];
#pragma unroll
        for (int ai = 0; ai < 2; ++ai)
#pragma unroll
            for (int m = 0; m < 4; ++m) { const int r = r0 + ai * HALF + m * 16;
                if (r < n_e) { const float w = wv[ai][m]; f32x4 o[2];
#pragma unroll
                    for (int n = 0; n < 2; ++n) { const f32x4 g = acc[ai][0][m][n], up = acc[ai][1][m][n];
#pragma unroll
                        for (int j = 0; j < 4; ++j) o[n][j] = w * silu_f(g[j]) * up[j]; }
                    u32x4 q; q.x = cvt_pk_bf16(o[0][0], o[0][1]); q.y = cvt_pk_bf16(o[0][2], o[0][3]); q.z = cvt_pk_bf16(o[1][0], o[1][1]); q.w = cvt_pk_bf16(o[1][2], o[1][3]);
                    *(u32x4*)(HID + (size_t)(u.p3 + r) * FF + col0) = q; } }
    }
};
struct EpiDown {
    static constexpr bool PERM = true;
    bf16* Y; LAS int* mm;
    __device__ __forceinline__ void operator()(const f32x4 (&acc)[2][2][4][2], const GU& u, int wr, int wc, int fr, int fq) const {
        const int e = u.p0, n_e = mm[e], r0 = u.p1 * BM + wr * 64 + fr, col0 = u.p2 * BM + wc * 32 + 8 * fq;
#pragma unroll
        for (int ai = 0; ai < 2; ++ai)
#pragma unroll
            for (int m = 0; m < 4; ++m) { const int r = r0 + ai * HALF + m * 16;
                if (r < n_e) {
#pragma unroll
                    for (int bj = 0; bj < 2; ++bj) { const f32x4 v0 = acc[ai][bj][m][0], v1 = acc[ai][bj][m][1];
                        u32x4 q; q.x = cvt_pk_bf16(v0[0], v0[1]); q.y = cvt_pk_bf16(v0[2], v0[3]); q.z = cvt_pk_bf16(v1[0], v1[1]); q.w = cvt_pk_bf16(v1[2], v1[3]);
                        *(u32x4*)(Y + (size_t)(u.p3 + r) * D + col0 + bj * HALF) = q; } } }
    }
};
}

__device__ __forceinline__ void fast_inproj(Frame& F) {
    pg::DenseSched S{(const char*)(F.ws + WS_WIN), D, T / 256, N_IN / 256, F.G, F.wg, TC / 256, T / 256, 4};
    pg::EpiInProj E{F.ws};
    pg::gemm_phase(F.lds, (const char*)(F.ws + WS_HB), D, S, E);
}
__device__ __forceinline__ void fast_outproj(Frame& F, size_t a_off, size_t w_off, const float* base, float* X, const float* gate, const float* bias) {
    pg::DenseSched S{(const char*)(F.ws + w_off), D, T / 256, D / 256, F.G, F.wg, 0, 0, 0};
    if (XBF16) {
        if (base == X) { pg::EpiResB<true> E{nullptr, (bf16*)(F.ws + WS_XB), gate, bias}; pg::gemm_phase(F.lds, (const char*)(F.ws + a_off), D, S, E); }
        else { pg::EpiResB<false> E{base, (bf16*)(F.ws + WS_XB), gate, bias}; pg::gemm_phase(F.lds, (const char*)(F.ws + a_off), D, S, E); }
    } else { pg::EpiRes E{base, X, gate, bias}; pg::gemm_phase(F.lds, (const char*)(F.ws + a_off), D, S, E); }
}
__device__ __forceinline__ void fast_pw1(Frame& F) {
    pg::DenseSched S{(const char*)(F.ws + WS_WPW1), D, T / 256, 2048 / 256, F.G, F.wg, 0, 0, 0};
    pg::EpiGLU E{(bf16*)(F.ws + WS_U), F.in[I_PW1B]};
    pg::gemm_phase(F.lds, (const char*)(F.ws + WS_HB), D, S, E);
}
__device__ __forceinline__ void fast_moe_gateup(Frame& F, int layer) {
    LAS int* mm = moe_map(F, layer);
    pg::MoeSched<true> S{(const char*)(F.ws + WS_WGU) + (size_t)layer * 16 * 1024 * 1024 * 2, (size_t)1024 * 1024 * 2, D, (const int*)(F.ws + WS_SLOTT) + layer * 16 * CAP, mm, F.G, F.wg};
    pg::EpiGateUp E{(bf16*)(F.ws + WS_HID), (const float*)(F.ws + WS_SLOTW) + layer * 16 * CAP, mm};
    pg::gemm_phase(F.lds, (const char*)(F.ws + WS_HB), D, S, E);
}
__device__ __forceinline__ void fast_moe_down(Frame& F, int layer) {
    LAS int* mm = moe_map(F, layer);
    pg::MoeSched<false> S{(const char*)(F.ws + WS_WDN) + (size_t)layer * 16 * 1024 * 512 * 2, (size_t)1024 * 512 * 2, FF, nullptr, mm, F.G, F.wg};
    pg::EpiDown E{(bf16*)(F.ws + WS_Y), mm};
    pg::gemm_phase(F.lds, (const char*)(F.ws + WS_HID), FF, S, E);
}


struct AttnBlk { const bf16* kp; const bf16* vp; int pitch; int kb; bool valid, masked; };
__device__ __forceinline__ AttnBlk attn_blk(const unsigned char* ws, int bi, int b, int kvh, int qs) {
    AttnBlk a;
    if (bi < 8) { a.kp = (const bf16*)(ws + WS_CK) + (size_t)(b * CL + bi * 32) * 128 + kvh * 64; a.vp = (const bf16*)(ws + WS_CV) + (size_t)(b * 2 + kvh) * 64 * CL + bi * 32; a.pitch = CL; a.kb = 0; a.valid = true; a.masked = false; }
    else { const int kb = qs - 128 + 32 * (bi - 8); a.valid = (kb >= 0 && kb < L); a.kb = kb; a.masked = true; a.pitch = L;
        a.kp = (const bf16*)(ws + WS_K) + (size_t)(b * L + kb) * 128 + kvh * 64; a.vp = (const bf16*)(ws + WS_V) + (size_t)(b * 2 + kvh) * 64 * L + kb; }
    return a;
}
__device__ __forceinline__ void attn_load(const AttnBlk& a, int r, int h, bf16x8 (&kf)[4], u32x4 (&vf)[2][2]) {
    if (a.valid) {
#pragma unroll
        for (int s = 0; s < 4; ++s) kf[s] = *(const bf16x8*)(a.kp + (size_t)r * 128 + 16 * s + 8 * h);
#pragma unroll
        for (int db = 0; db < 2; ++db)
#pragma unroll
            for (int ks = 0; ks < 2; ++ks) { const bf16* vr = a.vp + (size_t)(32 * db + r) * a.pitch + 16 * ks + 4 * h;
                const u32x2 lo = *(const u32x2*)vr, hi = *(const u32x2*)(vr + 8); vf[db][ks] = (u32x4){lo.x, lo.y, hi.x, hi.y}; }
    }
}
__device__ __forceinline__ void attn_compute(const AttnBlk& a, int qs, int r, int h, const bf16x8 (&kf)[4], const u32x4 (&vf)[2][2], const bf16x8 (&qf)[2][4],
                                             f32x16 (&o)[2][2], float (&m)[2], float (&l)[2]) {
    if (!a.valid) return;
#pragma unroll
    for (int nq = 0; nq < 2; ++nq) {
        f32x16 st;
#pragma unroll
        for (int i = 0; i < 16; ++i) st[i] = 0.f;
#pragma unroll
        for (int s = 0; s < 4; ++s) st = __builtin_amdgcn_mfma_f32_32x32x16_bf16(kf[s], qf[nq][s], st, 0, 0, 0);
        float t[16]; float tmax = -INFINITY;
        const int dbase = a.kb - qs - 32 * nq - r + 4 * h;
#pragma unroll
        for (int i = 0; i < 16; ++i) { float v = st[i] * (0.125f * 1.4426950408889634f);
            if (a.masked) { const int df = dbase + (i & 3) + 8 * (i >> 2); v = (df >= -128 && df <= 128) ? v : -INFINITY; }
            t[i] = v; tmax = fmaxf(tmax, v); }
        tmax = fmaxf(tmax, __shfl_xor(tmax, 32));
        const float mn = fmaxf(m[nq], tmax), alpha = __builtin_amdgcn_exp2f(m[nq] - mn); m[nq] = mn;
        float ps = 0.f;
#pragma unroll
        for (int i = 0; i < 16; ++i) { t[i] = __builtin_amdgcn_exp2f(t[i] - mn); ps += t[i]; }
        l[nq] = l[nq] * alpha + ps;
#pragma unroll
        for (int i = 0; i < 16; ++i) { o[0][nq][i] *= alpha; o[1][nq][i] *= alpha; }
        bf16x8 pf[2];
#pragma unroll
        for (int ks = 0; ks < 2; ++ks) { const u32x4 w = {pkbf(t[8 * ks], t[8 * ks + 1]), pkbf(t[8 * ks + 2], t[8 * ks + 3]), pkbf(t[8 * ks + 4], t[8 * ks + 5]), pkbf(t[8 * ks + 6], t[8 * ks + 7])};
            pf[ks] = __builtin_bit_cast(bf16x8, w); }
#pragma unroll
        for (int db = 0; db < 2; ++db)
#pragma unroll
            for (int ks = 0; ks < 2; ++ks) o[db][nq] = __builtin_amdgcn_mfma_f32_32x32x16_bf16(__builtin_bit_cast(bf16x8, vf[db][ks]), pf[ks], o[db][nq], 0, 0, 0);
    }
}
__device__ __forceinline__ void phase_attn_mfma(Frame& F) {
    const bf16* Q = (const bf16*)(F.ws + WS_Q); bf16* MIX = (bf16*)(F.ws + WS_MIX);
    const int g = F.wave >> 1, half = F.wave & 1, r = F.lane & 31, h = F.lane >> 5;
    for (int item = F.wg; item < NB * 2 * 64; item += F.G) {
        const int qb = item & 63, kvh = (item >> 6) & 1, b = item >> 7, hd = kvh * 4 + g, qs = qb * 128 + half * 64;
        bf16x8 qf[2][4];
#pragma unroll
        for (int nq = 0; nq < 2; ++nq)
#pragma unroll
            for (int s = 0; s < 4; ++s) qf[nq][s] = *(const bf16x8*)(Q + (size_t)(b * L + qs + 32 * nq + r) * 512 + hd * 64 + 16 * s + 8 * h);
        f32x16 o[2][2];
#pragma unroll
        for (int db = 0; db < 2; ++db)
#pragma unroll
            for (int nq = 0; nq < 2; ++nq)
#pragma unroll
                for (int i = 0; i < 16; ++i) o[db][nq][i] = 0.f;
        float m[2], l[2];
        m[0] = m[1] = F.in[I_SINK][hd] * 1.4426950408889634f; l[0] = l[1] = (h == 0) ? 1.f : 0.f;
        bf16x8 kfA[4], kfB[4]; u32x4 vfA[2][2], vfB[2][2];
        AttnBlk ba = attn_blk(F.ws, 0, b, kvh, qs), bb;
        attn_load(ba, r, h, kfA, vfA);
#pragma unroll 1
        for (int bi = 0; bi < 18; bi += 2) {
            bb = attn_blk(F.ws, bi + 1, b, kvh, qs); attn_load(bb, r, h, kfB, vfB);
            attn_compute(ba, qs, r, h, kfA, vfA, qf, o, m, l);
            if (bi + 2 < 18) { ba = attn_blk(F.ws, bi + 2, b, kvh, qs); attn_load(ba, r, h, kfA, vfA); }
            attn_compute(bb, qs, r, h, kfB, vfB, qf, o, m, l);
        }
#pragma unroll
        for (int nq = 0; nq < 2; ++nq) {
            const float lt = l[nq] + __shfl_xor(l[nq], 32), il = 1.f / lt;
            bf16* orow = MIX + (size_t)(b * L + qs + 32 * nq + r) * 1024 + 512 + hd * 64;
#pragma unroll
            for (int db = 0; db < 2; ++db)
#pragma unroll
                for (int i4 = 0; i4 < 4; ++i4) { u32x2 w; w.x = pkbf(o[db][nq][4 * i4] * il, o[db][nq][4 * i4 + 1] * il); w.y = pkbf(o[db][nq][4 * i4 + 2] * il, o[db][nq][4 * i4 + 3] * il);
                    *(u32x2*)(orow + 32 * db + 8 * i4 + 4 * h) = w; }
        }
    }
}


__device__ __forceinline__ float half_max(float v) { const auto r = __builtin_amdgcn_permlane32_swap(__float_as_uint(v), __float_as_uint(v), false, false); return fmaxf(__uint_as_float(r[0]), __uint_as_float(r[1])); }
__device__ __forceinline__ float half_sum(float v) { const auto r = __builtin_amdgcn_permlane32_swap(__float_as_uint(v), __float_as_uint(v), false, false); return __uint_as_float(r[0]) + __uint_as_float(r[1]); }
constexpr int AT_KP = 72, AT_VP = 136;
constexpr int AT_KB = 128 * AT_KP * 2, AT_BUF = AT_KB + 64 * AT_VP * 2;
struct AtChunk { const bf16* kg; const bf16* vg; int vpitch, lc, b, kvh, qb, c; bool valid, local, any; };
__device__ __forceinline__ AtChunk at_chunk(const unsigned char* ws, int seq, int wg, int G) {
    AtChunk k; const int item = wg + (seq / 5) * G; k.c = seq % 5; k.any = item < NB * 2 * 64;
    k.qb = item & 63; k.kvh = (item >> 6) & 1; k.b = (item >> 7) & 3; k.local = k.c >= 2; k.lc = k.c - 2;
    if (!k.local) { k.valid = k.any; k.vpitch = CL; k.kg = (const bf16*)(ws + WS_CK) + (size_t)(k.b * CL + 128 * k.c) * 128 + k.kvh * 64; k.vg = (const bf16*)(ws + WS_CV) + (size_t)(k.b * 2 + k.kvh) * 64 * CL + 128 * k.c; }
    else { const int key0 = 128 * k.qb - 128 + 128 * k.lc; k.valid = k.any && key0 >= 0 && key0 < L; k.vpitch = L;
        k.kg = (const bf16*)(ws + WS_K) + (size_t)(k.b * L + key0) * 128 + k.kvh * 64; k.vg = (const bf16*)(ws + WS_V) + (size_t)(k.b * 2 + k.kvh) * 64 * L + key0; }
    return k;
}
__device__ __forceinline__ void at_issue(const AtChunk& k, int tid, u32x4 (&rg)[4]) {
    if (k.valid) {
#pragma unroll
        for (int i = 0; i < 2; ++i) { const int id = tid + 512 * i; rg[i] = *(const u32x4*)(k.kg + (size_t)(id >> 3) * 128 + (id & 7) * 8); }
#pragma unroll
        for (int i = 0; i < 2; ++i) { const int id = tid + 512 * i; rg[2 + i] = *(const u32x4*)(k.vg + (size_t)(id >> 4) * k.vpitch + (id & 15) * 8); }
    }
}
__device__ __forceinline__ void at_write(const AtChunk& k, LAS unsigned char* buf, int tid, const u32x4 (&rg)[4]) {
    if (k.valid) {
#pragma unroll
        for (int i = 0; i < 2; ++i) { const int id = tid + 512 * i; *(LAS u32x4*)(buf + (id >> 3) * (AT_KP * 2) + (id & 7) * 16) = rg[i]; }
#pragma unroll
        for (int i = 0; i < 2; ++i) { const int id = tid + 512 * i; *(LAS u32x4*)(buf + AT_KB + (id >> 4) * (AT_VP * 2) + (id & 15) * 16) = rg[2 + i]; }
    }
}
__device__ __forceinline__ void at_load(LAS unsigned char* buf, int blk, int r, int h, bf16x8 (&kf)[4], u32x4 (&vf)[2][2]) {
#pragma unroll
    for (int s2 = 0; s2 < 4; ++s2) kf[s2] = *(const LAS bf16x8*)(buf + (32 * blk + r) * (AT_KP * 2) + (16 * s2 + 8 * h) * 2);
#pragma unroll
    for (int db = 0; db < 2; ++db)
#pragma unroll
        for (int ks = 0; ks < 2; ++ks) { const LAS unsigned char* vr = buf + AT_KB + (32 * db + r) * (AT_VP * 2) + (32 * blk + 16 * ks + 4 * h) * 2;
            const u32x2 lo = *(const LAS u32x2*)vr, hi = *(const LAS u32x2*)(vr + 16); vf[db][ks] = (u32x4){lo.x, lo.y, hi.x, hi.y}; }
}
__device__ __forceinline__ void at_math(const bf16x8 (&kf)[4], const u32x4 (&vf)[2][2], bool masked, int kbrel, int r, int h, const bf16x8 (&qf)[2][4], f32x16 (&o)[2][2], float (&m)[2], float (&l)[2]) {
    constexpr float C = 0.125f * 1.4426950408889634f;
#pragma unroll
    for (int nq = 0; nq < 2; ++nq) {
        f32x16 st;
#pragma unroll
        for (int i = 0; i < 16; ++i) st[i] = 0.f;
#pragma unroll
        for (int s2 = 0; s2 < 4; ++s2) st = __builtin_amdgcn_mfma_f32_32x32x16_bf16(kf[s2], qf[nq][s2], st, 0, 0, 0);
        if (masked) { const int dbase = kbrel - 32 * nq - r + 4 * h;
#pragma unroll
            for (int i = 0; i < 16; ++i) { const int df = dbase + (i & 3) + 8 * (i >> 2); st[i] = (df >= -128 && df <= 128) ? st[i] : -INFINITY; } }
        float smax = st[0];
#pragma unroll
        for (int i = 1; i < 16; ++i) smax = fmaxf(smax, st[i]);
        smax = half_max(smax);
        const float mn = fmaxf(m[nq], smax * C), alpha = __builtin_amdgcn_exp2f(m[nq] - mn); m[nq] = mn;
        float t[16]; float ps = 0.f;
#pragma unroll
        for (int i = 0; i < 16; ++i) { t[i] = __builtin_amdgcn_exp2f(__builtin_fmaf(st[i], C, -mn)); ps += t[i]; }
        l[nq] = l[nq] * alpha + ps;
        if (__ballot(alpha != 1.f)) {
#pragma unroll
            for (int i = 0; i < 16; ++i) { o[0][nq][i] *= alpha; o[1][nq][i] *= alpha; } }
        bf16x8 pf[2];
#pragma unroll
        for (int ks = 0; ks < 2; ++ks) { const u32x4 w = {pkbf(t[8 * ks], t[8 * ks + 1]), pkbf(t[8 * ks + 2], t[8 * ks + 3]), pkbf(t[8 * ks + 4], t[8 * ks + 5]), pkbf(t[8 * ks + 6], t[8 * ks + 7])};
            pf[ks] = __builtin_bit_cast(bf16x8, w); }
#pragma unroll
        for (int db = 0; db < 2; ++db)
#pragma unroll
            for (int ks = 0; ks < 2; ++ks) o[db][nq] = __builtin_amdgcn_mfma_f32_32x32x16_bf16(__builtin_bit_cast(bf16x8, vf[db][ks]), pf[ks], o[db][nq], 0, 0, 0);
    }
}
__device__ __forceinline__ void phase_attn_lds(Frame& F) {
    const bf16* Q = (const bf16*)(F.ws + WS_Q); bf16* MIX = (bf16*)(F.ws + WS_MIX);
    const int g = F.wave >> 1, half = F.wave & 1, r = F.lane & 31, h = F.lane >> 5;
    __syncthreads();
    u32x4 rg[4];
    AtChunk ck = at_chunk(F.ws, 0, F.wg, F.G);
    if (!ck.any) return;
    at_issue(ck, F.tid, rg); at_write(ck, F.lds, F.tid, rg);
    __syncthreads();
    bf16x8 qf[2][4]; f32x16 o[2][2]; float m[2], l[2];
#pragma unroll 1
    for (int seq = 0; ck.any; ++seq) {
        LAS unsigned char* buf = F.lds + (seq & 1) * AT_BUF;
        const AtChunk nk = at_chunk(F.ws, seq + 1, F.wg, F.G);
        at_issue(nk, F.tid, rg);
        const int hd = ck.kvh * 4 + g, qs = ck.qb * 128 + half * 64;
        if (ck.c == 0) {
#pragma unroll
            for (int nq = 0; nq < 2; ++nq)
#pragma unroll
                for (int s2 = 0; s2 < 4; ++s2) qf[nq][s2] = *(const bf16x8*)(Q + (size_t)(ck.b * L + qs + 32 * nq + r) * 512 + hd * 64 + 16 * s2 + 8 * h);
#pragma unroll
            for (int db = 0; db < 2; ++db)
#pragma unroll
                for (int nq = 0; nq < 2; ++nq)
#pragma unroll
                    for (int i = 0; i < 16; ++i) o[db][nq][i] = 0.f;
            m[0] = m[1] = F.in[I_SINK][hd] * 1.4426950408889634f; l[0] = l[1] = (h == 0) ? 1.f : 0.f;
        }
        if (ck.valid) {
            int b0 = 0, b1 = 4;
            if (ck.local) { b0 = 2 * half - 4 * ck.lc; b0 = b0 < 0 ? 0 : b0; b1 = 2 * half + 10 - 4 * ck.lc; b1 = b1 > 4 ? 4 : b1; }
            if (b0 < b1) {
                bf16x8 kfA[4], kfB[4]; u32x4 vfA[2][2], vfB[2][2];
                at_load(buf, b0, r, h, kfA, vfA);
#pragma unroll 1
                for (int blk = b0; blk < b1; blk += 2) {
                    const int iA = 4 * ck.lc + blk - 2 * half, iB = iA + 1;
                    if (blk + 1 < b1) at_load(buf, blk + 1, r, h, kfB, vfB);
                    at_math(kfA, vfA, ck.local && (iA < 2 || iA > 7), 32 * iA - 128, r, h, qf, o, m, l);
                    if (blk + 1 < b1) {
                        if (blk + 2 < b1) at_load(buf, blk + 2, r, h, kfA, vfA);
                        at_math(kfB, vfB, ck.local && (iB < 2 || iB > 7), 32 * iB - 128, r, h, qf, o, m, l);
                    }
                }
            }
        }
        if (ck.c == 4) {
#pragma unroll
            for (int nq = 0; nq < 2; ++nq) {
                const float lt = half_sum(l[nq]), il = __builtin_amdgcn_rcpf(lt);
                bf16* orow = MIX + (size_t)(ck.b * L + qs + 32 * nq + r) * 1024 + 512 + hd * 64;
#pragma unroll
                for (int db = 0; db < 2; ++db)
#pragma unroll
                    for (int i4 = 0; i4 < 4; ++i4) { u32x2 w; w.x = pkbf(o[db][nq][4 * i4] * il, o[db][nq][4 * i4 + 1] * il); w.y = pkbf(o[db][nq][4 * i4 + 2] * il, o[db][nq][4 * i4 + 3] * il);
                        *(u32x2*)(orow + 32 * db + 8 * i4 + 4 * h) = w; }
            }
        }
        at_write(nk, F.lds + ((seq + 1) & 1) * AT_BUF, F.tid, rg);
        __syncthreads();
        ck = nk;
    }
}

constexpr int F1_PC = 136, F1_PW = 68, F2_P = 264;
constexpr int F1_CSC = 0, F1_CSS = 128 * F1_PC * 2, F1_C64 = 2 * 128 * F1_PC * 2, F1_S64 = F1_C64 + 64 * F1_PW * 2;
__device__ __forceinline__ bf16x8 pack8(float a0, float a1, float a2, float a3, float a4, float a5, float a6, float a7) {
    const u32x4 w = {pkbf(a0, a1), pkbf(a2, a3), pkbf(a4, a5), pkbf(a6, a7)}; return __builtin_bit_cast(bf16x8, w); }
__device__ __forceinline__ void phase_fft1_mfma(Frame& F) {
    __syncthreads();
    LAS bf16* csc = (LAS bf16*)(F.lds + F1_CSC); LAS bf16* css = (LAS bf16*)(F.lds + F1_CSS); LAS bf16* c64 = (LAS bf16*)(F.lds + F1_C64); LAS bf16* s64 = (LAS bf16*)(F.lds + F1_S64);
    for (int i = F.tid; i < 128 * 128; i += NTHR) { const int n = i >> 7, k = i & 127; const float ang = (float)((n * k) & 127) * (6.283185307179586f / 128.f);
        csc[n * F1_PC + k] = (bf16)f2bf(__cosf(ang)); css[n * F1_PC + k] = (bf16)f2bf(__sinf(ang)); }
    for (int i = F.tid; i < 64 * 64; i += NTHR) { const int c = i >> 6, a = i & 63; const float ang = (float)((c * a) & 63) * (6.283185307179586f / 64.f);
        c64[c * F1_PW + a] = (bf16)f2bf(__cosf(ang)); s64[c * F1_PW + a] = (bf16)f2bf(__sinf(ang)); }
    __syncthreads();
    const bf16* UF = (const bf16*)(F.ws + WS_UF); bf16* Gb = (bf16*)(F.ws + WS_G);
    const int r = F.lane & 31, h = F.lane >> 5, g = F.wave >> 1;
    for (int item = F.wg; item < NB * FN2; item += F.G) {
        const int b = item >> 7, bp = item & 127;
#pragma unroll 1
        for (int q = 0; q < 2; ++q) {
            const int cbk = 2 * F.wave + q, n = 32 * (cbk & 3) + r, ch = 32 * cbk + r;
            f32x16 zr[2], zi[2];
#pragma unroll
            for (int rb = 0; rb < 2; ++rb) {
                bf16x8 uf[8];
#pragma unroll
                for (int s2 = 0; s2 < 8; ++s2) uf[s2] = *(const bf16x8*)(UF + (size_t)(b * L + 128 * (32 * rb + r) + bp) * 512 + g * 128 + 16 * s2 + 8 * h);
#pragma unroll
                for (int i = 0; i < 16; ++i) { zr[rb][i] = 0.f; zi[rb][i] = 0.f; }
#pragma unroll
                for (int s2 = 0; s2 < 8; ++s2) { const bf16x8 bc = *(const LAS bf16x8*)(csc + n * F1_PC + 16 * s2 + 8 * h), bs = *(const LAS bf16x8*)(css + n * F1_PC + 16 * s2 + 8 * h);
                    zr[rb] = __builtin_amdgcn_mfma_f32_32x32x16_bf16(uf[s2], bc, zr[rb], 0, 0, 0); zi[rb] = __builtin_amdgcn_mfma_f32_32x32x16_bf16(uf[s2], bs, zi[rb], 0, 0, 0); }
                __builtin_amdgcn_sched_barrier(0);
            }
            bf16x8 zfr[4], zfi[4];
#pragma unroll
            for (int ks = 0; ks < 4; ++ks) { const int rb = ks >> 1, o = 8 * (ks & 1);
                zfr[ks] = pack8(zr[rb][o], zr[rb][o + 1], zr[rb][o + 2], zr[rb][o + 3], zr[rb][o + 4], zr[rb][o + 5], zr[rb][o + 6], zr[rb][o + 7]);
                zfi[ks] = pack8(-zi[rb][o], -zi[rb][o + 1], -zi[rb][o + 2], -zi[rb][o + 3], -zi[rb][o + 4], -zi[rb][o + 5], -zi[rb][o + 6], -zi[rb][o + 7]); }
            __builtin_amdgcn_sched_barrier(0);
#pragma unroll 1
            for (int rbc = 0; rbc < 2; ++rbc) {
                f32x16 gr, gi; const int cr = 32 * rbc + r;
#pragma unroll
                for (int i = 0; i < 16; ++i) { gr[i] = 0.f; gi[i] = 0.f; }
#pragma unroll
                for (int ks = 0; ks < 4; ++ks) {
                    const u32x2 cl = *(const LAS u32x2*)(c64 + cr * F1_PW + 16 * ks + 4 * h), chh = *(const LAS u32x2*)(c64 + cr * F1_PW + 16 * ks + 8 + 4 * h);
                    const u32x2 sl = *(const LAS u32x2*)(s64 + cr * F1_PW + 16 * ks + 4 * h), shh = *(const LAS u32x2*)(s64 + cr * F1_PW + 16 * ks + 8 + 4 * h);
                    const u32x4 sw = {sl.x, sl.y, shh.x, shh.y}; const u32x4 swn = sw ^ 0x80008000u;
                    const bf16x8 wc = __builtin_bit_cast(bf16x8, ((u32x4){cl.x, cl.y, chh.x, chh.y})), wsn = __builtin_bit_cast(bf16x8, sw), wsm = __builtin_bit_cast(bf16x8, swn);
                    gr = __builtin_amdgcn_mfma_f32_32x32x16_bf16(wc, zfr[ks], gr, 0, 0, 0); gr = __builtin_amdgcn_mfma_f32_32x32x16_bf16(wsn, zfi[ks], gr, 0, 0, 0);
                    gi = __builtin_amdgcn_mfma_f32_32x32x16_bf16(wc, zfi[ks], gi, 0, 0, 0); gi = __builtin_amdgcn_mfma_f32_32x32x16_bf16(wsm, zfr[ks], gi, 0, 0, 0); }
                __builtin_amdgcn_sched_barrier(0);
#pragma unroll
                for (int i = 0; i < 16; ++i) { const int c = 32 * rbc + crow(i, h); const float ang = (float)(bp * c) * (6.283185307179586f / 8192.f), cs = __cosf(ang), sn = __sinf(ang);
                    const float re = gr[i] * cs + gi[i] * sn, im = gi[i] * cs - gr[i] * sn;
                    bf16* o = Gb + (size_t)((b * FN1 + c) * FN2 + bp) * 1024 + ch; o[0] = (bf16)f2bf(re); o[512] = (bf16)f2bf(im);
                    if ((i & 3) == 3) __builtin_amdgcn_sched_barrier(0); }
            }
        }
    }
    __syncthreads();
}
__device__ __forceinline__ void phase_fft2_mfma(Frame& F) {
    __syncthreads();
    LAS bf16* t2 = (LAS bf16*)F.lds;
    for (int i = F.tid; i < 128 * 256; i += NTHR) { const int d = i >> 8, k = i & 255; const float ang = (float)((d * (k & 127)) & 127) * (6.283185307179586f / 128.f);
        t2[d * F2_P + k] = (bf16)f2bf(k < 128 ? __cosf(ang) : __sinf(ang)); }
    __syncthreads();
    const bf16* Gb = (const bf16*)(F.ws + WS_G); bf16* MIX = (bf16*)(F.ws + WS_MIX);
    const int r = F.lane & 31, h = F.lane >> 5;
    for (int item = F.wg; item < NB * FN1; item += F.G) {
        const int b = item >> 6, c = item & 63;
        const bf16* Gp = Gb + (size_t)((b * FN1 + c) * FN2) * 1024 + 64 * F.wave + r;
        f32x16 y[4][2];
#pragma unroll
        for (int rb = 0; rb < 4; ++rb)
#pragma unroll
            for (int cb = 0; cb < 2; ++cb)
#pragma unroll
                for (int i = 0; i < 16; ++i) y[rb][cb][i] = 0.f;
        unsigned eA[2][8], eB[2][8];
#define F2_GATHER(dst, ks_) do { const bf16* p_ = Gp + (size_t)(16 * ((ks_) & 7) + 8 * h) * 1024 + ((ks_) >> 3) * 512; \
            _Pragma("unroll") for (int cb = 0; cb < 2; ++cb) _Pragma("unroll") for (int j = 0; j < 8; ++j) dst[cb][j] = p_[(size_t)j * 1024 + 32 * cb]; } while (0)
#define F2_MMA(src, ks_) do { bf16x8 bfr[2]; _Pragma("unroll") for (int cb = 0; cb < 2; ++cb) { \
                const u32x4 w = {src[cb][0] | (src[cb][1] << 16), src[cb][2] | (src[cb][3] << 16), src[cb][4] | (src[cb][5] << 16), src[cb][6] | (src[cb][7] << 16)}; bfr[cb] = __builtin_bit_cast(bf16x8, w); } \
            _Pragma("unroll") for (int rb = 0; rb < 4; ++rb) { const bf16x8 a = *(const LAS bf16x8*)(t2 + (32 * rb + r) * F2_P + 16 * (ks_) + 8 * h); \
                _Pragma("unroll") for (int cb = 0; cb < 2; ++cb) y[rb][cb] = __builtin_amdgcn_mfma_f32_32x32x16_bf16(a, bfr[cb], y[rb][cb], 0, 0, 0); } } while (0)
        F2_GATHER(eA, 0);
#pragma unroll 1
        for (int ks = 0; ks < 16; ks += 2) {
            F2_GATHER(eB, ks + 1);
            F2_MMA(eA, ks);
            if (ks + 2 < 16) F2_GATHER(eA, ks + 2);
            F2_MMA(eB, ks + 1);
        }
#undef F2_GATHER
#undef F2_MMA
#pragma unroll
        for (int rb = 0; rb < 4; ++rb)
#pragma unroll
            for (int cb = 0; cb < 2; ++cb)
#pragma unroll
                for (int i = 0; i < 16; ++i) { const int d = 32 * rb + crow(i, h); MIX[(size_t)(b * L + c + 64 * d) * 1024 + 64 * F.wave + 32 * cb + r] = (bf16)f2bf(y[rb][cb][i] * (1.f / 1024.f)); }
    }
    __syncthreads();
}


typedef float f32x2_t __attribute__((ext_vector_type(2)));
template <int IR> struct DwIn {
    static __device__ __forceinline__ void run(const unsigned (&uin)[62], const f32x2_t (&w)[31], f32x2_t (&o)[32]) {
        const f32x2_t x = {bflo(uin[IR]), bfhi(uin[IR])};
#pragma unroll
        for (int r = 0; r < 32; ++r) { if (IR - r >= 0 && IR - r <= 30) o[r] += w[(IR - r >= 0 && IR - r <= 30) ? IR - r : 0] * x; }
        DwIn<IR + 1>::run(uin, w, o);
    }
};
template <> struct DwIn<62> { static __device__ __forceinline__ void run(const unsigned (&)[62], const f32x2_t (&)[31], f32x2_t (&)[32]) {} };
template <int IR> struct DwIn16 {
    static __device__ __forceinline__ void run(const unsigned (&uin)[46], const f32x2_t (&w)[31], f32x2_t (&o)[16]) {
        const f32x2_t x = {bflo(uin[IR]), bfhi(uin[IR])};
#pragma unroll
        for (int r = 0; r < 16; ++r) { if (IR - r >= 0 && IR - r <= 30) o[r] += w[(IR - r >= 0 && IR - r <= 30) ? IR - r : 0] * x; }
        DwIn16<IR + 1>::run(uin, w, o);
    }
};
template <> struct DwIn16<46> { static __device__ __forceinline__ void run(const unsigned (&)[46], const f32x2_t (&)[31], f32x2_t (&)[16]) {} };
__device__ __forceinline__ void phase_dwconv_fast(Frame& F) {
    const bf16* U = (const bf16*)(F.ws + WS_U); bf16* V1 = (bf16*)(F.ws + WS_V1);
    const float* dww = F.in[I_DWW];
    const int c0 = 2 * F.tid;
    f32x2_t w[31];
#pragma unroll
    for (int j = 0; j < 31; ++j) w[j] = *(const f32x2_t*)(dww + (size_t)j * D + c0);
    const f32x2_t bb = *(const f32x2_t*)(F.in[I_DWB] + c0), gg = *(const f32x2_t*)(F.in[I_LNG] + c0), lb = *(const f32x2_t*)(F.in[I_LNB] + c0);
    LAS float* red = (LAS float*)F.lds;
    LAS float* stat = red + 16 * 8 * 2;
    __syncthreads();
    for (int run = F.wg; run < T / 128; run += F.G) {
        const int row0 = run * 128, l0 = row0 & (L - 1);
        unsigned uin[46], nx[16];
#pragma unroll
        for (int ir = 0; ir < 46; ++ir) { const int l = l0 - 15 + ir; const bool ok = (l >= 0 && l < L);
            const unsigned u = *(const unsigned*)(U + (size_t)(ok ? row0 - 15 + ir : row0) * D + c0); uin[ir] = ok ? u : 0u; }
#pragma unroll 1
        for (int step = 0; step < 8; ++step) {
            const int r0 = row0 + 16 * step;
            if (step < 7) {
#pragma unroll
                for (int j = 0; j < 16; ++j) { const int l = l0 + 16 * step + 31 + j; const bool ok = l < L;
                    const unsigned u = *(const unsigned*)(U + (size_t)(ok ? r0 + 31 + j : r0) * D + c0); nx[j] = ok ? u : 0u; }
            }
            f32x2_t o[16];
#pragma unroll
            for (int r = 0; r < 16; ++r) o[r] = bb;
            DwIn16<0>::run(uin, w, o);
#pragma unroll
            for (int r = 0; r < 16; ++r) { const float sm = wave_sum(o[r].x + o[r].y), sq = wave_sum(o[r].x * o[r].x + o[r].y * o[r].y);
                if (F.lane == 0) { red[(r * 8 + F.wave) * 2] = sm; red[(r * 8 + F.wave) * 2 + 1] = sq; } }
            __syncthreads();
            if (F.tid < 16) { float sm = 0.f, sq = 0.f;
#pragma unroll
                for (int wv = 0; wv < 8; ++wv) { sm += red[(F.tid * 8 + wv) * 2]; sq += red[(F.tid * 8 + wv) * 2 + 1]; }
                const float mean = sm * (1.f / D), var = fmaxf(sq * (1.f / D) - mean * mean, 0.f);
                stat[2 * F.tid] = mean; stat[2 * F.tid + 1] = rsqrtf(var + EPS); }
            __syncthreads();
#pragma unroll
            for (int r = 0; r < 16; ++r) { const float mean = stat[2 * r], rstd = stat[2 * r + 1];
                const float y0 = silu_f((o[r].x - mean) * rstd * gg.x + lb.x), y1 = silu_f((o[r].y - mean) * rstd * gg.y + lb.y);
                *(unsigned*)(V1 + (size_t)(r0 + r) * D + c0) = pkbf(y0, y1); }
#pragma unroll
            for (int i = 0; i < 30; ++i) uin[i] = uin[i + 16];
#pragma unroll
            for (int j = 0; j < 16; ++j) uin[30 + j] = nx[j];
        }
        __syncthreads();
    }
}

namespace pg {
struct MU { const char* B; const char* A; int K, type, e, rt, pn, hb, buf; };
struct MoeMergedSched {
    const char* Wgu; const char* Wdn; const char* HBp; const char* HIDp; const int* list; const float* wlist; LAS int* mm; unsigned* tcnt; unsigned* tmo; int G, c, U;
    __device__ __forceinline__ bool flat(int L, int type, MU& u) const {
        for (int e = 0; e < 16; ++e) { const int n = mm[e], nu = ((n + 255) >> 8) * 4;
            if (L < nu) { u.e = e; u.rt = L >> 2; u.pn = L & 3; u.hb = mm[16 + e]; u.type = type; u.buf = 0;
                if (type == 0) { u.K = D; u.A = HBp; u.B = Wgu + (size_t)e * (1024 * 1024 * 2) + (size_t)u.pn * BM * D * 2; }
                else { u.K = FF; u.A = HIDp; u.B = Wdn + (size_t)e * (1024 * 512 * 2) + (size_t)u.pn * BM * FF * 2; }
                return true; }
            L -= nu; }
        return false;
    }
    __device__ __forceinline__ bool next(int i, MU& u) const {
        const int ngu = c < U ? (U - 1 - c) / G + 1 : 0;
        if (i < ngu) return flat(i * G + c, 0, u);
        const int k = i - ngu, x = U % G; int j;
        if (c >= x) { if (k == 0) j = c - x; else j = (G - 1 - c) + (k - 1) * G + (G - x); } else j = (G - 1 - c) + k * G + (G - x);
        if (j >= U) return false;
        return flat(j, 1, u);
    }
    __device__ __forceinline__ unsigned voff(const MU& u, int buf, LAS unsigned char* lds, int R, int C) const {
        if (u.type == 0) { const int tok = ((const LAS int*)(lds + TAB_OFF))[buf * 256 + R]; return (unsigned)((tok * D + C) * 2); }
        return (unsigned)(((u.hb + u.rt * BM + R) * FF + C) * 2);
    }
    __device__ __forceinline__ void stage_table(const MU& u, int buf, LAS unsigned char* lds, int wid, int lane) const {
        const int r = (wid & 3) * 64 + lane;
        __builtin_amdgcn_global_load_lds((const unsigned*)(list + u.e * CAP + u.rt * BM + r), (LAS unsigned*)(lds + TAB_OFF + buf * 1024 + (wid & 3) * 256), 4, 0, 0);
        __builtin_amdgcn_global_load_lds((const unsigned*)(wlist + u.e * CAP + u.rt * BM + r), (LAS unsigned*)(lds + TAB_OFF + 2048 + buf * 1024 + (wid & 3) * 256), 4, 0, 0);
    }
    __device__ __forceinline__ unsigned* tile_word(const MU& u) const { return tcnt + ((u.hb >> 8) + u.rt) * 64; }
    __device__ __forceinline__ void wait_ready(const MU& u, int wid) const {
        if (wid == 0) {
            unsigned* w = tile_word(u); unsigned spins = 0;
            while ((unsigned)__builtin_amdgcn_readfirstlane(__hip_atomic_load(w, __ATOMIC_RELAXED, __HIP_MEMORY_SCOPE_AGENT)) < 32u) {
                __builtin_amdgcn_s_sleep(2);
                if ((++spins & 255u) == 0u) { if (__builtin_amdgcn_readfirstlane(__hip_atomic_load(tmo, __ATOMIC_RELAXED, __HIP_MEMORY_SCOPE_AGENT)) != 0u) break;
                    if (spins > (1u << 20)) { __hip_atomic_store(tmo, 1u, __ATOMIC_RELAXED, __HIP_MEMORY_SCOPE_AGENT); break; } } }
        }
        asm volatile("" ::: "memory"); __builtin_amdgcn_s_barrier(); asm volatile("" ::: "memory");
    }
};
struct EpiGateUpWT {
    __amdgpu_buffer_rsrc_t rsrc; LAS unsigned char* lds; LAS int* mm;
    __device__ __forceinline__ void operator()(const f32x4 (&acc)[2][2][4][2], const MU& u, int wr, int wc, int fr, int fq) const {
        const int e = u.e, n_e = mm[e], r0 = u.rt * BM + wr * 64 + fr, col0 = u.pn * HALF + wc * 32 + 8 * fq;
        float wv[2][4];
#pragma unroll
        for (int ai = 0; ai < 2; ++ai)
#pragma unroll
            for (int m = 0; m < 4; ++m) wv[ai][m] = ((const LAS float*)(lds + TAB_OFF + 2048))[u.buf * 256 + wr * 64 + fr + ai * HALF + m * 16];
#pragma unroll
        for (int ai = 0; ai < 2; ++ai)
#pragma unroll
            for (int m = 0; m < 4; ++m) { const int r = r0 + ai * HALF + m * 16;
                if (r < n_e) { const float w = wv[ai][m]; f32x4 o[2];
#pragma unroll
                    for (int n = 0; n < 2; ++n) { const f32x4 g = acc[ai][0][m][n], up = acc[ai][1][m][n];
#pragma unroll
                        for (int j = 0; j < 4; ++j) o[n][j] = w * silu_f(g[j]) * up[j]; }
                    u32x4 q; q.x = cvt_pk_bf16(o[0][0], o[0][1]); q.y = cvt_pk_bf16(o[0][2], o[0][3]); q.z = cvt_pk_bf16(o[1][0], o[1][1]); q.w = cvt_pk_bf16(o[1][2], o[1][3]);
                    __builtin_amdgcn_raw_buffer_store_b128(q, rsrc, (unsigned)(((u.hb + r) * FF + col0) * 2), 0, 16); } }
    }
};
struct EpiDownM {
    unsigned char* Y8; LAS int* mm;
    __device__ __forceinline__ void operator()(const f32x4 (&acc)[2][2][4][2], const MU& u, int wr, int wc, int fr, int fq) const {
        const int e = u.e, n_e = mm[e], r0 = u.rt * BM + wr * 64 + fr, col0 = u.pn * BM + 64 * wc + 16 * fq;
#pragma unroll
        for (int ai = 0; ai < 2; ++ai)
#pragma unroll
            for (int m = 0; m < 4; ++m) { const int r = r0 + ai * HALF + m * 16;
                if (r < n_e) { u32x4 q; q.x = pk_fp8x4(acc[ai][0][m][0]); q.y = pk_fp8x4(acc[ai][0][m][1]); q.z = pk_fp8x4(acc[ai][1][m][0]); q.w = pk_fp8x4(acc[ai][1][m][1]);
                    *(u32x4*)(Y8 + (size_t)(u.hb + r) * D + col0) = q; } }
    }
};
__device__ __forceinline__ void gemm_phase_moe(LAS unsigned char* lds, const MoeMergedSched& S, const EpiGateUpWT& EA, const EpiDownM& EB) {
    const int tid = threadIdx.x, wid = __builtin_amdgcn_readfirstlane(tid >> 6), lane = tid & 63, wr = wid >> 2, wc = wid & 3, fr = lane & 15, fq = lane >> 4;
    int sR[2], sC[2]; unsigned vbA[2], vbD[2];
#pragma unroll
    for (int i = 0; i < 2; ++i) { int R, C; stage_rc(tid * 16 + i * 8192, R, C); sR[i] = R; sC[i] = C; const int Rb = (R & ~31) + perm32(R & 31);
        const int RbD = 64 * ((Rb >> 5) & 3) + 16 * ((Rb >> 3) & 3) + (Rb & 7);
        vbA[i] = (unsigned)(Rb * D + C) * 2u; vbD[i] = (unsigned)(RbD * FF + C) * 2u; }
    const size_t kstep = (size_t)(BK * 2);
    const unsigned ldsw = (unsigned)wid * 1024u;
    const int aoff = lds_byte(wr * 64 + fr, fq * 8), boff = lds_byte(wc * 32 + fr, fq * 8);
#define PG_SA(b, h) (((b) * 2 + (h)) * HTB)
#define PG_SB(b, h) ((4 + (b) * 2 + (h)) * HTB)
#define PG_STAGE(bufoff, gbase, voff) do { _Pragma("unroll") for (int _i = 0; _i < 2; ++_i) \
        __builtin_amdgcn_global_load_lds((const unsigned*)((const char*)(gbase) + (voff)[_i]), (LAS unsigned*)(lds + (bufoff) + ldsw + _i * 8192), 16, 0, 0); } while (0)
#define PG_LDA(dst, b, h) do { _Pragma("unroll") for (int m = 0; m < 4; ++m) _Pragma("unroll") for (int k = 0; k < 2; ++k) dst[m][k] = *(const LAS bf16x8*)(lds + PG_SA(b, h) + aoff + m * 2048 + k * 1024); } while (0)
#define PG_LDB(dst, b, h) do { _Pragma("unroll") for (int n = 0; n < 2; ++n) _Pragma("unroll") for (int k = 0; k < 2; ++k) dst[n][k] = *(const LAS bf16x8*)(lds + PG_SB(b, h) + boff + n * 2048 + k * 1024); } while (0)
#define PG_MMA(ai, bj, At, Bt) do { __builtin_amdgcn_s_setprio(1); _Pragma("unroll") for (int m = 0; m < 4; ++m) _Pragma("unroll") for (int n = 0; n < 2; ++n) _Pragma("unroll") for (int k = 0; k < 2; ++k) \
        acc[ai][bj][m][n] = __builtin_amdgcn_mfma_f32_16x16x32_bf16(Bt[n][k], At[m][k], acc[ai][bj][m][n], 0, 0, 0); __builtin_amdgcn_s_setprio(0); } while (0)
#define PG_WAIT_V(n) asm volatile("s_waitcnt vmcnt(" #n ")" ::: "memory")
#define PG_WAIT_L(n) asm volatile("s_waitcnt lgkmcnt(" #n ")" ::: "memory")
#define PG_BAR __builtin_amdgcn_s_barrier()
#define PG_SCHED __builtin_amdgcn_sched_barrier(0)
    MU cur, nxt; int ui = 0;
    if (!S.next(0, cur)) return;
    cur.buf = 0;
    f32x4 acc[2][2][4][2];
#pragma unroll
    for (int a = 0; a < 2; ++a)
#pragma unroll
        for (int b = 0; b < 2; ++b)
#pragma unroll
            for (int m = 0; m < 4; ++m)
#pragma unroll
                for (int n = 0; n < 2; ++n) acc[a][b][m][n] = (f32x4){0.f, 0.f, 0.f, 0.f};
    bf16x8 At[4][2], B0[2][2], B1[2][2];
    if (cur.type == 0) { S.stage_table(cur, 0, lds, wid, lane); PG_WAIT_V(0); PG_BAR; } else S.wait_ready(cur, wid);
    unsigned voC[2][2], voN[2][2];
#pragma unroll
    for (int h = 0; h < 2; ++h)
#pragma unroll
        for (int i = 0; i < 2; ++i) { voC[h][i] = S.voff(cur, 0, lds, h * HALF + sR[i], sC[i]); voN[h][i] = voC[h][i]; }
    const char* cB = cur.B; const char* cA = cur.A; size_t hsC = (size_t)(cur.type == 0 ? HALF : 8) * cur.K * 2; int nt = cur.K / BK;
    if (cur.type == 0) { PG_STAGE(PG_SB(0, 0), cB, vbA); PG_STAGE(PG_SB(0, 1), cB + hsC, vbA); } else { PG_STAGE(PG_SB(0, 0), cB, vbD); PG_STAGE(PG_SB(0, 1), cB + hsC, vbD); }
    PG_STAGE(PG_SA(0, 0), cA, voC[0]); PG_STAGE(PG_SA(0, 1), cA, voC[1]);
    if (wr == 1) PG_BAR;
    PG_WAIT_V(2); PG_BAR;
    if (cur.type == 0) { PG_STAGE(PG_SB(1, 0), cB + kstep, vbA); } else { PG_STAGE(PG_SB(1, 0), cB + kstep, vbD); }
    PG_STAGE(PG_SA(1, 0), cA + kstep, voC[0]);
    if (cur.type == 0) { PG_STAGE(PG_SB(1, 1), cB + hsC + kstep, vbA); } else { PG_STAGE(PG_SB(1, 1), cB + hsC + kstep, vbD); }
    PG_WAIT_V(6); PG_BAR;
    for (;;) {
        const bool has_next = S.next(ui + 1, nxt); nxt.buf = (ui + 1) & 1;
        if (has_next && nxt.type == 0) S.stage_table(nxt, (ui + 1) & 1, lds, wid, lane);
        const char* nB = has_next ? nxt.B : cB; const char* nA = has_next ? nxt.A : cA; const size_t hsN = has_next ? (size_t)(nxt.type == 0 ? HALF : 8) * nxt.K * 2 : hsC;
        for (int t = 0; t < nt; t += 2) {
            const bool last = (t == nt - 2);
            if (last && has_next) {
                if (nxt.type == 1) S.wait_ready(nxt, wid);
#pragma unroll
                for (int h = 0; h < 2; ++h)
#pragma unroll
                    for (int i = 0; i < 2; ++i) voN[h][i] = S.voff(nxt, (ui + 1) & 1, lds, h * HALF + sR[i], sC[i]);
            }
            unsigned vo2[2][2], vb2[2]; const bool b2gu = last ? (has_next ? nxt.type == 0 : cur.type == 0) : (cur.type == 0);
#pragma unroll
            for (int h = 0; h < 2; ++h)
#pragma unroll
                for (int i = 0; i < 2; ++i) vo2[h][i] = last ? voN[h][i] : voC[h][i];
#pragma unroll
            for (int i = 0; i < 2; ++i) vb2[i] = b2gu ? vbA[i] : vbD[i];
            const size_t hs2 = last ? hsN : hsC;
            const char* a1 = cA + (size_t)(t + 1) * kstep;
            const char* a2 = last ? nA : cA + (size_t)(t + 2) * kstep; const char* b2 = last ? nB : cB + (size_t)(t + 2) * kstep;
            const char* a3 = a2 + kstep; const char* b3 = b2 + kstep;
            PG_LDB(B0, 0, 0); PG_LDB(B1, 0, 1); PG_SCHED; PG_LDA(At, 0, 0); PG_STAGE(PG_SA(1, 1), a1, voC[1]);
            PG_WAIT_V(8); PG_WAIT_L(0); PG_BAR; PG_MMA(0, 0, At, B0); PG_MMA(0, 1, At, B1); PG_BAR; PG_SCHED;
            PG_LDA(At, 0, 1); PG_STAGE(PG_SB(0, 0), b2, vb2); PG_STAGE(PG_SB(0, 1), b2 + hs2, vb2); PG_STAGE(PG_SA(0, 0), a2, vo2[0]);
            PG_WAIT_V(8); PG_WAIT_L(0); PG_BAR; PG_MMA(1, 0, At, B0); PG_MMA(1, 1, At, B1); PG_BAR; PG_SCHED;
            PG_LDB(B0, 1, 0); PG_LDB(B1, 1, 1); PG_SCHED; PG_LDA(At, 1, 0); PG_STAGE(PG_SA(0, 1), a2, vo2[1]);
            PG_WAIT_V(8); PG_WAIT_L(0); PG_BAR; PG_MMA(0, 0, At, B0); PG_MMA(0, 1, At, B1); PG_BAR; PG_SCHED;
            PG_LDA(At, 1, 1); PG_STAGE(PG_SB(1, 0), b3, vb2); PG_STAGE(PG_SB(1, 1), b3 + hs2, vb2); PG_STAGE(PG_SA(1, 0), a3, vo2[0]);
            PG_WAIT_V(8); PG_WAIT_L(0); PG_BAR; PG_MMA(1, 0, At, B0); PG_MMA(1, 1, At, B1); PG_BAR; PG_SCHED;
        }
        if (wr == 0) PG_BAR;
        if (cur.type == 0) { EA(acc, cur, wr, wc, fr, fq);
            PG_WAIT_V(0);
            if (lane == 0) __hip_atomic_fetch_add(S.tile_word(cur), 1u, __ATOMIC_RELAXED, __HIP_MEMORY_SCOPE_AGENT); }
        else EB(acc, cur, wr, wc, fr, fq);
        if (!has_next) break;
#pragma unroll
        for (int a = 0; a < 2; ++a)
#pragma unroll
            for (int b = 0; b < 2; ++b)
#pragma unroll
                for (int m = 0; m < 4; ++m)
#pragma unroll
                    for (int n = 0; n < 2; ++n) acc[a][b][m][n] = (f32x4){0.f, 0.f, 0.f, 0.f};
        cur = nxt; cB = nB; cA = nA; hsC = hsN; nt = cur.K / BK; ++ui;
#pragma unroll
        for (int h = 0; h < 2; ++h)
#pragma unroll
            for (int i = 0; i < 2; ++i) voC[h][i] = voN[h][i];
        if (wr == 1) PG_BAR;
    }
    PG_WAIT_V(0);
    PG_BAR;
#undef PG_SA
#undef PG_SB
#undef PG_STAGE
#undef PG_LDA
#undef PG_LDB
#undef PG_MMA
#undef PG_WAIT_V
#undef PG_WAIT_L
#undef PG_BAR
#undef PG_SCHED
}
}
__device__ __forceinline__ void fast_moe_merged(Frame& F, int layer) {
    LAS int* mm = moe_map(F, layer);
    int U = 0;
    for (int e = 0; e < 16; ++e) U += ((mm[e] + 255) >> 8) * 4;
    pg::MoeMergedSched S{(const char*)(F.ws + WS_WGU) + (size_t)layer * 16 * 1024 * 1024 * 2, (const char*)(F.ws + WS_WDN) + (size_t)layer * 16 * 1024 * 512 * 2,
                         (const char*)(F.ws + WS_HB), (const char*)(F.ws + WS_HID), (const int*)(F.ws + WS_SLOTT) + layer * 16 * CAP, (const float*)(F.ws + WS_SLOTW) + layer * 16 * CAP, mm,
                         F.ctl + CW_TILE + layer * 288 * 64, F.ctl + CW_TMO2, F.G, F.wg, U};
    pg::EpiGateUpWT EA{__builtin_amdgcn_make_buffer_rsrc((void*)(F.ws + WS_HID), 0, HROWS * FF * 2, 0x00020000), F.lds, mm};
    pg::EpiDownM EB{(unsigned char*)(F.ws + WS_Y), mm};
    pg::gemm_phase_moe(F.lds, S, EA, EB);
}

constexpr int NPH = 18;
__global__ void __launch_bounds__(NTHR, 2) mega(Args args) {
    extern __shared__ __attribute__((aligned(16))) unsigned char lds[];
    Frame F;
    F.lds = (LAS unsigned char*)lds;
    F.tid = threadIdx.x; F.lane = F.tid & 63; F.wave = __builtin_amdgcn_readfirstlane(F.tid >> 6);
    F.G = gridDim.x; F.wg = blockIdx.x;
    F.out = args.out; F.ws = args.ws; F.ctl = (unsigned*)(args.ws + WS_CTL);
    volatile LAS unsigned* bst = (volatile LAS unsigned*)(F.lds + LDS_BYTES - 16);
    if (F.tid < 4) bst[F.tid] = 0u;
    __syncthreads();
    const int lo = args.ph_lo, hi = args.ph_hi;
    XcdBarrier bar; bar.bar = F.ctl + CW_BAR; bar.x = 0; bar.st = bst;
    if (hi - lo > 1) bar = xcd_barrier_post(F.ctl + CW_BAR, bst);
#define IN(k) (lo <= (k) && (k) < hi)
#define SEAM(k) do { if (IN(k) && IN((k) + 1)) xcd_barrier(bar); } while (0)
    const float* mod = (const float*)(F.ws + WS_MOD);

#ifndef DBL_MASK
#define DBL_MASK 0x0u
#endif
#define RUN(k, body) do { if (IN(k)) { _Pragma("unroll 1") for (int _r = 0; _r < ((((DBL_MASK) >> (k)) & 1u) ? 2 : 1); ++_r) { if (_r) xcd_barrier(bar); F.lane = fresh_lane(); body; } } } while (0)
    RUN(0, phase_prep(F)); SEAM(0);
    RUN(1, phase_norm1_l0(F)); SEAM(1);
    RUN(2, if (FAST_GEMM) fast_inproj(F); else phase_inproj(F)); SEAM(2);
    if (IN(3)) { F.lane = fresh_lane();
#pragma unroll 1
        for (int _r = 0; _r < ((DBL_MASK & 0x100000u) ? 2 : 1); ++_r) { if (FAST_ATTN == 2 && FAST_GEMM) phase_attn_lds(F); else if (FAST_ATTN && FAST_GEMM) phase_attn_mfma(F); else phase_attn_simple(F); }
#pragma unroll 1
        for (int _r = 0; _r < ((DBL_MASK & 0x200000u) ? 2 : 1); ++_r) { if (FAST_FFT) phase_fft1_mfma(F); else phase_fft1_simple(F); }
    } SEAM(3);
    RUN(4, if (FAST_FFT) phase_fft2_mfma(F); else phase_fft2_simple(F)); SEAM(4);
    if (IN(5)) { if (!FAST_FFT) phase_fft3_simple(F); } if (!FAST_FFT) SEAM(5);
    RUN(6, if (FAST_GEMM) fast_outproj(F, WS_MIX, WS_WOUT, F.in[I_X], F.out, mod + 2048, nullptr); else phase_outproj(F, (const bf16*)(F.ws + WS_MIX), (const bf16*)(F.ws + WS_WOUT), F.in[I_X], F.out, mod + 2048, nullptr)); SEAM(6);
    if (IN(7)) { F.lane = fresh_lane(); if (XBF16) phase_norm2_route_mfma(F, 0); else phase_norm2_route(F, 0); } SEAM(7);
    if (MOE_MERGED && FAST_GEMM) { if (IN(8)) { F.lane = fresh_lane(); fast_moe_merged(F, 0); } if (IN(8) && IN(10)) xcd_barrier(bar); }
    else { RUN(8, if (FAST_GEMM) fast_moe_gateup(F, 0); else phase_moe_gateup(F, 0)); SEAM(8);
    RUN(9, if (FAST_GEMM) fast_moe_down(F, 0); else phase_moe_down(F, 0)); SEAM(9); }
    if (IN(10)) { F.lane = fresh_lane(); phase_combine<false>(F, 0); } SEAM(10);
    RUN(11, if (FAST_GEMM) fast_pw1(F); else phase_pw1(F)); SEAM(11);
    RUN(12, phase_dwconv_fast(F)); SEAM(12);
    if (IN(13)) { F.lane = fresh_lane(); if (FAST_GEMM) fast_outproj(F, WS_V1, WS_WPW2, F.out, F.out, mod + 5 * 6144 + 2048, F.in[I_PW2B]); else phase_outproj(F, (const bf16*)(F.ws + WS_V1), (const bf16*)(F.ws + WS_WPW2), F.out, F.out, mod + 5 * 6144 + 2048, F.in[I_PW2B]); } SEAM(13);
    if (IN(14)) { F.lane = fresh_lane(); if (XBF16) phase_norm2_route_mfma(F, 1); else phase_norm2_route(F, 1); } SEAM(14);
    if (MOE_MERGED && FAST_GEMM) { if (IN(15)) { F.lane = fresh_lane(); fast_moe_merged(F, 1); } if (IN(15) && IN(17)) xcd_barrier(bar); }
    else { RUN(15, if (FAST_GEMM) fast_moe_gateup(F, 1); else phase_moe_gateup(F, 1)); SEAM(15);
    RUN(16, if (FAST_GEMM) fast_moe_down(F, 1); else phase_moe_down(F, 1)); SEAM(16); }
    if (IN(17)) { F.lane = fresh_lane(); phase_combine<true>(F, 1); }
#undef RUN
#undef IN
#undef SEAM
}

extern "C" void kernel_launch(void* const* d_in, const int* in_sizes, int n_in, void* d_out, int out_size, void* d_ws, size_t ws_size, hipStream_t stream) {
    static int grid = 0;
    if (grid == 0) {
        if (n_in != 25 || out_size != T * D || ws_size < WS_END) { fprintf(stderr, "kernel_launch: unexpected shapes (n_in %d out %d ws %zu)\n", n_in, out_size, ws_size); grid = -1; return; }
        int dev = 0, cus = 0, per_cu = 0;
        if (hipGetDevice(&dev) != hipSuccess || hipDeviceGetAttribute(&cus, hipDeviceAttributeMultiprocessorCount, dev) != hipSuccess) { grid = -1; return; }
        if (hipFuncSetAttribute((const void*)mega, hipFuncAttributeMaxDynamicSharedMemorySize, LDS_BYTES) != hipSuccess) { fprintf(stderr, "kernel_launch: hipFuncSetAttribute failed\n"); grid = -1; return; }
        if (hipOccupancyMaxActiveBlocksPerMultiprocessor(&per_cu, (const void*)mega, NTHR, LDS_BYTES) != hipSuccess || per_cu < 1) { fprintf(stderr, "kernel_launch: occupancy query says %d\n", per_cu); }
        (void)hipGetLastError();
        grid = cus;
    }
    if (grid < 0) return;
    (void)hipMemsetAsync((char*)d_ws + WS_CTL, 0, CTL_BYTES, stream);
    Args a{};
    for (int i = 0; i < 25; ++i) a.in[i] = (const float*)d_in[i];
    a.out = (float*)d_out; a.ws = (unsigned char*)d_ws;
#if MK_ONE_LAUNCH
    a.ph_lo = 0; a.ph_hi = NPH;
    hipLaunchKernelGGL(mega, dim3(grid), dim3(NTHR), LDS_BYTES, stream, a);
#else
#ifndef PROBE_PHASE
#define PROBE_PHASE -1
#endif
    for (int p = 0; p < NPH; ++p) { a.ph_lo = p; a.ph_hi = p + 1; hipLaunchKernelGGL(mega, dim3(grid), dim3(NTHR), LDS_BYTES, stream, a);
        if (p == PROBE_PHASE) { if (p == 7 || p == 14) (void)hipMemsetAsync((char*)d_ws + WS_CTL, 0, CTL_BYTES, stream);
            hipLaunchKernelGGL(mega, dim3(grid), dim3(NTHR), LDS_BYTES, stream, a); } }
#endif
}
```

```cpp
#include <hip/hip_runtime.h>
#include <cstdio>

#ifndef MK_ONE_LAUNCH
#define MK_ONE_LAUNCH 1
#endif

#define GAS __attribute__((address_space(1)))
#define LAS __attribute__((address_space(3)))
typedef unsigned short bf16;
typedef short bf16x8 __attribute__((ext_vector_type(8)));
typedef float f32x4 __attribute__((ext_vector_type(4)));
typedef float f32x16 __attribute__((ext_vector_type(16)));
typedef unsigned u32x4 __attribute__((ext_vector_type(4)));
typedef unsigned u32x2 __attribute__((ext_vector_type(2)));

constexpr int D = 1024, NB = 4, L = 8192, T = NB * L, CL = 256, TC = NB * CL;
constexpr int NE = 16, FF = 512, CONVW = 31;
constexpr int N_IN = 1280;
constexpr int FN1 = 64, FN2 = 128;
#ifndef FAST_GEMM
#define FAST_GEMM 1
#endif
#ifndef MOE_MERGED
#define MOE_MERGED 1
#endif
#ifndef XBF16
#define XBF16 FAST_GEMM
#endif
#ifndef FAST_ATTN
#define FAST_ATTN 2
#endif
#ifndef FAST_FFT
#define FAST_FFT 1
#endif
constexpr int IL = FAST_GEMM ? 128 : 32;
constexpr float EPS = 1e-6f;
constexpr int NWAVES = 8, NTHR = 512;
constexpr int CAP = 32768;
constexpr int HROWS = 65536 + 4096;

constexpr size_t MiB = 1u << 20;
constexpr size_t WS_CTL = 0, CTL_BYTES = 1 * MiB;
constexpr size_t WS_MOD = 1 * MiB;
constexpr size_t WS_TW = 1 * MiB + 512 * 1024;
constexpr size_t WS_WIN = 2 * MiB, WS_WOUT = 6 * MiB, WS_WPW1 = 10 * MiB, WS_WPW2 = 14 * MiB;
constexpr size_t WS_WGU = 16 * MiB, WS_WDN = 80 * MiB;
constexpr size_t WS_TOKE = 112 * MiB, WS_TOKP = 113 * MiB, WS_TOKW = 114 * MiB;
constexpr size_t WS_SLOTT = 116 * MiB, WS_SLOTW = 120 * MiB;
constexpr size_t WS_HB = 128 * MiB;
constexpr size_t WS_UF = 196 * MiB, WS_Q = 228 * MiB, WS_K = 260 * MiB, WS_V = 268 * MiB, WS_CK = 276 * MiB, WS_CV = 277 * MiB;
constexpr size_t WS_G = 280 * MiB, WS_MIX = 344 * MiB, WS_AB = 408 * MiB;
constexpr size_t WS_XB = 408 * MiB;
constexpr size_t WS_HID = 196 * MiB, WS_Y = 264 * MiB;
constexpr size_t WS_U = 196 * MiB, WS_V1 = 260 * MiB;
constexpr size_t WS_END = 472 * MiB;
constexpr int CW_BAR = 4096;
constexpr int CW_CNT = 8192;
constexpr int CW_TILE = 16384;
constexpr int CW_TMO2 = 2048;

constexpr int LDS_BYTES = 147456;

__device__ __forceinline__ unsigned f2bf(float f) { unsigned u = __float_as_uint(f); return (u + 0x7fffu + ((u >> 16) & 1u)) >> 16; }
__device__ __forceinline__ float bf2f(unsigned b) { return __uint_as_float(b << 16); }
typedef __bf16 b16x2_t __attribute__((ext_vector_type(2)));
__device__ __forceinline__ unsigned pkbf(float a, float b) { typedef float f2 __attribute__((ext_vector_type(2))); f2 v = {a, b}; return __builtin_bit_cast(unsigned, __builtin_convertvector(v, b16x2_t)); }
__device__ __forceinline__ unsigned pk2(float lo, float hi) { return pkbf(lo, hi); }
__device__ __forceinline__ float bflo(unsigned w) { return __uint_as_float(w << 16); }
__device__ __forceinline__ float bfhi(unsigned w) { return __uint_as_float(w & 0xffff0000u); }
__device__ __forceinline__ float wave_sum(float v) {
    v += __builtin_bit_cast(float, __builtin_amdgcn_mov_dpp(__builtin_bit_cast(int, v), 0xB1, 0xf, 0xf, true));
    v += __builtin_bit_cast(float, __builtin_amdgcn_mov_dpp(__builtin_bit_cast(int, v), 0x4E, 0xf, 0xf, true));
    v += __builtin_bit_cast(float, __builtin_amdgcn_mov_dpp(__builtin_bit_cast(int, v), 0x141, 0xf, 0xf, true));
    v += __builtin_bit_cast(float, __builtin_amdgcn_mov_dpp(__builtin_bit_cast(int, v), 0x140, 0xf, 0xf, true));
    const int iv = __builtin_bit_cast(int, v);
    const float a = __builtin_bit_cast(float, __builtin_amdgcn_readlane(iv, 15)), b = __builtin_bit_cast(float, __builtin_amdgcn_readlane(iv, 31));
    const float c = __builtin_bit_cast(float, __builtin_amdgcn_readlane(iv, 47)), d = __builtin_bit_cast(float, __builtin_amdgcn_readlane(iv, 63));
    return (a + b) + (c + d);
}
__device__ __forceinline__ float silu_f(float x) { return x * __builtin_amdgcn_rcpf(1.f + __expf(-x)); }
__device__ __forceinline__ float sigmoid_f(float x) { return __builtin_amdgcn_rcpf(1.f + __expf(-x)); }
constexpr float YSCALE = 32.f;
__device__ __forceinline__ unsigned pk_fp8x4(f32x4 v) {
    int d = __builtin_amdgcn_cvt_pk_fp8_f32(__builtin_amdgcn_fmed3f(v[0] * YSCALE, -448.f, 448.f), __builtin_amdgcn_fmed3f(v[1] * YSCALE, -448.f, 448.f), 0, false);
    d = __builtin_amdgcn_cvt_pk_fp8_f32(__builtin_amdgcn_fmed3f(v[2] * YSCALE, -448.f, 448.f), __builtin_amdgcn_fmed3f(v[3] * YSCALE, -448.f, 448.f), d, true);
    return (unsigned)d;
}
__device__ __forceinline__ f32x4 un_fp8x4(unsigned d) { typedef float f2 __attribute__((ext_vector_type(2)));
    const f2 lo = __builtin_amdgcn_cvt_pk_f32_fp8((int)d, false), hi = __builtin_amdgcn_cvt_pk_f32_fp8((int)d, true); return (f32x4){lo.x, lo.y, hi.x, hi.y}; }
#define LDS_WAIT() asm volatile("s_waitcnt lgkmcnt(0)" ::: "memory")
__device__ __forceinline__ int fresh_lane() { int l; asm volatile("v_mbcnt_lo_u32_b32 %0, -1, 0\n\tv_mbcnt_hi_u32_b32 %0, -1, %0" : "=v"(l)); return l; }

#define XB_TMO      128
#define XB_XCNT(j)  (256  + 64 * (j))
#define XB_XSUB(j)  (1280 + 64 * (j))
#define XB_XGEN(j)  (2304 + 64 * (j))
#define XB_TOP      3328
#define XB_TOPGEN   3392
#define XCD_BAR_WORDS 3456
#define XB_SPIN_CAP (1u << 20)
__device__ __forceinline__ unsigned xb_ld(unsigned* p)              { return __hip_atomic_load(p, __ATOMIC_RELAXED, __HIP_MEMORY_SCOPE_AGENT); }
__device__ __forceinline__ unsigned xb_add(unsigned* p, unsigned v) { return __hip_atomic_fetch_add(p, v, __ATOMIC_RELAXED, __HIP_MEMORY_SCOPE_AGENT); }
__device__ __forceinline__ unsigned xb_xcc_id() { return (unsigned)__builtin_amdgcn_s_getreg((3 << 11) | 20) & 0xFu; }
#define XB_SPIN(cond, bar) do { unsigned _sp = 0; while (cond) { __builtin_amdgcn_s_sleep(1); \
    if ((++_sp & 255u) == 0u) { if (xb_ld(&(bar)[XB_TMO])) break; if (_sp > XB_SPIN_CAP) { atomicAdd(&(bar)[XB_TMO], 1u); break; } } } } while (0)
struct XcdBarrier { unsigned* bar; unsigned x; volatile LAS unsigned* st; };
__device__ __forceinline__ XcdBarrier xcd_barrier_post(unsigned* bar, volatile LAS unsigned* st) {
    XcdBarrier b; b.bar = bar; b.x = xb_xcc_id(); b.st = st;
    if (threadIdx.x == 0) (void)xb_add(&bar[XB_XCNT(b.x)], 1u);
    return b;
}
__device__ __forceinline__ void xcd_barrier_complete(unsigned* bar, unsigned x, unsigned& nloc, unsigned& nx) {
    const unsigned G = gridDim.x * gridDim.y * gridDim.z;
    unsigned sum, cnt, mine, sp = 0u;
    for (;;) {
        sum = 0u; cnt = 0u; mine = 0u;
#pragma unroll
        for (unsigned j = 0; j < 16; ++j) { const unsigned c = xb_ld(&bar[XB_XCNT(j)]); sum += c; cnt += (c > 0u) ? 1u : 0u; mine = (j == x) ? c : mine; }
        if (sum == G) break;
        __builtin_amdgcn_s_sleep(1);
        if ((++sp & 255u) == 0u) { if (xb_ld(&bar[XB_TMO])) break; if (sp > XB_SPIN_CAP) { atomicAdd(&bar[XB_TMO], 1u); break; } }
    }
    nloc = mine > 0u ? mine : 1u; nx = cnt > 0u ? cnt : 1u;
}
__device__ __forceinline__ void xcd_barrier(const XcdBarrier& b) {
    asm volatile("s_waitcnt vmcnt(0)" ::: "memory");
    __syncthreads();
    if (threadIdx.x == 0) {
        unsigned* bar = b.bar;
        __builtin_amdgcn_s_waitcnt(0);
        unsigned nloc = b.st[0], nx = b.st[1];
        if (nloc == 0u) { xcd_barrier_complete(bar, b.x, nloc, nx); b.st[0] = nloc; b.st[1] = nx; }
        const unsigned old = xb_add(&bar[XB_XSUB(b.x)], 1u);
        const unsigned gen = old / nloc;
        if (old + 1u == (gen + 1u) * nloc) {
            __builtin_amdgcn_fence(__ATOMIC_RELEASE, "agent");
            asm volatile("s_waitcnt vmcnt(0)" ::: "memory");
            const unsigned og = xb_add(&bar[XB_TOP], 1u);
            const unsigned tg = og / nx;
            if (og + 1u == (tg + 1u) * nx) xb_add(&bar[XB_TOPGEN], 1u);
            else XB_SPIN(xb_ld(&bar[XB_TOPGEN]) == tg, bar);
            __builtin_amdgcn_fence(__ATOMIC_ACQUIRE, "agent");
            xb_add(&bar[XB_XGEN(b.x)], 1u);
            asm volatile("s_waitcnt vmcnt(0)" ::: "memory");
        } else {
            XB_SPIN(xb_ld(&bar[XB_XGEN(b.x)]) == gen, bar);
            __builtin_amdgcn_fence(__ATOMIC_ACQUIRE, "agent");
            asm volatile("s_waitcnt vmcnt(0)" ::: "memory");
        }
    }
    __syncthreads();
}

struct Args { const float* in[25]; float* out; unsigned char* ws; int ph_lo, ph_hi; };
enum { I_X = 0, I_C, I_CTX, I_CCTX, I_ADAW, I_ADAB, I_NMG, I_NFG, I_WIN, I_WOUT, I_SINK, I_PW1W, I_PW1B, I_DWW, I_DWB, I_LNG, I_LNB,
       I_PW2W, I_PW2B, I_RW, I_RB, I_WG, I_WU, I_WD, I_FNG };

struct InPtrs {
    __device__ __forceinline__ const float* operator[](int i) const { const float* r;
        asm volatile("s_load_dwordx2 %0, %1, %2\n\ts_waitcnt lgkmcnt(0)" : "=s"(r) : "s"(__builtin_amdgcn_kernarg_segment_ptr()), "s"(i * 8)); return r; }
};
struct Frame {
    LAS unsigned char* lds;
    int tid, lane, wave, G, wg;
    InPtrs in;
    float* out;
    unsigned char* ws;
    unsigned* ctl;
};

__device__ __forceinline__ int crow(int i, int h) { return (i & 3) + 8 * (i >> 2) + 4 * h; }
template <class RowPtr, class Epi>
__device__ __forceinline__ void sgemm_tile(const RowPtr& rowptr, const bf16* Bt, int K, int m0, int n0, const Epi& epi, int wave, int lane) {
    const int wm = wave & 3, wn = wave >> 2, r = lane & 31, h = lane >> 5;
    const bf16* ap = rowptr(m0 + wm * 32 + r) + 8 * h;
    const bf16* bp0 = Bt + (size_t)(n0 + wn * 64 + r) * K + 8 * h;
    const bf16* bp1 = bp0 + (size_t)32 * K;
    f32x16 c0, c1;
#pragma unroll
    for (int i = 0; i < 16; ++i) { c0[i] = 0.f; c1[i] = 0.f; }
#pragma unroll 2
    for (int k = 0; k < K; k += 32) {
        const bf16x8 a0 = *(const bf16x8*)(ap + k), a1 = *(const bf16x8*)(ap + k + 16);
        const bf16x8 b00 = *(const bf16x8*)(bp0 + k), b01 = *(const bf16x8*)(bp0 + k + 16);
        const bf16x8 b10 = *(const bf16x8*)(bp1 + k), b11 = *(const bf16x8*)(bp1 + k + 16);
        c0 = __builtin_amdgcn_mfma_f32_32x32x16_bf16(a0, b00, c0, 0, 0, 0);
        c1 = __builtin_amdgcn_mfma_f32_32x32x16_bf16(a0, b10, c1, 0, 0, 0);
        c0 = __builtin_amdgcn_mfma_f32_32x32x16_bf16(a1, b01, c0, 0, 0, 0);
        c1 = __builtin_amdgcn_mfma_f32_32x32x16_bf16(a1, b11, c1, 0, 0, 0);
    }
    epi(m0 + wm * 32, n0 + wn * 64, c0, c1, lane);
}

__device__ __forceinline__ void p0_transpose_item(const float* W, int K, int N, bf16* WT, int k0, int n0, int drow0, LAS float* scr, int lane) {
#pragma unroll 8
    for (int i = 0; i < 32; ++i) { const int kk = 2 * i + (lane >> 5); scr[kk * 33 + (lane & 31)] = W[(size_t)(k0 + kk) * N + n0 + (lane & 31)]; }
    LDS_WAIT(); asm volatile("" ::: "memory");
    const int c = lane & 7;
#pragma unroll
    for (int j = 0; j < 4; ++j) { const int n = (lane >> 3) + 8 * j; const LAS float* s = scr + (8 * c) * 33 + n;
        u32x4 o; o.x = pk2(s[0 * 33], s[1 * 33]); o.y = pk2(s[2 * 33], s[3 * 33]); o.z = pk2(s[4 * 33], s[5 * 33]); o.w = pk2(s[6 * 33], s[7 * 33]);
        *(u32x4*)(WT + (size_t)(drow0 + n) * K + k0 + 8 * c) = o; }
    LDS_WAIT(); asm volatile("" ::: "memory");
}
__device__ __forceinline__ int il_row(int j, int half) { return (j / IL) * (2 * IL) + half * IL + (j % IL); }

constexpr int T_NITEMS = 640 + 512 + 1024 + 512 + 3 * 32 * 256, T_DEFER_ATT = 10 * 2048;
struct TItem { const float* W; bf16* WT; int K, N, k0, n0, drow0; bool ok; };
__device__ __forceinline__ TItem t_decode(const Frame& F, int it) {
    constexpr int S0 = 640, S1 = 512, S2 = 1024, S3 = 512, SM = 32 * 256;
    TItem t; t.ok = it < S0 + S1 + S2 + S3 + 3 * SM; t.W = F.in[I_WIN]; t.WT = (bf16*)(F.ws + WS_WIN); t.K = 1024; t.N = 1280; t.k0 = 0; t.n0 = 0; t.drow0 = 0;
    int r = it;
    if (r < S0) { const int kb = r / 40, nb = r % 40; t.k0 = kb * 64; t.n0 = nb * 32; t.drow0 = nb * 32; return t; } r -= S0;
    if (r < S1) { const int kb = r / 32, nb = r % 32; t.W = F.in[I_WOUT]; t.WT = (bf16*)(F.ws + WS_WOUT); t.N = 1024; t.k0 = kb * 64; t.n0 = nb * 32; t.drow0 = nb * 32; return t; } r -= S1;
    if (r < S2) { const int kb = r / 64, nb = r % 64, n0 = nb * 32; t.W = F.in[I_PW1W]; t.WT = (bf16*)(F.ws + WS_WPW1); t.N = 2048; t.k0 = kb * 64; t.n0 = n0; t.drow0 = il_row(n0 & 1023, n0 >> 10); return t; } r -= S2;
    if (r < S3) { const int kb = r / 32, nb = r % 32; t.W = F.in[I_PW2W]; t.WT = (bf16*)(F.ws + WS_WPW2); t.N = 1024; t.k0 = kb * 64; t.n0 = nb * 32; t.drow0 = nb * 32; return t; } r -= S3;
    if (r < SM) { const int le = r >> 8, q = r & 255, kb = q / 16, nb = q % 16; t.W = F.in[I_WG] + (size_t)le * 1024 * 512; t.WT = (bf16*)(F.ws + WS_WGU) + (size_t)le * 1024 * 1024; t.N = 512; t.k0 = kb * 64; t.n0 = nb * 32; t.drow0 = il_row(nb * 32, 0); return t; } r -= SM;
    if (r < SM) { const int le = r >> 8, q = r & 255, kb = q / 16, nb = q % 16; t.W = F.in[I_WU] + (size_t)le * 1024 * 512; t.WT = (bf16*)(F.ws + WS_WGU) + (size_t)le * 1024 * 1024; t.N = 512; t.k0 = kb * 64; t.n0 = nb * 32; t.drow0 = il_row(nb * 32, 1); return t; } r -= SM;
    { const int le = (r >> 8) & 31, q = r & 255, kb = q / 32, nb = q % 32; t.W = F.in[I_WD] + (size_t)le * 512 * 1024; t.WT = (bf16*)(F.ws + WS_WDN) + (size_t)le * 1024 * 512; t.K = 512; t.N = 1024; t.k0 = kb * 64; t.n0 = nb * 32; t.drow0 = nb * 32; }
    return t;
}
__device__ __forceinline__ void t_load(const TItem& t, int lane, float (&v)[32]) {
    if (t.ok) {
#pragma unroll
        for (int i = 0; i < 32; ++i) v[i] = t.W[(size_t)(t.k0 + 2 * i + (lane >> 5)) * t.N + t.n0 + (lane & 31)];
    }
}
__device__ __forceinline__ void t_store(const TItem& t, LAS float* scr, int lane, const float (&v)[32]) {
#pragma unroll
    for (int i = 0; i < 32; ++i) scr[(2 * i + (lane >> 5)) * 33 + (lane & 31)] = v[i];
    LDS_WAIT(); asm volatile("" ::: "memory");
    const int c = lane & 7;
#pragma unroll
    for (int j = 0; j < 4; ++j) { const int n = (lane >> 3) + 8 * j; const LAS float* s = scr + (8 * c) * 33 + n;
        u32x4 o; o.x = pk2(s[0 * 33], s[1 * 33]); o.y = pk2(s[2 * 33], s[3 * 33]); o.z = pk2(s[4 * 33], s[5 * 33]); o.w = pk2(s[6 * 33], s[7 * 33]);
        *(u32x4*)(t.WT + (size_t)(t.drow0 + n) * t.K + t.k0 + 8 * c) = o; }
    LDS_WAIT(); asm volatile("" ::: "memory");
}
__device__ __forceinline__ void t_dma(const TItem& t, LAS unsigned char* scr, int lane) {
    if (t.ok) {
#pragma unroll
        for (int i = 0; i < 8; ++i)
            __builtin_amdgcn_global_load_lds((const unsigned*)(t.W + (size_t)(t.k0 + 8 * i + (lane >> 3)) * t.N + t.n0 + 4 * (lane & 7)), (LAS unsigned*)(scr + 1056 * i), 16, 0, 0);
    }
}
__device__ __forceinline__ void t_store_dma(const TItem& t, const LAS float* scr, int lane) {
    const int c = lane & 7;
#pragma unroll 1
    for (int j = 0; j < 4; ++j) { const int n = (lane >> 3) + 8 * j; float e[8];
#pragma unroll
        for (int q = 0; q < 8; ++q) e[q] = scr[264 * c + 32 * q + n];
        { u32x4 o; o.x = pk2(e[0], e[1]); o.y = pk2(e[2], e[3]); o.z = pk2(e[4], e[5]); o.w = pk2(e[6], e[7]); *(u32x4*)(t.WT + (size_t)(t.drow0 + n) * t.K + t.k0 + 8 * c) = o; } }
    LDS_WAIT(); asm volatile("" ::: "memory");
}
__device__ __forceinline__ void phase_prep(Frame& F) {
    {
        LAS float* sc = (LAS float*)F.lds;
        LAS float* red = sc + 5 * 1024;
        bool loaded = false;
        for (int it = F.wg; it < 192; it += F.G) {
            if (!loaded) {
                for (int i = F.tid; i < 5 * 1024; i += NTHR) { const int b = i >> 10, k = i & 1023; const float v = b < 4 ? F.in[I_C][b * 1024 + k] : F.in[I_CCTX][k]; sc[i] = silu_f(v); }
                __syncthreads(); loaded = true;
            }
            const int l = it / 96, n0 = (it % 96) * 64, c4 = F.tid & 15, kg = F.tid >> 4;
            const float* w = F.in[I_ADAW] + (size_t)l * 1024 * 6144 + n0 + 4 * c4;
            f32x4 a[5];
#pragma unroll
            for (int b = 0; b < 5; ++b) a[b] = (f32x4){0.f, 0.f, 0.f, 0.f};
#pragma unroll 16
            for (int kk = 0; kk < 32; ++kk) { const int k = kg * 32 + kk; const f32x4 wv = *(const f32x4*)(w + (size_t)k * 6144);
#pragma unroll
                for (int b = 0; b < 5; ++b) a[b] += sc[b * 1024 + k] * wv; }
#pragma unroll
            for (int b = 0; b < 5; ++b) *(LAS f32x4*)(red + (kg * 5 + b) * 64 + 4 * c4) = a[b];
            __syncthreads();
            if (F.tid < 320) { const int b = F.tid >> 6, c2 = F.tid & 63; float sm = 0.f;
#pragma unroll
                for (int g = 0; g < 32; ++g) sm += red[(g * 5 + b) * 64 + c2];
                ((float*)(F.ws + WS_MOD))[((size_t)l * 5 + b) * 6144 + n0 + c2] = sm + F.in[I_ADAB][l * 6144 + n0 + c2]; }
            __syncthreads();
        }
        __syncthreads();
    }
    { u32x4* z = (u32x4*)(F.ws + WS_SLOTT); const u32x4 zero = {0u, 0u, 0u, 0u};
      for (int i = F.wg * NTHR + F.tid; i < 2 * 16 * CAP / 4; i += F.G * NTHR) z[i] = zero; }
    { float* tw = (float*)(F.ws + WS_TW);
      for (int k = F.wg * NTHR + F.tid; k < 8192; k += F.G * NTHR) { const float a = (float)k * (6.283185307179586f / 8192.f); tw[2 * k] = __cosf(a); tw[2 * k + 1] = __sinf(a); } }
    {
        LAS float* scr = (LAS float*)(F.lds + F.wave * 8704);
        const int gw = F.wg * NWAVES + F.wave, NGW = F.G * NWAVES;
        auto vmap = [](int v) { return v < 640 ? v : v + T_DEFER_ATT; };
        TItem cur = t_decode(F, vmap(gw)); float va[32], vb[32];
        t_load(cur, F.lane, va);
#pragma unroll 1
        for (int it = gw; cur.ok; it += NGW) {
            const TItem nxt = t_decode(F, vmap(it + NGW));
            t_load(nxt, F.lane, vb);
            t_store(cur, scr, F.lane, va);
#pragma unroll
            for (int i = 0; i < 32; ++i) va[i] = vb[i];
            cur = nxt;
        }
    }
}

#define ROFF(lane, j) (512 * ((j) >> 1) + 8 * (lane) + 4 * ((j) & 1))
__device__ __forceinline__ void row_load(const float* p, int lane, f32x4 (&v)[4]) {
#pragma unroll
    for (int j = 0; j < 4; ++j) v[j] = *(const f32x4*)(p + ROFF(lane, j));
}
__device__ __forceinline__ void row_load_bf(const bf16* p, int lane, f32x4 (&v)[4]) {
#pragma unroll
    for (int jj = 0; jj < 2; ++jj) { const u32x4 w = *(const u32x4*)(p + 512 * jj + 8 * lane); v[2 * jj] = (f32x4){bflo(w.x), bfhi(w.x), bflo(w.y), bfhi(w.y)}; v[2 * jj + 1] = (f32x4){bflo(w.z), bfhi(w.z), bflo(w.w), bfhi(w.w)}; }
}
__device__ __forceinline__ void xrow_load(const float* xf, const bf16* xb, size_t row, int lane, f32x4 (&v)[4]) { if (XBF16) row_load_bf(xb + row * D, lane, v); else row_load(xf + row * D, lane, v); }
__device__ __forceinline__ float row_sumsq(const f32x4 (&v)[4]) {
    float s = 0.f;
#pragma unroll
    for (int j = 0; j < 4; ++j) s += (v[j].x * v[j].x + v[j].y * v[j].y) + (v[j].z * v[j].z + v[j].w * v[j].w);
    return wave_sum(s);
}
__device__ __forceinline__ void row_modulate(f32x4 (&v)[4], float rstd, const float* g, const float* sh, const float* sc, int lane) {
#pragma unroll
    for (int j = 0; j < 4; ++j) { const int o = ROFF(lane, j); const f32x4 gg = *(const f32x4*)(g + o), s1 = *(const f32x4*)(sc + o), s0 = *(const f32x4*)(sh + o);
        v[j] = v[j] * rstd * gg * (1.f + s1) + s0; }
}
__device__ __forceinline__ void row_store_bf16(bf16* dst, const f32x4 (&v)[4], int lane) {
#pragma unroll
    for (int jj = 0; jj < 2; ++jj) { u32x4 w; w.x = pk2(v[2 * jj].x, v[2 * jj].y); w.y = pk2(v[2 * jj].z, v[2 * jj].w); w.z = pk2(v[2 * jj + 1].x, v[2 * jj + 1].y); w.w = pk2(v[2 * jj + 1].z, v[2 * jj + 1].w); *(u32x4*)(dst + 512 * jj + 8 * lane) = w; }
}

__device__ __forceinline__ void phase_norm1_l0(Frame& F) {
    const int gw = F.wg * NWAVES + F.wave, NGW = F.G * NWAVES;
    const float* mod = (const float*)(F.ws + WS_MOD);
    bf16* HB = (bf16*)(F.ws + WS_HB);
    for (int row = gw; row < T + TC; row += NGW) {
        const float* src = row < T ? F.in[I_X] + (size_t)row * D : F.in[I_CTX] + (size_t)(row - T) * D;
        const int b = row < T ? (row >> 13) : 4;
        f32x4 v[4]; row_load(src, F.lane, v);
        const float rstd = rsqrtf(row_sumsq(v) * (1.f / D) + EPS);
        const float* m = mod + (size_t)b * 6144;
        row_modulate(v, rstd, F.in[I_NMG], m, m + 1024, F.lane);
        row_store_bf16(HB + (size_t)row * D, v, F.lane);
    }
}

struct RowLin { const bf16* base; size_t pitch; __device__ __forceinline__ const bf16* operator()(int m) const { return base + (size_t)m * pitch; } };

__device__ __forceinline__ void inproj_block(Frame& F, int mb, int nbk, const f32x16& c, int lane) {
    const int h = lane >> 5, cl = lane & 31;
    bf16* dst; int pitch, cbase; bool rope = false; bool isctx = (mb >= T);
    if (nbk < 512) { dst = (bf16*)(F.ws + WS_UF); pitch = 512; cbase = 0; }
    else if (nbk < 1024) { dst = (bf16*)(F.ws + WS_Q); pitch = 512; cbase = 512; rope = true; }
    else if (nbk < 1152) { dst = isctx ? (bf16*)(F.ws + WS_CK) : (bf16*)(F.ws + WS_K); pitch = 128; cbase = 1024; rope = !isctx; }
    else { dst = isctx ? (bf16*)(F.ws + WS_CV) : (bf16*)(F.ws + WS_V); pitch = 128; cbase = 1152; }
    const int rbase = isctx ? mb - T : mb;
    const int col = nbk - cbase + cl;
    const float inv = exp2f(-(float)(cl & 15) * (13.287712379549449f / 16.f));
    const bool second = (cl & 16) != 0; const bool bycol = ((nbk >> 5) & 1) != 0;
#pragma unroll
    for (int i = 0; i < 16; ++i) {
        const int rr = crow(i, h); float v = c[i];
        if (rope) {
            const float partner = __shfl_xor(v, 16);
            const int l = (mb + rr) & (L - 1);
            const float pos = (float)(bycol ? (l & 63) : (l >> 6));
            const float ang = pos * inv, cs = __cosf(ang), sn = __sinf(ang);
            v = second ? (partner * sn + v * cs) : (v * cs - partner * sn);
        }
        dst[(size_t)(rbase + rr) * pitch + col] = (bf16)f2bf(v);
    }
}
__device__ __forceinline__ void phase_inproj(Frame& F) {
    const bf16* HB = (const bf16*)(F.ws + WS_HB); const bf16* Wt = (const bf16*)(F.ws + WS_WIN);
    constexpr int MT = (T + TC) / 128, NT = N_IN / 128;
    RowLin rp{HB, (size_t)D};
    for (int u = F.wg; u < MT * NT; u += F.G) {
        const int mt = u / NT, nt = u % NT;
        if (mt >= T / 128 && nt < 8) continue;
        auto epi = [&](int mb, int nb, const f32x16& c0, const f32x16& c1, int lane) { inproj_block(F, mb, nb, c0, lane); inproj_block(F, mb, nb + 32, c1, lane); };
        sgemm_tile(rp, Wt, D, mt * 128, nt * 128, epi, F.wave, F.lane);
    }
}

__device__ __forceinline__ void attn_key(const bf16* kp, const bf16* vp, const float (&q)[64], float& m, float& s, float (&o)[64]) {
    float dot = 0.f;
#pragma unroll
    for (int j = 0; j < 8; ++j) { const u32x4 w = *(const u32x4*)(kp + 8 * j);
        dot += q[8 * j + 0] * bflo(w.x) + q[8 * j + 1] * bfhi(w.x) + q[8 * j + 2] * bflo(w.y) + q[8 * j + 3] * bfhi(w.y)
             + q[8 * j + 4] * bflo(w.z) + q[8 * j + 5] * bfhi(w.z) + q[8 * j + 6] * bflo(w.w) + q[8 * j + 7] * bfhi(w.w); }
    const float mn = fmaxf(m, dot), alpha = __expf(m - mn), p = __expf(dot - mn);
    s = s * alpha + p; m = mn;
#pragma unroll
    for (int j = 0; j < 8; ++j) { const u32x4 w = *(const u32x4*)(vp + 8 * j);
        o[8 * j + 0] = o[8 * j + 0] * alpha + p * bflo(w.x); o[8 * j + 1] = o[8 * j + 1] * alpha + p * bfhi(w.x);
        o[8 * j + 2] = o[8 * j + 2] * alpha + p * bflo(w.y); o[8 * j + 3] = o[8 * j + 3] * alpha + p * bfhi(w.y);
        o[8 * j + 4] = o[8 * j + 4] * alpha + p * bflo(w.z); o[8 * j + 5] = o[8 * j + 5] * alpha + p * bfhi(w.z);
        o[8 * j + 6] = o[8 * j + 6] * alpha + p * bflo(w.w); o[8 * j + 7] = o[8 * j + 7] * alpha + p * bfhi(w.w); }
}
__device__ __forceinline__ void phase_attn_simple(Frame& F) {
    const bf16* Q = (const bf16*)(F.ws + WS_Q); const bf16* Kb = (const bf16*)(F.ws + WS_K); const bf16* Vb = (const bf16*)(F.ws + WS_V);
    const bf16* CK = (const bf16*)(F.ws + WS_CK); const bf16* CV = (const bf16*)(F.ws + WS_CV); bf16* MIX = (bf16*)(F.ws + WS_MIX);
    for (int idx = F.wg * NTHR + F.tid; idx < T * 8; idx += F.G * NTHR) {
        const int hd = idx / T, t = idx % T, b = t >> 13, l = t & (L - 1), kvh = hd >> 2;
        float q[64], o[64];
#pragma unroll
        for (int j = 0; j < 8; ++j) { const u32x4 w = *(const u32x4*)(Q + (size_t)t * 512 + hd * 64 + 8 * j);
            q[8 * j + 0] = bflo(w.x) * 0.125f; q[8 * j + 1] = bfhi(w.x) * 0.125f; q[8 * j + 2] = bflo(w.y) * 0.125f; q[8 * j + 3] = bfhi(w.y) * 0.125f;
            q[8 * j + 4] = bflo(w.z) * 0.125f; q[8 * j + 5] = bfhi(w.z) * 0.125f; q[8 * j + 6] = bflo(w.w) * 0.125f; q[8 * j + 7] = bfhi(w.w) * 0.125f; }
#pragma unroll
        for (int j = 0; j < 64; ++j) o[j] = 0.f;
        float m = F.in[I_SINK][hd], s = 1.f;
        for (int c = 0; c < CL; ++c) { const size_t r = (size_t)(b * CL + c) * 128 + kvh * 64; attn_key(CK + r, CV + r, q, m, s, o); }
        const int lo = l - 128 < 0 ? 0 : l - 128, hi = l + 128 > L - 1 ? L - 1 : l + 128;
        for (int kp = lo; kp <= hi; ++kp) { const size_t r = (size_t)(b * L + kp) * 128 + kvh * 64; attn_key(Kb + r, Vb + r, q, m, s, o); }
        const float is = 1.f / s;
#pragma unroll
        for (int j = 0; j < 8; ++j) { u32x4 w; w.x = pk2(o[8 * j] * is, o[8 * j + 1] * is); w.y = pk2(o[8 * j + 2] * is, o[8 * j + 3] * is); w.z = pk2(o[8 * j + 4] * is, o[8 * j + 5] * is); w.w = pk2(o[8 * j + 6] * is, o[8 * j + 7] * is);
            *(u32x4*)(MIX + (size_t)t * 1024 + 512 + hd * 64 + 8 * j) = w; }
    }
}

__device__ __forceinline__ void phase_fft1_simple(Frame& F) {
    const bf16* UF = (const bf16*)(F.ws + WS_UF); bf16* Gb = (bf16*)(F.ws + WS_G); const float* tw = (const float*)(F.ws + WS_TW);
    for (int idx = F.wg * NTHR + F.tid; idx < NB * FN1 * FN2 * 512; idx += F.G * NTHR) {
        const int ch = idx & 511, bp = (idx >> 9) & 127, c = (idx >> 16) & 63, b = idx >> 22;
        float re = 0.f, im = 0.f;
        for (int a = 0; a < FN1; ++a) { const float u = bf2f(UF[(size_t)(b * L + 128 * a + bp) * 512 + ch]); const int k = ((a * c) & 63) * 128;
            re += u * tw[2 * k]; im -= u * tw[2 * k + 1]; }
        const int k2 = bp * c; const float cs = tw[2 * k2], sn = tw[2 * k2 + 1];
        const float gr = re * cs + im * sn, gi = im * cs - re * sn;
        const size_t row = (size_t)(b * FN1 + c) * FN2 + bp;
        Gb[row * 1024 + ch] = (bf16)f2bf(gr); Gb[row * 1024 + 512 + ch] = (bf16)f2bf(gi);
    }
}
__device__ __forceinline__ void phase_fft2_simple(Frame& F) {
    const bf16* Gb = (const bf16*)(F.ws + WS_G); bf16* AB = (bf16*)(F.ws + WS_AB); const float* tw = (const float*)(F.ws + WS_TW);
    for (int idx = F.wg * NTHR + F.tid; idx < NB * FN1 * FN2 * 512; idx += F.G * NTHR) {
        const int ch = idx & 511, d = (idx >> 9) & 127, c = (idx >> 16) & 63, b = idx >> 22;
        float fr = 0.f, fi = 0.f;
        for (int bp = 0; bp < FN2; ++bp) { const size_t row = (size_t)(b * FN1 + c) * FN2 + bp; const float gr = bf2f(Gb[row * 1024 + ch]), gi = bf2f(Gb[row * 1024 + 512 + ch]);
            const int k = ((bp * d) & 127) * 64; const float cs = tw[2 * k], sn = tw[2 * k + 1];
            fr += gr * cs + gi * sn; fi += gi * cs - gr * sn; }
        const size_t t = (size_t)b * L + c + 64 * d;
        AB[t * 1024 + ch] = (bf16)f2bf(fr); AB[t * 1024 + 512 + ch] = (bf16)f2bf(-fi);
    }
}
__device__ __forceinline__ void phase_fft3_simple(Frame& F) {
    const bf16* AB = (const bf16*)(F.ws + WS_AB); bf16* MIX = (bf16*)(F.ws + WS_MIX); const float* tw = (const float*)(F.ws + WS_TW);
    LAS float* t128 = (LAS float*)F.lds;
    for (int i = F.tid; i < 128; i += NTHR) { t128[2 * i] = tw[2 * (i * 64)]; t128[2 * i + 1] = tw[2 * (i * 64) + 1]; }
    __syncthreads();
    for (int idx = F.wg * NTHR + F.tid; idx < T * 512; idx += F.G * NTHR) {
        const int cp = idx & 127, g = (idx >> 7) & 3, t = idx >> 9;
        const bf16* arow = AB + (size_t)t * 1024 + g * 128;
        float y = 0.f;
        for (int cc = 0; cc < 128; ++cc) { const int k = (cc * cp) & 127; y += bf2f(arow[cc]) * t128[2 * k] - bf2f(arow[512 + cc]) * t128[2 * k + 1]; }
        MIX[(size_t)t * 1024 + g * 128 + cp] = (bf16)f2bf(y * (1.f / 1024.f));
    }
    __syncthreads();
}

__device__ __forceinline__ void phase_outproj(Frame& F, const bf16* A, const bf16* Wt, const float* base, float* X, const float* gate  , const float* bias) {
    RowLin rp{A, (size_t)D};
    for (int u = F.wg; u < (T / 128) * 8; u += F.G) {
        const int mt = u / 8, nt = u % 8;
        auto epi = [&](int mb, int nb, const f32x16& c0, const f32x16& c1, int lane) {
            const int h = lane >> 5, cl = lane & 31, b = mb >> 13;
#pragma unroll
            for (int half = 0; half < 2; ++half) { const int col = nb + 32 * half + cl; const float gv = gate[(size_t)b * 6144 + col], bv = bias ? bias[col] : 0.f;
#pragma unroll
                for (int i = 0; i < 16; ++i) { const size_t o = (size_t)(mb + crow(i, h)) * D + col; const float a = half ? c1[i] : c0[i]; X[o] = base[o] + gv * (a + bv); } }
        };
        sgemm_tile(rp, Wt, D, mt * 128, nt * 128, epi, F.wave, F.lane);
    }
}

__device__ __forceinline__ void route_select(const float (&lg)[16], const float* rb, int& be1, int& be2, float& w1, float& w2) {
    float best = -1e30f; float bs1 = 0.f, bs2 = 0.f; be1 = 0; be2 = 0;
#pragma unroll
    for (int g = 0; g < 4; ++g) {
        float v1 = -1e30f, v2 = -1e30f, s1 = 0.f, s2 = 0.f; int j1 = 0, j2 = 0;
#pragma unroll
        for (int q = 0; q < 4; ++q) { const float sc = sigmoid_f(lg[4 * g + q]), x = sc + rb[4 * g + q];
            if (x > v1) { v2 = v1; j2 = j1; s2 = s1; v1 = x; j1 = q; s1 = sc; } else if (x > v2) { v2 = x; j2 = q; s2 = sc; } }
        const float gs = v1 + v2;
        if (gs > best) { best = gs; be1 = 4 * g + j1; be2 = 4 * g + j2; bs1 = s1; bs2 = s2; }
    }
    const float inv = 1.f / (bs1 + bs2); w1 = bs1 * inv; w2 = bs2 * inv;
}
__device__ __forceinline__ void phase_norm2_route(Frame& F, int layer) {
    const float* mod = (const float*)(F.ws + WS_MOD) + (size_t)layer * 5 * 6144;
    const float* X = F.out; const bf16* XB = (const bf16*)(F.ws + WS_XB); bf16* HB = (bf16*)(F.ws + WS_HB);
    const float* rw = F.in[I_RW]; const float* rb = F.in[I_RB];
    int* tok_e = (int*)(F.ws + WS_TOKE); int* tok_p = (int*)(F.ws + WS_TOKP); float* tok_w = (float*)(F.ws + WS_TOKW);
    int* slot_t = (int*)(F.ws + WS_SLOTT) + layer * 16 * CAP;
    float* slot_w = (float*)(F.ws + WS_SLOTW) + layer * 16 * CAP;
    unsigned* cnt = F.ctl + CW_CNT + layer * 16 * 64;
    LAS float* rwt = (LAS float*)F.lds;
    LAS int* sel_e = (LAS int*)(F.lds + 65536);
    LAS float* sel_w = (LAS float*)(F.lds + 65536 + 1024);
    LAS int* wcnt = (LAS int*)(F.lds + 65536 + 2048);
    LAS int* ebase = wcnt + 64;
    __syncthreads();
    for (int t = F.tid; t < 4096; t += NTHR) { const int i = t >> 2, e4 = t & 3; const f32x4 w = *(const f32x4*)(rw + (size_t)i * 16 + 4 * e4);
        const int p = (i & 512) + 256 * ((i >> 2) & 1) + 4 * ((i >> 3) & 63) + (i & 3);
        rwt[(4 * e4 + 0) * 1024 + p] = w.x; rwt[(4 * e4 + 1) * 1024 + p] = w.y; rwt[(4 * e4 + 2) * 1024 + p] = w.z; rwt[(4 * e4 + 3) * 1024 + p] = w.w; }
    __syncthreads();
    for (int rb0 = F.wg; rb0 < T / 128; rb0 += F.G) {
        const int b = (rb0 * 128) >> 13;
        f32x4 gm[4], sh[4];
        { const float* m = mod + (size_t)b * 6144; const float* g = F.in[I_NFG] + layer * D;
#pragma unroll
          for (int jj = 0; jj < 4; ++jj) { const int o = ROFF(F.lane, jj); gm[jj] = *(const f32x4*)(g + o) * (1.f + *(const f32x4*)(m + 4096 + o)); sh[jj] = *(const f32x4*)(m + 3072 + o); } }
        const int rbase = rb0 * 128 + F.wave * 16;
        f32x4 v0[4], v1[4]; xrow_load(X, XB, (size_t)rbase, F.lane, v0); xrow_load(X, XB, (size_t)(rbase + 1), F.lane, v1);
#pragma unroll 1
        for (int j = 0; j < 16; j += 2) {
            const int lr = F.wave * 16 + j, row = rbase + j;
            f32x4 n0[4], n1[4];
            { const int nr = (j + 2 < 16) ? row + 2 : row; xrow_load(X, XB, (size_t)nr, F.lane, n0); xrow_load(X, XB, (size_t)(nr + 1), F.lane, n1); }
            const float rstd0 = rsqrtf(row_sumsq(v0) * (1.f / D) + EPS), rstd1 = rsqrtf(row_sumsq(v1) * (1.f / D) + EPS);
#pragma unroll
            for (int jj = 0; jj < 4; ++jj) { v0[jj] = v0[jj] * rstd0 * gm[jj] + sh[jj]; v1[jj] = v1[jj] * rstd1 * gm[jj] + sh[jj]; }
            row_store_bf16(HB + (size_t)row * D, v0, F.lane); row_store_bf16(HB + (size_t)(row + 1) * D, v1, F.lane);
            float lg0[16], lg1[16];
#pragma unroll
            for (int e = 0; e < 16; ++e) { float a0 = 0.f, a1 = 0.f;
#pragma unroll
                for (int jj = 0; jj < 4; ++jj) { const f32x4 w4 = *(const LAS f32x4*)(rwt + e * 1024 + 256 * jj + 4 * F.lane);
                    a0 += (v0[jj].x * w4.x + v0[jj].y * w4.y) + (v0[jj].z * w4.z + v0[jj].w * w4.w); a1 += (v1[jj].x * w4.x + v1[jj].y * w4.y) + (v1[jj].z * w4.z + v1[jj].w * w4.w); }
                lg0[e] = a0; lg1[e] = a1; }
#pragma unroll
            for (int e = 0; e < 16; ++e) { lg0[e] = wave_sum(lg0[e]); lg1[e] = wave_sum(lg1[e]); }
            int e1, e2; float w1, w2;
            route_select(lg0, rb, e1, e2, w1, w2);
            if (F.lane == 0) { sel_e[2 * lr] = e1; sel_e[2 * lr + 1] = e2; sel_w[2 * lr] = w1; sel_w[2 * lr + 1] = w2; }
            route_select(lg1, rb, e1, e2, w1, w2);
            if (F.lane == 0) { sel_e[2 * lr + 2] = e1; sel_e[2 * lr + 3] = e2; sel_w[2 * lr + 2] = w1; sel_w[2 * lr + 3] = w2; }
#pragma unroll
            for (int jj = 0; jj < 4; ++jj) { v0[jj] = n0[jj]; v1[jj] = n1[jj]; }
        }
        __syncthreads();
        int my_e = 0, my_rank = 0; float my_w = 0.f;
        if (F.tid < 256) { my_e = sel_e[F.tid]; my_w = sel_w[F.tid];
            const unsigned long long below = (1ull << F.lane) - 1ull;
#pragma unroll 1
            for (int ee = 0; ee < 16; ++ee) { const unsigned long long mk = __ballot(my_e == ee);
                if (my_e == ee) my_rank = __popcll(mk & below);
                if (F.lane == 0) wcnt[F.wave * 16 + ee] = __popcll(mk); } }
        __syncthreads();
        if (F.tid < 16) { const int n = wcnt[F.tid] + wcnt[16 + F.tid] + wcnt[32 + F.tid] + wcnt[48 + F.tid];
            ebase[F.tid] = n ? (int)atomicAdd(cnt + F.tid * 64, (unsigned)n) : 0; }
        __syncthreads();
        if (F.tid < 256) { int pos = ebase[my_e] + my_rank;
            for (int w = 0; w < F.wave; ++w) pos += wcnt[w * 16 + my_e];
            const int tok = rb0 * 128 + (F.tid >> 1), k = F.tid & 1;
            slot_t[my_e * CAP + pos] = tok; slot_w[my_e * CAP + pos] = my_w; tok_e[2 * tok + k] = my_e; tok_p[2 * tok + k] = pos; tok_w[2 * tok + k] = my_w; }
        __syncthreads();
    }
}


__device__ __forceinline__ void phase_norm2_route_mfma(Frame& F, int layer) {
    constexpr int AP = 1032;
    const float* mod = (const float*)(F.ws + WS_MOD) + (size_t)layer * 5 * 6144;
    const bf16* XB = (const bf16*)(F.ws + WS_XB); bf16* HB = (bf16*)(F.ws + WS_HB);
    const float* rw = F.in[I_RW]; const float* rb = F.in[I_RB]; const float* gsrc = F.in[I_NFG] + layer * D;
    int* tok_e = (int*)(F.ws + WS_TOKE); int* tok_p = (int*)(F.ws + WS_TOKP); float* tok_w = (float*)(F.ws + WS_TOKW);
    int* slot_t = (int*)(F.ws + WS_SLOTT) + layer * 16 * CAP;
    float* slot_w = (float*)(F.ws + WS_SLOTW) + layer * 16 * CAP;
    unsigned* cnt = F.ctl + CW_CNT + layer * 16 * 64;
    LAS bf16* AH = (LAS bf16*)F.lds; LAS bf16* AL = AH + 16 * AP;
    LAS float* cbv = (LAS float*)(F.lds + 2 * 16 * AP * 2);
    LAS float* rstdv = cbv + 16;
    LAS float* lgt = rstdv + 128;
    LAS int* sel_e = (LAS int*)(lgt + 128 * 16);
    LAS float* sel_w = (LAS float*)(sel_e + 256);
    LAS int* wcnt = (LAS int*)(sel_w + 256);
    LAS int* ebase = wcnt + 64;
    LAS float* cpart = (LAS float*)(ebase + 16);
    for (int rb0 = F.wg; rb0 < T / 128; rb0 += F.G) {
        const int b = (rb0 * 128) >> 13; const float* m = mod + (size_t)b * 6144;
        __syncthreads();
        { float cp[16];
#pragma unroll
          for (int e = 0; e < 16; ++e) cp[e] = 0.f;
          for (int k = F.tid; k < D; k += NTHR) { const float gmk = gsrc[k] * (1.f + m[4096 + k]), shk = m[3072 + k];
#pragma unroll
              for (int e4 = 0; e4 < 4; ++e4) { const f32x4 w4 = *(const f32x4*)(rw + (size_t)k * 16 + 4 * e4);
#pragma unroll
                  for (int q = 0; q < 4; ++q) { const int e = 4 * e4 + q; const float pr = gmk * w4[q]; const unsigned hi = f2bf(pr); const unsigned lo = f2bf(pr - bf2f(hi));
                      AH[e * AP + k] = (bf16)hi; AL[e * AP + k] = (bf16)lo; cp[e] += shk * w4[q]; } } }
#pragma unroll
          for (int e = 0; e < 16; ++e) { const float t = wave_sum(cp[e]); if (F.lane == 0) cpart[F.wave * 16 + e] = t; } }
        __syncthreads();
        if (F.tid < 16) { float t = 0.f;
#pragma unroll
            for (int w = 0; w < 8; ++w) t += cpart[w * 16 + F.tid];
            cbv[F.tid] = t; }
        f32x4 gm[4], sh[4];
#pragma unroll
        for (int jj = 0; jj < 4; ++jj) { const int o = ROFF(F.lane, jj); gm[jj] = *(const f32x4*)(gsrc + o) * (1.f + *(const f32x4*)(m + 4096 + o)); sh[jj] = *(const f32x4*)(m + 3072 + o); }
        const int rbase = rb0 * 128 + F.wave * 16;
        f32x4 v0[4], v1[4]; row_load_bf(XB + (size_t)rbase * D, F.lane, v0); row_load_bf(XB + (size_t)(rbase + 1) * D, F.lane, v1);
#pragma unroll 1
        for (int j = 0; j < 16; j += 2) {
            const int lr = F.wave * 16 + j, row = rbase + j;
            f32x4 n0[4], n1[4];
            { const int nr = (j + 2 < 16) ? row + 2 : row; row_load_bf(XB + (size_t)nr * D, F.lane, n0); row_load_bf(XB + (size_t)(nr + 1) * D, F.lane, n1); }
            const float rstd0 = rsqrtf(row_sumsq(v0) * (1.f / D) + EPS), rstd1 = rsqrtf(row_sumsq(v1) * (1.f / D) + EPS);
#pragma unroll
            for (int jj = 0; jj < 4; ++jj) { v0[jj] = v0[jj] * rstd0 * gm[jj] + sh[jj]; v1[jj] = v1[jj] * rstd1 * gm[jj] + sh[jj]; }
            row_store_bf16(HB + (size_t)row * D, v0, F.lane); row_store_bf16(HB + (size_t)(row + 1) * D, v1, F.lane);
            if (F.lane == 0) { rstdv[lr] = rstd0; rstdv[lr + 1] = rstd1; }
#pragma unroll
            for (int jj = 0; jj < 4; ++jj) { v0[jj] = n0[jj]; v1[jj] = n1[jj]; }
        }
        __syncthreads();
        { const int fr = F.lane & 15, fq = F.lane >> 4;
          f32x4 acc = {0.f, 0.f, 0.f, 0.f};
          const bf16* xr = XB + (size_t)(rb0 * 128 + 16 * F.wave + fr) * D + 8 * fq;
          const LAS bf16* ah = AH + fr * AP + 8 * fq; const LAS bf16* al = AL + fr * AP + 8 * fq;
#pragma unroll 8
          for (int s2 = 0; s2 < 32; ++s2) { const bf16x8 xb = *(const bf16x8*)(xr + 32 * s2);
              acc = __builtin_amdgcn_mfma_f32_16x16x32_bf16(*(const LAS bf16x8*)(ah + 32 * s2), xb, acc, 0, 0, 0);
              acc = __builtin_amdgcn_mfma_f32_16x16x32_bf16(*(const LAS bf16x8*)(al + 32 * s2), xb, acc, 0, 0, 0); }
          const int lrow = 16 * F.wave + fr; const float rs = rstdv[lrow];
#pragma unroll
          for (int i = 0; i < 4; ++i) lgt[lrow * 16 + 4 * fq + i] = rs * acc[i] + cbv[4 * fq + i]; }
        __syncthreads();
        if (F.tid < 128) { float lg[16];
#pragma unroll
            for (int e4 = 0; e4 < 4; ++e4) { const f32x4 t = *(const LAS f32x4*)(lgt + F.tid * 16 + 4 * e4); lg[4 * e4] = t.x; lg[4 * e4 + 1] = t.y; lg[4 * e4 + 2] = t.z; lg[4 * e4 + 3] = t.w; }
            int e1, e2; float w1, w2; route_select(lg, rb, e1, e2, w1, w2);
            sel_e[2 * F.tid] = e1; sel_e[2 * F.tid + 1] = e2; sel_w[2 * F.tid] = w1; sel_w[2 * F.tid + 1] = w2; }
        __syncthreads();
        int my_e = 0, my_rank = 0; float my_w = 0.f;
        if (F.tid < 256) { my_e = sel_e[F.tid]; my_w = sel_w[F.tid];
            const unsigned long long below = (1ull << F.lane) - 1ull;
#pragma unroll 1
            for (int ee = 0; ee < 16; ++ee) { const unsigned long long mk = __ballot(my_e == ee);
                if (my_e == ee) my_rank = __popcll(mk & below);
                if (F.lane == 0) wcnt[F.wave * 16 + ee] = __popcll(mk); } }
        __syncthreads();
        if (F.tid < 16) { const int n = wcnt[F.tid] + wcnt[16 + F.tid] + wcnt[32 + F.tid] + wcnt[48 + F.tid];
            ebase[F.tid] = n ? (int)atomicAdd(cnt + F.tid * 64, (unsigned)n) : 0; }
        __syncthreads();
        if (F.tid < 256) { int pos = ebase[my_e] + my_rank;
            for (int w = 0; w < F.wave; ++w) pos += wcnt[w * 16 + my_e];
            const int tok = rb0 * 128 + (F.tid >> 1), k = F.tid & 1;
            slot_t[my_e * CAP + pos] = tok; slot_w[my_e * CAP + pos] = my_w; tok_e[2 * tok + k] = my_e; tok_p[2 * tok + k] = pos; tok_w[2 * tok + k] = my_w; }
    }
    __syncthreads();
}

constexpr int MOEMAP_OFF = LDS_BYTES - 256;
__device__ __forceinline__ LAS int* moe_map(Frame& F, int layer) {
    LAS int* mm = (LAS int*)(F.lds + MOEMAP_OFF);
    __syncthreads();
    if (F.tid < 64) { const unsigned* cnt = F.ctl + CW_CNT + layer * 16 * 64;
        const int n = (F.tid < 16) ? (int)__hip_atomic_load(cnt + F.tid * 64, __ATOMIC_RELAXED, __HIP_MEMORY_SCOPE_AGENT) : 0;
        const int pad = (n + 255) & ~255; int x = pad;
#pragma unroll
        for (int o = 1; o < 16; o <<= 1) { const int t = __shfl_up(x, o); if (F.lane >= o) x += t; }
        if (F.tid < 16) { mm[F.tid] = n; mm[16 + F.tid] = x - pad; } }
    __syncthreads();
    return mm;
}
struct RowGather { const bf16* base; const int* list; int n; __device__ __forceinline__ const bf16* operator()(int m) const { const int tok = m < n ? list[m] : 0; return base + (size_t)tok * D; } };

__device__ __forceinline__ void phase_moe_gateup(Frame& F, int layer) {
    LAS int* mm = moe_map(F, layer);
    const bf16* HB = (const bf16*)(F.ws + WS_HB); bf16* HID = (bf16*)(F.ws + WS_HID);
    const int* slot_t = (const int*)(F.ws + WS_SLOTT) + layer * 16 * CAP; const float* slot_w = (const float*)(F.ws + WS_SLOTW) + layer * 16 * CAP;
    int ubase = 0;
#pragma unroll 1
    for (int e = 0; e < 16; ++e) {
        const int n = mm[e], hbe = mm[16 + e], rt = (n + 127) >> 7, nu = rt * 8;
        const bf16* Wt = (const bf16*)(F.ws + WS_WGU) + (size_t)(layer * 16 + e) * 1024 * 1024;
        RowGather rp{HB, slot_t + e * CAP, n};
        int first = (F.wg - ubase % F.G + F.G) % F.G;
        for (int u = first; u < nu; u += F.G) {
            const int mt = u / 8, nt = u % 8;
            auto epi = [&](int mb, int nb, const f32x16& c0, const f32x16& c1, int lane) {
                const int h = lane >> 5, cl = lane & 31; const int col = (nb >> 1) + cl;
#pragma unroll
                for (int i = 0; i < 16; ++i) { const int r = mb + crow(i, h);
                    if (r < n) { const float w = slot_w[e * CAP + r]; HID[(size_t)(hbe + r) * FF + col] = (bf16)f2bf(w * silu_f(c0[i]) * c1[i]); } }
            };
            sgemm_tile(rp, Wt, D, mt * 128, nt * 128, epi, F.wave, F.lane);
        }
        ubase += nu;
    }
}
__device__ __forceinline__ void phase_moe_down(Frame& F, int layer) {
    LAS int* mm = moe_map(F, layer);
    const bf16* HID = (const bf16*)(F.ws + WS_HID); bf16* Y = (bf16*)(F.ws + WS_Y);
    int ubase = 0;
#pragma unroll 1
    for (int e = 0; e < 16; ++e) {
        const int n = mm[e], hbe = mm[16 + e], rt = (n + 127) >> 7, nu = rt * 8;
        const bf16* Wt = (const bf16*)(F.ws + WS_WDN) + (size_t)(layer * 16 + e) * 1024 * 512;
        RowLin rp{HID + (size_t)hbe * FF, (size_t)FF};
        int first = (F.wg - ubase % F.G + F.G) % F.G;
        for (int u = first; u < nu; u += F.G) {
            const int mt = u / 8, nt = u % 8;
            auto epi = [&](int mb, int nb, const f32x16& c0, const f32x16& c1, int lane) {
                const int h = lane >> 5, cl = lane & 31;
#pragma unroll
                for (int i = 0; i < 16; ++i) { const int r = mb + crow(i, h);
                    if (r < n) { bf16* yr = Y + (size_t)(hbe + r) * D + nb + cl; yr[0] = (bf16)f2bf(c0[i]); yr[32] = (bf16)f2bf(c1[i]); } }
            };
            sgemm_tile(rp, Wt, FF, mt * 128, nt * 128, epi, F.wave, F.lane);
        }
        ubase += nu;
    }
}

template <bool FINAL>
__device__ __forceinline__ void phase_combine(Frame& F, int layer) {
    LAS int* hbs = moe_map(F, layer) + 16;
    const int gw = F.wg * NWAVES + F.wave, NGW = F.G * NWAVES;
    const float* mod = (const float*)(F.ws + WS_MOD);
    const int* tok_e = (const int*)(F.ws + WS_TOKE); const int* tok_p = (const int*)(F.ws + WS_TOKP);
    const unsigned char* Y8 = (const unsigned char*)(F.ws + WS_Y);
    float* X = F.out; bf16* XB = (bf16*)(F.ws + WS_XB); bf16* HB = (bf16*)(F.ws + WS_HB);
    for (int blk = gw; blk < T / 16; blk += NGW) {
        const int rbase = blk * 16, b = rbase >> 13;
        f32x4 g2v[4], gm[4], shv[4];
        { const float* g2 = mod + ((size_t)layer * 5 + b) * 6144 + 5120;
#pragma unroll
          for (int j = 0; j < 4; ++j) { const int o = ROFF(F.lane, j); g2v[j] = *(const f32x4*)(g2 + o) * (1.f / YSCALE);
              if (FINAL) { gm[j] = *(const f32x4*)(F.in[I_FNG] + o); shv[j] = (f32x4){0.f, 0.f, 0.f, 0.f}; }
              else { const float* m = mod + ((size_t)(layer + 1) * 5 + b) * 6144; gm[j] = *(const f32x4*)(F.in[I_NMG] + (layer + 1) * D + o) * (1.f + *(const f32x4*)(m + 1024 + o)); shv[j] = *(const f32x4*)(m + o); } } }
        int4 te = *(const int4*)(tok_e + 2 * rbase), tp = *(const int4*)(tok_p + 2 * rbase);
        u32x4 xa[2][2], xn[2][2]; u32x2 ya[2][2][2], yn[2][2][2];
        { const int s00 = hbs[te.x] + tp.x, s01 = hbs[te.y] + tp.y, s10 = hbs[te.z] + tp.z, s11 = hbs[te.w] + tp.w;
#pragma unroll
          for (int jj = 0; jj < 2; ++jj) { const int o = 512 * jj + 8 * F.lane;
              xa[0][jj] = *(const u32x4*)(XB + (size_t)rbase * D + o); xa[1][jj] = *(const u32x4*)(XB + (size_t)(rbase + 1) * D + o);
              ya[0][0][jj] = *(const u32x2*)(Y8 + (size_t)s00 * D + o); ya[0][1][jj] = *(const u32x2*)(Y8 + (size_t)s01 * D + o);
              ya[1][0][jj] = *(const u32x2*)(Y8 + (size_t)s10 * D + o); ya[1][1][jj] = *(const u32x2*)(Y8 + (size_t)s11 * D + o); } }
        te = *(const int4*)(tok_e + 2 * (rbase + 2)); tp = *(const int4*)(tok_p + 2 * (rbase + 2));
#pragma unroll 1
        for (int jr = 0; jr < 16; jr += 2) {
            const int row = rbase + jr;
            if (jr + 2 < 16) { const int nr = row + 2;
                const int s00 = hbs[te.x] + tp.x, s01 = hbs[te.y] + tp.y, s10 = hbs[te.z] + tp.z, s11 = hbs[te.w] + tp.w;
#pragma unroll
                for (int jj = 0; jj < 2; ++jj) { const int o = 512 * jj + 8 * F.lane;
                    xn[0][jj] = *(const u32x4*)(XB + (size_t)nr * D + o); xn[1][jj] = *(const u32x4*)(XB + (size_t)(nr + 1) * D + o);
                    yn[0][0][jj] = *(const u32x2*)(Y8 + (size_t)s00 * D + o); yn[0][1][jj] = *(const u32x2*)(Y8 + (size_t)s01 * D + o);
                    yn[1][0][jj] = *(const u32x2*)(Y8 + (size_t)s10 * D + o); yn[1][1][jj] = *(const u32x2*)(Y8 + (size_t)s11 * D + o); }
                const int n2 = (jr + 4 < 16) ? row + 4 : row; te = *(const int4*)(tok_e + 2 * n2); tp = *(const int4*)(tok_p + 2 * n2); }
            f32x4 v[2][4];
#pragma unroll
            for (int q = 0; q < 2; ++q)
#pragma unroll
                for (int jj = 0; jj < 2; ++jj) { const u32x4 xw = xa[q][jj]; const u32x2 a0 = ya[q][0][jj], a1 = ya[q][1][jj];
                    v[q][2 * jj] = (f32x4){bflo(xw.x), bfhi(xw.x), bflo(xw.y), bfhi(xw.y)} + g2v[2 * jj] * (un_fp8x4(a0.x) + un_fp8x4(a1.x));
                    v[q][2 * jj + 1] = (f32x4){bflo(xw.z), bfhi(xw.z), bflo(xw.w), bfhi(xw.w)} + g2v[2 * jj + 1] * (un_fp8x4(a0.y) + un_fp8x4(a1.y)); }
            const float rstd0 = rsqrtf(row_sumsq(v[0]) * (1.f / D) + EPS), rstd1 = rsqrtf(row_sumsq(v[1]) * (1.f / D) + EPS);
#pragma unroll
            for (int q = 0; q < 2; ++q) { const float rstd = q ? rstd1 : rstd0; const size_t ro = (size_t)(row + q) * D;
                if (FINAL) {
#pragma unroll
                    for (int j = 0; j < 4; ++j) *(f32x4*)(X + ro + ROFF(F.lane, j)) = v[q][j] * rstd * gm[j];
                } else {
                    row_store_bf16(XB + ro, v[q], F.lane);
#pragma unroll
                    for (int j = 0; j < 4; ++j) v[q][j] = v[q][j] * rstd * gm[j] + shv[j];
                    row_store_bf16(HB + ro, v[q], F.lane);
                }
            }
#pragma unroll
            for (int q = 0; q < 2; ++q)
#pragma unroll
                for (int jj = 0; jj < 2; ++jj) { xa[q][jj] = xn[q][jj]; ya[q][0][jj] = yn[q][0][jj]; ya[q][1][jj] = yn[q][1][jj]; }
        }
    }
    __syncthreads();
}

__device__ __forceinline__ void phase_pw1(Frame& F) {
    const bf16* HB = (const bf16*)(F.ws + WS_HB); const bf16* Wt = (const bf16*)(F.ws + WS_WPW1); bf16* U = (bf16*)(F.ws + WS_U);
    const float* bias = F.in[I_PW1B];
    RowLin rp{HB, (size_t)D};
    for (int u = F.wg; u < (T / 128) * 16; u += F.G) {
        const int mt = u / 16, nt = u % 16;
        auto epi = [&](int mb, int nb, const f32x16& c0, const f32x16& c1, int lane) {
            const int h = lane >> 5, cl = lane & 31, col = (nb >> 1) + cl; const float ba = bias[col], bg = bias[1024 + col];
#pragma unroll
            for (int i = 0; i < 16; ++i) U[(size_t)(mb + crow(i, h)) * D + col] = (bf16)f2bf((c0[i] + ba) * sigmoid_f(c1[i] + bg));
        };
        sgemm_tile(rp, Wt, D, mt * 128, nt * 128, epi, F.wave, F.lane);
    }
}
__device__ __forceinline__ void phase_dwconv(Frame& F) {
    const bf16* U = (const bf16*)(F.ws + WS_U); bf16* V1 = (bf16*)(F.ws + WS_V1);
    const float* dww = F.in[I_DWW]; const float* dwb = F.in[I_DWB]; const float* lng = F.in[I_LNG]; const float* lnb = F.in[I_LNB];
    const int gw = F.wg * NWAVES + F.wave, NGW = F.G * NWAVES;
    for (int row = gw; row < T; row += NGW) {
        const int l = row & (L - 1);
        f32x4 acc[4];
#pragma unroll
        for (int j = 0; j < 4; ++j) acc[j] = *(const f32x4*)(dwb + 4 * F.lane + 256 * j);
        for (int tp = 0; tp < CONVW; ++tp) { const int ll = l + tp - 15; if (ll < 0 || ll >= L) continue;
            const bf16* ur = U + (size_t)(row + tp - 15) * D; const float* wr = dww + (size_t)tp * D;
#pragma unroll
            for (int j = 0; j < 4; ++j) { const int o = 4 * F.lane + 256 * j; const u32x2 uu = *(const u32x2*)(ur + o); const f32x4 ww = *(const f32x4*)(wr + o);
                acc[j].x += bflo(uu.x) * ww.x; acc[j].y += bfhi(uu.x) * ww.y; acc[j].z += bflo(uu.y) * ww.z; acc[j].w += bfhi(uu.y) * ww.w; } }
        float s = 0.f;
#pragma unroll
        for (int j = 0; j < 4; ++j) s += (acc[j].x + acc[j].y) + (acc[j].z + acc[j].w);
        const float mean = wave_sum(s) * (1.f / D); float q = 0.f;
#pragma unroll
        for (int j = 0; j < 4; ++j) { acc[j] = acc[j] - mean; q += (acc[j].x * acc[j].x + acc[j].y * acc[j].y) + (acc[j].z * acc[j].z + acc[j].w * acc[j].w); }
        const float rstd = rsqrtf(wave_sum(q) * (1.f / D) + EPS);
#pragma unroll
        for (int j = 0; j < 4; ++j) { const int o = 4 * F.lane + 256 * j; const f32x4 gg = *(const f32x4*)(lng + o), bb = *(const f32x4*)(lnb + o);
            f32x4 y = acc[j] * rstd * gg + bb; y.x = silu_f(y.x); y.y = silu_f(y.y); y.z = silu_f(y.z); y.w = silu_f(y.w); acc[j] = y; }
        row_store_bf16(V1 + (size_t)row * D, acc, F.lane);
    }
}


namespace pg {
constexpr int BM = 256, BK = 64, HALF = 128, HTB = HALF * BK * 2, STAGE_BYTES = 8 * HTB;
constexpr int TAB_OFF = STAGE_BYTES;
__device__ __forceinline__ int lds_byte(int r, int c) { const int st = (r >> 4) * 2 + (c >> 5), rr = r & 15, cc = c & 31, ob = rr * 64 + cc * 2; return st * 1024 + (ob ^ (((ob >> 9) & 1) << 5)); }
__device__ __forceinline__ void stage_rc(int b, int& R, int& C) { const int st = b / 1024, sb = b % 1024, swz = sb ^ (((sb >> 9) & 1) << 5); R = (st >> 1) * 16 + swz / 64; C = (st & 1) * 32 + (swz % 64) / 2; }
__device__ __forceinline__ int perm32(int rho) { const int n = rho >> 4, i = rho & 15; return 8 * (i >> 2) + 4 * n + (i & 3); }
__device__ __forceinline__ unsigned cvt_pk_bf16(float lo, float hi) { unsigned r; asm volatile("v_cvt_pk_bf16_f32 %0, %1, %2" : "=v"(r) : "v"(lo), "v"(hi)); return r; }

struct GU { const char* B; int p0, p1, p2, p3; };

template <class Epi, class Sched>
__device__ __forceinline__ void gemm_phase(LAS unsigned char* lds, const char* Abase, const int K, const Sched& S, const Epi& E) {
    const int tid = threadIdx.x, wid = __builtin_amdgcn_readfirstlane(tid >> 6), lane = tid & 63, wr = wid >> 2, wc = wid & 3, fr = lane & 15, fq = lane >> 4;
    const int nt = K / BK;
    int sR[2], sC[2]; unsigned voffB[2];
#pragma unroll
    for (int i = 0; i < 2; ++i) { int R, C; stage_rc(tid * 16 + i * 8192, R, C); sR[i] = R; sC[i] = C; const int Rb = Epi::PERM ? ((R & ~31) + perm32(R & 31)) : R; voffB[i] = (unsigned)(Rb * K + C) * 2u; }
    const size_t kstep = (size_t)(BK * 2);
    const size_t hstep = (size_t)HALF * K * 2;
    const unsigned ldsw = (unsigned)wid * 1024u;
    const int aoff = lds_byte(wr * 64 + fr, fq * 8), boff = lds_byte(wc * 32 + fr, fq * 8);
#define PG_SA(b, h) (((b) * 2 + (h)) * HTB)
#define PG_SB(b, h) ((4 + (b) * 2 + (h)) * HTB)
#define PG_STAGE(bufoff, gbase, voff) do { _Pragma("unroll") for (int _i = 0; _i < 2; ++_i) \
        __builtin_amdgcn_global_load_lds((const unsigned*)((const char*)(gbase) + (voff)[_i]), (LAS unsigned*)(lds + (bufoff) + ldsw + _i * 8192), 16, 0, 0); } while (0)
#define PG_LDA(dst, b, h) do { _Pragma("unroll") for (int m = 0; m < 4; ++m) _Pragma("unroll") for (int k = 0; k < 2; ++k) dst[m][k] = *(const LAS bf16x8*)(lds + PG_SA(b, h) + aoff + m * 2048 + k * 1024); } while (0)
#define PG_LDB(dst, b, h) do { _Pragma("unroll") for (int n = 0; n < 2; ++n) _Pragma("unroll") for (int k = 0; k < 2; ++k) dst[n][k] = *(const LAS bf16x8*)(lds + PG_SB(b, h) + boff + n * 2048 + k * 1024); } while (0)
#define PG_MMA(ai, bj, At, Bt) do { __builtin_amdgcn_s_setprio(1); _Pragma("unroll") for (int m = 0; m < 4; ++m) _Pragma("unroll") for (int n = 0; n < 2; ++n) _Pragma("unroll") for (int k = 0; k < 2; ++k) \
        acc[ai][bj][m][n] = __builtin_amdgcn_mfma_f32_16x16x32_bf16(Bt[n][k], At[m][k], acc[ai][bj][m][n], 0, 0, 0); __builtin_amdgcn_s_setprio(0); } while (0)
#define PG_WAIT_V(n) asm volatile("s_waitcnt vmcnt(" #n ")" ::: "memory")
#define PG_WAIT_L(n) asm volatile("s_waitcnt lgkmcnt(" #n ")" ::: "memory")
#define PG_BAR __builtin_amdgcn_s_barrier()
#define PG_SCHED __builtin_amdgcn_sched_barrier(0)
    GU cur, nxt; int ui = 0;
    if (!S.next(0, cur)) return;
    f32x4 acc[2][2][4][2];
#pragma unroll
    for (int a = 0; a < 2; ++a)
#pragma unroll
        for (int b = 0; b < 2; ++b)
#pragma unroll
            for (int m = 0; m < 4; ++m)
#pragma unroll
                for (int n = 0; n < 2; ++n) acc[a][b][m][n] = (f32x4){0.f, 0.f, 0.f, 0.f};
    bf16x8 At[4][2], B0[2][2], B1[2][2];
    if constexpr (Sched::GATHER) { S.stage_table(cur, 0, lds, wid, lane); PG_WAIT_V(0); PG_BAR; }
    unsigned voC[2][2], voN[2][2];
#pragma unroll
    for (int h = 0; h < 2; ++h)
#pragma unroll
        for (int i = 0; i < 2; ++i) { voC[h][i] = S.voff(cur, 0, lds, h * HALF + sR[i], sC[i]); voN[h][i] = voC[h][i]; }
    const char* cB = cur.B;
    PG_STAGE(PG_SB(0, 0), cB, voffB); PG_STAGE(PG_SB(0, 1), cB + hstep, voffB); PG_STAGE(PG_SA(0, 0), Abase, voC[0]); PG_STAGE(PG_SA(0, 1), Abase, voC[1]);
    if (wr == 1) PG_BAR;
    PG_WAIT_V(2); PG_BAR;
    PG_STAGE(PG_SB(1, 0), cB + kstep, voffB); PG_STAGE(PG_SA(1, 0), Abase + kstep, voC[0]); PG_STAGE(PG_SB(1, 1), cB + hstep + kstep, voffB);
    PG_WAIT_V(6); PG_BAR;
    for (;;) {
        const bool has_next = S.next(ui + 1, nxt);
        if constexpr (Sched::GATHER) { if (has_next) S.stage_table(nxt, (ui + 1) & 1, lds, wid, lane); }
        const char* nB = has_next ? nxt.B : cB;
        for (int t = 0; t < nt; t += 2) {
            const bool last = (t == nt - 2);
            if (last && has_next) {
#pragma unroll
                for (int h = 0; h < 2; ++h)
#pragma unroll
                    for (int i = 0; i < 2; ++i) voN[h][i] = S.voff(nxt, (ui + 1) & 1, lds, h * HALF + sR[i], sC[i]);
            }
            unsigned vo2[2][2];
#pragma unroll
            for (int h = 0; h < 2; ++h)
#pragma unroll
                for (int i = 0; i < 2; ++i) vo2[h][i] = last ? voN[h][i] : voC[h][i];
            const char* a1 = Abase + (size_t)(t + 1) * kstep;
            const char* a2 = last ? Abase : Abase + (size_t)(t + 2) * kstep; const char* b2 = last ? nB : cB + (size_t)(t + 2) * kstep;
            const char* a3 = a2 + kstep; const char* b3 = b2 + kstep;
            PG_LDB(B0, 0, 0); PG_LDB(B1, 0, 1); PG_SCHED; PG_LDA(At, 0, 0); PG_STAGE(PG_SA(1, 1), a1, voC[1]);
            PG_WAIT_V(8); PG_WAIT_L(0); PG_BAR; PG_MMA(0, 0, At, B0); PG_MMA(0, 1, At, B1); PG_BAR; PG_SCHED;
            PG_LDA(At, 0, 1); PG_STAGE(PG_SB(0, 0), b2, voffB); PG_STAGE(PG_SB(0, 1), b2 + hstep, voffB); PG_STAGE(PG_SA(0, 0), a2, vo2[0]);
            PG_WAIT_V(8); PG_WAIT_L(0); PG_BAR; PG_MMA(1, 0, At, B0); PG_MMA(1, 1, At, B1); PG_BAR; PG_SCHED;
            PG_LDB(B0, 1, 0); PG_LDB(B1, 1, 1); PG_SCHED; PG_LDA(At, 1, 0); PG_STAGE(PG_SA(0, 1), a2, vo2[1]);
            PG_WAIT_V(8); PG_WAIT_L(0); PG_BAR; PG_MMA(0, 0, At, B0); PG_MMA(0, 1, At, B1); PG_BAR; PG_SCHED;
            PG_LDA(At, 1, 1); PG_STAGE(PG_SB(1, 0), b3, voffB); PG_STAGE(PG_SB(1, 1), b3 + hstep, voffB); PG_STAGE(PG_SA(1, 0), a3, vo2[0]);
            PG_WAIT_V(8); PG_WAIT_L(0); PG_BAR; PG_MMA(1, 0, At, B0); PG_MMA(1, 1, At, B1); PG_BAR; PG_SCHED;
        }
        if (wr == 0) PG_BAR;
        E(acc, cur, wr, wc, fr, fq);
        if (!has_next) break;
#pragma unroll
        for (int a = 0; a < 2; ++a)
#pragma unroll
            for (int b = 0; b < 2; ++b)
#pragma unroll
                for (int m = 0; m < 4; ++m)
#pragma unroll
                    for (int n = 0; n < 2; ++n) acc[a][b][m][n] = (f32x4){0.f, 0.f, 0.f, 0.f};
        cur = nxt; cB = nB; ++ui;
#pragma unroll
        for (int h = 0; h < 2; ++h)
#pragma unroll
            for (int i = 0; i < 2; ++i) voC[h][i] = voN[h][i];
        if (wr == 1) PG_BAR;
    }
    PG_WAIT_V(0);
    PG_BAR;
#undef PG_SA
#undef PG_SB
#undef PG_STAGE
#undef PG_LDA
#undef PG_LDB
#undef PG_MMA
#undef PG_WAIT_V
#undef PG_WAIT_L
#undef PG_BAR
#undef PG_SCHED
}

__device__ __forceinline__ void static_tile(int L, int nM, int nN, int& pm, int& pn) {
    const int nwg = nM * nN; int wgid = L; { const int q = nwg / 8, r = nwg % 8, xcd = wgid % 8, off = wgid / 8; wgid = (xcd < r ? xcd * (q + 1) : r * (q + 1) + (xcd - r) * q) + off; }
    const int nig = 8 * nN, gid = wgid / nig, fm = gid * 8, gsz = (nM - fm) < 8 ? (nM - fm) : 8;
    pm = fm + ((wgid % nig) % gsz); pn = (wgid % nig) / gsz;
}
struct DenseSched {
    static constexpr bool GATHER = false;
    const char* Bt; int K, nM, nN, G, c, xn, xm0, xpn;
    __device__ __forceinline__ bool next(int i, GU& u) const {
        const int L = i * G + c, nmain = nM * nN; int pm, pn;
        if (L < nmain) static_tile(L, nM, nN, pm, pn); else if (L < nmain + xn) { pm = xm0 + (L - nmain); pn = xpn; } else return false;
        u.B = Bt + (size_t)pn * BM * K * 2; u.p0 = pm; u.p1 = pn; u.p2 = 0; u.p3 = 0; return true;
    }
    __device__ __forceinline__ unsigned voff(const GU& u, int, LAS unsigned char*, int R, int C) const { return (unsigned)(((u.p0 * BM + R) * K + C) * 2); }
    __device__ __forceinline__ void stage_table(const GU&, int, LAS unsigned char*, int, int) const {}
};
template <bool GATHER_> struct MoeSched {
    static constexpr bool GATHER = GATHER_;
    const char* Wt; size_t wstride; int K; const int* list; LAS int* mm; int G, c;
    __device__ __forceinline__ bool next(int i, GU& u) const {
        int L = i * G + c;
        for (int e = 0; e < 16; ++e) { const int n = mm[e], nu = ((n + 255) >> 8) * 4;
            if (L < nu) { const int rt = L >> 2, pn = L & 3; u.B = Wt + (size_t)e * wstride + (size_t)pn * BM * K * 2; u.p0 = e; u.p1 = rt; u.p2 = pn; u.p3 = mm[16 + e]; return true; }
            L -= nu; }
        return false;
    }
    __device__ __forceinline__ unsigned voff(const GU& u, int buf, LAS unsigned char* lds, int R, int C) const {
        if constexpr (GATHER_) { const int tok = ((const LAS int*)(lds + TAB_OFF))[buf * 256 + R]; return (unsigned)((tok * K + C) * 2); }
        else return (unsigned)(((u.p3 + u.p1 * BM + R) * K + C) * 2);
    }
    __device__ __forceinline__ void stage_table(const GU& u, int buf, LAS unsigned char* lds, int wid, int lane) const {
        if constexpr (GATHER_) { const int r = (wid & 3) * 64 + lane;
            __builtin_amdgcn_global_load_lds((const unsigned*)(list + u.p0 * CAP + u.p1 * BM + r), (LAS unsigned*)(lds + TAB_OFF + buf * 1024 + (wid & 3) * 256), 4, 0, 0); }
    }
};

struct EpiInProj {
    static constexpr bool PERM = false;
    unsigned char* ws;
    __device__ __forceinline__ void operator()(const f32x4 (&acc)[2][2][4][2], const GU& u, int wr, int wc, int fr, int fq) const {
        const int pm = u.p0, pn = u.p1; const bool isctx = pm >= T / BM;
        float inv[4];
#pragma unroll
        for (int j = 0; j < 4; ++j) inv[j] = exp2f(-(float)(4 * fq + j) * (13.287712379549449f / 16.f));
#pragma unroll
        for (int bj = 0; bj < 2; ++bj) {
            const int cb = pn * BM + bj * HALF + wc * 32;
            bf16* dst; int pitch, cbase; bool rope = false;
            if (cb < 512) { dst = (bf16*)(ws + WS_UF); pitch = 512; cbase = 0; }
            else if (cb < 1024) { dst = (bf16*)(ws + WS_Q); pitch = 512; cbase = 512; rope = true; }
            else if (cb < 1152) { dst = isctx ? (bf16*)(ws + WS_CK) : (bf16*)(ws + WS_K); pitch = 128; cbase = 1024; rope = !isctx; }
            else { dst = isctx ? (bf16*)(ws + WS_CV) : (bf16*)(ws + WS_V); pitch = 128; cbase = 1152; }
            const bool bycol = ((cb >> 5) & 1) != 0;
#pragma unroll
            for (int ai = 0; ai < 2; ++ai)
#pragma unroll
                for (int m = 0; m < 4; ++m) {
                    const int row = pm * BM + ai * HALF + wr * 64 + m * 16 + fr;
                    f32x4 v0 = acc[ai][bj][m][0], v1 = acc[ai][bj][m][1];
                    if (rope) { const int l = row & (L - 1); const float pos = (float)(bycol ? (l & 63) : (l >> 6));
#pragma unroll
                        for (int j = 0; j < 4; ++j) { const float ang = pos * inv[j], cs = __cosf(ang), sn = __sinf(ang); const float x1 = v0[j], x2 = v1[j]; v0[j] = x1 * cs - x2 * sn; v1[j] = x1 * sn + x2 * cs; } }
                    const int orow = isctx ? row - T : row;
                    if (FAST_ATTN && cb >= 1152) {
                        const int kp = isctx ? CL : L, bb = isctx ? (orow >> 8) : (orow >> 13), key = isctx ? (orow & (CL - 1)) : (orow & (L - 1));
#pragma unroll
                        for (int n = 0; n < 2; ++n)
#pragma unroll
                            for (int j = 0; j < 4; ++j) { const int c = (cb - 1152) + 16 * n + 4 * fq + j;
                                dst[((size_t)bb * 128 + c) * kp + key] = (bf16)f2bf(n ? v1[j] : v0[j]); }
                        continue;
                    }
                    bf16* o = dst + (size_t)orow * pitch + (cb - cbase) + 4 * fq;
                    u32x2 w0, w1; w0.x = cvt_pk_bf16(v0[0], v0[1]); w0.y = cvt_pk_bf16(v0[2], v0[3]); w1.x = cvt_pk_bf16(v1[0], v1[1]); w1.y = cvt_pk_bf16(v1[2], v1[3]);
                    *(u32x2*)o = w0; *(u32x2*)(o + 16) = w1;
                }
        }
    }
};
struct EpiRes {
    static constexpr bool PERM = false;
    const float* base; float* X; const float* gate; const float* bias;
    __device__ __forceinline__ void operator()(const f32x4 (&acc)[2][2][4][2], const GU& u, int wr, int wc, int fr, int fq) const {
        const int row0 = u.p0 * BM + wr * 64 + fr, col0 = u.p1 * BM + wc * 32 + 4 * fq; const int b = (u.p0 * BM) >> 13;
        f32x4 gv[2][2], bv[2][2];
#pragma unroll
        for (int bj = 0; bj < 2; ++bj)
#pragma unroll
            for (int n = 0; n < 2; ++n) { gv[bj][n] = *(const f32x4*)(gate + (size_t)b * 6144 + col0 + bj * HALF + n * 16); bv[bj][n] = bias ? *(const f32x4*)(bias + col0 + bj * HALF + n * 16) : (f32x4){0.f, 0.f, 0.f, 0.f}; }
#pragma unroll
        for (int ai = 0; ai < 2; ++ai)
#pragma unroll
            for (int mp = 0; mp < 2; ++mp) {
                f32x4 bs[2][2][2];
#pragma unroll
                for (int mm = 0; mm < 2; ++mm) { const size_t off = (size_t)(row0 + ai * HALF + (2 * mp + mm) * 16) * D + col0;
#pragma unroll
                    for (int bj = 0; bj < 2; ++bj)
#pragma unroll
                        for (int n = 0; n < 2; ++n) bs[mm][bj][n] = *(const f32x4*)(base + off + bj * HALF + n * 16); }
#pragma unroll
                for (int mm = 0; mm < 2; ++mm) { const int m = 2 * mp + mm; const size_t off = (size_t)(row0 + ai * HALF + m * 16) * D + col0;
#pragma unroll
                    for (int bj = 0; bj < 2; ++bj)
#pragma unroll
                        for (int n = 0; n < 2; ++n) *(f32x4*)(X + off + bj * HALF + n * 16) = bs[mm][bj][n] + gv[bj][n] * (acc[ai][bj][m][n] + bv[bj][n]); }
                asm volatile("" ::: "memory"); }
    }
};
template <bool BASEBF> struct EpiResB {
    static constexpr bool PERM = false;
    const float* basef; bf16* XB; const float* gate; const float* bias;
    __device__ __forceinline__ void operator()(const f32x4 (&acc)[2][2][4][2], const GU& u, int wr, int wc, int fr, int fq) const {
        const int row0 = u.p0 * BM + wr * 64 + fr, col0 = u.p1 * BM + wc * 32 + 4 * fq; const int b = (u.p0 * BM) >> 13;
        f32x4 gv[2][2], bv[2][2];
#pragma unroll
        for (int bj = 0; bj < 2; ++bj)
#pragma unroll
            for (int n = 0; n < 2; ++n) { gv[bj][n] = *(const f32x4*)(gate + (size_t)b * 6144 + col0 + bj * HALF + n * 16); bv[bj][n] = bias ? *(const f32x4*)(bias + col0 + bj * HALF + n * 16) : (f32x4){0.f, 0.f, 0.f, 0.f}; }
        constexpr int NB2 = BASEBF ? 4 : 2;
#pragma unroll
        for (int ai = 0; ai < 2; ++ai)
#pragma unroll
            for (int mb = 0; mb < 4; mb += NB2) {
                f32x4 bf[BASEBF ? 1 : NB2][2][2]; u32x2 bw[BASEBF ? NB2 : 1][2][2];
#pragma unroll
                for (int mm = 0; mm < NB2; ++mm) { const size_t off = (size_t)(row0 + ai * HALF + (mb + mm) * 16) * D + col0;
#pragma unroll
                    for (int bj = 0; bj < 2; ++bj)
#pragma unroll
                        for (int n = 0; n < 2; ++n) { if (BASEBF) bw[mm][bj][n] = *(const u32x2*)(XB + off + bj * HALF + n * 16); else bf[mm][bj][n] = *(const f32x4*)(basef + off + bj * HALF + n * 16); } }
#pragma unroll
                for (int mm = 0; mm < NB2; ++mm) { const int m = mb + mm; const size_t off = (size_t)(row0 + ai * HALF + m * 16) * D + col0;
#pragma unroll
                    for (int bj = 0; bj < 2; ++bj)
#pragma unroll
                        for (int n = 0; n < 2; ++n) { f32x4 bsv;
                            if (BASEBF) { const u32x2 w = bw[mm][bj][n]; bsv = (f32x4){bflo(w.x), bfhi(w.x), bflo(w.y), bfhi(w.y)}; } else bsv = bf[mm][bj][n];
                            const f32x4 o = bsv + gv[bj][n] * (acc[ai][bj][m][n] + bv[bj][n]);
                            u32x2 w2; w2.x = cvt_pk_bf16(o[0], o[1]); w2.y = cvt_pk_bf16(o[2], o[3]); *(u32x2*)(XB + off + bj * HALF + n * 16) = w2; } }
                asm volatile("" ::: "memory"); }
    }
};
struct EpiGLU {
    static constexpr bool PERM = true;
    bf16* U; const float* bias;
    __device__ __forceinline__ void operator()(const f32x4 (&acc)[2][2][4][2], const GU& u, int wr, int wc, int fr, int fq) const {
        const int row0 = u.p0 * BM + wr * 64 + fr, col0 = u.p1 * HALF + wc * 32 + 8 * fq;
        f32x4 ba[2], bg[2];
#pragma unroll
        for (int n = 0; n < 2; ++n) { ba[n] = *(const f32x4*)(bias + col0 + 4 * n); bg[n] = *(const f32x4*)(bias + 1024 + col0 + 4 * n); }
#pragma unroll
        for (int ai = 0; ai < 2; ++ai)
#pragma unroll
            for (int m = 0; m < 4; ++m) { f32x4 o[2];
#pragma unroll
                for (int n = 0; n < 2; ++n) { const f32x4 a = acc[ai][0][m][n] + ba[n], g = acc[ai][1][m][n] + bg[n];
#pragma unroll
                    for (int j = 0; j < 4; ++j) o[n][j] = a[j] * sigmoid_f(g[j]); }
                u32x4 w; w.x = cvt_pk_bf16(o[0][0], o[0][1]); w.y = cvt_pk_bf16(o[0][2], o[0][3]); w.z = cvt_pk_bf16(o[1][0], o[1][1]); w.w = cvt_pk_bf16(o[1][2], o[1][3]);
                *(u32x4*)(U + (size_t)(row0 + ai * HALF + m * 16) * D + col0) = w; }
    }
};
struct EpiGateUp {
    static constexpr bool PERM = true;
    bf16* HID; const float* slot_w; LAS int* mm;
    __device__ __forceinline__ void operator()(const f32x4 (&acc)[2][2][4][2], const GU& u, int wr, int wc, int fr, int fq) const {
        const int e = u.p0, n_e = mm[e], r0 = u.p1 * BM + wr * 64 + fr, col0 = u.p2 * HALF + wc * 32 + 8 * fq;
        float wv[2][4];
#pragma unroll
        for (int ai = 0; ai < 2; ++ai)
#pragma unroll
            for (int m = 0; m < 4; ++m) wv[ai][m] = slot_w[e * CAP + r0 + ai * HALF + m * 16];
#pragma unroll
        for (int ai = 0; ai < 2; ++ai)
#pragma unroll
            for (int m = 0; m < 4; ++m) { const int r = r0 + ai * HALF + m * 16;
                if (r < n_e) { const float w = wv[ai][m]; f32x4 o[2];
#pragma unroll
                    for (int n = 0; n < 2; ++n) { const f32x4 g = acc[ai][0][m][n], up = acc[ai][1][m][n];
#pragma unroll
                        for (int j = 0; j < 4; ++j) o[n][j] = w * silu_f(g[j]) * up[j]; }
                    u32x4 q; q.x = cvt_pk_bf16(o[0][0], o[0][1]); q.y = cvt_pk_bf16(o[0][2], o[0][3]); q.z = cvt_pk_bf16(o[1][0], o[1][1]); q.w = cvt_pk_bf16(o[1][2], o[1][3]);
                    *(u32x4*)(HID + (size_t)(u.p3 + r) * FF + col0) = q; } }
    }
};
struct EpiDown {
    static constexpr bool PERM = true;
    bf16* Y; LAS int* mm;
    __device__ __forceinline__ void operator()(const f32x4 (&acc)[2][2][4][2], const GU& u, int wr, int wc, int fr, int fq) const {
        const int e = u.p0, n_e = mm[e], r0 = u.p1 * BM + wr * 64 + fr, col0 = u.p2 * BM + wc * 32 + 8 * fq;
#pragma unroll
        for (int ai = 0; ai < 2; ++ai)
#pragma unroll
            for (int m = 0; m < 4; ++m) { const int r = r0 + ai * HALF + m * 16;
                if (r < n_e) {
#pragma unroll
                    for (int bj = 0; bj < 2; ++bj) { const f32x4 v0 = acc[ai][bj][m][0], v1 = acc[ai][bj][m][1];
                        u32x4 q; q.x = cvt_pk_bf16(v0[0], v0[1]); q.y = cvt_pk_bf16(v0[2], v0[3]); q.z = cvt_pk_bf16(v1[0], v1[1]); q.w = cvt_pk_bf16(v1[2], v1[3]);
                        *(u32x4*)(Y + (size_t)(u.p3 + r) * D + col0 + bj * HALF) = q; } } }
    }
};
}

__device__ __forceinline__ void fast_inproj(Frame& F) {
    pg::DenseSched S{(const char*)(F.ws + WS_WIN), D, T / 256, N_IN / 256, F.G, F.wg, TC / 256, T / 256, 4};
    pg::EpiInProj E{F.ws};
    pg::gemm_phase(F.lds, (const char*)(F.ws + WS_HB), D, S, E);
}
__device__ __forceinline__ void fast_outproj(Frame& F, size_t a_off, size_t w_off, const float* base, float* X, const float* gate, const float* bias) {
    pg::DenseSched S{(const char*)(F.ws + w_off), D, T / 256, D / 256, F.G, F.wg, 0, 0, 0};
    if (XBF16) {
        if (base == X) { pg::EpiResB<true> E{nullptr, (bf16*)(F.ws + WS_XB), gate, bias}; pg::gemm_phase(F.lds, (const char*)(F.ws + a_off), D, S, E); }
        else { pg::EpiResB<false> E{base, (bf16*)(F.ws + WS_XB), gate, bias}; pg::gemm_phase(F.lds, (const char*)(F.ws + a_off), D, S, E); }
    } else { pg::EpiRes E{base, X, gate, bias}; pg::gemm_phase(F.lds, (const char*)(F.ws + a_off), D, S, E); }
}
__device__ __forceinline__ void fast_pw1(Frame& F) {
    pg::DenseSched S{(const char*)(F.ws + WS_WPW1), D, T / 256, 2048 / 256, F.G, F.wg, 0, 0, 0};
    pg::EpiGLU E{(bf16*)(F.ws + WS_U), F.in[I_PW1B]};
    pg::gemm_phase(F.lds, (const char*)(F.ws + WS_HB), D, S, E);
}
__device__ __forceinline__ void fast_moe_gateup(Frame& F, int layer) {
    LAS int* mm = moe_map(F, layer);
    pg::MoeSched<true> S{(const char*)(F.ws + WS_WGU) + (size_t)layer * 16 * 1024 * 1024 * 2, (size_t)1024 * 1024 * 2, D, (const int*)(F.ws + WS_SLOTT) + layer * 16 * CAP, mm, F.G, F.wg};
    pg::EpiGateUp E{(bf16*)(F.ws + WS_HID), (const float*)(F.ws + WS_SLOTW) + layer * 16 * CAP, mm};
    pg::gemm_phase(F.lds, (const char*)(F.ws + WS_HB), D, S, E);
}
__device__ __forceinline__ void fast_moe_down(Frame& F, int layer) {
    LAS int* mm = moe_map(F, layer);
    pg::MoeSched<false> S{(const char*)(F.ws + WS_WDN) + (size_t)layer * 16 * 1024 * 512 * 2, (size_t)1024 * 512 * 2, FF, nullptr, mm, F.G, F.wg};
    pg::EpiDown E{(bf16*)(F.ws + WS_Y), mm};
    pg::gemm_phase(F.lds, (const char*)(F.ws + WS_HID), FF, S, E);
}


struct AttnBlk { const bf16* kp; const bf16* vp; int pitch; int kb; bool valid, masked; };
__device__ __forceinline__ AttnBlk attn_blk(const unsigned char* ws, int bi, int b, int kvh, int qs) {
    AttnBlk a;
    if (bi < 8) { a.kp = (const bf16*)(ws + WS_CK) + (size_t)(b * CL + bi * 32) * 128 + kvh * 64; a.vp = (const bf16*)(ws + WS_CV) + (size_t)(b * 2 + kvh) * 64 * CL + bi * 32; a.pitch = CL; a.kb = 0; a.valid = true; a.masked = false; }
    else { const int kb = qs - 128 + 32 * (bi - 8); a.valid = (kb >= 0 && kb < L); a.kb = kb; a.masked = true; a.pitch = L;
        a.kp = (const bf16*)(ws + WS_K) + (size_t)(b * L + kb) * 128 + kvh * 64; a.vp = (const bf16*)(ws + WS_V) + (size_t)(b * 2 + kvh) * 64 * L + kb; }
    return a;
}
__device__ __forceinline__ void attn_load(const AttnBlk& a, int r, int h, bf16x8 (&kf)[4], u32x4 (&vf)[2][2]) {
    if (a.valid) {
#pragma unroll
        for (int s = 0; s < 4; ++s) kf[s] = *(const bf16x8*)(a.kp + (size_t)r * 128 + 16 * s + 8 * h);
#pragma unroll
        for (int db = 0; db < 2; ++db)
#pragma unroll
            for (int ks = 0; ks < 2; ++ks) { const bf16* vr = a.vp + (size_t)(32 * db + r) * a.pitch + 16 * ks + 4 * h;
                const u32x2 lo = *(const u32x2*)vr, hi = *(const u32x2*)(vr + 8); vf[db][ks] = (u32x4){lo.x, lo.y, hi.x, hi.y}; }
    }
}
__device__ __forceinline__ void attn_compute(const AttnBlk& a, int qs, int r, int h, const bf16x8 (&kf)[4], const u32x4 (&vf)[2][2], const bf16x8 (&qf)[2][4],
                                             f32x16 (&o)[2][2], float (&m)[2], float (&l)[2]) {
    if (!a.valid) return;
#pragma unroll
    for (int nq = 0; nq < 2; ++nq) {
        f32x16 st;
#pragma unroll
        for (int i = 0; i < 16; ++i) st[i] = 0.f;
#pragma unroll
        for (int s = 0; s < 4; ++s) st = __builtin_amdgcn_mfma_f32_32x32x16_bf16(kf[s], qf[nq][s], st, 0, 0, 0);
        float t[16]; float tmax = -INFINITY;
        const int dbase = a.kb - qs - 32 * nq - r + 4 * h;
#pragma unroll
        for (int i = 0; i < 16; ++i) { float v = st[i] * (0.125f * 1.4426950408889634f);
            if (a.masked) { const int df = dbase + (i & 3) + 8 * (i >> 2); v = (df >= -128 && df <= 128) ? v : -INFINITY; }
            t[i] = v; tmax = fmaxf(tmax, v); }
        tmax = fmaxf(tmax, __shfl_xor(tmax, 32));
        const float mn = fmaxf(m[nq], tmax), alpha = __builtin_amdgcn_exp2f(m[nq] - mn); m[nq] = mn;
        float ps = 0.f;
#pragma unroll
        for (int i = 0; i < 16; ++i) { t[i] = __builtin_amdgcn_exp2f(t[i] - mn); ps += t[i]; }
        l[nq] = l[nq] * alpha + ps;
#pragma unroll
        for (int i = 0; i < 16; ++i) { o[0][nq][i] *= alpha; o[1][nq][i] *= alpha; }
        bf16x8 pf[2];
#pragma unroll
        for (int ks = 0; ks < 2; ++ks) { const u32x4 w = {pkbf(t[8 * ks], t[8 * ks + 1]), pkbf(t[8 * ks + 2], t[8 * ks + 3]), pkbf(t[8 * ks + 4], t[8 * ks + 5]), pkbf(t[8 * ks + 6], t[8 * ks + 7])};
            pf[ks] = __builtin_bit_cast(bf16x8, w); }
#pragma unroll
        for (int db = 0; db < 2; ++db)
#pragma unroll
            for (int ks = 0; ks < 2; ++ks) o[db][nq] = __builtin_amdgcn_mfma_f32_32x32x16_bf16(__builtin_bit_cast(bf16x8, vf[db][ks]), pf[ks], o[db][nq], 0, 0, 0);
    }
}
__device__ __forceinline__ void phase_attn_mfma(Frame& F) {
    const bf16* Q = (const bf16*)(F.ws + WS_Q); bf16* MIX = (bf16*)(F.ws + WS_MIX);
    const int g = F.wave >> 1, half = F.wave & 1, r = F.lane & 31, h = F.lane >> 5;
    for (int item = F.wg; item < NB * 2 * 64; item += F.G) {
        const int qb = item & 63, kvh = (item >> 6) & 1, b = item >> 7, hd = kvh * 4 + g, qs = qb * 128 + half * 64;
        bf16x8 qf[2][4];
#pragma unroll
        for (int nq = 0; nq < 2; ++nq)
#pragma unroll
            for (int s = 0; s < 4; ++s) qf[nq][s] = *(const bf16x8*)(Q + (size_t)(b * L + qs + 32 * nq + r) * 512 + hd * 64 + 16 * s + 8 * h);
        f32x16 o[2][2];
#pragma unroll
        for (int db = 0; db < 2; ++db)
#pragma unroll
            for (int nq = 0; nq < 2; ++nq)
#pragma unroll
                for (int i = 0; i < 16; ++i) o[db][nq][i] = 0.f;
        float m[2], l[2];
        m[0] = m[1] = F.in[I_SINK][hd] * 1.4426950408889634f; l[0] = l[1] = (h == 0) ? 1.f : 0.f;
        bf16x8 kfA[4], kfB[4]; u32x4 vfA[2][2], vfB[2][2];
        AttnBlk ba = attn_blk(F.ws, 0, b, kvh, qs), bb;
        attn_load(ba, r, h, kfA, vfA);
#pragma unroll 1
        for (int bi = 0; bi < 18; bi += 2) {
            bb = attn_blk(F.ws, bi + 1, b, kvh, qs); attn_load(bb, r, h, kfB, vfB);
            attn_compute(ba, qs, r, h, kfA, vfA, qf, o, m, l);
            if (bi + 2 < 18) { ba = attn_blk(F.ws, bi + 2, b, kvh, qs); attn_load(ba, r, h, kfA, vfA); }
            attn_compute(bb, qs, r, h, kfB, vfB, qf, o, m, l);
        }
#pragma unroll
        for (int nq = 0; nq < 2; ++nq) {
            const float lt = l[nq] + __shfl_xor(l[nq], 32), il = 1.f / lt;
            bf16* orow = MIX + (size_t)(b * L + qs + 32 * nq + r) * 1024 + 512 + hd * 64;
#pragma unroll
            for (int db = 0; db < 2; ++db)
#pragma unroll
                for (int i4 = 0; i4 < 4; ++i4) { u32x2 w; w.x = pkbf(o[db][nq][4 * i4] * il, o[db][nq][4 * i4 + 1] * il); w.y = pkbf(o[db][nq][4 * i4 + 2] * il, o[db][nq][4 * i4 + 3] * il);
                    *(u32x2*)(orow + 32 * db + 8 * i4 + 4 * h) = w; }
        }
    }
}


__device__ __forceinline__ float half_max(float v) { const auto r = __builtin_amdgcn_permlane32_swap(__float_as_uint(v), __float_as_uint(v), false, false); return fmaxf(__uint_as_float(r[0]), __uint_as_float(r[1])); }
__device__ __forceinline__ float half_sum(float v) { const auto r = __builtin_amdgcn_permlane32_swap(__float_as_uint(v), __float_as_uint(v), false, false); return __uint_as_float(r[0]) + __uint_as_float(r[1]); }
constexpr int AT_KP = 72, AT_VP = 136;
constexpr int AT_KB = 128 * AT_KP * 2, AT_BUF = AT_KB + 64 * AT_VP * 2;
struct AtChunk { const bf16* kg; const bf16* vg; int vpitch, lc, b, kvh, qb, c; bool valid, local, any; };
__device__ __forceinline__ AtChunk at_chunk(const unsigned char* ws, int seq, int wg, int G) {
    AtChunk k; const int item = wg + (seq / 5) * G; k.c = seq % 5; k.any = item < NB * 2 * 64;
    k.qb = item & 63; k.kvh = (item >> 6) & 1; k.b = (item >> 7) & 3; k.local = k.c >= 2; k.lc = k.c - 2;
    if (!k.local) { k.valid = k.any; k.vpitch = CL; k.kg = (const bf16*)(ws + WS_CK) + (size_t)(k.b * CL + 128 * k.c) * 128 + k.kvh * 64; k.vg = (const bf16*)(ws + WS_CV) + (size_t)(k.b * 2 + k.kvh) * 64 * CL + 128 * k.c; }
    else { const int key0 = 128 * k.qb - 128 + 128 * k.lc; k.valid = k.any && key0 >= 0 && key0 < L; k.vpitch = L;
        k.kg = (const bf16*)(ws + WS_K) + (size_t)(k.b * L + key0) * 128 + k.kvh * 64; k.vg = (const bf16*)(ws + WS_V) + (size_t)(k.b * 2 + k.kvh) * 64 * L + key0; }
    return k;
}
__device__ __forceinline__ void at_issue(const AtChunk& k, int tid, u32x4 (&rg)[4]) {
    if (k.valid) {
#pragma unroll
        for (int i = 0; i < 2; ++i) { const int id = tid + 512 * i; rg[i] = *(const u32x4*)(k.kg + (size_t)(id >> 3) * 128 + (id & 7) * 8); }
#pragma unroll
        for (int i = 0; i < 2; ++i) { const int id = tid + 512 * i; rg[2 + i] = *(const u32x4*)(k.vg + (size_t)(id >> 4) * k.vpitch + (id & 15) * 8); }
    }
}
__device__ __forceinline__ void at_write(const AtChunk& k, LAS unsigned char* buf, int tid, const u32x4 (&rg)[4]) {
    if (k.valid) {
#pragma unroll
        for (int i = 0; i < 2; ++i) { const int id = tid + 512 * i; *(LAS u32x4*)(buf + (id >> 3) * (AT_KP * 2) + (id & 7) * 16) = rg[i]; }
#pragma unroll
        for (int i = 0; i < 2; ++i) { const int id = tid + 512 * i; *(LAS u32x4*)(buf + AT_KB + (id >> 4) * (AT_VP * 2) + (id & 15) * 16) = rg[2 + i]; }
    }
}
__device__ __forceinline__ void at_load(LAS unsigned char* buf, int blk, int r, int h, bf16x8 (&kf)[4], u32x4 (&vf)[2][2]) {
#pragma unroll
    for (int s2 = 0; s2 < 4; ++s2) kf[s2] = *(const LAS bf16x8*)(buf + (32 * blk + r) * (AT_KP * 2) + (16 * s2 + 8 * h) * 2);
#pragma unroll
    for (int db = 0; db < 2; ++db)
#pragma unroll
        for (int ks = 0; ks < 2; ++ks) { const LAS unsigned char* vr = buf + AT_KB + (32 * db + r) * (AT_VP * 2) + (32 * blk + 16 * ks + 4 * h) * 2;
            const u32x2 lo = *(const LAS u32x2*)vr, hi = *(const LAS u32x2*)(vr + 16); vf[db][ks] = (u32x4){lo.x, lo.y, hi.x, hi.y}; }
}
__device__ __forceinline__ void at_math(const bf16x8 (&kf)[4], const u32x4 (&vf)[2][2], bool masked, int kbrel, int r, int h, const bf16x8 (&qf)[2][4], f32x16 (&o)[2][2], float (&m)[2], float (&l)[2]) {
    constexpr float C = 0.125f * 1.4426950408889634f;
#pragma unroll
    for (int nq = 0; nq < 2; ++nq) {
        f32x16 st;
#pragma unroll
        for (int i = 0; i < 16; ++i) st[i] = 0.f;
#pragma unroll
        for (int s2 = 0; s2 < 4; ++s2) st = __builtin_amdgcn_mfma_f32_32x32x16_bf16(kf[s2], qf[nq][s2], st, 0, 0, 0);
        if (masked) { const int dbase = kbrel - 32 * nq - r + 4 * h;
#pragma unroll
            for (int i = 0; i < 16; ++i) { const int df = dbase + (i & 3) + 8 * (i >> 2); st[i] = (df >= -128 && df <= 128) ? st[i] : -INFINITY; } }
        float smax = st[0];
#pragma unroll
        for (int i = 1; i < 16; ++i) smax = fmaxf(smax, st[i]);
        smax = half_max(smax);
        const float mn = fmaxf(m[nq], smax * C), alpha = __builtin_amdgcn_exp2f(m[nq] - mn); m[nq] = mn;
        float t[16]; float ps = 0.f;
#pragma unroll
        for (int i = 0; i < 16; ++i) { t[i] = __builtin_amdgcn_exp2f(__builtin_fmaf(st[i], C, -mn)); ps += t[i]; }
        l[nq] = l[nq] * alpha + ps;
        if (__ballot(alpha != 1.f)) {
#pragma unroll
            for (int i = 0; i < 16; ++i) { o[0][nq][i] *= alpha; o[1][nq][i] *= alpha; } }
        bf16x8 pf[2];
#pragma unroll
        for (int ks = 0; ks < 2; ++ks) { const u32x4 w = {pkbf(t[8 * ks], t[8 * ks + 1]), pkbf(t[8 * ks + 2], t[8 * ks + 3]), pkbf(t[8 * ks + 4], t[8 * ks + 5]), pkbf(t[8 * ks + 6], t[8 * ks + 7])};
            pf[ks] = __builtin_bit_cast(bf16x8, w); }
#pragma unroll
        for (int db = 0; db < 2; ++db)
#pragma unroll
            for (int ks = 0; ks < 2; ++ks) o[db][nq] = __builtin_amdgcn_mfma_f32_32x32x16_bf16(__builtin_bit_cast(bf16x8, vf[db][ks]), pf[ks], o[db][nq], 0, 0, 0);
    }
}
__device__ __forceinline__ void phase_attn_lds(Frame& F) {
    const bf16* Q = (const bf16*)(F.ws + WS_Q); bf16* MIX = (bf16*)(F.ws + WS_MIX);
    const int g = F.wave >> 1, half = F.wave & 1, r = F.lane & 31, h = F.lane >> 5;
    __syncthreads();
    u32x4 rg[4];
    AtChunk ck = at_chunk(F.ws, 0, F.wg, F.G);
    if (!ck.any) return;
    at_issue(ck, F.tid, rg); at_write(ck, F.lds, F.tid, rg);
    __syncthreads();
    bf16x8 qf[2][4]; f32x16 o[2][2]; float m[2], l[2];
#pragma unroll 1
    for (int seq = 0; ck.any; ++seq) {
        LAS unsigned char* buf = F.lds + (seq & 1) * AT_BUF;
        const TItem ti = t_decode(F, seq < 10 ? 640 + (F.wg * NWAVES + F.wave) + seq * (F.G * NWAVES) : (1 << 30));
        t_dma(ti, F.lds + 2 * AT_BUF + F.wave * 8704, F.lane);
        const AtChunk nk = at_chunk(F.ws, seq + 1, F.wg, F.G);
        at_issue(nk, F.tid, rg);
        const int hd = ck.kvh * 4 + g, qs = ck.qb * 128 + half * 64;
        if (ck.c == 0) {
#pragma unroll
            for (int nq = 0; nq < 2; ++nq)
#pragma unroll
                for (int s2 = 0; s2 < 4; ++s2) qf[nq][s2] = *(const bf16x8*)(Q + (size_t)(ck.b * L + qs + 32 * nq + r) * 512 + hd * 64 + 16 * s2 + 8 * h);
#pragma unroll
            for (int db = 0; db < 2; ++db)
#pragma unroll
                for (int nq = 0; nq < 2; ++nq)
#pragma unroll
                    for (int i = 0; i < 16; ++i) o[db][nq][i] = 0.f;
            m[0] = m[1] = F.in[I_SINK][hd] * 1.4426950408889634f; l[0] = l[1] = (h == 0) ? 1.f : 0.f;
        }
        if (ck.valid) {
            int b0 = 0, b1 = 4;
            if (ck.local) { b0 = 2 * half - 4 * ck.lc; b0 = b0 < 0 ? 0 : b0; b1 = 2 * half + 10 - 4 * ck.lc; b1 = b1 > 4 ? 4 : b1; }
            if (b0 < b1) {
                bf16x8 kfA[4], kfB[4]; u32x4 vfA[2][2], vfB[2][2];
                at_load(buf, b0, r, h, kfA, vfA);
#pragma unroll 1
                for (int blk = b0; blk < b1; blk += 2) {
                    const int iA = 4 * ck.lc + blk - 2 * half, iB = iA + 1;
                    if (blk + 1 < b1) at_load(buf, blk + 1, r, h, kfB, vfB);
                    at_math(kfA, vfA, ck.local && (iA < 2 || iA > 7), 32 * iA - 128, r, h, qf, o, m, l);
                    if (blk + 1 < b1) {
                        if (blk + 2 < b1) at_load(buf, blk + 2, r, h, kfA, vfA);
                        at_math(kfB, vfB, ck.local && (iB < 2 || iB > 7), 32 * iB - 128, r, h, qf, o, m, l);
                    }
                }
            }
        }
        if (ck.c == 4) {
#pragma unroll
            for (int nq = 0; nq < 2; ++nq) {
                const float lt = half_sum(l[nq]), il = __builtin_amdgcn_rcpf(lt);
                bf16* orow = MIX + (size_t)(ck.b * L + qs + 32 * nq + r) * 1024 + 512 + hd * 64;
#pragma unroll
                for (int db = 0; db < 2; ++db)
#pragma unroll
                    for (int i4 = 0; i4 < 4; ++i4) { u32x2 w; w.x = pkbf(o[db][nq][4 * i4] * il, o[db][nq][4 * i4 + 1] * il); w.y = pkbf(o[db][nq][4 * i4 + 2] * il, o[db][nq][4 * i4 + 3] * il);
                        *(u32x2*)(orow + 32 * db + 8 * i4 + 4 * h) = w; }
            }
        }
        if (ti.ok) { asm volatile("s_waitcnt vmcnt(0)" ::: "memory"); t_store_dma(ti, (const LAS float*)(F.lds + 2 * AT_BUF + F.wave * 8704), F.lane); }
        at_write(nk, F.lds + ((seq + 1) & 1) * AT_BUF, F.tid, rg);
        __syncthreads();
        ck = nk;
    }
}

constexpr int F1_PC = 136, F1_PW = 68, F2_P = 264;
constexpr int F1_CSC = 0, F1_CSS = 128 * F1_PC * 2, F1_C64 = 2 * 128 * F1_PC * 2, F1_S64 = F1_C64 + 64 * F1_PW * 2;
__device__ __forceinline__ bf16x8 pack8(float a0, float a1, float a2, float a3, float a4, float a5, float a6, float a7) {
    const u32x4 w = {pkbf(a0, a1), pkbf(a2, a3), pkbf(a4, a5), pkbf(a6, a7)}; return __builtin_bit_cast(bf16x8, w); }
__device__ __forceinline__ void phase_fft1_mfma(Frame& F) {
    __syncthreads();
    LAS bf16* csc = (LAS bf16*)(F.lds + F1_CSC); LAS bf16* css = (LAS bf16*)(F.lds + F1_CSS); LAS bf16* c64 = (LAS bf16*)(F.lds + F1_C64); LAS bf16* s64 = (LAS bf16*)(F.lds + F1_S64);
    for (int i = F.tid; i < 128 * 128; i += NTHR) { const int n = i >> 7, k = i & 127; const float ang = (float)((n * k) & 127) * (6.283185307179586f / 128.f);
        csc[n * F1_PC + k] = (bf16)f2bf(__cosf(ang)); css[n * F1_PC + k] = (bf16)f2bf(__sinf(ang)); }
    for (int i = F.tid; i < 64 * 64; i += NTHR) { const int c = i >> 6, a = i & 63; const float ang = (float)((c * a) & 63) * (6.283185307179586f / 64.f);
        c64[c * F1_PW + a] = (bf16)f2bf(__cosf(ang)); s64[c * F1_PW + a] = (bf16)f2bf(__sinf(ang)); }
    __syncthreads();
    const bf16* UF = (const bf16*)(F.ws + WS_UF); bf16* Gb = (bf16*)(F.ws + WS_G);
    const int r = F.lane & 31, h = F.lane >> 5, g = F.wave >> 1;
    for (int item = F.wg; item < NB * FN2; item += F.G) {
        const int b = item >> 7, bp = item & 127;
#pragma unroll 1
        for (int q = 0; q < 2; ++q) {
            const int cbk = 2 * F.wave + q, n = 32 * (cbk & 3) + r, ch = 32 * cbk + r;
            f32x16 zr[2], zi[2];
#pragma unroll
            for (int rb = 0; rb < 2; ++rb) {
                bf16x8 uf[8];
#pragma unroll
                for (int s2 = 0; s2 < 8; ++s2) uf[s2] = *(const bf16x8*)(UF + (size_t)(b * L + 128 * (32 * rb + r) + bp) * 512 + g * 128 + 16 * s2 + 8 * h);
#pragma unroll
                for (int i = 0; i < 16; ++i) { zr[rb][i] = 0.f; zi[rb][i] = 0.f; }
#pragma unroll
                for (int s2 = 0; s2 < 8; ++s2) { const bf16x8 bc = *(const LAS bf16x8*)(csc + n * F1_PC + 16 * s2 + 8 * h), bs = *(const LAS bf16x8*)(css + n * F1_PC + 16 * s2 + 8 * h);
                    zr[rb] = __builtin_amdgcn_mfma_f32_32x32x16_bf16(uf[s2], bc, zr[rb], 0, 0, 0); zi[rb] = __builtin_amdgcn_mfma_f32_32x32x16_bf16(uf[s2], bs, zi[rb], 0, 0, 0); }
                __builtin_amdgcn_sched_barrier(0);
            }
            bf16x8 zfr[4], zfi[4];
#pragma unroll
            for (int ks = 0; ks < 4; ++ks) { const int rb = ks >> 1, o = 8 * (ks & 1);
                zfr[ks] = pack8(zr[rb][o], zr[rb][o + 1], zr[rb][o + 2], zr[rb][o + 3], zr[rb][o + 4], zr[rb][o + 5], zr[rb][o + 6], zr[rb][o + 7]);
                zfi[ks] = pack8(-zi[rb][o], -zi[rb][o + 1], -zi[rb][o + 2], -zi[rb][o + 3], -zi[rb][o + 4], -zi[rb][o + 5], -zi[rb][o + 6], -zi[rb][o + 7]); }
            __builtin_amdgcn_sched_barrier(0);
#pragma unroll 1
            for (int rbc = 0; rbc < 2; ++rbc) {
                f32x16 gr, gi; const int cr = 32 * rbc + r;
#pragma unroll
                for (int i = 0; i < 16; ++i) { gr[i] = 0.f; gi[i] = 0.f; }
#pragma unroll
                for (int ks = 0; ks < 4; ++ks) {
                    const u32x2 cl = *(const LAS u32x2*)(c64 + cr * F1_PW + 16 * ks + 4 * h), chh = *(const LAS u32x2*)(c64 + cr * F1_PW + 16 * ks + 8 + 4 * h);
                    const u32x2 sl = *(const LAS u32x2*)(s64 + cr * F1_PW + 16 * ks + 4 * h), shh = *(const LAS u32x2*)(s64 + cr * F1_PW + 16 * ks + 8 + 4 * h);
                    const u32x4 sw = {sl.x, sl.y, shh.x, shh.y}; const u32x4 swn = sw ^ 0x80008000u;
                    const bf16x8 wc = __builtin_bit_cast(bf16x8, ((u32x4){cl.x, cl.y, chh.x, chh.y})), wsn = __builtin_bit_cast(bf16x8, sw), wsm = __builtin_bit_cast(bf16x8, swn);
                    gr = __builtin_amdgcn_mfma_f32_32x32x16_bf16(wc, zfr[ks], gr, 0, 0, 0); gr = __builtin_amdgcn_mfma_f32_32x32x16_bf16(wsn, zfi[ks], gr, 0, 0, 0);
                    gi = __builtin_amdgcn_mfma_f32_32x32x16_bf16(wc, zfi[ks], gi, 0, 0, 0); gi = __builtin_amdgcn_mfma_f32_32x32x16_bf16(wsm, zfr[ks], gi, 0, 0, 0); }
                __builtin_amdgcn_sched_barrier(0);
#pragma unroll
                for (int i = 0; i < 16; ++i) { const int c = 32 * rbc + crow(i, h); const float ang = (float)(bp * c) * (6.283185307179586f / 8192.f), cs = __cosf(ang), sn = __sinf(ang);
                    const float re = gr[i] * cs + gi[i] * sn, im = gi[i] * cs - gr[i] * sn;
                    bf16* o = Gb + (size_t)((b * FN1 + c) * FN2 + bp) * 1024 + ch; o[0] = (bf16)f2bf(re); o[512] = (bf16)f2bf(im);
                    if ((i & 3) == 3) __builtin_amdgcn_sched_barrier(0); }
            }
        }
    }
    __syncthreads();
}
__device__ __forceinline__ void phase_fft2_mfma(Frame& F) {
    __syncthreads();
    LAS bf16* t2 = (LAS bf16*)F.lds;
    for (int i = F.tid; i < 128 * 256; i += NTHR) { const int d = i >> 8, k = i & 255; const float ang = (float)((d * (k & 127)) & 127) * (6.283185307179586f / 128.f);
        t2[d * F2_P + k] = (bf16)f2bf(k < 128 ? __cosf(ang) : __sinf(ang)); }
    __syncthreads();
    const bf16* Gb = (const bf16*)(F.ws + WS_G); bf16* MIX = (bf16*)(F.ws + WS_MIX);
    const int r = F.lane & 31, h = F.lane >> 5;
    for (int item = F.wg; item < NB * FN1; item += F.G) {
        const int b = item >> 6, c = item & 63;
        const bf16* Gp = Gb + (size_t)((b * FN1 + c) * FN2) * 1024 + 64 * F.wave + r;
        f32x16 y[4][2];
#pragma unroll
        for (int rb = 0; rb < 4; ++rb)
#pragma unroll
            for (int cb = 0; cb < 2; ++cb)
#pragma unroll
                for (int i = 0; i < 16; ++i) y[rb][cb][i] = 0.f;
        unsigned eA[2][8], eB[2][8];
#define F2_GATHER(dst, ks_) do { const bf16* p_ = Gp + (size_t)(16 * ((ks_) & 7) + 8 * h) * 1024 + ((ks_) >> 3) * 512; \
            _Pragma("unroll") for (int cb = 0; cb < 2; ++cb) _Pragma("unroll") for (int j = 0; j < 8; ++j) dst[cb][j] = p_[(size_t)j * 1024 + 32 * cb]; } while (0)
#define F2_MMA(src, ks_) do { bf16x8 bfr[2]; _Pragma("unroll") for (int cb = 0; cb < 2; ++cb) { \
                const u32x4 w = {src[cb][0] | (src[cb][1] << 16), src[cb][2] | (src[cb][3] << 16), src[cb][4] | (src[cb][5] << 16), src[cb][6] | (src[cb][7] << 16)}; bfr[cb] = __builtin_bit_cast(bf16x8, w); } \
            _Pragma("unroll") for (int rb = 0; rb < 4; ++rb) { const bf16x8 a = *(const LAS bf16x8*)(t2 + (32 * rb + r) * F2_P + 16 * (ks_) + 8 * h); \
                _Pragma("unroll") for (int cb = 0; cb < 2; ++cb) y[rb][cb] = __builtin_amdgcn_mfma_f32_32x32x16_bf16(a, bfr[cb], y[rb][cb], 0, 0, 0); } } while (0)
        F2_GATHER(eA, 0);
#pragma unroll 1
        for (int ks = 0; ks < 16; ks += 2) {
            F2_GATHER(eB, ks + 1);
            F2_MMA(eA, ks);
            if (ks + 2 < 16) F2_GATHER(eA, ks + 2);
            F2_MMA(eB, ks + 1);
        }
#undef F2_GATHER
#undef F2_MMA
#pragma unroll
        for (int rb = 0; rb < 4; ++rb)
#pragma unroll
            for (int cb = 0; cb < 2; ++cb)
#pragma unroll
                for (int i = 0; i < 16; ++i) { const int d = 32 * rb + crow(i, h); MIX[(size_t)(b * L + c + 64 * d) * 1024 + 64 * F.wave + 32 * cb + r] = (bf16)f2bf(y[rb][cb][i] * (1.f / 1024.f)); }
    }
    __syncthreads();
}


typedef float f32x2_t __attribute__((ext_vector_type(2)));
template <int IR> struct DwIn {
    static __device__ __forceinline__ void run(const unsigned (&uin)[62], const f32x2_t (&w)[31], f32x2_t (&o)[32]) {
        const f32x2_t x = {bflo(uin[IR]), bfhi(uin[IR])};
#pragma unroll
        for (int r = 0; r < 32; ++r) { if (IR - r >= 0 && IR - r <= 30) o[r] += w[(IR - r >= 0 && IR - r <= 30) ? IR - r : 0] * x; }
        DwIn<IR + 1>::run(uin, w, o);
    }
};
template <> struct DwIn<62> { static __device__ __forceinline__ void run(const unsigned (&)[62], const f32x2_t (&)[31], f32x2_t (&)[32]) {} };
template <int IR> struct DwIn16 {
    static __device__ __forceinline__ void run(const unsigned (&uin)[46], const f32x2_t (&w)[31], f32x2_t (&o)[16]) {
        const f32x2_t x = {bflo(uin[IR]), bfhi(uin[IR])};
#pragma unroll
        for (int r = 0; r < 16; ++r) { if (IR - r >= 0 && IR - r <= 30) o[r] += w[(IR - r >= 0 && IR - r <= 30) ? IR - r : 0] * x; }
        DwIn16<IR + 1>::run(uin, w, o);
    }
};
template <> struct DwIn16<46> { static __device__ __forceinline__ void run(const unsigned (&)[46], const f32x2_t (&)[31], f32x2_t (&)[16]) {} };
__device__ __forceinline__ void phase_dwconv_fast(Frame& F) {
    const bf16* U = (const bf16*)(F.ws + WS_U); bf16* V1 = (bf16*)(F.ws + WS_V1);
    const float* dww = F.in[I_DWW];
    const int c0 = 2 * F.tid;
    f32x2_t w[31];
#pragma unroll
    for (int j = 0; j < 31; ++j) w[j] = *(const f32x2_t*)(dww + (size_t)j * D + c0);
    const f32x2_t bb = *(const f32x2_t*)(F.in[I_DWB] + c0), gg = *(const f32x2_t*)(F.in[I_LNG] + c0), lb = *(const f32x2_t*)(F.in[I_LNB] + c0);
    LAS float* red = (LAS float*)F.lds;
    LAS float* stat = red + 16 * 8 * 2;
    __syncthreads();
    for (int run = F.wg; run < T / 128; run += F.G) {
        const int row0 = run * 128, l0 = row0 & (L - 1);
        unsigned uin[46], nx[16];
#pragma unroll
        for (int ir = 0; ir < 46; ++ir) { const int l = l0 - 15 + ir; const bool ok = (l >= 0 && l < L);
            const unsigned u = *(const unsigned*)(U + (size_t)(ok ? row0 - 15 + ir : row0) * D + c0); uin[ir] = ok ? u : 0u; }
#pragma unroll 1
        for (int step = 0; step < 8; ++step) {
            const int r0 = row0 + 16 * step;
            if (step < 7) {
#pragma unroll
                for (int j = 0; j < 16; ++j) { const int l = l0 + 16 * step + 31 + j; const bool ok = l < L;
                    const unsigned u = *(const unsigned*)(U + (size_t)(ok ? r0 + 31 + j : r0) * D + c0); nx[j] = ok ? u : 0u; }
            }
            f32x2_t o[16];
#pragma unroll
            for (int r = 0; r < 16; ++r) o[r] = bb;
            DwIn16<0>::run(uin, w, o);
#pragma unroll
            for (int r = 0; r < 16; ++r) { const float sm = wave_sum(o[r].x + o[r].y), sq = wave_sum(o[r].x * o[r].x + o[r].y * o[r].y);
                if (F.lane == 0) { red[(r * 8 + F.wave) * 2] = sm; red[(r * 8 + F.wave) * 2 + 1] = sq; } }
            __syncthreads();
            if (F.tid < 16) { float sm = 0.f, sq = 0.f;
#pragma unroll
                for (int wv = 0; wv < 8; ++wv) { sm += red[(F.tid * 8 + wv) * 2]; sq += red[(F.tid * 8 + wv) * 2 + 1]; }
                const float mean = sm * (1.f / D), var = fmaxf(sq * (1.f / D) - mean * mean, 0.f);
                stat[2 * F.tid] = mean; stat[2 * F.tid + 1] = rsqrtf(var + EPS); }
            __syncthreads();
#pragma unroll
            for (int r = 0; r < 16; ++r) { const float mean = stat[2 * r], rstd = stat[2 * r + 1];
                const float y0 = silu_f((o[r].x - mean) * rstd * gg.x + lb.x), y1 = silu_f((o[r].y - mean) * rstd * gg.y + lb.y);
                *(unsigned*)(V1 + (size_t)(r0 + r) * D + c0) = pkbf(y0, y1); }
#pragma unroll
            for (int i = 0; i < 30; ++i) uin[i] = uin[i + 16];
#pragma unroll
            for (int j = 0; j < 16; ++j) uin[30 + j] = nx[j];
        }
        __syncthreads();
    }
}

namespace pg {
struct MU { const char* B; const char* A; int K, type, e, rt, pn, hb, buf; };
struct MoeMergedSched {
    const char* Wgu; const char* Wdn; const char* HBp; const char* HIDp; const int* list; const float* wlist; LAS int* mm; unsigned* tcnt; unsigned* tmo; int G, c, U;
    __device__ __forceinline__ bool flat(int L, int type, MU& u) const {
        for (int e = 0; e < 16; ++e) { const int n = mm[e], nu = ((n + 255) >> 8) * 4;
            if (L < nu) { u.e = e; u.rt = L >> 2; u.pn = L & 3; u.hb = mm[16 + e]; u.type = type; u.buf = 0;
                if (type == 0) { u.K = D; u.A = HBp; u.B = Wgu + (size_t)e * (1024 * 1024 * 2) + (size_t)u.pn * BM * D * 2; }
                else { u.K = FF; u.A = HIDp; u.B = Wdn + (size_t)e * (1024 * 512 * 2) + (size_t)u.pn * BM * FF * 2; }
                return true; }
            L -= nu; }
        return false;
    }
    __device__ __forceinline__ bool next(int i, MU& u) const {
        const int ngu = c < U ? (U - 1 - c) / G + 1 : 0;
        if (i < ngu) return flat(i * G + c, 0, u);
        const int k = i - ngu, x = U % G; int j;
        if (c >= x) { if (k == 0) j = c - x; else j = (G - 1 - c) + (k - 1) * G + (G - x); } else j = (G - 1 - c) + k * G + (G - x);
        if (j >= U) return false;
        return flat(j, 1, u);
    }
    __device__ __forceinline__ unsigned voff(const MU& u, int buf, LAS unsigned char* lds, int R, int C) const {
        if (u.type == 0) { const int tok = ((const LAS int*)(lds + TAB_OFF))[buf * 256 + R]; return (unsigned)((tok * D + C) * 2); }
        return (unsigned)(((u.hb + u.rt * BM + R) * FF + C) * 2);
    }
    __device__ __forceinline__ void stage_table(const MU& u, int buf, LAS unsigned char* lds, int wid, int lane) const {
        const int r = (wid & 3) * 64 + lane;
        __builtin_amdgcn_global_load_lds((const unsigned*)(list + u.e * CAP + u.rt * BM + r), (LAS unsigned*)(lds + TAB_OFF + buf * 1024 + (wid & 3) * 256), 4, 0, 0);
        __builtin_amdgcn_global_load_lds((const unsigned*)(wlist + u.e * CAP + u.rt * BM + r), (LAS unsigned*)(lds + TAB_OFF + 2048 + buf * 1024 + (wid & 3) * 256), 4, 0, 0);
    }
    __device__ __forceinline__ unsigned* tile_word(const MU& u) const { return tcnt + ((u.hb >> 8) + u.rt) * 64; }
    __device__ __forceinline__ void wait_ready(const MU& u, int wid) const {
        if (wid == 0) {
            unsigned* w = tile_word(u); unsigned spins = 0;
            while ((unsigned)__builtin_amdgcn_readfirstlane(__hip_atomic_load(w, __ATOMIC_RELAXED, __HIP_MEMORY_SCOPE_AGENT)) < 32u) {
                __builtin_amdgcn_s_sleep(2);
                if ((++spins & 255u) == 0u) { if (__builtin_amdgcn_readfirstlane(__hip_atomic_load(tmo, __ATOMIC_RELAXED, __HIP_MEMORY_SCOPE_AGENT)) != 0u) break;
                    if (spins > (1u << 20)) { __hip_atomic_store(tmo, 1u, __ATOMIC_RELAXED, __HIP_MEMORY_SCOPE_AGENT); break; } } }
        }
        asm volatile("" ::: "memory"); __builtin_amdgcn_s_barrier(); asm volatile("" ::: "memory");
    }
};
struct EpiGateUpWT {
    __amdgpu_buffer_rsrc_t rsrc; LAS unsigned char* lds; LAS int* mm;
    __device__ __forceinline__ void operator()(const f32x4 (&acc)[2][2][4][2], const MU& u, int wr, int wc, int fr, int fq) const {
        const int e = u.e, n_e = mm[e], r0 = u.rt * BM + wr * 64 + fr, col0 = u.pn * HALF + wc * 32 + 8 * fq;
        float wv[2][4];
#pragma unroll
        for (int ai = 0; ai < 2; ++ai)
#pragma unroll
            for (int m = 0; m < 4; ++m) wv[ai][m] = ((const LAS float*)(lds + TAB_OFF + 2048))[u.buf * 256 + wr * 64 + fr + ai * HALF + m * 16];
#pragma unroll
        for (int ai = 0; ai < 2; ++ai)
#pragma unroll
            for (int m = 0; m < 4; ++m) { const int r = r0 + ai * HALF + m * 16;
                if (r < n_e) { const float w = wv[ai][m]; f32x4 o[2];
#pragma unroll
                    for (int n = 0; n < 2; ++n) { const f32x4 g = acc[ai][0][m][n], up = acc[ai][1][m][n];
#pragma unroll
                        for (int j = 0; j < 4; ++j) o[n][j] = w * silu_f(g[j]) * up[j]; }
                    u32x4 q; q.x = cvt_pk_bf16(o[0][0], o[0][1]); q.y = cvt_pk_bf16(o[0][2], o[0][3]); q.z = cvt_pk_bf16(o[1][0], o[1][1]); q.w = cvt_pk_bf16(o[1][2], o[1][3]);
                    __builtin_amdgcn_raw_buffer_store_b128(q, rsrc, (unsigned)(((u.hb + r) * FF + col0) * 2), 0, 16); } }
    }
};
struct EpiDownM {
    unsigned char* Y8; LAS int* mm;
    __device__ __forceinline__ void operator()(const f32x4 (&acc)[2][2][4][2], const MU& u, int wr, int wc, int fr, int fq) const {
        const int e = u.e, n_e = mm[e], r0 = u.rt * BM + wr * 64 + fr, col0 = u.pn * BM + 64 * wc + 16 * fq;
#pragma unroll
        for (int ai = 0; ai < 2; ++ai)
#pragma unroll
            for (int m = 0; m < 4; ++m) { const int r = r0 + ai * HALF + m * 16;
                if (r < n_e) { u32x4 q; q.x = pk_fp8x4(acc[ai][0][m][0]); q.y = pk_fp8x4(acc[ai][0][m][1]); q.z = pk_fp8x4(acc[ai][1][m][0]); q.w = pk_fp8x4(acc[ai][1][m][1]);
                    *(u32x4*)(Y8 + (size_t)(u.hb + r) * D + col0) = q; } }
    }
};
__device__ __forceinline__ void gemm_phase_moe(LAS unsigned char* lds, const MoeMergedSched& S, const EpiGateUpWT& EA, const EpiDownM& EB) {
    const int tid = threadIdx.x, wid = __builtin_amdgcn_readfirstlane(tid >> 6), lane = tid & 63, wr = wid >> 2, wc = wid & 3, fr = lane & 15, fq = lane >> 4;
    int sR[2], sC[2]; unsigned vbA[2], vbD[2];
#pragma unroll
    for (int i = 0; i < 2; ++i) { int R, C; stage_rc(tid * 16 + i * 8192, R, C); sR[i] = R; sC[i] = C; const int Rb = (R & ~31) + perm32(R & 31);
        const int RbD = 64 * ((Rb >> 5) & 3) + 16 * ((Rb >> 3) & 3) + (Rb & 7);
        vbA[i] = (unsigned)(Rb * D + C) * 2u; vbD[i] = (unsigned)(RbD * FF + C) * 2u; }
    const size_t kstep = (size_t)(BK * 2);
    const unsigned ldsw = (unsigned)wid * 1024u;
    const int aoff = lds_byte(wr * 64 + fr, fq * 8), boff = lds_byte(wc * 32 + fr, fq * 8);
#define PG_SA(b, h) (((b) * 2 + (h)) * HTB)
#define PG_SB(b, h) ((4 + (b) * 2 + (h)) * HTB)
#define PG_STAGE(bufoff, gbase, voff) do { _Pragma("unroll") for (int _i = 0; _i < 2; ++_i) \
        __builtin_amdgcn_global_load_lds((const unsigned*)((const char*)(gbase) + (voff)[_i]), (LAS unsigned*)(lds + (bufoff) + ldsw + _i * 8192), 16, 0, 0); } while (0)
#define PG_LDA(dst, b, h) do { _Pragma("unroll") for (int m = 0; m < 4; ++m) _Pragma("unroll") for (int k = 0; k < 2; ++k) dst[m][k] = *(const LAS bf16x8*)(lds + PG_SA(b, h) + aoff + m * 2048 + k * 1024); } while (0)
#define PG_LDB(dst, b, h) do { _Pragma("unroll") for (int n = 0; n < 2; ++n) _Pragma("unroll") for (int k = 0; k < 2; ++k) dst[n][k] = *(const LAS bf16x8*)(lds + PG_SB(b, h) + boff + n * 2048 + k * 1024); } while (0)
#define PG_MMA(ai, bj, At, Bt) do { __builtin_amdgcn_s_setprio(1); _Pragma("unroll") for (int m = 0; m < 4; ++m) _Pragma("unroll") for (int n = 0; n < 2; ++n) _Pragma("unroll") for (int k = 0; k < 2; ++k) \
        acc[ai][bj][m][n] = __builtin_amdgcn_mfma_f32_16x16x32_bf16(Bt[n][k], At[m][k], acc[ai][bj][m][n], 0, 0, 0); __builtin_amdgcn_s_setprio(0); } while (0)
#define PG_WAIT_V(n) asm volatile("s_waitcnt vmcnt(" #n ")" ::: "memory")
#define PG_WAIT_L(n) asm volatile("s_waitcnt lgkmcnt(" #n ")" ::: "memory")
#define PG_BAR __builtin_amdgcn_s_barrier()
#define PG_SCHED __builtin_amdgcn_sched_barrier(0)
    MU cur, nxt; int ui = 0;
    if (!S.next(0, cur)) return;
    cur.buf = 0;
    f32x4 acc[2][2][4][2];
#pragma unroll
    for (int a = 0; a < 2; ++a)
#pragma unroll
        for (int b = 0; b < 2; ++b)
#pragma unroll
            for (int m = 0; m < 4; ++m)
#pragma unroll
                for (int n = 0; n < 2; ++n) acc[a][b][m][n] = (f32x4){0.f, 0.f, 0.f, 0.f};
    bf16x8 At[4][2], B0[2][2], B1[2][2];
    if (cur.type == 0) { S.stage_table(cur, 0, lds, wid, lane); PG_WAIT_V(0); PG_BAR; } else S.wait_ready(cur, wid);
    unsigned voC[2][2], voN[2][2];
#pragma unroll
    for (int h = 0; h < 2; ++h)
#pragma unroll
        for (int i = 0; i < 2; ++i) { voC[h][i] = S.voff(cur, 0, lds, h * HALF + sR[i], sC[i]); voN[h][i] = voC[h][i]; }
    const char* cB = cur.B; const char* cA = cur.A; size_t hsC = (size_t)(cur.type == 0 ? HALF : 8) * cur.K * 2; int nt = cur.K / BK;
    if (cur.type == 0) { PG_STAGE(PG_SB(0, 0), cB, vbA); PG_STAGE(PG_SB(0, 1), cB + hsC, vbA); } else { PG_STAGE(PG_SB(0, 0), cB, vbD); PG_STAGE(PG_SB(0, 1), cB + hsC, vbD); }
    PG_STAGE(PG_SA(0, 0), cA, voC[0]); PG_STAGE(PG_SA(0, 1), cA, voC[1]);
    if (wr == 1) PG_BAR;
    PG_WAIT_V(2); PG_BAR;
    if (cur.type == 0) { PG_STAGE(PG_SB(1, 0), cB + kstep, vbA); } else { PG_STAGE(PG_SB(1, 0), cB + kstep, vbD); }
    PG_STAGE(PG_SA(1, 0), cA + kstep, voC[0]);
    if (cur.type == 0) { PG_STAGE(PG_SB(1, 1), cB + hsC + kstep, vbA); } else { PG_STAGE(PG_SB(1, 1), cB + hsC + kstep, vbD); }
    PG_WAIT_V(6); PG_BAR;
    for (;;) {
        const bool has_next = S.next(ui + 1, nxt); nxt.buf = (ui + 1) & 1;
        if (has_next && nxt.type == 0) S.stage_table(nxt, (ui + 1) & 1, lds, wid, lane);
        const char* nB = has_next ? nxt.B : cB; const char* nA = has_next ? nxt.A : cA; const size_t hsN = has_next ? (size_t)(nxt.type == 0 ? HALF : 8) * nxt.K * 2 : hsC;
        for (int t = 0; t < nt; t += 2) {
            const bool last = (t == nt - 2);
            if (last && has_next) {
                if (nxt.type == 1) S.wait_ready(nxt, wid);
#pragma unroll
                for (int h = 0; h < 2; ++h)
#pragma unroll
                    for (int i = 0; i < 2; ++i) voN[h][i] = S.voff(nxt, (ui + 1) & 1, lds, h * HALF + sR[i], sC[i]);
            }
            unsigned vo2[2][2], vb2[2]; const bool b2gu = last ? (has_next ? nxt.type == 0 : cur.type == 0) : (cur.type == 0);
#pragma unroll
            for (int h = 0; h < 2; ++h)
#pragma unroll
                for (int i = 0; i < 2; ++i) vo2[h][i] = last ? voN[h][i] : voC[h][i];
#pragma unroll
            for (int i = 0; i < 2; ++i) vb2[i] = b2gu ? vbA[i] : vbD[i];
            const size_t hs2 = last ? hsN : hsC;
            const char* a1 = cA + (size_t)(t + 1) * kstep;
            const char* a2 = last ? nA : cA + (size_t)(t + 2) * kstep; const char* b2 = last ? nB : cB + (size_t)(t + 2) * kstep;
            const char* a3 = a2 + kstep; const char* b3 = b2 + kstep;
            PG_LDB(B0, 0, 0); PG_LDB(B1, 0, 1); PG_SCHED; PG_LDA(At, 0, 0); PG_STAGE(PG_SA(1, 1), a1, voC[1]);
            PG_WAIT_V(8); PG_WAIT_L(0); PG_BAR; PG_MMA(0, 0, At, B0); PG_MMA(0, 1, At, B1); PG_BAR; PG_SCHED;
            PG_LDA(At, 0, 1); PG_STAGE(PG_SB(0, 0), b2, vb2); PG_STAGE(PG_SB(0, 1), b2 + hs2, vb2); PG_STAGE(PG_SA(0, 0), a2, vo2[0]);
            PG_WAIT_V(8); PG_WAIT_L(0); PG_BAR; PG_MMA(1, 0, At, B0); PG_MMA(1, 1, At, B1); PG_BAR; PG_SCHED;
            PG_LDB(B0, 1, 0); PG_LDB(B1, 1, 1); PG_SCHED; PG_LDA(At, 1, 0); PG_STAGE(PG_SA(0, 1), a2, vo2[1]);
            PG_WAIT_V(8); PG_WAIT_L(0); PG_BAR; PG_MMA(0, 0, At, B0); PG_MMA(0, 1, At, B1); PG_BAR; PG_SCHED;
            PG_LDA(At, 1, 1); PG_STAGE(PG_SB(1, 0), b3, vb2); PG_STAGE(PG_SB(1, 1), b3 + hs2, vb2); PG_STAGE(PG_SA(1, 0), a3, vo2[0]);
            PG_WAIT_V(8); PG_WAIT_L(0); PG_BAR; PG_MMA(1, 0, At, B0); PG_MMA(1, 1, At, B1); PG_BAR; PG_SCHED;
        }
        if (wr == 0) PG_BAR;
        if (cur.type == 0) { EA(acc, cur, wr, wc, fr, fq);
            PG_WAIT_V(0);
            if (lane == 0) __hip_atomic_fetch_add(S.tile_word(cur), 1u, __ATOMIC_RELAXED, __HIP_MEMORY_SCOPE_AGENT); }
        else EB(acc, cur, wr, wc, fr, fq);
        if (!has_next) break;
#pragma unroll
        for (int a = 0; a < 2; ++a)
#pragma unroll
            for (int b = 0; b < 2; ++b)
#pragma unroll
                for (int m = 0; m < 4; ++m)
#pragma unroll
                    for (int n = 0; n < 2; ++n) acc[a][b][m][n] = (f32x4){0.f, 0.f, 0.f, 0.f};
        cur = nxt; cB = nB; cA = nA; hsC = hsN; nt = cur.K / BK; ++ui;
#pragma unroll
        for (int h = 0; h < 2; ++h)
#pragma unroll
            for (int i = 0; i < 2; ++i) voC[h][i] = voN[h][i];
        if (wr == 1) PG_BAR;
    }
    PG_WAIT_V(0);
    PG_BAR;
#undef PG_SA
#undef PG_SB
#undef PG_STAGE
#undef PG_LDA
#undef PG_LDB
#undef PG_MMA
#undef PG_WAIT_V
#undef PG_WAIT_L
#undef PG_BAR
#undef PG_SCHED
}
}
__device__ __forceinline__ void fast_moe_merged(Frame& F, int layer) {
    LAS int* mm = moe_map(F, layer);
    int U = 0;
    for (int e = 0; e < 16; ++e) U += ((mm[e] + 255) >> 8) * 4;
    pg::MoeMergedSched S{(const char*)(F.ws + WS_WGU) + (size_t)layer * 16 * 1024 * 1024 * 2, (const char*)(F.ws + WS_WDN) + (size_t)layer * 16 * 1024 * 512 * 2,
                         (const char*)(F.ws + WS_HB), (const char*)(F.ws + WS_HID), (const int*)(F.ws + WS_SLOTT) + layer * 16 * CAP, (const float*)(F.ws + WS_SLOTW) + layer * 16 * CAP, mm,
                         F.ctl + CW_TILE + layer * 288 * 64, F.ctl + CW_TMO2, F.G, F.wg, U};
    pg::EpiGateUpWT EA{__builtin_amdgcn_make_buffer_rsrc((void*)(F.ws + WS_HID), 0, HROWS * FF * 2, 0x00020000), F.lds, mm};
    pg::EpiDownM EB{(unsigned char*)(F.ws + WS_Y), mm};
    pg::gemm_phase_moe(F.lds, S, EA, EB);
}

constexpr int NPH = 18;
__global__ void __launch_bounds__(NTHR, 2) mega(Args args) {
    extern __shared__ __attribute__((aligned(16))) unsigned char lds[];
    Frame F;
    F.lds = (LAS unsigned char*)lds;
    F.tid = threadIdx.x; F.lane = F.tid & 63; F.wave = __builtin_amdgcn_readfirstlane(F.tid >> 6);
    F.G = gridDim.x; F.wg = blockIdx.x;
    F.out = args.out; F.ws = args.ws; F.ctl = (unsigned*)(args.ws + WS_CTL);
    volatile LAS unsigned* bst = (volatile LAS unsigned*)(F.lds + LDS_BYTES - 16);
    if (F.tid < 4) bst[F.tid] = 0u;
    __syncthreads();
    const int lo = args.ph_lo, hi = args.ph_hi;
    XcdBarrier bar; bar.bar = F.ctl + CW_BAR; bar.x = 0; bar.st = bst;
    if (hi - lo > 1) bar = xcd_barrier_post(F.ctl + CW_BAR, bst);
#define IN(k) (lo <= (k) && (k) < hi)
#define SEAM(k) do { if (IN(k) && IN((k) + 1)) xcd_barrier(bar); } while (0)
    const float* mod = (const float*)(F.ws + WS_MOD);

#ifndef DBL_MASK
#define DBL_MASK 0x0u
#endif
#define RUN(k, body) do { if (IN(k)) { _Pragma("unroll 1") for (int _r = 0; _r < ((((DBL_MASK) >> (k)) & 1u) ? 2 : 1); ++_r) { if (_r) xcd_barrier(bar); F.lane = fresh_lane(); body; } } } while (0)
    RUN(0, phase_prep(F)); SEAM(0);
    RUN(1, phase_norm1_l0(F)); SEAM(1);
    RUN(2, if (FAST_GEMM) fast_inproj(F); else phase_inproj(F)); SEAM(2);
    if (IN(3)) { F.lane = fresh_lane();
#pragma unroll 1
        for (int _r = 0; _r < ((DBL_MASK & 0x100000u) ? 2 : 1); ++_r) { if (FAST_ATTN == 2 && FAST_GEMM) phase_attn_lds(F); else if (FAST_ATTN && FAST_GEMM) phase_attn_mfma(F); else phase_attn_simple(F); }
#pragma unroll 1
        for (int _r = 0; _r < ((DBL_MASK & 0x200000u) ? 2 : 1); ++_r) { if (FAST_FFT) phase_fft1_mfma(F); else phase_fft1_simple(F); }
    } SEAM(3);
    RUN(4, if (FAST_FFT) phase_fft2_mfma(F); else phase_fft2_simple(F)); SEAM(4);
    if (IN(5)) { if (!FAST_FFT) phase_fft3_simple(F); } if (!FAST_FFT) SEAM(5);
    RUN(6, if (FAST_GEMM) fast_outproj(F, WS_MIX, WS_WOUT, F.in[I_X], F.out, mod + 2048, nullptr); else phase_outproj(F, (const bf16*)(F.ws + WS_MIX), (const bf16*)(F.ws + WS_WOUT), F.in[I_X], F.out, mod + 2048, nullptr)); SEAM(6);
    if (IN(7)) { F.lane = fresh_lane(); if (XBF16) phase_norm2_route_mfma(F, 0); else phase_norm2_route(F, 0); } SEAM(7);
    if (MOE_MERGED && FAST_GEMM) { if (IN(8)) { F.lane = fresh_lane(); fast_moe_merged(F, 0); } if (IN(8) && IN(10)) xcd_barrier(bar); }
    else { RUN(8, if (FAST_GEMM) fast_moe_gateup(F, 0); else phase_moe_gateup(F, 0)); SEAM(8);
    RUN(9, if (FAST_GEMM) fast_moe_down(F, 0); else phase_moe_down(F, 0)); SEAM(9); }
    if (IN(10)) { F.lane = fresh_lane(); phase_combine<false>(F, 0); } SEAM(10);
    RUN(11, if (FAST_GEMM) fast_pw1(F); else phase_pw1(F)); SEAM(11);
    RUN(12, phase_dwconv_fast(F)); SEAM(12);
    if (IN(13)) { F.lane = fresh_lane(); if (FAST_GEMM) fast_outproj(F, WS_V1, WS_WPW2, F.out, F.out, mod + 5 * 6144 + 2048, F.in[I_PW2B]); else phase_outproj(F, (const bf16*)(F.ws + WS_V1), (const bf16*)(F.ws + WS_WPW2), F.out, F.out, mod + 5 * 6144 + 2048, F.in[I_PW2B]); } SEAM(13);
    if (IN(14)) { F.lane = fresh_lane(); if (XBF16) phase_norm2_route_mfma(F, 1); else phase_norm2_route(F, 1); } SEAM(14);
    if (MOE_MERGED && FAST_GEMM) { if (IN(15)) { F.lane = fresh_lane(); fast_moe_merged(F, 1); } if (IN(15) && IN(17)) xcd_barrier(bar); }
    else { RUN(15, if (FAST_GEMM) fast_moe_gateup(F, 1); else phase_moe_gateup(F, 1)); SEAM(15);
    RUN(16, if (FAST_GEMM) fast_moe_down(F, 1); else phase_moe_down(F, 1)); SEAM(16); }
    if (IN(17)) { F.lane = fresh_lane(); phase_combine<true>(F, 1); }
#undef RUN
#undef IN
#undef SEAM
}

extern "C" void kernel_launch(void* const* d_in, const int* in_sizes, int n_in, void* d_out, int out_size, void* d_ws, size_t ws_size, hipStream_t stream) {
    static int grid = 0;
    if (grid == 0) {
        if (n_in != 25 || out_size != T * D || ws_size < WS_END) { fprintf(stderr, "kernel_launch: unexpected shapes (n_in %d out %d ws %zu)\n", n_in, out_size, ws_size); grid = -1; return; }
        int dev = 0, cus = 0, per_cu = 0;
        if (hipGetDevice(&dev) != hipSuccess || hipDeviceGetAttribute(&cus, hipDeviceAttributeMultiprocessorCount, dev) != hipSuccess) { grid = -1; return; }
        if (hipFuncSetAttribute((const void*)mega, hipFuncAttributeMaxDynamicSharedMemorySize, LDS_BYTES) != hipSuccess) { fprintf(stderr, "kernel_launch: hipFuncSetAttribute failed\n"); grid = -1; return; }
        if (hipOccupancyMaxActiveBlocksPerMultiprocessor(&per_cu, (const void*)mega, NTHR, LDS_BYTES) != hipSuccess || per_cu < 1) { fprintf(stderr, "kernel_launch: occupancy query says %d\n", per_cu); }
        (void)hipGetLastError();
        grid = cus;
    }
    if (grid < 0) return;
    (void)hipMemsetAsync((char*)d_ws + WS_CTL, 0, CTL_BYTES, stream);
    Args a{};
    for (int i = 0; i < 25; ++i) a.in[i] = (const float*)d_in[i];
    a.out = (float*)d_out; a.ws = (unsigned char*)d_ws;
#if MK_ONE_LAUNCH
    a.ph_lo = 0; a.ph_hi = NPH;
    hipLaunchKernelGGL(mega, dim3(grid), dim3(NTHR), LDS_BYTES, stream, a);
#else
#ifndef PROBE_PHASE
#define PROBE_PHASE -1
#endif
    for (int p = 0; p < NPH; ++p) { a.ph_lo = p; a.ph_hi = p + 1; hipLaunchKernelGGL(mega, dim3(grid), dim3(NTHR), LDS_BYTES, stream, a);
        if (p == PROBE_PHASE) { if (p == 7 || p == 14) (void)hipMemsetAsync((char*)d_ws + WS_CTL, 0, CTL_BYTES, stream);
            hipLaunchKernelGGL(mega, dim3(grid), dim3(NTHR), LDS_BYTES, stream, a); } }
#endif
}
```

```cpp
#include <hip/hip_runtime.h>
#include <cstdio>

#ifndef MK_ONE_LAUNCH
#define MK_ONE_LAUNCH 1
#endif

#define GAS __attribute__((address_space(1)))
#define LAS __attribute__((address_space(3)))
typedef unsigned short bf16;
typedef short bf16x8 __attribute__((ext_vector_type(8)));
typedef float f32x4 __attribute__((ext_vector_type(4)));
typedef float f32x16 __attribute__((ext_vector_type(16)));
typedef unsigned u32x4 __attribute__((ext_vector_type(4)));
typedef unsigned u32x2 __attribute__((ext_vector_type(2)));

constexpr int D = 1024, NB = 4, L = 8192, T = NB * L, CL = 256, TC = NB * CL;
constexpr int NE = 16, FF = 512, CONVW = 31;
constexpr int N_IN = 1280;
constexpr int FN1 = 64, FN2 = 128;
#ifndef FAST_GEMM
#define FAST_GEMM 1
#endif
#ifndef MOE_MERGED
#define MOE_MERGED 1
#endif
#ifndef XBF16
#define XBF16 FAST_GEMM
#endif
#ifndef FAST_ATTN
#define FAST_ATTN 2
#endif
#ifndef FAST_FFT
#define FAST_FFT 1
#endif
constexpr int IL = FAST_GEMM ? 128 : 32;
constexpr float EPS = 1e-6f;
constexpr int NWAVES = 8, NTHR = 512;
constexpr int CAP = 32768;
constexpr int HROWS = 65536 + 4096;

constexpr size_t MiB = 1u << 20;
constexpr size_t WS_CTL = 0, CTL_BYTES = 1 * MiB;
constexpr size_t WS_MOD = 1 * MiB;
constexpr size_t WS_TW = 1 * MiB + 512 * 1024;
constexpr size_t WS_WIN = 2 * MiB, WS_WOUT = 6 * MiB, WS_WPW1 = 10 * MiB, WS_WPW2 = 14 * MiB;
constexpr size_t WS_WGU = 16 * MiB, WS_WDN = 80 * MiB;
constexpr size_t WS_TOKE = 112 * MiB, WS_TOKP = 113 * MiB, WS_TOKW = 114 * MiB;
constexpr size_t WS_SLOTT = 116 * MiB, WS_SLOTW = 120 * MiB;
constexpr size_t WS_HB = 128 * MiB;
constexpr size_t WS_UF = 196 * MiB, WS_Q = 228 * MiB, WS_K = 260 * MiB, WS_V = 268 * MiB, WS_CK = 276 * MiB, WS_CV = 277 * MiB;
constexpr size_t WS_G = 280 * MiB, WS_MIX = 344 * MiB, WS_AB = 408 * MiB;
constexpr size_t WS_XB = 408 * MiB;
constexpr size_t WS_HID = 196 * MiB, WS_Y = 264 * MiB;
constexpr size_t WS_U = 196 * MiB, WS_V1 = 260 * MiB;
constexpr size_t WS_END = 472 * MiB;
constexpr int CW_BAR = 4096;
constexpr int CW_CNT = 8192;
constexpr int CW_TILE = 16384;
constexpr int CW_TMO2 = 2048;

constexpr int LDS_BYTES = 147456;

__device__ __forceinline__ unsigned f2bf(float f) { unsigned u = __float_as_uint(f); return (u + 0x7fffu + ((u >> 16) & 1u)) >> 16; }
__device__ __forceinline__ float bf2f(unsigned b) { return __uint_as_float(b << 16); }
typedef __bf16 b16x2_t __attribute__((ext_vector_type(2)));
__device__ __forceinline__ unsigned pkbf(float a, float b) { typedef float f2 __attribute__((ext_vector_type(2))); f2 v = {a, b}; return __builtin_bit_cast(unsigned, __builtin_convertvector(v, b16x2_t)); }
__device__ __forceinline__ unsigned pk2(float lo, float hi) { return pkbf(lo, hi); }
__device__ __forceinline__ float bflo(unsigned w) { return __uint_as_float(w << 16); }
__device__ __forceinline__ float bfhi(unsigned w) { return __uint_as_float(w & 0xffff0000u); }
__device__ __forceinline__ float wave_sum(float v) {
    v += __builtin_bit_cast(float, __builtin_amdgcn_mov_dpp(__builtin_bit_cast(int, v), 0xB1, 0xf, 0xf, true));
    v += __builtin_bit_cast(float, __builtin_amdgcn_mov_dpp(__builtin_bit_cast(int, v), 0x4E, 0xf, 0xf, true));
    v += __builtin_bit_cast(float, __builtin_amdgcn_mov_dpp(__builtin_bit_cast(int, v), 0x141, 0xf, 0xf, true));
    v += __builtin_bit_cast(float, __builtin_amdgcn_mov_dpp(__builtin_bit_cast(int, v), 0x140, 0xf, 0xf, true));
    const int iv = __builtin_bit_cast(int, v);
    const float a = __builtin_bit_cast(float, __builtin_amdgcn_readlane(iv, 15)), b = __builtin_bit_cast(float, __builtin_amdgcn_readlane(iv, 31));
    const float c = __builtin_bit_cast(float, __builtin_amdgcn_readlane(iv, 47)), d = __builtin_bit_cast(float, __builtin_amdgcn_readlane(iv, 63));
    return (a + b) + (c + d);
}
__device__ __forceinline__ float silu_f(float x) { return x * __builtin_amdgcn_rcpf(1.f + __expf(-x)); }
__device__ __forceinline__ float sigmoid_f(float x) { return __builtin_amdgcn_rcpf(1.f + __expf(-x)); }
constexpr float YSCALE = 32.f;
__device__ __forceinline__ unsigned pk_fp8x4(f32x4 v) {
    int d = __builtin_amdgcn_cvt_pk_fp8_f32(__builtin_amdgcn_fmed3f(v[0] * YSCALE, -448.f, 448.f), __builtin_amdgcn_fmed3f(v[1] * YSCALE, -448.f, 448.f), 0, false);
    d = __builtin_amdgcn_cvt_pk_fp8_f32(__builtin_amdgcn_fmed3f(v[2] * YSCALE, -448.f, 448.f), __builtin_amdgcn_fmed3f(v[3] * YSCALE, -448.f, 448.f), d, true);
    return (unsigned)d;
}
__device__ __forceinline__ f32x4 un_fp8x4(unsigned d) { typedef float f2 __attribute__((ext_vector_type(2)));
    const f2 lo = __builtin_amdgcn_cvt_pk_f32_fp8((int)d, false), hi = __builtin_amdgcn_cvt_pk_f32_fp8((int)d, true); return (f32x4){lo.x, lo.y, hi.x, hi.y}; }
#define LDS_WAIT() asm volatile("s_waitcnt lgkmcnt(0)" ::: "memory")
__device__ __forceinline__ int fresh_lane() { int l; asm volatile("v_mbcnt_lo_u32_b32 %0, -1, 0\n\tv_mbcnt_hi_u32_b32 %0, -1, %0" : "=v"(l)); return l; }

#define XB_TMO      128
#define XB_XCNT(j)  (256  + 64 * (j))
#define XB_XSUB(j)  (1280 + 64 * (j))
#define XB_XGEN(j)  (2304 + 64 * (j))
#define XB_TOP      3328
#define XB_TOPGEN   3392
#define XCD_BAR_WORDS 3456
#define XB_SPIN_CAP (1u << 20)
__device__ __forceinline__ unsigned xb_ld(unsigned* p)              { return __hip_atomic_load(p, __ATOMIC_RELAXED, __HIP_MEMORY_SCOPE_AGENT); }
__device__ __forceinline__ unsigned xb_add(unsigned* p, unsigned v) { return __hip_atomic_fetch_add(p, v, __ATOMIC_RELAXED, __HIP_MEMORY_SCOPE_AGENT); }
__device__ __forceinline__ unsigned xb_xcc_id() { return (unsigned)__builtin_amdgcn_s_getreg((3 << 11) | 20) & 0xFu; }
#define XB_SPIN(cond, bar) do { unsigned _sp = 0; while (cond) { __builtin_amdgcn_s_sleep(1); \
    if ((++_sp & 255u) == 0u) { if (xb_ld(&(bar)[XB_TMO])) break; if (_sp > XB_SPIN_CAP) { atomicAdd(&(bar)[XB_TMO], 1u); break; } } } } while (0)
struct XcdBarrier { unsigned* bar; unsigned x; volatile LAS unsigned* st; };
__device__ __forceinline__ XcdBarrier xcd_barrier_post(unsigned* bar, volatile LAS unsigned* st) {
    XcdBarrier b; b.bar = bar; b.x = xb_xcc_id(); b.st = st;
    if (threadIdx.x == 0) (void)xb_add(&bar[XB_XCNT(b.x)], 1u);
    return b;
}
__device__ __forceinline__ void xcd_barrier_complete(unsigned* bar, unsigned x, unsigned& nloc, unsigned& nx) {
    const unsigned G = gridDim.x * gridDim.y * gridDim.z;
    unsigned sum, cnt, mine, sp = 0u;
    for (;;) {
        sum = 0u; cnt = 0u; mine = 0u;
#pragma unroll
        for (unsigned j = 0; j < 16; ++j) { const unsigned c = xb_ld(&bar[XB_XCNT(j)]); sum += c; cnt += (c > 0u) ? 1u : 0u; mine = (j == x) ? c : mine; }
        if (sum == G) break;
        __builtin_amdgcn_s_sleep(1);
        if ((++sp & 255u) == 0u) { if (xb_ld(&bar[XB_TMO])) break; if (sp > XB_SPIN_CAP) { atomicAdd(&bar[XB_TMO], 1u); break; } }
    }
    nloc = mine > 0u ? mine : 1u; nx = cnt > 0u ? cnt : 1u;
}
__device__ __forceinline__ void xcd_barrier(const XcdBarrier& b) {
    asm volatile("s_waitcnt vmcnt(0)" ::: "memory");
    __syncthreads();
    if (threadIdx.x == 0) {
        unsigned* bar = b.bar;
        __builtin_amdgcn_s_waitcnt(0);
        unsigned nloc = b.st[0], nx = b.st[1];
        if (nloc == 0u) { xcd_barrier_complete(bar, b.x, nloc, nx); b.st[0] = nloc; b.st[1] = nx; }
        const unsigned old = xb_add(&bar[XB_XSUB(b.x)], 1u);
        const unsigned gen = old / nloc;
        if (old + 1u == (gen + 1u) * nloc) {
            __builtin_amdgcn_fence(__ATOMIC_RELEASE, "agent");
            asm volatile("s_waitcnt vmcnt(0)" ::: "memory");
            const unsigned og = xb_add(&bar[XB_TOP], 1u);
            const unsigned tg = og / nx;
            if (og + 1u == (tg + 1u) * nx) xb_add(&bar[XB_TOPGEN], 1u);
            else XB_SPIN(xb_ld(&bar[XB_TOPGEN]) == tg, bar);
            __builtin_amdgcn_fence(__ATOMIC_ACQUIRE, "agent");
            xb_add(&bar[XB_XGEN(b.x)], 1u);
            asm volatile("s_waitcnt vmcnt(0)" ::: "memory");
        } else {
            XB_SPIN(xb_ld(&bar[XB_XGEN(b.x)]) == gen, bar);
            __builtin_amdgcn_fence(__ATOMIC_ACQUIRE, "agent");
            asm volatile("s_waitcnt vmcnt(0)" ::: "memory");
        }
    }
    __syncthreads();
}

struct Args { const float* in[25]; float* out; unsigned char* ws; int ph_lo, ph_hi; };
enum { I_X = 0, I_C, I_CTX, I_CCTX, I_ADAW, I_ADAB, I_NMG, I_NFG, I_WIN, I_WOUT, I_SINK, I_PW1W, I_PW1B, I_DWW, I_DWB, I_LNG, I_LNB,
       I_PW2W, I_PW2B, I_RW, I_RB, I_WG, I_WU, I_WD, I_FNG };

struct InPtrs {
    __device__ __forceinline__ const float* operator[](int i) const { const float* r;
        asm volatile("s_load_dwordx2 %0, %1, %2\n\ts_waitcnt lgkmcnt(0)" : "=s"(r) : "s"(__builtin_amdgcn_kernarg_segment_ptr()), "s"(i * 8)); return r; }
};
struct Frame {
    LAS unsigned char* lds;
    int tid, lane, wave, G, wg;
    InPtrs in;
    float* out;
    unsigned char* ws;
    unsigned* ctl;
};

__device__ __forceinline__ int crow(int i, int h) { return (i & 3) + 8 * (i >> 2) + 4 * h; }
template <class RowPtr, class Epi>
__device__ __forceinline__ void sgemm_tile(const RowPtr& rowptr, const bf16* Bt, int K, int m0, int n0, const Epi& epi, int wave, int lane) {
    const int wm = wave & 3, wn = wave >> 2, r = lane & 31, h = lane >> 5;
    const bf16* ap = rowptr(m0 + wm * 32 + r) + 8 * h;
    const bf16* bp0 = Bt + (size_t)(n0 + wn * 64 + r) * K + 8 * h;
    const bf16* bp1 = bp0 + (size_t)32 * K;
    f32x16 c0, c1;
#pragma unroll
    for (int i = 0; i < 16; ++i) { c0[i] = 0.f; c1[i] = 0.f; }
#pragma unroll 2
    for (int k = 0; k < K; k += 32) {
        const bf16x8 a0 = *(const bf16x8*)(ap + k), a1 = *(const bf16x8*)(ap + k + 16);
        const bf16x8 b00 = *(const bf16x8*)(bp0 + k), b01 = *(const bf16x8*)(bp0 + k + 16);
        const bf16x8 b10 = *(const bf16x8*)(bp1 + k), b11 = *(const bf16x8*)(bp1 + k + 16);
        c0 = __builtin_amdgcn_mfma_f32_32x32x16_bf16(a0, b00, c0, 0, 0, 0);
        c1 = __builtin_amdgcn_mfma_f32_32x32x16_bf16(a0, b10, c1, 0, 0, 0);
        c0 = __builtin_amdgcn_mfma_f32_32x32x16_bf16(a1, b01, c0, 0, 0, 0);
        c1 = __builtin_amdgcn_mfma_f32_32x32x16_bf16(a1, b11, c1, 0, 0, 0);
    }
    epi(m0 + wm * 32, n0 + wn * 64, c0, c1, lane);
}

__device__ __forceinline__ void p0_transpose_item(const float* W, int K, int N, bf16* WT, int k0, int n0, int drow0, LAS float* scr, int lane) {
#pragma unroll 8
    for (int i = 0; i < 32; ++i) { const int kk = 2 * i + (lane >> 5); scr[kk * 33 + (lane & 31)] = W[(size_t)(k0 + kk) * N + n0 + (lane & 31)]; }
    LDS_WAIT(); asm volatile("" ::: "memory");
    const int c = lane & 7;
#pragma unroll
    for (int j = 0; j < 4; ++j) { const int n = (lane >> 3) + 8 * j; const LAS float* s = scr + (8 * c) * 33 + n;
        u32x4 o; o.x = pk2(s[0 * 33], s[1 * 33]); o.y = pk2(s[2 * 33], s[3 * 33]); o.z = pk2(s[4 * 33], s[5 * 33]); o.w = pk2(s[6 * 33], s[7 * 33]);
        *(u32x4*)(WT + (size_t)(drow0 + n) * K + k0 + 8 * c) = o; }
    LDS_WAIT(); asm volatile("" ::: "memory");
}
__device__ __forceinline__ int il_row(int j, int half) { return (j / IL) * (2 * IL) + half * IL + (j % IL); }

constexpr int T_NITEMS = 640 + 512 + 1024 + 512 + 3 * 32 * 256, T_DEFER_ATT = 10 * 2048;
struct TItem { const float* W; bf16* WT; int K, N, k0, n0, drow0; bool ok; };
__device__ __forceinline__ TItem t_decode(const Frame& F, int it) {
    constexpr int S0 = 640, S1 = 512, S2 = 1024, S3 = 512, SM = 32 * 256;
    TItem t; t.ok = it < S0 + S1 + S2 + S3 + 3 * SM; t.W = F.in[I_WIN]; t.WT = (bf16*)(F.ws + WS_WIN); t.K = 1024; t.N = 1280; t.k0 = 0; t.n0 = 0; t.drow0 = 0;
    int r = it;
    if (r < S0) { const int kb = r / 40, nb = r % 40; t.k0 = kb * 64; t.n0 = nb * 32; t.drow0 = nb * 32; return t; } r -= S0;
    if (r < S1) { const int kb = r / 32, nb = r % 32; t.W = F.in[I_WOUT]; t.WT = (bf16*)(F.ws + WS_WOUT); t.N = 1024; t.k0 = kb * 64; t.n0 = nb * 32; t.drow0 = nb * 32; return t; } r -= S1;
    if (r < S2) { const int kb = r / 64, nb = r % 64, n0 = nb * 32; t.W = F.in[I_PW1W]; t.WT = (bf16*)(F.ws + WS_WPW1); t.N = 2048; t.k0 = kb * 64; t.n0 = n0; t.drow0 = il_row(n0 & 1023, n0 >> 10); return t; } r -= S2;
    if (r < S3) { const int kb = r / 32, nb = r % 32; t.W = F.in[I_PW2W]; t.WT = (bf16*)(F.ws + WS_WPW2); t.N = 1024; t.k0 = kb * 64; t.n0 = nb * 32; t.drow0 = nb * 32; return t; } r -= S3;
    if (r < SM) { const int le = r >> 8, q = r & 255, kb = q / 16, nb = q % 16; t.W = F.in[I_WG] + (size_t)le * 1024 * 512; t.WT = (bf16*)(F.ws + WS_WGU) + (size_t)le * 1024 * 1024; t.N = 512; t.k0 = kb * 64; t.n0 = nb * 32; t.drow0 = il_row(nb * 32, 0); return t; } r -= SM;
    if (r < SM) { const int le = r >> 8, q = r & 255, kb = q / 16, nb = q % 16; t.W = F.in[I_WU] + (size_t)le * 1024 * 512; t.WT = (bf16*)(F.ws + WS_WGU) + (size_t)le * 1024 * 1024; t.N = 512; t.k0 = kb * 64; t.n0 = nb * 32; t.drow0 = il_row(nb * 32, 1); return t; } r -= SM;
    { const int le = (r >> 8) & 31, q = r & 255, kb = q / 32, nb = q % 32; t.W = F.in[I_WD] + (size_t)le * 512 * 1024; t.WT = (bf16*)(F.ws + WS_WDN) + (size_t)le * 1024 * 512; t.K = 512; t.N = 1024; t.k0 = kb * 64; t.n0 = nb * 32; t.drow0 = nb * 32; }
    return t;
}
__device__ __forceinline__ void t_load(const TItem& t, int lane, float (&v)[32]) {
    if (t.ok) {
#pragma unroll
        for (int i = 0; i < 32; ++i) v[i] = t.W[(size_t)(t.k0 + 2 * i + (lane >> 5)) * t.N + t.n0 + (lane & 31)];
    }
}
__device__ __forceinline__ void t_store(const TItem& t, LAS float* scr, int lane, const float (&v)[32]) {
#pragma unroll
    for (int i = 0; i < 32; ++i) scr[(2 * i + (lane >> 5)) * 33 + (lane & 31)] = v[i];
    LDS_WAIT(); asm volatile("" ::: "memory");
    const int c = lane & 7;
#pragma unroll
    for (int j = 0; j < 4; ++j) { const int n = (lane >> 3) + 8 * j; const LAS float* s = scr + (8 * c) * 33 + n;
        u32x4 o; o.x = pk2(s[0 * 33], s[1 * 33]); o.y = pk2(s[2 * 33], s[3 * 33]); o.z = pk2(s[4 * 33], s[5 * 33]); o.w = pk2(s[6 * 33], s[7 * 33]);
        *(u32x4*)(t.WT + (size_t)(t.drow0 + n) * t.K + t.k0 + 8 * c) = o; }
    LDS_WAIT(); asm volatile("" ::: "memory");
}
__device__ __forceinline__ void t_dma(const TItem& t, LAS unsigned char* scr, int lane) {
    if (t.ok) {
#pragma unroll
        for (int i = 0; i < 8; ++i)
            __builtin_amdgcn_global_load_lds((const unsigned*)(t.W + (size_t)(t.k0 + 8 * i + (lane >> 3)) * t.N + t.n0 + 4 * (lane & 7)), (LAS unsigned*)(scr + 1056 * i), 16, 0, 0);
    }
}
__device__ __forceinline__ void t_store_dma(const TItem& t, const LAS float* scr, int lane) {
    const int c = lane & 7;
#pragma unroll 1
    for (int j = 0; j < 4; ++j) { const int n = (lane >> 3) + 8 * j; float e[8];
#pragma unroll
        for (int q = 0; q < 8; ++q) e[q] = scr[264 * c + 32 * q + n];
        { u32x4 o; o.x = pk2(e[0], e[1]); o.y = pk2(e[2], e[3]); o.z = pk2(e[4], e[5]); o.w = pk2(e[6], e[7]); *(u32x4*)(t.WT + (size_t)(t.drow0 + n) * t.K + t.k0 + 8 * c) = o; } }
    LDS_WAIT(); asm volatile("" ::: "memory");
}
__device__ __forceinline__ void t_items_tail(Frame& F, int r, int nw) {
    LAS float* scr = (LAS float*)(F.lds + F.wave * 8704);
    TItem cur = t_decode(F, 640 + T_DEFER_ATT + r); float va[32], vb[32];
    t_load(cur, F.lane, va);
#pragma unroll 1
    for (int it = r; cur.ok; it += nw) {
        const TItem nxt = t_decode(F, 640 + T_DEFER_ATT + it + nw);
        t_load(nxt, F.lane, vb);
        t_store(cur, scr, F.lane, va);
#pragma unroll
        for (int i = 0; i < 32; ++i) va[i] = vb[i];
        cur = nxt;
    }
}
__device__ __forceinline__ void phase_prep(Frame& F) {
    {
        LAS float* sc = (LAS float*)F.lds;
        LAS float* red = sc + 5 * 1024;
        bool loaded = false;
        for (int it = F.wg; it < 192; it += F.G) {
            if (!loaded) {
                for (int i = F.tid; i < 5 * 1024; i += NTHR) { const int b = i >> 10, k = i & 1023; const float v = b < 4 ? F.in[I_C][b * 1024 + k] : F.in[I_CCTX][k]; sc[i] = silu_f(v); }
                __syncthreads(); loaded = true;
            }
            const int l = it / 96, n0 = (it % 96) * 64, c4 = F.tid & 15, kg = F.tid >> 4;
            const float* w = F.in[I_ADAW] + (size_t)l * 1024 * 6144 + n0 + 4 * c4;
            f32x4 a[5];
#pragma unroll
            for (int b = 0; b < 5; ++b) a[b] = (f32x4){0.f, 0.f, 0.f, 0.f};
#pragma unroll 16
            for (int kk = 0; kk < 32; ++kk) { const int k = kg * 32 + kk; const f32x4 wv = *(const f32x4*)(w + (size_t)k * 6144);
#pragma unroll
                for (int b = 0; b < 5; ++b) a[b] += sc[b * 1024 + k] * wv; }
#pragma unroll
            for (int b = 0; b < 5; ++b) *(LAS f32x4*)(red + (kg * 5 + b) * 64 + 4 * c4) = a[b];
            __syncthreads();
            if (F.tid < 320) { const int b = F.tid >> 6, c2 = F.tid & 63; float sm = 0.f;
#pragma unroll
                for (int g = 0; g < 32; ++g) sm += red[(g * 5 + b) * 64 + c2];
                ((float*)(F.ws + WS_MOD))[((size_t)l * 5 + b) * 6144 + n0 + c2] = sm + F.in[I_ADAB][l * 6144 + n0 + c2]; }
            __syncthreads();
        }
        __syncthreads();
    }
    { u32x4* z = (u32x4*)(F.ws + WS_SLOTT); const u32x4 zero = {0u, 0u, 0u, 0u};
      for (int i = F.wg * NTHR + F.tid; i < 2 * 16 * CAP / 4; i += F.G * NTHR) z[i] = zero; }
    { float* tw = (float*)(F.ws + WS_TW);
      for (int k = F.wg * NTHR + F.tid; k < 8192; k += F.G * NTHR) { const float a = (float)k * (6.283185307179586f / 8192.f); tw[2 * k] = __cosf(a); tw[2 * k + 1] = __sinf(a); } }
    {
        LAS float* scr = (LAS float*)(F.lds + F.wave * 8704);
        const int gw = F.wg * NWAVES + F.wave, NGW = F.G * NWAVES;
        auto vmap = [](int v) { return v < 640 ? v : (1 << 30); };
        TItem cur = t_decode(F, vmap(gw)); float va[32], vb[32];
        t_load(cur, F.lane, va);
#pragma unroll 1
        for (int it = gw; cur.ok; it += NGW) {
            const TItem nxt = t_decode(F, vmap(it + NGW));
            t_load(nxt, F.lane, vb);
            t_store(cur, scr, F.lane, va);
#pragma unroll
            for (int i = 0; i < 32; ++i) va[i] = vb[i];
            cur = nxt;
        }
    }
}

#define ROFF(lane, j) (512 * ((j) >> 1) + 8 * (lane) + 4 * ((j) & 1))
__device__ __forceinline__ void row_load(const float* p, int lane, f32x4 (&v)[4]) {
#pragma unroll
    for (int j = 0; j < 4; ++j) v[j] = *(const f32x4*)(p + ROFF(lane, j));
}
__device__ __forceinline__ void row_load_bf(const bf16* p, int lane, f32x4 (&v)[4]) {
#pragma unroll
    for (int jj = 0; jj < 2; ++jj) { const u32x4 w = *(const u32x4*)(p + 512 * jj + 8 * lane); v[2 * jj] = (f32x4){bflo(w.x), bfhi(w.x), bflo(w.y), bfhi(w.y)}; v[2 * jj + 1] = (f32x4){bflo(w.z), bfhi(w.z), bflo(w.w), bfhi(w.w)}; }
}
__device__ __forceinline__ void xrow_load(const float* xf, const bf16* xb, size_t row, int lane, f32x4 (&v)[4]) { if (XBF16) row_load_bf(xb + row * D, lane, v); else row_load(xf + row * D, lane, v); }
__device__ __forceinline__ float row_sumsq(const f32x4 (&v)[4]) {
    float s = 0.f;
#pragma unroll
    for (int j = 0; j < 4; ++j) s += (v[j].x * v[j].x + v[j].y * v[j].y) + (v[j].z * v[j].z + v[j].w * v[j].w);
    return wave_sum(s);
}
__device__ __forceinline__ void row_modulate(f32x4 (&v)[4], float rstd, const float* g, const float* sh, const float* sc, int lane) {
#pragma unroll
    for (int j = 0; j < 4; ++j) { const int o = ROFF(lane, j); const f32x4 gg = *(const f32x4*)(g + o), s1 = *(const f32x4*)(sc + o), s0 = *(const f32x4*)(sh + o);
        v[j] = v[j] * rstd * gg * (1.f + s1) + s0; }
}
__device__ __forceinline__ void row_store_bf16(bf16* dst, const f32x4 (&v)[4], int lane) {
#pragma unroll
    for (int jj = 0; jj < 2; ++jj) { u32x4 w; w.x = pk2(v[2 * jj].x, v[2 * jj].y); w.y = pk2(v[2 * jj].z, v[2 * jj].w); w.z = pk2(v[2 * jj + 1].x, v[2 * jj + 1].y); w.w = pk2(v[2 * jj + 1].z, v[2 * jj + 1].w); *(u32x4*)(dst + 512 * jj + 8 * lane) = w; }
}

__device__ __forceinline__ void phase_norm1_l0(Frame& F) {
    const int gw = F.wg * NWAVES + F.wave, NGW = F.G * NWAVES;
    const float* mod = (const float*)(F.ws + WS_MOD);
    bf16* HB = (bf16*)(F.ws + WS_HB);
    for (int row = gw; row < T + TC; row += NGW) {
        const float* src = row < T ? F.in[I_X] + (size_t)row * D : F.in[I_CTX] + (size_t)(row - T) * D;
        const int b = row < T ? (row >> 13) : 4;
        f32x4 v[4]; row_load(src, F.lane, v);
        const float rstd = rsqrtf(row_sumsq(v) * (1.f / D) + EPS);
        const float* m = mod + (size_t)b * 6144;
        row_modulate(v, rstd, F.in[I_NMG], m, m + 1024, F.lane);
        row_store_bf16(HB + (size_t)row * D, v, F.lane);
    }
}

struct RowLin { const bf16* base; size_t pitch; __device__ __forceinline__ const bf16* operator()(int m) const { return base + (size_t)m * pitch; } };

__device__ __forceinline__ void inproj_block(Frame& F, int mb, int nbk, const f32x16& c, int lane) {
    const int h = lane >> 5, cl = lane & 31;
    bf16* dst; int pitch, cbase; bool rope = false; bool isctx = (mb >= T);
    if (nbk < 512) { dst = (bf16*)(F.ws + WS_UF); pitch = 512; cbase = 0; }
    else if (nbk < 1024) { dst = (bf16*)(F.ws + WS_Q); pitch = 512; cbase = 512; rope = true; }
    else if (nbk < 1152) { dst = isctx ? (bf16*)(F.ws + WS_CK) : (bf16*)(F.ws + WS_K); pitch = 128; cbase = 1024; rope = !isctx; }
    else { dst = isctx ? (bf16*)(F.ws + WS_CV) : (bf16*)(F.ws + WS_V); pitch = 128; cbase = 1152; }
    const int rbase = isctx ? mb - T : mb;
    const int col = nbk - cbase + cl;
    const float inv = exp2f(-(float)(cl & 15) * (13.287712379549449f / 16.f));
    const bool second = (cl & 16) != 0; const bool bycol = ((nbk >> 5) & 1) != 0;
#pragma unroll
    for (int i = 0; i < 16; ++i) {
        const int rr = crow(i, h); float v = c[i];
        if (rope) {
            const float partner = __shfl_xor(v, 16);
            const int l = (mb + rr) & (L - 1);
            const float pos = (float)(bycol ? (l & 63) : (l >> 6));
            const float ang = pos * inv, cs = __cosf(ang), sn = __sinf(ang);
            v = second ? (partner * sn + v * cs) : (v * cs - partner * sn);
        }
        dst[(size_t)(rbase + rr) * pitch + col] = (bf16)f2bf(v);
    }
}
__device__ __forceinline__ void phase_inproj(Frame& F) {
    const bf16* HB = (const bf16*)(F.ws + WS_HB); const bf16* Wt = (const bf16*)(F.ws + WS_WIN);
    constexpr int MT = (T + TC) / 128, NT = N_IN / 128;
    RowLin rp{HB, (size_t)D};
    for (int u = F.wg; u < MT * NT; u += F.G) {
        const int mt = u / NT, nt = u % NT;
        if (mt >= T / 128 && nt < 8) continue;
        auto epi = [&](int mb, int nb, const f32x16& c0, const f32x16& c1, int lane) { inproj_block(F, mb, nb, c0, lane); inproj_block(F, mb, nb + 32, c1, lane); };
        sgemm_tile(rp, Wt, D, mt * 128, nt * 128, epi, F.wave, F.lane);
    }
}

__device__ __forceinline__ void attn_key(const bf16* kp, const bf16* vp, const float (&q)[64], float& m, float& s, float (&o)[64]) {
    float dot = 0.f;
#pragma unroll
    for (int j = 0; j < 8; ++j) { const u32x4 w = *(const u32x4*)(kp + 8 * j);
        dot += q[8 * j + 0] * bflo(w.x) + q[8 * j + 1] * bfhi(w.x) + q[8 * j + 2] * bflo(w.y) + q[8 * j + 3] * bfhi(w.y)
             + q[8 * j + 4] * bflo(w.z) + q[8 * j + 5] * bfhi(w.z) + q[8 * j + 6] * bflo(w.w) + q[8 * j + 7] * bfhi(w.w); }
    const float mn = fmaxf(m, dot), alpha = __expf(m - mn), p = __expf(dot - mn);
    s = s * alpha + p; m = mn;
#pragma unroll
    for (int j = 0; j < 8; ++j) { const u32x4 w = *(const u32x4*)(vp + 8 * j);
        o[8 * j + 0] = o[8 * j + 0] * alpha + p * bflo(w.x); o[8 * j + 1] = o[8 * j + 1] * alpha + p * bfhi(w.x);
        o[8 * j + 2] = o[8 * j + 2] * alpha + p * bflo(w.y); o[8 * j + 3] = o[8 * j + 3] * alpha + p * bfhi(w.y);
        o[8 * j + 4] = o[8 * j + 4] * alpha + p * bflo(w.z); o[8 * j + 5] = o[8 * j + 5] * alpha + p * bfhi(w.z);
        o[8 * j + 6] = o[8 * j + 6] * alpha + p * bflo(w.w); o[8 * j + 7] = o[8 * j + 7] * alpha + p * bfhi(w.w); }
}
__device__ __forceinline__ void phase_attn_simple(Frame& F) {
    const bf16* Q = (const bf16*)(F.ws + WS_Q); const bf16* Kb = (const bf16*)(F.ws + WS_K); const bf16* Vb = (const bf16*)(F.ws + WS_V);
    const bf16* CK = (const bf16*)(F.ws + WS_CK); const bf16* CV = (const bf16*)(F.ws + WS_CV); bf16* MIX = (bf16*)(F.ws + WS_MIX);
    for (int idx = F.wg * NTHR + F.tid; idx < T * 8; idx += F.G * NTHR) {
        const int hd = idx / T, t = idx % T, b = t >> 13, l = t & (L - 1), kvh = hd >> 2;
        float q[64], o[64];
#pragma unroll
        for (int j = 0; j < 8; ++j) { const u32x4 w = *(const u32x4*)(Q + (size_t)t * 512 + hd * 64 + 8 * j);
            q[8 * j + 0] = bflo(w.x) * 0.125f; q[8 * j + 1] = bfhi(w.x) * 0.125f; q[8 * j + 2] = bflo(w.y) * 0.125f; q[8 * j + 3] = bfhi(w.y) * 0.125f;
            q[8 * j + 4] = bflo(w.z) * 0.125f; q[8 * j + 5] = bfhi(w.z) * 0.125f; q[8 * j + 6] = bflo(w.w) * 0.125f; q[8 * j + 7] = bfhi(w.w) * 0.125f; }
#pragma unroll
        for (int j = 0; j < 64; ++j) o[j] = 0.f;
        float m = F.in[I_SINK][hd], s = 1.f;
        for (int c = 0; c < CL; ++c) { const size_t r = (size_t)(b * CL + c) * 128 + kvh * 64; attn_key(CK + r, CV + r, q, m, s, o); }
        const int lo = l - 128 < 0 ? 0 : l - 128, hi = l + 128 > L - 1 ? L - 1 : l + 128;
        for (int kp = lo; kp <= hi; ++kp) { const size_t r = (size_t)(b * L + kp) * 128 + kvh * 64; attn_key(Kb + r, Vb + r, q, m, s, o); }
        const float is = 1.f / s;
#pragma unroll
        for (int j = 0; j < 8; ++j) { u32x4 w; w.x = pk2(o[8 * j] * is, o[8 * j + 1] * is); w.y = pk2(o[8 * j + 2] * is, o[8 * j + 3] * is); w.z = pk2(o[8 * j + 4] * is, o[8 * j + 5] * is); w.w = pk2(o[8 * j + 6] * is, o[8 * j + 7] * is);
            *(u32x4*)(MIX + (size_t)t * 1024 + 512 + hd * 64 + 8 * j) = w; }
    }
}

__device__ __forceinline__ void phase_fft1_simple(Frame& F) {
    const bf16* UF = (const bf16*)(F.ws + WS_UF); bf16* Gb = (bf16*)(F.ws + WS_G); const float* tw = (const float*)(F.ws + WS_TW);
    for (int idx = F.wg * NTHR + F.tid; idx < NB * FN1 * FN2 * 512; idx += F.G * NTHR) {
        const int ch = idx & 511, bp = (idx >> 9) & 127, c = (idx >> 16) & 63, b = idx >> 22;
        float re = 0.f, im = 0.f;
        for (int a = 0; a < FN1; ++a) { const float u = bf2f(UF[(size_t)(b * L + 128 * a + bp) * 512 + ch]); const int k = ((a * c) & 63) * 128;
            re += u * tw[2 * k]; im -= u * tw[2 * k + 1]; }
        const int k2 = bp * c; const float cs = tw[2 * k2], sn = tw[2 * k2 + 1];
        const float gr = re * cs + im * sn, gi = im * cs - re * sn;
        const size_t row = (size_t)(b * FN1 + c) * FN2 + bp;
        Gb[row * 1024 + ch] = (bf16)f2bf(gr); Gb[row * 1024 + 512 + ch] = (bf16)f2bf(gi);
    }
}
__device__ __forceinline__ void phase_fft2_simple(Frame& F) {
    const bf16* Gb = (const bf16*)(F.ws + WS_G); bf16* AB = (bf16*)(F.ws + WS_AB); const float* tw = (const float*)(F.ws + WS_TW);
    for (int idx = F.wg * NTHR + F.tid; idx < NB * FN1 * FN2 * 512; idx += F.G * NTHR) {
        const int ch = idx & 511, d = (idx >> 9) & 127, c = (idx >> 16) & 63, b = idx >> 22;
        float fr = 0.f, fi = 0.f;
        for (int bp = 0; bp < FN2; ++bp) { const size_t row = (size_t)(b * FN1 + c) * FN2 + bp; const float gr = bf2f(Gb[row * 1024 + ch]), gi = bf2f(Gb[row * 1024 + 512 + ch]);
            const int k = ((bp * d) & 127) * 64; const float cs = tw[2 * k], sn = tw[2 * k + 1];
            fr += gr * cs + gi * sn; fi += gi * cs - gr * sn; }
        const size_t t = (size_t)b * L + c + 64 * d;
        AB[t * 1024 + ch] = (bf16)f2bf(fr); AB[t * 1024 + 512 + ch] = (bf16)f2bf(-fi);
    }
}
__device__ __forceinline__ void phase_fft3_simple(Frame& F) {
    const bf16* AB = (const bf16*)(F.ws + WS_AB); bf16* MIX = (bf16*)(F.ws + WS_MIX); const float* tw = (const float*)(F.ws + WS_TW);
    LAS float* t128 = (LAS float*)F.lds;
    for (int i = F.tid; i < 128; i += NTHR) { t128[2 * i] = tw[2 * (i * 64)]; t128[2 * i + 1] = tw[2 * (i * 64) + 1]; }
    __syncthreads();
    for (int idx = F.wg * NTHR + F.tid; idx < T * 512; idx += F.G * NTHR) {
        const int cp = idx & 127, g = (idx >> 7) & 3, t = idx >> 9;
        const bf16* arow = AB + (size_t)t * 1024 + g * 128;
        float y = 0.f;
        for (int cc = 0; cc < 128; ++cc) { const int k = (cc * cp) & 127; y += bf2f(arow[cc]) * t128[2 * k] - bf2f(arow[512 + cc]) * t128[2 * k + 1]; }
        MIX[(size_t)t * 1024 + g * 128 + cp] = (bf16)f2bf(y * (1.f / 1024.f));
    }
    __syncthreads();
}

__device__ __forceinline__ void phase_outproj(Frame& F, const bf16* A, const bf16* Wt, const float* base, float* X, const float* gate  , const float* bias) {
    RowLin rp{A, (size_t)D};
    for (int u = F.wg; u < (T / 128) * 8; u += F.G) {
        const int mt = u / 8, nt = u % 8;
        auto epi = [&](int mb, int nb, const f32x16& c0, const f32x16& c1, int lane) {
            const int h = lane >> 5, cl = lane & 31, b = mb >> 13;
#pragma unroll
            for (int half = 0; half < 2; ++half) { const int col = nb + 32 * half + cl; const float gv = gate[(size_t)b * 6144 + col], bv = bias ? bias[col] : 0.f;
#pragma unroll
                for (int i = 0; i < 16; ++i) { const size_t o = (size_t)(mb + crow(i, h)) * D + col; const float a = half ? c1[i] : c0[i]; X[o] = base[o] + gv * (a + bv); } }
        };
        sgemm_tile(rp, Wt, D, mt * 128, nt * 128, epi, F.wave, F.lane);
    }
}

__device__ __forceinline__ void route_select(const float (&lg)[16], const float* rb, int& be1, int& be2, float& w1, float& w2) {
    float best = -1e30f; float bs1 = 0.f, bs2 = 0.f; be1 = 0; be2 = 0;
#pragma unroll
    for (int g = 0; g < 4; ++g) {
        float v1 = -1e30f, v2 = -1e30f, s1 = 0.f, s2 = 0.f; int j1 = 0, j2 = 0;
#pragma unroll
        for (int q = 0; q < 4; ++q) { const float sc = sigmoid_f(lg[4 * g + q]), x = sc + rb[4 * g + q];
            if (x > v1) { v2 = v1; j2 = j1; s2 = s1; v1 = x; j1 = q; s1 = sc; } else if (x > v2) { v2 = x; j2 = q; s2 = sc; } }
        const float gs = v1 + v2;
        if (gs > best) { best = gs; be1 = 4 * g + j1; be2 = 4 * g + j2; bs1 = s1; bs2 = s2; }
    }
    const float inv = 1.f / (bs1 + bs2); w1 = bs1 * inv; w2 = bs2 * inv;
}
__device__ __forceinline__ void phase_norm2_route(Frame& F, int layer) {
    const float* mod = (const float*)(F.ws + WS_MOD) + (size_t)layer * 5 * 6144;
    const float* X = F.out; const bf16* XB = (const bf16*)(F.ws + WS_XB); bf16* HB = (bf16*)(F.ws + WS_HB);
    const float* rw = F.in[I_RW]; const float* rb = F.in[I_RB];
    int* tok_e = (int*)(F.ws + WS_TOKE); int* tok_p = (int*)(F.ws + WS_TOKP); float* tok_w = (float*)(F.ws + WS_TOKW);
    int* slot_t = (int*)(F.ws + WS_SLOTT) + layer * 16 * CAP;
    float* slot_w = (float*)(F.ws + WS_SLOTW) + layer * 16 * CAP;
    unsigned* cnt = F.ctl + CW_CNT + layer * 16 * 64;
    LAS float* rwt = (LAS float*)F.lds;
    LAS int* sel_e = (LAS int*)(F.lds + 65536);
    LAS float* sel_w = (LAS float*)(F.lds + 65536 + 1024);
    LAS int* wcnt = (LAS int*)(F.lds + 65536 + 2048);
    LAS int* ebase = wcnt + 64;
    __syncthreads();
    for (int t = F.tid; t < 4096; t += NTHR) { const int i = t >> 2, e4 = t & 3; const f32x4 w = *(const f32x4*)(rw + (size_t)i * 16 + 4 * e4);
        const int p = (i & 512) + 256 * ((i >> 2) & 1) + 4 * ((i >> 3) & 63) + (i & 3);
        rwt[(4 * e4 + 0) * 1024 + p] = w.x; rwt[(4 * e4 + 1) * 1024 + p] = w.y; rwt[(4 * e4 + 2) * 1024 + p] = w.z; rwt[(4 * e4 + 3) * 1024 + p] = w.w; }
    __syncthreads();
    for (int rb0 = F.wg; rb0 < T / 128; rb0 += F.G) {
        const int b = (rb0 * 128) >> 13;
        f32x4 gm[4], sh[4];
        { const float* m = mod + (size_t)b * 6144; const float* g = F.in[I_NFG] + layer * D;
#pragma unroll
          for (int jj = 0; jj < 4; ++jj) { const int o = ROFF(F.lane, jj); gm[jj] = *(const f32x4*)(g + o) * (1.f + *(const f32x4*)(m + 4096 + o)); sh[jj] = *(const f32x4*)(m + 3072 + o); } }
        const int rbase = rb0 * 128 + F.wave * 16;
        f32x4 v0[4], v1[4]; xrow_load(X, XB, (size_t)rbase, F.lane, v0); xrow_load(X, XB, (size_t)(rbase + 1), F.lane, v1);
#pragma unroll 1
        for (int j = 0; j < 16; j += 2) {
            const int lr = F.wave * 16 + j, row = rbase + j;
            f32x4 n0[4], n1[4];
            { const int nr = (j + 2 < 16) ? row + 2 : row; xrow_load(X, XB, (size_t)nr, F.lane, n0); xrow_load(X, XB, (size_t)(nr + 1), F.lane, n1); }
            const float rstd0 = rsqrtf(row_sumsq(v0) * (1.f / D) + EPS), rstd1 = rsqrtf(row_sumsq(v1) * (1.f / D) + EPS);
#pragma unroll
            for (int jj = 0; jj < 4; ++jj) { v0[jj] = v0[jj] * rstd0 * gm[jj] + sh[jj]; v1[jj] = v1[jj] * rstd1 * gm[jj] + sh[jj]; }
            row_store_bf16(HB + (size_t)row * D, v0, F.lane); row_store_bf16(HB + (size_t)(row + 1) * D, v1, F.lane);
            float lg0[16], lg1[16];
#pragma unroll
            for (int e = 0; e < 16; ++e) { float a0 = 0.f, a1 = 0.f;
#pragma unroll
                for (int jj = 0; jj < 4; ++jj) { const f32x4 w4 = *(const LAS f32x4*)(rwt + e * 1024 + 256 * jj + 4 * F.lane);
                    a0 += (v0[jj].x * w4.x + v0[jj].y * w4.y) + (v0[jj].z * w4.z + v0[jj].w * w4.w); a1 += (v1[jj].x * w4.x + v1[jj].y * w4.y) + (v1[jj].z * w4.z + v1[jj].w * w4.w); }
                lg0[e] = a0; lg1[e] = a1; }
#pragma unroll
            for (int e = 0; e < 16; ++e) { lg0[e] = wave_sum(lg0[e]); lg1[e] = wave_sum(lg1[e]); }
            int e1, e2; float w1, w2;
            route_select(lg0, rb, e1, e2, w1, w2);
            if (F.lane == 0) { sel_e[2 * lr] = e1; sel_e[2 * lr + 1] = e2; sel_w[2 * lr] = w1; sel_w[2 * lr + 1] = w2; }
            route_select(lg1, rb, e1, e2, w1, w2);
            if (F.lane == 0) { sel_e[2 * lr + 2] = e1; sel_e[2 * lr + 3] = e2; sel_w[2 * lr + 2] = w1; sel_w[2 * lr + 3] = w2; }
#pragma unroll
            for (int jj = 0; jj < 4; ++jj) { v0[jj] = n0[jj]; v1[jj] = n1[jj]; }
        }
        __syncthreads();
        int my_e = 0, my_rank = 0; float my_w = 0.f;
        if (F.tid < 256) { my_e = sel_e[F.tid]; my_w = sel_w[F.tid];
            const unsigned long long below = (1ull << F.lane) - 1ull;
#pragma unroll 1
            for (int ee = 0; ee < 16; ++ee) { const unsigned long long mk = __ballot(my_e == ee);
                if (my_e == ee) my_rank = __popcll(mk & below);
                if (F.lane == 0) wcnt[F.wave * 16 + ee] = __popcll(mk); } }
        __syncthreads();
        if (F.tid < 16) { const int n = wcnt[F.tid] + wcnt[16 + F.tid] + wcnt[32 + F.tid] + wcnt[48 + F.tid];
            ebase[F.tid] = n ? (int)atomicAdd(cnt + F.tid * 64, (unsigned)n) : 0; }
        __syncthreads();
        if (F.tid < 256) { int pos = ebase[my_e] + my_rank;
            for (int w = 0; w < F.wave; ++w) pos += wcnt[w * 16 + my_e];
            const int tok = rb0 * 128 + (F.tid >> 1), k = F.tid & 1;
            slot_t[my_e * CAP + pos] = tok; slot_w[my_e * CAP + pos] = my_w; tok_e[2 * tok + k] = my_e; tok_p[2 * tok + k] = pos; tok_w[2 * tok + k] = my_w; }
        __syncthreads();
    }
}


__device__ __forceinline__ void phase_norm2_route_mfma(Frame& F, int layer) {
    constexpr int AP = 1032;
    const float* mod = (const float*)(F.ws + WS_MOD) + (size_t)layer * 5 * 6144;
    const bf16* XB = (const bf16*)(F.ws + WS_XB); bf16* HB = (bf16*)(F.ws + WS_HB);
    const float* rw = F.in[I_RW]; const float* rb = F.in[I_RB]; const float* gsrc = F.in[I_NFG] + layer * D;
    int* tok_e = (int*)(F.ws + WS_TOKE); int* tok_p = (int*)(F.ws + WS_TOKP); float* tok_w = (float*)(F.ws + WS_TOKW);
    int* slot_t = (int*)(F.ws + WS_SLOTT) + layer * 16 * CAP;
    float* slot_w = (float*)(F.ws + WS_SLOTW) + layer * 16 * CAP;
    unsigned* cnt = F.ctl + CW_CNT + layer * 16 * 64;
    LAS bf16* AH = (LAS bf16*)F.lds; LAS bf16* AL = AH + 16 * AP;
    LAS float* cbv = (LAS float*)(F.lds + 2 * 16 * AP * 2);
    LAS float* rstdv = cbv + 16;
    LAS float* lgt = rstdv + 128;
    LAS int* sel_e = (LAS int*)(lgt + 128 * 16);
    LAS float* sel_w = (LAS float*)(sel_e + 256);
    LAS int* wcnt = (LAS int*)(sel_w + 256);
    LAS int* ebase = wcnt + 64;
    LAS float* cpart = (LAS float*)(ebase + 16);
    for (int rb0 = F.wg; rb0 < T / 128; rb0 += F.G) {
        const int b = (rb0 * 128) >> 13; const float* m = mod + (size_t)b * 6144;
        __syncthreads();
        { float cp[16];
#pragma unroll
          for (int e = 0; e < 16; ++e) cp[e] = 0.f;
          for (int k = F.tid; k < D; k += NTHR) { const float gmk = gsrc[k] * (1.f + m[4096 + k]), shk = m[3072 + k];
#pragma unroll
              for (int e4 = 0; e4 < 4; ++e4) { const f32x4 w4 = *(const f32x4*)(rw + (size_t)k * 16 + 4 * e4);
#pragma unroll
                  for (int q = 0; q < 4; ++q) { const int e = 4 * e4 + q; const float pr = gmk * w4[q]; const unsigned hi = f2bf(pr); const unsigned lo = f2bf(pr - bf2f(hi));
                      AH[e * AP + k] = (bf16)hi; AL[e * AP + k] = (bf16)lo; cp[e] += shk * w4[q]; } } }
#pragma unroll
          for (int e = 0; e < 16; ++e) { const float t = wave_sum(cp[e]); if (F.lane == 0) cpart[F.wave * 16 + e] = t; } }
        __syncthreads();
        if (F.tid < 16) { float t = 0.f;
#pragma unroll
            for (int w = 0; w < 8; ++w) t += cpart[w * 16 + F.tid];
            cbv[F.tid] = t; }
        f32x4 gm[4], sh[4];
#pragma unroll
        for (int jj = 0; jj < 4; ++jj) { const int o = ROFF(F.lane, jj); gm[jj] = *(const f32x4*)(gsrc + o) * (1.f + *(const f32x4*)(m + 4096 + o)); sh[jj] = *(const f32x4*)(m + 3072 + o); }
        const int rbase = rb0 * 128 + F.wave * 16;
        f32x4 v0[4], v1[4]; row_load_bf(XB + (size_t)rbase * D, F.lane, v0); row_load_bf(XB + (size_t)(rbase + 1) * D, F.lane, v1);
#pragma unroll 1
        for (int j = 0; j < 16; j += 2) {
            const int lr = F.wave * 16 + j, row = rbase + j;
            f32x4 n0[4], n1[4];
            { const int nr = (j + 2 < 16) ? row + 2 : row; row_load_bf(XB + (size_t)nr * D, F.lane, n0); row_load_bf(XB + (size_t)(nr + 1) * D, F.lane, n1); }
            const float rstd0 = rsqrtf(row_sumsq(v0) * (1.f / D) + EPS), rstd1 = rsqrtf(row_sumsq(v1) * (1.f / D) + EPS);
#pragma unroll
            for (int jj = 0; jj < 4; ++jj) { v0[jj] = v0[jj] * rstd0 * gm[jj] + sh[jj]; v1[jj] = v1[jj] * rstd1 * gm[jj] + sh[jj]; }
            row_store_bf16(HB + (size_t)row * D, v0, F.lane); row_store_bf16(HB + (size_t)(row + 1) * D, v1, F.lane);
            if (F.lane == 0) { rstdv[lr] = rstd0; rstdv[lr + 1] = rstd1; }
#pragma unroll
            for (int jj = 0; jj < 4; ++jj) { v0[jj] = n0[jj]; v1[jj] = n1[jj]; }
        }
        __syncthreads();
        { const int fr = F.lane & 15, fq = F.lane >> 4;
          f32x4 acc = {0.f, 0.f, 0.f, 0.f};
          const bf16* xr = XB + (size_t)(rb0 * 128 + 16 * F.wave + fr) * D + 8 * fq;
          const LAS bf16* ah = AH + fr * AP + 8 * fq; const LAS bf16* al = AL + fr * AP + 8 * fq;
#pragma unroll 8
          for (int s2 = 0; s2 < 32; ++s2) { const bf16x8 xb = *(const bf16x8*)(xr + 32 * s2);
              acc = __builtin_amdgcn_mfma_f32_16x16x32_bf16(*(const LAS bf16x8*)(ah + 32 * s2), xb, acc, 0, 0, 0);
              acc = __builtin_amdgcn_mfma_f32_16x16x32_bf16(*(const LAS bf16x8*)(al + 32 * s2), xb, acc, 0, 0, 0); }
          const int lrow = 16 * F.wave + fr; const float rs = rstdv[lrow];
#pragma unroll
          for (int i = 0; i < 4; ++i) lgt[lrow * 16 + 4 * fq + i] = rs * acc[i] + cbv[4 * fq + i]; }
        __syncthreads();
        if (F.tid < 128) { float lg[16];
#pragma unroll
            for (int e4 = 0; e4 < 4; ++e4) { const f32x4 t = *(const LAS f32x4*)(lgt + F.tid * 16 + 4 * e4); lg[4 * e4] = t.x; lg[4 * e4 + 1] = t.y; lg[4 * e4 + 2] = t.z; lg[4 * e4 + 3] = t.w; }
            int e1, e2; float w1, w2; route_select(lg, rb, e1, e2, w1, w2);
            sel_e[2 * F.tid] = e1; sel_e[2 * F.tid + 1] = e2; sel_w[2 * F.tid] = w1; sel_w[2 * F.tid + 1] = w2; }
        __syncthreads();
        int my_e = 0, my_rank = 0; float my_w = 0.f;
        if (F.tid < 256) { my_e = sel_e[F.tid]; my_w = sel_w[F.tid];
            const unsigned long long below = (1ull << F.lane) - 1ull;
#pragma unroll 1
            for (int ee = 0; ee < 16; ++ee) { const unsigned long long mk = __ballot(my_e == ee);
                if (my_e == ee) my_rank = __popcll(mk & below);
                if (F.lane == 0) wcnt[F.wave * 16 + ee] = __popcll(mk); } }
        __syncthreads();
        if (F.tid < 16) { const int n = wcnt[F.tid] + wcnt[16 + F.tid] + wcnt[32 + F.tid] + wcnt[48 + F.tid];
            ebase[F.tid] = n ? (int)atomicAdd(cnt + F.tid * 64, (unsigned)n) : 0; }
        __syncthreads();
        if (F.tid < 256) { int pos = ebase[my_e] + my_rank;
            for (int w = 0; w < F.wave; ++w) pos += wcnt[w * 16 + my_e];
            const int tok = rb0 * 128 + (F.tid >> 1), k = F.tid & 1;
            slot_t[my_e * CAP + pos] = tok; slot_w[my_e * CAP + pos] = my_w; tok_e[2 * tok + k] = my_e; tok_p[2 * tok + k] = pos; tok_w[2 * tok + k] = my_w; }
    }
    __syncthreads();
}

constexpr int MOEMAP_OFF = LDS_BYTES - 256;
__device__ __forceinline__ LAS int* moe_map(Frame& F, int layer) {
    LAS int* mm = (LAS int*)(F.lds + MOEMAP_OFF);
    __syncthreads();
    if (F.tid < 64) { const unsigned* cnt = F.ctl + CW_CNT + layer * 16 * 64;
        const int n = (F.tid < 16) ? (int)__hip_atomic_load(cnt + F.tid * 64, __ATOMIC_RELAXED, __HIP_MEMORY_SCOPE_AGENT) : 0;
        const int pad = (n + 255) & ~255; int x = pad;
#pragma unroll
        for (int o = 1; o < 16; o <<= 1) { const int t = __shfl_up(x, o); if (F.lane >= o) x += t; }
        if (F.tid < 16) { mm[F.tid] = n; mm[16 + F.tid] = x - pad; } }
    __syncthreads();
    return mm;
}
struct RowGather { const bf16* base; const int* list; int n; __device__ __forceinline__ const bf16* operator()(int m) const { const int tok = m < n ? list[m] : 0; return base + (size_t)tok * D; } };

__device__ __forceinline__ void phase_moe_gateup(Frame& F, int layer) {
    LAS int* mm = moe_map(F, layer);
    const bf16* HB = (const bf16*)(F.ws + WS_HB); bf16* HID = (bf16*)(F.ws + WS_HID);
    const int* slot_t = (const int*)(F.ws + WS_SLOTT) + layer * 16 * CAP; const float* slot_w = (const float*)(F.ws + WS_SLOTW) + layer * 16 * CAP;
    int ubase = 0;
#pragma unroll 1
    for (int e = 0; e < 16; ++e) {
        const int n = mm[e], hbe = mm[16 + e], rt = (n + 127) >> 7, nu = rt * 8;
        const bf16* Wt = (const bf16*)(F.ws + WS_WGU) + (size_t)(layer * 16 + e) * 1024 * 1024;
        RowGather rp{HB, slot_t + e * CAP, n};
        int first = (F.wg - ubase % F.G + F.G) % F.G;
        for (int u = first; u < nu; u += F.G) {
            const int mt = u / 8, nt = u % 8;
            auto epi = [&](int mb, int nb, const f32x16& c0, const f32x16& c1, int lane) {
                const int h = lane >> 5, cl = lane & 31; const int col = (nb >> 1) + cl;
#pragma unroll
                for (int i = 0; i < 16; ++i) { const int r = mb + crow(i, h);
                    if (r < n) { const float w = slot_w[e * CAP + r]; HID[(size_t)(hbe + r) * FF + col] = (bf16)f2bf(w * silu_f(c0[i]) * c1[i]); } }
            };
            sgemm_tile(rp, Wt, D, mt * 128, nt * 128, epi, F.wave, F.lane);
        }
        ubase += nu;
    }
}
__device__ __forceinline__ void phase_moe_down(Frame& F, int layer) {
    LAS int* mm = moe_map(F, layer);
    const bf16* HID = (const bf16*)(F.ws + WS_HID); bf16* Y = (bf16*)(F.ws + WS_Y);
    int ubase = 0;
#pragma unroll 1
    for (int e = 0; e < 16; ++e) {
        const int n = mm[e], hbe = mm[16 + e], rt = (n + 127) >> 7, nu = rt * 8;
        const bf16* Wt = (const bf16*)(F.ws + WS_WDN) + (size_t)(layer * 16 + e) * 1024 * 512;
        RowLin rp{HID + (size_t)hbe * FF, (size_t)FF};
        int first = (F.wg - ubase % F.G + F.G) % F.G;
        for (int u = first; u < nu; u += F.G) {
            const int mt = u / 8, nt = u % 8;
            auto epi = [&](int mb, int nb, const f32x16& c0, const f32x16& c1, int lane) {
                const int h = lane >> 5, cl = lane & 31;
#pragma unroll
                for (int i = 0; i < 16; ++i) { const int r = mb + crow(i, h);
                    if (r < n) { bf16* yr = Y + (size_t)(hbe + r) * D + nb + cl; yr[0] = (bf16)f2bf(c0[i]); yr[32] = (bf16)f2bf(c1[i]); } }
            };
            sgemm_tile(rp, Wt, FF, mt * 128, nt * 128, epi, F.wave, F.lane);
        }
        ubase += nu;
    }
}

template <bool FINAL>
__device__ __forceinline__ void phase_combine(Frame& F, int layer) {
    LAS int* hbs = moe_map(F, layer) + 16;
    const int gw = F.wg * NWAVES + F.wave, NGW = F.G * NWAVES;
    const float* mod = (const float*)(F.ws + WS_MOD);
    const int* tok_e = (const int*)(F.ws + WS_TOKE); const int* tok_p = (const int*)(F.ws + WS_TOKP);
    const unsigned char* Y8 = (const unsigned char*)(F.ws + WS_Y);
    float* X = F.out; bf16* XB = (bf16*)(F.ws + WS_XB); bf16* HB = (bf16*)(F.ws + WS_HB);
    for (int blk = gw; blk < T / 16; blk += NGW) {
        const int rbase = blk * 16, b = rbase >> 13;
        f32x4 g2v[4], gm[4], shv[4];
        { const float* g2 = mod + ((size_t)layer * 5 + b) * 6144 + 5120;
#pragma unroll
          for (int j = 0; j < 4; ++j) { const int o = ROFF(F.lane, j); g2v[j] = *(const f32x4*)(g2 + o) * (1.f / YSCALE);
              if (FINAL) { gm[j] = *(const f32x4*)(F.in[I_FNG] + o); shv[j] = (f32x4){0.f, 0.f, 0.f, 0.f}; }
              else { const float* m = mod + ((size_t)(layer + 1) * 5 + b) * 6144; gm[j] = *(const f32x4*)(F.in[I_NMG] + (layer + 1) * D + o) * (1.f + *(const f32x4*)(m + 1024 + o)); shv[j] = *(const f32x4*)(m + o); } } }
        int4 te = *(const int4*)(tok_e + 2 * rbase), tp = *(const int4*)(tok_p + 2 * rbase);
        u32x4 xa[2][2], xn[2][2]; u32x2 ya[2][2][2], yn[2][2][2];
        { const int s00 = hbs[te.x] + tp.x, s01 = hbs[te.y] + tp.y, s10 = hbs[te.z] + tp.z, s11 = hbs[te.w] + tp.w;
#pragma unroll
          for (int jj = 0; jj < 2; ++jj) { const int o = 512 * jj + 8 * F.lane;
              xa[0][jj] = *(const u32x4*)(XB + (size_t)rbase * D + o); xa[1][jj] = *(const u32x4*)(XB + (size_t)(rbase + 1) * D + o);
              ya[0][0][jj] = *(const u32x2*)(Y8 + (size_t)s00 * D + o); ya[0][1][jj] = *(const u32x2*)(Y8 + (size_t)s01 * D + o);
              ya[1][0][jj] = *(const u32x2*)(Y8 + (size_t)s10 * D + o); ya[1][1][jj] = *(const u32x2*)(Y8 + (size_t)s11 * D + o); } }
        te = *(const int4*)(tok_e + 2 * (rbase + 2)); tp = *(const int4*)(tok_p + 2 * (rbase + 2));
#pragma unroll 1
        for (int jr = 0; jr < 16; jr += 2) {
            const int row = rbase + jr;
            if (jr + 2 < 16) { const int nr = row + 2;
                const int s00 = hbs[te.x] + tp.x, s01 = hbs[te.y] + tp.y, s10 = hbs[te.z] + tp.z, s11 = hbs[te.w] + tp.w;
#pragma unroll
                for (int jj = 0; jj < 2; ++jj) { const int o = 512 * jj + 8 * F.lane;
                    xn[0][jj] = *(const u32x4*)(XB + (size_t)nr * D + o); xn[1][jj] = *(const u32x4*)(XB + (size_t)(nr + 1) * D + o);
                    yn[0][0][jj] = *(const u32x2*)(Y8 + (size_t)s00 * D + o); yn[0][1][jj] = *(const u32x2*)(Y8 + (size_t)s01 * D + o);
                    yn[1][0][jj] = *(const u32x2*)(Y8 + (size_t)s10 * D + o); yn[1][1][jj] = *(const u32x2*)(Y8 + (size_t)s11 * D + o); }
                const int n2 = (jr + 4 < 16) ? row + 4 : row; te = *(const int4*)(tok_e + 2 * n2); tp = *(const int4*)(tok_p + 2 * n2); }
            f32x4 v[2][4];
#pragma unroll
            for (int q = 0; q < 2; ++q)
#pragma unroll
                for (int jj = 0; jj < 2; ++jj) { const u32x4 xw = xa[q][jj]; const u32x2 a0 = ya[q][0][jj], a1 = ya[q][1][jj];
                    v[q][2 * jj] = (f32x4){bflo(xw.x), bfhi(xw.x), bflo(xw.y), bfhi(xw.y)} + g2v[2 * jj] * (un_fp8x4(a0.x) + un_fp8x4(a1.x));
                    v[q][2 * jj + 1] = (f32x4){bflo(xw.z), bfhi(xw.z), bflo(xw.w), bfhi(xw.w)} + g2v[2 * jj + 1] * (un_fp8x4(a0.y) + un_fp8x4(a1.y)); }
            const float rstd0 = rsqrtf(row_sumsq(v[0]) * (1.f / D) + EPS), rstd1 = rsqrtf(row_sumsq(v[1]) * (1.f / D) + EPS);
#pragma unroll
            for (int q = 0; q < 2; ++q) { const float rstd = q ? rstd1 : rstd0; const size_t ro = (size_t)(row + q) * D;
                if (FINAL) {
#pragma unroll
                    for (int j = 0; j < 4; ++j) *(f32x4*)(X + ro + ROFF(F.lane, j)) = v[q][j] * rstd * gm[j];
                } else {
                    row_store_bf16(XB + ro, v[q], F.lane);
#pragma unroll
                    for (int j = 0; j < 4; ++j) v[q][j] = v[q][j] * rstd * gm[j] + shv[j];
                    row_store_bf16(HB + ro, v[q], F.lane);
                }
            }
#pragma unroll
            for (int q = 0; q < 2; ++q)
#pragma unroll
                for (int jj = 0; jj < 2; ++jj) { xa[q][jj] = xn[q][jj]; ya[q][0][jj] = yn[q][0][jj]; ya[q][1][jj] = yn[q][1][jj]; }
        }
    }
    __syncthreads();
}

__device__ __forceinline__ void phase_pw1(Frame& F) {
    const bf16* HB = (const bf16*)(F.ws + WS_HB); const bf16* Wt = (const bf16*)(F.ws + WS_WPW1); bf16* U = (bf16*)(F.ws + WS_U);
    const float* bias = F.in[I_PW1B];
    RowLin rp{HB, (size_t)D};
    for (int u = F.wg; u < (T / 128) * 16; u += F.G) {
        const int mt = u / 16, nt = u % 16;
        auto epi = [&](int mb, int nb, const f32x16& c0, const f32x16& c1, int lane) {
            const int h = lane >> 5, cl = lane & 31, col = (nb >> 1) + cl; const float ba = bias[col], bg = bias[1024 + col];
#pragma unroll
            for (int i = 0; i < 16; ++i) U[(size_t)(mb + crow(i, h)) * D + col] = (bf16)f2bf((c0[i] + ba) * sigmoid_f(c1[i] + bg));
        };
        sgemm_tile(rp, Wt, D, mt * 128, nt * 128, epi, F.wave, F.lane);
    }
}
__device__ __forceinline__ void phase_dwconv(Frame& F) {
    const bf16* U = (const bf16*)(F.ws + WS_U); bf16* V1 = (bf16*)(F.ws + WS_V1);
    const float* dww = F.in[I_DWW]; const float* dwb = F.in[I_DWB]; const float* lng = F.in[I_LNG]; const float* lnb = F.in[I_LNB];
    const int gw = F.wg * NWAVES + F.wave, NGW = F.G * NWAVES;
    for (int row = gw; row < T; row += NGW) {
        const int l = row & (L - 1);
        f32x4 acc[4];
#pragma unroll
        for (int j = 0; j < 4; ++j) acc[j] = *(const f32x4*)(dwb + 4 * F.lane + 256 * j);
        for (int tp = 0; tp < CONVW; ++tp) { const int ll = l + tp - 15; if (ll < 0 || ll >= L) continue;
            const bf16* ur = U + (size_t)(row + tp - 15) * D; const float* wr = dww + (size_t)tp * D;
#pragma unroll
            for (int j = 0; j < 4; ++j) { const int o = 4 * F.lane + 256 * j; const u32x2 uu = *(const u32x2*)(ur + o); const f32x4 ww = *(const f32x4*)(wr + o);
                acc[j].x += bflo(uu.x) * ww.x; acc[j].y += bfhi(uu.x) * ww.y; acc[j].z += bflo(uu.y) * ww.z; acc[j].w += bfhi(uu.y) * ww.w; } }
        float s = 0.f;
#pragma unroll
        for (int j = 0; j < 4; ++j) s += (acc[j].x + acc[j].y) + (acc[j].z + acc[j].w);
        const float mean = wave_sum(s) * (1.f / D); float q = 0.f;
#pragma unroll
        for (int j = 0; j < 4; ++j) { acc[j] = acc[j] - mean; q += (acc[j].x * acc[j].x + acc[j].y * acc[j].y) + (acc[j].z * acc[j].z + acc[j].w * acc[j].w); }
        const float rstd = rsqrtf(wave_sum(q) * (1.f / D) + EPS);
#pragma unroll
        for (int j = 0; j < 4; ++j) { const int o = 4 * F.lane + 256 * j; const f32x4 gg = *(const f32x4*)(lng + o), bb = *(const f32x4*)(lnb + o);
            f32x4 y = acc[j] * rstd * gg + bb; y.x = silu_f(y.x); y.y = silu_f(y.y); y.z = silu_f(y.z); y.w = silu_f(y.w); acc[j] = y; }
        row_store_bf16(V1 + (size_t)row * D, acc, F.lane);
    }
}


namespace pg {
constexpr int BM = 256, BK = 64, HALF = 128, HTB = HALF * BK * 2, STAGE_BYTES = 8 * HTB;
constexpr int TAB_OFF = STAGE_BYTES;
__device__ __forceinline__ int lds_byte(int r, int c) { const int st = (r >> 4) * 2 + (c >> 5), rr = r & 15, cc = c & 31, ob = rr * 64 + cc * 2; return st * 1024 + (ob ^ (((ob >> 9) & 1) << 5)); }
__device__ __forceinline__ void stage_rc(int b, int& R, int& C) { const int st = b / 1024, sb = b % 1024, swz = sb ^ (((sb >> 9) & 1) << 5); R = (st >> 1) * 16 + swz / 64; C = (st & 1) * 32 + (swz % 64) / 2; }
__device__ __forceinline__ int perm32(int rho) { const int n = rho >> 4, i = rho & 15; return 8 * (i >> 2) + 4 * n + (i & 3); }
__device__ __forceinline__ unsigned cvt_pk_bf16(float lo, float hi) { unsigned r; asm volatile("v_cvt_pk_bf16_f32 %0, %1, %2" : "=v"(r) : "v"(lo), "v"(hi)); return r; }

struct GU { const char* B; int p0, p1, p2, p3; };

template <class Epi, class Sched>
__device__ __forceinline__ void gemm_phase(LAS unsigned char* lds, const char* Abase, const int K, const Sched& S, const Epi& E) {
    const int tid = threadIdx.x, wid = __builtin_amdgcn_readfirstlane(tid >> 6), lane = tid & 63, wr = wid >> 2, wc = wid & 3, fr = lane & 15, fq = lane >> 4;
    const int nt = K / BK;
    int sR[2], sC[2]; unsigned voffB[2];
#pragma unroll
    for (int i = 0; i < 2; ++i) { int R, C; stage_rc(tid * 16 + i * 8192, R, C); sR[i] = R; sC[i] = C; const int Rb = Epi::PERM ? ((R & ~31) + perm32(R & 31)) : R; voffB[i] = (unsigned)(Rb * K + C) * 2u; }
    const size_t kstep = (size_t)(BK * 2);
    const size_t hstep = (size_t)HALF * K * 2;
    const unsigned ldsw = (unsigned)wid * 1024u;
    const int aoff = lds_byte(wr * 64 + fr, fq * 8), boff = lds_byte(wc * 32 + fr, fq * 8);
#define PG_SA(b, h) (((b) * 2 + (h)) * HTB)
#define PG_SB(b, h) ((4 + (b) * 2 + (h)) * HTB)
#define PG_STAGE(bufoff, gbase, voff) do { _Pragma("unroll") for (int _i = 0; _i < 2; ++_i) \
        __builtin_amdgcn_global_load_lds((const unsigned*)((const char*)(gbase) + (voff)[_i]), (LAS unsigned*)(lds + (bufoff) + ldsw + _i * 8192), 16, 0, 0); } while (0)
#define PG_LDA(dst, b, h) do { _Pragma("unroll") for (int m = 0; m < 4; ++m) _Pragma("unroll") for (int k = 0; k < 2; ++k) dst[m][k] = *(const LAS bf16x8*)(lds + PG_SA(b, h) + aoff + m * 2048 + k * 1024); } while (0)
#define PG_LDB(dst, b, h) do { _Pragma("unroll") for (int n = 0; n < 2; ++n) _Pragma("unroll") for (int k = 0; k < 2; ++k) dst[n][k] = *(const LAS bf16x8*)(lds + PG_SB(b, h) + boff + n * 2048 + k * 1024); } while (0)
#define PG_MMA(ai, bj, At, Bt) do { __builtin_amdgcn_s_setprio(1); _Pragma("unroll") for (int m = 0; m < 4; ++m) _Pragma("unroll") for (int n = 0; n < 2; ++n) _Pragma("unroll") for (int k = 0; k < 2; ++k) \
        acc[ai][bj][m][n] = __builtin_amdgcn_mfma_f32_16x16x32_bf16(Bt[n][k], At[m][k], acc[ai][bj][m][n], 0, 0, 0); __builtin_amdgcn_s_setprio(0); } while (0)
#define PG_WAIT_V(n) asm volatile("s_waitcnt vmcnt(" #n ")" ::: "memory")
#define PG_WAIT_L(n) asm volatile("s_waitcnt lgkmcnt(" #n ")" ::: "memory")
#define PG_BAR __builtin_amdgcn_s_barrier()
#define PG_SCHED __builtin_amdgcn_sched_barrier(0)
    GU cur, nxt; int ui = 0;
    if (!S.next(0, cur)) return;
    f32x4 acc[2][2][4][2];
#pragma unroll
    for (int a = 0; a < 2; ++a)
#pragma unroll
        for (int b = 0; b < 2; ++b)
#pragma unroll
            for (int m = 0; m < 4; ++m)
#pragma unroll
                for (int n = 0; n < 2; ++n) acc[a][b][m][n] = (f32x4){0.f, 0.f, 0.f, 0.f};
    bf16x8 At[4][2], B0[2][2], B1[2][2];
    if constexpr (Sched::GATHER) { S.stage_table(cur, 0, lds, wid, lane); PG_WAIT_V(0); PG_BAR; }
    unsigned voC[2][2], voN[2][2];
#pragma unroll
    for (int h = 0; h < 2; ++h)
#pragma unroll
        for (int i = 0; i < 2; ++i) { voC[h][i] = S.voff(cur, 0, lds, h * HALF + sR[i], sC[i]); voN[h][i] = voC[h][i]; }
    const char* cB = cur.B;
    PG_STAGE(PG_SB(0, 0), cB, voffB); PG_STAGE(PG_SB(0, 1), cB + hstep, voffB); PG_STAGE(PG_SA(0, 0), Abase, voC[0]); PG_STAGE(PG_SA(0, 1), Abase, voC[1]);
    if (wr == 1) PG_BAR;
    PG_WAIT_V(2); PG_BAR;
    PG_STAGE(PG_SB(1, 0), cB + kstep, voffB); PG_STAGE(PG_SA(1, 0), Abase + kstep, voC[0]); PG_STAGE(PG_SB(1, 1), cB + hstep + kstep, voffB);
    PG_WAIT_V(6); PG_BAR;
    for (;;) {
        const bool has_next = S.next(ui + 1, nxt);
        if constexpr (Sched::GATHER) { if (has_next) S.stage_table(nxt, (ui + 1) & 1, lds, wid, lane); }
        const char* nB = has_next ? nxt.B : cB;
        for (int t = 0; t < nt; t += 2) {
            const bool last = (t == nt - 2);
            if (last && has_next) {
#pragma unroll
                for (int h = 0; h < 2; ++h)
#pragma unroll
                    for (int i = 0; i < 2; ++i) voN[h][i] = S.voff(nxt, (ui + 1) & 1, lds, h * HALF + sR[i], sC[i]);
            }
            unsigned vo2[2][2];
#pragma unroll
            for (int h = 0; h < 2; ++h)
#pragma unroll
                for (int i = 0; i < 2; ++i) vo2[h][i] = last ? voN[h][i] : voC[h][i];
            const char* a1 = Abase + (size_t)(t + 1) * kstep;
            const char* a2 = last ? Abase : Abase + (size_t)(t + 2) * kstep; const char* b2 = last ? nB : cB + (size_t)(t + 2) * kstep;
            const char* a3 = a2 + kstep; const char* b3 = b2 + kstep;
            PG_LDB(B0, 0, 0); PG_LDB(B1, 0, 1); PG_SCHED; PG_LDA(At, 0, 0); PG_STAGE(PG_SA(1, 1), a1, voC[1]);
            PG_WAIT_V(8); PG_WAIT_L(0); PG_BAR; PG_MMA(0, 0, At, B0); PG_MMA(0, 1, At, B1); PG_BAR; PG_SCHED;
            PG_LDA(At, 0, 1); PG_STAGE(PG_SB(0, 0), b2, voffB); PG_STAGE(PG_SB(0, 1), b2 + hstep, voffB); PG_STAGE(PG_SA(0, 0), a2, vo2[0]);
            PG_WAIT_V(8); PG_WAIT_L(0); PG_BAR; PG_MMA(1, 0, At, B0); PG_MMA(1, 1, At, B1); PG_BAR; PG_SCHED;
            PG_LDB(B0, 1, 0); PG_LDB(B1, 1, 1); PG_SCHED; PG_LDA(At, 1, 0); PG_STAGE(PG_SA(0, 1), a2, vo2[1]);
            PG_WAIT_V(8); PG_WAIT_L(0); PG_BAR; PG_MMA(0, 0, At, B0); PG_MMA(0, 1, At, B1); PG_BAR; PG_SCHED;
            PG_LDA(At, 1, 1); PG_STAGE(PG_SB(1, 0), b3, voffB); PG_STAGE(PG_SB(1, 1), b3 + hstep, voffB); PG_STAGE(PG_SA(1, 0), a3, vo2[0]);
            PG_WAIT_V(8); PG_WAIT_L(0); PG_BAR; PG_MMA(1, 0, At, B0); PG_MMA(1, 1, At, B1); PG_BAR; PG_SCHED;
        }
        if (wr == 0) PG_BAR;
        E(acc, cur, wr, wc, fr, fq);
        if (!has_next) break;
#pragma unroll
        for (int a = 0; a < 2; ++a)
#pragma unroll
            for (int b = 0; b < 2; ++b)
#pragma unroll
                for (int m = 0; m < 4; ++m)
#pragma unroll
                    for (int n = 0; n < 2; ++n) acc[a][b][m][n] = (f32x4){0.f, 0.f, 0.f, 0.f};
        cur = nxt; cB = nB; ++ui;
#pragma unroll
        for (int h = 0; h < 2; ++h)
#pragma unroll
            for (int i = 0; i < 2; ++i) voC[h][i] = voN[h][i];
        if (wr == 1) PG_BAR;
    }
    PG_WAIT_V(0);
    PG_BAR;
#undef PG_SA
#undef PG_SB
#undef PG_STAGE
#undef PG_LDA
#undef PG_LDB
#undef PG_MMA
#undef PG_WAIT_V
#undef PG_WAIT_L
#undef PG_BAR
#undef PG_SCHED
}

__device__ __forceinline__ void static_tile(int L, int nM, int nN, int& pm, int& pn) {
    const int nwg = nM * nN; int wgid = L; { const int q = nwg / 8, r = nwg % 8, xcd = wgid % 8, off = wgid / 8; wgid = (xcd < r ? xcd * (q + 1) : r * (q + 1) + (xcd - r) * q) + off; }
    const int nig = 8 * nN, gid = wgid / nig, fm = gid * 8, gsz = (nM - fm) < 8 ? (nM - fm) : 8;
    pm = fm + ((wgid % nig) % gsz); pn = (wgid % nig) / gsz;
}
struct DenseSched {
    static constexpr bool GATHER = false;
    const char* Bt; int K, nM, nN, G, c, xn, xm0, xpn;
    __device__ __forceinline__ bool next(int i, GU& u) const {
        const int L = i * G + c, nmain = nM * nN; int pm, pn;
        if (L < nmain) static_tile(L, nM, nN, pm, pn); else if (L < nmain + xn) { pm = xm0 + (L - nmain); pn = xpn; } else return false;
        u.B = Bt + (size_t)pn * BM * K * 2; u.p0 = pm; u.p1 = pn; u.p2 = 0; u.p3 = 0; return true;
    }
    __device__ __forceinline__ unsigned voff(const GU& u, int, LAS unsigned char*, int R, int C) const { return (unsigned)(((u.p0 * BM + R) * K + C) * 2); }
    __device__ __forceinline__ void stage_table(const GU&, int, LAS unsigned char*, int, int) const {}
};
template <bool GATHER_> struct MoeSched {
    static constexpr bool GATHER = GATHER_;
    const char* Wt; size_t wstride; int K; const int* list; LAS int* mm; int G, c;
    __device__ __forceinline__ bool next(int i, GU& u) const {
        int L = i * G + c;
        for (int e = 0; e < 16; ++e) { const int n = mm[e], nu = ((n + 255) >> 8) * 4;
            if (L < nu) { const int rt = L >> 2, pn = L & 3; u.B = Wt + (size_t)e * wstride + (size_t)pn * BM * K * 2; u.p0 = e; u.p1 = rt; u.p2 = pn; u.p3 = mm[16 + e]; return true; }
            L -= nu; }
        return false;
    }
    __device__ __forceinline__ unsigned voff(const GU& u, int buf, LAS unsigned char* lds, int R, int C) const {
        if constexpr (GATHER_) { const int tok = ((const LAS int*)(lds + TAB_OFF))[buf * 256 + R]; return (unsigned)((tok * K + C) * 2); }
        else return (unsigned)(((u.p3 + u.p1 * BM + R) * K + C) * 2);
    }
    __device__ __forceinline__ void stage_table(const GU& u, int buf, LAS unsigned char* lds, int wid, int lane) const {
        if constexpr (GATHER_) { const int r = (wid & 3) * 64 + lane;
            __builtin_amdgcn_global_load_lds((const unsigned*)(list + u.p0 * CAP + u.p1 * BM + r), (LAS unsigned*)(lds + TAB_OFF + buf * 1024 + (wid & 3) * 256), 4, 0, 0); }
    }
};

struct EpiInProj {
    static constexpr bool PERM = false;
    unsigned char* ws;
    __device__ __forceinline__ void operator()(const f32x4 (&acc)[2][2][4][2], const GU& u, int wr, int wc, int fr, int fq) const {
        const int pm = u.p0, pn = u.p1; const bool isctx = pm >= T / BM;
        float inv[4];
#pragma unroll
        for (int j = 0; j < 4; ++j) inv[j] = exp2f(-(float)(4 * fq + j) * (13.287712379549449f / 16.f));
#pragma unroll
        for (int bj = 0; bj < 2; ++bj) {
            const int cb = pn * BM + bj * HALF + wc * 32;
            bf16* dst; int pitch, cbase; bool rope = false;
            if (cb < 512) { dst = (bf16*)(ws + WS_UF); pitch = 512; cbase = 0; }
            else if (cb < 1024) { dst = (bf16*)(ws + WS_Q); pitch = 512; cbase = 512; rope = true; }
            else if (cb < 1152) { dst = isctx ? (bf16*)(ws + WS_CK) : (bf16*)(ws + WS_K); pitch = 128; cbase = 1024; rope = !isctx; }
            else { dst = isctx ? (bf16*)(ws + WS_CV) : (bf16*)(ws + WS_V); pitch = 128; cbase = 1152; }
            const bool bycol = ((cb >> 5) & 1) != 0;
#pragma unroll
            for (int ai = 0; ai < 2; ++ai)
#pragma unroll
                for (int m = 0; m < 4; ++m) {
                    const int row = pm * BM + ai * HALF + wr * 64 + m * 16 + fr;
                    f32x4 v0 = acc[ai][bj][m][0], v1 = acc[ai][bj][m][1];
                    if (rope) { const int l = row & (L - 1); const float pos = (float)(bycol ? (l & 63) : (l >> 6));
#pragma unroll
                        for (int j = 0; j < 4; ++j) { const float ang = pos * inv[j], cs = __cosf(ang), sn = __sinf(ang); const float x1 = v0[j], x2 = v1[j]; v0[j] = x1 * cs - x2 * sn; v1[j] = x1 * sn + x2 * cs; } }
                    const int orow = isctx ? row - T : row;
                    if (FAST_ATTN && cb >= 1152) {
                        const int kp = isctx ? CL : L, bb = isctx ? (orow >> 8) : (orow >> 13), key = isctx ? (orow & (CL - 1)) : (orow & (L - 1));
#pragma unroll
                        for (int n = 0; n < 2; ++n)
#pragma unroll
                            for (int j = 0; j < 4; ++j) { const int c = (cb - 1152) + 16 * n + 4 * fq + j;
                                dst[((size_t)bb * 128 + c) * kp + key] = (bf16)f2bf(n ? v1[j] : v0[j]); }
                        continue;
                    }
                    bf16* o = dst + (size_t)orow * pitch + (cb - cbase) + 4 * fq;
                    u32x2 w0, w1; w0.x = cvt_pk_bf16(v0[0], v0[1]); w0.y = cvt_pk_bf16(v0[2], v0[3]); w1.x = cvt_pk_bf16(v1[0], v1[1]); w1.y = cvt_pk_bf16(v1[2], v1[3]);
                    *(u32x2*)o = w0; *(u32x2*)(o + 16) = w1;
                }
        }
    }
};
struct EpiRes {
    static constexpr bool PERM = false;
    const float* base; float* X; const float* gate; const float* bias;
    __device__ __forceinline__ void operator()(const f32x4 (&acc)[2][2][4][2], const GU& u, int wr, int wc, int fr, int fq) const {
        const int row0 = u.p0 * BM + wr * 64 + fr, col0 = u.p1 * BM + wc * 32 + 4 * fq; const int b = (u.p0 * BM) >> 13;
        f32x4 gv[2][2], bv[2][2];
#pragma unroll
        for (int bj = 0; bj < 2; ++bj)
#pragma unroll
            for (int n = 0; n < 2; ++n) { gv[bj][n] = *(const f32x4*)(gate + (size_t)b * 6144 + col0 + bj * HALF + n * 16); bv[bj][n] = bias ? *(const f32x4*)(bias + col0 + bj * HALF + n * 16) : (f32x4){0.f, 0.f, 0.f, 0.f}; }
#pragma unroll
        for (int ai = 0; ai < 2; ++ai)
#pragma unroll
            for (int mp = 0; mp < 2; ++mp) {
                f32x4 bs[2][2][2];
#pragma unroll
                for (int mm = 0; mm < 2; ++mm) { const size_t off = (size_t)(row0 + ai * HALF + (2 * mp + mm) * 16) * D + col0;
#pragma unroll
                    for (int bj = 0; bj < 2; ++bj)
#pragma unroll
                        for (int n = 0; n < 2; ++n) bs[mm][bj][n] = *(const f32x4*)(base + off + bj * HALF + n * 16); }
#pragma unroll
                for (int mm = 0; mm < 2; ++mm) { const int m = 2 * mp + mm; const size_t off = (size_t)(row0 + ai * HALF + m * 16) * D + col0;
#pragma unroll
                    for (int bj = 0; bj < 2; ++bj)
#pragma unroll
                        for (int n = 0; n < 2; ++n) *(f32x4*)(X + off + bj * HALF + n * 16) = bs[mm][bj][n] + gv[bj][n] * (acc[ai][bj][m][n] + bv[bj][n]); }
                asm volatile("" ::: "memory"); }
    }
};
template <bool BASEBF> struct EpiResB {
    static constexpr bool PERM = false;
    const float* basef; bf16* XB; const float* gate; const float* bias;
    __device__ __forceinline__ void operator()(const f32x4 (&acc)[2][2][4][2], const GU& u, int wr, int wc, int fr, int fq) const {
        const int row0 = u.p0 * BM + wr * 64 + fr, col0 = u.p1 * BM + wc * 32 + 4 * fq; const int b = (u.p0 * BM) >> 13;
        f32x4 gv[2][2], bv[2][2];
#pragma unroll
        for (int bj = 0; bj < 2; ++bj)
#pragma unroll
            for (int n = 0; n < 2; ++n) { gv[bj][n] = *(const f32x4*)(gate + (size_t)b * 6144 + col0 + bj * HALF + n * 16); bv[bj][n] = bias ? *(const f32x4*)(bias + col0 + bj * HALF + n * 16) : (f32x4){0.f, 0.f, 0.f, 0.f}; }
        constexpr int NB2 = BASEBF ? 4 : 2;
#pragma unroll
        for (int ai = 0; ai < 2; ++ai)
#pragma unroll
            for (int mb = 0; mb < 4; mb += NB2) {
                f32x4 bf[BASEBF ? 1 : NB2][2][2]; u32x2 bw[BASEBF ? NB2 : 1][2][2];
#pragma unroll
                for (int mm = 0; mm < NB2; ++mm) { const size_t off = (size_t)(row0 + ai * HALF + (mb + mm) * 16) * D + col0;
#pragma unroll
                    for (int bj = 0; bj < 2; ++bj)
#pragma unroll
                        for (int n = 0; n < 2; ++n) { if (BASEBF) bw[mm][bj][n] = *(const u32x2*)(XB + off + bj * HALF + n * 16); else bf[mm][bj][n] = *(const f32x4*)(basef + off + bj * HALF + n * 16); } }
#pragma unroll
                for (int mm = 0; mm < NB2; ++mm) { const int m = mb + mm; const size_t off = (size_t)(row0 + ai * HALF + m * 16) * D + col0;
#pragma unroll
                    for (int bj = 0; bj < 2; ++bj)
#pragma unroll
                        for (int n = 0; n < 2; ++n) { f32x4 bsv;
                            if (BASEBF) { const u32x2 w = bw[mm][bj][n]; bsv = (f32x4){bflo(w.x), bfhi(w.x), bflo(w.y), bfhi(w.y)}; } else bsv = bf[mm][bj][n];
                            const f32x4 o = bsv + gv[bj][n] * (acc[ai][bj][m][n] + bv[bj][n]);
                            u32x2 w2; w2.x = cvt_pk_bf16(o[0], o[1]); w2.y = cvt_pk_bf16(o[2], o[3]); *(u32x2*)(XB + off + bj * HALF + n * 16) = w2; } }
                asm volatile("" ::: "memory"); }
    }
};
struct EpiGLU {
    static constexpr bool PERM = true;
    bf16* U; const float* bias;
    __device__ __forceinline__ void operator()(const f32x4 (&acc)[2][2][4][2], const GU& u, int wr, int wc, int fr, int fq) const {
        const int row0 = u.p0 * BM + wr * 64 + fr, col0 = u.p1 * HALF + wc * 32 + 8 * fq;
        f32x4 ba[2], bg[2];
#pragma unroll
        for (int n = 0; n < 2; ++n) { ba[n] = *(const f32x4*)(bias + col0 + 4 * n); bg[n] = *(const f32x4*)(bias + 1024 + col0 + 4 * n); }
#pragma unroll
        for (int ai = 0; ai < 2; ++ai)
#pragma unroll
            for (int m = 0; m < 4; ++m) { f32x4 o[2];
#pragma unroll
                for (int n = 0; n < 2; ++n) { const f32x4 a = acc[ai][0][m][n] + ba[n], g = acc[ai][1][m][n] + bg[n];
#pragma unroll
                    for (int j = 0; j < 4; ++j) o[n][j] = a[j] * sigmoid_f(g[j]); }
                u32x4 w; w.x = cvt_pk_bf16(o[0][0], o[0][1]); w.y = cvt_pk_bf16(o[0][2], o[0][3]); w.z = cvt_pk_bf16(o[1][0], o[1][1]); w.w = cvt_pk_bf16(o[1][2], o[1][3]);
                *(u32x4*)(U + (size_t)(row0 + ai * HALF + m * 16) * D + col0) = w; }
    }
};
struct EpiGateUp {
    static constexpr bool PERM = true;
    bf16* HID; const float* slot_w; LAS int* mm;
    __device__ __forceinline__ void operator()(const f32x4 (&acc)[2][2][4][2], const GU& u, int wr, int wc, int fr, int fq) const {
        const int e = u.p0, n_e = mm[e], r0 = u.p1 * BM + wr * 64 + fr, col0 = u.p2 * HALF + wc * 32 + 8 * fq;
        float wv[2][4];
#pragma unroll
        for (int ai = 0; ai < 2; ++ai)
#pragma unroll
            for (int m = 0; m < 4; ++m) wv[ai][m] = slot_w[e * CAP + r0 + ai * HALF + m * 16];
#pragma unroll
        for (int ai = 0; ai < 2; ++ai)
#pragma unroll
            for (int m = 0; m < 4; ++m) { const int r = r0 + ai * HALF + m * 16;
                if (r < n_e) { const float w = wv[ai][m]; f32x4 o[2];
#pragma unroll
                    for (int n = 0; n < 2; ++n) { const f32x4 g = acc[ai][0][m][n], up = acc[ai][1][m][n];
#pragma unroll
                        for (int j = 0; j < 4; ++j) o[n][j] = w * silu_f(g[j]) * up[j]; }
                    u32x4 q; q.x = cvt_pk_bf16(o[0][0], o[0][1]); q.y = cvt_pk_bf16(o[0][2], o[0][3]); q.z = cvt_pk_bf16(o[1][0], o[1][1]); q.w = cvt_pk_bf16(o[1][2], o[1][3]);
                    *(u32x4*)(HID + (size_t)(u.p3 + r) * FF + col0) = q; } }
    }
};
struct EpiDown {
    static constexpr bool PERM = true;
    bf16* Y; LAS int* mm;
    __device__ __forceinline__ void operator()(const f32x4 (&acc)[2][2][4][2], const GU& u, int wr, int wc, int fr, int fq) const {
        const int e = u.p0, n_e = mm[e], r0 = u.p1 * BM + wr * 64 + fr, col0 = u.p2 * BM + wc * 32 + 8 * fq;
#pragma unroll
        for (int ai = 0; ai < 2; ++ai)
#pragma unroll
            for (int m = 0; m < 4; ++m) { const int r = r0 + ai * HALF + m * 16;
                if (r < n_e) {
#pragma unroll
                    for (int bj = 0; bj < 2; ++bj) { const f32x4 v0 = acc[ai][bj][m][0], v1 = acc[ai][bj][m][1];
                        u32x4 q; q.x = cvt_pk_bf16(v0[0], v0[1]); q.y = cvt_pk_bf16(v0[2], v0[3]); q.z = cvt_pk_bf16(v1[0], v1[1]); q.w = cvt_pk_bf16(v1[2], v1[3]);
                        *(u32x4*)(Y + (size_t)(u.p3 + r) * D + col0 + bj * HALF) = q; } } }
    }
};
}

__device__ __forceinline__ void fast_inproj(Frame& F) {
    pg::DenseSched S{(const char*)(F.ws + WS_WIN), D, T / 256, N_IN / 256, F.G, F.wg, TC / 256, T / 256, 4};
    pg::EpiInProj E{F.ws};
    pg::gemm_phase(F.lds, (const char*)(F.ws + WS_HB), D, S, E);
    const int nbusy = (T / 256) * (N_IN / 256) + TC / 256 - 2 * F.G;
    if (nbusy > 0 && nbusy < F.G) { if (F.wg >= nbusy) t_items_tail(F, (F.wg - nbusy) * NWAVES + F.wave, (F.G - nbusy) * NWAVES); }
    else t_items_tail(F, F.wg * NWAVES + F.wave, F.G * NWAVES);
}
__device__ __forceinline__ void fast_outproj(Frame& F, size_t a_off, size_t w_off, const float* base, float* X, const float* gate, const float* bias) {
    pg::DenseSched S{(const char*)(F.ws + w_off), D, T / 256, D / 256, F.G, F.wg, 0, 0, 0};
    if (XBF16) {
        if (base == X) { pg::EpiResB<true> E{nullptr, (bf16*)(F.ws + WS_XB), gate, bias}; pg::gemm_phase(F.lds, (const char*)(F.ws + a_off), D, S, E); }
        else { pg::EpiResB<false> E{base, (bf16*)(F.ws + WS_XB), gate, bias}; pg::gemm_phase(F.lds, (const char*)(F.ws + a_off), D, S, E); }
    } else { pg::EpiRes E{base, X, gate, bias}; pg::gemm_phase(F.lds, (const char*)(F.ws + a_off), D, S, E); }
}
__device__ __forceinline__ void fast_pw1(Frame& F) {
    pg::DenseSched S{(const char*)(F.ws + WS_WPW1), D, T / 256, 2048 / 256, F.G, F.wg, 0, 0, 0};
    pg::EpiGLU E{(bf16*)(F.ws + WS_U), F.in[I_PW1B]};
    pg::gemm_phase(F.lds, (const char*)(F.ws + WS_HB), D, S, E);
}
__device__ __forceinline__ void fast_moe_gateup(Frame& F, int layer) {
    LAS int* mm = moe_map(F, layer);
    pg::MoeSched<true> S{(const char*)(F.ws + WS_WGU) + (size_t)layer * 16 * 1024 * 1024 * 2, (size_t)1024 * 1024 * 2, D, (const int*)(F.ws + WS_SLOTT) + layer * 16 * CAP, mm, F.G, F.wg};
    pg::EpiGateUp E{(bf16*)(F.ws + WS_HID), (const float*)(F.ws + WS_SLOTW) + layer * 16 * CAP, mm};
    pg::gemm_phase(F.lds, (const char*)(F.ws + WS_HB), D, S, E);
}
__device__ __forceinline__ void fast_moe_down(Frame& F, int layer) {
    LAS int* mm = moe_map(F, layer);
    pg::MoeSched<false> S{(const char*)(F.ws + WS_WDN) + (size_t)layer * 16 * 1024 * 512 * 2, (size_t)1024 * 512 * 2, FF, nullptr, mm, F.G, F.wg};
    pg::EpiDown E{(bf16*)(F.ws + WS_Y), mm};
    pg::gemm_phase(F.lds, (const char*)(F.ws + WS_HID), FF, S, E);
}


struct AttnBlk { const bf16* kp; const bf16* vp; int pitch; int kb; bool valid, masked; };
__device__ __forceinline__ AttnBlk attn_blk(const unsigned char* ws, int bi, int b, int kvh, int qs) {
    AttnBlk a;
    if (bi < 8) { a.kp = (const bf16*)(ws + WS_CK) + (size_t)(b * CL + bi * 32) * 128 + kvh * 64; a.vp = (const bf16*)(ws + WS_CV) + (size_t)(b * 2 + kvh) * 64 * CL + bi * 32; a.pitch = CL; a.kb = 0; a.valid = true; a.masked = false; }
    else { const int kb = qs - 128 + 32 * (bi - 8); a.valid = (kb >= 0 && kb < L); a.kb = kb; a.masked = true; a.pitch = L;
        a.kp = (const bf16*)(ws + WS_K) + (size_t)(b * L + kb) * 128 + kvh * 64; a.vp = (const bf16*)(ws + WS_V) + (size_t)(b * 2 + kvh) * 64 * L + kb; }
    return a;
}
__device__ __forceinline__ void attn_load(const AttnBlk& a, int r, int h, bf16x8 (&kf)[4], u32x4 (&vf)[2][2]) {
    if (a.valid) {
#pragma unroll
        for (int s = 0; s < 4; ++s) kf[s] = *(const bf16x8*)(a.kp + (size_t)r * 128 + 16 * s + 8 * h);
#pragma unroll
        for (int db = 0; db < 2; ++db)
#pragma unroll
            for (int ks = 0; ks < 2; ++ks) { const bf16* vr = a.vp + (size_t)(32 * db + r) * a.pitch + 16 * ks + 4 * h;
                const u32x2 lo = *(const u32x2*)vr, hi = *(const u32x2*)(vr + 8); vf[db][ks] = (u32x4){lo.x, lo.y, hi.x, hi.y}; }
    }
}
__device__ __forceinline__ void attn_compute(const AttnBlk& a, int qs, int r, int h, const bf16x8 (&kf)[4], const u32x4 (&vf)[2][2], const bf16x8 (&qf)[2][4],
                                             f32x16 (&o)[2][2], float (&m)[2], float (&l)[2]) {
    if (!a.valid) return;
#pragma unroll
    for (int nq = 0; nq < 2; ++nq) {
        f32x16 st;
#pragma unroll
        for (int i = 0; i < 16; ++i) st[i] = 0.f;
#pragma unroll
        for (int s = 0; s < 4; ++s) st = __builtin_amdgcn_mfma_f32_32x32x16_bf16(kf[s], qf[nq][s], st, 0, 0, 0);
        float t[16]; float tmax = -INFINITY;
        const int dbase = a.kb - qs - 32 * nq - r + 4 * h;
#pragma unroll
        for (int i = 0; i < 16; ++i) { float v = st[i] * (0.125f * 1.4426950408889634f);
            if (a.masked) { const int df = dbase + (i & 3) + 8 * (i >> 2); v = (df >= -128 && df <= 128) ? v : -INFINITY; }
            t[i] = v; tmax = fmaxf(tmax, v); }
        tmax = fmaxf(tmax, __shfl_xor(tmax, 32));
        const float mn = fmaxf(m[nq], tmax), alpha = __builtin_amdgcn_exp2f(m[nq] - mn); m[nq] = mn;
        float ps = 0.f;
#pragma unroll
        for (int i = 0; i < 16; ++i) { t[i] = __builtin_amdgcn_exp2f(t[i] - mn); ps += t[i]; }
        l[nq] = l[nq] * alpha + ps;
#pragma unroll
        for (int i = 0; i < 16; ++i) { o[0][nq][i] *= alpha; o[1][nq][i] *= alpha; }
        bf16x8 pf[2];
#pragma unroll
        for (int ks = 0; ks < 2; ++ks) { const u32x4 w = {pkbf(t[8 * ks], t[8 * ks + 1]), pkbf(t[8 * ks + 2], t[8 * ks + 3]), pkbf(t[8 * ks + 4], t[8 * ks + 5]), pkbf(t[8 * ks + 6], t[8 * ks + 7])};
            pf[ks] = __builtin_bit_cast(bf16x8, w); }
#pragma unroll
        for (int db = 0; db < 2; ++db)
#pragma unroll
            for (int ks = 0; ks < 2; ++ks) o[db][nq] = __builtin_amdgcn_mfma_f32_32x32x16_bf16(__builtin_bit_cast(bf16x8, vf[db][ks]), pf[ks], o[db][nq], 0, 0, 0);
    }
}
__device__ __forceinline__ void phase_attn_mfma(Frame& F) {
    const bf16* Q = (const bf16*)(F.ws + WS_Q); bf16* MIX = (bf16*)(F.ws + WS_MIX);
    const int g = F.wave >> 1, half = F.wave & 1, r = F.lane & 31, h = F.lane >> 5;
    for (int item = F.wg; item < NB * 2 * 64; item += F.G) {
        const int qb = item & 63, kvh = (item >> 6) & 1, b = item >> 7, hd = kvh * 4 + g, qs = qb * 128 + half * 64;
        bf16x8 qf[2][4];
#pragma unroll
        for (int nq = 0; nq < 2; ++nq)
#pragma unroll
            for (int s = 0; s < 4; ++s) qf[nq][s] = *(const bf16x8*)(Q + (size_t)(b * L + qs + 32 * nq + r) * 512 + hd * 64 + 16 * s + 8 * h);
        f32x16 o[2][2];
#pragma unroll
        for (int db = 0; db < 2; ++db)
#pragma unroll
            for (int nq = 0; nq < 2; ++nq)
#pragma unroll
                for (int i = 0; i < 16; ++i) o[db][nq][i] = 0.f;
        float m[2], l[2];
        m[0] = m[1] = F.in[I_SINK][hd] * 1.4426950408889634f; l[0] = l[1] = (h == 0) ? 1.f : 0.f;
        bf16x8 kfA[4], kfB[4]; u32x4 vfA[2][2], vfB[2][2];
        AttnBlk ba = attn_blk(F.ws, 0, b, kvh, qs), bb;
        attn_load(ba, r, h, kfA, vfA);
#pragma unroll 1
        for (int bi = 0; bi < 18; bi += 2) {
            bb = attn_blk(F.ws, bi + 1, b, kvh, qs); attn_load(bb, r, h, kfB, vfB);
            attn_compute(ba, qs, r, h, kfA, vfA, qf, o, m, l);
            if (bi + 2 < 18) { ba = attn_blk(F.ws, bi + 2, b, kvh, qs); attn_load(ba, r, h, kfA, vfA); }
            attn_compute(bb, qs, r, h, kfB, vfB, qf, o, m, l);
        }
#pragma unroll
        for (int nq = 0; nq < 2; ++nq) {
            const float lt = l[nq] + __shfl_xor(l[nq], 32), il = 1.f / lt;
            bf16* orow = MIX + (size_t)(b * L + qs + 32 * nq + r) * 1024 + 512 + hd * 64;
#pragma unroll
            for (int db = 0; db < 2; ++db)
#pragma unroll
                for (int i4 = 0; i4 < 4; ++i4) { u32x2 w; w.x = pkbf(o[db][nq][4 * i4] * il, o[db][nq][4 * i4 + 1] * il); w.y = pkbf(o[db][nq][4 * i4 + 2] * il, o[db][nq][4 * i4 + 3] * il);
                    *(u32x2*)(orow + 32 * db + 8 * i4 + 4 * h) = w; }
        }
    }
}


__device__ __forceinline__ float half_max(float v) { const auto r = __builtin_amdgcn_permlane32_swap(__float_as_uint(v), __float_as_uint(v), false, false); return fmaxf(__uint_as_float(r[0]), __uint_as_float(r[1])); }
__device__ __forceinline__ float half_sum(float v) { const auto r = __builtin_amdgcn_permlane32_swap(__float_as_uint(v), __float_as_uint(v), false, false); return __uint_as_float(r[0]) + __uint_as_float(r[1]); }
constexpr int AT_KP = 72, AT_VP = 136;
constexpr int AT_KB = 128 * AT_KP * 2, AT_BUF = AT_KB + 64 * AT_VP * 2;
struct AtChunk { const bf16* kg; const bf16* vg; int vpitch, lc, b, kvh, qb, c; bool valid, local, any; };
__device__ __forceinline__ AtChunk at_chunk(const unsigned char* ws, int seq, int wg, int G) {
    AtChunk k; const int item = wg + (seq / 5) * G; k.c = seq % 5; k.any = item < NB * 2 * 64;
    k.qb = item & 63; k.kvh = (item >> 6) & 1; k.b = (item >> 7) & 3; k.local = k.c >= 2; k.lc = k.c - 2;
    if (!k.local) { k.valid = k.any; k.vpitch = CL; k.kg = (const bf16*)(ws + WS_CK) + (size_t)(k.b * CL + 128 * k.c) * 128 + k.kvh * 64; k.vg = (const bf16*)(ws + WS_CV) + (size_t)(k.b * 2 + k.kvh) * 64 * CL + 128 * k.c; }
    else { const int key0 = 128 * k.qb - 128 + 128 * k.lc; k.valid = k.any && key0 >= 0 && key0 < L; k.vpitch = L;
        k.kg = (const bf16*)(ws + WS_K) + (size_t)(k.b * L + key0) * 128 + k.kvh * 64; k.vg = (const bf16*)(ws + WS_V) + (size_t)(k.b * 2 + k.kvh) * 64 * L + key0; }
    return k;
}
__device__ __forceinline__ void at_issue(const AtChunk& k, int tid, u32x4 (&rg)[4]) {
    if (k.valid) {
#pragma unroll
        for (int i = 0; i < 2; ++i) { const int id = tid + 512 * i; rg[i] = *(const u32x4*)(k.kg + (size_t)(id >> 3) * 128 + (id & 7) * 8); }
#pragma unroll
        for (int i = 0; i < 2; ++i) { const int id = tid + 512 * i; rg[2 + i] = *(const u32x4*)(k.vg + (size_t)(id >> 4) * k.vpitch + (id & 15) * 8); }
    }
}
__device__ __forceinline__ void at_write(const AtChunk& k, LAS unsigned char* buf, int tid, const u32x4 (&rg)[4]) {
    if (k.valid) {
#pragma unroll
        for (int i = 0; i < 2; ++i) { const int id = tid + 512 * i; *(LAS u32x4*)(buf + (id >> 3) * (AT_KP * 2) + (id & 7) * 16) = rg[i]; }
#pragma unroll
        for (int i = 0; i < 2; ++i) { const int id = tid + 512 * i; *(LAS u32x4*)(buf + AT_KB + (id >> 4) * (AT_VP * 2) + (id & 15) * 16) = rg[2 + i]; }
    }
}
__device__ __forceinline__ void at_load(LAS unsigned char* buf, int blk, int r, int h, bf16x8 (&kf)[4], u32x4 (&vf)[2][2]) {
#pragma unroll
    for (int s2 = 0; s2 < 4; ++s2) kf[s2] = *(const LAS bf16x8*)(buf + (32 * blk + r) * (AT_KP * 2) + (16 * s2 + 8 * h) * 2);
#pragma unroll
    for (int db = 0; db < 2; ++db)
#pragma unroll
        for (int ks = 0; ks < 2; ++ks) { const LAS unsigned char* vr = buf + AT_KB + (32 * db + r) * (AT_VP * 2) + (32 * blk + 16 * ks + 4 * h) * 2;
            const u32x2 lo = *(const LAS u32x2*)vr, hi = *(const LAS u32x2*)(vr + 16); vf[db][ks] = (u32x4){lo.x, lo.y, hi.x, hi.y}; }
}
__device__ __forceinline__ void at_math(const bf16x8 (&kf)[4], const u32x4 (&vf)[2][2], bool masked, int kbrel, int r, int h, const bf16x8 (&qf)[2][4], f32x16 (&o)[2][2], float (&m)[2], float (&l)[2]) {
    constexpr float C = 0.125f * 1.4426950408889634f;
#pragma unroll
    for (int nq = 0; nq < 2; ++nq) {
        f32x16 st;
#pragma unroll
        for (int i = 0; i < 16; ++i) st[i] = 0.f;
#pragma unroll
        for (int s2 = 0; s2 < 4; ++s2) st = __builtin_amdgcn_mfma_f32_32x32x16_bf16(kf[s2], qf[nq][s2], st, 0, 0, 0);
        if (masked) { const int dbase = kbrel - 32 * nq - r + 4 * h;
#pragma unroll
            for (int i = 0; i < 16; ++i) { const int df = dbase + (i & 3) + 8 * (i >> 2); st[i] = (df >= -128 && df <= 128) ? st[i] : -INFINITY; } }
        float smax = st[0];
#pragma unroll
        for (int i = 1; i < 16; ++i) smax = fmaxf(smax, st[i]);
        smax = half_max(smax);
        const float mn = fmaxf(m[nq], smax * C), alpha = __builtin_amdgcn_exp2f(m[nq] - mn); m[nq] = mn;
        float t[16]; float ps = 0.f;
#pragma unroll
        for (int i = 0; i < 16; ++i) { t[i] = __builtin_amdgcn_exp2f(__builtin_fmaf(st[i], C, -mn)); ps += t[i]; }
        l[nq] = l[nq] * alpha + ps;
        if (__ballot(alpha != 1.f)) {
#pragma unroll
            for (int i = 0; i < 16; ++i) { o[0][nq][i] *= alpha; o[1][nq][i] *= alpha; } }
        bf16x8 pf[2];
#pragma unroll
        for (int ks = 0; ks < 2; ++ks) { const u32x4 w = {pkbf(t[8 * ks], t[8 * ks + 1]), pkbf(t[8 * ks + 2], t[8 * ks + 3]), pkbf(t[8 * ks + 4], t[8 * ks + 5]), pkbf(t[8 * ks + 6], t[8 * ks + 7])};
            pf[ks] = __builtin_bit_cast(bf16x8, w); }
#pragma unroll
        for (int db = 0; db < 2; ++db)
#pragma unroll
            for (int ks = 0; ks < 2; ++ks) o[db][nq] = __builtin_amdgcn_mfma_f32_32x32x16_bf16(__builtin_bit_cast(bf16x8, vf[db][ks]), pf[ks], o[db][nq], 0, 0, 0);
    }
}
__device__ __forceinline__ void phase_attn_lds(Frame& F) {
    const bf16* Q = (const bf16*)(F.ws + WS_Q); bf16* MIX = (bf16*)(F.ws + WS_MIX);
    const int g = F.wave >> 1, half = F.wave & 1, r = F.lane & 31, h = F.lane >> 5;
    __syncthreads();
    u32x4 rg[4];
    AtChunk ck = at_chunk(F.ws, 0, F.wg, F.G);
    if (!ck.any) return;
    at_issue(ck, F.tid, rg); at_write(ck, F.lds, F.tid, rg);
    __syncthreads();
    bf16x8 qf[2][4]; f32x16 o[2][2]; float m[2], l[2];
#pragma unroll 1
    for (int seq = 0; ck.any; ++seq) {
        LAS unsigned char* buf = F.lds + (seq & 1) * AT_BUF;
        const TItem ti = t_decode(F, seq < 10 ? 640 + (F.wg * NWAVES + F.wave) + seq * (F.G * NWAVES) : (1 << 30));
        t_dma(ti, F.lds + 2 * AT_BUF + F.wave * 8704, F.lane);
        const AtChunk nk = at_chunk(F.ws, seq + 1, F.wg, F.G);
        at_issue(nk, F.tid, rg);
        const int hd = ck.kvh * 4 + g, qs = ck.qb * 128 + half * 64;
        if (ck.c == 0) {
#pragma unroll
            for (int nq = 0; nq < 2; ++nq)
#pragma unroll
                for (int s2 = 0; s2 < 4; ++s2) qf[nq][s2] = *(const bf16x8*)(Q + (size_t)(ck.b * L + qs + 32 * nq + r) * 512 + hd * 64 + 16 * s2 + 8 * h);
#pragma unroll
            for (int db = 0; db < 2; ++db)
#pragma unroll
                for (int nq = 0; nq < 2; ++nq)
#pragma unroll
                    for (int i = 0; i < 16; ++i) o[db][nq][i] = 0.f;
            m[0] = m[1] = F.in[I_SINK][hd] * 1.4426950408889634f; l[0] = l[1] = (h == 0) ? 1.f : 0.f;
        }
        if (ck.valid) {
            int b0 = 0, b1 = 4;
            if (ck.local) { b0 = 2 * half - 4 * ck.lc; b0 = b0 < 0 ? 0 : b0; b1 = 2 * half + 10 - 4 * ck.lc; b1 = b1 > 4 ? 4 : b1; }
            if (b0 < b1) {
                bf16x8 kfA[4], kfB[4]; u32x4 vfA[2][2], vfB[2][2];
                at_load(buf, b0, r, h, kfA, vfA);
#pragma unroll 1
                for (int blk = b0; blk < b1; blk += 2) {
                    const int iA = 4 * ck.lc + blk - 2 * half, iB = iA + 1;
                    if (blk + 1 < b1) at_load(buf, blk + 1, r, h, kfB, vfB);
                    at_math(kfA, vfA, ck.local && (iA < 2 || iA > 7), 32 * iA - 128, r, h, qf, o, m, l);
                    if (blk + 1 < b1) {
                        if (blk + 2 < b1) at_load(buf, blk + 2, r, h, kfA, vfA);
                        at_math(kfB, vfB, ck.local && (iB < 2 || iB > 7), 32 * iB - 128, r, h, qf, o, m, l);
                    }
                }
            }
        }
        if (ck.c == 4) {
#pragma unroll
            for (int nq = 0; nq < 2; ++nq) {
                const float lt = half_sum(l[nq]), il = __builtin_amdgcn_rcpf(lt);
                bf16* orow = MIX + (size_t)(ck.b * L + qs + 32 * nq + r) * 1024 + 512 + hd * 64;
#pragma unroll
                for (int db = 0; db < 2; ++db)
#pragma unroll
                    for (int i4 = 0; i4 < 4; ++i4) { u32x2 w; w.x = pkbf(o[db][nq][4 * i4] * il, o[db][nq][4 * i4 + 1] * il); w.y = pkbf(o[db][nq][4 * i4 + 2] * il, o[db][nq][4 * i4 + 3] * il);
                        *(u32x2*)(orow + 32 * db + 8 * i4 + 4 * h) = w; }
            }
        }
        if (ti.ok) { asm volatile("s_waitcnt vmcnt(0)" ::: "memory"); t_store_dma(ti, (const LAS float*)(F.lds + 2 * AT_BUF + F.wave * 8704), F.lane); }
        at_write(nk, F.lds + ((seq + 1) & 1) * AT_BUF, F.tid, rg);
        __syncthreads();
        ck = nk;
    }
}

constexpr int F1_PC = 136, F1_PW = 68, F2_P = 264;
constexpr int F1_CSC = 0, F1_CSS = 128 * F1_PC * 2, F1_C64 = 2 * 128 * F1_PC * 2, F1_S64 = F1_C64 + 64 * F1_PW * 2;
__device__ __forceinline__ bf16x8 pack8(float a0, float a1, float a2, float a3, float a4, float a5, float a6, float a7) {
    const u32x4 w = {pkbf(a0, a1), pkbf(a2, a3), pkbf(a4, a5), pkbf(a6, a7)}; return __builtin_bit_cast(bf16x8, w); }
__device__ __forceinline__ void phase_fft1_mfma(Frame& F) {
    __syncthreads();
    LAS bf16* csc = (LAS bf16*)(F.lds + F1_CSC); LAS bf16* css = (LAS bf16*)(F.lds + F1_CSS); LAS bf16* c64 = (LAS bf16*)(F.lds + F1_C64); LAS bf16* s64 = (LAS bf16*)(F.lds + F1_S64);
    for (int i = F.tid; i < 128 * 128; i += NTHR) { const int n = i >> 7, k = i & 127; const float ang = (float)((n * k) & 127) * (6.283185307179586f / 128.f);
        csc[n * F1_PC + k] = (bf16)f2bf(__cosf(ang)); css[n * F1_PC + k] = (bf16)f2bf(__sinf(ang)); }
    for (int i = F.tid; i < 64 * 64; i += NTHR) { const int c = i >> 6, a = i & 63; const float ang = (float)((c * a) & 63) * (6.283185307179586f / 64.f);
        c64[c * F1_PW + a] = (bf16)f2bf(__cosf(ang)); s64[c * F1_PW + a] = (bf16)f2bf(__sinf(ang)); }
    __syncthreads();
    const bf16* UF = (const bf16*)(F.ws + WS_UF); bf16* Gb = (bf16*)(F.ws + WS_G);
    const int r = F.lane & 31, h = F.lane >> 5, g = F.wave >> 1;
    for (int item = F.wg; item < NB * FN2; item += F.G) {
        const int b = item >> 7, bp = item & 127;
#pragma unroll 1
        for (int q = 0; q < 2; ++q) {
            const int cbk = 2 * F.wave + q, n = 32 * (cbk & 3) + r, ch = 32 * cbk + r;
            f32x16 zr[2], zi[2];
#pragma unroll
            for (int rb = 0; rb < 2; ++rb) {
                bf16x8 uf[8];
#pragma unroll
                for (int s2 = 0; s2 < 8; ++s2) uf[s2] = *(const bf16x8*)(UF + (size_t)(b * L + 128 * (32 * rb + r) + bp) * 512 + g * 128 + 16 * s2 + 8 * h);
#pragma unroll
                for (int i = 0; i < 16; ++i) { zr[rb][i] = 0.f; zi[rb][i] = 0.f; }
#pragma unroll
                for (int s2 = 0; s2 < 8; ++s2) { const bf16x8 bc = *(const LAS bf16x8*)(csc + n * F1_PC + 16 * s2 + 8 * h), bs = *(const LAS bf16x8*)(css + n * F1_PC + 16 * s2 + 8 * h);
                    zr[rb] = __builtin_amdgcn_mfma_f32_32x32x16_bf16(uf[s2], bc, zr[rb], 0, 0, 0); zi[rb] = __builtin_amdgcn_mfma_f32_32x32x16_bf16(uf[s2], bs, zi[rb], 0, 0, 0); }
                __builtin_amdgcn_sched_barrier(0);
            }
            bf16x8 zfr[4], zfi[4];
#pragma unroll
            for (int ks = 0; ks < 4; ++ks) { const int rb = ks >> 1, o = 8 * (ks & 1);
                zfr[ks] = pack8(zr[rb][o], zr[rb][o + 1], zr[rb][o + 2], zr[rb][o + 3], zr[rb][o + 4], zr[rb][o + 5], zr[rb][o + 6], zr[rb][o + 7]);
                zfi[ks] = pack8(-zi[rb][o], -zi[rb][o + 1], -zi[rb][o + 2], -zi[rb][o + 3], -zi[rb][o + 4], -zi[rb][o + 5], -zi[rb][o + 6], -zi[rb][o + 7]); }
            __builtin_amdgcn_sched_barrier(0);
#pragma unroll 1
            for (int rbc = 0; rbc < 2; ++rbc) {
                f32x16 gr, gi; const int cr = 32 * rbc + r;
#pragma unroll
                for (int i = 0; i < 16; ++i) { gr[i] = 0.f; gi[i] = 0.f; }
#pragma unroll
                for (int ks = 0; ks < 4; ++ks) {
                    const u32x2 cl = *(const LAS u32x2*)(c64 + cr * F1_PW + 16 * ks + 4 * h), chh = *(const LAS u32x2*)(c64 + cr * F1_PW + 16 * ks + 8 + 4 * h);
                    const u32x2 sl = *(const LAS u32x2*)(s64 + cr * F1_PW + 16 * ks + 4 * h), shh = *(const LAS u32x2*)(s64 + cr * F1_PW + 16 * ks + 8 + 4 * h);
                    const u32x4 sw = {sl.x, sl.y, shh.x, shh.y}; const u32x4 swn = sw ^ 0x80008000u;
                    const bf16x8 wc = __builtin_bit_cast(bf16x8, ((u32x4){cl.x, cl.y, chh.x, chh.y})), wsn = __builtin_bit_cast(bf16x8, sw), wsm = __builtin_bit_cast(bf16x8, swn);
                    gr = __builtin_amdgcn_mfma_f32_32x32x16_bf16(wc, zfr[ks], gr, 0, 0, 0); gr = __builtin_amdgcn_mfma_f32_32x32x16_bf16(wsn, zfi[ks], gr, 0, 0, 0);
                    gi = __builtin_amdgcn_mfma_f32_32x32x16_bf16(wc, zfi[ks], gi, 0, 0, 0); gi = __builtin_amdgcn_mfma_f32_32x32x16_bf16(wsm, zfr[ks], gi, 0, 0, 0); }
                __builtin_amdgcn_sched_barrier(0);
#pragma unroll
                for (int i = 0; i < 16; ++i) { const int c = 32 * rbc + crow(i, h); const float ang = (float)(bp * c) * (6.283185307179586f / 8192.f), cs = __cosf(ang), sn = __sinf(ang);
                    const float re = gr[i] * cs + gi[i] * sn, im = gi[i] * cs - gr[i] * sn;
                    bf16* o = Gb + (size_t)((b * FN1 + c) * FN2 + bp) * 1024 + ch; o[0] = (bf16)f2bf(re); o[512] = (bf16)f2bf(im);
                    if ((i & 3) == 3) __builtin_amdgcn_sched_barrier(0); }
            }
        }
    }
    __syncthreads();
}
__device__ __forceinline__ void phase_fft2_mfma(Frame& F) {
    __syncthreads();
    LAS bf16* t2 = (LAS bf16*)F.lds;
    for (int i = F.tid; i < 128 * 256; i += NTHR) { const int d = i >> 8, k = i & 255; const float ang = (float)((d * (k & 127)) & 127) * (6.283185307179586f / 128.f);
        t2[d * F2_P + k] = (bf16)f2bf(k < 128 ? __cosf(ang) : __sinf(ang)); }
    __syncthreads();
    const bf16* Gb = (const bf16*)(F.ws + WS_G); bf16* MIX = (bf16*)(F.ws + WS_MIX);
    const int r = F.lane & 31, h = F.lane >> 5;
    for (int item = F.wg; item < NB * FN1; item += F.G) {
        const int b = item >> 6, c = item & 63;
        const bf16* Gp = Gb + (size_t)((b * FN1 + c) * FN2) * 1024 + 64 * F.wave + r;
        f32x16 y[4][2];
#pragma unroll
        for (int rb = 0; rb < 4; ++rb)
#pragma unroll
            for (int cb = 0; cb < 2; ++cb)
#pragma unroll
                for (int i = 0; i < 16; ++i) y[rb][cb][i] = 0.f;
        unsigned eA[2][8], eB[2][8];
#define F2_GATHER(dst, ks_) do { const bf16* p_ = Gp + (size_t)(16 * ((ks_) & 7) + 8 * h) * 1024 + ((ks_) >> 3) * 512; \
            _Pragma("unroll") for (int cb = 0; cb < 2; ++cb) _Pragma("unroll") for (int j = 0; j < 8; ++j) dst[cb][j] = p_[(size_t)j * 1024 + 32 * cb]; } while (0)
#define F2_MMA(src, ks_) do { bf16x8 bfr[2]; _Pragma("unroll") for (int cb = 0; cb < 2; ++cb) { \
                const u32x4 w = {src[cb][0] | (src[cb][1] << 16), src[cb][2] | (src[cb][3] << 16), src[cb][4] | (src[cb][5] << 16), src[cb][6] | (src[cb][7] << 16)}; bfr[cb] = __builtin_bit_cast(bf16x8, w); } \
            _Pragma("unroll") for (int rb = 0; rb < 4; ++rb) { const bf16x8 a = *(const LAS bf16x8*)(t2 + (32 * rb + r) * F2_P + 16 * (ks_) + 8 * h); \
                _Pragma("unroll") for (int cb = 0; cb < 2; ++cb) y[rb][cb] = __builtin_amdgcn_mfma_f32_32x32x16_bf16(a, bfr[cb], y[rb][cb], 0, 0, 0); } } while (0)
        F2_GATHER(eA, 0);
#pragma unroll 1
        for (int ks = 0; ks < 16; ks += 2) {
            F2_GATHER(eB, ks + 1);
            F2_MMA(eA, ks);
            if (ks + 2 < 16) F2_GATHER(eA, ks + 2);
            F2_MMA(eB, ks + 1);
        }
#undef F2_GATHER
#undef F2_MMA
#pragma unroll
        for (int rb = 0; rb < 4; ++rb)
#pragma unroll
            for (int cb = 0; cb < 2; ++cb)
#pragma unroll
                for (int i = 0; i < 16; ++i) { const int d = 32 * rb + crow(i, h); MIX[(size_t)(b * L + c + 64 * d) * 1024 + 64 * F.wave + 32 * cb + r] = (bf16)f2bf(y[rb][cb][i] * (1.f / 1024.f)); }
    }
    __syncthreads();
}


typedef float f32x2_t __attribute__((ext_vector_type(2)));
template <int IR> struct DwIn {
    static __device__ __forceinline__ void run(const unsigned (&uin)[62], const f32x2_t (&w)[31], f32x2_t (&o)[32]) {
        const f32x2_t x = {bflo(uin[IR]), bfhi(uin[IR])};
#pragma unroll
        for (int r = 0; r < 32; ++r) { if (IR - r >= 0 && IR - r <= 30) o[r] += w[(IR - r >= 0 && IR - r <= 30) ? IR - r : 0] * x; }
        DwIn<IR + 1>::run(uin, w, o);
    }
};
template <> struct DwIn<62> { static __device__ __forceinline__ void run(const unsigned (&)[62], const f32x2_t (&)[31], f32x2_t (&)[32]) {} };
template <int IR> struct DwIn16 {
    static __device__ __forceinline__ void run(const unsigned (&uin)[46], const f32x2_t (&w)[31], f32x2_t (&o)[16]) {
        const f32x2_t x = {bflo(uin[IR]), bfhi(uin[IR])};
#pragma unroll
        for (int r = 0; r < 16; ++r) { if (IR - r >= 0 && IR - r <= 30) o[r] += w[(IR - r >= 0 && IR - r <= 30) ? IR - r : 0] * x; }
        DwIn16<IR + 1>::run(uin, w, o);
    }
};
template <> struct DwIn16<46> { static __device__ __forceinline__ void run(const unsigned (&)[46], const f32x2_t (&)[31], f32x2_t (&)[16]) {} };
__device__ __forceinline__ void phase_dwconv_fast(Frame& F) {
    const bf16* U = (const bf16*)(F.ws + WS_U); bf16* V1 = (bf16*)(F.ws + WS_V1);
    const float* dww = F.in[I_DWW];
    const int c0 = 2 * F.tid;
    f32x2_t w[31];
#pragma unroll
    for (int j = 0; j < 31; ++j) w[j] = *(const f32x2_t*)(dww + (size_t)j * D + c0);
    const f32x2_t bb = *(const f32x2_t*)(F.in[I_DWB] + c0), gg = *(const f32x2_t*)(F.in[I_LNG] + c0), lb = *(const f32x2_t*)(F.in[I_LNB] + c0);
    LAS float* red = (LAS float*)F.lds;
    LAS float* stat = red + 16 * 8 * 2;
    __syncthreads();
    for (int run = F.wg; run < T / 128; run += F.G) {
        const int row0 = run * 128, l0 = row0 & (L - 1);
        unsigned uin[46], nx[16];
#pragma unroll
        for (int ir = 0; ir < 46; ++ir) { const int l = l0 - 15 + ir; const bool ok = (l >= 0 && l < L);
            const unsigned u = *(const unsigned*)(U + (size_t)(ok ? row0 - 15 + ir : row0) * D + c0); uin[ir] = ok ? u : 0u; }
#pragma unroll 1
        for (int step = 0; step < 8; ++step) {
            const int r0 = row0 + 16 * step;
            if (step < 7) {
#pragma unroll
                for (int j = 0; j < 16; ++j) { const int l = l0 + 16 * step + 31 + j; const bool ok = l < L;
                    const unsigned u = *(const unsigned*)(U + (size_t)(ok ? r0 + 31 + j : r0) * D + c0); nx[j] = ok ? u : 0u; }
            }
            f32x2_t o[16];
#pragma unroll
            for (int r = 0; r < 16; ++r) o[r] = bb;
            DwIn16<0>::run(uin, w, o);
#pragma unroll
            for (int r = 0; r < 16; ++r) { const float sm = wave_sum(o[r].x + o[r].y), sq = wave_sum(o[r].x * o[r].x + o[r].y * o[r].y);
                if (F.lane == 0) { red[(r * 8 + F.wave) * 2] = sm; red[(r * 8 + F.wave) * 2 + 1] = sq; } }
            __syncthreads();
            if (F.tid < 16) { float sm = 0.f, sq = 0.f;
#pragma unroll
                for (int wv = 0; wv < 8; ++wv) { sm += red[(F.tid * 8 + wv) * 2]; sq += red[(F.tid * 8 + wv) * 2 + 1]; }
                const float mean = sm * (1.f / D), var = fmaxf(sq * (1.f / D) - mean * mean, 0.f);
                stat[2 * F.tid] = mean; stat[2 * F.tid + 1] = rsqrtf(var + EPS); }
            __syncthreads();
#pragma unroll
            for (int r = 0; r < 16; ++r) { const float mean = stat[2 * r], rstd = stat[2 * r + 1];
                const float y0 = silu_f((o[r].x - mean) * rstd * gg.x + lb.x), y1 = silu_f((o[r].y - mean) * rstd * gg.y + lb.y);
                *(unsigned*)(V1 + (size_t)(r0 + r) * D + c0) = pkbf(y0, y1); }
#pragma unroll
            for (int i = 0; i < 30; ++i) uin[i] = uin[i + 16];
#pragma unroll
            for (int j = 0; j < 16; ++j) uin[30 + j] = nx[j];
        }
        __syncthreads();
    }
}

namespace pg {
struct MU { const char* B; const char* A; int K, type, e, rt, pn, hb, buf; };
struct MoeMergedSched {
    const char* Wgu; const char* Wdn; const char* HBp; const char* HIDp; const int* list; const float* wlist; LAS int* mm; unsigned* tcnt; unsigned* tmo; int G, c, U;
    __device__ __forceinline__ bool flat(int L, int type, MU& u) const {
        for (int e = 0; e < 16; ++e) { const int n = mm[e], nu = ((n + 255) >> 8) * 4;
            if (L < nu) { u.e = e; u.rt = L >> 2; u.pn = L & 3; u.hb = mm[16 + e]; u.type = type; u.buf = 0;
                if (type == 0) { u.K = D; u.A = HBp; u.B = Wgu + (size_t)e * (1024 * 1024 * 2) + (size_t)u.pn * BM * D * 2; }
                else { u.K = FF; u.A = HIDp; u.B = Wdn + (size_t)e * (1024 * 512 * 2) + (size_t)u.pn * BM * FF * 2; }
                return true; }
            L -= nu; }
        return false;
    }
    __device__ __forceinline__ bool next(int i, MU& u) const {
        const int ngu = c < U ? (U - 1 - c) / G + 1 : 0;
        if (i < ngu) return flat(i * G + c, 0, u);
        const int k = i - ngu, x = U % G; int j;
        if (c >= x) { if (k == 0) j = c - x; else j = (G - 1 - c) + (k - 1) * G + (G - x); } else j = (G - 1 - c) + k * G + (G - x);
        if (j >= U) return false;
        return flat(j, 1, u);
    }
    __device__ __forceinline__ unsigned voff(const MU& u, int buf, LAS unsigned char* lds, int R, int C) const {
        if (u.type == 0) { const int tok = ((const LAS int*)(lds + TAB_OFF))[buf * 256 + R]; return (unsigned)((tok * D + C) * 2); }
        return (unsigned)(((u.hb + u.rt * BM + R) * FF + C) * 2);
    }
    __device__ __forceinline__ void stage_table(const MU& u, int buf, LAS unsigned char* lds, int wid, int lane) const {
        const int r = (wid & 3) * 64 + lane;
        __builtin_amdgcn_global_load_lds((const unsigned*)(list + u.e * CAP + u.rt * BM + r), (LAS unsigned*)(lds + TAB_OFF + buf * 1024 + (wid & 3) * 256), 4, 0, 0);
        __builtin_amdgcn_global_load_lds((const unsigned*)(wlist + u.e * CAP + u.rt * BM + r), (LAS unsigned*)(lds + TAB_OFF + 2048 + buf * 1024 + (wid & 3) * 256), 4, 0, 0);
    }
    __device__ __forceinline__ unsigned* tile_word(const MU& u) const { return tcnt + ((u.hb >> 8) + u.rt) * 64; }
    __device__ __forceinline__ void wait_ready(const MU& u, int wid) const {
        if (wid == 0) {
            unsigned* w = tile_word(u); unsigned spins = 0;
            while ((unsigned)__builtin_amdgcn_readfirstlane(__hip_atomic_load(w, __ATOMIC_RELAXED, __HIP_MEMORY_SCOPE_AGENT)) < 32u) {
                __builtin_amdgcn_s_sleep(2);
                if ((++spins & 255u) == 0u) { if (__builtin_amdgcn_readfirstlane(__hip_atomic_load(tmo, __ATOMIC_RELAXED, __HIP_MEMORY_SCOPE_AGENT)) != 0u) break;
                    if (spins > (1u << 20)) { __hip_atomic_store(tmo, 1u, __ATOMIC_RELAXED, __HIP_MEMORY_SCOPE_AGENT); break; } } }
        }
        asm volatile("" ::: "memory"); __builtin_amdgcn_s_barrier(); asm volatile("" ::: "memory");
    }
};
struct EpiGateUpWT {
    __amdgpu_buffer_rsrc_t rsrc; LAS unsigned char* lds; LAS int* mm;
    __device__ __forceinline__ void operator()(const f32x4 (&acc)[2][2][4][2], const MU& u, int wr, int wc, int fr, int fq) const {
        const int e = u.e, n_e = mm[e], r0 = u.rt * BM + wr * 64 + fr, col0 = u.pn * HALF + wc * 32 + 8 * fq;
        float wv[2][4];
#pragma unroll
        for (int ai = 0; ai < 2; ++ai)
#pragma unroll
            for (int m = 0; m < 4; ++m) wv[ai][m] = ((const LAS float*)(lds + TAB_OFF + 2048))[u.buf * 256 + wr * 64 + fr + ai * HALF + m * 16];
#pragma unroll
        for (int ai = 0; ai < 2; ++ai)
#pragma unroll
            for (int m = 0; m < 4; ++m) { const int r = r0 + ai * HALF + m * 16;
                if (r < n_e) { const float w = wv[ai][m]; f32x4 o[2];
#pragma unroll
                    for (int n = 0; n < 2; ++n) { const f32x4 g = acc[ai][0][m][n], up = acc[ai][1][m][n];
#pragma unroll
                        for (int j = 0; j < 4; ++j) o[n][j] = w * silu_f(g[j]) * up[j]; }
                    u32x4 q; q.x = cvt_pk_bf16(o[0][0], o[0][1]); q.y = cvt_pk_bf16(o[0][2], o[0][3]); q.z = cvt_pk_bf16(o[1][0], o[1][1]); q.w = cvt_pk_bf16(o[1][2], o[1][3]);
                    __builtin_amdgcn_raw_buffer_store_b128(q, rsrc, (unsigned)(((u.hb + r) * FF + col0) * 2), 0, 16); } }
    }
};
struct EpiDownM {
    unsigned char* Y8; LAS int* mm;
    __device__ __forceinline__ void operator()(const f32x4 (&acc)[2][2][4][2], const MU& u, int wr, int wc, int fr, int fq) const {
        const int e = u.e, n_e = mm[e], r0 = u.rt * BM + wr * 64 + fr, col0 = u.pn * BM + 64 * wc + 16 * fq;
#pragma unroll
        for (int ai = 0; ai < 2; ++ai)
#pragma unroll
            for (int m = 0; m < 4; ++m) { const int r = r0 + ai * HALF + m * 16;
                if (r < n_e) { u32x4 q; q.x = pk_fp8x4(acc[ai][0][m][0]); q.y = pk_fp8x4(acc[ai][0][m][1]); q.z = pk_fp8x4(acc[ai][1][m][0]); q.w = pk_fp8x4(acc[ai][1][m][1]);
                    *(u32x4*)(Y8 + (size_t)(u.hb + r) * D + col0) = q; } }
    }
};
__device__ __forceinline__ void gemm_phase_moe(LAS unsigned char* lds, const MoeMergedSched& S, const EpiGateUpWT& EA, const EpiDownM& EB) {
    const int tid = threadIdx.x, wid = __builtin_amdgcn_readfirstlane(tid >> 6), lane = tid & 63, wr = wid >> 2, wc = wid & 3, fr = lane & 15, fq = lane >> 4;
    int sR[2], sC[2]; unsigned vbA[2], vbD[2];
#pragma unroll
    for (int i = 0; i < 2; ++i) { int R, C; stage_rc(tid * 16 + i * 8192, R, C); sR[i] = R; sC[i] = C; const int Rb = (R & ~31) + perm32(R & 31);
        const int RbD = 64 * ((Rb >> 5) & 3) + 16 * ((Rb >> 3) & 3) + (Rb & 7);
        vbA[i] = (unsigned)(Rb * D + C) * 2u; vbD[i] = (unsigned)(RbD * FF + C) * 2u; }
    const size_t kstep = (size_t)(BK * 2);
    const unsigned ldsw = (unsigned)wid * 1024u;
    const int aoff = lds_byte(wr * 64 + fr, fq * 8), boff = lds_byte(wc * 32 + fr, fq * 8);
#define PG_SA(b, h) (((b) * 2 + (h)) * HTB)
#define PG_SB(b, h) ((4 + (b) * 2 + (h)) * HTB)
#define PG_STAGE(bufoff, gbase, voff) do { _Pragma("unroll") for (int _i = 0; _i < 2; ++_i) \
        __builtin_amdgcn_global_load_lds((const unsigned*)((const char*)(gbase) + (voff)[_i]), (LAS unsigned*)(lds + (bufoff) + ldsw + _i * 8192), 16, 0, 0); } while (0)
#define PG_LDA(dst, b, h) do { _Pragma("unroll") for (int m = 0; m < 4; ++m) _Pragma("unroll") for (int k = 0; k < 2; ++k) dst[m][k] = *(const LAS bf16x8*)(lds + PG_SA(b, h) + aoff + m * 2048 + k * 1024); } while (0)
#define PG_LDB(dst, b, h) do { _Pragma("unroll") for (int n = 0; n < 2; ++n) _Pragma("unroll") for (int k = 0; k < 2; ++k) dst[n][k] = *(const LAS bf16x8*)(lds + PG_SB(b, h) + boff + n * 2048 + k * 1024); } while (0)
#define PG_MMA(ai, bj, At, Bt) do { __builtin_amdgcn_s_setprio(1); _Pragma("unroll") for (int m = 0; m < 4; ++m) _Pragma("unroll") for (int n = 0; n < 2; ++n) _Pragma("unroll") for (int k = 0; k < 2; ++k) \
        acc[ai][bj][m][n] = __builtin_amdgcn_mfma_f32_16x16x32_bf16(Bt[n][k], At[m][k], acc[ai][bj][m][n], 0, 0, 0); __builtin_amdgcn_s_setprio(0); } while (0)
#define PG_WAIT_V(n) asm volatile("s_waitcnt vmcnt(" #n ")" ::: "memory")
#define PG_WAIT_L(n) asm volatile("s_waitcnt lgkmcnt(" #n ")" ::: "memory")
#define PG_BAR __builtin_amdgcn_s_barrier()
#define PG_SCHED __builtin_amdgcn_sched_barrier(0)
    MU cur, nxt; int ui = 0;
    if (!S.next(0, cur)) return;
    cur.buf = 0;
    f32x4 acc[2][2][4][2];
#pragma unroll
    for (int a = 0; a < 2; ++a)
#pragma unroll
        for (int b = 0; b < 2; ++b)
#pragma unroll
            for (int m = 0; m < 4; ++m)
#pragma unroll
                for (int n = 0; n < 2; ++n) acc[a][b][m][n] = (f32x4){0.f, 0.f, 0.f, 0.f};
    bf16x8 At[4][2], B0[2][2], B1[2][2];
    if (cur.type == 0) { S.stage_table(cur, 0, lds, wid, lane); PG_WAIT_V(0); PG_BAR; } else S.wait_ready(cur, wid);
    unsigned voC[2][2], voN[2][2];
#pragma unroll
    for (int h = 0; h < 2; ++h)
#pragma unroll
        for (int i = 0; i < 2; ++i) { voC[h][i] = S.voff(cur, 0, lds, h * HALF + sR[i], sC[i]); voN[h][i] = voC[h][i]; }
    const char* cB = cur.B; const char* cA = cur.A; size_t hsC = (size_t)(cur.type == 0 ? HALF : 8) * cur.K * 2; int nt = cur.K / BK;
    if (cur.type == 0) { PG_STAGE(PG_SB(0, 0), cB, vbA); PG_STAGE(PG_SB(0, 1), cB + hsC, vbA); } else { PG_STAGE(PG_SB(0, 0), cB, vbD); PG_STAGE(PG_SB(0, 1), cB + hsC, vbD); }
    PG_STAGE(PG_SA(0, 0), cA, voC[0]); PG_STAGE(PG_SA(0, 1), cA, voC[1]);
    if (wr == 1) PG_BAR;
    PG_WAIT_V(2); PG_BAR;
    if (cur.type == 0) { PG_STAGE(PG_SB(1, 0), cB + kstep, vbA); } else { PG_STAGE(PG_SB(1, 0), cB + kstep, vbD); }
    PG_STAGE(PG_SA(1, 0), cA + kstep, voC[0]);
    if (cur.type == 0) { PG_STAGE(PG_SB(1, 1), cB + hsC + kstep, vbA); } else { PG_STAGE(PG_SB(1, 1), cB + hsC + kstep, vbD); }
    PG_WAIT_V(6); PG_BAR;
    for (;;) {
        const bool has_next = S.next(ui + 1, nxt); nxt.buf = (ui + 1) & 1;
        if (has_next && nxt.type == 0) S.stage_table(nxt, (ui + 1) & 1, lds, wid, lane);
        const char* nB = has_next ? nxt.B : cB; const char* nA = has_next ? nxt.A : cA; const size_t hsN = has_next ? (size_t)(nxt.type == 0 ? HALF : 8) * nxt.K * 2 : hsC;
        for (int t = 0; t < nt; t += 2) {
            const bool last = (t == nt - 2);
            if (last && has_next) {
                if (nxt.type == 1) S.wait_ready(nxt, wid);
#pragma unroll
                for (int h = 0; h < 2; ++h)
#pragma unroll
                    for (int i = 0; i < 2; ++i) voN[h][i] = S.voff(nxt, (ui + 1) & 1, lds, h * HALF + sR[i], sC[i]);
            }
            unsigned vo2[2][2], vb2[2]; const bool b2gu = last ? (has_next ? nxt.type == 0 : cur.type == 0) : (cur.type == 0);
#pragma unroll
            for (int h = 0; h < 2; ++h)
#pragma unroll
                for (int i = 0; i < 2; ++i) vo2[h][i] = last ? voN[h][i] : voC[h][i];
#pragma unroll
            for (int i = 0; i < 2; ++i) vb2[i] = b2gu ? vbA[i] : vbD[i];
            const size_t hs2 = last ? hsN : hsC;
            const char* a1 = cA + (size_t)(t + 1) * kstep;
            const char* a2 = last ? nA : cA + (size_t)(t + 2) * kstep; const char* b2 = last ? nB : cB + (size_t)(t + 2) * kstep;
            const char* a3 = a2 + kstep; const char* b3 = b2 + kstep;
            PG_LDB(B0, 0, 0); PG_LDB(B1, 0, 1); PG_SCHED; PG_LDA(At, 0, 0); PG_STAGE(PG_SA(1, 1), a1, voC[1]);
            PG_WAIT_V(8); PG_WAIT_L(0); PG_BAR; PG_MMA(0, 0, At, B0); PG_MMA(0, 1, At, B1); PG_BAR; PG_SCHED;
            PG_LDA(At, 0, 1); PG_STAGE(PG_SB(0, 0), b2, vb2); PG_STAGE(PG_SB(0, 1), b2 + hs2, vb2); PG_STAGE(PG_SA(0, 0), a2, vo2[0]);
            PG_WAIT_V(8); PG_WAIT_L(0); PG_BAR; PG_MMA(1, 0, At, B0); PG_MMA(1, 1, At, B1); PG_BAR; PG_SCHED;
            PG_LDB(B0, 1, 0); PG_LDB(B1, 1, 1); PG_SCHED; PG_LDA(At, 1, 0); PG_STAGE(PG_SA(0, 1), a2, vo2[1]);
            PG_WAIT_V(8); PG_WAIT_L(0); PG_BAR; PG_MMA(0, 0, At, B0); PG_MMA(0, 1, At, B1); PG_BAR; PG_SCHED;
            PG_LDA(At, 1, 1); PG_STAGE(PG_SB(1, 0), b3, vb2); PG_STAGE(PG_SB(1, 1), b3 + hs2, vb2); PG_STAGE(PG_SA(1, 0), a3, vo2[0]);
            PG_WAIT_V(8); PG_WAIT_L(0); PG_BAR; PG_MMA(1, 0, At, B0); PG_MMA(1, 1, At, B1); PG_BAR; PG_SCHED;
        }
        if (wr == 0) PG_BAR;
        if (cur.type == 0) { EA(acc, cur, wr, wc, fr, fq);
            PG_WAIT_V(0);
            if (lane == 0) __hip_atomic_fetch_add(S.tile_word(cur), 1u, __ATOMIC_RELAXED, __HIP_MEMORY_SCOPE_AGENT); }
        else EB(acc, cur, wr, wc, fr, fq);
        if (!has_next) break;
#pragma unroll
        for (int a = 0; a < 2; ++a)
#pragma unroll
            for (int b = 0; b < 2; ++b)
#pragma unroll
                for (int m = 0; m < 4; ++m)
#pragma unroll
                    for (int n = 0; n < 2; ++n) acc[a][b][m][n] = (f32x4){0.f, 0.f, 0.f, 0.f};
        cur = nxt; cB = nB; cA = nA; hsC = hsN; nt = cur.K / BK; ++ui;
#pragma unroll
        for (int h = 0; h < 2; ++h)
#pragma unroll
            for (int i = 0; i < 2; ++i) voC[h][i] = voN[h][i];
        if (wr == 1) PG_BAR;
    }
    PG_WAIT_V(0);
    PG_BAR;
#undef PG_SA
#undef PG_SB
#undef PG_STAGE
#undef PG_LDA
#undef PG_LDB
#undef PG_MMA
#undef PG_WAIT_V
#undef PG_WAIT_L
#undef PG_BAR
#undef PG_SCHED
}
}
__device__ __forceinline__ void fast_moe_merged(Frame& F, int layer) {
    LAS int* mm = moe_map(F, layer);
    int U = 0;
    for (int e = 0; e < 16; ++e) U += ((mm[e] + 255) >> 8) * 4;
    pg::MoeMergedSched S{(const char*)(F.ws + WS_WGU) + (size_t)layer * 16 * 1024 * 1024 * 2, (const char*)(F.ws + WS_WDN) + (size_t)layer * 16 * 1024 * 512 * 2,
                         (const char*)(F.ws + WS_HB), (const char*)(F.ws + WS_HID), (const int*)(F.ws + WS_SLOTT) + layer * 16 * CAP, (const float*)(F.ws + WS_SLOTW) + layer * 16 * CAP, mm,
                         F.ctl + CW_TILE + layer * 288 * 64, F.ctl + CW_TMO2, F.G, F.wg, U};
    pg::EpiGateUpWT EA{__builtin_amdgcn_make_buffer_rsrc((void*)(F.ws + WS_HID), 0, HROWS * FF * 2, 0x00020000), F.lds, mm};
    pg::EpiDownM EB{(unsigned char*)(F.ws + WS_Y), mm};
    pg::gemm_phase_moe(F.lds, S, EA, EB);
}

constexpr int NPH = 18;
__global__ void __launch_bounds__(NTHR, 2) mega(Args args) {
    extern __shared__ __attribute__((aligned(16))) unsigned char lds[];
    Frame F;
    F.lds = (LAS unsigned char*)lds;
    F.tid = threadIdx.x; F.lane = F.tid & 63; F.wave = __builtin_amdgcn_readfirstlane(F.tid >> 6);
    F.G = gridDim.x; F.wg = blockIdx.x;
    F.out = args.out; F.ws = args.ws; F.ctl = (unsigned*)(args.ws + WS_CTL);
    volatile LAS unsigned* bst = (volatile LAS unsigned*)(F.lds + LDS_BYTES - 16);
    if (F.tid < 4) bst[F.tid] = 0u;
    __syncthreads();
    const int lo = args.ph_lo, hi = args.ph_hi;
    XcdBarrier bar; bar.bar = F.ctl + CW_BAR; bar.x = 0; bar.st = bst;
    if (hi - lo > 1) bar = xcd_barrier_post(F.ctl + CW_BAR, bst);
#define IN(k) (lo <= (k) && (k) < hi)
#define SEAM(k) do { if (IN(k) && IN((k) + 1)) xcd_barrier(bar); } while (0)
    const float* mod = (const float*)(F.ws + WS_MOD);

#ifndef DBL_MASK
#define DBL_MASK 0x0u
#endif
#define RUN(k, body) do { if (IN(k)) { _Pragma("unroll 1") for (int _r = 0; _r < ((((DBL_MASK) >> (k)) & 1u) ? 2 : 1); ++_r) { if (_r) xcd_barrier(bar); F.lane = fresh_lane(); body; } } } while (0)
    RUN(0, phase_prep(F)); SEAM(0);
    RUN(1, phase_norm1_l0(F)); SEAM(1);
    RUN(2, if (FAST_GEMM) fast_inproj(F); else phase_inproj(F)); SEAM(2);
    if (IN(3)) { F.lane = fresh_lane();
#pragma unroll 1
        for (int _r = 0; _r < ((DBL_MASK & 0x100000u) ? 2 : 1); ++_r) { if (FAST_ATTN == 2 && FAST_GEMM) phase_attn_lds(F); else if (FAST_ATTN && FAST_GEMM) phase_attn_mfma(F); else phase_attn_simple(F); }
#pragma unroll 1
        for (int _r = 0; _r < ((DBL_MASK & 0x200000u) ? 2 : 1); ++_r) { if (FAST_FFT) phase_fft1_mfma(F); else phase_fft1_simple(F); }
    } SEAM(3);
    RUN(4, if (FAST_FFT) phase_fft2_mfma(F); else phase_fft2_simple(F)); SEAM(4);
    if (IN(5)) { if (!FAST_FFT) phase_fft3_simple(F); } if (!FAST_FFT) SEAM(5);
    RUN(6, if (FAST_GEMM) fast_outproj(F, WS_MIX, WS_WOUT, F.in[I_X], F.out, mod + 2048, nullptr); else phase_outproj(F, (const bf16*)(F.ws + WS_MIX), (const bf16*)(F.ws + WS_WOUT), F.in[I_X], F.out, mod + 2048, nullptr)); SEAM(6);
    if (IN(7)) { F.lane = fresh_lane(); if (XBF16) phase_norm2_route_mfma(F, 0); else phase_norm2_route(F, 0); } SEAM(7);
    if (MOE_MERGED && FAST_GEMM) { if (IN(8)) { F.lane = fresh_lane(); fast_moe_merged(F, 0); } if (IN(8) && IN(10)) xcd_barrier(bar); }
    else { RUN(8, if (FAST_GEMM) fast_moe_gateup(F, 0); else phase_moe_gateup(F, 0)); SEAM(8);
    RUN(9, if (FAST_GEMM) fast_moe_down(F, 0); else phase_moe_down(F, 0)); SEAM(9); }
    if (IN(10)) { F.lane = fresh_lane(); phase_combine<false>(F, 0); } SEAM(10);
    RUN(11, if (FAST_GEMM) fast_pw1(F); else phase_pw1(F)); SEAM(11);
    RUN(12, phase_dwconv_fast(F)); SEAM(12);
    if (IN(13)) { F.lane = fresh_lane(); if (FAST_GEMM) fast_outproj(F, WS_V1, WS_WPW2, F.out, F.out, mod + 5 * 6144 + 2048, F.in[I_PW2B]); else phase_outproj(F, (const bf16*)(F.ws + WS_V1), (const bf16*)(F.ws + WS_WPW2), F.out, F.out, mod + 5 * 6144 + 2048, F.in[I_PW2B]); } SEAM(13);
    if (IN(14)) { F.lane = fresh_lane(); if (XBF16) phase_norm2_route_mfma(F, 1); else phase_norm2_route(F, 1); } SEAM(14);
    if (MOE_MERGED && FAST_GEMM) { if (IN(15)) { F.lane = fresh_lane(); fast_moe_merged(F, 1); } if (IN(15) && IN(17)) xcd_barrier(bar); }
    else { RUN(15, if (FAST_GEMM) fast_moe_gateup(F, 1); else phase_moe_gateup(F, 1)); SEAM(15);
    RUN(16, if (FAST_GEMM) fast_moe_down(F, 1); else phase_moe_down(F, 1)); SEAM(16); }
    if (IN(17)) { F.lane = fresh_lane(); phase_combine<true>(F, 1); }
#undef RUN
#undef IN
#undef SEAM
}

extern "C" void kernel_launch(void* const* d_in, const int* in_sizes, int n_in, void* d_out, int out_size, void* d_ws, size_t ws_size, hipStream_t stream) {
    static int grid = 0;
    if (grid == 0) {
        if (n_in != 25 || out_size != T * D || ws_size < WS_END) { fprintf(stderr, "kernel_launch: unexpected shapes (n_in %d out %d ws %zu)\n", n_in, out_size, ws_size); grid = -1; return; }
        int dev = 0, cus = 0, per_cu = 0;
        if (hipGetDevice(&dev) != hipSuccess || hipDeviceGetAttribute(&cus, hipDeviceAttributeMultiprocessorCount, dev) != hipSuccess) { grid = -1; return; }
        if (hipFuncSetAttribute((const void*)mega, hipFuncAttributeMaxDynamicSharedMemorySize, LDS_BYTES) != hipSuccess) { fprintf(stderr, "kernel_launch: hipFuncSetAttribute failed\n"); grid = -1; return; }
        if (hipOccupancyMaxActiveBlocksPerMultiprocessor(&per_cu, (const void*)mega, NTHR, LDS_BYTES) != hipSuccess || per_cu < 1) { fprintf(stderr, "kernel_launch: occupancy query says %d\n", per_cu); }
        (void)hipGetLastError();
        grid = cus;
    }
    if (grid < 0) return;
    (void)hipMemsetAsync((char*)d_ws + WS_CTL, 0, CTL_BYTES, stream);
    Args a{};
    for (int i = 0; i < 25; ++i) a.in[i] = (const float*)d_in[i];
    a.out = (float*)d_out; a.ws = (unsigned char*)d_ws;
#if MK_ONE_LAUNCH
    a.ph_lo = 0; a.ph_hi = NPH;
    hipLaunchKernelGGL(mega, dim3(grid), dim3(NTHR), LDS_BYTES, stream, a);
#else
#ifndef PROBE_PHASE
#define PROBE_PHASE -1
#endif
    for (int p = 0; p < NPH; ++p) { a.ph_lo = p; a.ph_hi = p + 1; hipLaunchKernelGGL(mega, dim3(grid), dim3(NTHR), LDS_BYTES, stream, a);
        if (p == PROBE_PHASE) { if (p == 7 || p == 14) (void)hipMemsetAsync((char*)d_ws + WS_CTL, 0, CTL_BYTES, stream);
            hipLaunchKernelGGL(mega, dim3(grid), dim3(NTHR), LDS_BYTES, stream, a); } }
#endif
}
```

```cpp
#include <hip/hip_runtime.h>
#include <cstdio>

#ifndef MK_ONE_LAUNCH
#define MK_ONE_LAUNCH 1
#endif

#define GAS __attribute__((address_space(1)))
#define LAS __attribute__((address_space(3)))
typedef unsigned short bf16;
typedef short bf16x8 __attribute__((ext_vector_type(8)));
typedef float f32x4 __attribute__((ext_vector_type(4)));
typedef float f32x16 __attribute__((ext_vector_type(16)));
typedef unsigned u32x4 __attribute__((ext_vector_type(4)));
typedef unsigned u32x2 __attribute__((ext_vector_type(2)));

constexpr int D = 1024, NB = 4, L = 8192, T = NB * L, CL = 256, TC = NB * CL;
constexpr int NE = 16, FF = 512, CONVW = 31;
constexpr int N_IN = 1280;
constexpr int FN1 = 64, FN2 = 128;
#ifndef FAST_GEMM
#define FAST_GEMM 1
#endif
#ifndef MOE_MERGED
#define MOE_MERGED 1
#endif
#ifndef XBF16
#define XBF16 FAST_GEMM
#endif
#ifndef FAST_ATTN
#define FAST_ATTN 2
#endif
#ifndef FAST_FFT
#define FAST_FFT 1
#endif
constexpr int IL = FAST_GEMM ? 128 : 32;
constexpr float EPS = 1e-6f;
constexpr int NWAVES = 8, NTHR = 512;
constexpr int CAP = 32768;
constexpr int HROWS = 65536 + 4096;

constexpr size_t MiB = 1u << 20;
constexpr size_t WS_CTL = 0, CTL_BYTES = 1 * MiB;
constexpr size_t WS_MOD = 1 * MiB;
constexpr size_t WS_TW = 1 * MiB + 512 * 1024;
constexpr size_t WS_WIN = 2 * MiB, WS_WOUT = 6 * MiB, WS_WPW1 = 10 * MiB, WS_WPW2 = 14 * MiB;
constexpr size_t WS_WGU = 16 * MiB, WS_WDN = 80 * MiB;
constexpr size_t WS_TOKE = 112 * MiB, WS_TOKP = 113 * MiB, WS_TOKW = 114 * MiB;
constexpr size_t WS_SLOTT = 116 * MiB, WS_SLOTW = 120 * MiB;
constexpr size_t WS_HB = 128 * MiB;
constexpr size_t WS_UF = 196 * MiB, WS_Q = 228 * MiB, WS_K = 260 * MiB, WS_V = 268 * MiB, WS_CK = 276 * MiB, WS_CV = 277 * MiB;
constexpr size_t WS_G = 280 * MiB, WS_MIX = 344 * MiB, WS_AB = 408 * MiB;
constexpr size_t WS_XB = 408 * MiB;
constexpr size_t WS_HID = 196 * MiB, WS_Y = 264 * MiB;
constexpr size_t WS_U = 196 * MiB, WS_V1 = 260 * MiB;
constexpr size_t WS_END = 472 * MiB;
constexpr int CW_BAR = 4096;
constexpr int CW_CNT = 8192;
constexpr int CW_TILE = 16384;
constexpr int CW_TMO2 = 2048;

constexpr int LDS_BYTES = 147456;

__device__ __forceinline__ unsigned f2bf(float f) { unsigned u = __float_as_uint(f); return (u + 0x7fffu + ((u >> 16) & 1u)) >> 16; }
__device__ __forceinline__ float bf2f(unsigned b) { return __uint_as_float(b << 16); }
typedef __bf16 b16x2_t __attribute__((ext_vector_type(2)));
__device__ __forceinline__ unsigned pkbf(float a, float b) { typedef float f2 __attribute__((ext_vector_type(2))); f2 v = {a, b}; return __builtin_bit_cast(unsigned, __builtin_convertvector(v, b16x2_t)); }
__device__ __forceinline__ unsigned pk2(float lo, float hi) { return pkbf(lo, hi); }
__device__ __forceinline__ float bflo(unsigned w) { return __uint_as_float(w << 16); }
__device__ __forceinline__ float bfhi(unsigned w) { return __uint_as_float(w & 0xffff0000u); }
__device__ __forceinline__ float wave_sum(float v) {
    v += __builtin_bit_cast(float, __builtin_amdgcn_mov_dpp(__builtin_bit_cast(int, v), 0xB1, 0xf, 0xf, true));
    v += __builtin_bit_cast(float, __builtin_amdgcn_mov_dpp(__builtin_bit_cast(int, v), 0x4E, 0xf, 0xf, true));
    v += __builtin_bit_cast(float, __builtin_amdgcn_mov_dpp(__builtin_bit_cast(int, v), 0x141, 0xf, 0xf, true));
    v += __builtin_bit_cast(float, __builtin_amdgcn_mov_dpp(__builtin_bit_cast(int, v), 0x140, 0xf, 0xf, true));
    const int iv = __builtin_bit_cast(int, v);
    const float a = __builtin_bit_cast(float, __builtin_amdgcn_readlane(iv, 15)), b = __builtin_bit_cast(float, __builtin_amdgcn_readlane(iv, 31));
    const float c = __builtin_bit_cast(float, __builtin_amdgcn_readlane(iv, 47)), d = __builtin_bit_cast(float, __builtin_amdgcn_readlane(iv, 63));
    return (a + b) + (c + d);
}
__device__ __forceinline__ float silu_f(float x) { return x * __builtin_amdgcn_rcpf(1.f + __expf(-x)); }
__device__ __forceinline__ float sigmoid_f(float x) { return __builtin_amdgcn_rcpf(1.f + __expf(-x)); }
constexpr float YSCALE = 32.f;
__device__ __forceinline__ unsigned pk_fp8x4(f32x4 v) {
    int d = __builtin_amdgcn_cvt_pk_fp8_f32(__builtin_amdgcn_fmed3f(v[0] * YSCALE, -448.f, 448.f), __builtin_amdgcn_fmed3f(v[1] * YSCALE, -448.f, 448.f), 0, false);
    d = __builtin_amdgcn_cvt_pk_fp8_f32(__builtin_amdgcn_fmed3f(v[2] * YSCALE, -448.f, 448.f), __builtin_amdgcn_fmed3f(v[3] * YSCALE, -448.f, 448.f), d, true);
    return (unsigned)d;
}
__device__ __forceinline__ f32x4 un_fp8x4(unsigned d) { typedef float f2 __attribute__((ext_vector_type(2)));
    const f2 lo = __builtin_amdgcn_cvt_pk_f32_fp8((int)d, false), hi = __builtin_amdgcn_cvt_pk_f32_fp8((int)d, true); return (f32x4){lo.x, lo.y, hi.x, hi.y}; }
#define LDS_WAIT() asm volatile("s_waitcnt lgkmcnt(0)" ::: "memory")
__device__ __forceinline__ int fresh_lane() { int l; asm volatile("v_mbcnt_lo_u32_b32 %0, -1, 0\n\tv_mbcnt_hi_u32_b32 %0, -1, %0" : "=v"(l)); return l; }

#define XB_TMO      128
#define XB_XCNT(j)  (256  + 64 * (j))
#define XB_XSUB(j)  (1280 + 64 * (j))
#define XB_XGEN(j)  (2304 + 64 * (j))
#define XB_TOP      3328
#define XB_TOPGEN   3392
#define XCD_BAR_WORDS 3456
#define XB_SPIN_CAP (1u << 20)
__device__ __forceinline__ unsigned xb_ld(unsigned* p)              { return __hip_atomic_load(p, __ATOMIC_RELAXED, __HIP_MEMORY_SCOPE_AGENT); }
__device__ __forceinline__ unsigned xb_add(unsigned* p, unsigned v) { return __hip_atomic_fetch_add(p, v, __ATOMIC_RELAXED, __HIP_MEMORY_SCOPE_AGENT); }
__device__ __forceinline__ unsigned xb_xcc_id() { return (unsigned)__builtin_amdgcn_s_getreg((3 << 11) | 20) & 0xFu; }
#define XB_SPIN(cond, bar) do { unsigned _sp = 0; while (cond) { __builtin_amdgcn_s_sleep(1); \
    if ((++_sp & 255u) == 0u) { if (xb_ld(&(bar)[XB_TMO])) break; if (_sp > XB_SPIN_CAP) { atomicAdd(&(bar)[XB_TMO], 1u); break; } } } } while (0)
struct XcdBarrier { unsigned* bar; unsigned x; volatile LAS unsigned* st; };
__device__ __forceinline__ XcdBarrier xcd_barrier_post(unsigned* bar, volatile LAS unsigned* st) {
    XcdBarrier b; b.bar = bar; b.x = xb_xcc_id(); b.st = st;
    if (threadIdx.x == 0) (void)xb_add(&bar[XB_XCNT(b.x)], 1u);
    return b;
}
__device__ __forceinline__ void xcd_barrier_complete(unsigned* bar, unsigned x, unsigned& nloc, unsigned& nx) {
    const unsigned G = gridDim.x * gridDim.y * gridDim.z;
    unsigned sum, cnt, mine, sp = 0u;
    for (;;) {
        sum = 0u; cnt = 0u; mine = 0u;
#pragma unroll
        for (unsigned j = 0; j < 16; ++j) { const unsigned c = xb_ld(&bar[XB_XCNT(j)]); sum += c; cnt += (c > 0u) ? 1u : 0u; mine = (j == x) ? c : mine; }
        if (sum == G) break;
        __builtin_amdgcn_s_sleep(1);
        if ((++sp & 255u) == 0u) { if (xb_ld(&bar[XB_TMO])) break; if (sp > XB_SPIN_CAP) { atomicAdd(&bar[XB_TMO], 1u); break; } }
    }
    nloc = mine > 0u ? mine : 1u; nx = cnt > 0u ? cnt : 1u;
}
__device__ __forceinline__ void xcd_barrier(const XcdBarrier& b) {
    asm volatile("s_waitcnt vmcnt(0)" ::: "memory");
    __syncthreads();
    if (threadIdx.x == 0) {
        unsigned* bar = b.bar;
        __builtin_amdgcn_s_waitcnt(0);
        unsigned nloc = b.st[0], nx = b.st[1];
        if (nloc == 0u) { xcd_barrier_complete(bar, b.x, nloc, nx); b.st[0] = nloc; b.st[1] = nx; }
        const unsigned old = xb_add(&bar[XB_XSUB(b.x)], 1u);
        const unsigned gen = old / nloc;
        if (old + 1u == (gen + 1u) * nloc) {
            __builtin_amdgcn_fence(__ATOMIC_RELEASE, "agent");
            asm volatile("s_waitcnt vmcnt(0)" ::: "memory");
            const unsigned og = xb_add(&bar[XB_TOP], 1u);
            const unsigned tg = og / nx;
            if (og + 1u == (tg + 1u) * nx) xb_add(&bar[XB_TOPGEN], 1u);
            else XB_SPIN(xb_ld(&bar[XB_TOPGEN]) == tg, bar);
            __builtin_amdgcn_fence(__ATOMIC_ACQUIRE, "agent");
            xb_add(&bar[XB_XGEN(b.x)], 1u);
            asm volatile("s_waitcnt vmcnt(0)" ::: "memory");
        } else {
            XB_SPIN(xb_ld(&bar[XB_XGEN(b.x)]) == gen, bar);
            __builtin_amdgcn_fence(__ATOMIC_ACQUIRE, "agent");
            asm volatile("s_waitcnt vmcnt(0)" ::: "memory");
        }
    }
    __syncthreads();
}

struct Args { const float* in[25]; float* out; unsigned char* ws; int ph_lo, ph_hi; };
enum { I_X = 0, I_C, I_CTX, I_CCTX, I_ADAW, I_ADAB, I_NMG, I_NFG, I_WIN, I_WOUT, I_SINK, I_PW1W, I_PW1B, I_DWW, I_DWB, I_LNG, I_LNB,
       I_PW2W, I_PW2B, I_RW, I_RB, I_WG, I_WU, I_WD, I_FNG };

struct InPtrs {
    __device__ __forceinline__ const float* operator[](int i) const { const float* r;
        asm volatile("s_load_dwordx2 %0, %1, %2\n\ts_waitcnt lgkmcnt(0)" : "=s"(r) : "s"(__builtin_amdgcn_kernarg_segment_ptr()), "s"(i * 8)); return r; }
};
struct Frame {
    LAS unsigned char* lds;
    int tid, lane, wave, G, wg;
    InPtrs in;
    float* out;
    unsigned char* ws;
    unsigned* ctl;
};

__device__ __forceinline__ int crow(int i, int h) { return (i & 3) + 8 * (i >> 2) + 4 * h; }
template <class RowPtr, class Epi>
__device__ __forceinline__ void sgemm_tile(const RowPtr& rowptr, const bf16* Bt, int K, int m0, int n0, const Epi& epi, int wave, int lane) {
    const int wm = wave & 3, wn = wave >> 2, r = lane & 31, h = lane >> 5;
    const bf16* ap = rowptr(m0 + wm * 32 + r) + 8 * h;
    const bf16* bp0 = Bt + (size_t)(n0 + wn * 64 + r) * K + 8 * h;
    const bf16* bp1 = bp0 + (size_t)32 * K;
    f32x16 c0, c1;
#pragma unroll
    for (int i = 0; i < 16; ++i) { c0[i] = 0.f; c1[i] = 0.f; }
#pragma unroll 2
    for (int k = 0; k < K; k += 32) {
        const bf16x8 a0 = *(const bf16x8*)(ap + k), a1 = *(const bf16x8*)(ap + k + 16);
        const bf16x8 b00 = *(const bf16x8*)(bp0 + k), b01 = *(const bf16x8*)(bp0 + k + 16);
        const bf16x8 b10 = *(const bf16x8*)(bp1 + k), b11 = *(const bf16x8*)(bp1 + k + 16);
        c0 = __builtin_amdgcn_mfma_f32_32x32x16_bf16(a0, b00, c0, 0, 0, 0);
        c1 = __builtin_amdgcn_mfma_f32_32x32x16_bf16(a0, b10, c1, 0, 0, 0);
        c0 = __builtin_amdgcn_mfma_f32_32x32x16_bf16(a1, b01, c0, 0, 0, 0);
        c1 = __builtin_amdgcn_mfma_f32_32x32x16_bf16(a1, b11, c1, 0, 0, 0);
    }
    epi(m0 + wm * 32, n0 + wn * 64, c0, c1, lane);
}

__device__ __forceinline__ void p0_transpose_item(const float* W, int K, int N, bf16* WT, int k0, int n0, int drow0, LAS float* scr, int lane) {
#pragma unroll 8
    for (int i = 0; i < 32; ++i) { const int kk = 2 * i + (lane >> 5); scr[kk * 33 + (lane & 31)] = W[(size_t)(k0 + kk) * N + n0 + (lane & 31)]; }
    LDS_WAIT(); asm volatile("" ::: "memory");
    const int c = lane & 7;
#pragma unroll
    for (int j = 0; j < 4; ++j) { const int n = (lane >> 3) + 8 * j; const LAS float* s = scr + (8 * c) * 33 + n;
        u32x4 o; o.x = pk2(s[0 * 33], s[1 * 33]); o.y = pk2(s[2 * 33], s[3 * 33]); o.z = pk2(s[4 * 33], s[5 * 33]); o.w = pk2(s[6 * 33], s[7 * 33]);
        *(u32x4*)(WT + (size_t)(drow0 + n) * K + k0 + 8 * c) = o; }
    LDS_WAIT(); asm volatile("" ::: "memory");
}
__device__ __forceinline__ int il_row(int j, int half) { return (j / IL) * (2 * IL) + half * IL + (j % IL); }

constexpr int T_NITEMS = 640 + 512 + 1024 + 512 + 3 * 32 * 256, T_DEFER_ATT = 10 * 2048;
struct TItem { const float* W; bf16* WT; int K, N, k0, n0, drow0; bool ok; };
__device__ __forceinline__ TItem t_decode(const Frame& F, int it) {
    constexpr int S0 = 640, S1 = 512, S2 = 1024, S3 = 512, SM = 32 * 256;
    TItem t; t.ok = it < S0 + S1 + S2 + S3 + 3 * SM; t.W = F.in[I_WIN]; t.WT = (bf16*)(F.ws + WS_WIN); t.K = 1024; t.N = 1280; t.k0 = 0; t.n0 = 0; t.drow0 = 0;
    int r = it;
    if (r < S0) { const int kb = r / 40, nb = r % 40; t.k0 = kb * 64; t.n0 = nb * 32; t.drow0 = nb * 32; return t; } r -= S0;
    if (r < S1) { const int kb = r / 32, nb = r % 32; t.W = F.in[I_WOUT]; t.WT = (bf16*)(F.ws + WS_WOUT); t.N = 1024; t.k0 = kb * 64; t.n0 = nb * 32; t.drow0 = nb * 32; return t; } r -= S1;
    if (r < S2) { const int kb = r / 64, nb = r % 64, n0 = nb * 32; t.W = F.in[I_PW1W]; t.WT = (bf16*)(F.ws + WS_WPW1); t.N = 2048; t.k0 = kb * 64; t.n0 = n0; t.drow0 = il_row(n0 & 1023, n0 >> 10); return t; } r -= S2;
    if (r < S3) { const int kb = r / 32, nb = r % 32; t.W = F.in[I_PW2W]; t.WT = (bf16*)(F.ws + WS_WPW2); t.N = 1024; t.k0 = kb * 64; t.n0 = nb * 32; t.drow0 = nb * 32; return t; } r -= S3;
    if (r < SM) { const int le = r >> 8, q = r & 255, kb = q / 16, nb = q % 16; t.W = F.in[I_WG] + (size_t)le * 1024 * 512; t.WT = (bf16*)(F.ws + WS_WGU) + (size_t)le * 1024 * 1024; t.N = 512; t.k0 = kb * 64; t.n0 = nb * 32; t.drow0 = il_row(nb * 32, 0); return t; } r -= SM;
    if (r < SM) { const int le = r >> 8, q = r & 255, kb = q / 16, nb = q % 16; t.W = F.in[I_WU] + (size_t)le * 1024 * 512; t.WT = (bf16*)(F.ws + WS_WGU) + (size_t)le * 1024 * 1024; t.N = 512; t.k0 = kb * 64; t.n0 = nb * 32; t.drow0 = il_row(nb * 32, 1); return t; } r -= SM;
    { const int le = (r >> 8) & 31, q = r & 255, kb = q / 32, nb = q % 32; t.W = F.in[I_WD] + (size_t)le * 512 * 1024; t.WT = (bf16*)(F.ws + WS_WDN) + (size_t)le * 1024 * 512; t.K = 512; t.N = 1024; t.k0 = kb * 64; t.n0 = nb * 32; t.drow0 = nb * 32; }
    return t;
}
__device__ __forceinline__ void t_load(const TItem& t, int lane, float (&v)[32]) {
    if (t.ok) {
#pragma unroll
        for (int i = 0; i < 32; ++i) v[i] = t.W[(size_t)(t.k0 + 2 * i + (lane >> 5)) * t.N + t.n0 + (lane & 31)];
    }
}
__device__ __forceinline__ void t_store(const TItem& t, LAS float* scr, int lane, const float (&v)[32]) {
#pragma unroll
    for (int i = 0; i < 32; ++i) scr[(2 * i + (lane >> 5)) * 33 + (lane & 31)] = v[i];
    LDS_WAIT(); asm volatile("" ::: "memory");
    const int c = lane & 7;
#pragma unroll
    for (int j = 0; j < 4; ++j) { const int n = (lane >> 3) + 8 * j; const LAS float* s = scr + (8 * c) * 33 + n;
        u32x4 o; o.x = pk2(s[0 * 33], s[1 * 33]); o.y = pk2(s[2 * 33], s[3 * 33]); o.z = pk2(s[4 * 33], s[5 * 33]); o.w = pk2(s[6 * 33], s[7 * 33]);
        *(u32x4*)(t.WT + (size_t)(t.drow0 + n) * t.K + t.k0 + 8 * c) = o; }
    LDS_WAIT(); asm volatile("" ::: "memory");
}
__device__ __forceinline__ void t_dma(const TItem& t, LAS unsigned char* scr, int lane) {
    if (t.ok) {
#pragma unroll
        for (int i = 0; i < 8; ++i)
            __builtin_amdgcn_global_load_lds((const unsigned*)(t.W + (size_t)(t.k0 + 8 * i + (lane >> 3)) * t.N + t.n0 + 4 * (lane & 7)), (LAS unsigned*)(scr + 1056 * i), 16, 0, 0);
    }
}
__device__ __forceinline__ void t_store_dma(const TItem& t, const LAS float* scr, int lane) {
    const int c = lane & 7;
#pragma unroll 1
    for (int j = 0; j < 4; ++j) { const int n = (lane >> 3) + 8 * j; float e[8];
#pragma unroll
        for (int q = 0; q < 8; ++q) e[q] = scr[264 * c + 32 * q + n];
        { u32x4 o; o.x = pk2(e[0], e[1]); o.y = pk2(e[2], e[3]); o.z = pk2(e[4], e[5]); o.w = pk2(e[6], e[7]); *(u32x4*)(t.WT + (size_t)(t.drow0 + n) * t.K + t.k0 + 8 * c) = o; } }
    LDS_WAIT(); asm volatile("" ::: "memory");
}
__device__ __forceinline__ void t_items_tail(Frame& F, int r, int nw) {
    LAS float* scr = (LAS float*)(F.lds + F.wave * 8704);
    TItem cur = t_decode(F, 640 + T_DEFER_ATT + r); float va[32], vb[32];
    t_load(cur, F.lane, va);
#pragma unroll 1
    for (int it = r; cur.ok; it += nw) {
        const TItem nxt = t_decode(F, 640 + T_DEFER_ATT + it + nw);
        t_load(nxt, F.lane, vb);
        t_store(cur, scr, F.lane, va);
#pragma unroll
        for (int i = 0; i < 32; ++i) va[i] = vb[i];
        cur = nxt;
    }
}
__device__ __forceinline__ void phase_prep(Frame& F) {
    {
        LAS float* sc = (LAS float*)F.lds;
        LAS float* red = sc + 5 * 1024;
        bool loaded = false;
        for (int it = F.wg; it < 192; it += F.G) {
            if (!loaded) {
                for (int i = F.tid; i < 5 * 1024; i += NTHR) { const int b = i >> 10, k = i & 1023; const float v = b < 4 ? F.in[I_C][b * 1024 + k] : F.in[I_CCTX][k]; sc[i] = silu_f(v); }
                __syncthreads(); loaded = true;
            }
            const int l = it / 96, n0 = (it % 96) * 64, c4 = F.tid & 15, kg = F.tid >> 4;
            const float* w = F.in[I_ADAW] + (size_t)l * 1024 * 6144 + n0 + 4 * c4;
            f32x4 a[5];
#pragma unroll
            for (int b = 0; b < 5; ++b) a[b] = (f32x4){0.f, 0.f, 0.f, 0.f};
#pragma unroll 16
            for (int kk = 0; kk < 32; ++kk) { const int k = kg * 32 + kk; const f32x4 wv = *(const f32x4*)(w + (size_t)k * 6144);
#pragma unroll
                for (int b = 0; b < 5; ++b) a[b] += sc[b * 1024 + k] * wv; }
#pragma unroll
            for (int b = 0; b < 5; ++b) *(LAS f32x4*)(red + (kg * 5 + b) * 64 + 4 * c4) = a[b];
            __syncthreads();
            if (F.tid < 320) { const int b = F.tid >> 6, c2 = F.tid & 63; float sm = 0.f;
#pragma unroll
                for (int g = 0; g < 32; ++g) sm += red[(g * 5 + b) * 64 + c2];
                ((float*)(F.ws + WS_MOD))[((size_t)l * 5 + b) * 6144 + n0 + c2] = sm + F.in[I_ADAB][l * 6144 + n0 + c2]; }
            __syncthreads();
        }
        __syncthreads();
    }
    { u32x4* z = (u32x4*)(F.ws + WS_SLOTT); const u32x4 zero = {0u, 0u, 0u, 0u};
      for (int i = F.wg * NTHR + F.tid; i < 2 * 16 * CAP / 4; i += F.G * NTHR) z[i] = zero; }
    { float* tw = (float*)(F.ws + WS_TW);
      for (int k = F.wg * NTHR + F.tid; k < 8192; k += F.G * NTHR) { const float a = (float)k * (6.283185307179586f / 8192.f); tw[2 * k] = __cosf(a); tw[2 * k + 1] = __sinf(a); } }
    {
        LAS float* scr = (LAS float*)(F.lds + F.wave * 8704);
        const int gw = F.wg * NWAVES + F.wave, NGW = F.G * NWAVES;
        auto vmap = [](int v) { return v < 640 ? v : (1 << 30); };
        TItem cur = t_decode(F, vmap(gw)); float va[32], vb[32];
        t_load(cur, F.lane, va);
#pragma unroll 1
        for (int it = gw; cur.ok; it += NGW) {
            const TItem nxt = t_decode(F, vmap(it + NGW));
            t_load(nxt, F.lane, vb);
            t_store(cur, scr, F.lane, va);
#pragma unroll
            for (int i = 0; i < 32; ++i) va[i] = vb[i];
            cur = nxt;
        }
    }
}

#define ROFF(lane, j) (512 * ((j) >> 1) + 8 * (lane) + 4 * ((j) & 1))
__device__ __forceinline__ void row_load(const float* p, int lane, f32x4 (&v)[4]) {
#pragma unroll
    for (int j = 0; j < 4; ++j) v[j] = *(const f32x4*)(p + ROFF(lane, j));
}
__device__ __forceinline__ void row_load_bf(const bf16* p, int lane, f32x4 (&v)[4]) {
#pragma unroll
    for (int jj = 0; jj < 2; ++jj) { const u32x4 w = *(const u32x4*)(p + 512 * jj + 8 * lane); v[2 * jj] = (f32x4){bflo(w.x), bfhi(w.x), bflo(w.y), bfhi(w.y)}; v[2 * jj + 1] = (f32x4){bflo(w.z), bfhi(w.z), bflo(w.w), bfhi(w.w)}; }
}
__device__ __forceinline__ void xrow_load(const float* xf, const bf16* xb, size_t row, int lane, f32x4 (&v)[4]) { if (XBF16) row_load_bf(xb + row * D, lane, v); else row_load(xf + row * D, lane, v); }
__device__ __forceinline__ float row_sumsq(const f32x4 (&v)[4]) {
    float s = 0.f;
#pragma unroll
    for (int j = 0; j < 4; ++j) s += (v[j].x * v[j].x + v[j].y * v[j].y) + (v[j].z * v[j].z + v[j].w * v[j].w);
    return wave_sum(s);
}
__device__ __forceinline__ void row_modulate(f32x4 (&v)[4], float rstd, const float* g, const float* sh, const float* sc, int lane) {
#pragma unroll
    for (int j = 0; j < 4; ++j) { const int o = ROFF(lane, j); const f32x4 gg = *(const f32x4*)(g + o), s1 = *(const f32x4*)(sc + o), s0 = *(const f32x4*)(sh + o);
        v[j] = v[j] * rstd * gg * (1.f + s1) + s0; }
}
__device__ __forceinline__ void row_store_bf16(bf16* dst, const f32x4 (&v)[4], int lane) {
#pragma unroll
    for (int jj = 0; jj < 2; ++jj) { u32x4 w; w.x = pk2(v[2 * jj].x, v[2 * jj].y); w.y = pk2(v[2 * jj].z, v[2 * jj].w); w.z = pk2(v[2 * jj + 1].x, v[2 * jj + 1].y); w.w = pk2(v[2 * jj + 1].z, v[2 * jj + 1].w); *(u32x4*)(dst + 512 * jj + 8 * lane) = w; }
}

__device__ __forceinline__ void phase_norm1_l0(Frame& F) {
    const int gw = F.wg * NWAVES + F.wave, NGW = F.G * NWAVES;
    const float* mod = (const float*)(F.ws + WS_MOD);
    bf16* HB = (bf16*)(F.ws + WS_HB);
    for (int row = gw; row < T + TC; row += NGW) {
        const float* src = row < T ? F.in[I_X] + (size_t)row * D : F.in[I_CTX] + (size_t)(row - T) * D;
        const int b = row < T ? (row >> 13) : 4;
        f32x4 v[4]; row_load(src, F.lane, v);
        const float rstd = rsqrtf(row_sumsq(v) * (1.f / D) + EPS);
        const float* m = mod + (size_t)b * 6144;
        row_modulate(v, rstd, F.in[I_NMG], m, m + 1024, F.lane);
        row_store_bf16(HB + (size_t)row * D, v, F.lane);
    }
}

struct RowLin { const bf16* base; size_t pitch; __device__ __forceinline__ const bf16* operator()(int m) const { return base + (size_t)m * pitch; } };

__device__ __forceinline__ void inproj_block(Frame& F, int mb, int nbk, const f32x16& c, int lane) {
    const int h = lane >> 5, cl = lane & 31;
    bf16* dst; int pitch, cbase; bool rope = false; bool isctx = (mb >= T);
    if (nbk < 512) { dst = (bf16*)(F.ws + WS_UF); pitch = 512; cbase = 0; }
    else if (nbk < 1024) { dst = (bf16*)(F.ws + WS_Q); pitch = 512; cbase = 512; rope = true; }
    else if (nbk < 1152) { dst = isctx ? (bf16*)(F.ws + WS_CK) : (bf16*)(F.ws + WS_K); pitch = 128; cbase = 1024; rope = !isctx; }
    else { dst = isctx ? (bf16*)(F.ws + WS_CV) : (bf16*)(F.ws + WS_V); pitch = 128; cbase = 1152; }
    const int rbase = isctx ? mb - T : mb;
    const int col = nbk - cbase + cl;
    const float inv = exp2f(-(float)(cl & 15) * (13.287712379549449f / 16.f));
    const bool second = (cl & 16) != 0; const bool bycol = ((nbk >> 5) & 1) != 0;
#pragma unroll
    for (int i = 0; i < 16; ++i) {
        const int rr = crow(i, h); float v = c[i];
        if (rope) {
            const float partner = __shfl_xor(v, 16);
            const int l = (mb + rr) & (L - 1);
            const float pos = (float)(bycol ? (l & 63) : (l >> 6));
            const float ang = pos * inv, cs = __cosf(ang), sn = __sinf(ang);
            v = second ? (partner * sn + v * cs) : (v * cs - partner * sn);
        }
        dst[(size_t)(rbase + rr) * pitch + col] = (bf16)f2bf(v);
    }
}
__device__ __forceinline__ void phase_inproj(Frame& F) {
    const bf16* HB = (const bf16*)(F.ws + WS_HB); const bf16* Wt = (const bf16*)(F.ws + WS_WIN);
    constexpr int MT = (T + TC) / 128, NT = N_IN / 128;
    RowLin rp{HB, (size_t)D};
    for (int u = F.wg; u < MT * NT; u += F.G) {
        const int mt = u / NT, nt = u % NT;
        if (mt >= T / 128 && nt < 8) continue;
        auto epi = [&](int mb, int nb, const f32x16& c0, const f32x16& c1, int lane) { inproj_block(F, mb, nb, c0, lane); inproj_block(F, mb, nb + 32, c1, lane); };
        sgemm_tile(rp, Wt, D, mt * 128, nt * 128, epi, F.wave, F.lane);
    }
}

__device__ __forceinline__ void attn_key(const bf16* kp, const bf16* vp, const float (&q)[64], float& m, float& s, float (&o)[64]) {
    float dot = 0.f;
#pragma unroll
    for (int j = 0; j < 8; ++j) { const u32x4 w = *(const u32x4*)(kp + 8 * j);
        dot += q[8 * j + 0] * bflo(w.x) + q[8 * j + 1] * bfhi(w.x) + q[8 * j + 2] * bflo(w.y) + q[8 * j + 3] * bfhi(w.y)
             + q[8 * j + 4] * bflo(w.z) + q[8 * j + 5] * bfhi(w.z) + q[8 * j + 6] * bflo(w.w) + q[8 * j + 7] * bfhi(w.w); }
    const float mn = fmaxf(m, dot), alpha = __expf(m - mn), p = __expf(dot - mn);
    s = s * alpha + p; m = mn;
#pragma unroll
    for (int j = 0; j < 8; ++j) { const u32x4 w = *(const u32x4*)(vp + 8 * j);
        o[8 * j + 0] = o[8 * j + 0] * alpha + p * bflo(w.x); o[8 * j + 1] = o[8 * j + 1] * alpha + p * bfhi(w.x);
        o[8 * j + 2] = o[8 * j + 2] * alpha + p * bflo(w.y); o[8 * j + 3] = o[8 * j + 3] * alpha + p * bfhi(w.y);
        o[8 * j + 4] = o[8 * j + 4] * alpha + p * bflo(w.z); o[8 * j + 5] = o[8 * j + 5] * alpha + p * bfhi(w.z);
        o[8 * j + 6] = o[8 * j + 6] * alpha + p * bflo(w.w); o[8 * j + 7] = o[8 * j + 7] * alpha + p * bfhi(w.w); }
}
__device__ __forceinline__ void phase_attn_simple(Frame& F) {
    const bf16* Q = (const bf16*)(F.ws + WS_Q); const bf16* Kb = (const bf16*)(F.ws + WS_K); const bf16* Vb = (const bf16*)(F.ws + WS_V);
    const bf16* CK = (const bf16*)(F.ws + WS_CK); const bf16* CV = (const bf16*)(F.ws + WS_CV); bf16* MIX = (bf16*)(F.ws + WS_MIX);
    for (int idx = F.wg * NTHR + F.tid; idx < T * 8; idx += F.G * NTHR) {
        const int hd = idx / T, t = idx % T, b = t >> 13, l = t & (L - 1), kvh = hd >> 2;
        float q[64], o[64];
#pragma unroll
        for (int j = 0; j < 8; ++j) { const u32x4 w = *(const u32x4*)(Q + (size_t)t * 512 + hd * 64 + 8 * j);
            q[8 * j + 0] = bflo(w.x) * 0.125f; q[8 * j + 1] = bfhi(w.x) * 0.125f; q[8 * j + 2] = bflo(w.y) * 0.125f; q[8 * j + 3] = bfhi(w.y) * 0.125f;
            q[8 * j + 4] = bflo(w.z) * 0.125f; q[8 * j + 5] = bfhi(w.z) * 0.125f; q[8 * j + 6] = bflo(w.w) * 0.125f; q[8 * j + 7] = bfhi(w.w) * 0.125f; }
#pragma unroll
        for (int j = 0; j < 64; ++j) o[j] = 0.f;
        float m = F.in[I_SINK][hd], s = 1.f;
        for (int c = 0; c < CL; ++c) { const size_t r = (size_t)(b * CL + c) * 128 + kvh * 64; attn_key(CK + r, CV + r, q, m, s, o); }
        const int lo = l - 128 < 0 ? 0 : l - 128, hi = l + 128 > L - 1 ? L - 1 : l + 128;
        for (int kp = lo; kp <= hi; ++kp) { const size_t r = (size_t)(b * L + kp) * 128 + kvh * 64; attn_key(Kb + r, Vb + r, q, m, s, o); }
        const float is = 1.f / s;
#pragma unroll
        for (int j = 0; j < 8; ++j) { u32x4 w; w.x = pk2(o[8 * j] * is, o[8 * j + 1] * is); w.y = pk2(o[8 * j + 2] * is, o[8 * j + 3] * is); w.z = pk2(o[8 * j + 4] * is, o[8 * j + 5] * is); w.w = pk2(o[8 * j + 6] * is, o[8 * j + 7] * is);
            *(u32x4*)(MIX + (size_t)t * 1024 + 512 + hd * 64 + 8 * j) = w; }
    }
}

__device__ __forceinline__ void phase_fft1_simple(Frame& F) {
    const bf16* UF = (const bf16*)(F.ws + WS_UF); bf16* Gb = (bf16*)(F.ws + WS_G); const float* tw = (const float*)(F.ws + WS_TW);
    for (int idx = F.wg * NTHR + F.tid; idx < NB * FN1 * FN2 * 512; idx += F.G * NTHR) {
        const int ch = idx & 511, bp = (idx >> 9) & 127, c = (idx >> 16) & 63, b = idx >> 22;
        float re = 0.f, im = 0.f;
        for (int a = 0; a < FN1; ++a) { const float u = bf2f(UF[(size_t)(b * L + 128 * a + bp) * 512 + ch]); const int k = ((a * c) & 63) * 128;
            re += u * tw[2 * k]; im -= u * tw[2 * k + 1]; }
        const int k2 = bp * c; const float cs = tw[2 * k2], sn = tw[2 * k2 + 1];
        const float gr = re * cs + im * sn, gi = im * cs - re * sn;
        const size_t row = (size_t)(b * FN1 + c) * FN2 + bp;
        Gb[row * 1024 + ch] = (bf16)f2bf(gr); Gb[row * 1024 + 512 + ch] = (bf16)f2bf(gi);
    }
}
__device__ __forceinline__ void phase_fft2_simple(Frame& F) {
    const bf16* Gb = (const bf16*)(F.ws + WS_G); bf16* AB = (bf16*)(F.ws + WS_AB); const float* tw = (const float*)(F.ws + WS_TW);
    for (int idx = F.wg * NTHR + F.tid; idx < NB * FN1 * FN2 * 512; idx += F.G * NTHR) {
        const int ch = idx & 511, d = (idx >> 9) & 127, c = (idx >> 16) & 63, b = idx >> 22;
        float fr = 0.f, fi = 0.f;
        for (int bp = 0; bp < FN2; ++bp) { const size_t row = (size_t)(b * FN1 + c) * FN2 + bp; const float gr = bf2f(Gb[row * 1024 + ch]), gi = bf2f(Gb[row * 1024 + 512 + ch]);
            const int k = ((bp * d) & 127) * 64; const float cs = tw[2 * k], sn = tw[2 * k + 1];
            fr += gr * cs + gi * sn; fi += gi * cs - gr * sn; }
        const size_t t = (size_t)b * L + c + 64 * d;
        AB[t * 1024 + ch] = (bf16)f2bf(fr); AB[t * 1024 + 512 + ch] = (bf16)f2bf(-fi);
    }
}
__device__ __forceinline__ void phase_fft3_simple(Frame& F) {
    const bf16* AB = (const bf16*)(F.ws + WS_AB); bf16* MIX = (bf16*)(F.ws + WS_MIX); const float* tw = (const float*)(F.ws + WS_TW);
    LAS float* t128 = (LAS float*)F.lds;
    for (int i = F.tid; i < 128; i += NTHR) { t128[2 * i] = tw[2 * (i * 64)]; t128[2 * i + 1] = tw[2 * (i * 64) + 1]; }
    __syncthreads();
    for (int idx = F.wg * NTHR + F.tid; idx < T * 512; idx += F.G * NTHR) {
        const int cp = idx & 127, g = (idx >> 7) & 3, t = idx >> 9;
        const bf16* arow = AB + (size_t)t * 1024 + g * 128;
        float y = 0.f;
        for (int cc = 0; cc < 128; ++cc) { const int k = (cc * cp) & 127; y += bf2f(arow[cc]) * t128[2 * k] - bf2f(arow[512 + cc]) * t128[2 * k + 1]; }
        MIX[(size_t)t * 1024 + g * 128 + cp] = (bf16)f2bf(y * (1.f / 1024.f));
    }
    __syncthreads();
}

__device__ __forceinline__ void phase_outproj(Frame& F, const bf16* A, const bf16* Wt, const float* base, float* X, const float* gate  , const float* bias) {
    RowLin rp{A, (size_t)D};
    for (int u = F.wg; u < (T / 128) * 8; u += F.G) {
        const int mt = u / 8, nt = u % 8;
        auto epi = [&](int mb, int nb, const f32x16& c0, const f32x16& c1, int lane) {
            const int h = lane >> 5, cl = lane & 31, b = mb >> 13;
#pragma unroll
            for (int half = 0; half < 2; ++half) { const int col = nb + 32 * half + cl; const float gv = gate[(size_t)b * 6144 + col], bv = bias ? bias[col] : 0.f;
#pragma unroll
                for (int i = 0; i < 16; ++i) { const size_t o = (size_t)(mb + crow(i, h)) * D + col; const float a = half ? c1[i] : c0[i]; X[o] = base[o] + gv * (a + bv); } }
        };
        sgemm_tile(rp, Wt, D, mt * 128, nt * 128, epi, F.wave, F.lane);
    }
}

__device__ __forceinline__ void route_select(const float (&lg)[16], const float* rb, int& be1, int& be2, float& w1, float& w2) {
    float best = -1e30f; float bs1 = 0.f, bs2 = 0.f; be1 = 0; be2 = 0;
#pragma unroll
    for (int g = 0; g < 4; ++g) {
        float v1 = -1e30f, v2 = -1e30f, s1 = 0.f, s2 = 0.f; int j1 = 0, j2 = 0;
#pragma unroll
        for (int q = 0; q < 4; ++q) { const float sc = sigmoid_f(lg[4 * g + q]), x = sc + rb[4 * g + q];
            if (x > v1) { v2 = v1; j2 = j1; s2 = s1; v1 = x; j1 = q; s1 = sc; } else if (x > v2) { v2 = x; j2 = q; s2 = sc; } }
        const float gs = v1 + v2;
        if (gs > best) { best = gs; be1 = 4 * g + j1; be2 = 4 * g + j2; bs1 = s1; bs2 = s2; }
    }
    const float inv = 1.f / (bs1 + bs2); w1 = bs1 * inv; w2 = bs2 * inv;
}
__device__ __forceinline__ void phase_norm2_route(Frame& F, int layer) {
    const float* mod = (const float*)(F.ws + WS_MOD) + (size_t)layer * 5 * 6144;
    const float* X = F.out; const bf16* XB = (const bf16*)(F.ws + WS_XB); bf16* HB = (bf16*)(F.ws + WS_HB);
    const float* rw = F.in[I_RW]; const float* rb = F.in[I_RB];
    int* tok_e = (int*)(F.ws + WS_TOKE); int* tok_p = (int*)(F.ws + WS_TOKP); float* tok_w = (float*)(F.ws + WS_TOKW);
    int* slot_t = (int*)(F.ws + WS_SLOTT) + layer * 16 * CAP;
    float* slot_w = (float*)(F.ws + WS_SLOTW) + layer * 16 * CAP;
    unsigned* cnt = F.ctl + CW_CNT + layer * 16 * 64;
    LAS float* rwt = (LAS float*)F.lds;
    LAS int* sel_e = (LAS int*)(F.lds + 65536);
    LAS float* sel_w = (LAS float*)(F.lds + 65536 + 1024);
    LAS int* wcnt = (LAS int*)(F.lds + 65536 + 2048);
    LAS int* ebase = wcnt + 64;
    __syncthreads();
    for (int t = F.tid; t < 4096; t += NTHR) { const int i = t >> 2, e4 = t & 3; const f32x4 w = *(const f32x4*)(rw + (size_t)i * 16 + 4 * e4);
        const int p = (i & 512) + 256 * ((i >> 2) & 1) + 4 * ((i >> 3) & 63) + (i & 3);
        rwt[(4 * e4 + 0) * 1024 + p] = w.x; rwt[(4 * e4 + 1) * 1024 + p] = w.y; rwt[(4 * e4 + 2) * 1024 + p] = w.z; rwt[(4 * e4 + 3) * 1024 + p] = w.w; }
    __syncthreads();
    for (int rb0 = F.wg; rb0 < T / 128; rb0 += F.G) {
        const int b = (rb0 * 128) >> 13;
        f32x4 gm[4], sh[4];
        { const float* m = mod + (size_t)b * 6144; const float* g = F.in[I_NFG] + layer * D;
#pragma unroll
          for (int jj = 0; jj < 4; ++jj) { const int o = ROFF(F.lane, jj); gm[jj] = *(const f32x4*)(g + o) * (1.f + *(const f32x4*)(m + 4096 + o)); sh[jj] = *(const f32x4*)(m + 3072 + o); } }
        const int rbase = rb0 * 128 + F.wave * 16;
        f32x4 v0[4], v1[4]; xrow_load(X, XB, (size_t)rbase, F.lane, v0); xrow_load(X, XB, (size_t)(rbase + 1), F.lane, v1);
#pragma unroll 1
        for (int j = 0; j < 16; j += 2) {
            const int lr = F.wave * 16 + j, row = rbase + j;
            f32x4 n0[4], n1[4];
            { const int nr = (j + 2 < 16) ? row + 2 : row; xrow_load(X, XB, (size_t)nr, F.lane, n0); xrow_load(X, XB, (size_t)(nr + 1), F.lane, n1); }
            const float rstd0 = rsqrtf(row_sumsq(v0) * (1.f / D) + EPS), rstd1 = rsqrtf(row_sumsq(v1) * (1.f / D) + EPS);
#pragma unroll
            for (int jj = 0; jj < 4; ++jj) { v0[jj] = v0[jj] * rstd0 * gm[jj] + sh[jj]; v1[jj] = v1[jj] * rstd1 * gm[jj] + sh[jj]; }
            row_store_bf16(HB + (size_t)row * D, v0, F.lane); row_store_bf16(HB + (size_t)(row + 1) * D, v1, F.lane);
            float lg0[16], lg1[16];
#pragma unroll
            for (int e = 0; e < 16; ++e) { float a0 = 0.f, a1 = 0.f;
#pragma unroll
                for (int jj = 0; jj < 4; ++jj) { const f32x4 w4 = *(const LAS f32x4*)(rwt + e * 1024 + 256 * jj + 4 * F.lane);
                    a0 += (v0[jj].x * w4.x + v0[jj].y * w4.y) + (v0[jj].z * w4.z + v0[jj].w * w4.w); a1 += (v1[jj].x * w4.x + v1[jj].y * w4.y) + (v1[jj].z * w4.z + v1[jj].w * w4.w); }
                lg0[e] = a0; lg1[e] = a1; }
#pragma unroll
            for (int e = 0; e < 16; ++e) { lg0[e] = wave_sum(lg0[e]); lg1[e] = wave_sum(lg1[e]); }
            int e1, e2; float w1, w2;
            route_select(lg0, rb, e1, e2, w1, w2);
            if (F.lane == 0) { sel_e[2 * lr] = e1; sel_e[2 * lr + 1] = e2; sel_w[2 * lr] = w1; sel_w[2 * lr + 1] = w2; }
            route_select(lg1, rb, e1, e2, w1, w2);
            if (F.lane == 0) { sel_e[2 * lr + 2] = e1; sel_e[2 * lr + 3] = e2; sel_w[2 * lr + 2] = w1; sel_w[2 * lr + 3] = w2; }
#pragma unroll
            for (int jj = 0; jj < 4; ++jj) { v0[jj] = n0[jj]; v1[jj] = n1[jj]; }
        }
        __syncthreads();
        int my_e = 0, my_rank = 0; float my_w = 0.f;
        if (F.tid < 256) { my_e = sel_e[F.tid]; my_w = sel_w[F.tid];
            const unsigned long long below = (1ull << F.lane) - 1ull;
#pragma unroll 1
            for (int ee = 0; ee < 16; ++ee) { const unsigned long long mk = __ballot(my_e == ee);
                if (my_e == ee) my_rank = __popcll(mk & below);
                if (F.lane == 0) wcnt[F.wave * 16 + ee] = __popcll(mk); } }
        __syncthreads();
        if (F.tid < 16) { const int n = wcnt[F.tid] + wcnt[16 + F.tid] + wcnt[32 + F.tid] + wcnt[48 + F.tid];
            ebase[F.tid] = n ? (int)atomicAdd(cnt + F.tid * 64, (unsigned)n) : 0; }
        __syncthreads();
        if (F.tid < 256) { int pos = ebase[my_e] + my_rank;
            for (int w = 0; w < F.wave; ++w) pos += wcnt[w * 16 + my_e];
            const int tok = rb0 * 128 + (F.tid >> 1), k = F.tid & 1;
            slot_t[my_e * CAP + pos] = tok; slot_w[my_e * CAP + pos] = my_w; tok_e[2 * tok + k] = my_e; tok_p[2 * tok + k] = pos; tok_w[2 * tok + k] = my_w; }
        __syncthreads();
    }
}


__device__ __forceinline__ void phase_norm2_route_mfma(Frame& F, int layer) {
    constexpr int AP = 1032;
    const float* mod = (const float*)(F.ws + WS_MOD) + (size_t)layer * 5 * 6144;
    const bf16* XB = (const bf16*)(F.ws + WS_XB); bf16* HB = (bf16*)(F.ws + WS_HB);
    const float* rw = F.in[I_RW]; const float* rb = F.in[I_RB]; const float* gsrc = F.in[I_NFG] + layer * D;
    int* tok_e = (int*)(F.ws + WS_TOKE); int* tok_p = (int*)(F.ws + WS_TOKP); float* tok_w = (float*)(F.ws + WS_TOKW);
    int* slot_t = (int*)(F.ws + WS_SLOTT) + layer * 16 * CAP;
    float* slot_w = (float*)(F.ws + WS_SLOTW) + layer * 16 * CAP;
    unsigned* cnt = F.ctl + CW_CNT + layer * 16 * 64;
    LAS bf16* AH = (LAS bf16*)F.lds; LAS bf16* AL = AH + 16 * AP;
    LAS float* cbv = (LAS float*)(F.lds + 2 * 16 * AP * 2);
    LAS float* rstdv = cbv + 16;
    LAS float* lgt = rstdv + 128;
    LAS int* sel_e = (LAS int*)(lgt + 128 * 16);
    LAS float* sel_w = (LAS float*)(sel_e + 256);
    LAS int* wcnt = (LAS int*)(sel_w + 256);
    LAS int* ebase = wcnt + 64;
    LAS float* cpart = (LAS float*)(ebase + 16);
    for (int rb0 = F.wg; rb0 < T / 128; rb0 += F.G) {
        const int b = (rb0 * 128) >> 13; const float* m = mod + (size_t)b * 6144;
        __syncthreads();
        { float cp[16];
#pragma unroll
          for (int e = 0; e < 16; ++e) cp[e] = 0.f;
          for (int k = F.tid; k < D; k += NTHR) { const float gmk = gsrc[k] * (1.f + m[4096 + k]), shk = m[3072 + k];
#pragma unroll
              for (int e4 = 0; e4 < 4; ++e4) { const f32x4 w4 = *(const f32x4*)(rw + (size_t)k * 16 + 4 * e4);
#pragma unroll
                  for (int q = 0; q < 4; ++q) { const int e = 4 * e4 + q; const float pr = gmk * w4[q]; const unsigned hi = f2bf(pr); const unsigned lo = f2bf(pr - bf2f(hi));
                      AH[e * AP + k] = (bf16)hi; AL[e * AP + k] = (bf16)lo; cp[e] += shk * w4[q]; } } }
#pragma unroll
          for (int e = 0; e < 16; ++e) { const float t = wave_sum(cp[e]); if (F.lane == 0) cpart[F.wave * 16 + e] = t; } }
        __syncthreads();
        if (F.tid < 16) { float t = 0.f;
#pragma unroll
            for (int w = 0; w < 8; ++w) t += cpart[w * 16 + F.tid];
            cbv[F.tid] = t; }
        f32x4 gm[4], sh[4];
#pragma unroll
        for (int jj = 0; jj < 4; ++jj) { const int o = ROFF(F.lane, jj); gm[jj] = *(const f32x4*)(gsrc + o) * (1.f + *(const f32x4*)(m + 4096 + o)); sh[jj] = *(const f32x4*)(m + 3072 + o); }
        const int rbase = rb0 * 128 + F.wave * 16;
        f32x4 v0[4], v1[4]; row_load_bf(XB + (size_t)rbase * D, F.lane, v0); row_load_bf(XB + (size_t)(rbase + 1) * D, F.lane, v1);
#pragma unroll 1
        for (int j = 0; j < 16; j += 2) {
            const int lr = F.wave * 16 + j, row = rbase + j;
            f32x4 n0[4], n1[4];
            { const int nr = (j + 2 < 16) ? row + 2 : row; row_load_bf(XB + (size_t)nr * D, F.lane, n0); row_load_bf(XB + (size_t)(nr + 1) * D, F.lane, n1); }
            const float rstd0 = rsqrtf(row_sumsq(v0) * (1.f / D) + EPS), rstd1 = rsqrtf(row_sumsq(v1) * (1.f / D) + EPS);
#pragma unroll
            for (int jj = 0; jj < 4; ++jj) { v0[jj] = v0[jj] * rstd0 * gm[jj] + sh[jj]; v1[jj] = v1[jj] * rstd1 * gm[jj] + sh[jj]; }
            row_store_bf16(HB + (size_t)row * D, v0, F.lane); row_store_bf16(HB + (size_t)(row + 1) * D, v1, F.lane);
            if (F.lane == 0) { rstdv[lr] = rstd0; rstdv[lr + 1] = rstd1; }
#pragma unroll
            for (int jj = 0; jj < 4; ++jj) { v0[jj] = n0[jj]; v1[jj] = n1[jj]; }
        }
        __syncthreads();
        { const int fr = F.lane & 15, fq = F.lane >> 4;
          f32x4 acc = {0.f, 0.f, 0.f, 0.f};
          const bf16* xr = XB + (size_t)(rb0 * 128 + 16 * F.wave + fr) * D + 8 * fq;
          const LAS bf16* ah = AH + fr * AP + 8 * fq; const LAS bf16* al = AL + fr * AP + 8 * fq;
#pragma unroll 8
          for (int s2 = 0; s2 < 32; ++s2) { const bf16x8 xb = *(const bf16x8*)(xr + 32 * s2);
              acc = __builtin_amdgcn_mfma_f32_16x16x32_bf16(*(const LAS bf16x8*)(ah + 32 * s2), xb, acc, 0, 0, 0);
              acc = __builtin_amdgcn_mfma_f32_16x16x32_bf16(*(const LAS bf16x8*)(al + 32 * s2), xb, acc, 0, 0, 0); }
          const int lrow = 16 * F.wave + fr; const float rs = rstdv[lrow];
#pragma unroll
          for (int i = 0; i < 4; ++i) lgt[lrow * 16 + 4 * fq + i] = rs * acc[i] + cbv[4 * fq + i]; }
        __syncthreads();
        if (F.tid < 128) { float lg[16];
#pragma unroll
            for (int e4 = 0; e4 < 4; ++e4) { const f32x4 t = *(const LAS f32x4*)(lgt + F.tid * 16 + 4 * e4); lg[4 * e4] = t.x; lg[4 * e4 + 1] = t.y; lg[4 * e4 + 2] = t.z; lg[4 * e4 + 3] = t.w; }
            int e1, e2; float w1, w2; route_select(lg, rb, e1, e2, w1, w2);
            sel_e[2 * F.tid] = e1; sel_e[2 * F.tid + 1] = e2; sel_w[2 * F.tid] = w1; sel_w[2 * F.tid + 1] = w2; }
        __syncthreads();
        int my_e = 0, my_rank = 0; float my_w = 0.f;
        if (F.tid < 256) { my_e = sel_e[F.tid]; my_w = sel_w[F.tid];
            const unsigned long long below = (1ull << F.lane) - 1ull;
#pragma unroll 1
            for (int ee = 0; ee < 16; ++ee) { const unsigned long long mk = __ballot(my_e == ee);
                if (my_e == ee) my_rank = __popcll(mk & below);
                if (F.lane == 0) wcnt[F.wave * 16 + ee] = __popcll(mk); } }
        __syncthreads();
        if (F.tid < 16) { const int n = wcnt[F.tid] + wcnt[16 + F.tid] + wcnt[32 + F.tid] + wcnt[48 + F.tid];
            ebase[F.tid] = n ? (int)atomicAdd(cnt + F.tid * 64, (unsigned)n) : 0; }
        __syncthreads();
        if (F.tid < 256) { int pos = ebase[my_e] + my_rank;
            for (int w = 0; w < F.wave; ++w) pos += wcnt[w * 16 + my_e];
            const int tok = rb0 * 128 + (F.tid >> 1), k = F.tid & 1;
            slot_t[my_e * CAP + pos] = tok; slot_w[my_e * CAP + pos] = my_w; tok_e[2 * tok + k] = my_e; tok_p[2 * tok + k] = pos; tok_w[2 * tok + k] = my_w; }
    }
    __syncthreads();
}

constexpr int MOEMAP_OFF = LDS_BYTES - 256;
__device__ __forceinline__ LAS int* moe_map(Frame& F, int layer) {
    LAS int* mm = (LAS int*)(F.lds + MOEMAP_OFF);
    __syncthreads();
    if (F.tid < 64) { const unsigned* cnt = F.ctl + CW_CNT + layer * 16 * 64;
        const int n = (F.tid < 16) ? (int)__hip_atomic_load(cnt + F.tid * 64, __ATOMIC_RELAXED, __HIP_MEMORY_SCOPE_AGENT) : 0;
        const int pad = (n + 255) & ~255; int x = pad;
#pragma unroll
        for (int o = 1; o < 16; o <<= 1) { const int t = __shfl_up(x, o); if (F.lane >= o) x += t; }
        if (F.tid < 16) { mm[F.tid] = n; mm[16 + F.tid] = x - pad; } }
    __syncthreads();
    return mm;
}
struct RowGather { const bf16* base; const int* list; int n; __device__ __forceinline__ const bf16* operator()(int m) const { const int tok = m < n ? list[m] : 0; return base + (size_t)tok * D; } };

__device__ __forceinline__ void phase_moe_gateup(Frame& F, int layer) {
    LAS int* mm = moe_map(F, layer);
    const bf16* HB = (const bf16*)(F.ws + WS_HB); bf16* HID = (bf16*)(F.ws + WS_HID);
    const int* slot_t = (const int*)(F.ws + WS_SLOTT) + layer * 16 * CAP; const float* slot_w = (const float*)(F.ws + WS_SLOTW) + layer * 16 * CAP;
    int ubase = 0;
#pragma unroll 1
    for (int e = 0; e < 16; ++e) {
        const int n = mm[e], hbe = mm[16 + e], rt = (n + 127) >> 7, nu = rt * 8;
        const bf16* Wt = (const bf16*)(F.ws + WS_WGU) + (size_t)(layer * 16 + e) * 1024 * 1024;
        RowGather rp{HB, slot_t + e * CAP, n};
        int first = (F.wg - ubase % F.G + F.G) % F.G;
        for (int u = first; u < nu; u += F.G) {
            const int mt = u / 8, nt = u % 8;
            auto epi = [&](int mb, int nb, const f32x16& c0, const f32x16& c1, int lane) {
                const int h = lane >> 5, cl = lane & 31; const int col = (nb >> 1) + cl;
#pragma unroll
                for (int i = 0; i < 16; ++i) { const int r = mb + crow(i, h);
                    if (r < n) { const float w = slot_w[e * CAP + r]; HID[(size_t)(hbe + r) * FF + col] = (bf16)f2bf(w * silu_f(c0[i]) * c1[i]); } }
            };
            sgemm_tile(rp, Wt, D, mt * 128, nt * 128, epi, F.wave, F.lane);
        }
        ubase += nu;
    }
}
__device__ __forceinline__ void phase_moe_down(Frame& F, int layer) {
    LAS int* mm = moe_map(F, layer);
    const bf16* HID = (const bf16*)(F.ws + WS_HID); bf16* Y = (bf16*)(F.ws + WS_Y);
    int ubase = 0;
#pragma unroll 1
    for (int e = 0; e < 16; ++e) {
        const int n = mm[e], hbe = mm[16 + e], rt = (n + 127) >> 7, nu = rt * 8;
        const bf16* Wt = (const bf16*)(F.ws + WS_WDN) + (size_t)(layer * 16 + e) * 1024 * 512;
        RowLin rp{HID + (size_t)hbe * FF, (size_t)FF};
        int first = (F.wg - ubase % F.G + F.G) % F.G;
        for (int u = first; u < nu; u += F.G) {
            const int mt = u / 8, nt = u % 8;
            auto epi = [&](int mb, int nb, const f32x16& c0, const f32x16& c1, int lane) {
                const int h = lane >> 5, cl = lane & 31;
#pragma unroll
                for (int i = 0; i < 16; ++i) { const int r = mb + crow(i, h);
                    if (r < n) { bf16* yr = Y + (size_t)(hbe + r) * D + nb + cl; yr[0] = (bf16)f2bf(c0[i]); yr[32] = (bf16)f2bf(c1[i]); } }
            };
            sgemm_tile(rp, Wt, FF, mt * 128, nt * 128, epi, F.wave, F.lane);
        }
        ubase += nu;
    }
}

template <bool FINAL>
__device__ __forceinline__ void phase_combine(Frame& F, int layer) {
    LAS int* hbs = moe_map(F, layer) + 16;
    const int gw = F.wg * NWAVES + F.wave, NGW = F.G * NWAVES;
    const float* mod = (const float*)(F.ws + WS_MOD);
    const int* tok_e = (const int*)(F.ws + WS_TOKE); const int* tok_p = (const int*)(F.ws + WS_TOKP);
    const unsigned char* Y8 = (const unsigned char*)(F.ws + WS_Y);
    float* X = F.out; bf16* XB = (bf16*)(F.ws + WS_XB); bf16* HB = (bf16*)(F.ws + WS_HB);
    for (int blk = gw; blk < T / 16; blk += NGW) {
        const int rbase = blk * 16, b = rbase >> 13;
        f32x4 g2v[4], gm[4], shv[4];
        { const float* g2 = mod + ((size_t)layer * 5 + b) * 6144 + 5120;
#pragma unroll
          for (int j = 0; j < 4; ++j) { const int o = ROFF(F.lane, j); g2v[j] = *(const f32x4*)(g2 + o) * (1.f / YSCALE);
              if (FINAL) { gm[j] = *(const f32x4*)(F.in[I_FNG] + o); shv[j] = (f32x4){0.f, 0.f, 0.f, 0.f}; }
              else { const float* m = mod + ((size_t)(layer + 1) * 5 + b) * 6144; gm[j] = *(const f32x4*)(F.in[I_NMG] + (layer + 1) * D + o) * (1.f + *(const f32x4*)(m + 1024 + o)); shv[j] = *(const f32x4*)(m + o); } } }
        int4 te = *(const int4*)(tok_e + 2 * rbase), tp = *(const int4*)(tok_p + 2 * rbase);
        u32x4 xa[2][2], xn[2][2]; u32x2 ya[2][2][2], yn[2][2][2];
        { const int s00 = hbs[te.x] + tp.x, s01 = hbs[te.y] + tp.y, s10 = hbs[te.z] + tp.z, s11 = hbs[te.w] + tp.w;
#pragma unroll
          for (int jj = 0; jj < 2; ++jj) { const int o = 512 * jj + 8 * F.lane;
              xa[0][jj] = *(const u32x4*)(XB + (size_t)rbase * D + o); xa[1][jj] = *(const u32x4*)(XB + (size_t)(rbase + 1) * D + o);
              ya[0][0][jj] = *(const u32x2*)(Y8 + (size_t)s00 * D + o); ya[0][1][jj] = *(const u32x2*)(Y8 + (size_t)s01 * D + o);
              ya[1][0][jj] = *(const u32x2*)(Y8 + (size_t)s10 * D + o); ya[1][1][jj] = *(const u32x2*)(Y8 + (size_t)s11 * D + o); } }
        te = *(const int4*)(tok_e + 2 * (rbase + 2)); tp = *(const int4*)(tok_p + 2 * (rbase + 2));
#pragma unroll 1
        for (int jr = 0; jr < 16; jr += 2) {
            const int row = rbase + jr;
            if (jr + 2 < 16) { const int nr = row + 2;
                const int s00 = hbs[te.x] + tp.x, s01 = hbs[te.y] + tp.y, s10 = hbs[te.z] + tp.z, s11 = hbs[te.w] + tp.w;
#pragma unroll
                for (int jj = 0; jj < 2; ++jj) { const int o = 512 * jj + 8 * F.lane;
                    xn[0][jj] = *(const u32x4*)(XB + (size_t)nr * D + o); xn[1][jj] = *(const u32x4*)(XB + (size_t)(nr + 1) * D + o);
                    yn[0][0][jj] = *(const u32x2*)(Y8 + (size_t)s00 * D + o); yn[0][1][jj] = *(const u32x2*)(Y8 + (size_t)s01 * D + o);
                    yn[1][0][jj] = *(const u32x2*)(Y8 + (size_t)s10 * D + o); yn[1][1][jj] = *(const u32x2*)(Y8 + (size_t)s11 * D + o); }
                const int n2 = (jr + 4 < 16) ? row + 4 : row; te = *(const int4*)(tok_e + 2 * n2); tp = *(const int4*)(tok_p + 2 * n2); }
            f32x4 v[2][4];
#pragma unroll
            for (int q = 0; q < 2; ++q)
#pragma unroll
                for (int jj = 0; jj < 2; ++jj) { const u32x4 xw = xa[q][jj]; const u32x2 a0 = ya[q][0][jj], a1 = ya[q][1][jj];
                    v[q][2 * jj] = (f32x4){bflo(xw.x), bfhi(xw.x), bflo(xw.y), bfhi(xw.y)} + g2v[2 * jj] * (un_fp8x4(a0.x) + un_fp8x4(a1.x));
                    v[q][2 * jj + 1] = (f32x4){bflo(xw.z), bfhi(xw.z), bflo(xw.w), bfhi(xw.w)} + g2v[2 * jj + 1] * (un_fp8x4(a0.y) + un_fp8x4(a1.y)); }
            const float rstd0 = rsqrtf(row_sumsq(v[0]) * (1.f / D) + EPS), rstd1 = rsqrtf(row_sumsq(v[1]) * (1.f / D) + EPS);
#pragma unroll
            for (int q = 0; q < 2; ++q) { const float rstd = q ? rstd1 : rstd0; const size_t ro = (size_t)(row + q) * D;
                if (FINAL) {
#pragma unroll
                    for (int j = 0; j < 4; ++j) *(f32x4*)(X + ro + ROFF(F.lane, j)) = v[q][j] * rstd * gm[j];
                } else {
                    row_store_bf16(XB + ro, v[q], F.lane);
#pragma unroll
                    for (int j = 0; j < 4; ++j) v[q][j] = v[q][j] * rstd * gm[j] + shv[j];
                    row_store_bf16(HB + ro, v[q], F.lane);
                }
            }
#pragma unroll
            for (int q = 0; q < 2; ++q)
#pragma unroll
                for (int jj = 0; jj < 2; ++jj) { xa[q][jj] = xn[q][jj]; ya[q][0][jj] = yn[q][0][jj]; ya[q][1][jj] = yn[q][1][jj]; }
        }
    }
    __syncthreads();
}

__device__ __forceinline__ void phase_pw1(Frame& F) {
    const bf16* HB = (const bf16*)(F.ws + WS_HB); const bf16* Wt = (const bf16*)(F.ws + WS_WPW1); bf16* U = (bf16*)(F.ws + WS_U);
    const float* bias = F.in[I_PW1B];
    RowLin rp{HB, (size_t)D};
    for (int u = F.wg; u < (T / 128) * 16; u += F.G) {
        const int mt = u / 16, nt = u % 16;
        auto epi = [&](int mb, int nb, const f32x16& c0, const f32x16& c1, int lane) {
            const int h = lane >> 5, cl = lane & 31, col = (nb >> 1) + cl; const float ba = bias[col], bg = bias[1024 + col];
#pragma unroll
            for (int i = 0; i < 16; ++i) U[(size_t)(mb + crow(i, h)) * D + col] = (bf16)f2bf((c0[i] + ba) * sigmoid_f(c1[i] + bg));
        };
        sgemm_tile(rp, Wt, D, mt * 128, nt * 128, epi, F.wave, F.lane);
    }
}
__device__ __forceinline__ void phase_dwconv(Frame& F) {
    const bf16* U = (const bf16*)(F.ws + WS_U); bf16* V1 = (bf16*)(F.ws + WS_V1);
    const float* dww = F.in[I_DWW]; const float* dwb = F.in[I_DWB]; const float* lng = F.in[I_LNG]; const float* lnb = F.in[I_LNB];
    const int gw = F.wg * NWAVES + F.wave, NGW = F.G * NWAVES;
    for (int row = gw; row < T; row += NGW) {
        const int l = row & (L - 1);
        f32x4 acc[4];
#pragma unroll
        for (int j = 0; j < 4; ++j) acc[j] = *(const f32x4*)(dwb + 4 * F.lane + 256 * j);
        for (int tp = 0; tp < CONVW; ++tp) { const int ll = l + tp - 15; if (ll < 0 || ll >= L) continue;
            const bf16* ur = U + (size_t)(row + tp - 15) * D; const float* wr = dww + (size_t)tp * D;
#pragma unroll
            for (int j = 0; j < 4; ++j) { const int o = 4 * F.lane + 256 * j; const u32x2 uu = *(const u32x2*)(ur + o); const f32x4 ww = *(const f32x4*)(wr + o);
                acc[j].x += bflo(uu.x) * ww.x; acc[j].y += bfhi(uu.x) * ww.y; acc[j].z += bflo(uu.y) * ww.z; acc[j].w += bfhi(uu.y) * ww.w; } }
        float s = 0.f;
#pragma unroll
        for (int j = 0; j < 4; ++j) s += (acc[j].x + acc[j].y) + (acc[j].z + acc[j].w);
        const float mean = wave_sum(s) * (1.f / D); float q = 0.f;
#pragma unroll
        for (int j = 0; j < 4; ++j) { acc[j] = acc[j] - mean; q += (acc[j].x * acc[j].x + acc[j].y * acc[j].y) + (acc[j].z * acc[j].z + acc[j].w * acc[j].w); }
        const float rstd = rsqrtf(wave_sum(q) * (1.f / D) + EPS);
#pragma unroll
        for (int j = 0; j < 4; ++j) { const int o = 4 * F.lane + 256 * j; const f32x4 gg = *(const f32x4*)(lng + o), bb = *(const f32x4*)(lnb + o);
            f32x4 y = acc[j] * rstd * gg + bb; y.x = silu_f(y.x); y.y = silu_f(y.y); y.z = silu_f(y.z); y.w = silu_f(y.w); acc[j] = y; }
        row_store_bf16(V1 + (size_t)row * D, acc, F.lane);
    }
}


namespace pg {
constexpr int BM = 256, BK = 64, HALF = 128, HTB = HALF * BK * 2, STAGE_BYTES = 8 * HTB;
constexpr int TAB_OFF = STAGE_BYTES;
__device__ __forceinline__ int lds_byte(int r, int c) { const int st = (r >> 4) * 2 + (c >> 5), rr = r & 15, cc = c & 31, ob = rr * 64 + cc * 2; return st * 1024 + (ob ^ (((ob >> 9) & 1) << 5)); }
__device__ __forceinline__ void stage_rc(int b, int& R, int& C) { const int st = b / 1024, sb = b % 1024, swz = sb ^ (((sb >> 9) & 1) << 5); R = (st >> 1) * 16 + swz / 64; C = (st & 1) * 32 + (swz % 64) / 2; }
__device__ __forceinline__ int perm32(int rho) { const int n = rho >> 4, i = rho & 15; return 8 * (i >> 2) + 4 * n + (i & 3); }
__device__ __forceinline__ unsigned cvt_pk_bf16(float lo, float hi) { unsigned r; asm volatile("v_cvt_pk_bf16_f32 %0, %1, %2" : "=v"(r) : "v"(lo), "v"(hi)); return r; }

struct GU { const char* B; int p0, p1, p2, p3; };

template <class Epi, class Sched>
__device__ __forceinline__ void gemm_phase(LAS unsigned char* lds, const char* Abase, const int K, const Sched& S, const Epi& E) {
    const int tid = threadIdx.x, wid = __builtin_amdgcn_readfirstlane(tid >> 6), lane = tid & 63, wr = wid >> 2, wc = wid & 3, fr = lane & 15, fq = lane >> 4;
    const int nt = K / BK;
    int sR[2], sC[2]; unsigned voffB[2];
#pragma unroll
    for (int i = 0; i < 2; ++i) { int R, C; stage_rc(tid * 16 + i * 8192, R, C); sR[i] = R; sC[i] = C; const int Rb = Epi::PERM ? ((R & ~31) + perm32(R & 31)) : R; voffB[i] = (unsigned)(Rb * K + C) * 2u; }
    const size_t kstep = (size_t)(BK * 2);
    const size_t hstep = (size_t)HALF * K * 2;
    const unsigned ldsw = (unsigned)wid * 1024u;
    const int aoff = lds_byte(wr * 64 + fr, fq * 8), boff = lds_byte(wc * 32 + fr, fq * 8);
#define PG_SA(b, h) (((b) * 2 + (h)) * HTB)
#define PG_SB(b, h) ((4 + (b) * 2 + (h)) * HTB)
#define PG_STAGE(bufoff, gbase, voff) do { _Pragma("unroll") for (int _i = 0; _i < 2; ++_i) \
        __builtin_amdgcn_global_load_lds((const unsigned*)((const char*)(gbase) + (voff)[_i]), (LAS unsigned*)(lds + (bufoff) + ldsw + _i * 8192), 16, 0, 0); } while (0)
#define PG_LDA(dst, b, h) do { _Pragma("unroll") for (int m = 0; m < 4; ++m) _Pragma("unroll") for (int k = 0; k < 2; ++k) dst[m][k] = *(const LAS bf16x8*)(lds + PG_SA(b, h) + aoff + m * 2048 + k * 1024); } while (0)
#define PG_LDB(dst, b, h) do { _Pragma("unroll") for (int n = 0; n < 2; ++n) _Pragma("unroll") for (int k = 0; k < 2; ++k) dst[n][k] = *(const LAS bf16x8*)(lds + PG_SB(b, h) + boff + n * 2048 + k * 1024); } while (0)
#define PG_MMA(ai, bj, At, Bt) do { __builtin_amdgcn_s_setprio(1); _Pragma("unroll") for (int m = 0; m < 4; ++m) _Pragma("unroll") for (int n = 0; n < 2; ++n) _Pragma("unroll") for (int k = 0; k < 2; ++k) \
        acc[ai][bj][m][n] = __builtin_amdgcn_mfma_f32_16x16x32_bf16(Bt[n][k], At[m][k], acc[ai][bj][m][n], 0, 0, 0); __builtin_amdgcn_s_setprio(0); } while (0)
#define PG_WAIT_V(n) asm volatile("s_waitcnt vmcnt(" #n ")" ::: "memory")
#define PG_WAIT_L(n) asm volatile("s_waitcnt lgkmcnt(" #n ")" ::: "memory")
#define PG_BAR __builtin_amdgcn_s_barrier()
#define PG_SCHED __builtin_amdgcn_sched_barrier(0)
    GU cur, nxt; int ui = 0;
    if (!S.next(0, cur)) return;
    f32x4 acc[2][2][4][2];
#pragma unroll
    for (int a = 0; a < 2; ++a)
#pragma unroll
        for (int b = 0; b < 2; ++b)
#pragma unroll
            for (int m = 0; m < 4; ++m)
#pragma unroll
                for (int n = 0; n < 2; ++n) acc[a][b][m][n] = (f32x4){0.f, 0.f, 0.f, 0.f};
    bf16x8 At[4][2], B0[2][2], B1[2][2];
    if constexpr (Sched::GATHER) { S.stage_table(cur, 0, lds, wid, lane); PG_WAIT_V(0); PG_BAR; }
    unsigned voC[2][2], voN[2][2];
#pragma unroll
    for (int h = 0; h < 2; ++h)
#pragma unroll
        for (int i = 0; i < 2; ++i) { voC[h][i] = S.voff(cur, 0, lds, h * HALF + sR[i], sC[i]); voN[h][i] = voC[h][i]; }
    const char* cB = cur.B;
    PG_STAGE(PG_SB(0, 0), cB, voffB); PG_STAGE(PG_SB(0, 1), cB + hstep, voffB); PG_STAGE(PG_SA(0, 0), Abase, voC[0]); PG_STAGE(PG_SA(0, 1), Abase, voC[1]);
    if (wr == 1) PG_BAR;
    PG_WAIT_V(2); PG_BAR;
    PG_STAGE(PG_SB(1, 0), cB + kstep, voffB); PG_STAGE(PG_SA(1, 0), Abase + kstep, voC[0]); PG_STAGE(PG_SB(1, 1), cB + hstep + kstep, voffB);
    PG_WAIT_V(6); PG_BAR;
    for (;;) {
        const bool has_next = S.next(ui + 1, nxt);
        if constexpr (Sched::GATHER) { if (has_next) S.stage_table(nxt, (ui + 1) & 1, lds, wid, lane); }
        const char* nB = has_next ? nxt.B : cB;
        for (int t = 0; t < nt; t += 2) {
            const bool last = (t == nt - 2);
            if (last && has_next) {
#pragma unroll
                for (int h = 0; h < 2; ++h)
#pragma unroll
                    for (int i = 0; i < 2; ++i) voN[h][i] = S.voff(nxt, (ui + 1) & 1, lds, h * HALF + sR[i], sC[i]);
            }
            unsigned vo2[2][2];
#pragma unroll
            for (int h = 0; h < 2; ++h)
#pragma unroll
                for (int i = 0; i < 2; ++i) vo2[h][i] = last ? voN[h][i] : voC[h][i];
            const char* a1 = Abase + (size_t)(t + 1) * kstep;
            const char* a2 = last ? Abase : Abase + (size_t)(t + 2) * kstep; const char* b2 = last ? nB : cB + (size_t)(t + 2) * kstep;
            const char* a3 = a2 + kstep; const char* b3 = b2 + kstep;
            PG_LDB(B0, 0, 0); PG_LDB(B1, 0, 1); PG_SCHED; PG_LDA(At, 0, 0); PG_STAGE(PG_SA(1, 1), a1, voC[1]);
            PG_WAIT_V(8); PG_WAIT_L(0); PG_BAR; PG_MMA(0, 0, At, B0); PG_MMA(0, 1, At, B1); PG_BAR; PG_SCHED;
            PG_LDA(At, 0, 1); PG_STAGE(PG_SB(0, 0), b2, voffB); PG_STAGE(PG_SB(0, 1), b2 + hstep, voffB); PG_STAGE(PG_SA(0, 0), a2, vo2[0]);
            PG_WAIT_V(8); PG_WAIT_L(0); PG_BAR; PG_MMA(1, 0, At, B0); PG_MMA(1, 1, At, B1); PG_BAR; PG_SCHED;
            PG_LDB(B0, 1, 0); PG_LDB(B1, 1, 1); PG_SCHED; PG_LDA(At, 1, 0); PG_STAGE(PG_SA(0, 1), a2, vo2[1]);
            PG_WAIT_V(8); PG_WAIT_L(0); PG_BAR; PG_MMA(0, 0, At, B0); PG_MMA(0, 1, At, B1); PG_BAR; PG_SCHED;
            PG_LDA(At, 1, 1); PG_STAGE(PG_SB(1, 0), b3, voffB); PG_STAGE(PG_SB(1, 1), b3 + hstep, voffB); PG_STAGE(PG_SA(1, 0), a3, vo2[0]);
            PG_WAIT_V(8); PG_WAIT_L(0); PG_BAR; PG_MMA(1, 0, At, B0); PG_MMA(1, 1, At, B1); PG_BAR; PG_SCHED;
        }
        if (wr == 0) PG_BAR;
        E(acc, cur, wr, wc, fr, fq);
        if (!has_next) break;
#pragma unroll
        for (int a = 0; a < 2; ++a)
#pragma unroll
            for (int b = 0; b < 2; ++b)
#pragma unroll
                for (int m = 0; m < 4; ++m)
#pragma unroll
                    for (int n = 0; n < 2; ++n) acc[a][b][m][n] = (f32x4){0.f, 0.f, 0.f, 0.f};
        cur = nxt; cB = nB; ++ui;
#pragma unroll
        for (int h = 0; h < 2; ++h)
#pragma unroll
            for (int i = 0; i < 2; ++i) voC[h][i] = voN[h][i];
        if (wr == 1) PG_BAR;
    }
    PG_WAIT_V(0);
    PG_BAR;
#undef PG_SA
#undef PG_SB
#undef PG_STAGE
#undef PG_LDA
#undef PG_LDB
#undef PG_MMA
#undef PG_WAIT_V
#undef PG_WAIT_L
#undef PG_BAR
#undef PG_SCHED
}

__device__ __forceinline__ void static_tile(int L, int nM, int nN, int& pm, int& pn) {
    const int nwg = nM * nN; int wgid = L; { const int q = nwg / 8, r = nwg % 8, xcd = wgid % 8, off = wgid / 8; wgid = (xcd < r ? xcd * (q + 1) : r * (q + 1) + (xcd - r) * q) + off; }
    const int nig = 8 * nN, gid = wgid / nig, fm = gid * 8, gsz = (nM - fm) < 8 ? (nM - fm) : 8;
    pm = fm + ((wgid % nig) % gsz); pn = (wgid % nig) / gsz;
}
struct DenseSched {
    static constexpr bool GATHER = false;
    const char* Bt; int K, nM, nN, G, c, xn, xm0, xpn;
    __device__ __forceinline__ bool next(int i, GU& u) const {
        const int L = i * G + c, nmain = nM * nN; int pm, pn;
        if (L < nmain) static_tile(L, nM, nN, pm, pn); else if (L < nmain + xn) { pm = xm0 + (L - nmain); pn = xpn; } else return false;
        u.B = Bt + (size_t)pn * BM * K * 2; u.p0 = pm; u.p1 = pn; u.p2 = 0; u.p3 = 0; return true;
    }
    __device__ __forceinline__ unsigned voff(const GU& u, int, LAS unsigned char*, int R, int C) const { return (unsigned)(((u.p0 * BM + R) * K + C) * 2); }
    __device__ __forceinline__ void stage_table(const GU&, int, LAS unsigned char*, int, int) const {}
};
template <bool GATHER_> struct MoeSched {
    static constexpr bool GATHER = GATHER_;
    const char* Wt; size_t wstride; int K; const int* list; LAS int* mm; int G, c;
    __device__ __forceinline__ bool next(int i, GU& u) const {
        int L = i * G + c;
        for (int e = 0; e < 16; ++e) { const int n = mm[e], nu = ((n + 255) >> 8) * 4;
            if (L < nu) { const int rt = L >> 2, pn = L & 3; u.B = Wt + (size_t)e * wstride + (size_t)pn * BM * K * 2; u.p0 = e; u.p1 = rt; u.p2 = pn; u.p3 = mm[16 + e]; return true; }
            L -= nu; }
        return false;
    }
    __device__ __forceinline__ unsigned voff(const GU& u, int buf, LAS unsigned char* lds, int R, int C) const {
        if constexpr (GATHER_) { const int tok = ((const LAS int*)(lds + TAB_OFF))[buf * 256 + R]; return (unsigned)((tok * K + C) * 2); }
        else return (unsigned)(((u.p3 + u.p1 * BM + R) * K + C) * 2);
    }
    __device__ __forceinline__ void stage_table(const GU& u, int buf, LAS unsigned char* lds, int wid, int lane) const {
        if constexpr (GATHER_) { const int r = (wid & 3) * 64 + lane;
            __builtin_amdgcn_global_load_lds((const unsigned*)(list + u.p0 * CAP + u.p1 * BM + r), (LAS unsigned*)(lds + TAB_OFF + buf * 1024 + (wid & 3) * 256), 4, 0, 0); }
    }
};

struct EpiInProj {
    static constexpr bool PERM = false;
    unsigned char* ws;
    __device__ __forceinline__ void operator()(const f32x4 (&acc)[2][2][4][2], const GU& u, int wr, int wc, int fr, int fq) const {
        const int pm = u.p0, pn = u.p1; const bool isctx = pm >= T / BM;
        float inv[4];
#pragma unroll
        for (int j = 0; j < 4; ++j) inv[j] = exp2f(-(float)(4 * fq + j) * (13.287712379549449f / 16.f));
#pragma unroll
        for (int bj = 0; bj < 2; ++bj) {
            const int cb = pn * BM + bj * HALF + wc * 32;
            bf16* dst; int pitch, cbase; bool rope = false;
            if (cb < 512) { dst = (bf16*)(ws + WS_UF); pitch = 512; cbase = 0; }
            else if (cb < 1024) { dst = (bf16*)(ws + WS_Q); pitch = 512; cbase = 512; rope = true; }
            else if (cb < 1152) { dst = isctx ? (bf16*)(ws + WS_CK) : (bf16*)(ws + WS_K); pitch = 128; cbase = 1024; rope = !isctx; }
            else { dst = isctx ? (bf16*)(ws + WS_CV) : (bf16*)(ws + WS_V); pitch = 128; cbase = 1152; }
            const bool bycol = ((cb >> 5) & 1) != 0;
#pragma unroll
            for (int ai = 0; ai < 2; ++ai)
#pragma unroll
                for (int m = 0; m < 4; ++m) {
                    const int row = pm * BM + ai * HALF + wr * 64 + m * 16 + fr;
                    f32x4 v0 = acc[ai][bj][m][0], v1 = acc[ai][bj][m][1];
                    if (rope) { const int l = row & (L - 1); const float pos = (float)(bycol ? (l & 63) : (l >> 6));
#pragma unroll
                        for (int j = 0; j < 4; ++j) { const float ang = pos * inv[j], cs = __cosf(ang), sn = __sinf(ang); const float x1 = v0[j], x2 = v1[j]; v0[j] = x1 * cs - x2 * sn; v1[j] = x1 * sn + x2 * cs; } }
                    const int orow = isctx ? row - T : row;
                    if (FAST_ATTN && cb >= 1152) {
                        const int kp = isctx ? CL : L, bb = isctx ? (orow >> 8) : (orow >> 13), key = isctx ? (orow & (CL - 1)) : (orow & (L - 1));
#pragma unroll
                        for (int n = 0; n < 2; ++n)
#pragma unroll
                            for (int j = 0; j < 4; ++j) { const int c = (cb - 1152) + 16 * n + 4 * fq + j;
                                dst[((size_t)bb * 128 + c) * kp + key] = (bf16)f2bf(n ? v1[j] : v0[j]); }
                        continue;
                    }
                    bf16* o = dst + (size_t)orow * pitch + (cb - cbase) + 4 * fq;
                    u32x2 w0, w1; w0.x = cvt_pk_bf16(v0[0], v0[1]); w0.y = cvt_pk_bf16(v0[2], v0[3]); w1.x = cvt_pk_bf16(v1[0], v1[1]); w1.y = cvt_pk_bf16(v1[2], v1[3]);
                    *(u32x2*)o = w0; *(u32x2*)(o + 16) = w1;
                }
        }
    }
};
struct EpiRes {
    static constexpr bool PERM = false;
    const float* base; float* X; const float* gate; const float* bias;
    __device__ __forceinline__ void operator()(const f32x4 (&acc)[2][2][4][2], const GU& u, int wr, int wc, int fr, int fq) const {
        const int row0 = u.p0 * BM + wr * 64 + fr, col0 = u.p1 * BM + wc * 32 + 4 * fq; const int b = (u.p0 * BM) >> 13;
        f32x4 gv[2][2], bv[2][2];
#pragma unroll
        for (int bj = 0; bj < 2; ++bj)
#pragma unroll
            for (int n = 0; n < 2; ++n) { gv[bj][n] = *(const f32x4*)(gate + (size_t)b * 6144 + col0 + bj * HALF + n * 16); bv[bj][n] = bias ? *(const f32x4*)(bias + col0 + bj * HALF + n * 16) : (f32x4){0.f, 0.f, 0.f, 0.f}; }
#pragma unroll
        for (int ai = 0; ai < 2; ++ai)
#pragma unroll
            for (int mp = 0; mp < 2; ++mp) {
                f32x4 bs[2][2][2];
#pragma unroll
                for (int mm = 0; mm < 2; ++mm) { const size_t off = (size_t)(row0 + ai * HALF + (2 * mp + mm) * 16) * D + col0;
#pragma unroll
                    for (int bj = 0; bj < 2; ++bj)
#pragma unroll
                        for (int n = 0; n < 2; ++n) bs[mm][bj][n] = *(const f32x4*)(base + off + bj * HALF + n * 16); }
#pragma unroll
                for (int mm = 0; mm < 2; ++mm) { const int m = 2 * mp + mm; const size_t off = (size_t)(row0 + ai * HALF + m * 16) * D + col0;
#pragma unroll
                    for (int bj = 0; bj < 2; ++bj)
#pragma unroll
                        for (int n = 0; n < 2; ++n) *(f32x4*)(X + off + bj * HALF + n * 16) = bs[mm][bj][n] + gv[bj][n] * (acc[ai][bj][m][n] + bv[bj][n]); }
                asm volatile("" ::: "memory"); }
    }
};
template <bool BASEBF> struct EpiResB {
    static constexpr bool PERM = true;
    const float* basef; bf16* XB; const float* gate; const float* bias;
    __device__ __forceinline__ void operator()(const f32x4 (&acc)[2][2][4][2], const GU& u, int wr, int wc, int fr, int fq) const {
        const int row0 = u.p0 * BM + wr * 64 + fr, col0 = u.p1 * BM + wc * 32 + 8 * fq; const int b = (u.p0 * BM) >> 13;
        f32x4 gv[2][2], bv[2][2];
#pragma unroll
        for (int bj = 0; bj < 2; ++bj)
#pragma unroll
            for (int n = 0; n < 2; ++n) { gv[bj][n] = *(const f32x4*)(gate + (size_t)b * 6144 + col0 + bj * HALF + n * 4); bv[bj][n] = bias ? *(const f32x4*)(bias + col0 + bj * HALF + n * 4) : (f32x4){0.f, 0.f, 0.f, 0.f}; }
        constexpr int NB2 = BASEBF ? 4 : 2;
#pragma unroll
        for (int ai = 0; ai < 2; ++ai)
#pragma unroll
            for (int mb = 0; mb < 4; mb += NB2) {
                f32x4 bf[BASEBF ? 1 : NB2][2][2]; u32x4 bw[BASEBF ? NB2 : 1][2];
#pragma unroll
                for (int mm = 0; mm < NB2; ++mm) { const size_t off = (size_t)(row0 + ai * HALF + (mb + mm) * 16) * D + col0;
#pragma unroll
                    for (int bj = 0; bj < 2; ++bj) {
                        if (BASEBF) bw[mm][bj] = *(const u32x4*)(XB + off + bj * HALF);
                        else { bf[mm][bj][0] = *(const f32x4*)(basef + off + bj * HALF); bf[mm][bj][1] = *(const f32x4*)(basef + off + bj * HALF + 4); } } }
#pragma unroll
                for (int mm = 0; mm < NB2; ++mm) { const int m = mb + mm; const size_t off = (size_t)(row0 + ai * HALF + m * 16) * D + col0;
#pragma unroll
                    for (int bj = 0; bj < 2; ++bj) { f32x4 o[2];
#pragma unroll
                        for (int n = 0; n < 2; ++n) { f32x4 bsv;
                            if (BASEBF) { const unsigned wa = n ? bw[mm][bj].z : bw[mm][bj].x, wb = n ? bw[mm][bj].w : bw[mm][bj].y; bsv = (f32x4){bflo(wa), bfhi(wa), bflo(wb), bfhi(wb)}; } else bsv = bf[mm][bj][n];
                            o[n] = bsv + gv[bj][n] * (acc[ai][bj][m][n] + bv[bj][n]); }
                        u32x4 w2; w2.x = cvt_pk_bf16(o[0][0], o[0][1]); w2.y = cvt_pk_bf16(o[0][2], o[0][3]); w2.z = cvt_pk_bf16(o[1][0], o[1][1]); w2.w = cvt_pk_bf16(o[1][2], o[1][3]);
                        *(u32x4*)(XB + off + bj * HALF) = w2; } }
                asm volatile("" ::: "memory"); }
    }
};
struct EpiGLU {
    static constexpr bool PERM = true;
    bf16* U; const float* bias;
    __device__ __forceinline__ void operator()(const f32x4 (&acc)[2][2][4][2], const GU& u, int wr, int wc, int fr, int fq) const {
        const int row0 = u.p0 * BM + wr * 64 + fr, col0 = u.p1 * HALF + wc * 32 + 8 * fq;
        f32x4 ba[2], bg[2];
#pragma unroll
        for (int n = 0; n < 2; ++n) { ba[n] = *(const f32x4*)(bias + col0 + 4 * n); bg[n] = *(const f32x4*)(bias + 1024 + col0 + 4 * n); }
#pragma unroll
        for (int ai = 0; ai < 2; ++ai)
#pragma unroll
            for (int m = 0; m < 4; ++m) { f32x4 o[2];
#pragma unroll
                for (int n = 0; n < 2; ++n) { const f32x4 a = acc[ai][0][m][n] + ba[n], g = acc[ai][1][m][n] + bg[n];
#pragma unroll
                    for (int j = 0; j < 4; ++j) o[n][j] = a[j] * sigmoid_f(g[j]); }
                u32x4 w; w.x = cvt_pk_bf16(o[0][0], o[0][1]); w.y = cvt_pk_bf16(o[0][2], o[0][3]); w.z = cvt_pk_bf16(o[1][0], o[1][1]); w.w = cvt_pk_bf16(o[1][2], o[1][3]);
                *(u32x4*)(U + (size_t)(row0 + ai * HALF + m * 16) * D + col0) = w; }
    }
};
struct EpiGateUp {
    static constexpr bool PERM = true;
    bf16* HID; const float* slot_w; LAS int* mm;
    __device__ __forceinline__ void operator()(const f32x4 (&acc)[2][2][4][2], const GU& u, int wr, int wc, int fr, int fq) const {
        const int e = u.p0, n_e = mm[e], r0 = u.p1 * BM + wr * 64 + fr, col0 = u.p2 * HALF + wc * 32 + 8 * fq;
        float wv[2][4];
#pragma unroll
        for (int ai = 0; ai < 2; ++ai)
#pragma unroll
            for (int m = 0; m < 4; ++m) wv[ai][m] = slot_w[e * CAP + r0 + ai * HALF + m * 16];
#pragma unroll
        for (int ai = 0; ai < 2; ++ai)
#pragma unroll
            for (int m = 0; m < 4; ++m) { const int r = r0 + ai * HALF + m * 16;
                if (r < n_e) { const float w = wv[ai][m]; f32x4 o[2];
#pragma unroll
                    for (int n = 0; n < 2; ++n) { const f32x4 g = acc[ai][0][m][n], up = acc[ai][1][m][n];
#pragma unroll
                        for (int j = 0; j < 4; ++j) o[n][j] = w * silu_f(g[j]) * up[j]; }
                    u32x4 q; q.x = cvt_pk_bf16(o[0][0], o[0][1]); q.y = cvt_pk_bf16(o[0][2], o[0][3]); q.z = cvt_pk_bf16(o[1][0], o[1][1]); q.w = cvt_pk_bf16(o[1][2], o[1][3]);
                    *(u32x4*)(HID + (size_t)(u.p3 + r) * FF + col0) = q; } }
    }
};
struct EpiDown {
    static constexpr bool PERM = true;
    bf16* Y; LAS int* mm;
    __device__ __forceinline__ void operator()(const f32x4 (&acc)[2][2][4][2], const GU& u, int wr, int wc, int fr, int fq) const {
        const int e = u.p0, n_e = mm[e], r0 = u.p1 * BM + wr * 64 + fr, col0 = u.p2 * BM + wc * 32 + 8 * fq;
#pragma unroll
        for (int ai = 0; ai < 2; ++ai)
#pragma unroll
            for (int m = 0; m < 4; ++m) { const int r = r0 + ai * HALF + m * 16;
                if (r < n_e) {
#pragma unroll
                    for (int bj = 0; bj < 2; ++bj) { const f32x4 v0 = acc[ai][bj][m][0], v1 = acc[ai][bj][m][1];
                        u32x4 q; q.x = cvt_pk_bf16(v0[0], v0[1]); q.y = cvt_pk_bf16(v0[2], v0[3]); q.z = cvt_pk_bf16(v1[0], v1[1]); q.w = cvt_pk_bf16(v1[2], v1[3]);
                        *(u32x4*)(Y + (size_t)(u.p3 + r) * D + col0 + bj * HALF) = q; } } }
    }
};
}

__device__ __forceinline__ void fast_inproj(Frame& F) {
    pg::DenseSched S{(const char*)(F.ws + WS_WIN), D, T / 256, N_IN / 256, F.G, F.wg, TC / 256, T / 256, 4};
    pg::EpiInProj E{F.ws};
    pg::gemm_phase(F.lds, (const char*)(F.ws + WS_HB), D, S, E);
    const int nbusy = (T / 256) * (N_IN / 256) + TC / 256 - 2 * F.G;
    if (nbusy > 0 && nbusy < F.G) { if (F.wg >= nbusy) t_items_tail(F, (F.wg - nbusy) * NWAVES + F.wave, (F.G - nbusy) * NWAVES); }
    else t_items_tail(F, F.wg * NWAVES + F.wave, F.G * NWAVES);
}
__device__ __forceinline__ void fast_outproj(Frame& F, size_t a_off, size_t w_off, const float* base, float* X, const float* gate, const float* bias) {
    pg::DenseSched S{(const char*)(F.ws + w_off), D, T / 256, D / 256, F.G, F.wg, 0, 0, 0};
    if (XBF16) {
        if (base == X) { pg::EpiResB<true> E{nullptr, (bf16*)(F.ws + WS_XB), gate, bias}; pg::gemm_phase(F.lds, (const char*)(F.ws + a_off), D, S, E); }
        else { pg::EpiResB<false> E{base, (bf16*)(F.ws + WS_XB), gate, bias}; pg::gemm_phase(F.lds, (const char*)(F.ws + a_off), D, S, E); }
    } else { pg::EpiRes E{base, X, gate, bias}; pg::gemm_phase(F.lds, (const char*)(F.ws + a_off), D, S, E); }
}
__device__ __forceinline__ void fast_pw1(Frame& F) {
    pg::DenseSched S{(const char*)(F.ws + WS_WPW1), D, T / 256, 2048 / 256, F.G, F.wg, 0, 0, 0};
    pg::EpiGLU E{(bf16*)(F.ws + WS_U), F.in[I_PW1B]};
    pg::gemm_phase(F.lds, (const char*)(F.ws + WS_HB), D, S, E);
}
__device__ __forceinline__ void fast_moe_gateup(Frame& F, int layer) {
    LAS int* mm = moe_map(F, layer);
    pg::MoeSched<true> S{(const char*)(F.ws + WS_WGU) + (size_t)layer * 16 * 1024 * 1024 * 2, (size_t)1024 * 1024 * 2, D, (const int*)(F.ws + WS_SLOTT) + layer * 16 * CAP, mm, F.G, F.wg};
    pg::EpiGateUp E{(bf16*)(F.ws + WS_HID), (const float*)(F.ws + WS_SLOTW) + layer * 16 * CAP, mm};
    pg::gemm_phase(F.lds, (const char*)(F.ws + WS_HB), D, S, E);
}
__device__ __forceinline__ void fast_moe_down(Frame& F, int layer) {
    LAS int* mm = moe_map(F, layer);
    pg::MoeSched<false> S{(const char*)(F.ws + WS_WDN) + (size_t)layer * 16 * 1024 * 512 * 2, (size_t)1024 * 512 * 2, FF, nullptr, mm, F.G, F.wg};
    pg::EpiDown E{(bf16*)(F.ws + WS_Y), mm};
    pg::gemm_phase(F.lds, (const char*)(F.ws + WS_HID), FF, S, E);
}


struct AttnBlk { const bf16* kp; const bf16* vp; int pitch; int kb; bool valid, masked; };
__device__ __forceinline__ AttnBlk attn_blk(const unsigned char* ws, int bi, int b, int kvh, int qs) {
    AttnBlk a;
    if (bi < 8) { a.kp = (const bf16*)(ws + WS_CK) + (size_t)(b * CL + bi * 32) * 128 + kvh * 64; a.vp = (const bf16*)(ws + WS_CV) + (size_t)(b * 2 + kvh) * 64 * CL + bi * 32; a.pitch = CL; a.kb = 0; a.valid = true; a.masked = false; }
    else { const int kb = qs - 128 + 32 * (bi - 8); a.valid = (kb >= 0 && kb < L); a.kb = kb; a.masked = true; a.pitch = L;
        a.kp = (const bf16*)(ws + WS_K) + (size_t)(b * L + kb) * 128 + kvh * 64; a.vp = (const bf16*)(ws + WS_V) + (size_t)(b * 2 + kvh) * 64 * L + kb; }
    return a;
}
__device__ __forceinline__ void attn_load(const AttnBlk& a, int r, int h, bf16x8 (&kf)[4], u32x4 (&vf)[2][2]) {
    if (a.valid) {
#pragma unroll
        for (int s = 0; s < 4; ++s) kf[s] = *(const bf16x8*)(a.kp + (size_t)r * 128 + 16 * s + 8 * h);
#pragma unroll
        for (int db = 0; db < 2; ++db)
#pragma unroll
            for (int ks = 0; ks < 2; ++ks) { const bf16* vr = a.vp + (size_t)(32 * db + r) * a.pitch + 16 * ks + 4 * h;
                const u32x2 lo = *(const u32x2*)vr, hi = *(const u32x2*)(vr + 8); vf[db][ks] = (u32x4){lo.x, lo.y, hi.x, hi.y}; }
    }
}
__device__ __forceinline__ void attn_compute(const AttnBlk& a, int qs, int r, int h, const bf16x8 (&kf)[4], const u32x4 (&vf)[2][2], const bf16x8 (&qf)[2][4],
                                             f32x16 (&o)[2][2], float (&m)[2], float (&l)[2]) {
    if (!a.valid) return;
#pragma unroll
    for (int nq = 0; nq < 2; ++nq) {
        f32x16 st;
#pragma unroll
        for (int i = 0; i < 16; ++i) st[i] = 0.f;
#pragma unroll
        for (int s = 0; s < 4; ++s) st = __builtin_amdgcn_mfma_f32_32x32x16_bf16(kf[s], qf[nq][s], st, 0, 0, 0);
        float t[16]; float tmax = -INFINITY;
        const int dbase = a.kb - qs - 32 * nq - r + 4 * h;
#pragma unroll
        for (int i = 0; i < 16; ++i) { float v = st[i] * (0.125f * 1.4426950408889634f);
            if (a.masked) { const int df = dbase + (i & 3) + 8 * (i >> 2); v = (df >= -128 && df <= 128) ? v : -INFINITY; }
            t[i] = v; tmax = fmaxf(tmax, v); }
        tmax = fmaxf(tmax, __shfl_xor(tmax, 32));
        const float mn = fmaxf(m[nq], tmax), alpha = __builtin_amdgcn_exp2f(m[nq] - mn); m[nq] = mn;
        float ps = 0.f;
#pragma unroll
        for (int i = 0; i < 16; ++i) { t[i] = __builtin_amdgcn_exp2f(t[i] - mn); ps += t[i]; }
        l[nq] = l[nq] * alpha + ps;
#pragma unroll
        for (int i = 0; i < 16; ++i) { o[0][nq][i] *= alpha; o[1][nq][i] *= alpha; }
        bf16x8 pf[2];
#pragma unroll
        for (int ks = 0; ks < 2; ++ks) { const u32x4 w = {pkbf(t[8 * ks], t[8 * ks + 1]), pkbf(t[8 * ks + 2], t[8 * ks + 3]), pkbf(t[8 * ks + 4], t[8 * ks + 5]), pkbf(t[8 * ks + 6], t[8 * ks + 7])};
            pf[ks] = __builtin_bit_cast(bf16x8, w); }
#pragma unroll
        for (int db = 0; db < 2; ++db)
#pragma unroll
            for (int ks = 0; ks < 2; ++ks) o[db][nq] = __builtin_amdgcn_mfma_f32_32x32x16_bf16(__builtin_bit_cast(bf16x8, vf[db][ks]), pf[ks], o[db][nq], 0, 0, 0);
    }
}
__device__ __forceinline__ void phase_attn_mfma(Frame& F) {
    const bf16* Q = (const bf16*)(F.ws + WS_Q); bf16* MIX = (bf16*)(F.ws + WS_MIX);
    const int g = F.wave >> 1, half = F.wave & 1, r = F.lane & 31, h = F.lane >> 5;
    for (int item = F.wg; item < NB * 2 * 64; item += F.G) {
        const int qb = item & 63, kvh = (item >> 6) & 1, b = item >> 7, hd = kvh * 4 + g, qs = qb * 128 + half * 64;
        bf16x8 qf[2][4];
#pragma unroll
        for (int nq = 0; nq < 2; ++nq)
#pragma unroll
            for (int s = 0; s < 4; ++s) qf[nq][s] = *(const bf16x8*)(Q + (size_t)(b * L + qs + 32 * nq + r) * 512 + hd * 64 + 16 * s + 8 * h);
        f32x16 o[2][2];
#pragma unroll
        for (int db = 0; db < 2; ++db)
#pragma unroll
            for (int nq = 0; nq < 2; ++nq)
#pragma unroll
                for (int i = 0; i < 16; ++i) o[db][nq][i] = 0.f;
        float m[2], l[2];
        m[0] = m[1] = F.in[I_SINK][hd] * 1.4426950408889634f; l[0] = l[1] = (h == 0) ? 1.f : 0.f;
        bf16x8 kfA[4], kfB[4]; u32x4 vfA[2][2], vfB[2][2];
        AttnBlk ba = attn_blk(F.ws, 0, b, kvh, qs), bb;
        attn_load(ba, r, h, kfA, vfA);
#pragma unroll 1
        for (int bi = 0; bi < 18; bi += 2) {
            bb = attn_blk(F.ws, bi + 1, b, kvh, qs); attn_load(bb, r, h, kfB, vfB);
            attn_compute(ba, qs, r, h, kfA, vfA, qf, o, m, l);
            if (bi + 2 < 18) { ba = attn_blk(F.ws, bi + 2, b, kvh, qs); attn_load(ba, r, h, kfA, vfA); }
            attn_compute(bb, qs, r, h, kfB, vfB, qf, o, m, l);
        }
#pragma unroll
        for (int nq = 0; nq < 2; ++nq) {
            const float lt = l[nq] + __shfl_xor(l[nq], 32), il = 1.f / lt;
            bf16* orow = MIX + (size_t)(b * L + qs + 32 * nq + r) * 1024 + 512 + hd * 64;
#pragma unroll
            for (int db = 0; db < 2; ++db)
#pragma unroll
                for (int i4 = 0; i4 < 4; ++i4) { u32x2 w; w.x = pkbf(o[db][nq][4 * i4] * il, o[db][nq][4 * i4 + 1] * il); w.y = pkbf(o[db][nq][4 * i4 + 2] * il, o[db][nq][4 * i4 + 3] * il);
                    *(u32x2*)(orow + 32 * db + 8 * i4 + 4 * h) = w; }
        }
    }
}


__device__ __forceinline__ float half_max(float v) { const auto r = __builtin_amdgcn_permlane32_swap(__float_as_uint(v), __float_as_uint(v), false, false); return fmaxf(__uint_as_float(r[0]), __uint_as_float(r[1])); }
__device__ __forceinline__ float half_sum(float v) { const auto r = __builtin_amdgcn_permlane32_swap(__float_as_uint(v), __float_as_uint(v), false, false); return __uint_as_float(r[0]) + __uint_as_float(r[1]); }
constexpr int AT_KP = 72, AT_VP = 136;
constexpr int AT_KB = 128 * AT_KP * 2, AT_BUF = AT_KB + 64 * AT_VP * 2;
struct AtChunk { const bf16* kg; const bf16* vg; int vpitch, lc, b, kvh, qb, c; bool valid, local, any; };
__device__ __forceinline__ AtChunk at_chunk(const unsigned char* ws, int seq, int wg, int G) {
    AtChunk k; const int item = wg + (seq / 5) * G; k.c = seq % 5; k.any = item < NB * 2 * 64;
    k.qb = item & 63; k.kvh = (item >> 6) & 1; k.b = (item >> 7) & 3; k.local = k.c >= 2; k.lc = k.c - 2;
    if (!k.local) { k.valid = k.any; k.vpitch = CL; k.kg = (const bf16*)(ws + WS_CK) + (size_t)(k.b * CL + 128 * k.c) * 128 + k.kvh * 64; k.vg = (const bf16*)(ws + WS_CV) + (size_t)(k.b * 2 + k.kvh) * 64 * CL + 128 * k.c; }
    else { const int key0 = 128 * k.qb - 128 + 128 * k.lc; k.valid = k.any && key0 >= 0 && key0 < L; k.vpitch = L;
        k.kg = (const bf16*)(ws + WS_K) + (size_t)(k.b * L + key0) * 128 + k.kvh * 64; k.vg = (const bf16*)(ws + WS_V) + (size_t)(k.b * 2 + k.kvh) * 64 * L + key0; }
    return k;
}
__device__ __forceinline__ void at_issue(const AtChunk& k, int tid, u32x4 (&rg)[4]) {
    if (k.valid) {
#pragma unroll
        for (int i = 0; i < 2; ++i) { const int id = tid + 512 * i; rg[i] = *(const u32x4*)(k.kg + (size_t)(id >> 3) * 128 + (id & 7) * 8); }
#pragma unroll
        for (int i = 0; i < 2; ++i) { const int id = tid + 512 * i; rg[2 + i] = *(const u32x4*)(k.vg + (size_t)(id >> 4) * k.vpitch + (id & 15) * 8); }
    }
}
__device__ __forceinline__ void at_write(const AtChunk& k, LAS unsigned char* buf, int tid, const u32x4 (&rg)[4]) {
    if (k.valid) {
#pragma unroll
        for (int i = 0; i < 2; ++i) { const int id = tid + 512 * i; *(LAS u32x4*)(buf + (id >> 3) * (AT_KP * 2) + (id & 7) * 16) = rg[i]; }
#pragma unroll
        for (int i = 0; i < 2; ++i) { const int id = tid + 512 * i; *(LAS u32x4*)(buf + AT_KB + (id >> 4) * (AT_VP * 2) + (id & 15) * 16) = rg[2 + i]; }
    }
}
__device__ __forceinline__ void at_load(LAS unsigned char* buf, int blk, int r, int h, bf16x8 (&kf)[4], u32x4 (&vf)[2][2]) {
#pragma unroll
    for (int s2 = 0; s2 < 4; ++s2) kf[s2] = *(const LAS bf16x8*)(buf + (32 * blk + r) * (AT_KP * 2) + (16 * s2 + 8 * h) * 2);
#pragma unroll
    for (int db = 0; db < 2; ++db)
#pragma unroll
        for (int ks = 0; ks < 2; ++ks) { const LAS unsigned char* vr = buf + AT_KB + (32 * db + r) * (AT_VP * 2) + (32 * blk + 16 * ks + 4 * h) * 2;
            const u32x2 lo = *(const LAS u32x2*)vr, hi = *(const LAS u32x2*)(vr + 16); vf[db][ks] = (u32x4){lo.x, lo.y, hi.x, hi.y}; }
}
__device__ __forceinline__ void at_math(const bf16x8 (&kf)[4], const u32x4 (&vf)[2][2], bool masked, int kbrel, int r, int h, const bf16x8 (&qf)[2][4], f32x16 (&o)[2][2], float (&m)[2], float (&l)[2]) {
    constexpr float C = 0.125f * 1.4426950408889634f;
#pragma unroll
    for (int nq = 0; nq < 2; ++nq) {
        f32x16 st;
#pragma unroll
        for (int i = 0; i < 16; ++i) st[i] = 0.f;
#pragma unroll
        for (int s2 = 0; s2 < 4; ++s2) st = __builtin_amdgcn_mfma_f32_32x32x16_bf16(kf[s2], qf[nq][s2], st, 0, 0, 0);
        if (masked) { const int dbase = kbrel - 32 * nq - r + 4 * h;
#pragma unroll
            for (int i = 0; i < 16; ++i) { const int df = dbase + (i & 3) + 8 * (i >> 2); st[i] = (df >= -128 && df <= 128) ? st[i] : -INFINITY; } }
        float smax = st[0];
#pragma unroll
        for (int i = 1; i < 16; ++i) smax = fmaxf(smax, st[i]);
        smax = half_max(smax);
        const float mn = fmaxf(m[nq], smax * C), alpha = __builtin_amdgcn_exp2f(m[nq] - mn); m[nq] = mn;
        float t[16]; float ps = 0.f;
#pragma unroll
        for (int i = 0; i < 16; ++i) { t[i] = __builtin_amdgcn_exp2f(__builtin_fmaf(st[i], C, -mn)); ps += t[i]; }
        l[nq] = l[nq] * alpha + ps;
        if (__ballot(alpha != 1.f)) {
#pragma unroll
            for (int i = 0; i < 16; ++i) { o[0][nq][i] *= alpha; o[1][nq][i] *= alpha; } }
        bf16x8 pf[2];
#pragma unroll
        for (int ks = 0; ks < 2; ++ks) { const u32x4 w = {pkbf(t[8 * ks], t[8 * ks + 1]), pkbf(t[8 * ks + 2], t[8 * ks + 3]), pkbf(t[8 * ks + 4], t[8 * ks + 5]), pkbf(t[8 * ks + 6], t[8 * ks + 7])};
            pf[ks] = __builtin_bit_cast(bf16x8, w); }
#pragma unroll
        for (int db = 0; db < 2; ++db)
#pragma unroll
            for (int ks = 0; ks < 2; ++ks) o[db][nq] = __builtin_amdgcn_mfma_f32_32x32x16_bf16(__builtin_bit_cast(bf16x8, vf[db][ks]), pf[ks], o[db][nq], 0, 0, 0);
    }
}
__device__ __forceinline__ void phase_attn_lds(Frame& F) {
    const bf16* Q = (const bf16*)(F.ws + WS_Q); bf16* MIX = (bf16*)(F.ws + WS_MIX);
    const int g = F.wave >> 1, half = F.wave & 1, r = F.lane & 31, h = F.lane >> 5;
    __syncthreads();
    u32x4 rg[4];
    AtChunk ck = at_chunk(F.ws, 0, F.wg, F.G);
    if (!ck.any) return;
    at_issue(ck, F.tid, rg); at_write(ck, F.lds, F.tid, rg);
    __syncthreads();
    bf16x8 qf[2][4]; f32x16 o[2][2]; float m[2], l[2];
#pragma unroll 1
    for (int seq = 0; ck.any; ++seq) {
        LAS unsigned char* buf = F.lds + (seq & 1) * AT_BUF;
        const TItem ti = t_decode(F, seq < 10 ? 640 + (F.wg * NWAVES + F.wave) + seq * (F.G * NWAVES) : (1 << 30));
        t_dma(ti, F.lds + 2 * AT_BUF + F.wave * 8704, F.lane);
        const AtChunk nk = at_chunk(F.ws, seq + 1, F.wg, F.G);
        at_issue(nk, F.tid, rg);
        const int hd = ck.kvh * 4 + g, qs = ck.qb * 128 + half * 64;
        if (ck.c == 0) {
#pragma unroll
            for (int nq = 0; nq < 2; ++nq)
#pragma unroll
                for (int s2 = 0; s2 < 4; ++s2) qf[nq][s2] = *(const bf16x8*)(Q + (size_t)(ck.b * L + qs + 32 * nq + r) * 512 + hd * 64 + 16 * s2 + 8 * h);
#pragma unroll
            for (int db = 0; db < 2; ++db)
#pragma unroll
                for (int nq = 0; nq < 2; ++nq)
#pragma unroll
                    for (int i = 0; i < 16; ++i) o[db][nq][i] = 0.f;
            m[0] = m[1] = F.in[I_SINK][hd] * 1.4426950408889634f; l[0] = l[1] = (h == 0) ? 1.f : 0.f;
        }
        if (ck.valid) {
            int b0 = 0, b1 = 4;
            if (ck.local) { b0 = 2 * half - 4 * ck.lc; b0 = b0 < 0 ? 0 : b0; b1 = 2 * half + 10 - 4 * ck.lc; b1 = b1 > 4 ? 4 : b1; }
            if (b0 < b1) {
                bf16x8 kfA[4], kfB[4]; u32x4 vfA[2][2], vfB[2][2];
                at_load(buf, b0, r, h, kfA, vfA);
#pragma unroll 1
                for (int blk = b0; blk < b1; blk += 2) {
                    const int iA = 4 * ck.lc + blk - 2 * half, iB = iA + 1;
                    if (blk + 1 < b1) at_load(buf, blk + 1, r, h, kfB, vfB);
                    at_math(kfA, vfA, ck.local && (iA < 2 || iA > 7), 32 * iA - 128, r, h, qf, o, m, l);
                    if (blk + 1 < b1) {
                        if (blk + 2 < b1) at_load(buf, blk + 2, r, h, kfA, vfA);
                        at_math(kfB, vfB, ck.local && (iB < 2 || iB > 7), 32 * iB - 128, r, h, qf, o, m, l);
                    }
                }
            }
        }
        if (ck.c == 4) {
#pragma unroll
            for (int nq = 0; nq < 2; ++nq) {
                const float lt = half_sum(l[nq]), il = __builtin_amdgcn_rcpf(lt);
                bf16* orow = MIX + (size_t)(ck.b * L + qs + 32 * nq + r) * 1024 + 512 + hd * 64;
#pragma unroll
                for (int db = 0; db < 2; ++db)
#pragma unroll
                    for (int i4 = 0; i4 < 4; ++i4) { u32x2 w; w.x = pkbf(o[db][nq][4 * i4] * il, o[db][nq][4 * i4 + 1] * il); w.y = pkbf(o[db][nq][4 * i4 + 2] * il, o[db][nq][4 * i4 + 3] * il);
                        *(u32x2*)(orow + 32 * db + 8 * i4 + 4 * h) = w; }
            }
        }
        if (ti.ok) { asm volatile("s_waitcnt vmcnt(0)" ::: "memory"); t_store_dma(ti, (const LAS float*)(F.lds + 2 * AT_BUF + F.wave * 8704), F.lane); }
        at_write(nk, F.lds + ((seq + 1) & 1) * AT_BUF, F.tid, rg);
        __syncthreads();
        ck = nk;
    }
}

constexpr int F1_PC = 136, F1_PW = 68, F2_P = 264;
constexpr int F1_CSC = 0, F1_CSS = 128 * F1_PC * 2, F1_C64 = 2 * 128 * F1_PC * 2, F1_S64 = F1_C64 + 64 * F1_PW * 2;
__device__ __forceinline__ bf16x8 pack8(float a0, float a1, float a2, float a3, float a4, float a5, float a6, float a7) {
    const u32x4 w = {pkbf(a0, a1), pkbf(a2, a3), pkbf(a4, a5), pkbf(a6, a7)}; return __builtin_bit_cast(bf16x8, w); }
__device__ __forceinline__ void phase_fft1_mfma(Frame& F) {
    __syncthreads();
    LAS bf16* csc = (LAS bf16*)(F.lds + F1_CSC); LAS bf16* css = (LAS bf16*)(F.lds + F1_CSS); LAS bf16* c64 = (LAS bf16*)(F.lds + F1_C64); LAS bf16* s64 = (LAS bf16*)(F.lds + F1_S64);
    for (int i = F.tid; i < 128 * 128; i += NTHR) { const int n = i >> 7, k = i & 127; const float ang = (float)((n * k) & 127) * (6.283185307179586f / 128.f);
        csc[n * F1_PC + k] = (bf16)f2bf(__cosf(ang)); css[n * F1_PC + k] = (bf16)f2bf(__sinf(ang)); }
    for (int i = F.tid; i < 64 * 64; i += NTHR) { const int c = i >> 6, a = i & 63; const float ang = (float)((c * a) & 63) * (6.283185307179586f / 64.f);
        c64[c * F1_PW + a] = (bf16)f2bf(__cosf(ang)); s64[c * F1_PW + a] = (bf16)f2bf(__sinf(ang)); }
    __syncthreads();
    const bf16* UF = (const bf16*)(F.ws + WS_UF); bf16* Gb = (bf16*)(F.ws + WS_G);
    const int r = F.lane & 31, h = F.lane >> 5, g = F.wave >> 1;
    for (int item = F.wg; item < NB * FN2; item += F.G) {
        const int b = item >> 7, bp = item & 127;
#pragma unroll 1
        for (int q = 0; q < 2; ++q) {
            const int cbk = 2 * F.wave + q, n = 32 * (cbk & 3) + r, ch = 32 * cbk + r;
            f32x16 zr[2], zi[2];
#pragma unroll
            for (int rb = 0; rb < 2; ++rb) {
                bf16x8 uf[8];
#pragma unroll
                for (int s2 = 0; s2 < 8; ++s2) uf[s2] = *(const bf16x8*)(UF + (size_t)(b * L + 128 * (32 * rb + r) + bp) * 512 + g * 128 + 16 * s2 + 8 * h);
#pragma unroll
                for (int i = 0; i < 16; ++i) { zr[rb][i] = 0.f; zi[rb][i] = 0.f; }
#pragma unroll
                for (int s2 = 0; s2 < 8; ++s2) { const bf16x8 bc = *(const LAS bf16x8*)(csc + n * F1_PC + 16 * s2 + 8 * h), bs = *(const LAS bf16x8*)(css + n * F1_PC + 16 * s2 + 8 * h);
                    zr[rb] = __builtin_amdgcn_mfma_f32_32x32x16_bf16(uf[s2], bc, zr[rb], 0, 0, 0); zi[rb] = __builtin_amdgcn_mfma_f32_32x32x16_bf16(uf[s2], bs, zi[rb], 0, 0, 0); }
                __builtin_amdgcn_sched_barrier(0);
            }
            bf16x8 zfr[4], zfi[4];
#pragma unroll
            for (int ks = 0; ks < 4; ++ks) { const int rb = ks >> 1, o = 8 * (ks & 1);
                zfr[ks] = pack8(zr[rb][o], zr[rb][o + 1], zr[rb][o + 2], zr[rb][o + 3], zr[rb][o + 4], zr[rb][o + 5], zr[rb][o + 6], zr[rb][o + 7]);
                zfi[ks] = pack8(-zi[rb][o], -zi[rb][o + 1], -zi[rb][o + 2], -zi[rb][o + 3], -zi[rb][o + 4], -zi[rb][o + 5], -zi[rb][o + 6], -zi[rb][o + 7]); }
            __builtin_amdgcn_sched_barrier(0);
#pragma unroll 1
            for (int rbc = 0; rbc < 2; ++rbc) {
                f32x16 gr, gi; const int cr = 32 * rbc + r;
#pragma unroll
                for (int i = 0; i < 16; ++i) { gr[i] = 0.f; gi[i] = 0.f; }
#pragma unroll
                for (int ks = 0; ks < 4; ++ks) {
                    const u32x2 cl = *(const LAS u32x2*)(c64 + cr * F1_PW + 16 * ks + 4 * h), chh = *(const LAS u32x2*)(c64 + cr * F1_PW + 16 * ks + 8 + 4 * h);
                    const u32x2 sl = *(const LAS u32x2*)(s64 + cr * F1_PW + 16 * ks + 4 * h), shh = *(const LAS u32x2*)(s64 + cr * F1_PW + 16 * ks + 8 + 4 * h);
                    const u32x4 sw = {sl.x, sl.y, shh.x, shh.y}; const u32x4 swn = sw ^ 0x80008000u;
                    const bf16x8 wc = __builtin_bit_cast(bf16x8, ((u32x4){cl.x, cl.y, chh.x, chh.y})), wsn = __builtin_bit_cast(bf16x8, sw), wsm = __builtin_bit_cast(bf16x8, swn);
                    gr = __builtin_amdgcn_mfma_f32_32x32x16_bf16(wc, zfr[ks], gr, 0, 0, 0); gr = __builtin_amdgcn_mfma_f32_32x32x16_bf16(wsn, zfi[ks], gr, 0, 0, 0);
                    gi = __builtin_amdgcn_mfma_f32_32x32x16_bf16(wc, zfi[ks], gi, 0, 0, 0); gi = __builtin_amdgcn_mfma_f32_32x32x16_bf16(wsm, zfr[ks], gi, 0, 0, 0); }
                __builtin_amdgcn_sched_barrier(0);
#pragma unroll
                for (int i = 0; i < 16; ++i) { const int c = 32 * rbc + crow(i, h); const float ang = (float)(bp * c) * (6.283185307179586f / 8192.f), cs = __cosf(ang), sn = __sinf(ang);
                    const float re = gr[i] * cs + gi[i] * sn, im = gi[i] * cs - gr[i] * sn;
                    bf16* o = Gb + (size_t)((b * FN1 + c) * FN2 + bp) * 1024 + ch; o[0] = (bf16)f2bf(re); o[512] = (bf16)f2bf(im);
                    if ((i & 3) == 3) __builtin_amdgcn_sched_barrier(0); }
            }
        }
    }
    __syncthreads();
}
__device__ __forceinline__ void phase_fft2_mfma(Frame& F) {
    __syncthreads();
    LAS bf16* t2 = (LAS bf16*)F.lds;
    for (int i = F.tid; i < 128 * 256; i += NTHR) { const int d = i >> 8, k = i & 255; const float ang = (float)((d * (k & 127)) & 127) * (6.283185307179586f / 128.f);
        t2[d * F2_P + k] = (bf16)f2bf(k < 128 ? __cosf(ang) : __sinf(ang)); }
    __syncthreads();
    const bf16* Gb = (const bf16*)(F.ws + WS_G); bf16* MIX = (bf16*)(F.ws + WS_MIX);
    const int r = F.lane & 31, h = F.lane >> 5;
    for (int item = F.wg; item < NB * FN1; item += F.G) {
        const int b = item >> 6, c = item & 63;
        const bf16* Gp = Gb + (size_t)((b * FN1 + c) * FN2) * 1024 + 64 * F.wave + r;
        f32x16 y[4][2];
#pragma unroll
        for (int rb = 0; rb < 4; ++rb)
#pragma unroll
            for (int cb = 0; cb < 2; ++cb)
#pragma unroll
                for (int i = 0; i < 16; ++i) y[rb][cb][i] = 0.f;
        unsigned eA[2][8], eB[2][8];
#define F2_GATHER(dst, ks_) do { const bf16* p_ = Gp + (size_t)(16 * ((ks_) & 7) + 8 * h) * 1024 + ((ks_) >> 3) * 512; \
            _Pragma("unroll") for (int cb = 0; cb < 2; ++cb) _Pragma("unroll") for (int j = 0; j < 8; ++j) dst[cb][j] = p_[(size_t)j * 1024 + 32 * cb]; } while (0)
#define F2_MMA(src, ks_) do { bf16x8 bfr[2]; _Pragma("unroll") for (int cb = 0; cb < 2; ++cb) { \
                const u32x4 w = {src[cb][0] | (src[cb][1] << 16), src[cb][2] | (src[cb][3] << 16), src[cb][4] | (src[cb][5] << 16), src[cb][6] | (src[cb][7] << 16)}; bfr[cb] = __builtin_bit_cast(bf16x8, w); } \
            _Pragma("unroll") for (int rb = 0; rb < 4; ++rb) { const bf16x8 a = *(const LAS bf16x8*)(t2 + (32 * rb + r) * F2_P + 16 * (ks_) + 8 * h); \
                _Pragma("unroll") for (int cb = 0; cb < 2; ++cb) y[rb][cb] = __builtin_amdgcn_mfma_f32_32x32x16_bf16(a, bfr[cb], y[rb][cb], 0, 0, 0); } } while (0)
        F2_GATHER(eA, 0);
#pragma unroll 1
        for (int ks = 0; ks < 16; ks += 2) {
            F2_GATHER(eB, ks + 1);
            F2_MMA(eA, ks);
            if (ks + 2 < 16) F2_GATHER(eA, ks + 2);
            F2_MMA(eB, ks + 1);
        }
#undef F2_GATHER
#undef F2_MMA
#pragma unroll
        for (int rb = 0; rb < 4; ++rb)
#pragma unroll
            for (int cb = 0; cb < 2; ++cb)
#pragma unroll
                for (int i = 0; i < 16; ++i) { const int d = 32 * rb + crow(i, h); MIX[(size_t)(b * L + c + 64 * d) * 1024 + 64 * F.wave + 32 * cb + r] = (bf16)f2bf(y[rb][cb][i] * (1.f / 1024.f)); }
    }
    __syncthreads();
}


typedef float f32x2_t __attribute__((ext_vector_type(2)));
template <int IR> struct DwIn {
    static __device__ __forceinline__ void run(const unsigned (&uin)[62], const f32x2_t (&w)[31], f32x2_t (&o)[32]) {
        const f32x2_t x = {bflo(uin[IR]), bfhi(uin[IR])};
#pragma unroll
        for (int r = 0; r < 32; ++r) { if (IR - r >= 0 && IR - r <= 30) o[r] += w[(IR - r >= 0 && IR - r <= 30) ? IR - r : 0] * x; }
        DwIn<IR + 1>::run(uin, w, o);
    }
};
template <> struct DwIn<62> { static __device__ __forceinline__ void run(const unsigned (&)[62], const f32x2_t (&)[31], f32x2_t (&)[32]) {} };
template <int IR> struct DwIn16 {
    static __device__ __forceinline__ void run(const unsigned (&uin)[46], const f32x2_t (&w)[31], f32x2_t (&o)[16]) {
        const f32x2_t x = {bflo(uin[IR]), bfhi(uin[IR])};
#pragma unroll
        for (int r = 0; r < 16; ++r) { if (IR - r >= 0 && IR - r <= 30) o[r] += w[(IR - r >= 0 && IR - r <= 30) ? IR - r : 0] * x; }
        DwIn16<IR + 1>::run(uin, w, o);
    }
};
template <> struct DwIn16<46> { static __device__ __forceinline__ void run(const unsigned (&)[46], const f32x2_t (&)[31], f32x2_t (&)[16]) {} };
__device__ __forceinline__ void phase_dwconv_fast(Frame& F) {
    const bf16* U = (const bf16*)(F.ws + WS_U); bf16* V1 = (bf16*)(F.ws + WS_V1);
    const float* dww = F.in[I_DWW];
    const int c0 = 2 * F.tid;
    f32x2_t w[31];
#pragma unroll
    for (int j = 0; j < 31; ++j) w[j] = *(const f32x2_t*)(dww + (size_t)j * D + c0);
    const f32x2_t bb = *(const f32x2_t*)(F.in[I_DWB] + c0), gg = *(const f32x2_t*)(F.in[I_LNG] + c0), lb = *(const f32x2_t*)(F.in[I_LNB] + c0);
    LAS float* red = (LAS float*)F.lds;
    LAS float* stat = red + 16 * 8 * 2;
    __syncthreads();
    for (int run = F.wg; run < T / 128; run += F.G) {
        const int row0 = run * 128, l0 = row0 & (L - 1);
        unsigned uin[46], nx[16];
#pragma unroll
        for (int ir = 0; ir < 46; ++ir) { const int l = l0 - 15 + ir; const bool ok = (l >= 0 && l < L);
            const unsigned u = *(const unsigned*)(U + (size_t)(ok ? row0 - 15 + ir : row0) * D + c0); uin[ir] = ok ? u : 0u; }
#pragma unroll 1
        for (int step = 0; step < 8; ++step) {
            const int r0 = row0 + 16 * step;
            if (step < 7) {
#pragma unroll
                for (int j = 0; j < 16; ++j) { const int l = l0 + 16 * step + 31 + j; const bool ok = l < L;
                    const unsigned u = *(const unsigned*)(U + (size_t)(ok ? r0 + 31 + j : r0) * D + c0); nx[j] = ok ? u : 0u; }
            }
            f32x2_t o[16];
#pragma unroll
            for (int r = 0; r < 16; ++r) o[r] = bb;
            DwIn16<0>::run(uin, w, o);
#pragma unroll
            for (int r = 0; r < 16; ++r) { const float sm = wave_sum(o[r].x + o[r].y), sq = wave_sum(o[r].x * o[r].x + o[r].y * o[r].y);
                if (F.lane == 0) { red[(r * 8 + F.wave) * 2] = sm; red[(r * 8 + F.wave) * 2 + 1] = sq; } }
            __syncthreads();
            if (F.tid < 16) { float sm = 0.f, sq = 0.f;
#pragma unroll
                for (int wv = 0; wv < 8; ++wv) { sm += red[(F.tid * 8 + wv) * 2]; sq += red[(F.tid * 8 + wv) * 2 + 1]; }
                const float mean = sm * (1.f / D), var = fmaxf(sq * (1.f / D) - mean * mean, 0.f);
                stat[2 * F.tid] = mean; stat[2 * F.tid + 1] = rsqrtf(var + EPS); }
            __syncthreads();
#pragma unroll
            for (int r = 0; r < 16; ++r) { const float mean = stat[2 * r], rstd = stat[2 * r + 1];
                const float y0 = silu_f((o[r].x - mean) * rstd * gg.x + lb.x), y1 = silu_f((o[r].y - mean) * rstd * gg.y + lb.y);
                *(unsigned*)(V1 + (size_t)(r0 + r) * D + c0) = pkbf(y0, y1); }
#pragma unroll
            for (int i = 0; i < 30; ++i) uin[i] = uin[i + 16];
#pragma unroll
            for (int j = 0; j < 16; ++j) uin[30 + j] = nx[j];
        }
        __syncthreads();
    }
}

namespace pg {
struct MU { const char* B; const char* A; int K, type, e, rt, pn, hb, buf; };
struct MoeMergedSched {
    const char* Wgu; const char* Wdn; const char* HBp; const char* HIDp; const int* list; const float* wlist; LAS int* mm; unsigned* tcnt; unsigned* tmo; int G, c, U;
    __device__ __forceinline__ bool flat(int L, int type, MU& u) const {
        for (int e = 0; e < 16; ++e) { const int n = mm[e], nu = ((n + 255) >> 8) * 4;
            if (L < nu) { u.e = e; u.rt = L >> 2; u.pn = L & 3; u.hb = mm[16 + e]; u.type = type; u.buf = 0;
                if (type == 0) { u.K = D; u.A = HBp; u.B = Wgu + (size_t)e * (1024 * 1024 * 2) + (size_t)u.pn * BM * D * 2; }
                else { u.K = FF; u.A = HIDp; u.B = Wdn + (size_t)e * (1024 * 512 * 2) + (size_t)u.pn * BM * FF * 2; }
                return true; }
            L -= nu; }
        return false;
    }
    __device__ __forceinline__ bool next(int i, MU& u) const {
        const int ngu = c < U ? (U - 1 - c) / G + 1 : 0;
        if (i < ngu) return flat(i * G + c, 0, u);
        const int k = i - ngu, x = U % G; int j;
        if (c >= x) { if (k == 0) j = c - x; else j = (G - 1 - c) + (k - 1) * G + (G - x); } else j = (G - 1 - c) + k * G + (G - x);
        if (j >= U) return false;
        return flat(j, 1, u);
    }
    __device__ __forceinline__ unsigned voff(const MU& u, int buf, LAS unsigned char* lds, int R, int C) const {
        if (u.type == 0) { const int tok = ((const LAS int*)(lds + TAB_OFF))[buf * 256 + R]; return (unsigned)((tok * D + C) * 2); }
        return (unsigned)(((u.hb + u.rt * BM + R) * FF + C) * 2);
    }
    __device__ __forceinline__ void stage_table(const MU& u, int buf, LAS unsigned char* lds, int wid, int lane) const {
        const int r = (wid & 3) * 64 + lane;
        __builtin_amdgcn_global_load_lds((const unsigned*)(list + u.e * CAP + u.rt * BM + r), (LAS unsigned*)(lds + TAB_OFF + buf * 1024 + (wid & 3) * 256), 4, 0, 0);
        __builtin_amdgcn_global_load_lds((const unsigned*)(wlist + u.e * CAP + u.rt * BM + r), (LAS unsigned*)(lds + TAB_OFF + 2048 + buf * 1024 + (wid & 3) * 256), 4, 0, 0);
    }
    __device__ __forceinline__ unsigned* tile_word(const MU& u) const { return tcnt + ((u.hb >> 8) + u.rt) * 64; }
    __device__ __forceinline__ void wait_ready(const MU& u, int wid) const {
        if (wid == 0) {
            unsigned* w = tile_word(u); unsigned spins = 0;
            while ((unsigned)__builtin_amdgcn_readfirstlane(__hip_atomic_load(w, __ATOMIC_RELAXED, __HIP_MEMORY_SCOPE_AGENT)) < 32u) {
                __builtin_amdgcn_s_sleep(2);
                if ((++spins & 255u) == 0u) { if (__builtin_amdgcn_readfirstlane(__hip_atomic_load(tmo, __ATOMIC_RELAXED, __HIP_MEMORY_SCOPE_AGENT)) != 0u) break;
                    if (spins > (1u << 20)) { __hip_atomic_store(tmo, 1u, __ATOMIC_RELAXED, __HIP_MEMORY_SCOPE_AGENT); break; } } }
        }
        asm volatile("" ::: "memory"); __builtin_amdgcn_s_barrier(); asm volatile("" ::: "memory");
    }
};
struct EpiGateUpWT {
    __amdgpu_buffer_rsrc_t rsrc; LAS unsigned char* lds; LAS int* mm;
    __device__ __forceinline__ void operator()(const f32x4 (&acc)[2][2][4][2], const MU& u, int wr, int wc, int fr, int fq) const {
        const int e = u.e, n_e = mm[e], r0 = u.rt * BM + wr * 64 + fr, col0 = u.pn * HALF + wc * 32 + 8 * fq;
        float wv[2][4];
#pragma unroll
        for (int ai = 0; ai < 2; ++ai)
#pragma unroll
            for (int m = 0; m < 4; ++m) wv[ai][m] = ((const LAS float*)(lds + TAB_OFF + 2048))[u.buf * 256 + wr * 64 + fr + ai * HALF + m * 16];
#pragma unroll
        for (int ai = 0; ai < 2; ++ai)
#pragma unroll
            for (int m = 0; m < 4; ++m) { const int r = r0 + ai * HALF + m * 16;
                if (r < n_e) { const float w = wv[ai][m]; f32x4 o[2];
#pragma unroll
                    for (int n = 0; n < 2; ++n) { const f32x4 g = acc[ai][0][m][n], up = acc[ai][1][m][n];
#pragma unroll
                        for (int j = 0; j < 4; ++j) o[n][j] = w * silu_f(g[j]) * up[j]; }
                    u32x4 q; q.x = cvt_pk_bf16(o[0][0], o[0][1]); q.y = cvt_pk_bf16(o[0][2], o[0][3]); q.z = cvt_pk_bf16(o[1][0], o[1][1]); q.w = cvt_pk_bf16(o[1][2], o[1][3]);
                    __builtin_amdgcn_raw_buffer_store_b128(q, rsrc, (unsigned)(((u.hb + r) * FF + col0) * 2), 0, 16); } }
    }
};
struct EpiDownM {
    unsigned char* Y8; LAS int* mm;
    __device__ __forceinline__ void operator()(const f32x4 (&acc)[2][2][4][2], const MU& u, int wr, int wc, int fr, int fq) const {
        const int e = u.e, n_e = mm[e], r0 = u.rt * BM + wr * 64 + fr, col0 = u.pn * BM + 64 * wc + 16 * fq;
#pragma unroll
        for (int ai = 0; ai < 2; ++ai)
#pragma unroll
            for (int m = 0; m < 4; ++m) { const int r = r0 + ai * HALF + m * 16;
                if (r < n_e) { u32x4 q; q.x = pk_fp8x4(acc[ai][0][m][0]); q.y = pk_fp8x4(acc[ai][0][m][1]); q.z = pk_fp8x4(acc[ai][1][m][0]); q.w = pk_fp8x4(acc[ai][1][m][1]);
                    *(u32x4*)(Y8 + (size_t)(u.hb + r) * D + col0) = q; } }
    }
};
__device__ __forceinline__ void gemm_phase_moe(LAS unsigned char* lds, const MoeMergedSched& S, const EpiGateUpWT& EA, const EpiDownM& EB) {
    const int tid = threadIdx.x, wid = __builtin_amdgcn_readfirstlane(tid >> 6), lane = tid & 63, wr = wid >> 2, wc = wid & 3, fr = lane & 15, fq = lane >> 4;
    int sR[2], sC[2]; unsigned vbA[2], vbD[2];
#pragma unroll
    for (int i = 0; i < 2; ++i) { int R, C; stage_rc(tid * 16 + i * 8192, R, C); sR[i] = R; sC[i] = C; const int Rb = (R & ~31) + perm32(R & 31);
        const int RbD = 64 * ((Rb >> 5) & 3) + 16 * ((Rb >> 3) & 3) + (Rb & 7);
        vbA[i] = (unsigned)(Rb * D + C) * 2u; vbD[i] = (unsigned)(RbD * FF + C) * 2u; }
    const size_t kstep = (size_t)(BK * 2);
    const unsigned ldsw = (unsigned)wid * 1024u;
    const int aoff = lds_byte(wr * 64 + fr, fq * 8), boff = lds_byte(wc * 32 + fr, fq * 8);
#define PG_SA(b, h) (((b) * 2 + (h)) * HTB)
#define PG_SB(b, h) ((4 + (b) * 2 + (h)) * HTB)
#define PG_STAGE(bufoff, gbase, voff) do { _Pragma("unroll") for (int _i = 0; _i < 2; ++_i) \
        __builtin_amdgcn_global_load_lds((const unsigned*)((const char*)(gbase) + (voff)[_i]), (LAS unsigned*)(lds + (bufoff) + ldsw + _i * 8192), 16, 0, 0); } while (0)
#define PG_LDA(dst, b, h) do { _Pragma("unroll") for (int m = 0; m < 4; ++m) _Pragma("unroll") for (int k = 0; k < 2; ++k) dst[m][k] = *(const LAS bf16x8*)(lds + PG_SA(b, h) + aoff + m * 2048 + k * 1024); } while (0)
#define PG_LDB(dst, b, h) do { _Pragma("unroll") for (int n = 0; n < 2; ++n) _Pragma("unroll") for (int k = 0; k < 2; ++k) dst[n][k] = *(const LAS bf16x8*)(lds + PG_SB(b, h) + boff + n * 2048 + k * 1024); } while (0)
#define PG_MMA(ai, bj, At, Bt) do { __builtin_amdgcn_s_setprio(1); _Pragma("unroll") for (int m = 0; m < 4; ++m) _Pragma("unroll") for (int n = 0; n < 2; ++n) _Pragma("unroll") for (int k = 0; k < 2; ++k) \
        acc[ai][bj][m][n] = __builtin_amdgcn_mfma_f32_16x16x32_bf16(Bt[n][k], At[m][k], acc[ai][bj][m][n], 0, 0, 0); __builtin_amdgcn_s_setprio(0); } while (0)
#define PG_WAIT_V(n) asm volatile("s_waitcnt vmcnt(" #n ")" ::: "memory")
#define PG_WAIT_L(n) asm volatile("s_waitcnt lgkmcnt(" #n ")" ::: "memory")
#define PG_BAR __builtin_amdgcn_s_barrier()
#define PG_SCHED __builtin_amdgcn_sched_barrier(0)
    MU cur, nxt; int ui = 0;
    if (!S.next(0, cur)) return;
    cur.buf = 0;
    f32x4 acc[2][2][4][2];
#pragma unroll
    for (int a = 0; a < 2; ++a)
#pragma unroll
        for (int b = 0; b < 2; ++b)
#pragma unroll
            for (int m = 0; m < 4; ++m)
#pragma unroll
                for (int n = 0; n < 2; ++n) acc[a][b][m][n] = (f32x4){0.f, 0.f, 0.f, 0.f};
    bf16x8 At[4][2], B0[2][2], B1[2][2];
    if (cur.type == 0) { S.stage_table(cur, 0, lds, wid, lane); PG_WAIT_V(0); PG_BAR; } else S.wait_ready(cur, wid);
    unsigned voC[2][2], voN[2][2];
#pragma unroll
    for (int h = 0; h < 2; ++h)
#pragma unroll
        for (int i = 0; i < 2; ++i) { voC[h][i] = S.voff(cur, 0, lds, h * HALF + sR[i], sC[i]); voN[h][i] = voC[h][i]; }
    const char* cB = cur.B; const char* cA = cur.A; size_t hsC = (size_t)(cur.type == 0 ? HALF : 8) * cur.K * 2; int nt = cur.K / BK;
    if (cur.type == 0) { PG_STAGE(PG_SB(0, 0), cB, vbA); PG_STAGE(PG_SB(0, 1), cB + hsC, vbA); } else { PG_STAGE(PG_SB(0, 0), cB, vbD); PG_STAGE(PG_SB(0, 1), cB + hsC, vbD); }
    PG_STAGE(PG_SA(0, 0), cA, voC[0]); PG_STAGE(PG_SA(0, 1), cA, voC[1]);
    if (wr == 1) PG_BAR;
    PG_WAIT_V(2); PG_BAR;
    if (cur.type == 0) { PG_STAGE(PG_SB(1, 0), cB + kstep, vbA); } else { PG_STAGE(PG_SB(1, 0), cB + kstep, vbD); }
    PG_STAGE(PG_SA(1, 0), cA + kstep, voC[0]);
    if (cur.type == 0) { PG_STAGE(PG_SB(1, 1), cB + hsC + kstep, vbA); } else { PG_STAGE(PG_SB(1, 1), cB + hsC + kstep, vbD); }
    PG_WAIT_V(6); PG_BAR;
    for (;;) {
        const bool has_next = S.next(ui + 1, nxt); nxt.buf = (ui + 1) & 1;
        if (has_next && nxt.type == 0) S.stage_table(nxt, (ui + 1) & 1, lds, wid, lane);
        const char* nB = has_next ? nxt.B : cB; const char* nA = has_next ? nxt.A : cA; const size_t hsN = has_next ? (size_t)(nxt.type == 0 ? HALF : 8) * nxt.K * 2 : hsC;
        for (int t = 0; t < nt; t += 2) {
            const bool last = (t == nt - 2);
            if (last && has_next) {
                if (nxt.type == 1) S.wait_ready(nxt, wid);
#pragma unroll
                for (int h = 0; h < 2; ++h)
#pragma unroll
                    for (int i = 0; i < 2; ++i) voN[h][i] = S.voff(nxt, (ui + 1) & 1, lds, h * HALF + sR[i], sC[i]);
            }
            unsigned vo2[2][2], vb2[2]; const bool b2gu = last ? (has_next ? nxt.type == 0 : cur.type == 0) : (cur.type == 0);
#pragma unroll
            for (int h = 0; h < 2; ++h)
#pragma unroll
                for (int i = 0; i < 2; ++i) vo2[h][i] = last ? voN[h][i] : voC[h][i];
#pragma unroll
            for (int i = 0; i < 2; ++i) vb2[i] = b2gu ? vbA[i] : vbD[i];
            const size_t hs2 = last ? hsN : hsC;
            const char* a1 = cA + (size_t)(t + 1) * kstep;
            const char* a2 = last ? nA : cA + (size_t)(t + 2) * kstep; const char* b2 = last ? nB : cB + (size_t)(t + 2) * kstep;
            const char* a3 = a2 + kstep; const char* b3 = b2 + kstep;
            PG_LDB(B0, 0, 0); PG_LDB(B1, 0, 1); PG_SCHED; PG_LDA(At, 0, 0); PG_STAGE(PG_SA(1, 1), a1, voC[1]);
            PG_WAIT_V(8); PG_WAIT_L(0); PG_BAR; PG_MMA(0, 0, At, B0); PG_MMA(0, 1, At, B1); PG_BAR; PG_SCHED;
            PG_LDA(At, 0, 1); PG_STAGE(PG_SB(0, 0), b2, vb2); PG_STAGE(PG_SB(0, 1), b2 + hs2, vb2); PG_STAGE(PG_SA(0, 0), a2, vo2[0]);
            PG_WAIT_V(8); PG_WAIT_L(0); PG_BAR; PG_MMA(1, 0, At, B0); PG_MMA(1, 1, At, B1); PG_BAR; PG_SCHED;
            PG_LDB(B0, 1, 0); PG_LDB(B1, 1, 1); PG_SCHED; PG_LDA(At, 1, 0); PG_STAGE(PG_SA(0, 1), a2, vo2[1]);
            PG_WAIT_V(8); PG_WAIT_L(0); PG_BAR; PG_MMA(0, 0, At, B0); PG_MMA(0, 1, At, B1); PG_BAR; PG_SCHED;
            PG_LDA(At, 1, 1); PG_STAGE(PG_SB(1, 0), b3, vb2); PG_STAGE(PG_SB(1, 1), b3 + hs2, vb2); PG_STAGE(PG_SA(1, 0), a3, vo2[0]);
            PG_WAIT_V(8); PG_WAIT_L(0); PG_BAR; PG_MMA(1, 0, At, B0); PG_MMA(1, 1, At, B1); PG_BAR; PG_SCHED;
        }
        if (wr == 0) PG_BAR;
        if (cur.type == 0) { EA(acc, cur, wr, wc, fr, fq);
            PG_WAIT_V(0);
            if (lane == 0) __hip_atomic_fetch_add(S.tile_word(cur), 1u, __ATOMIC_RELAXED, __HIP_MEMORY_SCOPE_AGENT); }
        else EB(acc, cur, wr, wc, fr, fq);
        if (!has_next) break;
#pragma unroll
        for (int a = 0; a < 2; ++a)
#pragma unroll
            for (int b = 0; b < 2; ++b)
#pragma unroll
                for (int m = 0; m < 4; ++m)
#pragma unroll
                    for (int n = 0; n < 2; ++n) acc[a][b][m][n] = (f32x4){0.f, 0.f, 0.f, 0.f};
        cur = nxt; cB = nB; cA = nA; hsC = hsN; nt = cur.K / BK; ++ui;
#pragma unroll
        for (int h = 0; h < 2; ++h)
#pragma unroll
            for (int i = 0; i < 2; ++i) voC[h][i] = voN[h][i];
        if (wr == 1) PG_BAR;
    }
    PG_WAIT_V(0);
    PG_BAR;
#undef PG_SA
#undef PG_SB
#undef PG_STAGE
#undef PG_LDA
#undef PG_LDB
#undef PG_MMA
#undef PG_WAIT_V
#undef PG_WAIT_L
#undef PG_BAR
#undef PG_SCHED
}
}
__device__ __forceinline__ void fast_moe_merged(Frame& F, int layer) {
    LAS int* mm = moe_map(F, layer);
    int U = 0;
    for (int e = 0; e < 16; ++e) U += ((mm[e] + 255) >> 8) * 4;
    pg::MoeMergedSched S{(const char*)(F.ws + WS_WGU) + (size_t)layer * 16 * 1024 * 1024 * 2, (const char*)(F.ws + WS_WDN) + (size_t)layer * 16 * 1024 * 512 * 2,
                         (const char*)(F.ws + WS_HB), (const char*)(F.ws + WS_HID), (const int*)(F.ws + WS_SLOTT) + layer * 16 * CAP, (const float*)(F.ws + WS_SLOTW) + layer * 16 * CAP, mm,
                         F.ctl + CW_TILE + layer * 288 * 64, F.ctl + CW_TMO2, F.G, F.wg, U};
    pg::EpiGateUpWT EA{__builtin_amdgcn_make_buffer_rsrc((void*)(F.ws + WS_HID), 0, HROWS * FF * 2, 0x00020000), F.lds, mm};
    pg::EpiDownM EB{(unsigned char*)(F.ws + WS_Y), mm};
    pg::gemm_phase_moe(F.lds, S, EA, EB);
}

constexpr int NPH = 18;
__global__ void __launch_bounds__(NTHR, 2) mega(Args args) {
    extern __shared__ __attribute__((aligned(16))) unsigned char lds[];
    Frame F;
    F.lds = (LAS unsigned char*)lds;
    F.tid = threadIdx.x; F.lane = F.tid & 63; F.wave = __builtin_amdgcn_readfirstlane(F.tid >> 6);
    F.G = gridDim.x; F.wg = blockIdx.x;
    F.out = args.out; F.ws = args.ws; F.ctl = (unsigned*)(args.ws + WS_CTL);
    volatile LAS unsigned* bst = (volatile LAS unsigned*)(F.lds + LDS_BYTES - 16);
    if (F.tid < 4) bst[F.tid] = 0u;
    __syncthreads();
    const int lo = args.ph_lo, hi = args.ph_hi;
    XcdBarrier bar; bar.bar = F.ctl + CW_BAR; bar.x = 0; bar.st = bst;
    if (hi - lo > 1) bar = xcd_barrier_post(F.ctl + CW_BAR, bst);
#define IN(k) (lo <= (k) && (k) < hi)
#define SEAM(k) do { if (IN(k) && IN((k) + 1)) xcd_barrier(bar); } while (0)
    const float* mod = (const float*)(F.ws + WS_MOD);

#ifndef DBL_MASK
#define DBL_MASK 0x0u
#endif
#define RUN(k, body) do { if (IN(k)) { _Pragma("unroll 1") for (int _r = 0; _r < ((((DBL_MASK) >> (k)) & 1u) ? 2 : 1); ++_r) { if (_r) xcd_barrier(bar); F.lane = fresh_lane(); body; } } } while (0)
    RUN(0, phase_prep(F)); SEAM(0);
    RUN(1, phase_norm1_l0(F)); SEAM(1);
    RUN(2, if (FAST_GEMM) fast_inproj(F); else phase_inproj(F)); SEAM(2);
    if (IN(3)) { F.lane = fresh_lane();
#pragma unroll 1
        for (int _r = 0; _r < ((DBL_MASK & 0x100000u) ? 2 : 1); ++_r) { if (FAST_ATTN == 2 && FAST_GEMM) phase_attn_lds(F); else if (FAST_ATTN && FAST_GEMM) phase_attn_mfma(F); else phase_attn_simple(F); }
#pragma unroll 1
        for (int _r = 0; _r < ((DBL_MASK & 0x200000u) ? 2 : 1); ++_r) { if (FAST_FFT) phase_fft1_mfma(F); else phase_fft1_simple(F); }
    } SEAM(3);
    RUN(4, if (FAST_FFT) phase_fft2_mfma(F); else phase_fft2_simple(F)); SEAM(4);
    if (IN(5)) { if (!FAST_FFT) phase_fft3_simple(F); } if (!FAST_FFT) SEAM(5);
    RUN(6, if (FAST_GEMM) fast_outproj(F, WS_MIX, WS_WOUT, F.in[I_X], F.out, mod + 2048, nullptr); else phase_outproj(F, (const bf16*)(F.ws + WS_MIX), (const bf16*)(F.ws + WS_WOUT), F.in[I_X], F.out, mod + 2048, nullptr)); SEAM(6);
    if (IN(7)) { F.lane = fresh_lane(); if (XBF16) phase_norm2_route_mfma(F, 0); else phase_norm2_route(F, 0); } SEAM(7);
    if (MOE_MERGED && FAST_GEMM) { if (IN(8)) { F.lane = fresh_lane(); fast_moe_merged(F, 0); } if (IN(8) && IN(10)) xcd_barrier(bar); }
    else { RUN(8, if (FAST_GEMM) fast_moe_gateup(F, 0); else phase_moe_gateup(F, 0)); SEAM(8);
    RUN(9, if (FAST_GEMM) fast_moe_down(F, 0); else phase_moe_down(F, 0)); SEAM(9); }
    if (IN(10)) { F.lane = fresh_lane(); phase_combine<false>(F, 0); } SEAM(10);
    RUN(11, if (FAST_GEMM) fast_pw1(F); else phase_pw1(F)); SEAM(11);
    RUN(12, phase_dwconv_fast(F)); SEAM(12);
    if (IN(13)) { F.lane = fresh_lane(); if (FAST_GEMM) fast_outproj(F, WS_V1, WS_WPW2, F.out, F.out, mod + 5 * 6144 + 2048, F.in[I_PW2B]); else phase_outproj(F, (const bf16*)(F.ws + WS_V1), (const bf16*)(F.ws + WS_WPW2), F.out, F.out, mod + 5 * 6144 + 2048, F.in[I_PW2B]); } SEAM(13);
    if (IN(14)) { F.lane = fresh_lane(); if (XBF16) phase_norm2_route_mfma(F, 1); else phase_norm2_route(F, 1); } SEAM(14);
    if (MOE_MERGED && FAST_GEMM) { if (IN(15)) { F.lane = fresh_lane(); fast_moe_merged(F, 1); } if (IN(15) && IN(17)) xcd_barrier(bar); }
    else { RUN(15, if (FAST_GEMM) fast_moe_gateup(F, 1); else phase_moe_gateup(F, 1)); SEAM(15);
    RUN(16, if (FAST_GEMM) fast_moe_down(F, 1); else phase_moe_down(F, 1)); SEAM(16); }
    if (IN(17)) { F.lane = fresh_lane(); phase_combine<true>(F, 1); }
#undef RUN
#undef IN
#undef SEAM
}

extern "C" void kernel_launch(void* const* d_in, const int* in_sizes, int n_in, void* d_out, int out_size, void* d_ws, size_t ws_size, hipStream_t stream) {
    static int grid = 0;
    if (grid == 0) {
        if (n_in != 25 || out_size != T * D || ws_size < WS_END) { fprintf(stderr, "kernel_launch: unexpected shapes (n_in %d out %d ws %zu)\n", n_in, out_size, ws_size); grid = -1; return; }
        int dev = 0, cus = 0, per_cu = 0;
        if (hipGetDevice(&dev) != hipSuccess || hipDeviceGetAttribute(&cus, hipDeviceAttributeMultiprocessorCount, dev) != hipSuccess) { grid = -1; return; }
        if (hipFuncSetAttribute((const void*)mega, hipFuncAttributeMaxDynamicSharedMemorySize, LDS_BYTES) != hipSuccess) { fprintf(stderr, "kernel_launch: hipFuncSetAttribute failed\n"); grid = -1; return; }
        if (hipOccupancyMaxActiveBlocksPerMultiprocessor(&per_cu, (const void*)mega, NTHR, LDS_BYTES) != hipSuccess || per_cu < 1) { fprintf(stderr, "kernel_launch: occupancy query says %d\n", per_cu); }
        (void)hipGetLastError();
        grid = cus;
    }
    if (grid < 0) return;
    (void)hipMemsetAsync((char*)d_ws + WS_CTL, 0, CTL_BYTES, stream);
    Args a{};
    for (int i = 0; i < 25; ++i) a.in[i] = (const float*)d_in[i];
    a.out = (float*)d_out; a.ws = (unsigned char*)d_ws;
#if MK_ONE_LAUNCH
    a.ph_lo = 0; a.ph_hi = NPH;
    hipLaunchKernelGGL(mega, dim3(grid), dim3(NTHR), LDS_BYTES, stream, a);
#else
#ifndef PROBE_PHASE
#define PROBE_PHASE -1
#endif
    for (int p = 0; p < NPH; ++p) { a.ph_lo = p; a.ph_hi = p + 1; hipLaunchKernelGGL(mega, dim3(grid), dim3(NTHR), LDS_BYTES, stream, a);
        if (p == PROBE_PHASE) { if (p == 7 || p == 14) (void)hipMemsetAsync((char*)d_ws + WS_CTL, 0, CTL_BYTES, stream);
            hipLaunchKernelGGL(mega, dim3(grid), dim3(NTHR), LDS_BYTES, stream, a); } }
#endif
}
```

```cpp
#include <hip/hip_runtime.h>
#include <cstdio>

#ifndef MK_ONE_LAUNCH
#define MK_ONE_LAUNCH 1
#endif

#define GAS __attribute__((address_space(1)))
#define LAS __attribute__((address_space(3)))
typedef unsigned short bf16;
typedef short bf16x8 __attribute__((ext_vector_type(8)));
typedef float f32x4 __attribute__((ext_vector_type(4)));
typedef float f32x16 __attribute__((ext_vector_type(16)));
typedef unsigned u32x4 __attribute__((ext_vector_type(4)));
typedef unsigned u32x2 __attribute__((ext_vector_type(2)));

constexpr int D = 1024, NB = 4, L = 8192, T = NB * L, CL = 256, TC = NB * CL;
constexpr int NE = 16, FF = 512, CONVW = 31;
constexpr int N_IN = 1280;
constexpr int FN1 = 64, FN2 = 128;
#ifndef FAST_GEMM
#define FAST_GEMM 1
#endif
#ifndef MOE_MERGED
#define MOE_MERGED 1
#endif
#ifndef XBF16
#define XBF16 FAST_GEMM
#endif
#ifndef FAST_ATTN
#define FAST_ATTN 2
#endif
#ifndef FAST_FFT
#define FAST_FFT 1
#endif
constexpr int IL = FAST_GEMM ? 128 : 32;
constexpr float EPS = 1e-6f;
constexpr int NWAVES = 8, NTHR = 512;
constexpr int CAP = 32768;
constexpr int HROWS = 65536 + 4096;

constexpr size_t MiB = 1u << 20;
constexpr size_t WS_CTL = 0, CTL_BYTES = 1 * MiB;
constexpr size_t WS_MOD = 1 * MiB;
constexpr size_t WS_TW = 1 * MiB + 512 * 1024;
constexpr size_t WS_WIN = 2 * MiB, WS_WOUT = 6 * MiB, WS_WPW1 = 10 * MiB, WS_WPW2 = 14 * MiB;
constexpr size_t WS_WGU = 16 * MiB, WS_WDN = 80 * MiB;
constexpr size_t WS_TOKE = 112 * MiB, WS_TOKP = 113 * MiB, WS_TOKW = 114 * MiB;
constexpr size_t WS_SLOTT = 116 * MiB, WS_SLOTW = 120 * MiB;
constexpr size_t WS_HB = 128 * MiB;
constexpr size_t WS_UF = 196 * MiB, WS_Q = 228 * MiB, WS_K = 260 * MiB, WS_V = 268 * MiB, WS_CK = 276 * MiB, WS_CV = 277 * MiB;
constexpr size_t WS_G = 280 * MiB, WS_MIX = 344 * MiB, WS_AB = 408 * MiB;
constexpr size_t WS_XB = 408 * MiB;
constexpr size_t WS_HID = 196 * MiB, WS_Y = 264 * MiB;
constexpr size_t WS_U = 196 * MiB, WS_V1 = 260 * MiB;
constexpr size_t WS_END = 472 * MiB;
constexpr int CW_BAR = 4096;
constexpr int CW_CNT = 8192;
constexpr int CW_TILE = 16384;
constexpr int CW_TMO2 = 2048;

constexpr int LDS_BYTES = 147456;

__device__ __forceinline__ unsigned f2bf(float f) { unsigned u = __float_as_uint(f); return (u + 0x7fffu + ((u >> 16) & 1u)) >> 16; }
__device__ __forceinline__ float bf2f(unsigned b) { return __uint_as_float(b << 16); }
typedef __bf16 b16x2_t __attribute__((ext_vector_type(2)));
__device__ __forceinline__ unsigned pkbf(float a, float b) { typedef float f2 __attribute__((ext_vector_type(2))); f2 v = {a, b}; return __builtin_bit_cast(unsigned, __builtin_convertvector(v, b16x2_t)); }
__device__ __forceinline__ unsigned pk2(float lo, float hi) { return pkbf(lo, hi); }
__device__ __forceinline__ float bflo(unsigned w) { return __uint_as_float(w << 16); }
__device__ __forceinline__ float bfhi(unsigned w) { return __uint_as_float(w & 0xffff0000u); }
__device__ __forceinline__ float wave_sum(float v) {
    v += __builtin_bit_cast(float, __builtin_amdgcn_mov_dpp(__builtin_bit_cast(int, v), 0xB1, 0xf, 0xf, true));
    v += __builtin_bit_cast(float, __builtin_amdgcn_mov_dpp(__builtin_bit_cast(int, v), 0x4E, 0xf, 0xf, true));
    v += __builtin_bit_cast(float, __builtin_amdgcn_mov_dpp(__builtin_bit_cast(int, v), 0x141, 0xf, 0xf, true));
    v += __builtin_bit_cast(float, __builtin_amdgcn_mov_dpp(__builtin_bit_cast(int, v), 0x140, 0xf, 0xf, true));
    const int iv = __builtin_bit_cast(int, v);
    const float a = __builtin_bit_cast(float, __builtin_amdgcn_readlane(iv, 15)), b = __builtin_bit_cast(float, __builtin_amdgcn_readlane(iv, 31));
    const float c = __builtin_bit_cast(float, __builtin_amdgcn_readlane(iv, 47)), d = __builtin_bit_cast(float, __builtin_amdgcn_readlane(iv, 63));
    return (a + b) + (c + d);
}
__device__ __forceinline__ float silu_f(float x) { return x * __builtin_amdgcn_rcpf(1.f + __expf(-x)); }
__device__ __forceinline__ float sigmoid_f(float x) { return __builtin_amdgcn_rcpf(1.f + __expf(-x)); }
constexpr float YSCALE = 32.f;
__device__ __forceinline__ unsigned pk_fp8x4(f32x4 v) {
    int d = __builtin_amdgcn_cvt_pk_fp8_f32(__builtin_amdgcn_fmed3f(v[0] * YSCALE, -448.f, 448.f), __builtin_amdgcn_fmed3f(v[1] * YSCALE, -448.f, 448.f), 0, false);
    d = __builtin_amdgcn_cvt_pk_fp8_f32(__builtin_amdgcn_fmed3f(v[2] * YSCALE, -448.f, 448.f), __builtin_amdgcn_fmed3f(v[3] * YSCALE, -448.f, 448.f), d, true);
    return (unsigned)d;
}
__device__ __forceinline__ f32x4 un_fp8x4(unsigned d) { typedef float f2 __attribute__((ext_vector_type(2)));
    const f2 lo = __builtin_amdgcn_cvt_pk_f32_fp8((int)d, false), hi = __builtin_amdgcn_cvt_pk_f32_fp8((int)d, true); return (f32x4){lo.x, lo.y, hi.x, hi.y}; }
#define LDS_WAIT() asm volatile("s_waitcnt lgkmcnt(0)" ::: "memory")
__device__ __forceinline__ int fresh_lane() { int l; asm volatile("v_mbcnt_lo_u32_b32 %0, -1, 0\n\tv_mbcnt_hi_u32_b32 %0, -1, %0" : "=v"(l)); return l; }

#define XB_TMO      128
#define XB_XCNT(j)  (256  + 64 * (j))
#define XB_XSUB(j)  (1280 + 64 * (j))
#define XB_XGEN(j)  (2304 + 64 * (j))
#define XB_TOP      3328
#define XB_TOPGEN   3392
#define XCD_BAR_WORDS 3456
#define XB_SPIN_CAP (1u << 20)
__device__ __forceinline__ unsigned xb_ld(unsigned* p)              { return __hip_atomic_load(p, __ATOMIC_RELAXED, __HIP_MEMORY_SCOPE_AGENT); }
__device__ __forceinline__ unsigned xb_add(unsigned* p, unsigned v) { return __hip_atomic_fetch_add(p, v, __ATOMIC_RELAXED, __HIP_MEMORY_SCOPE_AGENT); }
__device__ __forceinline__ unsigned xb_xcc_id() { return (unsigned)__builtin_amdgcn_s_getreg((3 << 11) | 20) & 0xFu; }
#define XB_SPIN(cond, bar) do { unsigned _sp = 0; while (cond) { __builtin_amdgcn_s_sleep(1); \
    if ((++_sp & 255u) == 0u) { if (xb_ld(&(bar)[XB_TMO])) break; if (_sp > XB_SPIN_CAP) { atomicAdd(&(bar)[XB_TMO], 1u); break; } } } } while (0)
struct XcdBarrier { unsigned* bar; unsigned x; volatile LAS unsigned* st; };
__device__ __forceinline__ XcdBarrier xcd_barrier_post(unsigned* bar, volatile LAS unsigned* st) {
    XcdBarrier b; b.bar = bar; b.x = xb_xcc_id(); b.st = st;
    if (threadIdx.x == 0) (void)xb_add(&bar[XB_XCNT(b.x)], 1u);
    return b;
}
__device__ __forceinline__ void xcd_barrier_complete(unsigned* bar, unsigned x, unsigned& nloc, unsigned& nx) {
    const unsigned G = gridDim.x * gridDim.y * gridDim.z;
    unsigned sum, cnt, mine, sp = 0u;
    for (;;) {
        sum = 0u; cnt = 0u; mine = 0u;
#pragma unroll
        for (unsigned j = 0; j < 16; ++j) { const unsigned c = xb_ld(&bar[XB_XCNT(j)]); sum += c; cnt += (c > 0u) ? 1u : 0u; mine = (j == x) ? c : mine; }
        if (sum == G) break;
        __builtin_amdgcn_s_sleep(1);
        if ((++sp & 255u) == 0u) { if (xb_ld(&bar[XB_TMO])) break; if (sp > XB_SPIN_CAP) { atomicAdd(&bar[XB_TMO], 1u); break; } }
    }
    nloc = mine > 0u ? mine : 1u; nx = cnt > 0u ? cnt : 1u;
}
__device__ __forceinline__ void xcd_barrier(const XcdBarrier& b) {
    asm volatile("s_waitcnt vmcnt(0)" ::: "memory");
    __syncthreads();
    if (threadIdx.x == 0) {
        unsigned* bar = b.bar;
        __builtin_amdgcn_s_waitcnt(0);
        unsigned nloc = b.st[0], nx = b.st[1];
        if (nloc == 0u) { xcd_barrier_complete(bar, b.x, nloc, nx); b.st[0] = nloc; b.st[1] = nx; }
        const unsigned old = xb_add(&bar[XB_XSUB(b.x)], 1u);
        const unsigned gen = old / nloc;
        if (old + 1u == (gen + 1u) * nloc) {
            __builtin_amdgcn_fence(__ATOMIC_RELEASE, "agent");
            asm volatile("s_waitcnt vmcnt(0)" ::: "memory");
            const unsigned og = xb_add(&bar[XB_TOP], 1u);
            const unsigned tg = og / nx;
            if (og + 1u == (tg + 1u) * nx) xb_add(&bar[XB_TOPGEN], 1u);
            else XB_SPIN(xb_ld(&bar[XB_TOPGEN]) == tg, bar);
            __builtin_amdgcn_fence(__ATOMIC_ACQUIRE, "agent");
            xb_add(&bar[XB_XGEN(b.x)], 1u);
            asm volatile("s_waitcnt vmcnt(0)" ::: "memory");
        } else {
            XB_SPIN(xb_ld(&bar[XB_XGEN(b.x)]) == gen, bar);
            __builtin_amdgcn_fence(__ATOMIC_ACQUIRE, "agent");
            asm volatile("s_waitcnt vmcnt(0)" ::: "memory");
        }
    }
    __syncthreads();
}

struct Args { const float* in[25]; float* out; unsigned char* ws; int ph_lo, ph_hi; };
enum { I_X = 0, I_C, I_CTX, I_CCTX, I_ADAW, I_ADAB, I_NMG, I_NFG, I_WIN, I_WOUT, I_SINK, I_PW1W, I_PW1B, I_DWW, I_DWB, I_LNG, I_LNB,
       I_PW2W, I_PW2B, I_RW, I_RB, I_WG, I_WU, I_WD, I_FNG };

struct InPtrs {
    __device__ __forceinline__ const float* operator[](int i) const { const float* r;
        asm volatile("s_load_dwordx2 %0, %1, %2\n\ts_waitcnt lgkmcnt(0)" : "=s"(r) : "s"(__builtin_amdgcn_kernarg_segment_ptr()), "s"(i * 8)); return r; }
};
struct Frame {
    LAS unsigned char* lds;
    int tid, lane, wave, G, wg;
    InPtrs in;
    float* out;
    unsigned char* ws;
    unsigned* ctl;
};

__device__ __forceinline__ int crow(int i, int h) { return (i & 3) + 8 * (i >> 2) + 4 * h; }
template <class RowPtr, class Epi>
__device__ __forceinline__ void sgemm_tile(const RowPtr& rowptr, const bf16* Bt, int K, int m0, int n0, const Epi& epi, int wave, int lane) {
    const int wm = wave & 3, wn = wave >> 2, r = lane & 31, h = lane >> 5;
    const bf16* ap = rowptr(m0 + wm * 32 + r) + 8 * h;
    const bf16* bp0 = Bt + (size_t)(n0 + wn * 64 + r) * K + 8 * h;
    const bf16* bp1 = bp0 + (size_t)32 * K;
    f32x16 c0, c1;
#pragma unroll
    for (int i = 0; i < 16; ++i) { c0[i] = 0.f; c1[i] = 0.f; }
#pragma unroll 2
    for (int k = 0; k < K; k += 32) {
        const bf16x8 a0 = *(const bf16x8*)(ap + k), a1 = *(const bf16x8*)(ap + k + 16);
        const bf16x8 b00 = *(const bf16x8*)(bp0 + k), b01 = *(const bf16x8*)(bp0 + k + 16);
        const bf16x8 b10 = *(const bf16x8*)(bp1 + k), b11 = *(const bf16x8*)(bp1 + k + 16);
        c0 = __builtin_amdgcn_mfma_f32_32x32x16_bf16(a0, b00, c0, 0, 0, 0);
        c1 = __builtin_amdgcn_mfma_f32_32x32x16_bf16(a0, b10, c1, 0, 0, 0);
        c0 = __builtin_amdgcn_mfma_f32_32x32x16_bf16(a1, b01, c0, 0, 0, 0);
        c1 = __builtin_amdgcn_mfma_f32_32x32x16_bf16(a1, b11, c1, 0, 0, 0);
    }
    epi(m0 + wm * 32, n0 + wn * 64, c0, c1, lane);
}

__device__ __forceinline__ void p0_transpose_item(const float* W, int K, int N, bf16* WT, int k0, int n0, int drow0, LAS float* scr, int lane) {
#pragma unroll 8
    for (int i = 0; i < 32; ++i) { const int kk = 2 * i + (lane >> 5); scr[kk * 33 + (lane & 31)] = W[(size_t)(k0 + kk) * N + n0 + (lane & 31)]; }
    LDS_WAIT(); asm volatile("" ::: "memory");
    const int c = lane & 7;
#pragma unroll
    for (int j = 0; j < 4; ++j) { const int n = (lane >> 3) + 8 * j; const LAS float* s = scr + (8 * c) * 33 + n;
        u32x4 o; o.x = pk2(s[0 * 33], s[1 * 33]); o.y = pk2(s[2 * 33], s[3 * 33]); o.z = pk2(s[4 * 33], s[5 * 33]); o.w = pk2(s[6 * 33], s[7 * 33]);
        *(u32x4*)(WT + (size_t)(drow0 + n) * K + k0 + 8 * c) = o; }
    LDS_WAIT(); asm volatile("" ::: "memory");
}
__device__ __forceinline__ int il_row(int j, int half) { return (j / IL) * (2 * IL) + half * IL + (j % IL); }

constexpr int T_NITEMS = 640 + 512 + 1024 + 512 + 3 * 32 * 256, T_DEFER_ATT = 10 * 2048;
struct TItem { const float* W; bf16* WT; int K, N, k0, n0, drow0; bool ok; };
__device__ __forceinline__ TItem t_decode(const Frame& F, int it) {
    constexpr int S0 = 640, S1 = 512, S2 = 1024, S3 = 512, SM = 32 * 256;
    TItem t; t.ok = it < S0 + S1 + S2 + S3 + 3 * SM; t.W = F.in[I_WIN]; t.WT = (bf16*)(F.ws + WS_WIN); t.K = 1024; t.N = 1280; t.k0 = 0; t.n0 = 0; t.drow0 = 0;
    int r = it;
    if (r < S0) { const int kb = r / 40, nb = r % 40; t.k0 = kb * 64; t.n0 = nb * 32; t.drow0 = nb * 32; return t; } r -= S0;
    if (r < S1) { const int kb = r / 32, nb = r % 32; t.W = F.in[I_WOUT]; t.WT = (bf16*)(F.ws + WS_WOUT); t.N = 1024; t.k0 = kb * 64; t.n0 = nb * 32; t.drow0 = nb * 32; return t; } r -= S1;
    if (r < S2) { const int kb = r / 64, nb = r % 64, n0 = nb * 32; t.W = F.in[I_PW1W]; t.WT = (bf16*)(F.ws + WS_WPW1); t.N = 2048; t.k0 = kb * 64; t.n0 = n0; t.drow0 = il_row(n0 & 1023, n0 >> 10); return t; } r -= S2;
    if (r < S3) { const int kb = r / 32, nb = r % 32; t.W = F.in[I_PW2W]; t.WT = (bf16*)(F.ws + WS_WPW2); t.N = 1024; t.k0 = kb * 64; t.n0 = nb * 32; t.drow0 = nb * 32; return t; } r -= S3;
    if (r < SM) { const int le = r >> 8, q = r & 255, kb = q / 16, nb = q % 16; t.W = F.in[I_WG] + (size_t)le * 1024 * 512; t.WT = (bf16*)(F.ws + WS_WGU) + (size_t)le * 1024 * 1024; t.N = 512; t.k0 = kb * 64; t.n0 = nb * 32; t.drow0 = il_row(nb * 32, 0); return t; } r -= SM;
    if (r < SM) { const int le = r >> 8, q = r & 255, kb = q / 16, nb = q % 16; t.W = F.in[I_WU] + (size_t)le * 1024 * 512; t.WT = (bf16*)(F.ws + WS_WGU) + (size_t)le * 1024 * 1024; t.N = 512; t.k0 = kb * 64; t.n0 = nb * 32; t.drow0 = il_row(nb * 32, 1); return t; } r -= SM;
    { const int le = (r >> 8) & 31, q = r & 255, kb = q / 32, nb = q % 32; t.W = F.in[I_WD] + (size_t)le * 512 * 1024; t.WT = (bf16*)(F.ws + WS_WDN) + (size_t)le * 1024 * 512; t.K = 512; t.N = 1024; t.k0 = kb * 64; t.n0 = nb * 32; t.drow0 = nb * 32; }
    return t;
}
__device__ __forceinline__ void t_load(const TItem& t, int lane, float (&v)[32]) {
    if (t.ok) {
#pragma unroll
        for (int i = 0; i < 32; ++i) v[i] = t.W[(size_t)(t.k0 + 2 * i + (lane >> 5)) * t.N + t.n0 + (lane & 31)];
    }
}
__device__ __forceinline__ void t_store(const TItem& t, LAS float* scr, int lane, const float (&v)[32]) {
#pragma unroll
    for (int i = 0; i < 32; ++i) scr[(2 * i + (lane >> 5)) * 33 + (lane & 31)] = v[i];
    LDS_WAIT(); asm volatile("" ::: "memory");
    const int c = lane & 7;
#pragma unroll
    for (int j = 0; j < 4; ++j) { const int n = (lane >> 3) + 8 * j; const LAS float* s = scr + (8 * c) * 33 + n;
        u32x4 o; o.x = pk2(s[0 * 33], s[1 * 33]); o.y = pk2(s[2 * 33], s[3 * 33]); o.z = pk2(s[4 * 33], s[5 * 33]); o.w = pk2(s[6 * 33], s[7 * 33]);
        *(u32x4*)(t.WT + (size_t)(t.drow0 + n) * t.K + t.k0 + 8 * c) = o; }
    LDS_WAIT(); asm volatile("" ::: "memory");
}
__device__ __forceinline__ void t_dma(const TItem& t, LAS unsigned char* scr, int lane) {
    if (t.ok) {
#pragma unroll
        for (int i = 0; i < 8; ++i)
            __builtin_amdgcn_global_load_lds((const unsigned*)(t.W + (size_t)(t.k0 + 8 * i + (lane >> 3)) * t.N + t.n0 + 4 * (lane & 7)), (LAS unsigned*)(scr + 1056 * i), 16, 0, 0);
    }
}
__device__ __forceinline__ void t_store_dma(const TItem& t, const LAS float* scr, int lane) {
    const int c = lane & 7;
#pragma unroll 1
    for (int j = 0; j < 4; ++j) { const int n = (lane >> 3) + 8 * j; float e[8];
#pragma unroll
        for (int q = 0; q < 8; ++q) e[q] = scr[264 * c + 32 * q + n];
        { u32x4 o; o.x = pk2(e[0], e[1]); o.y = pk2(e[2], e[3]); o.z = pk2(e[4], e[5]); o.w = pk2(e[6], e[7]); *(u32x4*)(t.WT + (size_t)(t.drow0 + n) * t.K + t.k0 + 8 * c) = o; } }
    LDS_WAIT(); asm volatile("" ::: "memory");
}
__device__ __forceinline__ void t_items_tail(Frame& F, int r, int nw) {
    LAS float* scr = (LAS float*)(F.lds + F.wave * 8704);
    TItem cur = t_decode(F, 640 + T_DEFER_ATT + r); float va[32], vb[32];
    t_load(cur, F.lane, va);
#pragma unroll 1
    for (int it = r; cur.ok; it += nw) {
        const TItem nxt = t_decode(F, 640 + T_DEFER_ATT + it + nw);
        t_load(nxt, F.lane, vb);
        t_store(cur, scr, F.lane, va);
#pragma unroll
        for (int i = 0; i < 32; ++i) va[i] = vb[i];
        cur = nxt;
    }
}
__device__ __forceinline__ void phase_prep(Frame& F) {
    {
        LAS float* sc = (LAS float*)F.lds;
        LAS float* red = sc + 5 * 1024;
        bool loaded = false;
        for (int it = F.wg; it < 192; it += F.G) {
            if (!loaded) {
                for (int i = F.tid; i < 5 * 1024; i += NTHR) { const int b = i >> 10, k = i & 1023; const float v = b < 4 ? F.in[I_C][b * 1024 + k] : F.in[I_CCTX][k]; sc[i] = silu_f(v); }
                __syncthreads(); loaded = true;
            }
            const int l = it / 96, n0 = (it % 96) * 64, c4 = F.tid & 15, kg = F.tid >> 4;
            const float* w = F.in[I_ADAW] + (size_t)l * 1024 * 6144 + n0 + 4 * c4;
            f32x4 a[5];
#pragma unroll
            for (int b = 0; b < 5; ++b) a[b] = (f32x4){0.f, 0.f, 0.f, 0.f};
#pragma unroll 16
            for (int kk = 0; kk < 32; ++kk) { const int k = kg * 32 + kk; const f32x4 wv = *(const f32x4*)(w + (size_t)k * 6144);
#pragma unroll
                for (int b = 0; b < 5; ++b) a[b] += sc[b * 1024 + k] * wv; }
#pragma unroll
            for (int b = 0; b < 5; ++b) *(LAS f32x4*)(red + (kg * 5 + b) * 64 + 4 * c4) = a[b];
            __syncthreads();
            if (F.tid < 320) { const int b = F.tid >> 6, c2 = F.tid & 63; float sm = 0.f;
#pragma unroll
                for (int g = 0; g < 32; ++g) sm += red[(g * 5 + b) * 64 + c2];
                ((float*)(F.ws + WS_MOD))[((size_t)l * 5 + b) * 6144 + n0 + c2] = sm + F.in[I_ADAB][l * 6144 + n0 + c2]; }
            __syncthreads();
        }
        __syncthreads();
    }
    { u32x4* z = (u32x4*)(F.ws + WS_SLOTT); const u32x4 zero = {0u, 0u, 0u, 0u};
      for (int i = F.wg * NTHR + F.tid; i < 2 * 16 * CAP / 4; i += F.G * NTHR) z[i] = zero; }
    { float* tw = (float*)(F.ws + WS_TW);
      for (int k = F.wg * NTHR + F.tid; k < 8192; k += F.G * NTHR) { const float a = (float)k * (6.283185307179586f / 8192.f); tw[2 * k] = __cosf(a); tw[2 * k + 1] = __sinf(a); } }
    {
        LAS float* scr = (LAS float*)(F.lds + F.wave * 8704);
        const int gw = F.wg * NWAVES + F.wave, NGW = F.G * NWAVES;
        auto vmap = [](int v) { return v < 640 ? v : (1 << 30); };
        TItem cur = t_decode(F, vmap(gw)); float va[32], vb[32];
        t_load(cur, F.lane, va);
#pragma unroll 1
        for (int it = gw; cur.ok; it += NGW) {
            const TItem nxt = t_decode(F, vmap(it + NGW));
            t_load(nxt, F.lane, vb);
            t_store(cur, scr, F.lane, va);
#pragma unroll
            for (int i = 0; i < 32; ++i) va[i] = vb[i];
            cur = nxt;
        }
    }
}

#define ROFF(lane, j) (512 * ((j) >> 1) + 8 * (lane) + 4 * ((j) & 1))
__device__ __forceinline__ void row_load(const float* p, int lane, f32x4 (&v)[4]) {
#pragma unroll
    for (int j = 0; j < 4; ++j) v[j] = *(const f32x4*)(p + ROFF(lane, j));
}
__device__ __forceinline__ void row_load_bf(const bf16* p, int lane, f32x4 (&v)[4]) {
#pragma unroll
    for (int jj = 0; jj < 2; ++jj) { const u32x4 w = *(const u32x4*)(p + 512 * jj + 8 * lane); v[2 * jj] = (f32x4){bflo(w.x), bfhi(w.x), bflo(w.y), bfhi(w.y)}; v[2 * jj + 1] = (f32x4){bflo(w.z), bfhi(w.z), bflo(w.w), bfhi(w.w)}; }
}
__device__ __forceinline__ void xrow_load(const float* xf, const bf16* xb, size_t row, int lane, f32x4 (&v)[4]) { if (XBF16) row_load_bf(xb + row * D, lane, v); else row_load(xf + row * D, lane, v); }
__device__ __forceinline__ float row_sumsq(const f32x4 (&v)[4]) {
    float s = 0.f;
#pragma unroll
    for (int j = 0; j < 4; ++j) s += (v[j].x * v[j].x + v[j].y * v[j].y) + (v[j].z * v[j].z + v[j].w * v[j].w);
    return wave_sum(s);
}
__device__ __forceinline__ void row_modulate(f32x4 (&v)[4], float rstd, const float* g, const float* sh, const float* sc, int lane) {
#pragma unroll
    for (int j = 0; j < 4; ++j) { const int o = ROFF(lane, j); const f32x4 gg = *(const f32x4*)(g + o), s1 = *(const f32x4*)(sc + o), s0 = *(const f32x4*)(sh + o);
        v[j] = v[j] * rstd * gg * (1.f + s1) + s0; }
}
__device__ __forceinline__ void row_store_bf16(bf16* dst, const f32x4 (&v)[4], int lane) {
#pragma unroll
    for (int jj = 0; jj < 2; ++jj) { u32x4 w; w.x = pk2(v[2 * jj].x, v[2 * jj].y); w.y = pk2(v[2 * jj].z, v[2 * jj].w); w.z = pk2(v[2 * jj + 1].x, v[2 * jj + 1].y); w.w = pk2(v[2 * jj + 1].z, v[2 * jj + 1].w); *(u32x4*)(dst + 512 * jj + 8 * lane) = w; }
}

__device__ __forceinline__ void phase_norm1_l0(Frame& F) {
    const int gw = F.wg * NWAVES + F.wave, NGW = F.G * NWAVES;
    const float* mod = (const float*)(F.ws + WS_MOD);
    bf16* HB = (bf16*)(F.ws + WS_HB);
    for (int row = gw; row < T + TC; row += NGW) {
        const float* src = row < T ? F.in[I_X] + (size_t)row * D : F.in[I_CTX] + (size_t)(row - T) * D;
        const int b = row < T ? (row >> 13) : 4;
        f32x4 v[4]; row_load(src, F.lane, v);
        const float rstd = rsqrtf(row_sumsq(v) * (1.f / D) + EPS);
        const float* m = mod + (size_t)b * 6144;
        row_modulate(v, rstd, F.in[I_NMG], m, m + 1024, F.lane);
        row_store_bf16(HB + (size_t)row * D, v, F.lane);
    }
}

struct RowLin { const bf16* base; size_t pitch; __device__ __forceinline__ const bf16* operator()(int m) const { return base + (size_t)m * pitch; } };

__device__ __forceinline__ void inproj_block(Frame& F, int mb, int nbk, const f32x16& c, int lane) {
    const int h = lane >> 5, cl = lane & 31;
    bf16* dst; int pitch, cbase; bool rope = false; bool isctx = (mb >= T);
    if (nbk < 512) { dst = (bf16*)(F.ws + WS_UF); pitch = 512; cbase = 0; }
    else if (nbk < 1024) { dst = (bf16*)(F.ws + WS_Q); pitch = 512; cbase = 512; rope = true; }
    else if (nbk < 1152) { dst = isctx ? (bf16*)(F.ws + WS_CK) : (bf16*)(F.ws + WS_K); pitch = 128; cbase = 1024; rope = !isctx; }
    else { dst = isctx ? (bf16*)(F.ws + WS_CV) : (bf16*)(F.ws + WS_V); pitch = 128; cbase = 1152; }
    const int rbase = isctx ? mb - T : mb;
    const int col = nbk - cbase + cl;
    const float inv = exp2f(-(float)(cl & 15) * (13.287712379549449f / 16.f));
    const bool second = (cl & 16) != 0; const bool bycol = ((nbk >> 5) & 1) != 0;
#pragma unroll
    for (int i = 0; i < 16; ++i) {
        const int rr = crow(i, h); float v = c[i];
        if (rope) {
            const float partner = __shfl_xor(v, 16);
            const int l = (mb + rr) & (L - 1);
            const float pos = (float)(bycol ? (l & 63) : (l >> 6));
            const float ang = pos * inv, cs = __cosf(ang), sn = __sinf(ang);
            v = second ? (partner * sn + v * cs) : (v * cs - partner * sn);
        }
        dst[(size_t)(rbase + rr) * pitch + col] = (bf16)f2bf(v);
    }
}
__device__ __forceinline__ void phase_inproj(Frame& F) {
    const bf16* HB = (const bf16*)(F.ws + WS_HB); const bf16* Wt = (const bf16*)(F.ws + WS_WIN);
    constexpr int MT = (T + TC) / 128, NT = N_IN / 128;
    RowLin rp{HB, (size_t)D};
    for (int u = F.wg; u < MT * NT; u += F.G) {
        const int mt = u / NT, nt = u % NT;
        if (mt >= T / 128 && nt < 8) continue;
        auto epi = [&](int mb, int nb, const f32x16& c0, const f32x16& c1, int lane) { inproj_block(F, mb, nb, c0, lane); inproj_block(F, mb, nb + 32, c1, lane); };
        sgemm_tile(rp, Wt, D, mt * 128, nt * 128, epi, F.wave, F.lane);
    }
}

__device__ __forceinline__ void attn_key(const bf16* kp, const bf16* vp, const float (&q)[64], float& m, float& s, float (&o)[64]) {
    float dot = 0.f;
#pragma unroll
    for (int j = 0; j < 8; ++j) { const u32x4 w = *(const u32x4*)(kp + 8 * j);
        dot += q[8 * j + 0] * bflo(w.x) + q[8 * j + 1] * bfhi(w.x) + q[8 * j + 2] * bflo(w.y) + q[8 * j + 3] * bfhi(w.y)
             + q[8 * j + 4] * bflo(w.z) + q[8 * j + 5] * bfhi(w.z) + q[8 * j + 6] * bflo(w.w) + q[8 * j + 7] * bfhi(w.w); }
    const float mn = fmaxf(m, dot), alpha = __expf(m - mn), p = __expf(dot - mn);
    s = s * alpha + p; m = mn;
#pragma unroll
    for (int j = 0; j < 8; ++j) { const u32x4 w = *(const u32x4*)(vp + 8 * j);
        o[8 * j + 0] = o[8 * j + 0] * alpha + p * bflo(w.x); o[8 * j + 1] = o[8 * j + 1] * alpha + p * bfhi(w.x);
        o[8 * j + 2] = o[8 * j + 2] * alpha + p * bflo(w.y); o[8 * j + 3] = o[8 * j + 3] * alpha + p * bfhi(w.y);
        o[8 * j + 4] = o[8 * j + 4] * alpha + p * bflo(w.z); o[8 * j + 5] = o[8 * j + 5] * alpha + p * bfhi(w.z);
        o[8 * j + 6] = o[8 * j + 6] * alpha + p * bflo(w.w); o[8 * j + 7] = o[8 * j + 7] * alpha + p * bfhi(w.w); }
}
__device__ __forceinline__ void phase_attn_simple(Frame& F) {
    const bf16* Q = (const bf16*)(F.ws + WS_Q); const bf16* Kb = (const bf16*)(F.ws + WS_K); const bf16* Vb = (const bf16*)(F.ws + WS_V);
    const bf16* CK = (const bf16*)(F.ws + WS_CK); const bf16* CV = (const bf16*)(F.ws + WS_CV); bf16* MIX = (bf16*)(F.ws + WS_MIX);
    for (int idx = F.wg * NTHR + F.tid; idx < T * 8; idx += F.G * NTHR) {
        const int hd = idx / T, t = idx % T, b = t >> 13, l = t & (L - 1), kvh = hd >> 2;
        float q[64], o[64];
#pragma unroll
        for (int j = 0; j < 8; ++j) { const u32x4 w = *(const u32x4*)(Q + (size_t)t * 512 + hd * 64 + 8 * j);
            q[8 * j + 0] = bflo(w.x) * 0.125f; q[8 * j + 1] = bfhi(w.x) * 0.125f; q[8 * j + 2] = bflo(w.y) * 0.125f; q[8 * j + 3] = bfhi(w.y) * 0.125f;
            q[8 * j + 4] = bflo(w.z) * 0.125f; q[8 * j + 5] = bfhi(w.z) * 0.125f; q[8 * j + 6] = bflo(w.w) * 0.125f; q[8 * j + 7] = bfhi(w.w) * 0.125f; }
#pragma unroll
        for (int j = 0; j < 64; ++j) o[j] = 0.f;
        float m = F.in[I_SINK][hd], s = 1.f;
        for (int c = 0; c < CL; ++c) { const size_t r = (size_t)(b * CL + c) * 128 + kvh * 64; attn_key(CK + r, CV + r, q, m, s, o); }
        const int lo = l - 128 < 0 ? 0 : l - 128, hi = l + 128 > L - 1 ? L - 1 : l + 128;
        for (int kp = lo; kp <= hi; ++kp) { const size_t r = (size_t)(b * L + kp) * 128 + kvh * 64; attn_key(Kb + r, Vb + r, q, m, s, o); }
        const float is = 1.f / s;
#pragma unroll
        for (int j = 0; j < 8; ++j) { u32x4 w; w.x = pk2(o[8 * j] * is, o[8 * j + 1] * is); w.y = pk2(o[8 * j + 2] * is, o[8 * j + 3] * is); w.z = pk2(o[8 * j + 4] * is, o[8 * j + 5] * is); w.w = pk2(o[8 * j + 6] * is, o[8 * j + 7] * is);
            *(u32x4*)(MIX + (size_t)t * 1024 + 512 + hd * 64 + 8 * j) = w; }
    }
}

__device__ __forceinline__ void phase_fft1_simple(Frame& F) {
    const bf16* UF = (const bf16*)(F.ws + WS_UF); bf16* Gb = (bf16*)(F.ws + WS_G); const float* tw = (const float*)(F.ws + WS_TW);
    for (int idx = F.wg * NTHR + F.tid; idx < NB * FN1 * FN2 * 512; idx += F.G * NTHR) {
        const int ch = idx & 511, bp = (idx >> 9) & 127, c = (idx >> 16) & 63, b = idx >> 22;
        float re = 0.f, im = 0.f;
        for (int a = 0; a < FN1; ++a) { const float u = bf2f(UF[(size_t)(b * L + 128 * a + bp) * 512 + ch]); const int k = ((a * c) & 63) * 128;
            re += u * tw[2 * k]; im -= u * tw[2 * k + 1]; }
        const int k2 = bp * c; const float cs = tw[2 * k2], sn = tw[2 * k2 + 1];
        const float gr = re * cs + im * sn, gi = im * cs - re * sn;
        const size_t row = (size_t)(b * FN1 + c) * FN2 + bp;
        Gb[row * 1024 + ch] = (bf16)f2bf(gr); Gb[row * 1024 + 512 + ch] = (bf16)f2bf(gi);
    }
}
__device__ __forceinline__ void phase_fft2_simple(Frame& F) {
    const bf16* Gb = (const bf16*)(F.ws + WS_G); bf16* AB = (bf16*)(F.ws + WS_AB); const float* tw = (const float*)(F.ws + WS_TW);
    for (int idx = F.wg * NTHR + F.tid; idx < NB * FN1 * FN2 * 512; idx += F.G * NTHR) {
        const int ch = idx & 511, d = (idx >> 9) & 127, c = (idx >> 16) & 63, b = idx >> 22;
        float fr = 0.f, fi = 0.f;
        for (int bp = 0; bp < FN2; ++bp) { const size_t row = (size_t)(b * FN1 + c) * FN2 + bp; const float gr = bf2f(Gb[row * 1024 + ch]), gi = bf2f(Gb[row * 1024 + 512 + ch]);
            const int k = ((bp * d) & 127) * 64; const float cs = tw[2 * k], sn = tw[2 * k + 1];
            fr += gr * cs + gi * sn; fi += gi * cs - gr * sn; }
        const size_t t = (size_t)b * L + c + 64 * d;
        AB[t * 1024 + ch] = (bf16)f2bf(fr); AB[t * 1024 + 512 + ch] = (bf16)f2bf(-fi);
    }
}
__device__ __forceinline__ void phase_fft3_simple(Frame& F) {
    const bf16* AB = (const bf16*)(F.ws + WS_AB); bf16* MIX = (bf16*)(F.ws + WS_MIX); const float* tw = (const float*)(F.ws + WS_TW);
    LAS float* t128 = (LAS float*)F.lds;
    for (int i = F.tid; i < 128; i += NTHR) { t128[2 * i] = tw[2 * (i * 64)]; t128[2 * i + 1] = tw[2 * (i * 64) + 1]; }
    __syncthreads();
    for (int idx = F.wg * NTHR + F.tid; idx < T * 512; idx += F.G * NTHR) {
        const int cp = idx & 127, g = (idx >> 7) & 3, t = idx >> 9;
        const bf16* arow = AB + (size_t)t * 1024 + g * 128;
        float y = 0.f;
        for (int cc = 0; cc < 128; ++cc) { const int k = (cc * cp) & 127; y += bf2f(arow[cc]) * t128[2 * k] - bf2f(arow[512 + cc]) * t128[2 * k + 1]; }
        MIX[(size_t)t * 1024 + g * 128 + cp] = (bf16)f2bf(y * (1.f / 1024.f));
    }
    __syncthreads();
}

__device__ __forceinline__ void phase_outproj(Frame& F, const bf16* A, const bf16* Wt, const float* base, float* X, const float* gate  , const float* bias) {
    RowLin rp{A, (size_t)D};
    for (int u = F.wg; u < (T / 128) * 8; u += F.G) {
        const int mt = u / 8, nt = u % 8;
        auto epi = [&](int mb, int nb, const f32x16& c0, const f32x16& c1, int lane) {
            const int h = lane >> 5, cl = lane & 31, b = mb >> 13;
#pragma unroll
            for (int half = 0; half < 2; ++half) { const int col = nb + 32 * half + cl; const float gv = gate[(size_t)b * 6144 + col], bv = bias ? bias[col] : 0.f;
#pragma unroll
                for (int i = 0; i < 16; ++i) { const size_t o = (size_t)(mb + crow(i, h)) * D + col; const float a = half ? c1[i] : c0[i]; X[o] = base[o] + gv * (a + bv); } }
        };
        sgemm_tile(rp, Wt, D, mt * 128, nt * 128, epi, F.wave, F.lane);
    }
}

__device__ __forceinline__ void route_select(const float (&lg)[16], const float* rb, int& be1, int& be2, float& w1, float& w2) {
    float best = -1e30f; float bs1 = 0.f, bs2 = 0.f; be1 = 0; be2 = 0;
#pragma unroll
    for (int g = 0; g < 4; ++g) {
        float v1 = -1e30f, v2 = -1e30f, s1 = 0.f, s2 = 0.f; int j1 = 0, j2 = 0;
#pragma unroll
        for (int q = 0; q < 4; ++q) { const float sc = sigmoid_f(lg[4 * g + q]), x = sc + rb[4 * g + q];
            if (x > v1) { v2 = v1; j2 = j1; s2 = s1; v1 = x; j1 = q; s1 = sc; } else if (x > v2) { v2 = x; j2 = q; s2 = sc; } }
        const float gs = v1 + v2;
        if (gs > best) { best = gs; be1 = 4 * g + j1; be2 = 4 * g + j2; bs1 = s1; bs2 = s2; }
    }
    const float inv = 1.f / (bs1 + bs2); w1 = bs1 * inv; w2 = bs2 * inv;
}
__device__ __forceinline__ void phase_norm2_route(Frame& F, int layer) {
    const float* mod = (const float*)(F.ws + WS_MOD) + (size_t)layer * 5 * 6144;
    const float* X = F.out; const bf16* XB = (const bf16*)(F.ws + WS_XB); bf16* HB = (bf16*)(F.ws + WS_HB);
    const float* rw = F.in[I_RW]; const float* rb = F.in[I_RB];
    int* tok_e = (int*)(F.ws + WS_TOKE); int* tok_p = (int*)(F.ws + WS_TOKP); float* tok_w = (float*)(F.ws + WS_TOKW);
    int* slot_t = (int*)(F.ws + WS_SLOTT) + layer * 16 * CAP;
    float* slot_w = (float*)(F.ws + WS_SLOTW) + layer * 16 * CAP;
    unsigned* cnt = F.ctl + CW_CNT + layer * 16 * 64;
    LAS float* rwt = (LAS float*)F.lds;
    LAS int* sel_e = (LAS int*)(F.lds + 65536);
    LAS float* sel_w = (LAS float*)(F.lds + 65536 + 1024);
    LAS int* wcnt = (LAS int*)(F.lds + 65536 + 2048);
    LAS int* ebase = wcnt + 64;
    __syncthreads();
    for (int t = F.tid; t < 4096; t += NTHR) { const int i = t >> 2, e4 = t & 3; const f32x4 w = *(const f32x4*)(rw + (size_t)i * 16 + 4 * e4);
        const int p = (i & 512) + 256 * ((i >> 2) & 1) + 4 * ((i >> 3) & 63) + (i & 3);
        rwt[(4 * e4 + 0) * 1024 + p] = w.x; rwt[(4 * e4 + 1) * 1024 + p] = w.y; rwt[(4 * e4 + 2) * 1024 + p] = w.z; rwt[(4 * e4 + 3) * 1024 + p] = w.w; }
    __syncthreads();
    for (int rb0 = F.wg; rb0 < T / 128; rb0 += F.G) {
        const int b = (rb0 * 128) >> 13;
        f32x4 gm[4], sh[4];
        { const float* m = mod + (size_t)b * 6144; const float* g = F.in[I_NFG] + layer * D;
#pragma unroll
          for (int jj = 0; jj < 4; ++jj) { const int o = ROFF(F.lane, jj); gm[jj] = *(const f32x4*)(g + o) * (1.f + *(const f32x4*)(m + 4096 + o)); sh[jj] = *(const f32x4*)(m + 3072 + o); } }
        const int rbase = rb0 * 128 + F.wave * 16;
        f32x4 v0[4], v1[4]; xrow_load(X, XB, (size_t)rbase, F.lane, v0); xrow_load(X, XB, (size_t)(rbase + 1), F.lane, v1);
#pragma unroll 1
        for (int j = 0; j < 16; j += 2) {
            const int lr = F.wave * 16 + j, row = rbase + j;
            f32x4 n0[4], n1[4];
            { const int nr = (j + 2 < 16) ? row + 2 : row; xrow_load(X, XB, (size_t)nr, F.lane, n0); xrow_load(X, XB, (size_t)(nr + 1), F.lane, n1); }
            const float rstd0 = rsqrtf(row_sumsq(v0) * (1.f / D) + EPS), rstd1 = rsqrtf(row_sumsq(v1) * (1.f / D) + EPS);
#pragma unroll
            for (int jj = 0; jj < 4; ++jj) { v0[jj] = v0[jj] * rstd0 * gm[jj] + sh[jj]; v1[jj] = v1[jj] * rstd1 * gm[jj] + sh[jj]; }
            row_store_bf16(HB + (size_t)row * D, v0, F.lane); row_store_bf16(HB + (size_t)(row + 1) * D, v1, F.lane);
            float lg0[16], lg1[16];
#pragma unroll
            for (int e = 0; e < 16; ++e) { float a0 = 0.f, a1 = 0.f;
#pragma unroll
                for (int jj = 0; jj < 4; ++jj) { const f32x4 w4 = *(const LAS f32x4*)(rwt + e * 1024 + 256 * jj + 4 * F.lane);
                    a0 += (v0[jj].x * w4.x + v0[jj].y * w4.y) + (v0[jj].z * w4.z + v0[jj].w * w4.w); a1 += (v1[jj].x * w4.x + v1[jj].y * w4.y) + (v1[jj].z * w4.z + v1[jj].w * w4.w); }
                lg0[e] = a0; lg1[e] = a1; }
#pragma unroll
            for (int e = 0; e < 16; ++e) { lg0[e] = wave_sum(lg0[e]); lg1[e] = wave_sum(lg1[e]); }
            int e1, e2; float w1, w2;
            route_select(lg0, rb, e1, e2, w1, w2);
            if (F.lane == 0) { sel_e[2 * lr] = e1; sel_e[2 * lr + 1] = e2; sel_w[2 * lr] = w1; sel_w[2 * lr + 1] = w2; }
            route_select(lg1, rb, e1, e2, w1, w2);
            if (F.lane == 0) { sel_e[2 * lr + 2] = e1; sel_e[2 * lr + 3] = e2; sel_w[2 * lr + 2] = w1; sel_w[2 * lr + 3] = w2; }
#pragma unroll
            for (int jj = 0; jj < 4; ++jj) { v0[jj] = n0[jj]; v1[jj] = n1[jj]; }
        }
        __syncthreads();
        int my_e = 0, my_rank = 0; float my_w = 0.f;
        if (F.tid < 256) { my_e = sel_e[F.tid]; my_w = sel_w[F.tid];
            const unsigned long long below = (1ull << F.lane) - 1ull;
#pragma unroll 1
            for (int ee = 0; ee < 16; ++ee) { const unsigned long long mk = __ballot(my_e == ee);
                if (my_e == ee) my_rank = __popcll(mk & below);
                if (F.lane == 0) wcnt[F.wave * 16 + ee] = __popcll(mk); } }
        __syncthreads();
        if (F.tid < 16) { const int n = wcnt[F.tid] + wcnt[16 + F.tid] + wcnt[32 + F.tid] + wcnt[48 + F.tid];
            ebase[F.tid] = n ? (int)atomicAdd(cnt + F.tid * 64, (unsigned)n) : 0; }
        __syncthreads();
        if (F.tid < 256) { int pos = ebase[my_e] + my_rank;
            for (int w = 0; w < F.wave; ++w) pos += wcnt[w * 16 + my_e];
            const int tok = rb0 * 128 + (F.tid >> 1), k = F.tid & 1;
            slot_t[my_e * CAP + pos] = tok; slot_w[my_e * CAP + pos] = my_w; tok_e[2 * tok + k] = my_e; tok_p[2 * tok + k] = pos; tok_w[2 * tok + k] = my_w; }
        __syncthreads();
    }
}


__device__ __forceinline__ void phase_norm2_route_mfma(Frame& F, int layer) {
    constexpr int AP = 1032;
    const float* mod = (const float*)(F.ws + WS_MOD) + (size_t)layer * 5 * 6144;
    const bf16* XB = (const bf16*)(F.ws + WS_XB); bf16* HB = (bf16*)(F.ws + WS_HB);
    const float* rw = F.in[I_RW]; const float* rb = F.in[I_RB]; const float* gsrc = F.in[I_NFG] + layer * D;
    int* tok_e = (int*)(F.ws + WS_TOKE); int* tok_p = (int*)(F.ws + WS_TOKP); float* tok_w = (float*)(F.ws + WS_TOKW);
    int* slot_t = (int*)(F.ws + WS_SLOTT) + layer * 16 * CAP;
    float* slot_w = (float*)(F.ws + WS_SLOTW) + layer * 16 * CAP;
    unsigned* cnt = F.ctl + CW_CNT + layer * 16 * 64;
    LAS bf16* AH = (LAS bf16*)F.lds; LAS bf16* AL = AH + 16 * AP;
    LAS float* cbv = (LAS float*)(F.lds + 2 * 16 * AP * 2);
    LAS float* rstdv = cbv + 16;
    LAS float* lgt = rstdv + 128;
    LAS int* sel_e = (LAS int*)(lgt + 128 * 16);
    LAS float* sel_w = (LAS float*)(sel_e + 256);
    LAS int* wcnt = (LAS int*)(sel_w + 256);
    LAS int* ebase = wcnt + 64;
    LAS float* cpart = (LAS float*)(ebase + 16);
    for (int rb0 = F.wg; rb0 < T / 128; rb0 += F.G) {
        const int b = (rb0 * 128) >> 13; const float* m = mod + (size_t)b * 6144;
        __syncthreads();
        { float cp[16];
#pragma unroll
          for (int e = 0; e < 16; ++e) cp[e] = 0.f;
          for (int k = F.tid; k < D; k += NTHR) { const float gmk = gsrc[k] * (1.f + m[4096 + k]), shk = m[3072 + k];
#pragma unroll
              for (int e4 = 0; e4 < 4; ++e4) { const f32x4 w4 = *(const f32x4*)(rw + (size_t)k * 16 + 4 * e4);
#pragma unroll
                  for (int q = 0; q < 4; ++q) { const int e = 4 * e4 + q; const float pr = gmk * w4[q]; const unsigned hi = f2bf(pr); const unsigned lo = f2bf(pr - bf2f(hi));
                      AH[e * AP + k] = (bf16)hi; AL[e * AP + k] = (bf16)lo; cp[e] += shk * w4[q]; } } }
#pragma unroll
          for (int e = 0; e < 16; ++e) { const float t = wave_sum(cp[e]); if (F.lane == 0) cpart[F.wave * 16 + e] = t; } }
        __syncthreads();
        if (F.tid < 16) { float t = 0.f;
#pragma unroll
            for (int w = 0; w < 8; ++w) t += cpart[w * 16 + F.tid];
            cbv[F.tid] = t; }
        f32x4 gm[4], sh[4];
#pragma unroll
        for (int jj = 0; jj < 4; ++jj) { const int o = ROFF(F.lane, jj); gm[jj] = *(const f32x4*)(gsrc + o) * (1.f + *(const f32x4*)(m + 4096 + o)); sh[jj] = *(const f32x4*)(m + 3072 + o); }
        const int rbase = rb0 * 128 + F.wave * 16;
        f32x4 v0[4], v1[4]; row_load_bf(XB + (size_t)rbase * D, F.lane, v0); row_load_bf(XB + (size_t)(rbase + 1) * D, F.lane, v1);
#pragma unroll 1
        for (int j = 0; j < 16; j += 2) {
            const int lr = F.wave * 16 + j, row = rbase + j;
            f32x4 n0[4], n1[4];
            { const int nr = (j + 2 < 16) ? row + 2 : row; row_load_bf(XB + (size_t)nr * D, F.lane, n0); row_load_bf(XB + (size_t)(nr + 1) * D, F.lane, n1); }
            const float rstd0 = rsqrtf(row_sumsq(v0) * (1.f / D) + EPS), rstd1 = rsqrtf(row_sumsq(v1) * (1.f / D) + EPS);
#pragma unroll
            for (int jj = 0; jj < 4; ++jj) { v0[jj] = v0[jj] * rstd0 * gm[jj] + sh[jj]; v1[jj] = v1[jj] * rstd1 * gm[jj] + sh[jj]; }
            row_store_bf16(HB + (size_t)row * D, v0, F.lane); row_store_bf16(HB + (size_t)(row + 1) * D, v1, F.lane);
            if (F.lane == 0) { rstdv[lr] = rstd0; rstdv[lr + 1] = rstd1; }
#pragma unroll
            for (int jj = 0; jj < 4; ++jj) { v0[jj] = n0[jj]; v1[jj] = n1[jj]; }
        }
        __syncthreads();
        { const int fr = F.lane & 15, fq = F.lane >> 4;
          f32x4 acc = {0.f, 0.f, 0.f, 0.f};
          const bf16* xr = XB + (size_t)(rb0 * 128 + 16 * F.wave + fr) * D + 8 * fq;
          const LAS bf16* ah = AH + fr * AP + 8 * fq; const LAS bf16* al = AL + fr * AP + 8 * fq;
#pragma unroll 8
          for (int s2 = 0; s2 < 32; ++s2) { const bf16x8 xb = *(const bf16x8*)(xr + 32 * s2);
              acc = __builtin_amdgcn_mfma_f32_16x16x32_bf16(*(const LAS bf16x8*)(ah + 32 * s2), xb, acc, 0, 0, 0);
              acc = __builtin_amdgcn_mfma_f32_16x16x32_bf16(*(const LAS bf16x8*)(al + 32 * s2), xb, acc, 0, 0, 0); }
          const int lrow = 16 * F.wave + fr; const float rs = rstdv[lrow];
#pragma unroll
          for (int i = 0; i < 4; ++i) lgt[lrow * 16 + 4 * fq + i] = rs * acc[i] + cbv[4 * fq + i]; }
        __syncthreads();
        if (F.tid < 128) { float lg[16];
#pragma unroll
            for (int e4 = 0; e4 < 4; ++e4) { const f32x4 t = *(const LAS f32x4*)(lgt + F.tid * 16 + 4 * e4); lg[4 * e4] = t.x; lg[4 * e4 + 1] = t.y; lg[4 * e4 + 2] = t.z; lg[4 * e4 + 3] = t.w; }
            int e1, e2; float w1, w2; route_select(lg, rb, e1, e2, w1, w2);
            sel_e[2 * F.tid] = e1; sel_e[2 * F.tid + 1] = e2; sel_w[2 * F.tid] = w1; sel_w[2 * F.tid + 1] = w2; }
        __syncthreads();
        int my_e = 0, my_rank = 0; float my_w = 0.f;
        if (F.tid < 256) { my_e = sel_e[F.tid]; my_w = sel_w[F.tid];
            const unsigned long long below = (1ull << F.lane) - 1ull;
#pragma unroll 1
            for (int ee = 0; ee < 16; ++ee) { const unsigned long long mk = __ballot(my_e == ee);
                if (my_e == ee) my_rank = __popcll(mk & below);
                if (F.lane == 0) wcnt[F.wave * 16 + ee] = __popcll(mk); } }
        __syncthreads();
        if (F.tid < 16) { const int n = wcnt[F.tid] + wcnt[16 + F.tid] + wcnt[32 + F.tid] + wcnt[48 + F.tid];
            ebase[F.tid] = n ? (int)atomicAdd(cnt + F.tid * 64, (unsigned)n) : 0; }
        __syncthreads();
        if (F.tid < 256) { int pos = ebase[my_e] + my_rank;
            for (int w = 0; w < F.wave; ++w) pos += wcnt[w * 16 + my_e];
            const int tok = rb0 * 128 + (F.tid >> 1), k = F.tid & 1;
            slot_t[my_e * CAP + pos] = tok; slot_w[my_e * CAP + pos] = my_w; tok_e[2 * tok + k] = my_e; tok_p[2 * tok + k] = pos; tok_w[2 * tok + k] = my_w; }
    }
    __syncthreads();
}

constexpr int MOEMAP_OFF = LDS_BYTES - 256;
__device__ __forceinline__ LAS int* moe_map(Frame& F, int layer) {
    LAS int* mm = (LAS int*)(F.lds + MOEMAP_OFF);
    __syncthreads();
    if (F.tid < 64) { const unsigned* cnt = F.ctl + CW_CNT + layer * 16 * 64;
        const int n = (F.tid < 16) ? (int)__hip_atomic_load(cnt + F.tid * 64, __ATOMIC_RELAXED, __HIP_MEMORY_SCOPE_AGENT) : 0;
        const int pad = (n + 255) & ~255; int x = pad;
#pragma unroll
        for (int o = 1; o < 16; o <<= 1) { const int t = __shfl_up(x, o); if (F.lane >= o) x += t; }
        if (F.tid < 16) { mm[F.tid] = n; mm[16 + F.tid] = x - pad; } }
    __syncthreads();
    return mm;
}
struct RowGather { const bf16* base; const int* list; int n; __device__ __forceinline__ const bf16* operator()(int m) const { const int tok = m < n ? list[m] : 0; return base + (size_t)tok * D; } };

__device__ __forceinline__ void phase_moe_gateup(Frame& F, int layer) {
    LAS int* mm = moe_map(F, layer);
    const bf16* HB = (const bf16*)(F.ws + WS_HB); bf16* HID = (bf16*)(F.ws + WS_HID);
    const int* slot_t = (const int*)(F.ws + WS_SLOTT) + layer * 16 * CAP; const float* slot_w = (const float*)(F.ws + WS_SLOTW) + layer * 16 * CAP;
    int ubase = 0;
#pragma unroll 1
    for (int e = 0; e < 16; ++e) {
        const int n = mm[e], hbe = mm[16 + e], rt = (n + 127) >> 7, nu = rt * 8;
        const bf16* Wt = (const bf16*)(F.ws + WS_WGU) + (size_t)(layer * 16 + e) * 1024 * 1024;
        RowGather rp{HB, slot_t + e * CAP, n};
        int first = (F.wg - ubase % F.G + F.G) % F.G;
        for (int u = first; u < nu; u += F.G) {
            const int mt = u / 8, nt = u % 8;
            auto epi = [&](int mb, int nb, const f32x16& c0, const f32x16& c1, int lane) {
                const int h = lane >> 5, cl = lane & 31; const int col = (nb >> 1) + cl;
#pragma unroll
                for (int i = 0; i < 16; ++i) { const int r = mb + crow(i, h);
                    if (r < n) { const float w = slot_w[e * CAP + r]; HID[(size_t)(hbe + r) * FF + col] = (bf16)f2bf(w * silu_f(c0[i]) * c1[i]); } }
            };
            sgemm_tile(rp, Wt, D, mt * 128, nt * 128, epi, F.wave, F.lane);
        }
        ubase += nu;
    }
}
__device__ __forceinline__ void phase_moe_down(Frame& F, int layer) {
    LAS int* mm = moe_map(F, layer);
    const bf16* HID = (const bf16*)(F.ws + WS_HID); bf16* Y = (bf16*)(F.ws + WS_Y);
    int ubase = 0;
#pragma unroll 1
    for (int e = 0; e < 16; ++e) {
        const int n = mm[e], hbe = mm[16 + e], rt = (n + 127) >> 7, nu = rt * 8;
        const bf16* Wt = (const bf16*)(F.ws + WS_WDN) + (size_t)(layer * 16 + e) * 1024 * 512;
        RowLin rp{HID + (size_t)hbe * FF, (size_t)FF};
        int first = (F.wg - ubase % F.G + F.G) % F.G;
        for (int u = first; u < nu; u += F.G) {
            const int mt = u / 8, nt = u % 8;
            auto epi = [&](int mb, int nb, const f32x16& c0, const f32x16& c1, int lane) {
                const int h = lane >> 5, cl = lane & 31;
#pragma unroll
                for (int i = 0; i < 16; ++i) { const int r = mb + crow(i, h);
                    if (r < n) { bf16* yr = Y + (size_t)(hbe + r) * D + nb + cl; yr[0] = (bf16)f2bf(c0[i]); yr[32] = (bf16)f2bf(c1[i]); } }
            };
            sgemm_tile(rp, Wt, FF, mt * 128, nt * 128, epi, F.wave, F.lane);
        }
        ubase += nu;
    }
}

template <bool FINAL>
__device__ __forceinline__ void phase_combine(Frame& F, int layer) {
    LAS int* hbs = moe_map(F, layer) + 16;
    const int gw = F.wg * NWAVES + F.wave, NGW = F.G * NWAVES;
    const float* mod = (const float*)(F.ws + WS_MOD);
    const int* tok_e = (const int*)(F.ws + WS_TOKE); const int* tok_p = (const int*)(F.ws + WS_TOKP);
    const unsigned char* Y8 = (const unsigned char*)(F.ws + WS_Y);
    float* X = F.out; bf16* XB = (bf16*)(F.ws + WS_XB); bf16* HB = (bf16*)(F.ws + WS_HB);
    for (int blk = gw; blk < T / 16; blk += NGW) {
        const int rbase = blk * 16, b = rbase >> 13;
        f32x4 g2v[4], gm[4], shv[4];
        { const float* g2 = mod + ((size_t)layer * 5 + b) * 6144 + 5120;
#pragma unroll
          for (int j = 0; j < 4; ++j) { const int o = ROFF(F.lane, j); g2v[j] = *(const f32x4*)(g2 + o) * (1.f / YSCALE);
              if (FINAL) { gm[j] = *(const f32x4*)(F.in[I_FNG] + o); shv[j] = (f32x4){0.f, 0.f, 0.f, 0.f}; }
              else { const float* m = mod + ((size_t)(layer + 1) * 5 + b) * 6144; gm[j] = *(const f32x4*)(F.in[I_NMG] + (layer + 1) * D + o) * (1.f + *(const f32x4*)(m + 1024 + o)); shv[j] = *(const f32x4*)(m + o); } } }
        int4 te = *(const int4*)(tok_e + 2 * rbase), tp = *(const int4*)(tok_p + 2 * rbase);
        u32x4 xa[2][2], xn[2][2]; u32x2 ya[2][2][2], yn[2][2][2];
        { const int s00 = hbs[te.x] + tp.x, s01 = hbs[te.y] + tp.y, s10 = hbs[te.z] + tp.z, s11 = hbs[te.w] + tp.w;
#pragma unroll
          for (int jj = 0; jj < 2; ++jj) { const int o = 512 * jj + 8 * F.lane;
              xa[0][jj] = *(const u32x4*)(XB + (size_t)rbase * D + o); xa[1][jj] = *(const u32x4*)(XB + (size_t)(rbase + 1) * D + o);
              ya[0][0][jj] = *(const u32x2*)(Y8 + (size_t)s00 * D + o); ya[0][1][jj] = *(const u32x2*)(Y8 + (size_t)s01 * D + o);
              ya[1][0][jj] = *(const u32x2*)(Y8 + (size_t)s10 * D + o); ya[1][1][jj] = *(const u32x2*)(Y8 + (size_t)s11 * D + o); } }
        te = *(const int4*)(tok_e + 2 * (rbase + 2)); tp = *(const int4*)(tok_p + 2 * (rbase + 2));
#pragma unroll 1
        for (int jr = 0; jr < 16; jr += 2) {
            const int row = rbase + jr;
            if (jr + 2 < 16) { const int nr = row + 2;
                const int s00 = hbs[te.x] + tp.x, s01 = hbs[te.y] + tp.y, s10 = hbs[te.z] + tp.z, s11 = hbs[te.w] + tp.w;
#pragma unroll
                for (int jj = 0; jj < 2; ++jj) { const int o = 512 * jj + 8 * F.lane;
                    xn[0][jj] = *(const u32x4*)(XB + (size_t)nr * D + o); xn[1][jj] = *(const u32x4*)(XB + (size_t)(nr + 1) * D + o);
                    yn[0][0][jj] = *(const u32x2*)(Y8 + (size_t)s00 * D + o); yn[0][1][jj] = *(const u32x2*)(Y8 + (size_t)s01 * D + o);
                    yn[1][0][jj] = *(const u32x2*)(Y8 + (size_t)s10 * D + o); yn[1][1][jj] = *(const u32x2*)(Y8 + (size_t)s11 * D + o); }
                const int n2 = (jr + 4 < 16) ? row + 4 : row; te = *(const int4*)(tok_e + 2 * n2); tp = *(const int4*)(tok_p + 2 * n2); }
            f32x4 v[2][4];
#pragma unroll
            for (int q = 0; q < 2; ++q)
#pragma unroll
                for (int jj = 0; jj < 2; ++jj) { const u32x4 xw = xa[q][jj]; const u32x2 a0 = ya[q][0][jj], a1 = ya[q][1][jj];
                    v[q][2 * jj] = (f32x4){bflo(xw.x), bfhi(xw.x), bflo(xw.y), bfhi(xw.y)} + g2v[2 * jj] * (un_fp8x4(a0.x) + un_fp8x4(a1.x));
                    v[q][2 * jj + 1] = (f32x4){bflo(xw.z), bfhi(xw.z), bflo(xw.w), bfhi(xw.w)} + g2v[2 * jj + 1] * (un_fp8x4(a0.y) + un_fp8x4(a1.y)); }
            const float rstd0 = rsqrtf(row_sumsq(v[0]) * (1.f / D) + EPS), rstd1 = rsqrtf(row_sumsq(v[1]) * (1.f / D) + EPS);
#pragma unroll
            for (int q = 0; q < 2; ++q) { const float rstd = q ? rstd1 : rstd0; const size_t ro = (size_t)(row + q) * D;
                if (FINAL) {
#pragma unroll
                    for (int j = 0; j < 4; ++j) *(f32x4*)(X + ro + ROFF(F.lane, j)) = v[q][j] * rstd * gm[j];
                } else {
                    row_store_bf16(XB + ro, v[q], F.lane);
#pragma unroll
                    for (int j = 0; j < 4; ++j) v[q][j] = v[q][j] * rstd * gm[j] + shv[j];
                    row_store_bf16(HB + ro, v[q], F.lane);
                }
            }
#pragma unroll
            for (int q = 0; q < 2; ++q)
#pragma unroll
                for (int jj = 0; jj < 2; ++jj) { xa[q][jj] = xn[q][jj]; ya[q][0][jj] = yn[q][0][jj]; ya[q][1][jj] = yn[q][1][jj]; }
        }
    }
    __syncthreads();
}

__device__ __forceinline__ void phase_pw1(Frame& F) {
    const bf16* HB = (const bf16*)(F.ws + WS_HB); const bf16* Wt = (const bf16*)(F.ws + WS_WPW1); bf16* U = (bf16*)(F.ws + WS_U);
    const float* bias = F.in[I_PW1B];
    RowLin rp{HB, (size_t)D};
    for (int u = F.wg; u < (T / 128) * 16; u += F.G) {
        const int mt = u / 16, nt = u % 16;
        auto epi = [&](int mb, int nb, const f32x16& c0, const f32x16& c1, int lane) {
            const int h = lane >> 5, cl = lane & 31, col = (nb >> 1) + cl; const float ba = bias[col], bg = bias[1024 + col];
#pragma unroll
            for (int i = 0; i < 16; ++i) U[(size_t)(mb + crow(i, h)) * D + col] = (bf16)f2bf((c0[i] + ba) * sigmoid_f(c1[i] + bg));
        };
        sgemm_tile(rp, Wt, D, mt * 128, nt * 128, epi, F.wave, F.lane);
    }
}
__device__ __forceinline__ void phase_dwconv(Frame& F) {
    const bf16* U = (const bf16*)(F.ws + WS_U); bf16* V1 = (bf16*)(F.ws + WS_V1);
    const float* dww = F.in[I_DWW]; const float* dwb = F.in[I_DWB]; const float* lng = F.in[I_LNG]; const float* lnb = F.in[I_LNB];
    const int gw = F.wg * NWAVES + F.wave, NGW = F.G * NWAVES;
    for (int row = gw; row < T; row += NGW) {
        const int l = row & (L - 1);
        f32x4 acc[4];
#pragma unroll
        for (int j = 0; j < 4; ++j) acc[j] = *(const f32x4*)(dwb + 4 * F.lane + 256 * j);
        for (int tp = 0; tp < CONVW; ++tp) { const int ll = l + tp - 15; if (ll < 0 || ll >= L) continue;
            const bf16* ur = U + (size_t)(row + tp - 15) * D; const float* wr = dww + (size_t)tp * D;
#pragma unroll
            for (int j = 0; j < 4; ++j) { const int o = 4 * F.lane + 256 * j; const u32x2 uu = *(const u32x2*)(ur + o); const f32x4 ww = *(const f32x4*)(wr + o);
                acc[j].x += bflo(uu.x) * ww.x; acc[j].y += bfhi(uu.x) * ww.y; acc[j].z += bflo(uu.y) * ww.z; acc[j].w += bfhi(uu.y) * ww.w; } }
        float s = 0.f;
#pragma unroll
        for (int j = 0; j < 4; ++j) s += (acc[j].x + acc[j].y) + (acc[j].z + acc[j].w);
        const float mean = wave_sum(s) * (1.f / D); float q = 0.f;
#pragma unroll
        for (int j = 0; j < 4; ++j) { acc[j] = acc[j] - mean; q += (acc[j].x * acc[j].x + acc[j].y * acc[j].y) + (acc[j].z * acc[j].z + acc[j].w * acc[j].w); }
        const float rstd = rsqrtf(wave_sum(q) * (1.f / D) + EPS);
#pragma unroll
        for (int j = 0; j < 4; ++j) { const int o = 4 * F.lane + 256 * j; const f32x4 gg = *(const f32x4*)(lng + o), bb = *(const f32x4*)(lnb + o);
            f32x4 y = acc[j] * rstd * gg + bb; y.x = silu_f(y.x); y.y = silu_f(y.y); y.z = silu_f(y.z); y.w = silu_f(y.w); acc[j] = y; }
        row_store_bf16(V1 + (size_t)row * D, acc, F.lane);
    }
}


namespace pg {
constexpr int BM = 256, BK = 64, HALF = 128, HTB = HALF * BK * 2, STAGE_BYTES = 8 * HTB;
constexpr int TAB_OFF = STAGE_BYTES;
__device__ __forceinline__ int lds_byte(int r, int c) { const int st = (r >> 4) * 2 + (c >> 5), rr = r & 15, cc = c & 31, ob = rr * 64 + cc * 2; return st * 1024 + (ob ^ (((ob >> 9) & 1) << 5)); }
__device__ __forceinline__ void stage_rc(int b, int& R, int& C) { const int st = b / 1024, sb = b % 1024, swz = sb ^ (((sb >> 9) & 1) << 5); R = (st >> 1) * 16 + swz / 64; C = (st & 1) * 32 + (swz % 64) / 2; }
__device__ __forceinline__ int perm32(int rho) { const int n = rho >> 4, i = rho & 15; return 8 * (i >> 2) + 4 * n + (i & 3); }
__device__ __forceinline__ unsigned cvt_pk_bf16(float lo, float hi) { unsigned r; asm volatile("v_cvt_pk_bf16_f32 %0, %1, %2" : "=v"(r) : "v"(lo), "v"(hi)); return r; }

struct GU { const char* B; int p0, p1, p2, p3; };

template <class Epi, class Sched>
__device__ __forceinline__ void gemm_phase(LAS unsigned char* lds, const char* Abase, const int K, const Sched& S, const Epi& E) {
    const int tid = threadIdx.x, wid = __builtin_amdgcn_readfirstlane(tid >> 6), lane = tid & 63, wr = wid >> 2, wc = wid & 3, fr = lane & 15, fq = lane >> 4;
    const int nt = K / BK;
    int sR[2], sC[2]; unsigned voffB[2];
#pragma unroll
    for (int i = 0; i < 2; ++i) { int R, C; stage_rc(tid * 16 + i * 8192, R, C); sR[i] = R; sC[i] = C; const int Rb = Epi::PERM ? ((R & ~31) + perm32(R & 31)) : R; voffB[i] = (unsigned)(Rb * K + C) * 2u; }
    const size_t kstep = (size_t)(BK * 2);
    const size_t hstep = (size_t)HALF * K * 2;
    const unsigned ldsw = (unsigned)wid * 1024u;
    const int aoff = lds_byte(wr * 64 + fr, fq * 8), boff = lds_byte(wc * 32 + fr, fq * 8);
#define PG_SA(b, h) (((b) * 2 + (h)) * HTB)
#define PG_SB(b, h) ((4 + (b) * 2 + (h)) * HTB)
#define PG_STAGE(bufoff, gbase, voff) do { _Pragma("unroll") for (int _i = 0; _i < 2; ++_i) \
        __builtin_amdgcn_global_load_lds((const unsigned*)((const char*)(gbase) + (voff)[_i]), (LAS unsigned*)(lds + (bufoff) + ldsw + _i * 8192), 16, 0, 0); } while (0)
#define PG_LDA(dst, b, h) do { _Pragma("unroll") for (int m = 0; m < 4; ++m) _Pragma("unroll") for (int k = 0; k < 2; ++k) dst[m][k] = *(const LAS bf16x8*)(lds + PG_SA(b, h) + aoff + m * 2048 + k * 1024); } while (0)
#define PG_LDB(dst, b, h) do { _Pragma("unroll") for (int n = 0; n < 2; ++n) _Pragma("unroll") for (int k = 0; k < 2; ++k) dst[n][k] = *(const LAS bf16x8*)(lds + PG_SB(b, h) + boff + n * 2048 + k * 1024); } while (0)
#define PG_MMA(ai, bj, At, Bt) do { __builtin_amdgcn_s_setprio(1); _Pragma("unroll") for (int m = 0; m < 4; ++m) _Pragma("unroll") for (int n = 0; n < 2; ++n) _Pragma("unroll") for (int k = 0; k < 2; ++k) \
        acc[ai][bj][m][n] = __builtin_amdgcn_mfma_f32_16x16x32_bf16(Bt[n][k], At[m][k], acc[ai][bj][m][n], 0, 0, 0); __builtin_amdgcn_s_setprio(0); } while (0)
#define PG_WAIT_V(n) asm volatile("s_waitcnt vmcnt(" #n ")" ::: "memory")
#define PG_WAIT_L(n) asm volatile("s_waitcnt lgkmcnt(" #n ")" ::: "memory")
#define PG_BAR __builtin_amdgcn_s_barrier()
#define PG_SCHED __builtin_amdgcn_sched_barrier(0)
    GU cur, nxt; int ui = 0;
    if (!S.next(0, cur)) return;
    f32x4 acc[2][2][4][2];
#pragma unroll
    for (int a = 0; a < 2; ++a)
#pragma unroll
        for (int b = 0; b < 2; ++b)
#pragma unroll
            for (int m = 0; m < 4; ++m)
#pragma unroll
                for (int n = 0; n < 2; ++n) acc[a][b][m][n] = (f32x4){0.f, 0.f, 0.f, 0.f};
    bf16x8 At[4][2], B0[2][2], B1[2][2];
    if constexpr (Sched::GATHER) { S.stage_table(cur, 0, lds, wid, lane); PG_WAIT_V(0); PG_BAR; }
    unsigned voC[2][2], voN[2][2];
#pragma unroll
    for (int h = 0; h < 2; ++h)
#pragma unroll
        for (int i = 0; i < 2; ++i) { voC[h][i] = S.voff(cur, 0, lds, h * HALF + sR[i], sC[i]); voN[h][i] = voC[h][i]; }
    const char* cB = cur.B;
    PG_STAGE(PG_SB(0, 0), cB, voffB); PG_STAGE(PG_SB(0, 1), cB + hstep, voffB); PG_STAGE(PG_SA(0, 0), Abase, voC[0]); PG_STAGE(PG_SA(0, 1), Abase, voC[1]);
    if (wr == 1) PG_BAR;
    PG_WAIT_V(2); PG_BAR;
    PG_STAGE(PG_SB(1, 0), cB + kstep, voffB); PG_STAGE(PG_SA(1, 0), Abase + kstep, voC[0]); PG_STAGE(PG_SB(1, 1), cB + hstep + kstep, voffB);
    PG_WAIT_V(6); PG_BAR;
    for (;;) {
        const bool has_next = S.next(ui + 1, nxt);
        if constexpr (Sched::GATHER) { if (has_next) S.stage_table(nxt, (ui + 1) & 1, lds, wid, lane); }
        const char* nB = has_next ? nxt.B : cB;
        for (int t = 0; t < nt; t += 2) {
            const bool last = (t == nt - 2);
            if (last && has_next) {
#pragma unroll
                for (int h = 0; h < 2; ++h)
#pragma unroll
                    for (int i = 0; i < 2; ++i) voN[h][i] = S.voff(nxt, (ui + 1) & 1, lds, h * HALF + sR[i], sC[i]);
            }
            unsigned vo2[2][2];
#pragma unroll
            for (int h = 0; h < 2; ++h)
#pragma unroll
                for (int i = 0; i < 2; ++i) vo2[h][i] = last ? voN[h][i] : voC[h][i];
            const char* a1 = Abase + (size_t)(t + 1) * kstep;
            const char* a2 = last ? Abase : Abase + (size_t)(t + 2) * kstep; const char* b2 = last ? nB : cB + (size_t)(t + 2) * kstep;
            const char* a3 = a2 + kstep; const char* b3 = b2 + kstep;
            PG_LDB(B0, 0, 0); PG_LDB(B1, 0, 1); PG_SCHED; PG_LDA(At, 0, 0); PG_STAGE(PG_SA(1, 1), a1, voC[1]);
            PG_WAIT_V(8); PG_WAIT_L(0); PG_BAR; PG_MMA(0, 0, At, B0); PG_MMA(0, 1, At, B1); PG_BAR; PG_SCHED;
            PG_LDA(At, 0, 1); PG_STAGE(PG_SB(0, 0), b2, voffB); PG_STAGE(PG_SB(0, 1), b2 + hstep, voffB); PG_STAGE(PG_SA(0, 0), a2, vo2[0]);
            PG_WAIT_V(8); PG_WAIT_L(0); PG_BAR; PG_MMA(1, 0, At, B0); PG_MMA(1, 1, At, B1); PG_BAR; PG_SCHED;
            PG_LDB(B0, 1, 0); PG_LDB(B1, 1, 1); PG_SCHED; PG_LDA(At, 1, 0); PG_STAGE(PG_SA(0, 1), a2, vo2[1]);
            PG_WAIT_V(8); PG_WAIT_L(0); PG_BAR; PG_MMA(0, 0, At, B0); PG_MMA(0, 1, At, B1); PG_BAR; PG_SCHED;
            PG_LDA(At, 1, 1); PG_STAGE(PG_SB(1, 0), b3, voffB); PG_STAGE(PG_SB(1, 1), b3 + hstep, voffB); PG_STAGE(PG_SA(1, 0), a3, vo2[0]);
            PG_WAIT_V(8); PG_WAIT_L(0); PG_BAR; PG_MMA(1, 0, At, B0); PG_MMA(1, 1, At, B1); PG_BAR; PG_SCHED;
        }
        if (wr == 0) PG_BAR;
        E(acc, cur, wr, wc, fr, fq);
        if (!has_next) break;
#pragma unroll
        for (int a = 0; a < 2; ++a)
#pragma unroll
            for (int b = 0; b < 2; ++b)
#pragma unroll
                for (int m = 0; m < 4; ++m)
#pragma unroll
                    for (int n = 0; n < 2; ++n) acc[a][b][m][n] = (f32x4){0.f, 0.f, 0.f, 0.f};
        cur = nxt; cB = nB; ++ui;
#pragma unroll
        for (int h = 0; h < 2; ++h)
#pragma unroll
            for (int i = 0; i < 2; ++i) voC[h][i] = voN[h][i];
        if (wr == 1) PG_BAR;
    }
    PG_WAIT_V(0);
    PG_BAR;
#undef PG_SA
#undef PG_SB
#undef PG_STAGE
#undef PG_LDA
#undef PG_LDB
#undef PG_MMA
#undef PG_WAIT_V
#undef PG_WAIT_L
#undef PG_BAR
#undef PG_SCHED
}

__device__ __forceinline__ void static_tile(int L, int nM, int nN, int& pm, int& pn) {
    const int nwg = nM * nN; int wgid = L; { const int q = nwg / 8, r = nwg % 8, xcd = wgid % 8, off = wgid / 8; wgid = (xcd < r ? xcd * (q + 1) : r * (q + 1) + (xcd - r) * q) + off; }
    const int nig = 8 * nN, gid = wgid / nig, fm = gid * 8, gsz = (nM - fm) < 8 ? (nM - fm) : 8;
    pm = fm + ((wgid % nig) % gsz); pn = (wgid % nig) / gsz;
}
struct DenseSched {
    static constexpr bool GATHER = false;
    const char* Bt; int K, nM, nN, G, c, xn, xm0, xpn;
    __device__ __forceinline__ bool next(int i, GU& u) const {
        const int L = i * G + c, nmain = nM * nN; int pm, pn;
        if (L < nmain) static_tile(L, nM, nN, pm, pn); else if (L < nmain + xn) { pm = xm0 + (L - nmain); pn = xpn; } else return false;
        u.B = Bt + (size_t)pn * BM * K * 2; u.p0 = pm; u.p1 = pn; u.p2 = 0; u.p3 = 0; return true;
    }
    __device__ __forceinline__ unsigned voff(const GU& u, int, LAS unsigned char*, int R, int C) const { return (unsigned)(((u.p0 * BM + R) * K + C) * 2); }
    __device__ __forceinline__ void stage_table(const GU&, int, LAS unsigned char*, int, int) const {}
};
template <bool GATHER_> struct MoeSched {
    static constexpr bool GATHER = GATHER_;
    const char* Wt; size_t wstride; int K; const int* list; LAS int* mm; int G, c;
    __device__ __forceinline__ bool next(int i, GU& u) const {
        int L = i * G + c;
        for (int e = 0; e < 16; ++e) { const int n = mm[e], nu = ((n + 255) >> 8) * 4;
            if (L < nu) { const int rt = L >> 2, pn = L & 3; u.B = Wt + (size_t)e * wstride + (size_t)pn * BM * K * 2; u.p0 = e; u.p1 = rt; u.p2 = pn; u.p3 = mm[16 + e]; return true; }
            L -= nu; }
        return false;
    }
    __device__ __forceinline__ unsigned voff(const GU& u, int buf, LAS unsigned char* lds, int R, int C) const {
        if constexpr (GATHER_) { const int tok = ((const LAS int*)(lds + TAB_OFF))[buf * 256 + R]; return (unsigned)((tok * K + C) * 2); }
        else return (unsigned)(((u.p3 + u.p1 * BM + R) * K + C) * 2);
    }
    __device__ __forceinline__ void stage_table(const GU& u, int buf, LAS unsigned char* lds, int wid, int lane) const {
        if constexpr (GATHER_) { const int r = (wid & 3) * 64 + lane;
            __builtin_amdgcn_global_load_lds((const unsigned*)(list + u.p0 * CAP + u.p1 * BM + r), (LAS unsigned*)(lds + TAB_OFF + buf * 1024 + (wid & 3) * 256), 4, 0, 0); }
    }
};

struct EpiInProj {
    static constexpr bool PERM = false;
    unsigned char* ws;
    __device__ __forceinline__ void operator()(const f32x4 (&acc)[2][2][4][2], const GU& u, int wr, int wc, int fr, int fq) const {
        const int pm = u.p0, pn = u.p1; const bool isctx = pm >= T / BM;
        float inv[4];
#pragma unroll
        for (int j = 0; j < 4; ++j) inv[j] = exp2f(-(float)(4 * fq + j) * (13.287712379549449f / 16.f));
#pragma unroll
        for (int bj = 0; bj < 2; ++bj) {
            const int cb = pn * BM + bj * HALF + wc * 32;
            bf16* dst; int pitch, cbase; bool rope = false;
            if (cb < 512) { dst = (bf16*)(ws + WS_UF); pitch = 512; cbase = 0; }
            else if (cb < 1024) { dst = (bf16*)(ws + WS_Q); pitch = 512; cbase = 512; rope = true; }
            else if (cb < 1152) { dst = isctx ? (bf16*)(ws + WS_CK) : (bf16*)(ws + WS_K); pitch = 128; cbase = 1024; rope = !isctx; }
            else { dst = isctx ? (bf16*)(ws + WS_CV) : (bf16*)(ws + WS_V); pitch = 128; cbase = 1152; }
            const bool bycol = ((cb >> 5) & 1) != 0;
#pragma unroll
            for (int ai = 0; ai < 2; ++ai)
#pragma unroll
                for (int m = 0; m < 4; ++m) {
                    const int row = pm * BM + ai * HALF + wr * 64 + m * 16 + fr;
                    f32x4 v0 = acc[ai][bj][m][0], v1 = acc[ai][bj][m][1];
                    if (rope) { const int l = row & (L - 1); const float pos = (float)(bycol ? (l & 63) : (l >> 6));
#pragma unroll
                        for (int j = 0; j < 4; ++j) { const float ang = pos * inv[j], cs = __cosf(ang), sn = __sinf(ang); const float x1 = v0[j], x2 = v1[j]; v0[j] = x1 * cs - x2 * sn; v1[j] = x1 * sn + x2 * cs; } }
                    const int orow = isctx ? row - T : row;
                    if (FAST_ATTN && cb >= 1152) {
                        const int kp = isctx ? CL : L, bb = isctx ? (orow >> 8) : (orow >> 13), key = isctx ? (orow & (CL - 1)) : (orow & (L - 1));
#pragma unroll
                        for (int n = 0; n < 2; ++n)
#pragma unroll
                            for (int j = 0; j < 4; ++j) { const int c = (cb - 1152) + 16 * n + 4 * fq + j;
                                dst[((size_t)bb * 128 + c) * kp + key] = (bf16)f2bf(n ? v1[j] : v0[j]); }
                        continue;
                    }
                    bf16* o = dst + (size_t)orow * pitch + (cb - cbase) + 4 * fq;
                    u32x2 w0, w1; w0.x = cvt_pk_bf16(v0[0], v0[1]); w0.y = cvt_pk_bf16(v0[2], v0[3]); w1.x = cvt_pk_bf16(v1[0], v1[1]); w1.y = cvt_pk_bf16(v1[2], v1[3]);
                    *(u32x2*)o = w0; *(u32x2*)(o + 16) = w1;
                }
        }
    }
};
struct EpiRes {
    static constexpr bool PERM = false;
    const float* base; float* X; const float* gate; const float* bias;
    __device__ __forceinline__ void operator()(const f32x4 (&acc)[2][2][4][2], const GU& u, int wr, int wc, int fr, int fq) const {
        const int row0 = u.p0 * BM + wr * 64 + fr, col0 = u.p1 * BM + wc * 32 + 4 * fq; const int b = (u.p0 * BM) >> 13;
        f32x4 gv[2][2], bv[2][2];
#pragma unroll
        for (int bj = 0; bj < 2; ++bj)
#pragma unroll
            for (int n = 0; n < 2; ++n) { gv[bj][n] = *(const f32x4*)(gate + (size_t)b * 6144 + col0 + bj * HALF + n * 16); bv[bj][n] = bias ? *(const f32x4*)(bias + col0 + bj * HALF + n * 16) : (f32x4){0.f, 0.f, 0.f, 0.f}; }
#pragma unroll
        for (int ai = 0; ai < 2; ++ai)
#pragma unroll
            for (int mp = 0; mp < 2; ++mp) {
                f32x4 bs[2][2][2];
#pragma unroll
                for (int mm = 0; mm < 2; ++mm) { const size_t off = (size_t)(row0 + ai * HALF + (2 * mp + mm) * 16) * D + col0;
#pragma unroll
                    for (int bj = 0; bj < 2; ++bj)
#pragma unroll
                        for (int n = 0; n < 2; ++n) bs[mm][bj][n] = *(const f32x4*)(base + off + bj * HALF + n * 16); }
#pragma unroll
                for (int mm = 0; mm < 2; ++mm) { const int m = 2 * mp + mm; const size_t off = (size_t)(row0 + ai * HALF + m * 16) * D + col0;
#pragma unroll
                    for (int bj = 0; bj < 2; ++bj)
#pragma unroll
                        for (int n = 0; n < 2; ++n) *(f32x4*)(X + off + bj * HALF + n * 16) = bs[mm][bj][n] + gv[bj][n] * (acc[ai][bj][m][n] + bv[bj][n]); }
                asm volatile("" ::: "memory"); }
    }
};
template <bool BASEBF> struct EpiResB {
    static constexpr bool PERM = true;
    const float* basef; bf16* XB; const float* gate; const float* bias;
    __device__ __forceinline__ void operator()(const f32x4 (&acc)[2][2][4][2], const GU& u, int wr, int wc, int fr, int fq) const {
        const int row0 = u.p0 * BM + wr * 64 + fr, col0 = u.p1 * BM + wc * 32 + 8 * fq; const int b = (u.p0 * BM) >> 13;
        f32x4 gv[2][2], bv[2][2];
#pragma unroll
        for (int bj = 0; bj < 2; ++bj)
#pragma unroll
            for (int n = 0; n < 2; ++n) { gv[bj][n] = *(const f32x4*)(gate + (size_t)b * 6144 + col0 + bj * HALF + n * 4); bv[bj][n] = bias ? *(const f32x4*)(bias + col0 + bj * HALF + n * 4) : (f32x4){0.f, 0.f, 0.f, 0.f}; }
        constexpr int NB2 = BASEBF ? 4 : 2;
#pragma unroll
        for (int ai = 0; ai < 2; ++ai)
#pragma unroll
            for (int mb = 0; mb < 4; mb += NB2) {
                f32x4 bf[BASEBF ? 1 : NB2][2][2]; u32x4 bw[BASEBF ? NB2 : 1][2];
#pragma unroll
                for (int mm = 0; mm < NB2; ++mm) { const size_t off = (size_t)(row0 + ai * HALF + (mb + mm) * 16) * D + col0;
#pragma unroll
                    for (int bj = 0; bj < 2; ++bj) {
                        if (BASEBF) bw[mm][bj] = *(const u32x4*)(XB + off + bj * HALF);
                        else { bf[mm][bj][0] = *(const f32x4*)(basef + off + bj * HALF); bf[mm][bj][1] = *(const f32x4*)(basef + off + bj * HALF + 4); } } }
#pragma unroll
                for (int mm = 0; mm < NB2; ++mm) { const int m = mb + mm; const size_t off = (size_t)(row0 + ai * HALF + m * 16) * D + col0;
#pragma unroll
                    for (int bj = 0; bj < 2; ++bj) { f32x4 o[2];
#pragma unroll
                        for (int n = 0; n < 2; ++n) { f32x4 bsv;
                            if (BASEBF) { const unsigned wa = n ? bw[mm][bj].z : bw[mm][bj].x, wb = n ? bw[mm][bj].w : bw[mm][bj].y; bsv = (f32x4){bflo(wa), bfhi(wa), bflo(wb), bfhi(wb)}; } else bsv = bf[mm][bj][n];
                            o[n] = bsv + gv[bj][n] * (acc[ai][bj][m][n] + bv[bj][n]); }
                        u32x4 w2; w2.x = cvt_pk_bf16(o[0][0], o[0][1]); w2.y = cvt_pk_bf16(o[0][2], o[0][3]); w2.z = cvt_pk_bf16(o[1][0], o[1][1]); w2.w = cvt_pk_bf16(o[1][2], o[1][3]);
                        *(u32x4*)(XB + off + bj * HALF) = w2; } }
                asm volatile("" ::: "memory"); }
    }
};
struct EpiGLU {
    static constexpr bool PERM = true;
    bf16* U; const float* bias;
    __device__ __forceinline__ void operator()(const f32x4 (&acc)[2][2][4][2], const GU& u, int wr, int wc, int fr, int fq) const {
        const int row0 = u.p0 * BM + wr * 64 + fr, col0 = u.p1 * HALF + wc * 32 + 8 * fq;
        f32x4 ba[2], bg[2];
#pragma unroll
        for (int n = 0; n < 2; ++n) { ba[n] = *(const f32x4*)(bias + col0 + 4 * n); bg[n] = *(const f32x4*)(bias + 1024 + col0 + 4 * n); }
#pragma unroll
        for (int ai = 0; ai < 2; ++ai)
#pragma unroll
            for (int m = 0; m < 4; ++m) { f32x4 o[2];
#pragma unroll
                for (int n = 0; n < 2; ++n) { const f32x4 a = acc[ai][0][m][n] + ba[n], g = acc[ai][1][m][n] + bg[n];
#pragma unroll
                    for (int j = 0; j < 4; ++j) o[n][j] = a[j] * sigmoid_f(g[j]); }
                u32x4 w; w.x = cvt_pk_bf16(o[0][0], o[0][1]); w.y = cvt_pk_bf16(o[0][2], o[0][3]); w.z = cvt_pk_bf16(o[1][0], o[1][1]); w.w = cvt_pk_bf16(o[1][2], o[1][3]);
                *(u32x4*)(U + (size_t)(row0 + ai * HALF + m * 16) * D + col0) = w; }
    }
};
struct EpiGateUp {
    static constexpr bool PERM = true;
    bf16* HID; const float* slot_w; LAS int* mm;
    __device__ __forceinline__ void operator()(const f32x4 (&acc)[2][2][4][2], const GU& u, int wr, int wc, int fr, int fq) const {
        const int e = u.p0, n_e = mm[e], r0 = u.p1 * BM + wr * 64 + fr, col0 = u.p2 * HALF + wc * 32 + 8 * fq;
        float wv[2][4];
#pragma unroll
        for (int ai = 0; ai < 2; ++ai)
#pragma unroll
            for (int m = 0; m < 4; ++m) wv[ai][m] = slot_w[e * CAP + r0 + ai * HALF + m * 16];
#pragma unroll
        for (int ai = 0; ai < 2; ++ai)
#pragma unroll
            for (int m = 0; m < 4; ++m) { const int r = r0 + ai * HALF + m * 16;
                if (r < n_e) { const float w = wv[ai][m]; f32x4 o[2];
#pragma unroll
                    for (int n = 0; n < 2; ++n) { const f32x4 g = acc[ai][0][m][n], up = acc[ai][1][m][n];
#pragma unroll
                        for (int j = 0; j < 4; ++j) o[n][j] = w * silu_f(g[j]) * up[j]; }
                    u32x4 q; q.x = cvt_pk_bf16(o[0][0], o[0][1]); q.y = cvt_pk_bf16(o[0][2], o[0][3]); q.z = cvt_pk_bf16(o[1][0], o[1][1]); q.w = cvt_pk_bf16(o[1][2], o[1][3]);
                    *(u32x4*)(HID + (size_t)(u.p3 + r) * FF + col0) = q; } }
    }
};
struct EpiDown {
    static constexpr bool PERM = true;
    bf16* Y; LAS int* mm;
    __device__ __forceinline__ void operator()(const f32x4 (&acc)[2][2][4][2], const GU& u, int wr, int wc, int fr, int fq) const {
        const int e = u.p0, n_e = mm[e], r0 = u.p1 * BM + wr * 64 + fr, col0 = u.p2 * BM + wc * 32 + 8 * fq;
#pragma unroll
        for (int ai = 0; ai < 2; ++ai)
#pragma unroll
            for (int m = 0; m < 4; ++m) { const int r = r0 + ai * HALF + m * 16;
                if (r < n_e) {
#pragma unroll
                    for (int bj = 0; bj < 2; ++bj) { const f32x4 v0 = acc[ai][bj][m][0], v1 = acc[ai][bj][m][1];
                        u32x4 q; q.x = cvt_pk_bf16(v0[0], v0[1]); q.y = cvt_pk_bf16(v0[2], v0[3]); q.z = cvt_pk_bf16(v1[0], v1[1]); q.w = cvt_pk_bf16(v1[2], v1[3]);
                        *(u32x4*)(Y + (size_t)(u.p3 + r) * D + col0 + bj * HALF) = q; } } }
    }
};
}

__device__ __forceinline__ void fast_inproj(Frame& F) {
    pg::DenseSched S{(const char*)(F.ws + WS_WIN), D, T / 256, N_IN / 256, F.G, F.wg, TC / 256, T / 256, 4};
    pg::EpiInProj E{F.ws};
    pg::gemm_phase(F.lds, (const char*)(F.ws + WS_HB), D, S, E);
    const int nbusy = (T / 256) * (N_IN / 256) + TC / 256 - 2 * F.G;
    if (nbusy > 0 && nbusy < F.G) { if (F.wg >= nbusy) t_items_tail(F, (F.wg - nbusy) * NWAVES + F.wave, (F.G - nbusy) * NWAVES); }
    else t_items_tail(F, F.wg * NWAVES + F.wave, F.G * NWAVES);
}
__device__ __forceinline__ void fast_outproj(Frame& F, size_t a_off, size_t w_off, const float* base, float* X, const float* gate, const float* bias) {
    pg::DenseSched S{(const char*)(F.ws + w_off), D, T / 256, D / 256, F.G, F.wg, 0, 0, 0};
    if (XBF16) {
        if (base == X) { pg::EpiResB<true> E{nullptr, (bf16*)(F.ws + WS_XB), gate, bias}; pg::gemm_phase(F.lds, (const char*)(F.ws + a_off), D, S, E); }
        else { pg::EpiResB<false> E{base, (bf16*)(F.ws + WS_XB), gate, bias}; pg::gemm_phase(F.lds, (const char*)(F.ws + a_off), D, S, E); }
    } else { pg::EpiRes E{base, X, gate, bias}; pg::gemm_phase(F.lds, (const char*)(F.ws + a_off), D, S, E); }
}
__device__ __forceinline__ void fast_pw1(Frame& F) {
    pg::DenseSched S{(const char*)(F.ws + WS_WPW1), D, T / 256, 2048 / 256, F.G, F.wg, 0, 0, 0};
    pg::EpiGLU E{(bf16*)(F.ws + WS_U), F.in[I_PW1B]};
    pg::gemm_phase(F.lds, (const char*)(F.ws + WS_HB), D, S, E);
}
__device__ __forceinline__ void fast_moe_gateup(Frame& F, int layer) {
    LAS int* mm = moe_map(F, layer);
    pg::MoeSched<true> S{(const char*)(F.ws + WS_WGU) + (size_t)layer * 16 * 1024 * 1024 * 2, (size_t)1024 * 1024 * 2, D, (const int*)(F.ws + WS_SLOTT) + layer * 16 * CAP, mm, F.G, F.wg};
    pg::EpiGateUp E{(bf16*)(F.ws + WS_HID), (const float*)(F.ws + WS_SLOTW) + layer * 16 * CAP, mm};
    pg::gemm_phase(F.lds, (const char*)(F.ws + WS_HB), D, S, E);
}
__device__ __forceinline__ void fast_moe_down(Frame& F, int layer) {
    LAS int* mm = moe_map(F, layer);
    pg::MoeSched<false> S{(const char*)(F.ws + WS_WDN) + (size_t)layer * 16 * 1024 * 512 * 2, (size_t)1024 * 512 * 2, FF, nullptr, mm, F.G, F.wg};
    pg::EpiDown E{(bf16*)(F.ws + WS_Y), mm};
    pg::gemm_phase(F.lds, (const char*)(F.ws + WS_HID), FF, S, E);
}


struct AttnBlk { const bf16* kp; const bf16* vp; int pitch; int kb; bool valid, masked; };
__device__ __forceinline__ AttnBlk attn_blk(const unsigned char* ws, int bi, int b, int kvh, int qs) {
    AttnBlk a;
    if (bi < 8) { a.kp = (const bf16*)(ws + WS_CK) + (size_t)(b * CL + bi * 32) * 128 + kvh * 64; a.vp = (const bf16*)(ws + WS_CV) + (size_t)(b * 2 + kvh) * 64 * CL + bi * 32; a.pitch = CL; a.kb = 0; a.valid = true; a.masked = false; }
    else { const int kb = qs - 128 + 32 * (bi - 8); a.valid = (kb >= 0 && kb < L); a.kb = kb; a.masked = true; a.pitch = L;
        a.kp = (const bf16*)(ws + WS_K) + (size_t)(b * L + kb) * 128 + kvh * 64; a.vp = (const bf16*)(ws + WS_V) + (size_t)(b * 2 + kvh) * 64 * L + kb; }
    return a;
}
__device__ __forceinline__ void attn_load(const AttnBlk& a, int r, int h, bf16x8 (&kf)[4], u32x4 (&vf)[2][2]) {
    if (a.valid) {
#pragma unroll
        for (int s = 0; s < 4; ++s) kf[s] = *(const bf16x8*)(a.kp + (size_t)r * 128 + 16 * s + 8 * h);
#pragma unroll
        for (int db = 0; db < 2; ++db)
#pragma unroll
            for (int ks = 0; ks < 2; ++ks) { const bf16* vr = a.vp + (size_t)(32 * db + r) * a.pitch + 16 * ks + 4 * h;
                const u32x2 lo = *(const u32x2*)vr, hi = *(const u32x2*)(vr + 8); vf[db][ks] = (u32x4){lo.x, lo.y, hi.x, hi.y}; }
    }
}
__device__ __forceinline__ void attn_compute(const AttnBlk& a, int qs, int r, int h, const bf16x8 (&kf)[4], const u32x4 (&vf)[2][2], const bf16x8 (&qf)[2][4],
                                             f32x16 (&o)[2][2], float (&m)[2], float (&l)[2]) {
    if (!a.valid) return;
#pragma unroll
    for (int nq = 0; nq < 2; ++nq) {
        f32x16 st;
#pragma unroll
        for (int i = 0; i < 16; ++i) st[i] = 0.f;
#pragma unroll
        for (int s = 0; s < 4; ++s) st = __builtin_amdgcn_mfma_f32_32x32x16_bf16(kf[s], qf[nq][s], st, 0, 0, 0);
        float t[16]; float tmax = -INFINITY;
        const int dbase = a.kb - qs - 32 * nq - r + 4 * h;
#pragma unroll
        for (int i = 0; i < 16; ++i) { float v = st[i] * (0.125f * 1.4426950408889634f);
            if (a.masked) { const int df = dbase + (i & 3) + 8 * (i >> 2); v = (df >= -128 && df <= 128) ? v : -INFINITY; }
            t[i] = v; tmax = fmaxf(tmax, v); }
        tmax = fmaxf(tmax, __shfl_xor(tmax, 32));
        const float mn = fmaxf(m[nq], tmax), alpha = __builtin_amdgcn_exp2f(m[nq] - mn); m[nq] = mn;
        float ps = 0.f;
#pragma unroll
        for (int i = 0; i < 16; ++i) { t[i] = __builtin_amdgcn_exp2f(t[i] - mn); ps += t[i]; }
        l[nq] = l[nq] * alpha + ps;
#pragma unroll
        for (int i = 0; i < 16; ++i) { o[0][nq][i] *= alpha; o[1][nq][i] *= alpha; }
        bf16x8 pf[2];
#pragma unroll
        for (int ks = 0; ks < 2; ++ks) { const u32x4 w = {pkbf(t[8 * ks], t[8 * ks + 1]), pkbf(t[8 * ks + 2], t[8 * ks + 3]), pkbf(t[8 * ks + 4], t[8 * ks + 5]), pkbf(t[8 * ks + 6], t[8 * ks + 7])};
            pf[ks] = __builtin_bit_cast(bf16x8, w); }
#pragma unroll
        for (int db = 0; db < 2; ++db)
#pragma unroll
            for (int ks = 0; ks < 2; ++ks) o[db][nq] = __builtin_amdgcn_mfma_f32_32x32x16_bf16(__builtin_bit_cast(bf16x8, vf[db][ks]), pf[ks], o[db][nq], 0, 0, 0);
    }
}
__device__ __forceinline__ void phase_attn_mfma(Frame& F) {
    const bf16* Q = (const bf16*)(F.ws + WS_Q); bf16* MIX = (bf16*)(F.ws + WS_MIX);
    const int g = F.wave >> 1, half = F.wave & 1, r = F.lane & 31, h = F.lane >> 5;
    for (int item = F.wg; item < NB * 2 * 64; item += F.G) {
        const int qb = item & 63, kvh = (item >> 6) & 1, b = item >> 7, hd = kvh * 4 + g, qs = qb * 128 + half * 64;
        bf16x8 qf[2][4];
#pragma unroll
        for (int nq = 0; nq < 2; ++nq)
#pragma unroll
            for (int s = 0; s < 4; ++s) qf[nq][s] = *(const bf16x8*)(Q + (size_t)(b * L + qs + 32 * nq + r) * 512 + hd * 64 + 16 * s + 8 * h);
        f32x16 o[2][2];
#pragma unroll
        for (int db = 0; db < 2; ++db)
#pragma unroll
            for (int nq = 0; nq < 2; ++nq)
#pragma unroll
                for (int i = 0; i < 16; ++i) o[db][nq][i] = 0.f;
        float m[2], l[2];
        m[0] = m[1] = F.in[I_SINK][hd] * 1.4426950408889634f; l[0] = l[1] = (h == 0) ? 1.f : 0.f;
        bf16x8 kfA[4], kfB[4]; u32x4 vfA[2][2], vfB[2][2];
        AttnBlk ba = attn_blk(F.ws, 0, b, kvh, qs), bb;
        attn_load(ba, r, h, kfA, vfA);
#pragma unroll 1
        for (int bi = 0; bi < 18; bi += 2) {
            bb = attn_blk(F.ws, bi + 1, b, kvh, qs); attn_load(bb, r, h, kfB, vfB);
            attn_compute(ba, qs, r, h, kfA, vfA, qf, o, m, l);
            if (bi + 2 < 18) { ba = attn_blk(F.ws, bi + 2, b, kvh, qs); attn_load(ba, r, h, kfA, vfA); }
            attn_compute(bb, qs, r, h, kfB, vfB, qf, o, m, l);
        }
#pragma unroll
        for (int nq = 0; nq < 2; ++nq) {
            const float lt = l[nq] + __shfl_xor(l[nq], 32), il = 1.f / lt;
            bf16* orow = MIX + (size_t)(b * L + qs + 32 * nq + r) * 1024 + 512 + hd * 64;
#pragma unroll
            for (int db = 0; db < 2; ++db)
#pragma unroll
                for (int i4 = 0; i4 < 4; ++i4) { u32x2 w; w.x = pkbf(o[db][nq][4 * i4] * il, o[db][nq][4 * i4 + 1] * il); w.y = pkbf(o[db][nq][4 * i4 + 2] * il, o[db][nq][4 * i4 + 3] * il);
                    *(u32x2*)(orow + 32 * db + 8 * i4 + 4 * h) = w; }
        }
    }
}


__device__ __forceinline__ float half_max(float v) { const auto r = __builtin_amdgcn_permlane32_swap(__float_as_uint(v), __float_as_uint(v), false, false); return fmaxf(__uint_as_float(r[0]), __uint_as_float(r[1])); }
__device__ __forceinline__ float half_sum(float v) { const auto r = __builtin_amdgcn_permlane32_swap(__float_as_uint(v), __float_as_uint(v), false, false); return __uint_as_float(r[0]) + __uint_as_float(r[1]); }
constexpr int AT_KP = 72, AT_VP = 136;
constexpr int AT_KB = 128 * AT_KP * 2, AT_BUF = AT_KB + 64 * AT_VP * 2;
struct AtChunk { const bf16* kg; const bf16* vg; int vpitch, lc, b, kvh, qb, c; bool valid, local, any; };
__device__ __forceinline__ AtChunk at_chunk(const unsigned char* ws, int seq, int wg, int G) {
    AtChunk k; const int item = wg + (seq / 5) * G; k.c = seq % 5; k.any = item < NB * 2 * 64;
    k.qb = item & 63; k.kvh = (item >> 6) & 1; k.b = (item >> 7) & 3; k.local = k.c >= 2; k.lc = k.c - 2;
    if (!k.local) { k.valid = k.any; k.vpitch = CL; k.kg = (const bf16*)(ws + WS_CK) + (size_t)(k.b * CL + 128 * k.c) * 128 + k.kvh * 64; k.vg = (const bf16*)(ws + WS_CV) + (size_t)(k.b * 2 + k.kvh) * 64 * CL + 128 * k.c; }
    else { const int key0 = 128 * k.qb - 128 + 128 * k.lc; k.valid = k.any && key0 >= 0 && key0 < L; k.vpitch = L;
        k.kg = (const bf16*)(ws + WS_K) + (size_t)(k.b * L + key0) * 128 + k.kvh * 64; k.vg = (const bf16*)(ws + WS_V) + (size_t)(k.b * 2 + k.kvh) * 64 * L + key0; }
    return k;
}
__device__ __forceinline__ void at_issue(const AtChunk& k, int tid, u32x4 (&rg)[4]) {
    if (k.valid) {
#pragma unroll
        for (int i = 0; i < 2; ++i) { const int id = tid + 512 * i; rg[i] = *(const u32x4*)(k.kg + (size_t)(id >> 3) * 128 + (id & 7) * 8); }
#pragma unroll
        for (int i = 0; i < 2; ++i) { const int id = tid + 512 * i; rg[2 + i] = *(const u32x4*)(k.vg + (size_t)(id >> 4) * k.vpitch + (id & 15) * 8); }
    }
}
__device__ __forceinline__ void at_write(const AtChunk& k, LAS unsigned char* buf, int tid, const u32x4 (&rg)[4]) {
    if (k.valid) {
#pragma unroll
        for (int i = 0; i < 2; ++i) { const int id = tid + 512 * i; *(LAS u32x4*)(buf + (id >> 3) * (AT_KP * 2) + (id & 7) * 16) = rg[i]; }
#pragma unroll
        for (int i = 0; i < 2; ++i) { const int id = tid + 512 * i; *(LAS u32x4*)(buf + AT_KB + (id >> 4) * (AT_VP * 2) + (id & 15) * 16) = rg[2 + i]; }
    }
}
__device__ __forceinline__ void at_load(LAS unsigned char* buf, int blk, int r, int h, bf16x8 (&kf)[4], u32x4 (&vf)[2][2]) {
#pragma unroll
    for (int s2 = 0; s2 < 4; ++s2) kf[s2] = *(const LAS bf16x8*)(buf + (32 * blk + r) * (AT_KP * 2) + (16 * s2 + 8 * h) * 2);
#pragma unroll
    for (int db = 0; db < 2; ++db)
#pragma unroll
        for (int ks = 0; ks < 2; ++ks) { const LAS unsigned char* vr = buf + AT_KB + (32 * db + r) * (AT_VP * 2) + (32 * blk + 16 * ks + 4 * h) * 2;
            const u32x2 lo = *(const LAS u32x2*)vr, hi = *(const LAS u32x2*)(vr + 16); vf[db][ks] = (u32x4){lo.x, lo.y, hi.x, hi.y}; }
}
__device__ __forceinline__ void at_math(const bf16x8 (&kf)[4], const u32x4 (&vf)[2][2], bool masked, int kbrel, int r, int h, const bf16x8 (&qf)[2][4], f32x16 (&o)[2][2], float (&m)[2], float (&l)[2]) {
    constexpr float C = 0.125f * 1.4426950408889634f;
#pragma unroll
    for (int nq = 0; nq < 2; ++nq) {
        f32x16 st;
#pragma unroll
        for (int i = 0; i < 16; ++i) st[i] = 0.f;
#pragma unroll
        for (int s2 = 0; s2 < 4; ++s2) st = __builtin_amdgcn_mfma_f32_32x32x16_bf16(kf[s2], qf[nq][s2], st, 0, 0, 0);
        if (masked) { const int dbase = kbrel - 32 * nq - r + 4 * h;
#pragma unroll
            for (int i = 0; i < 16; ++i) { const int df = dbase + (i & 3) + 8 * (i >> 2); st[i] = (df >= -128 && df <= 128) ? st[i] : -INFINITY; } }
        float smax = st[0];
#pragma unroll
        for (int i = 1; i < 16; ++i) smax = fmaxf(smax, st[i]);
        smax = half_max(smax);
        const float mn = fmaxf(m[nq], smax * C), alpha = __builtin_amdgcn_exp2f(m[nq] - mn); m[nq] = mn;
        float t[16]; float ps = 0.f;
#pragma unroll
        for (int i = 0; i < 16; ++i) { t[i] = __builtin_amdgcn_exp2f(__builtin_fmaf(st[i], C, -mn)); ps += t[i]; }
        l[nq] = l[nq] * alpha + ps;
        if (__ballot(alpha != 1.f)) {
#pragma unroll
            for (int i = 0; i < 16; ++i) { o[0][nq][i] *= alpha; o[1][nq][i] *= alpha; } }
        bf16x8 pf[2];
#pragma unroll
        for (int ks = 0; ks < 2; ++ks) { const u32x4 w = {pkbf(t[8 * ks], t[8 * ks + 1]), pkbf(t[8 * ks + 2], t[8 * ks + 3]), pkbf(t[8 * ks + 4], t[8 * ks + 5]), pkbf(t[8 * ks + 6], t[8 * ks + 7])};
            pf[ks] = __builtin_bit_cast(bf16x8, w); }
#pragma unroll
        for (int db = 0; db < 2; ++db)
#pragma unroll
            for (int ks = 0; ks < 2; ++ks) o[db][nq] = __builtin_amdgcn_mfma_f32_32x32x16_bf16(__builtin_bit_cast(bf16x8, vf[db][ks]), pf[ks], o[db][nq], 0, 0, 0);
    }
}
__device__ __forceinline__ void phase_attn_lds(Frame& F) {
    const bf16* Q = (const bf16*)(F.ws + WS_Q); bf16* MIX = (bf16*)(F.ws + WS_MIX);
    const int g = F.wave >> 1, half = F.wave & 1, r = F.lane & 31, h = F.lane >> 5;
    __syncthreads();
    u32x4 rg[4];
    AtChunk ck = at_chunk(F.ws, 0, F.wg, F.G);
    if (!ck.any) return;
    at_issue(ck, F.tid, rg); at_write(ck, F.lds, F.tid, rg);
    __syncthreads();
    bf16x8 qf[2][4]; f32x16 o[2][2]; float m[2], l[2];
#pragma unroll 1
    for (int seq = 0; ck.any; ++seq) {
        LAS unsigned char* buf = F.lds + (seq & 1) * AT_BUF;
        const TItem ti = t_decode(F, seq < 10 ? 640 + (F.wg * NWAVES + F.wave) + seq * (F.G * NWAVES) : (1 << 30));
        t_dma(ti, F.lds + 2 * AT_BUF + F.wave * 8704, F.lane);
        const AtChunk nk = at_chunk(F.ws, seq + 1, F.wg, F.G);
        at_issue(nk, F.tid, rg);
        const int hd = ck.kvh * 4 + g, qs = ck.qb * 128 + half * 64;
        if (ck.c == 0) {
#pragma unroll
            for (int nq = 0; nq < 2; ++nq)
#pragma unroll
                for (int s2 = 0; s2 < 4; ++s2) qf[nq][s2] = *(const bf16x8*)(Q + (size_t)(ck.b * L + qs + 32 * nq + r) * 512 + hd * 64 + 16 * s2 + 8 * h);
#pragma unroll
            for (int db = 0; db < 2; ++db)
#pragma unroll
                for (int nq = 0; nq < 2; ++nq)
#pragma unroll
                    for (int i = 0; i < 16; ++i) o[db][nq][i] = 0.f;
            m[0] = m[1] = F.in[I_SINK][hd] * 1.4426950408889634f; l[0] = l[1] = (h == 0) ? 1.f : 0.f;
        }
        if (ck.valid) {
            int b0 = 0, b1 = 4;
            if (ck.local) { b0 = 2 * half - 4 * ck.lc; b0 = b0 < 0 ? 0 : b0; b1 = 2 * half + 10 - 4 * ck.lc; b1 = b1 > 4 ? 4 : b1; }
            if (b0 < b1) {
                bf16x8 kfA[4], kfB[4]; u32x4 vfA[2][2], vfB[2][2];
                at_load(buf, b0, r, h, kfA, vfA);
#pragma unroll 1
                for (int blk = b0; blk < b1; blk += 2) {
                    const int iA = 4 * ck.lc + blk - 2 * half, iB = iA + 1;
                    if (blk + 1 < b1) at_load(buf, blk + 1, r, h, kfB, vfB);
                    at_math(kfA, vfA, ck.local && (iA < 2 || iA > 7), 32 * iA - 128, r, h, qf, o, m, l);
                    if (blk + 1 < b1) {
                        if (blk + 2 < b1) at_load(buf, blk + 2, r, h, kfA, vfA);
                        at_math(kfB, vfB, ck.local && (iB < 2 || iB > 7), 32 * iB - 128, r, h, qf, o, m, l);
                    }
                }
            }
        }
        if (ck.c == 4) {
#pragma unroll
            for (int nq = 0; nq < 2; ++nq) {
                const float lt = half_sum(l[nq]), il = __builtin_amdgcn_rcpf(lt);
                bf16* orow = MIX + (size_t)(ck.b * L + qs + 32 * nq + r) * 1024 + 512 + hd * 64;
#pragma unroll
                for (int db = 0; db < 2; ++db)
#pragma unroll
                    for (int i4 = 0; i4 < 4; ++i4) { u32x2 w; w.x = pkbf(o[db][nq][4 * i4] * il, o[db][nq][4 * i4 + 1] * il); w.y = pkbf(o[db][nq][4 * i4 + 2] * il, o[db][nq][4 * i4 + 3] * il);
                        *(u32x2*)(orow + 32 * db + 8 * i4 + 4 * h) = w; }
            }
        }
        if (ti.ok) { asm volatile("s_waitcnt vmcnt(0)" ::: "memory"); t_store_dma(ti, (const LAS float*)(F.lds + 2 * AT_BUF + F.wave * 8704), F.lane); }
        at_write(nk, F.lds + ((seq + 1) & 1) * AT_BUF, F.tid, rg);
        __syncthreads();
        ck = nk;
    }
}

constexpr int F1_PC = 136, F1_PW = 68, F2_P = 264;
constexpr int F1_CSC = 0, F1_CSS = 128 * F1_PC * 2, F1_C64 = 2 * 128 * F1_PC * 2, F1_S64 = F1_C64 + 64 * F1_PW * 2;
__device__ __forceinline__ bf16x8 pack8(float a0, float a1, float a2, float a3, float a4, float a5, float a6, float a7) {
    const u32x4 w = {pkbf(a0, a1), pkbf(a2, a3), pkbf(a4, a5), pkbf(a6, a7)}; return __builtin_bit_cast(bf16x8, w); }
__device__ __forceinline__ void phase_fft1_mfma(Frame& F) {
    __syncthreads();
    LAS bf16* csc = (LAS bf16*)(F.lds + F1_CSC); LAS bf16* css = (LAS bf16*)(F.lds + F1_CSS); LAS bf16* c64 = (LAS bf16*)(F.lds + F1_C64); LAS bf16* s64 = (LAS bf16*)(F.lds + F1_S64);
    for (int i = F.tid; i < 128 * 128; i += NTHR) { const int n = i >> 7, k = i & 127; const float ang = (float)((n * k) & 127) * (6.283185307179586f / 128.f);
        csc[n * F1_PC + k] = (bf16)f2bf(__cosf(ang)); css[n * F1_PC + k] = (bf16)f2bf(__sinf(ang)); }
    for (int i = F.tid; i < 64 * 64; i += NTHR) { const int c = i >> 6, a = i & 63; const float ang = (float)((c * a) & 63) * (6.283185307179586f / 64.f);
        c64[c * F1_PW + a] = (bf16)f2bf(__cosf(ang)); s64[c * F1_PW + a] = (bf16)f2bf(__sinf(ang)); }
    __syncthreads();
    const bf16* UF = (const bf16*)(F.ws + WS_UF); bf16* Gb = (bf16*)(F.ws + WS_G);
    const int r = F.lane & 31, h = F.lane >> 5, g = F.wave >> 1;
    for (int item = F.wg; item < NB * FN2; item += F.G) {
        const int b = item >> 7, bp = item & 127;
        bf16x8 uf[2][8];
#pragma unroll
        for (int rb = 0; rb < 2; ++rb)
#pragma unroll
            for (int s2 = 0; s2 < 8; ++s2) uf[rb][s2] = *(const bf16x8*)(UF + (size_t)(b * L + 128 * (32 * rb + r) + bp) * 512 + g * 128 + 16 * s2 + 8 * h);
#pragma unroll 1
        for (int q = 0; q < 2; ++q) {
            const int cbk = 2 * F.wave + q, n = 32 * (cbk & 3) + r, ch = 32 * cbk + r;
            f32x16 zr[2], zi[2];
#pragma unroll
            for (int rb = 0; rb < 2; ++rb) {
#pragma unroll
                for (int i = 0; i < 16; ++i) { zr[rb][i] = 0.f; zi[rb][i] = 0.f; }
#pragma unroll
                for (int s2 = 0; s2 < 8; ++s2) { const bf16x8 bc = *(const LAS bf16x8*)(csc + n * F1_PC + 16 * s2 + 8 * h), bs = *(const LAS bf16x8*)(css + n * F1_PC + 16 * s2 + 8 * h);
                    zr[rb] = __builtin_amdgcn_mfma_f32_32x32x16_bf16(uf[rb][s2], bc, zr[rb], 0, 0, 0); zi[rb] = __builtin_amdgcn_mfma_f32_32x32x16_bf16(uf[rb][s2], bs, zi[rb], 0, 0, 0); }
                __builtin_amdgcn_sched_barrier(0);
            }
            bf16x8 zfr[4], zfi[4];
#pragma unroll
            for (int ks = 0; ks < 4; ++ks) { const int rb = ks >> 1, o = 8 * (ks & 1);
                zfr[ks] = pack8(zr[rb][o], zr[rb][o + 1], zr[rb][o + 2], zr[rb][o + 3], zr[rb][o + 4], zr[rb][o + 5], zr[rb][o + 6], zr[rb][o + 7]);
                zfi[ks] = pack8(-zi[rb][o], -zi[rb][o + 1], -zi[rb][o + 2], -zi[rb][o + 3], -zi[rb][o + 4], -zi[rb][o + 5], -zi[rb][o + 6], -zi[rb][o + 7]); }
            __builtin_amdgcn_sched_barrier(0);
#pragma unroll 1
            for (int rbc = 0; rbc < 2; ++rbc) {
                f32x16 gr, gi; const int cr = 32 * rbc + r;
#pragma unroll
                for (int i = 0; i < 16; ++i) { gr[i] = 0.f; gi[i] = 0.f; }
#pragma unroll
                for (int ks = 0; ks < 4; ++ks) {
                    const u32x2 cl = *(const LAS u32x2*)(c64 + cr * F1_PW + 16 * ks + 4 * h), chh = *(const LAS u32x2*)(c64 + cr * F1_PW + 16 * ks + 8 + 4 * h);
                    const u32x2 sl = *(const LAS u32x2*)(s64 + cr * F1_PW + 16 * ks + 4 * h), shh = *(const LAS u32x2*)(s64 + cr * F1_PW + 16 * ks + 8 + 4 * h);
                    const u32x4 sw = {sl.x, sl.y, shh.x, shh.y}; const u32x4 swn = sw ^ 0x80008000u;
                    const bf16x8 wc = __builtin_bit_cast(bf16x8, ((u32x4){cl.x, cl.y, chh.x, chh.y})), wsn = __builtin_bit_cast(bf16x8, sw), wsm = __builtin_bit_cast(bf16x8, swn);
                    gr = __builtin_amdgcn_mfma_f32_32x32x16_bf16(wc, zfr[ks], gr, 0, 0, 0); gr = __builtin_amdgcn_mfma_f32_32x32x16_bf16(wsn, zfi[ks], gr, 0, 0, 0);
                    gi = __builtin_amdgcn_mfma_f32_32x32x16_bf16(wc, zfi[ks], gi, 0, 0, 0); gi = __builtin_amdgcn_mfma_f32_32x32x16_bf16(wsm, zfr[ks], gi, 0, 0, 0); }
                __builtin_amdgcn_sched_barrier(0);
#pragma unroll
                for (int i = 0; i < 16; ++i) { const int c = 32 * rbc + crow(i, h); const float ang = (float)(bp * c) * (6.283185307179586f / 8192.f), cs = __cosf(ang), sn = __sinf(ang);
                    const float re = gr[i] * cs + gi[i] * sn, im = gi[i] * cs - gr[i] * sn;
                    bf16* o = Gb + (size_t)((b * FN1 + c) * FN2 + bp) * 1024 + ch; o[0] = (bf16)f2bf(re); o[512] = (bf16)f2bf(im);
                    if ((i & 3) == 3) __builtin_amdgcn_sched_barrier(0); }
            }
        }
    }
    __syncthreads();
}
__device__ __forceinline__ void phase_fft2_mfma(Frame& F) {
    __syncthreads();
    LAS bf16* t2 = (LAS bf16*)F.lds;
    for (int i = F.tid; i < 128 * 256; i += NTHR) { const int d = i >> 8, k = i & 255; const float ang = (float)((d * (k & 127)) & 127) * (6.283185307179586f / 128.f);
        t2[d * F2_P + k] = (bf16)f2bf(k < 128 ? __cosf(ang) : __sinf(ang)); }
    __syncthreads();
    const bf16* Gb = (const bf16*)(F.ws + WS_G); bf16* MIX = (bf16*)(F.ws + WS_MIX);
    const int r = F.lane & 31, h = F.lane >> 5;
    for (int item = F.wg; item < NB * FN1; item += F.G) {
        const int b = item >> 6, c = item & 63;
        const bf16* Gp = Gb + (size_t)((b * FN1 + c) * FN2) * 1024 + 64 * F.wave + r;
        f32x16 y[4][2];
#pragma unroll
        for (int rb = 0; rb < 4; ++rb)
#pragma unroll
            for (int cb = 0; cb < 2; ++cb)
#pragma unroll
                for (int i = 0; i < 16; ++i) y[rb][cb][i] = 0.f;
        unsigned eA[2][8], eB[2][8], eC[2][8], eD[2][8];
#define F2_GATHER(dst, ks_) do { const bf16* p_ = Gp + (size_t)(16 * ((ks_) & 7) + 8 * h) * 1024 + ((ks_) >> 3) * 512; \
            _Pragma("unroll") for (int cb = 0; cb < 2; ++cb) _Pragma("unroll") for (int j = 0; j < 8; ++j) dst[cb][j] = p_[(size_t)j * 1024 + 32 * cb]; } while (0)
#define F2_MMA(src, ks_) do { bf16x8 bfr[2]; _Pragma("unroll") for (int cb = 0; cb < 2; ++cb) { \
                const u32x4 w = {src[cb][0] | (src[cb][1] << 16), src[cb][2] | (src[cb][3] << 16), src[cb][4] | (src[cb][5] << 16), src[cb][6] | (src[cb][7] << 16)}; bfr[cb] = __builtin_bit_cast(bf16x8, w); } \
            _Pragma("unroll") for (int rb = 0; rb < 4; ++rb) { const bf16x8 a = *(const LAS bf16x8*)(t2 + (32 * rb + r) * F2_P + 16 * (ks_) + 8 * h); \
                _Pragma("unroll") for (int cb = 0; cb < 2; ++cb) y[rb][cb] = __builtin_amdgcn_mfma_f32_32x32x16_bf16(a, bfr[cb], y[rb][cb], 0, 0, 0); } } while (0)
        F2_GATHER(eA, 0); F2_GATHER(eB, 1); F2_GATHER(eC, 2);
#pragma unroll 1
        for (int ks = 0; ks < 16; ks += 4) {
            F2_GATHER(eD, ks + 3);
            F2_MMA(eA, ks);
            if (ks + 4 < 16) F2_GATHER(eA, ks + 4);
            F2_MMA(eB, ks + 1);
            if (ks + 4 < 16) F2_GATHER(eB, ks + 5);
            F2_MMA(eC, ks + 2);
            if (ks + 4 < 16) F2_GATHER(eC, ks + 6);
            F2_MMA(eD, ks + 3);
        }
#undef F2_GATHER
#undef F2_MMA
#pragma unroll
        for (int rb = 0; rb < 4; ++rb)
#pragma unroll
            for (int cb = 0; cb < 2; ++cb)
#pragma unroll
                for (int i = 0; i < 16; ++i) { const int d = 32 * rb + crow(i, h); MIX[(size_t)(b * L + c + 64 * d) * 1024 + 64 * F.wave + 32 * cb + r] = (bf16)f2bf(y[rb][cb][i] * (1.f / 1024.f)); }
    }
    __syncthreads();
}


typedef float f32x2_t __attribute__((ext_vector_type(2)));
template <int IR> struct DwIn {
    static __device__ __forceinline__ void run(const unsigned (&uin)[62], const f32x2_t (&w)[31], f32x2_t (&o)[32]) {
        const f32x2_t x = {bflo(uin[IR]), bfhi(uin[IR])};
#pragma unroll
        for (int r = 0; r < 32; ++r) { if (IR - r >= 0 && IR - r <= 30) o[r] += w[(IR - r >= 0 && IR - r <= 30) ? IR - r : 0] * x; }
        DwIn<IR + 1>::run(uin, w, o);
    }
};
template <> struct DwIn<62> { static __device__ __forceinline__ void run(const unsigned (&)[62], const f32x2_t (&)[31], f32x2_t (&)[32]) {} };
template <int IR> struct DwIn16 {
    static __device__ __forceinline__ void run(const unsigned (&uin)[46], const f32x2_t (&w)[31], f32x2_t (&o)[16]) {
        const f32x2_t x = {bflo(uin[IR]), bfhi(uin[IR])};
#pragma unroll
        for (int r = 0; r < 16; ++r) { if (IR - r >= 0 && IR - r <= 30) o[r] += w[(IR - r >= 0 && IR - r <= 30) ? IR - r : 0] * x; }
        DwIn16<IR + 1>::run(uin, w, o);
    }
};
template <> struct DwIn16<46> { static __device__ __forceinline__ void run(const unsigned (&)[46], const f32x2_t (&)[31], f32x2_t (&)[16]) {} };
__device__ __forceinline__ void phase_dwconv_fast(Frame& F) {
    const bf16* U = (const bf16*)(F.ws + WS_U); bf16* V1 = (bf16*)(F.ws + WS_V1);
    const float* dww = F.in[I_DWW];
    const int c0 = 2 * F.tid;
    f32x2_t w[31];
#pragma unroll
    for (int j = 0; j < 31; ++j) w[j] = *(const f32x2_t*)(dww + (size_t)j * D + c0);
    const f32x2_t bb = *(const f32x2_t*)(F.in[I_DWB] + c0), gg = *(const f32x2_t*)(F.in[I_LNG] + c0), lb = *(const f32x2_t*)(F.in[I_LNB] + c0);
    LAS float* red = (LAS float*)F.lds;
    LAS float* stat = red + 16 * 8 * 2;
    __syncthreads();
    for (int run = F.wg; run < T / 128; run += F.G) {
        const int row0 = run * 128, l0 = row0 & (L - 1);
        unsigned uin[46], nx[16];
#pragma unroll
        for (int ir = 0; ir < 46; ++ir) { const int l = l0 - 15 + ir; const bool ok = (l >= 0 && l < L);
            const unsigned u = *(const unsigned*)(U + (size_t)(ok ? row0 - 15 + ir : row0) * D + c0); uin[ir] = ok ? u : 0u; }
#pragma unroll 1
        for (int step = 0; step < 8; ++step) {
            const int r0 = row0 + 16 * step;
            if (step < 7) {
#pragma unroll
                for (int j = 0; j < 16; ++j) { const int l = l0 + 16 * step + 31 + j; const bool ok = l < L;
                    const unsigned u = *(const unsigned*)(U + (size_t)(ok ? r0 + 31 + j : r0) * D + c0); nx[j] = ok ? u : 0u; }
            }
            f32x2_t o[16];
#pragma unroll
            for (int r = 0; r < 16; ++r) o[r] = bb;
            DwIn16<0>::run(uin, w, o);
#pragma unroll
            for (int r = 0; r < 16; ++r) { const float sm = wave_sum(o[r].x + o[r].y), sq = wave_sum(o[r].x * o[r].x + o[r].y * o[r].y);
                if (F.lane == 0) { red[(r * 8 + F.wave) * 2] = sm; red[(r * 8 + F.wave) * 2 + 1] = sq; } }
            __syncthreads();
            if (F.tid < 16) { float sm = 0.f, sq = 0.f;
#pragma unroll
                for (int wv = 0; wv < 8; ++wv) { sm += red[(F.tid * 8 + wv) * 2]; sq += red[(F.tid * 8 + wv) * 2 + 1]; }
                const float mean = sm * (1.f / D), var = fmaxf(sq * (1.f / D) - mean * mean, 0.f);
                stat[2 * F.tid] = mean; stat[2 * F.tid + 1] = rsqrtf(var + EPS); }
            __syncthreads();
#pragma unroll
            for (int r = 0; r < 16; ++r) { const float mean = stat[2 * r], rstd = stat[2 * r + 1];
                const float y0 = silu_f((o[r].x - mean) * rstd * gg.x + lb.x), y1 = silu_f((o[r].y - mean) * rstd * gg.y + lb.y);
                *(unsigned*)(V1 + (size_t)(r0 + r) * D + c0) = pkbf(y0, y1); }
#pragma unroll
            for (int i = 0; i < 30; ++i) uin[i] = uin[i + 16];
#pragma unroll
            for (int j = 0; j < 16; ++j) uin[30 + j] = nx[j];
        }
        __syncthreads();
    }
}

namespace pg {
struct MU { const char* B; const char* A; int K, type, e, rt, pn, hb, buf; };
struct MoeMergedSched {
    const char* Wgu; const char* Wdn; const char* HBp; const char* HIDp; const int* list; const float* wlist; LAS int* mm; unsigned* tcnt; unsigned* tmo; int G, c, U;
    __device__ __forceinline__ bool flat(int L, int type, MU& u) const {
        for (int e = 0; e < 16; ++e) { const int n = mm[e], nu = ((n + 255) >> 8) * 4;
            if (L < nu) { u.e = e; u.rt = L >> 2; u.pn = L & 3; u.hb = mm[16 + e]; u.type = type; u.buf = 0;
                if (type == 0) { u.K = D; u.A = HBp; u.B = Wgu + (size_t)e * (1024 * 1024 * 2) + (size_t)u.pn * BM * D * 2; }
                else { u.K = FF; u.A = HIDp; u.B = Wdn + (size_t)e * (1024 * 512 * 2) + (size_t)u.pn * BM * FF * 2; }
                return true; }
            L -= nu; }
        return false;
    }
    __device__ __forceinline__ bool next(int i, MU& u) const {
        const int ngu = c < U ? (U - 1 - c) / G + 1 : 0;
        if (i < ngu) return flat(i * G + c, 0, u);
        const int k = i - ngu, x = U % G; int j;
        if (c >= x) { if (k == 0) j = c - x; else j = (G - 1 - c) + (k - 1) * G + (G - x); } else j = (G - 1 - c) + k * G + (G - x);
        if (j >= U) return false;
        return flat(j, 1, u);
    }
    __device__ __forceinline__ unsigned voff(const MU& u, int buf, LAS unsigned char* lds, int R, int C) const {
        if (u.type == 0) { const int tok = ((const LAS int*)(lds + TAB_OFF))[buf * 256 + R]; return (unsigned)((tok * D + C) * 2); }
        return (unsigned)(((u.hb + u.rt * BM + R) * FF + C) * 2);
    }
    __device__ __forceinline__ void stage_table(const MU& u, int buf, LAS unsigned char* lds, int wid, int lane) const {
        const int r = (wid & 3) * 64 + lane;
        __builtin_amdgcn_global_load_lds((const unsigned*)(list + u.e * CAP + u.rt * BM + r), (LAS unsigned*)(lds + TAB_OFF + buf * 1024 + (wid & 3) * 256), 4, 0, 0);
        __builtin_amdgcn_global_load_lds((const unsigned*)(wlist + u.e * CAP + u.rt * BM + r), (LAS unsigned*)(lds + TAB_OFF + 2048 + buf * 1024 + (wid & 3) * 256), 4, 0, 0);
    }
    __device__ __forceinline__ unsigned* tile_word(const MU& u) const { return tcnt + ((u.hb >> 8) + u.rt) * 64; }
    __device__ __forceinline__ void wait_ready(const MU& u, int wid) const {
        if (wid == 0) {
            unsigned* w = tile_word(u); unsigned spins = 0;
            while ((unsigned)__builtin_amdgcn_readfirstlane(__hip_atomic_load(w, __ATOMIC_RELAXED, __HIP_MEMORY_SCOPE_AGENT)) < 32u) {
                __builtin_amdgcn_s_sleep(2);
                if ((++spins & 255u) == 0u) { if (__builtin_amdgcn_readfirstlane(__hip_atomic_load(tmo, __ATOMIC_RELAXED, __HIP_MEMORY_SCOPE_AGENT)) != 0u) break;
                    if (spins > (1u << 20)) { __hip_atomic_store(tmo, 1u, __ATOMIC_RELAXED, __HIP_MEMORY_SCOPE_AGENT); break; } } }
        }
        asm volatile("" ::: "memory"); __builtin_amdgcn_s_barrier(); asm volatile("" ::: "memory");
    }
};
struct EpiGateUpWT {
    __amdgpu_buffer_rsrc_t rsrc; LAS unsigned char* lds; LAS int* mm;
    __device__ __forceinline__ void operator()(const f32x4 (&acc)[2][2][4][2], const MU& u, int wr, int wc, int fr, int fq) const {
        const int e = u.e, n_e = mm[e], r0 = u.rt * BM + wr * 64 + fr, col0 = u.pn * HALF + wc * 32 + 8 * fq;
        float wv[2][4];
#pragma unroll
        for (int ai = 0; ai < 2; ++ai)
#pragma unroll
            for (int m = 0; m < 4; ++m) wv[ai][m] = ((const LAS float*)(lds + TAB_OFF + 2048))[u.buf * 256 + wr * 64 + fr + ai * HALF + m * 16];
#pragma unroll
        for (int ai = 0; ai < 2; ++ai)
#pragma unroll
            for (int m = 0; m < 4; ++m) { const int r = r0 + ai * HALF + m * 16;
                if (r < n_e) { const float w = wv[ai][m]; f32x4 o[2];
#pragma unroll
                    for (int n = 0; n < 2; ++n) { const f32x4 g = acc[ai][0][m][n], up = acc[ai][1][m][n];
#pragma unroll
                        for (int j = 0; j < 4; ++j) o[n][j] = w * silu_f(g[j]) * up[j]; }
                    u32x4 q; q.x = cvt_pk_bf16(o[0][0], o[0][1]); q.y = cvt_pk_bf16(o[0][2], o[0][3]); q.z = cvt_pk_bf16(o[1][0], o[1][1]); q.w = cvt_pk_bf16(o[1][2], o[1][3]);
                    __builtin_amdgcn_raw_buffer_store_b128(q, rsrc, (unsigned)(((u.hb + r) * FF + col0) * 2), 0, 16); } }
    }
};
struct EpiDownM {
    unsigned char* Y8; LAS int* mm;
    __device__ __forceinline__ void operator()(const f32x4 (&acc)[2][2][4][2], const MU& u, int wr, int wc, int fr, int fq) const {
        const int e = u.e, n_e = mm[e], r0 = u.rt * BM + wr * 64 + fr, col0 = u.pn * BM + 64 * wc + 16 * fq;
#pragma unroll
        for (int ai = 0; ai < 2; ++ai)
#pragma unroll
            for (int m = 0; m < 4; ++m) { const int r = r0 + ai * HALF + m * 16;
                if (r < n_e) { u32x4 q; q.x = pk_fp8x4(acc[ai][0][m][0]); q.y = pk_fp8x4(acc[ai][0][m][1]); q.z = pk_fp8x4(acc[ai][1][m][0]); q.w = pk_fp8x4(acc[ai][1][m][1]);
                    *(u32x4*)(Y8 + (size_t)(u.hb + r) * D + col0) = q; } }
    }
};
__device__ __forceinline__ void gemm_phase_moe(LAS unsigned char* lds, const MoeMergedSched& S, const EpiGateUpWT& EA, const EpiDownM& EB) {
    const int tid = threadIdx.x, wid = __builtin_amdgcn_readfirstlane(tid >> 6), lane = tid & 63, wr = wid >> 2, wc = wid & 3, fr = lane & 15, fq = lane >> 4;
    int sR[2], sC[2]; unsigned vbA[2], vbD[2];
#pragma unroll
    for (int i = 0; i < 2; ++i) { int R, C; stage_rc(tid * 16 + i * 8192, R, C); sR[i] = R; sC[i] = C; const int Rb = (R & ~31) + perm32(R & 31);
        const int RbD = 64 * ((Rb >> 5) & 3) + 16 * ((Rb >> 3) & 3) + (Rb & 7);
        vbA[i] = (unsigned)(Rb * D + C) * 2u; vbD[i] = (unsigned)(RbD * FF + C) * 2u; }
    const size_t kstep = (size_t)(BK * 2);
    const unsigned ldsw = (unsigned)wid * 1024u;
    const int aoff = lds_byte(wr * 64 + fr, fq * 8), boff = lds_byte(wc * 32 + fr, fq * 8);
#define PG_SA(b, h) (((b) * 2 + (h)) * HTB)
#define PG_SB(b, h) ((4 + (b) * 2 + (h)) * HTB)
#define PG_STAGE(bufoff, gbase, voff) do { _Pragma("unroll") for (int _i = 0; _i < 2; ++_i) \
        __builtin_amdgcn_global_load_lds((const unsigned*)((const char*)(gbase) + (voff)[_i]), (LAS unsigned*)(lds + (bufoff) + ldsw + _i * 8192), 16, 0, 0); } while (0)
#define PG_LDA(dst, b, h) do { _Pragma("unroll") for (int m = 0; m < 4; ++m) _Pragma("unroll") for (int k = 0; k < 2; ++k) dst[m][k] = *(const LAS bf16x8*)(lds + PG_SA(b, h) + aoff + m * 2048 + k * 1024); } while (0)
#define PG_LDB(dst, b, h) do { _Pragma("unroll") for (int n = 0; n < 2; ++n) _Pragma("unroll") for (int k = 0; k < 2; ++k) dst[n][k] = *(const LAS bf16x8*)(lds + PG_SB(b, h) + boff + n * 2048 + k * 1024); } while (0)
#define PG_MMA(ai, bj, At, Bt) do { __builtin_amdgcn_s_setprio(1); _Pragma("unroll") for (int m = 0; m < 4; ++m) _Pragma("unroll") for (int n = 0; n < 2; ++n) _Pragma("unroll") for (int k = 0; k < 2; ++k) \
        acc[ai][bj][m][n] = __builtin_amdgcn_mfma_f32_16x16x32_bf16(Bt[n][k], At[m][k], acc[ai][bj][m][n], 0, 0, 0); __builtin_amdgcn_s_setprio(0); } while (0)
#define PG_WAIT_V(n) asm volatile("s_waitcnt vmcnt(" #n ")" ::: "memory")
#define PG_WAIT_L(n) asm volatile("s_waitcnt lgkmcnt(" #n ")" ::: "memory")
#define PG_BAR __builtin_amdgcn_s_barrier()
#define PG_SCHED __builtin_amdgcn_sched_barrier(0)
    MU cur, nxt; int ui = 0;
    if (!S.next(0, cur)) return;
    cur.buf = 0;
    f32x4 acc[2][2][4][2];
#pragma unroll
    for (int a = 0; a < 2; ++a)
#pragma unroll
        for (int b = 0; b < 2; ++b)
#pragma unroll
            for (int m = 0; m < 4; ++m)
#pragma unroll
                for (int n = 0; n < 2; ++n) acc[a][b][m][n] = (f32x4){0.f, 0.f, 0.f, 0.f};
    bf16x8 At[4][2], B0[2][2], B1[2][2];
    if (cur.type == 0) { S.stage_table(cur, 0, lds, wid, lane); PG_WAIT_V(0); PG_BAR; } else S.wait_ready(cur, wid);
    unsigned voC[2][2], voN[2][2];
#pragma unroll
    for (int h = 0; h < 2; ++h)
#pragma unroll
        for (int i = 0; i < 2; ++i) { voC[h][i] = S.voff(cur, 0, lds, h * HALF + sR[i], sC[i]); voN[h][i] = voC[h][i]; }
    const char* cB = cur.B; const char* cA = cur.A; size_t hsC = (size_t)(cur.type == 0 ? HALF : 8) * cur.K * 2; int nt = cur.K / BK;
    if (cur.type == 0) { PG_STAGE(PG_SB(0, 0), cB, vbA); PG_STAGE(PG_SB(0, 1), cB + hsC, vbA); } else { PG_STAGE(PG_SB(0, 0), cB, vbD); PG_STAGE(PG_SB(0, 1), cB + hsC, vbD); }
    PG_STAGE(PG_SA(0, 0), cA, voC[0]); PG_STAGE(PG_SA(0, 1), cA, voC[1]);
    if (wr == 1) PG_BAR;
    PG_WAIT_V(2); PG_BAR;
    if (cur.type == 0) { PG_STAGE(PG_SB(1, 0), cB + kstep, vbA); } else { PG_STAGE(PG_SB(1, 0), cB + kstep, vbD); }
    PG_STAGE(PG_SA(1, 0), cA + kstep, voC[0]);
    if (cur.type == 0) { PG_STAGE(PG_SB(1, 1), cB + hsC + kstep, vbA); } else { PG_STAGE(PG_SB(1, 1), cB + hsC + kstep, vbD); }
    PG_WAIT_V(6); PG_BAR;
    for (;;) {
        const bool has_next = S.next(ui + 1, nxt); nxt.buf = (ui + 1) & 1;
        if (has_next && nxt.type == 0) S.stage_table(nxt, (ui + 1) & 1, lds, wid, lane);
        const char* nB = has_next ? nxt.B : cB; const char* nA = has_next ? nxt.A : cA; const size_t hsN = has_next ? (size_t)(nxt.type == 0 ? HALF : 8) * nxt.K * 2 : hsC;
        for (int t = 0; t < nt; t += 2) {
            const bool last = (t == nt - 2);
            if (last && has_next) {
                if (nxt.type == 1) S.wait_ready(nxt, wid);
#pragma unroll
                for (int h = 0; h < 2; ++h)
#pragma unroll
                    for (int i = 0; i < 2; ++i) voN[h][i] = S.voff(nxt, (ui + 1) & 1, lds, h * HALF + sR[i], sC[i]);
            }
            unsigned vo2[2][2], vb2[2]; const bool b2gu = last ? (has_next ? nxt.type == 0 : cur.type == 0) : (cur.type == 0);
#pragma unroll
            for (int h = 0; h < 2; ++h)
#pragma unroll
                for (int i = 0; i < 2; ++i) vo2[h][i] = last ? voN[h][i] : voC[h][i];
#pragma unroll
            for (int i = 0; i < 2; ++i) vb2[i] = b2gu ? vbA[i] : vbD[i];
            const size_t hs2 = last ? hsN : hsC;
            const char* a1 = cA + (size_t)(t + 1) * kstep;
            const char* a2 = last ? nA : cA + (size_t)(t + 2) * kstep; const char* b2 = last ? nB : cB + (size_t)(t + 2) * kstep;
            const char* a3 = a2 + kstep; const char* b3 = b2 + kstep;
            PG_LDB(B0, 0, 0); PG_LDB(B1, 0, 1); PG_SCHED; PG_LDA(At, 0, 0); PG_STAGE(PG_SA(1, 1), a1, voC[1]);
            PG_WAIT_V(8); PG_WAIT_L(0); PG_BAR; PG_MMA(0, 0, At, B0); PG_MMA(0, 1, At, B1); PG_BAR; PG_SCHED;
            PG_LDA(At, 0, 1); PG_STAGE(PG_SB(0, 0), b2, vb2); PG_STAGE(PG_SB(0, 1), b2 + hs2, vb2); PG_STAGE(PG_SA(0, 0), a2, vo2[0]);
            PG_WAIT_V(8); PG_WAIT_L(0); PG_BAR; PG_MMA(1, 0, At, B0); PG_MMA(1, 1, At, B1); PG_BAR; PG_SCHED;
            PG_LDB(B0, 1, 0); PG_LDB(B1, 1, 1); PG_SCHED; PG_LDA(At, 1, 0); PG_STAGE(PG_SA(0, 1), a2, vo2[1]);
            PG_WAIT_V(8); PG_WAIT_L(0); PG_BAR; PG_MMA(0, 0, At, B0); PG_MMA(0, 1, At, B1); PG_BAR; PG_SCHED;
            PG_LDA(At, 1, 1); PG_STAGE(PG_SB(1, 0), b3, vb2); PG_STAGE(PG_SB(1, 1), b3 + hs2, vb2); PG_STAGE(PG_SA(1, 0), a3, vo2[0]);
            PG_WAIT_V(8); PG_WAIT_L(0); PG_BAR; PG_MMA(1, 0, At, B0); PG_MMA(1, 1, At, B1); PG_BAR; PG_SCHED;
        }
        if (wr == 0) PG_BAR;
        if (cur.type == 0) { EA(acc, cur, wr, wc, fr, fq);
            PG_WAIT_V(0);
            if (lane == 0) __hip_atomic_fetch_add(S.tile_word(cur), 1u, __ATOMIC_RELAXED, __HIP_MEMORY_SCOPE_AGENT); }
        else EB(acc, cur, wr, wc, fr, fq);
        if (!has_next) break;
#pragma unroll
        for (int a = 0; a < 2; ++a)
#pragma unroll
            for (int b = 0; b < 2; ++b)
#pragma unroll
                for (int m = 0; m < 4; ++m)
#pragma unroll
                    for (int n = 0; n < 2; ++n) acc[a][b][m][n] = (f32x4){0.f, 0.f, 0.f, 0.f};
        cur = nxt; cB = nB; cA = nA; hsC = hsN; nt = cur.K / BK; ++ui;
#pragma unroll
        for (int h = 0; h < 2; ++h)
#pragma unroll
            for (int i = 0; i < 2; ++i) voC[h][i] = voN[h][i];
        if (wr == 1) PG_BAR;
    }
    PG_WAIT_V(0);
    PG_BAR;
#undef PG_SA
#undef PG_SB
#undef PG_STAGE
#undef PG_LDA
#undef PG_LDB
#undef PG_MMA
#undef PG_WAIT_V
#undef PG_WAIT_L
#undef PG_BAR
#undef PG_SCHED
}
}
__device__ __forceinline__ void fast_moe_merged(Frame& F, int layer) {
    LAS int* mm = moe_map(F, layer);
    int U = 0;
    for (int e = 0; e < 16; ++e) U += ((mm[e] + 255) >> 8) * 4;
    pg::MoeMergedSched S{(const char*)(F.ws + WS_WGU) + (size_t)layer * 16 * 1024 * 1024 * 2, (const char*)(F.ws + WS_WDN) + (size_t)layer * 16 * 1024 * 512 * 2,
                         (const char*)(F.ws + WS_HB), (const char*)(F.ws + WS_HID), (const int*)(F.ws + WS_SLOTT) + layer * 16 * CAP, (const float*)(F.ws + WS_SLOTW) + layer * 16 * CAP, mm,
                         F.ctl + CW_TILE + layer * 288 * 64, F.ctl + CW_TMO2, F.G, F.wg, U};
    pg::EpiGateUpWT EA{__builtin_amdgcn_make_buffer_rsrc((void*)(F.ws + WS_HID), 0, HROWS * FF * 2, 0x00020000), F.lds, mm};
    pg::EpiDownM EB{(unsigned char*)(F.ws + WS_Y), mm};
    pg::gemm_phase_moe(F.lds, S, EA, EB);
}

constexpr int NPH = 18;
__global__ void __launch_bounds__(NTHR, 2) mega(Args args) {
    extern __shared__ __attribute__((aligned(16))) unsigned char lds[];
    Frame F;
    F.lds = (LAS unsigned char*)lds;
    F.tid = threadIdx.x; F.lane = F.tid & 63; F.wave = __builtin_amdgcn_readfirstlane(F.tid >> 6);
    F.G = gridDim.x; F.wg = blockIdx.x;
    F.out = args.out; F.ws = args.ws; F.ctl = (unsigned*)(args.ws + WS_CTL);
    volatile LAS unsigned* bst = (volatile LAS unsigned*)(F.lds + LDS_BYTES - 16);
    if (F.tid < 4) bst[F.tid] = 0u;
    __syncthreads();
    const int lo = args.ph_lo, hi = args.ph_hi;
    XcdBarrier bar; bar.bar = F.ctl + CW_BAR; bar.x = 0; bar.st = bst;
    if (hi - lo > 1) bar = xcd_barrier_post(F.ctl + CW_BAR, bst);
#define IN(k) (lo <= (k) && (k) < hi)
#define SEAM(k) do { if (IN(k) && IN((k) + 1)) xcd_barrier(bar); } while (0)
    const float* mod = (const float*)(F.ws + WS_MOD);

#ifndef DBL_MASK
#define DBL_MASK 0x0u
#endif
#define RUN(k, body) do { if (IN(k)) { _Pragma("unroll 1") for (int _r = 0; _r < ((((DBL_MASK) >> (k)) & 1u) ? 2 : 1); ++_r) { if (_r) xcd_barrier(bar); F.lane = fresh_lane(); body; } } } while (0)
    RUN(0, phase_prep(F)); SEAM(0);
    RUN(1, phase_norm1_l0(F)); SEAM(1);
    RUN(2, if (FAST_GEMM) fast_inproj(F); else phase_inproj(F)); SEAM(2);
    if (IN(3)) { F.lane = fresh_lane();
#pragma unroll 1
        for (int _r = 0; _r < ((DBL_MASK & 0x100000u) ? 2 : 1); ++_r) { if (FAST_ATTN == 2 && FAST_GEMM) phase_attn_lds(F); else if (FAST_ATTN && FAST_GEMM) phase_attn_mfma(F); else phase_attn_simple(F); }
#pragma unroll 1
        for (int _r = 0; _r < ((DBL_MASK & 0x200000u) ? 2 : 1); ++_r) { if (FAST_FFT) phase_fft1_mfma(F); else phase_fft1_simple(F); }
    } SEAM(3);
    RUN(4, if (FAST_FFT) phase_fft2_mfma(F); else phase_fft2_simple(F)); SEAM(4);
    if (IN(5)) { if (!FAST_FFT) phase_fft3_simple(F); } if (!FAST_FFT) SEAM(5);
    RUN(6, if (FAST_GEMM) fast_outproj(F, WS_MIX, WS_WOUT, F.in[I_X], F.out, mod + 2048, nullptr); else phase_outproj(F, (const bf16*)(F.ws + WS_MIX), (const bf16*)(F.ws + WS_WOUT), F.in[I_X], F.out, mod + 2048, nullptr)); SEAM(6);
    if (IN(7)) { F.lane = fresh_lane(); if (XBF16) phase_norm2_route_mfma(F, 0); else phase_norm2_route(F, 0); } SEAM(7);
    if (MOE_MERGED && FAST_GEMM) { if (IN(8)) { F.lane = fresh_lane(); fast_moe_merged(F, 0); } if (IN(8) && IN(10)) xcd_barrier(bar); }
    else { RUN(8, if (FAST_GEMM) fast_moe_gateup(F, 0); else phase_moe_gateup(F, 0)); SEAM(8);
    RUN(9, if (FAST_GEMM) fast_moe_down(F, 0); else phase_moe_down(F, 0)); SEAM(9); }
    if (IN(10)) { F.lane = fresh_lane(); phase_combine<false>(F, 0); } SEAM(10);
    RUN(11, if (FAST_GEMM) fast_pw1(F); else phase_pw1(F)); SEAM(11);
    RUN(12, phase_dwconv_fast(F)); SEAM(12);
    if (IN(13)) { F.lane = fresh_lane(); if (FAST_GEMM) fast_outproj(F, WS_V1, WS_WPW2, F.out, F.out, mod + 5 * 6144 + 2048, F.in[I_PW2B]); else phase_outproj(F, (const bf16*)(F.ws + WS_V1), (const bf16*)(F.ws + WS_WPW2), F.out, F.out, mod + 5 * 6144 + 2048, F.in[I_PW2B]); } SEAM(13);
    if (IN(14)) { F.lane = fresh_lane(); if (XBF16) phase_norm2_route_mfma(F, 1); else phase_norm2_route(F, 1); } SEAM(14);
    if (MOE_MERGED && FAST_GEMM) { if (IN(15)) { F.lane = fresh_lane(); fast_moe_merged(F, 1); } if (IN(15) && IN(17)) xcd_barrier(bar); }
    else { RUN(15, if (FAST_GEMM) fast_moe_gateup(F, 1); else phase_moe_gateup(F, 1)); SEAM(15);
    RUN(16, if (FAST_GEMM) fast_moe_down(F, 1); else phase_moe_down(F, 1)); SEAM(16); }
    if (IN(17)) { F.lane = fresh_lane(); phase_combine<true>(F, 1); }
#undef RUN
#undef IN
#undef SEAM
}

extern "C" void kernel_launch(void* const* d_in, const int* in_sizes, int n_in, void* d_out, int out_size, void* d_ws, size_t ws_size, hipStream_t stream) {
    static int grid = 0;
    if (grid == 0) {
        if (n_in != 25 || out_size != T * D || ws_size < WS_END) { fprintf(stderr, "kernel_launch: unexpected shapes (n_in %d out %d ws %zu)\n", n_in, out_size, ws_size); grid = -1; return; }
        int dev = 0, cus = 0, per_cu = 0;
        if (hipGetDevice(&dev) != hipSuccess || hipDeviceGetAttribute(&cus, hipDeviceAttributeMultiprocessorCount, dev) != hipSuccess) { grid = -1; return; }
        if (hipFuncSetAttribute((const void*)mega, hipFuncAttributeMaxDynamicSharedMemorySize, LDS_BYTES) != hipSuccess) { fprintf(stderr, "kernel_launch: hipFuncSetAttribute failed\n"); grid = -1; return; }
        if (hipOccupancyMaxActiveBlocksPerMultiprocessor(&per_cu, (const void*)mega, NTHR, LDS_BYTES) != hipSuccess || per_cu < 1) { fprintf(stderr, "kernel_launch: occupancy query says %d\n", per_cu); }
        (void)hipGetLastError();
        grid = cus;
    }
    if (grid < 0) return;
    (void)hipMemsetAsync((char*)d_ws + WS_CTL, 0, CTL_BYTES, stream);
    Args a{};
    for (int i = 0; i < 25; ++i) a.in[i] = (const float*)d_in[i];
    a.out = (float*)d_out; a.ws = (unsigned char*)d_ws;
#if MK_ONE_LAUNCH
    a.ph_lo = 0; a.ph_hi = NPH;
    hipLaunchKernelGGL(mega, dim3(grid), dim3(NTHR), LDS_BYTES, stream, a);
#else
#ifndef PROBE_PHASE
#define PROBE_PHASE -1
#endif
    for (int p = 0; p < NPH; ++p) { a.ph_lo = p; a.ph_hi = p + 1; hipLaunchKernelGGL(mega, dim3(grid), dim3(NTHR), LDS_BYTES, stream, a);
        if (p == PROBE_PHASE) { if (p == 7 || p == 14) (void)hipMemsetAsync((char*)d_ws + WS_CTL, 0, CTL_BYTES, stream);
            hipLaunchKernelGGL(mega, dim3(grid), dim3(NTHR), LDS_BYTES, stream, a); } }
#endif
}
```

```cpp
#include <hip/hip_runtime.h>
#include <cstdio>

#ifndef MK_ONE_LAUNCH
#define MK_ONE_LAUNCH 1
#endif

#define GAS __attribute__((address_space(1)))
#define LAS __attribute__((address_space(3)))
typedef unsigned short bf16;
typedef short bf16x8 __attribute__((ext_vector_type(8)));
typedef float f32x4 __attribute__((ext_vector_type(4)));
typedef float f32x16 __attribute__((ext_vector_type(16)));
typedef unsigned u32x4 __attribute__((ext_vector_type(4)));
typedef unsigned u32x2 __attribute__((ext_vector_type(2)));

constexpr int D = 1024, NB = 4, L = 8192, T = NB * L, CL = 256, TC = NB * CL;
constexpr int NE = 16, FF = 512, CONVW = 31;
constexpr int N_IN = 1280;
constexpr int FN1 = 64, FN2 = 128;
#ifndef FAST_GEMM
#define FAST_GEMM 1
#endif
#ifndef MOE_MERGED
#define MOE_MERGED 1
#endif
#ifndef XBF16
#define XBF16 FAST_GEMM
#endif
#ifndef FAST_ATTN
#define FAST_ATTN 2
#endif
#ifndef FAST_FFT
#define FAST_FFT 1
#endif
constexpr int IL = FAST_GEMM ? 128 : 32;
constexpr float EPS = 1e-6f;
constexpr int NWAVES = 8, NTHR = 512;
constexpr int CAP = 32768;
constexpr int HROWS = 65536 + 4096;

constexpr size_t MiB = 1u << 20;
constexpr size_t WS_CTL = 0, CTL_BYTES = 1 * MiB;
constexpr size_t WS_MOD = 1 * MiB;
constexpr size_t WS_TW = 1 * MiB + 512 * 1024;
constexpr size_t WS_WIN = 2 * MiB, WS_WOUT = 6 * MiB, WS_WPW1 = 10 * MiB, WS_WPW2 = 14 * MiB;
constexpr size_t WS_WGU = 16 * MiB, WS_WDN = 80 * MiB;
constexpr size_t WS_TOKE = 112 * MiB, WS_TOKP = 113 * MiB, WS_TOKW = 114 * MiB;
constexpr size_t WS_SLOTT = 116 * MiB, WS_SLOTW = 120 * MiB;
constexpr size_t WS_HB = 128 * MiB;
constexpr size_t WS_UF = 196 * MiB, WS_Q = 228 * MiB, WS_K = 260 * MiB, WS_V = 268 * MiB, WS_CK = 276 * MiB, WS_CV = 277 * MiB;
constexpr size_t WS_G = 280 * MiB, WS_MIX = 344 * MiB, WS_AB = 408 * MiB;
constexpr size_t WS_XB = 408 * MiB;
constexpr size_t WS_HID = 196 * MiB, WS_Y = 264 * MiB;
constexpr size_t WS_U = 196 * MiB, WS_V1 = 260 * MiB;
constexpr size_t WS_END = 472 * MiB;
constexpr int CW_BAR = 4096;
constexpr int CW_CNT = 8192;
constexpr int CW_TILE = 16384;
constexpr int CW_TMO2 = 2048;

constexpr int LDS_BYTES = 147456;

__device__ __forceinline__ unsigned f2bf(float f) { unsigned u = __float_as_uint(f); return (u + 0x7fffu + ((u >> 16) & 1u)) >> 16; }
__device__ __forceinline__ float bf2f(unsigned b) { return __uint_as_float(b << 16); }
typedef __bf16 b16x2_t __attribute__((ext_vector_type(2)));
__device__ __forceinline__ unsigned pkbf(float a, float b) { typedef float f2 __attribute__((ext_vector_type(2))); f2 v = {a, b}; return __builtin_bit_cast(unsigned, __builtin_convertvector(v, b16x2_t)); }
__device__ __forceinline__ unsigned pk2(float lo, float hi) { return pkbf(lo, hi); }
__device__ __forceinline__ float bflo(unsigned w) { return __uint_as_float(w << 16); }
__device__ __forceinline__ float bfhi(unsigned w) { return __uint_as_float(w & 0xffff0000u); }
__device__ __forceinline__ float wave_sum(float v) {
    v += __builtin_bit_cast(float, __builtin_amdgcn_mov_dpp(__builtin_bit_cast(int, v), 0xB1, 0xf, 0xf, true));
    v += __builtin_bit_cast(float, __builtin_amdgcn_mov_dpp(__builtin_bit_cast(int, v), 0x4E, 0xf, 0xf, true));
    v += __builtin_bit_cast(float, __builtin_amdgcn_mov_dpp(__builtin_bit_cast(int, v), 0x141, 0xf, 0xf, true));
    v += __builtin_bit_cast(float, __builtin_amdgcn_mov_dpp(__builtin_bit_cast(int, v), 0x140, 0xf, 0xf, true));
    const int iv = __builtin_bit_cast(int, v);
    const float a = __builtin_bit_cast(float, __builtin_amdgcn_readlane(iv, 15)), b = __builtin_bit_cast(float, __builtin_amdgcn_readlane(iv, 31));
    const float c = __builtin_bit_cast(float, __builtin_amdgcn_readlane(iv, 47)), d = __builtin_bit_cast(float, __builtin_amdgcn_readlane(iv, 63));
    return (a + b) + (c + d);
}
__device__ __forceinline__ float silu_f(float x) { return x * __builtin_amdgcn_rcpf(1.f + __expf(-x)); }
__device__ __forceinline__ float sigmoid_f(float x) { return __builtin_amdgcn_rcpf(1.f + __expf(-x)); }
constexpr float YSCALE = 32.f;
__device__ __forceinline__ unsigned pk_fp8x4(f32x4 v) {
    int d = __builtin_amdgcn_cvt_pk_fp8_f32(__builtin_amdgcn_fmed3f(v[0] * YSCALE, -448.f, 448.f), __builtin_amdgcn_fmed3f(v[1] * YSCALE, -448.f, 448.f), 0, false);
    d = __builtin_amdgcn_cvt_pk_fp8_f32(__builtin_amdgcn_fmed3f(v[2] * YSCALE, -448.f, 448.f), __builtin_amdgcn_fmed3f(v[3] * YSCALE, -448.f, 448.f), d, true);
    return (unsigned)d;
}
__device__ __forceinline__ f32x4 un_fp8x4(unsigned d) { typedef float f2 __attribute__((ext_vector_type(2)));
    const f2 lo = __builtin_amdgcn_cvt_pk_f32_fp8((int)d, false), hi = __builtin_amdgcn_cvt_pk_f32_fp8((int)d, true); return (f32x4){lo.x, lo.y, hi.x, hi.y}; }
#define LDS_WAIT() asm volatile("s_waitcnt lgkmcnt(0)" ::: "memory")
__device__ __forceinline__ int fresh_lane() { int l; asm volatile("v_mbcnt_lo_u32_b32 %0, -1, 0\n\tv_mbcnt_hi_u32_b32 %0, -1, %0" : "=v"(l)); return l; }

#define XB_TMO      128
#define XB_XCNT(j)  (256  + 64 * (j))
#define XB_XSUB(j)  (1280 + 64 * (j))
#define XB_XGEN(j)  (2304 + 64 * (j))
#define XB_TOP      3328
#define XB_TOPGEN   3392
#define XCD_BAR_WORDS 3456
#define XB_SPIN_CAP (1u << 20)
__device__ __forceinline__ unsigned xb_ld(unsigned* p)              { return __hip_atomic_load(p, __ATOMIC_RELAXED, __HIP_MEMORY_SCOPE_AGENT); }
__device__ __forceinline__ unsigned xb_add(unsigned* p, unsigned v) { return __hip_atomic_fetch_add(p, v, __ATOMIC_RELAXED, __HIP_MEMORY_SCOPE_AGENT); }
__device__ __forceinline__ unsigned xb_xcc_id() { return (unsigned)__builtin_amdgcn_s_getreg((3 << 11) | 20) & 0xFu; }
#define XB_SPIN(cond, bar) do { unsigned _sp = 0; while (cond) { __builtin_amdgcn_s_sleep(1); \
    if ((++_sp & 255u) == 0u) { if (xb_ld(&(bar)[XB_TMO])) break; if (_sp > XB_SPIN_CAP) { atomicAdd(&(bar)[XB_TMO], 1u); break; } } } } while (0)
struct XcdBarrier { unsigned* bar; unsigned x; volatile LAS unsigned* st; };
__device__ __forceinline__ XcdBarrier xcd_barrier_post(unsigned* bar, volatile LAS unsigned* st) {
    XcdBarrier b; b.bar = bar; b.x = xb_xcc_id(); b.st = st;
    if (threadIdx.x == 0) (void)xb_add(&bar[XB_XCNT(b.x)], 1u);
    return b;
}
__device__ __forceinline__ void xcd_barrier_complete(unsigned* bar, unsigned x, unsigned& nloc, unsigned& nx) {
    const unsigned G = gridDim.x * gridDim.y * gridDim.z;
    unsigned sum, cnt, mine, sp = 0u;
    for (;;) {
        sum = 0u; cnt = 0u; mine = 0u;
#pragma unroll
        for (unsigned j = 0; j < 16; ++j) { const unsigned c = xb_ld(&bar[XB_XCNT(j)]); sum += c; cnt += (c > 0u) ? 1u : 0u; mine = (j == x) ? c : mine; }
        if (sum == G) break;
        __builtin_amdgcn_s_sleep(1);
        if ((++sp & 255u) == 0u) { if (xb_ld(&bar[XB_TMO])) break; if (sp > XB_SPIN_CAP) { atomicAdd(&bar[XB_TMO], 1u); break; } }
    }
    nloc = mine > 0u ? mine : 1u; nx = cnt > 0u ? cnt : 1u;
}
__device__ __forceinline__ void xcd_barrier(const XcdBarrier& b) {
    asm volatile("s_waitcnt vmcnt(0)" ::: "memory");
    __syncthreads();
    if (threadIdx.x == 0) {
        unsigned* bar = b.bar;
        __builtin_amdgcn_s_waitcnt(0);
        unsigned nloc = b.st[0], nx = b.st[1];
        if (nloc == 0u) { xcd_barrier_complete(bar, b.x, nloc, nx); b.st[0] = nloc; b.st[1] = nx; }
        const unsigned old = xb_add(&bar[XB_XSUB(b.x)], 1u);
        const unsigned gen = old / nloc;
        if (old + 1u == (gen + 1u) * nloc) {
            __builtin_amdgcn_fence(__ATOMIC_RELEASE, "agent");
            asm volatile("s_waitcnt vmcnt(0)" ::: "memory");
            const unsigned og = xb_add(&bar[XB_TOP], 1u);
            const unsigned tg = og / nx;
            if (og + 1u == (tg + 1u) * nx) xb_add(&bar[XB_TOPGEN], 1u);
            else XB_SPIN(xb_ld(&bar[XB_TOPGEN]) == tg, bar);
            __builtin_amdgcn_fence(__ATOMIC_ACQUIRE, "agent");
            xb_add(&bar[XB_XGEN(b.x)], 1u);
            asm volatile("s_waitcnt vmcnt(0)" ::: "memory");
        } else {
            XB_SPIN(xb_ld(&bar[XB_XGEN(b.x)]) == gen, bar);
            __builtin_amdgcn_fence(__ATOMIC_ACQUIRE, "agent");
            asm volatile("s_waitcnt vmcnt(0)" ::: "memory");
        }
    }
    __syncthreads();
}

struct Args { const float* in[25]; float* out; unsigned char* ws; int ph_lo, ph_hi; };
enum { I_X = 0, I_C, I_CTX, I_CCTX, I_ADAW, I_ADAB, I_NMG, I_NFG, I_WIN, I_WOUT, I_SINK, I_PW1W, I_PW1B, I_DWW, I_DWB, I_LNG, I_LNB,
       I_PW2W, I_PW2B, I_RW, I_RB, I_WG, I_WU, I_WD, I_FNG };

struct InPtrs {
    __device__ __forceinline__ const float* operator[](int i) const { const float* r;
        asm volatile("s_load_dwordx2 %0, %1, %2\n\ts_waitcnt lgkmcnt(0)" : "=s"(r) : "s"(__builtin_amdgcn_kernarg_segment_ptr()), "s"(i * 8)); return r; }
};
struct Frame {
    LAS unsigned char* lds;
    int tid, lane, wave, G, wg;
    InPtrs in;
    float* out;
    unsigned char* ws;
    unsigned* ctl;
};

__device__ __forceinline__ int crow(int i, int h) { return (i & 3) + 8 * (i >> 2) + 4 * h; }
template <class RowPtr, class Epi>
__device__ __forceinline__ void sgemm_tile(const RowPtr& rowptr, const bf16* Bt, int K, int m0, int n0, const Epi& epi, int wave, int lane) {
    const int wm = wave & 3, wn = wave >> 2, r = lane & 31, h = lane >> 5;
    const bf16* ap = rowptr(m0 + wm * 32 + r) + 8 * h;
    const bf16* bp0 = Bt + (size_t)(n0 + wn * 64 + r) * K + 8 * h;
    const bf16* bp1 = bp0 + (size_t)32 * K;
    f32x16 c0, c1;
#pragma unroll
    for (int i = 0; i < 16; ++i) { c0[i] = 0.f; c1[i] = 0.f; }
#pragma unroll 2
    for (int k = 0; k < K; k += 32) {
        const bf16x8 a0 = *(const bf16x8*)(ap + k), a1 = *(const bf16x8*)(ap + k + 16);
        const bf16x8 b00 = *(const bf16x8*)(bp0 + k), b01 = *(const bf16x8*)(bp0 + k + 16);
        const bf16x8 b10 = *(const bf16x8*)(bp1 + k), b11 = *(const bf16x8*)(bp1 + k + 16);
        c0 = __builtin_amdgcn_mfma_f32_32x32x16_bf16(a0, b00, c0, 0, 0, 0);
        c1 = __builtin_amdgcn_mfma_f32_32x32x16_bf16(a0, b10, c1, 0, 0, 0);
        c0 = __builtin_amdgcn_mfma_f32_32x32x16_bf16(a1, b01, c0, 0, 0, 0);
        c1 = __builtin_amdgcn_mfma_f32_32x32x16_bf16(a1, b11, c1, 0, 0, 0);
    }
    epi(m0 + wm * 32, n0 + wn * 64, c0, c1, lane);
}

__device__ __forceinline__ void p0_transpose_item(const float* W, int K, int N, bf16* WT, int k0, int n0, int drow0, LAS float* scr, int lane) {
#pragma unroll 8
    for (int i = 0; i < 32; ++i) { const int kk = 2 * i + (lane >> 5); scr[kk * 33 + (lane & 31)] = W[(size_t)(k0 + kk) * N + n0 + (lane & 31)]; }
    LDS_WAIT(); asm volatile("" ::: "memory");
    const int c = lane & 7;
#pragma unroll
    for (int j = 0; j < 4; ++j) { const int n = (lane >> 3) + 8 * j; const LAS float* s = scr + (8 * c) * 33 + n;
        u32x4 o; o.x = pk2(s[0 * 33], s[1 * 33]); o.y = pk2(s[2 * 33], s[3 * 33]); o.z = pk2(s[4 * 33], s[5 * 33]); o.w = pk2(s[6 * 33], s[7 * 33]);
        *(u32x4*)(WT + (size_t)(drow0 + n) * K + k0 + 8 * c) = o; }
    LDS_WAIT(); asm volatile("" ::: "memory");
}
__device__ __forceinline__ int il_row(int j, int half) { return (j / IL) * (2 * IL) + half * IL + (j % IL); }

constexpr int T_NITEMS = 640 + 512 + 1024 + 512 + 3 * 32 * 256, T_DEFER_ATT = 10 * 2048;
struct TItem { const float* W; bf16* WT; int K, N, k0, n0, drow0; bool ok; };
__device__ __forceinline__ TItem t_decode(const Frame& F, int it) {
    constexpr int S0 = 640, S1 = 512, S2 = 1024, S3 = 512, SM = 32 * 256;
    TItem t; t.ok = it < S0 + S1 + S2 + S3 + 3 * SM; t.W = F.in[I_WIN]; t.WT = (bf16*)(F.ws + WS_WIN); t.K = 1024; t.N = 1280; t.k0 = 0; t.n0 = 0; t.drow0 = 0;
    int r = it;
    if (r < S0) { const int kb = r / 40, nb = r % 40; t.k0 = kb * 64; t.n0 = nb * 32; t.drow0 = nb * 32; return t; } r -= S0;
    if (r < S1) { const int kb = r / 32, nb = r % 32; t.W = F.in[I_WOUT]; t.WT = (bf16*)(F.ws + WS_WOUT); t.N = 1024; t.k0 = kb * 64; t.n0 = nb * 32; t.drow0 = nb * 32; return t; } r -= S1;
    if (r < S2) { const int kb = r / 64, nb = r % 64, n0 = nb * 32; t.W = F.in[I_PW1W]; t.WT = (bf16*)(F.ws + WS_WPW1); t.N = 2048; t.k0 = kb * 64; t.n0 = n0; t.drow0 = il_row(n0 & 1023, n0 >> 10); return t; } r -= S2;
    if (r < S3) { const int kb = r / 32, nb = r % 32; t.W = F.in[I_PW2W]; t.WT = (bf16*)(F.ws + WS_WPW2); t.N = 1024; t.k0 = kb * 64; t.n0 = nb * 32; t.drow0 = nb * 32; return t; } r -= S3;
    if (r < SM) { const int le = r >> 8, q = r & 255, kb = q / 16, nb = q % 16; t.W = F.in[I_WG] + (size_t)le * 1024 * 512; t.WT = (bf16*)(F.ws + WS_WGU) + (size_t)le * 1024 * 1024; t.N = 512; t.k0 = kb * 64; t.n0 = nb * 32; t.drow0 = il_row(nb * 32, 0); return t; } r -= SM;
    if (r < SM) { const int le = r >> 8, q = r & 255, kb = q / 16, nb = q % 16; t.W = F.in[I_WU] + (size_t)le * 1024 * 512; t.WT = (bf16*)(F.ws + WS_WGU) + (size_t)le * 1024 * 1024; t.N = 512; t.k0 = kb * 64; t.n0 = nb * 32; t.drow0 = il_row(nb * 32, 1); return t; } r -= SM;
    { const int le = (r >> 8) & 31, q = r & 255, kb = q / 32, nb = q % 32; t.W = F.in[I_WD] + (size_t)le * 512 * 1024; t.WT = (bf16*)(F.ws + WS_WDN) + (size_t)le * 1024 * 512; t.K = 512; t.N = 1024; t.k0 = kb * 64; t.n0 = nb * 32; t.drow0 = nb * 32; }
    return t;
}
__device__ __forceinline__ void t_load(const TItem& t, int lane, float (&v)[32]) {
    if (t.ok) {
#pragma unroll
        for (int i = 0; i < 32; ++i) v[i] = t.W[(size_t)(t.k0 + 2 * i + (lane >> 5)) * t.N + t.n0 + (lane & 31)];
    }
}
__device__ __forceinline__ void t_store(const TItem& t, LAS float* scr, int lane, const float (&v)[32]) {
#pragma unroll
    for (int i = 0; i < 32; ++i) scr[(2 * i + (lane >> 5)) * 33 + (lane & 31)] = v[i];
    LDS_WAIT(); asm volatile("" ::: "memory");
    const int c = lane & 7;
#pragma unroll
    for (int j = 0; j < 4; ++j) { const int n = (lane >> 3) + 8 * j; const LAS float* s = scr + (8 * c) * 33 + n;
        u32x4 o; o.x = pk2(s[0 * 33], s[1 * 33]); o.y = pk2(s[2 * 33], s[3 * 33]); o.z = pk2(s[4 * 33], s[5 * 33]); o.w = pk2(s[6 * 33], s[7 * 33]);
        *(u32x4*)(t.WT + (size_t)(t.drow0 + n) * t.K + t.k0 + 8 * c) = o; }
    LDS_WAIT(); asm volatile("" ::: "memory");
}
__device__ __forceinline__ void t_dma(const TItem& t, LAS unsigned char* scr, int lane) {
    if (t.ok) {
#pragma unroll
        for (int i = 0; i < 8; ++i)
            __builtin_amdgcn_global_load_lds((const unsigned*)(t.W + (size_t)(t.k0 + 8 * i + (lane >> 3)) * t.N + t.n0 + 4 * (lane & 7)), (LAS unsigned*)(scr + 1056 * i), 16, 0, 0);
    }
}
__device__ __forceinline__ void t_store_dma(const TItem& t, const LAS float* scr, int lane) {
    const int c = lane & 7;
#pragma unroll 1
    for (int j = 0; j < 4; ++j) { const int n = (lane >> 3) + 8 * j; float e[8];
#pragma unroll
        for (int q = 0; q < 8; ++q) e[q] = scr[264 * c + 32 * q + n];
        { u32x4 o; o.x = pk2(e[0], e[1]); o.y = pk2(e[2], e[3]); o.z = pk2(e[4], e[5]); o.w = pk2(e[6], e[7]); *(u32x4*)(t.WT + (size_t)(t.drow0 + n) * t.K + t.k0 + 8 * c) = o; } }
    LDS_WAIT(); asm volatile("" ::: "memory");
}
__device__ __forceinline__ void t_items_tail(Frame& F, int r, int nw) {
    LAS float* scr = (LAS float*)(F.lds + F.wave * 8704);
    TItem cur = t_decode(F, 640 + T_DEFER_ATT + r); float va[32], vb[32];
    t_load(cur, F.lane, va);
#pragma unroll 1
    for (int it = r; cur.ok; it += nw) {
        const TItem nxt = t_decode(F, 640 + T_DEFER_ATT + it + nw);
        t_load(nxt, F.lane, vb);
        t_store(cur, scr, F.lane, va);
#pragma unroll
        for (int i = 0; i < 32; ++i) va[i] = vb[i];
        cur = nxt;
    }
}
__device__ __forceinline__ void phase_prep(Frame& F) {
    {
        LAS float* sc = (LAS float*)F.lds;
        LAS float* red = sc + 5 * 1024;
        bool loaded = false;
        for (int it = F.wg; it < 192; it += F.G) {
            if (!loaded) {
                for (int i = F.tid; i < 5 * 1024; i += NTHR) { const int b = i >> 10, k = i & 1023; const float v = b < 4 ? F.in[I_C][b * 1024 + k] : F.in[I_CCTX][k]; sc[i] = silu_f(v); }
                __syncthreads(); loaded = true;
            }
            const int l = it / 96, n0 = (it % 96) * 64, c4 = F.tid & 15, kg = F.tid >> 4;
            const float* w = F.in[I_ADAW] + (size_t)l * 1024 * 6144 + n0 + 4 * c4;
            f32x4 a[5];
#pragma unroll
            for (int b = 0; b < 5; ++b) a[b] = (f32x4){0.f, 0.f, 0.f, 0.f};
#pragma unroll 16
            for (int kk = 0; kk < 32; ++kk) { const int k = kg * 32 + kk; const f32x4 wv = *(const f32x4*)(w + (size_t)k * 6144);
#pragma unroll
                for (int b = 0; b < 5; ++b) a[b] += sc[b * 1024 + k] * wv; }
#pragma unroll
            for (int b = 0; b < 5; ++b) *(LAS f32x4*)(red + (kg * 5 + b) * 64 + 4 * c4) = a[b];
            __syncthreads();
            if (F.tid < 320) { const int b = F.tid >> 6, c2 = F.tid & 63; float sm = 0.f;
#pragma unroll
                for (int g = 0; g < 32; ++g) sm += red[(g * 5 + b) * 64 + c2];
                ((float*)(F.ws + WS_MOD))[((size_t)l * 5 + b) * 6144 + n0 + c2] = sm + F.in[I_ADAB][l * 6144 + n0 + c2]; }
            __syncthreads();
        }
        __syncthreads();
    }
    { u32x4* z = (u32x4*)(F.ws + WS_SLOTT); const u32x4 zero = {0u, 0u, 0u, 0u};
      for (int i = F.wg * NTHR + F.tid; i < 2 * 16 * CAP / 4; i += F.G * NTHR) z[i] = zero; }
    { float* tw = (float*)(F.ws + WS_TW);
      for (int k = F.wg * NTHR + F.tid; k < 8192; k += F.G * NTHR) { const float a = (float)k * (6.283185307179586f / 8192.f); tw[2 * k] = __cosf(a); tw[2 * k + 1] = __sinf(a); } }
    {
        LAS float* scr = (LAS float*)(F.lds + F.wave * 8704);
        const int gw = F.wg * NWAVES + F.wave, NGW = F.G * NWAVES;
        auto vmap = [](int v) { return v < 640 ? v : (1 << 30); };
        TItem cur = t_decode(F, vmap(gw)); float va[32], vb[32];
        t_load(cur, F.lane, va);
#pragma unroll 1
        for (int it = gw; cur.ok; it += NGW) {
            const TItem nxt = t_decode(F, vmap(it + NGW));
            t_load(nxt, F.lane, vb);
            t_store(cur, scr, F.lane, va);
#pragma unroll
            for (int i = 0; i < 32; ++i) va[i] = vb[i];
            cur = nxt;
        }
    }
}

#define ROFF(lane, j) (512 * ((j) >> 1) + 8 * (lane) + 4 * ((j) & 1))
__device__ __forceinline__ void row_load(const float* p, int lane, f32x4 (&v)[4]) {
#pragma unroll
    for (int j = 0; j < 4; ++j) v[j] = *(const f32x4*)(p + ROFF(lane, j));
}
__device__ __forceinline__ void row_load_bf(const bf16* p, int lane, f32x4 (&v)[4]) {
#pragma unroll
    for (int jj = 0; jj < 2; ++jj) { const u32x4 w = *(const u32x4*)(p + 512 * jj + 8 * lane); v[2 * jj] = (f32x4){bflo(w.x), bfhi(w.x), bflo(w.y), bfhi(w.y)}; v[2 * jj + 1] = (f32x4){bflo(w.z), bfhi(w.z), bflo(w.w), bfhi(w.w)}; }
}
__device__ __forceinline__ void xrow_load(const float* xf, const bf16* xb, size_t row, int lane, f32x4 (&v)[4]) { if (XBF16) row_load_bf(xb + row * D, lane, v); else row_load(xf + row * D, lane, v); }
__device__ __forceinline__ float row_sumsq(const f32x4 (&v)[4]) {
    float s = 0.f;
#pragma unroll
    for (int j = 0; j < 4; ++j) s += (v[j].x * v[j].x + v[j].y * v[j].y) + (v[j].z * v[j].z + v[j].w * v[j].w);
    return wave_sum(s);
}
__device__ __forceinline__ void row_modulate(f32x4 (&v)[4], float rstd, const float* g, const float* sh, const float* sc, int lane) {
#pragma unroll
    for (int j = 0; j < 4; ++j) { const int o = ROFF(lane, j); const f32x4 gg = *(const f32x4*)(g + o), s1 = *(const f32x4*)(sc + o), s0 = *(const f32x4*)(sh + o);
        v[j] = v[j] * rstd * gg * (1.f + s1) + s0; }
}
__device__ __forceinline__ void row_store_bf16(bf16* dst, const f32x4 (&v)[4], int lane) {
#pragma unroll
    for (int jj = 0; jj < 2; ++jj) { u32x4 w; w.x = pk2(v[2 * jj].x, v[2 * jj].y); w.y = pk2(v[2 * jj].z, v[2 * jj].w); w.z = pk2(v[2 * jj + 1].x, v[2 * jj + 1].y); w.w = pk2(v[2 * jj + 1].z, v[2 * jj + 1].w); *(u32x4*)(dst + 512 * jj + 8 * lane) = w; }
}

__device__ __forceinline__ void phase_norm1_l0(Frame& F) {
    const int gw = F.wg * NWAVES + F.wave, NGW = F.G * NWAVES;
    const float* mod = (const float*)(F.ws + WS_MOD);
    bf16* HB = (bf16*)(F.ws + WS_HB);
    for (int row = gw; row < T + TC; row += NGW) {
        const float* src = row < T ? F.in[I_X] + (size_t)row * D : F.in[I_CTX] + (size_t)(row - T) * D;
        const int b = row < T ? (row >> 13) : 4;
        f32x4 v[4]; row_load(src, F.lane, v);
        const float rstd = rsqrtf(row_sumsq(v) * (1.f / D) + EPS);
        const float* m = mod + (size_t)b * 6144;
        row_modulate(v, rstd, F.in[I_NMG], m, m + 1024, F.lane);
        row_store_bf16(HB + (size_t)row * D, v, F.lane);
    }
}

struct RowLin { const bf16* base; size_t pitch; __device__ __forceinline__ const bf16* operator()(int m) const { return base + (size_t)m * pitch; } };

__device__ __forceinline__ void inproj_block(Frame& F, int mb, int nbk, const f32x16& c, int lane) {
    const int h = lane >> 5, cl = lane & 31;
    bf16* dst; int pitch, cbase; bool rope = false; bool isctx = (mb >= T);
    if (nbk < 512) { dst = (bf16*)(F.ws + WS_UF); pitch = 512; cbase = 0; }
    else if (nbk < 1024) { dst = (bf16*)(F.ws + WS_Q); pitch = 512; cbase = 512; rope = true; }
    else if (nbk < 1152) { dst = isctx ? (bf16*)(F.ws + WS_CK) : (bf16*)(F.ws + WS_K); pitch = 128; cbase = 1024; rope = !isctx; }
    else { dst = isctx ? (bf16*)(F.ws + WS_CV) : (bf16*)(F.ws + WS_V); pitch = 128; cbase = 1152; }
    const int rbase = isctx ? mb - T : mb;
    const int col = nbk - cbase + cl;
    const float inv = exp2f(-(float)(cl & 15) * (13.287712379549449f / 16.f));
    const bool second = (cl & 16) != 0; const bool bycol = ((nbk >> 5) & 1) != 0;
#pragma unroll
    for (int i = 0; i < 16; ++i) {
        const int rr = crow(i, h); float v = c[i];
        if (rope) {
            const float partner = __shfl_xor(v, 16);
            const int l = (mb + rr) & (L - 1);
            const float pos = (float)(bycol ? (l & 63) : (l >> 6));
            const float ang = pos * inv, cs = __cosf(ang), sn = __sinf(ang);
            v = second ? (partner * sn + v * cs) : (v * cs - partner * sn);
        }
        dst[(size_t)(rbase + rr) * pitch + col] = (bf16)f2bf(v);
    }
}
__device__ __forceinline__ void phase_inproj(Frame& F) {
    const bf16* HB = (const bf16*)(F.ws + WS_HB); const bf16* Wt = (const bf16*)(F.ws + WS_WIN);
    constexpr int MT = (T + TC) / 128, NT = N_IN / 128;
    RowLin rp{HB, (size_t)D};
    for (int u = F.wg; u < MT * NT; u += F.G) {
        const int mt = u / NT, nt = u % NT;
        if (mt >= T / 128 && nt < 8) continue;
        auto epi = [&](int mb, int nb, const f32x16& c0, const f32x16& c1, int lane) { inproj_block(F, mb, nb, c0, lane); inproj_block(F, mb, nb + 32, c1, lane); };
        sgemm_tile(rp, Wt, D, mt * 128, nt * 128, epi, F.wave, F.lane);
    }
}

__device__ __forceinline__ void attn_key(const bf16* kp, const bf16* vp, const float (&q)[64], float& m, float& s, float (&o)[64]) {
    float dot = 0.f;
#pragma unroll
    for (int j = 0; j < 8; ++j) { const u32x4 w = *(const u32x4*)(kp + 8 * j);
        dot += q[8 * j + 0] * bflo(w.x) + q[8 * j + 1] * bfhi(w.x) + q[8 * j + 2] * bflo(w.y) + q[8 * j + 3] * bfhi(w.y)
             + q[8 * j + 4] * bflo(w.z) + q[8 * j + 5] * bfhi(w.z) + q[8 * j + 6] * bflo(w.w) + q[8 * j + 7] * bfhi(w.w); }
    const float mn = fmaxf(m, dot), alpha = __expf(m - mn), p = __expf(dot - mn);
    s = s * alpha + p; m = mn;
#pragma unroll
    for (int j = 0; j < 8; ++j) { const u32x4 w = *(const u32x4*)(vp + 8 * j);
        o[8 * j + 0] = o[8 * j + 0] * alpha + p * bflo(w.x); o[8 * j + 1] = o[8 * j + 1] * alpha + p * bfhi(w.x);
        o[8 * j + 2] = o[8 * j + 2] * alpha + p * bflo(w.y); o[8 * j + 3] = o[8 * j + 3] * alpha + p * bfhi(w.y);
        o[8 * j + 4] = o[8 * j + 4] * alpha + p * bflo(w.z); o[8 * j + 5] = o[8 * j + 5] * alpha + p * bfhi(w.z);
        o[8 * j + 6] = o[8 * j + 6] * alpha + p * bflo(w.w); o[8 * j + 7] = o[8 * j + 7] * alpha + p * bfhi(w.w); }
}
__device__ __forceinline__ void phase_attn_simple(Frame& F) {
    const bf16* Q = (const bf16*)(F.ws + WS_Q); const bf16* Kb = (const bf16*)(F.ws + WS_K); const bf16* Vb = (const bf16*)(F.ws + WS_V);
    const bf16* CK = (const bf16*)(F.ws + WS_CK); const bf16* CV = (const bf16*)(F.ws + WS_CV); bf16* MIX = (bf16*)(F.ws + WS_MIX);
    for (int idx = F.wg * NTHR + F.tid; idx < T * 8; idx += F.G * NTHR) {
        const int hd = idx / T, t = idx % T, b = t >> 13, l = t & (L - 1), kvh = hd >> 2;
        float q[64], o[64];
#pragma unroll
        for (int j = 0; j < 8; ++j) { const u32x4 w = *(const u32x4*)(Q + (size_t)t * 512 + hd * 64 + 8 * j);
            q[8 * j + 0] = bflo(w.x) * 0.125f; q[8 * j + 1] = bfhi(w.x) * 0.125f; q[8 * j + 2] = bflo(w.y) * 0.125f; q[8 * j + 3] = bfhi(w.y) * 0.125f;
            q[8 * j + 4] = bflo(w.z) * 0.125f; q[8 * j + 5] = bfhi(w.z) * 0.125f; q[8 * j + 6] = bflo(w.w) * 0.125f; q[8 * j + 7] = bfhi(w.w) * 0.125f; }
#pragma unroll
        for (int j = 0; j < 64; ++j) o[j] = 0.f;
        float m = F.in[I_SINK][hd], s = 1.f;
        for (int c = 0; c < CL; ++c) { const size_t r = (size_t)(b * CL + c) * 128 + kvh * 64; attn_key(CK + r, CV + r, q, m, s, o); }
        const int lo = l - 128 < 0 ? 0 : l - 128, hi = l + 128 > L - 1 ? L - 1 : l + 128;
        for (int kp = lo; kp <= hi; ++kp) { const size_t r = (size_t)(b * L + kp) * 128 + kvh * 64; attn_key(Kb + r, Vb + r, q, m, s, o); }
        const float is = 1.f / s;
#pragma unroll
        for (int j = 0; j < 8; ++j) { u32x4 w; w.x = pk2(o[8 * j] * is, o[8 * j + 1] * is); w.y = pk2(o[8 * j + 2] * is, o[8 * j + 3] * is); w.z = pk2(o[8 * j + 4] * is, o[8 * j + 5] * is); w.w = pk2(o[8 * j + 6] * is, o[8 * j + 7] * is);
            *(u32x4*)(MIX + (size_t)t * 1024 + 512 + hd * 64 + 8 * j) = w; }
    }
}

__device__ __forceinline__ void phase_fft1_simple(Frame& F) {
    const bf16* UF = (const bf16*)(F.ws + WS_UF); bf16* Gb = (bf16*)(F.ws + WS_G); const float* tw = (const float*)(F.ws + WS_TW);
    for (int idx = F.wg * NTHR + F.tid; idx < NB * FN1 * FN2 * 512; idx += F.G * NTHR) {
        const int ch = idx & 511, bp = (idx >> 9) & 127, c = (idx >> 16) & 63, b = idx >> 22;
        float re = 0.f, im = 0.f;
        for (int a = 0; a < FN1; ++a) { const float u = bf2f(UF[(size_t)(b * L + 128 * a + bp) * 512 + ch]); const int k = ((a * c) & 63) * 128;
            re += u * tw[2 * k]; im -= u * tw[2 * k + 1]; }
        const int k2 = bp * c; const float cs = tw[2 * k2], sn = tw[2 * k2 + 1];
        const float gr = re * cs + im * sn, gi = im * cs - re * sn;
        const size_t row = (size_t)(b * FN1 + c) * FN2 + bp;
        Gb[row * 1024 + ch] = (bf16)f2bf(gr); Gb[row * 1024 + 512 + ch] = (bf16)f2bf(gi);
    }
}
__device__ __forceinline__ void phase_fft2_simple(Frame& F) {
    const bf16* Gb = (const bf16*)(F.ws + WS_G); bf16* AB = (bf16*)(F.ws + WS_AB); const float* tw = (const float*)(F.ws + WS_TW);
    for (int idx = F.wg * NTHR + F.tid; idx < NB * FN1 * FN2 * 512; idx += F.G * NTHR) {
        const int ch = idx & 511, d = (idx >> 9) & 127, c = (idx >> 16) & 63, b = idx >> 22;
        float fr = 0.f, fi = 0.f;
        for (int bp = 0; bp < FN2; ++bp) { const size_t row = (size_t)(b * FN1 + c) * FN2 + bp; const float gr = bf2f(Gb[row * 1024 + ch]), gi = bf2f(Gb[row * 1024 + 512 + ch]);
            const int k = ((bp * d) & 127) * 64; const float cs = tw[2 * k], sn = tw[2 * k + 1];
            fr += gr * cs + gi * sn; fi += gi * cs - gr * sn; }
        const size_t t = (size_t)b * L + c + 64 * d;
        AB[t * 1024 + ch] = (bf16)f2bf(fr); AB[t * 1024 + 512 + ch] = (bf16)f2bf(-fi);
    }
}
__device__ __forceinline__ void phase_fft3_simple(Frame& F) {
    const bf16* AB = (const bf16*)(F.ws + WS_AB); bf16* MIX = (bf16*)(F.ws + WS_MIX); const float* tw = (const float*)(F.ws + WS_TW);
    LAS float* t128 = (LAS float*)F.lds;
    for (int i = F.tid; i < 128; i += NTHR) { t128[2 * i] = tw[2 * (i * 64)]; t128[2 * i + 1] = tw[2 * (i * 64) + 1]; }
    __syncthreads();
    for (int idx = F.wg * NTHR + F.tid; idx < T * 512; idx += F.G * NTHR) {
        const int cp = idx & 127, g = (idx >> 7) & 3, t = idx >> 9;
        const bf16* arow = AB + (size_t)t * 1024 + g * 128;
        float y = 0.f;
        for (int cc = 0; cc < 128; ++cc) { const int k = (cc * cp) & 127; y += bf2f(arow[cc]) * t128[2 * k] - bf2f(arow[512 + cc]) * t128[2 * k + 1]; }
        MIX[(size_t)t * 1024 + g * 128 + cp] = (bf16)f2bf(y * (1.f / 1024.f));
    }
    __syncthreads();
}

__device__ __forceinline__ void phase_outproj(Frame& F, const bf16* A, const bf16* Wt, const float* base, float* X, const float* gate  , const float* bias) {
    RowLin rp{A, (size_t)D};
    for (int u = F.wg; u < (T / 128) * 8; u += F.G) {
        const int mt = u / 8, nt = u % 8;
        auto epi = [&](int mb, int nb, const f32x16& c0, const f32x16& c1, int lane) {
            const int h = lane >> 5, cl = lane & 31, b = mb >> 13;
#pragma unroll
            for (int half = 0; half < 2; ++half) { const int col = nb + 32 * half + cl; const float gv = gate[(size_t)b * 6144 + col], bv = bias ? bias[col] : 0.f;
#pragma unroll
                for (int i = 0; i < 16; ++i) { const size_t o = (size_t)(mb + crow(i, h)) * D + col; const float a = half ? c1[i] : c0[i]; X[o] = base[o] + gv * (a + bv); } }
        };
        sgemm_tile(rp, Wt, D, mt * 128, nt * 128, epi, F.wave, F.lane);
    }
}

__device__ __forceinline__ void route_select(const float (&lg)[16], const float* rb, int& be1, int& be2, float& w1, float& w2) {
    float best = -1e30f; float bs1 = 0.f, bs2 = 0.f; be1 = 0; be2 = 0;
#pragma unroll
    for (int g = 0; g < 4; ++g) {
        float v1 = -1e30f, v2 = -1e30f, s1 = 0.f, s2 = 0.f; int j1 = 0, j2 = 0;
#pragma unroll
        for (int q = 0; q < 4; ++q) { const float sc = sigmoid_f(lg[4 * g + q]), x = sc + rb[4 * g + q];
            if (x > v1) { v2 = v1; j2 = j1; s2 = s1; v1 = x; j1 = q; s1 = sc; } else if (x > v2) { v2 = x; j2 = q; s2 = sc; } }
        const float gs = v1 + v2;
        if (gs > best) { best = gs; be1 = 4 * g + j1; be2 = 4 * g + j2; bs1 = s1; bs2 = s2; }
    }
    const float inv = 1.f / (bs1 + bs2); w1 = bs1 * inv; w2 = bs2 * inv;
}
__device__ __forceinline__ void phase_norm2_route(Frame& F, int layer) {
    const float* mod = (const float*)(F.ws + WS_MOD) + (size_t)layer * 5 * 6144;
    const float* X = F.out; const bf16* XB = (const bf16*)(F.ws + WS_XB); bf16* HB = (bf16*)(F.ws + WS_HB);
    const float* rw = F.in[I_RW]; const float* rb = F.in[I_RB];
    int* tok_e = (int*)(F.ws + WS_TOKE); int* tok_p = (int*)(F.ws + WS_TOKP); float* tok_w = (float*)(F.ws + WS_TOKW);
    int* slot_t = (int*)(F.ws + WS_SLOTT) + layer * 16 * CAP;
    float* slot_w = (float*)(F.ws + WS_SLOTW) + layer * 16 * CAP;
    unsigned* cnt = F.ctl + CW_CNT + layer * 16 * 64;
    LAS float* rwt = (LAS float*)F.lds;
    LAS int* sel_e = (LAS int*)(F.lds + 65536);
    LAS float* sel_w = (LAS float*)(F.lds + 65536 + 1024);
    LAS int* wcnt = (LAS int*)(F.lds + 65536 + 2048);
    LAS int* ebase = wcnt + 64;
    __syncthreads();
    for (int t = F.tid; t < 4096; t += NTHR) { const int i = t >> 2, e4 = t & 3; const f32x4 w = *(const f32x4*)(rw + (size_t)i * 16 + 4 * e4);
        const int p = (i & 512) + 256 * ((i >> 2) & 1) + 4 * ((i >> 3) & 63) + (i & 3);
        rwt[(4 * e4 + 0) * 1024 + p] = w.x; rwt[(4 * e4 + 1) * 1024 + p] = w.y; rwt[(4 * e4 + 2) * 1024 + p] = w.z; rwt[(4 * e4 + 3) * 1024 + p] = w.w; }
    __syncthreads();
    for (int rb0 = F.wg; rb0 < T / 128; rb0 += F.G) {
        const int b = (rb0 * 128) >> 13;
        f32x4 gm[4], sh[4];
        { const float* m = mod + (size_t)b * 6144; const float* g = F.in[I_NFG] + layer * D;
#pragma unroll
          for (int jj = 0; jj < 4; ++jj) { const int o = ROFF(F.lane, jj); gm[jj] = *(const f32x4*)(g + o) * (1.f + *(const f32x4*)(m + 4096 + o)); sh[jj] = *(const f32x4*)(m + 3072 + o); } }
        const int rbase = rb0 * 128 + F.wave * 16;
        f32x4 v0[4], v1[4]; xrow_load(X, XB, (size_t)rbase, F.lane, v0); xrow_load(X, XB, (size_t)(rbase + 1), F.lane, v1);
#pragma unroll 1
        for (int j = 0; j < 16; j += 2) {
            const int lr = F.wave * 16 + j, row = rbase + j;
            f32x4 n0[4], n1[4];
            { const int nr = (j + 2 < 16) ? row + 2 : row; xrow_load(X, XB, (size_t)nr, F.lane, n0); xrow_load(X, XB, (size_t)(nr + 1), F.lane, n1); }
            const float rstd0 = rsqrtf(row_sumsq(v0) * (1.f / D) + EPS), rstd1 = rsqrtf(row_sumsq(v1) * (1.f / D) + EPS);
#pragma unroll
            for (int jj = 0; jj < 4; ++jj) { v0[jj] = v0[jj] * rstd0 * gm[jj] + sh[jj]; v1[jj] = v1[jj] * rstd1 * gm[jj] + sh[jj]; }
            row_store_bf16(HB + (size_t)row * D, v0, F.lane); row_store_bf16(HB + (size_t)(row + 1) * D, v1, F.lane);
            float lg0[16], lg1[16];
#pragma unroll
            for (int e = 0; e < 16; ++e) { float a0 = 0.f, a1 = 0.f;
#pragma unroll
                for (int jj = 0; jj < 4; ++jj) { const f32x4 w4 = *(const LAS f32x4*)(rwt + e * 1024 + 256 * jj + 4 * F.lane);
                    a0 += (v0[jj].x * w4.x + v0[jj].y * w4.y) + (v0[jj].z * w4.z + v0[jj].w * w4.w); a1 += (v1[jj].x * w4.x + v1[jj].y * w4.y) + (v1[jj].z * w4.z + v1[jj].w * w4.w); }
                lg0[e] = a0; lg1[e] = a1; }
#pragma unroll
            for (int e = 0; e < 16; ++e) { lg0[e] = wave_sum(lg0[e]); lg1[e] = wave_sum(lg1[e]); }
            int e1, e2; float w1, w2;
            route_select(lg0, rb, e1, e2, w1, w2);
            if (F.lane == 0) { sel_e[2 * lr] = e1; sel_e[2 * lr + 1] = e2; sel_w[2 * lr] = w1; sel_w[2 * lr + 1] = w2; }
            route_select(lg1, rb, e1, e2, w1, w2);
            if (F.lane == 0) { sel_e[2 * lr + 2] = e1; sel_e[2 * lr + 3] = e2; sel_w[2 * lr + 2] = w1; sel_w[2 * lr + 3] = w2; }
#pragma unroll
            for (int jj = 0; jj < 4; ++jj) { v0[jj] = n0[jj]; v1[jj] = n1[jj]; }
        }
        __syncthreads();
        int my_e = 0, my_rank = 0; float my_w = 0.f;
        if (F.tid < 256) { my_e = sel_e[F.tid]; my_w = sel_w[F.tid];
            const unsigned long long below = (1ull << F.lane) - 1ull;
#pragma unroll 1
            for (int ee = 0; ee < 16; ++ee) { const unsigned long long mk = __ballot(my_e == ee);
                if (my_e == ee) my_rank = __popcll(mk & below);
                if (F.lane == 0) wcnt[F.wave * 16 + ee] = __popcll(mk); } }
        __syncthreads();
        if (F.tid < 16) { const int n = wcnt[F.tid] + wcnt[16 + F.tid] + wcnt[32 + F.tid] + wcnt[48 + F.tid];
            ebase[F.tid] = n ? (int)atomicAdd(cnt + F.tid * 64, (unsigned)n) : 0; }
        __syncthreads();
        if (F.tid < 256) { int pos = ebase[my_e] + my_rank;
            for (int w = 0; w < F.wave; ++w) pos += wcnt[w * 16 + my_e];
            const int tok = rb0 * 128 + (F.tid >> 1), k = F.tid & 1;
            slot_t[my_e * CAP + pos] = tok; slot_w[my_e * CAP + pos] = my_w; tok_e[2 * tok + k] = my_e; tok_p[2 * tok + k] = pos; tok_w[2 * tok + k] = my_w; }
        __syncthreads();
    }
}


__device__ __forceinline__ void phase_norm2_route_mfma(Frame& F, int layer) {
    constexpr int AP = 1032;
    const float* mod = (const float*)(F.ws + WS_MOD) + (size_t)layer * 5 * 6144;
    const bf16* XB = (const bf16*)(F.ws + WS_XB); bf16* HB = (bf16*)(F.ws + WS_HB);
    const float* rw = F.in[I_RW]; const float* rb = F.in[I_RB]; const float* gsrc = F.in[I_NFG] + layer * D;
    int* tok_e = (int*)(F.ws + WS_TOKE); int* tok_p = (int*)(F.ws + WS_TOKP); float* tok_w = (float*)(F.ws + WS_TOKW);
    int* slot_t = (int*)(F.ws + WS_SLOTT) + layer * 16 * CAP;
    float* slot_w = (float*)(F.ws + WS_SLOTW) + layer * 16 * CAP;
    unsigned* cnt = F.ctl + CW_CNT + layer * 16 * 64;
    LAS bf16* AH = (LAS bf16*)F.lds; LAS bf16* AL = AH + 16 * AP;
    LAS float* cbv = (LAS float*)(F.lds + 2 * 16 * AP * 2);
    LAS float* rstdv = cbv + 16;
    LAS float* lgt = rstdv + 128;
    LAS int* sel_e = (LAS int*)(lgt + 128 * 16);
    LAS float* sel_w = (LAS float*)(sel_e + 256);
    LAS int* wcnt = (LAS int*)(sel_w + 256);
    LAS int* ebase = wcnt + 64;
    LAS float* cpart = (LAS float*)(ebase + 16);
    for (int rb0 = F.wg; rb0 < T / 128; rb0 += F.G) {
        const int b = (rb0 * 128) >> 13; const float* m = mod + (size_t)b * 6144;
        __syncthreads();
        { float cp[16];
#pragma unroll
          for (int e = 0; e < 16; ++e) cp[e] = 0.f;
          for (int k = F.tid; k < D; k += NTHR) { const float gmk = gsrc[k] * (1.f + m[4096 + k]), shk = m[3072 + k];
#pragma unroll
              for (int e4 = 0; e4 < 4; ++e4) { const f32x4 w4 = *(const f32x4*)(rw + (size_t)k * 16 + 4 * e4);
#pragma unroll
                  for (int q = 0; q < 4; ++q) { const int e = 4 * e4 + q; const float pr = gmk * w4[q]; const unsigned hi = f2bf(pr); const unsigned lo = f2bf(pr - bf2f(hi));
                      AH[e * AP + k] = (bf16)hi; AL[e * AP + k] = (bf16)lo; cp[e] += shk * w4[q]; } } }
#pragma unroll
          for (int e = 0; e < 16; ++e) { const float t = wave_sum(cp[e]); if (F.lane == 0) cpart[F.wave * 16 + e] = t; } }
        __syncthreads();
        if (F.tid < 16) { float t = 0.f;
#pragma unroll
            for (int w = 0; w < 8; ++w) t += cpart[w * 16 + F.tid];
            cbv[F.tid] = t; }
        f32x4 gm[4], sh[4];
#pragma unroll
        for (int jj = 0; jj < 4; ++jj) { const int o = ROFF(F.lane, jj); gm[jj] = *(const f32x4*)(gsrc + o) * (1.f + *(const f32x4*)(m + 4096 + o)); sh[jj] = *(const f32x4*)(m + 3072 + o); }
        const int rbase = rb0 * 128 + F.wave * 16;
        f32x4 v0[4], v1[4]; row_load_bf(XB + (size_t)rbase * D, F.lane, v0); row_load_bf(XB + (size_t)(rbase + 1) * D, F.lane, v1);
#pragma unroll 1
        for (int j = 0; j < 16; j += 2) {
            const int lr = F.wave * 16 + j, row = rbase + j;
            f32x4 n0[4], n1[4];
            { const int nr = (j + 2 < 16) ? row + 2 : row; row_load_bf(XB + (size_t)nr * D, F.lane, n0); row_load_bf(XB + (size_t)(nr + 1) * D, F.lane, n1); }
            const float rstd0 = rsqrtf(row_sumsq(v0) * (1.f / D) + EPS), rstd1 = rsqrtf(row_sumsq(v1) * (1.f / D) + EPS);
#pragma unroll
            for (int jj = 0; jj < 4; ++jj) { v0[jj] = v0[jj] * rstd0 * gm[jj] + sh[jj]; v1[jj] = v1[jj] * rstd1 * gm[jj] + sh[jj]; }
            row_store_bf16(HB + (size_t)row * D, v0, F.lane); row_store_bf16(HB + (size_t)(row + 1) * D, v1, F.lane);
            if (F.lane == 0) { rstdv[lr] = rstd0; rstdv[lr + 1] = rstd1; }
#pragma unroll
            for (int jj = 0; jj < 4; ++jj) { v0[jj] = n0[jj]; v1[jj] = n1[jj]; }
        }
        __syncthreads();
        { const int fr = F.lane & 15, fq = F.lane >> 4;
          f32x4 acc = {0.f, 0.f, 0.f, 0.f};
          const bf16* xr = XB + (size_t)(rb0 * 128 + 16 * F.wave + fr) * D + 8 * fq;
          const LAS bf16* ah = AH + fr * AP + 8 * fq; const LAS bf16* al = AL + fr * AP + 8 * fq;
#pragma unroll 8
          for (int s2 = 0; s2 < 32; ++s2) { const bf16x8 xb = *(const bf16x8*)(xr + 32 * s2);
              acc = __builtin_amdgcn_mfma_f32_16x16x32_bf16(*(const LAS bf16x8*)(ah + 32 * s2), xb, acc, 0, 0, 0);
              acc = __builtin_amdgcn_mfma_f32_16x16x32_bf16(*(const LAS bf16x8*)(al + 32 * s2), xb, acc, 0, 0, 0); }
          const int lrow = 16 * F.wave + fr; const float rs = rstdv[lrow];
#pragma unroll
          for (int i = 0; i < 4; ++i) lgt[lrow * 16 + 4 * fq + i] = rs * acc[i] + cbv[4 * fq + i]; }
        __syncthreads();
        if (F.tid < 128) { float lg[16];
#pragma unroll
            for (int e4 = 0; e4 < 4; ++e4) { const f32x4 t = *(const LAS f32x4*)(lgt + F.tid * 16 + 4 * e4); lg[4 * e4] = t.x; lg[4 * e4 + 1] = t.y; lg[4 * e4 + 2] = t.z; lg[4 * e4 + 3] = t.w; }
            int e1, e2; float w1, w2; route_select(lg, rb, e1, e2, w1, w2);
            sel_e[2 * F.tid] = e1; sel_e[2 * F.tid + 1] = e2; sel_w[2 * F.tid] = w1; sel_w[2 * F.tid + 1] = w2; }
        __syncthreads();
        int my_e = 0, my_rank = 0; float my_w = 0.f;
        if (F.tid < 256) { my_e = sel_e[F.tid]; my_w = sel_w[F.tid];
            const unsigned long long below = (1ull << F.lane) - 1ull;
#pragma unroll 1
            for (int ee = 0; ee < 16; ++ee) { const unsigned long long mk = __ballot(my_e == ee);
                if (my_e == ee) my_rank = __popcll(mk & below);
                if (F.lane == 0) wcnt[F.wave * 16 + ee] = __popcll(mk); } }
        __syncthreads();
        if (F.tid < 16) { const int n = wcnt[F.tid] + wcnt[16 + F.tid] + wcnt[32 + F.tid] + wcnt[48 + F.tid];
            ebase[F.tid] = n ? (int)atomicAdd(cnt + F.tid * 64, (unsigned)n) : 0; }
        __syncthreads();
        if (F.tid < 256) { int pos = ebase[my_e] + my_rank;
            for (int w = 0; w < F.wave; ++w) pos += wcnt[w * 16 + my_e];
            const int tok = rb0 * 128 + (F.tid >> 1), k = F.tid & 1;
            slot_t[my_e * CAP + pos] = tok; slot_w[my_e * CAP + pos] = my_w; tok_e[2 * tok + k] = my_e; tok_p[2 * tok + k] = pos; tok_w[2 * tok + k] = my_w; }
    }
    __syncthreads();
}

constexpr int MOEMAP_OFF = LDS_BYTES - 256;
__device__ __forceinline__ LAS int* moe_map(Frame& F, int layer) {
    LAS int* mm = (LAS int*)(F.lds + MOEMAP_OFF);
    __syncthreads();
    if (F.tid < 64) { const unsigned* cnt = F.ctl + CW_CNT + layer * 16 * 64;
        const int n = (F.tid < 16) ? (int)__hip_atomic_load(cnt + F.tid * 64, __ATOMIC_RELAXED, __HIP_MEMORY_SCOPE_AGENT) : 0;
        const int pad = (n + 255) & ~255; int x = pad;
#pragma unroll
        for (int o = 1; o < 16; o <<= 1) { const int t = __shfl_up(x, o); if (F.lane >= o) x += t; }
        if (F.tid < 16) { mm[F.tid] = n; mm[16 + F.tid] = x - pad; } }
    __syncthreads();
    return mm;
}
struct RowGather { const bf16* base; const int* list; int n; __device__ __forceinline__ const bf16* operator()(int m) const { const int tok = m < n ? list[m] : 0; return base + (size_t)tok * D; } };

__device__ __forceinline__ void phase_moe_gateup(Frame& F, int layer) {
    LAS int* mm = moe_map(F, layer);
    const bf16* HB = (const bf16*)(F.ws + WS_HB); bf16* HID = (bf16*)(F.ws + WS_HID);
    const int* slot_t = (const int*)(F.ws + WS_SLOTT) + layer * 16 * CAP; const float* slot_w = (const float*)(F.ws + WS_SLOTW) + layer * 16 * CAP;
    int ubase = 0;
#pragma unroll 1
    for (int e = 0; e < 16; ++e) {
        const int n = mm[e], hbe = mm[16 + e], rt = (n + 127) >> 7, nu = rt * 8;
        const bf16* Wt = (const bf16*)(F.ws + WS_WGU) + (size_t)(layer * 16 + e) * 1024 * 1024;
        RowGather rp{HB, slot_t + e * CAP, n};
        int first = (F.wg - ubase % F.G + F.G) % F.G;
        for (int u = first; u < nu; u += F.G) {
            const int mt = u / 8, nt = u % 8;
            auto epi = [&](int mb, int nb, const f32x16& c0, const f32x16& c1, int lane) {
                const int h = lane >> 5, cl = lane & 31; const int col = (nb >> 1) + cl;
#pragma unroll
                for (int i = 0; i < 16; ++i) { const int r = mb + crow(i, h);
                    if (r < n) { const float w = slot_w[e * CAP + r]; HID[(size_t)(hbe + r) * FF + col] = (bf16)f2bf(w * silu_f(c0[i]) * c1[i]); } }
            };
            sgemm_tile(rp, Wt, D, mt * 128, nt * 128, epi, F.wave, F.lane);
        }
        ubase += nu;
    }
}
__device__ __forceinline__ void phase_moe_down(Frame& F, int layer) {
    LAS int* mm = moe_map(F, layer);
    const bf16* HID = (const bf16*)(F.ws + WS_HID); bf16* Y = (bf16*)(F.ws + WS_Y);
    int ubase = 0;
#pragma unroll 1
    for (int e = 0; e < 16; ++e) {
        const int n = mm[e], hbe = mm[16 + e], rt = (n + 127) >> 7, nu = rt * 8;
        const bf16* Wt = (const bf16*)(F.ws + WS_WDN) + (size_t)(layer * 16 + e) * 1024 * 512;
        RowLin rp{HID + (size_t)hbe * FF, (size_t)FF};
        int first = (F.wg - ubase % F.G + F.G) % F.G;
        for (int u = first; u < nu; u += F.G) {
            const int mt = u / 8, nt = u % 8;
            auto epi = [&](int mb, int nb, const f32x16& c0, const f32x16& c1, int lane) {
                const int h = lane >> 5, cl = lane & 31;
#pragma unroll
                for (int i = 0; i < 16; ++i) { const int r = mb + crow(i, h);
                    if (r < n) { bf16* yr = Y + (size_t)(hbe + r) * D + nb + cl; yr[0] = (bf16)f2bf(c0[i]); yr[32] = (bf16)f2bf(c1[i]); } }
            };
            sgemm_tile(rp, Wt, FF, mt * 128, nt * 128, epi, F.wave, F.lane);
        }
        ubase += nu;
    }
}

template <bool FINAL>
__device__ __forceinline__ void phase_combine(Frame& F, int layer) {
    LAS int* hbs = moe_map(F, layer) + 16;
    const int gw = F.wg * NWAVES + F.wave, NGW = F.G * NWAVES;
    const float* mod = (const float*)(F.ws + WS_MOD);
    const int* tok_e = (const int*)(F.ws + WS_TOKE); const int* tok_p = (const int*)(F.ws + WS_TOKP);
    const unsigned char* Y8 = (const unsigned char*)(F.ws + WS_Y);
    float* X = F.out; bf16* XB = (bf16*)(F.ws + WS_XB); bf16* HB = (bf16*)(F.ws + WS_HB);
    for (int blk = gw; blk < T / 16; blk += NGW) {
        const int rbase = blk * 16, b = rbase >> 13;
        f32x4 g2v[4], gm[4], shv[4];
        { const float* g2 = mod + ((size_t)layer * 5 + b) * 6144 + 5120;
#pragma unroll
          for (int j = 0; j < 4; ++j) { const int o = ROFF(F.lane, j); g2v[j] = *(const f32x4*)(g2 + o) * (1.f / YSCALE);
              if (FINAL) { gm[j] = *(const f32x4*)(F.in[I_FNG] + o); shv[j] = (f32x4){0.f, 0.f, 0.f, 0.f}; }
              else { const float* m = mod + ((size_t)(layer + 1) * 5 + b) * 6144; gm[j] = *(const f32x4*)(F.in[I_NMG] + (layer + 1) * D + o) * (1.f + *(const f32x4*)(m + 1024 + o)); shv[j] = *(const f32x4*)(m + o); } } }
        int4 te = *(const int4*)(tok_e + 2 * rbase), tp = *(const int4*)(tok_p + 2 * rbase);
        u32x4 xa[2][2], xn[2][2]; u32x2 ya[2][2][2], yn[2][2][2];
        { const int s00 = hbs[te.x] + tp.x, s01 = hbs[te.y] + tp.y, s10 = hbs[te.z] + tp.z, s11 = hbs[te.w] + tp.w;
#pragma unroll
          for (int jj = 0; jj < 2; ++jj) { const int o = 512 * jj + 8 * F.lane;
              xa[0][jj] = *(const u32x4*)(XB + (size_t)rbase * D + o); xa[1][jj] = *(const u32x4*)(XB + (size_t)(rbase + 1) * D + o);
              ya[0][0][jj] = *(const u32x2*)(Y8 + (size_t)s00 * D + o); ya[0][1][jj] = *(const u32x2*)(Y8 + (size_t)s01 * D + o);
              ya[1][0][jj] = *(const u32x2*)(Y8 + (size_t)s10 * D + o); ya[1][1][jj] = *(const u32x2*)(Y8 + (size_t)s11 * D + o); } }
        te = *(const int4*)(tok_e + 2 * (rbase + 2)); tp = *(const int4*)(tok_p + 2 * (rbase + 2));
#pragma unroll 1
        for (int jr = 0; jr < 16; jr += 2) {
            const int row = rbase + jr;
            if (jr + 2 < 16) { const int nr = row + 2;
                const int s00 = hbs[te.x] + tp.x, s01 = hbs[te.y] + tp.y, s10 = hbs[te.z] + tp.z, s11 = hbs[te.w] + tp.w;
#pragma unroll
                for (int jj = 0; jj < 2; ++jj) { const int o = 512 * jj + 8 * F.lane;
                    xn[0][jj] = *(const u32x4*)(XB + (size_t)nr * D + o); xn[1][jj] = *(const u32x4*)(XB + (size_t)(nr + 1) * D + o);
                    yn[0][0][jj] = *(const u32x2*)(Y8 + (size_t)s00 * D + o); yn[0][1][jj] = *(const u32x2*)(Y8 + (size_t)s01 * D + o);
                    yn[1][0][jj] = *(const u32x2*)(Y8 + (size_t)s10 * D + o); yn[1][1][jj] = *(const u32x2*)(Y8 + (size_t)s11 * D + o); }
                const int n2 = (jr + 4 < 16) ? row + 4 : row; te = *(const int4*)(tok_e + 2 * n2); tp = *(const int4*)(tok_p + 2 * n2); }
            f32x4 v[2][4];
#pragma unroll
            for (int q = 0; q < 2; ++q)
#pragma unroll
                for (int jj = 0; jj < 2; ++jj) { const u32x4 xw = xa[q][jj]; const u32x2 a0 = ya[q][0][jj], a1 = ya[q][1][jj];
                    v[q][2 * jj] = (f32x4){bflo(xw.x), bfhi(xw.x), bflo(xw.y), bfhi(xw.y)} + g2v[2 * jj] * (un_fp8x4(a0.x) + un_fp8x4(a1.x));
                    v[q][2 * jj + 1] = (f32x4){bflo(xw.z), bfhi(xw.z), bflo(xw.w), bfhi(xw.w)} + g2v[2 * jj + 1] * (un_fp8x4(a0.y) + un_fp8x4(a1.y)); }
            const float rstd0 = rsqrtf(row_sumsq(v[0]) * (1.f / D) + EPS), rstd1 = rsqrtf(row_sumsq(v[1]) * (1.f / D) + EPS);
#pragma unroll
            for (int q = 0; q < 2; ++q) { const float rstd = q ? rstd1 : rstd0; const size_t ro = (size_t)(row + q) * D;
                if (FINAL) {
#pragma unroll
                    for (int j = 0; j < 4; ++j) *(f32x4*)(X + ro + ROFF(F.lane, j)) = v[q][j] * rstd * gm[j];
                } else {
                    row_store_bf16(XB + ro, v[q], F.lane);
#pragma unroll
                    for (int j = 0; j < 4; ++j) v[q][j] = v[q][j] * rstd * gm[j] + shv[j];
                    row_store_bf16(HB + ro, v[q], F.lane);
                }
            }
#pragma unroll
            for (int q = 0; q < 2; ++q)
#pragma unroll
                for (int jj = 0; jj < 2; ++jj) { xa[q][jj] = xn[q][jj]; ya[q][0][jj] = yn[q][0][jj]; ya[q][1][jj] = yn[q][1][jj]; }
        }
    }
    __syncthreads();
}

__device__ __forceinline__ void phase_pw1(Frame& F) {
    const bf16* HB = (const bf16*)(F.ws + WS_HB); const bf16* Wt = (const bf16*)(F.ws + WS_WPW1); bf16* U = (bf16*)(F.ws + WS_U);
    const float* bias = F.in[I_PW1B];
    RowLin rp{HB, (size_t)D};
    for (int u = F.wg; u < (T / 128) * 16; u += F.G) {
        const int mt = u / 16, nt = u % 16;
        auto epi = [&](int mb, int nb, const f32x16& c0, const f32x16& c1, int lane) {
            const int h = lane >> 5, cl = lane & 31, col = (nb >> 1) + cl; const float ba = bias[col], bg = bias[1024 + col];
#pragma unroll
            for (int i = 0; i < 16; ++i) U[(size_t)(mb + crow(i, h)) * D + col] = (bf16)f2bf((c0[i] + ba) * sigmoid_f(c1[i] + bg));
        };
        sgemm_tile(rp, Wt, D, mt * 128, nt * 128, epi, F.wave, F.lane);
    }
}
__device__ __forceinline__ void phase_dwconv(Frame& F) {
    const bf16* U = (const bf16*)(F.ws + WS_U); bf16* V1 = (bf16*)(F.ws + WS_V1);
    const float* dww = F.in[I_DWW]; const float* dwb = F.in[I_DWB]; const float* lng = F.in[I_LNG]; const float* lnb = F.in[I_LNB];
    const int gw = F.wg * NWAVES + F.wave, NGW = F.G * NWAVES;
    for (int row = gw; row < T; row += NGW) {
        const int l = row & (L - 1);
        f32x4 acc[4];
#pragma unroll
        for (int j = 0; j < 4; ++j) acc[j] = *(const f32x4*)(dwb + 4 * F.lane + 256 * j);
        for (int tp = 0; tp < CONVW; ++tp) { const int ll = l + tp - 15; if (ll < 0 || ll >= L) continue;
            const bf16* ur = U + (size_t)(row + tp - 15) * D; const float* wr = dww + (size_t)tp * D;
#pragma unroll
            for (int j = 0; j < 4; ++j) { const int o = 4 * F.lane + 256 * j; const u32x2 uu = *(const u32x2*)(ur + o); const f32x4 ww = *(const f32x4*)(wr + o);
                acc[j].x += bflo(uu.x) * ww.x; acc[j].y += bfhi(uu.x) * ww.y; acc[j].z += bflo(uu.y) * ww.z; acc[j].w += bfhi(uu.y) * ww.w; } }
        float s = 0.f;
#pragma unroll
        for (int j = 0; j < 4; ++j) s += (acc[j].x + acc[j].y) + (acc[j].z + acc[j].w);
        const float mean = wave_sum(s) * (1.f / D); float q = 0.f;
#pragma unroll
        for (int j = 0; j < 4; ++j) { acc[j] = acc[j] - mean; q += (acc[j].x * acc[j].x + acc[j].y * acc[j].y) + (acc[j].z * acc[j].z + acc[j].w * acc[j].w); }
        const float rstd = rsqrtf(wave_sum(q) * (1.f / D) + EPS);
#pragma unroll
        for (int j = 0; j < 4; ++j) { const int o = 4 * F.lane + 256 * j; const f32x4 gg = *(const f32x4*)(lng + o), bb = *(const f32x4*)(lnb + o);
            f32x4 y = acc[j] * rstd * gg + bb; y.x = silu_f(y.x); y.y = silu_f(y.y); y.z = silu_f(y.z); y.w = silu_f(y.w); acc[j] = y; }
        row_store_bf16(V1 + (size_t)row * D, acc, F.lane);
    }
}


namespace pg {
constexpr int BM = 256, BK = 64, HALF = 128, HTB = HALF * BK * 2, STAGE_BYTES = 8 * HTB;
constexpr int TAB_OFF = STAGE_BYTES;
__device__ __forceinline__ int lds_byte(int r, int c) { const int st = (r >> 4) * 2 + (c >> 5), rr = r & 15, cc = c & 31, ob = rr * 64 + cc * 2; return st * 1024 + (ob ^ (((ob >> 9) & 1) << 5)); }
__device__ __forceinline__ void stage_rc(int b, int& R, int& C) { const int st = b / 1024, sb = b % 1024, swz = sb ^ (((sb >> 9) & 1) << 5); R = (st >> 1) * 16 + swz / 64; C = (st & 1) * 32 + (swz % 64) / 2; }
__device__ __forceinline__ int perm32(int rho) { const int n = rho >> 4, i = rho & 15; return 8 * (i >> 2) + 4 * n + (i & 3); }
__device__ __forceinline__ unsigned cvt_pk_bf16(float lo, float hi) { unsigned r; asm volatile("v_cvt_pk_bf16_f32 %0, %1, %2" : "=v"(r) : "v"(lo), "v"(hi)); return r; }

struct GU { const char* B; int p0, p1, p2, p3; };

template <class Epi, class Sched>
__device__ __forceinline__ void gemm_phase(LAS unsigned char* lds, const char* Abase, const int K, const Sched& S, const Epi& E) {
    const int tid = threadIdx.x, wid = __builtin_amdgcn_readfirstlane(tid >> 6), lane = tid & 63, wr = wid >> 2, wc = wid & 3, fr = lane & 15, fq = lane >> 4;
    const int nt = K / BK;
    int sR[2], sC[2]; unsigned voffB[2];
#pragma unroll
    for (int i = 0; i < 2; ++i) { int R, C; stage_rc(tid * 16 + i * 8192, R, C); sR[i] = R; sC[i] = C; const int Rb = Epi::PERM ? ((R & ~31) + perm32(R & 31)) : R; voffB[i] = (unsigned)(Rb * K + C) * 2u; }
    const size_t kstep = (size_t)(BK * 2);
    const size_t hstep = (size_t)HALF * K * 2;
    const unsigned ldsw = (unsigned)wid * 1024u;
    const int aoff = lds_byte(wr * 64 + fr, fq * 8), boff = lds_byte(wc * 32 + fr, fq * 8);
#define PG_SA(b, h) (((b) * 2 + (h)) * HTB)
#define PG_SB(b, h) ((4 + (b) * 2 + (h)) * HTB)
#define PG_STAGE(bufoff, gbase, voff) do { _Pragma("unroll") for (int _i = 0; _i < 2; ++_i) \
        __builtin_amdgcn_global_load_lds((const unsigned*)((const char*)(gbase) + (voff)[_i]), (LAS unsigned*)(lds + (bufoff) + ldsw + _i * 8192), 16, 0, 0); } while (0)
#define PG_LDA(dst, b, h) do { _Pragma("unroll") for (int m = 0; m < 4; ++m) _Pragma("unroll") for (int k = 0; k < 2; ++k) dst[m][k] = *(const LAS bf16x8*)(lds + PG_SA(b, h) + aoff + m * 2048 + k * 1024); } while (0)
#define PG_LDB(dst, b, h) do { _Pragma("unroll") for (int n = 0; n < 2; ++n) _Pragma("unroll") for (int k = 0; k < 2; ++k) dst[n][k] = *(const LAS bf16x8*)(lds + PG_SB(b, h) + boff + n * 2048 + k * 1024); } while (0)
#define PG_MMA(ai, bj, At, Bt) do { __builtin_amdgcn_s_setprio(1); _Pragma("unroll") for (int m = 0; m < 4; ++m) _Pragma("unroll") for (int n = 0; n < 2; ++n) _Pragma("unroll") for (int k = 0; k < 2; ++k) \
        acc[ai][bj][m][n] = __builtin_amdgcn_mfma_f32_16x16x32_bf16(Bt[n][k], At[m][k], acc[ai][bj][m][n], 0, 0, 0); __builtin_amdgcn_s_setprio(0); } while (0)
#define PG_WAIT_V(n) asm volatile("s_waitcnt vmcnt(" #n ")" ::: "memory")
#define PG_WAIT_L(n) asm volatile("s_waitcnt lgkmcnt(" #n ")" ::: "memory")
#define PG_BAR __builtin_amdgcn_s_barrier()
#define PG_SCHED __builtin_amdgcn_sched_barrier(0)
    GU cur, nxt; int ui = 0;
    if (!S.next(0, cur)) return;
    f32x4 acc[2][2][4][2];
#pragma unroll
    for (int a = 0; a < 2; ++a)
#pragma unroll
        for (int b = 0; b < 2; ++b)
#pragma unroll
            for (int m = 0; m < 4; ++m)
#pragma unroll
                for (int n = 0; n < 2; ++n) acc[a][b][m][n] = (f32x4){0.f, 0.f, 0.f, 0.f};
    bf16x8 At[4][2], B0[2][2], B1[2][2];
    if constexpr (Sched::GATHER) { S.stage_table(cur, 0, lds, wid, lane); PG_WAIT_V(0); PG_BAR; }
    unsigned voC[2][2], voN[2][2];
#pragma unroll
    for (int h = 0; h < 2; ++h)
#pragma unroll
        for (int i = 0; i < 2; ++i) { voC[h][i] = S.voff(cur, 0, lds, h * HALF + sR[i], sC[i]); voN[h][i] = voC[h][i]; }
    const char* cB = cur.B;
    PG_STAGE(PG_SB(0, 0), cB, voffB); PG_STAGE(PG_SB(0, 1), cB + hstep, voffB); PG_STAGE(PG_SA(0, 0), Abase, voC[0]); PG_STAGE(PG_SA(0, 1), Abase, voC[1]);
    if (wr == 1) PG_BAR;
    PG_WAIT_V(2); PG_BAR;
    PG_STAGE(PG_SB(1, 0), cB + kstep, voffB); PG_STAGE(PG_SA(1, 0), Abase + kstep, voC[0]); PG_STAGE(PG_SB(1, 1), cB + hstep + kstep, voffB);
    PG_WAIT_V(6); PG_BAR;
    for (;;) {
        const bool has_next = S.next(ui + 1, nxt);
        if constexpr (Sched::GATHER) { if (has_next) S.stage_table(nxt, (ui + 1) & 1, lds, wid, lane); }
        const char* nB = has_next ? nxt.B : cB;
        for (int t = 0; t < nt; t += 2) {
            const bool last = (t == nt - 2);
            if (last && has_next) {
#pragma unroll
                for (int h = 0; h < 2; ++h)
#pragma unroll
                    for (int i = 0; i < 2; ++i) voN[h][i] = S.voff(nxt, (ui + 1) & 1, lds, h * HALF + sR[i], sC[i]);
            }
            unsigned vo2[2][2];
#pragma unroll
            for (int h = 0; h < 2; ++h)
#pragma unroll
                for (int i = 0; i < 2; ++i) vo2[h][i] = last ? voN[h][i] : voC[h][i];
            const char* a1 = Abase + (size_t)(t + 1) * kstep;
            const char* a2 = last ? Abase : Abase + (size_t)(t + 2) * kstep; const char* b2 = last ? nB : cB + (size_t)(t + 2) * kstep;
            const char* a3 = a2 + kstep; const char* b3 = b2 + kstep;
            PG_LDB(B0, 0, 0); PG_LDB(B1, 0, 1); PG_SCHED; PG_LDA(At, 0, 0); PG_STAGE(PG_SA(1, 1), a1, voC[1]);
            PG_WAIT_V(8); PG_WAIT_L(0); PG_BAR; PG_MMA(0, 0, At, B0); PG_MMA(0, 1, At, B1); PG_BAR; PG_SCHED;
            PG_LDA(At, 0, 1); PG_STAGE(PG_SB(0, 0), b2, voffB); PG_STAGE(PG_SB(0, 1), b2 + hstep, voffB); PG_STAGE(PG_SA(0, 0), a2, vo2[0]);
            PG_WAIT_V(8); PG_WAIT_L(0); PG_BAR; PG_MMA(1, 0, At, B0); PG_MMA(1, 1, At, B1); PG_BAR; PG_SCHED;
            PG_LDB(B0, 1, 0); PG_LDB(B1, 1, 1); PG_SCHED; PG_LDA(At, 1, 0); PG_STAGE(PG_SA(0, 1), a2, vo2[1]);
            PG_WAIT_V(8); PG_WAIT_L(0); PG_BAR; PG_MMA(0, 0, At, B0); PG_MMA(0, 1, At, B1); PG_BAR; PG_SCHED;
            PG_LDA(At, 1, 1); PG_STAGE(PG_SB(1, 0), b3, voffB); PG_STAGE(PG_SB(1, 1), b3 + hstep, voffB); PG_STAGE(PG_SA(1, 0), a3, vo2[0]);
            PG_WAIT_V(8); PG_WAIT_L(0); PG_BAR; PG_MMA(1, 0, At, B0); PG_MMA(1, 1, At, B1); PG_BAR; PG_SCHED;
        }
        if (wr == 0) PG_BAR;
        E(acc, cur, wr, wc, fr, fq);
        if (!has_next) break;
#pragma unroll
        for (int a = 0; a < 2; ++a)
#pragma unroll
            for (int b = 0; b < 2; ++b)
#pragma unroll
                for (int m = 0; m < 4; ++m)
#pragma unroll
                    for (int n = 0; n < 2; ++n) acc[a][b][m][n] = (f32x4){0.f, 0.f, 0.f, 0.f};
        cur = nxt; cB = nB; ++ui;
#pragma unroll
        for (int h = 0; h < 2; ++h)
#pragma unroll
            for (int i = 0; i < 2; ++i) voC[h][i] = voN[h][i];
        if (wr == 1) PG_BAR;
    }
    PG_WAIT_V(0);
    PG_BAR;
#undef PG_SA
#undef PG_SB
#undef PG_STAGE
#undef PG_LDA
#undef PG_LDB
#undef PG_MMA
#undef PG_WAIT_V
#undef PG_WAIT_L
#undef PG_BAR
#undef PG_SCHED
}

__device__ __forceinline__ void static_tile(int L, int nM, int nN, int& pm, int& pn) {
    const int nwg = nM * nN; int wgid = L; { const int q = nwg / 8, r = nwg % 8, xcd = wgid % 8, off = wgid / 8; wgid = (xcd < r ? xcd * (q + 1) : r * (q + 1) + (xcd - r) * q) + off; }
    const int nig = 8 * nN, gid = wgid / nig, fm = gid * 8, gsz = (nM - fm) < 8 ? (nM - fm) : 8;
    pm = fm + ((wgid % nig) % gsz); pn = (wgid % nig) / gsz;
}
struct DenseSched {
    static constexpr bool GATHER = false;
    const char* Bt; int K, nM, nN, G, c, xn, xm0, xpn;
    __device__ __forceinline__ bool next(int i, GU& u) const {
        const int L = i * G + c, nmain = nM * nN; int pm, pn;
        if (L < nmain) static_tile(L, nM, nN, pm, pn); else if (L < nmain + xn) { pm = xm0 + (L - nmain); pn = xpn; } else return false;
        u.B = Bt + (size_t)pn * BM * K * 2; u.p0 = pm; u.p1 = pn; u.p2 = 0; u.p3 = 0; return true;
    }
    __device__ __forceinline__ unsigned voff(const GU& u, int, LAS unsigned char*, int R, int C) const { return (unsigned)(((u.p0 * BM + R) * K + C) * 2); }
    __device__ __forceinline__ void stage_table(const GU&, int, LAS unsigned char*, int, int) const {}
};
template <bool GATHER_> struct MoeSched {
    static constexpr bool GATHER = GATHER_;
    const char* Wt; size_t wstride; int K; const int* list; LAS int* mm; int G, c;
    __device__ __forceinline__ bool next(int i, GU& u) const {
        int L = i * G + c;
        for (int e = 0; e < 16; ++e) { const int n = mm[e], nu = ((n + 255) >> 8) * 4;
            if (L < nu) { const int rt = L >> 2, pn = L & 3; u.B = Wt + (size_t)e * wstride + (size_t)pn * BM * K * 2; u.p0 = e; u.p1 = rt; u.p2 = pn; u.p3 = mm[16 + e]; return true; }
            L -= nu; }
        return false;
    }
    __device__ __forceinline__ unsigned voff(const GU& u, int buf, LAS unsigned char* lds, int R, int C) const {
        if constexpr (GATHER_) { const int tok = ((const LAS int*)(lds + TAB_OFF))[buf * 256 + R]; return (unsigned)((tok * K + C) * 2); }
        else return (unsigned)(((u.p3 + u.p1 * BM + R) * K + C) * 2);
    }
    __device__ __forceinline__ void stage_table(const GU& u, int buf, LAS unsigned char* lds, int wid, int lane) const {
        if constexpr (GATHER_) { const int r = (wid & 3) * 64 + lane;
            __builtin_amdgcn_global_load_lds((const unsigned*)(list + u.p0 * CAP + u.p1 * BM + r), (LAS unsigned*)(lds + TAB_OFF + buf * 1024 + (wid & 3) * 256), 4, 0, 0); }
    }
};

struct EpiInProj {
    static constexpr bool PERM = false;
    unsigned char* ws;
    __device__ __forceinline__ void operator()(const f32x4 (&acc)[2][2][4][2], const GU& u, int wr, int wc, int fr, int fq) const {
        const int pm = u.p0, pn = u.p1; const bool isctx = pm >= T / BM;
        float inv[4];
#pragma unroll
        for (int j = 0; j < 4; ++j) inv[j] = exp2f(-(float)(4 * fq + j) * (13.287712379549449f / 16.f));
#pragma unroll
        for (int bj = 0; bj < 2; ++bj) {
            const int cb = pn * BM + bj * HALF + wc * 32;
            bf16* dst; int pitch, cbase; bool rope = false;
            if (cb < 512) { dst = (bf16*)(ws + WS_UF); pitch = 512; cbase = 0; }
            else if (cb < 1024) { dst = (bf16*)(ws + WS_Q); pitch = 512; cbase = 512; rope = true; }
            else if (cb < 1152) { dst = isctx ? (bf16*)(ws + WS_CK) : (bf16*)(ws + WS_K); pitch = 128; cbase = 1024; rope = !isctx; }
            else { dst = isctx ? (bf16*)(ws + WS_CV) : (bf16*)(ws + WS_V); pitch = 128; cbase = 1152; }
            const bool bycol = ((cb >> 5) & 1) != 0;
#pragma unroll
            for (int ai = 0; ai < 2; ++ai)
#pragma unroll
                for (int m = 0; m < 4; ++m) {
                    const int row = pm * BM + ai * HALF + wr * 64 + m * 16 + fr;
                    f32x4 v0 = acc[ai][bj][m][0], v1 = acc[ai][bj][m][1];
                    if (rope) { const int l = row & (L - 1); const float pos = (float)(bycol ? (l & 63) : (l >> 6));
#pragma unroll
                        for (int j = 0; j < 4; ++j) { const float ang = pos * inv[j], cs = __cosf(ang), sn = __sinf(ang); const float x1 = v0[j], x2 = v1[j]; v0[j] = x1 * cs - x2 * sn; v1[j] = x1 * sn + x2 * cs; } }
                    const int orow = isctx ? row - T : row;
                    if (FAST_ATTN && cb >= 1152) {
                        const int kp = isctx ? CL : L, bb = isctx ? (orow >> 8) : (orow >> 13), key = isctx ? (orow & (CL - 1)) : (orow & (L - 1));
#pragma unroll
                        for (int n = 0; n < 2; ++n)
#pragma unroll
                            for (int j = 0; j < 4; ++j) { const int c = (cb - 1152) + 16 * n + 4 * fq + j;
                                dst[((size_t)bb * 128 + c) * kp + key] = (bf16)f2bf(n ? v1[j] : v0[j]); }
                        continue;
                    }
                    bf16* o = dst + (size_t)orow * pitch + (cb - cbase) + 4 * fq;
                    u32x2 w0, w1; w0.x = cvt_pk_bf16(v0[0], v0[1]); w0.y = cvt_pk_bf16(v0[2], v0[3]); w1.x = cvt_pk_bf16(v1[0], v1[1]); w1.y = cvt_pk_bf16(v1[2], v1[3]);
                    *(u32x2*)o = w0; *(u32x2*)(o + 16) = w1;
                }
        }
    }
};
struct EpiRes {
    static constexpr bool PERM = false;
    const float* base; float* X; const float* gate; const float* bias;
    __device__ __forceinline__ void operator()(const f32x4 (&acc)[2][2][4][2], const GU& u, int wr, int wc, int fr, int fq) const {
        const int row0 = u.p0 * BM + wr * 64 + fr, col0 = u.p1 * BM + wc * 32 + 4 * fq; const int b = (u.p0 * BM) >> 13;
        f32x4 gv[2][2], bv[2][2];
#pragma unroll
        for (int bj = 0; bj < 2; ++bj)
#pragma unroll
            for (int n = 0; n < 2; ++n) { gv[bj][n] = *(const f32x4*)(gate + (size_t)b * 6144 + col0 + bj * HALF + n * 16); bv[bj][n] = bias ? *(const f32x4*)(bias + col0 + bj * HALF + n * 16) : (f32x4){0.f, 0.f, 0.f, 0.f}; }
#pragma unroll
        for (int ai = 0; ai < 2; ++ai)
#pragma unroll
            for (int mp = 0; mp < 2; ++mp) {
                f32x4 bs[2][2][2];
#pragma unroll
                for (int mm = 0; mm < 2; ++mm) { const size_t off = (size_t)(row0 + ai * HALF + (2 * mp + mm) * 16) * D + col0;
#pragma unroll
                    for (int bj = 0; bj < 2; ++bj)
#pragma unroll
                        for (int n = 0; n < 2; ++n) bs[mm][bj][n] = *(const f32x4*)(base + off + bj * HALF + n * 16); }
#pragma unroll
                for (int mm = 0; mm < 2; ++mm) { const int m = 2 * mp + mm; const size_t off = (size_t)(row0 + ai * HALF + m * 16) * D + col0;
#pragma unroll
                    for (int bj = 0; bj < 2; ++bj)
#pragma unroll
                        for (int n = 0; n < 2; ++n) *(f32x4*)(X + off + bj * HALF + n * 16) = bs[mm][bj][n] + gv[bj][n] * (acc[ai][bj][m][n] + bv[bj][n]); }
                asm volatile("" ::: "memory"); }
    }
};
template <bool BASEBF> struct EpiResB {
    static constexpr bool PERM = true;
    const float* basef; bf16* XB; const float* gate; const float* bias;
    __device__ __forceinline__ void operator()(const f32x4 (&acc)[2][2][4][2], const GU& u, int wr, int wc, int fr, int fq) const {
        const int row0 = u.p0 * BM + wr * 64 + fr, col0 = u.p1 * BM + wc * 32 + 8 * fq; const int b = (u.p0 * BM) >> 13;
        f32x4 gv[2][2], bv[2][2];
#pragma unroll
        for (int bj = 0; bj < 2; ++bj)
#pragma unroll
            for (int n = 0; n < 2; ++n) { gv[bj][n] = *(const f32x4*)(gate + (size_t)b * 6144 + col0 + bj * HALF + n * 4); bv[bj][n] = bias ? *(const f32x4*)(bias + col0 + bj * HALF + n * 4) : (f32x4){0.f, 0.f, 0.f, 0.f}; }
        constexpr int NB2 = BASEBF ? 4 : 2;
#pragma unroll
        for (int ai = 0; ai < 2; ++ai)
#pragma unroll
            for (int mb = 0; mb < 4; mb += NB2) {
                f32x4 bf[BASEBF ? 1 : NB2][2][2]; u32x4 bw[BASEBF ? NB2 : 1][2];
#pragma unroll
                for (int mm = 0; mm < NB2; ++mm) { const size_t off = (size_t)(row0 + ai * HALF + (mb + mm) * 16) * D + col0;
#pragma unroll
                    for (int bj = 0; bj < 2; ++bj) {
                        if (BASEBF) bw[mm][bj] = *(const u32x4*)(XB + off + bj * HALF);
                        else { bf[mm][bj][0] = *(const f32x4*)(basef + off + bj * HALF); bf[mm][bj][1] = *(const f32x4*)(basef + off + bj * HALF + 4); } } }
#pragma unroll
                for (int mm = 0; mm < NB2; ++mm) { const int m = mb + mm; const size_t off = (size_t)(row0 + ai * HALF + m * 16) * D + col0;
#pragma unroll
                    for (int bj = 0; bj < 2; ++bj) { f32x4 o[2];
#pragma unroll
                        for (int n = 0; n < 2; ++n) { f32x4 bsv;
                            if (BASEBF) { const unsigned wa = n ? bw[mm][bj].z : bw[mm][bj].x, wb = n ? bw[mm][bj].w : bw[mm][bj].y; bsv = (f32x4){bflo(wa), bfhi(wa), bflo(wb), bfhi(wb)}; } else bsv = bf[mm][bj][n];
                            o[n] = bsv + gv[bj][n] * (acc[ai][bj][m][n] + bv[bj][n]); }
                        u32x4 w2; w2.x = cvt_pk_bf16(o[0][0], o[0][1]); w2.y = cvt_pk_bf16(o[0][2], o[0][3]); w2.z = cvt_pk_bf16(o[1][0], o[1][1]); w2.w = cvt_pk_bf16(o[1][2], o[1][3]);
                        *(u32x4*)(XB + off + bj * HALF) = w2; } }
                asm volatile("" ::: "memory"); }
    }
};
struct EpiGLU {
    static constexpr bool PERM = true;
    bf16* U; const float* bias;
    __device__ __forceinline__ void operator()(const f32x4 (&acc)[2][2][4][2], const GU& u, int wr, int wc, int fr, int fq) const {
        const int row0 = u.p0 * BM + wr * 64 + fr, col0 = u.p1 * HALF + wc * 32 + 8 * fq;
        f32x4 ba[2], bg[2];
#pragma unroll
        for (int n = 0; n < 2; ++n) { ba[n] = *(const f32x4*)(bias + col0 + 4 * n); bg[n] = *(const f32x4*)(bias + 1024 + col0 + 4 * n); }
#pragma unroll
        for (int ai = 0; ai < 2; ++ai)
#pragma unroll
            for (int m = 0; m < 4; ++m) { f32x4 o[2];
#pragma unroll
                for (int n = 0; n < 2; ++n) { const f32x4 a = acc[ai][0][m][n] + ba[n], g = acc[ai][1][m][n] + bg[n];
#pragma unroll
                    for (int j = 0; j < 4; ++j) o[n][j] = a[j] * sigmoid_f(g[j]); }
                u32x4 w; w.x = cvt_pk_bf16(o[0][0], o[0][1]); w.y = cvt_pk_bf16(o[0][2], o[0][3]); w.z = cvt_pk_bf16(o[1][0], o[1][1]); w.w = cvt_pk_bf16(o[1][2], o[1][3]);
                *(u32x4*)(U + (size_t)(row0 + ai * HALF + m * 16) * D + col0) = w; }
    }
};
struct EpiGateUp {
    static constexpr bool PERM = true;
    bf16* HID; const float* slot_w; LAS int* mm;
    __device__ __forceinline__ void operator()(const f32x4 (&acc)[2][2][4][2], const GU& u, int wr, int wc, int fr, int fq) const {
        const int e = u.p0, n_e = mm[e], r0 = u.p1 * BM + wr * 64 + fr, col0 = u.p2 * HALF + wc * 32 + 8 * fq;
        float wv[2][4];
#pragma unroll
        for (int ai = 0; ai < 2; ++ai)
#pragma unroll
            for (int m = 0; m < 4; ++m) wv[ai][m] = slot_w[e * CAP + r0 + ai * HALF + m * 16];
#pragma unroll
        for (int ai = 0; ai < 2; ++ai)
#pragma unroll
            for (int m = 0; m < 4; ++m) { const int r = r0 + ai * HALF + m * 16;
                if (r < n_e) { const float w = wv[ai][m]; f32x4 o[2];
#pragma unroll
                    for (int n = 0; n < 2; ++n) { const f32x4 g = acc[ai][0][m][n], up = acc[ai][1][m][n];
#pragma unroll
                        for (int j = 0; j < 4; ++j) o[n][j] = w * silu_f(g[j]) * up[j]; }
                    u32x4 q; q.x = cvt_pk_bf16(o[0][0], o[0][1]); q.y = cvt_pk_bf16(o[0][2], o[0][3]); q.z = cvt_pk_bf16(o[1][0], o[1][1]); q.w = cvt_pk_bf16(o[1][2], o[1][3]);
                    *(u32x4*)(HID + (size_t)(u.p3 + r) * FF + col0) = q; } }
    }
};
struct EpiDown {
    static constexpr bool PERM = true;
    bf16* Y; LAS int* mm;
    __device__ __forceinline__ void operator()(const f32x4 (&acc)[2][2][4][2], const GU& u, int wr, int wc, int fr, int fq) const {
        const int e = u.p0, n_e = mm[e], r0 = u.p1 * BM + wr * 64 + fr, col0 = u.p2 * BM + wc * 32 + 8 * fq;
#pragma unroll
        for (int ai = 0; ai < 2; ++ai)
#pragma unroll
            for (int m = 0; m < 4; ++m) { const int r = r0 + ai * HALF + m * 16;
                if (r < n_e) {
#pragma unroll
                    for (int bj = 0; bj < 2; ++bj) { const f32x4 v0 = acc[ai][bj][m][0], v1 = acc[ai][bj][m][1];
                        u32x4 q; q.x = cvt_pk_bf16(v0[0], v0[1]); q.y = cvt_pk_bf16(v0[2], v0[3]); q.z = cvt_pk_bf16(v1[0], v1[1]); q.w = cvt_pk_bf16(v1[2], v1[3]);
                        *(u32x4*)(Y + (size_t)(u.p3 + r) * D + col0 + bj * HALF) = q; } } }
    }
};
}

__device__ __forceinline__ void fast_inproj(Frame& F) {
    pg::DenseSched S{(const char*)(F.ws + WS_WIN), D, T / 256, N_IN / 256, F.G, F.wg, TC / 256, T / 256, 4};
    pg::EpiInProj E{F.ws};
    pg::gemm_phase(F.lds, (const char*)(F.ws + WS_HB), D, S, E);
    const int nbusy = (T / 256) * (N_IN / 256) + TC / 256 - 2 * F.G;
    if (nbusy > 0 && nbusy < F.G) { if (F.wg >= nbusy) t_items_tail(F, (F.wg - nbusy) * NWAVES + F.wave, (F.G - nbusy) * NWAVES); }
    else t_items_tail(F, F.wg * NWAVES + F.wave, F.G * NWAVES);
}
__device__ __forceinline__ void fast_outproj(Frame& F, size_t a_off, size_t w_off, const float* base, float* X, const float* gate, const float* bias) {
    pg::DenseSched S{(const char*)(F.ws + w_off), D, T / 256, D / 256, F.G, F.wg, 0, 0, 0};
    if (XBF16) {
        if (base == X) { pg::EpiResB<true> E{nullptr, (bf16*)(F.ws + WS_XB), gate, bias}; pg::gemm_phase(F.lds, (const char*)(F.ws + a_off), D, S, E); }
        else { pg::EpiResB<false> E{base, (bf16*)(F.ws + WS_XB), gate, bias}; pg::gemm_phase(F.lds, (const char*)(F.ws + a_off), D, S, E); }
    } else { pg::EpiRes E{base, X, gate, bias}; pg::gemm_phase(F.lds, (const char*)(F.ws + a_off), D, S, E); }
}
__device__ __forceinline__ void fast_pw1(Frame& F) {
    pg::DenseSched S{(const char*)(F.ws + WS_WPW1), D, T / 256, 2048 / 256, F.G, F.wg, 0, 0, 0};
    pg::EpiGLU E{(bf16*)(F.ws + WS_U), F.in[I_PW1B]};
    pg::gemm_phase(F.lds, (const char*)(F.ws + WS_HB), D, S, E);
}
__device__ __forceinline__ void fast_moe_gateup(Frame& F, int layer) {
    LAS int* mm = moe_map(F, layer);
    pg::MoeSched<true> S{(const char*)(F.ws + WS_WGU) + (size_t)layer * 16 * 1024 * 1024 * 2, (size_t)1024 * 1024 * 2, D, (const int*)(F.ws + WS_SLOTT) + layer * 16 * CAP, mm, F.G, F.wg};
    pg::EpiGateUp E{(bf16*)(F.ws + WS_HID), (const float*)(F.ws + WS_SLOTW) + layer * 16 * CAP, mm};
    pg::gemm_phase(F.lds, (const char*)(F.ws + WS_HB), D, S, E);
}
__device__ __forceinline__ void fast_moe_down(Frame& F, int layer) {
    LAS int* mm = moe_map(F, layer);
    pg::MoeSched<false> S{(const char*)(F.ws + WS_WDN) + (size_t)layer * 16 * 1024 * 512 * 2, (size_t)1024 * 512 * 2, FF, nullptr, mm, F.G, F.wg};
    pg::EpiDown E{(bf16*)(F.ws + WS_Y), mm};
    pg::gemm_phase(F.lds, (const char*)(F.ws + WS_HID), FF, S, E);
}


struct AttnBlk { const bf16* kp; const bf16* vp; int pitch; int kb; bool valid, masked; };
__device__ __forceinline__ AttnBlk attn_blk(const unsigned char* ws, int bi, int b, int kvh, int qs) {
    AttnBlk a;
    if (bi < 8) { a.kp = (const bf16*)(ws + WS_CK) + (size_t)(b * CL + bi * 32) * 128 + kvh * 64; a.vp = (const bf16*)(ws + WS_CV) + (size_t)(b * 2 + kvh) * 64 * CL + bi * 32; a.pitch = CL; a.kb = 0; a.valid = true; a.masked = false; }
    else { const int kb = qs - 128 + 32 * (bi - 8); a.valid = (kb >= 0 && kb < L); a.kb = kb; a.masked = true; a.pitch = L;
        a.kp = (const bf16*)(ws + WS_K) + (size_t)(b * L + kb) * 128 + kvh * 64; a.vp = (const bf16*)(ws + WS_V) + (size_t)(b * 2 + kvh) * 64 * L + kb; }
    return a;
}
__device__ __forceinline__ void attn_load(const AttnBlk& a, int r, int h, bf16x8 (&kf)[4], u32x4 (&vf)[2][2]) {
    if (a.valid) {
#pragma unroll
        for (int s = 0; s < 4; ++s) kf[s] = *(const bf16x8*)(a.kp + (size_t)r * 128 + 16 * s + 8 * h);
#pragma unroll
        for (int db = 0; db < 2; ++db)
#pragma unroll
            for (int ks = 0; ks < 2; ++ks) { const bf16* vr = a.vp + (size_t)(32 * db + r) * a.pitch + 16 * ks + 4 * h;
                const u32x2 lo = *(const u32x2*)vr, hi = *(const u32x2*)(vr + 8); vf[db][ks] = (u32x4){lo.x, lo.y, hi.x, hi.y}; }
    }
}
__device__ __forceinline__ void attn_compute(const AttnBlk& a, int qs, int r, int h, const bf16x8 (&kf)[4], const u32x4 (&vf)[2][2], const bf16x8 (&qf)[2][4],
                                             f32x16 (&o)[2][2], float (&m)[2], float (&l)[2]) {
    if (!a.valid) return;
#pragma unroll
    for (int nq = 0; nq < 2; ++nq) {
        f32x16 st;
#pragma unroll
        for (int i = 0; i < 16; ++i) st[i] = 0.f;
#pragma unroll
        for (int s = 0; s < 4; ++s) st = __builtin_amdgcn_mfma_f32_32x32x16_bf16(kf[s], qf[nq][s], st, 0, 0, 0);
        float t[16]; float tmax = -INFINITY;
        const int dbase = a.kb - qs - 32 * nq - r + 4 * h;
#pragma unroll
        for (int i = 0; i < 16; ++i) { float v = st[i] * (0.125f * 1.4426950408889634f);
            if (a.masked) { const int df = dbase + (i & 3) + 8 * (i >> 2); v = (df >= -128 && df <= 128) ? v : -INFINITY; }
            t[i] = v; tmax = fmaxf(tmax, v); }
        tmax = fmaxf(tmax, __shfl_xor(tmax, 32));
        const float mn = fmaxf(m[nq], tmax), alpha = __builtin_amdgcn_exp2f(m[nq] - mn); m[nq] = mn;
        float ps = 0.f;
#pragma unroll
        for (int i = 0; i < 16; ++i) { t[i] = __builtin_amdgcn_exp2f(t[i] - mn); ps += t[i]; }
        l[nq] = l[nq] * alpha + ps;
#pragma unroll
        for (int i = 0; i < 16; ++i) { o[0][nq][i] *= alpha; o[1][nq][i] *= alpha; }
        bf16x8 pf[2];
#pragma unroll
        for (int ks = 0; ks < 2; ++ks) { const u32x4 w = {pkbf(t[8 * ks], t[8 * ks + 1]), pkbf(t[8 * ks + 2], t[8 * ks + 3]), pkbf(t[8 * ks + 4], t[8 * ks + 5]), pkbf(t[8 * ks + 6], t[8 * ks + 7])};
            pf[ks] = __builtin_bit_cast(bf16x8, w); }
#pragma unroll
        for (int db = 0; db < 2; ++db)
#pragma unroll
            for (int ks = 0; ks < 2; ++ks) o[db][nq] = __builtin_amdgcn_mfma_f32_32x32x16_bf16(__builtin_bit_cast(bf16x8, vf[db][ks]), pf[ks], o[db][nq], 0, 0, 0);
    }
}
__device__ __forceinline__ void phase_attn_mfma(Frame& F) {
    const bf16* Q = (const bf16*)(F.ws + WS_Q); bf16* MIX = (bf16*)(F.ws + WS_MIX);
    const int g = F.wave >> 1, half = F.wave & 1, r = F.lane & 31, h = F.lane >> 5;
    for (int item = F.wg; item < NB * 2 * 64; item += F.G) {
        const int qb = item & 63, kvh = (item >> 6) & 1, b = item >> 7, hd = kvh * 4 + g, qs = qb * 128 + half * 64;
        bf16x8 qf[2][4];
#pragma unroll
        for (int nq = 0; nq < 2; ++nq)
#pragma unroll
            for (int s = 0; s < 4; ++s) qf[nq][s] = *(const bf16x8*)(Q + (size_t)(b * L + qs + 32 * nq + r) * 512 + hd * 64 + 16 * s + 8 * h);
        f32x16 o[2][2];
#pragma unroll
        for (int db = 0; db < 2; ++db)
#pragma unroll
            for (int nq = 0; nq < 2; ++nq)
#pragma unroll
                for (int i = 0; i < 16; ++i) o[db][nq][i] = 0.f;
        float m[2], l[2];
        m[0] = m[1] = F.in[I_SINK][hd] * 1.4426950408889634f; l[0] = l[1] = (h == 0) ? 1.f : 0.f;
        bf16x8 kfA[4], kfB[4]; u32x4 vfA[2][2], vfB[2][2];
        AttnBlk ba = attn_blk(F.ws, 0, b, kvh, qs), bb;
        attn_load(ba, r, h, kfA, vfA);
#pragma unroll 1
        for (int bi = 0; bi < 18; bi += 2) {
            bb = attn_blk(F.ws, bi + 1, b, kvh, qs); attn_load(bb, r, h, kfB, vfB);
            attn_compute(ba, qs, r, h, kfA, vfA, qf, o, m, l);
            if (bi + 2 < 18) { ba = attn_blk(F.ws, bi + 2, b, kvh, qs); attn_load(ba, r, h, kfA, vfA); }
            attn_compute(bb, qs, r, h, kfB, vfB, qf, o, m, l);
        }
#pragma unroll
        for (int nq = 0; nq < 2; ++nq) {
            const float lt = l[nq] + __shfl_xor(l[nq], 32), il = 1.f / lt;
            bf16* orow = MIX + (size_t)(b * L + qs + 32 * nq + r) * 1024 + 512 + hd * 64;
#pragma unroll
            for (int db = 0; db < 2; ++db)
#pragma unroll
                for (int i4 = 0; i4 < 4; ++i4) { u32x2 w; w.x = pkbf(o[db][nq][4 * i4] * il, o[db][nq][4 * i4 + 1] * il); w.y = pkbf(o[db][nq][4 * i4 + 2] * il, o[db][nq][4 * i4 + 3] * il);
                    *(u32x2*)(orow + 32 * db + 8 * i4 + 4 * h) = w; }
        }
    }
}


__device__ __forceinline__ float half_max(float v) { const auto r = __builtin_amdgcn_permlane32_swap(__float_as_uint(v), __float_as_uint(v), false, false); return fmaxf(__uint_as_float(r[0]), __uint_as_float(r[1])); }
__device__ __forceinline__ float half_sum(float v) { const auto r = __builtin_amdgcn_permlane32_swap(__float_as_uint(v), __float_as_uint(v), false, false); return __uint_as_float(r[0]) + __uint_as_float(r[1]); }
constexpr int AT_KP = 72, AT_VP = 136;
constexpr int AT_KB = 128 * AT_KP * 2, AT_BUF = AT_KB + 64 * AT_VP * 2;
struct AtChunk { const bf16* kg; const bf16* vg; int vpitch, lc, b, kvh, qb, c; bool valid, local, any; };
__device__ __forceinline__ AtChunk at_chunk(const unsigned char* ws, int seq, int wg, int G) {
    AtChunk k; const int item = wg + (seq / 5) * G; k.c = seq % 5; k.any = item < NB * 2 * 64;
    k.qb = item & 63; k.kvh = (item >> 6) & 1; k.b = (item >> 7) & 3; k.local = k.c >= 2; k.lc = k.c - 2;
    if (!k.local) { k.valid = k.any; k.vpitch = CL; k.kg = (const bf16*)(ws + WS_CK) + (size_t)(k.b * CL + 128 * k.c) * 128 + k.kvh * 64; k.vg = (const bf16*)(ws + WS_CV) + (size_t)(k.b * 2 + k.kvh) * 64 * CL + 128 * k.c; }
    else { const int key0 = 128 * k.qb - 128 + 128 * k.lc; k.valid = k.any && key0 >= 0 && key0 < L; k.vpitch = L;
        k.kg = (const bf16*)(ws + WS_K) + (size_t)(k.b * L + key0) * 128 + k.kvh * 64; k.vg = (const bf16*)(ws + WS_V) + (size_t)(k.b * 2 + k.kvh) * 64 * L + key0; }
    return k;
}
__device__ __forceinline__ void at_issue(const AtChunk& k, int tid, u32x4 (&rg)[4]) {
    if (k.valid) {
#pragma unroll
        for (int i = 0; i < 2; ++i) { const int id = tid + 512 * i; rg[i] = *(const u32x4*)(k.kg + (size_t)(id >> 3) * 128 + (id & 7) * 8); }
#pragma unroll
        for (int i = 0; i < 2; ++i) { const int id = tid + 512 * i; rg[2 + i] = *(const u32x4*)(k.vg + (size_t)(id >> 4) * k.vpitch + (id & 15) * 8); }
    }
}
__device__ __forceinline__ void at_write(const AtChunk& k, LAS unsigned char* buf, int tid, const u32x4 (&rg)[4]) {
    if (k.valid) {
#pragma unroll
        for (int i = 0; i < 2; ++i) { const int id = tid + 512 * i; *(LAS u32x4*)(buf + (id >> 3) * (AT_KP * 2) + (id & 7) * 16) = rg[i]; }
#pragma unroll
        for (int i = 0; i < 2; ++i) { const int id = tid + 512 * i; *(LAS u32x4*)(buf + AT_KB + (id >> 4) * (AT_VP * 2) + (id & 15) * 16) = rg[2 + i]; }
    }
}
__device__ __forceinline__ void at_load(LAS unsigned char* buf, int blk, int r, int h, bf16x8 (&kf)[4], u32x4 (&vf)[2][2]) {
#pragma unroll
    for (int s2 = 0; s2 < 4; ++s2) kf[s2] = *(const LAS bf16x8*)(buf + (32 * blk + r) * (AT_KP * 2) + (16 * s2 + 8 * h) * 2);
#pragma unroll
    for (int db = 0; db < 2; ++db)
#pragma unroll
        for (int ks = 0; ks < 2; ++ks) { const LAS unsigned char* vr = buf + AT_KB + (32 * db + r) * (AT_VP * 2) + (32 * blk + 16 * ks + 4 * h) * 2;
            const u32x2 lo = *(const LAS u32x2*)vr, hi = *(const LAS u32x2*)(vr + 16); vf[db][ks] = (u32x4){lo.x, lo.y, hi.x, hi.y}; }
}
__device__ __forceinline__ void at_math(const bf16x8 (&kf)[4], const u32x4 (&vf)[2][2], bool masked, int kbrel, int r, int h, const bf16x8 (&qf)[2][4], f32x16 (&o)[2][2], float (&m)[2], float (&l)[2]) {
    constexpr float C = 0.125f * 1.4426950408889634f;
#pragma unroll
    for (int nq = 0; nq < 2; ++nq) {
        f32x16 st;
#pragma unroll
        for (int i = 0; i < 16; ++i) st[i] = 0.f;
#pragma unroll
        for (int s2 = 0; s2 < 4; ++s2) st = __builtin_amdgcn_mfma_f32_32x32x16_bf16(kf[s2], qf[nq][s2], st, 0, 0, 0);
        if (masked) { const int dbase = kbrel - 32 * nq - r + 4 * h;
#pragma unroll
            for (int i = 0; i < 16; ++i) { const int df = dbase + (i & 3) + 8 * (i >> 2); st[i] = (df >= -128 && df <= 128) ? st[i] : -INFINITY; } }
        float smax = st[0];
#pragma unroll
        for (int i = 1; i < 16; ++i) smax = fmaxf(smax, st[i]);
        smax = half_max(smax);
        const float mn = fmaxf(m[nq], smax * C), alpha = __builtin_amdgcn_exp2f(m[nq] - mn); m[nq] = mn;
        float t[16]; float ps = 0.f;
#pragma unroll
        for (int i = 0; i < 16; ++i) { t[i] = __builtin_amdgcn_exp2f(__builtin_fmaf(st[i], C, -mn)); ps += t[i]; }
        l[nq] = l[nq] * alpha + ps;
        if (__ballot(alpha != 1.f)) {
#pragma unroll
            for (int i = 0; i < 16; ++i) { o[0][nq][i] *= alpha; o[1][nq][i] *= alpha; } }
        bf16x8 pf[2];
#pragma unroll
        for (int ks = 0; ks < 2; ++ks) { const u32x4 w = {pkbf(t[8 * ks], t[8 * ks + 1]), pkbf(t[8 * ks + 2], t[8 * ks + 3]), pkbf(t[8 * ks + 4], t[8 * ks + 5]), pkbf(t[8 * ks + 6], t[8 * ks + 7])};
            pf[ks] = __builtin_bit_cast(bf16x8, w); }
#pragma unroll
        for (int db = 0; db < 2; ++db)
#pragma unroll
            for (int ks = 0; ks < 2; ++ks) o[db][nq] = __builtin_amdgcn_mfma_f32_32x32x16_bf16(__builtin_bit_cast(bf16x8, vf[db][ks]), pf[ks], o[db][nq], 0, 0, 0);
    }
}
__device__ __forceinline__ void phase_attn_lds(Frame& F) {
    const bf16* Q = (const bf16*)(F.ws + WS_Q); bf16* MIX = (bf16*)(F.ws + WS_MIX);
    const int g = F.wave >> 1, half = F.wave & 1, r = F.lane & 31, h = F.lane >> 5;
    __syncthreads();
    u32x4 rg[4];
    AtChunk ck = at_chunk(F.ws, 0, F.wg, F.G);
    if (!ck.any) return;
    at_issue(ck, F.tid, rg); at_write(ck, F.lds, F.tid, rg);
    __syncthreads();
    bf16x8 qf[2][4]; f32x16 o[2][2]; float m[2], l[2];
#pragma unroll 1
    for (int seq = 0; ck.any; ++seq) {
        LAS unsigned char* buf = F.lds + (seq & 1) * AT_BUF;
        const TItem ti = t_decode(F, seq < 10 ? 640 + (F.wg * NWAVES + F.wave) + seq * (F.G * NWAVES) : (1 << 30));
        t_dma(ti, F.lds + 2 * AT_BUF + F.wave * 8704, F.lane);
        const AtChunk nk = at_chunk(F.ws, seq + 1, F.wg, F.G);
        at_issue(nk, F.tid, rg);
        const int hd = ck.kvh * 4 + g, qs = ck.qb * 128 + half * 64;
        if (ck.c == 0) {
#pragma unroll
            for (int nq = 0; nq < 2; ++nq)
#pragma unroll
                for (int s2 = 0; s2 < 4; ++s2) qf[nq][s2] = *(const bf16x8*)(Q + (size_t)(ck.b * L + qs + 32 * nq + r) * 512 + hd * 64 + 16 * s2 + 8 * h);
#pragma unroll
            for (int db = 0; db < 2; ++db)
#pragma unroll
                for (int nq = 0; nq < 2; ++nq)
#pragma unroll
                    for (int i = 0; i < 16; ++i) o[db][nq][i] = 0.f;
            m[0] = m[1] = F.in[I_SINK][hd] * 1.4426950408889634f; l[0] = l[1] = (h == 0) ? 1.f : 0.f;
        }
        if (ck.valid) {
            int b0 = 0, b1 = 4;
            if (ck.local) { b0 = 2 * half - 4 * ck.lc; b0 = b0 < 0 ? 0 : b0; b1 = 2 * half + 10 - 4 * ck.lc; b1 = b1 > 4 ? 4 : b1; }
            if (b0 < b1) {
                bf16x8 kfA[4], kfB[4]; u32x4 vfA[2][2], vfB[2][2];
                at_load(buf, b0, r, h, kfA, vfA);
#pragma unroll 1
                for (int blk = b0; blk < b1; blk += 2) {
                    const int iA = 4 * ck.lc + blk - 2 * half, iB = iA + 1;
                    if (blk + 1 < b1) at_load(buf, blk + 1, r, h, kfB, vfB);
                    at_math(kfA, vfA, ck.local && (iA < 2 || iA > 7), 32 * iA - 128, r, h, qf, o, m, l);
                    if (blk + 1 < b1) {
                        if (blk + 2 < b1) at_load(buf, blk + 2, r, h, kfA, vfA);
                        at_math(kfB, vfB, ck.local && (iB < 2 || iB > 7), 32 * iB - 128, r, h, qf, o, m, l);
                    }
                }
            }
        }
        if (ck.c == 4) {
#pragma unroll
            for (int nq = 0; nq < 2; ++nq) {
                const float lt = half_sum(l[nq]), il = __builtin_amdgcn_rcpf(lt);
                bf16* orow = MIX + (size_t)(ck.b * L + qs + 32 * nq + r) * 1024 + 512 + hd * 64;
#pragma unroll
                for (int db = 0; db < 2; ++db)
#pragma unroll
                    for (int i4 = 0; i4 < 4; ++i4) { u32x2 w; w.x = pkbf(o[db][nq][4 * i4] * il, o[db][nq][4 * i4 + 1] * il); w.y = pkbf(o[db][nq][4 * i4 + 2] * il, o[db][nq][4 * i4 + 3] * il);
                        *(u32x2*)(orow + 32 * db + 8 * i4 + 4 * h) = w; }
            }
        }
        if (ti.ok) { asm volatile("s_waitcnt vmcnt(0)" ::: "memory"); t_store_dma(ti, (const LAS float*)(F.lds + 2 * AT_BUF + F.wave * 8704), F.lane); }
        at_write(nk, F.lds + ((seq + 1) & 1) * AT_BUF, F.tid, rg);
        __syncthreads();
        ck = nk;
    }
}

constexpr int F1_PC = 136, F1_PW = 68, F2_P = 264;
constexpr int F1_CSC = 0, F1_CSS = 128 * F1_PC * 2, F1_C64 = 2 * 128 * F1_PC * 2, F1_S64 = F1_C64 + 64 * F1_PW * 2;
__device__ __forceinline__ bf16x8 pack8(float a0, float a1, float a2, float a3, float a4, float a5, float a6, float a7) {
    const u32x4 w = {pkbf(a0, a1), pkbf(a2, a3), pkbf(a4, a5), pkbf(a6, a7)}; return __builtin_bit_cast(bf16x8, w); }
__device__ __forceinline__ void phase_fft1_mfma(Frame& F) {
    __syncthreads();
    LAS bf16* csc = (LAS bf16*)(F.lds + F1_CSC); LAS bf16* css = (LAS bf16*)(F.lds + F1_CSS); LAS bf16* c64 = (LAS bf16*)(F.lds + F1_C64); LAS bf16* s64 = (LAS bf16*)(F.lds + F1_S64);
    for (int i = F.tid; i < 128 * 128; i += NTHR) { const int n = i >> 7, k = i & 127; const float ang = (float)((n * k) & 127) * (6.283185307179586f / 128.f);
        csc[n * F1_PC + k] = (bf16)f2bf(__cosf(ang)); css[n * F1_PC + k] = (bf16)f2bf(__sinf(ang)); }
    for (int i = F.tid; i < 64 * 64; i += NTHR) { const int c = i >> 6, a = i & 63; const float ang = (float)((c * a) & 63) * (6.283185307179586f / 64.f);
        c64[c * F1_PW + a] = (bf16)f2bf(__cosf(ang)); s64[c * F1_PW + a] = (bf16)f2bf(__sinf(ang)); }
    __syncthreads();
    const bf16* UF = (const bf16*)(F.ws + WS_UF); bf16* Gb = (bf16*)(F.ws + WS_G);
    const int r = F.lane & 31, h = F.lane >> 5, g = F.wave >> 1;
    for (int item = F.wg; item < NB * FN2; item += F.G) {
        const int b = item >> 7, bp = item & 127;
        bf16x8 uf[2][8];
#pragma unroll
        for (int rb = 0; rb < 2; ++rb)
#pragma unroll
            for (int s2 = 0; s2 < 8; ++s2) uf[rb][s2] = *(const bf16x8*)(UF + (size_t)(b * L + 128 * (32 * rb + r) + bp) * 512 + g * 128 + 16 * s2 + 8 * h);
#pragma unroll 1
        for (int q = 0; q < 2; ++q) {
            const int cbk = 2 * F.wave + q, n = 32 * (cbk & 3) + r, ch = 32 * cbk + r;
            f32x16 zr[2], zi[2];
#pragma unroll
            for (int rb = 0; rb < 2; ++rb) {
#pragma unroll
                for (int i = 0; i < 16; ++i) { zr[rb][i] = 0.f; zi[rb][i] = 0.f; }
#pragma unroll
                for (int s2 = 0; s2 < 8; ++s2) { const bf16x8 bc = *(const LAS bf16x8*)(csc + n * F1_PC + 16 * s2 + 8 * h), bs = *(const LAS bf16x8*)(css + n * F1_PC + 16 * s2 + 8 * h);
                    zr[rb] = __builtin_amdgcn_mfma_f32_32x32x16_bf16(uf[rb][s2], bc, zr[rb], 0, 0, 0); zi[rb] = __builtin_amdgcn_mfma_f32_32x32x16_bf16(uf[rb][s2], bs, zi[rb], 0, 0, 0); }
                __builtin_amdgcn_sched_barrier(0);
            }
            bf16x8 zfr[4], zfi[4];
#pragma unroll
            for (int ks = 0; ks < 4; ++ks) { const int rb = ks >> 1, o = 8 * (ks & 1);
                zfr[ks] = pack8(zr[rb][o], zr[rb][o + 1], zr[rb][o + 2], zr[rb][o + 3], zr[rb][o + 4], zr[rb][o + 5], zr[rb][o + 6], zr[rb][o + 7]);
                zfi[ks] = pack8(-zi[rb][o], -zi[rb][o + 1], -zi[rb][o + 2], -zi[rb][o + 3], -zi[rb][o + 4], -zi[rb][o + 5], -zi[rb][o + 6], -zi[rb][o + 7]); }
            __builtin_amdgcn_sched_barrier(0);
#pragma unroll 1
            for (int rbc = 0; rbc < 2; ++rbc) {
                f32x16 gr, gi; const int cr = 32 * rbc + r;
#pragma unroll
                for (int i = 0; i < 16; ++i) { gr[i] = 0.f; gi[i] = 0.f; }
#pragma unroll
                for (int ks = 0; ks < 4; ++ks) {
                    const u32x2 cl = *(const LAS u32x2*)(c64 + cr * F1_PW + 16 * ks + 4 * h), chh = *(const LAS u32x2*)(c64 + cr * F1_PW + 16 * ks + 8 + 4 * h);
                    const u32x2 sl = *(const LAS u32x2*)(s64 + cr * F1_PW + 16 * ks + 4 * h), shh = *(const LAS u32x2*)(s64 + cr * F1_PW + 16 * ks + 8 + 4 * h);
                    const u32x4 sw = {sl.x, sl.y, shh.x, shh.y}; const u32x4 swn = sw ^ 0x80008000u;
                    const bf16x8 wc = __builtin_bit_cast(bf16x8, ((u32x4){cl.x, cl.y, chh.x, chh.y})), wsn = __builtin_bit_cast(bf16x8, sw), wsm = __builtin_bit_cast(bf16x8, swn);
                    gr = __builtin_amdgcn_mfma_f32_32x32x16_bf16(wc, zfr[ks], gr, 0, 0, 0); gr = __builtin_amdgcn_mfma_f32_32x32x16_bf16(wsn, zfi[ks], gr, 0, 0, 0);
                    gi = __builtin_amdgcn_mfma_f32_32x32x16_bf16(wc, zfi[ks], gi, 0, 0, 0); gi = __builtin_amdgcn_mfma_f32_32x32x16_bf16(wsm, zfr[ks], gi, 0, 0, 0); }
                __builtin_amdgcn_sched_barrier(0);
#pragma unroll
                for (int i = 0; i < 16; ++i) { const int c = 32 * rbc + crow(i, h); const float ang = (float)(bp * c) * (6.283185307179586f / 8192.f), cs = __cosf(ang), sn = __sinf(ang);
                    const float re = gr[i] * cs + gi[i] * sn, im = gi[i] * cs - gr[i] * sn;
                    bf16* o = Gb + (size_t)((b * FN1 + c) * FN2 + bp) * 1024 + ch; o[0] = (bf16)f2bf(re); o[512] = (bf16)f2bf(im);
                    if ((i & 3) == 3) __builtin_amdgcn_sched_barrier(0); }
            }
        }
    }
    __syncthreads();
}
__device__ __forceinline__ void phase_fft2_mfma(Frame& F) {
    __syncthreads();
    LAS bf16* t2 = (LAS bf16*)F.lds;
    for (int i = F.tid; i < 128 * 256; i += NTHR) { const int d = i >> 8, k = i & 255; const float ang = (float)((d * (k & 127)) & 127) * (6.283185307179586f / 128.f);
        t2[d * F2_P + k] = (bf16)f2bf(k < 128 ? __cosf(ang) : __sinf(ang)); }
    __syncthreads();
    const bf16* Gb = (const bf16*)(F.ws + WS_G); bf16* MIX = (bf16*)(F.ws + WS_MIX);
    const int r = F.lane & 31, h = F.lane >> 5;
    for (int item = F.wg; item < NB * FN1; item += F.G) {
        const int b = item >> 6, c = item & 63;
        const bf16* Gp = Gb + (size_t)((b * FN1 + c) * FN2) * 1024 + 64 * F.wave + r;
        f32x16 y[4][2];
#pragma unroll
        for (int rb = 0; rb < 4; ++rb)
#pragma unroll
            for (int cb = 0; cb < 2; ++cb)
#pragma unroll
                for (int i = 0; i < 16; ++i) y[rb][cb][i] = 0.f;
        unsigned eA[2][8], eB[2][8], eC[2][8], eD[2][8];
#define F2_GATHER(dst, ks_) do { const bf16* p_ = Gp + (size_t)(16 * ((ks_) & 7) + 8 * h) * 1024 + ((ks_) >> 3) * 512; \
            _Pragma("unroll") for (int cb = 0; cb < 2; ++cb) _Pragma("unroll") for (int j = 0; j < 8; ++j) dst[cb][j] = p_[(size_t)j * 1024 + 32 * cb]; } while (0)
#define F2_MMA(src, ks_) do { bf16x8 bfr[2]; _Pragma("unroll") for (int cb = 0; cb < 2; ++cb) { \
                const u32x4 w = {src[cb][0] | (src[cb][1] << 16), src[cb][2] | (src[cb][3] << 16), src[cb][4] | (src[cb][5] << 16), src[cb][6] | (src[cb][7] << 16)}; bfr[cb] = __builtin_bit_cast(bf16x8, w); } \
            _Pragma("unroll") for (int rb = 0; rb < 4; ++rb) { const bf16x8 a = *(const LAS bf16x8*)(t2 + (32 * rb + r) * F2_P + 16 * (ks_) + 8 * h); \
                _Pragma("unroll") for (int cb = 0; cb < 2; ++cb) y[rb][cb] = __builtin_amdgcn_mfma_f32_32x32x16_bf16(a, bfr[cb], y[rb][cb], 0, 0, 0); } } while (0)
        F2_GATHER(eA, 0); F2_GATHER(eB, 1); F2_GATHER(eC, 2);
#pragma unroll 1
        for (int ks = 0; ks < 16; ks += 4) {
            F2_GATHER(eD, ks + 3);
            F2_MMA(eA, ks);
            if (ks + 4 < 16) F2_GATHER(eA, ks + 4);
            F2_MMA(eB, ks + 1);
            if (ks + 4 < 16) F2_GATHER(eB, ks + 5);
            F2_MMA(eC, ks + 2);
            if (ks + 4 < 16) F2_GATHER(eC, ks + 6);
            F2_MMA(eD, ks + 3);
        }
#undef F2_GATHER
#undef F2_MMA
#pragma unroll
        for (int rb = 0; rb < 4; ++rb)
#pragma unroll
            for (int cb = 0; cb < 2; ++cb)
#pragma unroll
                for (int i = 0; i < 16; ++i) { const int d = 32 * rb + crow(i, h); MIX[(size_t)(b * L + c + 64 * d) * 1024 + 64 * F.wave + 32 * cb + r] = (bf16)f2bf(y[rb][cb][i] * (1.f / 1024.f)); }
    }
    __syncthreads();
}


typedef float f32x2_t __attribute__((ext_vector_type(2)));
template <int CTRL> __device__ __forceinline__ float dppf(float v) { return __uint_as_float((unsigned)__builtin_amdgcn_update_dpp(0, (int)__float_as_uint(v), CTRL, 0xf, 0xf, true)); }
__device__ __forceinline__ float swap32_add(float a, float b) { const auto r = __builtin_amdgcn_permlane32_swap(__float_as_uint(a), __float_as_uint(b), false, false); return __uint_as_float(r[0]) + __uint_as_float(r[1]); }
__device__ __forceinline__ float swap16_add(float a, float b) { const auto r = __builtin_amdgcn_permlane16_swap(__float_as_uint(a), __float_as_uint(b), false, false); return __uint_as_float(r[0]) + __uint_as_float(r[1]); }
template <int CTRL> __device__ __forceinline__ float sel_add(float a, float b, bool hi) { const float t = hi ? b : a, u = hi ? a : b; return t + dppf<CTRL>(u); }
template <int IR> struct DwIn {
    static __device__ __forceinline__ void run(const unsigned (&uin)[62], const f32x2_t (&w)[31], f32x2_t (&o)[32]) {
        const f32x2_t x = {bflo(uin[IR]), bfhi(uin[IR])};
#pragma unroll
        for (int r = 0; r < 32; ++r) { if (IR - r >= 0 && IR - r <= 30) o[r] += w[(IR - r >= 0 && IR - r <= 30) ? IR - r : 0] * x; }
        DwIn<IR + 1>::run(uin, w, o);
    }
};
template <> struct DwIn<62> { static __device__ __forceinline__ void run(const unsigned (&)[62], const f32x2_t (&)[31], f32x2_t (&)[32]) {} };
template <int IR> struct DwIn16 {
    static __device__ __forceinline__ void run(const unsigned (&uin)[46], const f32x2_t (&w)[31], f32x2_t (&o)[16]) {
        const f32x2_t x = {bflo(uin[IR]), bfhi(uin[IR])};
#pragma unroll
        for (int r = 0; r < 16; ++r) { if (IR - r >= 0 && IR - r <= 30) o[r] += w[(IR - r >= 0 && IR - r <= 30) ? IR - r : 0] * x; }
        DwIn16<IR + 1>::run(uin, w, o);
    }
};
template <> struct DwIn16<46> { static __device__ __forceinline__ void run(const unsigned (&)[46], const f32x2_t (&)[31], f32x2_t (&)[16]) {} };
__device__ __forceinline__ void phase_dwconv_fast(Frame& F) {
    const bf16* U = (const bf16*)(F.ws + WS_U); bf16* V1 = (bf16*)(F.ws + WS_V1);
    const float* dww = F.in[I_DWW];
    const int c0 = 2 * F.tid;
    f32x2_t w[31];
#pragma unroll
    for (int j = 0; j < 31; ++j) w[j] = *(const f32x2_t*)(dww + (size_t)j * D + c0);
    const f32x2_t bb = *(const f32x2_t*)(F.in[I_DWB] + c0), gg = *(const f32x2_t*)(F.in[I_LNG] + c0), lb = *(const f32x2_t*)(F.in[I_LNB] + c0);
    LAS float* red = (LAS float*)F.lds;
    LAS float* stat = red + 16 * 8 * 2;
    __syncthreads();
    for (int run = F.wg; run < T / 128; run += F.G) {
        const int row0 = run * 128, l0 = row0 & (L - 1);
        unsigned uin[46], nx[16];
#pragma unroll
        for (int ir = 0; ir < 46; ++ir) { const int l = l0 - 15 + ir; const bool ok = (l >= 0 && l < L);
            const unsigned u = *(const unsigned*)(U + (size_t)(ok ? row0 - 15 + ir : row0) * D + c0); uin[ir] = ok ? u : 0u; }
#pragma unroll 1
        for (int step = 0; step < 8; ++step) {
            const int r0 = row0 + 16 * step;
            if (step < 7) {
#pragma unroll
                for (int j = 0; j < 16; ++j) { const int l = l0 + 16 * step + 31 + j; const bool ok = l < L;
                    const unsigned u = *(const unsigned*)(U + (size_t)(ok ? r0 + 31 + j : r0) * D + c0); nx[j] = ok ? u : 0u; }
            }
            f32x2_t o[16];
#pragma unroll
            for (int r = 0; r < 16; ++r) o[r] = bb;
            DwIn16<0>::run(uin, w, o);
            {
                float W[16], X[8], Y[4], Z2[2];
#pragma unroll
                for (int i = 0; i < 16; ++i) W[i] = swap32_add(o[i].x + o[i].y, o[i].x * o[i].x + o[i].y * o[i].y);
#pragma unroll
                for (int i = 0; i < 8; ++i) X[i] = swap16_add(W[2 * i], W[2 * i + 1]);
                const bool b3 = (F.lane & 8) != 0, b2 = (F.lane & 4) != 0, b1 = (F.lane & 2) != 0;
#pragma unroll
                for (int i = 0; i < 4; ++i) Y[i] = sel_add<0x140>(X[2 * i], X[2 * i + 1], b3);
#pragma unroll
                for (int i = 0; i < 2; ++i) Z2[i] = sel_add<0x141>(Y[2 * i], Y[2 * i + 1], b2);
                float Z = sel_add<0x4E>(Z2[0], Z2[1], b1);
                Z += dppf<0xB1>(Z);
                const int rr = ((F.lane >> 4) & 1) + ((F.lane >> 3) & 1) * 2 + ((F.lane >> 2) & 1) * 4 + ((F.lane >> 1) & 1) * 8;
                if (!(F.lane & 1)) red[(rr * 8 + F.wave) * 2 + (F.lane >> 5)] = Z;
            }
            __syncthreads();
            if (F.tid < 16) { float sm = 0.f, sq = 0.f;
#pragma unroll
                for (int wv = 0; wv < 8; ++wv) { sm += red[(F.tid * 8 + wv) * 2]; sq += red[(F.tid * 8 + wv) * 2 + 1]; }
                const float mean = sm * (1.f / D), var = fmaxf(sq * (1.f / D) - mean * mean, 0.f);
                stat[2 * F.tid] = mean; stat[2 * F.tid + 1] = rsqrtf(var + EPS); }
            __syncthreads();
#pragma unroll
            for (int r = 0; r < 16; ++r) { const float mean = stat[2 * r], rstd = stat[2 * r + 1];
                const f32x2_t A = gg * rstd, B = lb - A * mean, y = o[r] * A + B;
                *(unsigned*)(V1 + (size_t)(r0 + r) * D + c0) = pkbf(silu_f(y.x), silu_f(y.y)); }
#pragma unroll
            for (int i = 0; i < 30; ++i) uin[i] = uin[i + 16];
#pragma unroll
            for (int j = 0; j < 16; ++j) uin[30 + j] = nx[j];
        }
        __syncthreads();
    }
}

namespace pg {
struct MU { const char* B; const char* A; int K, type, e, rt, pn, hb, buf; };
struct MoeMergedSched {
    const char* Wgu; const char* Wdn; const char* HBp; const char* HIDp; const int* list; const float* wlist; LAS int* mm; unsigned* tcnt; unsigned* tmo; int G, c, U;
    __device__ __forceinline__ bool flat(int L, int type, MU& u) const {
        for (int e = 0; e < 16; ++e) { const int n = mm[e], nu = ((n + 255) >> 8) * 4;
            if (L < nu) { u.e = e; u.rt = L >> 2; u.pn = L & 3; u.hb = mm[16 + e]; u.type = type; u.buf = 0;
                if (type == 0) { u.K = D; u.A = HBp; u.B = Wgu + (size_t)e * (1024 * 1024 * 2) + (size_t)u.pn * BM * D * 2; }
                else { u.K = FF; u.A = HIDp; u.B = Wdn + (size_t)e * (1024 * 512 * 2) + (size_t)u.pn * BM * FF * 2; }
                return true; }
            L -= nu; }
        return false;
    }
    __device__ __forceinline__ bool next(int i, MU& u) const {
        const int ngu = c < U ? (U - 1 - c) / G + 1 : 0;
        if (i < ngu) return flat(i * G + c, 0, u);
        const int k = i - ngu, x = U % G; int j;
        if (c >= x) { if (k == 0) j = c - x; else j = (G - 1 - c) + (k - 1) * G + (G - x); } else j = (G - 1 - c) + k * G + (G - x);
        if (j >= U) return false;
        return flat(j, 1, u);
    }
    __device__ __forceinline__ unsigned voff(const MU& u, int buf, LAS unsigned char* lds, int R, int C) const {
        if (u.type == 0) { const int tok = ((const LAS int*)(lds + TAB_OFF))[buf * 256 + R]; return (unsigned)((tok * D + C) * 2); }
        return (unsigned)(((u.hb + u.rt * BM + R) * FF + C) * 2);
    }
    __device__ __forceinline__ void stage_table(const MU& u, int buf, LAS unsigned char* lds, int wid, int lane) const {
        const int r = (wid & 3) * 64 + lane;
        __builtin_amdgcn_global_load_lds((const unsigned*)(list + u.e * CAP + u.rt * BM + r), (LAS unsigned*)(lds + TAB_OFF + buf * 1024 + (wid & 3) * 256), 4, 0, 0);
        __builtin_amdgcn_global_load_lds((const unsigned*)(wlist + u.e * CAP + u.rt * BM + r), (LAS unsigned*)(lds + TAB_OFF + 2048 + buf * 1024 + (wid & 3) * 256), 4, 0, 0);
    }
    __device__ __forceinline__ unsigned* tile_word(const MU& u) const { return tcnt + ((u.hb >> 8) + u.rt) * 64; }
    __device__ __forceinline__ void wait_ready(const MU& u, int wid) const {
        if (wid == 0) {
            unsigned* w = tile_word(u); unsigned spins = 0;
            while ((unsigned)__builtin_amdgcn_readfirstlane(__hip_atomic_load(w, __ATOMIC_RELAXED, __HIP_MEMORY_SCOPE_AGENT)) < 32u) {
                __builtin_amdgcn_s_sleep(2);
                if ((++spins & 255u) == 0u) { if (__builtin_amdgcn_readfirstlane(__hip_atomic_load(tmo, __ATOMIC_RELAXED, __HIP_MEMORY_SCOPE_AGENT)) != 0u) break;
                    if (spins > (1u << 20)) { __hip_atomic_store(tmo, 1u, __ATOMIC_RELAXED, __HIP_MEMORY_SCOPE_AGENT); break; } } }
        }
        asm volatile("" ::: "memory"); __builtin_amdgcn_s_barrier(); asm volatile("" ::: "memory");
    }
};
struct EpiGateUpWT {
    __amdgpu_buffer_rsrc_t rsrc; LAS unsigned char* lds; LAS int* mm;
    __device__ __forceinline__ void operator()(const f32x4 (&acc)[2][2][4][2], const MU& u, int wr, int wc, int fr, int fq) const {
        const int e = u.e, n_e = mm[e], r0 = u.rt * BM + wr * 64 + fr, col0 = u.pn * HALF + wc * 32 + 8 * fq;
        float wv[2][4];
#pragma unroll
        for (int ai = 0; ai < 2; ++ai)
#pragma unroll
            for (int m = 0; m < 4; ++m) wv[ai][m] = ((const LAS float*)(lds + TAB_OFF + 2048))[u.buf * 256 + wr * 64 + fr + ai * HALF + m * 16];
#pragma unroll
        for (int ai = 0; ai < 2; ++ai)
#pragma unroll
            for (int m = 0; m < 4; ++m) { const int r = r0 + ai * HALF + m * 16;
                if (r < n_e) { const float w = wv[ai][m]; f32x4 o[2];
#pragma unroll
                    for (int n = 0; n < 2; ++n) { const f32x4 g = acc[ai][0][m][n], up = acc[ai][1][m][n];
#pragma unroll
                        for (int j = 0; j < 4; ++j) o[n][j] = w * silu_f(g[j]) * up[j]; }
                    u32x4 q; q.x = cvt_pk_bf16(o[0][0], o[0][1]); q.y = cvt_pk_bf16(o[0][2], o[0][3]); q.z = cvt_pk_bf16(o[1][0], o[1][1]); q.w = cvt_pk_bf16(o[1][2], o[1][3]);
                    __builtin_amdgcn_raw_buffer_store_b128(q, rsrc, (unsigned)(((u.hb + r) * FF + col0) * 2), 0, 16); } }
    }
};
struct EpiDownM {
    unsigned char* Y8; LAS int* mm;
    __device__ __forceinline__ void operator()(const f32x4 (&acc)[2][2][4][2], const MU& u, int wr, int wc, int fr, int fq) const {
        const int e = u.e, n_e = mm[e], r0 = u.rt * BM + wr * 64 + fr, col0 = u.pn * BM + 64 * wc + 16 * fq;
#pragma unroll
        for (int ai = 0; ai < 2; ++ai)
#pragma unroll
            for (int m = 0; m < 4; ++m) { const int r = r0 + ai * HALF + m * 16;
                if (r < n_e) { u32x4 q; q.x = pk_fp8x4(acc[ai][0][m][0]); q.y = pk_fp8x4(acc[ai][0][m][1]); q.z = pk_fp8x4(acc[ai][1][m][0]); q.w = pk_fp8x4(acc[ai][1][m][1]);
                    *(u32x4*)(Y8 + (size_t)(u.hb + r) * D + col0) = q; } }
    }
};
__device__ __forceinline__ void gemm_phase_moe(LAS unsigned char* lds, const MoeMergedSched& S, const EpiGateUpWT& EA, const EpiDownM& EB) {
    const int tid = threadIdx.x, wid = __builtin_amdgcn_readfirstlane(tid >> 6), lane = tid & 63, wr = wid >> 2, wc = wid & 3, fr = lane & 15, fq = lane >> 4;
    int sR[2], sC[2]; unsigned vbA[2], vbD[2];
#pragma unroll
    for (int i = 0; i < 2; ++i) { int R, C; stage_rc(tid * 16 + i * 8192, R, C); sR[i] = R; sC[i] = C; const int Rb = (R & ~31) + perm32(R & 31);
        const int RbD = 64 * ((Rb >> 5) & 3) + 16 * ((Rb >> 3) & 3) + (Rb & 7);
        vbA[i] = (unsigned)(Rb * D + C) * 2u; vbD[i] = (unsigned)(RbD * FF + C) * 2u; }
    const size_t kstep = (size_t)(BK * 2);
    const unsigned ldsw = (unsigned)wid * 1024u;
    const int aoff = lds_byte(wr * 64 + fr, fq * 8), boff = lds_byte(wc * 32 + fr, fq * 8);
#define PG_SA(b, h) (((b) * 2 + (h)) * HTB)
#define PG_SB(b, h) ((4 + (b) * 2 + (h)) * HTB)
#define PG_STAGE(bufoff, gbase, voff) do { _Pragma("unroll") for (int _i = 0; _i < 2; ++_i) \
        __builtin_amdgcn_global_load_lds((const unsigned*)((const char*)(gbase) + (voff)[_i]), (LAS unsigned*)(lds + (bufoff) + ldsw + _i * 8192), 16, 0, 0); } while (0)
#define PG_LDA(dst, b, h) do { _Pragma("unroll") for (int m = 0; m < 4; ++m) _Pragma("unroll") for (int k = 0; k < 2; ++k) dst[m][k] = *(const LAS bf16x8*)(lds + PG_SA(b, h) + aoff + m * 2048 + k * 1024); } while (0)
#define PG_LDB(dst, b, h) do { _Pragma("unroll") for (int n = 0; n < 2; ++n) _Pragma("unroll") for (int k = 0; k < 2; ++k) dst[n][k] = *(const LAS bf16x8*)(lds + PG_SB(b, h) + boff + n * 2048 + k * 1024); } while (0)
#define PG_MMA(ai, bj, At, Bt) do { __builtin_amdgcn_s_setprio(1); _Pragma("unroll") for (int m = 0; m < 4; ++m) _Pragma("unroll") for (int n = 0; n < 2; ++n) _Pragma("unroll") for (int k = 0; k < 2; ++k) \
        acc[ai][bj][m][n] = __builtin_amdgcn_mfma_f32_16x16x32_bf16(Bt[n][k], At[m][k], acc[ai][bj][m][n], 0, 0, 0); __builtin_amdgcn_s_setprio(0); } while (0)
#define PG_WAIT_V(n) asm volatile("s_waitcnt vmcnt(" #n ")" ::: "memory")
#define PG_WAIT_L(n) asm volatile("s_waitcnt lgkmcnt(" #n ")" ::: "memory")
#define PG_BAR __builtin_amdgcn_s_barrier()
#define PG_SCHED __builtin_amdgcn_sched_barrier(0)
    MU cur, nxt; int ui = 0;
    if (!S.next(0, cur)) return;
    cur.buf = 0;
    f32x4 acc[2][2][4][2];
#pragma unroll
    for (int a = 0; a < 2; ++a)
#pragma unroll
        for (int b = 0; b < 2; ++b)
#pragma unroll
            for (int m = 0; m < 4; ++m)
#pragma unroll
                for (int n = 0; n < 2; ++n) acc[a][b][m][n] = (f32x4){0.f, 0.f, 0.f, 0.f};
    bf16x8 At[4][2], B0[2][2], B1[2][2];
    if (cur.type == 0) { S.stage_table(cur, 0, lds, wid, lane); PG_WAIT_V(0); PG_BAR; } else S.wait_ready(cur, wid);
    unsigned voC[2][2], voN[2][2];
#pragma unroll
    for (int h = 0; h < 2; ++h)
#pragma unroll
        for (int i = 0; i < 2; ++i) { voC[h][i] = S.voff(cur, 0, lds, h * HALF + sR[i], sC[i]); voN[h][i] = voC[h][i]; }
    const char* cB = cur.B; const char* cA = cur.A; size_t hsC = (size_t)(cur.type == 0 ? HALF : 8) * cur.K * 2; int nt = cur.K / BK;
    if (cur.type == 0) { PG_STAGE(PG_SB(0, 0), cB, vbA); PG_STAGE(PG_SB(0, 1), cB + hsC, vbA); } else { PG_STAGE(PG_SB(0, 0), cB, vbD); PG_STAGE(PG_SB(0, 1), cB + hsC, vbD); }
    PG_STAGE(PG_SA(0, 0), cA, voC[0]); PG_STAGE(PG_SA(0, 1), cA, voC[1]);
    if (wr == 1) PG_BAR;
    PG_WAIT_V(2); PG_BAR;
    if (cur.type == 0) { PG_STAGE(PG_SB(1, 0), cB + kstep, vbA); } else { PG_STAGE(PG_SB(1, 0), cB + kstep, vbD); }
    PG_STAGE(PG_SA(1, 0), cA + kstep, voC[0]);
    if (cur.type == 0) { PG_STAGE(PG_SB(1, 1), cB + hsC + kstep, vbA); } else { PG_STAGE(PG_SB(1, 1), cB + hsC + kstep, vbD); }
    PG_WAIT_V(6); PG_BAR;
    for (;;) {
        const bool has_next = S.next(ui + 1, nxt); nxt.buf = (ui + 1) & 1;
        if (has_next && nxt.type == 0) S.stage_table(nxt, (ui + 1) & 1, lds, wid, lane);
        const char* nB = has_next ? nxt.B : cB; const char* nA = has_next ? nxt.A : cA; const size_t hsN = has_next ? (size_t)(nxt.type == 0 ? HALF : 8) * nxt.K * 2 : hsC;
        for (int t = 0; t < nt; t += 2) {
            const bool last = (t == nt - 2);
            if (last && has_next) {
                if (nxt.type == 1) S.wait_ready(nxt, wid);
#pragma unroll
                for (int h = 0; h < 2; ++h)
#pragma unroll
                    for (int i = 0; i < 2; ++i) voN[h][i] = S.voff(nxt, (ui + 1) & 1, lds, h * HALF + sR[i], sC[i]);
            }
            unsigned vo2[2][2], vb2[2]; const bool b2gu = last ? (has_next ? nxt.type == 0 : cur.type == 0) : (cur.type == 0);
#pragma unroll
            for (int h = 0; h < 2; ++h)
#pragma unroll
                for (int i = 0; i < 2; ++i) vo2[h][i] = last ? voN[h][i] : voC[h][i];
#pragma unroll
            for (int i = 0; i < 2; ++i) vb2[i] = b2gu ? vbA[i] : vbD[i];
            const size_t hs2 = last ? hsN : hsC;
            const char* a1 = cA + (size_t)(t + 1) * kstep;
            const char* a2 = last ? nA : cA + (size_t)(t + 2) * kstep; const char* b2 = last ? nB : cB + (size_t)(t + 2) * kstep;
            const char* a3 = a2 + kstep; const char* b3 = b2 + kstep;
            PG_LDB(B0, 0, 0); PG_LDB(B1, 0, 1); PG_SCHED; PG_LDA(At, 0, 0); PG_STAGE(PG_SA(1, 1), a1, voC[1]);
            PG_WAIT_V(8); PG_WAIT_L(0); PG_BAR; PG_MMA(0, 0, At, B0); PG_MMA(0, 1, At, B1); PG_BAR; PG_SCHED;
            PG_LDA(At, 0, 1); PG_STAGE(PG_SB(0, 0), b2, vb2); PG_STAGE(PG_SB(0, 1), b2 + hs2, vb2); PG_STAGE(PG_SA(0, 0), a2, vo2[0]);
            PG_WAIT_V(8); PG_WAIT_L(0); PG_BAR; PG_MMA(1, 0, At, B0); PG_MMA(1, 1, At, B1); PG_BAR; PG_SCHED;
            PG_LDB(B0, 1, 0); PG_LDB(B1, 1, 1); PG_SCHED; PG_LDA(At, 1, 0); PG_STAGE(PG_SA(0, 1), a2, vo2[1]);
            PG_WAIT_V(8); PG_WAIT_L(0); PG_BAR; PG_MMA(0, 0, At, B0); PG_MMA(0, 1, At, B1); PG_BAR; PG_SCHED;
            PG_LDA(At, 1, 1); PG_STAGE(PG_SB(1, 0), b3, vb2); PG_STAGE(PG_SB(1, 1), b3 + hs2, vb2); PG_STAGE(PG_SA(1, 0), a3, vo2[0]);
            PG_WAIT_V(8); PG_WAIT_L(0); PG_BAR; PG_MMA(1, 0, At, B0); PG_MMA(1, 1, At, B1); PG_BAR; PG_SCHED;
        }
        if (wr == 0) PG_BAR;
        if (cur.type == 0) { EA(acc, cur, wr, wc, fr, fq);
            PG_WAIT_V(0);
            if (lane == 0) __hip_atomic_fetch_add(S.tile_word(cur), 1u, __ATOMIC_RELAXED, __HIP_MEMORY_SCOPE_AGENT); }
        else EB(acc, cur, wr, wc, fr, fq);
        if (!has_next) break;
#pragma unroll
        for (int a = 0; a < 2; ++a)
#pragma unroll
            for (int b = 0; b < 2; ++b)
#pragma unroll
                for (int m = 0; m < 4; ++m)
#pragma unroll
                    for (int n = 0; n < 2; ++n) acc[a][b][m][n] = (f32x4){0.f, 0.f, 0.f, 0.f};
        cur = nxt; cB = nB; cA = nA; hsC = hsN; nt = cur.K / BK; ++ui;
#pragma unroll
        for (int h = 0; h < 2; ++h)
#pragma unroll
            for (int i = 0; i < 2; ++i) voC[h][i] = voN[h][i];
        if (wr == 1) PG_BAR;
    }
    PG_WAIT_V(0);
    PG_BAR;
#undef PG_SA
#undef PG_SB
#undef PG_STAGE
#undef PG_LDA
#undef PG_LDB
#undef PG_MMA
#undef PG_WAIT_V
#undef PG_WAIT_L
#undef PG_BAR
#undef PG_SCHED
}
}
__device__ __forceinline__ void fast_moe_merged(Frame& F, int layer) {
    LAS int* mm = moe_map(F, layer);
    int U = 0;
    for (int e = 0; e < 16; ++e) U += ((mm[e] + 255) >> 8) * 4;
    pg::MoeMergedSched S{(const char*)(F.ws + WS_WGU) + (size_t)layer * 16 * 1024 * 1024 * 2, (const char*)(F.ws + WS_WDN) + (size_t)layer * 16 * 1024 * 512 * 2,
                         (const char*)(F.ws + WS_HB), (const char*)(F.ws + WS_HID), (const int*)(F.ws + WS_SLOTT) + layer * 16 * CAP, (const float*)(F.ws + WS_SLOTW) + layer * 16 * CAP, mm,
                         F.ctl + CW_TILE + layer * 288 * 64, F.ctl + CW_TMO2, F.G, F.wg, U};
    pg::EpiGateUpWT EA{__builtin_amdgcn_make_buffer_rsrc((void*)(F.ws + WS_HID), 0, HROWS * FF * 2, 0x00020000), F.lds, mm};
    pg::EpiDownM EB{(unsigned char*)(F.ws + WS_Y), mm};
    pg::gemm_phase_moe(F.lds, S, EA, EB);
}

constexpr int NPH = 18;
__global__ void __launch_bounds__(NTHR, 2) mega(Args args) {
    extern __shared__ __attribute__((aligned(16))) unsigned char lds[];
    Frame F;
    F.lds = (LAS unsigned char*)lds;
    F.tid = threadIdx.x; F.lane = F.tid & 63; F.wave = __builtin_amdgcn_readfirstlane(F.tid >> 6);
    F.G = gridDim.x; F.wg = blockIdx.x;
    F.out = args.out; F.ws = args.ws; F.ctl = (unsigned*)(args.ws + WS_CTL);
    volatile LAS unsigned* bst = (volatile LAS unsigned*)(F.lds + LDS_BYTES - 16);
    if (F.tid < 4) bst[F.tid] = 0u;
    __syncthreads();
    const int lo = args.ph_lo, hi = args.ph_hi;
    XcdBarrier bar; bar.bar = F.ctl + CW_BAR; bar.x = 0; bar.st = bst;
    if (hi - lo > 1) bar = xcd_barrier_post(F.ctl + CW_BAR, bst);
#define IN(k) (lo <= (k) && (k) < hi)
#define SEAM(k) do { if (IN(k) && IN((k) + 1)) xcd_barrier(bar); } while (0)
    const float* mod = (const float*)(F.ws + WS_MOD);

#ifndef DBL_MASK
#define DBL_MASK 0x0u
#endif
#define RUN(k, body) do { if (IN(k)) { _Pragma("unroll 1") for (int _r = 0; _r < ((((DBL_MASK) >> (k)) & 1u) ? 2 : 1); ++_r) { if (_r) xcd_barrier(bar); F.lane = fresh_lane(); body; } } } while (0)
    RUN(0, phase_prep(F)); SEAM(0);
    RUN(1, phase_norm1_l0(F)); SEAM(1);
    RUN(2, if (FAST_GEMM) fast_inproj(F); else phase_inproj(F)); SEAM(2);
    if (IN(3)) { F.lane = fresh_lane();
#pragma unroll 1
        for (int _r = 0; _r < ((DBL_MASK & 0x100000u) ? 2 : 1); ++_r) { if (FAST_ATTN == 2 && FAST_GEMM) phase_attn_lds(F); else if (FAST_ATTN && FAST_GEMM) phase_attn_mfma(F); else phase_attn_simple(F); }
#pragma unroll 1
        for (int _r = 0; _r < ((DBL_MASK & 0x200000u) ? 2 : 1); ++_r) { if (FAST_FFT) phase_fft1_mfma(F); else phase_fft1_simple(F); }
    } SEAM(3);
    RUN(4, if (FAST_FFT) phase_fft2_mfma(F); else phase_fft2_simple(F)); SEAM(4);
    if (IN(5)) { if (!FAST_FFT) phase_fft3_simple(F); } if (!FAST_FFT) SEAM(5);
    RUN(6, if (FAST_GEMM) fast_outproj(F, WS_MIX, WS_WOUT, F.in[I_X], F.out, mod + 2048, nullptr); else phase_outproj(F, (const bf16*)(F.ws + WS_MIX), (const bf16*)(F.ws + WS_WOUT), F.in[I_X], F.out, mod + 2048, nullptr)); SEAM(6);
    if (IN(7)) { F.lane = fresh_lane(); if (XBF16) phase_norm2_route_mfma(F, 0); else phase_norm2_route(F, 0); } SEAM(7);
    if (MOE_MERGED && FAST_GEMM) { if (IN(8)) { F.lane = fresh_lane(); fast_moe_merged(F, 0); } if (IN(8) && IN(10)) xcd_barrier(bar); }
    else { RUN(8, if (FAST_GEMM) fast_moe_gateup(F, 0); else phase_moe_gateup(F, 0)); SEAM(8);
    RUN(9, if (FAST_GEMM) fast_moe_down(F, 0); else phase_moe_down(F, 0)); SEAM(9); }
    if (IN(10)) { F.lane = fresh_lane(); phase_combine<false>(F, 0); } SEAM(10);
    RUN(11, if (FAST_GEMM) fast_pw1(F); else phase_pw1(F)); SEAM(11);
    RUN(12, phase_dwconv_fast(F)); SEAM(12);
    if (IN(13)) { F.lane = fresh_lane(); if (FAST_GEMM) fast_outproj(F, WS_V1, WS_WPW2, F.out, F.out, mod + 5 * 6144 + 2048, F.in[I_PW2B]); else phase_outproj(F, (const bf16*)(F.ws + WS_V1), (const bf16*)(F.ws + WS_WPW2), F.out, F.out, mod + 5 * 6144 + 2048, F.in[I_PW2B]); } SEAM(13);
    if (IN(14)) { F.lane = fresh_lane(); if (XBF16) phase_norm2_route_mfma(F, 1); else phase_norm2_route(F, 1); } SEAM(14);
    if (MOE_MERGED && FAST_GEMM) { if (IN(15)) { F.lane = fresh_lane(); fast_moe_merged(F, 1); } if (IN(15) && IN(17)) xcd_barrier(bar); }
    else { RUN(15, if (FAST_GEMM) fast_moe_gateup(F, 1); else phase_moe_gateup(F, 1)); SEAM(15);
    RUN(16, if (FAST_GEMM) fast_moe_down(F, 1); else phase_moe_down(F, 1)); SEAM(16); }
    if (IN(17)) { F.lane = fresh_lane(); phase_combine<true>(F, 1); }
#undef RUN
#undef IN
#undef SEAM
}

extern "C" void kernel_launch(void* const* d_in, const int* in_sizes, int n_in, void* d_out, int out_size, void* d_ws, size_t ws_size, hipStream_t stream) {
    static int grid = 0;
    if (grid == 0) {
        if (n_in != 25 || out_size != T * D || ws_size < WS_END) { fprintf(stderr, "kernel_launch: unexpected shapes (n_in %d out %d ws %zu)\n", n_in, out_size, ws_size); grid = -1; return; }
        int dev = 0, cus = 0, per_cu = 0;
        if (hipGetDevice(&dev) != hipSuccess || hipDeviceGetAttribute(&cus, hipDeviceAttributeMultiprocessorCount, dev) != hipSuccess) { grid = -1; return; }
        if (hipFuncSetAttribute((const void*)mega, hipFuncAttributeMaxDynamicSharedMemorySize, LDS_BYTES) != hipSuccess) { fprintf(stderr, "kernel_launch: hipFuncSetAttribute failed\n"); grid = -1; return; }
        if (hipOccupancyMaxActiveBlocksPerMultiprocessor(&per_cu, (const void*)mega, NTHR, LDS_BYTES) != hipSuccess || per_cu < 1) { fprintf(stderr, "kernel_launch: occupancy query says %d\n", per_cu); }
        (void)hipGetLastError();
        grid = cus;
    }
    if (grid < 0) return;
    (void)hipMemsetAsync((char*)d_ws + WS_CTL, 0, CTL_BYTES, stream);
    Args a{};
    for (int i = 0; i < 25; ++i) a.in[i] = (const float*)d_in[i];
    a.out = (float*)d_out; a.ws = (unsigned char*)d_ws;
#if MK_ONE_LAUNCH
    a.ph_lo = 0; a.ph_hi = NPH;
    hipLaunchKernelGGL(mega, dim3(grid), dim3(NTHR), LDS_BYTES, stream, a);
#else
#ifndef PROBE_PHASE
#define PROBE_PHASE -1
#endif
    for (int p = 0; p < NPH; ++p) { a.ph_lo = p; a.ph_hi = p + 1; hipLaunchKernelGGL(mega, dim3(grid), dim3(NTHR), LDS_BYTES, stream, a);
        if (p == PROBE_PHASE) { if (p == 7 || p == 14) (void)hipMemsetAsync((char*)d_ws + WS_CTL, 0, CTL_BYTES, stream);
            hipLaunchKernelGGL(mega, dim3(grid), dim3(NTHR), LDS_BYTES, stream, a); } }
#endif
}
```

```cpp
#include <hip/hip_runtime.h>
#include <cstdio>

#ifndef MK_ONE_LAUNCH
#define MK_ONE_LAUNCH 1
#endif

#define GAS __attribute__((address_space(1)))
#define LAS __attribute__((address_space(3)))
typedef unsigned short bf16;
typedef short bf16x8 __attribute__((ext_vector_type(8)));
typedef float f32x4 __attribute__((ext_vector_type(4)));
typedef float f32x16 __attribute__((ext_vector_type(16)));
typedef unsigned u32x4 __attribute__((ext_vector_type(4)));
typedef unsigned u32x2 __attribute__((ext_vector_type(2)));

constexpr int D = 1024, NB = 4, L = 8192, T = NB * L, CL = 256, TC = NB * CL;
constexpr int NE = 16, FF = 512, CONVW = 31;
constexpr int N_IN = 1280;
constexpr int FN1 = 64, FN2 = 128;
#ifndef FAST_GEMM
#define FAST_GEMM 1
#endif
#ifndef MOE_MERGED
#define MOE_MERGED 1
#endif
#ifndef XBF16
#define XBF16 FAST_GEMM
#endif
#ifndef FAST_ATTN
#define FAST_ATTN 2
#endif
#ifndef FAST_FFT
#define FAST_FFT 1
#endif
constexpr int IL = FAST_GEMM ? 128 : 32;
constexpr float EPS = 1e-6f;
constexpr int NWAVES = 8, NTHR = 512;
constexpr int CAP = 32768;
constexpr int HROWS = 65536 + 4096;

constexpr size_t MiB = 1u << 20;
constexpr size_t WS_CTL = 0, CTL_BYTES = 1 * MiB;
constexpr size_t WS_MOD = 1 * MiB;
constexpr size_t WS_TW = 1 * MiB + 512 * 1024;
constexpr size_t WS_WIN = 2 * MiB, WS_WOUT = 6 * MiB, WS_WPW1 = 10 * MiB, WS_WPW2 = 14 * MiB;
constexpr size_t WS_WGU = 16 * MiB, WS_WDN = 80 * MiB;
constexpr size_t WS_TOKE = 112 * MiB, WS_TOKP = 113 * MiB, WS_TOKW = 114 * MiB;
constexpr size_t WS_SLOTT = 116 * MiB, WS_SLOTW = 120 * MiB;
constexpr size_t WS_HB = 128 * MiB;
constexpr size_t WS_UF = 196 * MiB, WS_Q = 228 * MiB, WS_K = 260 * MiB, WS_V = 268 * MiB, WS_CK = 276 * MiB, WS_CV = 277 * MiB;
constexpr size_t WS_G = 280 * MiB, WS_MIX = 344 * MiB, WS_AB = 408 * MiB;
constexpr size_t WS_XB = 408 * MiB;
constexpr size_t WS_HID = 196 * MiB, WS_Y = 264 * MiB;
constexpr size_t WS_U = 196 * MiB, WS_V1 = 260 * MiB;
constexpr size_t WS_END = 472 * MiB;
constexpr int CW_BAR = 4096;
constexpr int CW_CNT = 8192;
constexpr int CW_TILE = 16384;
constexpr int CW_TMO2 = 2048;

constexpr int LDS_BYTES = 147456;

__device__ __forceinline__ unsigned f2bf(float f) { unsigned u = __float_as_uint(f); return (u + 0x7fffu + ((u >> 16) & 1u)) >> 16; }
__device__ __forceinline__ float bf2f(unsigned b) { return __uint_as_float(b << 16); }
typedef __bf16 b16x2_t __attribute__((ext_vector_type(2)));
__device__ __forceinline__ unsigned pkbf(float a, float b) { typedef float f2 __attribute__((ext_vector_type(2))); f2 v = {a, b}; return __builtin_bit_cast(unsigned, __builtin_convertvector(v, b16x2_t)); }
__device__ __forceinline__ unsigned pk2(float lo, float hi) { return pkbf(lo, hi); }
__device__ __forceinline__ float bflo(unsigned w) { return __uint_as_float(w << 16); }
__device__ __forceinline__ float bfhi(unsigned w) { return __uint_as_float(w & 0xffff0000u); }
__device__ __forceinline__ float wave_sum(float v) {
    v += __builtin_bit_cast(float, __builtin_amdgcn_mov_dpp(__builtin_bit_cast(int, v), 0xB1, 0xf, 0xf, true));
    v += __builtin_bit_cast(float, __builtin_amdgcn_mov_dpp(__builtin_bit_cast(int, v), 0x4E, 0xf, 0xf, true));
    v += __builtin_bit_cast(float, __builtin_amdgcn_mov_dpp(__builtin_bit_cast(int, v), 0x141, 0xf, 0xf, true));
    v += __builtin_bit_cast(float, __builtin_amdgcn_mov_dpp(__builtin_bit_cast(int, v), 0x140, 0xf, 0xf, true));
    const int iv = __builtin_bit_cast(int, v);
    const float a = __builtin_bit_cast(float, __builtin_amdgcn_readlane(iv, 15)), b = __builtin_bit_cast(float, __builtin_amdgcn_readlane(iv, 31));
    const float c = __builtin_bit_cast(float, __builtin_amdgcn_readlane(iv, 47)), d = __builtin_bit_cast(float, __builtin_amdgcn_readlane(iv, 63));
    return (a + b) + (c + d);
}
template <int CTRL> __device__ __forceinline__ float dppf(float v) { return __uint_as_float((unsigned)__builtin_amdgcn_update_dpp(0, (int)__float_as_uint(v), CTRL, 0xf, 0xf, true)); }
__device__ __forceinline__ float swap32_add(float a, float b) { const auto r = __builtin_amdgcn_permlane32_swap(__float_as_uint(a), __float_as_uint(b), false, false); return __uint_as_float(r[0]) + __uint_as_float(r[1]); }
__device__ __forceinline__ float swap16_add(float a, float b) { const auto r = __builtin_amdgcn_permlane16_swap(__float_as_uint(a), __float_as_uint(b), false, false); return __uint_as_float(r[0]) + __uint_as_float(r[1]); }
template <int CTRL> __device__ __forceinline__ float sel_add(float a, float b, bool hi) { const float t = hi ? b : a, u = hi ? a : b; return t + dppf<CTRL>(u); }
typedef __bf16 bf16x2_t __attribute__((ext_vector_type(2)));
__device__ __forceinline__ float dot2_bf16(unsigned w, unsigned x, float acc) { return __builtin_amdgcn_fdot2_f32_bf16(__builtin_bit_cast(bf16x2_t, w), __builtin_bit_cast(bf16x2_t, x), acc, false); }
__device__ __forceinline__ float silu_f(float x) { return x * __builtin_amdgcn_rcpf(1.f + __expf(-x)); }
__device__ __forceinline__ float sigmoid_f(float x) { return __builtin_amdgcn_rcpf(1.f + __expf(-x)); }
constexpr float YSCALE = 32.f;
__device__ __forceinline__ unsigned pk_fp8x4(f32x4 v) {
    int d = __builtin_amdgcn_cvt_pk_fp8_f32(__builtin_amdgcn_fmed3f(v[0] * YSCALE, -448.f, 448.f), __builtin_amdgcn_fmed3f(v[1] * YSCALE, -448.f, 448.f), 0, false);
    d = __builtin_amdgcn_cvt_pk_fp8_f32(__builtin_amdgcn_fmed3f(v[2] * YSCALE, -448.f, 448.f), __builtin_amdgcn_fmed3f(v[3] * YSCALE, -448.f, 448.f), d, true);
    return (unsigned)d;
}
__device__ __forceinline__ f32x4 un_fp8x4(unsigned d) { typedef float f2 __attribute__((ext_vector_type(2)));
    const f2 lo = __builtin_amdgcn_cvt_pk_f32_fp8((int)d, false), hi = __builtin_amdgcn_cvt_pk_f32_fp8((int)d, true); return (f32x4){lo.x, lo.y, hi.x, hi.y}; }
#define LDS_WAIT() asm volatile("s_waitcnt lgkmcnt(0)" ::: "memory")
__device__ __forceinline__ int fresh_lane() { int l; asm volatile("v_mbcnt_lo_u32_b32 %0, -1, 0\n\tv_mbcnt_hi_u32_b32 %0, -1, %0" : "=v"(l)); return l; }

#define XB_TMO      128
#define XB_XCNT(j)  (256  + 64 * (j))
#define XB_XSUB(j)  (1280 + 64 * (j))
#define XB_XGEN(j)  (2304 + 64 * (j))
#define XB_TOP      3328
#define XB_TOPGEN   3392
#define XCD_BAR_WORDS 3456
#define XB_SPIN_CAP (1u << 20)
__device__ __forceinline__ unsigned xb_ld(unsigned* p)              { return __hip_atomic_load(p, __ATOMIC_RELAXED, __HIP_MEMORY_SCOPE_AGENT); }
__device__ __forceinline__ unsigned xb_add(unsigned* p, unsigned v) { return __hip_atomic_fetch_add(p, v, __ATOMIC_RELAXED, __HIP_MEMORY_SCOPE_AGENT); }
__device__ __forceinline__ unsigned xb_xcc_id() { return (unsigned)__builtin_amdgcn_s_getreg((3 << 11) | 20) & 0xFu; }
#define XB_SPIN(cond, bar) do { unsigned _sp = 0; while (cond) { __builtin_amdgcn_s_sleep(1); \
    if ((++_sp & 255u) == 0u) { if (xb_ld(&(bar)[XB_TMO])) break; if (_sp > XB_SPIN_CAP) { atomicAdd(&(bar)[XB_TMO], 1u); break; } } } } while (0)
struct XcdBarrier { unsigned* bar; unsigned x; volatile LAS unsigned* st; };
__device__ __forceinline__ XcdBarrier xcd_barrier_post(unsigned* bar, volatile LAS unsigned* st) {
    XcdBarrier b; b.bar = bar; b.x = xb_xcc_id(); b.st = st;
    if (threadIdx.x == 0) (void)xb_add(&bar[XB_XCNT(b.x)], 1u);
    return b;
}
__device__ __forceinline__ void xcd_barrier_complete(unsigned* bar, unsigned x, unsigned& nloc, unsigned& nx) {
    const unsigned G = gridDim.x * gridDim.y * gridDim.z;
    unsigned sum, cnt, mine, sp = 0u;
    for (;;) {
        sum = 0u; cnt = 0u; mine = 0u;
#pragma unroll
        for (unsigned j = 0; j < 16; ++j) { const unsigned c = xb_ld(&bar[XB_XCNT(j)]); sum += c; cnt += (c > 0u) ? 1u : 0u; mine = (j == x) ? c : mine; }
        if (sum == G) break;
        __builtin_amdgcn_s_sleep(1);
        if ((++sp & 255u) == 0u) { if (xb_ld(&bar[XB_TMO])) break; if (sp > XB_SPIN_CAP) { atomicAdd(&bar[XB_TMO], 1u); break; } }
    }
    nloc = mine > 0u ? mine : 1u; nx = cnt > 0u ? cnt : 1u;
}
__device__ __forceinline__ void xcd_barrier(const XcdBarrier& b) {
    asm volatile("s_waitcnt vmcnt(0)" ::: "memory");
    __syncthreads();
    if (threadIdx.x == 0) {
        unsigned* bar = b.bar;
        __builtin_amdgcn_s_waitcnt(0);
        unsigned nloc = b.st[0], nx = b.st[1];
        if (nloc == 0u) { xcd_barrier_complete(bar, b.x, nloc, nx); b.st[0] = nloc; b.st[1] = nx; }
        const unsigned old = xb_add(&bar[XB_XSUB(b.x)], 1u);
        const unsigned gen = old / nloc;
        if (old + 1u == (gen + 1u) * nloc) {
            __builtin_amdgcn_fence(__ATOMIC_RELEASE, "agent");
            asm volatile("s_waitcnt vmcnt(0)" ::: "memory");
            const unsigned og = xb_add(&bar[XB_TOP], 1u);
            const unsigned tg = og / nx;
            if (og + 1u == (tg + 1u) * nx) xb_add(&bar[XB_TOPGEN], 1u);
            else XB_SPIN(xb_ld(&bar[XB_TOPGEN]) == tg, bar);
            __builtin_amdgcn_fence(__ATOMIC_ACQUIRE, "agent");
            xb_add(&bar[XB_XGEN(b.x)], 1u);
            asm volatile("s_waitcnt vmcnt(0)" ::: "memory");
        } else {
            XB_SPIN(xb_ld(&bar[XB_XGEN(b.x)]) == gen, bar);
            __builtin_amdgcn_fence(__ATOMIC_ACQUIRE, "agent");
            asm volatile("s_waitcnt vmcnt(0)" ::: "memory");
        }
    }
    __syncthreads();
}

struct Args { const float* in[25]; float* out; unsigned char* ws; int ph_lo, ph_hi; };
enum { I_X = 0, I_C, I_CTX, I_CCTX, I_ADAW, I_ADAB, I_NMG, I_NFG, I_WIN, I_WOUT, I_SINK, I_PW1W, I_PW1B, I_DWW, I_DWB, I_LNG, I_LNB,
       I_PW2W, I_PW2B, I_RW, I_RB, I_WG, I_WU, I_WD, I_FNG };

struct InPtrs {
    __device__ __forceinline__ const float* operator[](int i) const { const float* r;
        asm volatile("s_load_dwordx2 %0, %1, %2\n\ts_waitcnt lgkmcnt(0)" : "=s"(r) : "s"(__builtin_amdgcn_kernarg_segment_ptr()), "s"(i * 8)); return r; }
};
struct Frame {
    LAS unsigned char* lds;
    int tid, lane, wave, G, wg;
    InPtrs in;
    float* out;
    unsigned char* ws;
    unsigned* ctl;
};

__device__ __forceinline__ int crow(int i, int h) { return (i & 3) + 8 * (i >> 2) + 4 * h; }
template <class RowPtr, class Epi>
__device__ __forceinline__ void sgemm_tile(const RowPtr& rowptr, const bf16* Bt, int K, int m0, int n0, const Epi& epi, int wave, int lane) {
    const int wm = wave & 3, wn = wave >> 2, r = lane & 31, h = lane >> 5;
    const bf16* ap = rowptr(m0 + wm * 32 + r) + 8 * h;
    const bf16* bp0 = Bt + (size_t)(n0 + wn * 64 + r) * K + 8 * h;
    const bf16* bp1 = bp0 + (size_t)32 * K;
    f32x16 c0, c1;
#pragma unroll
    for (int i = 0; i < 16; ++i) { c0[i] = 0.f; c1[i] = 0.f; }
#pragma unroll 2
    for (int k = 0; k < K; k += 32) {
        const bf16x8 a0 = *(const bf16x8*)(ap + k), a1 = *(const bf16x8*)(ap + k + 16);
        const bf16x8 b00 = *(const bf16x8*)(bp0 + k), b01 = *(const bf16x8*)(bp0 + k + 16);
        const bf16x8 b10 = *(const bf16x8*)(bp1 + k), b11 = *(const bf16x8*)(bp1 + k + 16);
        c0 = __builtin_amdgcn_mfma_f32_32x32x16_bf16(a0, b00, c0, 0, 0, 0);
        c1 = __builtin_amdgcn_mfma_f32_32x32x16_bf16(a0, b10, c1, 0, 0, 0);
        c0 = __builtin_amdgcn_mfma_f32_32x32x16_bf16(a1, b01, c0, 0, 0, 0);
        c1 = __builtin_amdgcn_mfma_f32_32x32x16_bf16(a1, b11, c1, 0, 0, 0);
    }
    epi(m0 + wm * 32, n0 + wn * 64, c0, c1, lane);
}

__device__ __forceinline__ void p0_transpose_item(const float* W, int K, int N, bf16* WT, int k0, int n0, int drow0, LAS float* scr, int lane) {
#pragma unroll 8
    for (int i = 0; i < 32; ++i) { const int kk = 2 * i + (lane >> 5); scr[kk * 33 + (lane & 31)] = W[(size_t)(k0 + kk) * N + n0 + (lane & 31)]; }
    LDS_WAIT(); asm volatile("" ::: "memory");
    const int c = lane & 7;
#pragma unroll
    for (int j = 0; j < 4; ++j) { const int n = (lane >> 3) + 8 * j; const LAS float* s = scr + (8 * c) * 33 + n;
        u32x4 o; o.x = pk2(s[0 * 33], s[1 * 33]); o.y = pk2(s[2 * 33], s[3 * 33]); o.z = pk2(s[4 * 33], s[5 * 33]); o.w = pk2(s[6 * 33], s[7 * 33]);
        *(u32x4*)(WT + (size_t)(drow0 + n) * K + k0 + 8 * c) = o; }
    LDS_WAIT(); asm volatile("" ::: "memory");
}
__device__ __forceinline__ int il_row(int j, int half) { return (j / IL) * (2 * IL) + half * IL + (j % IL); }

constexpr int T_NITEMS = 640 + 512 + 1024 + 512 + 3 * 32 * 256, T_DEFER_ATT = 10 * 2048;
struct TItem { const float* W; bf16* WT; int K, N, k0, n0, drow0; bool ok; };
__device__ __forceinline__ TItem t_decode(const Frame& F, int it) {
    constexpr int S0 = 640, S1 = 512, S2 = 1024, S3 = 512, SM = 32 * 256;
    TItem t; t.ok = it < S0 + S1 + S2 + S3 + 3 * SM; t.W = F.in[I_WIN]; t.WT = (bf16*)(F.ws + WS_WIN); t.K = 1024; t.N = 1280; t.k0 = 0; t.n0 = 0; t.drow0 = 0;
    int r = it;
    if (r < S0) { const int kb = r / 40, nb = r % 40; t.k0 = kb * 64; t.n0 = nb * 32; t.drow0 = nb * 32; return t; } r -= S0;
    if (r < S1) { const int kb = r / 32, nb = r % 32; t.W = F.in[I_WOUT]; t.WT = (bf16*)(F.ws + WS_WOUT); t.N = 1024; t.k0 = kb * 64; t.n0 = nb * 32; t.drow0 = nb * 32; return t; } r -= S1;
    if (r < S2) { const int kb = r / 64, nb = r % 64, n0 = nb * 32; t.W = F.in[I_PW1W]; t.WT = (bf16*)(F.ws + WS_WPW1); t.N = 2048; t.k0 = kb * 64; t.n0 = n0; t.drow0 = il_row(n0 & 1023, n0 >> 10); return t; } r -= S2;
    if (r < S3) { const int kb = r / 32, nb = r % 32; t.W = F.in[I_PW2W]; t.WT = (bf16*)(F.ws + WS_WPW2); t.N = 1024; t.k0 = kb * 64; t.n0 = nb * 32; t.drow0 = nb * 32; return t; } r -= S3;
    if (r < SM) { const int le = r >> 8, q = r & 255, kb = q / 16, nb = q % 16; t.W = F.in[I_WG] + (size_t)le * 1024 * 512; t.WT = (bf16*)(F.ws + WS_WGU) + (size_t)le * 1024 * 1024; t.N = 512; t.k0 = kb * 64; t.n0 = nb * 32; t.drow0 = il_row(nb * 32, 0); return t; } r -= SM;
    if (r < SM) { const int le = r >> 8, q = r & 255, kb = q / 16, nb = q % 16; t.W = F.in[I_WU] + (size_t)le * 1024 * 512; t.WT = (bf16*)(F.ws + WS_WGU) + (size_t)le * 1024 * 1024; t.N = 512; t.k0 = kb * 64; t.n0 = nb * 32; t.drow0 = il_row(nb * 32, 1); return t; } r -= SM;
    { const int le = (r >> 8) & 31, q = r & 255, kb = q / 32, nb = q % 32; t.W = F.in[I_WD] + (size_t)le * 512 * 1024; t.WT = (bf16*)(F.ws + WS_WDN) + (size_t)le * 1024 * 512; t.K = 512; t.N = 1024; t.k0 = kb * 64; t.n0 = nb * 32; t.drow0 = nb * 32; }
    return t;
}
__device__ __forceinline__ void t_load(const TItem& t, int lane, float (&v)[32]) {
    if (t.ok) {
#pragma unroll
        for (int i = 0; i < 32; ++i) v[i] = t.W[(size_t)(t.k0 + 2 * i + (lane >> 5)) * t.N + t.n0 + (lane & 31)];
    }
}
__device__ __forceinline__ void t_store(const TItem& t, LAS float* scr, int lane, const float (&v)[32]) {
#pragma unroll
    for (int i = 0; i < 32; ++i) scr[(2 * i + (lane >> 5)) * 33 + (lane & 31)] = v[i];
    LDS_WAIT(); asm volatile("" ::: "memory");
    const int c = lane & 7;
#pragma unroll
    for (int j = 0; j < 4; ++j) { const int n = (lane >> 3) + 8 * j; const LAS float* s = scr + (8 * c) * 33 + n;
        u32x4 o; o.x = pk2(s[0 * 33], s[1 * 33]); o.y = pk2(s[2 * 33], s[3 * 33]); o.z = pk2(s[4 * 33], s[5 * 33]); o.w = pk2(s[6 * 33], s[7 * 33]);
        *(u32x4*)(t.WT + (size_t)(t.drow0 + n) * t.K + t.k0 + 8 * c) = o; }
    LDS_WAIT(); asm volatile("" ::: "memory");
}
__device__ __forceinline__ void t_dma(const TItem& t, LAS unsigned char* scr, int lane) {
    if (t.ok) {
#pragma unroll
        for (int i = 0; i < 8; ++i)
            __builtin_amdgcn_global_load_lds((const unsigned*)(t.W + (size_t)(t.k0 + 8 * i + (lane >> 3)) * t.N + t.n0 + 4 * (lane & 7)), (LAS unsigned*)(scr + 1056 * i), 16, 0, 0);
    }
}
__device__ __forceinline__ void t_store_dma(const TItem& t, const LAS float* scr, int lane) {
    const int c = lane & 7;
#pragma unroll 1
    for (int j = 0; j < 4; ++j) { const int n = (lane >> 3) + 8 * j; float e[8];
#pragma unroll
        for (int q = 0; q < 8; ++q) e[q] = scr[264 * c + 32 * q + n];
        { u32x4 o; o.x = pk2(e[0], e[1]); o.y = pk2(e[2], e[3]); o.z = pk2(e[4], e[5]); o.w = pk2(e[6], e[7]); *(u32x4*)(t.WT + (size_t)(t.drow0 + n) * t.K + t.k0 + 8 * c) = o; } }
    LDS_WAIT(); asm volatile("" ::: "memory");
}
__device__ __forceinline__ void t_items_tail(Frame& F, int r, int nw) {
    LAS float* scr = (LAS float*)(F.lds + F.wave * 8704);
    TItem cur = t_decode(F, 640 + T_DEFER_ATT + r); float va[32], vb[32];
    t_load(cur, F.lane, va);
#pragma unroll 1
    for (int it = r; cur.ok; it += nw) {
        const TItem nxt = t_decode(F, 640 + T_DEFER_ATT + it + nw);
        t_load(nxt, F.lane, vb);
        t_store(cur, scr, F.lane, va);
#pragma unroll
        for (int i = 0; i < 32; ++i) va[i] = vb[i];
        cur = nxt;
    }
}
__device__ __forceinline__ void phase_prep(Frame& F) {
    {
        LAS float* sc = (LAS float*)F.lds;
        LAS float* red = sc + 5 * 1024;
        bool loaded = false;
        for (int it = F.wg; it < 192; it += F.G) {
            if (!loaded) {
                for (int i = F.tid; i < 5 * 1024; i += NTHR) { const int b = i >> 10, k = i & 1023; const float v = b < 4 ? F.in[I_C][b * 1024 + k] : F.in[I_CCTX][k]; sc[i] = silu_f(v); }
                __syncthreads(); loaded = true;
            }
            const int l = it / 96, n0 = (it % 96) * 64, c4 = F.tid & 15, kg = F.tid >> 4;
            const float* w = F.in[I_ADAW] + (size_t)l * 1024 * 6144 + n0 + 4 * c4;
            f32x4 a[5];
#pragma unroll
            for (int b = 0; b < 5; ++b) a[b] = (f32x4){0.f, 0.f, 0.f, 0.f};
#pragma unroll 16
            for (int kk = 0; kk < 32; ++kk) { const int k = kg * 32 + kk; const f32x4 wv = *(const f32x4*)(w + (size_t)k * 6144);
#pragma unroll
                for (int b = 0; b < 5; ++b) a[b] += sc[b * 1024 + k] * wv; }
#pragma unroll
            for (int b = 0; b < 5; ++b) *(LAS f32x4*)(red + (kg * 5 + b) * 64 + 4 * c4) = a[b];
            __syncthreads();
            if (F.tid < 320) { const int b = F.tid >> 6, c2 = F.tid & 63; float sm = 0.f;
#pragma unroll
                for (int g = 0; g < 32; ++g) sm += red[(g * 5 + b) * 64 + c2];
                ((float*)(F.ws + WS_MOD))[((size_t)l * 5 + b) * 6144 + n0 + c2] = sm + F.in[I_ADAB][l * 6144 + n0 + c2]; }
            __syncthreads();
        }
        __syncthreads();
    }
    { u32x4* z = (u32x4*)(F.ws + WS_SLOTT); const u32x4 zero = {0u, 0u, 0u, 0u};
      for (int i = F.wg * NTHR + F.tid; i < 2 * 16 * CAP / 4; i += F.G * NTHR) z[i] = zero; }
    { float* tw = (float*)(F.ws + WS_TW);
      for (int k = F.wg * NTHR + F.tid; k < 8192; k += F.G * NTHR) { const float a = (float)k * (6.283185307179586f / 8192.f); tw[2 * k] = __cosf(a); tw[2 * k + 1] = __sinf(a); } }
    {
        LAS float* scr = (LAS float*)(F.lds + F.wave * 8704);
        const int gw = F.wg * NWAVES + F.wave, NGW = F.G * NWAVES;
        auto vmap = [](int v) { return v < 640 ? v : (1 << 30); };
        TItem cur = t_decode(F, vmap(gw)); float va[32], vb[32];
        t_load(cur, F.lane, va);
#pragma unroll 1
        for (int it = gw; cur.ok; it += NGW) {
            const TItem nxt = t_decode(F, vmap(it + NGW));
            t_load(nxt, F.lane, vb);
            t_store(cur, scr, F.lane, va);
#pragma unroll
            for (int i = 0; i < 32; ++i) va[i] = vb[i];
            cur = nxt;
        }
    }
}

#define ROFF(lane, j) (512 * ((j) >> 1) + 8 * (lane) + 4 * ((j) & 1))
__device__ __forceinline__ void row_load(const float* p, int lane, f32x4 (&v)[4]) {
#pragma unroll
    for (int j = 0; j < 4; ++j) v[j] = *(const f32x4*)(p + ROFF(lane, j));
}
__device__ __forceinline__ void row_load_bf(const bf16* p, int lane, f32x4 (&v)[4]) {
#pragma unroll
    for (int jj = 0; jj < 2; ++jj) { const u32x4 w = *(const u32x4*)(p + 512 * jj + 8 * lane); v[2 * jj] = (f32x4){bflo(w.x), bfhi(w.x), bflo(w.y), bfhi(w.y)}; v[2 * jj + 1] = (f32x4){bflo(w.z), bfhi(w.z), bflo(w.w), bfhi(w.w)}; }
}
__device__ __forceinline__ void xrow_load(const float* xf, const bf16* xb, size_t row, int lane, f32x4 (&v)[4]) { if (XBF16) row_load_bf(xb + row * D, lane, v); else row_load(xf + row * D, lane, v); }
__device__ __forceinline__ float row_sumsq(const f32x4 (&v)[4]) {
    float s = 0.f;
#pragma unroll
    for (int j = 0; j < 4; ++j) s += (v[j].x * v[j].x + v[j].y * v[j].y) + (v[j].z * v[j].z + v[j].w * v[j].w);
    return wave_sum(s);
}
__device__ __forceinline__ void row_modulate(f32x4 (&v)[4], float rstd, const float* g, const float* sh, const float* sc, int lane) {
#pragma unroll
    for (int j = 0; j < 4; ++j) { const int o = ROFF(lane, j); const f32x4 gg = *(const f32x4*)(g + o), s1 = *(const f32x4*)(sc + o), s0 = *(const f32x4*)(sh + o);
        v[j] = v[j] * rstd * gg * (1.f + s1) + s0; }
}
__device__ __forceinline__ void row_store_bf16(bf16* dst, const f32x4 (&v)[4], int lane) {
#pragma unroll
    for (int jj = 0; jj < 2; ++jj) { u32x4 w; w.x = pk2(v[2 * jj].x, v[2 * jj].y); w.y = pk2(v[2 * jj].z, v[2 * jj].w); w.z = pk2(v[2 * jj + 1].x, v[2 * jj + 1].y); w.w = pk2(v[2 * jj + 1].z, v[2 * jj + 1].w); *(u32x4*)(dst + 512 * jj + 8 * lane) = w; }
}

__device__ __forceinline__ void phase_norm1_l0(Frame& F) {
    const int gw = F.wg * NWAVES + F.wave, NGW = F.G * NWAVES;
    const float* mod = (const float*)(F.ws + WS_MOD);
    bf16* HB = (bf16*)(F.ws + WS_HB);
    for (int row = gw; row < T + TC; row += NGW) {
        const float* src = row < T ? F.in[I_X] + (size_t)row * D : F.in[I_CTX] + (size_t)(row - T) * D;
        const int b = row < T ? (row >> 13) : 4;
        f32x4 v[4]; row_load(src, F.lane, v);
        const float rstd = rsqrtf(row_sumsq(v) * (1.f / D) + EPS);
        const float* m = mod + (size_t)b * 6144;
        row_modulate(v, rstd, F.in[I_NMG], m, m + 1024, F.lane);
        row_store_bf16(HB + (size_t)row * D, v, F.lane);
    }
}

struct RowLin { const bf16* base; size_t pitch; __device__ __forceinline__ const bf16* operator()(int m) const { return base + (size_t)m * pitch; } };

__device__ __forceinline__ void inproj_block(Frame& F, int mb, int nbk, const f32x16& c, int lane) {
    const int h = lane >> 5, cl = lane & 31;
    bf16* dst; int pitch, cbase; bool rope = false; bool isctx = (mb >= T);
    if (nbk < 512) { dst = (bf16*)(F.ws + WS_UF); pitch = 512; cbase = 0; }
    else if (nbk < 1024) { dst = (bf16*)(F.ws + WS_Q); pitch = 512; cbase = 512; rope = true; }
    else if (nbk < 1152) { dst = isctx ? (bf16*)(F.ws + WS_CK) : (bf16*)(F.ws + WS_K); pitch = 128; cbase = 1024; rope = !isctx; }
    else { dst = isctx ? (bf16*)(F.ws + WS_CV) : (bf16*)(F.ws + WS_V); pitch = 128; cbase = 1152; }
    const int rbase = isctx ? mb - T : mb;
    const int col = nbk - cbase + cl;
    const float inv = exp2f(-(float)(cl & 15) * (13.287712379549449f / 16.f));
    const bool second = (cl & 16) != 0; const bool bycol = ((nbk >> 5) & 1) != 0;
#pragma unroll
    for (int i = 0; i < 16; ++i) {
        const int rr = crow(i, h); float v = c[i];
        if (rope) {
            const float partner = __shfl_xor(v, 16);
            const int l = (mb + rr) & (L - 1);
            const float pos = (float)(bycol ? (l & 63) : (l >> 6));
            const float ang = pos * inv, cs = __cosf(ang), sn = __sinf(ang);
            v = second ? (partner * sn + v * cs) : (v * cs - partner * sn);
        }
        dst[(size_t)(rbase + rr) * pitch + col] = (bf16)f2bf(v);
    }
}
__device__ __forceinline__ void phase_inproj(Frame& F) {
    const bf16* HB = (const bf16*)(F.ws + WS_HB); const bf16* Wt = (const bf16*)(F.ws + WS_WIN);
    constexpr int MT = (T + TC) / 128, NT = N_IN / 128;
    RowLin rp{HB, (size_t)D};
    for (int u = F.wg; u < MT * NT; u += F.G) {
        const int mt = u / NT, nt = u % NT;
        if (mt >= T / 128 && nt < 8) continue;
        auto epi = [&](int mb, int nb, const f32x16& c0, const f32x16& c1, int lane) { inproj_block(F, mb, nb, c0, lane); inproj_block(F, mb, nb + 32, c1, lane); };
        sgemm_tile(rp, Wt, D, mt * 128, nt * 128, epi, F.wave, F.lane);
    }
}

__device__ __forceinline__ void attn_key(const bf16* kp, const bf16* vp, const float (&q)[64], float& m, float& s, float (&o)[64]) {
    float dot = 0.f;
#pragma unroll
    for (int j = 0; j < 8; ++j) { const u32x4 w = *(const u32x4*)(kp + 8 * j);
        dot += q[8 * j + 0] * bflo(w.x) + q[8 * j + 1] * bfhi(w.x) + q[8 * j + 2] * bflo(w.y) + q[8 * j + 3] * bfhi(w.y)
             + q[8 * j + 4] * bflo(w.z) + q[8 * j + 5] * bfhi(w.z) + q[8 * j + 6] * bflo(w.w) + q[8 * j + 7] * bfhi(w.w); }
    const float mn = fmaxf(m, dot), alpha = __expf(m - mn), p = __expf(dot - mn);
    s = s * alpha + p; m = mn;
#pragma unroll
    for (int j = 0; j < 8; ++j) { const u32x4 w = *(const u32x4*)(vp + 8 * j);
        o[8 * j + 0] = o[8 * j + 0] * alpha + p * bflo(w.x); o[8 * j + 1] = o[8 * j + 1] * alpha + p * bfhi(w.x);
        o[8 * j + 2] = o[8 * j + 2] * alpha + p * bflo(w.y); o[8 * j + 3] = o[8 * j + 3] * alpha + p * bfhi(w.y);
        o[8 * j + 4] = o[8 * j + 4] * alpha + p * bflo(w.z); o[8 * j + 5] = o[8 * j + 5] * alpha + p * bfhi(w.z);
        o[8 * j + 6] = o[8 * j + 6] * alpha + p * bflo(w.w); o[8 * j + 7] = o[8 * j + 7] * alpha + p * bfhi(w.w); }
}
__device__ __forceinline__ void phase_attn_simple(Frame& F) {
    const bf16* Q = (const bf16*)(F.ws + WS_Q); const bf16* Kb = (const bf16*)(F.ws + WS_K); const bf16* Vb = (const bf16*)(F.ws + WS_V);
    const bf16* CK = (const bf16*)(F.ws + WS_CK); const bf16* CV = (const bf16*)(F.ws + WS_CV); bf16* MIX = (bf16*)(F.ws + WS_MIX);
    for (int idx = F.wg * NTHR + F.tid; idx < T * 8; idx += F.G * NTHR) {
        const int hd = idx / T, t = idx % T, b = t >> 13, l = t & (L - 1), kvh = hd >> 2;
        float q[64], o[64];
#pragma unroll
        for (int j = 0; j < 8; ++j) { const u32x4 w = *(const u32x4*)(Q + (size_t)t * 512 + hd * 64 + 8 * j);
            q[8 * j + 0] = bflo(w.x) * 0.125f; q[8 * j + 1] = bfhi(w.x) * 0.125f; q[8 * j + 2] = bflo(w.y) * 0.125f; q[8 * j + 3] = bfhi(w.y) * 0.125f;
            q[8 * j + 4] = bflo(w.z) * 0.125f; q[8 * j + 5] = bfhi(w.z) * 0.125f; q[8 * j + 6] = bflo(w.w) * 0.125f; q[8 * j + 7] = bfhi(w.w) * 0.125f; }
#pragma unroll
        for (int j = 0; j < 64; ++j) o[j] = 0.f;
        float m = F.in[I_SINK][hd], s = 1.f;
        for (int c = 0; c < CL; ++c) { const size_t r = (size_t)(b * CL + c) * 128 + kvh * 64; attn_key(CK + r, CV + r, q, m, s, o); }
        const int lo = l - 128 < 0 ? 0 : l - 128, hi = l + 128 > L - 1 ? L - 1 : l + 128;
        for (int kp = lo; kp <= hi; ++kp) { const size_t r = (size_t)(b * L + kp) * 128 + kvh * 64; attn_key(Kb + r, Vb + r, q, m, s, o); }
        const float is = 1.f / s;
#pragma unroll
        for (int j = 0; j < 8; ++j) { u32x4 w; w.x = pk2(o[8 * j] * is, o[8 * j + 1] * is); w.y = pk2(o[8 * j + 2] * is, o[8 * j + 3] * is); w.z = pk2(o[8 * j + 4] * is, o[8 * j + 5] * is); w.w = pk2(o[8 * j + 6] * is, o[8 * j + 7] * is);
            *(u32x4*)(MIX + (size_t)t * 1024 + 512 + hd * 64 + 8 * j) = w; }
    }
}

__device__ __forceinline__ void phase_fft1_simple(Frame& F) {
    const bf16* UF = (const bf16*)(F.ws + WS_UF); bf16* Gb = (bf16*)(F.ws + WS_G); const float* tw = (const float*)(F.ws + WS_TW);
    for (int idx = F.wg * NTHR + F.tid; idx < NB * FN1 * FN2 * 512; idx += F.G * NTHR) {
        const int ch = idx & 511, bp = (idx >> 9) & 127, c = (idx >> 16) & 63, b = idx >> 22;
        float re = 0.f, im = 0.f;
        for (int a = 0; a < FN1; ++a) { const float u = bf2f(UF[(size_t)(b * L + 128 * a + bp) * 512 + ch]); const int k = ((a * c) & 63) * 128;
            re += u * tw[2 * k]; im -= u * tw[2 * k + 1]; }
        const int k2 = bp * c; const float cs = tw[2 * k2], sn = tw[2 * k2 + 1];
        const float gr = re * cs + im * sn, gi = im * cs - re * sn;
        const size_t row = (size_t)(b * FN1 + c) * FN2 + bp;
        Gb[row * 1024 + ch] = (bf16)f2bf(gr); Gb[row * 1024 + 512 + ch] = (bf16)f2bf(gi);
    }
}
__device__ __forceinline__ void phase_fft2_simple(Frame& F) {
    const bf16* Gb = (const bf16*)(F.ws + WS_G); bf16* AB = (bf16*)(F.ws + WS_AB); const float* tw = (const float*)(F.ws + WS_TW);
    for (int idx = F.wg * NTHR + F.tid; idx < NB * FN1 * FN2 * 512; idx += F.G * NTHR) {
        const int ch = idx & 511, d = (idx >> 9) & 127, c = (idx >> 16) & 63, b = idx >> 22;
        float fr = 0.f, fi = 0.f;
        for (int bp = 0; bp < FN2; ++bp) { const size_t row = (size_t)(b * FN1 + c) * FN2 + bp; const float gr = bf2f(Gb[row * 1024 + ch]), gi = bf2f(Gb[row * 1024 + 512 + ch]);
            const int k = ((bp * d) & 127) * 64; const float cs = tw[2 * k], sn = tw[2 * k + 1];
            fr += gr * cs + gi * sn; fi += gi * cs - gr * sn; }
        const size_t t = (size_t)b * L + c + 64 * d;
        AB[t * 1024 + ch] = (bf16)f2bf(fr); AB[t * 1024 + 512 + ch] = (bf16)f2bf(-fi);
    }
}
__device__ __forceinline__ void phase_fft3_simple(Frame& F) {
    const bf16* AB = (const bf16*)(F.ws + WS_AB); bf16* MIX = (bf16*)(F.ws + WS_MIX); const float* tw = (const float*)(F.ws + WS_TW);
    LAS float* t128 = (LAS float*)F.lds;
    for (int i = F.tid; i < 128; i += NTHR) { t128[2 * i] = tw[2 * (i * 64)]; t128[2 * i + 1] = tw[2 * (i * 64) + 1]; }
    __syncthreads();
    for (int idx = F.wg * NTHR + F.tid; idx < T * 512; idx += F.G * NTHR) {
        const int cp = idx & 127, g = (idx >> 7) & 3, t = idx >> 9;
        const bf16* arow = AB + (size_t)t * 1024 + g * 128;
        float y = 0.f;
        for (int cc = 0; cc < 128; ++cc) { const int k = (cc * cp) & 127; y += bf2f(arow[cc]) * t128[2 * k] - bf2f(arow[512 + cc]) * t128[2 * k + 1]; }
        MIX[(size_t)t * 1024 + g * 128 + cp] = (bf16)f2bf(y * (1.f / 1024.f));
    }
    __syncthreads();
}

__device__ __forceinline__ void phase_outproj(Frame& F, const bf16* A, const bf16* Wt, const float* base, float* X, const float* gate  , const float* bias) {
    RowLin rp{A, (size_t)D};
    for (int u = F.wg; u < (T / 128) * 8; u += F.G) {
        const int mt = u / 8, nt = u % 8;
        auto epi = [&](int mb, int nb, const f32x16& c0, const f32x16& c1, int lane) {
            const int h = lane >> 5, cl = lane & 31, b = mb >> 13;
#pragma unroll
            for (int half = 0; half < 2; ++half) { const int col = nb + 32 * half + cl; const float gv = gate[(size_t)b * 6144 + col], bv = bias ? bias[col] : 0.f;
#pragma unroll
                for (int i = 0; i < 16; ++i) { const size_t o = (size_t)(mb + crow(i, h)) * D + col; const float a = half ? c1[i] : c0[i]; X[o] = base[o] + gv * (a + bv); } }
        };
        sgemm_tile(rp, Wt, D, mt * 128, nt * 128, epi, F.wave, F.lane);
    }
}

__device__ __forceinline__ void route_select(const float (&lg)[16], const float* rb, int& be1, int& be2, float& w1, float& w2) {
    float best = -1e30f; float bs1 = 0.f, bs2 = 0.f; be1 = 0; be2 = 0;
#pragma unroll
    for (int g = 0; g < 4; ++g) {
        float v1 = -1e30f, v2 = -1e30f, s1 = 0.f, s2 = 0.f; int j1 = 0, j2 = 0;
#pragma unroll
        for (int q = 0; q < 4; ++q) { const float sc = sigmoid_f(lg[4 * g + q]), x = sc + rb[4 * g + q];
            if (x > v1) { v2 = v1; j2 = j1; s2 = s1; v1 = x; j1 = q; s1 = sc; } else if (x > v2) { v2 = x; j2 = q; s2 = sc; } }
        const float gs = v1 + v2;
        if (gs > best) { best = gs; be1 = 4 * g + j1; be2 = 4 * g + j2; bs1 = s1; bs2 = s2; }
    }
    const float inv = 1.f / (bs1 + bs2); w1 = bs1 * inv; w2 = bs2 * inv;
}
__device__ __forceinline__ void phase_norm2_route(Frame& F, int layer) {
    const float* mod = (const float*)(F.ws + WS_MOD) + (size_t)layer * 5 * 6144;
    const float* X = F.out; const bf16* XB = (const bf16*)(F.ws + WS_XB); bf16* HB = (bf16*)(F.ws + WS_HB);
    const float* rw = F.in[I_RW]; const float* rb = F.in[I_RB];
    int* tok_e = (int*)(F.ws + WS_TOKE); int* tok_p = (int*)(F.ws + WS_TOKP); float* tok_w = (float*)(F.ws + WS_TOKW);
    int* slot_t = (int*)(F.ws + WS_SLOTT) + layer * 16 * CAP;
    float* slot_w = (float*)(F.ws + WS_SLOTW) + layer * 16 * CAP;
    unsigned* cnt = F.ctl + CW_CNT + layer * 16 * 64;
    LAS float* rwt = (LAS float*)F.lds;
    LAS int* sel_e = (LAS int*)(F.lds + 65536);
    LAS float* sel_w = (LAS float*)(F.lds + 65536 + 1024);
    LAS int* wcnt = (LAS int*)(F.lds + 65536 + 2048);
    LAS int* ebase = wcnt + 64;
    __syncthreads();
    for (int t = F.tid; t < 4096; t += NTHR) { const int i = t >> 2, e4 = t & 3; const f32x4 w = *(const f32x4*)(rw + (size_t)i * 16 + 4 * e4);
        const int p = (i & 512) + 256 * ((i >> 2) & 1) + 4 * ((i >> 3) & 63) + (i & 3);
        rwt[(4 * e4 + 0) * 1024 + p] = w.x; rwt[(4 * e4 + 1) * 1024 + p] = w.y; rwt[(4 * e4 + 2) * 1024 + p] = w.z; rwt[(4 * e4 + 3) * 1024 + p] = w.w; }
    __syncthreads();
    for (int rb0 = F.wg; rb0 < T / 128; rb0 += F.G) {
        const int b = (rb0 * 128) >> 13;
        f32x4 gm[4], sh[4];
        { const float* m = mod + (size_t)b * 6144; const float* g = F.in[I_NFG] + layer * D;
#pragma unroll
          for (int jj = 0; jj < 4; ++jj) { const int o = ROFF(F.lane, jj); gm[jj] = *(const f32x4*)(g + o) * (1.f + *(const f32x4*)(m + 4096 + o)); sh[jj] = *(const f32x4*)(m + 3072 + o); } }
        const int rbase = rb0 * 128 + F.wave * 16;
        f32x4 v0[4], v1[4]; xrow_load(X, XB, (size_t)rbase, F.lane, v0); xrow_load(X, XB, (size_t)(rbase + 1), F.lane, v1);
#pragma unroll 1
        for (int j = 0; j < 16; j += 2) {
            const int lr = F.wave * 16 + j, row = rbase + j;
            f32x4 n0[4], n1[4];
            { const int nr = (j + 2 < 16) ? row + 2 : row; xrow_load(X, XB, (size_t)nr, F.lane, n0); xrow_load(X, XB, (size_t)(nr + 1), F.lane, n1); }
            const float rstd0 = rsqrtf(row_sumsq(v0) * (1.f / D) + EPS), rstd1 = rsqrtf(row_sumsq(v1) * (1.f / D) + EPS);
#pragma unroll
            for (int jj = 0; jj < 4; ++jj) { v0[jj] = v0[jj] * rstd0 * gm[jj] + sh[jj]; v1[jj] = v1[jj] * rstd1 * gm[jj] + sh[jj]; }
            row_store_bf16(HB + (size_t)row * D, v0, F.lane); row_store_bf16(HB + (size_t)(row + 1) * D, v1, F.lane);
            float lg0[16], lg1[16];
#pragma unroll
            for (int e = 0; e < 16; ++e) { float a0 = 0.f, a1 = 0.f;
#pragma unroll
                for (int jj = 0; jj < 4; ++jj) { const f32x4 w4 = *(const LAS f32x4*)(rwt + e * 1024 + 256 * jj + 4 * F.lane);
                    a0 += (v0[jj].x * w4.x + v0[jj].y * w4.y) + (v0[jj].z * w4.z + v0[jj].w * w4.w); a1 += (v1[jj].x * w4.x + v1[jj].y * w4.y) + (v1[jj].z * w4.z + v1[jj].w * w4.w); }
                lg0[e] = a0; lg1[e] = a1; }
#pragma unroll
            for (int e = 0; e < 16; ++e) { lg0[e] = wave_sum(lg0[e]); lg1[e] = wave_sum(lg1[e]); }
            int e1, e2; float w1, w2;
            route_select(lg0, rb, e1, e2, w1, w2);
            if (F.lane == 0) { sel_e[2 * lr] = e1; sel_e[2 * lr + 1] = e2; sel_w[2 * lr] = w1; sel_w[2 * lr + 1] = w2; }
            route_select(lg1, rb, e1, e2, w1, w2);
            if (F.lane == 0) { sel_e[2 * lr + 2] = e1; sel_e[2 * lr + 3] = e2; sel_w[2 * lr + 2] = w1; sel_w[2 * lr + 3] = w2; }
#pragma unroll
            for (int jj = 0; jj < 4; ++jj) { v0[jj] = n0[jj]; v1[jj] = n1[jj]; }
        }
        __syncthreads();
        int my_e = 0, my_rank = 0; float my_w = 0.f;
        if (F.tid < 256) { my_e = sel_e[F.tid]; my_w = sel_w[F.tid];
            const unsigned long long below = (1ull << F.lane) - 1ull;
#pragma unroll 1
            for (int ee = 0; ee < 16; ++ee) { const unsigned long long mk = __ballot(my_e == ee);
                if (my_e == ee) my_rank = __popcll(mk & below);
                if (F.lane == 0) wcnt[F.wave * 16 + ee] = __popcll(mk); } }
        __syncthreads();
        if (F.tid < 16) { const int n = wcnt[F.tid] + wcnt[16 + F.tid] + wcnt[32 + F.tid] + wcnt[48 + F.tid];
            ebase[F.tid] = n ? (int)atomicAdd(cnt + F.tid * 64, (unsigned)n) : 0; }
        __syncthreads();
        if (F.tid < 256) { int pos = ebase[my_e] + my_rank;
            for (int w = 0; w < F.wave; ++w) pos += wcnt[w * 16 + my_e];
            const int tok = rb0 * 128 + (F.tid >> 1), k = F.tid & 1;
            slot_t[my_e * CAP + pos] = tok; slot_w[my_e * CAP + pos] = my_w; tok_e[2 * tok + k] = my_e; tok_p[2 * tok + k] = pos; tok_w[2 * tok + k] = my_w; }
        __syncthreads();
    }
}


__device__ __forceinline__ void phase_norm2_route_mfma(Frame& F, int layer) {
    constexpr int AP = 1032;
    const float* mod = (const float*)(F.ws + WS_MOD) + (size_t)layer * 5 * 6144;
    const bf16* XB = (const bf16*)(F.ws + WS_XB); bf16* HB = (bf16*)(F.ws + WS_HB);
    const float* rw = F.in[I_RW]; const float* rb = F.in[I_RB]; const float* gsrc = F.in[I_NFG] + layer * D;
    int* tok_e = (int*)(F.ws + WS_TOKE); int* tok_p = (int*)(F.ws + WS_TOKP); float* tok_w = (float*)(F.ws + WS_TOKW);
    int* slot_t = (int*)(F.ws + WS_SLOTT) + layer * 16 * CAP;
    float* slot_w = (float*)(F.ws + WS_SLOTW) + layer * 16 * CAP;
    unsigned* cnt = F.ctl + CW_CNT + layer * 16 * 64;
    LAS bf16* AH = (LAS bf16*)F.lds; LAS bf16* AL = AH + 16 * AP;
    LAS float* cbv = (LAS float*)(F.lds + 2 * 16 * AP * 2);
    LAS float* rstdv = cbv + 16;
    LAS float* lgt = rstdv + 128;
    LAS int* sel_e = (LAS int*)(lgt + 128 * 16);
    LAS float* sel_w = (LAS float*)(sel_e + 256);
    LAS int* wcnt = (LAS int*)(sel_w + 256);
    LAS int* ebase = wcnt + 64;
    LAS float* cpart = (LAS float*)(ebase + 16);
    for (int rb0 = F.wg; rb0 < T / 128; rb0 += F.G) {
        const int b = (rb0 * 128) >> 13; const float* m = mod + (size_t)b * 6144;
        __syncthreads();
        { float cp[16];
#pragma unroll
          for (int e = 0; e < 16; ++e) cp[e] = 0.f;
          for (int k = F.tid; k < D; k += NTHR) { const float gmk = gsrc[k] * (1.f + m[4096 + k]), shk = m[3072 + k];
#pragma unroll
              for (int e4 = 0; e4 < 4; ++e4) { const f32x4 w4 = *(const f32x4*)(rw + (size_t)k * 16 + 4 * e4);
#pragma unroll
                  for (int q = 0; q < 4; ++q) { const int e = 4 * e4 + q; const float pr = gmk * w4[q]; const unsigned hi = f2bf(pr); const unsigned lo = f2bf(pr - bf2f(hi));
                      AH[e * AP + k] = (bf16)hi; AL[e * AP + k] = (bf16)lo; cp[e] += shk * w4[q]; } } }
#pragma unroll
          for (int e = 0; e < 16; ++e) { const float t = wave_sum(cp[e]); if (F.lane == 0) cpart[F.wave * 16 + e] = t; } }
        __syncthreads();
        if (F.tid < 16) { float t = 0.f;
#pragma unroll
            for (int w = 0; w < 8; ++w) t += cpart[w * 16 + F.tid];
            cbv[F.tid] = t; }
        f32x4 gm[4], sh[4];
#pragma unroll
        for (int jj = 0; jj < 4; ++jj) { const int o = ROFF(F.lane, jj); gm[jj] = *(const f32x4*)(gsrc + o) * (1.f + *(const f32x4*)(m + 4096 + o)); sh[jj] = *(const f32x4*)(m + 3072 + o); }
        const int rbase = rb0 * 128 + F.wave * 16;
        {
            u32x4 raw[16][2];
#pragma unroll
            for (int j = 0; j < 16; ++j)
#pragma unroll
                for (int hh = 0; hh < 2; ++hh) raw[j][hh] = *(const u32x4*)(XB + (size_t)(rbase + j) * D + 512 * hh + 8 * F.lane);
            float W[8], X[4], Y[2];
#pragma unroll
            for (int i = 0; i < 8; ++i) { float sa = 0.f, sb = 0.f;
#pragma unroll
                for (int hh = 0; hh < 2; ++hh) { const u32x4 a = raw[2 * i][hh], c = raw[2 * i + 1][hh];
                    sa = dot2_bf16(a.x, a.x, sa); sa = dot2_bf16(a.y, a.y, sa); sa = dot2_bf16(a.z, a.z, sa); sa = dot2_bf16(a.w, a.w, sa);
                    sb = dot2_bf16(c.x, c.x, sb); sb = dot2_bf16(c.y, c.y, sb); sb = dot2_bf16(c.z, c.z, sb); sb = dot2_bf16(c.w, c.w, sb); }
                W[i] = swap32_add(sa, sb); }
#pragma unroll
            for (int i = 0; i < 4; ++i) X[i] = swap16_add(W[2 * i], W[2 * i + 1]);
            const bool b3 = (F.lane & 8) != 0, b2 = (F.lane & 4) != 0;
#pragma unroll
            for (int i = 0; i < 2; ++i) Y[i] = sel_add<0x140>(X[2 * i], X[2 * i + 1], b3);
            float Z = sel_add<0x141>(Y[0], Y[1], b2);
            Z += dppf<0x4E>(Z); Z += dppf<0xB1>(Z);
            const int rr = ((F.lane >> 5) & 1) + ((F.lane >> 4) & 1) * 2 + ((F.lane >> 3) & 1) * 4 + ((F.lane >> 2) & 1) * 8;
            if (!(F.lane & 3)) rstdv[F.wave * 16 + rr] = rsqrtf(Z * (1.f / D) + EPS);
            __builtin_amdgcn_wave_barrier();
            float rs[16];
#pragma unroll
            for (int i = 0; i < 4; ++i) { const f32x4 t = *(const LAS f32x4*)(rstdv + F.wave * 16 + 4 * i); rs[4 * i] = t.x; rs[4 * i + 1] = t.y; rs[4 * i + 2] = t.z; rs[4 * i + 3] = t.w; }
#pragma unroll
            for (int j = 0; j < 16; ++j) { f32x4 v[4];
#pragma unroll
                for (int hh = 0; hh < 2; ++hh) { const u32x4 w = raw[j][hh]; v[2 * hh] = (f32x4){bflo(w.x), bfhi(w.x), bflo(w.y), bfhi(w.y)}; v[2 * hh + 1] = (f32x4){bflo(w.z), bfhi(w.z), bflo(w.w), bfhi(w.w)}; }
#pragma unroll
                for (int jj = 0; jj < 4; ++jj) v[jj] = v[jj] * rs[j] * gm[jj] + sh[jj];
                row_store_bf16(HB + (size_t)(rbase + j) * D, v, F.lane); }
        }
        __syncthreads();
        { const int fr = F.lane & 15, fq = F.lane >> 4;
          f32x4 acc = {0.f, 0.f, 0.f, 0.f};
          const bf16* xr = XB + (size_t)(rb0 * 128 + 16 * F.wave + fr) * D + 8 * fq;
          const LAS bf16* ah = AH + fr * AP + 8 * fq; const LAS bf16* al = AL + fr * AP + 8 * fq;
#pragma unroll
          for (int s2 = 0; s2 < 32; ++s2) { const bf16x8 xb = *(const bf16x8*)(xr + 32 * s2);
              acc = __builtin_amdgcn_mfma_f32_16x16x32_bf16(*(const LAS bf16x8*)(ah + 32 * s2), xb, acc, 0, 0, 0);
              acc = __builtin_amdgcn_mfma_f32_16x16x32_bf16(*(const LAS bf16x8*)(al + 32 * s2), xb, acc, 0, 0, 0); }
          const int lrow = 16 * F.wave + fr; const float rs = rstdv[lrow];
#pragma unroll
          for (int i = 0; i < 4; ++i) lgt[lrow * 16 + 4 * fq + i] = rs * acc[i] + cbv[4 * fq + i]; }
        __syncthreads();
        if (F.tid < 128) { float lg[16];
#pragma unroll
            for (int e4 = 0; e4 < 4; ++e4) { const f32x4 t = *(const LAS f32x4*)(lgt + F.tid * 16 + 4 * e4); lg[4 * e4] = t.x; lg[4 * e4 + 1] = t.y; lg[4 * e4 + 2] = t.z; lg[4 * e4 + 3] = t.w; }
            int e1, e2; float w1, w2; route_select(lg, rb, e1, e2, w1, w2);
            sel_e[2 * F.tid] = e1; sel_e[2 * F.tid + 1] = e2; sel_w[2 * F.tid] = w1; sel_w[2 * F.tid + 1] = w2; }
        __syncthreads();
        int my_e = 0, my_rank = 0; float my_w = 0.f;
        if (F.tid < 256) { my_e = sel_e[F.tid]; my_w = sel_w[F.tid];
            const unsigned long long below = (1ull << F.lane) - 1ull;
#pragma unroll 1
            for (int ee = 0; ee < 16; ++ee) { const unsigned long long mk = __ballot(my_e == ee);
                if (my_e == ee) my_rank = __popcll(mk & below);
                if (F.lane == 0) wcnt[F.wave * 16 + ee] = __popcll(mk); } }
        __syncthreads();
        if (F.tid < 16) { const int n = wcnt[F.tid] + wcnt[16 + F.tid] + wcnt[32 + F.tid] + wcnt[48 + F.tid];
            ebase[F.tid] = n ? (int)atomicAdd(cnt + F.tid * 64, (unsigned)n) : 0; }
        __syncthreads();
        if (F.tid < 256) { int pos = ebase[my_e] + my_rank;
            for (int w = 0; w < F.wave; ++w) pos += wcnt[w * 16 + my_e];
            const int tok = rb0 * 128 + (F.tid >> 1), k = F.tid & 1;
            slot_t[my_e * CAP + pos] = tok; slot_w[my_e * CAP + pos] = my_w; tok_e[2 * tok + k] = my_e; tok_p[2 * tok + k] = pos; tok_w[2 * tok + k] = my_w; }
    }
    __syncthreads();
}

constexpr int MOEMAP_OFF = LDS_BYTES - 256;
__device__ __forceinline__ LAS int* moe_map(Frame& F, int layer) {
    LAS int* mm = (LAS int*)(F.lds + MOEMAP_OFF);
    __syncthreads();
    if (F.tid < 64) { const unsigned* cnt = F.ctl + CW_CNT + layer * 16 * 64;
        const int n = (F.tid < 16) ? (int)__hip_atomic_load(cnt + F.tid * 64, __ATOMIC_RELAXED, __HIP_MEMORY_SCOPE_AGENT) : 0;
        const int pad = (n + 255) & ~255; int x = pad;
#pragma unroll
        for (int o = 1; o < 16; o <<= 1) { const int t = __shfl_up(x, o); if (F.lane >= o) x += t; }
        if (F.tid < 16) { mm[F.tid] = n; mm[16 + F.tid] = x - pad; } }
    __syncthreads();
    return mm;
}
struct RowGather { const bf16* base; const int* list; int n; __device__ __forceinline__ const bf16* operator()(int m) const { const int tok = m < n ? list[m] : 0; return base + (size_t)tok * D; } };

__device__ __forceinline__ void phase_moe_gateup(Frame& F, int layer) {
    LAS int* mm = moe_map(F, layer);
    const bf16* HB = (const bf16*)(F.ws + WS_HB); bf16* HID = (bf16*)(F.ws + WS_HID);
    const int* slot_t = (const int*)(F.ws + WS_SLOTT) + layer * 16 * CAP; const float* slot_w = (const float*)(F.ws + WS_SLOTW) + layer * 16 * CAP;
    int ubase = 0;
#pragma unroll 1
    for (int e = 0; e < 16; ++e) {
        const int n = mm[e], hbe = mm[16 + e], rt = (n + 127) >> 7, nu = rt * 8;
        const bf16* Wt = (const bf16*)(F.ws + WS_WGU) + (size_t)(layer * 16 + e) * 1024 * 1024;
        RowGather rp{HB, slot_t + e * CAP, n};
        int first = (F.wg - ubase % F.G + F.G) % F.G;
        for (int u = first; u < nu; u += F.G) {
            const int mt = u / 8, nt = u % 8;
            auto epi = [&](int mb, int nb, const f32x16& c0, const f32x16& c1, int lane) {
                const int h = lane >> 5, cl = lane & 31; const int col = (nb >> 1) + cl;
#pragma unroll
                for (int i = 0; i < 16; ++i) { const int r = mb + crow(i, h);
                    if (r < n) { const float w = slot_w[e * CAP + r]; HID[(size_t)(hbe + r) * FF + col] = (bf16)f2bf(w * silu_f(c0[i]) * c1[i]); } }
            };
            sgemm_tile(rp, Wt, D, mt * 128, nt * 128, epi, F.wave, F.lane);
        }
        ubase += nu;
    }
}
__device__ __forceinline__ void phase_moe_down(Frame& F, int layer) {
    LAS int* mm = moe_map(F, layer);
    const bf16* HID = (const bf16*)(F.ws + WS_HID); bf16* Y = (bf16*)(F.ws + WS_Y);
    int ubase = 0;
#pragma unroll 1
    for (int e = 0; e < 16; ++e) {
        const int n = mm[e], hbe = mm[16 + e], rt = (n + 127) >> 7, nu = rt * 8;
        const bf16* Wt = (const bf16*)(F.ws + WS_WDN) + (size_t)(layer * 16 + e) * 1024 * 512;
        RowLin rp{HID + (size_t)hbe * FF, (size_t)FF};
        int first = (F.wg - ubase % F.G + F.G) % F.G;
        for (int u = first; u < nu; u += F.G) {
            const int mt = u / 8, nt = u % 8;
            auto epi = [&](int mb, int nb, const f32x16& c0, const f32x16& c1, int lane) {
                const int h = lane >> 5, cl = lane & 31;
#pragma unroll
                for (int i = 0; i < 16; ++i) { const int r = mb + crow(i, h);
                    if (r < n) { bf16* yr = Y + (size_t)(hbe + r) * D + nb + cl; yr[0] = (bf16)f2bf(c0[i]); yr[32] = (bf16)f2bf(c1[i]); } }
            };
            sgemm_tile(rp, Wt, FF, mt * 128, nt * 128, epi, F.wave, F.lane);
        }
        ubase += nu;
    }
}

template <bool FINAL>
__device__ __forceinline__ void phase_combine(Frame& F, int layer) {
    LAS int* hbs = moe_map(F, layer) + 16;
    const int gw = F.wg * NWAVES + F.wave, NGW = F.G * NWAVES;
    const float* mod = (const float*)(F.ws + WS_MOD);
    const int* tok_e = (const int*)(F.ws + WS_TOKE); const int* tok_p = (const int*)(F.ws + WS_TOKP);
    const unsigned char* Y8 = (const unsigned char*)(F.ws + WS_Y);
    float* X = F.out; bf16* XB = (bf16*)(F.ws + WS_XB); bf16* HB = (bf16*)(F.ws + WS_HB);
    for (int blk = gw; blk < T / 16; blk += NGW) {
        const int rbase = blk * 16, b = rbase >> 13;
        f32x4 g2v[4], gm[4], shv[4];
        { const float* g2 = mod + ((size_t)layer * 5 + b) * 6144 + 5120;
#pragma unroll
          for (int j = 0; j < 4; ++j) { const int o = ROFF(F.lane, j); g2v[j] = *(const f32x4*)(g2 + o) * (1.f / YSCALE);
              if (FINAL) { gm[j] = *(const f32x4*)(F.in[I_FNG] + o); shv[j] = (f32x4){0.f, 0.f, 0.f, 0.f}; }
              else { const float* m = mod + ((size_t)(layer + 1) * 5 + b) * 6144; gm[j] = *(const f32x4*)(F.in[I_NMG] + (layer + 1) * D + o) * (1.f + *(const f32x4*)(m + 1024 + o)); shv[j] = *(const f32x4*)(m + o); } } }
        int4 te = *(const int4*)(tok_e + 2 * rbase), tp = *(const int4*)(tok_p + 2 * rbase);
        u32x4 xa[2][2], xn[2][2]; u32x2 ya[2][2][2], yn[2][2][2];
        { const int s00 = hbs[te.x] + tp.x, s01 = hbs[te.y] + tp.y, s10 = hbs[te.z] + tp.z, s11 = hbs[te.w] + tp.w;
#pragma unroll
          for (int jj = 0; jj < 2; ++jj) { const int o = 512 * jj + 8 * F.lane;
              xa[0][jj] = *(const u32x4*)(XB + (size_t)rbase * D + o); xa[1][jj] = *(const u32x4*)(XB + (size_t)(rbase + 1) * D + o);
              ya[0][0][jj] = *(const u32x2*)(Y8 + (size_t)s00 * D + o); ya[0][1][jj] = *(const u32x2*)(Y8 + (size_t)s01 * D + o);
              ya[1][0][jj] = *(const u32x2*)(Y8 + (size_t)s10 * D + o); ya[1][1][jj] = *(const u32x2*)(Y8 + (size_t)s11 * D + o); } }
        te = *(const int4*)(tok_e + 2 * (rbase + 2)); tp = *(const int4*)(tok_p + 2 * (rbase + 2));
#pragma unroll 1
        for (int jr = 0; jr < 16; jr += 2) {
            const int row = rbase + jr;
            if (jr + 2 < 16) { const int nr = row + 2;
                const int s00 = hbs[te.x] + tp.x, s01 = hbs[te.y] + tp.y, s10 = hbs[te.z] + tp.z, s11 = hbs[te.w] + tp.w;
#pragma unroll
                for (int jj = 0; jj < 2; ++jj) { const int o = 512 * jj + 8 * F.lane;
                    xn[0][jj] = *(const u32x4*)(XB + (size_t)nr * D + o); xn[1][jj] = *(const u32x4*)(XB + (size_t)(nr + 1) * D + o);
                    yn[0][0][jj] = *(const u32x2*)(Y8 + (size_t)s00 * D + o); yn[0][1][jj] = *(const u32x2*)(Y8 + (size_t)s01 * D + o);
                    yn[1][0][jj] = *(const u32x2*)(Y8 + (size_t)s10 * D + o); yn[1][1][jj] = *(const u32x2*)(Y8 + (size_t)s11 * D + o); }
                const int n2 = (jr + 4 < 16) ? row + 4 : row; te = *(const int4*)(tok_e + 2 * n2); tp = *(const int4*)(tok_p + 2 * n2); }
            f32x4 v[2][4];
#pragma unroll
            for (int q = 0; q < 2; ++q)
#pragma unroll
                for (int jj = 0; jj < 2; ++jj) { const u32x4 xw = xa[q][jj]; const u32x2 a0 = ya[q][0][jj], a1 = ya[q][1][jj];
                    v[q][2 * jj] = (f32x4){bflo(xw.x), bfhi(xw.x), bflo(xw.y), bfhi(xw.y)} + g2v[2 * jj] * (un_fp8x4(a0.x) + un_fp8x4(a1.x));
                    v[q][2 * jj + 1] = (f32x4){bflo(xw.z), bfhi(xw.z), bflo(xw.w), bfhi(xw.w)} + g2v[2 * jj + 1] * (un_fp8x4(a0.y) + un_fp8x4(a1.y)); }
            const float rstd0 = rsqrtf(row_sumsq(v[0]) * (1.f / D) + EPS), rstd1 = rsqrtf(row_sumsq(v[1]) * (1.f / D) + EPS);
#pragma unroll
            for (int q = 0; q < 2; ++q) { const float rstd = q ? rstd1 : rstd0; const size_t ro = (size_t)(row + q) * D;
                if (FINAL) {
#pragma unroll
                    for (int j = 0; j < 4; ++j) *(f32x4*)(X + ro + ROFF(F.lane, j)) = v[q][j] * rstd * gm[j];
                } else {
                    row_store_bf16(XB + ro, v[q], F.lane);
#pragma unroll
                    for (int j = 0; j < 4; ++j) v[q][j] = v[q][j] * rstd * gm[j] + shv[j];
                    row_store_bf16(HB + ro, v[q], F.lane);
                }
            }
#pragma unroll
            for (int q = 0; q < 2; ++q)
#pragma unroll
                for (int jj = 0; jj < 2; ++jj) { xa[q][jj] = xn[q][jj]; ya[q][0][jj] = yn[q][0][jj]; ya[q][1][jj] = yn[q][1][jj]; }
        }
    }
    __syncthreads();
}

__device__ __forceinline__ void phase_pw1(Frame& F) {
    const bf16* HB = (const bf16*)(F.ws + WS_HB); const bf16* Wt = (const bf16*)(F.ws + WS_WPW1); bf16* U = (bf16*)(F.ws + WS_U);
    const float* bias = F.in[I_PW1B];
    RowLin rp{HB, (size_t)D};
    for (int u = F.wg; u < (T / 128) * 16; u += F.G) {
        const int mt = u / 16, nt = u % 16;
        auto epi = [&](int mb, int nb, const f32x16& c0, const f32x16& c1, int lane) {
            const int h = lane >> 5, cl = lane & 31, col = (nb >> 1) + cl; const float ba = bias[col], bg = bias[1024 + col];
#pragma unroll
            for (int i = 0; i < 16; ++i) U[(size_t)(mb + crow(i, h)) * D + col] = (bf16)f2bf((c0[i] + ba) * sigmoid_f(c1[i] + bg));
        };
        sgemm_tile(rp, Wt, D, mt * 128, nt * 128, epi, F.wave, F.lane);
    }
}
__device__ __forceinline__ void phase_dwconv(Frame& F) {
    const bf16* U = (const bf16*)(F.ws + WS_U); bf16* V1 = (bf16*)(F.ws + WS_V1);
    const float* dww = F.in[I_DWW]; const float* dwb = F.in[I_DWB]; const float* lng = F.in[I_LNG]; const float* lnb = F.in[I_LNB];
    const int gw = F.wg * NWAVES + F.wave, NGW = F.G * NWAVES;
    for (int row = gw; row < T; row += NGW) {
        const int l = row & (L - 1);
        f32x4 acc[4];
#pragma unroll
        for (int j = 0; j < 4; ++j) acc[j] = *(const f32x4*)(dwb + 4 * F.lane + 256 * j);
        for (int tp = 0; tp < CONVW; ++tp) { const int ll = l + tp - 15; if (ll < 0 || ll >= L) continue;
            const bf16* ur = U + (size_t)(row + tp - 15) * D; const float* wr = dww + (size_t)tp * D;
#pragma unroll
            for (int j = 0; j < 4; ++j) { const int o = 4 * F.lane + 256 * j; const u32x2 uu = *(const u32x2*)(ur + o); const f32x4 ww = *(const f32x4*)(wr + o);
                acc[j].x += bflo(uu.x) * ww.x; acc[j].y += bfhi(uu.x) * ww.y; acc[j].z += bflo(uu.y) * ww.z; acc[j].w += bfhi(uu.y) * ww.w; } }
        float s = 0.f;
#pragma unroll
        for (int j = 0; j < 4; ++j) s += (acc[j].x + acc[j].y) + (acc[j].z + acc[j].w);
        const float mean = wave_sum(s) * (1.f / D); float q = 0.f;
#pragma unroll
        for (int j = 0; j < 4; ++j) { acc[j] = acc[j] - mean; q += (acc[j].x * acc[j].x + acc[j].y * acc[j].y) + (acc[j].z * acc[j].z + acc[j].w * acc[j].w); }
        const float rstd = rsqrtf(wave_sum(q) * (1.f / D) + EPS);
#pragma unroll
        for (int j = 0; j < 4; ++j) { const int o = 4 * F.lane + 256 * j; const f32x4 gg = *(const f32x4*)(lng + o), bb = *(const f32x4*)(lnb + o);
            f32x4 y = acc[j] * rstd * gg + bb; y.x = silu_f(y.x); y.y = silu_f(y.y); y.z = silu_f(y.z); y.w = silu_f(y.w); acc[j] = y; }
        row_store_bf16(V1 + (size_t)row * D, acc, F.lane);
    }
}


namespace pg {
constexpr int BM = 256, BK = 64, HALF = 128, HTB = HALF * BK * 2, STAGE_BYTES = 8 * HTB;
constexpr int TAB_OFF = STAGE_BYTES;
__device__ __forceinline__ int lds_byte(int r, int c) { const int st = (r >> 4) * 2 + (c >> 5), rr = r & 15, cc = c & 31, ob = rr * 64 + cc * 2; return st * 1024 + (ob ^ (((ob >> 9) & 1) << 5)); }
__device__ __forceinline__ void stage_rc(int b, int& R, int& C) { const int st = b / 1024, sb = b % 1024, swz = sb ^ (((sb >> 9) & 1) << 5); R = (st >> 1) * 16 + swz / 64; C = (st & 1) * 32 + (swz % 64) / 2; }
__device__ __forceinline__ int perm32(int rho) { const int n = rho >> 4, i = rho & 15; return 8 * (i >> 2) + 4 * n + (i & 3); }
__device__ __forceinline__ unsigned cvt_pk_bf16(float lo, float hi) { unsigned r; asm volatile("v_cvt_pk_bf16_f32 %0, %1, %2" : "=v"(r) : "v"(lo), "v"(hi)); return r; }

struct GU { const char* B; int p0, p1, p2, p3; };

template <class Epi, class Sched>
__device__ __forceinline__ void gemm_phase(LAS unsigned char* lds, const char* Abase, const int K, const Sched& S, const Epi& E) {
    const int tid = threadIdx.x, wid = __builtin_amdgcn_readfirstlane(tid >> 6), lane = tid & 63, wr = wid >> 2, wc = wid & 3, fr = lane & 15, fq = lane >> 4;
    const int nt = K / BK;
    int sR[2], sC[2]; unsigned voffB[2];
#pragma unroll
    for (int i = 0; i < 2; ++i) { int R, C; stage_rc(tid * 16 + i * 8192, R, C); sR[i] = R; sC[i] = C; const int Rb = Epi::PERM ? ((R & ~31) + perm32(R & 31)) : R; voffB[i] = (unsigned)(Rb * K + C) * 2u; }
    const size_t kstep = (size_t)(BK * 2);
    const size_t hstep = (size_t)HALF * K * 2;
    const unsigned ldsw = (unsigned)wid * 1024u;
    const int aoff = lds_byte(wr * 64 + fr, fq * 8), boff = lds_byte(wc * 32 + fr, fq * 8);
#define PG_SA(b, h) (((b) * 2 + (h)) * HTB)
#define PG_SB(b, h) ((4 + (b) * 2 + (h)) * HTB)
#define PG_STAGE(bufoff, gbase, voff) do { _Pragma("unroll") for (int _i = 0; _i < 2; ++_i) \
        __builtin_amdgcn_global_load_lds((const unsigned*)((const char*)(gbase) + (voff)[_i]), (LAS unsigned*)(lds + (bufoff) + ldsw + _i * 8192), 16, 0, 0); } while (0)
#define PG_LDA(dst, b, h) do { _Pragma("unroll") for (int m = 0; m < 4; ++m) _Pragma("unroll") for (int k = 0; k < 2; ++k) dst[m][k] = *(const LAS bf16x8*)(lds + PG_SA(b, h) + aoff + m * 2048 + k * 1024); } while (0)
#define PG_LDB(dst, b, h) do { _Pragma("unroll") for (int n = 0; n < 2; ++n) _Pragma("unroll") for (int k = 0; k < 2; ++k) dst[n][k] = *(const LAS bf16x8*)(lds + PG_SB(b, h) + boff + n * 2048 + k * 1024); } while (0)
#define PG_MMA(ai, bj, At, Bt) do { __builtin_amdgcn_s_setprio(1); _Pragma("unroll") for (int m = 0; m < 4; ++m) _Pragma("unroll") for (int n = 0; n < 2; ++n) _Pragma("unroll") for (int k = 0; k < 2; ++k) \
        acc[ai][bj][m][n] = __builtin_amdgcn_mfma_f32_16x16x32_bf16(Bt[n][k], At[m][k], acc[ai][bj][m][n], 0, 0, 0); __builtin_amdgcn_s_setprio(0); } while (0)
#define PG_WAIT_V(n) asm volatile("s_waitcnt vmcnt(" #n ")" ::: "memory")
#define PG_WAIT_L(n) asm volatile("s_waitcnt lgkmcnt(" #n ")" ::: "memory")
#define PG_BAR __builtin_amdgcn_s_barrier()
#define PG_SCHED __builtin_amdgcn_sched_barrier(0)
    GU cur, nxt; int ui = 0;
    if (!S.next(0, cur)) return;
    f32x4 acc[2][2][4][2];
#pragma unroll
    for (int a = 0; a < 2; ++a)
#pragma unroll
        for (int b = 0; b < 2; ++b)
#pragma unroll
            for (int m = 0; m < 4; ++m)
#pragma unroll
                for (int n = 0; n < 2; ++n) acc[a][b][m][n] = (f32x4){0.f, 0.f, 0.f, 0.f};
    bf16x8 At[4][2], B0[2][2], B1[2][2];
    if constexpr (Sched::GATHER) { S.stage_table(cur, 0, lds, wid, lane); PG_WAIT_V(0); PG_BAR; }
    unsigned voC[2][2], voN[2][2];
#pragma unroll
    for (int h = 0; h < 2; ++h)
#pragma unroll
        for (int i = 0; i < 2; ++i) { voC[h][i] = S.voff(cur, 0, lds, h * HALF + sR[i], sC[i]); voN[h][i] = voC[h][i]; }
    const char* cB = cur.B;
    PG_STAGE(PG_SB(0, 0), cB, voffB); PG_STAGE(PG_SB(0, 1), cB + hstep, voffB); PG_STAGE(PG_SA(0, 0), Abase, voC[0]); PG_STAGE(PG_SA(0, 1), Abase, voC[1]);
    if (wr == 1) PG_BAR;
    PG_WAIT_V(2); PG_BAR;
    PG_STAGE(PG_SB(1, 0), cB + kstep, voffB); PG_STAGE(PG_SA(1, 0), Abase + kstep, voC[0]); PG_STAGE(PG_SB(1, 1), cB + hstep + kstep, voffB);
    PG_WAIT_V(6); PG_BAR;
    for (;;) {
        const bool has_next = S.next(ui + 1, nxt);
        if constexpr (Sched::GATHER) { if (has_next) S.stage_table(nxt, (ui + 1) & 1, lds, wid, lane); }
        const char* nB = has_next ? nxt.B : cB;
        for (int t = 0; t < nt; t += 2) {
            const bool last = (t == nt - 2);
            if (last && has_next) {
#pragma unroll
                for (int h = 0; h < 2; ++h)
#pragma unroll
                    for (int i = 0; i < 2; ++i) voN[h][i] = S.voff(nxt, (ui + 1) & 1, lds, h * HALF + sR[i], sC[i]);
            }
            unsigned vo2[2][2];
#pragma unroll
            for (int h = 0; h < 2; ++h)
#pragma unroll
                for (int i = 0; i < 2; ++i) vo2[h][i] = last ? voN[h][i] : voC[h][i];
            const char* a1 = Abase + (size_t)(t + 1) * kstep;
            const char* a2 = last ? Abase : Abase + (size_t)(t + 2) * kstep; const char* b2 = last ? nB : cB + (size_t)(t + 2) * kstep;
            const char* a3 = a2 + kstep; const char* b3 = b2 + kstep;
            PG_LDB(B0, 0, 0); PG_LDB(B1, 0, 1); PG_SCHED; PG_LDA(At, 0, 0); PG_STAGE(PG_SA(1, 1), a1, voC[1]);
            PG_WAIT_V(8); PG_WAIT_L(0); PG_BAR; PG_MMA(0, 0, At, B0); PG_MMA(0, 1, At, B1); PG_BAR; PG_SCHED;
            PG_LDA(At, 0, 1); PG_STAGE(PG_SB(0, 0), b2, voffB); PG_STAGE(PG_SB(0, 1), b2 + hstep, voffB); PG_STAGE(PG_SA(0, 0), a2, vo2[0]);
            PG_WAIT_V(8); PG_WAIT_L(0); PG_BAR; PG_MMA(1, 0, At, B0); PG_MMA(1, 1, At, B1); PG_BAR; PG_SCHED;
            PG_LDB(B0, 1, 0); PG_LDB(B1, 1, 1); PG_SCHED; PG_LDA(At, 1, 0); PG_STAGE(PG_SA(0, 1), a2, vo2[1]);
            PG_WAIT_V(8); PG_WAIT_L(0); PG_BAR; PG_MMA(0, 0, At, B0); PG_MMA(0, 1, At, B1); PG_BAR; PG_SCHED;
            PG_LDA(At, 1, 1); PG_STAGE(PG_SB(1, 0), b3, voffB); PG_STAGE(PG_SB(1, 1), b3 + hstep, voffB); PG_STAGE(PG_SA(1, 0), a3, vo2[0]);
            PG_WAIT_V(8); PG_WAIT_L(0); PG_BAR; PG_MMA(1, 0, At, B0); PG_MMA(1, 1, At, B1); PG_BAR; PG_SCHED;
        }
        if (wr == 0) PG_BAR;
        E(acc, cur, wr, wc, fr, fq);
        if (!has_next) break;
#pragma unroll
        for (int a = 0; a < 2; ++a)
#pragma unroll
            for (int b = 0; b < 2; ++b)
#pragma unroll
                for (int m = 0; m < 4; ++m)
#pragma unroll
                    for (int n = 0; n < 2; ++n) acc[a][b][m][n] = (f32x4){0.f, 0.f, 0.f, 0.f};
        cur = nxt; cB = nB; ++ui;
#pragma unroll
        for (int h = 0; h < 2; ++h)
#pragma unroll
            for (int i = 0; i < 2; ++i) voC[h][i] = voN[h][i];
        if (wr == 1) PG_BAR;
    }
    PG_WAIT_V(0);
    PG_BAR;
#undef PG_SA
#undef PG_SB
#undef PG_STAGE
#undef PG_LDA
#undef PG_LDB
#undef PG_MMA
#undef PG_WAIT_V
#undef PG_WAIT_L
#undef PG_BAR
#undef PG_SCHED
}

__device__ __forceinline__ void static_tile(int L, int nM, int nN, int& pm, int& pn) {
    const int nwg = nM * nN; int wgid = L; { const int q = nwg / 8, r = nwg % 8, xcd = wgid % 8, off = wgid / 8; wgid = (xcd < r ? xcd * (q + 1) : r * (q + 1) + (xcd - r) * q) + off; }
    const int nig = 8 * nN, gid = wgid / nig, fm = gid * 8, gsz = (nM - fm) < 8 ? (nM - fm) : 8;
    pm = fm + ((wgid % nig) % gsz); pn = (wgid % nig) / gsz;
}
struct DenseSched {
    static constexpr bool GATHER = false;
    const char* Bt; int K, nM, nN, G, c, xn, xm0, xpn;
    __device__ __forceinline__ bool next(int i, GU& u) const {
        const int L = i * G + c, nmain = nM * nN; int pm, pn;
        if (L < nmain) static_tile(L, nM, nN, pm, pn); else if (L < nmain + xn) { pm = xm0 + (L - nmain); pn = xpn; } else return false;
        u.B = Bt + (size_t)pn * BM * K * 2; u.p0 = pm; u.p1 = pn; u.p2 = 0; u.p3 = 0; return true;
    }
    __device__ __forceinline__ unsigned voff(const GU& u, int, LAS unsigned char*, int R, int C) const { return (unsigned)(((u.p0 * BM + R) * K + C) * 2); }
    __device__ __forceinline__ void stage_table(const GU&, int, LAS unsigned char*, int, int) const {}
};
template <bool GATHER_> struct MoeSched {
    static constexpr bool GATHER = GATHER_;
    const char* Wt; size_t wstride; int K; const int* list; LAS int* mm; int G, c;
    __device__ __forceinline__ bool next(int i, GU& u) const {
        int L = i * G + c;
        for (int e = 0; e < 16; ++e) { const int n = mm[e], nu = ((n + 255) >> 8) * 4;
            if (L < nu) { const int rt = L >> 2, pn = L & 3; u.B = Wt + (size_t)e * wstride + (size_t)pn * BM * K * 2; u.p0 = e; u.p1 = rt; u.p2 = pn; u.p3 = mm[16 + e]; return true; }
            L -= nu; }
        return false;
    }
    __device__ __forceinline__ unsigned voff(const GU& u, int buf, LAS unsigned char* lds, int R, int C) const {
        if constexpr (GATHER_) { const int tok = ((const LAS int*)(lds + TAB_OFF))[buf * 256 + R]; return (unsigned)((tok * K + C) * 2); }
        else return (unsigned)(((u.p3 + u.p1 * BM + R) * K + C) * 2);
    }
    __device__ __forceinline__ void stage_table(const GU& u, int buf, LAS unsigned char* lds, int wid, int lane) const {
        if constexpr (GATHER_) { const int r = (wid & 3) * 64 + lane;
            __builtin_amdgcn_global_load_lds((const unsigned*)(list + u.p0 * CAP + u.p1 * BM + r), (LAS unsigned*)(lds + TAB_OFF + buf * 1024 + (wid & 3) * 256), 4, 0, 0); }
    }
};

struct EpiInProj {
    static constexpr bool PERM = false;
    unsigned char* ws;
    __device__ __forceinline__ void operator()(const f32x4 (&acc)[2][2][4][2], const GU& u, int wr, int wc, int fr, int fq) const {
        const int pm = u.p0, pn = u.p1; const bool isctx = pm >= T / BM;
        float inv[4];
#pragma unroll
        for (int j = 0; j < 4; ++j) inv[j] = exp2f(-(float)(4 * fq + j) * (13.287712379549449f / 16.f));
#pragma unroll
        for (int bj = 0; bj < 2; ++bj) {
            const int cb = pn * BM + bj * HALF + wc * 32;
            bf16* dst; int pitch, cbase; bool rope = false;
            if (cb < 512) { dst = (bf16*)(ws + WS_UF); pitch = 512; cbase = 0; }
            else if (cb < 1024) { dst = (bf16*)(ws + WS_Q); pitch = 512; cbase = 512; rope = true; }
            else if (cb < 1152) { dst = isctx ? (bf16*)(ws + WS_CK) : (bf16*)(ws + WS_K); pitch = 128; cbase = 1024; rope = !isctx; }
            else { dst = isctx ? (bf16*)(ws + WS_CV) : (bf16*)(ws + WS_V); pitch = 128; cbase = 1152; }
            const bool bycol = ((cb >> 5) & 1) != 0;
#pragma unroll
            for (int ai = 0; ai < 2; ++ai)
#pragma unroll
                for (int m = 0; m < 4; ++m) {
                    const int row = pm * BM + ai * HALF + wr * 64 + m * 16 + fr;
                    f32x4 v0 = acc[ai][bj][m][0], v1 = acc[ai][bj][m][1];
                    if (rope) { const int l = row & (L - 1); const float pos = (float)(bycol ? (l & 63) : (l >> 6));
#pragma unroll
                        for (int j = 0; j < 4; ++j) { const float ang = pos * inv[j], cs = __cosf(ang), sn = __sinf(ang); const float x1 = v0[j], x2 = v1[j]; v0[j] = x1 * cs - x2 * sn; v1[j] = x1 * sn + x2 * cs; } }
                    const int orow = isctx ? row - T : row;
                    if (FAST_ATTN && cb >= 1152) {
                        const int kp = isctx ? CL : L, bb = isctx ? (orow >> 8) : (orow >> 13), key = isctx ? (orow & (CL - 1)) : (orow & (L - 1));
#pragma unroll
                        for (int n = 0; n < 2; ++n)
#pragma unroll
                            for (int j = 0; j < 4; ++j) { const int c = (cb - 1152) + 16 * n + 4 * fq + j;
                                dst[((size_t)bb * 128 + c) * kp + key] = (bf16)f2bf(n ? v1[j] : v0[j]); }
                        continue;
                    }
                    bf16* o = dst + (size_t)orow * pitch + (cb - cbase) + 4 * fq;
                    u32x2 w0, w1; w0.x = cvt_pk_bf16(v0[0], v0[1]); w0.y = cvt_pk_bf16(v0[2], v0[3]); w1.x = cvt_pk_bf16(v1[0], v1[1]); w1.y = cvt_pk_bf16(v1[2], v1[3]);
                    *(u32x2*)o = w0; *(u32x2*)(o + 16) = w1;
                }
        }
    }
};
struct EpiRes {
    static constexpr bool PERM = false;
    const float* base; float* X; const float* gate; const float* bias;
    __device__ __forceinline__ void operator()(const f32x4 (&acc)[2][2][4][2], const GU& u, int wr, int wc, int fr, int fq) const {
        const int row0 = u.p0 * BM + wr * 64 + fr, col0 = u.p1 * BM + wc * 32 + 4 * fq; const int b = (u.p0 * BM) >> 13;
        f32x4 gv[2][2], bv[2][2];
#pragma unroll
        for (int bj = 0; bj < 2; ++bj)
#pragma unroll
            for (int n = 0; n < 2; ++n) { gv[bj][n] = *(const f32x4*)(gate + (size_t)b * 6144 + col0 + bj * HALF + n * 16); bv[bj][n] = bias ? *(const f32x4*)(bias + col0 + bj * HALF + n * 16) : (f32x4){0.f, 0.f, 0.f, 0.f}; }
#pragma unroll
        for (int ai = 0; ai < 2; ++ai)
#pragma unroll
            for (int mp = 0; mp < 2; ++mp) {
                f32x4 bs[2][2][2];
#pragma unroll
                for (int mm = 0; mm < 2; ++mm) { const size_t off = (size_t)(row0 + ai * HALF + (2 * mp + mm) * 16) * D + col0;
#pragma unroll
                    for (int bj = 0; bj < 2; ++bj)
#pragma unroll
                        for (int n = 0; n < 2; ++n) bs[mm][bj][n] = *(const f32x4*)(base + off + bj * HALF + n * 16); }
#pragma unroll
                for (int mm = 0; mm < 2; ++mm) { const int m = 2 * mp + mm; const size_t off = (size_t)(row0 + ai * HALF + m * 16) * D + col0;
#pragma unroll
                    for (int bj = 0; bj < 2; ++bj)
#pragma unroll
                        for (int n = 0; n < 2; ++n) *(f32x4*)(X + off + bj * HALF + n * 16) = bs[mm][bj][n] + gv[bj][n] * (acc[ai][bj][m][n] + bv[bj][n]); }
                asm volatile("" ::: "memory"); }
    }
};
template <bool BASEBF> struct EpiResB {
    static constexpr bool PERM = true;
    const float* basef; bf16* XB; const float* gate; const float* bias;
    __device__ __forceinline__ void operator()(const f32x4 (&acc)[2][2][4][2], const GU& u, int wr, int wc, int fr, int fq) const {
        const int row0 = u.p0 * BM + wr * 64 + fr, col0 = u.p1 * BM + wc * 32 + 8 * fq; const int b = (u.p0 * BM) >> 13;
        f32x4 gv[2][2], bv[2][2];
#pragma unroll
        for (int bj = 0; bj < 2; ++bj)
#pragma unroll
            for (int n = 0; n < 2; ++n) { gv[bj][n] = *(const f32x4*)(gate + (size_t)b * 6144 + col0 + bj * HALF + n * 4); bv[bj][n] = bias ? *(const f32x4*)(bias + col0 + bj * HALF + n * 4) : (f32x4){0.f, 0.f, 0.f, 0.f}; }
        constexpr int NB2 = BASEBF ? 4 : 2;
#pragma unroll
        for (int ai = 0; ai < 2; ++ai)
#pragma unroll
            for (int mb = 0; mb < 4; mb += NB2) {
                f32x4 bf[BASEBF ? 1 : NB2][2][2]; u32x4 bw[BASEBF ? NB2 : 1][2];
#pragma unroll
                for (int mm = 0; mm < NB2; ++mm) { const size_t off = (size_t)(row0 + ai * HALF + (mb + mm) * 16) * D + col0;
#pragma unroll
                    for (int bj = 0; bj < 2; ++bj) {
                        if (BASEBF) bw[mm][bj] = *(const u32x4*)(XB + off + bj * HALF);
                        else { bf[mm][bj][0] = *(const f32x4*)(basef + off + bj * HALF); bf[mm][bj][1] = *(const f32x4*)(basef + off + bj * HALF + 4); } } }
#pragma unroll
                for (int mm = 0; mm < NB2; ++mm) { const int m = mb + mm; const size_t off = (size_t)(row0 + ai * HALF + m * 16) * D + col0;
#pragma unroll
                    for (int bj = 0; bj < 2; ++bj) { f32x4 o[2];
#pragma unroll
                        for (int n = 0; n < 2; ++n) { f32x4 bsv;
                            if (BASEBF) { const unsigned wa = n ? bw[mm][bj].z : bw[mm][bj].x, wb = n ? bw[mm][bj].w : bw[mm][bj].y; bsv = (f32x4){bflo(wa), bfhi(wa), bflo(wb), bfhi(wb)}; } else bsv = bf[mm][bj][n];
                            o[n] = bsv + gv[bj][n] * (acc[ai][bj][m][n] + bv[bj][n]); }
                        u32x4 w2; w2.x = cvt_pk_bf16(o[0][0], o[0][1]); w2.y = cvt_pk_bf16(o[0][2], o[0][3]); w2.z = cvt_pk_bf16(o[1][0], o[1][1]); w2.w = cvt_pk_bf16(o[1][2], o[1][3]);
                        *(u32x4*)(XB + off + bj * HALF) = w2; } }
                asm volatile("" ::: "memory"); }
    }
};
struct EpiGLU {
    static constexpr bool PERM = true;
    bf16* U; const float* bias;
    __device__ __forceinline__ void operator()(const f32x4 (&acc)[2][2][4][2], const GU& u, int wr, int wc, int fr, int fq) const {
        const int row0 = u.p0 * BM + wr * 64 + fr, col0 = u.p1 * HALF + wc * 32 + 8 * fq;
        f32x4 ba[2], bg[2];
#pragma unroll
        for (int n = 0; n < 2; ++n) { ba[n] = *(const f32x4*)(bias + col0 + 4 * n); bg[n] = *(const f32x4*)(bias + 1024 + col0 + 4 * n); }
#pragma unroll
        for (int ai = 0; ai < 2; ++ai)
#pragma unroll
            for (int m = 0; m < 4; ++m) { f32x4 o[2];
#pragma unroll
                for (int n = 0; n < 2; ++n) { const f32x4 a = acc[ai][0][m][n] + ba[n], g = acc[ai][1][m][n] + bg[n];
#pragma unroll
                    for (int j = 0; j < 4; ++j) o[n][j] = a[j] * sigmoid_f(g[j]); }
                u32x4 w; w.x = cvt_pk_bf16(o[0][0], o[0][1]); w.y = cvt_pk_bf16(o[0][2], o[0][3]); w.z = cvt_pk_bf16(o[1][0], o[1][1]); w.w = cvt_pk_bf16(o[1][2], o[1][3]);
                *(u32x4*)(U + (size_t)(row0 + ai * HALF + m * 16) * D + col0) = w; }
    }
};
struct EpiGateUp {
    static constexpr bool PERM = true;
    bf16* HID; const float* slot_w; LAS int* mm;
    __device__ __forceinline__ void operator()(const f32x4 (&acc)[2][2][4][2], const GU& u, int wr, int wc, int fr, int fq) const {
        const int e = u.p0, n_e = mm[e], r0 = u.p1 * BM + wr * 64 + fr, col0 = u.p2 * HALF + wc * 32 + 8 * fq;
        float wv[2][4];
#pragma unroll
        for (int ai = 0; ai < 2; ++ai)
#pragma unroll
            for (int m = 0; m < 4; ++m) wv[ai][m] = slot_w[e * CAP + r0 + ai * HALF + m * 16];
#pragma unroll
        for (int ai = 0; ai < 2; ++ai)
#pragma unroll
            for (int m = 0; m < 4; ++m) { const int r = r0 + ai * HALF + m * 16;
                if (r < n_e) { const float w = wv[ai][m]; f32x4 o[2];
#pragma unroll
                    for (int n = 0; n < 2; ++n) { const f32x4 g = acc[ai][0][m][n], up = acc[ai][1][m][n];
#pragma unroll
                        for (int j = 0; j < 4; ++j) o[n][j] = w * silu_f(g[j]) * up[j]; }
                    u32x4 q; q.x = cvt_pk_bf16(o[0][0], o[0][1]); q.y = cvt_pk_bf16(o[0][2], o[0][3]); q.z = cvt_pk_bf16(o[1][0], o[1][1]); q.w = cvt_pk_bf16(o[1][2], o[1][3]);
                    *(u32x4*)(HID + (size_t)(u.p3 + r) * FF + col0) = q; } }
    }
};
struct EpiDown {
    static constexpr bool PERM = true;
    bf16* Y; LAS int* mm;
    __device__ __forceinline__ void operator()(const f32x4 (&acc)[2][2][4][2], const GU& u, int wr, int wc, int fr, int fq) const {
        const int e = u.p0, n_e = mm[e], r0 = u.p1 * BM + wr * 64 + fr, col0 = u.p2 * BM + wc * 32 + 8 * fq;
#pragma unroll
        for (int ai = 0; ai < 2; ++ai)
#pragma unroll
            for (int m = 0; m < 4; ++m) { const int r = r0 + ai * HALF + m * 16;
                if (r < n_e) {
#pragma unroll
                    for (int bj = 0; bj < 2; ++bj) { const f32x4 v0 = acc[ai][bj][m][0], v1 = acc[ai][bj][m][1];
                        u32x4 q; q.x = cvt_pk_bf16(v0[0], v0[1]); q.y = cvt_pk_bf16(v0[2], v0[3]); q.z = cvt_pk_bf16(v1[0], v1[1]); q.w = cvt_pk_bf16(v1[2], v1[3]);
                        *(u32x4*)(Y + (size_t)(u.p3 + r) * D + col0 + bj * HALF) = q; } } }
    }
};
}

__device__ __forceinline__ void fast_inproj(Frame& F) {
    pg::DenseSched S{(const char*)(F.ws + WS_WIN), D, T / 256, N_IN / 256, F.G, F.wg, TC / 256, T / 256, 4};
    pg::EpiInProj E{F.ws};
    pg::gemm_phase(F.lds, (const char*)(F.ws + WS_HB), D, S, E);
    const int nbusy = (T / 256) * (N_IN / 256) + TC / 256 - 2 * F.G;
    if (nbusy > 0 && nbusy < F.G) { if (F.wg >= nbusy) t_items_tail(F, (F.wg - nbusy) * NWAVES + F.wave, (F.G - nbusy) * NWAVES); }
    else t_items_tail(F, F.wg * NWAVES + F.wave, F.G * NWAVES);
}
__device__ __forceinline__ void fast_outproj(Frame& F, size_t a_off, size_t w_off, const float* base, float* X, const float* gate, const float* bias) {
    pg::DenseSched S{(const char*)(F.ws + w_off), D, T / 256, D / 256, F.G, F.wg, 0, 0, 0};
    if (XBF16) {
        if (base == X) { pg::EpiResB<true> E{nullptr, (bf16*)(F.ws + WS_XB), gate, bias}; pg::gemm_phase(F.lds, (const char*)(F.ws + a_off), D, S, E); }
        else { pg::EpiResB<false> E{base, (bf16*)(F.ws + WS_XB), gate, bias}; pg::gemm_phase(F.lds, (const char*)(F.ws + a_off), D, S, E); }
    } else { pg::EpiRes E{base, X, gate, bias}; pg::gemm_phase(F.lds, (const char*)(F.ws + a_off), D, S, E); }
}
__device__ __forceinline__ void fast_pw1(Frame& F) {
    pg::DenseSched S{(const char*)(F.ws + WS_WPW1), D, T / 256, 2048 / 256, F.G, F.wg, 0, 0, 0};
    pg::EpiGLU E{(bf16*)(F.ws + WS_U), F.in[I_PW1B]};
    pg::gemm_phase(F.lds, (const char*)(F.ws + WS_HB), D, S, E);
}
__device__ __forceinline__ void fast_moe_gateup(Frame& F, int layer) {
    LAS int* mm = moe_map(F, layer);
    pg::MoeSched<true> S{(const char*)(F.ws + WS_WGU) + (size_t)layer * 16 * 1024 * 1024 * 2, (size_t)1024 * 1024 * 2, D, (const int*)(F.ws + WS_SLOTT) + layer * 16 * CAP, mm, F.G, F.wg};
    pg::EpiGateUp E{(bf16*)(F.ws + WS_HID), (const float*)(F.ws + WS_SLOTW) + layer * 16 * CAP, mm};
    pg::gemm_phase(F.lds, (const char*)(F.ws + WS_HB), D, S, E);
}
__device__ __forceinline__ void fast_moe_down(Frame& F, int layer) {
    LAS int* mm = moe_map(F, layer);
    pg::MoeSched<false> S{(const char*)(F.ws + WS_WDN) + (size_t)layer * 16 * 1024 * 512 * 2, (size_t)1024 * 512 * 2, FF, nullptr, mm, F.G, F.wg};
    pg::EpiDown E{(bf16*)(F.ws + WS_Y), mm};
    pg::gemm_phase(F.lds, (const char*)(F.ws + WS_HID), FF, S, E);
}


struct AttnBlk { const bf16* kp; const bf16* vp; int pitch; int kb; bool valid, masked; };
__device__ __forceinline__ AttnBlk attn_blk(const unsigned char* ws, int bi, int b, int kvh, int qs) {
    AttnBlk a;
    if (bi < 8) { a.kp = (const bf16*)(ws + WS_CK) + (size_t)(b * CL + bi * 32) * 128 + kvh * 64; a.vp = (const bf16*)(ws + WS_CV) + (size_t)(b * 2 + kvh) * 64 * CL + bi * 32; a.pitch = CL; a.kb = 0; a.valid = true; a.masked = false; }
    else { const int kb = qs - 128 + 32 * (bi - 8); a.valid = (kb >= 0 && kb < L); a.kb = kb; a.masked = true; a.pitch = L;
        a.kp = (const bf16*)(ws + WS_K) + (size_t)(b * L + kb) * 128 + kvh * 64; a.vp = (const bf16*)(ws + WS_V) + (size_t)(b * 2 + kvh) * 64 * L + kb; }
    return a;
}
__device__ __forceinline__ void attn_load(const AttnBlk& a, int r, int h, bf16x8 (&kf)[4], u32x4 (&vf)[2][2]) {
    if (a.valid) {
#pragma unroll
        for (int s = 0; s < 4; ++s) kf[s] = *(const bf16x8*)(a.kp + (size_t)r * 128 + 16 * s + 8 * h);
#pragma unroll
        for (int db = 0; db < 2; ++db)
#pragma unroll
            for (int ks = 0; ks < 2; ++ks) { const bf16* vr = a.vp + (size_t)(32 * db + r) * a.pitch + 16 * ks + 4 * h;
                const u32x2 lo = *(const u32x2*)vr, hi = *(const u32x2*)(vr + 8); vf[db][ks] = (u32x4){lo.x, lo.y, hi.x, hi.y}; }
    }
}
__device__ __forceinline__ void attn_compute(const AttnBlk& a, int qs, int r, int h, const bf16x8 (&kf)[4], const u32x4 (&vf)[2][2], const bf16x8 (&qf)[2][4],
                                             f32x16 (&o)[2][2], float (&m)[2], float (&l)[2]) {
    if (!a.valid) return;
#pragma unroll
    for (int nq = 0; nq < 2; ++nq) {
        f32x16 st;
#pragma unroll
        for (int i = 0; i < 16; ++i) st[i] = 0.f;
#pragma unroll
        for (int s = 0; s < 4; ++s) st = __builtin_amdgcn_mfma_f32_32x32x16_bf16(kf[s], qf[nq][s], st, 0, 0, 0);
        float t[16]; float tmax = -INFINITY;
        const int dbase = a.kb - qs - 32 * nq - r + 4 * h;
#pragma unroll
        for (int i = 0; i < 16; ++i) { float v = st[i] * (0.125f * 1.4426950408889634f);
            if (a.masked) { const int df = dbase + (i & 3) + 8 * (i >> 2); v = (df >= -128 && df <= 128) ? v : -INFINITY; }
            t[i] = v; tmax = fmaxf(tmax, v); }
        tmax = fmaxf(tmax, __shfl_xor(tmax, 32));
        const float mn = fmaxf(m[nq], tmax), alpha = __builtin_amdgcn_exp2f(m[nq] - mn); m[nq] = mn;
        float ps = 0.f;
#pragma unroll
        for (int i = 0; i < 16; ++i) { t[i] = __builtin_amdgcn_exp2f(t[i] - mn); ps += t[i]; }
        l[nq] = l[nq] * alpha + ps;
#pragma unroll
        for (int i = 0; i < 16; ++i) { o[0][nq][i] *= alpha; o[1][nq][i] *= alpha; }
        bf16x8 pf[2];
#pragma unroll
        for (int ks = 0; ks < 2; ++ks) { const u32x4 w = {pkbf(t[8 * ks], t[8 * ks + 1]), pkbf(t[8 * ks + 2], t[8 * ks + 3]), pkbf(t[8 * ks + 4], t[8 * ks + 5]), pkbf(t[8 * ks + 6], t[8 * ks + 7])};
            pf[ks] = __builtin_bit_cast(bf16x8, w); }
#pragma unroll
        for (int db = 0; db < 2; ++db)
#pragma unroll
            for (int ks = 0; ks < 2; ++ks) o[db][nq] = __builtin_amdgcn_mfma_f32_32x32x16_bf16(__builtin_bit_cast(bf16x8, vf[db][ks]), pf[ks], o[db][nq], 0, 0, 0);
    }
}
__device__ __forceinline__ void phase_attn_mfma(Frame& F) {
    const bf16* Q = (const bf16*)(F.ws + WS_Q); bf16* MIX = (bf16*)(F.ws + WS_MIX);
    const int g = F.wave >> 1, half = F.wave & 1, r = F.lane & 31, h = F.lane >> 5;
    for (int item = F.wg; item < NB * 2 * 64; item += F.G) {
        const int qb = item & 63, kvh = (item >> 6) & 1, b = item >> 7, hd = kvh * 4 + g, qs = qb * 128 + half * 64;
        bf16x8 qf[2][4];
#pragma unroll
        for (int nq = 0; nq < 2; ++nq)
#pragma unroll
            for (int s = 0; s < 4; ++s) qf[nq][s] = *(const bf16x8*)(Q + (size_t)(b * L + qs + 32 * nq + r) * 512 + hd * 64 + 16 * s + 8 * h);
        f32x16 o[2][2];
#pragma unroll
        for (int db = 0; db < 2; ++db)
#pragma unroll
            for (int nq = 0; nq < 2; ++nq)
#pragma unroll
                for (int i = 0; i < 16; ++i) o[db][nq][i] = 0.f;
        float m[2], l[2];
        m[0] = m[1] = F.in[I_SINK][hd] * 1.4426950408889634f; l[0] = l[1] = (h == 0) ? 1.f : 0.f;
        bf16x8 kfA[4], kfB[4]; u32x4 vfA[2][2], vfB[2][2];
        AttnBlk ba = attn_blk(F.ws, 0, b, kvh, qs), bb;
        attn_load(ba, r, h, kfA, vfA);
#pragma unroll 1
        for (int bi = 0; bi < 18; bi += 2) {
            bb = attn_blk(F.ws, bi + 1, b, kvh, qs); attn_load(bb, r, h, kfB, vfB);
            attn_compute(ba, qs, r, h, kfA, vfA, qf, o, m, l);
            if (bi + 2 < 18) { ba = attn_blk(F.ws, bi + 2, b, kvh, qs); attn_load(ba, r, h, kfA, vfA); }
            attn_compute(bb, qs, r, h, kfB, vfB, qf, o, m, l);
        }
#pragma unroll
        for (int nq = 0; nq < 2; ++nq) {
            const float lt = l[nq] + __shfl_xor(l[nq], 32), il = 1.f / lt;
            bf16* orow = MIX + (size_t)(b * L + qs + 32 * nq + r) * 1024 + 512 + hd * 64;
#pragma unroll
            for (int db = 0; db < 2; ++db)
#pragma unroll
                for (int i4 = 0; i4 < 4; ++i4) { u32x2 w; w.x = pkbf(o[db][nq][4 * i4] * il, o[db][nq][4 * i4 + 1] * il); w.y = pkbf(o[db][nq][4 * i4 + 2] * il, o[db][nq][4 * i4 + 3] * il);
                    *(u32x2*)(orow + 32 * db + 8 * i4 + 4 * h) = w; }
        }
    }
}


__device__ __forceinline__ float half_max(float v) { const auto r = __builtin_amdgcn_permlane32_swap(__float_as_uint(v), __float_as_uint(v), false, false); return fmaxf(__uint_as_float(r[0]), __uint_as_float(r[1])); }
__device__ __forceinline__ float half_sum(float v) { const auto r = __builtin_amdgcn_permlane32_swap(__float_as_uint(v), __float_as_uint(v), false, false); return __uint_as_float(r[0]) + __uint_as_float(r[1]); }
constexpr int AT_KP = 72, AT_VP = 136;
constexpr int AT_KB = 128 * AT_KP * 2, AT_BUF = AT_KB + 64 * AT_VP * 2;
struct AtChunk { const bf16* kg; const bf16* vg; int vpitch, lc, b, kvh, qb, c; bool valid, local, any; };
__device__ __forceinline__ AtChunk at_chunk(const unsigned char* ws, int seq, int wg, int G) {
    AtChunk k; const int item = wg + (seq / 5) * G; k.c = seq % 5; k.any = item < NB * 2 * 64;
    k.qb = item & 63; k.kvh = (item >> 6) & 1; k.b = (item >> 7) & 3; k.local = k.c >= 2; k.lc = k.c - 2;
    if (!k.local) { k.valid = k.any; k.vpitch = CL; k.kg = (const bf16*)(ws + WS_CK) + (size_t)(k.b * CL + 128 * k.c) * 128 + k.kvh * 64; k.vg = (const bf16*)(ws + WS_CV) + (size_t)(k.b * 2 + k.kvh) * 64 * CL + 128 * k.c; }
    else { const int key0 = 128 * k.qb - 128 + 128 * k.lc; k.valid = k.any && key0 >= 0 && key0 < L; k.vpitch = L;
        k.kg = (const bf16*)(ws + WS_K) + (size_t)(k.b * L + key0) * 128 + k.kvh * 64; k.vg = (const bf16*)(ws + WS_V) + (size_t)(k.b * 2 + k.kvh) * 64 * L + key0; }
    return k;
}
__device__ __forceinline__ void at_issue(const AtChunk& k, int tid, u32x4 (&rg)[4]) {
    if (k.valid) {
#pragma unroll
        for (int i = 0; i < 2; ++i) { const int id = tid + 512 * i; rg[i] = *(const u32x4*)(k.kg + (size_t)(id >> 3) * 128 + (id & 7) * 8); }
#pragma unroll
        for (int i = 0; i < 2; ++i) { const int id = tid + 512 * i; rg[2 + i] = *(const u32x4*)(k.vg + (size_t)(id >> 4) * k.vpitch + (id & 15) * 8); }
    }
}
__device__ __forceinline__ void at_write(const AtChunk& k, LAS unsigned char* buf, int tid, const u32x4 (&rg)[4]) {
    if (k.valid) {
#pragma unroll
        for (int i = 0; i < 2; ++i) { const int id = tid + 512 * i; *(LAS u32x4*)(buf + (id >> 3) * (AT_KP * 2) + (id & 7) * 16) = rg[i]; }
#pragma unroll
        for (int i = 0; i < 2; ++i) { const int id = tid + 512 * i; *(LAS u32x4*)(buf + AT_KB + (id >> 4) * (AT_VP * 2) + (id & 15) * 16) = rg[2 + i]; }
    }
}
__device__ __forceinline__ void at_load(LAS unsigned char* buf, int blk, int r, int h, bf16x8 (&kf)[4], u32x4 (&vf)[2][2]) {
#pragma unroll
    for (int s2 = 0; s2 < 4; ++s2) kf[s2] = *(const LAS bf16x8*)(buf + (32 * blk + r) * (AT_KP * 2) + (16 * s2 + 8 * h) * 2);
#pragma unroll
    for (int db = 0; db < 2; ++db)
#pragma unroll
        for (int ks = 0; ks < 2; ++ks) { const LAS unsigned char* vr = buf + AT_KB + (32 * db + r) * (AT_VP * 2) + (32 * blk + 16 * ks + 4 * h) * 2;
            const u32x2 lo = *(const LAS u32x2*)vr, hi = *(const LAS u32x2*)(vr + 16); vf[db][ks] = (u32x4){lo.x, lo.y, hi.x, hi.y}; }
}
__device__ __forceinline__ void at_math(const bf16x8 (&kf)[4], const u32x4 (&vf)[2][2], bool masked, int kbrel, int r, int h, const bf16x8 (&qf)[2][4], f32x16 (&o)[2][2], float (&m)[2], float (&l)[2]) {
    constexpr float C = 0.125f * 1.4426950408889634f;
#pragma unroll
    for (int nq = 0; nq < 2; ++nq) {
        f32x16 st;
#pragma unroll
        for (int i = 0; i < 16; ++i) st[i] = 0.f;
#pragma unroll
        for (int s2 = 0; s2 < 4; ++s2) st = __builtin_amdgcn_mfma_f32_32x32x16_bf16(kf[s2], qf[nq][s2], st, 0, 0, 0);
        if (masked) { const int dbase = kbrel - 32 * nq - r + 4 * h;
#pragma unroll
            for (int i = 0; i < 16; ++i) { const int df = dbase + (i & 3) + 8 * (i >> 2); st[i] = (df >= -128 && df <= 128) ? st[i] : -INFINITY; } }
        float smax = st[0];
#pragma unroll
        for (int i = 1; i < 16; ++i) smax = fmaxf(smax, st[i]);
        smax = half_max(smax);
        const float mn = fmaxf(m[nq], smax * C), alpha = __builtin_amdgcn_exp2f(m[nq] - mn); m[nq] = mn;
        float t[16]; float ps = 0.f;
#pragma unroll
        for (int i = 0; i < 16; ++i) { t[i] = __builtin_amdgcn_exp2f(__builtin_fmaf(st[i], C, -mn)); ps += t[i]; }
        l[nq] = l[nq] * alpha + ps;
        if (__ballot(alpha != 1.f)) {
#pragma unroll
            for (int i = 0; i < 16; ++i) { o[0][nq][i] *= alpha; o[1][nq][i] *= alpha; } }
        bf16x8 pf[2];
#pragma unroll
        for (int ks = 0; ks < 2; ++ks) { const u32x4 w = {pkbf(t[8 * ks], t[8 * ks + 1]), pkbf(t[8 * ks + 2], t[8 * ks + 3]), pkbf(t[8 * ks + 4], t[8 * ks + 5]), pkbf(t[8 * ks + 6], t[8 * ks + 7])};
            pf[ks] = __builtin_bit_cast(bf16x8, w); }
#pragma unroll
        for (int db = 0; db < 2; ++db)
#pragma unroll
            for (int ks = 0; ks < 2; ++ks) o[db][nq] = __builtin_amdgcn_mfma_f32_32x32x16_bf16(__builtin_bit_cast(bf16x8, vf[db][ks]), pf[ks], o[db][nq], 0, 0, 0);
    }
}
__device__ __forceinline__ void phase_attn_lds(Frame& F) {
    const bf16* Q = (const bf16*)(F.ws + WS_Q); bf16* MIX = (bf16*)(F.ws + WS_MIX);
    const int g = F.wave >> 1, half = F.wave & 1, r = F.lane & 31, h = F.lane >> 5;
    __syncthreads();
    u32x4 rg[4];
    AtChunk ck = at_chunk(F.ws, 0, F.wg, F.G);
    if (!ck.any) return;
    at_issue(ck, F.tid, rg); at_write(ck, F.lds, F.tid, rg);
    __syncthreads();
    bf16x8 qf[2][4]; f32x16 o[2][2]; float m[2], l[2];
#pragma unroll 1
    for (int seq = 0; ck.any; ++seq) {
        LAS unsigned char* buf = F.lds + (seq & 1) * AT_BUF;
        const TItem ti = t_decode(F, seq < 10 ? 640 + (F.wg * NWAVES + F.wave) + seq * (F.G * NWAVES) : (1 << 30));
        t_dma(ti, F.lds + 2 * AT_BUF + F.wave * 8704, F.lane);
        const AtChunk nk = at_chunk(F.ws, seq + 1, F.wg, F.G);
        at_issue(nk, F.tid, rg);
        const int hd = ck.kvh * 4 + g, qs = ck.qb * 128 + half * 64;
        if (ck.c == 0) {
#pragma unroll
            for (int nq = 0; nq < 2; ++nq)
#pragma unroll
                for (int s2 = 0; s2 < 4; ++s2) qf[nq][s2] = *(const bf16x8*)(Q + (size_t)(ck.b * L + qs + 32 * nq + r) * 512 + hd * 64 + 16 * s2 + 8 * h);
#pragma unroll
            for (int db = 0; db < 2; ++db)
#pragma unroll
                for (int nq = 0; nq < 2; ++nq)
#pragma unroll
                    for (int i = 0; i < 16; ++i) o[db][nq][i] = 0.f;
            m[0] = m[1] = F.in[I_SINK][hd] * 1.4426950408889634f; l[0] = l[1] = (h == 0) ? 1.f : 0.f;
        }
        if (ck.valid) {
            int b0 = 0, b1 = 4;
            if (ck.local) { b0 = 2 * half - 4 * ck.lc; b0 = b0 < 0 ? 0 : b0; b1 = 2 * half + 10 - 4 * ck.lc; b1 = b1 > 4 ? 4 : b1; }
            if (b0 < b1) {
                bf16x8 kfA[4], kfB[4]; u32x4 vfA[2][2], vfB[2][2];
                at_load(buf, b0, r, h, kfA, vfA);
#pragma unroll 1
                for (int blk = b0; blk < b1; blk += 2) {
                    const int iA = 4 * ck.lc + blk - 2 * half, iB = iA + 1;
                    if (blk + 1 < b1) at_load(buf, blk + 1, r, h, kfB, vfB);
                    at_math(kfA, vfA, ck.local && (iA < 2 || iA > 7), 32 * iA - 128, r, h, qf, o, m, l);
                    if (blk + 1 < b1) {
                        if (blk + 2 < b1) at_load(buf, blk + 2, r, h, kfA, vfA);
                        at_math(kfB, vfB, ck.local && (iB < 2 || iB > 7), 32 * iB - 128, r, h, qf, o, m, l);
                    }
                }
            }
        }
        if (ck.c == 4) {
#pragma unroll
            for (int nq = 0; nq < 2; ++nq) {
                const float lt = half_sum(l[nq]), il = __builtin_amdgcn_rcpf(lt);
                bf16* orow = MIX + (size_t)(ck.b * L + qs + 32 * nq + r) * 1024 + 512 + hd * 64;
#pragma unroll
                for (int db = 0; db < 2; ++db)
#pragma unroll
                    for (int i4 = 0; i4 < 4; ++i4) { u32x2 w; w.x = pkbf(o[db][nq][4 * i4] * il, o[db][nq][4 * i4 + 1] * il); w.y = pkbf(o[db][nq][4 * i4 + 2] * il, o[db][nq][4 * i4 + 3] * il);
                        *(u32x2*)(orow + 32 * db + 8 * i4 + 4 * h) = w; }
            }
        }
        if (ti.ok) { asm volatile("s_waitcnt vmcnt(0)" ::: "memory"); t_store_dma(ti, (const LAS float*)(F.lds + 2 * AT_BUF + F.wave * 8704), F.lane); }
        at_write(nk, F.lds + ((seq + 1) & 1) * AT_BUF, F.tid, rg);
        __syncthreads();
        ck = nk;
    }
}

constexpr int F1_PC = 136, F1_PW = 68, F2_P = 264;
constexpr int F1_CSC = 0, F1_CSS = 128 * F1_PC * 2, F1_C64 = 2 * 128 * F1_PC * 2, F1_S64 = F1_C64 + 64 * F1_PW * 2;
__device__ __forceinline__ bf16x8 pack8(float a0, float a1, float a2, float a3, float a4, float a5, float a6, float a7) {
    const u32x4 w = {pkbf(a0, a1), pkbf(a2, a3), pkbf(a4, a5), pkbf(a6, a7)}; return __builtin_bit_cast(bf16x8, w); }
__device__ __forceinline__ void phase_fft1_mfma(Frame& F) {
    __syncthreads();
    LAS bf16* csc = (LAS bf16*)(F.lds + F1_CSC); LAS bf16* css = (LAS bf16*)(F.lds + F1_CSS); LAS bf16* c64 = (LAS bf16*)(F.lds + F1_C64); LAS bf16* s64 = (LAS bf16*)(F.lds + F1_S64);
    for (int i = F.tid; i < 128 * 128; i += NTHR) { const int n = i >> 7, k = i & 127; const float ang = (float)((n * k) & 127) * (6.283185307179586f / 128.f);
        csc[n * F1_PC + k] = (bf16)f2bf(__cosf(ang)); css[n * F1_PC + k] = (bf16)f2bf(__sinf(ang)); }
    for (int i = F.tid; i < 64 * 64; i += NTHR) { const int c = i >> 6, a = i & 63; const float ang = (float)((c * a) & 63) * (6.283185307179586f / 64.f);
        c64[c * F1_PW + a] = (bf16)f2bf(__cosf(ang)); s64[c * F1_PW + a] = (bf16)f2bf(__sinf(ang)); }
    __syncthreads();
    const bf16* UF = (const bf16*)(F.ws + WS_UF); bf16* Gb = (bf16*)(F.ws + WS_G);
    const int r = F.lane & 31, h = F.lane >> 5, g = F.wave >> 1;
    for (int item = F.wg; item < NB * FN2; item += F.G) {
        const int b = item >> 7, bp = item & 127;
        bf16x8 uf[2][8];
#pragma unroll
        for (int rb = 0; rb < 2; ++rb)
#pragma unroll
            for (int s2 = 0; s2 < 8; ++s2) uf[rb][s2] = *(const bf16x8*)(UF + (size_t)(b * L + 128 * (32 * rb + r) + bp) * 512 + g * 128 + 16 * s2 + 8 * h);
#pragma unroll 1
        for (int q = 0; q < 2; ++q) {
            const int cbk = 2 * F.wave + q, n = 32 * (cbk & 3) + r, ch = 32 * cbk + r;
            f32x16 zr[2], zi[2];
#pragma unroll
            for (int rb = 0; rb < 2; ++rb) {
#pragma unroll
                for (int i = 0; i < 16; ++i) { zr[rb][i] = 0.f; zi[rb][i] = 0.f; }
#pragma unroll
                for (int s2 = 0; s2 < 8; ++s2) { const bf16x8 bc = *(const LAS bf16x8*)(csc + n * F1_PC + 16 * s2 + 8 * h), bs = *(const LAS bf16x8*)(css + n * F1_PC + 16 * s2 + 8 * h);
                    zr[rb] = __builtin_amdgcn_mfma_f32_32x32x16_bf16(uf[rb][s2], bc, zr[rb], 0, 0, 0); zi[rb] = __builtin_amdgcn_mfma_f32_32x32x16_bf16(uf[rb][s2], bs, zi[rb], 0, 0, 0); }
                __builtin_amdgcn_sched_barrier(0);
            }
            bf16x8 zfr[4], zfi[4];
#pragma unroll
            for (int ks = 0; ks < 4; ++ks) { const int rb = ks >> 1, o = 8 * (ks & 1);
                zfr[ks] = pack8(zr[rb][o], zr[rb][o + 1], zr[rb][o + 2], zr[rb][o + 3], zr[rb][o + 4], zr[rb][o + 5], zr[rb][o + 6], zr[rb][o + 7]);
                zfi[ks] = pack8(-zi[rb][o], -zi[rb][o + 1], -zi[rb][o + 2], -zi[rb][o + 3], -zi[rb][o + 4], -zi[rb][o + 5], -zi[rb][o + 6], -zi[rb][o + 7]); }
            __builtin_amdgcn_sched_barrier(0);
#pragma unroll 1
            for (int rbc = 0; rbc < 2; ++rbc) {
                f32x16 gr, gi; const int cr = 32 * rbc + r;
#pragma unroll
                for (int i = 0; i < 16; ++i) { gr[i] = 0.f; gi[i] = 0.f; }
#pragma unroll
                for (int ks = 0; ks < 4; ++ks) {
                    const u32x2 cl = *(const LAS u32x2*)(c64 + cr * F1_PW + 16 * ks + 4 * h), chh = *(const LAS u32x2*)(c64 + cr * F1_PW + 16 * ks + 8 + 4 * h);
                    const u32x2 sl = *(const LAS u32x2*)(s64 + cr * F1_PW + 16 * ks + 4 * h), shh = *(const LAS u32x2*)(s64 + cr * F1_PW + 16 * ks + 8 + 4 * h);
                    const u32x4 sw = {sl.x, sl.y, shh.x, shh.y}; const u32x4 swn = sw ^ 0x80008000u;
                    const bf16x8 wc = __builtin_bit_cast(bf16x8, ((u32x4){cl.x, cl.y, chh.x, chh.y})), wsn = __builtin_bit_cast(bf16x8, sw), wsm = __builtin_bit_cast(bf16x8, swn);
                    gr = __builtin_amdgcn_mfma_f32_32x32x16_bf16(wc, zfr[ks], gr, 0, 0, 0); gr = __builtin_amdgcn_mfma_f32_32x32x16_bf16(wsn, zfi[ks], gr, 0, 0, 0);
                    gi = __builtin_amdgcn_mfma_f32_32x32x16_bf16(wc, zfi[ks], gi, 0, 0, 0); gi = __builtin_amdgcn_mfma_f32_32x32x16_bf16(wsm, zfr[ks], gi, 0, 0, 0); }
                __builtin_amdgcn_sched_barrier(0);
#pragma unroll
                for (int i = 0; i < 16; ++i) { const int c = 32 * rbc + crow(i, h); const float ang = (float)(bp * c) * (6.283185307179586f / 8192.f), cs = __cosf(ang), sn = __sinf(ang);
                    const float re = gr[i] * cs + gi[i] * sn, im = gi[i] * cs - gr[i] * sn;
                    bf16* o = Gb + (size_t)((b * FN1 + c) * FN2 + bp) * 1024 + ch; o[0] = (bf16)f2bf(re); o[512] = (bf16)f2bf(im);
                    if ((i & 3) == 3) __builtin_amdgcn_sched_barrier(0); }
            }
        }
    }
    __syncthreads();
}
__device__ __forceinline__ void phase_fft2_mfma(Frame& F) {
    __syncthreads();
    LAS bf16* t2 = (LAS bf16*)F.lds;
    for (int i = F.tid; i < 128 * 256; i += NTHR) { const int d = i >> 8, k = i & 255; const float ang = (float)((d * (k & 127)) & 127) * (6.283185307179586f / 128.f);
        t2[d * F2_P + k] = (bf16)f2bf(k < 128 ? __cosf(ang) : __sinf(ang)); }
    __syncthreads();
    const bf16* Gb = (const bf16*)(F.ws + WS_G); bf16* MIX = (bf16*)(F.ws + WS_MIX);
    const int r = F.lane & 31, h = F.lane >> 5;
    for (int item = F.wg; item < NB * FN1; item += F.G) {
        const int b = item >> 6, c = item & 63;
        const bf16* Gp = Gb + (size_t)((b * FN1 + c) * FN2) * 1024 + 64 * F.wave + r;
        f32x16 y[4][2];
#pragma unroll
        for (int rb = 0; rb < 4; ++rb)
#pragma unroll
            for (int cb = 0; cb < 2; ++cb)
#pragma unroll
                for (int i = 0; i < 16; ++i) y[rb][cb][i] = 0.f;
        unsigned eA[2][8], eB[2][8], eC[2][8], eD[2][8];
#define F2_GATHER(dst, ks_) do { const bf16* p_ = Gp + (size_t)(16 * ((ks_) & 7) + 8 * h) * 1024 + ((ks_) >> 3) * 512; \
            _Pragma("unroll") for (int cb = 0; cb < 2; ++cb) _Pragma("unroll") for (int j = 0; j < 8; ++j) dst[cb][j] = p_[(size_t)j * 1024 + 32 * cb]; } while (0)
#define F2_MMA(src, ks_) do { bf16x8 bfr[2]; _Pragma("unroll") for (int cb = 0; cb < 2; ++cb) { \
                const u32x4 w = {src[cb][0] | (src[cb][1] << 16), src[cb][2] | (src[cb][3] << 16), src[cb][4] | (src[cb][5] << 16), src[cb][6] | (src[cb][7] << 16)}; bfr[cb] = __builtin_bit_cast(bf16x8, w); } \
            _Pragma("unroll") for (int rb = 0; rb < 4; ++rb) { const bf16x8 a = *(const LAS bf16x8*)(t2 + (32 * rb + r) * F2_P + 16 * (ks_) + 8 * h); \
                _Pragma("unroll") for (int cb = 0; cb < 2; ++cb) y[rb][cb] = __builtin_amdgcn_mfma_f32_32x32x16_bf16(a, bfr[cb], y[rb][cb], 0, 0, 0); } } while (0)
        F2_GATHER(eA, 0); F2_GATHER(eB, 1); F2_GATHER(eC, 2);
#pragma unroll 1
        for (int ks = 0; ks < 16; ks += 4) {
            F2_GATHER(eD, ks + 3);
            F2_MMA(eA, ks);
            if (ks + 4 < 16) F2_GATHER(eA, ks + 4);
            F2_MMA(eB, ks + 1);
            if (ks + 4 < 16) F2_GATHER(eB, ks + 5);
            F2_MMA(eC, ks + 2);
            if (ks + 4 < 16) F2_GATHER(eC, ks + 6);
            F2_MMA(eD, ks + 3);
        }
#undef F2_GATHER
#undef F2_MMA
#pragma unroll
        for (int rb = 0; rb < 4; ++rb)
#pragma unroll
            for (int cb = 0; cb < 2; ++cb)
#pragma unroll
                for (int i = 0; i < 16; ++i) { const int d = 32 * rb + crow(i, h); MIX[(size_t)(b * L + c + 64 * d) * 1024 + 64 * F.wave + 32 * cb + r] = (bf16)f2bf(y[rb][cb][i] * (1.f / 1024.f)); }
    }
    __syncthreads();
}


typedef float f32x2_t __attribute__((ext_vector_type(2)));
template <int IR> struct DwIn {
    static __device__ __forceinline__ void run(const unsigned (&uin)[62], const f32x2_t (&w)[31], f32x2_t (&o)[32]) {
        const f32x2_t x = {bflo(uin[IR]), bfhi(uin[IR])};
#pragma unroll
        for (int r = 0; r < 32; ++r) { if (IR - r >= 0 && IR - r <= 30) o[r] += w[(IR - r >= 0 && IR - r <= 30) ? IR - r : 0] * x; }
        DwIn<IR + 1>::run(uin, w, o);
    }
};
template <> struct DwIn<62> { static __device__ __forceinline__ void run(const unsigned (&)[62], const f32x2_t (&)[31], f32x2_t (&)[32]) {} };
template <int IR> struct DwIn16 {
    static __device__ __forceinline__ void run(const unsigned (&uin)[46], const f32x2_t (&w)[31], f32x2_t (&o)[16]) {
        const f32x2_t x = {bflo(uin[IR]), bfhi(uin[IR])};
#pragma unroll
        for (int r = 0; r < 16; ++r) { if (IR - r >= 0 && IR - r <= 30) o[r] += w[(IR - r >= 0 && IR - r <= 30) ? IR - r : 0] * x; }
        DwIn16<IR + 1>::run(uin, w, o);
    }
};
template <> struct DwIn16<46> { static __device__ __forceinline__ void run(const unsigned (&)[46], const f32x2_t (&)[31], f32x2_t (&)[16]) {} };
__device__ __forceinline__ void phase_dwconv_fast(Frame& F) {
    const bf16* U = (const bf16*)(F.ws + WS_U); bf16* V1 = (bf16*)(F.ws + WS_V1);
    const float* dww = F.in[I_DWW];
    const int c0 = 2 * F.tid;
    f32x2_t w[31];
#pragma unroll
    for (int j = 0; j < 31; ++j) w[j] = *(const f32x2_t*)(dww + (size_t)j * D + c0);
    const f32x2_t bb = *(const f32x2_t*)(F.in[I_DWB] + c0), gg = *(const f32x2_t*)(F.in[I_LNG] + c0), lb = *(const f32x2_t*)(F.in[I_LNB] + c0);
    LAS float* red = (LAS float*)F.lds;
    LAS float* stat = red + 16 * 8 * 2;
    __syncthreads();
    for (int run = F.wg; run < T / 128; run += F.G) {
        const int row0 = run * 128, l0 = row0 & (L - 1);
        unsigned uin[46], nx[16];
#pragma unroll
        for (int ir = 0; ir < 46; ++ir) { const int l = l0 - 15 + ir; const bool ok = (l >= 0 && l < L);
            const unsigned u = *(const unsigned*)(U + (size_t)(ok ? row0 - 15 + ir : row0) * D + c0); uin[ir] = ok ? u : 0u; }
#pragma unroll 1
        for (int step = 0; step < 8; ++step) {
            const int r0 = row0 + 16 * step;
            if (step < 7) {
#pragma unroll
                for (int j = 0; j < 16; ++j) { const int l = l0 + 16 * step + 31 + j; const bool ok = l < L;
                    const unsigned u = *(const unsigned*)(U + (size_t)(ok ? r0 + 31 + j : r0) * D + c0); nx[j] = ok ? u : 0u; }
            }
            f32x2_t o[16];
#pragma unroll
            for (int r = 0; r < 16; ++r) o[r] = bb;
            DwIn16<0>::run(uin, w, o);
            {
                float W[16], X[8], Y[4], Z2[2];
#pragma unroll
                for (int i = 0; i < 16; ++i) W[i] = swap32_add(o[i].x + o[i].y, o[i].x * o[i].x + o[i].y * o[i].y);
#pragma unroll
                for (int i = 0; i < 8; ++i) X[i] = swap16_add(W[2 * i], W[2 * i + 1]);
                const bool b3 = (F.lane & 8) != 0, b2 = (F.lane & 4) != 0, b1 = (F.lane & 2) != 0;
#pragma unroll
                for (int i = 0; i < 4; ++i) Y[i] = sel_add<0x140>(X[2 * i], X[2 * i + 1], b3);
#pragma unroll
                for (int i = 0; i < 2; ++i) Z2[i] = sel_add<0x141>(Y[2 * i], Y[2 * i + 1], b2);
                float Z = sel_add<0x4E>(Z2[0], Z2[1], b1);
                Z += dppf<0xB1>(Z);
                const int rr = ((F.lane >> 4) & 1) + ((F.lane >> 3) & 1) * 2 + ((F.lane >> 2) & 1) * 4 + ((F.lane >> 1) & 1) * 8;
                if (!(F.lane & 1)) red[(rr * 8 + F.wave) * 2 + (F.lane >> 5)] = Z;
            }
            __syncthreads();
            if (F.tid < 16) { float sm = 0.f, sq = 0.f;
#pragma unroll
                for (int wv = 0; wv < 8; ++wv) { sm += red[(F.tid * 8 + wv) * 2]; sq += red[(F.tid * 8 + wv) * 2 + 1]; }
                const float mean = sm * (1.f / D), var = fmaxf(sq * (1.f / D) - mean * mean, 0.f);
                stat[2 * F.tid] = mean; stat[2 * F.tid + 1] = rsqrtf(var + EPS); }
            __syncthreads();
#pragma unroll
            for (int r = 0; r < 16; ++r) { const float mean = stat[2 * r], rstd = stat[2 * r + 1];
                const f32x2_t A = gg * rstd, B = lb - A * mean, y = o[r] * A + B;
                *(unsigned*)(V1 + (size_t)(r0 + r) * D + c0) = pkbf(silu_f(y.x), silu_f(y.y)); }
#pragma unroll
            for (int i = 0; i < 30; ++i) uin[i] = uin[i + 16];
#pragma unroll
            for (int j = 0; j < 16; ++j) uin[30 + j] = nx[j];
        }
        __syncthreads();
    }
}

namespace pg {
struct MU { const char* B; const char* A; int K, type, e, rt, pn, hb, buf; };
struct MoeMergedSched {
    const char* Wgu; const char* Wdn; const char* HBp; const char* HIDp; const int* list; const float* wlist; LAS int* mm; unsigned* tcnt; unsigned* tmo; int G, c, U;
    __device__ __forceinline__ bool flat(int L, int type, MU& u) const {
        for (int e = 0; e < 16; ++e) { const int n = mm[e], nu = ((n + 255) >> 8) * 4;
            if (L < nu) { u.e = e; u.rt = L >> 2; u.pn = L & 3; u.hb = mm[16 + e]; u.type = type; u.buf = 0;
                if (type == 0) { u.K = D; u.A = HBp; u.B = Wgu + (size_t)e * (1024 * 1024 * 2) + (size_t)u.pn * BM * D * 2; }
                else { u.K = FF; u.A = HIDp; u.B = Wdn + (size_t)e * (1024 * 512 * 2) + (size_t)u.pn * BM * FF * 2; }
                return true; }
            L -= nu; }
        return false;
    }
    __device__ __forceinline__ bool next(int i, MU& u) const {
        const int ngu = c < U ? (U - 1 - c) / G + 1 : 0;
        if (i < ngu) return flat(i * G + c, 0, u);
        const int k = i - ngu, x = U % G; int j;
        if (c >= x) { if (k == 0) j = c - x; else j = (G - 1 - c) + (k - 1) * G + (G - x); } else j = (G - 1 - c) + k * G + (G - x);
        if (j >= U) return false;
        return flat(j, 1, u);
    }
    __device__ __forceinline__ unsigned voff(const MU& u, int buf, LAS unsigned char* lds, int R, int C) const {
        if (u.type == 0) { const int tok = ((const LAS int*)(lds + TAB_OFF))[buf * 256 + R]; return (unsigned)((tok * D + C) * 2); }
        return (unsigned)(((u.hb + u.rt * BM + R) * FF + C) * 2);
    }
    __device__ __forceinline__ void stage_table(const MU& u, int buf, LAS unsigned char* lds, int wid, int lane) const {
        const int r = (wid & 3) * 64 + lane;
        __builtin_amdgcn_global_load_lds((const unsigned*)(list + u.e * CAP + u.rt * BM + r), (LAS unsigned*)(lds + TAB_OFF + buf * 1024 + (wid & 3) * 256), 4, 0, 0);
        __builtin_amdgcn_global_load_lds((const unsigned*)(wlist + u.e * CAP + u.rt * BM + r), (LAS unsigned*)(lds + TAB_OFF + 2048 + buf * 1024 + (wid & 3) * 256), 4, 0, 0);
    }
    __device__ __forceinline__ unsigned* tile_word(const MU& u) const { return tcnt + ((u.hb >> 8) + u.rt) * 64; }
    __device__ __forceinline__ void wait_ready(const MU& u, int wid) const {
        if (wid == 0) {
            unsigned* w = tile_word(u); unsigned spins = 0;
            while ((unsigned)__builtin_amdgcn_readfirstlane(__hip_atomic_load(w, __ATOMIC_RELAXED, __HIP_MEMORY_SCOPE_AGENT)) < 32u) {
                __builtin_amdgcn_s_sleep(2);
                if ((++spins & 255u) == 0u) { if (__builtin_amdgcn_readfirstlane(__hip_atomic_load(tmo, __ATOMIC_RELAXED, __HIP_MEMORY_SCOPE_AGENT)) != 0u) break;
                    if (spins > (1u << 20)) { __hip_atomic_store(tmo, 1u, __ATOMIC_RELAXED, __HIP_MEMORY_SCOPE_AGENT); break; } } }
        }
        asm volatile("" ::: "memory"); __builtin_amdgcn_s_barrier(); asm volatile("" ::: "memory");
    }
};
struct EpiGateUpWT {
    __amdgpu_buffer_rsrc_t rsrc; LAS unsigned char* lds; LAS int* mm;
    __device__ __forceinline__ void operator()(const f32x4 (&acc)[2][2][4][2], const MU& u, int wr, int wc, int fr, int fq) const {
        const int e = u.e, n_e = mm[e], r0 = u.rt * BM + wr * 64 + fr, col0 = u.pn * HALF + wc * 32 + 8 * fq;
        float wv[2][4];
#pragma unroll
        for (int ai = 0; ai < 2; ++ai)
#pragma unroll
            for (int m = 0; m < 4; ++m) wv[ai][m] = ((const LAS float*)(lds + TAB_OFF + 2048))[u.buf * 256 + wr * 64 + fr + ai * HALF + m * 16];
#pragma unroll
        for (int ai = 0; ai < 2; ++ai)
#pragma unroll
            for (int m = 0; m < 4; ++m) { const int r = r0 + ai * HALF + m * 16;
                if (r < n_e) { const float w = wv[ai][m]; f32x4 o[2];
#pragma unroll
                    for (int n = 0; n < 2; ++n) { const f32x4 g = acc[ai][0][m][n], up = acc[ai][1][m][n];
#pragma unroll
                        for (int j = 0; j < 4; ++j) o[n][j] = w * silu_f(g[j]) * up[j]; }
                    u32x4 q; q.x = cvt_pk_bf16(o[0][0], o[0][1]); q.y = cvt_pk_bf16(o[0][2], o[0][3]); q.z = cvt_pk_bf16(o[1][0], o[1][1]); q.w = cvt_pk_bf16(o[1][2], o[1][3]);
                    __builtin_amdgcn_raw_buffer_store_b128(q, rsrc, (unsigned)(((u.hb + r) * FF + col0) * 2), 0, 16); } }
    }
};
struct EpiDownM {
    unsigned char* Y8; LAS int* mm;
    __device__ __forceinline__ void operator()(const f32x4 (&acc)[2][2][4][2], const MU& u, int wr, int wc, int fr, int fq) const {
        const int e = u.e, n_e = mm[e], r0 = u.rt * BM + wr * 64 + fr, col0 = u.pn * BM + 64 * wc + 16 * fq;
#pragma unroll
        for (int ai = 0; ai < 2; ++ai)
#pragma unroll
            for (int m = 0; m < 4; ++m) { const int r = r0 + ai * HALF + m * 16;
                if (r < n_e) { u32x4 q; q.x = pk_fp8x4(acc[ai][0][m][0]); q.y = pk_fp8x4(acc[ai][0][m][1]); q.z = pk_fp8x4(acc[ai][1][m][0]); q.w = pk_fp8x4(acc[ai][1][m][1]);
                    *(u32x4*)(Y8 + (size_t)(u.hb + r) * D + col0) = q; } }
    }
};
__device__ __forceinline__ void gemm_phase_moe(LAS unsigned char* lds, const MoeMergedSched& S, const EpiGateUpWT& EA, const EpiDownM& EB) {
    const int tid = threadIdx.x, wid = __builtin_amdgcn_readfirstlane(tid >> 6), lane = tid & 63, wr = wid >> 2, wc = wid & 3, fr = lane & 15, fq = lane >> 4;
    int sR[2], sC[2]; unsigned vbA[2], vbD[2];
#pragma unroll
    for (int i = 0; i < 2; ++i) { int R, C; stage_rc(tid * 16 + i * 8192, R, C); sR[i] = R; sC[i] = C; const int Rb = (R & ~31) + perm32(R & 31);
        const int RbD = 64 * ((Rb >> 5) & 3) + 16 * ((Rb >> 3) & 3) + (Rb & 7);
        vbA[i] = (unsigned)(Rb * D + C) * 2u; vbD[i] = (unsigned)(RbD * FF + C) * 2u; }
    const size_t kstep = (size_t)(BK * 2);
    const unsigned ldsw = (unsigned)wid * 1024u;
    const int aoff = lds_byte(wr * 64 + fr, fq * 8), boff = lds_byte(wc * 32 + fr, fq * 8);
#define PG_SA(b, h) (((b) * 2 + (h)) * HTB)
#define PG_SB(b, h) ((4 + (b) * 2 + (h)) * HTB)
#define PG_STAGE(bufoff, gbase, voff) do { _Pragma("unroll") for (int _i = 0; _i < 2; ++_i) \
        __builtin_amdgcn_global_load_lds((const unsigned*)((const char*)(gbase) + (voff)[_i]), (LAS unsigned*)(lds + (bufoff) + ldsw + _i * 8192), 16, 0, 0); } while (0)
#define PG_LDA(dst, b, h) do { _Pragma("unroll") for (int m = 0; m < 4; ++m) _Pragma("unroll") for (int k = 0; k < 2; ++k) dst[m][k] = *(const LAS bf16x8*)(lds + PG_SA(b, h) + aoff + m * 2048 + k * 1024); } while (0)
#define PG_LDB(dst, b, h) do { _Pragma("unroll") for (int n = 0; n < 2; ++n) _Pragma("unroll") for (int k = 0; k < 2; ++k) dst[n][k] = *(const LAS bf16x8*)(lds + PG_SB(b, h) + boff + n * 2048 + k * 1024); } while (0)
#define PG_MMA(ai, bj, At, Bt) do { __builtin_amdgcn_s_setprio(1); _Pragma("unroll") for (int m = 0; m < 4; ++m) _Pragma("unroll") for (int n = 0; n < 2; ++n) _Pragma("unroll") for (int k = 0; k < 2; ++k) \
        acc[ai][bj][m][n] = __builtin_amdgcn_mfma_f32_16x16x32_bf16(Bt[n][k], At[m][k], acc[ai][bj][m][n], 0, 0, 0); __builtin_amdgcn_s_setprio(0); } while (0)
#define PG_WAIT_V(n) asm volatile("s_waitcnt vmcnt(" #n ")" ::: "memory")
#define PG_WAIT_L(n) asm volatile("s_waitcnt lgkmcnt(" #n ")" ::: "memory")
#define PG_BAR __builtin_amdgcn_s_barrier()
#define PG_SCHED __builtin_amdgcn_sched_barrier(0)
    MU cur, nxt; int ui = 0;
    if (!S.next(0, cur)) return;
    cur.buf = 0;
    f32x4 acc[2][2][4][2];
#pragma unroll
    for (int a = 0; a < 2; ++a)
#pragma unroll
        for (int b = 0; b < 2; ++b)
#pragma unroll
            for (int m = 0; m < 4; ++m)
#pragma unroll
                for (int n = 0; n < 2; ++n) acc[a][b][m][n] = (f32x4){0.f, 0.f, 0.f, 0.f};
    bf16x8 At[4][2], B0[2][2], B1[2][2];
    if (cur.type == 0) { S.stage_table(cur, 0, lds, wid, lane); PG_WAIT_V(0); PG_BAR; } else S.wait_ready(cur, wid);
    unsigned voC[2][2], voN[2][2];
#pragma unroll
    for (int h = 0; h < 2; ++h)
#pragma unroll
        for (int i = 0; i < 2; ++i) { voC[h][i] = S.voff(cur, 0, lds, h * HALF + sR[i], sC[i]); voN[h][i] = voC[h][i]; }
    const char* cB = cur.B; const char* cA = cur.A; size_t hsC = (size_t)(cur.type == 0 ? HALF : 8) * cur.K * 2; int nt = cur.K / BK;
    if (cur.type == 0) { PG_STAGE(PG_SB(0, 0), cB, vbA); PG_STAGE(PG_SB(0, 1), cB + hsC, vbA); } else { PG_STAGE(PG_SB(0, 0), cB, vbD); PG_STAGE(PG_SB(0, 1), cB + hsC, vbD); }
    PG_STAGE(PG_SA(0, 0), cA, voC[0]); PG_STAGE(PG_SA(0, 1), cA, voC[1]);
    if (wr == 1) PG_BAR;
    PG_WAIT_V(2); PG_BAR;
    if (cur.type == 0) { PG_STAGE(PG_SB(1, 0), cB + kstep, vbA); } else { PG_STAGE(PG_SB(1, 0), cB + kstep, vbD); }
    PG_STAGE(PG_SA(1, 0), cA + kstep, voC[0]);
    if (cur.type == 0) { PG_STAGE(PG_SB(1, 1), cB + hsC + kstep, vbA); } else { PG_STAGE(PG_SB(1, 1), cB + hsC + kstep, vbD); }
    PG_WAIT_V(6); PG_BAR;
    for (;;) {
        const bool has_next = S.next(ui + 1, nxt); nxt.buf = (ui + 1) & 1;
        if (has_next && nxt.type == 0) S.stage_table(nxt, (ui + 1) & 1, lds, wid, lane);
        const char* nB = has_next ? nxt.B : cB; const char* nA = has_next ? nxt.A : cA; const size_t hsN = has_next ? (size_t)(nxt.type == 0 ? HALF : 8) * nxt.K * 2 : hsC;
        for (int t = 0; t < nt; t += 2) {
            const bool last = (t == nt - 2);
            if (last && has_next) {
                if (nxt.type == 1) S.wait_ready(nxt, wid);
#pragma unroll
                for (int h = 0; h < 2; ++h)
#pragma unroll
                    for (int i = 0; i < 2; ++i) voN[h][i] = S.voff(nxt, (ui + 1) & 1, lds, h * HALF + sR[i], sC[i]);
            }
            unsigned vo2[2][2], vb2[2]; const bool b2gu = last ? (has_next ? nxt.type == 0 : cur.type == 0) : (cur.type == 0);
#pragma unroll
            for (int h = 0; h < 2; ++h)
#pragma unroll
                for (int i = 0; i < 2; ++i) vo2[h][i] = last ? voN[h][i] : voC[h][i];
#pragma unroll
            for (int i = 0; i < 2; ++i) vb2[i] = b2gu ? vbA[i] : vbD[i];
            const size_t hs2 = last ? hsN : hsC;
            const char* a1 = cA + (size_t)(t + 1) * kstep;
            const char* a2 = last ? nA : cA + (size_t)(t + 2) * kstep; const char* b2 = last ? nB : cB + (size_t)(t + 2) * kstep;
            const char* a3 = a2 + kstep; const char* b3 = b2 + kstep;
            PG_LDB(B0, 0, 0); PG_LDB(B1, 0, 1); PG_SCHED; PG_LDA(At, 0, 0); PG_STAGE(PG_SA(1, 1), a1, voC[1]);
            PG_WAIT_V(8); PG_WAIT_L(0); PG_BAR; PG_MMA(0, 0, At, B0); PG_MMA(0, 1, At, B1); PG_BAR; PG_SCHED;
            PG_LDA(At, 0, 1); PG_STAGE(PG_SB(0, 0), b2, vb2); PG_STAGE(PG_SB(0, 1), b2 + hs2, vb2); PG_STAGE(PG_SA(0, 0), a2, vo2[0]);
            PG_WAIT_V(8); PG_WAIT_L(0); PG_BAR; PG_MMA(1, 0, At, B0); PG_MMA(1, 1, At, B1); PG_BAR; PG_SCHED;
            PG_LDB(B0, 1, 0); PG_LDB(B1, 1, 1); PG_SCHED; PG_LDA(At, 1, 0); PG_STAGE(PG_SA(0, 1), a2, vo2[1]);
            PG_WAIT_V(8); PG_WAIT_L(0); PG_BAR; PG_MMA(0, 0, At, B0); PG_MMA(0, 1, At, B1); PG_BAR; PG_SCHED;
            PG_LDA(At, 1, 1); PG_STAGE(PG_SB(1, 0), b3, vb2); PG_STAGE(PG_SB(1, 1), b3 + hs2, vb2); PG_STAGE(PG_SA(1, 0), a3, vo2[0]);
            PG_WAIT_V(8); PG_WAIT_L(0); PG_BAR; PG_MMA(1, 0, At, B0); PG_MMA(1, 1, At, B1); PG_BAR; PG_SCHED;
        }
        if (wr == 0) PG_BAR;
        if (cur.type == 0) { EA(acc, cur, wr, wc, fr, fq);
            PG_WAIT_V(0);
            if (lane == 0) __hip_atomic_fetch_add(S.tile_word(cur), 1u, __ATOMIC_RELAXED, __HIP_MEMORY_SCOPE_AGENT); }
        else EB(acc, cur, wr, wc, fr, fq);
        if (!has_next) break;
#pragma unroll
        for (int a = 0; a < 2; ++a)
#pragma unroll
            for (int b = 0; b < 2; ++b)
#pragma unroll
                for (int m = 0; m < 4; ++m)
#pragma unroll
                    for (int n = 0; n < 2; ++n) acc[a][b][m][n] = (f32x4){0.f, 0.f, 0.f, 0.f};
        cur = nxt; cB = nB; cA = nA; hsC = hsN; nt = cur.K / BK; ++ui;
#pragma unroll
        for (int h = 0; h < 2; ++h)
#pragma unroll
            for (int i = 0; i < 2; ++i) voC[h][i] = voN[h][i];
        if (wr == 1) PG_BAR;
    }
    PG_WAIT_V(0);
    PG_BAR;
#undef PG_SA
#undef PG_SB
#undef PG_STAGE
#undef PG_LDA
#undef PG_LDB
#undef PG_MMA
#undef PG_WAIT_V
#undef PG_WAIT_L
#undef PG_BAR
#undef PG_SCHED
}
}
__device__ __forceinline__ void fast_moe_merged(Frame& F, int layer) {
    LAS int* mm = moe_map(F, layer);
    int U = 0;
    for (int e = 0; e < 16; ++e) U += ((mm[e] + 255) >> 8) * 4;
    pg::MoeMergedSched S{(const char*)(F.ws + WS_WGU) + (size_t)layer * 16 * 1024 * 1024 * 2, (const char*)(F.ws + WS_WDN) + (size_t)layer * 16 * 1024 * 512 * 2,
                         (const char*)(F.ws + WS_HB), (const char*)(F.ws + WS_HID), (const int*)(F.ws + WS_SLOTT) + layer * 16 * CAP, (const float*)(F.ws + WS_SLOTW) + layer * 16 * CAP, mm,
                         F.ctl + CW_TILE + layer * 288 * 64, F.ctl + CW_TMO2, F.G, F.wg, U};
    pg::EpiGateUpWT EA{__builtin_amdgcn_make_buffer_rsrc((void*)(F.ws + WS_HID), 0, HROWS * FF * 2, 0x00020000), F.lds, mm};
    pg::EpiDownM EB{(unsigned char*)(F.ws + WS_Y), mm};
    pg::gemm_phase_moe(F.lds, S, EA, EB);
}

constexpr int NPH = 18;
__global__ void __launch_bounds__(NTHR, 2) mega(Args args) {
    extern __shared__ __attribute__((aligned(16))) unsigned char lds[];
    Frame F;
    F.lds = (LAS unsigned char*)lds;
    F.tid = threadIdx.x; F.lane = F.tid & 63; F.wave = __builtin_amdgcn_readfirstlane(F.tid >> 6);
    F.G = gridDim.x; F.wg = blockIdx.x;
    F.out = args.out; F.ws = args.ws; F.ctl = (unsigned*)(args.ws + WS_CTL);
    volatile LAS unsigned* bst = (volatile LAS unsigned*)(F.lds + LDS_BYTES - 16);
    if (F.tid < 4) bst[F.tid] = 0u;
    __syncthreads();
    const int lo = args.ph_lo, hi = args.ph_hi;
    XcdBarrier bar; bar.bar = F.ctl + CW_BAR; bar.x = 0; bar.st = bst;
    if (hi - lo > 1) bar = xcd_barrier_post(F.ctl + CW_BAR, bst);
#define IN(k) (lo <= (k) && (k) < hi)
#define SEAM(k) do { if (IN(k) && IN((k) + 1)) xcd_barrier(bar); } while (0)
    const float* mod = (const float*)(F.ws + WS_MOD);

#ifndef DBL_MASK
#define DBL_MASK 0x0u
#endif
#define RUN(k, body) do { if (IN(k)) { _Pragma("unroll 1") for (int _r = 0; _r < ((((DBL_MASK) >> (k)) & 1u) ? 2 : 1); ++_r) { if (_r) xcd_barrier(bar); F.lane = fresh_lane(); body; } } } while (0)
    RUN(0, phase_prep(F)); SEAM(0);
    RUN(1, phase_norm1_l0(F)); SEAM(1);
    RUN(2, if (FAST_GEMM) fast_inproj(F); else phase_inproj(F)); SEAM(2);
    if (IN(3)) { F.lane = fresh_lane();
#pragma unroll 1
        for (int _r = 0; _r < ((DBL_MASK & 0x100000u) ? 2 : 1); ++_r) { if (FAST_ATTN == 2 && FAST_GEMM) phase_attn_lds(F); else if (FAST_ATTN && FAST_GEMM) phase_attn_mfma(F); else phase_attn_simple(F); }
#pragma unroll 1
        for (int _r = 0; _r < ((DBL_MASK & 0x200000u) ? 2 : 1); ++_r) { if (FAST_FFT) phase_fft1_mfma(F); else phase_fft1_simple(F); }
    } SEAM(3);
    RUN(4, if (FAST_FFT) phase_fft2_mfma(F); else phase_fft2_simple(F)); SEAM(4);
    if (IN(5)) { if (!FAST_FFT) phase_fft3_simple(F); } if (!FAST_FFT) SEAM(5);
    RUN(6, if (FAST_GEMM) fast_outproj(F, WS_MIX, WS_WOUT, F.in[I_X], F.out, mod + 2048, nullptr); else phase_outproj(F, (const bf16*)(F.ws + WS_MIX), (const bf16*)(F.ws + WS_WOUT), F.in[I_X], F.out, mod + 2048, nullptr)); SEAM(6);
    if (IN(7)) { F.lane = fresh_lane(); if (XBF16) phase_norm2_route_mfma(F, 0); else phase_norm2_route(F, 0); } SEAM(7);
    if (MOE_MERGED && FAST_GEMM) { if (IN(8)) { F.lane = fresh_lane(); fast_moe_merged(F, 0); } if (IN(8) && IN(10)) xcd_barrier(bar); }
    else { RUN(8, if (FAST_GEMM) fast_moe_gateup(F, 0); else phase_moe_gateup(F, 0)); SEAM(8);
    RUN(9, if (FAST_GEMM) fast_moe_down(F, 0); else phase_moe_down(F, 0)); SEAM(9); }
    if (IN(10)) { F.lane = fresh_lane(); phase_combine<false>(F, 0); } SEAM(10);
    RUN(11, if (FAST_GEMM) fast_pw1(F); else phase_pw1(F)); SEAM(11);
    RUN(12, phase_dwconv_fast(F)); SEAM(12);
    if (IN(13)) { F.lane = fresh_lane(); if (FAST_GEMM) fast_outproj(F, WS_V1, WS_WPW2, F.out, F.out, mod + 5 * 6144 + 2048, F.in[I_PW2B]); else phase_outproj(F, (const bf16*)(F.ws + WS_V1), (const bf16*)(F.ws + WS_WPW2), F.out, F.out, mod + 5 * 6144 + 2048, F.in[I_PW2B]); } SEAM(13);
    if (IN(14)) { F.lane = fresh_lane(); if (XBF16) phase_norm2_route_mfma(F, 1); else phase_norm2_route(F, 1); } SEAM(14);
    if (MOE_MERGED && FAST_GEMM) { if (IN(15)) { F.lane = fresh_lane(); fast_moe_merged(F, 1); } if (IN(15) && IN(17)) xcd_barrier(bar); }
    else { RUN(15, if (FAST_GEMM) fast_moe_gateup(F, 1); else phase_moe_gateup(F, 1)); SEAM(15);
    RUN(16, if (FAST_GEMM) fast_moe_down(F, 1); else phase_moe_down(F, 1)); SEAM(16); }
    if (IN(17)) { F.lane = fresh_lane(); phase_combine<true>(F, 1); }
#undef RUN
#undef IN
#undef SEAM
}

extern "C" void kernel_launch(void* const* d_in, const int* in_sizes, int n_in, void* d_out, int out_size, void* d_ws, size_t ws_size, hipStream_t stream) {
    static int grid = 0;
    if (grid == 0) {
        if (n_in != 25 || out_size != T * D || ws_size < WS_END) { fprintf(stderr, "kernel_launch: unexpected shapes (n_in %d out %d ws %zu)\n", n_in, out_size, ws_size); grid = -1; return; }
        int dev = 0, cus = 0, per_cu = 0;
        if (hipGetDevice(&dev) != hipSuccess || hipDeviceGetAttribute(&cus, hipDeviceAttributeMultiprocessorCount, dev) != hipSuccess) { grid = -1; return; }
        if (hipFuncSetAttribute((const void*)mega, hipFuncAttributeMaxDynamicSharedMemorySize, LDS_BYTES) != hipSuccess) { fprintf(stderr, "kernel_launch: hipFuncSetAttribute failed\n"); grid = -1; return; }
        if (hipOccupancyMaxActiveBlocksPerMultiprocessor(&per_cu, (const void*)mega, NTHR, LDS_BYTES) != hipSuccess || per_cu < 1) { fprintf(stderr, "kernel_launch: occupancy query says %d\n", per_cu); }
        (void)hipGetLastError();
        grid = cus;
    }
    if (grid < 0) return;
    (void)hipMemsetAsync((char*)d_ws + WS_CTL, 0, CTL_BYTES, stream);
    Args a{};
    for (int i = 0; i < 25; ++i) a.in[i] = (const float*)d_in[i];
    a.out = (float*)d_out; a.ws = (unsigned char*)d_ws;
#if MK_ONE_LAUNCH
    a.ph_lo = 0; a.ph_hi = NPH;
    hipLaunchKernelGGL(mega, dim3(grid), dim3(NTHR), LDS_BYTES, stream, a);
#else
#ifndef PROBE_PHASE
#define PROBE_PHASE -1
#endif
    for (int p = 0; p < NPH; ++p) { a.ph_lo = p; a.ph_hi = p + 1; hipLaunchKernelGGL(mega, dim3(grid), dim3(NTHR), LDS_BYTES, stream, a);
        if (p == PROBE_PHASE) { if (p == 7 || p == 14) (void)hipMemsetAsync((char*)d_ws + WS_CTL, 0, CTL_BYTES, stream);
            hipLaunchKernelGGL(mega, dim3(grid), dim3(NTHR), LDS_BYTES, stream, a); } }
#endif
}
```

```cpp
#include <hip/hip_runtime.h>
#include <cstdio>

#ifndef MK_ONE_LAUNCH
#define MK_ONE_LAUNCH 1
#endif

#define GAS __attribute__((address_space(1)))
#define LAS __attribute__((address_space(3)))
typedef unsigned short bf16;
typedef short bf16x8 __attribute__((ext_vector_type(8)));
typedef float f32x4 __attribute__((ext_vector_type(4)));
typedef float f32x16 __attribute__((ext_vector_type(16)));
typedef unsigned u32x4 __attribute__((ext_vector_type(4)));
typedef unsigned u32x2 __attribute__((ext_vector_type(2)));

constexpr int D = 1024, NB = 4, L = 8192, T = NB * L, CL = 256, TC = NB * CL;
constexpr int NE = 16, FF = 512, CONVW = 31;
constexpr int N_IN = 1280;
constexpr int FN1 = 64, FN2 = 128;
#ifndef FAST_GEMM
#define FAST_GEMM 1
#endif
#ifndef MOE_MERGED
#define MOE_MERGED 1
#endif
#ifndef XBF16
#define XBF16 FAST_GEMM
#endif
#ifndef FAST_ATTN
#define FAST_ATTN 2
#endif
#ifndef FAST_FFT
#define FAST_FFT 1
#endif
constexpr int IL = FAST_GEMM ? 128 : 32;
constexpr float EPS = 1e-6f;
constexpr int NWAVES = 8, NTHR = 512;
constexpr int CAP = 32768;
constexpr int HROWS = 65536 + 4096;

constexpr size_t MiB = 1u << 20;
constexpr size_t WS_CTL = 0, CTL_BYTES = 1 * MiB;
constexpr size_t WS_MOD = 1 * MiB;
constexpr size_t WS_TW = 1 * MiB + 512 * 1024;
constexpr size_t WS_WIN = 2 * MiB, WS_WOUT = 6 * MiB, WS_WPW1 = 10 * MiB, WS_WPW2 = 14 * MiB;
constexpr size_t WS_WGU = 16 * MiB, WS_WDN = 80 * MiB;
constexpr size_t WS_TOKE = 112 * MiB, WS_TOKP = 113 * MiB, WS_TOKW = 114 * MiB;
constexpr size_t WS_SLOTT = 116 * MiB, WS_SLOTW = 120 * MiB;
constexpr size_t WS_HB = 128 * MiB;
constexpr size_t WS_UF = 196 * MiB, WS_Q = 228 * MiB, WS_K = 260 * MiB, WS_V = 268 * MiB, WS_CK = 276 * MiB, WS_CV = 277 * MiB;
constexpr size_t WS_G = 280 * MiB, WS_MIX = 344 * MiB, WS_AB = 408 * MiB;
constexpr size_t WS_XB = 408 * MiB;
constexpr size_t WS_HID = 196 * MiB, WS_Y = 264 * MiB;
constexpr size_t WS_U = 196 * MiB, WS_V1 = 260 * MiB;
constexpr size_t WS_END = 472 * MiB;
constexpr int CW_BAR = 4096;
constexpr int CW_CNT = 8192;
constexpr int CW_TILE = 16384;
constexpr int CW_TMO2 = 2048;

constexpr int LDS_BYTES = 147456;

__device__ __forceinline__ unsigned f2bf(float f) { unsigned u = __float_as_uint(f); return (u + 0x7fffu + ((u >> 16) & 1u)) >> 16; }
__device__ __forceinline__ float bf2f(unsigned b) { return __uint_as_float(b << 16); }
typedef __bf16 b16x2_t __attribute__((ext_vector_type(2)));
__device__ __forceinline__ unsigned pkbf(float a, float b) { typedef float f2 __attribute__((ext_vector_type(2))); f2 v = {a, b}; return __builtin_bit_cast(unsigned, __builtin_convertvector(v, b16x2_t)); }
__device__ __forceinline__ unsigned pk2(float lo, float hi) { return pkbf(lo, hi); }
__device__ __forceinline__ float bflo(unsigned w) { return __uint_as_float(w << 16); }
__device__ __forceinline__ float bfhi(unsigned w) { return __uint_as_float(w & 0xffff0000u); }
__device__ __forceinline__ float wave_sum(float v) {
    v += __builtin_bit_cast(float, __builtin_amdgcn_mov_dpp(__builtin_bit_cast(int, v), 0xB1, 0xf, 0xf, true));
    v += __builtin_bit_cast(float, __builtin_amdgcn_mov_dpp(__builtin_bit_cast(int, v), 0x4E, 0xf, 0xf, true));
    v += __builtin_bit_cast(float, __builtin_amdgcn_mov_dpp(__builtin_bit_cast(int, v), 0x141, 0xf, 0xf, true));
    v += __builtin_bit_cast(float, __builtin_amdgcn_mov_dpp(__builtin_bit_cast(int, v), 0x140, 0xf, 0xf, true));
    const int iv = __builtin_bit_cast(int, v);
    const float a = __builtin_bit_cast(float, __builtin_amdgcn_readlane(iv, 15)), b = __builtin_bit_cast(float, __builtin_amdgcn_readlane(iv, 31));
    const float c = __builtin_bit_cast(float, __builtin_amdgcn_readlane(iv, 47)), d = __builtin_bit_cast(float, __builtin_amdgcn_readlane(iv, 63));
    return (a + b) + (c + d);
}
template <int CTRL> __device__ __forceinline__ float dppf(float v) { return __uint_as_float((unsigned)__builtin_amdgcn_update_dpp(0, (int)__float_as_uint(v), CTRL, 0xf, 0xf, true)); }
__device__ __forceinline__ float swap32_add(float a, float b) { const auto r = __builtin_amdgcn_permlane32_swap(__float_as_uint(a), __float_as_uint(b), false, false); return __uint_as_float(r[0]) + __uint_as_float(r[1]); }
__device__ __forceinline__ float swap16_add(float a, float b) { const auto r = __builtin_amdgcn_permlane16_swap(__float_as_uint(a), __float_as_uint(b), false, false); return __uint_as_float(r[0]) + __uint_as_float(r[1]); }
template <int CTRL> __device__ __forceinline__ float sel_add(float a, float b, bool hi) { const float t = hi ? b : a, u = hi ? a : b; return t + dppf<CTRL>(u); }
typedef __bf16 bf16x2_t __attribute__((ext_vector_type(2)));
__device__ __forceinline__ float dot2_bf16(unsigned w, unsigned x, float acc) { return __builtin_amdgcn_fdot2_f32_bf16(__builtin_bit_cast(bf16x2_t, w), __builtin_bit_cast(bf16x2_t, x), acc, false); }
__device__ __forceinline__ float silu_f(float x) { return x * __builtin_amdgcn_rcpf(1.f + __expf(-x)); }
__device__ __forceinline__ float sigmoid_f(float x) { return __builtin_amdgcn_rcpf(1.f + __expf(-x)); }
constexpr float YSCALE = 32.f;
__device__ __forceinline__ unsigned pk_fp8x4(f32x4 v) {
    int d = __builtin_amdgcn_cvt_pk_fp8_f32(__builtin_amdgcn_fmed3f(v[0] * YSCALE, -448.f, 448.f), __builtin_amdgcn_fmed3f(v[1] * YSCALE, -448.f, 448.f), 0, false);
    d = __builtin_amdgcn_cvt_pk_fp8_f32(__builtin_amdgcn_fmed3f(v[2] * YSCALE, -448.f, 448.f), __builtin_amdgcn_fmed3f(v[3] * YSCALE, -448.f, 448.f), d, true);
    return (unsigned)d;
}
__device__ __forceinline__ f32x4 un_fp8x4(unsigned d) { typedef float f2 __attribute__((ext_vector_type(2)));
    const f2 lo = __builtin_amdgcn_cvt_pk_f32_fp8((int)d, false), hi = __builtin_amdgcn_cvt_pk_f32_fp8((int)d, true); return (f32x4){lo.x, lo.y, hi.x, hi.y}; }
#define LDS_WAIT() asm volatile("s_waitcnt lgkmcnt(0)" ::: "memory")
__device__ __forceinline__ int fresh_lane() { int l; asm volatile("v_mbcnt_lo_u32_b32 %0, -1, 0\n\tv_mbcnt_hi_u32_b32 %0, -1, %0" : "=v"(l)); return l; }

#define XB_TMO      128
#define XB_XCNT(j)  (256  + 64 * (j))
#define XB_XSUB(j)  (1280 + 64 * (j))
#define XB_XGEN(j)  (2304 + 64 * (j))
#define XB_TOP      3328
#define XB_TOPGEN   3392
#define XCD_BAR_WORDS 3456
#define XB_SPIN_CAP (1u << 20)
__device__ __forceinline__ unsigned xb_ld(unsigned* p)              { return __hip_atomic_load(p, __ATOMIC_RELAXED, __HIP_MEMORY_SCOPE_AGENT); }
__device__ __forceinline__ unsigned xb_add(unsigned* p, unsigned v) { return __hip_atomic_fetch_add(p, v, __ATOMIC_RELAXED, __HIP_MEMORY_SCOPE_AGENT); }
__device__ __forceinline__ unsigned xb_xcc_id() { return (unsigned)__builtin_amdgcn_s_getreg((3 << 11) | 20) & 0xFu; }
#define XB_SPIN(cond, bar) do { unsigned _sp = 0; while (cond) { __builtin_amdgcn_s_sleep(1); \
    if ((++_sp & 255u) == 0u) { if (xb_ld(&(bar)[XB_TMO])) break; if (_sp > XB_SPIN_CAP) { atomicAdd(&(bar)[XB_TMO], 1u); break; } } } } while (0)
struct XcdBarrier { unsigned* bar; unsigned x; volatile LAS unsigned* st; };
__device__ __forceinline__ XcdBarrier xcd_barrier_post(unsigned* bar, volatile LAS unsigned* st) {
    XcdBarrier b; b.bar = bar; b.x = xb_xcc_id(); b.st = st;
    if (threadIdx.x == 0) (void)xb_add(&bar[XB_XCNT(b.x)], 1u);
    return b;
}
__device__ __forceinline__ void xcd_barrier_complete(unsigned* bar, unsigned x, unsigned& nloc, unsigned& nx) {
    const unsigned G = gridDim.x * gridDim.y * gridDim.z;
    unsigned sum, cnt, mine, sp = 0u;
    for (;;) {
        sum = 0u; cnt = 0u; mine = 0u;
#pragma unroll
        for (unsigned j = 0; j < 16; ++j) { const unsigned c = xb_ld(&bar[XB_XCNT(j)]); sum += c; cnt += (c > 0u) ? 1u : 0u; mine = (j == x) ? c : mine; }
        if (sum == G) break;
        __builtin_amdgcn_s_sleep(1);
        if ((++sp & 255u) == 0u) { if (xb_ld(&bar[XB_TMO])) break; if (sp > XB_SPIN_CAP) { atomicAdd(&bar[XB_TMO], 1u); break; } }
    }
    nloc = mine > 0u ? mine : 1u; nx = cnt > 0u ? cnt : 1u;
}
__device__ __forceinline__ void xcd_barrier(const XcdBarrier& b) {
    asm volatile("s_waitcnt vmcnt(0)" ::: "memory");
    __syncthreads();
    if (threadIdx.x == 0) {
        unsigned* bar = b.bar;
        __builtin_amdgcn_s_waitcnt(0);
        unsigned nloc = b.st[0], nx = b.st[1];
        if (nloc == 0u) { xcd_barrier_complete(bar, b.x, nloc, nx); b.st[0] = nloc; b.st[1] = nx; }
        const unsigned old = xb_add(&bar[XB_XSUB(b.x)], 1u);
        const unsigned gen = old / nloc;
        if (old + 1u == (gen + 1u) * nloc) {
            __builtin_amdgcn_fence(__ATOMIC_RELEASE, "agent");
            asm volatile("s_waitcnt vmcnt(0)" ::: "memory");
            const unsigned og = xb_add(&bar[XB_TOP], 1u);
            const unsigned tg = og / nx;
            if (og + 1u == (tg + 1u) * nx) xb_add(&bar[XB_TOPGEN], 1u);
            else XB_SPIN(xb_ld(&bar[XB_TOPGEN]) == tg, bar);
            __builtin_amdgcn_fence(__ATOMIC_ACQUIRE, "agent");
            xb_add(&bar[XB_XGEN(b.x)], 1u);
            asm volatile("s_waitcnt vmcnt(0)" ::: "memory");
        } else {
            XB_SPIN(xb_ld(&bar[XB_XGEN(b.x)]) == gen, bar);
            __builtin_amdgcn_fence(__ATOMIC_ACQUIRE, "agent");
            asm volatile("s_waitcnt vmcnt(0)" ::: "memory");
        }
    }
    __syncthreads();
}

struct Args { const float* in[25]; float* out; unsigned char* ws; int ph_lo, ph_hi; };
enum { I_X = 0, I_C, I_CTX, I_CCTX, I_ADAW, I_ADAB, I_NMG, I_NFG, I_WIN, I_WOUT, I_SINK, I_PW1W, I_PW1B, I_DWW, I_DWB, I_LNG, I_LNB,
       I_PW2W, I_PW2B, I_RW, I_RB, I_WG, I_WU, I_WD, I_FNG };

struct InPtrs {
    __device__ __forceinline__ const float* operator[](int i) const { const float* r;
        asm volatile("s_load_dwordx2 %0, %1, %2\n\ts_waitcnt lgkmcnt(0)" : "=s"(r) : "s"(__builtin_amdgcn_kernarg_segment_ptr()), "s"(i * 8)); return r; }
};
struct Frame {
    LAS unsigned char* lds;
    int tid, lane, wave, G, wg;
    InPtrs in;
    float* out;
    unsigned char* ws;
    unsigned* ctl;
};

__device__ __forceinline__ int crow(int i, int h) { return (i & 3) + 8 * (i >> 2) + 4 * h; }
template <class RowPtr, class Epi>
__device__ __forceinline__ void sgemm_tile(const RowPtr& rowptr, const bf16* Bt, int K, int m0, int n0, const Epi& epi, int wave, int lane) {
    const int wm = wave & 3, wn = wave >> 2, r = lane & 31, h = lane >> 5;
    const bf16* ap = rowptr(m0 + wm * 32 + r) + 8 * h;
    const bf16* bp0 = Bt + (size_t)(n0 + wn * 64 + r) * K + 8 * h;
    const bf16* bp1 = bp0 + (size_t)32 * K;
    f32x16 c0, c1;
#pragma unroll
    for (int i = 0; i < 16; ++i) { c0[i] = 0.f; c1[i] = 0.f; }
#pragma unroll 2
    for (int k = 0; k < K; k += 32) {
        const bf16x8 a0 = *(const bf16x8*)(ap + k), a1 = *(const bf16x8*)(ap + k + 16);
        const bf16x8 b00 = *(const bf16x8*)(bp0 + k), b01 = *(const bf16x8*)(bp0 + k + 16);
        const bf16x8 b10 = *(const bf16x8*)(bp1 + k), b11 = *(const bf16x8*)(bp1 + k + 16);
        c0 = __builtin_amdgcn_mfma_f32_32x32x16_bf16(a0, b00, c0, 0, 0, 0);
        c1 = __builtin_amdgcn_mfma_f32_32x32x16_bf16(a0, b10, c1, 0, 0, 0);
        c0 = __builtin_amdgcn_mfma_f32_32x32x16_bf16(a1, b01, c0, 0, 0, 0);
        c1 = __builtin_amdgcn_mfma_f32_32x32x16_bf16(a1, b11, c1, 0, 0, 0);
    }
    epi(m0 + wm * 32, n0 + wn * 64, c0, c1, lane);
}

__device__ __forceinline__ void p0_transpose_item(const float* W, int K, int N, bf16* WT, int k0, int n0, int drow0, LAS float* scr, int lane) {
#pragma unroll 8
    for (int i = 0; i < 32; ++i) { const int kk = 2 * i + (lane >> 5); scr[kk * 33 + (lane & 31)] = W[(size_t)(k0 + kk) * N + n0 + (lane & 31)]; }
    LDS_WAIT(); asm volatile("" ::: "memory");
    const int c = lane & 7;
#pragma unroll
    for (int j = 0; j < 4; ++j) { const int n = (lane >> 3) + 8 * j; const LAS float* s = scr + (8 * c) * 33 + n;
        u32x4 o; o.x = pk2(s[0 * 33], s[1 * 33]); o.y = pk2(s[2 * 33], s[3 * 33]); o.z = pk2(s[4 * 33], s[5 * 33]); o.w = pk2(s[6 * 33], s[7 * 33]);
        *(u32x4*)(WT + (size_t)(drow0 + n) * K + k0 + 8 * c) = o; }
    LDS_WAIT(); asm volatile("" ::: "memory");
}
__device__ __forceinline__ int il_row(int j, int half) { return (j / IL) * (2 * IL) + half * IL + (j % IL); }

constexpr int T_NITEMS = 640 + 512 + 1024 + 512 + 3 * 32 * 256, T_DEFER_ATT = 10 * 2048;
struct TItem { const float* W; bf16* WT; int K, N, k0, n0, drow0; bool ok; };
__device__ __forceinline__ TItem t_decode(const Frame& F, int it) {
    constexpr int S0 = 640, S1 = 512, S2 = 1024, S3 = 512, SM = 32 * 256;
    TItem t; t.ok = it < S0 + S1 + S2 + S3 + 3 * SM; t.W = F.in[I_WIN]; t.WT = (bf16*)(F.ws + WS_WIN); t.K = 1024; t.N = 1280; t.k0 = 0; t.n0 = 0; t.drow0 = 0;
    int r = it;
    if (r < S0) { const int kb = r / 40, nb = r % 40; t.k0 = kb * 64; t.n0 = nb * 32; t.drow0 = nb * 32; return t; } r -= S0;
    if (r < S1) { const int kb = r / 32, nb = r % 32; t.W = F.in[I_WOUT]; t.WT = (bf16*)(F.ws + WS_WOUT); t.N = 1024; t.k0 = kb * 64; t.n0 = nb * 32; t.drow0 = nb * 32; return t; } r -= S1;
    if (r < S2) { const int kb = r / 64, nb = r % 64, n0 = nb * 32; t.W = F.in[I_PW1W]; t.WT = (bf16*)(F.ws + WS_WPW1); t.N = 2048; t.k0 = kb * 64; t.n0 = n0; t.drow0 = il_row(n0 & 1023, n0 >> 10); return t; } r -= S2;
    if (r < S3) { const int kb = r / 32, nb = r % 32; t.W = F.in[I_PW2W]; t.WT = (bf16*)(F.ws + WS_WPW2); t.N = 1024; t.k0 = kb * 64; t.n0 = nb * 32; t.drow0 = nb * 32; return t; } r -= S3;
    if (r < SM) { const int le = r >> 8, q = r & 255, kb = q / 16, nb = q % 16; t.W = F.in[I_WG] + (size_t)le * 1024 * 512; t.WT = (bf16*)(F.ws + WS_WGU) + (size_t)le * 1024 * 1024; t.N = 512; t.k0 = kb * 64; t.n0 = nb * 32; t.drow0 = il_row(nb * 32, 0); return t; } r -= SM;
    if (r < SM) { const int le = r >> 8, q = r & 255, kb = q / 16, nb = q % 16; t.W = F.in[I_WU] + (size_t)le * 1024 * 512; t.WT = (bf16*)(F.ws + WS_WGU) + (size_t)le * 1024 * 1024; t.N = 512; t.k0 = kb * 64; t.n0 = nb * 32; t.drow0 = il_row(nb * 32, 1); return t; } r -= SM;
    { const int le = (r >> 8) & 31, q = r & 255, kb = q / 32, nb = q % 32; t.W = F.in[I_WD] + (size_t)le * 512 * 1024; t.WT = (bf16*)(F.ws + WS_WDN) + (size_t)le * 1024 * 512; t.K = 512; t.N = 1024; t.k0 = kb * 64; t.n0 = nb * 32; t.drow0 = nb * 32; }
    return t;
}
__device__ __forceinline__ void t_load(const TItem& t, int lane, float (&v)[32]) {
    if (t.ok) {
#pragma unroll
        for (int i = 0; i < 32; ++i) v[i] = t.W[(size_t)(t.k0 + 2 * i + (lane >> 5)) * t.N + t.n0 + (lane & 31)];
    }
}
__device__ __forceinline__ void t_store(const TItem& t, LAS float* scr, int lane, const float (&v)[32]) {
#pragma unroll
    for (int i = 0; i < 32; ++i) scr[(2 * i + (lane >> 5)) * 33 + (lane & 31)] = v[i];
    LDS_WAIT(); asm volatile("" ::: "memory");
    const int c = lane & 7;
#pragma unroll
    for (int j = 0; j < 4; ++j) { const int n = (lane >> 3) + 8 * j; const LAS float* s = scr + (8 * c) * 33 + n;
        u32x4 o; o.x = pk2(s[0 * 33], s[1 * 33]); o.y = pk2(s[2 * 33], s[3 * 33]); o.z = pk2(s[4 * 33], s[5 * 33]); o.w = pk2(s[6 * 33], s[7 * 33]);
        *(u32x4*)(t.WT + (size_t)(t.drow0 + n) * t.K + t.k0 + 8 * c) = o; }
    LDS_WAIT(); asm volatile("" ::: "memory");
}
__device__ __forceinline__ void t_dma(const TItem& t, LAS unsigned char* scr, int lane) {
    if (t.ok) {
#pragma unroll
        for (int i = 0; i < 8; ++i)
            __builtin_amdgcn_global_load_lds((const unsigned*)(t.W + (size_t)(t.k0 + 8 * i + (lane >> 3)) * t.N + t.n0 + 4 * (lane & 7)), (LAS unsigned*)(scr + 1056 * i), 16, 0, 0);
    }
}
__device__ __forceinline__ void t_store_dma(const TItem& t, const LAS float* scr, int lane) {
    const int c = lane & 7;
#pragma unroll 1
    for (int j = 0; j < 4; ++j) { const int n = (lane >> 3) + 8 * j; float e[8];
#pragma unroll
        for (int q = 0; q < 8; ++q) e[q] = scr[264 * c + 32 * q + n];
        { u32x4 o; o.x = pk2(e[0], e[1]); o.y = pk2(e[2], e[3]); o.z = pk2(e[4], e[5]); o.w = pk2(e[6], e[7]); *(u32x4*)(t.WT + (size_t)(t.drow0 + n) * t.K + t.k0 + 8 * c) = o; } }
    LDS_WAIT(); asm volatile("" ::: "memory");
}
__device__ __forceinline__ void t_items_tail(Frame& F, int r, int nw) {
    LAS float* scr = (LAS float*)(F.lds + F.wave * 8704);
    TItem cur = t_decode(F, 640 + T_DEFER_ATT + r); float va[32], vb[32];
    t_load(cur, F.lane, va);
#pragma unroll 1
    for (int it = r; cur.ok; it += nw) {
        const TItem nxt = t_decode(F, 640 + T_DEFER_ATT + it + nw);
        t_load(nxt, F.lane, vb);
        t_store(cur, scr, F.lane, va);
#pragma unroll
        for (int i = 0; i < 32; ++i) va[i] = vb[i];
        cur = nxt;
    }
}
__device__ __forceinline__ void phase_prep(Frame& F) {
    {
        LAS float* sc = (LAS float*)F.lds;
        LAS float* red = sc + 5 * 1024;
        bool loaded = false;
        for (int it = F.wg; it < 192; it += F.G) {
            if (!loaded) {
                for (int i = F.tid; i < 5 * 1024; i += NTHR) { const int b = i >> 10, k = i & 1023; const float v = b < 4 ? F.in[I_C][b * 1024 + k] : F.in[I_CCTX][k]; sc[i] = silu_f(v); }
                __syncthreads(); loaded = true;
            }
            const int l = it / 96, n0 = (it % 96) * 64, c4 = F.tid & 15, kg = F.tid >> 4;
            const float* w = F.in[I_ADAW] + (size_t)l * 1024 * 6144 + n0 + 4 * c4;
            f32x4 a[5];
#pragma unroll
            for (int b = 0; b < 5; ++b) a[b] = (f32x4){0.f, 0.f, 0.f, 0.f};
#pragma unroll 16
            for (int kk = 0; kk < 32; ++kk) { const int k = kg * 32 + kk; const f32x4 wv = *(const f32x4*)(w + (size_t)k * 6144);
#pragma unroll
                for (int b = 0; b < 5; ++b) a[b] += sc[b * 1024 + k] * wv; }
#pragma unroll
            for (int b = 0; b < 5; ++b) *(LAS f32x4*)(red + (kg * 5 + b) * 64 + 4 * c4) = a[b];
            __syncthreads();
            if (F.tid < 320) { const int b = F.tid >> 6, c2 = F.tid & 63; float sm = 0.f;
#pragma unroll
                for (int g = 0; g < 32; ++g) sm += red[(g * 5 + b) * 64 + c2];
                ((float*)(F.ws + WS_MOD))[((size_t)l * 5 + b) * 6144 + n0 + c2] = sm + F.in[I_ADAB][l * 6144 + n0 + c2]; }
            __syncthreads();
        }
        __syncthreads();
    }
    { u32x4* z = (u32x4*)(F.ws + WS_SLOTT); const u32x4 zero = {0u, 0u, 0u, 0u};
      for (int i = F.wg * NTHR + F.tid; i < 2 * 16 * CAP / 4; i += F.G * NTHR) z[i] = zero; }
    { float* tw = (float*)(F.ws + WS_TW);
      for (int k = F.wg * NTHR + F.tid; k < 8192; k += F.G * NTHR) { const float a = (float)k * (6.283185307179586f / 8192.f); tw[2 * k] = __cosf(a); tw[2 * k + 1] = __sinf(a); } }
    {
        LAS float* scr = (LAS float*)(F.lds + F.wave * 8704);
        const int gw = F.wg * NWAVES + F.wave, NGW = F.G * NWAVES;
        auto vmap = [](int v) { return v < 640 ? v : (1 << 30); };
        TItem cur = t_decode(F, vmap(gw)); float va[32], vb[32];
        t_load(cur, F.lane, va);
#pragma unroll 1
        for (int it = gw; cur.ok; it += NGW) {
            const TItem nxt = t_decode(F, vmap(it + NGW));
            t_load(nxt, F.lane, vb);
            t_store(cur, scr, F.lane, va);
#pragma unroll
            for (int i = 0; i < 32; ++i) va[i] = vb[i];
            cur = nxt;
        }
    }
}

#define ROFF(lane, j) (512 * ((j) >> 1) + 8 * (lane) + 4 * ((j) & 1))
__device__ __forceinline__ void row_load(const float* p, int lane, f32x4 (&v)[4]) {
#pragma unroll
    for (int j = 0; j < 4; ++j) v[j] = *(const f32x4*)(p + ROFF(lane, j));
}
__device__ __forceinline__ void row_load_bf(const bf16* p, int lane, f32x4 (&v)[4]) {
#pragma unroll
    for (int jj = 0; jj < 2; ++jj) { const u32x4 w = *(const u32x4*)(p + 512 * jj + 8 * lane); v[2 * jj] = (f32x4){bflo(w.x), bfhi(w.x), bflo(w.y), bfhi(w.y)}; v[2 * jj + 1] = (f32x4){bflo(w.z), bfhi(w.z), bflo(w.w), bfhi(w.w)}; }
}
__device__ __forceinline__ void xrow_load(const float* xf, const bf16* xb, size_t row, int lane, f32x4 (&v)[4]) { if (XBF16) row_load_bf(xb + row * D, lane, v); else row_load(xf + row * D, lane, v); }
__device__ __forceinline__ float row_sumsq(const f32x4 (&v)[4]) {
    float s = 0.f;
#pragma unroll
    for (int j = 0; j < 4; ++j) s += (v[j].x * v[j].x + v[j].y * v[j].y) + (v[j].z * v[j].z + v[j].w * v[j].w);
    return wave_sum(s);
}
__device__ __forceinline__ void row_modulate(f32x4 (&v)[4], float rstd, const float* g, const float* sh, const float* sc, int lane) {
#pragma unroll
    for (int j = 0; j < 4; ++j) { const int o = ROFF(lane, j); const f32x4 gg = *(const f32x4*)(g + o), s1 = *(const f32x4*)(sc + o), s0 = *(const f32x4*)(sh + o);
        v[j] = v[j] * rstd * gg * (1.f + s1) + s0; }
}
__device__ __forceinline__ void row_store_bf16(bf16* dst, const f32x4 (&v)[4], int lane) {
#pragma unroll
    for (int jj = 0; jj < 2; ++jj) { u32x4 w; w.x = pk2(v[2 * jj].x, v[2 * jj].y); w.y = pk2(v[2 * jj].z, v[2 * jj].w); w.z = pk2(v[2 * jj + 1].x, v[2 * jj + 1].y); w.w = pk2(v[2 * jj + 1].z, v[2 * jj + 1].w); *(u32x4*)(dst + 512 * jj + 8 * lane) = w; }
}

__device__ __forceinline__ void phase_norm1_l0(Frame& F) {
    const int gw = F.wg * NWAVES + F.wave, NGW = F.G * NWAVES;
    const float* mod = (const float*)(F.ws + WS_MOD);
    bf16* HB = (bf16*)(F.ws + WS_HB);
    for (int row = gw; row < T + TC; row += NGW) {
        const float* src = row < T ? F.in[I_X] + (size_t)row * D : F.in[I_CTX] + (size_t)(row - T) * D;
        const int b = row < T ? (row >> 13) : 4;
        f32x4 v[4]; row_load(src, F.lane, v);
        const float rstd = rsqrtf(row_sumsq(v) * (1.f / D) + EPS);
        const float* m = mod + (size_t)b * 6144;
        row_modulate(v, rstd, F.in[I_NMG], m, m + 1024, F.lane);
        row_store_bf16(HB + (size_t)row * D, v, F.lane);
    }
}

struct RowLin { const bf16* base; size_t pitch; __device__ __forceinline__ const bf16* operator()(int m) const { return base + (size_t)m * pitch; } };

__device__ __forceinline__ void inproj_block(Frame& F, int mb, int nbk, const f32x16& c, int lane) {
    const int h = lane >> 5, cl = lane & 31;
    bf16* dst; int pitch, cbase; bool rope = false; bool isctx = (mb >= T);
    if (nbk < 512) { dst = (bf16*)(F.ws + WS_UF); pitch = 512; cbase = 0; }
    else if (nbk < 1024) { dst = (bf16*)(F.ws + WS_Q); pitch = 512; cbase = 512; rope = true; }
    else if (nbk < 1152) { dst = isctx ? (bf16*)(F.ws + WS_CK) : (bf16*)(F.ws + WS_K); pitch = 128; cbase = 1024; rope = !isctx; }
    else { dst = isctx ? (bf16*)(F.ws + WS_CV) : (bf16*)(F.ws + WS_V); pitch = 128; cbase = 1152; }
    const int rbase = isctx ? mb - T : mb;
    const int col = nbk - cbase + cl;
    const float inv = exp2f(-(float)(cl & 15) * (13.287712379549449f / 16.f));
    const bool second = (cl & 16) != 0; const bool bycol = ((nbk >> 5) & 1) != 0;
#pragma unroll
    for (int i = 0; i < 16; ++i) {
        const int rr = crow(i, h); float v = c[i];
        if (rope) {
            const float partner = __shfl_xor(v, 16);
            const int l = (mb + rr) & (L - 1);
            const float pos = (float)(bycol ? (l & 63) : (l >> 6));
            const float ang = pos * inv, cs = __cosf(ang), sn = __sinf(ang);
            v = second ? (partner * sn + v * cs) : (v * cs - partner * sn);
        }
        dst[(size_t)(rbase + rr) * pitch + col] = (bf16)f2bf(v);
    }
}
__device__ __forceinline__ void phase_inproj(Frame& F) {
    const bf16* HB = (const bf16*)(F.ws + WS_HB); const bf16* Wt = (const bf16*)(F.ws + WS_WIN);
    constexpr int MT = (T + TC) / 128, NT = N_IN / 128;
    RowLin rp{HB, (size_t)D};
    for (int u = F.wg; u < MT * NT; u += F.G) {
        const int mt = u / NT, nt = u % NT;
        if (mt >= T / 128 && nt < 8) continue;
        auto epi = [&](int mb, int nb, const f32x16& c0, const f32x16& c1, int lane) { inproj_block(F, mb, nb, c0, lane); inproj_block(F, mb, nb + 32, c1, lane); };
        sgemm_tile(rp, Wt, D, mt * 128, nt * 128, epi, F.wave, F.lane);
    }
}

__device__ __forceinline__ void attn_key(const bf16* kp, const bf16* vp, const float (&q)[64], float& m, float& s, float (&o)[64]) {
    float dot = 0.f;
#pragma unroll
    for (int j = 0; j < 8; ++j) { const u32x4 w = *(const u32x4*)(kp + 8 * j);
        dot += q[8 * j + 0] * bflo(w.x) + q[8 * j + 1] * bfhi(w.x) + q[8 * j + 2] * bflo(w.y) + q[8 * j + 3] * bfhi(w.y)
             + q[8 * j + 4] * bflo(w.z) + q[8 * j + 5] * bfhi(w.z) + q[8 * j + 6] * bflo(w.w) + q[8 * j + 7] * bfhi(w.w); }
    const float mn = fmaxf(m, dot), alpha = __expf(m - mn), p = __expf(dot - mn);
    s = s * alpha + p; m = mn;
#pragma unroll
    for (int j = 0; j < 8; ++j) { const u32x4 w = *(const u32x4*)(vp + 8 * j);
        o[8 * j + 0] = o[8 * j + 0] * alpha + p * bflo(w.x); o[8 * j + 1] = o[8 * j + 1] * alpha + p * bfhi(w.x);
        o[8 * j + 2] = o[8 * j + 2] * alpha + p * bflo(w.y); o[8 * j + 3] = o[8 * j + 3] * alpha + p * bfhi(w.y);
        o[8 * j + 4] = o[8 * j + 4] * alpha + p * bflo(w.z); o[8 * j + 5] = o[8 * j + 5] * alpha + p * bfhi(w.z);
        o[8 * j + 6] = o[8 * j + 6] * alpha + p * bflo(w.w); o[8 * j + 7] = o[8 * j + 7] * alpha + p * bfhi(w.w); }
}
__device__ __forceinline__ void phase_attn_simple(Frame& F) {
    const bf16* Q = (const bf16*)(F.ws + WS_Q); const bf16* Kb = (const bf16*)(F.ws + WS_K); const bf16* Vb = (const bf16*)(F.ws + WS_V);
    const bf16* CK = (const bf16*)(F.ws + WS_CK); const bf16* CV = (const bf16*)(F.ws + WS_CV); bf16* MIX = (bf16*)(F.ws + WS_MIX);
    for (int idx = F.wg * NTHR + F.tid; idx < T * 8; idx += F.G * NTHR) {
        const int hd = idx / T, t = idx % T, b = t >> 13, l = t & (L - 1), kvh = hd >> 2;
        float q[64], o[64];
#pragma unroll
        for (int j = 0; j < 8; ++j) { const u32x4 w = *(const u32x4*)(Q + (size_t)t * 512 + hd * 64 + 8 * j);
            q[8 * j + 0] = bflo(w.x) * 0.125f; q[8 * j + 1] = bfhi(w.x) * 0.125f; q[8 * j + 2] = bflo(w.y) * 0.125f; q[8 * j + 3] = bfhi(w.y) * 0.125f;
            q[8 * j + 4] = bflo(w.z) * 0.125f; q[8 * j + 5] = bfhi(w.z) * 0.125f; q[8 * j + 6] = bflo(w.w) * 0.125f; q[8 * j + 7] = bfhi(w.w) * 0.125f; }
#pragma unroll
        for (int j = 0; j < 64; ++j) o[j] = 0.f;
        float m = F.in[I_SINK][hd], s = 1.f;
        for (int c = 0; c < CL; ++c) { const size_t r = (size_t)(b * CL + c) * 128 + kvh * 64; attn_key(CK + r, CV + r, q, m, s, o); }
        const int lo = l - 128 < 0 ? 0 : l - 128, hi = l + 128 > L - 1 ? L - 1 : l + 128;
        for (int kp = lo; kp <= hi; ++kp) { const size_t r = (size_t)(b * L + kp) * 128 + kvh * 64; attn_key(Kb + r, Vb + r, q, m, s, o); }
        const float is = 1.f / s;
#pragma unroll
        for (int j = 0; j < 8; ++j) { u32x4 w; w.x = pk2(o[8 * j] * is, o[8 * j + 1] * is); w.y = pk2(o[8 * j + 2] * is, o[8 * j + 3] * is); w.z = pk2(o[8 * j + 4] * is, o[8 * j + 5] * is); w.w = pk2(o[8 * j + 6] * is, o[8 * j + 7] * is);
            *(u32x4*)(MIX + (size_t)t * 1024 + 512 + hd * 64 + 8 * j) = w; }
    }
}

__device__ __forceinline__ void phase_fft1_simple(Frame& F) {
    const bf16* UF = (const bf16*)(F.ws + WS_UF); bf16* Gb = (bf16*)(F.ws + WS_G); const float* tw = (const float*)(F.ws + WS_TW);
    for (int idx = F.wg * NTHR + F.tid; idx < NB * FN1 * FN2 * 512; idx += F.G * NTHR) {
        const int ch = idx & 511, bp = (idx >> 9) & 127, c = (idx >> 16) & 63, b = idx >> 22;
        float re = 0.f, im = 0.f;
        for (int a = 0; a < FN1; ++a) { const float u = bf2f(UF[(size_t)(b * L + 128 * a + bp) * 512 + ch]); const int k = ((a * c) & 63) * 128;
            re += u * tw[2 * k]; im -= u * tw[2 * k + 1]; }
        const int k2 = bp * c; const float cs = tw[2 * k2], sn = tw[2 * k2 + 1];
        const float gr = re * cs + im * sn, gi = im * cs - re * sn;
        const size_t row = (size_t)(b * FN1 + c) * FN2 + bp;
        Gb[row * 1024 + ch] = (bf16)f2bf(gr); Gb[row * 1024 + 512 + ch] = (bf16)f2bf(gi);
    }
}
__device__ __forceinline__ void phase_fft2_simple(Frame& F) {
    const bf16* Gb = (const bf16*)(F.ws + WS_G); bf16* AB = (bf16*)(F.ws + WS_AB); const float* tw = (const float*)(F.ws + WS_TW);
    for (int idx = F.wg * NTHR + F.tid; idx < NB * FN1 * FN2 * 512; idx += F.G * NTHR) {
        const int ch = idx & 511, d = (idx >> 9) & 127, c = (idx >> 16) & 63, b = idx >> 22;
        float fr = 0.f, fi = 0.f;
        for (int bp = 0; bp < FN2; ++bp) { const size_t row = (size_t)(b * FN1 + c) * FN2 + bp; const float gr = bf2f(Gb[row * 1024 + ch]), gi = bf2f(Gb[row * 1024 + 512 + ch]);
            const int k = ((bp * d) & 127) * 64; const float cs = tw[2 * k], sn = tw[2 * k + 1];
            fr += gr * cs + gi * sn; fi += gi * cs - gr * sn; }
        const size_t t = (size_t)b * L + c + 64 * d;
        AB[t * 1024 + ch] = (bf16)f2bf(fr); AB[t * 1024 + 512 + ch] = (bf16)f2bf(-fi);
    }
}
__device__ __forceinline__ void phase_fft3_simple(Frame& F) {
    const bf16* AB = (const bf16*)(F.ws + WS_AB); bf16* MIX = (bf16*)(F.ws + WS_MIX); const float* tw = (const float*)(F.ws + WS_TW);
    LAS float* t128 = (LAS float*)F.lds;
    for (int i = F.tid; i < 128; i += NTHR) { t128[2 * i] = tw[2 * (i * 64)]; t128[2 * i + 1] = tw[2 * (i * 64) + 1]; }
    __syncthreads();
    for (int idx = F.wg * NTHR + F.tid; idx < T * 512; idx += F.G * NTHR) {
        const int cp = idx & 127, g = (idx >> 7) & 3, t = idx >> 9;
        const bf16* arow = AB + (size_t)t * 1024 + g * 128;
        float y = 0.f;
        for (int cc = 0; cc < 128; ++cc) { const int k = (cc * cp) & 127; y += bf2f(arow[cc]) * t128[2 * k] - bf2f(arow[512 + cc]) * t128[2 * k + 1]; }
        MIX[(size_t)t * 1024 + g * 128 + cp] = (bf16)f2bf(y * (1.f / 1024.f));
    }
    __syncthreads();
}

__device__ __forceinline__ void phase_outproj(Frame& F, const bf16* A, const bf16* Wt, const float* base, float* X, const float* gate  , const float* bias) {
    RowLin rp{A, (size_t)D};
    for (int u = F.wg; u < (T / 128) * 8; u += F.G) {
        const int mt = u / 8, nt = u % 8;
        auto epi = [&](int mb, int nb, const f32x16& c0, const f32x16& c1, int lane) {
            const int h = lane >> 5, cl = lane & 31, b = mb >> 13;
#pragma unroll
            for (int half = 0; half < 2; ++half) { const int col = nb + 32 * half + cl; const float gv = gate[(size_t)b * 6144 + col], bv = bias ? bias[col] : 0.f;
#pragma unroll
                for (int i = 0; i < 16; ++i) { const size_t o = (size_t)(mb + crow(i, h)) * D + col; const float a = half ? c1[i] : c0[i]; X[o] = base[o] + gv * (a + bv); } }
        };
        sgemm_tile(rp, Wt, D, mt * 128, nt * 128, epi, F.wave, F.lane);
    }
}

__device__ __forceinline__ void route_select(const float (&lg)[16], const float* rb, int& be1, int& be2, float& w1, float& w2) {
    float best = -1e30f; float bs1 = 0.f, bs2 = 0.f; be1 = 0; be2 = 0;
#pragma unroll
    for (int g = 0; g < 4; ++g) {
        float v1 = -1e30f, v2 = -1e30f, s1 = 0.f, s2 = 0.f; int j1 = 0, j2 = 0;
#pragma unroll
        for (int q = 0; q < 4; ++q) { const float sc = sigmoid_f(lg[4 * g + q]), x = sc + rb[4 * g + q];
            if (x > v1) { v2 = v1; j2 = j1; s2 = s1; v1 = x; j1 = q; s1 = sc; } else if (x > v2) { v2 = x; j2 = q; s2 = sc; } }
        const float gs = v1 + v2;
        if (gs > best) { best = gs; be1 = 4 * g + j1; be2 = 4 * g + j2; bs1 = s1; bs2 = s2; }
    }
    const float inv = 1.f / (bs1 + bs2); w1 = bs1 * inv; w2 = bs2 * inv;
}
__device__ __forceinline__ void phase_norm2_route(Frame& F, int layer) {
    const float* mod = (const float*)(F.ws + WS_MOD) + (size_t)layer * 5 * 6144;
    const float* X = F.out; const bf16* XB = (const bf16*)(F.ws + WS_XB); bf16* HB = (bf16*)(F.ws + WS_HB);
    const float* rw = F.in[I_RW]; const float* rb = F.in[I_RB];
    int* tok_e = (int*)(F.ws + WS_TOKE); int* tok_p = (int*)(F.ws + WS_TOKP); float* tok_w = (float*)(F.ws + WS_TOKW);
    int* slot_t = (int*)(F.ws + WS_SLOTT) + layer * 16 * CAP;
    float* slot_w = (float*)(F.ws + WS_SLOTW) + layer * 16 * CAP;
    unsigned* cnt = F.ctl + CW_CNT + layer * 16 * 64;
    LAS float* rwt = (LAS float*)F.lds;
    LAS int* sel_e = (LAS int*)(F.lds + 65536);
    LAS float* sel_w = (LAS float*)(F.lds + 65536 + 1024);
    LAS int* wcnt = (LAS int*)(F.lds + 65536 + 2048);
    LAS int* ebase = wcnt + 64;
    __syncthreads();
    for (int t = F.tid; t < 4096; t += NTHR) { const int i = t >> 2, e4 = t & 3; const f32x4 w = *(const f32x4*)(rw + (size_t)i * 16 + 4 * e4);
        const int p = (i & 512) + 256 * ((i >> 2) & 1) + 4 * ((i >> 3) & 63) + (i & 3);
        rwt[(4 * e4 + 0) * 1024 + p] = w.x; rwt[(4 * e4 + 1) * 1024 + p] = w.y; rwt[(4 * e4 + 2) * 1024 + p] = w.z; rwt[(4 * e4 + 3) * 1024 + p] = w.w; }
    __syncthreads();
    for (int rb0 = F.wg; rb0 < T / 128; rb0 += F.G) {
        const int b = (rb0 * 128) >> 13;
        f32x4 gm[4], sh[4];
        { const float* m = mod + (size_t)b * 6144; const float* g = F.in[I_NFG] + layer * D;
#pragma unroll
          for (int jj = 0; jj < 4; ++jj) { const int o = ROFF(F.lane, jj); gm[jj] = *(const f32x4*)(g + o) * (1.f + *(const f32x4*)(m + 4096 + o)); sh[jj] = *(const f32x4*)(m + 3072 + o); } }
        const int rbase = rb0 * 128 + F.wave * 16;
        f32x4 v0[4], v1[4]; xrow_load(X, XB, (size_t)rbase, F.lane, v0); xrow_load(X, XB, (size_t)(rbase + 1), F.lane, v1);
#pragma unroll 1
        for (int j = 0; j < 16; j += 2) {
            const int lr = F.wave * 16 + j, row = rbase + j;
            f32x4 n0[4], n1[4];
            { const int nr = (j + 2 < 16) ? row + 2 : row; xrow_load(X, XB, (size_t)nr, F.lane, n0); xrow_load(X, XB, (size_t)(nr + 1), F.lane, n1); }
            const float rstd0 = rsqrtf(row_sumsq(v0) * (1.f / D) + EPS), rstd1 = rsqrtf(row_sumsq(v1) * (1.f / D) + EPS);
#pragma unroll
            for (int jj = 0; jj < 4; ++jj) { v0[jj] = v0[jj] * rstd0 * gm[jj] + sh[jj]; v1[jj] = v1[jj] * rstd1 * gm[jj] + sh[jj]; }
            row_store_bf16(HB + (size_t)row * D, v0, F.lane); row_store_bf16(HB + (size_t)(row + 1) * D, v1, F.lane);
            float lg0[16], lg1[16];
#pragma unroll
            for (int e = 0; e < 16; ++e) { float a0 = 0.f, a1 = 0.f;
#pragma unroll
                for (int jj = 0; jj < 4; ++jj) { const f32x4 w4 = *(const LAS f32x4*)(rwt + e * 1024 + 256 * jj + 4 * F.lane);
                    a0 += (v0[jj].x * w4.x + v0[jj].y * w4.y) + (v0[jj].z * w4.z + v0[jj].w * w4.w); a1 += (v1[jj].x * w4.x + v1[jj].y * w4.y) + (v1[jj].z * w4.z + v1[jj].w * w4.w); }
                lg0[e] = a0; lg1[e] = a1; }
#pragma unroll
            for (int e = 0; e < 16; ++e) { lg0[e] = wave_sum(lg0[e]); lg1[e] = wave_sum(lg1[e]); }
            int e1, e2; float w1, w2;
            route_select(lg0, rb, e1, e2, w1, w2);
            if (F.lane == 0) { sel_e[2 * lr] = e1; sel_e[2 * lr + 1] = e2; sel_w[2 * lr] = w1; sel_w[2 * lr + 1] = w2; }
            route_select(lg1, rb, e1, e2, w1, w2);
            if (F.lane == 0) { sel_e[2 * lr + 2] = e1; sel_e[2 * lr + 3] = e2; sel_w[2 * lr + 2] = w1; sel_w[2 * lr + 3] = w2; }
#pragma unroll
            for (int jj = 0; jj < 4; ++jj) { v0[jj] = n0[jj]; v1[jj] = n1[jj]; }
        }
        __syncthreads();
        int my_e = 0, my_rank = 0; float my_w = 0.f;
        if (F.tid < 256) { my_e = sel_e[F.tid]; my_w = sel_w[F.tid];
            const unsigned long long below = (1ull << F.lane) - 1ull;
#pragma unroll 1
            for (int ee = 0; ee < 16; ++ee) { const unsigned long long mk = __ballot(my_e == ee);
                if (my_e == ee) my_rank = __popcll(mk & below);
                if (F.lane == 0) wcnt[F.wave * 16 + ee] = __popcll(mk); } }
        __syncthreads();
        if (F.tid < 16) { const int n = wcnt[F.tid] + wcnt[16 + F.tid] + wcnt[32 + F.tid] + wcnt[48 + F.tid];
            ebase[F.tid] = n ? (int)atomicAdd(cnt + F.tid * 64, (unsigned)n) : 0; }
        __syncthreads();
        if (F.tid < 256) { int pos = ebase[my_e] + my_rank;
            for (int w = 0; w < F.wave; ++w) pos += wcnt[w * 16 + my_e];
            const int tok = rb0 * 128 + (F.tid >> 1), k = F.tid & 1;
            slot_t[my_e * CAP + pos] = tok; slot_w[my_e * CAP + pos] = my_w; tok_e[2 * tok + k] = my_e; tok_p[2 * tok + k] = pos; tok_w[2 * tok + k] = my_w; }
        __syncthreads();
    }
}


__device__ __forceinline__ void phase_norm2_route_mfma(Frame& F, int layer) {
    constexpr int AP = 1032;
    const float* mod = (const float*)(F.ws + WS_MOD) + (size_t)layer * 5 * 6144;
    const bf16* XB = (const bf16*)(F.ws + WS_XB); bf16* HB = (bf16*)(F.ws + WS_HB);
    const float* rw = F.in[I_RW]; const float* rb = F.in[I_RB]; const float* gsrc = F.in[I_NFG] + layer * D;
    int* tok_e = (int*)(F.ws + WS_TOKE); int* tok_p = (int*)(F.ws + WS_TOKP); float* tok_w = (float*)(F.ws + WS_TOKW);
    int* slot_t = (int*)(F.ws + WS_SLOTT) + layer * 16 * CAP;
    float* slot_w = (float*)(F.ws + WS_SLOTW) + layer * 16 * CAP;
    unsigned* cnt = F.ctl + CW_CNT + layer * 16 * 64;
    LAS bf16* AH = (LAS bf16*)F.lds; LAS bf16* AL = AH + 16 * AP;
    LAS float* cbv = (LAS float*)(F.lds + 2 * 16 * AP * 2);
    LAS float* rstdv = cbv + 16;
    LAS float* lgt = rstdv + 128;
    LAS int* sel_e = (LAS int*)(lgt + 128 * 16);
    LAS float* sel_w = (LAS float*)(sel_e + 256);
    LAS int* wcnt = (LAS int*)(sel_w + 256);
    LAS int* ebase = wcnt + 64;
    LAS float* cpart = (LAS float*)(ebase + 16);
    for (int rb0 = F.wg; rb0 < T / 128; rb0 += F.G) {
        const int b = (rb0 * 128) >> 13; const float* m = mod + (size_t)b * 6144;
        __syncthreads();
        { float cp[16];
#pragma unroll
          for (int e = 0; e < 16; ++e) cp[e] = 0.f;
          for (int k = F.tid; k < D; k += NTHR) { const float gmk = gsrc[k] * (1.f + m[4096 + k]), shk = m[3072 + k];
#pragma unroll
              for (int e4 = 0; e4 < 4; ++e4) { const f32x4 w4 = *(const f32x4*)(rw + (size_t)k * 16 + 4 * e4);
#pragma unroll
                  for (int q = 0; q < 4; ++q) { const int e = 4 * e4 + q; const float pr = gmk * w4[q]; const unsigned hi = f2bf(pr); const unsigned lo = f2bf(pr - bf2f(hi));
                      AH[e * AP + k] = (bf16)hi; AL[e * AP + k] = (bf16)lo; cp[e] += shk * w4[q]; } } }
#pragma unroll
          for (int e = 0; e < 16; ++e) { const float t = wave_sum(cp[e]); if (F.lane == 0) cpart[F.wave * 16 + e] = t; } }
        __syncthreads();
        if (F.tid < 16) { float t = 0.f;
#pragma unroll
            for (int w = 0; w < 8; ++w) t += cpart[w * 16 + F.tid];
            cbv[F.tid] = t; }
        f32x4 gm[4], sh[4];
#pragma unroll
        for (int jj = 0; jj < 4; ++jj) { const int o = ROFF(F.lane, jj); gm[jj] = *(const f32x4*)(gsrc + o) * (1.f + *(const f32x4*)(m + 4096 + o)); sh[jj] = *(const f32x4*)(m + 3072 + o); }
        const int rbase = rb0 * 128 + F.wave * 16;
        {
            u32x4 raw[16][2];
#pragma unroll
            for (int j = 0; j < 16; ++j)
#pragma unroll
                for (int hh = 0; hh < 2; ++hh) raw[j][hh] = *(const u32x4*)(XB + (size_t)(rbase + j) * D + 512 * hh + 8 * F.lane);
            float W[8], X[4], Y[2];
#pragma unroll
            for (int i = 0; i < 8; ++i) { float sa = 0.f, sb = 0.f;
#pragma unroll
                for (int hh = 0; hh < 2; ++hh) { const u32x4 a = raw[2 * i][hh], c = raw[2 * i + 1][hh];
                    sa = dot2_bf16(a.x, a.x, sa); sa = dot2_bf16(a.y, a.y, sa); sa = dot2_bf16(a.z, a.z, sa); sa = dot2_bf16(a.w, a.w, sa);
                    sb = dot2_bf16(c.x, c.x, sb); sb = dot2_bf16(c.y, c.y, sb); sb = dot2_bf16(c.z, c.z, sb); sb = dot2_bf16(c.w, c.w, sb); }
                W[i] = swap32_add(sa, sb); }
#pragma unroll
            for (int i = 0; i < 4; ++i) X[i] = swap16_add(W[2 * i], W[2 * i + 1]);
            const bool b3 = (F.lane & 8) != 0, b2 = (F.lane & 4) != 0;
#pragma unroll
            for (int i = 0; i < 2; ++i) Y[i] = sel_add<0x140>(X[2 * i], X[2 * i + 1], b3);
            float Z = sel_add<0x141>(Y[0], Y[1], b2);
            Z += dppf<0x4E>(Z); Z += dppf<0xB1>(Z);
            const int rr = ((F.lane >> 5) & 1) + ((F.lane >> 4) & 1) * 2 + ((F.lane >> 3) & 1) * 4 + ((F.lane >> 2) & 1) * 8;
            if (!(F.lane & 3)) rstdv[F.wave * 16 + rr] = rsqrtf(Z * (1.f / D) + EPS);
            __builtin_amdgcn_wave_barrier();
            float rs[16];
#pragma unroll
            for (int i = 0; i < 4; ++i) { const f32x4 t = *(const LAS f32x4*)(rstdv + F.wave * 16 + 4 * i); rs[4 * i] = t.x; rs[4 * i + 1] = t.y; rs[4 * i + 2] = t.z; rs[4 * i + 3] = t.w; }
#pragma unroll
            for (int j = 0; j < 16; ++j) { f32x4 v[4];
#pragma unroll
                for (int hh = 0; hh < 2; ++hh) { const u32x4 w = raw[j][hh]; v[2 * hh] = (f32x4){bflo(w.x), bfhi(w.x), bflo(w.y), bfhi(w.y)}; v[2 * hh + 1] = (f32x4){bflo(w.z), bfhi(w.z), bflo(w.w), bfhi(w.w)}; }
#pragma unroll
                for (int jj = 0; jj < 4; ++jj) v[jj] = v[jj] * rs[j] * gm[jj] + sh[jj];
                row_store_bf16(HB + (size_t)(rbase + j) * D, v, F.lane); }
        }
        __syncthreads();
        { const int fr = F.lane & 15, fq = F.lane >> 4;
          f32x4 acc = {0.f, 0.f, 0.f, 0.f};
          const bf16* xr = XB + (size_t)(rb0 * 128 + 16 * F.wave + fr) * D + 8 * fq;
          const LAS bf16* ah = AH + fr * AP + 8 * fq; const LAS bf16* al = AL + fr * AP + 8 * fq;
#pragma unroll
          for (int s2 = 0; s2 < 32; ++s2) { const bf16x8 xb = *(const bf16x8*)(xr + 32 * s2);
              acc = __builtin_amdgcn_mfma_f32_16x16x32_bf16(*(const LAS bf16x8*)(ah + 32 * s2), xb, acc, 0, 0, 0);
              acc = __builtin_amdgcn_mfma_f32_16x16x32_bf16(*(const LAS bf16x8*)(al + 32 * s2), xb, acc, 0, 0, 0); }
          const int lrow = 16 * F.wave + fr; const float rs = rstdv[lrow];
#pragma unroll
          for (int i = 0; i < 4; ++i) lgt[lrow * 16 + 4 * fq + i] = rs * acc[i] + cbv[4 * fq + i]; }
        __syncthreads();
        if (F.tid < 128) { float lg[16];
#pragma unroll
            for (int e4 = 0; e4 < 4; ++e4) { const f32x4 t = *(const LAS f32x4*)(lgt + F.tid * 16 + 4 * e4); lg[4 * e4] = t.x; lg[4 * e4 + 1] = t.y; lg[4 * e4 + 2] = t.z; lg[4 * e4 + 3] = t.w; }
            int e1, e2; float w1, w2; route_select(lg, rb, e1, e2, w1, w2);
            sel_e[2 * F.tid] = e1; sel_e[2 * F.tid + 1] = e2; sel_w[2 * F.tid] = w1; sel_w[2 * F.tid + 1] = w2; }
        __syncthreads();
        int my_e = 0, my_rank = 0; float my_w = 0.f;
        if (F.tid < 256) { my_e = sel_e[F.tid]; my_w = sel_w[F.tid];
            const unsigned long long below = (1ull << F.lane) - 1ull;
#pragma unroll 1
            for (int ee = 0; ee < 16; ++ee) { const unsigned long long mk = __ballot(my_e == ee);
                if (my_e == ee) my_rank = __popcll(mk & below);
                if (F.lane == 0) wcnt[F.wave * 16 + ee] = __popcll(mk); } }
        __syncthreads();
        if (F.tid < 16) { const int n = wcnt[F.tid] + wcnt[16 + F.tid] + wcnt[32 + F.tid] + wcnt[48 + F.tid];
            ebase[F.tid] = n ? (int)atomicAdd(cnt + F.tid * 64, (unsigned)n) : 0; }
        __syncthreads();
        if (F.tid < 256) { int pos = ebase[my_e] + my_rank;
            for (int w = 0; w < F.wave; ++w) pos += wcnt[w * 16 + my_e];
            const int tok = rb0 * 128 + (F.tid >> 1), k = F.tid & 1;
            slot_t[my_e * CAP + pos] = tok; slot_w[my_e * CAP + pos] = my_w; tok_e[2 * tok + k] = my_e; tok_p[2 * tok + k] = pos; tok_w[2 * tok + k] = my_w; }
    }
    __syncthreads();
}

constexpr int MOEMAP_OFF = LDS_BYTES - 256;
__device__ __forceinline__ LAS int* moe_map(Frame& F, int layer) {
    LAS int* mm = (LAS int*)(F.lds + MOEMAP_OFF);
    __syncthreads();
    if (F.tid < 64) { const unsigned* cnt = F.ctl + CW_CNT + layer * 16 * 64;
        const int n = (F.tid < 16) ? (int)__hip_atomic_load(cnt + F.tid * 64, __ATOMIC_RELAXED, __HIP_MEMORY_SCOPE_AGENT) : 0;
        const int pad = (n + 255) & ~255; int x = pad;
#pragma unroll
        for (int o = 1; o < 16; o <<= 1) { const int t = __shfl_up(x, o); if (F.lane >= o) x += t; }
        if (F.tid < 16) { mm[F.tid] = n; mm[16 + F.tid] = x - pad; } }
    __syncthreads();
    return mm;
}
struct RowGather { const bf16* base; const int* list; int n; __device__ __forceinline__ const bf16* operator()(int m) const { const int tok = m < n ? list[m] : 0; return base + (size_t)tok * D; } };

__device__ __forceinline__ void phase_moe_gateup(Frame& F, int layer) {
    LAS int* mm = moe_map(F, layer);
    const bf16* HB = (const bf16*)(F.ws + WS_HB); bf16* HID = (bf16*)(F.ws + WS_HID);
    const int* slot_t = (const int*)(F.ws + WS_SLOTT) + layer * 16 * CAP; const float* slot_w = (const float*)(F.ws + WS_SLOTW) + layer * 16 * CAP;
    int ubase = 0;
#pragma unroll 1
    for (int e = 0; e < 16; ++e) {
        const int n = mm[e], hbe = mm[16 + e], rt = (n + 127) >> 7, nu = rt * 8;
        const bf16* Wt = (const bf16*)(F.ws + WS_WGU) + (size_t)(layer * 16 + e) * 1024 * 1024;
        RowGather rp{HB, slot_t + e * CAP, n};
        int first = (F.wg - ubase % F.G + F.G) % F.G;
        for (int u = first; u < nu; u += F.G) {
            const int mt = u / 8, nt = u % 8;
            auto epi = [&](int mb, int nb, const f32x16& c0, const f32x16& c1, int lane) {
                const int h = lane >> 5, cl = lane & 31; const int col = (nb >> 1) + cl;
#pragma unroll
                for (int i = 0; i < 16; ++i) { const int r = mb + crow(i, h);
                    if (r < n) { const float w = slot_w[e * CAP + r]; HID[(size_t)(hbe + r) * FF + col] = (bf16)f2bf(w * silu_f(c0[i]) * c1[i]); } }
            };
            sgemm_tile(rp, Wt, D, mt * 128, nt * 128, epi, F.wave, F.lane);
        }
        ubase += nu;
    }
}
__device__ __forceinline__ void phase_moe_down(Frame& F, int layer) {
    LAS int* mm = moe_map(F, layer);
    const bf16* HID = (const bf16*)(F.ws + WS_HID); bf16* Y = (bf16*)(F.ws + WS_Y);
    int ubase = 0;
#pragma unroll 1
    for (int e = 0; e < 16; ++e) {
        const int n = mm[e], hbe = mm[16 + e], rt = (n + 127) >> 7, nu = rt * 8;
        const bf16* Wt = (const bf16*)(F.ws + WS_WDN) + (size_t)(layer * 16 + e) * 1024 * 512;
        RowLin rp{HID + (size_t)hbe * FF, (size_t)FF};
        int first = (F.wg - ubase % F.G + F.G) % F.G;
        for (int u = first; u < nu; u += F.G) {
            const int mt = u / 8, nt = u % 8;
            auto epi = [&](int mb, int nb, const f32x16& c0, const f32x16& c1, int lane) {
                const int h = lane >> 5, cl = lane & 31;
#pragma unroll
                for (int i = 0; i < 16; ++i) { const int r = mb + crow(i, h);
                    if (r < n) { bf16* yr = Y + (size_t)(hbe + r) * D + nb + cl; yr[0] = (bf16)f2bf(c0[i]); yr[32] = (bf16)f2bf(c1[i]); } }
            };
            sgemm_tile(rp, Wt, FF, mt * 128, nt * 128, epi, F.wave, F.lane);
        }
        ubase += nu;
    }
}

template <bool FINAL>
__device__ __forceinline__ void phase_combine(Frame& F, int layer) {
    LAS int* hbs = moe_map(F, layer) + 16;
    const int gw = F.wg * NWAVES + F.wave, NGW = F.G * NWAVES;
    const float* mod = (const float*)(F.ws + WS_MOD);
    const int* tok_e = (const int*)(F.ws + WS_TOKE); const int* tok_p = (const int*)(F.ws + WS_TOKP);
    const unsigned char* Y8 = (const unsigned char*)(F.ws + WS_Y);
    float* X = F.out; bf16* XB = (bf16*)(F.ws + WS_XB); bf16* HB = (bf16*)(F.ws + WS_HB);
    for (int blk = gw; blk < T / 16; blk += NGW) {
        const int rbase = blk * 16, b = rbase >> 13;
        f32x4 g2v[4], gm[4], shv[4];
        { const float* g2 = mod + ((size_t)layer * 5 + b) * 6144 + 5120;
#pragma unroll
          for (int j = 0; j < 4; ++j) { const int o = ROFF(F.lane, j); g2v[j] = *(const f32x4*)(g2 + o) * (1.f / YSCALE);
              if (FINAL) { gm[j] = *(const f32x4*)(F.in[I_FNG] + o); shv[j] = (f32x4){0.f, 0.f, 0.f, 0.f}; }
              else { const float* m = mod + ((size_t)(layer + 1) * 5 + b) * 6144; gm[j] = *(const f32x4*)(F.in[I_NMG] + (layer + 1) * D + o) * (1.f + *(const f32x4*)(m + 1024 + o)); shv[j] = *(const f32x4*)(m + o); } } }
        int4 te = *(const int4*)(tok_e + 2 * rbase), tp = *(const int4*)(tok_p + 2 * rbase);
        u32x4 xa[2][2], xn[2][2]; u32x2 ya[2][2][2], yn[2][2][2];
        { const int s00 = hbs[te.x] + tp.x, s01 = hbs[te.y] + tp.y, s10 = hbs[te.z] + tp.z, s11 = hbs[te.w] + tp.w;
#pragma unroll
          for (int jj = 0; jj < 2; ++jj) { const int o = 512 * jj + 8 * F.lane;
              xa[0][jj] = *(const u32x4*)(XB + (size_t)rbase * D + o); xa[1][jj] = *(const u32x4*)(XB + (size_t)(rbase + 1) * D + o);
              ya[0][0][jj] = *(const u32x2*)(Y8 + (size_t)s00 * D + o); ya[0][1][jj] = *(const u32x2*)(Y8 + (size_t)s01 * D + o);
              ya[1][0][jj] = *(const u32x2*)(Y8 + (size_t)s10 * D + o); ya[1][1][jj] = *(const u32x2*)(Y8 + (size_t)s11 * D + o); } }
        te = *(const int4*)(tok_e + 2 * (rbase + 2)); tp = *(const int4*)(tok_p + 2 * (rbase + 2));
#pragma unroll 1
        for (int jr = 0; jr < 16; jr += 2) {
            const int row = rbase + jr;
            if (jr + 2 < 16) { const int nr = row + 2;
                const int s00 = hbs[te.x] + tp.x, s01 = hbs[te.y] + tp.y, s10 = hbs[te.z] + tp.z, s11 = hbs[te.w] + tp.w;
#pragma unroll
                for (int jj = 0; jj < 2; ++jj) { const int o = 512 * jj + 8 * F.lane;
                    xn[0][jj] = *(const u32x4*)(XB + (size_t)nr * D + o); xn[1][jj] = *(const u32x4*)(XB + (size_t)(nr + 1) * D + o);
                    yn[0][0][jj] = *(const u32x2*)(Y8 + (size_t)s00 * D + o); yn[0][1][jj] = *(const u32x2*)(Y8 + (size_t)s01 * D + o);
                    yn[1][0][jj] = *(const u32x2*)(Y8 + (size_t)s10 * D + o); yn[1][1][jj] = *(const u32x2*)(Y8 + (size_t)s11 * D + o); }
                const int n2 = (jr + 4 < 16) ? row + 4 : row; te = *(const int4*)(tok_e + 2 * n2); tp = *(const int4*)(tok_p + 2 * n2); }
            f32x4 v[2][4];
#pragma unroll
            for (int q = 0; q < 2; ++q)
#pragma unroll
                for (int jj = 0; jj < 2; ++jj) { const u32x4 xw = xa[q][jj]; const u32x2 a0 = ya[q][0][jj], a1 = ya[q][1][jj];
                    v[q][2 * jj] = (f32x4){bflo(xw.x), bfhi(xw.x), bflo(xw.y), bfhi(xw.y)} + g2v[2 * jj] * (un_fp8x4(a0.x) + un_fp8x4(a1.x));
                    v[q][2 * jj + 1] = (f32x4){bflo(xw.z), bfhi(xw.z), bflo(xw.w), bfhi(xw.w)} + g2v[2 * jj + 1] * (un_fp8x4(a0.y) + un_fp8x4(a1.y)); }
            const float rstd0 = rsqrtf(row_sumsq(v[0]) * (1.f / D) + EPS), rstd1 = rsqrtf(row_sumsq(v[1]) * (1.f / D) + EPS);
#pragma unroll
            for (int q = 0; q < 2; ++q) { const float rstd = q ? rstd1 : rstd0; const size_t ro = (size_t)(row + q) * D;
                if (FINAL) {
#pragma unroll
                    for (int j = 0; j < 4; ++j) *(f32x4*)(X + ro + ROFF(F.lane, j)) = v[q][j] * rstd * gm[j];
                } else {
                    row_store_bf16(XB + ro, v[q], F.lane);
#pragma unroll
                    for (int j = 0; j < 4; ++j) v[q][j] = v[q][j] * rstd * gm[j] + shv[j];
                    row_store_bf16(HB + ro, v[q], F.lane);
                }
            }
#pragma unroll
            for (int q = 0; q < 2; ++q)
#pragma unroll
                for (int jj = 0; jj < 2; ++jj) { xa[q][jj] = xn[q][jj]; ya[q][0][jj] = yn[q][0][jj]; ya[q][1][jj] = yn[q][1][jj]; }
        }
    }
    __syncthreads();
}

__device__ __forceinline__ void phase_pw1(Frame& F) {
    const bf16* HB = (const bf16*)(F.ws + WS_HB); const bf16* Wt = (const bf16*)(F.ws + WS_WPW1); bf16* U = (bf16*)(F.ws + WS_U);
    const float* bias = F.in[I_PW1B];
    RowLin rp{HB, (size_t)D};
    for (int u = F.wg; u < (T / 128) * 16; u += F.G) {
        const int mt = u / 16, nt = u % 16;
        auto epi = [&](int mb, int nb, const f32x16& c0, const f32x16& c1, int lane) {
            const int h = lane >> 5, cl = lane & 31, col = (nb >> 1) + cl; const float ba = bias[col], bg = bias[1024 + col];
#pragma unroll
            for (int i = 0; i < 16; ++i) U[(size_t)(mb + crow(i, h)) * D + col] = (bf16)f2bf((c0[i] + ba) * sigmoid_f(c1[i] + bg));
        };
        sgemm_tile(rp, Wt, D, mt * 128, nt * 128, epi, F.wave, F.lane);
    }
}
__device__ __forceinline__ void phase_dwconv(Frame& F) {
    const bf16* U = (const bf16*)(F.ws + WS_U); bf16* V1 = (bf16*)(F.ws + WS_V1);
    const float* dww = F.in[I_DWW]; const float* dwb = F.in[I_DWB]; const float* lng = F.in[I_LNG]; const float* lnb = F.in[I_LNB];
    const int gw = F.wg * NWAVES + F.wave, NGW = F.G * NWAVES;
    for (int row = gw; row < T; row += NGW) {
        const int l = row & (L - 1);
        f32x4 acc[4];
#pragma unroll
        for (int j = 0; j < 4; ++j) acc[j] = *(const f32x4*)(dwb + 4 * F.lane + 256 * j);
        for (int tp = 0; tp < CONVW; ++tp) { const int ll = l + tp - 15; if (ll < 0 || ll >= L) continue;
            const bf16* ur = U + (size_t)(row + tp - 15) * D; const float* wr = dww + (size_t)tp * D;
#pragma unroll
            for (int j = 0; j < 4; ++j) { const int o = 4 * F.lane + 256 * j; const u32x2 uu = *(const u32x2*)(ur + o); const f32x4 ww = *(const f32x4*)(wr + o);
                acc[j].x += bflo(uu.x) * ww.x; acc[j].y += bfhi(uu.x) * ww.y; acc[j].z += bflo(uu.y) * ww.z; acc[j].w += bfhi(uu.y) * ww.w; } }
        float s = 0.f;
#pragma unroll
        for (int j = 0; j < 4; ++j) s += (acc[j].x + acc[j].y) + (acc[j].z + acc[j].w);
        const float mean = wave_sum(s) * (1.f / D); float q = 0.f;
#pragma unroll
        for (int j = 0; j < 4; ++j) { acc[j] = acc[j] - mean; q += (acc[j].x * acc[j].x + acc[j].y * acc[j].y) + (acc[j].z * acc[j].z + acc[j].w * acc[j].w); }
        const float rstd = rsqrtf(wave_sum(q) * (1.f / D) + EPS);
#pragma unroll
        for (int j = 0; j < 4; ++j) { const int o = 4 * F.lane + 256 * j; const f32x4 gg = *(const f32x4*)(lng + o), bb = *(const f32x4*)(lnb + o);
            f32x4 y = acc[j] * rstd * gg + bb; y.x = silu_f(y.x); y.y = silu_f(y.y); y.z = silu_f(y.z); y.w = silu_f(y.w); acc[j] = y; }
        row_store_bf16(V1 + (size_t)row * D, acc, F.lane);
    }
}


namespace pg {
constexpr int BM = 256, BK = 64, HALF = 128, HTB = HALF * BK * 2, STAGE_BYTES = 8 * HTB;
constexpr int TAB_OFF = STAGE_BYTES;
__device__ __forceinline__ int lds_byte(int r, int c) { const int st = (r >> 4) * 2 + (c >> 5), rr = r & 15, cc = c & 31, ob = rr * 64 + cc * 2; return st * 1024 + (ob ^ (((ob >> 9) & 1) << 5)); }
__device__ __forceinline__ void stage_rc(int b, int& R, int& C) { const int st = b / 1024, sb = b % 1024, swz = sb ^ (((sb >> 9) & 1) << 5); R = (st >> 1) * 16 + swz / 64; C = (st & 1) * 32 + (swz % 64) / 2; }
__device__ __forceinline__ int perm32(int rho) { const int n = rho >> 4, i = rho & 15; return 8 * (i >> 2) + 4 * n + (i & 3); }
__device__ __forceinline__ unsigned cvt_pk_bf16(float lo, float hi) { unsigned r; asm volatile("v_cvt_pk_bf16_f32 %0, %1, %2" : "=v"(r) : "v"(lo), "v"(hi)); return r; }

struct GU { const char* B; int p0, p1, p2, p3; };

template <class Epi, class Sched>
__device__ __forceinline__ void gemm_phase(LAS unsigned char* lds, const char* Abase, const int K, const Sched& S, const Epi& E) {
    const int tid = threadIdx.x, wid = __builtin_amdgcn_readfirstlane(tid >> 6), lane = tid & 63, wr = wid >> 2, wc = wid & 3, fr = lane & 15, fq = lane >> 4;
    const int nt = K / BK;
    int sR[2], sC[2]; unsigned voffB[2];
#pragma unroll
    for (int i = 0; i < 2; ++i) { int R, C; stage_rc(tid * 16 + i * 8192, R, C); sR[i] = R; sC[i] = C; const int Rb = Epi::PERM ? ((R & ~31) + perm32(R & 31)) : R; voffB[i] = (unsigned)(Rb * K + C) * 2u; }
    const size_t kstep = (size_t)(BK * 2);
    const size_t hstep = (size_t)HALF * K * 2;
    const unsigned ldsw = (unsigned)wid * 1024u;
    const int aoff = lds_byte(wr * 64 + fr, fq * 8), boff = lds_byte(wc * 32 + fr, fq * 8);
#define PG_SA(b, h) (((b) * 2 + (h)) * HTB)
#define PG_SB(b, h) ((4 + (b) * 2 + (h)) * HTB)
#define PG_STAGE(bufoff, gbase, voff) do { _Pragma("unroll") for (int _i = 0; _i < 2; ++_i) \
        __builtin_amdgcn_global_load_lds((const unsigned*)((const char*)(gbase) + (voff)[_i]), (LAS unsigned*)(lds + (bufoff) + ldsw + _i * 8192), 16, 0, 0); } while (0)
#define PG_LDA(dst, b, h) do { _Pragma("unroll") for (int m = 0; m < 4; ++m) _Pragma("unroll") for (int k = 0; k < 2; ++k) dst[m][k] = *(const LAS bf16x8*)(lds + PG_SA(b, h) + aoff + m * 2048 + k * 1024); } while (0)
#define PG_LDB(dst, b, h) do { _Pragma("unroll") for (int n = 0; n < 2; ++n) _Pragma("unroll") for (int k = 0; k < 2; ++k) dst[n][k] = *(const LAS bf16x8*)(lds + PG_SB(b, h) + boff + n * 2048 + k * 1024); } while (0)
#define PG_MMA(ai, bj, At, Bt) do { __builtin_amdgcn_s_setprio(1); _Pragma("unroll") for (int m = 0; m < 4; ++m) _Pragma("unroll") for (int n = 0; n < 2; ++n) _Pragma("unroll") for (int k = 0; k < 2; ++k) \
        acc[ai][bj][m][n] = __builtin_amdgcn_mfma_f32_16x16x32_bf16(Bt[n][k], At[m][k], acc[ai][bj][m][n], 0, 0, 0); __builtin_amdgcn_s_setprio(0); } while (0)
#define PG_WAIT_V(n) asm volatile("s_waitcnt vmcnt(" #n ")" ::: "memory")
#define PG_WAIT_L(n) asm volatile("s_waitcnt lgkmcnt(" #n ")" ::: "memory")
#define PG_BAR __builtin_amdgcn_s_barrier()
#define PG_SCHED __builtin_amdgcn_sched_barrier(0)
    GU cur, nxt; int ui = 0;
    if (!S.next(0, cur)) return;
    f32x4 acc[2][2][4][2];
#pragma unroll
    for (int a = 0; a < 2; ++a)
#pragma unroll
        for (int b = 0; b < 2; ++b)
#pragma unroll
            for (int m = 0; m < 4; ++m)
#pragma unroll
                for (int n = 0; n < 2; ++n) acc[a][b][m][n] = (f32x4){0.f, 0.f, 0.f, 0.f};
    bf16x8 At[4][2], B0[2][2], B1[2][2];
    if constexpr (Sched::GATHER) { S.stage_table(cur, 0, lds, wid, lane); PG_WAIT_V(0); PG_BAR; }
    unsigned voC[2][2], voN[2][2];
#pragma unroll
    for (int h = 0; h < 2; ++h)
#pragma unroll
        for (int i = 0; i < 2; ++i) { voC[h][i] = S.voff(cur, 0, lds, h * HALF + sR[i], sC[i]); voN[h][i] = voC[h][i]; }
    const char* cB = cur.B;
    PG_STAGE(PG_SB(0, 0), cB, voffB); PG_STAGE(PG_SB(0, 1), cB + hstep, voffB); PG_STAGE(PG_SA(0, 0), Abase, voC[0]); PG_STAGE(PG_SA(0, 1), Abase, voC[1]);
    if (wr == 1) PG_BAR;
    PG_WAIT_V(2); PG_BAR;
    PG_STAGE(PG_SB(1, 0), cB + kstep, voffB); PG_STAGE(PG_SA(1, 0), Abase + kstep, voC[0]); PG_STAGE(PG_SB(1, 1), cB + hstep + kstep, voffB);
    PG_WAIT_V(6); PG_BAR;
    for (;;) {
        const bool has_next = S.next(ui + 1, nxt);
        if constexpr (Sched::GATHER) { if (has_next) S.stage_table(nxt, (ui + 1) & 1, lds, wid, lane); }
        const char* nB = has_next ? nxt.B : cB;
        for (int t = 0; t < nt; t += 2) {
            const bool last = (t == nt - 2);
            if (last && has_next) {
#pragma unroll
                for (int h = 0; h < 2; ++h)
#pragma unroll
                    for (int i = 0; i < 2; ++i) voN[h][i] = S.voff(nxt, (ui + 1) & 1, lds, h * HALF + sR[i], sC[i]);
            }
            unsigned vo2[2][2];
#pragma unroll
            for (int h = 0; h < 2; ++h)
#pragma unroll
                for (int i = 0; i < 2; ++i) vo2[h][i] = last ? voN[h][i] : voC[h][i];
            const char* a1 = Abase + (size_t)(t + 1) * kstep;
            const char* a2 = last ? Abase : Abase + (size_t)(t + 2) * kstep; const char* b2 = last ? nB : cB + (size_t)(t + 2) * kstep;
            const char* a3 = a2 + kstep; const char* b3 = b2 + kstep;
            PG_LDB(B0, 0, 0); PG_LDB(B1, 0, 1); PG_SCHED; PG_LDA(At, 0, 0); PG_STAGE(PG_SA(1, 1), a1, voC[1]);
            PG_WAIT_V(8); PG_WAIT_L(0); PG_BAR; PG_MMA(0, 0, At, B0); PG_MMA(0, 1, At, B1); PG_BAR; PG_SCHED;
            PG_LDA(At, 0, 1); PG_STAGE(PG_SB(0, 0), b2, voffB); PG_STAGE(PG_SB(0, 1), b2 + hstep, voffB); PG_STAGE(PG_SA(0, 0), a2, vo2[0]);
            PG_WAIT_V(8); PG_WAIT_L(0); PG_BAR; PG_MMA(1, 0, At, B0); PG_MMA(1, 1, At, B1); PG_BAR; PG_SCHED;
            PG_LDB(B0, 1, 0); PG_LDB(B1, 1, 1); PG_SCHED; PG_LDA(At, 1, 0); PG_STAGE(PG_SA(0, 1), a2, vo2[1]);
            PG_WAIT_V(8); PG_WAIT_L(0); PG_BAR; PG_MMA(0, 0, At, B0); PG_MMA(0, 1, At, B1); PG_BAR; PG_SCHED;
            PG_LDA(At, 1, 1); PG_STAGE(PG_SB(1, 0), b3, voffB); PG_STAGE(PG_SB(1, 1), b3 + hstep, voffB); PG_STAGE(PG_SA(1, 0), a3, vo2[0]);
            PG_WAIT_V(8); PG_WAIT_L(0); PG_BAR; PG_MMA(1, 0, At, B0); PG_MMA(1, 1, At, B1); PG_BAR; PG_SCHED;
        }
        if (wr == 0) PG_BAR;
        E(acc, cur, wr, wc, fr, fq);
        if (!has_next) break;
#pragma unroll
        for (int a = 0; a < 2; ++a)
#pragma unroll
            for (int b = 0; b < 2; ++b)
#pragma unroll
                for (int m = 0; m < 4; ++m)
#pragma unroll
                    for (int n = 0; n < 2; ++n) acc[a][b][m][n] = (f32x4){0.f, 0.f, 0.f, 0.f};
        cur = nxt; cB = nB; ++ui;
#pragma unroll
        for (int h = 0; h < 2; ++h)
#pragma unroll
            for (int i = 0; i < 2; ++i) voC[h][i] = voN[h][i];
        if (wr == 1) PG_BAR;
    }
    PG_WAIT_V(0);
    PG_BAR;
#undef PG_SA
#undef PG_SB
#undef PG_STAGE
#undef PG_LDA
#undef PG_LDB
#undef PG_MMA
#undef PG_WAIT_V
#undef PG_WAIT_L
#undef PG_BAR
#undef PG_SCHED
}

__device__ __forceinline__ void static_tile(int L, int nM, int nN, int& pm, int& pn) {
    const int nwg = nM * nN; int wgid = L; { const int q = nwg / 8, r = nwg % 8, xcd = wgid % 8, off = wgid / 8; wgid = (xcd < r ? xcd * (q + 1) : r * (q + 1) + (xcd - r) * q) + off; }
    const int nig = 8 * nN, gid = wgid / nig, fm = gid * 8, gsz = (nM - fm) < 8 ? (nM - fm) : 8;
    pm = fm + ((wgid % nig) % gsz); pn = (wgid % nig) / gsz;
}
struct DenseSched {
    static constexpr bool GATHER = false;
    const char* Bt; int K, nM, nN, G, c, xn, xm0, xpn;
    __device__ __forceinline__ bool next(int i, GU& u) const {
        const int L = i * G + c, nmain = nM * nN; int pm, pn;
        if (L < nmain) static_tile(L, nM, nN, pm, pn); else if (L < nmain + xn) { pm = xm0 + (L - nmain); pn = xpn; } else return false;
        u.B = Bt + (size_t)pn * BM * K * 2; u.p0 = pm; u.p1 = pn; u.p2 = 0; u.p3 = 0; return true;
    }
    __device__ __forceinline__ unsigned voff(const GU& u, int, LAS unsigned char*, int R, int C) const { return (unsigned)(((u.p0 * BM + R) * K + C) * 2); }
    __device__ __forceinline__ void stage_table(const GU&, int, LAS unsigned char*, int, int) const {}
};
template <bool GATHER_> struct MoeSched {
    static constexpr bool GATHER = GATHER_;
    const char* Wt; size_t wstride; int K; const int* list; LAS int* mm; int G, c;
    __device__ __forceinline__ bool next(int i, GU& u) const {
        int L = i * G + c;
        for (int e = 0; e < 16; ++e) { const int n = mm[e], nu = ((n + 255) >> 8) * 4;
            if (L < nu) { const int rt = L >> 2, pn = L & 3; u.B = Wt + (size_t)e * wstride + (size_t)pn * BM * K * 2; u.p0 = e; u.p1 = rt; u.p2 = pn; u.p3 = mm[16 + e]; return true; }
            L -= nu; }
        return false;
    }
    __device__ __forceinline__ unsigned voff(const GU& u, int buf, LAS unsigned char* lds, int R, int C) const {
        if constexpr (GATHER_) { const int tok = ((const LAS int*)(lds + TAB_OFF))[buf * 256 + R]; return (unsigned)((tok * K + C) * 2); }
        else return (unsigned)(((u.p3 + u.p1 * BM + R) * K + C) * 2);
    }
    __device__ __forceinline__ void stage_table(const GU& u, int buf, LAS unsigned char* lds, int wid, int lane) const {
        if constexpr (GATHER_) { const int r = (wid & 3) * 64 + lane;
            __builtin_amdgcn_global_load_lds((const unsigned*)(list + u.p0 * CAP + u.p1 * BM + r), (LAS unsigned*)(lds + TAB_OFF + buf * 1024 + (wid & 3) * 256), 4, 0, 0); }
    }
};

struct EpiInProj {
    static constexpr bool PERM = false;
    unsigned char* ws;
    __device__ __forceinline__ void operator()(const f32x4 (&acc)[2][2][4][2], const GU& u, int wr, int wc, int fr, int fq) const {
        const int pm = u.p0, pn = u.p1; const bool isctx = pm >= T / BM;
        float inv[4];
#pragma unroll
        for (int j = 0; j < 4; ++j) inv[j] = exp2f(-(float)(4 * fq + j) * (13.287712379549449f / 16.f));
#pragma unroll
        for (int bj = 0; bj < 2; ++bj) {
            const int cb = pn * BM + bj * HALF + wc * 32;
            bf16* dst; int pitch, cbase; bool rope = false;
            if (cb < 512) { dst = (bf16*)(ws + WS_UF); pitch = 512; cbase = 0; }
            else if (cb < 1024) { dst = (bf16*)(ws + WS_Q); pitch = 512; cbase = 512; rope = true; }
            else if (cb < 1152) { dst = isctx ? (bf16*)(ws + WS_CK) : (bf16*)(ws + WS_K); pitch = 128; cbase = 1024; rope = !isctx; }
            else { dst = isctx ? (bf16*)(ws + WS_CV) : (bf16*)(ws + WS_V); pitch = 128; cbase = 1152; }
            const bool bycol = ((cb >> 5) & 1) != 0;
#pragma unroll
            for (int ai = 0; ai < 2; ++ai)
#pragma unroll
                for (int m = 0; m < 4; ++m) {
                    const int row = pm * BM + ai * HALF + wr * 64 + m * 16 + fr;
                    f32x4 v0 = acc[ai][bj][m][0], v1 = acc[ai][bj][m][1];
                    if (rope) { const int l = row & (L - 1); const float pos = (float)(bycol ? (l & 63) : (l >> 6));
#pragma unroll
                        for (int j = 0; j < 4; ++j) { const float ang = pos * inv[j], cs = __cosf(ang), sn = __sinf(ang); const float x1 = v0[j], x2 = v1[j]; v0[j] = x1 * cs - x2 * sn; v1[j] = x1 * sn + x2 * cs; } }
                    const int orow = isctx ? row - T : row;
                    if (FAST_ATTN && cb >= 1152) {
                        const int kp = isctx ? CL : L, bb = isctx ? (orow >> 8) : (orow >> 13), key = isctx ? (orow & (CL - 1)) : (orow & (L - 1));
#pragma unroll
                        for (int n = 0; n < 2; ++n)
#pragma unroll
                            for (int j = 0; j < 4; ++j) { const int c = (cb - 1152) + 16 * n + 4 * fq + j;
                                dst[((size_t)bb * 128 + c) * kp + key] = (bf16)f2bf(n ? v1[j] : v0[j]); }
                        continue;
                    }
                    bf16* o = dst + (size_t)orow * pitch + (cb - cbase) + 4 * fq;
                    u32x2 w0, w1; w0.x = cvt_pk_bf16(v0[0], v0[1]); w0.y = cvt_pk_bf16(v0[2], v0[3]); w1.x = cvt_pk_bf16(v1[0], v1[1]); w1.y = cvt_pk_bf16(v1[2], v1[3]);
                    *(u32x2*)o = w0; *(u32x2*)(o + 16) = w1;
                }
        }
    }
};
struct EpiRes {
    static constexpr bool PERM = false;
    const float* base; float* X; const float* gate; const float* bias;
    __device__ __forceinline__ void operator()(const f32x4 (&acc)[2][2][4][2], const GU& u, int wr, int wc, int fr, int fq) const {
        const int row0 = u.p0 * BM + wr * 64 + fr, col0 = u.p1 * BM + wc * 32 + 4 * fq; const int b = (u.p0 * BM) >> 13;
        f32x4 gv[2][2], bv[2][2];
#pragma unroll
        for (int bj = 0; bj < 2; ++bj)
#pragma unroll
            for (int n = 0; n < 2; ++n) { gv[bj][n] = *(const f32x4*)(gate + (size_t)b * 6144 + col0 + bj * HALF + n * 16); bv[bj][n] = bias ? *(const f32x4*)(bias + col0 + bj * HALF + n * 16) : (f32x4){0.f, 0.f, 0.f, 0.f}; }
#pragma unroll
        for (int ai = 0; ai < 2; ++ai)
#pragma unroll
            for (int mp = 0; mp < 2; ++mp) {
                f32x4 bs[2][2][2];
#pragma unroll
                for (int mm = 0; mm < 2; ++mm) { const size_t off = (size_t)(row0 + ai * HALF + (2 * mp + mm) * 16) * D + col0;
#pragma unroll
                    for (int bj = 0; bj < 2; ++bj)
#pragma unroll
                        for (int n = 0; n < 2; ++n) bs[mm][bj][n] = *(const f32x4*)(base + off + bj * HALF + n * 16); }
#pragma unroll
                for (int mm = 0; mm < 2; ++mm) { const int m = 2 * mp + mm; const size_t off = (size_t)(row0 + ai * HALF + m * 16) * D + col0;
#pragma unroll
                    for (int bj = 0; bj < 2; ++bj)
#pragma unroll
                        for (int n = 0; n < 2; ++n) *(f32x4*)(X + off + bj * HALF + n * 16) = bs[mm][bj][n] + gv[bj][n] * (acc[ai][bj][m][n] + bv[bj][n]); }
                asm volatile("" ::: "memory"); }
    }
};
template <bool BASEBF> struct EpiResB {
    static constexpr bool PERM = true;
    const float* basef; bf16* XB; const float* gate; const float* bias;
    __device__ __forceinline__ void operator()(const f32x4 (&acc)[2][2][4][2], const GU& u, int wr, int wc, int fr, int fq) const {
        const int row0 = u.p0 * BM + wr * 64 + fr, col0 = u.p1 * BM + wc * 32 + 8 * fq; const int b = (u.p0 * BM) >> 13;
        f32x4 gv[2][2], bv[2][2];
#pragma unroll
        for (int bj = 0; bj < 2; ++bj)
#pragma unroll
            for (int n = 0; n < 2; ++n) { gv[bj][n] = *(const f32x4*)(gate + (size_t)b * 6144 + col0 + bj * HALF + n * 4); bv[bj][n] = bias ? *(const f32x4*)(bias + col0 + bj * HALF + n * 4) : (f32x4){0.f, 0.f, 0.f, 0.f}; }
        constexpr int NB2 = BASEBF ? 4 : 2;
#pragma unroll
        for (int ai = 0; ai < 2; ++ai)
#pragma unroll
            for (int mb = 0; mb < 4; mb += NB2) {
                f32x4 bf[BASEBF ? 1 : NB2][2][2]; u32x4 bw[BASEBF ? NB2 : 1][2];
#pragma unroll
                for (int mm = 0; mm < NB2; ++mm) { const size_t off = (size_t)(row0 + ai * HALF + (mb + mm) * 16) * D + col0;
#pragma unroll
                    for (int bj = 0; bj < 2; ++bj) {
                        if (BASEBF) bw[mm][bj] = *(const u32x4*)(XB + off + bj * HALF);
                        else { bf[mm][bj][0] = *(const f32x4*)(basef + off + bj * HALF); bf[mm][bj][1] = *(const f32x4*)(basef + off + bj * HALF + 4); } } }
#pragma unroll
                for (int mm = 0; mm < NB2; ++mm) { const int m = mb + mm; const size_t off = (size_t)(row0 + ai * HALF + m * 16) * D + col0;
#pragma unroll
                    for (int bj = 0; bj < 2; ++bj) { f32x4 o[2];
#pragma unroll
                        for (int n = 0; n < 2; ++n) { f32x4 bsv;
                            if (BASEBF) { const unsigned wa = n ? bw[mm][bj].z : bw[mm][bj].x, wb = n ? bw[mm][bj].w : bw[mm][bj].y; bsv = (f32x4){bflo(wa), bfhi(wa), bflo(wb), bfhi(wb)}; } else bsv = bf[mm][bj][n];
                            o[n] = bsv + gv[bj][n] * (acc[ai][bj][m][n] + bv[bj][n]); }
                        u32x4 w2; w2.x = cvt_pk_bf16(o[0][0], o[0][1]); w2.y = cvt_pk_bf16(o[0][2], o[0][3]); w2.z = cvt_pk_bf16(o[1][0], o[1][1]); w2.w = cvt_pk_bf16(o[1][2], o[1][3]);
                        *(u32x4*)(XB + off + bj * HALF) = w2; } }
                asm volatile("" ::: "memory"); }
    }
};
struct EpiGLU {
    static constexpr bool PERM = true;
    bf16* U; const float* bias;
    __device__ __forceinline__ void operator()(const f32x4 (&acc)[2][2][4][2], const GU& u, int wr, int wc, int fr, int fq) const {
        const int row0 = u.p0 * BM + wr * 64 + fr, col0 = u.p1 * HALF + wc * 32 + 8 * fq;
        f32x4 ba[2], bg[2];
#pragma unroll
        for (int n = 0; n < 2; ++n) { ba[n] = *(const f32x4*)(bias + col0 + 4 * n); bg[n] = *(const f32x4*)(bias + 1024 + col0 + 4 * n); }
#pragma unroll
        for (int ai = 0; ai < 2; ++ai)
#pragma unroll
            for (int m = 0; m < 4; ++m) { f32x4 o[2];
#pragma unroll
                for (int n = 0; n < 2; ++n) { const f32x4 a = acc[ai][0][m][n] + ba[n], g = acc[ai][1][m][n] + bg[n];
#pragma unroll
                    for (int j = 0; j < 4; ++j) o[n][j] = a[j] * sigmoid_f(g[j]); }
                u32x4 w; w.x = cvt_pk_bf16(o[0][0], o[0][1]); w.y = cvt_pk_bf16(o[0][2], o[0][3]); w.z = cvt_pk_bf16(o[1][0], o[1][1]); w.w = cvt_pk_bf16(o[1][2], o[1][3]);
                *(u32x4*)(U + (size_t)(row0 + ai * HALF + m * 16) * D + col0) = w; }
    }
};
struct EpiGateUp {
    static constexpr bool PERM = true;
    bf16* HID; const float* slot_w; LAS int* mm;
    __device__ __forceinline__ void operator()(const f32x4 (&acc)[2][2][4][2], const GU& u, int wr, int wc, int fr, int fq) const {
        const int e = u.p0, n_e = mm[e], r0 = u.p1 * BM + wr * 64 + fr, col0 = u.p2 * HALF + wc * 32 + 8 * fq;
        float wv[2][4];
#pragma unroll
        for (int ai = 0; ai < 2; ++ai)
#pragma unroll
            for (int m = 0; m < 4; ++m) wv[ai][m] = slot_w[e * CAP + r0 + ai * HALF + m * 16];
#pragma unroll
        for (int ai = 0; ai < 2; ++ai)
#pragma unroll
            for (int m = 0; m < 4; ++m) { const int r = r0 + ai * HALF + m * 16;
                if (r < n_e) { const float w = wv[ai][m]; f32x4 o[2];
#pragma unroll
                    for (int n = 0; n < 2; ++n) { const f32x4 g = acc[ai][0][m][n], up = acc[ai][1][m][n];
#pragma unroll
                        for (int j = 0; j < 4; ++j) o[n][j] = w * silu_f(g[j]) * up[j]; }
                    u32x4 q; q.x = cvt_pk_bf16(o[0][0], o[0][1]); q.y = cvt_pk_bf16(o[0][2], o[0][3]); q.z = cvt_pk_bf16(o[1][0], o[1][1]); q.w = cvt_pk_bf16(o[1][2], o[1][3]);
                    *(u32x4*)(HID + (size_t)(u.p3 + r) * FF + col0) = q; } }
    }
};
struct EpiDown {
    static constexpr bool PERM = true;
    bf16* Y; LAS int* mm;
    __device__ __forceinline__ void operator()(const f32x4 (&acc)[2][2][4][2], const GU& u, int wr, int wc, int fr, int fq) const {
        const int e = u.p0, n_e = mm[e], r0 = u.p1 * BM + wr * 64 + fr, col0 = u.p2 * BM + wc * 32 + 8 * fq;
#pragma unroll
        for (int ai = 0; ai < 2; ++ai)
#pragma unroll
            for (int m = 0; m < 4; ++m) { const int r = r0 + ai * HALF + m * 16;
                if (r < n_e) {
#pragma unroll
                    for (int bj = 0; bj < 2; ++bj) { const f32x4 v0 = acc[ai][bj][m][0], v1 = acc[ai][bj][m][1];
                        u32x4 q; q.x = cvt_pk_bf16(v0[0], v0[1]); q.y = cvt_pk_bf16(v0[2], v0[3]); q.z = cvt_pk_bf16(v1[0], v1[1]); q.w = cvt_pk_bf16(v1[2], v1[3]);
                        *(u32x4*)(Y + (size_t)(u.p3 + r) * D + col0 + bj * HALF) = q; } } }
    }
};
}

__device__ __forceinline__ void fast_inproj(Frame& F) {
    pg::DenseSched S{(const char*)(F.ws + WS_WIN), D, T / 256, N_IN / 256, F.G, F.wg, TC / 256, T / 256, 4};
    pg::EpiInProj E{F.ws};
    pg::gemm_phase(F.lds, (const char*)(F.ws + WS_HB), D, S, E);
    const int nbusy = (T / 256) * (N_IN / 256) + TC / 256 - 2 * F.G;
    if (nbusy > 0 && nbusy < F.G) { if (F.wg >= nbusy) t_items_tail(F, (F.wg - nbusy) * NWAVES + F.wave, (F.G - nbusy) * NWAVES); }
    else t_items_tail(F, F.wg * NWAVES + F.wave, F.G * NWAVES);
}
__device__ __forceinline__ void fast_outproj(Frame& F, size_t a_off, size_t w_off, const float* base, float* X, const float* gate, const float* bias) {
    pg::DenseSched S{(const char*)(F.ws + w_off), D, T / 256, D / 256, F.G, F.wg, 0, 0, 0};
    if (XBF16) {
        if (base == X) { pg::EpiResB<true> E{nullptr, (bf16*)(F.ws + WS_XB), gate, bias}; pg::gemm_phase(F.lds, (const char*)(F.ws + a_off), D, S, E); }
        else { pg::EpiResB<false> E{base, (bf16*)(F.ws + WS_XB), gate, bias}; pg::gemm_phase(F.lds, (const char*)(F.ws + a_off), D, S, E); }
    } else { pg::EpiRes E{base, X, gate, bias}; pg::gemm_phase(F.lds, (const char*)(F.ws + a_off), D, S, E); }
}
__device__ __forceinline__ void fast_pw1(Frame& F) {
    pg::DenseSched S{(const char*)(F.ws + WS_WPW1), D, T / 256, 2048 / 256, F.G, F.wg, 0, 0, 0};
    pg::EpiGLU E{(bf16*)(F.ws + WS_U), F.in[I_PW1B]};
    pg::gemm_phase(F.lds, (const char*)(F.ws + WS_HB), D, S, E);
}
__device__ __forceinline__ void fast_moe_gateup(Frame& F, int layer) {
    LAS int* mm = moe_map(F, layer);
    pg::MoeSched<true> S{(const char*)(F.ws + WS_WGU) + (size_t)layer * 16 * 1024 * 1024 * 2, (size_t)1024 * 1024 * 2, D, (const int*)(F.ws + WS_SLOTT) + layer * 16 * CAP, mm, F.G, F.wg};
    pg::EpiGateUp E{(bf16*)(F.ws + WS_HID), (const float*)(F.ws + WS_SLOTW) + layer * 16 * CAP, mm};
    pg::gemm_phase(F.lds, (const char*)(F.ws + WS_HB), D, S, E);
}
__device__ __forceinline__ void fast_moe_down(Frame& F, int layer) {
    LAS int* mm = moe_map(F, layer);
    pg::MoeSched<false> S{(const char*)(F.ws + WS_WDN) + (size_t)layer * 16 * 1024 * 512 * 2, (size_t)1024 * 512 * 2, FF, nullptr, mm, F.G, F.wg};
    pg::EpiDown E{(bf16*)(F.ws + WS_Y), mm};
    pg::gemm_phase(F.lds, (const char*)(F.ws + WS_HID), FF, S, E);
}


struct AttnBlk { const bf16* kp; const bf16* vp; int pitch; int kb; bool valid, masked; };
__device__ __forceinline__ AttnBlk attn_blk(const unsigned char* ws, int bi, int b, int kvh, int qs) {
    AttnBlk a;
    if (bi < 8) { a.kp = (const bf16*)(ws + WS_CK) + (size_t)(b * CL + bi * 32) * 128 + kvh * 64; a.vp = (const bf16*)(ws + WS_CV) + (size_t)(b * 2 + kvh) * 64 * CL + bi * 32; a.pitch = CL; a.kb = 0; a.valid = true; a.masked = false; }
    else { const int kb = qs - 128 + 32 * (bi - 8); a.valid = (kb >= 0 && kb < L); a.kb = kb; a.masked = true; a.pitch = L;
        a.kp = (const bf16*)(ws + WS_K) + (size_t)(b * L + kb) * 128 + kvh * 64; a.vp = (const bf16*)(ws + WS_V) + (size_t)(b * 2 + kvh) * 64 * L + kb; }
    return a;
}
__device__ __forceinline__ void attn_load(const AttnBlk& a, int r, int h, bf16x8 (&kf)[4], u32x4 (&vf)[2][2]) {
    if (a.valid) {
#pragma unroll
        for (int s = 0; s < 4; ++s) kf[s] = *(const bf16x8*)(a.kp + (size_t)r * 128 + 16 * s + 8 * h);
#pragma unroll
        for (int db = 0; db < 2; ++db)
#pragma unroll
            for (int ks = 0; ks < 2; ++ks) { const bf16* vr = a.vp + (size_t)(32 * db + r) * a.pitch + 16 * ks + 4 * h;
                const u32x2 lo = *(const u32x2*)vr, hi = *(const u32x2*)(vr + 8); vf[db][ks] = (u32x4){lo.x, lo.y, hi.x, hi.y}; }
    }
}
__device__ __forceinline__ void attn_compute(const AttnBlk& a, int qs, int r, int h, const bf16x8 (&kf)[4], const u32x4 (&vf)[2][2], const bf16x8 (&qf)[2][4],
                                             f32x16 (&o)[2][2], float (&m)[2], float (&l)[2]) {
    if (!a.valid) return;
#pragma unroll
    for (int nq = 0; nq < 2; ++nq) {
        f32x16 st;
#pragma unroll
        for (int i = 0; i < 16; ++i) st[i] = 0.f;
#pragma unroll
        for (int s = 0; s < 4; ++s) st = __builtin_amdgcn_mfma_f32_32x32x16_bf16(kf[s], qf[nq][s], st, 0, 0, 0);
        float t[16]; float tmax = -INFINITY;
        const int dbase = a.kb - qs - 32 * nq - r + 4 * h;
#pragma unroll
        for (int i = 0; i < 16; ++i) { float v = st[i] * (0.125f * 1.4426950408889634f);
            if (a.masked) { const int df = dbase + (i & 3) + 8 * (i >> 2); v = (df >= -128 && df <= 128) ? v : -INFINITY; }
            t[i] = v; tmax = fmaxf(tmax, v); }
        tmax = fmaxf(tmax, __shfl_xor(tmax, 32));
        const float mn = fmaxf(m[nq], tmax), alpha = __builtin_amdgcn_exp2f(m[nq] - mn); m[nq] = mn;
        float ps = 0.f;
#pragma unroll
        for (int i = 0; i < 16; ++i) { t[i] = __builtin_amdgcn_exp2f(t[i] - mn); ps += t[i]; }
        l[nq] = l[nq] * alpha + ps;
#pragma unroll
        for (int i = 0; i < 16; ++i) { o[0][nq][i] *= alpha; o[1][nq][i] *= alpha; }
        bf16x8 pf[2];
#pragma unroll
        for (int ks = 0; ks < 2; ++ks) { const u32x4 w = {pkbf(t[8 * ks], t[8 * ks + 1]), pkbf(t[8 * ks + 2], t[8 * ks + 3]), pkbf(t[8 * ks + 4], t[8 * ks + 5]), pkbf(t[8 * ks + 6], t[8 * ks + 7])};
            pf[ks] = __builtin_bit_cast(bf16x8, w); }
#pragma unroll
        for (int db = 0; db < 2; ++db)
#pragma unroll
            for (int ks = 0; ks < 2; ++ks) o[db][nq] = __builtin_amdgcn_mfma_f32_32x32x16_bf16(__builtin_bit_cast(bf16x8, vf[db][ks]), pf[ks], o[db][nq], 0, 0, 0);
    }
}
__device__ __forceinline__ void phase_attn_mfma(Frame& F) {
    const bf16* Q = (const bf16*)(F.ws + WS_Q); bf16* MIX = (bf16*)(F.ws + WS_MIX);
    const int g = F.wave >> 1, half = F.wave & 1, r = F.lane & 31, h = F.lane >> 5;
    for (int item = F.wg; item < NB * 2 * 64; item += F.G) {
        const int qb = item & 63, kvh = (item >> 6) & 1, b = item >> 7, hd = kvh * 4 + g, qs = qb * 128 + half * 64;
        bf16x8 qf[2][4];
#pragma unroll
        for (int nq = 0; nq < 2; ++nq)
#pragma unroll
            for (int s = 0; s < 4; ++s) qf[nq][s] = *(const bf16x8*)(Q + (size_t)(b * L + qs + 32 * nq + r) * 512 + hd * 64 + 16 * s + 8 * h);
        f32x16 o[2][2];
#pragma unroll
        for (int db = 0; db < 2; ++db)
#pragma unroll
            for (int nq = 0; nq < 2; ++nq)
#pragma unroll
                for (int i = 0; i < 16; ++i) o[db][nq][i] = 0.f;
        float m[2], l[2];
        m[0] = m[1] = F.in[I_SINK][hd] * 1.4426950408889634f; l[0] = l[1] = (h == 0) ? 1.f : 0.f;
        bf16x8 kfA[4], kfB[4]; u32x4 vfA[2][2], vfB[2][2];
        AttnBlk ba = attn_blk(F.ws, 0, b, kvh, qs), bb;
        attn_load(ba, r, h, kfA, vfA);
#pragma unroll 1
        for (int bi = 0; bi < 18; bi += 2) {
            bb = attn_blk(F.ws, bi + 1, b, kvh, qs); attn_load(bb, r, h, kfB, vfB);
            attn_compute(ba, qs, r, h, kfA, vfA, qf, o, m, l);
            if (bi + 2 < 18) { ba = attn_blk(F.ws, bi + 2, b, kvh, qs); attn_load(ba, r, h, kfA, vfA); }
            attn_compute(bb, qs, r, h, kfB, vfB, qf, o, m, l);
        }
#pragma unroll
        for (int nq = 0; nq < 2; ++nq) {
            const float lt = l[nq] + __shfl_xor(l[nq], 32), il = 1.f / lt;
            bf16* orow = MIX + (size_t)(b * L + qs + 32 * nq + r) * 1024 + 512 + hd * 64;
#pragma unroll
            for (int db = 0; db < 2; ++db)
#pragma unroll
                for (int i4 = 0; i4 < 4; ++i4) { u32x2 w; w.x = pkbf(o[db][nq][4 * i4] * il, o[db][nq][4 * i4 + 1] * il); w.y = pkbf(o[db][nq][4 * i4 + 2] * il, o[db][nq][4 * i4 + 3] * il);
                    *(u32x2*)(orow + 32 * db + 8 * i4 + 4 * h) = w; }
        }
    }
}


__device__ __forceinline__ float half_max(float v) { const auto r = __builtin_amdgcn_permlane32_swap(__float_as_uint(v), __float_as_uint(v), false, false); return fmaxf(__uint_as_float(r[0]), __uint_as_float(r[1])); }
__device__ __forceinline__ float half_sum(float v) { const auto r = __builtin_amdgcn_permlane32_swap(__float_as_uint(v), __float_as_uint(v), false, false); return __uint_as_float(r[0]) + __uint_as_float(r[1]); }
constexpr int AT_KP = 72, AT_VP = 136;
constexpr int AT_KB = 128 * AT_KP * 2, AT_BUF = AT_KB + 64 * AT_VP * 2;
struct AtChunk { const bf16* kg; const bf16* vg; int vpitch, lc, b, kvh, qb, c; bool valid, local, any; };
__device__ __forceinline__ AtChunk at_chunk(const unsigned char* ws, int seq, int wg, int G) {
    AtChunk k; const int item = wg + (seq / 5) * G; k.c = seq % 5; k.any = item < NB * 2 * 64;
    k.qb = item & 63; k.kvh = (item >> 6) & 1; k.b = (item >> 7) & 3; k.local = k.c >= 2; k.lc = k.c - 2;
    if (!k.local) { k.valid = k.any; k.vpitch = CL; k.kg = (const bf16*)(ws + WS_CK) + (size_t)(k.b * CL + 128 * k.c) * 128 + k.kvh * 64; k.vg = (const bf16*)(ws + WS_CV) + (size_t)(k.b * 2 + k.kvh) * 64 * CL + 128 * k.c; }
    else { const int key0 = 128 * k.qb - 128 + 128 * k.lc; k.valid = k.any && key0 >= 0 && key0 < L; k.vpitch = L;
        k.kg = (const bf16*)(ws + WS_K) + (size_t)(k.b * L + key0) * 128 + k.kvh * 64; k.vg = (const bf16*)(ws + WS_V) + (size_t)(k.b * 2 + k.kvh) * 64 * L + key0; }
    return k;
}
__device__ __forceinline__ void at_issue(const AtChunk& k, int tid, u32x4 (&rg)[4]) {
    if (k.valid) {
#pragma unroll
        for (int i = 0; i < 2; ++i) { const int id = tid + 512 * i; rg[i] = *(const u32x4*)(k.kg + (size_t)(id >> 3) * 128 + (id & 7) * 8); }
#pragma unroll
        for (int i = 0; i < 2; ++i) { const int id = tid + 512 * i; rg[2 + i] = *(const u32x4*)(k.vg + (size_t)(id >> 4) * k.vpitch + (id & 15) * 8); }
    }
}
__device__ __forceinline__ void at_write(const AtChunk& k, LAS unsigned char* buf, int tid, const u32x4 (&rg)[4]) {
    if (k.valid) {
#pragma unroll
        for (int i = 0; i < 2; ++i) { const int id = tid + 512 * i; *(LAS u32x4*)(buf + (id >> 3) * (AT_KP * 2) + (id & 7) * 16) = rg[i]; }
#pragma unroll
        for (int i = 0; i < 2; ++i) { const int id = tid + 512 * i; *(LAS u32x4*)(buf + AT_KB + (id >> 4) * (AT_VP * 2) + (id & 15) * 16) = rg[2 + i]; }
    }
}
__device__ __forceinline__ void at_load(LAS unsigned char* buf, int blk, int r, int h, bf16x8 (&kf)[4], u32x4 (&vf)[2][2]) {
#pragma unroll
    for (int s2 = 0; s2 < 4; ++s2) kf[s2] = *(const LAS bf16x8*)(buf + (32 * blk + r) * (AT_KP * 2) + (16 * s2 + 8 * h) * 2);
#pragma unroll
    for (int db = 0; db < 2; ++db)
#pragma unroll
        for (int ks = 0; ks < 2; ++ks) { const LAS unsigned char* vr = buf + AT_KB + (32 * db + r) * (AT_VP * 2) + (32 * blk + 16 * ks + 4 * h) * 2;
            const u32x2 lo = *(const LAS u32x2*)vr, hi = *(const LAS u32x2*)(vr + 16); vf[db][ks] = (u32x4){lo.x, lo.y, hi.x, hi.y}; }
}
__device__ __forceinline__ void at_math(const bf16x8 (&kf)[4], const u32x4 (&vf)[2][2], bool masked, int kbrel, int r, int h, const bf16x8 (&qf)[2][4], f32x16 (&o)[2][2], float (&m)[2], float (&l)[2]) {
    constexpr float C = 0.125f * 1.4426950408889634f;
#pragma unroll
    for (int nq = 0; nq < 2; ++nq) {
        f32x16 st;
#pragma unroll
        for (int i = 0; i < 16; ++i) st[i] = 0.f;
#pragma unroll
        for (int s2 = 0; s2 < 4; ++s2) st = __builtin_amdgcn_mfma_f32_32x32x16_bf16(kf[s2], qf[nq][s2], st, 0, 0, 0);
        if (masked) { const int dbase = kbrel - 32 * nq - r + 4 * h;
#pragma unroll
            for (int i = 0; i < 16; ++i) { const int df = dbase + (i & 3) + 8 * (i >> 2); st[i] = (df >= -128 && df <= 128) ? st[i] : -INFINITY; } }
        float smax = st[0];
#pragma unroll
        for (int i = 1; i < 16; ++i) smax = fmaxf(smax, st[i]);
        smax = half_max(smax);
        const float mn = fmaxf(m[nq], smax * C), alpha = __builtin_amdgcn_exp2f(m[nq] - mn); m[nq] = mn;
        float t[16]; float ps = 0.f;
#pragma unroll
        for (int i = 0; i < 16; ++i) { t[i] = __builtin_amdgcn_exp2f(__builtin_fmaf(st[i], C, -mn)); ps += t[i]; }
        l[nq] = l[nq] * alpha + ps;
        if (__ballot(alpha != 1.f)) {
#pragma unroll
            for (int i = 0; i < 16; ++i) { o[0][nq][i] *= alpha; o[1][nq][i] *= alpha; } }
        bf16x8 pf[2];
#pragma unroll
        for (int ks = 0; ks < 2; ++ks) { const u32x4 w = {pkbf(t[8 * ks], t[8 * ks + 1]), pkbf(t[8 * ks + 2], t[8 * ks + 3]), pkbf(t[8 * ks + 4], t[8 * ks + 5]), pkbf(t[8 * ks + 6], t[8 * ks + 7])};
            pf[ks] = __builtin_bit_cast(bf16x8, w); }
#pragma unroll
        for (int db = 0; db < 2; ++db)
#pragma unroll
            for (int ks = 0; ks < 2; ++ks) o[db][nq] = __builtin_amdgcn_mfma_f32_32x32x16_bf16(__builtin_bit_cast(bf16x8, vf[db][ks]), pf[ks], o[db][nq], 0, 0, 0);
    }
}
__device__ __forceinline__ void phase_attn_lds(Frame& F) {
    const bf16* Q = (const bf16*)(F.ws + WS_Q); bf16* MIX = (bf16*)(F.ws + WS_MIX);
    const int g = F.wave >> 1, half = F.wave & 1, r = F.lane & 31, h = F.lane >> 5;
    __syncthreads();
    u32x4 rg[4];
    AtChunk ck = at_chunk(F.ws, 0, F.wg, F.G);
    if (!ck.any) return;
    at_issue(ck, F.tid, rg); at_write(ck, F.lds, F.tid, rg);
    __syncthreads();
    bf16x8 qf[2][4]; f32x16 o[2][2]; float m[2], l[2];
#pragma unroll 1
    for (int seq = 0; ck.any; ++seq) {
        LAS unsigned char* buf = F.lds + (seq & 1) * AT_BUF;
        const TItem ti = t_decode(F, seq < 10 ? 640 + (F.wg * NWAVES + F.wave) + seq * (F.G * NWAVES) : (1 << 30));
        t_dma(ti, F.lds + 2 * AT_BUF + F.wave * 8704, F.lane);
        const AtChunk nk = at_chunk(F.ws, seq + 1, F.wg, F.G);
        at_issue(nk, F.tid, rg);
        const int hd = ck.kvh * 4 + g, qs = ck.qb * 128 + half * 64;
        if (ck.c == 0) {
#pragma unroll
            for (int nq = 0; nq < 2; ++nq)
#pragma unroll
                for (int s2 = 0; s2 < 4; ++s2) qf[nq][s2] = *(const bf16x8*)(Q + (size_t)(ck.b * L + qs + 32 * nq + r) * 512 + hd * 64 + 16 * s2 + 8 * h);
#pragma unroll
            for (int db = 0; db < 2; ++db)
#pragma unroll
                for (int nq = 0; nq < 2; ++nq)
#pragma unroll
                    for (int i = 0; i < 16; ++i) o[db][nq][i] = 0.f;
            m[0] = m[1] = F.in[I_SINK][hd] * 1.4426950408889634f; l[0] = l[1] = (h == 0) ? 1.f : 0.f;
        }
        if (ck.valid) {
            int b0 = 0, b1 = 4;
            if (ck.local) { b0 = 2 * half - 4 * ck.lc; b0 = b0 < 0 ? 0 : b0; b1 = 2 * half + 10 - 4 * ck.lc; b1 = b1 > 4 ? 4 : b1; }
            if (b0 < b1) {
                bf16x8 kfA[4], kfB[4]; u32x4 vfA[2][2], vfB[2][2];
                at_load(buf, b0, r, h, kfA, vfA);
#pragma unroll 1
                for (int blk = b0; blk < b1; blk += 2) {
                    const int iA = 4 * ck.lc + blk - 2 * half, iB = iA + 1;
                    if (blk + 1 < b1) at_load(buf, blk + 1, r, h, kfB, vfB);
                    at_math(kfA, vfA, ck.local && (iA < 2 || iA > 7), 32 * iA - 128, r, h, qf, o, m, l);
                    if (blk + 1 < b1) {
                        if (blk + 2 < b1) at_load(buf, blk + 2, r, h, kfA, vfA);
                        at_math(kfB, vfB, ck.local && (iB < 2 || iB > 7), 32 * iB - 128, r, h, qf, o, m, l);
                    }
                }
            }
        }
        if (ck.c == 4) {
#pragma unroll
            for (int nq = 0; nq < 2; ++nq) {
                const float lt = half_sum(l[nq]), il = __builtin_amdgcn_rcpf(lt);
                bf16* orow = MIX + (size_t)(ck.b * L + qs + 32 * nq + r) * 1024 + 512 + hd * 64;
#pragma unroll
                for (int db = 0; db < 2; ++db)
#pragma unroll
                    for (int i4 = 0; i4 < 4; ++i4) { u32x2 w; w.x = pkbf(o[db][nq][4 * i4] * il, o[db][nq][4 * i4 + 1] * il); w.y = pkbf(o[db][nq][4 * i4 + 2] * il, o[db][nq][4 * i4 + 3] * il);
                        *(u32x2*)(orow + 32 * db + 8 * i4 + 4 * h) = w; }
            }
        }
        if (ti.ok) { asm volatile("s_waitcnt vmcnt(0)" ::: "memory"); t_store_dma(ti, (const LAS float*)(F.lds + 2 * AT_BUF + F.wave * 8704), F.lane); }
        at_write(nk, F.lds + ((seq + 1) & 1) * AT_BUF, F.tid, rg);
        __syncthreads();
        ck = nk;
    }
}

constexpr int F1_PC = 136, F1_PW = 68, F2_P = 264;
constexpr int F1_CSC = 0, F1_CSS = 128 * F1_PC * 2, F1_C64 = 2 * 128 * F1_PC * 2, F1_S64 = F1_C64 + 64 * F1_PW * 2;
__device__ __forceinline__ bf16x8 pack8(float a0, float a1, float a2, float a3, float a4, float a5, float a6, float a7) {
    const u32x4 w = {pkbf(a0, a1), pkbf(a2, a3), pkbf(a4, a5), pkbf(a6, a7)}; return __builtin_bit_cast(bf16x8, w); }
__device__ __forceinline__ void phase_fft1_mfma(Frame& F) {
    __syncthreads();
    LAS bf16* csc = (LAS bf16*)(F.lds + F1_CSC); LAS bf16* css = (LAS bf16*)(F.lds + F1_CSS); LAS bf16* c64 = (LAS bf16*)(F.lds + F1_C64); LAS bf16* s64 = (LAS bf16*)(F.lds + F1_S64);
    for (int i = F.tid; i < 128 * 128; i += NTHR) { const int n = i >> 7, k = i & 127; const float ang = (float)((n * k) & 127) * (6.283185307179586f / 128.f);
        csc[n * F1_PC + k] = (bf16)f2bf(__cosf(ang)); css[n * F1_PC + k] = (bf16)f2bf(__sinf(ang)); }
    for (int i = F.tid; i < 64 * 64; i += NTHR) { const int c = i >> 6, a = i & 63; const float ang = (float)((c * a) & 63) * (6.283185307179586f / 64.f);
        c64[c * F1_PW + a] = (bf16)f2bf(__cosf(ang)); s64[c * F1_PW + a] = (bf16)f2bf(__sinf(ang)); }
    __syncthreads();
    const bf16* UF = (const bf16*)(F.ws + WS_UF); bf16* Gb = (bf16*)(F.ws + WS_G);
    const int r = F.lane & 31, h = F.lane >> 5, g = F.wave >> 1;
    LAS bf16* sre = (LAS bf16*)(F.lds + F1_S64 + 64 * F1_PW * 2 + F.wave * 5120); LAS bf16* sim = sre + 32 * 40;
    for (int item = F.wg; item < NB * FN2; item += F.G) {
        const int b = item >> 7, bp = item & 127;
        bf16x8 uf[2][8];
#pragma unroll
        for (int rb = 0; rb < 2; ++rb)
#pragma unroll
            for (int s2 = 0; s2 < 8; ++s2) uf[rb][s2] = *(const bf16x8*)(UF + (size_t)(b * L + 128 * (32 * rb + r) + bp) * 512 + g * 128 + 16 * s2 + 8 * h);
#pragma unroll 1
        for (int q = 0; q < 2; ++q) {
            const int cbk = 2 * F.wave + q, n = 32 * (cbk & 3) + r, ch = 32 * cbk + r;
            f32x16 zr[2], zi[2];
#pragma unroll
            for (int rb = 0; rb < 2; ++rb) {
#pragma unroll
                for (int i = 0; i < 16; ++i) { zr[rb][i] = 0.f; zi[rb][i] = 0.f; }
#pragma unroll
                for (int s2 = 0; s2 < 8; ++s2) { const bf16x8 bc = *(const LAS bf16x8*)(csc + n * F1_PC + 16 * s2 + 8 * h), bs = *(const LAS bf16x8*)(css + n * F1_PC + 16 * s2 + 8 * h);
                    zr[rb] = __builtin_amdgcn_mfma_f32_32x32x16_bf16(uf[rb][s2], bc, zr[rb], 0, 0, 0); zi[rb] = __builtin_amdgcn_mfma_f32_32x32x16_bf16(uf[rb][s2], bs, zi[rb], 0, 0, 0); }
                __builtin_amdgcn_sched_barrier(0);
            }
            bf16x8 zfr[4], zfi[4];
#pragma unroll
            for (int ks = 0; ks < 4; ++ks) { const int rb = ks >> 1, o = 8 * (ks & 1);
                zfr[ks] = pack8(zr[rb][o], zr[rb][o + 1], zr[rb][o + 2], zr[rb][o + 3], zr[rb][o + 4], zr[rb][o + 5], zr[rb][o + 6], zr[rb][o + 7]);
                zfi[ks] = pack8(-zi[rb][o], -zi[rb][o + 1], -zi[rb][o + 2], -zi[rb][o + 3], -zi[rb][o + 4], -zi[rb][o + 5], -zi[rb][o + 6], -zi[rb][o + 7]); }
            __builtin_amdgcn_sched_barrier(0);
#pragma unroll 1
            for (int rbc = 0; rbc < 2; ++rbc) {
                f32x16 gr, gi; const int cr = 32 * rbc + r;
#pragma unroll
                for (int i = 0; i < 16; ++i) { gr[i] = 0.f; gi[i] = 0.f; }
#pragma unroll
                for (int ks = 0; ks < 4; ++ks) {
                    const u32x2 cl = *(const LAS u32x2*)(c64 + cr * F1_PW + 16 * ks + 4 * h), chh = *(const LAS u32x2*)(c64 + cr * F1_PW + 16 * ks + 8 + 4 * h);
                    const u32x2 sl = *(const LAS u32x2*)(s64 + cr * F1_PW + 16 * ks + 4 * h), shh = *(const LAS u32x2*)(s64 + cr * F1_PW + 16 * ks + 8 + 4 * h);
                    const u32x4 sw = {sl.x, sl.y, shh.x, shh.y}; const u32x4 swn = sw ^ 0x80008000u;
                    const bf16x8 wc = __builtin_bit_cast(bf16x8, ((u32x4){cl.x, cl.y, chh.x, chh.y})), wsn = __builtin_bit_cast(bf16x8, sw), wsm = __builtin_bit_cast(bf16x8, swn);
                    gr = __builtin_amdgcn_mfma_f32_32x32x16_bf16(wc, zfr[ks], gr, 0, 0, 0); gr = __builtin_amdgcn_mfma_f32_32x32x16_bf16(wsn, zfi[ks], gr, 0, 0, 0);
                    gi = __builtin_amdgcn_mfma_f32_32x32x16_bf16(wc, zfi[ks], gi, 0, 0, 0); gi = __builtin_amdgcn_mfma_f32_32x32x16_bf16(wsm, zfr[ks], gi, 0, 0, 0); }
                __builtin_amdgcn_sched_barrier(0);
#pragma unroll
                for (int i = 0; i < 16; ++i) { const int cl = crow(i, h), c = 32 * rbc + cl; const float ang = (float)(bp * c) * (6.283185307179586f / 8192.f), cs = __cosf(ang), sn = __sinf(ang);
                    const float re = gr[i] * cs + gi[i] * sn, im = gi[i] * cs - gr[i] * sn;
                    sre[cl * 40 + r] = (bf16)f2bf(re); sim[cl * 40 + r] = (bf16)f2bf(im);
                    if ((i & 3) == 3) __builtin_amdgcn_sched_barrier(0); }
                asm volatile("" ::: "memory"); __builtin_amdgcn_wave_barrier(); asm volatile("" ::: "memory");
#pragma unroll
                for (int k = 0; k < 2; ++k) { const int cl = 16 * k + (F.lane >> 2), pc = F.lane & 3;
                    const u32x4 wre = *(const LAS u32x4*)(sre + cl * 40 + 8 * pc), wim = *(const LAS u32x4*)(sim + cl * 40 + 8 * pc);
                    bf16* o = Gb + (size_t)((b * FN1 + 32 * rbc + cl) * FN2 + bp) * 1024 + 32 * cbk + 8 * pc;
                    *(u32x4*)o = wre; *(u32x4*)(o + 512) = wim; }
                asm volatile("" ::: "memory"); __builtin_amdgcn_wave_barrier(); asm volatile("" ::: "memory");
            }
        }
    }
    __syncthreads();
}
__device__ __forceinline__ void phase_fft2_mfma(Frame& F) {
    __syncthreads();
    LAS bf16* t2 = (LAS bf16*)F.lds;
    for (int i = F.tid; i < 128 * 256; i += NTHR) { const int d = i >> 8, k = i & 255; const float ang = (float)((d * (k & 127)) & 127) * (6.283185307179586f / 128.f);
        t2[d * F2_P + k] = (bf16)f2bf(k < 128 ? __cosf(ang) : __sinf(ang)); }
    __syncthreads();
    const bf16* Gb = (const bf16*)(F.ws + WS_G); bf16* MIX = (bf16*)(F.ws + WS_MIX);
    const int r = F.lane & 31, h = F.lane >> 5;
    for (int item = F.wg; item < NB * FN1; item += F.G) {
        const int b = item >> 6, c = item & 63;
        const bf16* Gp = Gb + (size_t)((b * FN1 + c) * FN2) * 1024 + 64 * F.wave + r;
        f32x16 y[4][2];
#pragma unroll
        for (int rb = 0; rb < 4; ++rb)
#pragma unroll
            for (int cb = 0; cb < 2; ++cb)
#pragma unroll
                for (int i = 0; i < 16; ++i) y[rb][cb][i] = 0.f;
        unsigned eA[2][8], eB[2][8], eC[2][8], eD[2][8];
#define F2_GATHER(dst, ks_) do { const bf16* p_ = Gp + (size_t)(16 * ((ks_) & 7) + 8 * h) * 1024 + ((ks_) >> 3) * 512; \
            _Pragma("unroll") for (int cb = 0; cb < 2; ++cb) _Pragma("unroll") for (int j = 0; j < 8; ++j) dst[cb][j] = p_[(size_t)j * 1024 + 32 * cb]; } while (0)
#define F2_MMA(src, ks_) do { bf16x8 bfr[2]; _Pragma("unroll") for (int cb = 0; cb < 2; ++cb) { \
                const u32x4 w = {src[cb][0] | (src[cb][1] << 16), src[cb][2] | (src[cb][3] << 16), src[cb][4] | (src[cb][5] << 16), src[cb][6] | (src[cb][7] << 16)}; bfr[cb] = __builtin_bit_cast(bf16x8, w); } \
            _Pragma("unroll") for (int rb = 0; rb < 4; ++rb) { const bf16x8 a = *(const LAS bf16x8*)(t2 + (32 * rb + r) * F2_P + 16 * (ks_) + 8 * h); \
                _Pragma("unroll") for (int cb = 0; cb < 2; ++cb) y[rb][cb] = __builtin_amdgcn_mfma_f32_32x32x16_bf16(a, bfr[cb], y[rb][cb], 0, 0, 0); } } while (0)
        F2_GATHER(eA, 0); F2_GATHER(eB, 1); F2_GATHER(eC, 2);
#pragma unroll 1
        for (int ks = 0; ks < 16; ks += 4) {
            F2_GATHER(eD, ks + 3);
            F2_MMA(eA, ks);
            if (ks + 4 < 16) F2_GATHER(eA, ks + 4);
            F2_MMA(eB, ks + 1);
            if (ks + 4 < 16) F2_GATHER(eB, ks + 5);
            F2_MMA(eC, ks + 2);
            if (ks + 4 < 16) F2_GATHER(eC, ks + 6);
            F2_MMA(eD, ks + 3);
        }
#undef F2_GATHER
#undef F2_MMA
        LAS bf16* so = (LAS bf16*)(F.lds + 128 * F2_P * 2 + F.wave * 4608);
#pragma unroll
        for (int rb = 0; rb < 4; ++rb) {
#pragma unroll
            for (int cb = 0; cb < 2; ++cb)
#pragma unroll
                for (int i = 0; i < 16; ++i) so[crow(i, h) * 72 + 32 * cb + r] = (bf16)f2bf(y[rb][cb][i] * (1.f / 1024.f));
            asm volatile("" ::: "memory"); __builtin_amdgcn_wave_barrier(); asm volatile("" ::: "memory");
#pragma unroll
            for (int k = 0; k < 4; ++k) { const int dl = 8 * k + (F.lane >> 3), pc = F.lane & 7;
                const u32x4 w = *(const LAS u32x4*)(so + dl * 72 + 8 * pc);
                *(u32x4*)(MIX + (size_t)(b * L + c + 64 * (32 * rb + dl)) * 1024 + 64 * F.wave + 8 * pc) = w; }
            asm volatile("" ::: "memory"); __builtin_amdgcn_wave_barrier(); asm volatile("" ::: "memory");
        }
    }
    __syncthreads();
}


typedef float f32x2_t __attribute__((ext_vector_type(2)));
template <int IR> struct DwIn {
    static __device__ __forceinline__ void run(const unsigned (&uin)[62], const f32x2_t (&w)[31], f32x2_t (&o)[32]) {
        const f32x2_t x = {bflo(uin[IR]), bfhi(uin[IR])};
#pragma unroll
        for (int r = 0; r < 32; ++r) { if (IR - r >= 0 && IR - r <= 30) o[r] += w[(IR - r >= 0 && IR - r <= 30) ? IR - r : 0] * x; }
        DwIn<IR + 1>::run(uin, w, o);
    }
};
template <> struct DwIn<62> { static __device__ __forceinline__ void run(const unsigned (&)[62], const f32x2_t (&)[31], f32x2_t (&)[32]) {} };
template <int IR> struct DwIn16 {
    static __device__ __forceinline__ void run(const unsigned (&uin)[46], const f32x2_t (&w)[31], f32x2_t (&o)[16]) {
        const f32x2_t x = {bflo(uin[IR]), bfhi(uin[IR])};
#pragma unroll
        for (int r = 0; r < 16; ++r) { if (IR - r >= 0 && IR - r <= 30) o[r] += w[(IR - r >= 0 && IR - r <= 30) ? IR - r : 0] * x; }
        DwIn16<IR + 1>::run(uin, w, o);
    }
};
template <> struct DwIn16<46> { static __device__ __forceinline__ void run(const unsigned (&)[46], const f32x2_t (&)[31], f32x2_t (&)[16]) {} };
__device__ __forceinline__ void phase_dwconv_fast(Frame& F) {
    const bf16* U = (const bf16*)(F.ws + WS_U); bf16* V1 = (bf16*)(F.ws + WS_V1);
    const float* dww = F.in[I_DWW];
    const int c0 = 2 * F.tid;
    f32x2_t w[31];
#pragma unroll
    for (int j = 0; j < 31; ++j) w[j] = *(const f32x2_t*)(dww + (size_t)j * D + c0);
    const f32x2_t bb = *(const f32x2_t*)(F.in[I_DWB] + c0), gg = *(const f32x2_t*)(F.in[I_LNG] + c0), lb = *(const f32x2_t*)(F.in[I_LNB] + c0);
    LAS float* red = (LAS float*)F.lds;
    LAS float* stat = red + 16 * 8 * 2;
    __syncthreads();
    for (int run = F.wg; run < T / 128; run += F.G) {
        const int row0 = run * 128, l0 = row0 & (L - 1);
        unsigned uin[46], nx[16];
#pragma unroll
        for (int ir = 0; ir < 46; ++ir) { const int l = l0 - 15 + ir; const bool ok = (l >= 0 && l < L);
            const unsigned u = *(const unsigned*)(U + (size_t)(ok ? row0 - 15 + ir : row0) * D + c0); uin[ir] = ok ? u : 0u; }
#pragma unroll 1
        for (int step = 0; step < 8; ++step) {
            const int r0 = row0 + 16 * step;
            if (step < 7) {
#pragma unroll
                for (int j = 0; j < 16; ++j) { const int l = l0 + 16 * step + 31 + j; const bool ok = l < L;
                    const unsigned u = *(const unsigned*)(U + (size_t)(ok ? r0 + 31 + j : r0) * D + c0); nx[j] = ok ? u : 0u; }
            }
            f32x2_t o[16];
#pragma unroll
            for (int r = 0; r < 16; ++r) o[r] = bb;
            DwIn16<0>::run(uin, w, o);
            {
                float W[16], X[8], Y[4], Z2[2];
#pragma unroll
                for (int i = 0; i < 16; ++i) W[i] = swap32_add(o[i].x + o[i].y, o[i].x * o[i].x + o[i].y * o[i].y);
#pragma unroll
                for (int i = 0; i < 8; ++i) X[i] = swap16_add(W[2 * i], W[2 * i + 1]);
                const bool b3 = (F.lane & 8) != 0, b2 = (F.lane & 4) != 0, b1 = (F.lane & 2) != 0;
#pragma unroll
                for (int i = 0; i < 4; ++i) Y[i] = sel_add<0x140>(X[2 * i], X[2 * i + 1], b3);
#pragma unroll
                for (int i = 0; i < 2; ++i) Z2[i] = sel_add<0x141>(Y[2 * i], Y[2 * i + 1], b2);
                float Z = sel_add<0x4E>(Z2[0], Z2[1], b1);
                Z += dppf<0xB1>(Z);
                const int rr = ((F.lane >> 4) & 1) + ((F.lane >> 3) & 1) * 2 + ((F.lane >> 2) & 1) * 4 + ((F.lane >> 1) & 1) * 8;
                if (!(F.lane & 1)) red[(rr * 8 + F.wave) * 2 + (F.lane >> 5)] = Z;
            }
            __syncthreads();
            if (F.tid < 16) { float sm = 0.f, sq = 0.f;
#pragma unroll
                for (int wv = 0; wv < 8; ++wv) { sm += red[(F.tid * 8 + wv) * 2]; sq += red[(F.tid * 8 + wv) * 2 + 1]; }
                const float mean = sm * (1.f / D), var = fmaxf(sq * (1.f / D) - mean * mean, 0.f);
                stat[2 * F.tid] = mean; stat[2 * F.tid + 1] = rsqrtf(var + EPS); }
            __syncthreads();
#pragma unroll
            for (int r = 0; r < 16; ++r) { const float mean = stat[2 * r], rstd = stat[2 * r + 1];
                const f32x2_t A = gg * rstd, B = lb - A * mean, y = o[r] * A + B;
                *(unsigned*)(V1 + (size_t)(r0 + r) * D + c0) = pkbf(silu_f(y.x), silu_f(y.y)); }
#pragma unroll
            for (int i = 0; i < 30; ++i) uin[i] = uin[i + 16];
#pragma unroll
            for (int j = 0; j < 16; ++j) uin[30 + j] = nx[j];
        }
        __syncthreads();
    }
}

namespace pg {
struct MU { const char* B; const char* A; int K, type, e, rt, pn, hb, buf; };
struct MoeMergedSched {
    const char* Wgu; const char* Wdn; const char* HBp; const char* HIDp; const int* list; const float* wlist; LAS int* mm; unsigned* tcnt; unsigned* tmo; int G, c, U;
    __device__ __forceinline__ bool flat(int L, int type, MU& u) const {
        for (int e = 0; e < 16; ++e) { const int n = mm[e], nu = ((n + 255) >> 8) * 4;
            if (L < nu) { u.e = e; u.rt = L >> 2; u.pn = L & 3; u.hb = mm[16 + e]; u.type = type; u.buf = 0;
                if (type == 0) { u.K = D; u.A = HBp; u.B = Wgu + (size_t)e * (1024 * 1024 * 2) + (size_t)u.pn * BM * D * 2; }
                else { u.K = FF; u.A = HIDp; u.B = Wdn + (size_t)e * (1024 * 512 * 2) + (size_t)u.pn * BM * FF * 2; }
                return true; }
            L -= nu; }
        return false;
    }
    __device__ __forceinline__ bool next(int i, MU& u) const {
        const int ngu = c < U ? (U - 1 - c) / G + 1 : 0;
        if (i < ngu) return flat(i * G + c, 0, u);
        const int k = i - ngu, x = U % G; int j;
        if (c >= x) { if (k == 0) j = c - x; else j = (G - 1 - c) + (k - 1) * G + (G - x); } else j = (G - 1 - c) + k * G + (G - x);
        if (j >= U) return false;
        return flat(j, 1, u);
    }
    __device__ __forceinline__ unsigned voff(const MU& u, int buf, LAS unsigned char* lds, int R, int C) const {
        if (u.type == 0) { const int tok = ((const LAS int*)(lds + TAB_OFF))[buf * 256 + R]; return (unsigned)((tok * D + C) * 2); }
        return (unsigned)(((u.hb + u.rt * BM + R) * FF + C) * 2);
    }
    __device__ __forceinline__ void stage_table(const MU& u, int buf, LAS unsigned char* lds, int wid, int lane) const {
        const int r = (wid & 3) * 64 + lane;
        __builtin_amdgcn_global_load_lds((const unsigned*)(list + u.e * CAP + u.rt * BM + r), (LAS unsigned*)(lds + TAB_OFF + buf * 1024 + (wid & 3) * 256), 4, 0, 0);
        __builtin_amdgcn_global_load_lds((const unsigned*)(wlist + u.e * CAP + u.rt * BM + r), (LAS unsigned*)(lds + TAB_OFF + 2048 + buf * 1024 + (wid & 3) * 256), 4, 0, 0);
    }
    __device__ __forceinline__ unsigned* tile_word(const MU& u) const { return tcnt + ((u.hb >> 8) + u.rt) * 64; }
    __device__ __forceinline__ void wait_ready(const MU& u, int wid) const {
        if (wid == 0) {
            unsigned* w = tile_word(u); unsigned spins = 0;
            while ((unsigned)__builtin_amdgcn_readfirstlane(__hip_atomic_load(w, __ATOMIC_RELAXED, __HIP_MEMORY_SCOPE_AGENT)) < 32u) {
                __builtin_amdgcn_s_sleep(2);
                if ((++spins & 255u) == 0u) { if (__builtin_amdgcn_readfirstlane(__hip_atomic_load(tmo, __ATOMIC_RELAXED, __HIP_MEMORY_SCOPE_AGENT)) != 0u) break;
                    if (spins > (1u << 20)) { __hip_atomic_store(tmo, 1u, __ATOMIC_RELAXED, __HIP_MEMORY_SCOPE_AGENT); break; } } }
        }
        asm volatile("" ::: "memory"); __builtin_amdgcn_s_barrier(); asm volatile("" ::: "memory");
    }
};
struct EpiGateUpWT {
    __amdgpu_buffer_rsrc_t rsrc; LAS unsigned char* lds; LAS int* mm;
    __device__ __forceinline__ void operator()(const f32x4 (&acc)[2][2][4][2], const MU& u, int wr, int wc, int fr, int fq) const {
        const int e = u.e, n_e = mm[e], r0 = u.rt * BM + wr * 64 + fr, col0 = u.pn * HALF + wc * 32 + 8 * fq;
        float wv[2][4];
#pragma unroll
        for (int ai = 0; ai < 2; ++ai)
#pragma unroll
            for (int m = 0; m < 4; ++m) wv[ai][m] = ((const LAS float*)(lds + TAB_OFF + 2048))[u.buf * 256 + wr * 64 + fr + ai * HALF + m * 16];
#pragma unroll
        for (int ai = 0; ai < 2; ++ai)
#pragma unroll
            for (int m = 0; m < 4; ++m) { const int r = r0 + ai * HALF + m * 16;
                if (r < n_e) { const float w = wv[ai][m]; f32x4 o[2];
#pragma unroll
                    for (int n = 0; n < 2; ++n) { const f32x4 g = acc[ai][0][m][n], up = acc[ai][1][m][n];
#pragma unroll
                        for (int j = 0; j < 4; ++j) o[n][j] = w * silu_f(g[j]) * up[j]; }
                    u32x4 q; q.x = cvt_pk_bf16(o[0][0], o[0][1]); q.y = cvt_pk_bf16(o[0][2], o[0][3]); q.z = cvt_pk_bf16(o[1][0], o[1][1]); q.w = cvt_pk_bf16(o[1][2], o[1][3]);
                    __builtin_amdgcn_raw_buffer_store_b128(q, rsrc, (unsigned)(((u.hb + r) * FF + col0) * 2), 0, 16); } }
    }
};
struct EpiDownM {
    unsigned char* Y8; LAS int* mm;
    __device__ __forceinline__ void operator()(const f32x4 (&acc)[2][2][4][2], const MU& u, int wr, int wc, int fr, int fq) const {
        const int e = u.e, n_e = mm[e], r0 = u.rt * BM + wr * 64 + fr, col0 = u.pn * BM + 64 * wc + 16 * fq;
#pragma unroll
        for (int ai = 0; ai < 2; ++ai)
#pragma unroll
            for (int m = 0; m < 4; ++m) { const int r = r0 + ai * HALF + m * 16;
                if (r < n_e) { u32x4 q; q.x = pk_fp8x4(acc[ai][0][m][0]); q.y = pk_fp8x4(acc[ai][0][m][1]); q.z = pk_fp8x4(acc[ai][1][m][0]); q.w = pk_fp8x4(acc[ai][1][m][1]);
                    *(u32x4*)(Y8 + (size_t)(u.hb + r) * D + col0) = q; } }
    }
};
__device__ __forceinline__ void gemm_phase_moe(LAS unsigned char* lds, const MoeMergedSched& S, const EpiGateUpWT& EA, const EpiDownM& EB) {
    const int tid = threadIdx.x, wid = __builtin_amdgcn_readfirstlane(tid >> 6), lane = tid & 63, wr = wid >> 2, wc = wid & 3, fr = lane & 15, fq = lane >> 4;
    int sR[2], sC[2]; unsigned vbA[2], vbD[2];
#pragma unroll
    for (int i = 0; i < 2; ++i) { int R, C; stage_rc(tid * 16 + i * 8192, R, C); sR[i] = R; sC[i] = C; const int Rb = (R & ~31) + perm32(R & 31);
        const int RbD = 64 * ((Rb >> 5) & 3) + 16 * ((Rb >> 3) & 3) + (Rb & 7);
        vbA[i] = (unsigned)(Rb * D + C) * 2u; vbD[i] = (unsigned)(RbD * FF + C) * 2u; }
    const size_t kstep = (size_t)(BK * 2);
    const unsigned ldsw = (unsigned)wid * 1024u;
    const int aoff = lds_byte(wr * 64 + fr, fq * 8), boff = lds_byte(wc * 32 + fr, fq * 8);
#define PG_SA(b, h) (((b) * 2 + (h)) * HTB)
#define PG_SB(b, h) ((4 + (b) * 2 + (h)) * HTB)
#define PG_STAGE(bufoff, gbase, voff) do { _Pragma("unroll") for (int _i = 0; _i < 2; ++_i) \
        __builtin_amdgcn_global_load_lds((const unsigned*)((const char*)(gbase) + (voff)[_i]), (LAS unsigned*)(lds + (bufoff) + ldsw + _i * 8192), 16, 0, 0); } while (0)
#define PG_LDA(dst, b, h) do { _Pragma("unroll") for (int m = 0; m < 4; ++m) _Pragma("unroll") for (int k = 0; k < 2; ++k) dst[m][k] = *(const LAS bf16x8*)(lds + PG_SA(b, h) + aoff + m * 2048 + k * 1024); } while (0)
#define PG_LDB(dst, b, h) do { _Pragma("unroll") for (int n = 0; n < 2; ++n) _Pragma("unroll") for (int k = 0; k < 2; ++k) dst[n][k] = *(const LAS bf16x8*)(lds + PG_SB(b, h) + boff + n * 2048 + k * 1024); } while (0)
#define PG_MMA(ai, bj, At, Bt) do { __builtin_amdgcn_s_setprio(1); _Pragma("unroll") for (int m = 0; m < 4; ++m) _Pragma("unroll") for (int n = 0; n < 2; ++n) _Pragma("unroll") for (int k = 0; k < 2; ++k) \
        acc[ai][bj][m][n] = __builtin_amdgcn_mfma_f32_16x16x32_bf16(Bt[n][k], At[m][k], acc[ai][bj][m][n], 0, 0, 0); __builtin_amdgcn_s_setprio(0); } while (0)
#define PG_WAIT_V(n) asm volatile("s_waitcnt vmcnt(" #n ")" ::: "memory")
#define PG_WAIT_L(n) asm volatile("s_waitcnt lgkmcnt(" #n ")" ::: "memory")
#define PG_BAR __builtin_amdgcn_s_barrier()
#define PG_SCHED __builtin_amdgcn_sched_barrier(0)
    MU cur, nxt; int ui = 0;
    if (!S.next(0, cur)) return;
    cur.buf = 0;
    f32x4 acc[2][2][4][2];
#pragma unroll
    for (int a = 0; a < 2; ++a)
#pragma unroll
        for (int b = 0; b < 2; ++b)
#pragma unroll
            for (int m = 0; m < 4; ++m)
#pragma unroll
                for (int n = 0; n < 2; ++n) acc[a][b][m][n] = (f32x4){0.f, 0.f, 0.f, 0.f};
    bf16x8 At[4][2], B0[2][2], B1[2][2];
    if (cur.type == 0) { S.stage_table(cur, 0, lds, wid, lane); PG_WAIT_V(0); PG_BAR; } else S.wait_ready(cur, wid);
    unsigned voC[2][2], voN[2][2];
#pragma unroll
    for (int h = 0; h < 2; ++h)
#pragma unroll
        for (int i = 0; i < 2; ++i) { voC[h][i] = S.voff(cur, 0, lds, h * HALF + sR[i], sC[i]); voN[h][i] = voC[h][i]; }
    const char* cB = cur.B; const char* cA = cur.A; size_t hsC = (size_t)(cur.type == 0 ? HALF : 8) * cur.K * 2; int nt = cur.K / BK;
    if (cur.type == 0) { PG_STAGE(PG_SB(0, 0), cB, vbA); PG_STAGE(PG_SB(0, 1), cB + hsC, vbA); } else { PG_STAGE(PG_SB(0, 0), cB, vbD); PG_STAGE(PG_SB(0, 1), cB + hsC, vbD); }
    PG_STAGE(PG_SA(0, 0), cA, voC[0]); PG_STAGE(PG_SA(0, 1), cA, voC[1]);
    if (wr == 1) PG_BAR;
    PG_WAIT_V(2); PG_BAR;
    if (cur.type == 0) { PG_STAGE(PG_SB(1, 0), cB + kstep, vbA); } else { PG_STAGE(PG_SB(1, 0), cB + kstep, vbD); }
    PG_STAGE(PG_SA(1, 0), cA + kstep, voC[0]);
    if (cur.type == 0) { PG_STAGE(PG_SB(1, 1), cB + hsC + kstep, vbA); } else { PG_STAGE(PG_SB(1, 1), cB + hsC + kstep, vbD); }
    PG_WAIT_V(6); PG_BAR;
    for (;;) {
        const bool has_next = S.next(ui + 1, nxt); nxt.buf = (ui + 1) & 1;
        if (has_next && nxt.type == 0) S.stage_table(nxt, (ui + 1) & 1, lds, wid, lane);
        const char* nB = has_next ? nxt.B : cB; const char* nA = has_next ? nxt.A : cA; const size_t hsN = has_next ? (size_t)(nxt.type == 0 ? HALF : 8) * nxt.K * 2 : hsC;
        for (int t = 0; t < nt; t += 2) {
            const bool last = (t == nt - 2);
            if (last && has_next) {
                if (nxt.type == 1) S.wait_ready(nxt, wid);
#pragma unroll
                for (int h = 0; h < 2; ++h)
#pragma unroll
                    for (int i = 0; i < 2; ++i) voN[h][i] = S.voff(nxt, (ui + 1) & 1, lds, h * HALF + sR[i], sC[i]);
            }
            unsigned vo2[2][2], vb2[2]; const bool b2gu = last ? (has_next ? nxt.type == 0 : cur.type == 0) : (cur.type == 0);
#pragma unroll
            for (int h = 0; h < 2; ++h)
#pragma unroll
                for (int i = 0; i < 2; ++i) vo2[h][i] = last ? voN[h][i] : voC[h][i];
#pragma unroll
            for (int i = 0; i < 2; ++i) vb2[i] = b2gu ? vbA[i] : vbD[i];
            const size_t hs2 = last ? hsN : hsC;
            const char* a1 = cA + (size_t)(t + 1) * kstep;
            const char* a2 = last ? nA : cA + (size_t)(t + 2) * kstep; const char* b2 = last ? nB : cB + (size_t)(t + 2) * kstep;
            const char* a3 = a2 + kstep; const char* b3 = b2 + kstep;
            PG_LDB(B0, 0, 0); PG_LDB(B1, 0, 1); PG_SCHED; PG_LDA(At, 0, 0); PG_STAGE(PG_SA(1, 1), a1, voC[1]);
            PG_WAIT_V(8); PG_WAIT_L(0); PG_BAR; PG_MMA(0, 0, At, B0); PG_MMA(0, 1, At, B1); PG_BAR; PG_SCHED;
            PG_LDA(At, 0, 1); PG_STAGE(PG_SB(0, 0), b2, vb2); PG_STAGE(PG_SB(0, 1), b2 + hs2, vb2); PG_STAGE(PG_SA(0, 0), a2, vo2[0]);
            PG_WAIT_V(8); PG_WAIT_L(0); PG_BAR; PG_MMA(1, 0, At, B0); PG_MMA(1, 1, At, B1); PG_BAR; PG_SCHED;
            PG_LDB(B0, 1, 0); PG_LDB(B1, 1, 1); PG_SCHED; PG_LDA(At, 1, 0); PG_STAGE(PG_SA(0, 1), a2, vo2[1]);
            PG_WAIT_V(8); PG_WAIT_L(0); PG_BAR; PG_MMA(0, 0, At, B0); PG_MMA(0, 1, At, B1); PG_BAR; PG_SCHED;
            PG_LDA(At, 1, 1); PG_STAGE(PG_SB(1, 0), b3, vb2); PG_STAGE(PG_SB(1, 1), b3 + hs2, vb2); PG_STAGE(PG_SA(1, 0), a3, vo2[0]);
            PG_WAIT_V(8); PG_WAIT_L(0); PG_BAR; PG_MMA(1, 0, At, B0); PG_MMA(1, 1, At, B1); PG_BAR; PG_SCHED;
        }
        if (wr == 0) PG_BAR;
        if (cur.type == 0) { EA(acc, cur, wr, wc, fr, fq);
            PG_WAIT_V(0);
            if (lane == 0) __hip_atomic_fetch_add(S.tile_word(cur), 1u, __ATOMIC_RELAXED, __HIP_MEMORY_SCOPE_AGENT); }
        else EB(acc, cur, wr, wc, fr, fq);
        if (!has_next) break;
#pragma unroll
        for (int a = 0; a < 2; ++a)
#pragma unroll
            for (int b = 0; b < 2; ++b)
#pragma unroll
                for (int m = 0; m < 4; ++m)
#pragma unroll
                    for (int n = 0; n < 2; ++n) acc[a][b][m][n] = (f32x4){0.f, 0.f, 0.f, 0.f};
        cur = nxt; cB = nB; cA = nA; hsC = hsN; nt = cur.K / BK; ++ui;
#pragma unroll
        for (int h = 0; h < 2; ++h)
#pragma unroll
            for (int i = 0; i < 2; ++i) voC[h][i] = voN[h][i];
        if (wr == 1) PG_BAR;
    }
    PG_WAIT_V(0);
    PG_BAR;
#undef PG_SA
#undef PG_SB
#undef PG_STAGE
#undef PG_LDA
#undef PG_LDB
#undef PG_MMA
#undef PG_WAIT_V
#undef PG_WAIT_L
#undef PG_BAR
#undef PG_SCHED
}
}
__device__ __forceinline__ void fast_moe_merged(Frame& F, int layer) {
    LAS int* mm = moe_map(F, layer);
    int U = 0;
    for (int e = 0; e < 16; ++e) U += ((mm[e] + 255) >> 8) * 4;
    pg::MoeMergedSched S{(const char*)(F.ws + WS_WGU) + (size_t)layer * 16 * 1024 * 1024 * 2, (const char*)(F.ws + WS_WDN) + (size_t)layer * 16 * 1024 * 512 * 2,
                         (const char*)(F.ws + WS_HB), (const char*)(F.ws + WS_HID), (const int*)(F.ws + WS_SLOTT) + layer * 16 * CAP, (const float*)(F.ws + WS_SLOTW) + layer * 16 * CAP, mm,
                         F.ctl + CW_TILE + layer * 288 * 64, F.ctl + CW_TMO2, F.G, F.wg, U};
    pg::EpiGateUpWT EA{__builtin_amdgcn_make_buffer_rsrc((void*)(F.ws + WS_HID), 0, HROWS * FF * 2, 0x00020000), F.lds, mm};
    pg::EpiDownM EB{(unsigned char*)(F.ws + WS_Y), mm};
    pg::gemm_phase_moe(F.lds, S, EA, EB);
}

constexpr int NPH = 18;
__global__ void __launch_bounds__(NTHR, 2) mega(Args args) {
    extern __shared__ __attribute__((aligned(16))) unsigned char lds[];
    Frame F;
    F.lds = (LAS unsigned char*)lds;
    F.tid = threadIdx.x; F.lane = F.tid & 63; F.wave = __builtin_amdgcn_readfirstlane(F.tid >> 6);
    F.G = gridDim.x; F.wg = blockIdx.x;
    F.out = args.out; F.ws = args.ws; F.ctl = (unsigned*)(args.ws + WS_CTL);
    volatile LAS unsigned* bst = (volatile LAS unsigned*)(F.lds + LDS_BYTES - 16);
    if (F.tid < 4) bst[F.tid] = 0u;
    __syncthreads();
    const int lo = args.ph_lo, hi = args.ph_hi;
    XcdBarrier bar; bar.bar = F.ctl + CW_BAR; bar.x = 0; bar.st = bst;
    if (hi - lo > 1) bar = xcd_barrier_post(F.ctl + CW_BAR, bst);
#define IN(k) (lo <= (k) && (k) < hi)
#define SEAM(k) do { if (IN(k) && IN((k) + 1)) xcd_barrier(bar); } while (0)
    const float* mod = (const float*)(F.ws + WS_MOD);

#ifndef DBL_MASK
#define DBL_MASK 0x0u
#endif
#define RUN(k, body) do { if (IN(k)) { _Pragma("unroll 1") for (int _r = 0; _r < ((((DBL_MASK) >> (k)) & 1u) ? 2 : 1); ++_r) { if (_r) xcd_barrier(bar); F.lane = fresh_lane(); body; } } } while (0)
    RUN(0, phase_prep(F)); SEAM(0);
    RUN(1, phase_norm1_l0(F)); SEAM(1);
    RUN(2, if (FAST_GEMM) fast_inproj(F); else phase_inproj(F)); SEAM(2);
    if (IN(3)) { F.lane = fresh_lane();
#pragma unroll 1
        for (int _r = 0; _r < ((DBL_MASK & 0x100000u) ? 2 : 1); ++_r) { if (FAST_ATTN == 2 && FAST_GEMM) phase_attn_lds(F); else if (FAST_ATTN && FAST_GEMM) phase_attn_mfma(F); else phase_attn_simple(F); }
#pragma unroll 1
        for (int _r = 0; _r < ((DBL_MASK & 0x200000u) ? 2 : 1); ++_r) { if (FAST_FFT) phase_fft1_mfma(F); else phase_fft1_simple(F); }
    } SEAM(3);
    RUN(4, if (FAST_FFT) phase_fft2_mfma(F); else phase_fft2_simple(F)); SEAM(4);
    if (IN(5)) { if (!FAST_FFT) phase_fft3_simple(F); } if (!FAST_FFT) SEAM(5);
    RUN(6, if (FAST_GEMM) fast_outproj(F, WS_MIX, WS_WOUT, F.in[I_X], F.out, mod + 2048, nullptr); else phase_outproj(F, (const bf16*)(F.ws + WS_MIX), (const bf16*)(F.ws + WS_WOUT), F.in[I_X], F.out, mod + 2048, nullptr)); SEAM(6);
    if (IN(7)) { F.lane = fresh_lane(); if (XBF16) phase_norm2_route_mfma(F, 0); else phase_norm2_route(F, 0); } SEAM(7);
    if (MOE_MERGED && FAST_GEMM) { if (IN(8)) { F.lane = fresh_lane(); fast_moe_merged(F, 0); } if (IN(8) && IN(10)) xcd_barrier(bar); }
    else { RUN(8, if (FAST_GEMM) fast_moe_gateup(F, 0); else phase_moe_gateup(F, 0)); SEAM(8);
    RUN(9, if (FAST_GEMM) fast_moe_down(F, 0); else phase_moe_down(F, 0)); SEAM(9); }
    if (IN(10)) { F.lane = fresh_lane(); phase_combine<false>(F, 0); } SEAM(10);
    RUN(11, if (FAST_GEMM) fast_pw1(F); else phase_pw1(F)); SEAM(11);
    RUN(12, phase_dwconv_fast(F)); SEAM(12);
    if (IN(13)) { F.lane = fresh_lane(); if (FAST_GEMM) fast_outproj(F, WS_V1, WS_WPW2, F.out, F.out, mod + 5 * 6144 + 2048, F.in[I_PW2B]); else phase_outproj(F, (const bf16*)(F.ws + WS_V1), (const bf16*)(F.ws + WS_WPW2), F.out, F.out, mod + 5 * 6144 + 2048, F.in[I_PW2B]); } SEAM(13);
    if (IN(14)) { F.lane = fresh_lane(); if (XBF16) phase_norm2_route_mfma(F, 1); else phase_norm2_route(F, 1); } SEAM(14);
    if (MOE_MERGED && FAST_GEMM) { if (IN(15)) { F.lane = fresh_lane(); fast_moe_merged(F, 1); } if (IN(15) && IN(17)) xcd_barrier(bar); }
    else { RUN(15, if (FAST_GEMM) fast_moe_gateup(F, 1); else phase_moe_gateup(F, 1)); SEAM(15);
    RUN(16, if (FAST_GEMM) fast_moe_down(F, 1); else phase_moe_down(F, 1)); SEAM(16); }
    if (IN(17)) { F.lane = fresh_lane(); phase_combine<true>(F, 1); }
#undef RUN
#undef IN
#undef SEAM
}

extern "C" void kernel_launch(void* const* d_in, const int* in_sizes, int n_in, void* d_out, int out_size, void* d_ws, size_t ws_size, hipStream_t stream) {
    static int grid = 0;
    if (grid == 0) {
        if (n_in != 25 || out_size != T * D || ws_size < WS_END) { fprintf(stderr, "kernel_launch: unexpected shapes (n_in %d out %d ws %zu)\n", n_in, out_size, ws_size); grid = -1; return; }
        int dev = 0, cus = 0, per_cu = 0;
        if (hipGetDevice(&dev) != hipSuccess || hipDeviceGetAttribute(&cus, hipDeviceAttributeMultiprocessorCount, dev) != hipSuccess) { grid = -1; return; }
        if (hipFuncSetAttribute((const void*)mega, hipFuncAttributeMaxDynamicSharedMemorySize, LDS_BYTES) != hipSuccess) { fprintf(stderr, "kernel_launch: hipFuncSetAttribute failed\n"); grid = -1; return; }
        if (hipOccupancyMaxActiveBlocksPerMultiprocessor(&per_cu, (const void*)mega, NTHR, LDS_BYTES) != hipSuccess || per_cu < 1) { fprintf(stderr, "kernel_launch: occupancy query says %d\n", per_cu); }
        (void)hipGetLastError();
        grid = cus;
    }
    if (grid < 0) return;
    (void)hipMemsetAsync((char*)d_ws + WS_CTL, 0, CTL_BYTES, stream);
    Args a{};
    for (int i = 0; i < 25; ++i) a.in[i] = (const float*)d_in[i];
    a.out = (float*)d_out; a.ws = (unsigned char*)d_ws;
#if MK_ONE_LAUNCH
    a.ph_lo = 0; a.ph_hi = NPH;
    hipLaunchKernelGGL(mega, dim3(grid), dim3(NTHR), LDS_BYTES, stream, a);
#else
#ifndef PROBE_PHASE
#define PROBE_PHASE -1
#endif
    for (int p = 0; p < NPH; ++p) { a.ph_lo = p; a.ph_hi = p + 1; hipLaunchKernelGGL(mega, dim3(grid), dim3(NTHR), LDS_BYTES, stream, a);
        if (p == PROBE_PHASE) { if (p == 7 || p == 14) (void)hipMemsetAsync((char*)d_ws + WS_CTL, 0, CTL_BYTES, stream);
            hipLaunchKernelGGL(mega, dim3(grid), dim3(NTHR), LDS_BYTES, stream, a); } }
#endif
}
```

```cpp
#include <hip/hip_runtime.h>
#include <cstdio>

#ifndef MK_ONE_LAUNCH
#define MK_ONE_LAUNCH 1
#endif

#define GAS __attribute__((address_space(1)))
#define LAS __attribute__((address_space(3)))
typedef unsigned short bf16;
typedef short bf16x8 __attribute__((ext_vector_type(8)));
typedef float f32x4 __attribute__((ext_vector_type(4)));
typedef float f32x16 __attribute__((ext_vector_type(16)));
typedef unsigned u32x4 __attribute__((ext_vector_type(4)));
typedef unsigned u32x2 __attribute__((ext_vector_type(2)));

constexpr int D = 1024, NB = 4, L = 8192, T = NB * L, CL = 256, TC = NB * CL;
constexpr int NE = 16, FF = 512, CONVW = 31;
constexpr int N_IN = 1280;
constexpr int FN1 = 64, FN2 = 128;
#ifndef FAST_GEMM
#define FAST_GEMM 1
#endif
#ifndef MOE_MERGED
#define MOE_MERGED 1
#endif
#ifndef XBF16
#define XBF16 FAST_GEMM
#endif
#ifndef FAST_ATTN
#define FAST_ATTN 2
#endif
#ifndef FAST_FFT
#define FAST_FFT 1
#endif
constexpr int IL = FAST_GEMM ? 128 : 32;
constexpr float EPS = 1e-6f;
constexpr int NWAVES = 8, NTHR = 512;
constexpr int CAP = 32768;
constexpr int HROWS = 65536 + 4096;

constexpr size_t MiB = 1u << 20;
constexpr size_t WS_CTL = 0, CTL_BYTES = 1 * MiB;
constexpr size_t WS_MOD = 1 * MiB;
constexpr size_t WS_TW = 1 * MiB + 512 * 1024;
constexpr size_t WS_WIN = 2 * MiB, WS_WOUT = 6 * MiB, WS_WPW1 = 10 * MiB, WS_WPW2 = 14 * MiB;
constexpr size_t WS_WGU = 16 * MiB, WS_WDN = 80 * MiB;
constexpr size_t WS_TOKE = 112 * MiB, WS_TOKP = 113 * MiB, WS_TOKW = 114 * MiB;
constexpr size_t WS_SLOTT = 116 * MiB, WS_SLOTW = 120 * MiB;
constexpr size_t WS_HB = 128 * MiB;
constexpr size_t WS_UF = 196 * MiB, WS_Q = 228 * MiB, WS_K = 260 * MiB, WS_V = 268 * MiB, WS_CK = 276 * MiB, WS_CV = 277 * MiB;
constexpr size_t WS_G = 280 * MiB, WS_MIX = 344 * MiB, WS_AB = 408 * MiB;
constexpr size_t WS_XB = 408 * MiB;
constexpr size_t WS_HID = 196 * MiB, WS_Y = 264 * MiB;
constexpr size_t WS_U = 196 * MiB, WS_V1 = 260 * MiB;
constexpr size_t WS_END = 472 * MiB;
constexpr int CW_BAR = 4096;
constexpr int CW_CNT = 8192;
constexpr int CW_TILE = 16384;
constexpr int CW_TMO2 = 2048;

constexpr int LDS_BYTES = 147456;

__device__ __forceinline__ unsigned f2bf(float f) { unsigned u = __float_as_uint(f); return (u + 0x7fffu + ((u >> 16) & 1u)) >> 16; }
__device__ __forceinline__ float bf2f(unsigned b) { return __uint_as_float(b << 16); }
typedef __bf16 b16x2_t __attribute__((ext_vector_type(2)));
__device__ __forceinline__ unsigned pkbf(float a, float b) { typedef float f2 __attribute__((ext_vector_type(2))); f2 v = {a, b}; return __builtin_bit_cast(unsigned, __builtin_convertvector(v, b16x2_t)); }
__device__ __forceinline__ unsigned pk2(float lo, float hi) { return pkbf(lo, hi); }
__device__ __forceinline__ float bflo(unsigned w) { return __uint_as_float(w << 16); }
__device__ __forceinline__ float bfhi(unsigned w) { return __uint_as_float(w & 0xffff0000u); }
__device__ __forceinline__ float wave_sum(float v) {
    v += __builtin_bit_cast(float, __builtin_amdgcn_mov_dpp(__builtin_bit_cast(int, v), 0xB1, 0xf, 0xf, true));
    v += __builtin_bit_cast(float, __builtin_amdgcn_mov_dpp(__builtin_bit_cast(int, v), 0x4E, 0xf, 0xf, true));
    v += __builtin_bit_cast(float, __builtin_amdgcn_mov_dpp(__builtin_bit_cast(int, v), 0x141, 0xf, 0xf, true));
    v += __builtin_bit_cast(float, __builtin_amdgcn_mov_dpp(__builtin_bit_cast(int, v), 0x140, 0xf, 0xf, true));
    const int iv = __builtin_bit_cast(int, v);
    const float a = __builtin_bit_cast(float, __builtin_amdgcn_readlane(iv, 15)), b = __builtin_bit_cast(float, __builtin_amdgcn_readlane(iv, 31));
    const float c = __builtin_bit_cast(float, __builtin_amdgcn_readlane(iv, 47)), d = __builtin_bit_cast(float, __builtin_amdgcn_readlane(iv, 63));
    return (a + b) + (c + d);
}
template <int CTRL> __device__ __forceinline__ float dppf(float v) { return __uint_as_float((unsigned)__builtin_amdgcn_update_dpp(0, (int)__float_as_uint(v), CTRL, 0xf, 0xf, true)); }
__device__ __forceinline__ float swap32_add(float a, float b) { const auto r = __builtin_amdgcn_permlane32_swap(__float_as_uint(a), __float_as_uint(b), false, false); return __uint_as_float(r[0]) + __uint_as_float(r[1]); }
__device__ __forceinline__ float swap16_add(float a, float b) { const auto r = __builtin_amdgcn_permlane16_swap(__float_as_uint(a), __float_as_uint(b), false, false); return __uint_as_float(r[0]) + __uint_as_float(r[1]); }
template <int CTRL> __device__ __forceinline__ float sel_add(float a, float b, bool hi) { const float t = hi ? b : a, u = hi ? a : b; return t + dppf<CTRL>(u); }
typedef __bf16 bf16x2_t __attribute__((ext_vector_type(2)));
__device__ __forceinline__ float dot2_bf16(unsigned w, unsigned x, float acc) { return __builtin_amdgcn_fdot2_f32_bf16(__builtin_bit_cast(bf16x2_t, w), __builtin_bit_cast(bf16x2_t, x), acc, false); }
__device__ __forceinline__ float silu_f(float x) { return x * __builtin_amdgcn_rcpf(1.f + __expf(-x)); }
__device__ __forceinline__ float sigmoid_f(float x) { return __builtin_amdgcn_rcpf(1.f + __expf(-x)); }
constexpr float YSCALE = 32.f;
__device__ __forceinline__ unsigned pk_fp8x4(f32x4 v) {
    int d = __builtin_amdgcn_cvt_pk_fp8_f32(__builtin_amdgcn_fmed3f(v[0] * YSCALE, -448.f, 448.f), __builtin_amdgcn_fmed3f(v[1] * YSCALE, -448.f, 448.f), 0, false);
    d = __builtin_amdgcn_cvt_pk_fp8_f32(__builtin_amdgcn_fmed3f(v[2] * YSCALE, -448.f, 448.f), __builtin_amdgcn_fmed3f(v[3] * YSCALE, -448.f, 448.f), d, true);
    return (unsigned)d;
}
__device__ __forceinline__ f32x4 un_fp8x4(unsigned d) { typedef float f2 __attribute__((ext_vector_type(2)));
    const f2 lo = __builtin_amdgcn_cvt_pk_f32_fp8((int)d, false), hi = __builtin_amdgcn_cvt_pk_f32_fp8((int)d, true); return (f32x4){lo.x, lo.y, hi.x, hi.y}; }
#define LDS_WAIT() asm volatile("s_waitcnt lgkmcnt(0)" ::: "memory")
__device__ __forceinline__ int fresh_lane() { int l; asm volatile("v_mbcnt_lo_u32_b32 %0, -1, 0\n\tv_mbcnt_hi_u32_b32 %0, -1, %0" : "=v"(l)); return l; }

#define XB_TMO      128
#define XB_XCNT(j)  (256  + 64 * (j))
#define XB_XSUB(j)  (1280 + 64 * (j))
#define XB_XGEN(j)  (2304 + 64 * (j))
#define XB_TOP      3328
#define XB_TOPGEN   3392
#define XCD_BAR_WORDS 3456
#define XB_SPIN_CAP (1u << 20)
__device__ __forceinline__ unsigned xb_ld(unsigned* p)              { return __hip_atomic_load(p, __ATOMIC_RELAXED, __HIP_MEMORY_SCOPE_AGENT); }
__device__ __forceinline__ unsigned xb_add(unsigned* p, unsigned v) { return __hip_atomic_fetch_add(p, v, __ATOMIC_RELAXED, __HIP_MEMORY_SCOPE_AGENT); }
__device__ __forceinline__ unsigned xb_xcc_id() { return (unsigned)__builtin_amdgcn_s_getreg((3 << 11) | 20) & 0xFu; }
#define XB_SPIN(cond, bar) do { unsigned _sp = 0; while (cond) { __builtin_amdgcn_s_sleep(1); \
    if ((++_sp & 255u) == 0u) { if (xb_ld(&(bar)[XB_TMO])) break; if (_sp > XB_SPIN_CAP) { atomicAdd(&(bar)[XB_TMO], 1u); break; } } } } while (0)
struct XcdBarrier { unsigned* bar; unsigned x; volatile LAS unsigned* st; };
__device__ __forceinline__ XcdBarrier xcd_barrier_post(unsigned* bar, volatile LAS unsigned* st) {
    XcdBarrier b; b.bar = bar; b.x = xb_xcc_id(); b.st = st;
    if (threadIdx.x == 0) (void)xb_add(&bar[XB_XCNT(b.x)], 1u);
    return b;
}
__device__ __forceinline__ void xcd_barrier_complete(unsigned* bar, unsigned x, unsigned& nloc, unsigned& nx) {
    const unsigned G = gridDim.x * gridDim.y * gridDim.z;
    unsigned sum, cnt, mine, sp = 0u;
    for (;;) {
        sum = 0u; cnt = 0u; mine = 0u;
#pragma unroll
        for (unsigned j = 0; j < 16; ++j) { const unsigned c = xb_ld(&bar[XB_XCNT(j)]); sum += c; cnt += (c > 0u) ? 1u : 0u; mine = (j == x) ? c : mine; }
        if (sum == G) break;
        __builtin_amdgcn_s_sleep(1);
        if ((++sp & 255u) == 0u) { if (xb_ld(&bar[XB_TMO])) break; if (sp > XB_SPIN_CAP) { atomicAdd(&bar[XB_TMO], 1u); break; } }
    }
    nloc = mine > 0u ? mine : 1u; nx = cnt > 0u ? cnt : 1u;
}
__device__ __forceinline__ void xcd_barrier(const XcdBarrier& b) {
    asm volatile("s_waitcnt vmcnt(0)" ::: "memory");
    __syncthreads();
    if (threadIdx.x == 0) {
        unsigned* bar = b.bar;
        __builtin_amdgcn_s_waitcnt(0);
        unsigned nloc = b.st[0], nx = b.st[1];
        if (nloc == 0u) { xcd_barrier_complete(bar, b.x, nloc, nx); b.st[0] = nloc; b.st[1] = nx; }
        const unsigned old = xb_add(&bar[XB_XSUB(b.x)], 1u);
        const unsigned gen = old / nloc;
        if (old + 1u == (gen + 1u) * nloc) {
            __builtin_amdgcn_fence(__ATOMIC_RELEASE, "agent");
            asm volatile("s_waitcnt vmcnt(0)" ::: "memory");
            const unsigned og = xb_add(&bar[XB_TOP], 1u);
            const unsigned tg = og / nx;
            if (og + 1u == (tg + 1u) * nx) xb_add(&bar[XB_TOPGEN], 1u);
            else XB_SPIN(xb_ld(&bar[XB_TOPGEN]) == tg, bar);
            __builtin_amdgcn_fence(__ATOMIC_ACQUIRE, "agent");
            xb_add(&bar[XB_XGEN(b.x)], 1u);
            asm volatile("s_waitcnt vmcnt(0)" ::: "memory");
        } else {
            XB_SPIN(xb_ld(&bar[XB_XGEN(b.x)]) == gen, bar);
            __builtin_amdgcn_fence(__ATOMIC_ACQUIRE, "agent");
            asm volatile("s_waitcnt vmcnt(0)" ::: "memory");
        }
    }
    __syncthreads();
}

struct Args { const float* in[25]; float* out; unsigned char* ws; int ph_lo, ph_hi; };
enum { I_X = 0, I_C, I_CTX, I_CCTX, I_ADAW, I_ADAB, I_NMG, I_NFG, I_WIN, I_WOUT, I_SINK, I_PW1W, I_PW1B, I_DWW, I_DWB, I_LNG, I_LNB,
       I_PW2W, I_PW2B, I_RW, I_RB, I_WG, I_WU, I_WD, I_FNG };

struct InPtrs {
    __device__ __forceinline__ const float* operator[](int i) const { const float* r;
        asm volatile("s_load_dwordx2 %0, %1, %2\n\ts_waitcnt lgkmcnt(0)" : "=s"(r) : "s"(__builtin_amdgcn_kernarg_segment_ptr()), "s"(i * 8)); return r; }
};
struct Frame {
    LAS unsigned char* lds;
    int tid, lane, wave, G, wg;
    InPtrs in;
    float* out;
    unsigned char* ws;
    unsigned* ctl;
};

__device__ __forceinline__ int crow(int i, int h) { return (i & 3) + 8 * (i >> 2) + 4 * h; }
template <class RowPtr, class Epi>
__device__ __forceinline__ void sgemm_tile(const RowPtr& rowptr, const bf16* Bt, int K, int m0, int n0, const Epi& epi, int wave, int lane) {
    const int wm = wave & 3, wn = wave >> 2, r = lane & 31, h = lane >> 5;
    const bf16* ap = rowptr(m0 + wm * 32 + r) + 8 * h;
    const bf16* bp0 = Bt + (size_t)(n0 + wn * 64 + r) * K + 8 * h;
    const bf16* bp1 = bp0 + (size_t)32 * K;
    f32x16 c0, c1;
#pragma unroll
    for (int i = 0; i < 16; ++i) { c0[i] = 0.f; c1[i] = 0.f; }
#pragma unroll 2
    for (int k = 0; k < K; k += 32) {
        const bf16x8 a0 = *(const bf16x8*)(ap + k), a1 = *(const bf16x8*)(ap + k + 16);
        const bf16x8 b00 = *(const bf16x8*)(bp0 + k), b01 = *(const bf16x8*)(bp0 + k + 16);
        const bf16x8 b10 = *(const bf16x8*)(bp1 + k), b11 = *(const bf16x8*)(bp1 + k + 16);
        c0 = __builtin_amdgcn_mfma_f32_32x32x16_bf16(a0, b00, c0, 0, 0, 0);
        c1 = __builtin_amdgcn_mfma_f32_32x32x16_bf16(a0, b10, c1, 0, 0, 0);
        c0 = __builtin_amdgcn_mfma_f32_32x32x16_bf16(a1, b01, c0, 0, 0, 0);
        c1 = __builtin_amdgcn_mfma_f32_32x32x16_bf16(a1, b11, c1, 0, 0, 0);
    }
    epi(m0 + wm * 32, n0 + wn * 64, c0, c1, lane);
}

__device__ __forceinline__ void p0_transpose_item(const float* W, int K, int N, bf16* WT, int k0, int n0, int drow0, LAS float* scr, int lane) {
#pragma unroll 8
    for (int i = 0; i < 32; ++i) { const int kk = 2 * i + (lane >> 5); scr[kk * 33 + (lane & 31)] = W[(size_t)(k0 + kk) * N + n0 + (lane & 31)]; }
    LDS_WAIT(); asm volatile("" ::: "memory");
    const int c = lane & 7;
#pragma unroll
    for (int j = 0; j < 4; ++j) { const int n = (lane >> 3) + 8 * j; const LAS float* s = scr + (8 * c) * 33 + n;
        u32x4 o; o.x = pk2(s[0 * 33], s[1 * 33]); o.y = pk2(s[2 * 33], s[3 * 33]); o.z = pk2(s[4 * 33], s[5 * 33]); o.w = pk2(s[6 * 33], s[7 * 33]);
        *(u32x4*)(WT + (size_t)(drow0 + n) * K + k0 + 8 * c) = o; }
    LDS_WAIT(); asm volatile("" ::: "memory");
}
__device__ __forceinline__ int il_row(int j, int half) { return (j / IL) * (2 * IL) + half * IL + (j % IL); }

constexpr int T_NITEMS = 640 + 512 + 1024 + 512 + 3 * 32 * 256, T_DEFER_ATT = 10 * 2048;
struct TItem { const float* W; bf16* WT; int K, N, k0, n0, drow0; bool ok; };
__device__ __forceinline__ TItem t_decode(const Frame& F, int it) {
    constexpr int S0 = 640, S1 = 512, S2 = 1024, S3 = 512, SM = 32 * 256;
    TItem t; t.ok = it < S0 + S1 + S2 + S3 + 3 * SM; t.W = F.in[I_WIN]; t.WT = (bf16*)(F.ws + WS_WIN); t.K = 1024; t.N = 1280; t.k0 = 0; t.n0 = 0; t.drow0 = 0;
    int r = it;
    if (r < S0) { const int kb = r / 40, nb = r % 40; t.k0 = kb * 64; t.n0 = nb * 32; t.drow0 = nb * 32; return t; } r -= S0;
    if (r < S1) { const int kb = r / 32, nb = r % 32; t.W = F.in[I_WOUT]; t.WT = (bf16*)(F.ws + WS_WOUT); t.N = 1024; t.k0 = kb * 64; t.n0 = nb * 32; t.drow0 = nb * 32; return t; } r -= S1;
    if (r < S2) { const int kb = r / 64, nb = r % 64, n0 = nb * 32; t.W = F.in[I_PW1W]; t.WT = (bf16*)(F.ws + WS_WPW1); t.N = 2048; t.k0 = kb * 64; t.n0 = n0; t.drow0 = il_row(n0 & 1023, n0 >> 10); return t; } r -= S2;
    if (r < S3) { const int kb = r / 32, nb = r % 32; t.W = F.in[I_PW2W]; t.WT = (bf16*)(F.ws + WS_WPW2); t.N = 1024; t.k0 = kb * 64; t.n0 = nb * 32; t.drow0 = nb * 32; return t; } r -= S3;
    if (r < SM) { const int le = r >> 8, q = r & 255, kb = q / 16, nb = q % 16; t.W = F.in[I_WG] + (size_t)le * 1024 * 512; t.WT = (bf16*)(F.ws + WS_WGU) + (size_t)le * 1024 * 1024; t.N = 512; t.k0 = kb * 64; t.n0 = nb * 32; t.drow0 = il_row(nb * 32, 0); return t; } r -= SM;
    if (r < SM) { const int le = r >> 8, q = r & 255, kb = q / 16, nb = q % 16; t.W = F.in[I_WU] + (size_t)le * 1024 * 512; t.WT = (bf16*)(F.ws + WS_WGU) + (size_t)le * 1024 * 1024; t.N = 512; t.k0 = kb * 64; t.n0 = nb * 32; t.drow0 = il_row(nb * 32, 1); return t; } r -= SM;
    { const int le = (r >> 8) & 31, q = r & 255, kb = q / 32, nb = q % 32; t.W = F.in[I_WD] + (size_t)le * 512 * 1024; t.WT = (bf16*)(F.ws + WS_WDN) + (size_t)le * 1024 * 512; t.K = 512; t.N = 1024; t.k0 = kb * 64; t.n0 = nb * 32; t.drow0 = nb * 32; }
    return t;
}
__device__ __forceinline__ void t_load(const TItem& t, int lane, float (&v)[32]) {
    if (t.ok) {
#pragma unroll
        for (int i = 0; i < 32; ++i) v[i] = t.W[(size_t)(t.k0 + 2 * i + (lane >> 5)) * t.N + t.n0 + (lane & 31)];
    }
}
__device__ __forceinline__ void t_store(const TItem& t, LAS float* scr, int lane, const float (&v)[32]) {
#pragma unroll
    for (int i = 0; i < 32; ++i) scr[(2 * i + (lane >> 5)) * 33 + (lane & 31)] = v[i];
    LDS_WAIT(); asm volatile("" ::: "memory");
    const int c = lane & 7;
#pragma unroll
    for (int j = 0; j < 4; ++j) { const int n = (lane >> 3) + 8 * j; const LAS float* s = scr + (8 * c) * 33 + n;
        u32x4 o; o.x = pk2(s[0 * 33], s[1 * 33]); o.y = pk2(s[2 * 33], s[3 * 33]); o.z = pk2(s[4 * 33], s[5 * 33]); o.w = pk2(s[6 * 33], s[7 * 33]);
        *(u32x4*)(t.WT + (size_t)(t.drow0 + n) * t.K + t.k0 + 8 * c) = o; }
    LDS_WAIT(); asm volatile("" ::: "memory");
}
__device__ __forceinline__ void t_dma(const TItem& t, LAS unsigned char* scr, int lane) {
    if (t.ok) {
#pragma unroll
        for (int i = 0; i < 8; ++i)
            __builtin_amdgcn_global_load_lds((const unsigned*)(t.W + (size_t)(t.k0 + 8 * i + (lane >> 3)) * t.N + t.n0 + 4 * (lane & 7)), (LAS unsigned*)(scr + 1056 * i), 16, 0, 0);
    }
}
__device__ __forceinline__ void t_store_dma(const TItem& t, const LAS float* scr, int lane) {
    const int c = lane & 7;
#pragma unroll 1
    for (int j = 0; j < 4; ++j) { const int n = (lane >> 3) + 8 * j; float e[8];
#pragma unroll
        for (int q = 0; q < 8; ++q) e[q] = scr[264 * c + 32 * q + n];
        { u32x4 o; o.x = pk2(e[0], e[1]); o.y = pk2(e[2], e[3]); o.z = pk2(e[4], e[5]); o.w = pk2(e[6], e[7]); *(u32x4*)(t.WT + (size_t)(t.drow0 + n) * t.K + t.k0 + 8 * c) = o; } }
    LDS_WAIT(); asm volatile("" ::: "memory");
}
__device__ __forceinline__ void t_items_tail(Frame& F, int r, int nw) {
    LAS float* scr = (LAS float*)(F.lds + F.wave * 8704);
    TItem cur = t_decode(F, 640 + T_DEFER_ATT + r); float va[32], vb[32];
    t_load(cur, F.lane, va);
#pragma unroll 1
    for (int it = r; cur.ok; it += nw) {
        const TItem nxt = t_decode(F, 640 + T_DEFER_ATT + it + nw);
        t_load(nxt, F.lane, vb);
        t_store(cur, scr, F.lane, va);
#pragma unroll
        for (int i = 0; i < 32; ++i) va[i] = vb[i];
        cur = nxt;
    }
}
__device__ __forceinline__ void phase_prep(Frame& F) {
    {
        LAS float* sc = (LAS float*)F.lds;
        LAS float* red = sc + 5 * 1024;
        bool loaded = false;
        for (int it = F.wg; it < 192; it += F.G) {
            if (!loaded) {
                for (int i = F.tid; i < 5 * 1024; i += NTHR) { const int b = i >> 10, k = i & 1023; const float v = b < 4 ? F.in[I_C][b * 1024 + k] : F.in[I_CCTX][k]; sc[i] = silu_f(v); }
                __syncthreads(); loaded = true;
            }
            const int l = it / 96, n0 = (it % 96) * 64, c4 = F.tid & 15, kg = F.tid >> 4;
            const float* w = F.in[I_ADAW] + (size_t)l * 1024 * 6144 + n0 + 4 * c4;
            f32x4 a[5];
#pragma unroll
            for (int b = 0; b < 5; ++b) a[b] = (f32x4){0.f, 0.f, 0.f, 0.f};
#pragma unroll 16
            for (int kk = 0; kk < 32; ++kk) { const int k = kg * 32 + kk; const f32x4 wv = *(const f32x4*)(w + (size_t)k * 6144);
#pragma unroll
                for (int b = 0; b < 5; ++b) a[b] += sc[b * 1024 + k] * wv; }
#pragma unroll
            for (int b = 0; b < 5; ++b) *(LAS f32x4*)(red + (kg * 5 + b) * 64 + 4 * c4) = a[b];
            __syncthreads();
            if (F.tid < 320) { const int b = F.tid >> 6, c2 = F.tid & 63; float sm = 0.f;
#pragma unroll
                for (int g = 0; g < 32; ++g) sm += red[(g * 5 + b) * 64 + c2];
                ((float*)(F.ws + WS_MOD))[((size_t)l * 5 + b) * 6144 + n0 + c2] = sm + F.in[I_ADAB][l * 6144 + n0 + c2]; }
            __syncthreads();
        }
        __syncthreads();
    }
    { u32x4* z = (u32x4*)(F.ws + WS_SLOTT); const u32x4 zero = {0u, 0u, 0u, 0u};
      for (int i = F.wg * NTHR + F.tid; i < 2 * 16 * CAP / 4; i += F.G * NTHR) z[i] = zero; }
    { float* tw = (float*)(F.ws + WS_TW);
      for (int k = F.wg * NTHR + F.tid; k < 8192; k += F.G * NTHR) { const float a = (float)k * (6.283185307179586f / 8192.f); tw[2 * k] = __cosf(a); tw[2 * k + 1] = __sinf(a); } }
    {
        LAS float* scr = (LAS float*)(F.lds + F.wave * 8704);
        const int gw = F.wg * NWAVES + F.wave, NGW = F.G * NWAVES;
        auto vmap = [](int v) { return v < 640 ? v : (1 << 30); };
        TItem cur = t_decode(F, vmap(gw)); float va[32], vb[32];
        t_load(cur, F.lane, va);
#pragma unroll 1
        for (int it = gw; cur.ok; it += NGW) {
            const TItem nxt = t_decode(F, vmap(it + NGW));
            t_load(nxt, F.lane, vb);
            t_store(cur, scr, F.lane, va);
#pragma unroll
            for (int i = 0; i < 32; ++i) va[i] = vb[i];
            cur = nxt;
        }
    }
}

#define ROFF(lane, j) (512 * ((j) >> 1) + 8 * (lane) + 4 * ((j) & 1))
__device__ __forceinline__ void row_load(const float* p, int lane, f32x4 (&v)[4]) {
#pragma unroll
    for (int j = 0; j < 4; ++j) v[j] = *(const f32x4*)(p + ROFF(lane, j));
}
__device__ __forceinline__ void row_load_bf(const bf16* p, int lane, f32x4 (&v)[4]) {
#pragma unroll
    for (int jj = 0; jj < 2; ++jj) { const u32x4 w = *(const u32x4*)(p + 512 * jj + 8 * lane); v[2 * jj] = (f32x4){bflo(w.x), bfhi(w.x), bflo(w.y), bfhi(w.y)}; v[2 * jj + 1] = (f32x4){bflo(w.z), bfhi(w.z), bflo(w.w), bfhi(w.w)}; }
}
__device__ __forceinline__ void xrow_load(const float* xf, const bf16* xb, size_t row, int lane, f32x4 (&v)[4]) { if (XBF16) row_load_bf(xb + row * D, lane, v); else row_load(xf + row * D, lane, v); }
__device__ __forceinline__ float row_sumsq(const f32x4 (&v)[4]) {
    float s = 0.f;
#pragma unroll
    for (int j = 0; j < 4; ++j) s += (v[j].x * v[j].x + v[j].y * v[j].y) + (v[j].z * v[j].z + v[j].w * v[j].w);
    return wave_sum(s);
}
__device__ __forceinline__ void row_modulate(f32x4 (&v)[4], float rstd, const float* g, const float* sh, const float* sc, int lane) {
#pragma unroll
    for (int j = 0; j < 4; ++j) { const int o = ROFF(lane, j); const f32x4 gg = *(const f32x4*)(g + o), s1 = *(const f32x4*)(sc + o), s0 = *(const f32x4*)(sh + o);
        v[j] = v[j] * rstd * gg * (1.f + s1) + s0; }
}
__device__ __forceinline__ void row_store_bf16(bf16* dst, const f32x4 (&v)[4], int lane) {
#pragma unroll
    for (int jj = 0; jj < 2; ++jj) { u32x4 w; w.x = pk2(v[2 * jj].x, v[2 * jj].y); w.y = pk2(v[2 * jj].z, v[2 * jj].w); w.z = pk2(v[2 * jj + 1].x, v[2 * jj + 1].y); w.w = pk2(v[2 * jj + 1].z, v[2 * jj + 1].w); *(u32x4*)(dst + 512 * jj + 8 * lane) = w; }
}

__device__ __forceinline__ void phase_norm1_l0(Frame& F) {
    const int gw = F.wg * NWAVES + F.wave, NGW = F.G * NWAVES;
    const float* mod = (const float*)(F.ws + WS_MOD);
    bf16* HB = (bf16*)(F.ws + WS_HB);
    for (int row = gw; row < T + TC; row += NGW) {
        const float* src = row < T ? F.in[I_X] + (size_t)row * D : F.in[I_CTX] + (size_t)(row - T) * D;
        const int b = row < T ? (row >> 13) : 4;
        f32x4 v[4]; row_load(src, F.lane, v);
        const float rstd = rsqrtf(row_sumsq(v) * (1.f / D) + EPS);
        const float* m = mod + (size_t)b * 6144;
        row_modulate(v, rstd, F.in[I_NMG], m, m + 1024, F.lane);
        row_store_bf16(HB + (size_t)row * D, v, F.lane);
    }
}

struct RowLin { const bf16* base; size_t pitch; __device__ __forceinline__ const bf16* operator()(int m) const { return base + (size_t)m * pitch; } };

__device__ __forceinline__ void inproj_block(Frame& F, int mb, int nbk, const f32x16& c, int lane) {
    const int h = lane >> 5, cl = lane & 31;
    bf16* dst; int pitch, cbase; bool rope = false; bool isctx = (mb >= T);
    if (nbk < 512) { dst = (bf16*)(F.ws + WS_UF); pitch = 512; cbase = 0; }
    else if (nbk < 1024) { dst = (bf16*)(F.ws + WS_Q); pitch = 512; cbase = 512; rope = true; }
    else if (nbk < 1152) { dst = isctx ? (bf16*)(F.ws + WS_CK) : (bf16*)(F.ws + WS_K); pitch = 128; cbase = 1024; rope = !isctx; }
    else { dst = isctx ? (bf16*)(F.ws + WS_CV) : (bf16*)(F.ws + WS_V); pitch = 128; cbase = 1152; }
    const int rbase = isctx ? mb - T : mb;
    const int col = nbk - cbase + cl;
    const float inv = exp2f(-(float)(cl & 15) * (13.287712379549449f / 16.f));
    const bool second = (cl & 16) != 0; const bool bycol = ((nbk >> 5) & 1) != 0;
#pragma unroll
    for (int i = 0; i < 16; ++i) {
        const int rr = crow(i, h); float v = c[i];
        if (rope) {
            const float partner = __shfl_xor(v, 16);
            const int l = (mb + rr) & (L - 1);
            const float pos = (float)(bycol ? (l & 63) : (l >> 6));
            const float ang = pos * inv, cs = __cosf(ang), sn = __sinf(ang);
            v = second ? (partner * sn + v * cs) : (v * cs - partner * sn);
        }
        dst[(size_t)(rbase + rr) * pitch + col] = (bf16)f2bf(v);
    }
}
__device__ __forceinline__ void phase_inproj(Frame& F) {
    const bf16* HB = (const bf16*)(F.ws + WS_HB); const bf16* Wt = (const bf16*)(F.ws + WS_WIN);
    constexpr int MT = (T + TC) / 128, NT = N_IN / 128;
    RowLin rp{HB, (size_t)D};
    for (int u = F.wg; u < MT * NT; u += F.G) {
        const int mt = u / NT, nt = u % NT;
        if (mt >= T / 128 && nt < 8) continue;
        auto epi = [&](int mb, int nb, const f32x16& c0, const f32x16& c1, int lane) { inproj_block(F, mb, nb, c0, lane); inproj_block(F, mb, nb + 32, c1, lane); };
        sgemm_tile(rp, Wt, D, mt * 128, nt * 128, epi, F.wave, F.lane);
    }
}

__device__ __forceinline__ void attn_key(const bf16* kp, const bf16* vp, const float (&q)[64], float& m, float& s, float (&o)[64]) {
    float dot = 0.f;
#pragma unroll
    for (int j = 0; j < 8; ++j) { const u32x4 w = *(const u32x4*)(kp + 8 * j);
        dot += q[8 * j + 0] * bflo(w.x) + q[8 * j + 1] * bfhi(w.x) + q[8 * j + 2] * bflo(w.y) + q[8 * j + 3] * bfhi(w.y)
             + q[8 * j + 4] * bflo(w.z) + q[8 * j + 5] * bfhi(w.z) + q[8 * j + 6] * bflo(w.w) + q[8 * j + 7] * bfhi(w.w); }
    const float mn = fmaxf(m, dot), alpha = __expf(m - mn), p = __expf(dot - mn);
    s = s * alpha + p; m = mn;
#pragma unroll
    for (int j = 0; j < 8; ++j) { const u32x4 w = *(const u32x4*)(vp + 8 * j);
        o[8 * j + 0] = o[8 * j + 0] * alpha + p * bflo(w.x); o[8 * j + 1] = o[8 * j + 1] * alpha + p * bfhi(w.x);
        o[8 * j + 2] = o[8 * j + 2] * alpha + p * bflo(w.y); o[8 * j + 3] = o[8 * j + 3] * alpha + p * bfhi(w.y);
        o[8 * j + 4] = o[8 * j + 4] * alpha + p * bflo(w.z); o[8 * j + 5] = o[8 * j + 5] * alpha + p * bfhi(w.z);
        o[8 * j + 6] = o[8 * j + 6] * alpha + p * bflo(w.w); o[8 * j + 7] = o[8 * j + 7] * alpha + p * bfhi(w.w); }
}
__device__ __forceinline__ void phase_attn_simple(Frame& F) {
    const bf16* Q = (const bf16*)(F.ws + WS_Q); const bf16* Kb = (const bf16*)(F.ws + WS_K); const bf16* Vb = (const bf16*)(F.ws + WS_V);
    const bf16* CK = (const bf16*)(F.ws + WS_CK); const bf16* CV = (const bf16*)(F.ws + WS_CV); bf16* MIX = (bf16*)(F.ws + WS_MIX);
    for (int idx = F.wg * NTHR + F.tid; idx < T * 8; idx += F.G * NTHR) {
        const int hd = idx / T, t = idx % T, b = t >> 13, l = t & (L - 1), kvh = hd >> 2;
        float q[64], o[64];
#pragma unroll
        for (int j = 0; j < 8; ++j) { const u32x4 w = *(const u32x4*)(Q + (size_t)t * 512 + hd * 64 + 8 * j);
            q[8 * j + 0] = bflo(w.x) * 0.125f; q[8 * j + 1] = bfhi(w.x) * 0.125f; q[8 * j + 2] = bflo(w.y) * 0.125f; q[8 * j + 3] = bfhi(w.y) * 0.125f;
            q[8 * j + 4] = bflo(w.z) * 0.125f; q[8 * j + 5] = bfhi(w.z) * 0.125f; q[8 * j + 6] = bflo(w.w) * 0.125f; q[8 * j + 7] = bfhi(w.w) * 0.125f; }
#pragma unroll
        for (int j = 0; j < 64; ++j) o[j] = 0.f;
        float m = F.in[I_SINK][hd], s = 1.f;
        for (int c = 0; c < CL; ++c) { const size_t r = (size_t)(b * CL + c) * 128 + kvh * 64; attn_key(CK + r, CV + r, q, m, s, o); }
        const int lo = l - 128 < 0 ? 0 : l - 128, hi = l + 128 > L - 1 ? L - 1 : l + 128;
        for (int kp = lo; kp <= hi; ++kp) { const size_t r = (size_t)(b * L + kp) * 128 + kvh * 64; attn_key(Kb + r, Vb + r, q, m, s, o); }
        const float is = 1.f / s;
#pragma unroll
        for (int j = 0; j < 8; ++j) { u32x4 w; w.x = pk2(o[8 * j] * is, o[8 * j + 1] * is); w.y = pk2(o[8 * j + 2] * is, o[8 * j + 3] * is); w.z = pk2(o[8 * j + 4] * is, o[8 * j + 5] * is); w.w = pk2(o[8 * j + 6] * is, o[8 * j + 7] * is);
            *(u32x4*)(MIX + (size_t)t * 1024 + 512 + hd * 64 + 8 * j) = w; }
    }
}

__device__ __forceinline__ void phase_fft1_simple(Frame& F) {
    const bf16* UF = (const bf16*)(F.ws + WS_UF); bf16* Gb = (bf16*)(F.ws + WS_G); const float* tw = (const float*)(F.ws + WS_TW);
    for (int idx = F.wg * NTHR + F.tid; idx < NB * FN1 * FN2 * 512; idx += F.G * NTHR) {
        const int ch = idx & 511, bp = (idx >> 9) & 127, c = (idx >> 16) & 63, b = idx >> 22;
        float re = 0.f, im = 0.f;
        for (int a = 0; a < FN1; ++a) { const float u = bf2f(UF[(size_t)(b * L + 128 * a + bp) * 512 + ch]); const int k = ((a * c) & 63) * 128;
            re += u * tw[2 * k]; im -= u * tw[2 * k + 1]; }
        const int k2 = bp * c; const float cs = tw[2 * k2], sn = tw[2 * k2 + 1];
        const float gr = re * cs + im * sn, gi = im * cs - re * sn;
        const size_t row = (size_t)(b * FN1 + c) * FN2 + bp;
        Gb[row * 1024 + ch] = (bf16)f2bf(gr); Gb[row * 1024 + 512 + ch] = (bf16)f2bf(gi);
    }
}
__device__ __forceinline__ void phase_fft2_simple(Frame& F) {
    const bf16* Gb = (const bf16*)(F.ws + WS_G); bf16* AB = (bf16*)(F.ws + WS_AB); const float* tw = (const float*)(F.ws + WS_TW);
    for (int idx = F.wg * NTHR + F.tid; idx < NB * FN1 * FN2 * 512; idx += F.G * NTHR) {
        const int ch = idx & 511, d = (idx >> 9) & 127, c = (idx >> 16) & 63, b = idx >> 22;
        float fr = 0.f, fi = 0.f;
        for (int bp = 0; bp < FN2; ++bp) { const size_t row = (size_t)(b * FN1 + c) * FN2 + bp; const float gr = bf2f(Gb[row * 1024 + ch]), gi = bf2f(Gb[row * 1024 + 512 + ch]);
            const int k = ((bp * d) & 127) * 64; const float cs = tw[2 * k], sn = tw[2 * k + 1];
            fr += gr * cs + gi * sn; fi += gi * cs - gr * sn; }
        const size_t t = (size_t)b * L + c + 64 * d;
        AB[t * 1024 + ch] = (bf16)f2bf(fr); AB[t * 1024 + 512 + ch] = (bf16)f2bf(-fi);
    }
}
__device__ __forceinline__ void phase_fft3_simple(Frame& F) {
    const bf16* AB = (const bf16*)(F.ws + WS_AB); bf16* MIX = (bf16*)(F.ws + WS_MIX); const float* tw = (const float*)(F.ws + WS_TW);
    LAS float* t128 = (LAS float*)F.lds;
    for (int i = F.tid; i < 128; i += NTHR) { t128[2 * i] = tw[2 * (i * 64)]; t128[2 * i + 1] = tw[2 * (i * 64) + 1]; }
    __syncthreads();
    for (int idx = F.wg * NTHR + F.tid; idx < T * 512; idx += F.G * NTHR) {
        const int cp = idx & 127, g = (idx >> 7) & 3, t = idx >> 9;
        const bf16* arow = AB + (size_t)t * 1024 + g * 128;
        float y = 0.f;
        for (int cc = 0; cc < 128; ++cc) { const int k = (cc * cp) & 127; y += bf2f(arow[cc]) * t128[2 * k] - bf2f(arow[512 + cc]) * t128[2 * k + 1]; }
        MIX[(size_t)t * 1024 + g * 128 + cp] = (bf16)f2bf(y * (1.f / 1024.f));
    }
    __syncthreads();
}

__device__ __forceinline__ void phase_outproj(Frame& F, const bf16* A, const bf16* Wt, const float* base, float* X, const float* gate  , const float* bias) {
    RowLin rp{A, (size_t)D};
    for (int u = F.wg; u < (T / 128) * 8; u += F.G) {
        const int mt = u / 8, nt = u % 8;
        auto epi = [&](int mb, int nb, const f32x16& c0, const f32x16& c1, int lane) {
            const int h = lane >> 5, cl = lane & 31, b = mb >> 13;
#pragma unroll
            for (int half = 0; half < 2; ++half) { const int col = nb + 32 * half + cl; const float gv = gate[(size_t)b * 6144 + col], bv = bias ? bias[col] : 0.f;
#pragma unroll
                for (int i = 0; i < 16; ++i) { const size_t o = (size_t)(mb + crow(i, h)) * D + col; const float a = half ? c1[i] : c0[i]; X[o] = base[o] + gv * (a + bv); } }
        };
        sgemm_tile(rp, Wt, D, mt * 128, nt * 128, epi, F.wave, F.lane);
    }
}

__device__ __forceinline__ void route_select(const float (&lg)[16], const float* rb, int& be1, int& be2, float& w1, float& w2) {
    float best = -1e30f; float bs1 = 0.f, bs2 = 0.f; be1 = 0; be2 = 0;
#pragma unroll
    for (int g = 0; g < 4; ++g) {
        float v1 = -1e30f, v2 = -1e30f, s1 = 0.f, s2 = 0.f; int j1 = 0, j2 = 0;
#pragma unroll
        for (int q = 0; q < 4; ++q) { const float sc = sigmoid_f(lg[4 * g + q]), x = sc + rb[4 * g + q];
            if (x > v1) { v2 = v1; j2 = j1; s2 = s1; v1 = x; j1 = q; s1 = sc; } else if (x > v2) { v2 = x; j2 = q; s2 = sc; } }
        const float gs = v1 + v2;
        if (gs > best) { best = gs; be1 = 4 * g + j1; be2 = 4 * g + j2; bs1 = s1; bs2 = s2; }
    }
    const float inv = 1.f / (bs1 + bs2); w1 = bs1 * inv; w2 = bs2 * inv;
}
__device__ __forceinline__ void phase_norm2_route(Frame& F, int layer) {
    const float* mod = (const float*)(F.ws + WS_MOD) + (size_t)layer * 5 * 6144;
    const float* X = F.out; const bf16* XB = (const bf16*)(F.ws + WS_XB); bf16* HB = (bf16*)(F.ws + WS_HB);
    const float* rw = F.in[I_RW]; const float* rb = F.in[I_RB];
    int* tok_e = (int*)(F.ws + WS_TOKE); int* tok_p = (int*)(F.ws + WS_TOKP); float* tok_w = (float*)(F.ws + WS_TOKW);
    int* slot_t = (int*)(F.ws + WS_SLOTT) + layer * 16 * CAP;
    float* slot_w = (float*)(F.ws + WS_SLOTW) + layer * 16 * CAP;
    unsigned* cnt = F.ctl + CW_CNT + layer * 16 * 64;
    LAS float* rwt = (LAS float*)F.lds;
    LAS int* sel_e = (LAS int*)(F.lds + 65536);
    LAS float* sel_w = (LAS float*)(F.lds + 65536 + 1024);
    LAS int* wcnt = (LAS int*)(F.lds + 65536 + 2048);
    LAS int* ebase = wcnt + 64;
    __syncthreads();
    for (int t = F.tid; t < 4096; t += NTHR) { const int i = t >> 2, e4 = t & 3; const f32x4 w = *(const f32x4*)(rw + (size_t)i * 16 + 4 * e4);
        const int p = (i & 512) + 256 * ((i >> 2) & 1) + 4 * ((i >> 3) & 63) + (i & 3);
        rwt[(4 * e4 + 0) * 1024 + p] = w.x; rwt[(4 * e4 + 1) * 1024 + p] = w.y; rwt[(4 * e4 + 2) * 1024 + p] = w.z; rwt[(4 * e4 + 3) * 1024 + p] = w.w; }
    __syncthreads();
    for (int rb0 = F.wg; rb0 < T / 128; rb0 += F.G) {
        const int b = (rb0 * 128) >> 13;
        f32x4 gm[4], sh[4];
        { const float* m = mod + (size_t)b * 6144; const float* g = F.in[I_NFG] + layer * D;
#pragma unroll
          for (int jj = 0; jj < 4; ++jj) { const int o = ROFF(F.lane, jj); gm[jj] = *(const f32x4*)(g + o) * (1.f + *(const f32x4*)(m + 4096 + o)); sh[jj] = *(const f32x4*)(m + 3072 + o); } }
        const int rbase = rb0 * 128 + F.wave * 16;
        f32x4 v0[4], v1[4]; xrow_load(X, XB, (size_t)rbase, F.lane, v0); xrow_load(X, XB, (size_t)(rbase + 1), F.lane, v1);
#pragma unroll 1
        for (int j = 0; j < 16; j += 2) {
            const int lr = F.wave * 16 + j, row = rbase + j;
            f32x4 n0[4], n1[4];
            { const int nr = (j + 2 < 16) ? row + 2 : row; xrow_load(X, XB, (size_t)nr, F.lane, n0); xrow_load(X, XB, (size_t)(nr + 1), F.lane, n1); }
            const float rstd0 = rsqrtf(row_sumsq(v0) * (1.f / D) + EPS), rstd1 = rsqrtf(row_sumsq(v1) * (1.f / D) + EPS);
#pragma unroll
            for (int jj = 0; jj < 4; ++jj) { v0[jj] = v0[jj] * rstd0 * gm[jj] + sh[jj]; v1[jj] = v1[jj] * rstd1 * gm[jj] + sh[jj]; }
            row_store_bf16(HB + (size_t)row * D, v0, F.lane); row_store_bf16(HB + (size_t)(row + 1) * D, v1, F.lane);
            float lg0[16], lg1[16];
#pragma unroll
            for (int e = 0; e < 16; ++e) { float a0 = 0.f, a1 = 0.f;
#pragma unroll
                for (int jj = 0; jj < 4; ++jj) { const f32x4 w4 = *(const LAS f32x4*)(rwt + e * 1024 + 256 * jj + 4 * F.lane);
                    a0 += (v0[jj].x * w4.x + v0[jj].y * w4.y) + (v0[jj].z * w4.z + v0[jj].w * w4.w); a1 += (v1[jj].x * w4.x + v1[jj].y * w4.y) + (v1[jj].z * w4.z + v1[jj].w * w4.w); }
                lg0[e] = a0; lg1[e] = a1; }
#pragma unroll
            for (int e = 0; e < 16; ++e) { lg0[e] = wave_sum(lg0[e]); lg1[e] = wave_sum(lg1[e]); }
            int e1, e2; float w1, w2;
            route_select(lg0, rb, e1, e2, w1, w2);
            if (F.lane == 0) { sel_e[2 * lr] = e1; sel_e[2 * lr + 1] = e2; sel_w[2 * lr] = w1; sel_w[2 * lr + 1] = w2; }
            route_select(lg1, rb, e1, e2, w1, w2);
            if (F.lane == 0) { sel_e[2 * lr + 2] = e1; sel_e[2 * lr + 3] = e2; sel_w[2 * lr + 2] = w1; sel_w[2 * lr + 3] = w2; }
#pragma unroll
            for (int jj = 0; jj < 4; ++jj) { v0[jj] = n0[jj]; v1[jj] = n1[jj]; }
        }
        __syncthreads();
        int my_e = 0, my_rank = 0; float my_w = 0.f;
        if (F.tid < 256) { my_e = sel_e[F.tid]; my_w = sel_w[F.tid];
            const unsigned long long below = (1ull << F.lane) - 1ull;
#pragma unroll 1
            for (int ee = 0; ee < 16; ++ee) { const unsigned long long mk = __ballot(my_e == ee);
                if (my_e == ee) my_rank = __popcll(mk & below);
                if (F.lane == 0) wcnt[F.wave * 16 + ee] = __popcll(mk); } }
        __syncthreads();
        if (F.tid < 16) { const int n = wcnt[F.tid] + wcnt[16 + F.tid] + wcnt[32 + F.tid] + wcnt[48 + F.tid];
            ebase[F.tid] = n ? (int)atomicAdd(cnt + F.tid * 64, (unsigned)n) : 0; }
        __syncthreads();
        if (F.tid < 256) { int pos = ebase[my_e] + my_rank;
            for (int w = 0; w < F.wave; ++w) pos += wcnt[w * 16 + my_e];
            const int tok = rb0 * 128 + (F.tid >> 1), k = F.tid & 1;
            slot_t[my_e * CAP + pos] = tok; slot_w[my_e * CAP + pos] = my_w; tok_e[2 * tok + k] = my_e; tok_p[2 * tok + k] = pos; tok_w[2 * tok + k] = my_w; }
        __syncthreads();
    }
}


__device__ __forceinline__ void phase_norm2_route_mfma(Frame& F, int layer) {
    constexpr int AP = 1032;
    const float* mod = (const float*)(F.ws + WS_MOD) + (size_t)layer * 5 * 6144;
    const bf16* XB = (const bf16*)(F.ws + WS_XB); bf16* HB = (bf16*)(F.ws + WS_HB);
    const float* rw = F.in[I_RW]; const float* rb = F.in[I_RB]; const float* gsrc = F.in[I_NFG] + layer * D;
    int* tok_e = (int*)(F.ws + WS_TOKE); int* tok_p = (int*)(F.ws + WS_TOKP); float* tok_w = (float*)(F.ws + WS_TOKW);
    int* slot_t = (int*)(F.ws + WS_SLOTT) + layer * 16 * CAP;
    float* slot_w = (float*)(F.ws + WS_SLOTW) + layer * 16 * CAP;
    unsigned* cnt = F.ctl + CW_CNT + layer * 16 * 64;
    LAS bf16* AH = (LAS bf16*)F.lds; LAS bf16* AL = AH + 16 * AP;
    LAS float* cbv = (LAS float*)(F.lds + 2 * 16 * AP * 2);
    LAS float* rstdv = cbv + 16;
    LAS float* lgt = rstdv + 128;
    LAS int* sel_e = (LAS int*)(lgt + 128 * 16);
    LAS float* sel_w = (LAS float*)(sel_e + 256);
    LAS int* wcnt = (LAS int*)(sel_w + 256);
    LAS int* ebase = wcnt + 64;
    LAS float* cpart = (LAS float*)(ebase + 16);
    for (int rb0 = F.wg; rb0 < T / 128; rb0 += F.G) {
        const int b = (rb0 * 128) >> 13; const float* m = mod + (size_t)b * 6144;
        __syncthreads();
        { float cp[16];
#pragma unroll
          for (int e = 0; e < 16; ++e) cp[e] = 0.f;
          for (int k = F.tid; k < D; k += NTHR) { const float gmk = gsrc[k] * (1.f + m[4096 + k]), shk = m[3072 + k];
#pragma unroll
              for (int e4 = 0; e4 < 4; ++e4) { const f32x4 w4 = *(const f32x4*)(rw + (size_t)k * 16 + 4 * e4);
#pragma unroll
                  for (int q = 0; q < 4; ++q) { const int e = 4 * e4 + q; const float pr = gmk * w4[q]; const unsigned hi = f2bf(pr); const unsigned lo = f2bf(pr - bf2f(hi));
                      AH[e * AP + k] = (bf16)hi; AL[e * AP + k] = (bf16)lo; cp[e] += shk * w4[q]; } } }
#pragma unroll
          for (int e = 0; e < 16; ++e) { const float t = wave_sum(cp[e]); if (F.lane == 0) cpart[F.wave * 16 + e] = t; } }
        __syncthreads();
        if (F.tid < 16) { float t = 0.f;
#pragma unroll
            for (int w = 0; w < 8; ++w) t += cpart[w * 16 + F.tid];
            cbv[F.tid] = t; }
        f32x4 gm[4], sh[4];
#pragma unroll
        for (int jj = 0; jj < 4; ++jj) { const int o = ROFF(F.lane, jj); gm[jj] = *(const f32x4*)(gsrc + o) * (1.f + *(const f32x4*)(m + 4096 + o)); sh[jj] = *(const f32x4*)(m + 3072 + o); }
        const int rbase = rb0 * 128 + F.wave * 16;
        {
            u32x4 raw[16][2];
#pragma unroll
            for (int j = 0; j < 16; ++j)
#pragma unroll
                for (int hh = 0; hh < 2; ++hh) raw[j][hh] = *(const u32x4*)(XB + (size_t)(rbase + j) * D + 512 * hh + 8 * F.lane);
            float W[8], X[4], Y[2];
#pragma unroll
            for (int i = 0; i < 8; ++i) { float sa = 0.f, sb = 0.f;
#pragma unroll
                for (int hh = 0; hh < 2; ++hh) { const u32x4 a = raw[2 * i][hh], c = raw[2 * i + 1][hh];
                    sa = dot2_bf16(a.x, a.x, sa); sa = dot2_bf16(a.y, a.y, sa); sa = dot2_bf16(a.z, a.z, sa); sa = dot2_bf16(a.w, a.w, sa);
                    sb = dot2_bf16(c.x, c.x, sb); sb = dot2_bf16(c.y, c.y, sb); sb = dot2_bf16(c.z, c.z, sb); sb = dot2_bf16(c.w, c.w, sb); }
                W[i] = swap32_add(sa, sb); }
#pragma unroll
            for (int i = 0; i < 4; ++i) X[i] = swap16_add(W[2 * i], W[2 * i + 1]);
            const bool b3 = (F.lane & 8) != 0, b2 = (F.lane & 4) != 0;
#pragma unroll
            for (int i = 0; i < 2; ++i) Y[i] = sel_add<0x140>(X[2 * i], X[2 * i + 1], b3);
            float Z = sel_add<0x141>(Y[0], Y[1], b2);
            Z += dppf<0x4E>(Z); Z += dppf<0xB1>(Z);
            const int rr = ((F.lane >> 5) & 1) + ((F.lane >> 4) & 1) * 2 + ((F.lane >> 3) & 1) * 4 + ((F.lane >> 2) & 1) * 8;
            if (!(F.lane & 3)) rstdv[F.wave * 16 + rr] = rsqrtf(Z * (1.f / D) + EPS);
            __builtin_amdgcn_wave_barrier();
            float rs[16];
#pragma unroll
            for (int i = 0; i < 4; ++i) { const f32x4 t = *(const LAS f32x4*)(rstdv + F.wave * 16 + 4 * i); rs[4 * i] = t.x; rs[4 * i + 1] = t.y; rs[4 * i + 2] = t.z; rs[4 * i + 3] = t.w; }
#pragma unroll
            for (int j = 0; j < 16; ++j) { f32x4 v[4];
#pragma unroll
                for (int hh = 0; hh < 2; ++hh) { const u32x4 w = raw[j][hh]; v[2 * hh] = (f32x4){bflo(w.x), bfhi(w.x), bflo(w.y), bfhi(w.y)}; v[2 * hh + 1] = (f32x4){bflo(w.z), bfhi(w.z), bflo(w.w), bfhi(w.w)}; }
#pragma unroll
                for (int jj = 0; jj < 4; ++jj) v[jj] = v[jj] * rs[j] * gm[jj] + sh[jj];
                row_store_bf16(HB + (size_t)(rbase + j) * D, v, F.lane); }
        }
        __syncthreads();
        { const int fr = F.lane & 15, fq = F.lane >> 4;
          f32x4 acc = {0.f, 0.f, 0.f, 0.f};
          const bf16* xr = XB + (size_t)(rb0 * 128 + 16 * F.wave + fr) * D + 8 * fq;
          const LAS bf16* ah = AH + fr * AP + 8 * fq; const LAS bf16* al = AL + fr * AP + 8 * fq;
#pragma unroll
          for (int s2 = 0; s2 < 32; ++s2) { const bf16x8 xb = *(const bf16x8*)(xr + 32 * s2);
              acc = __builtin_amdgcn_mfma_f32_16x16x32_bf16(*(const LAS bf16x8*)(ah + 32 * s2), xb, acc, 0, 0, 0);
              acc = __builtin_amdgcn_mfma_f32_16x16x32_bf16(*(const LAS bf16x8*)(al + 32 * s2), xb, acc, 0, 0, 0); }
          const int lrow = 16 * F.wave + fr; const float rs = rstdv[lrow];
#pragma unroll
          for (int i = 0; i < 4; ++i) lgt[lrow * 16 + 4 * fq + i] = rs * acc[i] + cbv[4 * fq + i]; }
        __syncthreads();
        if (F.tid < 128) { float lg[16];
#pragma unroll
            for (int e4 = 0; e4 < 4; ++e4) { const f32x4 t = *(const LAS f32x4*)(lgt + F.tid * 16 + 4 * e4); lg[4 * e4] = t.x; lg[4 * e4 + 1] = t.y; lg[4 * e4 + 2] = t.z; lg[4 * e4 + 3] = t.w; }
            int e1, e2; float w1, w2; route_select(lg, rb, e1, e2, w1, w2);
            sel_e[2 * F.tid] = e1; sel_e[2 * F.tid + 1] = e2; sel_w[2 * F.tid] = w1; sel_w[2 * F.tid + 1] = w2; }
        __syncthreads();
        int my_e = 0, my_rank = 0; float my_w = 0.f;
        if (F.tid < 256) { my_e = sel_e[F.tid]; my_w = sel_w[F.tid];
            const unsigned long long below = (1ull << F.lane) - 1ull;
#pragma unroll 1
            for (int ee = 0; ee < 16; ++ee) { const unsigned long long mk = __ballot(my_e == ee);
                if (my_e == ee) my_rank = __popcll(mk & below);
                if (F.lane == 0) wcnt[F.wave * 16 + ee] = __popcll(mk); } }
        __syncthreads();
        if (F.tid < 16) { const int n = wcnt[F.tid] + wcnt[16 + F.tid] + wcnt[32 + F.tid] + wcnt[48 + F.tid];
            ebase[F.tid] = n ? (int)atomicAdd(cnt + F.tid * 64, (unsigned)n) : 0; }
        __syncthreads();
        if (F.tid < 256) { int pos = ebase[my_e] + my_rank;
            for (int w = 0; w < F.wave; ++w) pos += wcnt[w * 16 + my_e];
            const int tok = rb0 * 128 + (F.tid >> 1), k = F.tid & 1;
            slot_t[my_e * CAP + pos] = tok; slot_w[my_e * CAP + pos] = my_w; tok_e[2 * tok + k] = my_e; tok_p[2 * tok + k] = pos; tok_w[2 * tok + k] = my_w; }
    }
    __syncthreads();
}

constexpr int MOEMAP_OFF = LDS_BYTES - 256;
__device__ __forceinline__ LAS int* moe_map(Frame& F, int layer) {
    LAS int* mm = (LAS int*)(F.lds + MOEMAP_OFF);
    __syncthreads();
    if (F.tid < 64) { const unsigned* cnt = F.ctl + CW_CNT + layer * 16 * 64;
        const int n = (F.tid < 16) ? (int)__hip_atomic_load(cnt + F.tid * 64, __ATOMIC_RELAXED, __HIP_MEMORY_SCOPE_AGENT) : 0;
        const int pad = (n + 255) & ~255; int x = pad;
#pragma unroll
        for (int o = 1; o < 16; o <<= 1) { const int t = __shfl_up(x, o); if (F.lane >= o) x += t; }
        if (F.tid < 16) { mm[F.tid] = n; mm[16 + F.tid] = x - pad; } }
    __syncthreads();
    return mm;
}
struct RowGather { const bf16* base; const int* list; int n; __device__ __forceinline__ const bf16* operator()(int m) const { const int tok = m < n ? list[m] : 0; return base + (size_t)tok * D; } };

__device__ __forceinline__ void phase_moe_gateup(Frame& F, int layer) {
    LAS int* mm = moe_map(F, layer);
    const bf16* HB = (const bf16*)(F.ws + WS_HB); bf16* HID = (bf16*)(F.ws + WS_HID);
    const int* slot_t = (const int*)(F.ws + WS_SLOTT) + layer * 16 * CAP; const float* slot_w = (const float*)(F.ws + WS_SLOTW) + layer * 16 * CAP;
    int ubase = 0;
#pragma unroll 1
    for (int e = 0; e < 16; ++e) {
        const int n = mm[e], hbe = mm[16 + e], rt = (n + 127) >> 7, nu = rt * 8;
        const bf16* Wt = (const bf16*)(F.ws + WS_WGU) + (size_t)(layer * 16 + e) * 1024 * 1024;
        RowGather rp{HB, slot_t + e * CAP, n};
        int first = (F.wg - ubase % F.G + F.G) % F.G;
        for (int u = first; u < nu; u += F.G) {
            const int mt = u / 8, nt = u % 8;
            auto epi = [&](int mb, int nb, const f32x16& c0, const f32x16& c1, int lane) {
                const int h = lane >> 5, cl = lane & 31; const int col = (nb >> 1) + cl;
#pragma unroll
                for (int i = 0; i < 16; ++i) { const int r = mb + crow(i, h);
                    if (r < n) { const float w = slot_w[e * CAP + r]; HID[(size_t)(hbe + r) * FF + col] = (bf16)f2bf(w * silu_f(c0[i]) * c1[i]); } }
            };
            sgemm_tile(rp, Wt, D, mt * 128, nt * 128, epi, F.wave, F.lane);
        }
        ubase += nu;
    }
}
__device__ __forceinline__ void phase_moe_down(Frame& F, int layer) {
    LAS int* mm = moe_map(F, layer);
    const bf16* HID = (const bf16*)(F.ws + WS_HID); bf16* Y = (bf16*)(F.ws + WS_Y);
    int ubase = 0;
#pragma unroll 1
    for (int e = 0; e < 16; ++e) {
        const int n = mm[e], hbe = mm[16 + e], rt = (n + 127) >> 7, nu = rt * 8;
        const bf16* Wt = (const bf16*)(F.ws + WS_WDN) + (size_t)(layer * 16 + e) * 1024 * 512;
        RowLin rp{HID + (size_t)hbe * FF, (size_t)FF};
        int first = (F.wg - ubase % F.G + F.G) % F.G;
        for (int u = first; u < nu; u += F.G) {
            const int mt = u / 8, nt = u % 8;
            auto epi = [&](int mb, int nb, const f32x16& c0, const f32x16& c1, int lane) {
                const int h = lane >> 5, cl = lane & 31;
#pragma unroll
                for (int i = 0; i < 16; ++i) { const int r = mb + crow(i, h);
                    if (r < n) { bf16* yr = Y + (size_t)(hbe + r) * D + nb + cl; yr[0] = (bf16)f2bf(c0[i]); yr[32] = (bf16)f2bf(c1[i]); } }
            };
            sgemm_tile(rp, Wt, FF, mt * 128, nt * 128, epi, F.wave, F.lane);
        }
        ubase += nu;
    }
}

template <bool FINAL>
__device__ __forceinline__ void phase_combine(Frame& F, int layer) {
    LAS int* hbs = moe_map(F, layer) + 16;
    const int gw = F.wg * NWAVES + F.wave, NGW = F.G * NWAVES;
    const float* mod = (const float*)(F.ws + WS_MOD);
    const int* tok_e = (const int*)(F.ws + WS_TOKE); const int* tok_p = (const int*)(F.ws + WS_TOKP);
    const unsigned char* Y8 = (const unsigned char*)(F.ws + WS_Y);
    float* X = F.out; bf16* XB = (bf16*)(F.ws + WS_XB); bf16* HB = (bf16*)(F.ws + WS_HB);
    for (int blk = gw; blk < T / 16; blk += NGW) {
        const int rbase = blk * 16, b = rbase >> 13;
        f32x4 g2v[4], gm[4], shv[4];
        { const float* g2 = mod + ((size_t)layer * 5 + b) * 6144 + 5120;
#pragma unroll
          for (int j = 0; j < 4; ++j) { const int o = ROFF(F.lane, j); g2v[j] = *(const f32x4*)(g2 + o) * (1.f / YSCALE);
              if (FINAL) { gm[j] = *(const f32x4*)(F.in[I_FNG] + o); shv[j] = (f32x4){0.f, 0.f, 0.f, 0.f}; }
              else { const float* m = mod + ((size_t)(layer + 1) * 5 + b) * 6144; gm[j] = *(const f32x4*)(F.in[I_NMG] + (layer + 1) * D + o) * (1.f + *(const f32x4*)(m + 1024 + o)); shv[j] = *(const f32x4*)(m + o); } } }
        int4 te = *(const int4*)(tok_e + 2 * rbase), tp = *(const int4*)(tok_p + 2 * rbase);
        u32x4 xa[2][2], xn[2][2]; u32x2 ya[2][2][2], yn[2][2][2];
        { const int s00 = hbs[te.x] + tp.x, s01 = hbs[te.y] + tp.y, s10 = hbs[te.z] + tp.z, s11 = hbs[te.w] + tp.w;
#pragma unroll
          for (int jj = 0; jj < 2; ++jj) { const int o = 512 * jj + 8 * F.lane;
              xa[0][jj] = *(const u32x4*)(XB + (size_t)rbase * D + o); xa[1][jj] = *(const u32x4*)(XB + (size_t)(rbase + 1) * D + o);
              ya[0][0][jj] = *(const u32x2*)(Y8 + (size_t)s00 * D + o); ya[0][1][jj] = *(const u32x2*)(Y8 + (size_t)s01 * D + o);
              ya[1][0][jj] = *(const u32x2*)(Y8 + (size_t)s10 * D + o); ya[1][1][jj] = *(const u32x2*)(Y8 + (size_t)s11 * D + o); } }
        te = *(const int4*)(tok_e + 2 * (rbase + 2)); tp = *(const int4*)(tok_p + 2 * (rbase + 2));
#pragma unroll 1
        for (int jr = 0; jr < 16; jr += 2) {
            const int row = rbase + jr;
            if (jr + 2 < 16) { const int nr = row + 2;
                const int s00 = hbs[te.x] + tp.x, s01 = hbs[te.y] + tp.y, s10 = hbs[te.z] + tp.z, s11 = hbs[te.w] + tp.w;
#pragma unroll
                for (int jj = 0; jj < 2; ++jj) { const int o = 512 * jj + 8 * F.lane;
                    xn[0][jj] = *(const u32x4*)(XB + (size_t)nr * D + o); xn[1][jj] = *(const u32x4*)(XB + (size_t)(nr + 1) * D + o);
                    yn[0][0][jj] = *(const u32x2*)(Y8 + (size_t)s00 * D + o); yn[0][1][jj] = *(const u32x2*)(Y8 + (size_t)s01 * D + o);
                    yn[1][0][jj] = *(const u32x2*)(Y8 + (size_t)s10 * D + o); yn[1][1][jj] = *(const u32x2*)(Y8 + (size_t)s11 * D + o); }
                const int n2 = (jr + 4 < 16) ? row + 4 : row; te = *(const int4*)(tok_e + 2 * n2); tp = *(const int4*)(tok_p + 2 * n2); }
            f32x4 v[2][4];
#pragma unroll
            for (int q = 0; q < 2; ++q)
#pragma unroll
                for (int jj = 0; jj < 2; ++jj) { const u32x4 xw = xa[q][jj]; const u32x2 a0 = ya[q][0][jj], a1 = ya[q][1][jj];
                    v[q][2 * jj] = (f32x4){bflo(xw.x), bfhi(xw.x), bflo(xw.y), bfhi(xw.y)} + g2v[2 * jj] * (un_fp8x4(a0.x) + un_fp8x4(a1.x));
                    v[q][2 * jj + 1] = (f32x4){bflo(xw.z), bfhi(xw.z), bflo(xw.w), bfhi(xw.w)} + g2v[2 * jj + 1] * (un_fp8x4(a0.y) + un_fp8x4(a1.y)); }
            const float rstd0 = rsqrtf(row_sumsq(v[0]) * (1.f / D) + EPS), rstd1 = rsqrtf(row_sumsq(v[1]) * (1.f / D) + EPS);
#pragma unroll
            for (int q = 0; q < 2; ++q) { const float rstd = q ? rstd1 : rstd0; const size_t ro = (size_t)(row + q) * D;
                if (FINAL) {
#pragma unroll
                    for (int j = 0; j < 4; ++j) *(f32x4*)(X + ro + ROFF(F.lane, j)) = v[q][j] * rstd * gm[j];
                } else {
                    row_store_bf16(XB + ro, v[q], F.lane);
#pragma unroll
                    for (int j = 0; j < 4; ++j) v[q][j] = v[q][j] * rstd * gm[j] + shv[j];
                    row_store_bf16(HB + ro, v[q], F.lane);
                }
            }
#pragma unroll
            for (int q = 0; q < 2; ++q)
#pragma unroll
                for (int jj = 0; jj < 2; ++jj) { xa[q][jj] = xn[q][jj]; ya[q][0][jj] = yn[q][0][jj]; ya[q][1][jj] = yn[q][1][jj]; }
        }
    }
    __syncthreads();
}

__device__ __forceinline__ void phase_pw1(Frame& F) {
    const bf16* HB = (const bf16*)(F.ws + WS_HB); const bf16* Wt = (const bf16*)(F.ws + WS_WPW1); bf16* U = (bf16*)(F.ws + WS_U);
    const float* bias = F.in[I_PW1B];
    RowLin rp{HB, (size_t)D};
    for (int u = F.wg; u < (T / 128) * 16; u += F.G) {
        const int mt = u / 16, nt = u % 16;
        auto epi = [&](int mb, int nb, const f32x16& c0, const f32x16& c1, int lane) {
            const int h = lane >> 5, cl = lane & 31, col = (nb >> 1) + cl; const float ba = bias[col], bg = bias[1024 + col];
#pragma unroll
            for (int i = 0; i < 16; ++i) U[(size_t)(mb + crow(i, h)) * D + col] = (bf16)f2bf((c0[i] + ba) * sigmoid_f(c1[i] + bg));
        };
        sgemm_tile(rp, Wt, D, mt * 128, nt * 128, epi, F.wave, F.lane);
    }
}
__device__ __forceinline__ void phase_dwconv(Frame& F) {
    const bf16* U = (const bf16*)(F.ws + WS_U); bf16* V1 = (bf16*)(F.ws + WS_V1);
    const float* dww = F.in[I_DWW]; const float* dwb = F.in[I_DWB]; const float* lng = F.in[I_LNG]; const float* lnb = F.in[I_LNB];
    const int gw = F.wg * NWAVES + F.wave, NGW = F.G * NWAVES;
    for (int row = gw; row < T; row += NGW) {
        const int l = row & (L - 1);
        f32x4 acc[4];
#pragma unroll
        for (int j = 0; j < 4; ++j) acc[j] = *(const f32x4*)(dwb + 4 * F.lane + 256 * j);
        for (int tp = 0; tp < CONVW; ++tp) { const int ll = l + tp - 15; if (ll < 0 || ll >= L) continue;
            const bf16* ur = U + (size_t)(row + tp - 15) * D; const float* wr = dww + (size_t)tp * D;
#pragma unroll
            for (int j = 0; j < 4; ++j) { const int o = 4 * F.lane + 256 * j; const u32x2 uu = *(const u32x2*)(ur + o); const f32x4 ww = *(const f32x4*)(wr + o);
                acc[j].x += bflo(uu.x) * ww.x; acc[j].y += bfhi(uu.x) * ww.y; acc[j].z += bflo(uu.y) * ww.z; acc[j].w += bfhi(uu.y) * ww.w; } }
        float s = 0.f;
#pragma unroll
        for (int j = 0; j < 4; ++j) s += (acc[j].x + acc[j].y) + (acc[j].z + acc[j].w);
        const float mean = wave_sum(s) * (1.f / D); float q = 0.f;
#pragma unroll
        for (int j = 0; j < 4; ++j) { acc[j] = acc[j] - mean; q += (acc[j].x * acc[j].x + acc[j].y * acc[j].y) + (acc[j].z * acc[j].z + acc[j].w * acc[j].w); }
        const float rstd = rsqrtf(wave_sum(q) * (1.f / D) + EPS);
#pragma unroll
        for (int j = 0; j < 4; ++j) { const int o = 4 * F.lane + 256 * j; const f32x4 gg = *(const f32x4*)(lng + o), bb = *(const f32x4*)(lnb + o);
            f32x4 y = acc[j] * rstd * gg + bb; y.x = silu_f(y.x); y.y = silu_f(y.y); y.z = silu_f(y.z); y.w = silu_f(y.w); acc[j] = y; }
        row_store_bf16(V1 + (size_t)row * D, acc, F.lane);
    }
}


namespace pg {
constexpr int BM = 256, BK = 64, HALF = 128, HTB = HALF * BK * 2, STAGE_BYTES = 8 * HTB;
constexpr int TAB_OFF = STAGE_BYTES;
__device__ __forceinline__ int lds_byte(int r, int c) { const int st = (r >> 4) * 2 + (c >> 5), rr = r & 15, cc = c & 31, ob = rr * 64 + cc * 2; return st * 1024 + (ob ^ (((ob >> 9) & 1) << 5)); }
__device__ __forceinline__ void stage_rc(int b, int& R, int& C) { const int st = b / 1024, sb = b % 1024, swz = sb ^ (((sb >> 9) & 1) << 5); R = (st >> 1) * 16 + swz / 64; C = (st & 1) * 32 + (swz % 64) / 2; }
__device__ __forceinline__ int perm32(int rho) { const int n = rho >> 4, i = rho & 15; return 8 * (i >> 2) + 4 * n + (i & 3); }
__device__ __forceinline__ unsigned cvt_pk_bf16(float lo, float hi) { unsigned r; asm volatile("v_cvt_pk_bf16_f32 %0, %1, %2" : "=v"(r) : "v"(lo), "v"(hi)); return r; }

struct GU { const char* B; int p0, p1, p2, p3; };

template <class Epi, class Sched>
__device__ __forceinline__ void gemm_phase(LAS unsigned char* lds, const char* Abase, const int K, const Sched& S, const Epi& E) {
    const int tid = threadIdx.x, wid = __builtin_amdgcn_readfirstlane(tid >> 6), lane = tid & 63, wr = wid >> 2, wc = wid & 3, fr = lane & 15, fq = lane >> 4;
    const int nt = K / BK;
    int sR[2], sC[2]; unsigned voffB[2];
#pragma unroll
    for (int i = 0; i < 2; ++i) { int R, C; stage_rc(tid * 16 + i * 8192, R, C); sR[i] = R; sC[i] = C; const int Rb = Epi::PERM ? ((R & ~31) + perm32(R & 31)) : R; voffB[i] = (unsigned)(Rb * K + C) * 2u; }
    const size_t kstep = (size_t)(BK * 2);
    const size_t hstep = (size_t)HALF * K * 2;
    const unsigned ldsw = (unsigned)wid * 1024u;
    const int aoff = lds_byte(wr * 64 + fr, fq * 8), boff = lds_byte(wc * 32 + fr, fq * 8);
#define PG_SA(b, h) (((b) * 2 + (h)) * HTB)
#define PG_SB(b, h) ((4 + (b) * 2 + (h)) * HTB)
#define PG_STAGE(bufoff, gbase, voff) do { _Pragma("unroll") for (int _i = 0; _i < 2; ++_i) \
        __builtin_amdgcn_global_load_lds((const unsigned*)((const char*)(gbase) + (voff)[_i]), (LAS unsigned*)(lds + (bufoff) + ldsw + _i * 8192), 16, 0, 0); } while (0)
#define PG_LDA(dst, b, h) do { _Pragma("unroll") for (int m = 0; m < 4; ++m) _Pragma("unroll") for (int k = 0; k < 2; ++k) dst[m][k] = *(const LAS bf16x8*)(lds + PG_SA(b, h) + aoff + m * 2048 + k * 1024); } while (0)
#define PG_LDB(dst, b, h) do { _Pragma("unroll") for (int n = 0; n < 2; ++n) _Pragma("unroll") for (int k = 0; k < 2; ++k) dst[n][k] = *(const LAS bf16x8*)(lds + PG_SB(b, h) + boff + n * 2048 + k * 1024); } while (0)
#define PG_MMA(ai, bj, At, Bt) do { __builtin_amdgcn_s_setprio(1); _Pragma("unroll") for (int m = 0; m < 4; ++m) _Pragma("unroll") for (int n = 0; n < 2; ++n) _Pragma("unroll") for (int k = 0; k < 2; ++k) \
        acc[ai][bj][m][n] = __builtin_amdgcn_mfma_f32_16x16x32_bf16(Bt[n][k], At[m][k], acc[ai][bj][m][n], 0, 0, 0); __builtin_amdgcn_s_setprio(0); } while (0)
#define PG_WAIT_V(n) asm volatile("s_waitcnt vmcnt(" #n ")" ::: "memory")
#define PG_WAIT_L(n) asm volatile("s_waitcnt lgkmcnt(" #n ")" ::: "memory")
#define PG_BAR __builtin_amdgcn_s_barrier()
#define PG_SCHED __builtin_amdgcn_sched_barrier(0)
    GU cur, nxt; int ui = 0;
    if (!S.next(0, cur)) return;
    f32x4 acc[2][2][4][2];
#pragma unroll
    for (int a = 0; a < 2; ++a)
#pragma unroll
        for (int b = 0; b < 2; ++b)
#pragma unroll
            for (int m = 0; m < 4; ++m)
#pragma unroll
                for (int n = 0; n < 2; ++n) acc[a][b][m][n] = (f32x4){0.f, 0.f, 0.f, 0.f};
    bf16x8 At[4][2], B0[2][2], B1[2][2];
    if constexpr (Sched::GATHER) { S.stage_table(cur, 0, lds, wid, lane); PG_WAIT_V(0); PG_BAR; }
    unsigned voC[2][2], voN[2][2];
#pragma unroll
    for (int h = 0; h < 2; ++h)
#pragma unroll
        for (int i = 0; i < 2; ++i) { voC[h][i] = S.voff(cur, 0, lds, h * HALF + sR[i], sC[i]); voN[h][i] = voC[h][i]; }
    const char* cB = cur.B;
    PG_STAGE(PG_SB(0, 0), cB, voffB); PG_STAGE(PG_SB(0, 1), cB + hstep, voffB); PG_STAGE(PG_SA(0, 0), Abase, voC[0]); PG_STAGE(PG_SA(0, 1), Abase, voC[1]);
    if (wr == 1) PG_BAR;
    PG_WAIT_V(2); PG_BAR;
    PG_STAGE(PG_SB(1, 0), cB + kstep, voffB); PG_STAGE(PG_SA(1, 0), Abase + kstep, voC[0]); PG_STAGE(PG_SB(1, 1), cB + hstep + kstep, voffB);
    PG_WAIT_V(6); PG_BAR;
    for (;;) {
        const bool has_next = S.next(ui + 1, nxt);
        if constexpr (Sched::GATHER) { if (has_next) S.stage_table(nxt, (ui + 1) & 1, lds, wid, lane); }
        const char* nB = has_next ? nxt.B : cB;
        for (int t = 0; t < nt; t += 2) {
            const bool last = (t == nt - 2);
            if (last && has_next) {
#pragma unroll
                for (int h = 0; h < 2; ++h)
#pragma unroll
                    for (int i = 0; i < 2; ++i) voN[h][i] = S.voff(nxt, (ui + 1) & 1, lds, h * HALF + sR[i], sC[i]);
            }
            unsigned vo2[2][2];
#pragma unroll
            for (int h = 0; h < 2; ++h)
#pragma unroll
                for (int i = 0; i < 2; ++i) vo2[h][i] = last ? voN[h][i] : voC[h][i];
            const char* a1 = Abase + (size_t)(t + 1) * kstep;
            const char* a2 = last ? Abase : Abase + (size_t)(t + 2) * kstep; const char* b2 = last ? nB : cB + (size_t)(t + 2) * kstep;
            const char* a3 = a2 + kstep; const char* b3 = b2 + kstep;
            PG_LDB(B0, 0, 0); PG_LDB(B1, 0, 1); PG_SCHED; PG_LDA(At, 0, 0); PG_STAGE(PG_SA(1, 1), a1, voC[1]);
            PG_WAIT_V(8); PG_WAIT_L(0); PG_BAR; PG_MMA(0, 0, At, B0); PG_MMA(0, 1, At, B1); PG_BAR; PG_SCHED;
            PG_LDA(At, 0, 1); PG_STAGE(PG_SB(0, 0), b2, voffB); PG_STAGE(PG_SB(0, 1), b2 + hstep, voffB); PG_STAGE(PG_SA(0, 0), a2, vo2[0]);
            PG_WAIT_V(8); PG_WAIT_L(0); PG_BAR; PG_MMA(1, 0, At, B0); PG_MMA(1, 1, At, B1); PG_BAR; PG_SCHED;
            PG_LDB(B0, 1, 0); PG_LDB(B1, 1, 1); PG_SCHED; PG_LDA(At, 1, 0); PG_STAGE(PG_SA(0, 1), a2, vo2[1]);
            PG_WAIT_V(8); PG_WAIT_L(0); PG_BAR; PG_MMA(0, 0, At, B0); PG_MMA(0, 1, At, B1); PG_BAR; PG_SCHED;
            PG_LDA(At, 1, 1); PG_STAGE(PG_SB(1, 0), b3, voffB); PG_STAGE(PG_SB(1, 1), b3 + hstep, voffB); PG_STAGE(PG_SA(1, 0), a3, vo2[0]);
            PG_WAIT_V(8); PG_WAIT_L(0); PG_BAR; PG_MMA(1, 0, At, B0); PG_MMA(1, 1, At, B1); PG_BAR; PG_SCHED;
        }
        if (wr == 0) PG_BAR;
        E(acc, cur, wr, wc, fr, fq);
        if (!has_next) break;
#pragma unroll
        for (int a = 0; a < 2; ++a)
#pragma unroll
            for (int b = 0; b < 2; ++b)
#pragma unroll
                for (int m = 0; m < 4; ++m)
#pragma unroll
                    for (int n = 0; n < 2; ++n) acc[a][b][m][n] = (f32x4){0.f, 0.f, 0.f, 0.f};
        cur = nxt; cB = nB; ++ui;
#pragma unroll
        for (int h = 0; h < 2; ++h)
#pragma unroll
            for (int i = 0; i < 2; ++i) voC[h][i] = voN[h][i];
        if (wr == 1) PG_BAR;
    }
    PG_WAIT_V(0);
    PG_BAR;
#undef PG_SA
#undef PG_SB
#undef PG_STAGE
#undef PG_LDA
#undef PG_LDB
#undef PG_MMA
#undef PG_WAIT_V
#undef PG_WAIT_L
#undef PG_BAR
#undef PG_SCHED
}

__device__ __forceinline__ void static_tile(int L, int nM, int nN, int& pm, int& pn) {
    const int nwg = nM * nN; int wgid = L; { const int q = nwg / 8, r = nwg % 8, xcd = wgid % 8, off = wgid / 8; wgid = (xcd < r ? xcd * (q + 1) : r * (q + 1) + (xcd - r) * q) + off; }
    const int nig = 8 * nN, gid = wgid / nig, fm = gid * 8, gsz = (nM - fm) < 8 ? (nM - fm) : 8;
    pm = fm + ((wgid % nig) % gsz); pn = (wgid % nig) / gsz;
}
struct DenseSched {
    static constexpr bool GATHER = false;
    const char* Bt; int K, nM, nN, G, c, xn, xm0, xpn;
    __device__ __forceinline__ bool next(int i, GU& u) const {
        const int L = i * G + c, nmain = nM * nN; int pm, pn;
        if (L < nmain) static_tile(L, nM, nN, pm, pn); else if (L < nmain + xn) { pm = xm0 + (L - nmain); pn = xpn; } else return false;
        u.B = Bt + (size_t)pn * BM * K * 2; u.p0 = pm; u.p1 = pn; u.p2 = 0; u.p3 = 0; return true;
    }
    __device__ __forceinline__ unsigned voff(const GU& u, int, LAS unsigned char*, int R, int C) const { return (unsigned)(((u.p0 * BM + R) * K + C) * 2); }
    __device__ __forceinline__ void stage_table(const GU&, int, LAS unsigned char*, int, int) const {}
};
template <bool GATHER_> struct MoeSched {
    static constexpr bool GATHER = GATHER_;
    const char* Wt; size_t wstride; int K; const int* list; LAS int* mm; int G, c;
    __device__ __forceinline__ bool next(int i, GU& u) const {
        int L = i * G + c;
        for (int e = 0; e < 16; ++e) { const int n = mm[e], nu = ((n + 255) >> 8) * 4;
            if (L < nu) { const int rt = L >> 2, pn = L & 3; u.B = Wt + (size_t)e * wstride + (size_t)pn * BM * K * 2; u.p0 = e; u.p1 = rt; u.p2 = pn; u.p3 = mm[16 + e]; return true; }
            L -= nu; }
        return false;
    }
    __device__ __forceinline__ unsigned voff(const GU& u, int buf, LAS unsigned char* lds, int R, int C) const {
        if constexpr (GATHER_) { const int tok = ((const LAS int*)(lds + TAB_OFF))[buf * 256 + R]; return (unsigned)((tok * K + C) * 2); }
        else return (unsigned)(((u.p3 + u.p1 * BM + R) * K + C) * 2);
    }
    __device__ __forceinline__ void stage_table(const GU& u, int buf, LAS unsigned char* lds, int wid, int lane) const {
        if constexpr (GATHER_) { const int r = (wid & 3) * 64 + lane;
            __builtin_amdgcn_global_load_lds((const unsigned*)(list + u.p0 * CAP + u.p1 * BM + r), (LAS unsigned*)(lds + TAB_OFF + buf * 1024 + (wid & 3) * 256), 4, 0, 0); }
    }
};

struct EpiInProj {
    static constexpr bool PERM = false;
    unsigned char* ws;
    __device__ __forceinline__ void operator()(const f32x4 (&acc)[2][2][4][2], const GU& u, int wr, int wc, int fr, int fq) const {
        const int pm = u.p0, pn = u.p1; const bool isctx = pm >= T / BM;
        float inv[4];
#pragma unroll
        for (int j = 0; j < 4; ++j) inv[j] = exp2f(-(float)(4 * fq + j) * (13.287712379549449f / 16.f));
#pragma unroll
        for (int bj = 0; bj < 2; ++bj) {
            const int cb = pn * BM + bj * HALF + wc * 32;
            bf16* dst; int pitch, cbase; bool rope = false;
            if (cb < 512) { dst = (bf16*)(ws + WS_UF); pitch = 512; cbase = 0; }
            else if (cb < 1024) { dst = (bf16*)(ws + WS_Q); pitch = 512; cbase = 512; rope = true; }
            else if (cb < 1152) { dst = isctx ? (bf16*)(ws + WS_CK) : (bf16*)(ws + WS_K); pitch = 128; cbase = 1024; rope = !isctx; }
            else { dst = isctx ? (bf16*)(ws + WS_CV) : (bf16*)(ws + WS_V); pitch = 128; cbase = 1152; }
            const bool bycol = ((cb >> 5) & 1) != 0;
#pragma unroll
            for (int ai = 0; ai < 2; ++ai)
#pragma unroll
                for (int m = 0; m < 4; ++m) {
                    const int row = pm * BM + ai * HALF + wr * 64 + m * 16 + fr;
                    f32x4 v0 = acc[ai][bj][m][0], v1 = acc[ai][bj][m][1];
                    if (rope) { const int l = row & (L - 1); const float pos = (float)(bycol ? (l & 63) : (l >> 6));
#pragma unroll
                        for (int j = 0; j < 4; ++j) { const float ang = pos * inv[j], cs = __cosf(ang), sn = __sinf(ang); const float x1 = v0[j], x2 = v1[j]; v0[j] = x1 * cs - x2 * sn; v1[j] = x1 * sn + x2 * cs; } }
                    const int orow = isctx ? row - T : row;
                    if (FAST_ATTN && cb >= 1152) {
                        const int kp = isctx ? CL : L, bb = isctx ? (orow >> 8) : (orow >> 13), key = isctx ? (orow & (CL - 1)) : (orow & (L - 1));
#pragma unroll
                        for (int n = 0; n < 2; ++n)
#pragma unroll
                            for (int j = 0; j < 4; ++j) { const int c = (cb - 1152) + 16 * n + 4 * fq + j;
                                dst[((size_t)bb * 128 + c) * kp + key] = (bf16)f2bf(n ? v1[j] : v0[j]); }
                        continue;
                    }
                    bf16* o = dst + (size_t)orow * pitch + (cb - cbase) + 4 * fq;
                    u32x2 w0, w1; w0.x = cvt_pk_bf16(v0[0], v0[1]); w0.y = cvt_pk_bf16(v0[2], v0[3]); w1.x = cvt_pk_bf16(v1[0], v1[1]); w1.y = cvt_pk_bf16(v1[2], v1[3]);
                    *(u32x2*)o = w0; *(u32x2*)(o + 16) = w1;
                }
        }
    }
};
struct EpiRes {
    static constexpr bool PERM = false;
    const float* base; float* X; const float* gate; const float* bias;
    __device__ __forceinline__ void operator()(const f32x4 (&acc)[2][2][4][2], const GU& u, int wr, int wc, int fr, int fq) const {
        const int row0 = u.p0 * BM + wr * 64 + fr, col0 = u.p1 * BM + wc * 32 + 4 * fq; const int b = (u.p0 * BM) >> 13;
        f32x4 gv[2][2], bv[2][2];
#pragma unroll
        for (int bj = 0; bj < 2; ++bj)
#pragma unroll
            for (int n = 0; n < 2; ++n) { gv[bj][n] = *(const f32x4*)(gate + (size_t)b * 6144 + col0 + bj * HALF + n * 16); bv[bj][n] = bias ? *(const f32x4*)(bias + col0 + bj * HALF + n * 16) : (f32x4){0.f, 0.f, 0.f, 0.f}; }
#pragma unroll
        for (int ai = 0; ai < 2; ++ai)
#pragma unroll
            for (int mp = 0; mp < 2; ++mp) {
                f32x4 bs[2][2][2];
#pragma unroll
                for (int mm = 0; mm < 2; ++mm) { const size_t off = (size_t)(row0 + ai * HALF + (2 * mp + mm) * 16) * D + col0;
#pragma unroll
                    for (int bj = 0; bj < 2; ++bj)
#pragma unroll
                        for (int n = 0; n < 2; ++n) bs[mm][bj][n] = *(const f32x4*)(base + off + bj * HALF + n * 16); }
#pragma unroll
                for (int mm = 0; mm < 2; ++mm) { const int m = 2 * mp + mm; const size_t off = (size_t)(row0 + ai * HALF + m * 16) * D + col0;
#pragma unroll
                    for (int bj = 0; bj < 2; ++bj)
#pragma unroll
                        for (int n = 0; n < 2; ++n) *(f32x4*)(X + off + bj * HALF + n * 16) = bs[mm][bj][n] + gv[bj][n] * (acc[ai][bj][m][n] + bv[bj][n]); }
                asm volatile("" ::: "memory"); }
    }
};
template <bool BASEBF> struct EpiResB {
    static constexpr bool PERM = true;
    const float* basef; bf16* XB; const float* gate; const float* bias;
    __device__ __forceinline__ void operator()(const f32x4 (&acc)[2][2][4][2], const GU& u, int wr, int wc, int fr, int fq) const {
        const int row0 = u.p0 * BM + wr * 64 + fr, col0 = u.p1 * BM + wc * 32 + 8 * fq; const int b = (u.p0 * BM) >> 13;
        f32x4 gv[2][2], bv[2][2];
#pragma unroll
        for (int bj = 0; bj < 2; ++bj)
#pragma unroll
            for (int n = 0; n < 2; ++n) { gv[bj][n] = *(const f32x4*)(gate + (size_t)b * 6144 + col0 + bj * HALF + n * 4); bv[bj][n] = bias ? *(const f32x4*)(bias + col0 + bj * HALF + n * 4) : (f32x4){0.f, 0.f, 0.f, 0.f}; }
        constexpr int NB2 = BASEBF ? 4 : 2;
#pragma unroll
        for (int ai = 0; ai < 2; ++ai)
#pragma unroll
            for (int mb = 0; mb < 4; mb += NB2) {
                f32x4 bf[BASEBF ? 1 : NB2][2][2]; u32x4 bw[BASEBF ? NB2 : 1][2];
#pragma unroll
                for (int mm = 0; mm < NB2; ++mm) { const size_t off = (size_t)(row0 + ai * HALF + (mb + mm) * 16) * D + col0;
#pragma unroll
                    for (int bj = 0; bj < 2; ++bj) {
                        if (BASEBF) bw[mm][bj] = *(const u32x4*)(XB + off + bj * HALF);
                        else { bf[mm][bj][0] = *(const f32x4*)(basef + off + bj * HALF); bf[mm][bj][1] = *(const f32x4*)(basef + off + bj * HALF + 4); } } }
#pragma unroll
                for (int mm = 0; mm < NB2; ++mm) { const int m = mb + mm; const size_t off = (size_t)(row0 + ai * HALF + m * 16) * D + col0;
#pragma unroll
                    for (int bj = 0; bj < 2; ++bj) { f32x4 o[2];
#pragma unroll
                        for (int n = 0; n < 2; ++n) { f32x4 bsv;
                            if (BASEBF) { const unsigned wa = n ? bw[mm][bj].z : bw[mm][bj].x, wb = n ? bw[mm][bj].w : bw[mm][bj].y; bsv = (f32x4){bflo(wa), bfhi(wa), bflo(wb), bfhi(wb)}; } else bsv = bf[mm][bj][n];
                            o[n] = bsv + gv[bj][n] * (acc[ai][bj][m][n] + bv[bj][n]); }
                        u32x4 w2; w2.x = cvt_pk_bf16(o[0][0], o[0][1]); w2.y = cvt_pk_bf16(o[0][2], o[0][3]); w2.z = cvt_pk_bf16(o[1][0], o[1][1]); w2.w = cvt_pk_bf16(o[1][2], o[1][3]);
                        *(u32x4*)(XB + off + bj * HALF) = w2; } }
                asm volatile("" ::: "memory"); }
    }
};
struct EpiGLU {
    static constexpr bool PERM = true;
    bf16* U; const float* bias;
    __device__ __forceinline__ void operator()(const f32x4 (&acc)[2][2][4][2], const GU& u, int wr, int wc, int fr, int fq) const {
        const int row0 = u.p0 * BM + wr * 64 + fr, col0 = u.p1 * HALF + wc * 32 + 8 * fq;
        f32x4 ba[2], bg[2];
#pragma unroll
        for (int n = 0; n < 2; ++n) { ba[n] = *(const f32x4*)(bias + col0 + 4 * n); bg[n] = *(const f32x4*)(bias + 1024 + col0 + 4 * n); }
#pragma unroll
        for (int ai = 0; ai < 2; ++ai)
#pragma unroll
            for (int m = 0; m < 4; ++m) { f32x4 o[2];
#pragma unroll
                for (int n = 0; n < 2; ++n) { const f32x4 a = acc[ai][0][m][n] + ba[n], g = acc[ai][1][m][n] + bg[n];
#pragma unroll
                    for (int j = 0; j < 4; ++j) o[n][j] = a[j] * sigmoid_f(g[j]); }
                u32x4 w; w.x = cvt_pk_bf16(o[0][0], o[0][1]); w.y = cvt_pk_bf16(o[0][2], o[0][3]); w.z = cvt_pk_bf16(o[1][0], o[1][1]); w.w = cvt_pk_bf16(o[1][2], o[1][3]);
                *(u32x4*)(U + (size_t)(row0 + ai * HALF + m * 16) * D + col0) = w; }
    }
};
struct EpiGateUp {
    static constexpr bool PERM = true;
    bf16* HID; const float* slot_w; LAS int* mm;
    __device__ __forceinline__ void operator()(const f32x4 (&acc)[2][2][4][2], const GU& u, int wr, int wc, int fr, int fq) const {
        const int e = u.p0, n_e = mm[e], r0 = u.p1 * BM + wr * 64 + fr, col0 = u.p2 * HALF + wc * 32 + 8 * fq;
        float wv[2][4];
#pragma unroll
        for (int ai = 0; ai < 2; ++ai)
#pragma unroll
            for (int m = 0; m < 4; ++m) wv[ai][m] = slot_w[e * CAP + r0 + ai * HALF + m * 16];
#pragma unroll
        for (int ai = 0; ai < 2; ++ai)
#pragma unroll
            for (int m = 0; m < 4; ++m) { const int r = r0 + ai * HALF + m * 16;
                if (r < n_e) { const float w = wv[ai][m]; f32x4 o[2];
#pragma unroll
                    for (int n = 0; n < 2; ++n) { const f32x4 g = acc[ai][0][m][n], up = acc[ai][1][m][n];
#pragma unroll
                        for (int j = 0; j < 4; ++j) o[n][j] = w * silu_f(g[j]) * up[j]; }
                    u32x4 q; q.x = cvt_pk_bf16(o[0][0], o[0][1]); q.y = cvt_pk_bf16(o[0][2], o[0][3]); q.z = cvt_pk_bf16(o[1][0], o[1][1]); q.w = cvt_pk_bf16(o[1][2], o[1][3]);
                    *(u32x4*)(HID + (size_t)(u.p3 + r) * FF + col0) = q; } }
    }
};
struct EpiDown {
    static constexpr bool PERM = true;
    bf16* Y; LAS int* mm;
    __device__ __forceinline__ void operator()(const f32x4 (&acc)[2][2][4][2], const GU& u, int wr, int wc, int fr, int fq) const {
        const int e = u.p0, n_e = mm[e], r0 = u.p1 * BM + wr * 64 + fr, col0 = u.p2 * BM + wc * 32 + 8 * fq;
#pragma unroll
        for (int ai = 0; ai < 2; ++ai)
#pragma unroll
            for (int m = 0; m < 4; ++m) { const int r = r0 + ai * HALF + m * 16;
                if (r < n_e) {
#pragma unroll
                    for (int bj = 0; bj < 2; ++bj) { const f32x4 v0 = acc[ai][bj][m][0], v1 = acc[ai][bj][m][1];
                        u32x4 q; q.x = cvt_pk_bf16(v0[0], v0[1]); q.y = cvt_pk_bf16(v0[2], v0[3]); q.z = cvt_pk_bf16(v1[0], v1[1]); q.w = cvt_pk_bf16(v1[2], v1[3]);
                        *(u32x4*)(Y + (size_t)(u.p3 + r) * D + col0 + bj * HALF) = q; } } }
    }
};
}

__device__ __forceinline__ void fast_inproj(Frame& F) {
    pg::DenseSched S{(const char*)(F.ws + WS_WIN), D, T / 256, N_IN / 256, F.G, F.wg, TC / 256, T / 256, 4};
    pg::EpiInProj E{F.ws};
    pg::gemm_phase(F.lds, (const char*)(F.ws + WS_HB), D, S, E);
    const int nbusy = (T / 256) * (N_IN / 256) + TC / 256 - 2 * F.G;
    if (nbusy > 0 && nbusy < F.G) { if (F.wg >= nbusy) t_items_tail(F, (F.wg - nbusy) * NWAVES + F.wave, (F.G - nbusy) * NWAVES); }
    else t_items_tail(F, F.wg * NWAVES + F.wave, F.G * NWAVES);
}
__device__ __forceinline__ void fast_outproj(Frame& F, size_t a_off, size_t w_off, const float* base, float* X, const float* gate, const float* bias) {
    pg::DenseSched S{(const char*)(F.ws + w_off), D, T / 256, D / 256, F.G, F.wg, 0, 0, 0};
    if (XBF16) {
        if (base == X) { pg::EpiResB<true> E{nullptr, (bf16*)(F.ws + WS_XB), gate, bias}; pg::gemm_phase(F.lds, (const char*)(F.ws + a_off), D, S, E); }
        else { pg::EpiResB<false> E{base, (bf16*)(F.ws + WS_XB), gate, bias}; pg::gemm_phase(F.lds, (const char*)(F.ws + a_off), D, S, E); }
    } else { pg::EpiRes E{base, X, gate, bias}; pg::gemm_phase(F.lds, (const char*)(F.ws + a_off), D, S, E); }
}
__device__ __forceinline__ void fast_pw1(Frame& F) {
    pg::DenseSched S{(const char*)(F.ws + WS_WPW1), D, T / 256, 2048 / 256, F.G, F.wg, 0, 0, 0};
    pg::EpiGLU E{(bf16*)(F.ws + WS_U), F.in[I_PW1B]};
    pg::gemm_phase(F.lds, (const char*)(F.ws + WS_HB), D, S, E);
}
__device__ __forceinline__ void fast_moe_gateup(Frame& F, int layer) {
    LAS int* mm = moe_map(F, layer);
    pg::MoeSched<true> S{(const char*)(F.ws + WS_WGU) + (size_t)layer * 16 * 1024 * 1024 * 2, (size_t)1024 * 1024 * 2, D, (const int*)(F.ws + WS_SLOTT) + layer * 16 * CAP, mm, F.G, F.wg};
    pg::EpiGateUp E{(bf16*)(F.ws + WS_HID), (const float*)(F.ws + WS_SLOTW) + layer * 16 * CAP, mm};
    pg::gemm_phase(F.lds, (const char*)(F.ws + WS_HB), D, S, E);
}
__device__ __forceinline__ void fast_moe_down(Frame& F, int layer) {
    LAS int* mm = moe_map(F, layer);
    pg::MoeSched<false> S{(const char*)(F.ws + WS_WDN) + (size_t)layer * 16 * 1024 * 512 * 2, (size_t)1024 * 512 * 2, FF, nullptr, mm, F.G, F.wg};
    pg::EpiDown E{(bf16*)(F.ws + WS_Y), mm};
    pg::gemm_phase(F.lds, (const char*)(F.ws + WS_HID), FF, S, E);
}


struct AttnBlk { const bf16* kp; const bf16* vp; int pitch; int kb; bool valid, masked; };
__device__ __forceinline__ AttnBlk attn_blk(const unsigned char* ws, int bi, int b, int kvh, int qs) {
    AttnBlk a;
    if (bi < 8) { a.kp = (const bf16*)(ws + WS_CK) + (size_t)(b * CL + bi * 32) * 128 + kvh * 64; a.vp = (const bf16*)(ws + WS_CV) + (size_t)(b * 2 + kvh) * 64 * CL + bi * 32; a.pitch = CL; a.kb = 0; a.valid = true; a.masked = false; }
    else { const int kb = qs - 128 + 32 * (bi - 8); a.valid = (kb >= 0 && kb < L); a.kb = kb; a.masked = true; a.pitch = L;
        a.kp = (const bf16*)(ws + WS_K) + (size_t)(b * L + kb) * 128 + kvh * 64; a.vp = (const bf16*)(ws + WS_V) + (size_t)(b * 2 + kvh) * 64 * L + kb; }
    return a;
}
__device__ __forceinline__ void attn_load(const AttnBlk& a, int r, int h, bf16x8 (&kf)[4], u32x4 (&vf)[2][2]) {
    if (a.valid) {
#pragma unroll
        for (int s = 0; s < 4; ++s) kf[s] = *(const bf16x8*)(a.kp + (size_t)r * 128 + 16 * s + 8 * h);
#pragma unroll
        for (int db = 0; db < 2; ++db)
#pragma unroll
            for (int ks = 0; ks < 2; ++ks) { const bf16* vr = a.vp + (size_t)(32 * db + r) * a.pitch + 16 * ks + 4 * h;
                const u32x2 lo = *(const u32x2*)vr, hi = *(const u32x2*)(vr + 8); vf[db][ks] = (u32x4){lo.x, lo.y, hi.x, hi.y}; }
    }
}
__device__ __forceinline__ void attn_compute(const AttnBlk& a, int qs, int r, int h, const bf16x8 (&kf)[4], const u32x4 (&vf)[2][2], const bf16x8 (&qf)[2][4],
                                             f32x16 (&o)[2][2], float (&m)[2], float (&l)[2]) {
    if (!a.valid) return;
#pragma unroll
    for (int nq = 0; nq < 2; ++nq) {
        f32x16 st;
#pragma unroll
        for (int i = 0; i < 16; ++i) st[i] = 0.f;
#pragma unroll
        for (int s = 0; s < 4; ++s) st = __builtin_amdgcn_mfma_f32_32x32x16_bf16(kf[s], qf[nq][s], st, 0, 0, 0);
        float t[16]; float tmax = -INFINITY;
        const int dbase = a.kb - qs - 32 * nq - r + 4 * h;
#pragma unroll
        for (int i = 0; i < 16; ++i) { float v = st[i] * (0.125f * 1.4426950408889634f);
            if (a.masked) { const int df = dbase + (i & 3) + 8 * (i >> 2); v = (df >= -128 && df <= 128) ? v : -INFINITY; }
            t[i] = v; tmax = fmaxf(tmax, v); }
        tmax = fmaxf(tmax, __shfl_xor(tmax, 32));
        const float mn = fmaxf(m[nq], tmax), alpha = __builtin_amdgcn_exp2f(m[nq] - mn); m[nq] = mn;
        float ps = 0.f;
#pragma unroll
        for (int i = 0; i < 16; ++i) { t[i] = __builtin_amdgcn_exp2f(t[i] - mn); ps += t[i]; }
        l[nq] = l[nq] * alpha + ps;
#pragma unroll
        for (int i = 0; i < 16; ++i) { o[0][nq][i] *= alpha; o[1][nq][i] *= alpha; }
        bf16x8 pf[2];
#pragma unroll
        for (int ks = 0; ks < 2; ++ks) { const u32x4 w = {pkbf(t[8 * ks], t[8 * ks + 1]), pkbf(t[8 * ks + 2], t[8 * ks + 3]), pkbf(t[8 * ks + 4], t[8 * ks + 5]), pkbf(t[8 * ks + 6], t[8 * ks + 7])};
            pf[ks] = __builtin_bit_cast(bf16x8, w); }
#pragma unroll
        for (int db = 0; db < 2; ++db)
#pragma unroll
            for (int ks = 0; ks < 2; ++ks) o[db][nq] = __builtin_amdgcn_mfma_f32_32x32x16_bf16(__builtin_bit_cast(bf16x8, vf[db][ks]), pf[ks], o[db][nq], 0, 0, 0);
    }
}
__device__ __forceinline__ void phase_attn_mfma(Frame& F) {
    const bf16* Q = (const bf16*)(F.ws + WS_Q); bf16* MIX = (bf16*)(F.ws + WS_MIX);
    const int g = F.wave >> 1, half = F.wave & 1, r = F.lane & 31, h = F.lane >> 5;
    for (int item = F.wg; item < NB * 2 * 64; item += F.G) {
        const int qb = item & 63, kvh = (item >> 6) & 1, b = item >> 7, hd = kvh * 4 + g, qs = qb * 128 + half * 64;
        bf16x8 qf[2][4];
#pragma unroll
        for (int nq = 0; nq < 2; ++nq)
#pragma unroll
            for (int s = 0; s < 4; ++s) qf[nq][s] = *(const bf16x8*)(Q + (size_t)(b * L + qs + 32 * nq + r) * 512 + hd * 64 + 16 * s + 8 * h);
        f32x16 o[2][2];
#pragma unroll
        for (int db = 0; db < 2; ++db)
#pragma unroll
            for (int nq = 0; nq < 2; ++nq)
#pragma unroll
                for (int i = 0; i < 16; ++i) o[db][nq][i] = 0.f;
        float m[2], l[2];
        m[0] = m[1] = F.in[I_SINK][hd] * 1.4426950408889634f; l[0] = l[1] = (h == 0) ? 1.f : 0.f;
        bf16x8 kfA[4], kfB[4]; u32x4 vfA[2][2], vfB[2][2];
        AttnBlk ba = attn_blk(F.ws, 0, b, kvh, qs), bb;
        attn_load(ba, r, h, kfA, vfA);
#pragma unroll 1
        for (int bi = 0; bi < 18; bi += 2) {
            bb = attn_blk(F.ws, bi + 1, b, kvh, qs); attn_load(bb, r, h, kfB, vfB);
            attn_compute(ba, qs, r, h, kfA, vfA, qf, o, m, l);
            if (bi + 2 < 18) { ba = attn_blk(F.ws, bi + 2, b, kvh, qs); attn_load(ba, r, h, kfA, vfA); }
            attn_compute(bb, qs, r, h, kfB, vfB, qf, o, m, l);
        }
#pragma unroll
        for (int nq = 0; nq < 2; ++nq) {
            const float lt = l[nq] + __shfl_xor(l[nq], 32), il = 1.f / lt;
            bf16* orow = MIX + (size_t)(b * L + qs + 32 * nq + r) * 1024 + 512 + hd * 64;
#pragma unroll
            for (int db = 0; db < 2; ++db)
#pragma unroll
                for (int i4 = 0; i4 < 4; ++i4) { u32x2 w; w.x = pkbf(o[db][nq][4 * i4] * il, o[db][nq][4 * i4 + 1] * il); w.y = pkbf(o[db][nq][4 * i4 + 2] * il, o[db][nq][4 * i4 + 3] * il);
                    *(u32x2*)(orow + 32 * db + 8 * i4 + 4 * h) = w; }
        }
    }
}


__device__ __forceinline__ float half_max(float v) { const auto r = __builtin_amdgcn_permlane32_swap(__float_as_uint(v), __float_as_uint(v), false, false); return fmaxf(__uint_as_float(r[0]), __uint_as_float(r[1])); }
__device__ __forceinline__ float half_sum(float v) { const auto r = __builtin_amdgcn_permlane32_swap(__float_as_uint(v), __float_as_uint(v), false, false); return __uint_as_float(r[0]) + __uint_as_float(r[1]); }
constexpr int AT_KP = 72, AT_VP = 136;
constexpr int AT_KB = 128 * AT_KP * 2, AT_BUF = AT_KB + 64 * AT_VP * 2;
struct AtChunk { const bf16* kg; const bf16* vg; int vpitch, lc, b, kvh, qb, c; bool valid, local, any; };
__device__ __forceinline__ AtChunk at_chunk(const unsigned char* ws, int seq, int wg, int G) {
    AtChunk k; const int item = wg + (seq / 5) * G; k.c = seq % 5; k.any = item < NB * 2 * 64;
    k.qb = item & 63; k.kvh = (item >> 6) & 1; k.b = (item >> 7) & 3; k.local = k.c >= 2; k.lc = k.c - 2;
    if (!k.local) { k.valid = k.any; k.vpitch = CL; k.kg = (const bf16*)(ws + WS_CK) + (size_t)(k.b * CL + 128 * k.c) * 128 + k.kvh * 64; k.vg = (const bf16*)(ws + WS_CV) + (size_t)(k.b * 2 + k.kvh) * 64 * CL + 128 * k.c; }
    else { const int key0 = 128 * k.qb - 128 + 128 * k.lc; k.valid = k.any && key0 >= 0 && key0 < L; k.vpitch = L;
        k.kg = (const bf16*)(ws + WS_K) + (size_t)(k.b * L + key0) * 128 + k.kvh * 64; k.vg = (const bf16*)(ws + WS_V) + (size_t)(k.b * 2 + k.kvh) * 64 * L + key0; }
    return k;
}
__device__ __forceinline__ void at_issue(const AtChunk& k, int tid, u32x4 (&rg)[4]) {
    if (k.valid) {
#pragma unroll
        for (int i = 0; i < 2; ++i) { const int id = tid + 512 * i; rg[i] = *(const u32x4*)(k.kg + (size_t)(id >> 3) * 128 + (id & 7) * 8); }
#pragma unroll
        for (int i = 0; i < 2; ++i) { const int id = tid + 512 * i; rg[2 + i] = *(const u32x4*)(k.vg + (size_t)(id >> 4) * k.vpitch + (id & 15) * 8); }
    }
}
__device__ __forceinline__ void at_write(const AtChunk& k, LAS unsigned char* buf, int tid, const u32x4 (&rg)[4]) {
    if (k.valid) {
#pragma unroll
        for (int i = 0; i < 2; ++i) { const int id = tid + 512 * i; *(LAS u32x4*)(buf + (id >> 3) * (AT_KP * 2) + (id & 7) * 16) = rg[i]; }
#pragma unroll
        for (int i = 0; i < 2; ++i) { const int id = tid + 512 * i; *(LAS u32x4*)(buf + AT_KB + (id >> 4) * (AT_VP * 2) + (id & 15) * 16) = rg[2 + i]; }
    }
}
__device__ __forceinline__ void at_load(LAS unsigned char* buf, int blk, int r, int h, bf16x8 (&kf)[4], u32x4 (&vf)[2][2]) {
#pragma unroll
    for (int s2 = 0; s2 < 4; ++s2) kf[s2] = *(const LAS bf16x8*)(buf + (32 * blk + r) * (AT_KP * 2) + (16 * s2 + 8 * h) * 2);
#pragma unroll
    for (int db = 0; db < 2; ++db)
#pragma unroll
        for (int ks = 0; ks < 2; ++ks) { const LAS unsigned char* vr = buf + AT_KB + (32 * db + r) * (AT_VP * 2) + (32 * blk + 16 * ks + 4 * h) * 2;
            const u32x2 lo = *(const LAS u32x2*)vr, hi = *(const LAS u32x2*)(vr + 16); vf[db][ks] = (u32x4){lo.x, lo.y, hi.x, hi.y}; }
}
__device__ __forceinline__ void at_math(const bf16x8 (&kf)[4], const u32x4 (&vf)[2][2], bool masked, int kbrel, int r, int h, const bf16x8 (&qf)[2][4], f32x16 (&o)[2][2], float (&m)[2], float (&l)[2]) {
    constexpr float C = 0.125f * 1.4426950408889634f;
#pragma unroll
    for (int nq = 0; nq < 2; ++nq) {
        f32x16 st;
#pragma unroll
        for (int i = 0; i < 16; ++i) st[i] = 0.f;
#pragma unroll
        for (int s2 = 0; s2 < 4; ++s2) st = __builtin_amdgcn_mfma_f32_32x32x16_bf16(kf[s2], qf[nq][s2], st, 0, 0, 0);
        if (masked) { const int dbase = kbrel - 32 * nq - r + 4 * h;
#pragma unroll
            for (int i = 0; i < 16; ++i) { const int df = dbase + (i & 3) + 8 * (i >> 2); st[i] = (df >= -128 && df <= 128) ? st[i] : -INFINITY; } }
        float smax = st[0];
#pragma unroll
        for (int i = 1; i < 16; ++i) smax = fmaxf(smax, st[i]);
        smax = half_max(smax);
        const float mn = fmaxf(m[nq], smax * C), alpha = __builtin_amdgcn_exp2f(m[nq] - mn); m[nq] = mn;
        float t[16]; float ps = 0.f;
#pragma unroll
        for (int i = 0; i < 16; ++i) { t[i] = __builtin_amdgcn_exp2f(__builtin_fmaf(st[i], C, -mn)); ps += t[i]; }
        l[nq] = l[nq] * alpha + ps;
        if (__ballot(alpha != 1.f)) {
#pragma unroll
            for (int i = 0; i < 16; ++i) { o[0][nq][i] *= alpha; o[1][nq][i] *= alpha; } }
        bf16x8 pf[2];
#pragma unroll
        for (int ks = 0; ks < 2; ++ks) { const u32x4 w = {pkbf(t[8 * ks], t[8 * ks + 1]), pkbf(t[8 * ks + 2], t[8 * ks + 3]), pkbf(t[8 * ks + 4], t[8 * ks + 5]), pkbf(t[8 * ks + 6], t[8 * ks + 7])};
            pf[ks] = __builtin_bit_cast(bf16x8, w); }
#pragma unroll
        for (int db = 0; db < 2; ++db)
#pragma unroll
            for (int ks = 0; ks < 2; ++ks) o[db][nq] = __builtin_amdgcn_mfma_f32_32x32x16_bf16(__builtin_bit_cast(bf16x8, vf[db][ks]), pf[ks], o[db][nq], 0, 0, 0);
    }
}
__device__ __forceinline__ void phase_attn_lds(Frame& F) {
    const bf16* Q = (const bf16*)(F.ws + WS_Q); bf16* MIX = (bf16*)(F.ws + WS_MIX);
    const int g = F.wave >> 1, half = F.wave & 1, r = F.lane & 31, h = F.lane >> 5;
    __syncthreads();
    u32x4 rg[4];
    AtChunk ck = at_chunk(F.ws, 0, F.wg, F.G);
    if (!ck.any) return;
    at_issue(ck, F.tid, rg); at_write(ck, F.lds, F.tid, rg);
    __syncthreads();
    bf16x8 qf[2][4]; f32x16 o[2][2]; float m[2], l[2];
#pragma unroll 1
    for (int seq = 0; ck.any; ++seq) {
        LAS unsigned char* buf = F.lds + (seq & 1) * AT_BUF;
        const TItem ti = t_decode(F, seq < 10 ? 640 + (F.wg * NWAVES + F.wave) + seq * (F.G * NWAVES) : (1 << 30));
        t_dma(ti, F.lds + 2 * AT_BUF + F.wave * 8704, F.lane);
        const AtChunk nk = at_chunk(F.ws, seq + 1, F.wg, F.G);
        at_issue(nk, F.tid, rg);
        const int hd = ck.kvh * 4 + g, qs = ck.qb * 128 + half * 64;
        if (ck.c == 0) {
#pragma unroll
            for (int nq = 0; nq < 2; ++nq)
#pragma unroll
                for (int s2 = 0; s2 < 4; ++s2) qf[nq][s2] = *(const bf16x8*)(Q + (size_t)(ck.b * L + qs + 32 * nq + r) * 512 + hd * 64 + 16 * s2 + 8 * h);
#pragma unroll
            for (int db = 0; db < 2; ++db)
#pragma unroll
                for (int nq = 0; nq < 2; ++nq)
#pragma unroll
                    for (int i = 0; i < 16; ++i) o[db][nq][i] = 0.f;
            m[0] = m[1] = F.in[I_SINK][hd] * 1.4426950408889634f; l[0] = l[1] = (h == 0) ? 1.f : 0.f;
        }
        if (ck.valid) {
            int b0 = 0, b1 = 4;
            if (ck.local) { b0 = 2 * half - 4 * ck.lc; b0 = b0 < 0 ? 0 : b0; b1 = 2 * half + 10 - 4 * ck.lc; b1 = b1 > 4 ? 4 : b1; }
            if (b0 < b1) {
                bf16x8 kfA[4], kfB[4]; u32x4 vfA[2][2], vfB[2][2];
                at_load(buf, b0, r, h, kfA, vfA);
#pragma unroll 1
                for (int blk = b0; blk < b1; blk += 2) {
                    const int iA = 4 * ck.lc + blk - 2 * half, iB = iA + 1;
                    if (blk + 1 < b1) at_load(buf, blk + 1, r, h, kfB, vfB);
                    at_math(kfA, vfA, ck.local && (iA < 2 || iA > 7), 32 * iA - 128, r, h, qf, o, m, l);
                    if (blk + 1 < b1) {
                        if (blk + 2 < b1) at_load(buf, blk + 2, r, h, kfA, vfA);
                        at_math(kfB, vfB, ck.local && (iB < 2 || iB > 7), 32 * iB - 128, r, h, qf, o, m, l);
                    }
                }
            }
        }
        if (ck.c == 4) {
#pragma unroll
            for (int nq = 0; nq < 2; ++nq) {
                const float lt = half_sum(l[nq]), il = __builtin_amdgcn_rcpf(lt);
                bf16* orow = MIX + (size_t)(ck.b * L + qs + 32 * nq + r) * 1024 + 512 + hd * 64;
#pragma unroll
                for (int db = 0; db < 2; ++db)
#pragma unroll
                    for (int i4 = 0; i4 < 4; ++i4) { u32x2 w; w.x = pkbf(o[db][nq][4 * i4] * il, o[db][nq][4 * i4 + 1] * il); w.y = pkbf(o[db][nq][4 * i4 + 2] * il, o[db][nq][4 * i4 + 3] * il);
                        *(u32x2*)(orow + 32 * db + 8 * i4 + 4 * h) = w; }
            }
        }
        if (ti.ok) { asm volatile("s_waitcnt vmcnt(0)" ::: "memory"); t_store_dma(ti, (const LAS float*)(F.lds + 2 * AT_BUF + F.wave * 8704), F.lane); }
        at_write(nk, F.lds + ((seq + 1) & 1) * AT_BUF, F.tid, rg);
        __syncthreads();
        ck = nk;
    }
}

constexpr int F1_PC = 136, F1_PW = 68, F2_P = 264;
constexpr int F1_CSC = 0, F1_CSS = 128 * F1_PC * 2, F1_C64 = 2 * 128 * F1_PC * 2, F1_S64 = F1_C64 + 64 * F1_PW * 2;
__device__ __forceinline__ bf16x8 pack8(float a0, float a1, float a2, float a3, float a4, float a5, float a6, float a7) {
    const u32x4 w = {pkbf(a0, a1), pkbf(a2, a3), pkbf(a4, a5), pkbf(a6, a7)}; return __builtin_bit_cast(bf16x8, w); }
__device__ __forceinline__ void phase_fft1_mfma(Frame& F) {
    __syncthreads();
    LAS bf16* csc = (LAS bf16*)(F.lds + F1_CSC); LAS bf16* css = (LAS bf16*)(F.lds + F1_CSS); LAS bf16* c64 = (LAS bf16*)(F.lds + F1_C64); LAS bf16* s64 = (LAS bf16*)(F.lds + F1_S64);
    for (int i = F.tid; i < 128 * 128; i += NTHR) { const int n = i >> 7, k = i & 127; const float ang = (float)((n * k) & 127) * (6.283185307179586f / 128.f);
        csc[n * F1_PC + k] = (bf16)f2bf(__cosf(ang)); css[n * F1_PC + k] = (bf16)f2bf(__sinf(ang)); }
    for (int i = F.tid; i < 64 * 64; i += NTHR) { const int c = i >> 6, a = i & 63; const float ang = (float)((c * a) & 63) * (6.283185307179586f / 64.f);
        c64[c * F1_PW + a] = (bf16)f2bf(__cosf(ang)); s64[c * F1_PW + a] = (bf16)f2bf(__sinf(ang)); }
    __syncthreads();
    const bf16* UF = (const bf16*)(F.ws + WS_UF); bf16* Gb = (bf16*)(F.ws + WS_G);
    const int r = F.lane & 31, h = F.lane >> 5, g = F.wave >> 1;
    LAS bf16* sre = (LAS bf16*)(F.lds + F1_S64 + 64 * F1_PW * 2 + F.wave * 5120); LAS bf16* sim = sre + 32 * 40;
    for (int item = F.wg; item < NB * FN2; item += F.G) {
        const int b = item >> 7, bp = item & 127;
        bf16x8 uf[2][8];
#pragma unroll
        for (int rb = 0; rb < 2; ++rb)
#pragma unroll
            for (int s2 = 0; s2 < 8; ++s2) uf[rb][s2] = *(const bf16x8*)(UF + (size_t)(b * L + 128 * (32 * rb + r) + bp) * 512 + g * 128 + 16 * s2 + 8 * h);
#pragma unroll 1
        for (int q = 0; q < 2; ++q) {
            const int cbk = 2 * F.wave + q, n = 32 * (cbk & 3) + r, ch = 32 * cbk + r;
            f32x16 zr[2], zi[2];
#pragma unroll
            for (int rb = 0; rb < 2; ++rb) {
#pragma unroll
                for (int i = 0; i < 16; ++i) { zr[rb][i] = 0.f; zi[rb][i] = 0.f; }
#pragma unroll
                for (int s2 = 0; s2 < 8; ++s2) { const bf16x8 bc = *(const LAS bf16x8*)(csc + n * F1_PC + 16 * s2 + 8 * h), bs = *(const LAS bf16x8*)(css + n * F1_PC + 16 * s2 + 8 * h);
                    zr[rb] = __builtin_amdgcn_mfma_f32_32x32x16_bf16(uf[rb][s2], bc, zr[rb], 0, 0, 0); zi[rb] = __builtin_amdgcn_mfma_f32_32x32x16_bf16(uf[rb][s2], bs, zi[rb], 0, 0, 0); }
                __builtin_amdgcn_sched_barrier(0);
            }
            bf16x8 zfr[4], zfi[4];
#pragma unroll
            for (int ks = 0; ks < 4; ++ks) { const int rb = ks >> 1, o = 8 * (ks & 1);
                zfr[ks] = pack8(zr[rb][o], zr[rb][o + 1], zr[rb][o + 2], zr[rb][o + 3], zr[rb][o + 4], zr[rb][o + 5], zr[rb][o + 6], zr[rb][o + 7]);
                zfi[ks] = pack8(-zi[rb][o], -zi[rb][o + 1], -zi[rb][o + 2], -zi[rb][o + 3], -zi[rb][o + 4], -zi[rb][o + 5], -zi[rb][o + 6], -zi[rb][o + 7]); }
            __builtin_amdgcn_sched_barrier(0);
#pragma unroll 1
            for (int rbc = 0; rbc < 2; ++rbc) {
                f32x16 gr, gi; const int cr = 32 * rbc + r;
#pragma unroll
                for (int i = 0; i < 16; ++i) { gr[i] = 0.f; gi[i] = 0.f; }
#pragma unroll
                for (int ks = 0; ks < 4; ++ks) {
                    const u32x2 cl = *(const LAS u32x2*)(c64 + cr * F1_PW + 16 * ks + 4 * h), chh = *(const LAS u32x2*)(c64 + cr * F1_PW + 16 * ks + 8 + 4 * h);
                    const u32x2 sl = *(const LAS u32x2*)(s64 + cr * F1_PW + 16 * ks + 4 * h), shh = *(const LAS u32x2*)(s64 + cr * F1_PW + 16 * ks + 8 + 4 * h);
                    const u32x4 sw = {sl.x, sl.y, shh.x, shh.y}; const u32x4 swn = sw ^ 0x80008000u;
                    const bf16x8 wc = __builtin_bit_cast(bf16x8, ((u32x4){cl.x, cl.y, chh.x, chh.y})), wsn = __builtin_bit_cast(bf16x8, sw), wsm = __builtin_bit_cast(bf16x8, swn);
                    gr = __builtin_amdgcn_mfma_f32_32x32x16_bf16(wc, zfr[ks], gr, 0, 0, 0); gr = __builtin_amdgcn_mfma_f32_32x32x16_bf16(wsn, zfi[ks], gr, 0, 0, 0);
                    gi = __builtin_amdgcn_mfma_f32_32x32x16_bf16(wc, zfi[ks], gi, 0, 0, 0); gi = __builtin_amdgcn_mfma_f32_32x32x16_bf16(wsm, zfr[ks], gi, 0, 0, 0); }
                __builtin_amdgcn_sched_barrier(0);
#pragma unroll
                for (int i = 0; i < 16; ++i) { const int cl = crow(i, h), c = 32 * rbc + cl; const float ang = (float)(bp * c) * (6.283185307179586f / 8192.f), cs = __cosf(ang), sn = __sinf(ang);
                    const float re = gr[i] * cs + gi[i] * sn, im = gi[i] * cs - gr[i] * sn;
                    sre[cl * 40 + r] = (bf16)f2bf(re); sim[cl * 40 + r] = (bf16)f2bf(im);
                    if ((i & 3) == 3) __builtin_amdgcn_sched_barrier(0); }
                asm volatile("" ::: "memory"); __builtin_amdgcn_wave_barrier(); asm volatile("" ::: "memory");
#pragma unroll
                for (int k = 0; k < 2; ++k) { const int cl = 16 * k + (F.lane >> 2), pc = F.lane & 3;
                    const u32x4 wre = *(const LAS u32x4*)(sre + cl * 40 + 8 * pc), wim = *(const LAS u32x4*)(sim + cl * 40 + 8 * pc);
                    bf16* o = Gb + (size_t)((b * FN1 + 32 * rbc + cl) * FN2 + bp) * 1024 + 32 * cbk + 8 * pc;
                    *(u32x4*)o = wre; *(u32x4*)(o + 512) = wim; }
                asm volatile("" ::: "memory"); __builtin_amdgcn_wave_barrier(); asm volatile("" ::: "memory");
            }
        }
    }
    __syncthreads();
}
__device__ __forceinline__ void phase_fft2_mfma(Frame& F) {
    __syncthreads();
    LAS bf16* t2 = (LAS bf16*)F.lds;
    for (int i = F.tid; i < 128 * 256; i += NTHR) { const int d = i >> 8, k = i & 255; const float ang = (float)((d * (k & 127)) & 127) * (6.283185307179586f / 128.f);
        t2[d * F2_P + k] = (bf16)f2bf(k < 128 ? __cosf(ang) : __sinf(ang)); }
    __syncthreads();
    const bf16* Gb = (const bf16*)(F.ws + WS_G); bf16* MIX = (bf16*)(F.ws + WS_MIX);
    const int r = F.lane & 31, h = F.lane >> 5;
    for (int item = F.wg; item < NB * FN1; item += F.G) {
        const int b = item >> 6, c = item & 63;
        const bf16* Gp = Gb + (size_t)((b * FN1 + c) * FN2) * 1024 + 64 * F.wave + r;
        f32x16 y[4][2];
#pragma unroll
        for (int rb = 0; rb < 4; ++rb)
#pragma unroll
            for (int cb = 0; cb < 2; ++cb)
#pragma unroll
                for (int i = 0; i < 16; ++i) y[rb][cb][i] = 0.f;
        unsigned eA[2][8], eB[2][8], eC[2][8], eD[2][8];
#define F2_GATHER(dst, ks_) do { const bf16* p_ = Gp + (size_t)(16 * ((ks_) & 7) + 8 * h) * 1024 + ((ks_) >> 3) * 512; \
            _Pragma("unroll") for (int cb = 0; cb < 2; ++cb) _Pragma("unroll") for (int j = 0; j < 8; ++j) dst[cb][j] = p_[(size_t)j * 1024 + 32 * cb]; } while (0)
#define F2_MMA(src, ks_) do { bf16x8 bfr[2]; _Pragma("unroll") for (int cb = 0; cb < 2; ++cb) { \
                const u32x4 w = {src[cb][0] | (src[cb][1] << 16), src[cb][2] | (src[cb][3] << 16), src[cb][4] | (src[cb][5] << 16), src[cb][6] | (src[cb][7] << 16)}; bfr[cb] = __builtin_bit_cast(bf16x8, w); } \
            _Pragma("unroll") for (int rb = 0; rb < 4; ++rb) { const bf16x8 a = *(const LAS bf16x8*)(t2 + (32 * rb + r) * F2_P + 16 * (ks_) + 8 * h); \
                _Pragma("unroll") for (int cb = 0; cb < 2; ++cb) y[rb][cb] = __builtin_amdgcn_mfma_f32_32x32x16_bf16(a, bfr[cb], y[rb][cb], 0, 0, 0); } } while (0)
        F2_GATHER(eA, 0); F2_GATHER(eB, 1); F2_GATHER(eC, 2);
#pragma unroll 1
        for (int ks = 0; ks < 16; ks += 4) {
            F2_GATHER(eD, ks + 3);
            F2_MMA(eA, ks);
            if (ks + 4 < 16) F2_GATHER(eA, ks + 4);
            F2_MMA(eB, ks + 1);
            if (ks + 4 < 16) F2_GATHER(eB, ks + 5);
            F2_MMA(eC, ks + 2);
            if (ks + 4 < 16) F2_GATHER(eC, ks + 6);
            F2_MMA(eD, ks + 3);
        }
#undef F2_GATHER
#undef F2_MMA
        LAS bf16* so = (LAS bf16*)(F.lds + 128 * F2_P * 2 + F.wave * 4608);
#pragma unroll
        for (int rb = 0; rb < 4; ++rb) {
#pragma unroll
            for (int cb = 0; cb < 2; ++cb)
#pragma unroll
                for (int i = 0; i < 16; ++i) so[crow(i, h) * 72 + 32 * cb + r] = (bf16)f2bf(y[rb][cb][i] * (1.f / 1024.f));
            asm volatile("" ::: "memory"); __builtin_amdgcn_wave_barrier(); asm volatile("" ::: "memory");
#pragma unroll
            for (int k = 0; k < 4; ++k) { const int dl = 8 * k + (F.lane >> 3), pc = F.lane & 7;
                const u32x4 w = *(const LAS u32x4*)(so + dl * 72 + 8 * pc);
                *(u32x4*)(MIX + (size_t)(b * L + c + 64 * (32 * rb + dl)) * 1024 + 64 * F.wave + 8 * pc) = w; }
            asm volatile("" ::: "memory"); __builtin_amdgcn_wave_barrier(); asm volatile("" ::: "memory");
        }
    }
    __syncthreads();
}


typedef float f32x2_t __attribute__((ext_vector_type(2)));
template <int IR> struct DwIn {
    static __device__ __forceinline__ void run(const unsigned (&uin)[62], const f32x2_t (&w)[31], f32x2_t (&o)[32]) {
        const f32x2_t x = {bflo(uin[IR]), bfhi(uin[IR])};
#pragma unroll
        for (int r = 0; r < 32; ++r) { if (IR - r >= 0 && IR - r <= 30) o[r] += w[(IR - r >= 0 && IR - r <= 30) ? IR - r : 0] * x; }
        DwIn<IR + 1>::run(uin, w, o);
    }
};
template <> struct DwIn<62> { static __device__ __forceinline__ void run(const unsigned (&)[62], const f32x2_t (&)[31], f32x2_t (&)[32]) {} };
template <int IR> struct DwIn16 {
    static __device__ __forceinline__ void run(const unsigned (&uin)[46], const f32x2_t (&w)[31], f32x2_t (&o)[16]) {
        const f32x2_t x = {bflo(uin[IR]), bfhi(uin[IR])};
#pragma unroll
        for (int r = 0; r < 16; ++r) { if (IR - r >= 0 && IR - r <= 30) o[r] += w[(IR - r >= 0 && IR - r <= 30) ? IR - r : 0] * x; }
        DwIn16<IR + 1>::run(uin, w, o);
    }
};
template <> struct DwIn16<46> { static __device__ __forceinline__ void run(const unsigned (&)[46], const f32x2_t (&)[31], f32x2_t (&)[16]) {} };
__device__ __forceinline__ void phase_dwconv_fast(Frame& F) {
    const bf16* U = (const bf16*)(F.ws + WS_U); bf16* V1 = (bf16*)(F.ws + WS_V1);
    const float* dww = F.in[I_DWW];
    const int c0 = 2 * F.tid;
    f32x2_t w[31];
#pragma unroll
    for (int j = 0; j < 31; ++j) w[j] = *(const f32x2_t*)(dww + (size_t)j * D + c0);
    const f32x2_t bb = *(const f32x2_t*)(F.in[I_DWB] + c0), gg = *(const f32x2_t*)(F.in[I_LNG] + c0), lb = *(const f32x2_t*)(F.in[I_LNB] + c0);
    LAS float* red = (LAS float*)F.lds;
    LAS float* stat = red + 16 * 8 * 2;
    __syncthreads();
    for (int run = F.wg; run < T / 128; run += F.G) {
        const int row0 = run * 128, l0 = row0 & (L - 1);
        unsigned uin[46], nx[16];
#pragma unroll
        for (int ir = 0; ir < 46; ++ir) { const int l = l0 - 15 + ir; const bool ok = (l >= 0 && l < L);
            const unsigned u = *(const unsigned*)(U + (size_t)(ok ? row0 - 15 + ir : row0) * D + c0); uin[ir] = ok ? u : 0u; }
#pragma unroll 1
        for (int step = 0; step < 8; ++step) {
            const int r0 = row0 + 16 * step;
            if (step < 7) {
#pragma unroll
                for (int j = 0; j < 16; ++j) { const int l = l0 + 16 * step + 31 + j; const bool ok = l < L;
                    const unsigned u = *(const unsigned*)(U + (size_t)(ok ? r0 + 31 + j : r0) * D + c0); nx[j] = ok ? u : 0u; }
            }
            f32x2_t o[16];
#pragma unroll
            for (int r = 0; r < 16; ++r) o[r] = bb;
            DwIn16<0>::run(uin, w, o);
            {
                float W[16], X[8], Y[4], Z2[2];
#pragma unroll
                for (int i = 0; i < 16; ++i) W[i] = swap32_add(o[i].x + o[i].y, o[i].x * o[i].x + o[i].y * o[i].y);
#pragma unroll
                for (int i = 0; i < 8; ++i) X[i] = swap16_add(W[2 * i], W[2 * i + 1]);
                const bool b3 = (F.lane & 8) != 0, b2 = (F.lane & 4) != 0, b1 = (F.lane & 2) != 0;
#pragma unroll
                for (int i = 0; i < 4; ++i) Y[i] = sel_add<0x140>(X[2 * i], X[2 * i + 1], b3);
#pragma unroll
                for (int i = 0; i < 2; ++i) Z2[i] = sel_add<0x141>(Y[2 * i], Y[2 * i + 1], b2);
                float Z = sel_add<0x4E>(Z2[0], Z2[1], b1);
                Z += dppf<0xB1>(Z);
                const int rr = ((F.lane >> 4) & 1) + ((F.lane >> 3) & 1) * 2 + ((F.lane >> 2) & 1) * 4 + ((F.lane >> 1) & 1) * 8;
                if (!(F.lane & 1)) red[(rr * 8 + F.wave) * 2 + (F.lane >> 5)] = Z;
            }
            __syncthreads();
            if (F.tid < 16) { float sm = 0.f, sq = 0.f;
#pragma unroll
                for (int wv = 0; wv < 8; ++wv) { sm += red[(F.tid * 8 + wv) * 2]; sq += red[(F.tid * 8 + wv) * 2 + 1]; }
                const float mean = sm * (1.f / D), var = fmaxf(sq * (1.f / D) - mean * mean, 0.f);
                stat[2 * F.tid] = mean; stat[2 * F.tid + 1] = rsqrtf(var + EPS); }
            __syncthreads();
#pragma unroll
            for (int r = 0; r < 16; ++r) { const float mean = stat[2 * r], rstd = stat[2 * r + 1];
                const f32x2_t A = gg * rstd, B = lb - A * mean, y = o[r] * A + B;
                *(unsigned*)(V1 + (size_t)(r0 + r) * D + c0) = pkbf(silu_f(y.x), silu_f(y.y)); }
#pragma unroll
            for (int i = 0; i < 30; ++i) uin[i] = uin[i + 16];
#pragma unroll
            for (int j = 0; j < 16; ++j) uin[30 + j] = nx[j];
        }
        __syncthreads();
    }
}

namespace pg {
struct MU { const char* B; const char* A; int K, type, e, rt, pn, hb, buf; };
struct MoeMergedSched {
    const char* Wgu; const char* Wdn; const char* HBp; const char* HIDp; const int* list; const float* wlist; LAS int* mm; unsigned* tcnt; unsigned* tmo; int G, c, U;
    __device__ __forceinline__ bool flat(int L, int type, MU& u) const {
        for (int e = 0; e < 16; ++e) { const int n = mm[e], nu = ((n + 255) >> 8) * 4;
            if (L < nu) { u.e = e; u.rt = L >> 2; u.pn = L & 3; u.hb = mm[16 + e]; u.type = type; u.buf = 0;
                if (type == 0) { u.K = D; u.A = HBp; u.B = Wgu + (size_t)e * (1024 * 1024 * 2) + (size_t)u.pn * BM * D * 2; }
                else { u.K = FF; u.A = HIDp; u.B = Wdn + (size_t)e * (1024 * 512 * 2) + (size_t)u.pn * BM * FF * 2; }
                return true; }
            L -= nu; }
        return false;
    }
    __device__ __forceinline__ bool next(int i, MU& u) const {
        const int ngu = c < U ? (U - 1 - c) / G + 1 : 0;
        if ((c & 1) && ngu >= 3) { if (i == 2) i = ngu; else if (i > 2 && i <= ngu) i = i - 1; }
        if (i < ngu) return flat(i * G + c, 0, u);
        const int k = i - ngu, x = U % G; int j;
        if (c >= x) { if (k == 0) j = c - x; else j = (G - 1 - c) + (k - 1) * G + (G - x); } else j = (G - 1 - c) + k * G + (G - x);
        if (j >= U) return false;
        return flat(j, 1, u);
    }
    __device__ __forceinline__ unsigned voff(const MU& u, int buf, LAS unsigned char* lds, int R, int C) const {
        if (u.type == 0) { const int tok = ((const LAS int*)(lds + TAB_OFF))[buf * 256 + R]; return (unsigned)((tok * D + C) * 2); }
        return (unsigned)(((u.hb + u.rt * BM + R) * FF + C) * 2);
    }
    __device__ __forceinline__ void stage_table(const MU& u, int buf, LAS unsigned char* lds, int wid, int lane) const {
        const int r = (wid & 3) * 64 + lane;
        __builtin_amdgcn_global_load_lds((const unsigned*)(list + u.e * CAP + u.rt * BM + r), (LAS unsigned*)(lds + TAB_OFF + buf * 1024 + (wid & 3) * 256), 4, 0, 0);
        __builtin_amdgcn_global_load_lds((const unsigned*)(wlist + u.e * CAP + u.rt * BM + r), (LAS unsigned*)(lds + TAB_OFF + 2048 + buf * 1024 + (wid & 3) * 256), 4, 0, 0);
    }
    __device__ __forceinline__ unsigned* tile_word(const MU& u) const { return tcnt + ((u.hb >> 8) + u.rt) * 64; }
    __device__ __forceinline__ void wait_ready(const MU& u, int wid) const {
        if (wid == 0) {
            unsigned* w = tile_word(u); unsigned spins = 0;
            while ((unsigned)__builtin_amdgcn_readfirstlane(__hip_atomic_load(w, __ATOMIC_RELAXED, __HIP_MEMORY_SCOPE_AGENT)) < 32u) {
                __builtin_amdgcn_s_sleep(2);
                if ((++spins & 255u) == 0u) { if (__builtin_amdgcn_readfirstlane(__hip_atomic_load(tmo, __ATOMIC_RELAXED, __HIP_MEMORY_SCOPE_AGENT)) != 0u) break;
                    if (spins > (1u << 20)) { __hip_atomic_store(tmo, 1u, __ATOMIC_RELAXED, __HIP_MEMORY_SCOPE_AGENT); break; } } }
        }
        asm volatile("" ::: "memory"); __builtin_amdgcn_s_barrier(); asm volatile("" ::: "memory");
    }
};
struct EpiGateUpWT {
    __amdgpu_buffer_rsrc_t rsrc; LAS unsigned char* lds; LAS int* mm;
    __device__ __forceinline__ void operator()(const f32x4 (&acc)[2][2][4][2], const MU& u, int wr, int wc, int fr, int fq) const {
        const int e = u.e, n_e = mm[e], r0 = u.rt * BM + wr * 64 + fr, col0 = u.pn * HALF + wc * 32 + 8 * fq;
        float wv[2][4];
#pragma unroll
        for (int ai = 0; ai < 2; ++ai)
#pragma unroll
            for (int m = 0; m < 4; ++m) wv[ai][m] = ((const LAS float*)(lds + TAB_OFF + 2048))[u.buf * 256 + wr * 64 + fr + ai * HALF + m * 16];
#pragma unroll
        for (int ai = 0; ai < 2; ++ai)
#pragma unroll
            for (int m = 0; m < 4; ++m) { const int r = r0 + ai * HALF + m * 16;
                if (r < n_e) { const float w = wv[ai][m]; f32x4 o[2];
#pragma unroll
                    for (int n = 0; n < 2; ++n) { const f32x4 g = acc[ai][0][m][n], up = acc[ai][1][m][n];
#pragma unroll
                        for (int j = 0; j < 4; ++j) o[n][j] = w * silu_f(g[j]) * up[j]; }
                    u32x4 q; q.x = cvt_pk_bf16(o[0][0], o[0][1]); q.y = cvt_pk_bf16(o[0][2], o[0][3]); q.z = cvt_pk_bf16(o[1][0], o[1][1]); q.w = cvt_pk_bf16(o[1][2], o[1][3]);
                    __builtin_amdgcn_raw_buffer_store_b128(q, rsrc, (unsigned)(((u.hb + r) * FF + col0) * 2), 0, 16); } }
    }
};
struct EpiDownM {
    unsigned char* Y8; LAS int* mm;
    __device__ __forceinline__ void operator()(const f32x4 (&acc)[2][2][4][2], const MU& u, int wr, int wc, int fr, int fq) const {
        const int e = u.e, n_e = mm[e], r0 = u.rt * BM + wr * 64 + fr, col0 = u.pn * BM + 64 * wc + 16 * fq;
#pragma unroll
        for (int ai = 0; ai < 2; ++ai)
#pragma unroll
            for (int m = 0; m < 4; ++m) { const int r = r0 + ai * HALF + m * 16;
                if (r < n_e) { u32x4 q; q.x = pk_fp8x4(acc[ai][0][m][0]); q.y = pk_fp8x4(acc[ai][0][m][1]); q.z = pk_fp8x4(acc[ai][1][m][0]); q.w = pk_fp8x4(acc[ai][1][m][1]);
                    *(u32x4*)(Y8 + (size_t)(u.hb + r) * D + col0) = q; } }
    }
};
__device__ __forceinline__ void gemm_phase_moe(LAS unsigned char* lds, const MoeMergedSched& S, const EpiGateUpWT& EA, const EpiDownM& EB) {
    const int tid = threadIdx.x, wid = __builtin_amdgcn_readfirstlane(tid >> 6), lane = tid & 63, wr = wid >> 2, wc = wid & 3, fr = lane & 15, fq = lane >> 4;
    int sR[2], sC[2]; unsigned vbA[2], vbD[2];
#pragma unroll
    for (int i = 0; i < 2; ++i) { int R, C; stage_rc(tid * 16 + i * 8192, R, C); sR[i] = R; sC[i] = C; const int Rb = (R & ~31) + perm32(R & 31);
        const int RbD = 64 * ((Rb >> 5) & 3) + 16 * ((Rb >> 3) & 3) + (Rb & 7);
        vbA[i] = (unsigned)(Rb * D + C) * 2u; vbD[i] = (unsigned)(RbD * FF + C) * 2u; }
    const size_t kstep = (size_t)(BK * 2);
    const unsigned ldsw = (unsigned)wid * 1024u;
    const int aoff = lds_byte(wr * 64 + fr, fq * 8), boff = lds_byte(wc * 32 + fr, fq * 8);
#define PG_SA(b, h) (((b) * 2 + (h)) * HTB)
#define PG_SB(b, h) ((4 + (b) * 2 + (h)) * HTB)
#define PG_STAGE(bufoff, gbase, voff) do { _Pragma("unroll") for (int _i = 0; _i < 2; ++_i) \
        __builtin_amdgcn_global_load_lds((const unsigned*)((const char*)(gbase) + (voff)[_i]), (LAS unsigned*)(lds + (bufoff) + ldsw + _i * 8192), 16, 0, 0); } while (0)
#define PG_LDA(dst, b, h) do { _Pragma("unroll") for (int m = 0; m < 4; ++m) _Pragma("unroll") for (int k = 0; k < 2; ++k) dst[m][k] = *(const LAS bf16x8*)(lds + PG_SA(b, h) + aoff + m * 2048 + k * 1024); } while (0)
#define PG_LDB(dst, b, h) do { _Pragma("unroll") for (int n = 0; n < 2; ++n) _Pragma("unroll") for (int k = 0; k < 2; ++k) dst[n][k] = *(const LAS bf16x8*)(lds + PG_SB(b, h) + boff + n * 2048 + k * 1024); } while (0)
#define PG_MMA(ai, bj, At, Bt) do { __builtin_amdgcn_s_setprio(1); _Pragma("unroll") for (int m = 0; m < 4; ++m) _Pragma("unroll") for (int n = 0; n < 2; ++n) _Pragma("unroll") for (int k = 0; k < 2; ++k) \
        acc[ai][bj][m][n] = __builtin_amdgcn_mfma_f32_16x16x32_bf16(Bt[n][k], At[m][k], acc[ai][bj][m][n], 0, 0, 0); __builtin_amdgcn_s_setprio(0); } while (0)
#define PG_WAIT_V(n) asm volatile("s_waitcnt vmcnt(" #n ")" ::: "memory")
#define PG_WAIT_L(n) asm volatile("s_waitcnt lgkmcnt(" #n ")" ::: "memory")
#define PG_BAR __builtin_amdgcn_s_barrier()
#define PG_SCHED __builtin_amdgcn_sched_barrier(0)
    MU cur, nxt; int ui = 0;
    if (!S.next(0, cur)) return;
    cur.buf = 0;
    f32x4 acc[2][2][4][2];
#pragma unroll
    for (int a = 0; a < 2; ++a)
#pragma unroll
        for (int b = 0; b < 2; ++b)
#pragma unroll
            for (int m = 0; m < 4; ++m)
#pragma unroll
                for (int n = 0; n < 2; ++n) acc[a][b][m][n] = (f32x4){0.f, 0.f, 0.f, 0.f};
    bf16x8 At[4][2], B0[2][2], B1[2][2];
    if (cur.type == 0) { S.stage_table(cur, 0, lds, wid, lane); PG_WAIT_V(0); PG_BAR; } else S.wait_ready(cur, wid);
    unsigned voC[2][2], voN[2][2];
#pragma unroll
    for (int h = 0; h < 2; ++h)
#pragma unroll
        for (int i = 0; i < 2; ++i) { voC[h][i] = S.voff(cur, 0, lds, h * HALF + sR[i], sC[i]); voN[h][i] = voC[h][i]; }
    const char* cB = cur.B; const char* cA = cur.A; size_t hsC = (size_t)(cur.type == 0 ? HALF : 8) * cur.K * 2; int nt = cur.K / BK;
    if (cur.type == 0) { PG_STAGE(PG_SB(0, 0), cB, vbA); PG_STAGE(PG_SB(0, 1), cB + hsC, vbA); } else { PG_STAGE(PG_SB(0, 0), cB, vbD); PG_STAGE(PG_SB(0, 1), cB + hsC, vbD); }
    PG_STAGE(PG_SA(0, 0), cA, voC[0]); PG_STAGE(PG_SA(0, 1), cA, voC[1]);
    if (wr == 1) PG_BAR;
    PG_WAIT_V(2); PG_BAR;
    if (cur.type == 0) { PG_STAGE(PG_SB(1, 0), cB + kstep, vbA); } else { PG_STAGE(PG_SB(1, 0), cB + kstep, vbD); }
    PG_STAGE(PG_SA(1, 0), cA + kstep, voC[0]);
    if (cur.type == 0) { PG_STAGE(PG_SB(1, 1), cB + hsC + kstep, vbA); } else { PG_STAGE(PG_SB(1, 1), cB + hsC + kstep, vbD); }
    PG_WAIT_V(6); PG_BAR;
    for (;;) {
        const bool has_next = S.next(ui + 1, nxt); nxt.buf = (ui + 1) & 1;
        if (has_next && nxt.type == 0) S.stage_table(nxt, (ui + 1) & 1, lds, wid, lane);
        const char* nB = has_next ? nxt.B : cB; const char* nA = has_next ? nxt.A : cA; const size_t hsN = has_next ? (size_t)(nxt.type == 0 ? HALF : 8) * nxt.K * 2 : hsC;
        for (int t = 0; t < nt; t += 2) {
            const bool last = (t == nt - 2);
            if (last && has_next) {
                if (nxt.type == 1) S.wait_ready(nxt, wid);
#pragma unroll
                for (int h = 0; h < 2; ++h)
#pragma unroll
                    for (int i = 0; i < 2; ++i) voN[h][i] = S.voff(nxt, (ui + 1) & 1, lds, h * HALF + sR[i], sC[i]);
            }
            unsigned vo2[2][2], vb2[2]; const bool b2gu = last ? (has_next ? nxt.type == 0 : cur.type == 0) : (cur.type == 0);
#pragma unroll
            for (int h = 0; h < 2; ++h)
#pragma unroll
                for (int i = 0; i < 2; ++i) vo2[h][i] = last ? voN[h][i] : voC[h][i];
#pragma unroll
            for (int i = 0; i < 2; ++i) vb2[i] = b2gu ? vbA[i] : vbD[i];
            const size_t hs2 = last ? hsN : hsC;
            const char* a1 = cA + (size_t)(t + 1) * kstep;
            const char* a2 = last ? nA : cA + (size_t)(t + 2) * kstep; const char* b2 = last ? nB : cB + (size_t)(t + 2) * kstep;
            const char* a3 = a2 + kstep; const char* b3 = b2 + kstep;
            PG_LDB(B0, 0, 0); PG_LDB(B1, 0, 1); PG_SCHED; PG_LDA(At, 0, 0); PG_STAGE(PG_SA(1, 1), a1, voC[1]);
            PG_WAIT_V(8); PG_WAIT_L(0); PG_BAR; PG_MMA(0, 0, At, B0); PG_MMA(0, 1, At, B1); PG_BAR; PG_SCHED;
            PG_LDA(At, 0, 1); PG_STAGE(PG_SB(0, 0), b2, vb2); PG_STAGE(PG_SB(0, 1), b2 + hs2, vb2); PG_STAGE(PG_SA(0, 0), a2, vo2[0]);
            PG_WAIT_V(8); PG_WAIT_L(0); PG_BAR; PG_MMA(1, 0, At, B0); PG_MMA(1, 1, At, B1); PG_BAR; PG_SCHED;
            PG_LDB(B0, 1, 0); PG_LDB(B1, 1, 1); PG_SCHED; PG_LDA(At, 1, 0); PG_STAGE(PG_SA(0, 1), a2, vo2[1]);
            PG_WAIT_V(8); PG_WAIT_L(0); PG_BAR; PG_MMA(0, 0, At, B0); PG_MMA(0, 1, At, B1); PG_BAR; PG_SCHED;
            PG_LDA(At, 1, 1); PG_STAGE(PG_SB(1, 0), b3, vb2); PG_STAGE(PG_SB(1, 1), b3 + hs2, vb2); PG_STAGE(PG_SA(1, 0), a3, vo2[0]);
            PG_WAIT_V(8); PG_WAIT_L(0); PG_BAR; PG_MMA(1, 0, At, B0); PG_MMA(1, 1, At, B1); PG_BAR; PG_SCHED;
        }
        if (wr == 0) PG_BAR;
        if (cur.type == 0) { EA(acc, cur, wr, wc, fr, fq);
            PG_WAIT_V(0);
            if (lane == 0) __hip_atomic_fetch_add(S.tile_word(cur), 1u, __ATOMIC_RELAXED, __HIP_MEMORY_SCOPE_AGENT); }
        else EB(acc, cur, wr, wc, fr, fq);
        if (!has_next) break;
#pragma unroll
        for (int a = 0; a < 2; ++a)
#pragma unroll
            for (int b = 0; b < 2; ++b)
#pragma unroll
                for (int m = 0; m < 4; ++m)
#pragma unroll
                    for (int n = 0; n < 2; ++n) acc[a][b][m][n] = (f32x4){0.f, 0.f, 0.f, 0.f};
        cur = nxt; cB = nB; cA = nA; hsC = hsN; nt = cur.K / BK; ++ui;
#pragma unroll
        for (int h = 0; h < 2; ++h)
#pragma unroll
            for (int i = 0; i < 2; ++i) voC[h][i] = voN[h][i];
        if (wr == 1) PG_BAR;
    }
    PG_WAIT_V(0);
    PG_BAR;
#undef PG_SA
#undef PG_SB
#undef PG_STAGE
#undef PG_LDA
#undef PG_LDB
#undef PG_MMA
#undef PG_WAIT_V
#undef PG_WAIT_L
#undef PG_BAR
#undef PG_SCHED
}
}
__device__ __forceinline__ void fast_moe_merged(Frame& F, int layer) {
    LAS int* mm = moe_map(F, layer);
    int U = 0;
    for (int e = 0; e < 16; ++e) U += ((mm[e] + 255) >> 8) * 4;
    pg::MoeMergedSched S{(const char*)(F.ws + WS_WGU) + (size_t)layer * 16 * 1024 * 1024 * 2, (const char*)(F.ws + WS_WDN) + (size_t)layer * 16 * 1024 * 512 * 2,
                         (const char*)(F.ws + WS_HB), (const char*)(F.ws + WS_HID), (const int*)(F.ws + WS_SLOTT) + layer * 16 * CAP, (const float*)(F.ws + WS_SLOTW) + layer * 16 * CAP, mm,
                         F.ctl + CW_TILE + layer * 288 * 64, F.ctl + CW_TMO2, F.G, F.wg, U};
    pg::EpiGateUpWT EA{__builtin_amdgcn_make_buffer_rsrc((void*)(F.ws + WS_HID), 0, HROWS * FF * 2, 0x00020000), F.lds, mm};
    pg::EpiDownM EB{(unsigned char*)(F.ws + WS_Y), mm};
    pg::gemm_phase_moe(F.lds, S, EA, EB);
}

constexpr int NPH = 18;
__global__ void __launch_bounds__(NTHR, 2) mega(Args args) {
    extern __shared__ __attribute__((aligned(16))) unsigned char lds[];
    Frame F;
    F.lds = (LAS unsigned char*)lds;
    F.tid = threadIdx.x; F.lane = F.tid & 63; F.wave = __builtin_amdgcn_readfirstlane(F.tid >> 6);
    F.G = gridDim.x; F.wg = blockIdx.x;
    F.out = args.out; F.ws = args.ws; F.ctl = (unsigned*)(args.ws + WS_CTL);
    volatile LAS unsigned* bst = (volatile LAS unsigned*)(F.lds + LDS_BYTES - 16);
    if (F.tid < 4) bst[F.tid] = 0u;
    __syncthreads();
    const int lo = args.ph_lo, hi = args.ph_hi;
    XcdBarrier bar; bar.bar = F.ctl + CW_BAR; bar.x = 0; bar.st = bst;
    if (hi - lo > 1) bar = xcd_barrier_post(F.ctl + CW_BAR, bst);
#define IN(k) (lo <= (k) && (k) < hi)
#define SEAM(k) do { if (IN(k) && IN((k) + 1)) xcd_barrier(bar); } while (0)
    const float* mod = (const float*)(F.ws + WS_MOD);

#ifndef DBL_MASK
#define DBL_MASK 0x0u
#endif
#define RUN(k, body) do { if (IN(k)) { _Pragma("unroll 1") for (int _r = 0; _r < ((((DBL_MASK) >> (k)) & 1u) ? 2 : 1); ++_r) { if (_r) xcd_barrier(bar); F.lane = fresh_lane(); body; } } } while (0)
    RUN(0, phase_prep(F)); SEAM(0);
    RUN(1, phase_norm1_l0(F)); SEAM(1);
    RUN(2, if (FAST_GEMM) fast_inproj(F); else phase_inproj(F)); SEAM(2);
    if (IN(3)) { F.lane = fresh_lane();
#pragma unroll 1
        for (int _r = 0; _r < ((DBL_MASK & 0x100000u) ? 2 : 1); ++_r) { if (FAST_ATTN == 2 && FAST_GEMM) phase_attn_lds(F); else if (FAST_ATTN && FAST_GEMM) phase_attn_mfma(F); else phase_attn_simple(F); }
#pragma unroll 1
        for (int _r = 0; _r < ((DBL_MASK & 0x200000u) ? 2 : 1); ++_r) { if (FAST_FFT) phase_fft1_mfma(F); else phase_fft1_simple(F); }
    } SEAM(3);
    RUN(4, if (FAST_FFT) phase_fft2_mfma(F); else phase_fft2_simple(F)); SEAM(4);
    if (IN(5)) { if (!FAST_FFT) phase_fft3_simple(F); } if (!FAST_FFT) SEAM(5);
    RUN(6, if (FAST_GEMM) fast_outproj(F, WS_MIX, WS_WOUT, F.in[I_X], F.out, mod + 2048, nullptr); else phase_outproj(F, (const bf16*)(F.ws + WS_MIX), (const bf16*)(F.ws + WS_WOUT), F.in[I_X], F.out, mod + 2048, nullptr)); SEAM(6);
    if (IN(7)) { F.lane = fresh_lane(); if (XBF16) phase_norm2_route_mfma(F, 0); else phase_norm2_route(F, 0); } SEAM(7);
    if (MOE_MERGED && FAST_GEMM) { if (IN(8)) { F.lane = fresh_lane(); fast_moe_merged(F, 0); } if (IN(8) && IN(10)) xcd_barrier(bar); }
    else { RUN(8, if (FAST_GEMM) fast_moe_gateup(F, 0); else phase_moe_gateup(F, 0)); SEAM(8);
    RUN(9, if (FAST_GEMM) fast_moe_down(F, 0); else phase_moe_down(F, 0)); SEAM(9); }
    if (IN(10)) { F.lane = fresh_lane(); phase_combine<false>(F, 0); } SEAM(10);
    RUN(11, if (FAST_GEMM) fast_pw1(F); else phase_pw1(F)); SEAM(11);
    RUN(12, phase_dwconv_fast(F)); SEAM(12);
    if (IN(13)) { F.lane = fresh_lane(); if (FAST_GEMM) fast_outproj(F, WS_V1, WS_WPW2, F.out, F.out, mod + 5 * 6144 + 2048, F.in[I_PW2B]); else phase_outproj(F, (const bf16*)(F.ws + WS_V1), (const bf16*)(F.ws + WS_WPW2), F.out, F.out, mod + 5 * 6144 + 2048, F.in[I_PW2B]); } SEAM(13);
    if (IN(14)) { F.lane = fresh_lane(); if (XBF16) phase_norm2_route_mfma(F, 1); else phase_norm2_route(F, 1); } SEAM(14);
    if (MOE_MERGED && FAST_GEMM) { if (IN(15)) { F.lane = fresh_lane(); fast_moe_merged(F, 1); } if (IN(15) && IN(17)) xcd_barrier(bar); }
    else { RUN(15, if (FAST_GEMM) fast_moe_gateup(F, 1); else phase_moe_gateup(F, 1)); SEAM(15);
    RUN(16, if (FAST_GEMM) fast_moe_down(F, 1); else phase_moe_down(F, 1)); SEAM(16); }
    if (IN(17)) { F.lane = fresh_lane(); phase_combine<true>(F, 1); }
#undef RUN
#undef IN
#undef SEAM
}

extern "C" void kernel_launch(void* const* d_in, const int* in_sizes, int n_in, void* d_out, int out_size, void* d_ws, size_t ws_size, hipStream_t stream) {
    static int grid = 0;
    if (grid == 0) {
        if (n_in != 25 || out_size != T * D || ws_size < WS_END) { fprintf(stderr, "kernel_launch: unexpected shapes (n_in %d out %d ws %zu)\n", n_in, out_size, ws_size); grid = -1; return; }
        int dev = 0, cus = 0, per_cu = 0;
        if (hipGetDevice(&dev) != hipSuccess || hipDeviceGetAttribute(&cus, hipDeviceAttributeMultiprocessorCount, dev) != hipSuccess) { grid = -1; return; }
        if (hipFuncSetAttribute((const void*)mega, hipFuncAttributeMaxDynamicSharedMemorySize, LDS_BYTES) != hipSuccess) { fprintf(stderr, "kernel_launch: hipFuncSetAttribute failed\n"); grid = -1; return; }
        if (hipOccupancyMaxActiveBlocksPerMultiprocessor(&per_cu, (const void*)mega, NTHR, LDS_BYTES) != hipSuccess || per_cu < 1) { fprintf(stderr, "kernel_launch: occupancy query says %d\n", per_cu); }
        (void)hipGetLastError();
        grid = cus;
    }
    if (grid < 0) return;
    (void)hipMemsetAsync((char*)d_ws + WS_CTL, 0, CTL_BYTES, stream);
    Args a{};
    for (int i = 0; i < 25; ++i) a.in[i] = (const float*)d_in[i];
    a.out = (float*)d_out; a.ws = (unsigned char*)d_ws;
#if MK_ONE_LAUNCH
    a.ph_lo = 0; a.ph_hi = NPH;
    hipLaunchKernelGGL(mega, dim3(grid), dim3(NTHR), LDS_BYTES, stream, a);
#else
#ifndef PROBE_PHASE
#define PROBE_PHASE -1
#endif
    for (int p = 0; p < NPH; ++p) { a.ph_lo = p; a.ph_hi = p + 1; hipLaunchKernelGGL(mega, dim3(grid), dim3(NTHR), LDS_BYTES, stream, a);
        if (p == PROBE_PHASE) { if (p == 7 || p == 14) (void)hipMemsetAsync((char*)d_ws + WS_CTL, 0, CTL_BYTES, stream);
            hipLaunchKernelGGL(mega, dim3(grid), dim3(NTHR), LDS_BYTES, stream, a); } }
#endif
}
```

```cpp
#include <hip/hip_runtime.h>
#include <cstdio>

#ifndef MOE_F8
#define MOE_F8 1
#endif
#ifndef MK_ONE_LAUNCH
#define MK_ONE_LAUNCH 1
#endif

#define GAS __attribute__((address_space(1)))
#define LAS __attribute__((address_space(3)))
typedef unsigned short bf16;
typedef short bf16x8 __attribute__((ext_vector_type(8)));
typedef float f32x4 __attribute__((ext_vector_type(4)));
typedef float f32x16 __attribute__((ext_vector_type(16)));
typedef unsigned u32x4 __attribute__((ext_vector_type(4)));
typedef int i32x4_t __attribute__((ext_vector_type(4)));
typedef int i32x8_t __attribute__((ext_vector_type(8)));
typedef unsigned u32x2 __attribute__((ext_vector_type(2)));

constexpr int D = 1024, NB = 4, L = 8192, T = NB * L, CL = 256, TC = NB * CL;
constexpr int NE = 16, FF = 512, CONVW = 31;
constexpr int N_IN = 1280;
constexpr int FN1 = 64, FN2 = 128;
#ifndef FAST_GEMM
#define FAST_GEMM 1
#endif
#ifndef MOE_MERGED
#define MOE_MERGED 1
#endif
#ifndef XBF16
#define XBF16 FAST_GEMM
#endif
#ifndef FAST_ATTN
#define FAST_ATTN 2
#endif
#ifndef FAST_FFT
#define FAST_FFT 1
#endif
constexpr int IL = FAST_GEMM ? 128 : 32;
constexpr float EPS = 1e-6f;
constexpr int NWAVES = 8, NTHR = 512;
constexpr int CAP = 32768;
constexpr int HROWS = 65536 + 4096;

constexpr size_t MiB = 1u << 20;
constexpr size_t WS_CTL = 0, CTL_BYTES = 1 * MiB;
constexpr size_t WS_MOD = 1 * MiB;
constexpr size_t WS_TW = 1 * MiB + 512 * 1024;
constexpr size_t WS_WIN = 2 * MiB, WS_WOUT = 6 * MiB, WS_WPW1 = 10 * MiB, WS_WPW2 = 14 * MiB;
constexpr size_t WS_WGU = 16 * MiB, WS_WDN = 80 * MiB;
constexpr size_t WS_TOKE = 112 * MiB, WS_TOKP = 113 * MiB, WS_TOKW = 114 * MiB;
constexpr size_t WS_SLOTT = 116 * MiB, WS_SLOTW = 120 * MiB;
constexpr size_t WS_HB = 128 * MiB;
constexpr size_t WS_UF = 196 * MiB, WS_Q = 228 * MiB, WS_K = 260 * MiB, WS_V = 268 * MiB, WS_CK = 276 * MiB, WS_CV = 277 * MiB;
constexpr size_t WS_G = 280 * MiB, WS_MIX = 344 * MiB, WS_AB = 408 * MiB;
constexpr size_t WS_XB = 408 * MiB;
constexpr size_t WS_HID = 196 * MiB, WS_Y = 264 * MiB;
constexpr size_t WS_U = 196 * MiB, WS_V1 = 260 * MiB;
constexpr size_t WS_END = 472 * MiB;
constexpr int CW_BAR = 4096;
constexpr int CW_CNT = 8192;
constexpr int CW_TILE = 16384;
constexpr int CW_FFT = 2112;
constexpr int CW_ADA = 2432;
constexpr int CW_TMO2 = 2048;

constexpr int LDS_BYTES = 147456;

__device__ __forceinline__ unsigned f2bf(float f) { unsigned u = __float_as_uint(f); return (u + 0x7fffu + ((u >> 16) & 1u)) >> 16; }
__device__ __forceinline__ float bf2f(unsigned b) { return __uint_as_float(b << 16); }
typedef __bf16 b16x2_t __attribute__((ext_vector_type(2)));
__device__ __forceinline__ unsigned pkbf(float a, float b) { typedef float f2 __attribute__((ext_vector_type(2))); f2 v = {a, b}; return __builtin_bit_cast(unsigned, __builtin_convertvector(v, b16x2_t)); }
__device__ __forceinline__ unsigned pk2(float lo, float hi) { return pkbf(lo, hi); }
__device__ __forceinline__ float bflo(unsigned w) { return __uint_as_float(w << 16); }
__device__ __forceinline__ float bfhi(unsigned w) { return __uint_as_float(w & 0xffff0000u); }
__device__ __forceinline__ float wave_sum(float v) {
    v += __builtin_bit_cast(float, __builtin_amdgcn_mov_dpp(__builtin_bit_cast(int, v), 0xB1, 0xf, 0xf, true));
    v += __builtin_bit_cast(float, __builtin_amdgcn_mov_dpp(__builtin_bit_cast(int, v), 0x4E, 0xf, 0xf, true));
    v += __builtin_bit_cast(float, __builtin_amdgcn_mov_dpp(__builtin_bit_cast(int, v), 0x141, 0xf, 0xf, true));
    v += __builtin_bit_cast(float, __builtin_amdgcn_mov_dpp(__builtin_bit_cast(int, v), 0x140, 0xf, 0xf, true));
    const int iv = __builtin_bit_cast(int, v);
    const float a = __builtin_bit_cast(float, __builtin_amdgcn_readlane(iv, 15)), b = __builtin_bit_cast(float, __builtin_amdgcn_readlane(iv, 31));
    const float c = __builtin_bit_cast(float, __builtin_amdgcn_readlane(iv, 47)), d = __builtin_bit_cast(float, __builtin_amdgcn_readlane(iv, 63));
    return (a + b) + (c + d);
}
template <int CTRL> __device__ __forceinline__ float dppf(float v) { return __uint_as_float((unsigned)__builtin_amdgcn_update_dpp(0, (int)__float_as_uint(v), CTRL, 0xf, 0xf, true)); }
__device__ __forceinline__ float swap32_add(float a, float b) { const auto r = __builtin_amdgcn_permlane32_swap(__float_as_uint(a), __float_as_uint(b), false, false); return __uint_as_float(r[0]) + __uint_as_float(r[1]); }
__device__ __forceinline__ float swap16_add(float a, float b) { const auto r = __builtin_amdgcn_permlane16_swap(__float_as_uint(a), __float_as_uint(b), false, false); return __uint_as_float(r[0]) + __uint_as_float(r[1]); }
template <int CTRL> __device__ __forceinline__ float sel_add(float a, float b, bool hi) { const float t = hi ? b : a, u = hi ? a : b; return t + dppf<CTRL>(u); }
typedef __bf16 bf16x2_t __attribute__((ext_vector_type(2)));
__device__ __forceinline__ float dot2_bf16(unsigned w, unsigned x, float acc) { return __builtin_amdgcn_fdot2_f32_bf16(__builtin_bit_cast(bf16x2_t, w), __builtin_bit_cast(bf16x2_t, x), acc, false); }
__device__ __forceinline__ float silu_f(float x) { return x * __builtin_amdgcn_rcpf(1.f + __expf(-x)); }
__device__ __forceinline__ float sigmoid_f(float x) { return __builtin_amdgcn_rcpf(1.f + __expf(-x)); }
constexpr float YSCALE = 32.f;
__device__ __forceinline__ unsigned pk_fp8x4(f32x4 v) {
    int d = __builtin_amdgcn_cvt_pk_fp8_f32(__builtin_amdgcn_fmed3f(v[0] * YSCALE, -448.f, 448.f), __builtin_amdgcn_fmed3f(v[1] * YSCALE, -448.f, 448.f), 0, false);
    d = __builtin_amdgcn_cvt_pk_fp8_f32(__builtin_amdgcn_fmed3f(v[2] * YSCALE, -448.f, 448.f), __builtin_amdgcn_fmed3f(v[3] * YSCALE, -448.f, 448.f), d, true);
    return (unsigned)d;
}
constexpr float FSC = 16.f, WSC = 256.f, HSC = 32.f;
__device__ __forceinline__ unsigned pk_fp8x4s(f32x4 v, float sc) {
    int d = __builtin_amdgcn_cvt_pk_fp8_f32(__builtin_amdgcn_fmed3f(v[0] * sc, -448.f, 448.f), __builtin_amdgcn_fmed3f(v[1] * sc, -448.f, 448.f), 0, false);
    d = __builtin_amdgcn_cvt_pk_fp8_f32(__builtin_amdgcn_fmed3f(v[2] * sc, -448.f, 448.f), __builtin_amdgcn_fmed3f(v[3] * sc, -448.f, 448.f), d, true);
    return (unsigned)d;
}
__device__ __forceinline__ f32x4 un_fp8x4(unsigned d) { typedef float f2 __attribute__((ext_vector_type(2)));
    const f2 lo = __builtin_amdgcn_cvt_pk_f32_fp8((int)d, false), hi = __builtin_amdgcn_cvt_pk_f32_fp8((int)d, true); return (f32x4){lo.x, lo.y, hi.x, hi.y}; }
#define LDS_WAIT() asm volatile("s_waitcnt lgkmcnt(0)" ::: "memory")
__device__ __forceinline__ int fresh_lane() { int l; asm volatile("v_mbcnt_lo_u32_b32 %0, -1, 0\n\tv_mbcnt_hi_u32_b32 %0, -1, %0" : "=v"(l)); return l; }

#define XB_TMO      128
#define XB_XCNT(j)  (256  + 64 * (j))
#define XB_XSUB(j)  (1280 + 64 * (j))
#define XB_XGEN(j)  (2304 + 64 * (j))
#define XB_TOP      3328
#define XB_TOPGEN   3392
#define XCD_BAR_WORDS 3456
#define XB_SPIN_CAP (1u << 20)
__device__ __forceinline__ unsigned xb_ld(unsigned* p)              { return __hip_atomic_load(p, __ATOMIC_RELAXED, __HIP_MEMORY_SCOPE_AGENT); }
__device__ __forceinline__ unsigned xb_add(unsigned* p, unsigned v) { return __hip_atomic_fetch_add(p, v, __ATOMIC_RELAXED, __HIP_MEMORY_SCOPE_AGENT); }
__device__ __forceinline__ unsigned xb_xcc_id() { return (unsigned)__builtin_amdgcn_s_getreg((3 << 11) | 20) & 0xFu; }
#define XB_SPIN(cond, bar) do { unsigned _sp = 0; while (cond) { __builtin_amdgcn_s_sleep(1); \
    if ((++_sp & 255u) == 0u) { if (xb_ld(&(bar)[XB_TMO])) break; if (_sp > XB_SPIN_CAP) { atomicAdd(&(bar)[XB_TMO], 1u); break; } } } } while (0)
struct XcdBarrier { unsigned* bar; unsigned x; volatile LAS unsigned* st; };
__device__ __forceinline__ XcdBarrier xcd_barrier_post(unsigned* bar, volatile LAS unsigned* st) {
    XcdBarrier b; b.bar = bar; b.x = xb_xcc_id(); b.st = st;
    if (threadIdx.x == 0) (void)xb_add(&bar[XB_XCNT(b.x)], 1u);
    return b;
}
__device__ __forceinline__ void xcd_barrier_complete(unsigned* bar, unsigned x, unsigned& nloc, unsigned& nx) {
    const unsigned G = gridDim.x * gridDim.y * gridDim.z;
    unsigned sum, cnt, mine, sp = 0u;
    for (;;) {
        sum = 0u; cnt = 0u; mine = 0u;
#pragma unroll
        for (unsigned j = 0; j < 16; ++j) { const unsigned c = xb_ld(&bar[XB_XCNT(j)]); sum += c; cnt += (c > 0u) ? 1u : 0u; mine = (j == x) ? c : mine; }
        if (sum == G) break;
        __builtin_amdgcn_s_sleep(1);
        if ((++sp & 255u) == 0u) { if (xb_ld(&bar[XB_TMO])) break; if (sp > XB_SPIN_CAP) { atomicAdd(&bar[XB_TMO], 1u); break; } }
    }
    nloc = mine > 0u ? mine : 1u; nx = cnt > 0u ? cnt : 1u;
}
__device__ __forceinline__ void xcd_barrier(const XcdBarrier& b) {
    asm volatile("s_waitcnt vmcnt(0)" ::: "memory");
    __syncthreads();
    if (threadIdx.x == 0) {
        unsigned* bar = b.bar;
        __builtin_amdgcn_s_waitcnt(0);
        unsigned nloc = b.st[0], nx = b.st[1];
        if (nloc == 0u) { xcd_barrier_complete(bar, b.x, nloc, nx); b.st[0] = nloc; b.st[1] = nx; }
        const unsigned old = xb_add(&bar[XB_XSUB(b.x)], 1u);
        const unsigned gen = old / nloc;
        if (old + 1u == (gen + 1u) * nloc) {
            __builtin_amdgcn_fence(__ATOMIC_RELEASE, "agent");
            asm volatile("s_waitcnt vmcnt(0)" ::: "memory");
            const unsigned og = xb_add(&bar[XB_TOP], 1u);
            const unsigned tg = og / nx;
            if (og + 1u != (tg + 1u) * nx) XB_SPIN(xb_ld(&bar[XB_TOP]) < (tg + 1u) * nx, bar);
            xb_add(&bar[XB_XGEN(b.x)], 1u);
            __builtin_amdgcn_fence(__ATOMIC_ACQUIRE, "agent");
            asm volatile("s_waitcnt vmcnt(0)" ::: "memory");
        } else {
            XB_SPIN(xb_ld(&bar[XB_XGEN(b.x)]) == gen, bar);
            __builtin_amdgcn_fence(__ATOMIC_ACQUIRE, "agent");
            asm volatile("s_waitcnt vmcnt(0)" ::: "memory");
        }
    }
    __syncthreads();
}

struct Args { const float* in[25]; float* out; unsigned char* ws; int ph_lo, ph_hi; };
enum { I_X = 0, I_C, I_CTX, I_CCTX, I_ADAW, I_ADAB, I_NMG, I_NFG, I_WIN, I_WOUT, I_SINK, I_PW1W, I_PW1B, I_DWW, I_DWB, I_LNG, I_LNB,
       I_PW2W, I_PW2B, I_RW, I_RB, I_WG, I_WU, I_WD, I_FNG };

struct InPtrs {
    __device__ __forceinline__ const float* operator[](int i) const { const float* r;
        asm volatile("s_load_dwordx2 %0, %1, %2\n\ts_waitcnt lgkmcnt(0)" : "=s"(r) : "s"(__builtin_amdgcn_kernarg_segment_ptr()), "s"(i * 8)); return r; }
};
struct Frame {
    LAS unsigned char* lds;
    int tid, lane, wave, G, wg;
    InPtrs in;
    float* out;
    unsigned char* ws;
    unsigned* ctl;
};

__device__ __forceinline__ int crow(int i, int h) { return (i & 3) + 8 * (i >> 2) + 4 * h; }
template <class RowPtr, class Epi>
__device__ __forceinline__ void sgemm_tile(const RowPtr& rowptr, const bf16* Bt, int K, int m0, int n0, const Epi& epi, int wave, int lane) {
    const int wm = wave & 3, wn = wave >> 2, r = lane & 31, h = lane >> 5;
    const bf16* ap = rowptr(m0 + wm * 32 + r) + 8 * h;
    const bf16* bp0 = Bt + (size_t)(n0 + wn * 64 + r) * K + 8 * h;
    const bf16* bp1 = bp0 + (size_t)32 * K;
    f32x16 c0, c1;
#pragma unroll
    for (int i = 0; i < 16; ++i) { c0[i] = 0.f; c1[i] = 0.f; }
#pragma unroll 2
    for (int k = 0; k < K; k += 32) {
        const bf16x8 a0 = *(const bf16x8*)(ap + k), a1 = *(const bf16x8*)(ap + k + 16);
        const bf16x8 b00 = *(const bf16x8*)(bp0 + k), b01 = *(const bf16x8*)(bp0 + k + 16);
        const bf16x8 b10 = *(const bf16x8*)(bp1 + k), b11 = *(const bf16x8*)(bp1 + k + 16);
        c0 = __builtin_amdgcn_mfma_f32_32x32x16_bf16(a0, b00, c0, 0, 0, 0);
        c1 = __builtin_amdgcn_mfma_f32_32x32x16_bf16(a0, b10, c1, 0, 0, 0);
        c0 = __builtin_amdgcn_mfma_f32_32x32x16_bf16(a1, b01, c0, 0, 0, 0);
        c1 = __builtin_amdgcn_mfma_f32_32x32x16_bf16(a1, b11, c1, 0, 0, 0);
    }
    epi(m0 + wm * 32, n0 + wn * 64, c0, c1, lane);
}

__device__ __forceinline__ void p0_transpose_item(const float* W, int K, int N, bf16* WT, int k0, int n0, int drow0, LAS float* scr, int lane) {
#pragma unroll 8
    for (int i = 0; i < 32; ++i) { const int kk = 2 * i + (lane >> 5); scr[kk * 33 + (lane & 31)] = W[(size_t)(k0 + kk) * N + n0 + (lane & 31)]; }
    LDS_WAIT(); asm volatile("" ::: "memory");
    const int c = lane & 7;
#pragma unroll
    for (int j = 0; j < 4; ++j) { const int n = (lane >> 3) + 8 * j; const LAS float* s = scr + (8 * c) * 33 + n;
        u32x4 o; o.x = pk2(s[0 * 33], s[1 * 33]); o.y = pk2(s[2 * 33], s[3 * 33]); o.z = pk2(s[4 * 33], s[5 * 33]); o.w = pk2(s[6 * 33], s[7 * 33]);
        *(u32x4*)(WT + (size_t)(drow0 + n) * K + k0 + 8 * c) = o; }
    LDS_WAIT(); asm volatile("" ::: "memory");
}
__device__ __forceinline__ int il_row(int j, int half) { return (j / IL) * (2 * IL) + half * IL + (j % IL); }

constexpr int T_NITEMS = 640 + 512 + 1024 + 512 + 3 * 32 * 256, T_DEFER_ATT = 10 * 2048;
struct TItem { const float* W; bf16* WT; int K, N, k0, n0, drow0; bool ok; };
__device__ __forceinline__ TItem t_decode(const Frame& F, int it) {
    constexpr int S0 = 640, S1 = 512, S2 = 1024, S3 = 512, SM = 32 * 256;
    TItem t; t.ok = it < S0 + S1 + S2 + S3 + 3 * SM; t.W = F.in[I_WIN]; t.WT = (bf16*)(F.ws + WS_WIN); t.K = 1024; t.N = 1280; t.k0 = 0; t.n0 = 0; t.drow0 = 0;
    int r = it;
    if (r < S0) { const int kb = r / 40, nb = r % 40; t.K = -1024; t.k0 = kb * 64; t.n0 = nb * 32; t.drow0 = nb * 32; return t; } r -= S0;
    if (r < S1) { const int kb = r / 32, nb = r % 32; t.W = F.in[I_WOUT]; t.WT = (bf16*)(F.ws + WS_WOUT); t.K = -1024; t.N = 1024; t.k0 = kb * 64; t.n0 = nb * 32; t.drow0 = nb * 32; return t; } r -= S1;
    if (r < S2) { const int kb = r / 64, nb = r % 64, n0 = nb * 32; t.W = F.in[I_PW1W]; t.WT = (bf16*)(F.ws + WS_WPW1); t.K = -1024; t.N = 2048; t.k0 = kb * 64; t.n0 = n0; t.drow0 = il_row(n0 & 1023, n0 >> 10); return t; } r -= S2;
    if (r < S3) { const int kb = r / 32, nb = r % 32; t.W = F.in[I_PW2W]; t.WT = (bf16*)(F.ws + WS_WPW2); t.K = -1024; t.N = 1024; t.k0 = kb * 64; t.n0 = nb * 32; t.drow0 = nb * 32; return t; } r -= S3;
    if (r < SM) { const int le = r >> 8, q = r & 255, kb = q / 16, nb = q % 16; t.W = F.in[I_WG] + (size_t)le * 1024 * 512; t.WT = (bf16*)(F.ws + WS_WGU + (size_t)le * 1024 * 1024); t.N = 512; t.k0 = kb * 64; t.n0 = nb * 32; t.drow0 = il_row(nb * 32, 0); return t; } r -= SM;
    if (r < SM) { const int le = r >> 8, q = r & 255, kb = q / 16, nb = q % 16; t.W = F.in[I_WU] + (size_t)le * 1024 * 512; t.WT = (bf16*)(F.ws + WS_WGU + (size_t)le * 1024 * 1024); t.N = 512; t.k0 = kb * 64; t.n0 = nb * 32; t.drow0 = il_row(nb * 32, 1); return t; } r -= SM;
    { const int le = (r >> 8) & 31, q = r & 255, kb = q / 32, nb = q % 32; t.W = F.in[I_WD] + (size_t)le * 512 * 1024; t.WT = (bf16*)(F.ws + WS_WDN + (size_t)le * 1024 * 512); t.K = -512; t.N = 1024; t.k0 = kb * 64; t.n0 = nb * 32; t.drow0 = nb * 32; }
    return t;
}
__device__ __forceinline__ void t_load(const TItem& t, int lane, float (&v)[32]) {
    if (t.ok) {
#pragma unroll
        for (int i = 0; i < 32; ++i) v[i] = t.W[(size_t)(t.k0 + 2 * i + (lane >> 5)) * t.N + t.n0 + (lane & 31)];
    }
}
__device__ __forceinline__ void t_store(const TItem& t, LAS float* scr, int lane, const float (&v)[32]) {
#pragma unroll
    for (int i = 0; i < 32; ++i) scr[(2 * i + (lane >> 5)) * 33 + (lane & 31)] = v[i];
    LDS_WAIT(); asm volatile("" ::: "memory");
    const int c = lane & 7;
#pragma unroll
    for (int j = 0; j < 4; ++j) { const int n = (lane >> 3) + 8 * j; const LAS float* s = scr + (8 * c) * 33 + n;
        if (t.K < 0) { u32x2 o; o.x = pk_fp8x4s((f32x4){s[0 * 33], s[1 * 33], s[2 * 33], s[3 * 33]}, WSC); o.y = pk_fp8x4s((f32x4){s[4 * 33], s[5 * 33], s[6 * 33], s[7 * 33]}, WSC);
            *(u32x2*)((unsigned char*)t.WT + (size_t)(t.drow0 + n) * (-t.K) + t.k0 + 8 * c) = o; }
        else { u32x4 o; o.x = pk2(s[0 * 33], s[1 * 33]); o.y = pk2(s[2 * 33], s[3 * 33]); o.z = pk2(s[4 * 33], s[5 * 33]); o.w = pk2(s[6 * 33], s[7 * 33]);
            *(u32x4*)(t.WT + (size_t)(t.drow0 + n) * t.K + t.k0 + 8 * c) = o; } }
    LDS_WAIT(); asm volatile("" ::: "memory");
}
__device__ __forceinline__ void t_dma(const TItem& t, LAS unsigned char* scr, int lane) {
    if (t.ok) {
#pragma unroll
        for (int i = 0; i < 8; ++i)
            __builtin_amdgcn_global_load_lds((const unsigned*)(t.W + (size_t)(t.k0 + 8 * i + (lane >> 3)) * t.N + t.n0 + 4 * (lane & 7)), (LAS unsigned*)(scr + 1056 * i), 16, 0, 0);
    }
}
__device__ __forceinline__ void t_store_dma(const TItem& t, const LAS float* scr, int lane) {
    const int c = lane & 7;
#pragma unroll 1
    for (int j = 0; j < 4; ++j) { const int n = (lane >> 3) + 8 * j; u32x2 o8;
        { const LAS float* sp = scr + 264 * c + n; o8.x = pk_fp8x4s((f32x4){sp[0], sp[32], sp[64], sp[96]}, WSC); }
        asm volatile("" ::: "memory");
        { const LAS float* sp = scr + 264 * c + n + 128; o8.y = pk_fp8x4s((f32x4){sp[0], sp[32], sp[64], sp[96]}, WSC); }
        *(u32x2*)((unsigned char*)t.WT + (size_t)(t.drow0 + n) * 1024 + t.k0 + 8 * c) = o8; }
    LDS_WAIT(); asm volatile("" ::: "memory");
}
__device__ __forceinline__ int t_umap(int u) { return u < 8192 ? 640 + 18432 + u : (1 << 30); }
__device__ __forceinline__ void t_items_tail(Frame& F, int r, int nw) {
    LAS float* scr = (LAS float*)(F.lds + F.wave * 8704);
    TItem cur = t_decode(F, t_umap(r)); float va[32], vb[32];
    t_load(cur, F.lane, va);
#pragma unroll 1
    for (int it = r; cur.ok; it += nw) {
        const TItem nxt = t_decode(F, t_umap(it + nw));
        t_load(nxt, F.lane, vb);
        t_store(cur, scr, F.lane, va);
#pragma unroll
        for (int i = 0; i < 32; ++i) va[i] = vb[i];
        cur = nxt;
    }
}
__device__ __forceinline__ void phase_prep(Frame& F) {
    {
        LAS float* sc = (LAS float*)F.lds;
        LAS float* red = sc + 5 * 1024;
        bool loaded = false;
        for (int it = F.wg; it < 192; it += F.G) {
            if (!loaded) {
                for (int i = F.tid; i < 5 * 1024; i += NTHR) { const int b = i >> 10, k = i & 1023; const float v = b < 4 ? F.in[I_C][b * 1024 + k] : F.in[I_CCTX][k]; sc[i] = silu_f(v); }
                __syncthreads(); loaded = true;
            }
            const int l = it / 96, n0 = (it % 96) * 64, c4 = F.tid & 15, kg = F.tid >> 4;
            const float* w = F.in[I_ADAW] + (size_t)l * 1024 * 6144 + n0 + 4 * c4;
            f32x4 a[5];
#pragma unroll
            for (int b = 0; b < 5; ++b) a[b] = (f32x4){0.f, 0.f, 0.f, 0.f};
#pragma unroll 16
            for (int kk = 0; kk < 32; ++kk) { const int k = kg * 32 + kk; const f32x4 wv = *(const f32x4*)(w + (size_t)k * 6144);
#pragma unroll
                for (int b = 0; b < 5; ++b) a[b] += sc[b * 1024 + k] * wv; }
#pragma unroll
            for (int b = 0; b < 5; ++b) *(LAS f32x4*)(red + (kg * 5 + b) * 64 + 4 * c4) = a[b];
            __syncthreads();
            if (F.tid < 320) { const int b = F.tid >> 6, c2 = F.tid & 63; float sm = 0.f;
#pragma unroll
                for (int g = 0; g < 32; ++g) sm += red[(g * 5 + b) * 64 + c2];
                __hip_atomic_store((float*)(F.ws + WS_MOD) + ((size_t)l * 5 + b) * 6144 + n0 + c2, sm + F.in[I_ADAB][l * 6144 + n0 + c2], __ATOMIC_RELAXED, __HIP_MEMORY_SCOPE_AGENT); }
            asm volatile("s_waitcnt vmcnt(0)" ::: "memory");
            __syncthreads();
            if (it < 32 && F.tid == 0) (void)xb_add(F.ctl + CW_ADA, 1u);
        }
        __syncthreads();
    }
    { u32x4* z = (u32x4*)(F.ws + WS_SLOTT); const u32x4 zero = {0u, 0u, 0u, 0u};
      for (int i = F.wg * NTHR + F.tid; i < 2 * 16 * CAP / 4; i += F.G * NTHR) z[i] = zero; }
    { float* tw = (float*)(F.ws + WS_TW);
      for (int k = F.wg * NTHR + F.tid; k < 8192; k += F.G * NTHR) { const float a = (float)k * (6.283185307179586f / 8192.f); tw[2 * k] = __cosf(a); tw[2 * k + 1] = __sinf(a); } }
    {
        LAS float* scr = (LAS float*)(F.lds + F.wave * 8704);
        const int gw = F.wg * NWAVES + F.wave, NGW = F.G * NWAVES;
        auto vmap = [](int v) { return v < 640 + 2048 ? v : (1 << 30); };
        TItem cur = t_decode(F, vmap(gw)); float va[32], vb[32];
        t_load(cur, F.lane, va);
#pragma unroll 1
        for (int it = gw; cur.ok; it += NGW) {
            const TItem nxt = t_decode(F, vmap(it + NGW));
            t_load(nxt, F.lane, vb);
            t_store(cur, scr, F.lane, va);
#pragma unroll
            for (int i = 0; i < 32; ++i) va[i] = vb[i];
            cur = nxt;
        }
    }
}

#define ROFF(lane, j) (512 * ((j) >> 1) + 8 * (lane) + 4 * ((j) & 1))
__device__ __forceinline__ void row_load(const float* p, int lane, f32x4 (&v)[4]) {
#pragma unroll
    for (int j = 0; j < 4; ++j) v[j] = *(const f32x4*)(p + ROFF(lane, j));
}
__device__ __forceinline__ void row_load_bf(const bf16* p, int lane, f32x4 (&v)[4]) {
#pragma unroll
    for (int jj = 0; jj < 2; ++jj) { const u32x4 w = *(const u32x4*)(p + 512 * jj + 8 * lane); v[2 * jj] = (f32x4){bflo(w.x), bfhi(w.x), bflo(w.y), bfhi(w.y)}; v[2 * jj + 1] = (f32x4){bflo(w.z), bfhi(w.z), bflo(w.w), bfhi(w.w)}; }
}
__device__ __forceinline__ void xrow_load(const float* xf, const bf16* xb, size_t row, int lane, f32x4 (&v)[4]) { if (XBF16) row_load_bf(xb + row * D, lane, v); else row_load(xf + row * D, lane, v); }
__device__ __forceinline__ float row_sumsq(const f32x4 (&v)[4]) {
    float s = 0.f;
#pragma unroll
    for (int j = 0; j < 4; ++j) s += (v[j].x * v[j].x + v[j].y * v[j].y) + (v[j].z * v[j].z + v[j].w * v[j].w);
    return wave_sum(s);
}
__device__ __forceinline__ void row_modulate(f32x4 (&v)[4], float rstd, const float* g, const float* sh, const float* sc, int lane) {
#pragma unroll
    for (int j = 0; j < 4; ++j) { const int o = ROFF(lane, j); const f32x4 gg = *(const f32x4*)(g + o), s1 = *(const f32x4*)(sc + o), s0 = *(const f32x4*)(sh + o);
        v[j] = v[j] * rstd * gg * (1.f + s1) + s0; }
}
__device__ __forceinline__ void row_store_bf16(bf16* dst, const f32x4 (&v)[4], int lane) {
#pragma unroll
    for (int jj = 0; jj < 2; ++jj) { u32x4 w; w.x = pk2(v[2 * jj].x, v[2 * jj].y); w.y = pk2(v[2 * jj].z, v[2 * jj].w); w.z = pk2(v[2 * jj + 1].x, v[2 * jj + 1].y); w.w = pk2(v[2 * jj + 1].z, v[2 * jj + 1].w); *(u32x4*)(dst + 512 * jj + 8 * lane) = w; }
}

__device__ __forceinline__ void phase_norm1_l0(Frame& F) {
    if (F.tid == 0) { unsigned sp = 0u;
        while (xb_ld(F.ctl + CW_ADA) < 32u) { __builtin_amdgcn_s_sleep(2);
            if ((++sp & 255u) == 0u) { if (xb_ld(F.ctl + CW_TMO2)) break; if (sp > (1u << 20)) { __hip_atomic_store(F.ctl + CW_TMO2, 1u, __ATOMIC_RELAXED, __HIP_MEMORY_SCOPE_AGENT); break; } } } }
    __syncthreads();
    const int gw = F.wg * NWAVES + F.wave, NGW = F.G * NWAVES;
    const float* mod = (const float*)(F.ws + WS_MOD);
    bf16* HB = (bf16*)(F.ws + WS_HB);
    for (int row = gw; row < T + TC; row += NGW) {
        const float* src = row < T ? F.in[I_X] + (size_t)row * D : F.in[I_CTX] + (size_t)(row - T) * D;
        const int b = row < T ? (row >> 13) : 4;
        f32x4 v[4]; row_load(src, F.lane, v);
        const float rstd = rsqrtf(row_sumsq(v) * (1.f / D) + EPS);
        const float* m = mod + (size_t)b * 6144;
        row_modulate(v, rstd, F.in[I_NMG], m, m + 1024, F.lane);
#pragma unroll
        for (int hh = 0; hh < 2; ++hh) { u32x2 w8; w8.x = pk_fp8x4s(v[2 * hh], FSC); w8.y = pk_fp8x4s(v[2 * hh + 1], FSC); *(u32x2*)((unsigned char*)HB + (size_t)row * D + 512 * hh + 8 * F.lane) = w8; }
    }
}

struct RowLin { const bf16* base; size_t pitch; __device__ __forceinline__ const bf16* operator()(int m) const { return base + (size_t)m * pitch; } };

__device__ __forceinline__ void inproj_block(Frame& F, int mb, int nbk, const f32x16& c, int lane) {
    const int h = lane >> 5, cl = lane & 31;
    bf16* dst; int pitch, cbase; bool rope = false; bool isctx = (mb >= T);
    if (nbk < 512) { dst = (bf16*)(F.ws + WS_UF); pitch = 512; cbase = 0; }
    else if (nbk < 1024) { dst = (bf16*)(F.ws + WS_Q); pitch = 512; cbase = 512; rope = true; }
    else if (nbk < 1152) { dst = isctx ? (bf16*)(F.ws + WS_CK) : (bf16*)(F.ws + WS_K); pitch = 128; cbase = 1024; rope = !isctx; }
    else { dst = isctx ? (bf16*)(F.ws + WS_CV) : (bf16*)(F.ws + WS_V); pitch = 128; cbase = 1152; }
    const int rbase = isctx ? mb - T : mb;
    const int col = nbk - cbase + cl;
    const float inv = exp2f(-(float)(cl & 15) * (13.287712379549449f / 16.f));
    const bool second = (cl & 16) != 0; const bool bycol = ((nbk >> 5) & 1) != 0;
#pragma unroll
    for (int i = 0; i < 16; ++i) {
        const int rr = crow(i, h); float v = c[i];
        if (rope) {
            const float partner = __shfl_xor(v, 16);
            const int l = (mb + rr) & (L - 1);
            const float pos = (float)(bycol ? (l & 63) : (l >> 6));
            const float ang = pos * inv, cs = __cosf(ang), sn = __sinf(ang);
            v = second ? (partner * sn + v * cs) : (v * cs - partner * sn);
        }
        dst[(size_t)(rbase + rr) * pitch + col] = (bf16)f2bf(v);
    }
}
__device__ __forceinline__ void phase_inproj(Frame& F) {
    const bf16* HB = (const bf16*)(F.ws + WS_HB); const bf16* Wt = (const bf16*)(F.ws + WS_WIN);
    constexpr int MT = (T + TC) / 128, NT = N_IN / 128;
    RowLin rp{HB, (size_t)D};
    for (int u = F.wg; u < MT * NT; u += F.G) {
        const int mt = u / NT, nt = u % NT;
        if (mt >= T / 128 && nt < 8) continue;
        auto epi = [&](int mb, int nb, const f32x16& c0, const f32x16& c1, int lane) { inproj_block(F, mb, nb, c0, lane); inproj_block(F, mb, nb + 32, c1, lane); };
        sgemm_tile(rp, Wt, D, mt * 128, nt * 128, epi, F.wave, F.lane);
    }
}

__device__ __forceinline__ void attn_key(const bf16* kp, const bf16* vp, const float (&q)[64], float& m, float& s, float (&o)[64]) {
    float dot = 0.f;
#pragma unroll
    for (int j = 0; j < 8; ++j) { const u32x4 w = *(const u32x4*)(kp + 8 * j);
        dot += q[8 * j + 0] * bflo(w.x) + q[8 * j + 1] * bfhi(w.x) + q[8 * j + 2] * bflo(w.y) + q[8 * j + 3] * bfhi(w.y)
             + q[8 * j + 4] * bflo(w.z) + q[8 * j + 5] * bfhi(w.z) + q[8 * j + 6] * bflo(w.w) + q[8 * j + 7] * bfhi(w.w); }
    const float mn = fmaxf(m, dot), alpha = __expf(m - mn), p = __expf(dot - mn);
    s = s * alpha + p; m = mn;
#pragma unroll
    for (int j = 0; j < 8; ++j) { const u32x4 w = *(const u32x4*)(vp + 8 * j);
        o[8 * j + 0] = o[8 * j + 0] * alpha + p * bflo(w.x); o[8 * j + 1] = o[8 * j + 1] * alpha + p * bfhi(w.x);
        o[8 * j + 2] = o[8 * j + 2] * alpha + p * bflo(w.y); o[8 * j + 3] = o[8 * j + 3] * alpha + p * bfhi(w.y);
        o[8 * j + 4] = o[8 * j + 4] * alpha + p * bflo(w.z); o[8 * j + 5] = o[8 * j + 5] * alpha + p * bfhi(w.z);
        o[8 * j + 6] = o[8 * j + 6] * alpha + p * bflo(w.w); o[8 * j + 7] = o[8 * j + 7] * alpha + p * bfhi(w.w); }
}
__device__ __forceinline__ void phase_attn_simple(Frame& F) {
    const bf16* Q = (const bf16*)(F.ws + WS_Q); const bf16* Kb = (const bf16*)(F.ws + WS_K); const bf16* Vb = (const bf16*)(F.ws + WS_V);
    const bf16* CK = (const bf16*)(F.ws + WS_CK); const bf16* CV = (const bf16*)(F.ws + WS_CV); bf16* MIX = (bf16*)(F.ws + WS_MIX);
    for (int idx = F.wg * NTHR + F.tid; idx < T * 8; idx += F.G * NTHR) {
        const int hd = idx / T, t = idx % T, b = t >> 13, l = t & (L - 1), kvh = hd >> 2;
        float q[64], o[64];
#pragma unroll
        for (int j = 0; j < 8; ++j) { const u32x4 w = *(const u32x4*)(Q + (size_t)t * 512 + hd * 64 + 8 * j);
            q[8 * j + 0] = bflo(w.x) * 0.125f; q[8 * j + 1] = bfhi(w.x) * 0.125f; q[8 * j + 2] = bflo(w.y) * 0.125f; q[8 * j + 3] = bfhi(w.y) * 0.125f;
            q[8 * j + 4] = bflo(w.z) * 0.125f; q[8 * j + 5] = bfhi(w.z) * 0.125f; q[8 * j + 6] = bflo(w.w) * 0.125f; q[8 * j + 7] = bfhi(w.w) * 0.125f; }
#pragma unroll
        for (int j = 0; j < 64; ++j) o[j] = 0.f;
        float m = F.in[I_SINK][hd], s = 1.f;
        for (int c = 0; c < CL; ++c) { const size_t r = (size_t)(b * CL + c) * 128 + kvh * 64; attn_key(CK + r, CV + r, q, m, s, o); }
        const int lo = l - 128 < 0 ? 0 : l - 128, hi = l + 128 > L - 1 ? L - 1 : l + 128;
        for (int kp = lo; kp <= hi; ++kp) { const size_t r = (size_t)(b * L + kp) * 128 + kvh * 64; attn_key(Kb + r, Vb + r, q, m, s, o); }
        const float is = 1.f / s;
#pragma unroll
        for (int j = 0; j < 8; ++j) { u32x4 w; w.x = pk2(o[8 * j] * is, o[8 * j + 1] * is); w.y = pk2(o[8 * j + 2] * is, o[8 * j + 3] * is); w.z = pk2(o[8 * j + 4] * is, o[8 * j + 5] * is); w.w = pk2(o[8 * j + 6] * is, o[8 * j + 7] * is);
            *(u32x4*)(MIX + (size_t)t * 1024 + 512 + hd * 64 + 8 * j) = w; }
    }
}

__device__ __forceinline__ void phase_fft1_simple(Frame& F) {
    const bf16* UF = (const bf16*)(F.ws + WS_UF); bf16* Gb = (bf16*)(F.ws + WS_G); const float* tw = (const float*)(F.ws + WS_TW);
    for (int idx = F.wg * NTHR + F.tid; idx < NB * FN1 * FN2 * 512; idx += F.G * NTHR) {
        const int ch = idx & 511, bp = (idx >> 9) & 127, c = (idx >> 16) & 63, b = idx >> 22;
        float re = 0.f, im = 0.f;
        for (int a = 0; a < FN1; ++a) { const float u = bf2f(UF[(size_t)(b * L + 128 * a + bp) * 512 + ch]); const int k = ((a * c) & 63) * 128;
            re += u * tw[2 * k]; im -= u * tw[2 * k + 1]; }
        const int k2 = bp * c; const float cs = tw[2 * k2], sn = tw[2 * k2 + 1];
        const float gr = re * cs + im * sn, gi = im * cs - re * sn;
        const size_t row = (size_t)(b * FN1 + c) * FN2 + bp;
        Gb[row * 1024 + ch] = (bf16)f2bf(gr); Gb[row * 1024 + 512 + ch] = (bf16)f2bf(gi);
    }
}
__device__ __forceinline__ void phase_fft2_simple(Frame& F) {
    const bf16* Gb = (const bf16*)(F.ws + WS_G); bf16* AB = (bf16*)(F.ws + WS_AB); const float* tw = (const float*)(F.ws + WS_TW);
    for (int idx = F.wg * NTHR + F.tid; idx < NB * FN1 * FN2 * 512; idx += F.G * NTHR) {
        const int ch = idx & 511, d = (idx >> 9) & 127, c = (idx >> 16) & 63, b = idx >> 22;
        float fr = 0.f, fi = 0.f;
        for (int bp = 0; bp < FN2; ++bp) { const size_t row = (size_t)(b * FN1 + c) * FN2 + bp; const float gr = bf2f(Gb[row * 1024 + ch]), gi = bf2f(Gb[row * 1024 + 512 + ch]);
            const int k = ((bp * d) & 127) * 64; const float cs = tw[2 * k], sn = tw[2 * k + 1];
            fr += gr * cs + gi * sn; fi += gi * cs - gr * sn; }
        const size_t t = (size_t)b * L + c + 64 * d;
        AB[t * 1024 + ch] = (bf16)f2bf(fr); AB[t * 1024 + 512 + ch] = (bf16)f2bf(-fi);
    }
}
__device__ __forceinline__ void phase_fft3_simple(Frame& F) {
    const bf16* AB = (const bf16*)(F.ws + WS_AB); bf16* MIX = (bf16*)(F.ws + WS_MIX); const float* tw = (const float*)(F.ws + WS_TW);
    LAS float* t128 = (LAS float*)F.lds;
    for (int i = F.tid; i < 128; i += NTHR) { t128[2 * i] = tw[2 * (i * 64)]; t128[2 * i + 1] = tw[2 * (i * 64) + 1]; }
    __syncthreads();
    for (int idx = F.wg * NTHR + F.tid; idx < T * 512; idx += F.G * NTHR) {
        const int cp = idx & 127, g = (idx >> 7) & 3, t = idx >> 9;
        const bf16* arow = AB + (size_t)t * 1024 + g * 128;
        float y = 0.f;
        for (int cc = 0; cc < 128; ++cc) { const int k = (cc * cp) & 127; y += bf2f(arow[cc]) * t128[2 * k] - bf2f(arow[512 + cc]) * t128[2 * k + 1]; }
        MIX[(size_t)t * 1024 + g * 128 + cp] = (bf16)f2bf(y * (1.f / 1024.f));
    }
    __syncthreads();
}

__device__ __forceinline__ void phase_outproj(Frame& F, const bf16* A, const bf16* Wt, const float* base, float* X, const float* gate  , const float* bias) {
    RowLin rp{A, (size_t)D};
    for (int u = F.wg; u < (T / 128) * 8; u += F.G) {
        const int mt = u / 8, nt = u % 8;
        auto epi = [&](int mb, int nb, const f32x16& c0, const f32x16& c1, int lane) {
            const int h = lane >> 5, cl = lane & 31, b = mb >> 13;
#pragma unroll
            for (int half = 0; half < 2; ++half) { const int col = nb + 32 * half + cl; const float gv = gate[(size_t)b * 6144 + col], bv = bias ? bias[col] : 0.f;
#pragma unroll
                for (int i = 0; i < 16; ++i) { const size_t o = (size_t)(mb + crow(i, h)) * D + col; const float a = half ? c1[i] : c0[i]; X[o] = base[o] + gv * (a + bv); } }
        };
        sgemm_tile(rp, Wt, D, mt * 128, nt * 128, epi, F.wave, F.lane);
    }
}

__device__ __forceinline__ void route_select(const float (&lg)[16], const float* rb, int& be1, int& be2, float& w1, float& w2) {
    float best = -1e30f; float bs1 = 0.f, bs2 = 0.f; be1 = 0; be2 = 0;
#pragma unroll
    for (int g = 0; g < 4; ++g) {
        float v1 = -1e30f, v2 = -1e30f, s1 = 0.f, s2 = 0.f; int j1 = 0, j2 = 0;
#pragma unroll
        for (int q = 0; q < 4; ++q) { const float sc = sigmoid_f(lg[4 * g + q]), x = sc + rb[4 * g + q];
            if (x > v1) { v2 = v1; j2 = j1; s2 = s1; v1 = x; j1 = q; s1 = sc; } else if (x > v2) { v2 = x; j2 = q; s2 = sc; } }
        const float gs = v1 + v2;
        if (gs > best) { best = gs; be1 = 4 * g + j1; be2 = 4 * g + j2; bs1 = s1; bs2 = s2; }
    }
    const float inv = 1.f / (bs1 + bs2); w1 = bs1 * inv; w2 = bs2 * inv;
}
__device__ __forceinline__ void phase_norm2_route(Frame& F, int layer) {
    const float* mod = (const float*)(F.ws + WS_MOD) + (size_t)layer * 5 * 6144;
    const float* X = F.out; const bf16* XB = (const bf16*)(F.ws + WS_XB); bf16* HB = (bf16*)(F.ws + WS_HB);
    const float* rw = F.in[I_RW]; const float* rb = F.in[I_RB];
    int* tok_e = (int*)(F.ws + WS_TOKE); int* tok_p = (int*)(F.ws + WS_TOKP); float* tok_w = (float*)(F.ws + WS_TOKW);
    int* slot_t = (int*)(F.ws + WS_SLOTT) + layer * 16 * CAP;
    float* slot_w = (float*)(F.ws + WS_SLOTW) + layer * 16 * CAP;
    unsigned* cnt = F.ctl + CW_CNT + layer * 16 * 64;
    LAS float* rwt = (LAS float*)F.lds;
    LAS int* sel_e = (LAS int*)(F.lds + 65536);
    LAS float* sel_w = (LAS float*)(F.lds + 65536 + 1024);
    LAS int* wcnt = (LAS int*)(F.lds + 65536 + 2048);
    LAS int* ebase = wcnt + 64;
    __syncthreads();
    for (int t = F.tid; t < 4096; t += NTHR) { const int i = t >> 2, e4 = t & 3; const f32x4 w = *(const f32x4*)(rw + (size_t)i * 16 + 4 * e4);
        const int p = (i & 512) + 256 * ((i >> 2) & 1) + 4 * ((i >> 3) & 63) + (i & 3);
        rwt[(4 * e4 + 0) * 1024 + p] = w.x; rwt[(4 * e4 + 1) * 1024 + p] = w.y; rwt[(4 * e4 + 2) * 1024 + p] = w.z; rwt[(4 * e4 + 3) * 1024 + p] = w.w; }
    __syncthreads();
    for (int rb0 = F.wg; rb0 < T / 128; rb0 += F.G) {
        const int b = (rb0 * 128) >> 13;
        f32x4 gm[4], sh[4];
        { const float* m = mod + (size_t)b * 6144; const float* g = F.in[I_NFG] + layer * D;
#pragma unroll
          for (int jj = 0; jj < 4; ++jj) { const int o = ROFF(F.lane, jj); gm[jj] = *(const f32x4*)(g + o) * (1.f + *(const f32x4*)(m + 4096 + o)); sh[jj] = *(const f32x4*)(m + 3072 + o); } }
        const int rbase = rb0 * 128 + F.wave * 16;
        f32x4 v0[4], v1[4]; xrow_load(X, XB, (size_t)rbase, F.lane, v0); xrow_load(X, XB, (size_t)(rbase + 1), F.lane, v1);
#pragma unroll 1
        for (int j = 0; j < 16; j += 2) {
            const int lr = F.wave * 16 + j, row = rbase + j;
            f32x4 n0[4], n1[4];
            { const int nr = (j + 2 < 16) ? row + 2 : row; xrow_load(X, XB, (size_t)nr, F.lane, n0); xrow_load(X, XB, (size_t)(nr + 1), F.lane, n1); }
            const float rstd0 = rsqrtf(row_sumsq(v0) * (1.f / D) + EPS), rstd1 = rsqrtf(row_sumsq(v1) * (1.f / D) + EPS);
#pragma unroll
            for (int jj = 0; jj < 4; ++jj) { v0[jj] = v0[jj] * rstd0 * gm[jj] + sh[jj]; v1[jj] = v1[jj] * rstd1 * gm[jj] + sh[jj]; }
            row_store_bf16(HB + (size_t)row * D, v0, F.lane); row_store_bf16(HB + (size_t)(row + 1) * D, v1, F.lane);
            float lg0[16], lg1[16];
#pragma unroll
            for (int e = 0; e < 16; ++e) { float a0 = 0.f, a1 = 0.f;
#pragma unroll
                for (int jj = 0; jj < 4; ++jj) { const f32x4 w4 = *(const LAS f32x4*)(rwt + e * 1024 + 256 * jj + 4 * F.lane);
                    a0 += (v0[jj].x * w4.x + v0[jj].y * w4.y) + (v0[jj].z * w4.z + v0[jj].w * w4.w); a1 += (v1[jj].x * w4.x + v1[jj].y * w4.y) + (v1[jj].z * w4.z + v1[jj].w * w4.w); }
                lg0[e] = a0; lg1[e] = a1; }
#pragma unroll
            for (int e = 0; e < 16; ++e) { lg0[e] = wave_sum(lg0[e]); lg1[e] = wave_sum(lg1[e]); }
            int e1, e2; float w1, w2;
            route_select(lg0, rb, e1, e2, w1, w2);
            if (F.lane == 0) { sel_e[2 * lr] = e1; sel_e[2 * lr + 1] = e2; sel_w[2 * lr] = w1; sel_w[2 * lr + 1] = w2; }
            route_select(lg1, rb, e1, e2, w1, w2);
            if (F.lane == 0) { sel_e[2 * lr + 2] = e1; sel_e[2 * lr + 3] = e2; sel_w[2 * lr + 2] = w1; sel_w[2 * lr + 3] = w2; }
#pragma unroll
            for (int jj = 0; jj < 4; ++jj) { v0[jj] = n0[jj]; v1[jj] = n1[jj]; }
        }
        __syncthreads();
        int my_e = 0, my_rank = 0; float my_w = 0.f;
        if (F.tid < 256) { my_e = sel_e[F.tid]; my_w = sel_w[F.tid];
            const unsigned long long below = (1ull << F.lane) - 1ull;
#pragma unroll 1
            for (int ee = 0; ee < 16; ++ee) { const unsigned long long mk = __ballot(my_e == ee);
                if (my_e == ee) my_rank = __popcll(mk & below);
                if (F.lane == 0) wcnt[F.wave * 16 + ee] = __popcll(mk); } }
        __syncthreads();
        if (F.tid < 16) { const int n = wcnt[F.tid] + wcnt[16 + F.tid] + wcnt[32 + F.tid] + wcnt[48 + F.tid];
            ebase[F.tid] = n ? (int)atomicAdd(cnt + F.tid * 64, (unsigned)n) : 0; }
        __syncthreads();
        if (F.tid < 256) { int pos = ebase[my_e] + my_rank;
            for (int w = 0; w < F.wave; ++w) pos += wcnt[w * 16 + my_e];
            const int tok = rb0 * 128 + (F.tid >> 1), k = F.tid & 1;
            slot_t[my_e * CAP + pos] = tok; slot_w[my_e * CAP + pos] = my_w; tok_e[2 * tok + k] = my_e; tok_p[2 * tok + k] = pos; tok_w[2 * tok + k] = my_w; }
        __syncthreads();
    }
}


__device__ __forceinline__ void phase_norm2_route_mfma(Frame& F, int layer) {
    constexpr int AP = 1032;
    const float* mod = (const float*)(F.ws + WS_MOD) + (size_t)layer * 5 * 6144;
    const bf16* XB = (const bf16*)(F.ws + WS_XB); bf16* HB = (bf16*)(F.ws + WS_HB);
    const float* rw = F.in[I_RW]; const float* rb = F.in[I_RB]; const float* gsrc = F.in[I_NFG] + layer * D;
    int* tok_e = (int*)(F.ws + WS_TOKE); int* tok_p = (int*)(F.ws + WS_TOKP); float* tok_w = (float*)(F.ws + WS_TOKW);
    int* slot_t = (int*)(F.ws + WS_SLOTT) + layer * 16 * CAP;
    float* slot_w = (float*)(F.ws + WS_SLOTW) + layer * 16 * CAP;
    unsigned* cnt = F.ctl + CW_CNT + layer * 16 * 64;
    LAS bf16* AH = (LAS bf16*)F.lds; LAS bf16* AL = AH + 16 * AP;
    LAS float* cbv = (LAS float*)(F.lds + 2 * 16 * AP * 2);
    LAS float* rstdv = cbv + 16;
    LAS float* lgt = rstdv + 128;
    LAS int* sel_e = (LAS int*)(lgt + 128 * 16);
    LAS float* sel_w = (LAS float*)(sel_e + 256);
    LAS int* wcnt = (LAS int*)(sel_w + 256);
    LAS int* ebase = wcnt + 64;
    LAS float* cpart = (LAS float*)(ebase + 16);
    for (int rb0 = F.wg; rb0 < T / 128; rb0 += F.G) {
        const int b = (rb0 * 128) >> 13; const float* m = mod + (size_t)b * 6144;
        __syncthreads();
        { float cp[16];
#pragma unroll
          for (int e = 0; e < 16; ++e) cp[e] = 0.f;
          for (int k = F.tid; k < D; k += NTHR) { const float gmk = gsrc[k] * (1.f + m[4096 + k]), shk = m[3072 + k];
#pragma unroll
              for (int e4 = 0; e4 < 4; ++e4) { const f32x4 w4 = *(const f32x4*)(rw + (size_t)k * 16 + 4 * e4);
#pragma unroll
                  for (int q = 0; q < 4; ++q) { const int e = 4 * e4 + q; const float pr = gmk * w4[q]; const unsigned hi = f2bf(pr); const unsigned lo = f2bf(pr - bf2f(hi));
                      AH[e * AP + k] = (bf16)hi; AL[e * AP + k] = (bf16)lo; cp[e] += shk * w4[q]; } } }
#pragma unroll
          for (int e = 0; e < 16; ++e) { const float t = wave_sum(cp[e]); if (F.lane == 0) cpart[F.wave * 16 + e] = t; } }
        __syncthreads();
        if (F.tid < 16) { float t = 0.f;
#pragma unroll
            for (int w = 0; w < 8; ++w) t += cpart[w * 16 + F.tid];
            cbv[F.tid] = t; }
        f32x4 gm[4], sh[4];
#pragma unroll
        for (int jj = 0; jj < 4; ++jj) { const int o = ROFF(F.lane, jj); gm[jj] = *(const f32x4*)(gsrc + o) * (1.f + *(const f32x4*)(m + 4096 + o)); sh[jj] = *(const f32x4*)(m + 3072 + o); }
        const int rbase = rb0 * 128 + F.wave * 16;
        {
            u32x4 raw[16][2];
#pragma unroll
            for (int j = 0; j < 16; ++j)
#pragma unroll
                for (int hh = 0; hh < 2; ++hh) raw[j][hh] = *(const u32x4*)(XB + (size_t)(rbase + j) * D + 512 * hh + 8 * F.lane);
            float W[8], X[4], Y[2];
#pragma unroll
            for (int i = 0; i < 8; ++i) { float sa = 0.f, sb = 0.f;
#pragma unroll
                for (int hh = 0; hh < 2; ++hh) { const u32x4 a = raw[2 * i][hh], c = raw[2 * i + 1][hh];
                    sa = dot2_bf16(a.x, a.x, sa); sa = dot2_bf16(a.y, a.y, sa); sa = dot2_bf16(a.z, a.z, sa); sa = dot2_bf16(a.w, a.w, sa);
                    sb = dot2_bf16(c.x, c.x, sb); sb = dot2_bf16(c.y, c.y, sb); sb = dot2_bf16(c.z, c.z, sb); sb = dot2_bf16(c.w, c.w, sb); }
                W[i] = swap32_add(sa, sb); }
#pragma unroll
            for (int i = 0; i < 4; ++i) X[i] = swap16_add(W[2 * i], W[2 * i + 1]);
            const bool b3 = (F.lane & 8) != 0, b2 = (F.lane & 4) != 0;
#pragma unroll
            for (int i = 0; i < 2; ++i) Y[i] = sel_add<0x140>(X[2 * i], X[2 * i + 1], b3);
            float Z = sel_add<0x141>(Y[0], Y[1], b2);
            Z += dppf<0x4E>(Z); Z += dppf<0xB1>(Z);
            const int rr = ((F.lane >> 5) & 1) + ((F.lane >> 4) & 1) * 2 + ((F.lane >> 3) & 1) * 4 + ((F.lane >> 2) & 1) * 8;
            if (!(F.lane & 3)) rstdv[F.wave * 16 + rr] = rsqrtf(Z * (1.f / D) + EPS);
            __builtin_amdgcn_wave_barrier();
            float rs[16];
#pragma unroll
            for (int i = 0; i < 4; ++i) { const f32x4 t = *(const LAS f32x4*)(rstdv + F.wave * 16 + 4 * i); rs[4 * i] = t.x; rs[4 * i + 1] = t.y; rs[4 * i + 2] = t.z; rs[4 * i + 3] = t.w; }
#pragma unroll
            for (int j = 0; j < 16; ++j) { f32x4 v[4];
#pragma unroll
                for (int hh = 0; hh < 2; ++hh) { const u32x4 w = raw[j][hh]; v[2 * hh] = (f32x4){bflo(w.x), bfhi(w.x), bflo(w.y), bfhi(w.y)}; v[2 * hh + 1] = (f32x4){bflo(w.z), bfhi(w.z), bflo(w.w), bfhi(w.w)}; }
#pragma unroll
                for (int jj = 0; jj < 4; ++jj) v[jj] = v[jj] * rs[j] * gm[jj] + sh[jj];
#pragma unroll
                for (int hh = 0; hh < 2; ++hh) { u32x2 w; w.x = pk_fp8x4s(v[2 * hh], FSC); w.y = pk_fp8x4s(v[2 * hh + 1], FSC); *(u32x2*)((unsigned char*)HB + (size_t)(rbase + j) * D + 512 * hh + 8 * F.lane) = w; } }
        }
        __syncthreads();
        { const int fr = F.lane & 15, fq = F.lane >> 4;
          f32x4 acc = {0.f, 0.f, 0.f, 0.f};
          const bf16* xr = XB + (size_t)(rb0 * 128 + 16 * F.wave + fr) * D + 8 * fq;
          const LAS bf16* ah = AH + fr * AP + 8 * fq; const LAS bf16* al = AL + fr * AP + 8 * fq;
#pragma unroll
          for (int s2 = 0; s2 < 32; ++s2) { const bf16x8 xb = *(const bf16x8*)(xr + 32 * s2);
              acc = __builtin_amdgcn_mfma_f32_16x16x32_bf16(*(const LAS bf16x8*)(ah + 32 * s2), xb, acc, 0, 0, 0);
              acc = __builtin_amdgcn_mfma_f32_16x16x32_bf16(*(const LAS bf16x8*)(al + 32 * s2), xb, acc, 0, 0, 0); }
          const int lrow = 16 * F.wave + fr; const float rs = rstdv[lrow];
#pragma unroll
          for (int i = 0; i < 4; ++i) lgt[lrow * 16 + 4 * fq + i] = rs * acc[i] + cbv[4 * fq + i]; }
        __syncthreads();
        if (F.tid < 128) { float lg[16];
#pragma unroll
            for (int e4 = 0; e4 < 4; ++e4) { const f32x4 t = *(const LAS f32x4*)(lgt + F.tid * 16 + 4 * e4); lg[4 * e4] = t.x; lg[4 * e4 + 1] = t.y; lg[4 * e4 + 2] = t.z; lg[4 * e4 + 3] = t.w; }
            int e1, e2; float w1, w2; route_select(lg, rb, e1, e2, w1, w2);
            sel_e[2 * F.tid] = e1; sel_e[2 * F.tid + 1] = e2; sel_w[2 * F.tid] = w1; sel_w[2 * F.tid + 1] = w2; }
        __syncthreads();
        int my_e = 0, my_rank = 0; float my_w = 0.f;
        if (F.tid < 256) { my_e = sel_e[F.tid]; my_w = sel_w[F.tid];
            const unsigned long long below = (1ull << F.lane) - 1ull;
#pragma unroll 1
            for (int ee = 0; ee < 16; ++ee) { const unsigned long long mk = __ballot(my_e == ee);
                if (my_e == ee) my_rank = __popcll(mk & below);
                if (F.lane == 0) wcnt[F.wave * 16 + ee] = __popcll(mk); } }
        __syncthreads();
        if (F.tid < 16) { const int n = wcnt[F.tid] + wcnt[16 + F.tid] + wcnt[32 + F.tid] + wcnt[48 + F.tid];
            ebase[F.tid] = n ? (int)atomicAdd(cnt + F.tid * 64, (unsigned)n) : 0; }
        __syncthreads();
        if (F.tid < 256) { int pos = ebase[my_e] + my_rank;
            for (int w = 0; w < F.wave; ++w) pos += wcnt[w * 16 + my_e];
            const int tok = rb0 * 128 + (F.tid >> 1), k = F.tid & 1;
            slot_t[my_e * CAP + pos] = tok; slot_w[my_e * CAP + pos] = my_w; tok_e[2 * tok + k] = my_e; tok_p[2 * tok + k] = pos; tok_w[2 * tok + k] = my_w; }
    }
    __syncthreads();
}

constexpr int MOEMAP_OFF = LDS_BYTES - 256;
__device__ __forceinline__ LAS int* moe_map(Frame& F, int layer) {
    LAS int* mm = (LAS int*)(F.lds + MOEMAP_OFF);
    __syncthreads();
    if (F.tid < 64) { const unsigned* cnt = F.ctl + CW_CNT + layer * 16 * 64;
        const int n = (F.tid < 16) ? (int)__hip_atomic_load(cnt + F.tid * 64, __ATOMIC_RELAXED, __HIP_MEMORY_SCOPE_AGENT) : 0;
        const int pad = (n + 255) & ~255; int x = pad;
#pragma unroll
        for (int o = 1; o < 16; o <<= 1) { const int t = __shfl_up(x, o); if (F.lane >= o) x += t; }
        if (F.tid < 16) { mm[F.tid] = n; mm[16 + F.tid] = x - pad; } }
    __syncthreads();
    return mm;
}
struct RowGather { const bf16* base; const int* list; int n; __device__ __forceinline__ const bf16* operator()(int m) const { const int tok = m < n ? list[m] : 0; return base + (size_t)tok * D; } };

__device__ __forceinline__ void phase_moe_gateup(Frame& F, int layer) {
    LAS int* mm = moe_map(F, layer);
    const bf16* HB = (const bf16*)(F.ws + WS_HB); bf16* HID = (bf16*)(F.ws + WS_HID);
    const int* slot_t = (const int*)(F.ws + WS_SLOTT) + layer * 16 * CAP; const float* slot_w = (const float*)(F.ws + WS_SLOTW) + layer * 16 * CAP;
    int ubase = 0;
#pragma unroll 1
    for (int e = 0; e < 16; ++e) {
        const int n = mm[e], hbe = mm[16 + e], rt = (n + 127) >> 7, nu = rt * 8;
        const bf16* Wt = (const bf16*)(F.ws + WS_WGU) + (size_t)(layer * 16 + e) * 1024 * 1024;
        RowGather rp{HB, slot_t + e * CAP, n};
        int first = (F.wg - ubase % F.G + F.G) % F.G;
        for (int u = first; u < nu; u += F.G) {
            const int mt = u / 8, nt = u % 8;
            auto epi = [&](int mb, int nb, const f32x16& c0, const f32x16& c1, int lane) {
                const int h = lane >> 5, cl = lane & 31; const int col = (nb >> 1) + cl;
#pragma unroll
                for (int i = 0; i < 16; ++i) { const int r = mb + crow(i, h);
                    if (r < n) { const float w = slot_w[e * CAP + r]; HID[(size_t)(hbe + r) * FF + col] = (bf16)f2bf(w * silu_f(c0[i]) * c1[i]); } }
            };
            sgemm_tile(rp, Wt, D, mt * 128, nt * 128, epi, F.wave, F.lane);
        }
        ubase += nu;
    }
}
__device__ __forceinline__ void phase_moe_down(Frame& F, int layer) {
    LAS int* mm = moe_map(F, layer);
    const bf16* HID = (const bf16*)(F.ws + WS_HID); bf16* Y = (bf16*)(F.ws + WS_Y);
    int ubase = 0;
#pragma unroll 1
    for (int e = 0; e < 16; ++e) {
        const int n = mm[e], hbe = mm[16 + e], rt = (n + 127) >> 7, nu = rt * 8;
        const bf16* Wt = (const bf16*)(F.ws + WS_WDN) + (size_t)(layer * 16 + e) * 1024 * 512;
        RowLin rp{HID + (size_t)hbe * FF, (size_t)FF};
        int first = (F.wg - ubase % F.G + F.G) % F.G;
        for (int u = first; u < nu; u += F.G) {
            const int mt = u / 8, nt = u % 8;
            auto epi = [&](int mb, int nb, const f32x16& c0, const f32x16& c1, int lane) {
                const int h = lane >> 5, cl = lane & 31;
#pragma unroll
                for (int i = 0; i < 16; ++i) { const int r = mb + crow(i, h);
                    if (r < n) { bf16* yr = Y + (size_t)(hbe + r) * D + nb + cl; yr[0] = (bf16)f2bf(c0[i]); yr[32] = (bf16)f2bf(c1[i]); } }
            };
            sgemm_tile(rp, Wt, FF, mt * 128, nt * 128, epi, F.wave, F.lane);
        }
        ubase += nu;
    }
}

template <bool FINAL>
__device__ __forceinline__ void phase_combine(Frame& F, int layer) {
    LAS int* hbs = (MK_ONE_LAUNCH ? (LAS int*)(F.lds + MOEMAP_OFF) : moe_map(F, layer)) + 16;
    const int gw = F.wg * NWAVES + F.wave, NGW = F.G * NWAVES;
    const float* mod = (const float*)(F.ws + WS_MOD);
    const int* tok_e = (const int*)(F.ws + WS_TOKE); const int* tok_p = (const int*)(F.ws + WS_TOKP);
    const unsigned char* Y8 = (const unsigned char*)(F.ws + WS_Y);
    float* X = F.out; bf16* XB = (bf16*)(F.ws + WS_XB); bf16* HB = (bf16*)(F.ws + WS_HB);
    for (int blk = gw; blk < T / 16; blk += NGW) {
        const int rbase = blk * 16, b = rbase >> 13;
        f32x4 g2v[4], gm[4], shv[4];
        { const float* g2 = mod + ((size_t)layer * 5 + b) * 6144 + 5120;
#pragma unroll
          for (int j = 0; j < 4; ++j) { const int o = ROFF(F.lane, j); g2v[j] = *(const f32x4*)(g2 + o) * (1.f / YSCALE);
              if (FINAL) { gm[j] = *(const f32x4*)(F.in[I_FNG] + o); shv[j] = (f32x4){0.f, 0.f, 0.f, 0.f}; }
              else { const float* m = mod + ((size_t)(layer + 1) * 5 + b) * 6144; gm[j] = *(const f32x4*)(F.in[I_NMG] + (layer + 1) * D + o) * (1.f + *(const f32x4*)(m + 1024 + o)); shv[j] = *(const f32x4*)(m + o); } } }
        int4 te = *(const int4*)(tok_e + 2 * rbase), tp = *(const int4*)(tok_p + 2 * rbase);
        u32x4 xa[2][2], xn[2][2]; u32x2 ya[2][2][2], yn[2][2][2];
        { const int s00 = hbs[te.x] + tp.x, s01 = hbs[te.y] + tp.y, s10 = hbs[te.z] + tp.z, s11 = hbs[te.w] + tp.w;
#pragma unroll
          for (int jj = 0; jj < 2; ++jj) { const int o = 512 * jj + 8 * F.lane;
              xa[0][jj] = *(const u32x4*)(XB + (size_t)rbase * D + o); xa[1][jj] = *(const u32x4*)(XB + (size_t)(rbase + 1) * D + o);
              ya[0][0][jj] = *(const u32x2*)(Y8 + (size_t)s00 * D + o); ya[0][1][jj] = *(const u32x2*)(Y8 + (size_t)s01 * D + o);
              ya[1][0][jj] = *(const u32x2*)(Y8 + (size_t)s10 * D + o); ya[1][1][jj] = *(const u32x2*)(Y8 + (size_t)s11 * D + o); } }
        te = *(const int4*)(tok_e + 2 * (rbase + 2)); tp = *(const int4*)(tok_p + 2 * (rbase + 2));
#pragma unroll 1
        for (int jr = 0; jr < 16; jr += 2) {
            const int row = rbase + jr;
            if (jr + 2 < 16) { const int nr = row + 2;
                const int s00 = hbs[te.x] + tp.x, s01 = hbs[te.y] + tp.y, s10 = hbs[te.z] + tp.z, s11 = hbs[te.w] + tp.w;
#pragma unroll
                for (int jj = 0; jj < 2; ++jj) { const int o = 512 * jj + 8 * F.lane;
                    xn[0][jj] = *(const u32x4*)(XB + (size_t)nr * D + o); xn[1][jj] = *(const u32x4*)(XB + (size_t)(nr + 1) * D + o);
                    yn[0][0][jj] = *(const u32x2*)(Y8 + (size_t)s00 * D + o); yn[0][1][jj] = *(const u32x2*)(Y8 + (size_t)s01 * D + o);
                    yn[1][0][jj] = *(const u32x2*)(Y8 + (size_t)s10 * D + o); yn[1][1][jj] = *(const u32x2*)(Y8 + (size_t)s11 * D + o); }
                const int n2 = (jr + 4 < 16) ? row + 4 : row; te = *(const int4*)(tok_e + 2 * n2); tp = *(const int4*)(tok_p + 2 * n2); }
            f32x4 v[2][4];
#pragma unroll
            for (int q = 0; q < 2; ++q)
#pragma unroll
                for (int jj = 0; jj < 2; ++jj) { const u32x4 xw = xa[q][jj]; const u32x2 a0 = ya[q][0][jj], a1 = ya[q][1][jj];
                    v[q][2 * jj] = (f32x4){bflo(xw.x), bfhi(xw.x), bflo(xw.y), bfhi(xw.y)} + g2v[2 * jj] * (un_fp8x4(a0.x) + un_fp8x4(a1.x));
                    v[q][2 * jj + 1] = (f32x4){bflo(xw.z), bfhi(xw.z), bflo(xw.w), bfhi(xw.w)} + g2v[2 * jj + 1] * (un_fp8x4(a0.y) + un_fp8x4(a1.y)); }
            const float rstd0 = rsqrtf(row_sumsq(v[0]) * (1.f / D) + EPS), rstd1 = rsqrtf(row_sumsq(v[1]) * (1.f / D) + EPS);
#pragma unroll
            for (int q = 0; q < 2; ++q) { const float rstd = q ? rstd1 : rstd0; const size_t ro = (size_t)(row + q) * D;
                if (FINAL) {
#pragma unroll
                    for (int j = 0; j < 4; ++j) *(f32x4*)(X + ro + ROFF(F.lane, j)) = v[q][j] * rstd * gm[j];
                } else {
                    row_store_bf16(XB + ro, v[q], F.lane);
#pragma unroll
                    for (int j = 0; j < 4; ++j) v[q][j] = v[q][j] * rstd * gm[j] + shv[j];
#pragma unroll
                    for (int hh = 0; hh < 2; ++hh) { u32x2 w8; w8.x = pk_fp8x4s(v[q][2 * hh], FSC); w8.y = pk_fp8x4s(v[q][2 * hh + 1], FSC); *(u32x2*)((unsigned char*)HB + ro + 512 * hh + 8 * F.lane) = w8; }
                }
            }
#pragma unroll
            for (int q = 0; q < 2; ++q)
#pragma unroll
                for (int jj = 0; jj < 2; ++jj) { xa[q][jj] = xn[q][jj]; ya[q][0][jj] = yn[q][0][jj]; ya[q][1][jj] = yn[q][1][jj]; }
        }
    }
    __syncthreads();
}

__device__ __forceinline__ void phase_pw1(Frame& F) {
    const bf16* HB = (const bf16*)(F.ws + WS_HB); const bf16* Wt = (const bf16*)(F.ws + WS_WPW1); bf16* U = (bf16*)(F.ws + WS_U);
    const float* bias = F.in[I_PW1B];
    RowLin rp{HB, (size_t)D};
    for (int u = F.wg; u < (T / 128) * 16; u += F.G) {
        const int mt = u / 16, nt = u % 16;
        auto epi = [&](int mb, int nb, const f32x16& c0, const f32x16& c1, int lane) {
            const int h = lane >> 5, cl = lane & 31, col = (nb >> 1) + cl; const float ba = bias[col], bg = bias[1024 + col];
#pragma unroll
            for (int i = 0; i < 16; ++i) U[(size_t)(mb + crow(i, h)) * D + col] = (bf16)f2bf((c0[i] + ba) * sigmoid_f(c1[i] + bg));
        };
        sgemm_tile(rp, Wt, D, mt * 128, nt * 128, epi, F.wave, F.lane);
    }
}
__device__ __forceinline__ void phase_dwconv(Frame& F) {
    const bf16* U = (const bf16*)(F.ws + WS_U); bf16* V1 = (bf16*)(F.ws + WS_V1);
    const float* dww = F.in[I_DWW]; const float* dwb = F.in[I_DWB]; const float* lng = F.in[I_LNG]; const float* lnb = F.in[I_LNB];
    const int gw = F.wg * NWAVES + F.wave, NGW = F.G * NWAVES;
    for (int row = gw; row < T; row += NGW) {
        const int l = row & (L - 1);
        f32x4 acc[4];
#pragma unroll
        for (int j = 0; j < 4; ++j) acc[j] = *(const f32x4*)(dwb + 4 * F.lane + 256 * j);
        for (int tp = 0; tp < CONVW; ++tp) { const int ll = l + tp - 15; if (ll < 0 || ll >= L) continue;
            const bf16* ur = U + (size_t)(row + tp - 15) * D; const float* wr = dww + (size_t)tp * D;
#pragma unroll
            for (int j = 0; j < 4; ++j) { const int o = 4 * F.lane + 256 * j; const u32x2 uu = *(const u32x2*)(ur + o); const f32x4 ww = *(const f32x4*)(wr + o);
                acc[j].x += bflo(uu.x) * ww.x; acc[j].y += bfhi(uu.x) * ww.y; acc[j].z += bflo(uu.y) * ww.z; acc[j].w += bfhi(uu.y) * ww.w; } }
        float s = 0.f;
#pragma unroll
        for (int j = 0; j < 4; ++j) s += (acc[j].x + acc[j].y) + (acc[j].z + acc[j].w);
        const float mean = wave_sum(s) * (1.f / D); float q = 0.f;
#pragma unroll
        for (int j = 0; j < 4; ++j) { acc[j] = acc[j] - mean; q += (acc[j].x * acc[j].x + acc[j].y * acc[j].y) + (acc[j].z * acc[j].z + acc[j].w * acc[j].w); }
        const float rstd = rsqrtf(wave_sum(q) * (1.f / D) + EPS);
#pragma unroll
        for (int j = 0; j < 4; ++j) { const int o = 4 * F.lane + 256 * j; const f32x4 gg = *(const f32x4*)(lng + o), bb = *(const f32x4*)(lnb + o);
            f32x4 y = acc[j] * rstd * gg + bb; y.x = silu_f(y.x); y.y = silu_f(y.y); y.z = silu_f(y.z); y.w = silu_f(y.w); acc[j] = y; }
        row_store_bf16(V1 + (size_t)row * D, acc, F.lane);
    }
}


namespace pg {
constexpr int BM = 256, BK = 64, HALF = 128, HTB = HALF * BK * 2, STAGE_BYTES = 8 * HTB;
constexpr int TAB_OFF = STAGE_BYTES;
__device__ __forceinline__ int lds_byte(int r, int c) { const int st = (r >> 4) * 2 + (c >> 5), rr = r & 15, cc = c & 31, ob = rr * 64 + cc * 2; return st * 1024 + (ob ^ (((ob >> 9) & 1) << 5)); }
__device__ __forceinline__ void stage_rc(int b, int& R, int& C) { const int st = b / 1024, sb = b % 1024, swz = sb ^ (((sb >> 9) & 1) << 5); R = (st >> 1) * 16 + swz / 64; C = (st & 1) * 32 + (swz % 64) / 2; }
__device__ __forceinline__ int perm32(int rho) { const int n = rho >> 4, i = rho & 15; return 8 * (i >> 2) + 4 * n + (i & 3); }
__device__ __forceinline__ unsigned cvt_pk_bf16(float lo, float hi) { unsigned r; asm volatile("v_cvt_pk_bf16_f32 %0, %1, %2" : "=v"(r) : "v"(lo), "v"(hi)); return r; }

struct GU { const char* B; int p0, p1, p2, p3; };

template <class Epi, class Sched, bool F8 = false>
__device__ __forceinline__ void gemm_phase(LAS unsigned char* lds, const char* Abase, const int K, const Sched& S, const Epi& E) {
    const int tid = threadIdx.x, wid = __builtin_amdgcn_readfirstlane(tid >> 6), lane = tid & 63, wr = wid >> 2, wc = wid & 3, fr = lane & 15, fq = lane >> 4;
    const int nt = K / BK;
    int sR[2], sC[2]; unsigned voffB[2];
#pragma unroll
    for (int i = 0; i < 2; ++i) { int R, C; stage_rc(tid * 16 + i * 8192, R, C); sR[i] = R; sC[i] = C; int Rb = Epi::PERM ? ((R & ~31) + perm32(R & 31)) : R;
        if constexpr (Epi::REMAP16) Rb = 64 * ((Rb >> 5) & 3) + 16 * ((Rb >> 3) & 3) + (Rb & 7);
        voffB[i] = (unsigned)(Rb * K + C) * 2u; }
    const size_t kstep = (size_t)(BK * 2);
    const size_t hstep = (size_t)(Epi::REMAP16 ? 8 : HALF) * K * 2;
    const unsigned ldsw = (unsigned)wid * 1024u;
    const int aoff = lds_byte(wr * 64 + fr, fq * 8), boff = lds_byte(wc * 32 + fr, fq * 8);
#define PG_SA(b, h) (((b) * 2 + (h)) * HTB)
#define PG_SB(b, h) ((4 + (b) * 2 + (h)) * HTB)
#define PG_STAGE(bufoff, gbase, voff) do { _Pragma("unroll") for (int _i = 0; _i < 2; ++_i) \
        __builtin_amdgcn_global_load_lds((const unsigned*)((const char*)(gbase) + (voff)[_i]), (LAS unsigned*)(lds + (bufoff) + ldsw + _i * 8192), 16, 0, 0); } while (0)
#define PG_LDA(dst, b, h) do { _Pragma("unroll") for (int m = 0; m < 4; ++m) _Pragma("unroll") for (int k = 0; k < 2; ++k) dst[m][k] = *(const LAS bf16x8*)(lds + PG_SA(b, h) + aoff + m * 2048 + k * 1024); } while (0)
#define PG_LDB(dst, b, h) do { _Pragma("unroll") for (int n = 0; n < 2; ++n) _Pragma("unroll") for (int k = 0; k < 2; ++k) dst[n][k] = *(const LAS bf16x8*)(lds + PG_SB(b, h) + boff + n * 2048 + k * 1024); } while (0)
#define PG_C8(x) (__builtin_shufflevector(__builtin_bit_cast(i32x4_t, (x)[0]), __builtin_bit_cast(i32x4_t, (x)[1]), 0, 1, 2, 3, 4, 5, 6, 7))
#define PG_MMA(ai, bj, At, Bt) do { __builtin_amdgcn_s_setprio(1); _Pragma("unroll") for (int m = 0; m < 4; ++m) _Pragma("unroll") for (int n = 0; n < 2; ++n) { \
        if constexpr (F8) { asm volatile("v_mfma_f32_16x16x128_f8f6f4 %0, %1, %2, %0" : "+v"(acc[ai][bj][m][n]) : "v"(PG_C8(Bt[n])), "v"(PG_C8(At[m]))); } \
        else { _Pragma("unroll") for (int k = 0; k < 2; ++k) acc[ai][bj][m][n] = __builtin_amdgcn_mfma_f32_16x16x32_bf16(Bt[n][k], At[m][k], acc[ai][bj][m][n], 0, 0, 0); } } __builtin_amdgcn_s_setprio(0); } while (0)
#define PG_WAIT_V(n) asm volatile("s_waitcnt vmcnt(" #n ")" ::: "memory")
#define PG_WAIT_L(n) asm volatile("s_waitcnt lgkmcnt(" #n ")" ::: "memory")
#define PG_BAR __builtin_amdgcn_s_barrier()
#define PG_SCHED __builtin_amdgcn_sched_barrier(0)
    GU cur, nxt; int ui = 0;
    if (!S.next(0, cur)) return;
    f32x4 acc[2][2][4][2];
#pragma unroll
    for (int a = 0; a < 2; ++a)
#pragma unroll
        for (int b = 0; b < 2; ++b)
#pragma unroll
            for (int m = 0; m < 4; ++m)
#pragma unroll
                for (int n = 0; n < 2; ++n) acc[a][b][m][n] = (f32x4){0.f, 0.f, 0.f, 0.f};
    bf16x8 At[4][2], B0[2][2], B1[2][2];
    if constexpr (Sched::GATHER) { S.stage_table(cur, 0, lds, wid, lane); PG_WAIT_V(0); PG_BAR; }
    unsigned voC[2][2], voN[2][2];
#pragma unroll
    for (int h = 0; h < 2; ++h)
#pragma unroll
        for (int i = 0; i < 2; ++i) { voC[h][i] = S.voff(cur, 0, lds, h * HALF + sR[i], sC[i]); voN[h][i] = voC[h][i]; }
    const char* cB = cur.B;
    PG_STAGE(PG_SB(0, 0), cB, voffB); PG_STAGE(PG_SB(0, 1), cB + hstep, voffB); PG_STAGE(PG_SA(0, 0), Abase, voC[0]); PG_STAGE(PG_SA(0, 1), Abase, voC[1]);
    if (wr == 1) PG_BAR;
    PG_WAIT_V(2); PG_BAR;
    PG_STAGE(PG_SB(1, 0), cB + kstep, voffB); PG_STAGE(PG_SA(1, 0), Abase + kstep, voC[0]); PG_STAGE(PG_SB(1, 1), cB + hstep + kstep, voffB);
    PG_WAIT_V(6); PG_BAR;
    for (;;) {
        const bool has_next = S.next(ui + 1, nxt);
        if constexpr (Sched::GATHER) { if (has_next) S.stage_table(nxt, (ui + 1) & 1, lds, wid, lane); }
        const char* nB = has_next ? nxt.B : cB;
        for (int t = 0; t < nt; t += 2) {
            const bool last = (t == nt - 2);
            if (last && has_next) {
#pragma unroll
                for (int h = 0; h < 2; ++h)
#pragma unroll
                    for (int i = 0; i < 2; ++i) voN[h][i] = S.voff(nxt, (ui + 1) & 1, lds, h * HALF + sR[i], sC[i]);
            }
            unsigned vo2[2][2];
#pragma unroll
            for (int h = 0; h < 2; ++h)
#pragma unroll
                for (int i = 0; i < 2; ++i) vo2[h][i] = last ? voN[h][i] : voC[h][i];
            const char* a1 = Abase + (size_t)(t + 1) * kstep;
            const char* a2 = last ? Abase : Abase + (size_t)(t + 2) * kstep; const char* b2 = last ? nB : cB + (size_t)(t + 2) * kstep;
            const char* a3 = a2 + kstep; const char* b3 = b2 + kstep;
            PG_LDB(B0, 0, 0); PG_LDB(B1, 0, 1); PG_SCHED; PG_LDA(At, 0, 0); PG_STAGE(PG_SA(1, 1), a1, voC[1]);
            PG_WAIT_V(8); PG_WAIT_L(0); PG_BAR; PG_MMA(0, 0, At, B0); PG_MMA(0, 1, At, B1); PG_BAR; PG_SCHED;
            PG_LDA(At, 0, 1); PG_STAGE(PG_SB(0, 0), b2, voffB); PG_STAGE(PG_SB(0, 1), b2 + hstep, voffB); PG_STAGE(PG_SA(0, 0), a2, vo2[0]);
            PG_WAIT_V(8); PG_WAIT_L(0); PG_BAR; PG_MMA(1, 0, At, B0); PG_MMA(1, 1, At, B1); PG_BAR; PG_SCHED;
            PG_LDB(B0, 1, 0); PG_LDB(B1, 1, 1); PG_SCHED; PG_LDA(At, 1, 0); PG_STAGE(PG_SA(0, 1), a2, vo2[1]);
            PG_WAIT_V(8); PG_WAIT_L(0); PG_BAR; PG_MMA(0, 0, At, B0); PG_MMA(0, 1, At, B1); PG_BAR; PG_SCHED;
            PG_LDA(At, 1, 1); PG_STAGE(PG_SB(1, 0), b3, voffB); PG_STAGE(PG_SB(1, 1), b3 + hstep, voffB); PG_STAGE(PG_SA(1, 0), a3, vo2[0]);
            PG_WAIT_V(8); PG_WAIT_L(0); PG_BAR; PG_MMA(1, 0, At, B0); PG_MMA(1, 1, At, B1); PG_BAR; PG_SCHED;
        }
        if (wr == 0) PG_BAR;
        if constexpr (F8) { asm volatile("s_nop 15\n\ts_nop 15" ::: "memory"); }
        E(acc, cur, wr, wc, fr, fq);
        if (!has_next) break;
#pragma unroll
        for (int a = 0; a < 2; ++a)
#pragma unroll
            for (int b = 0; b < 2; ++b)
#pragma unroll
                for (int m = 0; m < 4; ++m)
#pragma unroll
                    for (int n = 0; n < 2; ++n) acc[a][b][m][n] = (f32x4){0.f, 0.f, 0.f, 0.f};
        cur = nxt; cB = nB; ++ui;
#pragma unroll
        for (int h = 0; h < 2; ++h)
#pragma unroll
            for (int i = 0; i < 2; ++i) voC[h][i] = voN[h][i];
        if (wr == 1) PG_BAR;
    }
    PG_WAIT_V(0);
    PG_BAR;
#undef PG_SA
#undef PG_SB
#undef PG_STAGE
#undef PG_LDA
#undef PG_LDB
#undef PG_MMA
#undef PG_C8
#undef PG_WAIT_V
#undef PG_WAIT_L
#undef PG_BAR
#undef PG_SCHED
}

__device__ __forceinline__ void static_tile(int L, int nM, int nN, int& pm, int& pn) {
    const int nwg = nM * nN; int wgid = L; { const int q = nwg / 8, r = nwg % 8, xcd = wgid % 8, off = wgid / 8; wgid = (xcd < r ? xcd * (q + 1) : r * (q + 1) + (xcd - r) * q) + off; }
    const int nig = 8 * nN, gid = wgid / nig, fm = gid * 8, gsz = (nM - fm) < 8 ? (nM - fm) : 8;
    pm = fm + ((wgid % nig) % gsz); pn = (wgid % nig) / gsz;
}
struct DenseSched {
    static constexpr bool GATHER = false;
    const char* Bt; int K, nM, nN, G, c, xn, xm0, xpn;
    __device__ __forceinline__ bool next(int i, GU& u) const {
        const int L = i * G + c, nmain = nM * nN; int pm, pn;
        if (L < nmain) static_tile(L, nM, nN, pm, pn); else if (L < nmain + xn) { pm = xm0 + (L - nmain); pn = xpn; } else return false;
        u.B = Bt + (size_t)pn * BM * K * 2; u.p0 = pm; u.p1 = pn; u.p2 = 0; u.p3 = 0; return true;
    }
    __device__ __forceinline__ unsigned voff(const GU& u, int, LAS unsigned char*, int R, int C) const { return (unsigned)(((u.p0 * BM + R) * K + C) * 2); }
    __device__ __forceinline__ void stage_table(const GU&, int, LAS unsigned char*, int, int) const {}
};
template <bool GATHER_> struct MoeSched {
    static constexpr bool GATHER = GATHER_;
    const char* Wt; size_t wstride; int K; const int* list; LAS int* mm; int G, c;
    __device__ __forceinline__ bool next(int i, GU& u) const {
        int L = i * G + c;
        for (int e = 0; e < 16; ++e) { const int n = mm[e], nu = ((n + 255) >> 8) * 4;
            if (L < nu) { const int rt = L >> 2, pn = L & 3; u.B = Wt + (size_t)e * wstride + (size_t)pn * BM * K * 2; u.p0 = e; u.p1 = rt; u.p2 = pn; u.p3 = mm[16 + e]; return true; }
            L -= nu; }
        return false;
    }
    __device__ __forceinline__ unsigned voff(const GU& u, int buf, LAS unsigned char* lds, int R, int C) const {
        if constexpr (GATHER_) { const int tok = ((const LAS int*)(lds + TAB_OFF))[buf * 256 + R]; return (unsigned)((tok * K + C) * 2); }
        else return (unsigned)(((u.p3 + u.p1 * BM + R) * K + C) * 2);
    }
    __device__ __forceinline__ void stage_table(const GU& u, int buf, LAS unsigned char* lds, int wid, int lane) const {
        if constexpr (GATHER_) { const int r = (wid & 3) * 64 + lane;
            __builtin_amdgcn_global_load_lds((const unsigned*)(list + u.p0 * CAP + u.p1 * BM + r), (LAS unsigned*)(lds + TAB_OFF + buf * 1024 + (wid & 3) * 256), 4, 0, 0); }
    }
};

struct EpiInProj {
    static constexpr bool REMAP16 = false;
    static constexpr bool PERM = false;
    unsigned char* ws; float ps;
    __device__ __forceinline__ void operator()(const f32x4 (&acc)[2][2][4][2], const GU& u, int wr, int wc, int fr, int fq) const {
        const int pm = u.p0, pn = u.p1; const bool isctx = pm >= T / BM;
        float inv[4];
#pragma unroll
        for (int j = 0; j < 4; ++j) inv[j] = exp2f(-(float)(4 * fq + j) * (13.287712379549449f / 16.f));
#pragma unroll
        for (int bj = 0; bj < 2; ++bj) {
            const int cb = pn * BM + bj * HALF + wc * 32;
            bf16* dst; int pitch, cbase; bool rope = false;
            if (cb < 512) { dst = (bf16*)(ws + WS_UF); pitch = 512; cbase = 0; }
            else if (cb < 1024) { dst = (bf16*)(ws + WS_Q); pitch = 512; cbase = 512; rope = true; }
            else if (cb < 1152) { dst = isctx ? (bf16*)(ws + WS_CK) : (bf16*)(ws + WS_K); pitch = 128; cbase = 1024; rope = !isctx; }
            else { dst = isctx ? (bf16*)(ws + WS_CV) : (bf16*)(ws + WS_V); pitch = 128; cbase = 1152; }
            const bool bycol = ((cb >> 5) & 1) != 0;
#pragma unroll
            for (int ai = 0; ai < 2; ++ai)
#pragma unroll
                for (int m = 0; m < 4; ++m) {
                    const int row = pm * BM + ai * HALF + wr * 64 + m * 16 + fr;
                    f32x4 v0 = acc[ai][bj][m][0] * ps, v1 = acc[ai][bj][m][1] * ps;
                    if (rope) { const int l = row & (L - 1); const float pos = (float)(bycol ? (l & 63) : (l >> 6));
#pragma unroll
                        for (int j = 0; j < 4; ++j) { const float ang = pos * inv[j], cs = __cosf(ang), sn = __sinf(ang); const float x1 = v0[j], x2 = v1[j]; v0[j] = x1 * cs - x2 * sn; v1[j] = x1 * sn + x2 * cs; } }
                    const int orow = isctx ? row - T : row;
                    if (FAST_ATTN && cb >= 1152) {
                        const int kp = isctx ? CL : L, bb = isctx ? (orow >> 8) : (orow >> 13), key = isctx ? (orow & (CL - 1)) : (orow & (L - 1));
#pragma unroll
                        for (int n = 0; n < 2; ++n)
#pragma unroll
                            for (int j = 0; j < 4; ++j) { const int c = (cb - 1152) + 16 * n + 4 * fq + j;
                                dst[((size_t)bb * 128 + c) * kp + key] = (bf16)f2bf(n ? v1[j] : v0[j]); }
                        continue;
                    }
                    bf16* o = dst + (size_t)orow * pitch + (cb - cbase) + 4 * fq;
                    u32x2 w0, w1; w0.x = cvt_pk_bf16(v0[0], v0[1]); w0.y = cvt_pk_bf16(v0[2], v0[3]); w1.x = cvt_pk_bf16(v1[0], v1[1]); w1.y = cvt_pk_bf16(v1[2], v1[3]);
                    *(u32x2*)o = w0; *(u32x2*)(o + 16) = w1;
                }
        }
    }
};
struct EpiRes {
    static constexpr bool REMAP16 = false;
    static constexpr bool PERM = false;
    const float* base; float* X; const float* gate; const float* bias;
    __device__ __forceinline__ void operator()(const f32x4 (&acc)[2][2][4][2], const GU& u, int wr, int wc, int fr, int fq) const {
        const int row0 = u.p0 * BM + wr * 64 + fr, col0 = u.p1 * BM + wc * 32 + 4 * fq; const int b = (u.p0 * BM) >> 13;
        f32x4 gv[2][2], bv[2][2];
#pragma unroll
        for (int bj = 0; bj < 2; ++bj)
#pragma unroll
            for (int n = 0; n < 2; ++n) { gv[bj][n] = *(const f32x4*)(gate + (size_t)b * 6144 + col0 + bj * HALF + n * 16); bv[bj][n] = bias ? *(const f32x4*)(bias + col0 + bj * HALF + n * 16) : (f32x4){0.f, 0.f, 0.f, 0.f}; }
#pragma unroll
        for (int ai = 0; ai < 2; ++ai)
#pragma unroll
            for (int mp = 0; mp < 2; ++mp) {
                f32x4 bs[2][2][2];
#pragma unroll
                for (int mm = 0; mm < 2; ++mm) { const size_t off = (size_t)(row0 + ai * HALF + (2 * mp + mm) * 16) * D + col0;
#pragma unroll
                    for (int bj = 0; bj < 2; ++bj)
#pragma unroll
                        for (int n = 0; n < 2; ++n) bs[mm][bj][n] = *(const f32x4*)(base + off + bj * HALF + n * 16); }
#pragma unroll
                for (int mm = 0; mm < 2; ++mm) { const int m = 2 * mp + mm; const size_t off = (size_t)(row0 + ai * HALF + m * 16) * D + col0;
#pragma unroll
                    for (int bj = 0; bj < 2; ++bj)
#pragma unroll
                        for (int n = 0; n < 2; ++n) *(f32x4*)(X + off + bj * HALF + n * 16) = bs[mm][bj][n] + gv[bj][n] * (acc[ai][bj][m][n] + bv[bj][n]); }
                asm volatile("" ::: "memory"); }
    }
};
template <bool BASEBF> struct EpiResB {
    static constexpr bool REMAP16 = false;
    static constexpr bool PERM = true;
    const float* basef; bf16* XB; const float* gate; const float* bias; float ps;
    __device__ __forceinline__ void operator()(const f32x4 (&acc)[2][2][4][2], const GU& u, int wr, int wc, int fr, int fq) const {
        const int row0 = u.p0 * BM + wr * 64 + fr, col0 = u.p1 * BM + wc * 32 + 8 * fq; const int b = (u.p0 * BM) >> 13;
        f32x4 gv[2][2], bv[2][2];
#pragma unroll
        for (int bj = 0; bj < 2; ++bj)
#pragma unroll
            for (int n = 0; n < 2; ++n) { gv[bj][n] = *(const f32x4*)(gate + (size_t)b * 6144 + col0 + bj * HALF + n * 4); bv[bj][n] = bias ? *(const f32x4*)(bias + col0 + bj * HALF + n * 4) : (f32x4){0.f, 0.f, 0.f, 0.f}; }
        constexpr int NB2 = BASEBF ? 4 : 2;
#pragma unroll
        for (int ai = 0; ai < 2; ++ai)
#pragma unroll
            for (int mb = 0; mb < 4; mb += NB2) {
                f32x4 bf[BASEBF ? 1 : NB2][2][2]; u32x4 bw[BASEBF ? NB2 : 1][2];
#pragma unroll
                for (int mm = 0; mm < NB2; ++mm) { const size_t off = (size_t)(row0 + ai * HALF + (mb + mm) * 16) * D + col0;
#pragma unroll
                    for (int bj = 0; bj < 2; ++bj) {
                        if (BASEBF) bw[mm][bj] = *(const u32x4*)(XB + off + bj * HALF);
                        else { bf[mm][bj][0] = *(const f32x4*)(basef + off + bj * HALF); bf[mm][bj][1] = *(const f32x4*)(basef + off + bj * HALF + 4); } } }
#pragma unroll
                for (int mm = 0; mm < NB2; ++mm) { const int m = mb + mm; const size_t off = (size_t)(row0 + ai * HALF + m * 16) * D + col0;
#pragma unroll
                    for (int bj = 0; bj < 2; ++bj) { f32x4 o[2];
#pragma unroll
                        for (int n = 0; n < 2; ++n) { f32x4 bsv;
                            if (BASEBF) { const unsigned wa = n ? bw[mm][bj].z : bw[mm][bj].x, wb = n ? bw[mm][bj].w : bw[mm][bj].y; bsv = (f32x4){bflo(wa), bfhi(wa), bflo(wb), bfhi(wb)}; } else bsv = bf[mm][bj][n];
                            o[n] = bsv + gv[bj][n] * (acc[ai][bj][m][n] * ps + bv[bj][n]); }
                        u32x4 w2; w2.x = cvt_pk_bf16(o[0][0], o[0][1]); w2.y = cvt_pk_bf16(o[0][2], o[0][3]); w2.z = cvt_pk_bf16(o[1][0], o[1][1]); w2.w = cvt_pk_bf16(o[1][2], o[1][3]);
                        *(u32x4*)(XB + off + bj * HALF) = w2; } }
                asm volatile("" ::: "memory"); }
    }
};
struct EpiGLU {
    static constexpr bool REMAP16 = false;
    static constexpr bool PERM = true;
    bf16* U; const float* bias; float ps;
    __device__ __forceinline__ void operator()(const f32x4 (&acc)[2][2][4][2], const GU& u, int wr, int wc, int fr, int fq) const {
        const int row0 = u.p0 * BM + wr * 64 + fr, col0 = u.p1 * HALF + wc * 32 + 8 * fq;
        f32x4 ba[2], bg[2];
#pragma unroll
        for (int n = 0; n < 2; ++n) { ba[n] = *(const f32x4*)(bias + col0 + 4 * n); bg[n] = *(const f32x4*)(bias + 1024 + col0 + 4 * n); }
#pragma unroll
        for (int ai = 0; ai < 2; ++ai)
#pragma unroll
            for (int m = 0; m < 4; ++m) { f32x4 o[2];
#pragma unroll
                for (int n = 0; n < 2; ++n) { const f32x4 a = acc[ai][0][m][n] * ps + ba[n], g = acc[ai][1][m][n] * ps + bg[n];
#pragma unroll
                    for (int j = 0; j < 4; ++j) o[n][j] = a[j] * sigmoid_f(g[j]); }
                u32x4 w; w.x = cvt_pk_bf16(o[0][0], o[0][1]); w.y = cvt_pk_bf16(o[0][2], o[0][3]); w.z = cvt_pk_bf16(o[1][0], o[1][1]); w.w = cvt_pk_bf16(o[1][2], o[1][3]);
                *(u32x4*)(U + (size_t)(row0 + ai * HALF + m * 16) * D + col0) = w; }
    }
};
struct EpiGateUp {
    static constexpr bool REMAP16 = false;
    static constexpr bool PERM = true;
    bf16* HID; const float* slot_w; LAS int* mm; float ps;
    __device__ __forceinline__ void operator()(const f32x4 (&acc)[2][2][4][2], const GU& u, int wr, int wc, int fr, int fq) const {
        const int e = u.p0, n_e = mm[e], r0 = u.p1 * BM + wr * 64 + fr, col0 = u.p2 * HALF + wc * 32 + 8 * fq;
        float wv[2][4];
#pragma unroll
        for (int ai = 0; ai < 2; ++ai)
#pragma unroll
            for (int m = 0; m < 4; ++m) wv[ai][m] = slot_w[e * CAP + r0 + ai * HALF + m * 16];
#pragma unroll
        for (int ai = 0; ai < 2; ++ai)
#pragma unroll
            for (int m = 0; m < 4; ++m) { const int r = r0 + ai * HALF + m * 16;
                if (r < n_e) { const float w = wv[ai][m] * ps; f32x4 o[2];
#pragma unroll
                    for (int n = 0; n < 2; ++n) { const f32x4 g = acc[ai][0][m][n] * ps, up = acc[ai][1][m][n];
#pragma unroll
                        for (int j = 0; j < 4; ++j) o[n][j] = w * silu_f(g[j]) * up[j]; }
                    u32x4 q; q.x = cvt_pk_bf16(o[0][0], o[0][1]); q.y = cvt_pk_bf16(o[0][2], o[0][3]); q.z = cvt_pk_bf16(o[1][0], o[1][1]); q.w = cvt_pk_bf16(o[1][2], o[1][3]);
                    *(u32x4*)(HID + (size_t)(u.p3 + r) * FF + col0) = q; } }
    }
};
struct EpiDown {
    static constexpr bool REMAP16 = false;
    static constexpr bool PERM = true;
    bf16* Y; LAS int* mm;
    __device__ __forceinline__ void operator()(const f32x4 (&acc)[2][2][4][2], const GU& u, int wr, int wc, int fr, int fq) const {
        const int e = u.p0, n_e = mm[e], r0 = u.p1 * BM + wr * 64 + fr, col0 = u.p2 * BM + wc * 32 + 8 * fq;
#pragma unroll
        for (int ai = 0; ai < 2; ++ai)
#pragma unroll
            for (int m = 0; m < 4; ++m) { const int r = r0 + ai * HALF + m * 16;
                if (r < n_e) {
#pragma unroll
                    for (int bj = 0; bj < 2; ++bj) { const f32x4 v0 = acc[ai][bj][m][0], v1 = acc[ai][bj][m][1];
                        u32x4 q; q.x = cvt_pk_bf16(v0[0], v0[1]); q.y = cvt_pk_bf16(v0[2], v0[3]); q.z = cvt_pk_bf16(v1[0], v1[1]); q.w = cvt_pk_bf16(v1[2], v1[3]);
                        *(u32x4*)(Y + (size_t)(u.p3 + r) * D + col0 + bj * HALF) = q; } } }
    }
};
struct EpiGateUpF8 {
    static constexpr bool PERM = true;
    static constexpr bool REMAP16 = false;
    unsigned char* HID8; const float* slot_w; LAS int* mm; float ps;
    __device__ __forceinline__ void operator()(const f32x4 (&acc)[2][2][4][2], const GU& u, int wr, int wc, int fr, int fq) const {
        const int e = u.p0, n_e = mm[e], r0 = u.p1 * BM + wr * 64 + fr, col0 = u.p2 * HALF + wc * 32 + 8 * fq;
        float wv[2][4];
#pragma unroll
        for (int ai = 0; ai < 2; ++ai)
#pragma unroll
            for (int m = 0; m < 4; ++m) wv[ai][m] = slot_w[e * CAP + r0 + ai * HALF + m * 16];
#pragma unroll
        for (int ai = 0; ai < 2; ++ai)
#pragma unroll
            for (int m = 0; m < 4; ++m) { const int r = r0 + ai * HALF + m * 16;
                if (r < n_e) { const float w = wv[ai][m] * ps; f32x4 o[2];
#pragma unroll
                    for (int n = 0; n < 2; ++n) { const f32x4 g = acc[ai][0][m][n] * ps, up = acc[ai][1][m][n];
#pragma unroll
                        for (int j = 0; j < 4; ++j) o[n][j] = w * silu_f(g[j]) * up[j]; }
                    u32x2 q; q.x = pk_fp8x4s(o[0], HSC); q.y = pk_fp8x4s(o[1], HSC);
                    *(u32x2*)(HID8 + (size_t)(u.p3 + r) * FF + col0) = q; } }
    }
};
struct EpiDownF8 {
    static constexpr bool PERM = true;
    static constexpr bool REMAP16 = true;
    unsigned char* Y8; LAS int* mm; float ps;
    __device__ __forceinline__ void operator()(const f32x4 (&acc)[2][2][4][2], const GU& u, int wr, int wc, int fr, int fq) const {
        const int e = u.p0, n_e = mm[e], r0 = u.p1 * BM + wr * 64 + fr, col0 = u.p2 * BM + 64 * wc + 16 * fq;
#pragma unroll
        for (int ai = 0; ai < 2; ++ai)
#pragma unroll
            for (int m = 0; m < 4; ++m) { const int r = r0 + ai * HALF + m * 16;
                if (r < n_e) { u32x4 q; q.x = pk_fp8x4(acc[ai][0][m][0] * ps); q.y = pk_fp8x4(acc[ai][0][m][1] * ps); q.z = pk_fp8x4(acc[ai][1][m][0] * ps); q.w = pk_fp8x4(acc[ai][1][m][1] * ps);
                    *(u32x4*)(Y8 + (size_t)(u.p3 + r) * D + col0) = q; } }
    }
};
}

__device__ __forceinline__ void fast_inproj(Frame& F) {
    pg::DenseSched S{(const char*)(F.ws + WS_WIN), FF, T / 256, N_IN / 256, F.G, F.wg, TC / 256, T / 256, 4};
    pg::EpiInProj E{F.ws, 1.f / (FSC * WSC)};
    pg::gemm_phase<pg::EpiInProj, pg::DenseSched, true>(F.lds, (const char*)(F.ws + WS_HB), FF, S, E);
    const int nbusy = (T / 256) * (N_IN / 256) + TC / 256 - 2 * F.G;
    if (nbusy > 0 && nbusy < F.G) { if (F.wg >= nbusy) t_items_tail(F, (F.wg - nbusy) * NWAVES + F.wave, (F.G - nbusy) * NWAVES); }
    else t_items_tail(F, F.wg * NWAVES + F.wave, F.G * NWAVES);
}
__device__ __forceinline__ void fast_outproj(Frame& F, size_t a_off, size_t w_off, const float* base, float* X, const float* gate, const float* bias) {
    if (XBF16) {
        pg::DenseSched S{(const char*)(F.ws + w_off), FF, T / 256, D / 256, F.G, F.wg, 0, 0, 0};
        if (base == X) { pg::EpiResB<true> E{nullptr, (bf16*)(F.ws + WS_XB), gate, bias, 1.f / (FSC * WSC)}; pg::gemm_phase<pg::EpiResB<true>, pg::DenseSched, true>(F.lds, (const char*)(F.ws + a_off), FF, S, E); }
        else { pg::EpiResB<false> E{base, (bf16*)(F.ws + WS_XB), gate, bias, 1.f / (FSC * WSC)}; pg::gemm_phase<pg::EpiResB<false>, pg::DenseSched, true>(F.lds, (const char*)(F.ws + a_off), FF, S, E); }
    } else { pg::DenseSched S{(const char*)(F.ws + w_off), D, T / 256, D / 256, F.G, F.wg, 0, 0, 0}; pg::EpiRes E{base, X, gate, bias}; pg::gemm_phase(F.lds, (const char*)(F.ws + a_off), D, S, E); }
}
__device__ __forceinline__ void fast_pw1(Frame& F) {
    pg::DenseSched S{(const char*)(F.ws + WS_WPW1), FF, T / 256, 2048 / 256, F.G, F.wg, 0, 0, 0};
    pg::EpiGLU E{(bf16*)(F.ws + WS_U), F.in[I_PW1B], 1.f / (FSC * WSC)};
    pg::gemm_phase<pg::EpiGLU, pg::DenseSched, true>(F.lds, (const char*)(F.ws + WS_HB), FF, S, E);
}
__device__ __forceinline__ void fast_moe_gateup(Frame& F, int layer) {
    LAS int* mm = moe_map(F, layer);
    pg::MoeSched<true> S{(const char*)(F.ws + WS_WGU) + (size_t)layer * 16 * 1024 * 1024 * 2, (size_t)1024 * 1024 * 2, D, (const int*)(F.ws + WS_SLOTT) + layer * 16 * CAP, mm, F.G, F.wg};
    pg::EpiGateUp E{(bf16*)(F.ws + WS_HID), (const float*)(F.ws + WS_SLOTW) + layer * 16 * CAP, mm, 1.f};
    pg::gemm_phase(F.lds, (const char*)(F.ws + WS_HB), D, S, E);
}
__device__ __forceinline__ void fast_moe_gateup_f8(Frame& F, int layer) {
    LAS int* mm = moe_map(F, layer);
    pg::MoeSched<true> S{(const char*)(F.ws + WS_WGU) + (size_t)layer * 16 * 1024 * 1024, (size_t)1024 * 1024, FF, (const int*)(F.ws + WS_SLOTT) + layer * 16 * CAP, mm, F.G, F.wg};
    pg::EpiGateUpF8 E{(unsigned char*)(F.ws + WS_HID), (const float*)(F.ws + WS_SLOTW) + layer * 16 * CAP, mm, 1.f / (FSC * WSC)};
    pg::gemm_phase<pg::EpiGateUpF8, pg::MoeSched<true>, true>(F.lds, (const char*)(F.ws + WS_HB), FF, S, E);
}
__device__ __forceinline__ void fast_moe_down_f8(Frame& F, int layer) {
    LAS int* mm = moe_map(F, layer);
    pg::MoeSched<false> S{(const char*)(F.ws + WS_WDN) + (size_t)layer * 16 * 1024 * 512, (size_t)1024 * 512, 256, nullptr, mm, F.G, F.wg};
    pg::EpiDownF8 E{(unsigned char*)(F.ws + WS_Y), mm, 1.f / (HSC * WSC)};
    pg::gemm_phase<pg::EpiDownF8, pg::MoeSched<false>, true>(F.lds, (const char*)(F.ws + WS_HID), 256, S, E);
}
__device__ __forceinline__ void fast_moe_down(Frame& F, int layer) {
    LAS int* mm = moe_map(F, layer);
    pg::MoeSched<false> S{(const char*)(F.ws + WS_WDN) + (size_t)layer * 16 * 1024 * 512 * 2, (size_t)1024 * 512 * 2, FF, nullptr, mm, F.G, F.wg};
    pg::EpiDown E{(bf16*)(F.ws + WS_Y), mm};
    pg::gemm_phase(F.lds, (const char*)(F.ws + WS_HID), FF, S, E);
}


struct AttnBlk { const bf16* kp; const bf16* vp; int pitch; int kb; bool valid, masked; };
__device__ __forceinline__ AttnBlk attn_blk(const unsigned char* ws, int bi, int b, int kvh, int qs) {
    AttnBlk a;
    if (bi < 8) { a.kp = (const bf16*)(ws + WS_CK) + (size_t)(b * CL + bi * 32) * 128 + kvh * 64; a.vp = (const bf16*)(ws + WS_CV) + (size_t)(b * 2 + kvh) * 64 * CL + bi * 32; a.pitch = CL; a.kb = 0; a.valid = true; a.masked = false; }
    else { const int kb = qs - 128 + 32 * (bi - 8); a.valid = (kb >= 0 && kb < L); a.kb = kb; a.masked = true; a.pitch = L;
        a.kp = (const bf16*)(ws + WS_K) + (size_t)(b * L + kb) * 128 + kvh * 64; a.vp = (const bf16*)(ws + WS_V) + (size_t)(b * 2 + kvh) * 64 * L + kb; }
    return a;
}
__device__ __forceinline__ void attn_load(const AttnBlk& a, int r, int h, bf16x8 (&kf)[4], u32x4 (&vf)[2][2]) {
    if (a.valid) {
#pragma unroll
        for (int s = 0; s < 4; ++s) kf[s] = *(const bf16x8*)(a.kp + (size_t)r * 128 + 16 * s + 8 * h);
#pragma unroll
        for (int db = 0; db < 2; ++db)
#pragma unroll
            for (int ks = 0; ks < 2; ++ks) { const bf16* vr = a.vp + (size_t)(32 * db + r) * a.pitch + 16 * ks + 4 * h;
                const u32x2 lo = *(const u32x2*)vr, hi = *(const u32x2*)(vr + 8); vf[db][ks] = (u32x4){lo.x, lo.y, hi.x, hi.y}; }
    }
}
__device__ __forceinline__ void attn_compute(const AttnBlk& a, int qs, int r, int h, const bf16x8 (&kf)[4], const u32x4 (&vf)[2][2], const bf16x8 (&qf)[2][4],
                                             f32x16 (&o)[2][2], float (&m)[2], float (&l)[2]) {
    if (!a.valid) return;
#pragma unroll
    for (int nq = 0; nq < 2; ++nq) {
        f32x16 st;
#pragma unroll
        for (int i = 0; i < 16; ++i) st[i] = 0.f;
#pragma unroll
        for (int s = 0; s < 4; ++s) st = __builtin_amdgcn_mfma_f32_32x32x16_bf16(kf[s], qf[nq][s], st, 0, 0, 0);
        float t[16]; float tmax = -INFINITY;
        const int dbase = a.kb - qs - 32 * nq - r + 4 * h;
#pragma unroll
        for (int i = 0; i < 16; ++i) { float v = st[i] * (0.125f * 1.4426950408889634f);
            if (a.masked) { const int df = dbase + (i & 3) + 8 * (i >> 2); v = (df >= -128 && df <= 128) ? v : -INFINITY; }
            t[i] = v; tmax = fmaxf(tmax, v); }
        tmax = fmaxf(tmax, __shfl_xor(tmax, 32));
        const float mn = fmaxf(m[nq], tmax), alpha = __builtin_amdgcn_exp2f(m[nq] - mn); m[nq] = mn;
        float ps = 0.f;
#pragma unroll
        for (int i = 0; i < 16; ++i) { t[i] = __builtin_amdgcn_exp2f(t[i] - mn); ps += t[i]; }
        l[nq] = l[nq] * alpha + ps;
#pragma unroll
        for (int i = 0; i < 16; ++i) { o[0][nq][i] *= alpha; o[1][nq][i] *= alpha; }
        bf16x8 pf[2];
#pragma unroll
        for (int ks = 0; ks < 2; ++ks) { const u32x4 w = {pkbf(t[8 * ks], t[8 * ks + 1]), pkbf(t[8 * ks + 2], t[8 * ks + 3]), pkbf(t[8 * ks + 4], t[8 * ks + 5]), pkbf(t[8 * ks + 6], t[8 * ks + 7])};
            pf[ks] = __builtin_bit_cast(bf16x8, w); }
#pragma unroll
        for (int db = 0; db < 2; ++db)
#pragma unroll
            for (int ks = 0; ks < 2; ++ks) o[db][nq] = __builtin_amdgcn_mfma_f32_32x32x16_bf16(__builtin_bit_cast(bf16x8, vf[db][ks]), pf[ks], o[db][nq], 0, 0, 0);
    }
}
__device__ __forceinline__ void phase_attn_mfma(Frame& F) {
    const bf16* Q = (const bf16*)(F.ws + WS_Q); bf16* MIX = (bf16*)(F.ws + WS_MIX);
    const int g = F.wave >> 1, half = F.wave & 1, r = F.lane & 31, h = F.lane >> 5;
    for (int item = F.wg; item < NB * 2 * 64; item += F.G) {
        const int qb = item & 63, kvh = (item >> 6) & 1, b = item >> 7, hd = kvh * 4 + g, qs = qb * 128 + half * 64;
        bf16x8 qf[2][4];
#pragma unroll
        for (int nq = 0; nq < 2; ++nq)
#pragma unroll
            for (int s = 0; s < 4; ++s) qf[nq][s] = *(const bf16x8*)(Q + (size_t)(b * L + qs + 32 * nq + r) * 512 + hd * 64 + 16 * s + 8 * h);
        f32x16 o[2][2];
#pragma unroll
        for (int db = 0; db < 2; ++db)
#pragma unroll
            for (int nq = 0; nq < 2; ++nq)
#pragma unroll
                for (int i = 0; i < 16; ++i) o[db][nq][i] = 0.f;
        float m[2], l[2];
        m[0] = m[1] = F.in[I_SINK][hd] * 1.4426950408889634f; l[0] = l[1] = (h == 0) ? 1.f : 0.f;
        bf16x8 kfA[4], kfB[4]; u32x4 vfA[2][2], vfB[2][2];
        AttnBlk ba = attn_blk(F.ws, 0, b, kvh, qs), bb;
        attn_load(ba, r, h, kfA, vfA);
#pragma unroll 1
        for (int bi = 0; bi < 18; bi += 2) {
            bb = attn_blk(F.ws, bi + 1, b, kvh, qs); attn_load(bb, r, h, kfB, vfB);
            attn_compute(ba, qs, r, h, kfA, vfA, qf, o, m, l);
            if (bi + 2 < 18) { ba = attn_blk(F.ws, bi + 2, b, kvh, qs); attn_load(ba, r, h, kfA, vfA); }
            attn_compute(bb, qs, r, h, kfB, vfB, qf, o, m, l);
        }
#pragma unroll
        for (int nq = 0; nq < 2; ++nq) {
            const float lt = l[nq] + __shfl_xor(l[nq], 32), il = 1.f / lt;
            bf16* orow = MIX + (size_t)(b * L + qs + 32 * nq + r) * 1024 + 512 + hd * 64;
#pragma unroll
            for (int db = 0; db < 2; ++db)
#pragma unroll
                for (int i4 = 0; i4 < 4; ++i4) { u32x2 w; w.x = pkbf(o[db][nq][4 * i4] * il, o[db][nq][4 * i4 + 1] * il); w.y = pkbf(o[db][nq][4 * i4 + 2] * il, o[db][nq][4 * i4 + 3] * il);
                    *(u32x2*)(orow + 32 * db + 8 * i4 + 4 * h) = w; }
        }
    }
}


__device__ __forceinline__ float half_max(float v) { const auto r = __builtin_amdgcn_permlane32_swap(__float_as_uint(v), __float_as_uint(v), false, false); return fmaxf(__uint_as_float(r[0]), __uint_as_float(r[1])); }
__device__ __forceinline__ float half_sum(float v) { const auto r = __builtin_amdgcn_permlane32_swap(__float_as_uint(v), __float_as_uint(v), false, false); return __uint_as_float(r[0]) + __uint_as_float(r[1]); }
constexpr int AT_KP = 72, AT_VP = 136;
constexpr int AT_KB = 128 * AT_KP * 2, AT_BUF = AT_KB + 64 * AT_VP * 2;
struct AtChunk { const bf16* kg; const bf16* vg; int vpitch, lc, b, kvh, qb, c; bool valid, local, any; };
__device__ __forceinline__ AtChunk at_chunk(const unsigned char* ws, int seq, int wg, int G) {
    AtChunk k; const int item = wg + (seq / 5) * G; k.c = seq % 5; k.any = item < NB * 2 * 64;
    k.qb = item & 63; k.kvh = (item >> 6) & 1; k.b = (item >> 7) & 3; k.local = k.c >= 2; k.lc = k.c - 2;
    if (!k.local) { k.valid = k.any; k.vpitch = CL; k.kg = (const bf16*)(ws + WS_CK) + (size_t)(k.b * CL + 128 * k.c) * 128 + k.kvh * 64; k.vg = (const bf16*)(ws + WS_CV) + (size_t)(k.b * 2 + k.kvh) * 64 * CL + 128 * k.c; }
    else { const int key0 = 128 * k.qb - 128 + 128 * k.lc; k.valid = k.any && key0 >= 0 && key0 < L; k.vpitch = L;
        k.kg = (const bf16*)(ws + WS_K) + (size_t)(k.b * L + key0) * 128 + k.kvh * 64; k.vg = (const bf16*)(ws + WS_V) + (size_t)(k.b * 2 + k.kvh) * 64 * L + key0; }
    return k;
}
__device__ __forceinline__ void at_issue(const AtChunk& k, int tid, u32x4 (&rg)[4]) {
    if (k.valid) {
#pragma unroll
        for (int i = 0; i < 2; ++i) { const int id = tid + 512 * i; rg[i] = *(const u32x4*)(k.kg + (size_t)(id >> 3) * 128 + (id & 7) * 8); }
#pragma unroll
        for (int i = 0; i < 2; ++i) { const int id = tid + 512 * i; rg[2 + i] = *(const u32x4*)(k.vg + (size_t)(id >> 4) * k.vpitch + (id & 15) * 8); }
    }
}
__device__ __forceinline__ void at_write(const AtChunk& k, LAS unsigned char* buf, int tid, const u32x4 (&rg)[4]) {
    if (k.valid) {
#pragma unroll
        for (int i = 0; i < 2; ++i) { const int id = tid + 512 * i; *(LAS u32x4*)(buf + (id >> 3) * (AT_KP * 2) + (id & 7) * 16) = rg[i]; }
#pragma unroll
        for (int i = 0; i < 2; ++i) { const int id = tid + 512 * i; *(LAS u32x4*)(buf + AT_KB + (id >> 4) * (AT_VP * 2) + (id & 15) * 16) = rg[2 + i]; }
    }
}
__device__ __forceinline__ void at_load(LAS unsigned char* buf, int blk, int r, int h, bf16x8 (&kf)[4], u32x4 (&vf)[2][2]) {
#pragma unroll
    for (int s2 = 0; s2 < 4; ++s2) kf[s2] = *(const LAS bf16x8*)(buf + (32 * blk + r) * (AT_KP * 2) + (16 * s2 + 8 * h) * 2);
#pragma unroll
    for (int db = 0; db < 2; ++db)
#pragma unroll
        for (int ks = 0; ks < 2; ++ks) { const LAS unsigned char* vr = buf + AT_KB + (32 * db + r) * (AT_VP * 2) + (32 * blk + 16 * ks + 4 * h) * 2;
            const u32x2 lo = *(const LAS u32x2*)vr, hi = *(const LAS u32x2*)(vr + 16); vf[db][ks] = (u32x4){lo.x, lo.y, hi.x, hi.y}; }
}
__device__ __forceinline__ void at_math(const bf16x8 (&kf)[4], const u32x4 (&vf)[2][2], bool masked, int kbrel, int r, int h, const bf16x8 (&qf)[2][4], f32x16 (&o)[2][2], float (&m)[2], float (&l)[2]) {
    constexpr float C = 0.125f * 1.4426950408889634f;
#pragma unroll
    for (int nq = 0; nq < 2; ++nq) {
        f32x16 st;
#pragma unroll
        for (int i = 0; i < 16; ++i) st[i] = 0.f;
#pragma unroll
        for (int s2 = 0; s2 < 4; ++s2) st = __builtin_amdgcn_mfma_f32_32x32x16_bf16(kf[s2], qf[nq][s2], st, 0, 0, 0);
        if (masked) { const int dbase = kbrel - 32 * nq - r + 4 * h;
#pragma unroll
            for (int i = 0; i < 16; ++i) { const int df = dbase + (i & 3) + 8 * (i >> 2); st[i] = (df >= -128 && df <= 128) ? st[i] : -INFINITY; } }
        float smax = st[0];
#pragma unroll
        for (int i = 1; i < 16; ++i) smax = fmaxf(smax, st[i]);
        smax = half_max(smax);
        const float cand = smax * C; const float mn = (cand > m[nq] + 8.f) ? cand : m[nq], alpha = __builtin_amdgcn_exp2f(m[nq] - mn); m[nq] = mn;
#pragma unroll
        for (int i = 0; i < 16; ++i) st[i] = __builtin_fmaf(st[i], C, -mn);
        __builtin_amdgcn_sched_barrier(0);
#pragma unroll
        for (int i = 0; i < 16; ++i) st[i] = __builtin_amdgcn_exp2f(st[i]);
        __builtin_amdgcn_sched_barrier(0);
        float ps = 0.f;
#pragma unroll
        for (int i = 0; i < 16; ++i) ps += st[i];
        l[nq] = l[nq] * alpha + ps;
        const f32x16& t = st;
        if (__ballot(alpha != 1.f)) {
#pragma unroll
            for (int i = 0; i < 16; ++i) { o[0][nq][i] *= alpha; o[1][nq][i] *= alpha; } }
        bf16x8 pf[2];
#pragma unroll
        for (int ks = 0; ks < 2; ++ks) { const u32x4 w = {pkbf(t[8 * ks], t[8 * ks + 1]), pkbf(t[8 * ks + 2], t[8 * ks + 3]), pkbf(t[8 * ks + 4], t[8 * ks + 5]), pkbf(t[8 * ks + 6], t[8 * ks + 7])};
            pf[ks] = __builtin_bit_cast(bf16x8, w); }
#pragma unroll
        for (int db = 0; db < 2; ++db)
#pragma unroll
            for (int ks = 0; ks < 2; ++ks) o[db][nq] = __builtin_amdgcn_mfma_f32_32x32x16_bf16(__builtin_bit_cast(bf16x8, vf[db][ks]), pf[ks], o[db][nq], 0, 0, 0);
    }
}
__device__ __forceinline__ void phase_attn_lds(Frame& F) {
    const bf16* Q = (const bf16*)(F.ws + WS_Q); bf16* MIX = (bf16*)(F.ws + WS_MIX);
    const int g = F.wave >> 1, half = F.wave & 1, r = F.lane & 31, h = F.lane >> 5;
    __syncthreads();
    u32x4 rg[4];
    AtChunk ck = at_chunk(F.ws, 0, F.wg, F.G);
    if (!ck.any) return;
    at_issue(ck, F.tid, rg); at_write(ck, F.lds, F.tid, rg);
    __syncthreads();
    bf16x8 qf[2][4]; f32x16 o[2][2]; float m[2], l[2];
#pragma unroll 1
    for (int seq = 0; ck.any; ++seq) {
        LAS unsigned char* buf = F.lds + (seq & 1) * AT_BUF;
        const int hd = ck.kvh * 4 + g, qs = ck.qb * 128 + half * 64;
        if (ck.c == 0) {
#pragma unroll
            for (int nq = 0; nq < 2; ++nq)
#pragma unroll
                for (int s2 = 0; s2 < 4; ++s2) qf[nq][s2] = *(const bf16x8*)(Q + (size_t)(ck.b * L + qs + 32 * nq + r) * 512 + hd * 64 + 16 * s2 + 8 * h);
            m[0] = m[1] = F.in[I_SINK][hd] * 1.4426950408889634f; l[0] = l[1] = (h == 0) ? 1.f : 0.f;
        }
        const AtChunk nk = at_chunk(F.ws, seq + 1, F.wg, F.G);
        at_issue(nk, F.tid, rg);
        const int tv = (F.wg * NWAVES + F.wave) + seq * (F.G * NWAVES);
        const TItem ti = t_decode(F, tv < 2 * 32 * 256 ? 640 + 2048 + tv : (1 << 30));
        t_dma(ti, F.lds + 2 * AT_BUF + F.wave * 8704, F.lane);
        if (ck.c == 0) {
#pragma unroll
            for (int db = 0; db < 2; ++db)
#pragma unroll
                for (int nq = 0; nq < 2; ++nq)
#pragma unroll
                    for (int i = 0; i < 16; ++i) o[db][nq][i] = 0.f;
        }
        if (ck.valid) {
            int b0 = 0, b1 = 4;
            if (ck.local) { b0 = 2 * half - 4 * ck.lc; b0 = b0 < 0 ? 0 : b0; b1 = 2 * half + 10 - 4 * ck.lc; b1 = b1 > 4 ? 4 : b1; }
            if (b0 < b1) {
                bf16x8 kfA[4], kfB[4]; u32x4 vfA[2][2], vfB[2][2];
                at_load(buf, b0, r, h, kfA, vfA);
#pragma unroll 1
                for (int blk = b0; blk < b1; blk += 2) {
                    const int iA = 4 * ck.lc + blk - 2 * half, iB = iA + 1;
                    if (blk + 1 < b1) at_load(buf, blk + 1, r, h, kfB, vfB);
                    at_math(kfA, vfA, ck.local && (iA < 2 || iA > 7), 32 * iA - 128, r, h, qf, o, m, l);
                    if (blk + 1 < b1) {
                        if (blk + 2 < b1) at_load(buf, blk + 2, r, h, kfA, vfA);
                        at_math(kfB, vfB, ck.local && (iB < 2 || iB > 7), 32 * iB - 128, r, h, qf, o, m, l);
                    }
                }
            }
        }
        if (ck.c == 4) {
#pragma unroll
            for (int nq = 0; nq < 2; ++nq) {
                const float lt = half_sum(l[nq]), il = __builtin_amdgcn_rcpf(lt);
                unsigned char* orow = (unsigned char*)MIX + (size_t)(ck.b * L + qs + 32 * nq + r) * 1024 + 512 + hd * 64;
                const float ils = il * FSC;
#pragma unroll
                for (int db = 0; db < 2; ++db)
#pragma unroll
                    for (int i4 = 0; i4 < 4; ++i4) *(unsigned*)(orow + 32 * db + 8 * i4 + 4 * h) = pk_fp8x4s((f32x4){o[db][nq][4 * i4], o[db][nq][4 * i4 + 1], o[db][nq][4 * i4 + 2], o[db][nq][4 * i4 + 3]}, ils);
            }
        }
        at_write(nk, F.lds + ((seq + 1) & 1) * AT_BUF, F.tid, rg);
        if (ti.ok) { asm volatile("s_waitcnt vmcnt(0)" ::: "memory"); t_store_dma(ti, (const LAS float*)(F.lds + 2 * AT_BUF + F.wave * 8704), F.lane); }
        __syncthreads();
        ck = nk;
    }
}

constexpr int F1_PC = 136, F1_PW = 68, F2_P = 264;
constexpr int F1_CSC = 0, F1_CSS = 128 * F1_PC * 2, F1_C64 = 2 * 128 * F1_PC * 2, F1_S64 = F1_C64 + 64 * F1_PW * 2;
__device__ __forceinline__ bf16x8 pack8(float a0, float a1, float a2, float a3, float a4, float a5, float a6, float a7) {
    const u32x4 w = {pkbf(a0, a1), pkbf(a2, a3), pkbf(a4, a5), pkbf(a6, a7)}; return __builtin_bit_cast(bf16x8, w); }
__device__ __forceinline__ void phase_fft1_mfma(Frame& F) {
    __syncthreads();
    LAS bf16* csc = (LAS bf16*)(F.lds + F1_CSC); LAS bf16* css = (LAS bf16*)(F.lds + F1_CSS); LAS bf16* c64 = (LAS bf16*)(F.lds + F1_C64); LAS bf16* s64 = (LAS bf16*)(F.lds + F1_S64);
    for (int i = F.tid; i < 128 * 128; i += NTHR) { const int n = i >> 7, k = i & 127; const float ang = (float)((n * k) & 127) * (6.283185307179586f / 128.f);
        csc[n * F1_PC + k] = (bf16)f2bf(__cosf(ang)); css[n * F1_PC + k] = (bf16)f2bf(__sinf(ang)); }
    for (int i = F.tid; i < 64 * 64; i += NTHR) { const int c = i >> 6, a = i & 63; const float ang = (float)((c * a) & 63) * (6.283185307179586f / 64.f);
        c64[c * F1_PW + a] = (bf16)f2bf(__cosf(ang)); s64[c * F1_PW + a] = (bf16)f2bf(__sinf(ang)); }
    __syncthreads();
    const bf16* UF = (const bf16*)(F.ws + WS_UF); bf16* Gb = (bf16*)(F.ws + WS_G);
    const int r = F.lane & 31, h = F.lane >> 5, g = F.wave >> 1;
    LAS bf16* sre = (LAS bf16*)(F.lds + F1_S64 + 64 * F1_PW * 2 + F.wave * 5120); LAS bf16* sim = sre + 32 * 40;
    const __amdgpu_buffer_rsrc_t grs = __builtin_amdgcn_make_buffer_rsrc((void*)(F.ws + WS_G), 0, 64 * 1024 * 1024, 0x00020000);
    for (int item = F.wg; item < NB * FN2; item += F.G) {
        const int b = item >> 7, bp = item & 127;
        bf16x8 uf[2][8];
#pragma unroll
        for (int rb = 0; rb < 2; ++rb)
#pragma unroll
            for (int s2 = 0; s2 < 8; ++s2) uf[rb][s2] = *(const bf16x8*)(UF + (size_t)(b * L + 128 * (32 * rb + r) + bp) * 512 + g * 128 + 16 * s2 + 8 * h);
#pragma unroll 1
        for (int q = 0; q < 2; ++q) {
            const int cbk = 2 * F.wave + q, n = 32 * (cbk & 3) + r, ch = 32 * cbk + r;
            f32x16 zr[2], zi[2];
#pragma unroll
            for (int rb = 0; rb < 2; ++rb) {
#pragma unroll
                for (int i = 0; i < 16; ++i) { zr[rb][i] = 0.f; zi[rb][i] = 0.f; }
#pragma unroll
                for (int s2 = 0; s2 < 8; ++s2) { const bf16x8 bc = *(const LAS bf16x8*)(csc + n * F1_PC + 16 * s2 + 8 * h), bs = *(const LAS bf16x8*)(css + n * F1_PC + 16 * s2 + 8 * h);
                    zr[rb] = __builtin_amdgcn_mfma_f32_32x32x16_bf16(uf[rb][s2], bc, zr[rb], 0, 0, 0); zi[rb] = __builtin_amdgcn_mfma_f32_32x32x16_bf16(uf[rb][s2], bs, zi[rb], 0, 0, 0); }
                __builtin_amdgcn_sched_barrier(0);
            }
            bf16x8 zfr[4], zfi[4];
#pragma unroll
            for (int ks = 0; ks < 4; ++ks) { const int rb = ks >> 1, o = 8 * (ks & 1);
                zfr[ks] = pack8(zr[rb][o], zr[rb][o + 1], zr[rb][o + 2], zr[rb][o + 3], zr[rb][o + 4], zr[rb][o + 5], zr[rb][o + 6], zr[rb][o + 7]);
                zfi[ks] = pack8(-zi[rb][o], -zi[rb][o + 1], -zi[rb][o + 2], -zi[rb][o + 3], -zi[rb][o + 4], -zi[rb][o + 5], -zi[rb][o + 6], -zi[rb][o + 7]); }
            __builtin_amdgcn_sched_barrier(0);
#pragma unroll 1
            for (int rbc = 0; rbc < 2; ++rbc) {
                f32x16 gr, gi; const int cr = 32 * rbc + r;
#pragma unroll
                for (int i = 0; i < 16; ++i) { gr[i] = 0.f; gi[i] = 0.f; }
#pragma unroll
                for (int ks = 0; ks < 4; ++ks) {
                    const u32x2 cl = *(const LAS u32x2*)(c64 + cr * F1_PW + 16 * ks + 4 * h), chh = *(const LAS u32x2*)(c64 + cr * F1_PW + 16 * ks + 8 + 4 * h);
                    const u32x2 sl = *(const LAS u32x2*)(s64 + cr * F1_PW + 16 * ks + 4 * h), shh = *(const LAS u32x2*)(s64 + cr * F1_PW + 16 * ks + 8 + 4 * h);
                    const u32x4 sw = {sl.x, sl.y, shh.x, shh.y}; const u32x4 swn = sw ^ 0x80008000u;
                    const bf16x8 wc = __builtin_bit_cast(bf16x8, ((u32x4){cl.x, cl.y, chh.x, chh.y})), wsn = __builtin_bit_cast(bf16x8, sw), wsm = __builtin_bit_cast(bf16x8, swn);
                    gr = __builtin_amdgcn_mfma_f32_32x32x16_bf16(wc, zfr[ks], gr, 0, 0, 0); gr = __builtin_amdgcn_mfma_f32_32x32x16_bf16(wsn, zfi[ks], gr, 0, 0, 0);
                    gi = __builtin_amdgcn_mfma_f32_32x32x16_bf16(wc, zfi[ks], gi, 0, 0, 0); gi = __builtin_amdgcn_mfma_f32_32x32x16_bf16(wsm, zfr[ks], gi, 0, 0, 0); }
                __builtin_amdgcn_sched_barrier(0);
#pragma unroll
                for (int i = 0; i < 16; ++i) { const int cl = crow(i, h), c = 32 * rbc + cl; const float ang = (float)(bp * c) * (6.283185307179586f / 8192.f), cs = __cosf(ang), sn = __sinf(ang);
                    const float re = gr[i] * cs + gi[i] * sn, im = gi[i] * cs - gr[i] * sn;
                    sre[cl * 40 + r] = (bf16)f2bf(re); sim[cl * 40 + r] = (bf16)f2bf(im);
                    if ((i & 3) == 3) __builtin_amdgcn_sched_barrier(0); }
                asm volatile("" ::: "memory"); __builtin_amdgcn_wave_barrier(); asm volatile("" ::: "memory");
#pragma unroll
                for (int k = 0; k < 2; ++k) { const int cl = 16 * k + (F.lane >> 2), pc = F.lane & 3;
                    const u32x4 wre = *(const LAS u32x4*)(sre + cl * 40 + 8 * pc), wim = *(const LAS u32x4*)(sim + cl * 40 + 8 * pc);
                    const unsigned go = (unsigned)((((b * FN1 + 32 * rbc + cl) * FN2 + bp) * 1024 + 32 * cbk + 8 * pc) * 2);
                    __builtin_amdgcn_raw_buffer_store_b128(wre, grs, go, 0, 16); __builtin_amdgcn_raw_buffer_store_b128(wim, grs, go + 1024, 0, 16); }
                asm volatile("" ::: "memory"); __builtin_amdgcn_wave_barrier(); asm volatile("" ::: "memory");
            }
        }
        asm volatile("s_waitcnt vmcnt(0)" ::: "memory");
        __syncthreads();
        if (F.tid == 0) (void)xb_add(F.ctl + CW_FFT + 64 * b, 1u);
    }
    __syncthreads();
}
__device__ __forceinline__ void phase_fft2_mfma(Frame& F) {
    __syncthreads();
    LAS bf16* t2 = (LAS bf16*)F.lds;
    for (int i = F.tid; i < 128 * 256; i += NTHR) { const int d = i >> 8, k = i & 255; const float ang = (float)((d * (k & 127)) & 127) * (6.283185307179586f / 128.f);
        t2[d * F2_P + k] = (bf16)f2bf(k < 128 ? __cosf(ang) : __sinf(ang)); }
    __syncthreads();
    const bf16* Gb = (const bf16*)(F.ws + WS_G); bf16* MIX = (bf16*)(F.ws + WS_MIX);
    const int r = F.lane & 31, h = F.lane >> 5;
    for (int item = F.wg; item < NB * FN1; item += F.G) {
        const int b = item >> 6, c = item & 63;
        if (F.tid == 0) { unsigned sp = 0u;
            while (xb_ld(F.ctl + CW_FFT + 64 * b) < (unsigned)FN2) { __builtin_amdgcn_s_sleep(2);
                if ((++sp & 255u) == 0u) { if (xb_ld(F.ctl + CW_TMO2)) break; if (sp > (1u << 20)) { __hip_atomic_store(F.ctl + CW_TMO2, 1u, __ATOMIC_RELAXED, __HIP_MEMORY_SCOPE_AGENT); break; } } } }
        __syncthreads();
        const bf16* Gp = Gb + (size_t)((b * FN1 + c) * FN2) * 1024 + 64 * F.wave + r;
        f32x16 y[4][2];
#pragma unroll
        for (int rb = 0; rb < 4; ++rb)
#pragma unroll
            for (int cb = 0; cb < 2; ++cb)
#pragma unroll
                for (int i = 0; i < 16; ++i) y[rb][cb][i] = 0.f;
        unsigned eA[2][8], eB[2][8], eC[2][8], eD[2][8];
#define F2_GATHER(dst, ks_) do { const bf16* p_ = Gp + (size_t)(16 * ((ks_) & 7) + 8 * h) * 1024 + ((ks_) >> 3) * 512; \
            _Pragma("unroll") for (int cb = 0; cb < 2; ++cb) _Pragma("unroll") for (int j = 0; j < 8; ++j) dst[cb][j] = p_[(size_t)j * 1024 + 32 * cb]; } while (0)
#define F2_MMA(src, ks_) do { bf16x8 bfr[2]; _Pragma("unroll") for (int cb = 0; cb < 2; ++cb) { \
                const u32x4 w = {src[cb][0] | (src[cb][1] << 16), src[cb][2] | (src[cb][3] << 16), src[cb][4] | (src[cb][5] << 16), src[cb][6] | (src[cb][7] << 16)}; bfr[cb] = __builtin_bit_cast(bf16x8, w); } \
            _Pragma("unroll") for (int rb = 0; rb < 4; ++rb) { const bf16x8 a = *(const LAS bf16x8*)(t2 + (32 * rb + r) * F2_P + 16 * (ks_) + 8 * h); \
                _Pragma("unroll") for (int cb = 0; cb < 2; ++cb) y[rb][cb] = __builtin_amdgcn_mfma_f32_32x32x16_bf16(a, bfr[cb], y[rb][cb], 0, 0, 0); } } while (0)
        F2_GATHER(eA, 0); F2_GATHER(eB, 1); F2_GATHER(eC, 2);
#pragma unroll 1
        for (int ks = 0; ks < 16; ks += 4) {
            F2_GATHER(eD, ks + 3);
            F2_MMA(eA, ks);
            if (ks + 4 < 16) F2_GATHER(eA, ks + 4);
            F2_MMA(eB, ks + 1);
            if (ks + 4 < 16) F2_GATHER(eB, ks + 5);
            F2_MMA(eC, ks + 2);
            if (ks + 4 < 16) F2_GATHER(eC, ks + 6);
            F2_MMA(eD, ks + 3);
        }
#undef F2_GATHER
#undef F2_MMA
        LAS bf16* so = (LAS bf16*)(F.lds + 128 * F2_P * 2 + F.wave * 4608);
#pragma unroll
        for (int rb = 0; rb < 4; ++rb) {
#pragma unroll
            for (int cb = 0; cb < 2; ++cb)
#pragma unroll
                for (int i = 0; i < 16; ++i) so[crow(i, h) * 72 + 32 * cb + r] = (bf16)f2bf(y[rb][cb][i] * (1.f / 1024.f));
            asm volatile("" ::: "memory"); __builtin_amdgcn_wave_barrier(); asm volatile("" ::: "memory");
#pragma unroll
            for (int k = 0; k < 4; ++k) { const int dl = 8 * k + (F.lane >> 3), pc = F.lane & 7;
                const u32x4 w = *(const LAS u32x4*)(so + dl * 72 + 8 * pc);
                u32x2 w8; w8.x = pk_fp8x4s((f32x4){bflo(w.x), bfhi(w.x), bflo(w.y), bfhi(w.y)}, FSC); w8.y = pk_fp8x4s((f32x4){bflo(w.z), bfhi(w.z), bflo(w.w), bfhi(w.w)}, FSC);
                *(u32x2*)((unsigned char*)MIX + (size_t)(b * L + c + 64 * (32 * rb + dl)) * 1024 + 64 * F.wave + 8 * pc) = w8; }
            asm volatile("" ::: "memory"); __builtin_amdgcn_wave_barrier(); asm volatile("" ::: "memory");
        }
    }
    __syncthreads();
}


typedef float f32x2_t __attribute__((ext_vector_type(2)));
template <int IR> struct DwIn {
    static __device__ __forceinline__ void run(const unsigned (&uin)[62], const f32x2_t (&w)[31], f32x2_t (&o)[32]) {
        const f32x2_t x = {bflo(uin[IR]), bfhi(uin[IR])};
#pragma unroll
        for (int r = 0; r < 32; ++r) { if (IR - r >= 0 && IR - r <= 30) o[r] += w[(IR - r >= 0 && IR - r <= 30) ? IR - r : 0] * x; }
        DwIn<IR + 1>::run(uin, w, o);
    }
};
template <> struct DwIn<62> { static __device__ __forceinline__ void run(const unsigned (&)[62], const f32x2_t (&)[31], f32x2_t (&)[32]) {} };
template <int IR> struct DwIn16 {
    static __device__ __forceinline__ void run(const unsigned (&uin)[46], const f32x2_t (&w)[31], f32x2_t (&o)[16]) {
        const f32x2_t x = {bflo(uin[IR]), bfhi(uin[IR])};
#pragma unroll
        for (int r = 0; r < 16; ++r) { if (IR - r >= 0 && IR - r <= 30) o[r] += w[(IR - r >= 0 && IR - r <= 30) ? IR - r : 0] * x; }
        DwIn16<IR + 1>::run(uin, w, o);
    }
};
template <> struct DwIn16<46> { static __device__ __forceinline__ void run(const unsigned (&)[46], const f32x2_t (&)[31], f32x2_t (&)[16]) {} };
__device__ __forceinline__ void phase_dwconv_fast(Frame& F) {
    const bf16* U = (const bf16*)(F.ws + WS_U); bf16* V1 = (bf16*)(F.ws + WS_V1);
    const float* dww = F.in[I_DWW];
    const int c0 = 2 * F.tid;
    f32x2_t w[31];
#pragma unroll
    for (int j = 0; j < 31; ++j) w[j] = *(const f32x2_t*)(dww + (size_t)j * D + c0);
    const f32x2_t bb = *(const f32x2_t*)(F.in[I_DWB] + c0), gg = *(const f32x2_t*)(F.in[I_LNG] + c0), lb = *(const f32x2_t*)(F.in[I_LNB] + c0);
    LAS float* red = (LAS float*)F.lds;
    LAS float* stat = red + 16 * 8 * 2;
    __syncthreads();
    for (int run = F.wg; run < T / 128; run += F.G) {
        const int row0 = run * 128, l0 = row0 & (L - 1);
        unsigned uin[46], nx[16];
#pragma unroll
        for (int ir = 0; ir < 46; ++ir) { const int l = l0 - 15 + ir; const bool ok = (l >= 0 && l < L);
            const unsigned u = *(const unsigned*)(U + (size_t)(ok ? row0 - 15 + ir : row0) * D + c0); uin[ir] = ok ? u : 0u; }
#pragma unroll 1
        for (int step = 0; step < 8; ++step) {
            const int r0 = row0 + 16 * step;
            if (step < 7) {
#pragma unroll
                for (int j = 0; j < 16; ++j) { const int l = l0 + 16 * step + 31 + j; const bool ok = l < L;
                    const unsigned u = *(const unsigned*)(U + (size_t)(ok ? r0 + 31 + j : r0) * D + c0); nx[j] = ok ? u : 0u; }
            }
            f32x2_t o[16];
#pragma unroll
            for (int r = 0; r < 16; ++r) o[r] = bb;
            DwIn16<0>::run(uin, w, o);
            {
                float W[16], X[8], Y[4], Z2[2];
#pragma unroll
                for (int i = 0; i < 16; ++i) W[i] = swap32_add(o[i].x + o[i].y, o[i].x * o[i].x + o[i].y * o[i].y);
#pragma unroll
                for (int i = 0; i < 8; ++i) X[i] = swap16_add(W[2 * i], W[2 * i + 1]);
                const bool b3 = (F.lane & 8) != 0, b2 = (F.lane & 4) != 0, b1 = (F.lane & 2) != 0;
#pragma unroll
                for (int i = 0; i < 4; ++i) Y[i] = sel_add<0x140>(X[2 * i], X[2 * i + 1], b3);
#pragma unroll
                for (int i = 0; i < 2; ++i) Z2[i] = sel_add<0x141>(Y[2 * i], Y[2 * i + 1], b2);
                float Z = sel_add<0x4E>(Z2[0], Z2[1], b1);
                Z += dppf<0xB1>(Z);
                const int rr = ((F.lane >> 4) & 1) + ((F.lane >> 3) & 1) * 2 + ((F.lane >> 2) & 1) * 4 + ((F.lane >> 1) & 1) * 8;
                if (!(F.lane & 1)) red[(rr * 8 + F.wave) * 2 + (F.lane >> 5)] = Z;
            }
            __syncthreads();
            if (F.tid < 16) { float sm = 0.f, sq = 0.f;
#pragma unroll
                for (int wv = 0; wv < 8; ++wv) { sm += red[(F.tid * 8 + wv) * 2]; sq += red[(F.tid * 8 + wv) * 2 + 1]; }
                const float mean = sm * (1.f / D), var = fmaxf(sq * (1.f / D) - mean * mean, 0.f);
                stat[2 * F.tid] = mean; stat[2 * F.tid + 1] = rsqrtf(var + EPS); }
            __syncthreads();
#pragma unroll
            for (int r = 0; r < 16; ++r) { const float mean = stat[2 * r], rstd = stat[2 * r + 1];
                const f32x2_t A = gg * rstd, B = lb - A * mean, y = o[r] * A + B;
                *(unsigned short*)((unsigned char*)V1 + (size_t)(r0 + r) * D + c0) = (unsigned short)__builtin_amdgcn_cvt_pk_fp8_f32(__builtin_amdgcn_fmed3f(silu_f(y.x) * FSC, -448.f, 448.f), __builtin_amdgcn_fmed3f(silu_f(y.y) * FSC, -448.f, 448.f), 0, false); }
#pragma unroll
            for (int i = 0; i < 30; ++i) uin[i] = uin[i + 16];
#pragma unroll
            for (int j = 0; j < 16; ++j) uin[30 + j] = nx[j];
        }
        __syncthreads();
    }
}

namespace pg {
struct MU { const char* B; const char* A; int K, type, e, rt, pn, hb, buf; };
struct MoeMergedSched {
    const char* Wgu; const char* Wdn; const char* HBp; const char* HIDp; const int* list; const float* wlist; LAS int* mm; unsigned* tcnt; unsigned* tmo; int G, c, U; bool down_only;
    __device__ __forceinline__ bool flat(int L, int type, MU& u) const {
        for (int e = 0; e < 16; ++e) { const int n = mm[e], nu = ((n + 255) >> 8) * 4;
            if (L < nu) { u.e = e; u.rt = L >> 2; u.pn = L & 3; u.hb = mm[16 + e]; u.type = type; u.buf = 0;
                if (type == 0) { u.K = 512; u.A = HBp; u.B = Wgu + (size_t)e * (1024 * 1024) + (size_t)u.pn * BM * 1024; }
                else { u.K = 256; u.A = HIDp; u.B = Wdn + (size_t)e * (1024 * 512) + (size_t)u.pn * BM * 512; }
                return true; }
            L -= nu; }
        return false;
    }
    __device__ __forceinline__ bool flat_fast(int L, int type, MU& u) const {
        const int row = (L >> 2) << 8; bool ok = false; u.e = 0; u.rt = 0; u.hb = 0;
#pragma unroll
        for (int e = 0; e < 16; ++e) { const int n = mm[e], hb = mm[16 + e], pad = (n + 255) & ~255;
            if (row >= hb && row < hb + pad) { u.e = e; u.hb = hb; u.rt = (row - hb) >> 8; ok = true; } }
        u.pn = L & 3; u.type = type; u.buf = 0;
        return ok;
    }
    __device__ __forceinline__ LAS int* recs(LAS unsigned char* lds) const { return (LAS int*)(lds + TAB_OFF + 6144); }
    __device__ __forceinline__ bool next(int i, MU& u, LAS unsigned char* lds) const {
        if (i >= 16) return false;
        const LAS int* r = recs(lds) + i * 8; const int type = r[0];
        if (type < 0) return false;
        u.type = type; u.e = r[1]; u.rt = r[2]; u.pn = r[3]; u.hb = r[4]; u.buf = 0;
        if (type == 0) { u.K = 512; u.A = HBp; u.B = Wgu + (size_t)u.e * (1024 * 1024) + (size_t)u.pn * BM * 1024; }
        else { u.K = 256; u.A = HIDp; u.B = Wdn + (size_t)u.e * (1024 * 512) + (size_t)u.pn * BM * 512; }
        return true;
    }
    __device__ __forceinline__ bool next_search(int i, MU& u) const {
        if (down_only) { const int j = i * G + c; return j < U ? flat(j, 1, u) : false; }
        const int ngu = c < U ? (U - 1 - c) / G + 1 : 0;
        if (false && (c & 1) && ngu >= 3) { if (i == 2) i = ngu; else if (i > 2 && i <= ngu) i = i - 1; }
        if (i < ngu) return flat_fast(i * G + c, 0, u);
        const int k = i - ngu, x = U % G; int j;
        if (c >= x) { if (k == 0) j = c - x; else j = (G - 1 - c) + (k - 1) * G + (G - x); } else j = (G - 1 - c) + k * G + (G - x);
        if (j >= U) return false;
        return flat_fast(j, 1, u);
    }
    __device__ __forceinline__ unsigned voff(const MU& u, int buf, LAS unsigned char* lds, int R, int C) const {
        if (u.type == 0) { const int tok = ((const LAS int*)(lds + TAB_OFF))[buf * 256 + R]; return (unsigned)((tok * 512 + C) * 2); }
        return (unsigned)(((u.hb + u.rt * BM + R) * 256 + C) * 2);
    }
    __device__ __forceinline__ void stage_table(const MU& u, int buf, LAS unsigned char* lds, int wid, int lane) const {
        const int r = (wid & 3) * 64 + lane;
        __builtin_amdgcn_global_load_lds((const unsigned*)(list + u.e * CAP + u.rt * BM + r), (LAS unsigned*)(lds + TAB_OFF + buf * 1024 + (wid & 3) * 256), 4, 0, 0);
        __builtin_amdgcn_global_load_lds((const unsigned*)(wlist + u.e * CAP + u.rt * BM + r), (LAS unsigned*)(lds + TAB_OFF + 3072 + buf * 1024 + (wid & 3) * 256), 4, 0, 0);
    }
    __device__ __forceinline__ unsigned* tile_word(const MU& u) const { return tcnt + ((u.hb >> 8) + u.rt) * 64; }
    __device__ __forceinline__ void wait_ready(const MU& u, int wid) const {
        if (wid == 0 && !down_only) {
            unsigned* w = tile_word(u); unsigned spins = 0;
            while ((unsigned)__builtin_amdgcn_readfirstlane(__hip_atomic_load(w, __ATOMIC_RELAXED, __HIP_MEMORY_SCOPE_AGENT)) < 32u) {
                __builtin_amdgcn_s_sleep(2);
                if ((++spins & 255u) == 0u) { if (__builtin_amdgcn_readfirstlane(__hip_atomic_load(tmo, __ATOMIC_RELAXED, __HIP_MEMORY_SCOPE_AGENT)) != 0u) break;
                    if (spins > (1u << 20)) { __hip_atomic_store(tmo, 1u, __ATOMIC_RELAXED, __HIP_MEMORY_SCOPE_AGENT); break; } } }
        }
        asm volatile("" ::: "memory"); __builtin_amdgcn_s_barrier(); asm volatile("" ::: "memory");
    }
};
struct EpiGateUpWT {
    __amdgpu_buffer_rsrc_t rsrc; LAS unsigned char* lds; LAS int* mm; unsigned char* hid8;
    __device__ __forceinline__ void operator()(const f32x4 (&acc)[2][2][4][2], const MU& u, int wr, int wc, int fr, int fq) const {
        const int e = u.e, n_e = mm[e], r0 = u.rt * BM + wr * 64 + fr, col0 = u.pn * HALF + wc * 32 + 8 * fq;
        float wv[2][4];
#pragma unroll
        for (int ai = 0; ai < 2; ++ai)
#pragma unroll
            for (int m = 0; m < 4; ++m) wv[ai][m] = ((const LAS float*)(lds + TAB_OFF + 3072))[u.buf * 256 + wr * 64 + fr + ai * HALF + m * 16];
#pragma unroll
        for (int ai = 0; ai < 2; ++ai)
#pragma unroll
            for (int m = 0; m < 4; ++m) { const int r = r0 + ai * HALF + m * 16;
                if (r < n_e) { constexpr float PS = 1.f / (FSC * WSC); const float w = wv[ai][m] * PS; f32x4 o[2];
#pragma unroll
                    for (int n = 0; n < 2; ++n) { const f32x4 g = acc[ai][0][m][n] * PS, up = acc[ai][1][m][n];
#pragma unroll
                        for (int j = 0; j < 4; ++j) o[n][j] = w * silu_f(g[j]) * up[j]; }
                    u32x2 q; q.x = pk_fp8x4s(o[0], HSC); q.y = pk_fp8x4s(o[1], HSC);
                    __hip_atomic_store((unsigned long long*)(hid8 + (size_t)(u.hb + r) * FF + col0), ((unsigned long long)q.y << 32) | q.x, __ATOMIC_RELAXED, __HIP_MEMORY_SCOPE_AGENT); } }
    }
};
struct EpiDownM {
    unsigned char* Y8; LAS int* mm;
    __device__ __forceinline__ void operator()(const f32x4 (&acc)[2][2][4][2], const MU& u, int wr, int wc, int fr, int fq) const {
        const int e = u.e, n_e = mm[e], r0 = u.rt * BM + wr * 64 + fr, col0 = u.pn * BM + 64 * wc + 16 * fq;
#pragma unroll
        for (int ai = 0; ai < 2; ++ai)
#pragma unroll
            for (int m = 0; m < 4; ++m) { const int r = r0 + ai * HALF + m * 16;
                if (r < n_e) { constexpr float PS = 1.f / (HSC * WSC); u32x4 q; q.x = pk_fp8x4(acc[ai][0][m][0] * PS); q.y = pk_fp8x4(acc[ai][0][m][1] * PS); q.z = pk_fp8x4(acc[ai][1][m][0] * PS); q.w = pk_fp8x4(acc[ai][1][m][1] * PS);
                    *(u32x4*)(Y8 + (size_t)(u.hb + r) * D + col0) = q; } }
    }
};
__device__ __forceinline__ void gemm_phase_moe(LAS unsigned char* lds, const MoeMergedSched& S, const EpiGateUpWT& EA, const EpiDownM& EB) {
    const int tid = threadIdx.x, wid = __builtin_amdgcn_readfirstlane(tid >> 6), lane = tid & 63, wr = wid >> 2, wc = wid & 3, fr = lane & 15, fq = lane >> 4;
    unsigned vbA[2], vbD[2];
#pragma unroll
    for (int i = 0; i < 2; ++i) { int R, C; stage_rc(tid * 16 + i * 8192, R, C); const int Rb = (R & ~31) + perm32(R & 31);
        const int RbD = 64 * ((Rb >> 5) & 3) + 16 * ((Rb >> 3) & 3) + (Rb & 7);
        vbA[i] = (unsigned)(Rb * 512 + C) * 2u; vbD[i] = (unsigned)(RbD * 256 + C) * 2u; }
    const size_t kstep = (size_t)(BK * 2);
    const unsigned ldsw = (unsigned)wid * 1024u;
    const int aoff = lds_byte(wr * 64 + fr, fq * 8), boff = lds_byte(wc * 32 + fr, fq * 8);
#define PG_SA(b, h) (((b) * 2 + (h)) * HTB)
#define PG_SB(b, h) ((4 + (b) * 2 + (h)) * HTB)
#define PG_STAGE(bufoff, gbase, voff) do { _Pragma("unroll") for (int _i = 0; _i < 2; ++_i) \
        __builtin_amdgcn_global_load_lds((const unsigned*)((const char*)(gbase) + (voff)[_i]), (LAS unsigned*)(lds + (bufoff) + ldsw + _i * 8192), 16, 0, 0); } while (0)
#define PG_LDA(dst, b, h) do { _Pragma("unroll") for (int m = 0; m < 4; ++m) _Pragma("unroll") for (int k = 0; k < 2; ++k) dst[m][k] = *(const LAS bf16x8*)(lds + PG_SA(b, h) + aoff + m * 2048 + k * 1024); } while (0)
#define PG_LDB(dst, b, h) do { _Pragma("unroll") for (int n = 0; n < 2; ++n) _Pragma("unroll") for (int k = 0; k < 2; ++k) dst[n][k] = *(const LAS bf16x8*)(lds + PG_SB(b, h) + boff + n * 2048 + k * 1024); } while (0)
#define PG_C8(x) (__builtin_shufflevector(__builtin_bit_cast(i32x4_t, (x)[0]), __builtin_bit_cast(i32x4_t, (x)[1]), 0, 1, 2, 3, 4, 5, 6, 7))
#define PG_MMA(ai, bj, At, Bt) do { __builtin_amdgcn_s_setprio(1); _Pragma("unroll") for (int m = 0; m < 4; ++m) _Pragma("unroll") for (int n = 0; n < 2; ++n) \
        asm volatile("v_mfma_f32_16x16x128_f8f6f4 %0, %1, %2, %0" : "+v"(acc[ai][bj][m][n]) : "v"(PG_C8(Bt[n])), "v"(PG_C8(At[m]))); __builtin_amdgcn_s_setprio(0); } while (0)
#define PG_WAIT_V(n) asm volatile("s_waitcnt vmcnt(" #n ")" ::: "memory")
#define PG_WAIT_L(n) asm volatile("s_waitcnt lgkmcnt(" #n ")" ::: "memory")
#define PG_BAR __builtin_amdgcn_s_barrier()
#define PG_SCHED __builtin_amdgcn_sched_barrier(0)
    MU cur, nxt; int ui = 0;
    if (!S.next(0, cur, lds)) return;
    cur.buf = 0;
    f32x4 acc[2][2][4][2];
#pragma unroll
    for (int a = 0; a < 2; ++a)
#pragma unroll
        for (int b = 0; b < 2; ++b)
#pragma unroll
            for (int m = 0; m < 4; ++m)
#pragma unroll
                for (int n = 0; n < 2; ++n) acc[a][b][m][n] = (f32x4){0.f, 0.f, 0.f, 0.f};
    bf16x8 At[4][2], B0[2][2], B1[2][2];
    if (cur.type == 0) { S.stage_table(cur, 0, lds, wid, lane); PG_WAIT_V(0); PG_BAR; } else S.wait_ready(cur, wid);
    unsigned voC[2][2];
#pragma unroll
    for (int h = 0; h < 2; ++h)
#pragma unroll
        for (int i = 0; i < 2; ++i) { int R, C; stage_rc(tid * 16 + i * 8192, R, C); voC[h][i] = S.voff(cur, 0, lds, h * HALF + R, C); }
    const char* cB = cur.B; const char* cA = cur.A; size_t hsC = (size_t)(cur.type == 0 ? HALF : 8) * cur.K * 2; int nt = cur.K / BK;
    if (cur.type == 0) { PG_STAGE(PG_SB(0, 0), cB, vbA); PG_STAGE(PG_SB(0, 1), cB + hsC, vbA); } else { PG_STAGE(PG_SB(0, 0), cB, vbD); PG_STAGE(PG_SB(0, 1), cB + hsC, vbD); }
    PG_STAGE(PG_SA(0, 0), cA, voC[0]); PG_STAGE(PG_SA(0, 1), cA, voC[1]);
    if (wr == 1) PG_BAR;
    PG_WAIT_V(2); PG_BAR;
    if (cur.type == 0) { PG_STAGE(PG_SB(1, 0), cB + kstep, vbA); } else { PG_STAGE(PG_SB(1, 0), cB + kstep, vbD); }
    PG_STAGE(PG_SA(1, 0), cA + kstep, voC[0]);
    if (cur.type == 0) { PG_STAGE(PG_SB(1, 1), cB + hsC + kstep, vbA); } else { PG_STAGE(PG_SB(1, 1), cB + hsC + kstep, vbD); }
    PG_WAIT_V(6); PG_BAR;
    for (;;) {
        const bool has_next = S.next(ui + 1, nxt, lds); nxt.buf = (ui + 1) % 3;
        if (has_next && nxt.type == 0) S.stage_table(nxt, (ui + 1) % 3, lds, wid, lane);
        const char* nB = has_next ? nxt.B : cB; const char* nA = has_next ? nxt.A : cA; const size_t hsN = has_next ? (size_t)(nxt.type == 0 ? HALF : 8) * nxt.K * 2 : hsC;
        for (int t = 0; t < nt; t += 2) {
            const bool last = (t == nt - 2);
            if (last && has_next && nxt.type == 1) S.wait_ready(nxt, wid);
            unsigned vb2[2]; const bool b2gu = last ? (has_next ? nxt.type == 0 : cur.type == 0) : (cur.type == 0);
#pragma unroll
            for (int i = 0; i < 2; ++i) vb2[i] = b2gu ? vbA[i] : vbD[i];
            const size_t hs2 = last ? hsN : hsC;
            const char* a1 = cA + (size_t)(t + 1) * kstep;
            const char* a2 = last ? nA : cA + (size_t)(t + 2) * kstep; const char* b2 = last ? nB : cB + (size_t)(t + 2) * kstep;
            const char* a3 = a2 + kstep; const char* b3 = b2 + kstep;
            PG_LDB(B0, 0, 0); PG_LDB(B1, 0, 1); PG_SCHED; PG_LDA(At, 0, 0); PG_STAGE(PG_SA(1, 1), a1, voC[1]);
            if (last && has_next) {
#pragma unroll
                for (int h = 0; h < 2; ++h)
#pragma unroll
                    for (int i = 0; i < 2; ++i) { int R, C; stage_rc(tid * 16 + i * 8192, R, C); voC[h][i] = S.voff(nxt, (ui + 1) % 3, lds, h * HALF + R, C); }
            }
            PG_WAIT_V(8); PG_WAIT_L(0); PG_BAR; PG_MMA(0, 0, At, B0); PG_MMA(0, 1, At, B1); PG_BAR; PG_SCHED;
            PG_LDA(At, 0, 1); PG_STAGE(PG_SB(0, 0), b2, vb2); PG_STAGE(PG_SB(0, 1), b2 + hs2, vb2); PG_STAGE(PG_SA(0, 0), a2, voC[0]);
            PG_WAIT_V(8); PG_WAIT_L(0); PG_BAR; PG_MMA(1, 0, At, B0); PG_MMA(1, 1, At, B1); PG_BAR; PG_SCHED;
            PG_LDB(B0, 1, 0); PG_LDB(B1, 1, 1); PG_SCHED; PG_LDA(At, 1, 0); PG_STAGE(PG_SA(0, 1), a2, voC[1]);
            PG_WAIT_V(8); PG_WAIT_L(0); PG_BAR; PG_MMA(0, 0, At, B0); PG_MMA(0, 1, At, B1); PG_BAR; PG_SCHED;
            PG_LDA(At, 1, 1); PG_STAGE(PG_SB(1, 0), b3, vb2); PG_STAGE(PG_SB(1, 1), b3 + hs2, vb2); PG_STAGE(PG_SA(1, 0), a3, voC[0]);
            PG_WAIT_V(8); PG_WAIT_L(0); PG_BAR; PG_MMA(1, 0, At, B0); PG_MMA(1, 1, At, B1); PG_BAR; PG_SCHED;
        }
        if (wr == 0) PG_BAR;
        asm volatile("s_nop 15\n\ts_nop 15" ::: "memory");
        const int le_ = fresh_lane(), fre = le_ & 15, fqe = le_ >> 4;
        if (cur.type == 0) { EA(acc, cur, wr, wc, fre, fqe);
            PG_WAIT_V(0);
            if (lane == 0) __hip_atomic_fetch_add(S.tile_word(cur), 1u, __ATOMIC_RELAXED, __HIP_MEMORY_SCOPE_AGENT); }
        else EB(acc, cur, wr, wc, fre, fqe);
        if (!has_next) break;
#pragma unroll
        for (int a = 0; a < 2; ++a)
#pragma unroll
            for (int b = 0; b < 2; ++b)
#pragma unroll
                for (int m = 0; m < 4; ++m)
#pragma unroll
                    for (int n = 0; n < 2; ++n) acc[a][b][m][n] = (f32x4){0.f, 0.f, 0.f, 0.f};
        cur = nxt; cB = nB; cA = nA; hsC = hsN; nt = cur.K / BK; ++ui;
        if (wr == 1) PG_BAR;
    }
    PG_WAIT_V(0);
    PG_BAR;
#undef PG_SA
#undef PG_SB
#undef PG_STAGE
#undef PG_LDA
#undef PG_LDB
#undef PG_MMA
#undef PG_C8
#undef PG_WAIT_V
#undef PG_WAIT_L
#undef PG_BAR
#undef PG_SCHED
}
}
__device__ __forceinline__ void fast_moe_merged(Frame& F, int layer) {
    LAS int* mm = moe_map(F, layer);
    int U = 0;
    for (int e = 0; e < 16; ++e) U += ((mm[e] + 255) >> 8) * 4;
    pg::MoeMergedSched S{(const char*)(F.ws + WS_WGU) + (size_t)layer * 16 * 1024 * 1024, (const char*)(F.ws + WS_WDN) + (size_t)layer * 16 * 1024 * 512,
                         (const char*)(F.ws + WS_HB), (const char*)(F.ws + WS_HID), (const int*)(F.ws + WS_SLOTT) + layer * 16 * CAP, (const float*)(F.ws + WS_SLOTW) + layer * 16 * CAP, mm,
                         F.ctl + CW_TILE + layer * 288 * 64, F.ctl + CW_TMO2, F.G, F.wg, U, false};
    pg::EpiGateUpWT EA{__builtin_amdgcn_make_buffer_rsrc((void*)(F.ws + WS_HID), 0, HROWS * FF, 0x00020000), F.lds, mm, F.ws + WS_HID};
    pg::EpiDownM EB{(unsigned char*)(F.ws + WS_Y), mm};
    if (F.tid < 16) { pg::MU u; const bool ok = S.next_search(F.tid, u); LAS int* r = S.recs(F.lds) + F.tid * 8;
        r[0] = ok ? u.type : -1; r[1] = u.e; r[2] = u.rt; r[3] = u.pn; r[4] = u.hb; }
    __syncthreads();
    pg::gemm_phase_moe(F.lds, S, EA, EB);
}

constexpr int NPH = 18;
__global__ void __launch_bounds__(NTHR, 2) mega(Args args) {
    extern __shared__ __attribute__((aligned(16))) unsigned char lds[];
    Frame F;
    F.lds = (LAS unsigned char*)lds;
    F.tid = threadIdx.x; F.lane = F.tid & 63; F.wave = __builtin_amdgcn_readfirstlane(F.tid >> 6);
    F.G = gridDim.x; F.wg = blockIdx.x;
    F.out = args.out; F.ws = args.ws; F.ctl = (unsigned*)(args.ws + WS_CTL);
    volatile LAS unsigned* bst = (volatile LAS unsigned*)(F.lds + LDS_BYTES - 16);
    if (F.tid < 4) bst[F.tid] = 0u;
    __syncthreads();
    const int lo = args.ph_lo, hi = args.ph_hi;
    XcdBarrier bar; bar.bar = F.ctl + CW_BAR; bar.x = 0; bar.st = bst;
    if (hi - lo > 1) bar = xcd_barrier_post(F.ctl + CW_BAR, bst);
#define IN(k) (lo <= (k) && (k) < hi)
#define SEAM(k) do { if (IN(k) && IN((k) + 1)) xcd_barrier(bar); } while (0)
    const float* mod = (const float*)(F.ws + WS_MOD);

#ifndef DBL_MASK
#define DBL_MASK 0x0u
#endif
#define RUN(k, body) do { if (IN(k)) { _Pragma("unroll 1") for (int _r = 0; _r < ((((DBL_MASK) >> (k)) & 1u) ? 2 : 1); ++_r) { if (_r) xcd_barrier(bar); F.lane = fresh_lane(); body; } } } while (0)
    RUN(0, phase_prep(F));
    RUN(1, phase_norm1_l0(F)); SEAM(1);
    RUN(2, if (FAST_GEMM) fast_inproj(F); else phase_inproj(F)); SEAM(2);
    if (IN(3)) { F.lane = fresh_lane();
#pragma unroll 1
        for (int _r = 0; _r < ((DBL_MASK & 0x100000u) ? 2 : 1); ++_r) { if (FAST_ATTN == 2 && FAST_GEMM) phase_attn_lds(F); else if (FAST_ATTN && FAST_GEMM) phase_attn_mfma(F); else phase_attn_simple(F); }
#pragma unroll 1
        for (int _r = 0; _r < ((DBL_MASK & 0x200000u) ? 2 : 1); ++_r) { F.lane = fresh_lane(); if (FAST_FFT) phase_fft1_mfma(F); else phase_fft1_simple(F); }
    }
    RUN(4, if (FAST_FFT) phase_fft2_mfma(F); else phase_fft2_simple(F)); SEAM(4);
    if (IN(5)) { if (!FAST_FFT) phase_fft3_simple(F); } if (!FAST_FFT) SEAM(5);
    RUN(6, if (FAST_GEMM) fast_outproj(F, WS_MIX, WS_WOUT, F.in[I_X], F.out, mod + 2048, nullptr); else phase_outproj(F, (const bf16*)(F.ws + WS_MIX), (const bf16*)(F.ws + WS_WOUT), F.in[I_X], F.out, mod + 2048, nullptr)); SEAM(6);
    if (IN(7)) { F.lane = fresh_lane(); if (XBF16) phase_norm2_route_mfma(F, 0); else phase_norm2_route(F, 0); } SEAM(7);
    if (MOE_F8 == 2 && FAST_GEMM) { RUN(8, fast_moe_gateup_f8(F, 0)); SEAM(8); RUN(9, fast_moe_down_f8(F, 0)); SEAM(9); }
    else if (MOE_MERGED && FAST_GEMM) { if (IN(8)) { F.lane = fresh_lane(); fast_moe_merged(F, 0); } if (IN(8) && IN(10)) xcd_barrier(bar); }
    else { RUN(8, if (FAST_GEMM) fast_moe_gateup(F, 0); else phase_moe_gateup(F, 0)); SEAM(8);
    RUN(9, if (FAST_GEMM) fast_moe_down(F, 0); else phase_moe_down(F, 0)); SEAM(9); }
    if (IN(10)) { F.lane = fresh_lane(); phase_combine<false>(F, 0); } SEAM(10);
    RUN(11, if (FAST_GEMM) fast_pw1(F); else phase_pw1(F)); SEAM(11);
    RUN(12, phase_dwconv_fast(F)); SEAM(12);
    if (IN(13)) { F.lane = fresh_lane(); if (FAST_GEMM) fast_outproj(F, WS_V1, WS_WPW2, F.out, F.out, mod + 5 * 6144 + 2048, F.in[I_PW2B]); else phase_outproj(F, (const bf16*)(F.ws + WS_V1), (const bf16*)(F.ws + WS_WPW2), F.out, F.out, mod + 5 * 6144 + 2048, F.in[I_PW2B]); } SEAM(13);
    if (IN(14)) { F.lane = fresh_lane(); if (XBF16) phase_norm2_route_mfma(F, 1); else phase_norm2_route(F, 1); } SEAM(14);
    if (MOE_F8 == 2 && FAST_GEMM) { RUN(15, fast_moe_gateup_f8(F, 1)); SEAM(15); RUN(16, fast_moe_down_f8(F, 1)); SEAM(16); }
    else if (MOE_MERGED && FAST_GEMM) { if (IN(15)) { F.lane = fresh_lane(); fast_moe_merged(F, 1); } if (IN(15) && IN(17)) xcd_barrier(bar); }
    else { RUN(15, if (FAST_GEMM) fast_moe_gateup(F, 1); else phase_moe_gateup(F, 1)); SEAM(15);
    RUN(16, if (FAST_GEMM) fast_moe_down(F, 1); else phase_moe_down(F, 1)); SEAM(16); }
    if (IN(17)) { F.lane = fresh_lane(); phase_combine<true>(F, 1); }
#undef RUN
#undef IN
#undef SEAM
}

extern "C" void kernel_launch(void* const* d_in, const int* in_sizes, int n_in, void* d_out, int out_size, void* d_ws, size_t ws_size, hipStream_t stream) {
    static int grid = 0;
    if (grid == 0) {
        if (n_in != 25 || out_size != T * D || ws_size < WS_END) { fprintf(stderr, "kernel_launch: unexpected shapes (n_in %d out %d ws %zu)\n", n_in, out_size, ws_size); grid = -1; return; }
        int dev = 0, cus = 0, per_cu = 0;
        if (hipGetDevice(&dev) != hipSuccess || hipDeviceGetAttribute(&cus, hipDeviceAttributeMultiprocessorCount, dev) != hipSuccess) { grid = -1; return; }
        if (hipFuncSetAttribute((const void*)mega, hipFuncAttributeMaxDynamicSharedMemorySize, LDS_BYTES) != hipSuccess) { fprintf(stderr, "kernel_launch: hipFuncSetAttribute failed\n"); grid = -1; return; }
        if (hipOccupancyMaxActiveBlocksPerMultiprocessor(&per_cu, (const void*)mega, NTHR, LDS_BYTES) != hipSuccess || per_cu < 1) { fprintf(stderr, "kernel_launch: occupancy query says %d\n", per_cu); }
        (void)hipGetLastError();
        grid = cus;
    }
    if (grid < 0) return;
    (void)hipMemsetAsync((char*)d_ws + WS_CTL, 0, CTL_BYTES, stream);
    Args a{};
    for (int i = 0; i < 25; ++i) a.in[i] = (const float*)d_in[i];
    a.out = (float*)d_out; a.ws = (unsigned char*)d_ws;
#if MK_ONE_LAUNCH
    a.ph_lo = 0; a.ph_hi = NPH;
    hipLaunchKernelGGL(mega, dim3(grid), dim3(NTHR), LDS_BYTES, stream, a);
#else
#ifndef PROBE_PHASE
#define PROBE_PHASE -1
#endif
    for (int p = 0; p < NPH; ++p) { a.ph_lo = p; a.ph_hi = p + 1; hipLaunchKernelGGL(mega, dim3(grid), dim3(NTHR), LDS_BYTES, stream, a);
        if (p == PROBE_PHASE) { if (p == 7 || p == 14) (void)hipMemsetAsync((char*)d_ws + WS_CTL, 0, CTL_BYTES, stream);
            hipLaunchKernelGGL(mega, dim3(grid), dim3(NTHR), LDS_BYTES, stream, a); } }
#endif
}
```
